# Optimizing an MI355X kernel written in HIP

```python
import jax, jax.numpy as jnp
from jax import lax
import numpy as np

D_MODEL = 1024
BATCH = 8
SEQ = 2048
DEPTH = 2

GRID_W = 64
CTX_LEN = 256
HEAD_DIM = 64
N_Q_HEADS = (D_MODEL // 2) // HEAD_DIM
N_KV_HEADS = 2
Q_PER_KV = N_Q_HEADS // N_KV_HEADS
Q_DIM = N_Q_HEADS * HEAD_DIM
KV_DIM = N_KV_HEADS * HEAD_DIM
WINDOW = 128
ATT_BLOCK = 128
ROPE_THETA = 10000.0
ROPE_PAIRS_PER_AXIS = HEAD_DIM // 4
CONV_CH = D_MODEL // 2
CONV_WIDTH = 31
EVEN_IN = 2 * CONV_CH + Q_DIM + 2 * KV_DIM
EVEN_MIX = CONV_CH + Q_DIM
KV_COL = 2 * CONV_CH + Q_DIM
CHUNK = 128
GMLP_CH = D_MODEL
GMLP_GROUPS = 8
GMLP_GROUP_CH = GMLP_CH // GMLP_GROUPS
N_EXPERTS = 32
TOP_K = 4
EXPERT_FF = D_MODEL
SWIGLU_LIMIT = 7.0
SWIGLU_ALPHA = 1.702
MOE_BLOCK = 128

EPS = 1e-6
NEG_INF = -1e30

kernel_name = "hybrid_conv_swa_gmlp_moe_dit"


def rms_norm(x, g):
    xf = x.astype(jnp.float32)
    y = xf * lax.rsqrt(jnp.mean(xf * xf, axis=-1, keepdims=True) + EPS)
    return (y * g).astype(x.dtype)


def layer_norm(x, g, b):
    xf = x.astype(jnp.float32)
    mu = jnp.mean(xf, axis=-1, keepdims=True)
    var = jnp.mean(jnp.square(xf - mu), axis=-1, keepdims=True)
    return ((xf - mu) * lax.rsqrt(var + EPS) * g + b).astype(x.dtype)


def ada_modulation(cvec, w, b):
    return jnp.split(jax.nn.silu(cvec) @ w + b, 6, axis=-1)


def modulate(x, g, shift, scale):
    return rms_norm(x, g) * (1.0 + scale) + shift


def axial_rope(rows):
    r = jnp.repeat(jnp.arange(rows), GRID_W).astype(jnp.float32)
    col = jnp.tile(jnp.arange(GRID_W), rows).astype(jnp.float32)
    inv_freq = ROPE_THETA ** (-jnp.arange(ROPE_PAIRS_PER_AXIS, dtype=jnp.float32) / ROPE_PAIRS_PER_AXIS)
    ang = jnp.concatenate([r[:, None] * inv_freq, col[:, None] * inv_freq], axis=-1)
    return jnp.cos(ang), jnp.sin(ang)


def apply_rope(x, cos, sin):
    xf = x.astype(jnp.float32)
    x1, x2 = jnp.split(xf, 2, axis=-1)
    c, s = cos[None, :, None, :], sin[None, :, None, :]
    return jnp.concatenate([x1 * c - x2 * s, x2 * c + x1 * s], axis=-1).astype(x.dtype)


def sink_softmax(logits, sink_logit):
    sink_b = jnp.broadcast_to(sink_logit, logits.shape[:-1] + (1,))
    p = jax.nn.softmax(jnp.concatenate([logits, sink_b], axis=-1), axis=-1)
    return p[..., :-1]


def conformer_conv(a_in, conv_w, conv_b, ln_g, ln_b):
    u, gate = jnp.split(a_in, 2, axis=-1)
    u = u * jax.nn.sigmoid(gate)
    u = lax.conv_general_dilated(
        u, conv_w[:, None, :], window_strides=(1,),
        padding=[(CONV_WIDTH // 2, CONV_WIDTH // 2)],
        dimension_numbers=('NWC', 'WIO', 'NWC'),
        feature_group_count=CONV_CH) + conv_b
    return jax.nn.silu(layer_norm(u, ln_g, ln_b))


def windowed_attention(q, k, v, k_c, v_c, sink):
    bsz, n = q.shape[0], q.shape[1]
    nb = n // ATT_BLOCK
    scale = HEAD_DIM ** -0.5
    qb = q.reshape(bsz, nb, ATT_BLOCK, N_KV_HEADS, Q_PER_KV, HEAD_DIM)

    def band(t):
        tp = jnp.pad(t, ((0, 0), (ATT_BLOCK, ATT_BLOCK), (0, 0), (0, 0)))
        tp = tp.reshape(bsz, nb + 2, ATT_BLOCK, N_KV_HEADS, HEAD_DIM)
        return jnp.concatenate([tp[:, :-2], tp[:, 1:-1], tp[:, 2:]], axis=2)

    kw, vw = band(k), band(v)
    s_win = jnp.einsum('bnqkgd,bnpkd->bnkgqp', qb, kw).astype(jnp.float32) * scale
    s_ctx = jnp.einsum('bnqkgd,bpkd->bnkgqp', qb, k_c).astype(jnp.float32) * scale
    qi = jnp.arange(ATT_BLOCK)[:, None]
    kp = jnp.arange(3 * ATT_BLOCK)[None, :]
    kpos = jnp.arange(nb)[:, None, None] * ATT_BLOCK - ATT_BLOCK + kp
    valid = (jnp.abs(kp - ATT_BLOCK - qi) <= WINDOW)[None] & (kpos >= 0) & (kpos < n)
    s_win = jnp.where(valid[None, :, None, None], s_win, NEG_INF)
    sink_l = sink.reshape(N_KV_HEADS, Q_PER_KV, 1, 1).astype(jnp.float32)
    p = sink_softmax(jnp.concatenate([s_win, s_ctx], axis=-1), sink_l).astype(v.dtype)
    p_win, p_ctx = p[..., :3 * ATT_BLOCK], p[..., 3 * ATT_BLOCK:]
    out = (jnp.einsum('bnkgqp,bnpkd->bnqkgd', p_win, vw)
           + jnp.einsum('bnkgqp,bpkd->bnqkgd', p_ctx, v_c))
    return out.reshape(bsz, n, Q_DIM)


def context_attention(q_c, k_c, v_c, sink):
    bsz, nl = q_c.shape[0], q_c.shape[1]
    qg = q_c.reshape(bsz, nl, N_KV_HEADS, Q_PER_KV, HEAD_DIM)
    s = jnp.einsum('bqkgd,bpkd->bkgqp', qg, k_c).astype(jnp.float32) * (HEAD_DIM ** -0.5)
    p = sink_softmax(s, sink.reshape(N_KV_HEADS, Q_PER_KV, 1, 1).astype(jnp.float32)).astype(v_c.dtype)
    return jnp.einsum('bkgqp,bpkd->bqkgd', p, v_c).reshape(bsz, nl, Q_DIM)


def even_mixer(hm, gm, w_in, b_in, conv_w, conv_b, ln_g, ln_b, qn_g, kn_g, sink, w_out, b_out,
               cos, sin, ctx_out):
    bsz, n, _ = hm.shape
    splits = [2 * CONV_CH, KV_COL, KV_COL + KV_DIM]
    a_in, q, k, v = jnp.split(hm @ w_in + b_in, splits, axis=-1)
    conv_h = conformer_conv(a_in, conv_w, conv_b, ln_g, ln_b)
    q = apply_rope(rms_norm(q.reshape(bsz, n, N_Q_HEADS, HEAD_DIM), qn_g), cos, sin)
    k = apply_rope(rms_norm(k.reshape(bsz, n, N_KV_HEADS, HEAD_DIM), kn_g), cos, sin)
    v = v.reshape(bsz, n, N_KV_HEADS, HEAD_DIM)
    nl = gm.shape[1]
    if ctx_out:
        a_c, q_c, k_c, v_c = jnp.split(gm @ w_in + b_in, splits, axis=-1)
    else:
        k_c, v_c = jnp.split(gm @ w_in[:, KV_COL:] + b_in[KV_COL:], 2, axis=-1)
    k_c = rms_norm(k_c.reshape(bsz, nl, N_KV_HEADS, HEAD_DIM), kn_g)
    v_c = v_c.reshape(bsz, nl, N_KV_HEADS, HEAD_DIM)
    att_h = windowed_attention(q, k, v, k_c, v_c, sink)
    out_h = jnp.concatenate([conv_h, att_h], axis=-1) @ w_out + b_out
    if not ctx_out:
        return out_h, None
    q_c = rms_norm(q_c.reshape(bsz, nl, N_Q_HEADS, HEAD_DIM), qn_g)
    att_c = context_attention(q_c, k_c, v_c, sink)
    conv_c = conformer_conv(a_c, conv_w, conv_b, ln_g, ln_b)
    out_c = jnp.concatenate([conv_c, att_c], axis=-1) @ w_out + b_out
    return out_h, out_c


def chunk_gmlp(xm, w_in, b_in, ln_g, ln_b, w_s, b_s, w_out, b_out):
    bsz, n, _ = xm.shape
    z = jax.nn.gelu(xm @ w_in + b_in, approximate=False)
    u, v = jnp.split(z, 2, axis=-1)
    v = layer_norm(v, ln_g, ln_b).reshape(bsz, n // CHUNK, CHUNK, GMLP_GROUPS, GMLP_GROUP_CH)
    sv = jnp.einsum('gpq,bnqgc->bnpgc', w_s, v) + b_s.T[:, :, None]
    return (u * sv.reshape(bsz, n, GMLP_CH)) @ w_out + b_out


def moe_ffn(xf, r_w, r_b, w1, b1, w2, b2):
    n, d = xf.shape
    logits = (xf @ r_w + r_b).astype(jnp.float32)
    top_val, top_idx = lax.top_k(logits, TOP_K)
    gates = jax.nn.softmax(top_val, axis=-1)
    n_assign = n * TOP_K
    flat_e = top_idx.reshape(-1)
    order = jnp.argsort(flat_e)
    e_sorted = flat_e[order]
    tok_sorted = order // TOP_K
    counts = jnp.zeros((N_EXPERTS,), jnp.int32).at[flat_e].add(1)
    padded = (counts + MOE_BLOCK - 1) // MOE_BLOCK * MOE_BLOCK
    start = jnp.cumsum(counts) - counts
    pend = jnp.cumsum(padded)
    pstart = pend - padded
    dest = pstart[e_sorted] + jnp.arange(n_assign) - start[e_sorted]
    n_blocks = (n_assign + N_EXPERTS * (MOE_BLOCK - 1) + MOE_BLOCK - 1) // MOE_BLOCK
    rows = jnp.zeros((n_blocks * MOE_BLOCK, d), xf.dtype).at[dest].set(xf[tok_sorted])
    block_expert = jnp.minimum(
        jnp.searchsorted(pend, jnp.arange(n_blocks) * MOE_BLOCK, side='right'), N_EXPERTS - 1)

    def expert_block(args):
        xb, e = args
        gate, up = jnp.split(xb @ w1[e] + b1[e], 2, axis=-1)
        gate = jnp.minimum(gate, SWIGLU_LIMIT)
        up = jnp.clip(up, -SWIGLU_LIMIT, SWIGLU_LIMIT)
        act = (up + 1.0) * gate * jax.nn.sigmoid(gate * SWIGLU_ALPHA)
        return act @ w2[e] + b2[e]

    y_rows = lax.map(expert_block, (rows.reshape(n_blocks, MOE_BLOCK, d), block_expert)).reshape(-1, d)
    y_assign = y_rows[dest] * gates.reshape(-1)[order][:, None].astype(xf.dtype)
    return jax.ops.segment_sum(y_assign, tok_sorted, num_segments=n)


def setup_inputs(seed: int = 0) -> dict:
    key = jax.random.key(seed)
    ks = iter(jax.random.split(key, 40))
    ne, no = (DEPTH + 1) // 2, DEPTH // 2
    d = D_MODEL

    def nrm(shape, scale):
        return jax.random.normal(next(ks), shape, jnp.float32) * scale

    return {
        'x': nrm((BATCH, SEQ, d), 1.0),
        'c': nrm((BATCH, d), 1.0),
        'ctx': nrm((BATCH, CTX_LEN, d), 1.0),
        'c_ctx': nrm((d,), 1.0),
        'ada_w': nrm((DEPTH, d, 6 * d), 0.5 * d ** -0.5),
        'ada_b': nrm((DEPTH, 6 * d), 0.02),
        'norm_mix_g': 1.0 + nrm((DEPTH, d), 0.1),
        'norm_ffn_g': 1.0 + nrm((DEPTH, d), 0.1),
        'ev_w_in': nrm((ne, d, EVEN_IN), d ** -0.5),
        'ev_b_in': nrm((ne, EVEN_IN), 0.02),
        'ev_conv_w': nrm((ne, CONV_WIDTH, CONV_CH), CONV_WIDTH ** -0.5),
        'ev_conv_b': nrm((ne, CONV_CH), 0.02),
        'ev_conv_ln_g': 1.0 + nrm((ne, CONV_CH), 0.1),
        'ev_conv_ln_b': nrm((ne, CONV_CH), 0.02),
        'ev_q_norm_g': 1.0 + nrm((ne, HEAD_DIM), 0.1),
        'ev_k_norm_g': 1.0 + nrm((ne, HEAD_DIM), 0.1),
        'ev_sink': nrm((ne, N_Q_HEADS), 0.5),
        'ev_w_out': nrm((ne, EVEN_MIX, d), EVEN_MIX ** -0.5),
        'ev_b_out': nrm((ne, d), 0.02),
        'od_w_in': nrm((no, d, 2 * GMLP_CH), d ** -0.5),
        'od_b_in': nrm((no, 2 * GMLP_CH), 0.02),
        'od_v_ln_g': 1.0 + nrm((no, GMLP_CH), 0.1),
        'od_v_ln_b': nrm((no, GMLP_CH), 0.02),
        'od_w_s': nrm((no, GMLP_GROUPS, CHUNK, CHUNK), CHUNK ** -0.5),
        'od_b_s': 1.0 + nrm((no, GMLP_GROUPS, CHUNK), 0.1),
        'od_w_out': nrm((no, GMLP_CH, d), GMLP_CH ** -0.5),
        'od_b_out': nrm((no, d), 0.02),
        'moe_router_w': nrm((DEPTH, d, N_EXPERTS), d ** -0.5),
        'moe_router_b': nrm((DEPTH, N_EXPERTS), 0.01),
        'moe_w1': nrm((DEPTH, N_EXPERTS, d, 2 * EXPERT_FF), d ** -0.5),
        'moe_b1': nrm((DEPTH, N_EXPERTS, 2 * EXPERT_FF), 0.02),
        'moe_w2': nrm((DEPTH, N_EXPERTS, EXPERT_FF, d), EXPERT_FF ** -0.5),
        'moe_b2': nrm((DEPTH, N_EXPERTS, d), 0.02),
    }


def reference(x, c, ctx, c_ctx, ada_w, ada_b, norm_mix_g, norm_ffn_g,
              ev_w_in, ev_b_in, ev_conv_w, ev_conv_b, ev_conv_ln_g, ev_conv_ln_b,
              ev_q_norm_g, ev_k_norm_g, ev_sink, ev_w_out, ev_b_out,
              od_w_in, od_b_in, od_v_ln_g, od_v_ln_b, od_w_s, od_b_s, od_w_out, od_b_out,
              moe_router_w, moe_router_b, moe_w1, moe_b1, moe_w2, moe_b2):
    n_lat = x.shape[1]
    rows = n_lat // GRID_W
    cos, sin = axial_rope(rows)
    h, g = x, ctx
    for l in range(DEPTH):
        i = l // 2
        is_even = l % 2 == 0
        ctx_read_later = any(j % 2 == 0 for j in range(l + 1, DEPTH))
        sh_m, sc_m, gt_m, sh_f, sc_f, gt_f = [m[:, None, :] for m in ada_modulation(c, ada_w[l], ada_b[l])]
        hm = modulate(h, norm_mix_g[l], sh_m, sc_m)
        if is_even or ctx_read_later:
            csh_m, csc_m, cgt_m, csh_f, csc_f, cgt_f = ada_modulation(c_ctx, ada_w[l], ada_b[l])
            gm = modulate(g, norm_mix_g[l], csh_m, csc_m)
        if is_even:
            mix_h, mix_g = even_mixer(hm, gm, ev_w_in[i], ev_b_in[i], ev_conv_w[i], ev_conv_b[i],
                                      ev_conv_ln_g[i], ev_conv_ln_b[i], ev_q_norm_g[i], ev_k_norm_g[i],
                                      ev_sink[i], ev_w_out[i], ev_b_out[i], cos, sin, ctx_read_later)
        else:
            gmlp_args = (od_w_in[i], od_b_in[i], od_v_ln_g[i], od_v_ln_b[i], od_w_s[i], od_b_s[i],
                         od_w_out[i], od_b_out[i])
            mix_h = chunk_gmlp(hm, *gmlp_args)
            mix_g = chunk_gmlp(gm, *gmlp_args) if ctx_read_later else None
        h = h + gt_m * mix_h
        moe_args = (moe_router_w[l], moe_router_b[l], moe_w1[l], moe_b1[l], moe_w2[l], moe_b2[l])
        hf = modulate(h, norm_ffn_g[l], sh_f, sc_f)
        if ctx_read_later:
            g = g + cgt_m * mix_g
            gf = modulate(g, norm_ffn_g[l], csh_f, csc_f)
            tokens = jnp.concatenate([gf, hf], axis=1)
            y = moe_ffn(tokens.reshape(-1, D_MODEL), *moe_args).reshape(tokens.shape)
            g = g + cgt_f * y[:, :g.shape[1]]
            h = h + gt_f * y[:, g.shape[1]:]
        else:
            h = h + gt_f * moe_ffn(hf.reshape(-1, D_MODEL), *moe_args).reshape(h.shape)
    return h
```

```cpp
#include <hip/hip_runtime.h>
#include <cstdio>
#include <cstdint>

#ifndef SLOW_MASK
#define SLOW_MASK 0x7f
#endif

#define LAS __attribute__((address_space(3)))
typedef unsigned short bf16;
typedef short bf16x8 __attribute__((ext_vector_type(8)));
typedef float f32x4 __attribute__((ext_vector_type(4)));
typedef float f32x2 __attribute__((ext_vector_type(2)));
typedef unsigned u32x4 __attribute__((ext_vector_type(4)));
typedef unsigned u32x2 __attribute__((ext_vector_type(2)));
typedef __bf16 bf16x2_t __attribute__((ext_vector_type(2)));

constexpr int NB = 8, SEQ = 2048, D = 1024, NTOK = NB * SEQ, CTXL = 256, NCTX = NB * CTXL;
constexpr int NE = 32, TOPK = 4, NASSIGN = NTOK * TOPK, ACT_ROWS = NASSIGN + NE * 256;
constexpr int EVEN_IN = 1792, KV_COL = 1536;
constexpr float EPS = 1e-6f, LOG2E = 1.4426950408889634f;
constexpr float QSCALE = 0.125f * LOG2E;
constexpr int MODW = 6 * D;
constexpr int NWAVES = 8, NTHREADS = 512;

constexpr size_t MiB = 1u << 20;
constexpr size_t WS_CTL = 0, CTL_ZERO_BYTES = 1 * MiB;
constexpr size_t WS_MOD = 1 * MiB;
constexpr size_t WS_LIST = 2 * MiB;
constexpr size_t WS_GATE = 4 * MiB;
constexpr size_t WS_WSB = 5 * MiB;
constexpr size_t WS_WINT = 6 * MiB;
constexpr size_t WS_WOUTT = 10 * MiB;
constexpr size_t WS_GWINT = 12 * MiB;
constexpr size_t WS_GWOUTT = 16 * MiB;
constexpr size_t WS_KC = 18 * MiB;
constexpr size_t WS_VC = 18 * MiB + 512 * 1024;
constexpr size_t WS_K = 19 * MiB;
constexpr size_t WS_V = 23 * MiB;
constexpr size_t WS_GM = 27 * MiB;
constexpr size_t WS_AROW = 31 * MiB;
constexpr size_t WS_Q = 32 * MiB;
constexpr size_t WS_GLU = 48 * MiB;
constexpr size_t WS_XA = 64 * MiB;
constexpr size_t WS_MIX = 96 * MiB;
constexpr size_t WS_H = 128 * MiB;
constexpr size_t WS_U = 192 * MiB;
constexpr size_t WS_VB = 224 * MiB;
constexpr size_t WS_W1T = 256 * MiB;
constexpr size_t WS_W2T = 512 * MiB;
constexpr size_t WS_ACT = 640 * MiB;
constexpr size_t WS_Y = 784 * MiB;
constexpr size_t WS_CF = 912 * MiB;
constexpr size_t WS_END = 1488 * MiB;
constexpr int CW_BAR = 4096, CW_CNT = 131072;
constexpr int MAX_LAUNCH = 20;

constexpr int RING_BYTES = 131072;
constexpr int MISC_OFF = RING_BYTES;
constexpr int TAB_OFF = RING_BYTES + 256;
constexpr int LDS_BYTES = 147456;

#define LDS_WAIT() asm volatile("s_waitcnt lgkmcnt(0)" ::: "memory")
#define VM_WAIT() asm volatile("s_waitcnt vmcnt(0)" ::: "memory")

__device__ __forceinline__ float bf2f(unsigned b) { return __uint_as_float(b << 16); }
__device__ __forceinline__ unsigned pk2(float lo, float hi) { f32x2 v = {lo, hi}; bf16x2_t b = __builtin_convertvector(v, bf16x2_t); return __builtin_bit_cast(unsigned, b); }
__device__ __forceinline__ float wave_sum(float v) {
#pragma unroll
    for (int o = 1; o < 64; o <<= 1) v += __shfl_xor(v, o);
    return v;
}
__device__ __forceinline__ float sigmoidf_(float x) { return __builtin_amdgcn_rcpf(1.0f + __builtin_amdgcn_exp2f(-x * LOG2E)); }

#define XB_TMO      128
#define XB_XCNT(j)  (256  + 64 * (j))
#define XB_XSUB(j)  (1280 + 64 * (j))
#define XB_XGEN(j)  (2304 + 64 * (j))
#define XB_TOP      3328
#define XB_TOPGEN   3392
#define XCD_BAR_WORDS 3456
#define XB_SPIN_CAP (1u << 20)
__device__ __forceinline__ unsigned xb_ld(unsigned* p)              { return __hip_atomic_load(p, __ATOMIC_RELAXED, __HIP_MEMORY_SCOPE_AGENT); }
__device__ __forceinline__ unsigned xb_add(unsigned* p, unsigned v) { return __hip_atomic_fetch_add(p, v, __ATOMIC_RELAXED, __HIP_MEMORY_SCOPE_AGENT); }
__device__ __forceinline__ unsigned xb_xcc_id() { return (unsigned)__builtin_amdgcn_s_getreg((3 << 11) | 20) & 0xFu; }
#define XB_SPIN(cond, bar) do { unsigned _sp = 0; while (cond) { __builtin_amdgcn_s_sleep(1); \
    if ((++_sp & 255u) == 0u) { if (xb_ld(&(bar)[XB_TMO])) break; if (_sp > XB_SPIN_CAP) { atomicAdd(&(bar)[XB_TMO], 1u); break; } } } } while (0)
struct XcdBarrier { unsigned* bar; unsigned x; volatile LAS unsigned* st; };
__device__ __forceinline__ XcdBarrier xcd_barrier_post(unsigned* bar, volatile LAS unsigned* st) {
    XcdBarrier b; b.bar = bar; b.x = xb_xcc_id(); b.st = st;
    if (threadIdx.x == 0) (void)xb_add(&bar[XB_XCNT(b.x)], 1u);
    return b;
}
__device__ __forceinline__ void xcd_barrier_complete(unsigned* bar, unsigned x, unsigned& nloc, unsigned& nx) {
    const unsigned G = gridDim.x * gridDim.y * gridDim.z;
    unsigned sum, cnt, mine, sp = 0u;
    for (;;) {
        sum = 0u; cnt = 0u; mine = 0u;
#pragma unroll
        for (unsigned j = 0; j < 16; ++j) { const unsigned c = xb_ld(&bar[XB_XCNT(j)]); sum += c; cnt += (c > 0u) ? 1u : 0u; mine = (j == x) ? c : mine; }
        if (sum == G) break;
        __builtin_amdgcn_s_sleep(1);
        if ((++sp & 255u) == 0u) { if (xb_ld(&bar[XB_TMO])) break; if (sp > XB_SPIN_CAP) { atomicAdd(&bar[XB_TMO], 1u); break; } }
    }
    nloc = mine > 0u ? mine : 1u; nx = cnt > 0u ? cnt : 1u;
}
__device__ __forceinline__ void xcd_barrier(const XcdBarrier& b) {
    asm volatile("s_waitcnt vmcnt(0)" ::: "memory");
    __syncthreads();
    if (threadIdx.x == 0) {
        unsigned* bar = b.bar;
        __builtin_amdgcn_s_waitcnt(0);
        unsigned nloc = b.st[0], nx = b.st[1];
        if (nloc == 0u) { xcd_barrier_complete(bar, b.x, nloc, nx); b.st[0] = nloc; b.st[1] = nx; }
        const unsigned old = xb_add(&bar[XB_XSUB(b.x)], 1u);
        const unsigned gen = old / nloc;
        if (old + 1u == (gen + 1u) * nloc) {
            __builtin_amdgcn_fence(__ATOMIC_RELEASE, "agent");
            asm volatile("s_waitcnt vmcnt(0)" ::: "memory");
            const unsigned og = xb_add(&bar[XB_TOP], 1u);
            const unsigned tg = og / nx;
            if (og + 1u == (tg + 1u) * nx) xb_add(&bar[XB_TOPGEN], 1u);
            else XB_SPIN(xb_ld(&bar[XB_TOPGEN]) == tg, bar);
            __builtin_amdgcn_fence(__ATOMIC_ACQUIRE, "agent");
            xb_add(&bar[XB_XGEN(b.x)], 1u);
            asm volatile("s_waitcnt vmcnt(0)" ::: "memory");
        } else {
            XB_SPIN(xb_ld(&bar[XB_XGEN(b.x)]) == gen, bar);
            __builtin_amdgcn_fence(__ATOMIC_ACQUIRE, "agent");
            asm volatile("s_waitcnt vmcnt(0)" ::: "memory");
        }
    }
    __syncthreads();
}

namespace pg8 {
constexpr int BM = 256, BK = 64, HALF = 128, HTB = HALF * BK * 2, STAGE_BYTES = 8 * HTB, KD = 1024  ;
__host__ __device__ __forceinline__ int lds_byte(int r, int c) { const int st = (r >> 4) * 2 + (c >> 5), rr = r & 15, cc = c & 31, ob = rr * 64 + cc * 2; return st * 1024 + (ob ^ (((ob >> 9) & 1) << 5)); }
__host__ __device__ __forceinline__ void stage_rc(int b, int& R, int& C) { const int st = b / 1024, sb = b % 1024, swz = sb ^ (((sb >> 9) & 1) << 5); R = (st >> 1) * 16 + swz / 64; C = (st & 1) * 32 + (swz % 64) / 2; }
__host__ __device__ __forceinline__ int perm32(int rho) { const int n = rho >> 4, i = rho & 15; return 8 * (i >> 2) + 4 * n + (i & 3); }

struct Unit { int pm, pn, e, cnt; };

template <class Epi, class Sched>
__device__ __forceinline__ void gemm_phase(LAS unsigned char* lds, const Sched& S, const Epi& E, const int tid) {
    const int wid = __builtin_amdgcn_readfirstlane(tid >> 6), lane = tid & 63, wr = wid >> 2, wc = wid & 3, fr = lane & 15, fq = lane >> 4;
    constexpr int K = KD, nt = K / BK;
    int Rr[2], Cc[2];
    unsigned voffA[2][2], voffB[2];
#pragma unroll
    for (int i = 0; i < 2; ++i) { stage_rc(tid * 16 + i * 8192, Rr[i], Cc[i]); const int Rb = Epi::PERM ? ((Rr[i] & ~31) + perm32(Rr[i] & 31)) : Rr[i];
        voffB[i] = (unsigned)(Rb * K + Cc[i]) * 2u; }
    constexpr size_t kstep = (size_t)(BK * 2);
    constexpr size_t hstep = (size_t)HALF * K * 2;
    const unsigned ldsw = (unsigned)wid * 1024u;
    const int aoff = lds_byte(wr * 64 + fr, fq * 8), boff = lds_byte(wc * 32 + fr, fq * 8);
#define PG8_SA(b, h) (((b) * 2 + (h)) * HTB)
#define PG8_SB(b, h) ((4 + (b) * 2 + (h)) * HTB)
#define PG8_STAGE(bufoff, gbase, voff) do { _Pragma("unroll") for (int _i = 0; _i < 2; ++_i) \
        __builtin_amdgcn_global_load_lds((const unsigned*)((const char*)(gbase) + (voff)[_i]), (LAS unsigned*)(lds + (bufoff) + ldsw + _i * 8192), 16, 0, 0); } while (0)
#define PG8_LDA(dst, b, h) do { _Pragma("unroll") for (int m = 0; m < 4; ++m) _Pragma("unroll") for (int k = 0; k < 2; ++k) dst[m][k] = *(const LAS bf16x8*)(lds + PG8_SA(b, h) + aoff + m * 2048 + k * 1024); } while (0)
#define PG8_LDB(dst, b, h) do { _Pragma("unroll") for (int n = 0; n < 2; ++n) _Pragma("unroll") for (int k = 0; k < 2; ++k) dst[n][k] = *(const LAS bf16x8*)(lds + PG8_SB(b, h) + boff + n * 2048 + k * 1024); } while (0)
#define PG8_MMA(ai, bj, At, Bt) do { __builtin_amdgcn_s_setprio(1); _Pragma("unroll") for (int m = 0; m < 4; ++m) _Pragma("unroll") for (int n = 0; n < 2; ++n) _Pragma("unroll") for (int k = 0; k < 2; ++k) \
        acc[ai][bj][m][n] = __builtin_amdgcn_mfma_f32_16x16x32_bf16(Bt[n][k], At[m][k], acc[ai][bj][m][n], 0, 0, 0); __builtin_amdgcn_s_setprio(0); } while (0)
#define PG8_WAIT_V(n) asm volatile("s_waitcnt vmcnt(" #n ")" ::: "memory")
#define PG8_WAIT_L(n) asm volatile("s_waitcnt lgkmcnt(" #n ")" ::: "memory")
#define PG8_BAR __builtin_amdgcn_s_barrier()
#define PG8_SCHED __builtin_amdgcn_sched_barrier(0)
    Unit cur, nxt; int ui = 0;
    if (!S.next(0, cur)) return;
    S.a_voff(cur, voffA, Rr, Cc);
    f32x4 acc[2][2][4][2];
#pragma unroll
    for (int a = 0; a < 2; ++a)
#pragma unroll
        for (int b = 0; b < 2; ++b)
#pragma unroll
            for (int m = 0; m < 4; ++m)
#pragma unroll
                for (int n = 0; n < 2; ++n) acc[a][b][m][n] = (f32x4){0.f, 0.f, 0.f, 0.f};
    bf16x8 At[4][2], B0[2][2], B1[2][2];
    const char* cA = S.a_ptr(cur); const char* cB = S.b_ptr(cur);
    PG8_STAGE(PG8_SB(0, 0), cB, voffB); PG8_STAGE(PG8_SB(0, 1), cB + hstep, voffB); PG8_STAGE(PG8_SA(0, 0), cA, voffA[0]); PG8_STAGE(PG8_SA(0, 1), cA, voffA[1]);
    if (wr == 1) PG8_BAR;
    PG8_WAIT_V(2); PG8_BAR;
    PG8_STAGE(PG8_SB(1, 0), cB + kstep, voffB); PG8_STAGE(PG8_SA(1, 0), cA + kstep, voffA[0]); PG8_STAGE(PG8_SB(1, 1), cB + hstep + kstep, voffB);
    PG8_WAIT_V(6); PG8_BAR;
    for (;;) {
        const bool has_next = S.next(ui + 1, nxt);
        const char* nA = has_next ? S.a_ptr(nxt) : cA; const char* nB = has_next ? S.b_ptr(nxt) : cB;
        for (int t = 0; t < nt; t += 2) {
            const bool last = (t == nt - 2);
            const char* a1 = cA + (size_t)(t + 1) * kstep;
            const char* a2 = last ? nA : cA + (size_t)(t + 2) * kstep; const char* b2 = last ? nB : cB + (size_t)(t + 2) * kstep;
            const char* a3 = a2 + kstep; const char* b3 = b2 + kstep;
            PG8_LDB(B0, 0, 0); PG8_LDB(B1, 0, 1); PG8_SCHED; PG8_LDA(At, 0, 0); PG8_STAGE(PG8_SA(1, 1), a1, voffA[1]);
            if (Sched::GATHER) { if (last && has_next) S.a_voff(nxt, voffA, Rr, Cc); }
            PG8_WAIT_V(8); PG8_WAIT_L(0); PG8_BAR; PG8_MMA(0, 0, At, B0); PG8_MMA(0, 1, At, B1); PG8_BAR; PG8_SCHED;
            PG8_LDA(At, 0, 1); PG8_STAGE(PG8_SB(0, 0), b2, voffB); PG8_STAGE(PG8_SB(0, 1), b2 + hstep, voffB); PG8_STAGE(PG8_SA(0, 0), a2, voffA[0]);
            PG8_WAIT_V(8); PG8_WAIT_L(0); PG8_BAR; PG8_MMA(1, 0, At, B0); PG8_MMA(1, 1, At, B1); PG8_BAR; PG8_SCHED;
            PG8_LDB(B0, 1, 0); PG8_LDB(B1, 1, 1); PG8_SCHED; PG8_LDA(At, 1, 0); PG8_STAGE(PG8_SA(0, 1), a2, voffA[1]);
            PG8_WAIT_V(8); PG8_WAIT_L(0); PG8_BAR; PG8_MMA(0, 0, At, B0); PG8_MMA(0, 1, At, B1); PG8_BAR; PG8_SCHED;
            PG8_LDA(At, 1, 1); PG8_STAGE(PG8_SB(1, 0), b3, voffB); PG8_STAGE(PG8_SB(1, 1), b3 + hstep, voffB); PG8_STAGE(PG8_SA(1, 0), a3, voffA[0]);
            PG8_WAIT_V(8); PG8_WAIT_L(0); PG8_BAR; PG8_MMA(1, 0, At, B0); PG8_MMA(1, 1, At, B1); PG8_BAR; PG8_SCHED;
        }
        if (wr == 0) PG8_BAR;
        E(acc, cur, wr, wc, fr, fq);
        if (!has_next) break;
#pragma unroll
        for (int a = 0; a < 2; ++a)
#pragma unroll
            for (int b = 0; b < 2; ++b)
#pragma unroll
                for (int m = 0; m < 4; ++m)
#pragma unroll
                    for (int n = 0; n < 2; ++n) acc[a][b][m][n] = (f32x4){0.f, 0.f, 0.f, 0.f};
        cur = nxt; cA = nA; cB = nB; ++ui;
        if (wr == 1) PG8_BAR;
    }
    PG8_WAIT_V(0);
    PG8_BAR;
#undef PG8_SA
#undef PG8_SB
#undef PG8_STAGE
#undef PG8_LDA
#undef PG8_LDB
#undef PG8_MMA
#undef PG8_WAIT_V
#undef PG8_WAIT_L
#undef PG8_BAR
#undef PG8_SCHED
}
}

struct Args { const float* in[33]; float* out; unsigned char* ws; int ph_lo, ph_hi, li, pad; };
enum { I_X = 0, I_C, I_CTX, I_CCTX, I_ADAW, I_ADAB, I_NMG, I_NFG, I_EWIN, I_EBIN, I_ECW, I_ECB, I_ELNG, I_ELNB, I_QNG, I_KNG, I_SINK, I_EWOUT, I_EBOUT,
       I_OWIN, I_OBIN, I_OLNG, I_OLNB, I_OWS, I_OBS, I_OWOUT, I_OBOUT, I_RW, I_RB, I_W1, I_B1, I_W2, I_B2 };

struct Ctx {
    LAS unsigned char* lds; int tid, lane, wave, G, vcu, gw, NGW; unsigned char* ws;
};

struct DenseSched {
    static constexpr bool GATHER = false;
    const bf16* A; const bf16* Bt; int nM, nN, nwg, G, c;
    const bf16* A2; const bf16* Bt2; int nM2;
    __device__ __forceinline__ void init(const bf16* A_, const bf16* Bt_, int M, int N, int G_, int c_) { A = A_; Bt = Bt_; nM = M / 256; nN = N / 256; nwg = nM * nN; G = G_; c = c_; A2 = nullptr; Bt2 = nullptr; nM2 = 0; }
    __device__ __forceinline__ bool next(int i, pg8::Unit& u) const {
        const int L = i * G + c; if (L >= nwg + nM2) return false;
        if (L >= nwg) { u.pm = L - nwg; u.pn = 0; u.e = 1; u.cnt = 256; return true; }
        int wgid = L; { const int q = nwg / 8, r = nwg % 8, xcd = wgid % 8, off = wgid / 8; wgid = (xcd < r ? xcd * (q + 1) : r * (q + 1) + (xcd - r) * q) + off; }
        const int nig = 8 * nN, gid = wgid / nig, fm = gid * 8, gsz = (nM - fm) < 8 ? (nM - fm) : 8;
        u.pm = fm + ((wgid % nig) % gsz); u.pn = (wgid % nig) / gsz; u.e = 0; u.cnt = 256; return true;
    }
    __device__ __forceinline__ const char* a_ptr(const pg8::Unit& u) const { return (const char*)(u.e ? A2 : A) + (size_t)u.pm * 256 * pg8::KD * 2; }
    __device__ __forceinline__ const char* b_ptr(const pg8::Unit& u) const { return (const char*)(u.e ? Bt2 : Bt) + (size_t)u.pn * 256 * pg8::KD * 2; }
    __device__ __forceinline__ void a_voff(const pg8::Unit&, unsigned (&v)[2][2], const int (&R)[2], const int (&C)[2]) const {
#pragma unroll
        for (int i = 0; i < 2; ++i) { v[0][i] = (unsigned)(R[i] * pg8::KD + C[i]) * 2u; v[1][i] = v[0][i] + (unsigned)(pg8::HALF * pg8::KD * 2); }
    }
};
struct MoeSched {
    const LAS int* tab; int NT, G, c; bool gather;
};
template <bool GATHER_, int NTILE_N>
struct MoeSchedT {
    static constexpr bool GATHER = GATHER_;
    const LAS int* tab; int G, c;
    const bf16* A;
    const bf16* Bt;
    const int* list;
    __device__ __forceinline__ bool next(int i, pg8::Unit& u) const {
        const int L = i * G + c; const int T = tab[0];
        if (L >= T * NTILE_N) return false;
        const int mt = L / NTILE_N; u.pn = L % NTILE_N;
        const int w = __builtin_amdgcn_readfirstlane(tab[1 + mt]); u.e = w >> 16; const int tl = w & 0xffff;
        const int cnt = __builtin_amdgcn_readfirstlane(tab[512 + u.e]), pb = __builtin_amdgcn_readfirstlane(tab[544 + u.e]);
        u.pm = pb + tl * 256; u.cnt = cnt - tl * 256;
        return true;
    }
    __device__ __forceinline__ const char* a_ptr(const pg8::Unit& u) const { return GATHER ? (const char*)A : (const char*)A + (size_t)u.pm * pg8::KD * 2; }
    __device__ __forceinline__ const char* b_ptr(const pg8::Unit& u) const { return (const char*)Bt + ((size_t)u.e * NTILE_N + u.pn) * 256 * pg8::KD * 2; }
    __device__ __forceinline__ void a_voff(const pg8::Unit& u, unsigned (&v)[2][2], const int (&R)[2], const int (&C)[2]) const {
        if (GATHER) {
            const int slot0 = u.pm - tab[544 + u.e];
            const int* lp = list + (size_t)u.e * NTOK + slot0;
#pragma unroll
            for (int h = 0; h < 2; ++h)
#pragma unroll
                for (int i = 0; i < 2; ++i) { const int r = h * 128 + R[i]; const int tok = (r < u.cnt) ? (lp[r] >> 2) : 0; v[h][i] = (unsigned)(tok * pg8::KD + C[i]) * 2u; }
        } else {
#pragma unroll
            for (int i = 0; i < 2; ++i) { v[0][i] = (unsigned)(R[i] * pg8::KD + C[i]) * 2u; v[1][i] = v[0][i] + (unsigned)(pg8::HALF * pg8::KD * 2); }
        }
    }
};
__device__ __forceinline__ void moe_build_table(const Ctx& X, const int* cnt  ) {
    LAS int* tab = (LAS int*)(X.lds + TAB_OFF);
    __syncthreads();
    if (X.tid == 0) {
        int T = 0, pb = 0;
        for (int e = 0; e < NE; ++e) { const int c = __hip_atomic_load(cnt + e, __ATOMIC_RELAXED, __HIP_MEMORY_SCOPE_AGENT); const int mt = (c + 255) >> 8;
            tab[512 + e] = c; tab[544 + e] = pb; for (int t = 0; t < mt; ++t) tab[1 + T + t] = (e << 16) | t; T += mt; pb += mt * 256; }
        tab[0] = T;
    }
    __syncthreads();
}

__device__ __forceinline__ f32x2 gelu_pk(f32x2 v) {
    const f32x2 av = __builtin_elementwise_abs(v), d = av * 0.2316418882f + 1.0f;
    f32x2 t; t.x = __builtin_amdgcn_rcpf(d.x); t.y = __builtin_amdgcn_rcpf(d.y);
    f32x2 q = t * 0.5307027145f + (-0.7265760135f); q = q * t + 0.7107068705f; q = q * t + (-0.142248368f); q = q * t + 0.127414796f; q = q * t;
    const f32x2 s = (v * v) * (-0.72134752044f);
    f32x2 e; e.x = __builtin_amdgcn_exp2f(s.x); e.y = __builtin_amdgcn_exp2f(s.y);
    const f32x2 m = v * (q * e), r = v - m;
    f32x2 o; o.x = v.x < 0.f ? m.x : r.x; o.y = v.y < 0.f ? m.y : r.y; return o;
}
__device__ __forceinline__ u32x4 pack8(f32x4 a, f32x4 b) { u32x4 w; w.x = pk2(a[0], a[1]); w.y = pk2(a[2], a[3]); w.z = pk2(b[0], b[1]); w.w = pk2(b[2], b[3]); return w; }

struct EpiIn {
    static constexpr bool PERM = true;
    bf16 *GLU, *Q, *Kb, *Vb, *KC, *VC; const float* bias;
    __device__ __forceinline__ void operator()(const f32x4 (&acc)[2][2][4][2], const pg8::Unit& u, int wr, int wc, int fr, int fq) const {
        const int row0 = u.pm * 256 + wr * 64 + fr; const int c8 = wc * 32 + 8 * fq;
        if (u.e == 0 && u.pn < 4) {
            const int j0 = u.pn * 128 + c8;
            f32x4 bu[2], bg[2];
#pragma unroll
            for (int n = 0; n < 2; ++n) { bu[n] = *(const f32x4*)(bias + j0 + 4 * n); bg[n] = *(const f32x4*)(bias + 512 + j0 + 4 * n); }
#pragma unroll
            for (int ai = 0; ai < 2; ++ai)
#pragma unroll
                for (int m = 0; m < 4; ++m) { f32x4 o[2];
#pragma unroll
                    for (int n = 0; n < 2; ++n) { const f32x4 uu = acc[ai][0][m][n] + bu[n], gg = acc[ai][1][m][n] + bg[n];
#pragma unroll
                        for (int k = 0; k < 4; ++k) o[n][k] = uu[k] * sigmoidf_(gg[k]); }
                    *(u32x4*)(GLU + (size_t)(row0 + ai * 128 + m * 16) * 512 + j0) = pack8(o[0], o[1]); }
        } else {
#pragma unroll
            for (int bj = 0; bj < 2; ++bj) {
                bf16* dst; int ld, col, bcol;
                if (u.pn >= 6 || u.e) { dst = u.e ? (bj ? VC : KC) : (bj ? Vb : Kb); ld = 128; col = c8; bcol = KV_COL + bj * 128 + c8; }
                else { dst = Q; ld = 512; col = (u.pn - 4) * 256 + bj * 128 + c8; bcol = 1024 + col; }
                f32x4 bv[2];
#pragma unroll
                for (int n = 0; n < 2; ++n) bv[n] = *(const f32x4*)(bias + bcol + 4 * n);
#pragma unroll
                for (int ai = 0; ai < 2; ++ai)
#pragma unroll
                    for (int m = 0; m < 4; ++m) *(u32x4*)(dst + (size_t)(row0 + ai * 128 + m * 16) * ld + col) = pack8(acc[ai][bj][m][0] + bv[0], acc[ai][bj][m][1] + bv[1]);
            }
        }
    }
};
struct EpiRes {
    static constexpr bool PERM = false;
    const float* base; float* out; const float* bias; const float* gate;
    __device__ __forceinline__ void operator()(const f32x4 (&acc)[2][2][4][2], const pg8::Unit& u, int wr, int wc, int fr, int fq) const {
        const int col0 = u.pn * 256 + wc * 32 + 4 * fq; const int b = (u.pm * 256) / SEQ;
        f32x4 bv[2][2], gv[2][2];
#pragma unroll
        for (int bj = 0; bj < 2; ++bj)
#pragma unroll
            for (int n = 0; n < 2; ++n) { bv[bj][n] = *(const f32x4*)(bias + col0 + bj * 128 + n * 16); gv[bj][n] = *(const f32x4*)(gate + (size_t)b * MODW + col0 + bj * 128 + n * 16); }
#pragma unroll
        for (int ai = 0; ai < 2; ++ai)
#pragma unroll
            for (int m = 0; m < 4; ++m) { const size_t off = (size_t)(u.pm * 256 + ai * 128 + wr * 64 + m * 16 + fr) * D + col0;
#pragma unroll
                for (int bj = 0; bj < 2; ++bj)
#pragma unroll
                    for (int n = 0; n < 2; ++n) { const f32x4 bs = *(const f32x4*)(base + off + bj * 128 + n * 16); *(f32x4*)(out + off + bj * 128 + n * 16) = bs + gv[bj][n] * (acc[ai][bj][m][n] + bv[bj][n]); } }
    }
};
struct EpiGelu {
    static constexpr bool PERM = true;
    bf16 *U, *V; const float* bias;
    __device__ __forceinline__ void operator()(const f32x4 (&acc)[2][2][4][2], const pg8::Unit& u, int wr, int wc, int fr, int fq) const {
        const int row0 = u.pm * 256 + wr * 64 + fr; const int colt = u.pn * 256; bf16* base = colt >= 1024 ? V : U; const int cb = (colt & 1023) + wc * 32 + 8 * fq, bcol = colt + wc * 32 + 8 * fq;
        f32x4 bv[2][2];
#pragma unroll
        for (int bj = 0; bj < 2; ++bj)
#pragma unroll
            for (int n = 0; n < 2; ++n) bv[bj][n] = *(const f32x4*)(bias + bcol + bj * 128 + 4 * n);
#pragma unroll
        for (int ai = 0; ai < 2; ++ai)
#pragma unroll
            for (int m = 0; m < 4; ++m) { bf16* rowp = base + (size_t)(row0 + ai * 128 + m * 16) * D + cb;
#pragma unroll
                for (int bj = 0; bj < 2; ++bj) { f32x4 v0 = acc[ai][bj][m][0] + bv[bj][0], v1 = acc[ai][bj][m][1] + bv[bj][1];
                    f32x2 a = gelu_pk((f32x2){v0[0], v0[1]}), b = gelu_pk((f32x2){v0[2], v0[3]}), c = gelu_pk((f32x2){v1[0], v1[1]}), d = gelu_pk((f32x2){v1[2], v1[3]});
                    *(u32x4*)(rowp + bj * 128) = pack8((f32x4){a.x, a.y, b.x, b.y}, (f32x4){c.x, c.y, d.x, d.y}); } }
    }
};
struct EpiSwiglu {
    static constexpr bool PERM = true;
    bf16* ACT; const float* b1;
    __device__ __forceinline__ void operator()(const f32x4 (&acc)[2][2][4][2], const pg8::Unit& u, int wr, int wc, int fr, int fq) const {
        const int j0 = u.pn * 128 + wc * 32 + 8 * fq; const float* bb = b1 + (size_t)u.e * 2048;
        f32x4 bg[2], bu[2];
#pragma unroll
        for (int n = 0; n < 2; ++n) { bg[n] = *(const f32x4*)(bb + j0 + 4 * n); bu[n] = *(const f32x4*)(bb + 1024 + j0 + 4 * n); }
#pragma unroll
        for (int ai = 0; ai < 2; ++ai)
#pragma unroll
            for (int m = 0; m < 4; ++m) { f32x4 o[2];
#pragma unroll
                for (int n = 0; n < 2; ++n) { const f32x4 g4 = acc[ai][0][m][n] + bg[n], u4 = acc[ai][1][m][n] + bu[n];
#pragma unroll
                    for (int k = 0; k < 4; ++k) { const float g = fminf(g4[k], 7.0f), up = fminf(fmaxf(u4[k], -7.0f), 7.0f); o[n][k] = (up + 1.0f) * g * sigmoidf_(g * 1.702f); } }
                *(u32x4*)(ACT + (size_t)(u.pm + ai * 128 + wr * 64 + m * 16 + fr) * D + j0) = pack8(o[0], o[1]); }
    }
};
struct EpiDown {
    static constexpr bool PERM = true;
    bf16* Y; const float* b2; const int* list; const float* gatew; const LAS int* tab;
    __device__ __forceinline__ void operator()(const f32x4 (&acc)[2][2][4][2], const pg8::Unit& u, int wr, int wc, int fr, int fq) const {
        const int c8 = u.pn * 256 + wc * 32 + 8 * fq; const float* bb = b2 + (size_t)u.e * D;
        const int slot0 = u.pm - tab[544 + u.e]; const int* lp = list + (size_t)u.e * NTOK + slot0;
        f32x4 bv[2][2];
#pragma unroll
        for (int bj = 0; bj < 2; ++bj)
#pragma unroll
            for (int n = 0; n < 2; ++n) bv[bj][n] = *(const f32x4*)(bb + c8 + bj * 128 + 4 * n);
#pragma unroll
        for (int ai = 0; ai < 2; ++ai)
#pragma unroll
            for (int m = 0; m < 4; ++m) { const int r = ai * 128 + wr * 64 + m * 16 + fr;
                if (r < u.cnt) { const int aid = lp[r]; const float gw = gatew[aid]; bf16* rowp = Y + (size_t)aid * D + c8;
#pragma unroll
                    for (int bj = 0; bj < 2; ++bj) *(u32x4*)(rowp + bj * 128) = pack8((acc[ai][bj][m][0] + bv[bj][0]) * gw, (acc[ai][bj][m][1] + bv[bj][1]) * gw); } }
    }
};

__device__ __forceinline__ void transpose_item(const float* __restrict__ W, int K, int N, bf16* __restrict__ WT, int dst_n0, int src_n0, int k0, LAS float* scr, int lane) {
#pragma unroll 16
    for (int i = 0; i < 32; ++i) { const int kk = 2 * i + (lane >> 5); scr[kk * 33 + (lane & 31)] = W[(size_t)(k0 + kk) * N + src_n0 + (lane & 31)]; }
    LDS_WAIT();
    const int c = lane & 7;
#pragma unroll
    for (int j = 0; j < 4; ++j) { const int n = (lane >> 3) + 8 * j; const LAS float* s = scr + (8 * c) * 33 + n;
        u32x4 o; o.x = pk2(s[0 * 33], s[1 * 33]); o.y = pk2(s[2 * 33], s[3 * 33]); o.z = pk2(s[4 * 33], s[5 * 33]); o.w = pk2(s[6 * 33], s[7 * 33]);
        *(u32x4*)(WT + (size_t)(dst_n0 + n) * K + k0 + 8 * c) = o; }
    LDS_WAIT();
}
__device__ __forceinline__ int pair_src(int nd, int halfw) { return ((nd & 255) >> 7) * halfw + (nd >> 8) * 128 + (nd & 127); }

__device__ __forceinline__ void phase_prologue(const Args& a, const Ctx& X) {
    {
        LAS float* sc = (LAS float*)X.lds;
        LAS float* red = (LAS float*)(X.lds + 36864);
        float* MOD = (float*)(X.ws + WS_MOD);
        for (int item = blockIdx.x; item < 2 * 96; item += X.G) {
            const int l = item / 96, j0 = (item % 96) * 64;
            for (int idx = X.tid; idx < 9 * 1024; idx += NTHREADS) { const int r = idx >> 10, k = idx & 1023; const float v = r < 8 ? a.in[I_C][r * 1024 + k] : a.in[I_CCTX][k]; sc[idx] = v * sigmoidf_(v); }
            __syncthreads();
            float acc[9];
#pragma unroll
            for (int r = 0; r < 9; ++r) acc[r] = 0.f;
            const float* w = a.in[I_ADAW] + (size_t)l * 1024 * MODW + j0 + X.lane;
#pragma unroll 8
            for (int k = X.wave * 128; k < X.wave * 128 + 128; ++k) { const float wv = w[(size_t)k * MODW];
#pragma unroll
                for (int r = 0; r < 9; ++r) acc[r] += sc[r * 1024 + k] * wv; }
#pragma unroll
            for (int r = 0; r < 9; ++r) red[(X.wave * 9 + r) * 64 + X.lane] = acc[r];
            __syncthreads();
            for (int t = X.tid; t < 9 * 64; t += NTHREADS) { const int r = t >> 6, cidx = t & 63; float s = 0.f;
#pragma unroll
                for (int w8 = 0; w8 < 8; ++w8) s += red[(w8 * 9 + r) * 64 + cidx];
                MOD[((size_t)l * 9 + r) * MODW + j0 + cidx] = s + a.in[I_ADAB][l * MODW + j0 + cidx]; }
            __syncthreads();
        }
    }
    LAS float* scr = (LAS float*)(X.lds + X.wave * 16384);
    bf16* WinT = (bf16*)(X.ws + WS_WINT); bf16* WoutT = (bf16*)(X.ws + WS_WOUTT); bf16* GWinT = (bf16*)(X.ws + WS_GWINT); bf16* GWoutT = (bf16*)(X.ws + WS_GWOUTT);
    bf16* W1T = (bf16*)(X.ws + WS_W1T); bf16* W2T = (bf16*)(X.ws + WS_W2T);
    constexpr int I_IN = 16 * (EVEN_IN / 32), I_OUT = 16 * 32, I_GIN = 16 * 64, I_GOUT = 16 * 32, I_M1 = 64 * 16 * 64, I_M2 = 64 * 16 * 32;
    constexpr int NITEMS = I_IN + I_OUT + I_GIN + I_GOUT + I_M1 + I_M2;
    for (int it = X.gw; it < NITEMS; it += X.NGW) {
        int r = it;
        if (r < I_M1) { const int mat = r >> 10, q = r & 1023, kb = q >> 6, nb = q & 63; const int nd = nb * 32;
            transpose_item(a.in[I_W1] + (size_t)mat * 1024 * 2048, 1024, 2048, W1T + (size_t)mat * 2048 * 1024, nd, pair_src(nd, 1024), kb * 64, scr, X.lane); continue; } r -= I_M1;
        if (r < I_M2) { const int mat = r >> 9, q = r & 511, kb = q >> 5, nb = q & 31;
            transpose_item(a.in[I_W2] + (size_t)mat * 1024 * 1024, 1024, 1024, W2T + (size_t)mat * 1024 * 1024, nb * 32, nb * 32, kb * 64, scr, X.lane); continue; } r -= I_M2;
        if (r < I_IN) { const int kb = r / 56, nb = r % 56; const int nd = nb * 32; const int ns = nd < 1024 ? pair_src(nd, 512) : nd;
            transpose_item(a.in[I_EWIN], 1024, EVEN_IN, WinT, nd, ns, kb * 64, scr, X.lane); continue; } r -= I_IN;
        if (r < I_OUT) { const int kb = r >> 5, nb = r & 31; transpose_item(a.in[I_EWOUT], 1024, 1024, WoutT, nb * 32, nb * 32, kb * 64, scr, X.lane); continue; } r -= I_OUT;
        if (r < I_GIN) { const int kb = r >> 6, nb = r & 63; transpose_item(a.in[I_OWIN], 1024, 2048, GWinT, nb * 32, nb * 32, kb * 64, scr, X.lane); continue; } r -= I_GIN;
        { const int kb = r >> 5, nb = r & 31; transpose_item(a.in[I_OWOUT], 1024, 1024, GWoutT, nb * 32, nb * 32, kb * 64, scr, X.lane); }
    }
    { bf16* WsB = (bf16*)(X.ws + WS_WSB); const float* ws = a.in[I_OWS];
      for (int i = (X.gw * 64 + X.lane) * 4; i < 8 * 128 * 128; i += X.NGW * 64 * 4) { const f32x4 v = *(const f32x4*)(ws + i); u32x2 o; o.x = pk2(v[0], v[1]); o.y = pk2(v[2], v[3]); *(u32x2*)(WsB + i) = o; } }
}

__device__ __forceinline__ void modulate_row(const float* xrow, const float* g, const float* sh, const float* sc, bf16* orow, int lane, f32x4 (&y)[4]) {
    const f32x4* xr = (const f32x4*)xrow + lane; f32x4 v[4]; float ss = 0.f;
#pragma unroll
    for (int j = 0; j < 4; ++j) { v[j] = xr[64 * j]; ss += (v[j][0] * v[j][0] + v[j][1] * v[j][1]) + (v[j][2] * v[j][2] + v[j][3] * v[j][3]); }
    const float rstd = rsqrtf(wave_sum(ss) * (1.0f / D) + EPS);
#pragma unroll
    for (int j = 0; j < 4; ++j) { const f32x4 gk = ((const f32x4*)g)[lane + 64 * j], sk = ((const f32x4*)sc)[lane + 64 * j], hk = ((const f32x4*)sh)[lane + 64 * j];
        y[j] = v[j] * rstd * gk * (1.0f + sk) + hk;
        u32x2 o; o.x = pk2(y[j][0], y[j][1]); o.y = pk2(y[j][2], y[j][3]); *((u32x2*)orow + lane + 64 * j) = o; }
}
__device__ __forceinline__ void phase_modulate0(const Args& a, const Ctx& X) {
    const float* MOD0 = (const float*)(X.ws + WS_MOD); f32x4 y[4];
    bf16* XA = (bf16*)(X.ws + WS_XA); bf16* GM = (bf16*)(X.ws + WS_GM);
    for (int row = X.gw; row < NTOK + NCTX; row += X.NGW) {
        if (row < NTOK) { const float* m = MOD0 + (size_t)(row / SEQ) * MODW; modulate_row(a.in[I_X] + (size_t)row * D, a.in[I_NMG], m, m + 1024, XA + (size_t)row * D, X.lane, y); }
        else { const int r = row - NTOK; const float* m = MOD0 + (size_t)8 * MODW; modulate_row(a.in[I_CTX] + (size_t)r * D, a.in[I_NMG], m, m + 1024, GM + (size_t)r * D, X.lane, y); }
    }
}

__device__ __forceinline__ void qk_chunks(bf16* buf, int nchunks, int rowlen, const float* gn, bool rope, float oscale, const Ctx& X) {
    for (int ch = X.gw; ch < nchunks; ch += X.NGW) {
        const int e0 = ch * 512 + 8 * X.lane; const int token = e0 / rowlen; const int d0 = e0 & 63;
        u32x4 raw = *(const u32x4*)(buf + e0); float v[8];
#pragma unroll
        for (int i = 0; i < 4; ++i) { v[2 * i] = bf2f(raw[i] & 0xffffu); v[2 * i + 1] = bf2f(raw[i] >> 16); }
        float ss = 0.f;
#pragma unroll
        for (int i = 0; i < 8; ++i) ss += v[i] * v[i];
        ss += __shfl_xor(ss, 1); ss += __shfl_xor(ss, 2); ss += __shfl_xor(ss, 4);
        const float rstd = rsqrtf(ss * (1.0f / 64.0f) + EPS);
#pragma unroll
        for (int i = 0; i < 8; ++i) v[i] = v[i] * rstd * gn[d0 + i];
        if (rope) {
            const int t = token % SEQ; const float rowp = (float)(t >> 6), colp = (float)(t & 63);
#pragma unroll
            for (int i = 0; i < 8; ++i) { const float pv = __shfl_xor(v[i], 4); const int dd = (d0 + i) & 31;
                const float inv = exp2f(-(float)(dd & 15) * (13.287712379549449f / 16.0f)); const float ang = (dd < 16 ? rowp : colp) * inv;
                float sn, cs; sincosf(ang, &sn, &cs);
                v[i] = (d0 < 32) ? (v[i] * cs - pv * sn) : (v[i] * cs + pv * sn); }
        }
        u32x4 o; o.x = pk2(v[0] * oscale, v[1] * oscale); o.y = pk2(v[2] * oscale, v[3] * oscale); o.z = pk2(v[4] * oscale, v[5] * oscale); o.w = pk2(v[6] * oscale, v[7] * oscale);
        *(u32x4*)(buf + e0) = o;
    }
}
__device__ __forceinline__ void phase_conv_qk(const Args& a, const Ctx& X) {
    qk_chunks((bf16*)(X.ws + WS_Q), NTOK, 512, a.in[I_QNG], true, QSCALE, X);
    qk_chunks((bf16*)(X.ws + WS_K), NTOK / 4, 128, a.in[I_KNG], true, 1.0f, X);
    qk_chunks((bf16*)(X.ws + WS_KC), NCTX / 4, 128, a.in[I_KNG], false, 1.0f, X);
    const bf16* GLU = (const bf16*)(X.ws + WS_GLU); bf16* MIX = (bf16*)(X.ws + WS_MIX);
    LAS unsigned* tin = (LAS unsigned*)X.lds;
    LAS float* tout = (LAS float*)(X.lds + 65536);
    const int cp = X.tid & 255, th = X.tid >> 8;
    float w0[31], w1[31];
#pragma unroll
    for (int j = 0; j < 31; ++j) { const f32x2 w = *(const f32x2*)(a.in[I_ECW] + j * 512 + 2 * cp); w0[j] = w.x; w1[j] = w.y; }
    const f32x2 cb = *(const f32x2*)(a.in[I_ECB] + 2 * cp);
    for (int tile = blockIdx.x; tile < NTOK / 32; tile += X.G) {
        const int row0 = tile * 32; const int t0 = row0 % SEQ;
        __syncthreads();
        for (int c = X.tid; c < 62 * 64; c += NTHREADS) { const int lr = c >> 6, cc = c & 63; const int t = t0 - 15 + lr;
            u32x4 v = (u32x4){0u, 0u, 0u, 0u}; if (t >= 0 && t < SEQ) v = *(const u32x4*)(GLU + (size_t)(row0 - 15 + lr) * 512 + cc * 8);
            *(LAS u32x4*)(tin + lr * 256 + cc * 4) = v; }
        __syncthreads();
        float a0[16], a1[16];
#pragma unroll
        for (int o = 0; o < 16; ++o) { a0[o] = cb.x; a1[o] = cb.y; }
#pragma unroll
        for (int rr = 0; rr < 46; ++rr) { const unsigned pv = tin[(16 * th + rr) * 256 + cp]; const float x0 = bf2f(pv & 0xffffu), x1 = bf2f(pv >> 16);
#pragma unroll
            for (int o = 0; o < 16; ++o) { const int j = rr - o; if (j >= 0 && j <= 30) { a0[o] += x0 * w0[j]; a1[o] += x1 * w1[j]; } } }
#pragma unroll
        for (int o = 0; o < 16; ++o) *(LAS f32x2*)(tout + (16 * th + o) * 512 + 2 * cp) = (f32x2){a0[o], a1[o]};
        __syncthreads();
#pragma unroll
        for (int q = 0; q < 4; ++q) { const int tl = X.wave * 4 + q; f32x4 v[2]; float s = 0.f;
#pragma unroll
            for (int j = 0; j < 2; ++j) { v[j] = *(const LAS f32x4*)(tout + tl * 512 + 4 * X.lane + 256 * j); s += (v[j][0] + v[j][1]) + (v[j][2] + v[j][3]); }
            const float mean = wave_sum(s) * (1.0f / 512.0f); float s2 = 0.f;
#pragma unroll
            for (int j = 0; j < 2; ++j) { v[j] = v[j] - mean; s2 += (v[j][0] * v[j][0] + v[j][1] * v[j][1]) + (v[j][2] * v[j][2] + v[j][3] * v[j][3]); }
            const float rstd = rsqrtf(wave_sum(s2) * (1.0f / 512.0f) + EPS);
#pragma unroll
            for (int j = 0; j < 2; ++j) { const f32x4 g = *(const f32x4*)(a.in[I_ELNG] + 4 * X.lane + 256 * j), b = *(const f32x4*)(a.in[I_ELNB] + 4 * X.lane + 256 * j);
                f32x4 y = v[j] * rstd * g + b;
#pragma unroll
                for (int k = 0; k < 4; ++k) y[k] = y[k] * sigmoidf_(y[k]);
                u32x2 o; o.x = pk2(y[0], y[1]); o.y = pk2(y[2], y[3]); *(u32x2*)(MIX + (size_t)(row0 + tl) * D + 4 * X.lane + 256 * j) = o; } }
    }
}

__device__ __forceinline__ void phase_attention(const Args& a, const Ctx& X) {
    const bf16* QN = (const bf16*)(X.ws + WS_Q); const bf16* KN = (const bf16*)(X.ws + WS_K); const bf16* VV = (const bf16*)(X.ws + WS_V);
    const bf16* KC = (const bf16*)(X.ws + WS_KC); const bf16* VC = (const bf16*)(X.ws + WS_VC); bf16* MIX = (bf16*)(X.ws + WS_MIX);
    LAS unsigned char* Ks = X.lds;
    LAS unsigned char* Vt = X.lds + 16384;
    const int lane = X.lane, l15 = lane & 15, g4 = lane >> 4;
    for (int unit = blockIdx.x; unit < NB * 2 * 32; unit += X.G) {
        const int b = unit >> 6, kh = (unit >> 5) & 1, qb = unit & 31; const int q0 = qb * 64;
        const int hq = kh * 4 + (X.wave >> 1), tq = (X.wave & 1) * 32;
        bf16x8 Qf[2][2];
#pragma unroll
        for (int qi = 0; qi < 2; ++qi)
#pragma unroll
            for (int s = 0; s < 2; ++s) Qf[qi][s] = *(const bf16x8*)(QN + (size_t)(b * SEQ + q0 + tq + 16 * qi + l15) * 512 + hq * 64 + 32 * s + 8 * g4);
        const float sink2 = a.in[I_SINK][hq] * LOG2E;
        float mrun[2], lrun[2]; f32x4 O[2][4];
#pragma unroll
        for (int qi = 0; qi < 2; ++qi) { mrun[qi] = sink2; lrun[qi] = (g4 == 0) ? 1.0f : 0.0f;
#pragma unroll
            for (int db = 0; db < 4; ++db) O[qi][db] = (f32x4){0.f, 0.f, 0.f, 0.f}; }
        for (int t = 0; t < 9; ++t) {
            const bf16* kp; const bf16* vp; int mode = 0;
            if (t < 5) { const int ks = q0 - 128 + 64 * t; if (ks < 0 || ks >= SEQ) continue; kp = KN + (size_t)(b * SEQ + ks) * 128 + kh * 64; vp = VV + (size_t)(b * SEQ + ks) * 128 + kh * 64; mode = (t == 0) ? 1 : (t == 4 ? 2 : 0); }
            else { const int ks = (t - 5) * 64; kp = KC + (size_t)(b * CTXL + ks) * 128 + kh * 64; vp = VC + (size_t)(b * CTXL + ks) * 128 + kh * 64; }
            __syncthreads();
            { const int key = X.tid >> 3, ch = X.tid & 7;
              const u32x4 kv = *(const u32x4*)(kp + (size_t)key * 128 + ch * 8); *(LAS u32x4*)(Ks + key * 144 + ch * 16) = kv;
              const u32x4 vv = *(const u32x4*)(vp + (size_t)key * 128 + ch * 8);
#pragma unroll
              for (int i = 0; i < 4; ++i) { *(LAS unsigned short*)(Vt + (8 * ch + 2 * i) * 136 + key * 2) = (unsigned short)(vv[i] & 0xffffu); *(LAS unsigned short*)(Vt + (8 * ch + 2 * i + 1) * 136 + key * 2) = (unsigned short)(vv[i] >> 16); } }
            __syncthreads();
            bf16x8 kf[4][2];
#pragma unroll
            for (int kb = 0; kb < 4; ++kb)
#pragma unroll
                for (int s = 0; s < 2; ++s) kf[kb][s] = *(const LAS bf16x8*)(Ks + (16 * kb + l15) * 144 + (32 * s + 8 * g4) * 2);
            bf16x8 vf[4][2];
#pragma unroll
            for (int db = 0; db < 4; ++db)
#pragma unroll
                for (int ks2 = 0; ks2 < 2; ++ks2) { const LAS unsigned char* p = Vt + (16 * db + l15) * 136 + (32 * ks2 + 4 * g4) * 2;
                    const u32x2 lo = *(const LAS u32x2*)p, hi = *(const LAS u32x2*)(p + 32);
                    u32x4 w; w.x = lo.x; w.y = lo.y; w.z = hi.x; w.w = hi.y; vf[db][ks2] = __builtin_bit_cast(bf16x8, w); }
#pragma unroll
            for (int qi = 0; qi < 2; ++qi) {
                f32x4 st[4];
#pragma unroll
                for (int kb = 0; kb < 4; ++kb) { st[kb] = (f32x4){0.f, 0.f, 0.f, 0.f};
#pragma unroll
                    for (int s = 0; s < 2; ++s) st[kb] = __builtin_amdgcn_mfma_f32_16x16x32_bf16(kf[kb][s], Qf[qi][s], st[kb], 0, 0, 0); }
                if (mode) { const int qloc = tq + 16 * qi + l15;
#pragma unroll
                    for (int kb = 0; kb < 4; ++kb)
#pragma unroll
                        for (int r = 0; r < 4; ++r) { const int kk = 16 * kb + 4 * g4 + r; const bool keep = (mode == 1) ? (kk >= qloc) : (kk <= qloc); if (!keep) st[kb][r] = -1e30f; } }
                float mx = st[0][0];
#pragma unroll
                for (int kb = 0; kb < 4; ++kb)
#pragma unroll
                    for (int r = 0; r < 4; ++r) mx = fmaxf(mx, st[kb][r]);
                mx = fmaxf(mx, __shfl_xor(mx, 16)); mx = fmaxf(mx, __shfl_xor(mx, 32));
                const float mnew = fmaxf(mrun[qi], mx); const float alpha = __builtin_amdgcn_exp2f(mrun[qi] - mnew); mrun[qi] = mnew;
                float ps = 0.f;
#pragma unroll
                for (int kb = 0; kb < 4; ++kb)
#pragma unroll
                    for (int r = 0; r < 4; ++r) { st[kb][r] = __builtin_amdgcn_exp2f(st[kb][r] - mnew); ps += st[kb][r]; }
                lrun[qi] = lrun[qi] * alpha + ps;
#pragma unroll
                for (int db = 0; db < 4; ++db) O[qi][db] = O[qi][db] * alpha;
#pragma unroll
                for (int ks2 = 0; ks2 < 2; ++ks2) { u32x4 w; w.x = pk2(st[2 * ks2][0], st[2 * ks2][1]); w.y = pk2(st[2 * ks2][2], st[2 * ks2][3]); w.z = pk2(st[2 * ks2 + 1][0], st[2 * ks2 + 1][1]); w.w = pk2(st[2 * ks2 + 1][2], st[2 * ks2 + 1][3]);
                    const bf16x8 pf = __builtin_bit_cast(bf16x8, w);
#pragma unroll
                    for (int db = 0; db < 4; ++db) O[qi][db] = __builtin_amdgcn_mfma_f32_16x16x32_bf16(vf[db][ks2], pf, O[qi][db], 0, 0, 0); }
            }
        }
#pragma unroll
        for (int qi = 0; qi < 2; ++qi) { float l = lrun[qi]; l += __shfl_xor(l, 16); l += __shfl_xor(l, 32); const float inv = 1.0f / l;
            bf16* orow = MIX + (size_t)(b * SEQ + q0 + tq + 16 * qi + l15) * D + 512 + hq * 64 + 4 * g4;
#pragma unroll
            for (int db = 0; db < 4; ++db) { u32x2 o; o.x = pk2(O[qi][db][0] * inv, O[qi][db][1] * inv); o.y = pk2(O[qi][db][2] * inv, O[qi][db][3] * inv); *(u32x2*)(orow + 16 * db) = o; } }
    }
}

__device__ __forceinline__ void phase_router(const Args& a, const Ctx& X, int layer) {
    const float* H = (const float*)(X.ws + WS_H); bf16* XA = (bf16*)(X.ws + WS_XA);
    const float* MODl = (const float*)(X.ws + WS_MOD) + (size_t)layer * 9 * MODW; const float* gn = a.in[I_NFG] + layer * D;
    const float* rw = a.in[I_RW] + (size_t)layer * D * NE; const float* rb = a.in[I_RB] + layer * NE;
    int* cntg = (int*)(X.ws + WS_CTL) + CW_CNT + layer * NE; int* list = (int*)(X.ws + WS_LIST); float* gatew = (float*)(X.ws + WS_GATE);
    LAS float* ybuf = (LAS float*)X.lds;
    LAS float* part = (LAS float*)(X.lds + 65536);
    LAS float* lg = (LAS float*)(X.lds + 65536 + 16384);
    LAS int* sel = (LAS int*)(X.lds + 65536 + 16384 + 2048);
    LAS int* lcnt = (LAS int*)(X.lds + 65536 + 16384 + 2048 + 1024);
    const int e = X.lane & 31, hf = X.lane >> 5;
    float wreg[64];
#pragma unroll
    for (int i = 0; i < 64; ++i) wreg[i] = rw[(size_t)(128 * X.wave + 64 * hf + i) * NE + e];
    for (int blk = blockIdx.x; blk < NTOK / 64; blk += X.G) {
        const int rowbase = blk * 64;
        __syncthreads();
        if (X.tid < 64) lcnt[X.tid] = 0;
        for (int bt = 0; bt < 4; ++bt) {
            __syncthreads();
#pragma unroll
            for (int i = 0; i < 2; ++i) { const int rl = 2 * X.wave + i, row = rowbase + 16 * bt + rl; const float* m = MODl + (size_t)(row / SEQ) * MODW; f32x4 y[4];
                modulate_row(H + (size_t)row * D, gn, m + 3 * 1024, m + 4 * 1024, XA + (size_t)row * D, X.lane, y);
#pragma unroll
                for (int j = 0; j < 4; ++j) *(LAS f32x4*)(ybuf + rl * 1024 + 4 * X.lane + 256 * j) = y[j]; }
            __syncthreads();
            for (int r = 0; r < 16; ++r) { float acc = 0.f; const LAS float* yp = ybuf + r * 1024 + 128 * X.wave + 64 * hf;
#pragma unroll
                for (int i4 = 0; i4 < 16; ++i4) { const f32x4 yv = *(const LAS f32x4*)(yp + 4 * i4); acc += yv[0] * wreg[4 * i4] + yv[1] * wreg[4 * i4 + 1] + yv[2] * wreg[4 * i4 + 2] + yv[3] * wreg[4 * i4 + 3]; }
                acc += __shfl_xor(acc, 32);
                if (hf == 0) part[(r * 8 + X.wave) * 32 + e] = acc; }
            __syncthreads();
            { const int r = X.tid >> 5, ee = X.tid & 31; float s = rb[ee];
#pragma unroll
              for (int w8 = 0; w8 < 8; ++w8) s += part[(r * 8 + w8) * 32 + ee];
              lg[r * 32 + ee] = s; }
            __syncthreads();
            if (X.tid < 16) { const int r = X.tid, rl = 16 * bt + r; unsigned used = 0u; float tv[4]; int ti[4];
#pragma unroll
                for (int k = 0; k < 4; ++k) { float best = -3.0e38f; int bi = 0;
                    for (int ee = 0; ee < 32; ++ee) { const float v = lg[r * 32 + ee]; if (!((used >> ee) & 1u) && v > best) { best = v; bi = ee; } }
                    used |= 1u << bi; tv[k] = best; ti[k] = bi; }
                float ex[4], sum = 0.f;
#pragma unroll
                for (int k = 0; k < 4; ++k) { ex[k] = __expf(tv[k] - tv[0]); sum += ex[k]; }
                const float inv = 1.0f / sum;
#pragma unroll
                for (int k = 0; k < 4; ++k) { const int rank = atomicAdd((int*)&lcnt[ti[k]], 1); sel[rl * 4 + k] = (ti[k] << 16) | rank; gatew[(size_t)(rowbase + rl) * 4 + k] = ex[k] * inv; } }
        }
        __syncthreads();
        if (X.tid < 32) lcnt[32 + X.tid] = atomicAdd(cntg + X.tid, lcnt[X.tid]);
        __syncthreads();
        if (X.tid < 256) { const int w = sel[X.tid]; const int ee = w >> 16, rank = w & 0xffff; list[(size_t)ee * NTOK + lcnt[32 + ee] + rank] = rowbase * 4 + X.tid; }
    }
}

__device__ __forceinline__ void phase_combine(const Args& a, const Ctx& X, int layer) {
    float* H = (float*)(X.ws + WS_H); const bf16* Y = (const bf16*)(X.ws + WS_Y); bf16* XA = (bf16*)(X.ws + WS_XA);
    const float* MODl = (const float*)(X.ws + WS_MOD) + (size_t)layer * 9 * MODW;
    for (int row = X.gw; row < NTOK; row += X.NGW) {
        const float* gt = MODl + (size_t)(row / SEQ) * MODW + 5 * 1024; f32x4 h[4];
#pragma unroll
        for (int j = 0; j < 4; ++j) { h[j] = ((const f32x4*)(H + (size_t)row * D))[X.lane + 64 * j]; f32x4 s = (f32x4){0.f, 0.f, 0.f, 0.f};
#pragma unroll
            for (int k = 0; k < 4; ++k) { const u32x2 w = ((const u32x2*)(Y + ((size_t)row * 4 + k) * D))[X.lane + 64 * j]; s += (f32x4){bf2f(w.x & 0xffffu), bf2f(w.x >> 16), bf2f(w.y & 0xffffu), bf2f(w.y >> 16)}; }
            h[j] = h[j] + ((const f32x4*)gt)[X.lane + 64 * j] * s; }
        if (layer == 1) {
#pragma unroll
            for (int j = 0; j < 4; ++j) ((f32x4*)(a.out + (size_t)row * D))[X.lane + 64 * j] = h[j];
        } else {
            float ss = 0.f;
#pragma unroll
            for (int j = 0; j < 4; ++j) { ((f32x4*)(H + (size_t)row * D))[X.lane + 64 * j] = h[j]; ss += (h[j][0] * h[j][0] + h[j][1] * h[j][1]) + (h[j][2] * h[j][2] + h[j][3] * h[j][3]); }
            const float rstd = rsqrtf(wave_sum(ss) * (1.0f / D) + EPS);
            const float* m1 = (const float*)(X.ws + WS_MOD) + (size_t)9 * MODW + (size_t)(row / SEQ) * MODW; const float* g = a.in[I_NMG] + D;
#pragma unroll
            for (int j = 0; j < 4; ++j) { const f32x4 gk = ((const f32x4*)g)[X.lane + 64 * j], hk = ((const f32x4*)m1)[X.lane + 64 * j], sk = ((const f32x4*)(m1 + 1024))[X.lane + 64 * j];
                const f32x4 y = h[j] * rstd * gk * (1.0f + sk) + hk; u32x2 o; o.x = pk2(y[0], y[1]); o.y = pk2(y[2], y[3]); ((u32x2*)(XA + (size_t)row * D))[X.lane + 64 * j] = o; }
        }
    }
}

__device__ __forceinline__ void phase_spatial(const Args& a, const Ctx& X) {
    const bf16* U = (const bf16*)(X.ws + WS_U); const bf16* VB = (const bf16*)(X.ws + WS_VB); bf16* SG = (bf16*)(X.ws + WS_MIX); const bf16* WsB = (const bf16*)(X.ws + WS_WSB);
    LAS float* stat = (LAS float*)X.lds;
    LAS unsigned char* Vt = X.lds + 4096;
    const int lane = X.lane, l15 = lane & 15, g4 = lane >> 4;
    for (int item = blockIdx.x; item < 128 * 8; item += X.G) {
        const int chunk = item >> 3, g = item & 7; const int row0 = chunk * 128;
        __syncthreads();
        for (int i = 0; i < 16; ++i) { const int r = X.wave * 16 + i; const u32x4* vr = (const u32x4*)(VB + (size_t)(row0 + r) * D); float s = 0.f, s2 = 0.f;
#pragma unroll
            for (int j = 0; j < 2; ++j) { const u32x4 w = vr[lane + 64 * j];
#pragma unroll
                for (int k = 0; k < 4; ++k) { const float x0 = bf2f(w[k] & 0xffffu), x1 = bf2f(w[k] >> 16); s += x0 + x1; s2 += x0 * x0 + x1 * x1; } }
            s = wave_sum(s); s2 = wave_sum(s2); const float mean = s * (1.0f / D); const float var = fmaxf(s2 * (1.0f / D) - mean * mean, 0.f);
            if (lane == 0) { stat[2 * r] = mean; stat[2 * r + 1] = rsqrtf(var + EPS); } }
        __syncthreads();
        for (int c = X.tid; c < 128 * 16; c += NTHREADS) { const int q = c >> 4, cc = c & 15; const u32x4 w = *(const u32x4*)(VB + (size_t)(row0 + q) * D + g * 128 + cc * 8);
            const float mean = stat[2 * q], rstd = stat[2 * q + 1]; const float* lg_ = a.in[I_OLNG] + g * 128 + cc * 8; const float* lb_ = a.in[I_OLNB] + g * 128 + cc * 8;
#pragma unroll
            for (int k = 0; k < 4; ++k) { const float y0 = (bf2f(w[k] & 0xffffu) - mean) * rstd * lg_[2 * k] + lb_[2 * k], y1 = (bf2f(w[k] >> 16) - mean) * rstd * lg_[2 * k + 1] + lb_[2 * k + 1];
                const unsigned pk = pk2(y0, y1);
                *(LAS unsigned short*)(Vt + (cc * 8 + 2 * k) * 272 + q * 2) = (unsigned short)(pk & 0xffffu); *(LAS unsigned short*)(Vt + (cc * 8 + 2 * k + 1) * 272 + q * 2) = (unsigned short)(pk >> 16); } }
        __syncthreads();
        f32x4 acc[8];
#pragma unroll
        for (int pb = 0; pb < 8; ++pb) acc[pb] = (f32x4){0.f, 0.f, 0.f, 0.f};
#pragma unroll
        for (int s = 0; s < 4; ++s) { const bf16x8 af = *(const LAS bf16x8*)(Vt + (16 * X.wave + l15) * 272 + (32 * s + 8 * g4) * 2);
#pragma unroll
            for (int pb = 0; pb < 8; ++pb) { const bf16x8 bfr = *(const bf16x8*)(WsB + ((size_t)g * 128 + 16 * pb + l15) * 128 + 32 * s + 8 * g4); acc[pb] = __builtin_amdgcn_mfma_f32_16x16x32_bf16(af, bfr, acc[pb], 0, 0, 0); } }
#pragma unroll
        for (int pb = 0; pb < 8; ++pb) { const int p = 16 * pb + l15; const float bs = a.in[I_OBS][g * 128 + p]; const size_t off = (size_t)(row0 + p) * D + g * 128 + 16 * X.wave + 4 * g4;
            const u32x2 uw = *(const u32x2*)(U + off);
            u32x2 o; o.x = pk2(bf2f(uw.x & 0xffffu) * (acc[pb][0] + bs), bf2f(uw.x >> 16) * (acc[pb][1] + bs)); o.y = pk2(bf2f(uw.y & 0xffffu) * (acc[pb][2] + bs), bf2f(uw.y >> 16) * (acc[pb][3] + bs));
            *(u32x2*)(SG + off) = o; }
    }
}

enum { PH_PRO = 0, PH_MOD0, PH_GIN, PH_CONV, PH_ATT, PH_GOUT, PH_RT0, PH_M1_0, PH_M2_0, PH_CMB0, PH_GMI, PH_SPA, PH_GMO, PH_RT1, PH_M1_1, PH_M2_1, PH_CMB1, NPHASE };

__global__ void __launch_bounds__(NTHREADS, 2) mega(Args a) {
    extern __shared__ __attribute__((aligned(16))) unsigned char lds_raw[];
    Ctx X; X.lds = (LAS unsigned char*)lds_raw; X.tid = threadIdx.x; X.lane = X.tid & 63; X.wave = __builtin_amdgcn_readfirstlane(X.tid >> 6);
    X.G = gridDim.x; { const int bx = blockIdx.x; X.vcu = (X.G % 8 == 0) ? (bx % 8) * (X.G / 8) + bx / 8 : bx; }
    X.gw = X.vcu * NWAVES + X.wave; X.NGW = X.G * NWAVES; X.ws = a.ws;
    volatile LAS unsigned* MISC = (volatile LAS unsigned*)(X.lds + MISC_OFF);
    if (X.tid < 64) MISC[X.tid] = 0u;
    __syncthreads();
    unsigned* ctl = (unsigned*)(a.ws + WS_CTL);
    XcdBarrier bar = xcd_barrier_post(ctl + CW_BAR + a.li * XCD_BAR_WORDS, MISC + 8);
    const Ctx X0 = X;
    for (int ph = a.ph_lo; ph < a.ph_hi; ++ph) {
        if (ph != a.ph_lo) xcd_barrier(bar);
        int z; asm volatile("s_mov_b32 %0, 0" : "=s"(z));
        X.tid = X0.tid + z; X.lane = X.tid & 63; X.wave = __builtin_amdgcn_readfirstlane(X.tid >> 6); X.gw = X.vcu * NWAVES + X.wave;
        unsigned char* ws = a.ws + z; X.ws = ws;
        switch (ph) {
        case PH_PRO: phase_prologue(a, X); break;
        case PH_MOD0: phase_modulate0(a, X); break;
        case PH_GIN: { DenseSched S; S.init((const bf16*)(ws + WS_XA), (const bf16*)(ws + WS_WINT), NTOK, EVEN_IN, X.G, (int)blockIdx.x);
            S.A2 = (const bf16*)(ws + WS_GM); S.Bt2 = (const bf16*)(ws + WS_WINT) + (size_t)KV_COL * D; S.nM2 = NCTX / 256;
            EpiIn E{(bf16*)(ws + WS_GLU), (bf16*)(ws + WS_Q), (bf16*)(ws + WS_K), (bf16*)(ws + WS_V), (bf16*)(ws + WS_KC), (bf16*)(ws + WS_VC), a.in[I_EBIN]};
            pg8::gemm_phase<EpiIn, DenseSched>(X.lds, S, E, X.tid); } break;
        case PH_CONV: phase_conv_qk(a, X); break;
        case PH_ATT: phase_attention(a, X); break;
        case PH_GOUT: { DenseSched S; S.init((const bf16*)(ws + WS_MIX), (const bf16*)(ws + WS_WOUTT), NTOK, D, X.G, (int)blockIdx.x);
            EpiRes E{a.in[I_X], (float*)(ws + WS_H), a.in[I_EBOUT], (const float*)(ws + WS_MOD) + 2 * 1024};
            pg8::gemm_phase<EpiRes, DenseSched>(X.lds, S, E, X.tid); } break;
        case PH_RT0: phase_router(a, X, 0); break;
        case PH_RT1: phase_router(a, X, 1); break;
        case PH_M1_0: case PH_M1_1: { const int l = (ph == PH_M1_1); moe_build_table(X, (const int*)(ws + WS_CTL) + CW_CNT + l * NE);
            MoeSchedT<true, 8> S; S.tab = (const LAS int*)(X.lds + TAB_OFF); S.G = X.G; S.c = X.vcu; S.A = (const bf16*)(ws + WS_XA); S.Bt = (const bf16*)(ws + WS_W1T) + (size_t)l * NE * 2048 * 1024; S.list = (const int*)(ws + WS_LIST);
            EpiSwiglu E{(bf16*)(ws + WS_ACT), a.in[I_B1] + (size_t)l * NE * 2048};
            pg8::gemm_phase<EpiSwiglu, MoeSchedT<true, 8>>(X.lds, S, E, X.tid); } break;
        case PH_M2_0: case PH_M2_1: { const int l = (ph == PH_M2_1); moe_build_table(X, (const int*)(ws + WS_CTL) + CW_CNT + l * NE);
            MoeSchedT<false, 4> S; S.tab = (const LAS int*)(X.lds + TAB_OFF); S.G = X.G; S.c = X.vcu; S.A = (const bf16*)(ws + WS_ACT); S.Bt = (const bf16*)(ws + WS_W2T) + (size_t)l * NE * 1024 * 1024; S.list = (const int*)(ws + WS_LIST);
            EpiDown E{(bf16*)(ws + WS_Y), a.in[I_B2] + (size_t)l * NE * D, (const int*)(ws + WS_LIST), (const float*)(ws + WS_GATE), (const LAS int*)(X.lds + TAB_OFF)};
            pg8::gemm_phase<EpiDown, MoeSchedT<false, 4>>(X.lds, S, E, X.tid); } break;
        case PH_CMB0: phase_combine(a, X, 0); break;
        case PH_CMB1: phase_combine(a, X, 1); break;
        case PH_GMI: { DenseSched S; S.init((const bf16*)(ws + WS_XA), (const bf16*)(ws + WS_GWINT), NTOK, 2048, X.G, (int)blockIdx.x);
            EpiGelu E{(bf16*)(ws + WS_U), (bf16*)(ws + WS_VB), a.in[I_OBIN]};
            pg8::gemm_phase<EpiGelu, DenseSched>(X.lds, S, E, X.tid); } break;
        case PH_SPA: phase_spatial(a, X); break;
        case PH_GMO: { DenseSched S; S.init((const bf16*)(ws + WS_MIX), (const bf16*)(ws + WS_GWOUTT), NTOK, D, X.G, (int)blockIdx.x);
            EpiRes E{(const float*)(ws + WS_H), (float*)(ws + WS_H), a.in[I_OBOUT], (const float*)(ws + WS_MOD) + (size_t)9 * MODW + 2 * 1024};
            pg8::gemm_phase<EpiRes, DenseSched>(X.lds, S, E, X.tid); } break;
        default: break;
        }
    }
}

__device__ __forceinline__ bool find_expert(const int* cnt, int s, int& e, int& slot) {
    int pb = 0;
    for (int i = 0; i < NE; ++i) { const int c = cnt[i]; const int pr = ((c + 255) >> 8) << 8; if (s < pb + pr) { e = i; slot = s - pb; return true; } pb += pr; }
    return false;
}
__global__ void __launch_bounds__(256) slow_gemm(const bf16* A, const int* arow, const bf16* Bt, float* C, int N, const int* cnt, size_t bstride) {
    __shared__ float As[16][65], Bs[16][65];
    const int tx = threadIdx.x & 15, ty = threadIdx.x >> 4; const int m0 = blockIdx.y * 64, n0 = blockIdx.x * 64;
    if (cnt) { int e, slot; if (!find_expert(cnt, m0, e, slot)) return; Bt += (size_t)e * bstride; }
    float acc[4][4];
    for (int i = 0; i < 4; ++i) for (int j = 0; j < 4; ++j) acc[i][j] = 0.f;
    for (int k0 = 0; k0 < 1024; k0 += 16) {
        for (int i = 0; i < 4; ++i) { const int idx = threadIdx.x + 256 * i; const int r = idx >> 4, kk = idx & 15; const int gm = m0 + r; const int ar = arow ? arow[gm] : gm;
            As[kk][r] = bf2f(A[(size_t)ar * 1024 + k0 + kk]); Bs[kk][r] = bf2f(Bt[(size_t)(n0 + r) * 1024 + k0 + kk]); }
        __syncthreads();
        for (int kk = 0; kk < 16; ++kk) { float av[4], bv[4];
            for (int i = 0; i < 4; ++i) { av[i] = As[kk][ty * 4 + i]; bv[i] = Bs[kk][tx * 4 + i]; }
            for (int i = 0; i < 4; ++i) for (int j = 0; j < 4; ++j) acc[i][j] += av[i] * bv[j]; }
        __syncthreads();
    }
    for (int i = 0; i < 4; ++i) for (int j = 0; j < 4; ++j) C[(size_t)(m0 + ty * 4 + i) * N + n0 + tx * 4 + j] = acc[i][j];
}
__device__ __forceinline__ unsigned short f2bf_s(float f) { return (unsigned short)(pk2(f, 0.f) & 0xffffu); }
__global__ void slow_epi_in(const float* C, const float* C2, const float* bias, bf16* GLU, bf16* Q, bf16* Kb, bf16* Vb, bf16* KC, bf16* VC) {
    const size_t i = (size_t)blockIdx.x * blockDim.x + threadIdx.x;
    if (i < (size_t)NTOK * 512) { const int row = (int)(i >> 9), j = (int)(i & 511); const int t = j >> 7, ii = j & 127; const float* cr = C + (size_t)row * EVEN_IN;
        const float u = cr[t * 256 + ii] + bias[j], g = cr[t * 256 + 128 + ii] + bias[512 + j];
        GLU[i] = f2bf_s(u / (1.0f + expf(-g)));
        Q[i] = f2bf_s(cr[1024 + j] + bias[1024 + j]);
        if (j < 128) { Kb[(size_t)row * 128 + j] = f2bf_s(cr[1536 + j] + bias[1536 + j]); Vb[(size_t)row * 128 + j] = f2bf_s(cr[1664 + j] + bias[1664 + j]); }
        if (row < NCTX && j < 128) { KC[(size_t)row * 128 + j] = f2bf_s(C2[(size_t)row * 256 + j] + bias[1536 + j]); VC[(size_t)row * 128 + j] = f2bf_s(C2[(size_t)row * 256 + 128 + j] + bias[1664 + j]); } }
}
__global__ void slow_epi_res(const float* C, const float* base, float* out, const float* bias, const float* gate) {
    const size_t i = (size_t)blockIdx.x * blockDim.x + threadIdx.x;
    if (i < (size_t)NTOK * D) { const int row = (int)(i >> 10), col = (int)(i & 1023); out[i] = base[i] + gate[(size_t)(row / SEQ) * MODW + col] * (C[i] + bias[col]); }
}
__global__ void slow_epi_gelu(const float* C, const float* bias, bf16* U, bf16* V) {
    const size_t i = (size_t)blockIdx.x * blockDim.x + threadIdx.x;
    if (i < (size_t)NTOK * 2048) { const int row = (int)(i >> 11), col = (int)(i & 2047); const float x = C[i] + bias[col]; const float y = 0.5f * x * (1.0f + erff(x * 0.70710678118654752f));
        if (col < 1024) U[(size_t)row * D + col] = f2bf_s(y); else V[(size_t)row * D + col - 1024] = f2bf_s(y); }
}
__global__ void slow_arow(const int* cnt, const int* list, int* arow) {
    const int s = blockIdx.x * blockDim.x + threadIdx.x; if (s >= ACT_ROWS) return;
    int e, slot; int r = 0; if (find_expert(cnt, s, e, slot) && slot < cnt[e]) r = list[(size_t)e * NTOK + slot] >> 2;
    arow[s] = r;
}
__global__ void slow_epi_swiglu(const float* C, const int* cnt, const float* b1, bf16* ACT) {
    const size_t i = (size_t)blockIdx.x * blockDim.x + threadIdx.x;
    if (i < (size_t)ACT_ROWS * 1024) { const int s = (int)(i >> 10), j = (int)(i & 1023); int e, slot; if (!find_expert(cnt, s, e, slot)) return;
        const int t = j >> 7, ii = j & 127; const float* cr = C + (size_t)s * 2048;
        float g = cr[t * 256 + ii] + b1[(size_t)e * 2048 + j], up = cr[t * 256 + 128 + ii] + b1[(size_t)e * 2048 + 1024 + j];
        g = fminf(g, 7.0f); up = fminf(fmaxf(up, -7.0f), 7.0f);
        ACT[i] = f2bf_s((up + 1.0f) * g / (1.0f + expf(-1.702f * g))); }
}
__global__ void slow_epi_down(const float* C, const int* cnt, const int* list, const float* gatew, const float* b2, bf16* Y) {
    const size_t i = (size_t)blockIdx.x * blockDim.x + threadIdx.x;
    if (i < (size_t)ACT_ROWS * 1024) { const int s = (int)(i >> 10), col = (int)(i & 1023); int e, slot; if (!find_expert(cnt, s, e, slot) || slot >= cnt[e]) return;
        const int aid = list[(size_t)e * NTOK + slot]; Y[(size_t)aid * D + col] = f2bf_s((C[i] + b2[(size_t)e * D + col]) * gatew[aid]); }
}
__global__ void __launch_bounds__(64) slow_attention(const bf16* QN, const bf16* KN, const bf16* VV, const bf16* KC, const bf16* VC, const float* sink, bf16* MIX) {
    const int i = blockIdx.x * blockDim.x + threadIdx.x; if (i >= NTOK * 8) return;
    const int row = i >> 3, h = i & 7, kh = h >> 2, b = row / SEQ, t = row % SEQ;
    float q[64], o[64];
    for (int d = 0; d < 64; ++d) { q[d] = bf2f(QN[(size_t)row * 512 + h * 64 + d]); o[d] = 0.f; }
    float m = sink[h] * LOG2E, l = 1.0f;
    const int j0 = t - 128 < 0 ? 0 : t - 128, j1 = t + 128 > SEQ - 1 ? SEQ - 1 : t + 128;
    for (int jj = j0; jj <= j1 + CTXL; ++jj) {
        const bf16* kp; const bf16* vp;
        if (jj <= j1) { kp = KN + (size_t)(b * SEQ + jj) * 128 + kh * 64; vp = VV + (size_t)(b * SEQ + jj) * 128 + kh * 64; }
        else { const int c = jj - j1 - 1; kp = KC + (size_t)(b * CTXL + c) * 128 + kh * 64; vp = VC + (size_t)(b * CTXL + c) * 128 + kh * 64; }
        float s = 0.f; for (int d = 0; d < 64; ++d) s += q[d] * bf2f(kp[d]);
        const float mn = fmaxf(m, s), al = exp2f(m - mn), p = exp2f(s - mn); m = mn; l = l * al + p;
        for (int d = 0; d < 64; ++d) o[d] = o[d] * al + p * bf2f(vp[d]);
    }
    for (int d = 0; d < 64; ++d) MIX[(size_t)row * D + 512 + h * 64 + d] = f2bf_s(o[d] / l);
}
__global__ void slow_vstats(const bf16* VB, float* stat) {
    const int row = blockIdx.x * blockDim.x + threadIdx.x; if (row >= NTOK) return;
    float s = 0.f; for (int c = 0; c < D; ++c) s += bf2f(VB[(size_t)row * D + c]); const float mean = s / D;
    float s2 = 0.f; for (int c = 0; c < D; ++c) { const float d = bf2f(VB[(size_t)row * D + c]) - mean; s2 += d * d; }
    stat[2 * row] = mean; stat[2 * row + 1] = rsqrtf(s2 / D + EPS);
}
__global__ void slow_spatial(const bf16* U, const bf16* VB, const float* stat, const float* ws, const float* bs, const float* lng, const float* lnb, bf16* SG) {
    const size_t i = (size_t)blockIdx.x * blockDim.x + threadIdx.x;
    if (i < (size_t)NTOK * D) { const int row = (int)(i >> 10), ch = (int)(i & 1023); const int g = ch >> 7, p = row & 127, r0 = row - p;
        float s = 0.f;
        for (int q = 0; q < 128; ++q) { const float vn = (bf2f(VB[(size_t)(r0 + q) * D + ch]) - stat[2 * (r0 + q)]) * stat[2 * (r0 + q) + 1] * lng[ch] + lnb[ch]; s += ws[((size_t)g * 128 + p) * 128 + q] * vn; }
        SG[i] = f2bf_s(bf2f(U[i]) * (s + bs[g * 128 + p])); }
}

static void launch_mega(Args& a, int lo, int hi, int& li, int grid, hipStream_t stream) {
    a.ph_lo = lo; a.ph_hi = hi; a.li = li++;
    hipLaunchKernelGGL(mega, dim3(grid), dim3(NTHREADS), LDS_BYTES, stream, a);
}
extern "C" void kernel_launch(void* const* d_in, const int* in_sizes, int n_in, void* d_out, int out_size, void* d_ws, size_t ws_size, hipStream_t stream) {
    static int grid = 0;
    if (grid == 0) {
        if (n_in != 33 || out_size != NTOK * D || ws_size < WS_END) { fprintf(stderr, "kernel_launch: unexpected problem (n_in %d, out %d, ws %zu)\n", n_in, out_size, ws_size); grid = -1; return; }
        int dev = 0, cus = 0, per_cu = 0;
        if (hipGetDevice(&dev) != hipSuccess || hipDeviceGetAttribute(&cus, hipDeviceAttributeMultiprocessorCount, dev) != hipSuccess) { grid = -1; return; }
        if (hipFuncSetAttribute((const void*)mega, hipFuncAttributeMaxDynamicSharedMemorySize, LDS_BYTES) != hipSuccess) { fprintf(stderr, "kernel_launch: hipFuncSetAttribute failed\n"); grid = -1; return; }
        if (hipOccupancyMaxActiveBlocksPerMultiprocessor(&per_cu, (const void*)mega, NTHREADS, LDS_BYTES) != hipSuccess || per_cu < 1) { fprintf(stderr, "kernel_launch: occupancy query says %d blocks per CU\n", per_cu); per_cu = 1; }
        (void)hipGetLastError();
        grid = cus;
    }
    if (grid < 0) return;
    unsigned char* ws = (unsigned char*)d_ws;
    (void)hipMemsetAsync(ws + WS_CTL, 0, CTL_ZERO_BYTES, stream);
    Args a{};
    for (int i = 0; i < 33; ++i) a.in[i] = (const float*)d_in[i];
    a.out = (float*)d_out; a.ws = ws;
    int li = 0;
    const float* in_[33]; for (int i = 0; i < 33; ++i) in_[i] = (const float*)d_in[i];
    float* CF = (float*)(ws + WS_CF); float* MOD = (float*)(ws + WS_MOD); int* CNT = (int*)(ws + WS_CTL) + CW_CNT;
    int lo = 0;
    auto flush = [&](int upto) { if (upto > lo) launch_mega(a, lo, upto, li, grid, stream); };
    for (int ph = 0; ph < NPHASE; ++ph) {
        bool slow = false;
        switch (ph) {
        case PH_GIN: slow = SLOW_MASK & 1; break;
        case PH_ATT: slow = SLOW_MASK & 2; break;
        case PH_GOUT: case PH_GMO: slow = SLOW_MASK & 4; break;
        case PH_M1_0: case PH_M1_1: slow = SLOW_MASK & 8; break;
        case PH_M2_0: case PH_M2_1: slow = SLOW_MASK & 16; break;
        case PH_GMI: slow = SLOW_MASK & 32; break;
        case PH_SPA: slow = SLOW_MASK & 64; break;
        default: break;
        }
        if (!slow) continue;
        flush(ph); lo = ph + 1;
        const int l = (ph == PH_M1_1 || ph == PH_M2_1) ? 1 : 0;
        switch (ph) {
        case PH_GIN:
            hipLaunchKernelGGL(slow_gemm, dim3(EVEN_IN / 64, NTOK / 64), dim3(256), 0, stream, (const bf16*)(ws + WS_XA), (const int*)nullptr, (const bf16*)(ws + WS_WINT), CF, EVEN_IN, (const int*)nullptr, (size_t)0);
            hipLaunchKernelGGL(slow_gemm, dim3(256 / 64, NCTX / 64), dim3(256), 0, stream, (const bf16*)(ws + WS_GM), (const int*)nullptr, (const bf16*)(ws + WS_WINT) + (size_t)KV_COL * D, CF + (size_t)NTOK * EVEN_IN, 256, (const int*)nullptr, (size_t)0);
            hipLaunchKernelGGL(slow_epi_in, dim3(NTOK * 512 / 256), dim3(256), 0, stream, (const float*)CF, (const float*)(CF + (size_t)NTOK * EVEN_IN), in_[I_EBIN], (bf16*)(ws + WS_GLU), (bf16*)(ws + WS_Q), (bf16*)(ws + WS_K), (bf16*)(ws + WS_V), (bf16*)(ws + WS_KC), (bf16*)(ws + WS_VC));
            break;
        case PH_ATT:
            hipLaunchKernelGGL(slow_attention, dim3(NTOK * 8 / 64), dim3(64), 0, stream, (const bf16*)(ws + WS_Q), (const bf16*)(ws + WS_K), (const bf16*)(ws + WS_V), (const bf16*)(ws + WS_KC), (const bf16*)(ws + WS_VC), in_[I_SINK], (bf16*)(ws + WS_MIX));
            break;
        case PH_GOUT:
            hipLaunchKernelGGL(slow_gemm, dim3(D / 64, NTOK / 64), dim3(256), 0, stream, (const bf16*)(ws + WS_MIX), (const int*)nullptr, (const bf16*)(ws + WS_WOUTT), CF, D, (const int*)nullptr, (size_t)0);
            hipLaunchKernelGGL(slow_epi_res, dim3(NTOK * D / 256), dim3(256), 0, stream, (const float*)CF, in_[I_X], (float*)(ws + WS_H), in_[I_EBOUT], (const float*)(MOD + 2 * 1024));
            break;
        case PH_GMO:
            hipLaunchKernelGGL(slow_gemm, dim3(D / 64, NTOK / 64), dim3(256), 0, stream, (const bf16*)(ws + WS_MIX), (const int*)nullptr, (const bf16*)(ws + WS_GWOUTT), CF, D, (const int*)nullptr, (size_t)0);
            hipLaunchKernelGGL(slow_epi_res, dim3(NTOK * D / 256), dim3(256), 0, stream, (const float*)CF, (const float*)(ws + WS_H), (float*)(ws + WS_H), in_[I_OBOUT], (const float*)(MOD + (size_t)9 * MODW + 2 * 1024));
            break;
        case PH_M1_0: case PH_M1_1:
            hipLaunchKernelGGL(slow_arow, dim3(ACT_ROWS / 256), dim3(256), 0, stream, (const int*)(CNT + l * NE), (const int*)(ws + WS_LIST), (int*)(ws + WS_AROW));
            hipLaunchKernelGGL(slow_gemm, dim3(2048 / 64, ACT_ROWS / 64), dim3(256), 0, stream, (const bf16*)(ws + WS_XA), (const int*)(ws + WS_AROW), (const bf16*)(ws + WS_W1T) + (size_t)l * NE * 2048 * 1024, CF, 2048, (const int*)(CNT + l * NE), (size_t)2048 * 1024);
            hipLaunchKernelGGL(slow_epi_swiglu, dim3(ACT_ROWS * 1024 / 256), dim3(256), 0, stream, (const float*)CF, (const int*)(CNT + l * NE), in_[I_B1] + (size_t)l * NE * 2048, (bf16*)(ws + WS_ACT));
            break;
        case PH_M2_0: case PH_M2_1:
            hipLaunchKernelGGL(slow_gemm, dim3(1024 / 64, ACT_ROWS / 64), dim3(256), 0, stream, (const bf16*)(ws + WS_ACT), (const int*)nullptr, (const bf16*)(ws + WS_W2T) + (size_t)l * NE * 1024 * 1024, CF, 1024, (const int*)(CNT + l * NE), (size_t)1024 * 1024);
            hipLaunchKernelGGL(slow_epi_down, dim3(ACT_ROWS * 1024 / 256), dim3(256), 0, stream, (const float*)CF, (const int*)(CNT + l * NE), (const int*)(ws + WS_LIST), (const float*)(ws + WS_GATE), in_[I_B2] + (size_t)l * NE * D, (bf16*)(ws + WS_Y));
            break;
        case PH_GMI:
            hipLaunchKernelGGL(slow_gemm, dim3(2048 / 64, NTOK / 64), dim3(256), 0, stream, (const bf16*)(ws + WS_XA), (const int*)nullptr, (const bf16*)(ws + WS_GWINT), CF, 2048, (const int*)nullptr, (size_t)0);
            hipLaunchKernelGGL(slow_epi_gelu, dim3(NTOK * 2048 / 256), dim3(256), 0, stream, (const float*)CF, in_[I_OBIN], (bf16*)(ws + WS_U), (bf16*)(ws + WS_VB));
            break;
        case PH_SPA:
            hipLaunchKernelGGL(slow_vstats, dim3(NTOK / 64), dim3(64), 0, stream, (const bf16*)(ws + WS_VB), CF);
            hipLaunchKernelGGL(slow_spatial, dim3(NTOK * D / 256), dim3(256), 0, stream, (const bf16*)(ws + WS_U), (const bf16*)(ws + WS_VB), (const float*)CF, in_[I_OWS], in_[I_OBS], in_[I_OLNG], in_[I_OLNB], (bf16*)(ws + WS_MIX));
            break;
        default: break;
        }
    }
    flush(NPHASE);
}
```

```cpp
#include <hip/hip_runtime.h>
#include <cstdio>
#include <cstdint>

#ifndef SLOW_MASK
#define SLOW_MASK 0x00
#endif

#define LAS __attribute__((address_space(3)))
typedef unsigned short bf16;
typedef short bf16x8 __attribute__((ext_vector_type(8)));
typedef float f32x4 __attribute__((ext_vector_type(4)));
typedef float f32x2 __attribute__((ext_vector_type(2)));
typedef unsigned u32x4 __attribute__((ext_vector_type(4)));
typedef unsigned u32x2 __attribute__((ext_vector_type(2)));
typedef __bf16 bf16x2_t __attribute__((ext_vector_type(2)));

constexpr int NB = 8, SEQ = 2048, D = 1024, NTOK = NB * SEQ, CTXL = 256, NCTX = NB * CTXL;
constexpr int NE = 32, TOPK = 4, NASSIGN = NTOK * TOPK, ACT_ROWS = NASSIGN + NE * 256;
constexpr int EVEN_IN = 1792, KV_COL = 1536;
constexpr float EPS = 1e-6f, LOG2E = 1.4426950408889634f;
constexpr float QSCALE = 0.125f * LOG2E;
constexpr int MODW = 6 * D;
constexpr int NWAVES = 8, NTHREADS = 512;

constexpr size_t MiB = 1u << 20;
constexpr size_t WS_CTL = 0, CTL_ZERO_BYTES = 1 * MiB;
constexpr size_t WS_MOD = 1 * MiB;
constexpr size_t WS_LIST = 2 * MiB;
constexpr size_t WS_GATE = 4 * MiB;
constexpr size_t WS_WSB = 5 * MiB;
constexpr size_t WS_WINT = 6 * MiB;
constexpr size_t WS_WOUTT = 10 * MiB;
constexpr size_t WS_GWINT = 12 * MiB;
constexpr size_t WS_GWOUTT = 16 * MiB;
constexpr size_t WS_KC = 18 * MiB;
constexpr size_t WS_VC = 18 * MiB + 512 * 1024;
constexpr size_t WS_K = 19 * MiB;
constexpr size_t WS_V = 23 * MiB;
constexpr size_t WS_GM = 27 * MiB;
constexpr size_t WS_AROW = 31 * MiB;
constexpr size_t WS_Q = 32 * MiB;
constexpr size_t WS_GLU = 48 * MiB;
constexpr size_t WS_XA = 64 * MiB;
constexpr size_t WS_MIX = 96 * MiB;
constexpr size_t WS_H = 128 * MiB;
constexpr size_t WS_U = 192 * MiB;
constexpr size_t WS_VB = 224 * MiB;
constexpr size_t WS_W1T = 256 * MiB;
constexpr size_t WS_W2T = 512 * MiB;
constexpr size_t WS_ACT = 640 * MiB;
constexpr size_t WS_Y = 784 * MiB;
constexpr size_t WS_CF = 912 * MiB;
constexpr size_t WS_END = 1488 * MiB;
constexpr int CW_BAR = 4096, CW_CNT = 131072;
constexpr int MAX_LAUNCH = 20;

constexpr int RING_BYTES = 131072;
constexpr int MISC_OFF = RING_BYTES;
constexpr int TAB_OFF = RING_BYTES + 256;
constexpr int LDS_BYTES = 147456;

#define LDS_WAIT() asm volatile("s_waitcnt lgkmcnt(0)" ::: "memory")
#define VM_WAIT() asm volatile("s_waitcnt vmcnt(0)" ::: "memory")

__device__ __forceinline__ float bf2f(unsigned b) { return __uint_as_float(b << 16); }
__device__ __forceinline__ unsigned pk2(float lo, float hi) { f32x2 v = {lo, hi}; bf16x2_t b = __builtin_convertvector(v, bf16x2_t); return __builtin_bit_cast(unsigned, b); }
__device__ __forceinline__ float wave_sum(float v) {
#pragma unroll
    for (int o = 1; o < 64; o <<= 1) v += __shfl_xor(v, o);
    return v;
}
__device__ __forceinline__ float sigmoidf_(float x) { return __builtin_amdgcn_rcpf(1.0f + __builtin_amdgcn_exp2f(-x * LOG2E)); }

#define XB_TMO      128
#define XB_XCNT(j)  (256  + 64 * (j))
#define XB_XSUB(j)  (1280 + 64 * (j))
#define XB_XGEN(j)  (2304 + 64 * (j))
#define XB_TOP      3328
#define XB_TOPGEN   3392
#define XCD_BAR_WORDS 3456
#define XB_SPIN_CAP (1u << 20)
__device__ __forceinline__ unsigned xb_ld(unsigned* p)              { return __hip_atomic_load(p, __ATOMIC_RELAXED, __HIP_MEMORY_SCOPE_AGENT); }
__device__ __forceinline__ unsigned xb_add(unsigned* p, unsigned v) { return __hip_atomic_fetch_add(p, v, __ATOMIC_RELAXED, __HIP_MEMORY_SCOPE_AGENT); }
__device__ __forceinline__ unsigned xb_xcc_id() { return (unsigned)__builtin_amdgcn_s_getreg((3 << 11) | 20) & 0xFu; }
#define XB_SPIN(cond, bar) do { unsigned _sp = 0; while (cond) { __builtin_amdgcn_s_sleep(1); \
    if ((++_sp & 255u) == 0u) { if (xb_ld(&(bar)[XB_TMO])) break; if (_sp > XB_SPIN_CAP) { atomicAdd(&(bar)[XB_TMO], 1u); break; } } } } while (0)
struct XcdBarrier { unsigned* bar; unsigned x; volatile LAS unsigned* st; };
__device__ __forceinline__ XcdBarrier xcd_barrier_post(unsigned* bar, volatile LAS unsigned* st) {
    XcdBarrier b; b.bar = bar; b.x = xb_xcc_id(); b.st = st;
    if (threadIdx.x == 0) (void)xb_add(&bar[XB_XCNT(b.x)], 1u);
    return b;
}
__device__ __forceinline__ void xcd_barrier_complete(unsigned* bar, unsigned x, unsigned& nloc, unsigned& nx) {
    const unsigned G = gridDim.x * gridDim.y * gridDim.z;
    unsigned sum, cnt, mine, sp = 0u;
    for (;;) {
        sum = 0u; cnt = 0u; mine = 0u;
#pragma unroll
        for (unsigned j = 0; j < 16; ++j) { const unsigned c = xb_ld(&bar[XB_XCNT(j)]); sum += c; cnt += (c > 0u) ? 1u : 0u; mine = (j == x) ? c : mine; }
        if (sum == G) break;
        __builtin_amdgcn_s_sleep(1);
        if ((++sp & 255u) == 0u) { if (xb_ld(&bar[XB_TMO])) break; if (sp > XB_SPIN_CAP) { atomicAdd(&bar[XB_TMO], 1u); break; } }
    }
    nloc = mine > 0u ? mine : 1u; nx = cnt > 0u ? cnt : 1u;
}
__device__ __forceinline__ void xcd_barrier(const XcdBarrier& b, const int tid) {
    asm volatile("s_waitcnt vmcnt(0)" ::: "memory");
    __syncthreads();
    if (tid == 0) {
        unsigned* bar = b.bar;
        __builtin_amdgcn_s_waitcnt(0);
        unsigned nloc = b.st[0], nx = b.st[1];
        if (nloc == 0u) { xcd_barrier_complete(bar, b.x, nloc, nx); b.st[0] = nloc; b.st[1] = nx; }
        const unsigned old = xb_add(&bar[XB_XSUB(b.x)], 1u);
        const unsigned gen = old / nloc;
        if (old + 1u == (gen + 1u) * nloc) {
            __builtin_amdgcn_fence(__ATOMIC_RELEASE, "agent");
            asm volatile("s_waitcnt vmcnt(0)" ::: "memory");
            const unsigned og = xb_add(&bar[XB_TOP], 1u);
            const unsigned tg = og / nx;
            if (og + 1u == (tg + 1u) * nx) xb_add(&bar[XB_TOPGEN], 1u);
            else XB_SPIN(xb_ld(&bar[XB_TOPGEN]) == tg, bar);
            __builtin_amdgcn_fence(__ATOMIC_ACQUIRE, "agent");
            xb_add(&bar[XB_XGEN(b.x)], 1u);
            asm volatile("s_waitcnt vmcnt(0)" ::: "memory");
        } else {
            XB_SPIN(xb_ld(&bar[XB_XGEN(b.x)]) == gen, bar);
            __builtin_amdgcn_fence(__ATOMIC_ACQUIRE, "agent");
            asm volatile("s_waitcnt vmcnt(0)" ::: "memory");
        }
    }
    __syncthreads();
}

namespace pg8 {
constexpr int BM = 256, BK = 64, HALF = 128, HTB = HALF * BK * 2, STAGE_BYTES = 8 * HTB, KD = 1024  ;
__host__ __device__ __forceinline__ int lds_byte(int r, int c) { const int st = (r >> 4) * 2 + (c >> 5), rr = r & 15, cc = c & 31, ob = rr * 64 + cc * 2; return st * 1024 + (ob ^ (((ob >> 9) & 1) << 5)); }
__host__ __device__ __forceinline__ void stage_rc(int b, int& R, int& C) { const int st = b / 1024, sb = b % 1024, swz = sb ^ (((sb >> 9) & 1) << 5); R = (st >> 1) * 16 + swz / 64; C = (st & 1) * 32 + (swz % 64) / 2; }
__host__ __device__ __forceinline__ int perm32(int rho) { const int n = rho >> 4, i = rho & 15; return 8 * (i >> 2) + 4 * n + (i & 3); }

struct Unit { int pm, pn, e, cnt; };

template <class Epi, class Sched>
__device__ __forceinline__ void gemm_phase(LAS unsigned char* lds, const Sched& S, const Epi& E, const int tid) {
    const int wid = __builtin_amdgcn_readfirstlane(tid >> 6), lane = tid & 63, wr = wid >> 2, wc = wid & 3, fr = lane & 15, fq = lane >> 4;
    constexpr int K = KD, nt = K / BK;
    int Rr[2], Cc[2];
    unsigned voffA[2][2], voffB[2];
#pragma unroll
    for (int i = 0; i < 2; ++i) { stage_rc(tid * 16 + i * 8192, Rr[i], Cc[i]); const int Rb = Epi::PERM ? ((Rr[i] & ~31) + perm32(Rr[i] & 31)) : Rr[i];
        voffB[i] = (unsigned)(Rb * K + Cc[i]) * 2u; }
    constexpr size_t kstep = (size_t)(BK * 2);
    constexpr size_t hstep = (size_t)HALF * K * 2;
    const unsigned ldsw = (unsigned)wid * 1024u;
    const int aoff = lds_byte(wr * 64 + fr, fq * 8), boff = lds_byte(wc * 32 + fr, fq * 8);
#define PG8_SA(b, h) (((b) * 2 + (h)) * HTB)
#define PG8_SB(b, h) ((4 + (b) * 2 + (h)) * HTB)
#define PG8_STAGE(bufoff, gbase, voff) do { _Pragma("unroll") for (int _i = 0; _i < 2; ++_i) \
        __builtin_amdgcn_global_load_lds((const unsigned*)((const char*)(gbase) + (voff)[_i]), (LAS unsigned*)(lds + (bufoff) + ldsw + _i * 8192), 16, 0, 0); } while (0)
#define PG8_LDA(dst, b, h) do { _Pragma("unroll") for (int m = 0; m < 4; ++m) _Pragma("unroll") for (int k = 0; k < 2; ++k) dst[m][k] = *(const LAS bf16x8*)(lds + PG8_SA(b, h) + aoff + m * 2048 + k * 1024); } while (0)
#define PG8_LDB(dst, b, h) do { _Pragma("unroll") for (int n = 0; n < 2; ++n) _Pragma("unroll") for (int k = 0; k < 2; ++k) dst[n][k] = *(const LAS bf16x8*)(lds + PG8_SB(b, h) + boff + n * 2048 + k * 1024); } while (0)
#define PG8_MMA(ai, bj, At, Bt) do { __builtin_amdgcn_s_setprio(1); _Pragma("unroll") for (int m = 0; m < 4; ++m) _Pragma("unroll") for (int n = 0; n < 2; ++n) _Pragma("unroll") for (int k = 0; k < 2; ++k) \
        acc[ai][bj][m][n] = __builtin_amdgcn_mfma_f32_16x16x32_bf16(Bt[n][k], At[m][k], acc[ai][bj][m][n], 0, 0, 0); __builtin_amdgcn_s_setprio(0); } while (0)
#define PG8_WAIT_V(n) asm volatile("s_waitcnt vmcnt(" #n ")" ::: "memory")
#define PG8_WAIT_L(n) asm volatile("s_waitcnt lgkmcnt(" #n ")" ::: "memory")
#define PG8_BAR __builtin_amdgcn_s_barrier()
#define PG8_SCHED __builtin_amdgcn_sched_barrier(0)
    Unit cur, nxt; int ui = 0;
    if (!S.next(0, cur)) return;
    S.a_voff(cur, voffA, Rr, Cc);
    f32x4 acc[2][2][4][2];
#pragma unroll
    for (int a = 0; a < 2; ++a)
#pragma unroll
        for (int b = 0; b < 2; ++b)
#pragma unroll
            for (int m = 0; m < 4; ++m)
#pragma unroll
                for (int n = 0; n < 2; ++n) acc[a][b][m][n] = (f32x4){0.f, 0.f, 0.f, 0.f};
    bf16x8 At[4][2], B0[2][2], B1[2][2];
    const char* cA = S.a_ptr(cur); const char* cB = S.b_ptr(cur);
    PG8_STAGE(PG8_SB(0, 0), cB, voffB); PG8_STAGE(PG8_SB(0, 1), cB + hstep, voffB); PG8_STAGE(PG8_SA(0, 0), cA, voffA[0]); PG8_STAGE(PG8_SA(0, 1), cA, voffA[1]);
    if (wr == 1) PG8_BAR;
    PG8_WAIT_V(2); PG8_BAR;
    PG8_STAGE(PG8_SB(1, 0), cB + kstep, voffB); PG8_STAGE(PG8_SA(1, 0), cA + kstep, voffA[0]); PG8_STAGE(PG8_SB(1, 1), cB + hstep + kstep, voffB);
    PG8_WAIT_V(6); PG8_BAR;
    for (;;) {
        const bool has_next = S.next(ui + 1, nxt);
        const char* nA = has_next ? S.a_ptr(nxt) : cA; const char* nB = has_next ? S.b_ptr(nxt) : cB;
        for (int t = 0; t < nt; t += 2) {
            const bool last = (t == nt - 2);
            const char* a1 = cA + (size_t)(t + 1) * kstep;
            const char* a2 = last ? nA : cA + (size_t)(t + 2) * kstep; const char* b2 = last ? nB : cB + (size_t)(t + 2) * kstep;
            const char* a3 = a2 + kstep; const char* b3 = b2 + kstep;
            PG8_LDB(B0, 0, 0); PG8_LDB(B1, 0, 1); PG8_SCHED; PG8_LDA(At, 0, 0); PG8_STAGE(PG8_SA(1, 1), a1, voffA[1]);
            if (Sched::GATHER) { if (last && has_next) S.a_voff(nxt, voffA, Rr, Cc); }
            PG8_WAIT_V(8); PG8_WAIT_L(0); PG8_BAR; PG8_MMA(0, 0, At, B0); PG8_MMA(0, 1, At, B1); PG8_BAR; PG8_SCHED;
            PG8_LDA(At, 0, 1); PG8_STAGE(PG8_SB(0, 0), b2, voffB); PG8_STAGE(PG8_SB(0, 1), b2 + hstep, voffB); PG8_STAGE(PG8_SA(0, 0), a2, voffA[0]);
            PG8_WAIT_V(8); PG8_WAIT_L(0); PG8_BAR; PG8_MMA(1, 0, At, B0); PG8_MMA(1, 1, At, B1); PG8_BAR; PG8_SCHED;
            PG8_LDB(B0, 1, 0); PG8_LDB(B1, 1, 1); PG8_SCHED; PG8_LDA(At, 1, 0); PG8_STAGE(PG8_SA(0, 1), a2, voffA[1]);
            PG8_WAIT_V(8); PG8_WAIT_L(0); PG8_BAR; PG8_MMA(0, 0, At, B0); PG8_MMA(0, 1, At, B1); PG8_BAR; PG8_SCHED;
            PG8_LDA(At, 1, 1); PG8_STAGE(PG8_SB(1, 0), b3, voffB); PG8_STAGE(PG8_SB(1, 1), b3 + hstep, voffB); PG8_STAGE(PG8_SA(1, 0), a3, voffA[0]);
            PG8_WAIT_V(8); PG8_WAIT_L(0); PG8_BAR; PG8_MMA(1, 0, At, B0); PG8_MMA(1, 1, At, B1); PG8_BAR; PG8_SCHED;
        }
        if (wr == 0) PG8_BAR;
        E(acc, cur, wr, wc, fr, fq);
        if (!has_next) break;
#pragma unroll
        for (int a = 0; a < 2; ++a)
#pragma unroll
            for (int b = 0; b < 2; ++b)
#pragma unroll
                for (int m = 0; m < 4; ++m)
#pragma unroll
                    for (int n = 0; n < 2; ++n) acc[a][b][m][n] = (f32x4){0.f, 0.f, 0.f, 0.f};
        cur = nxt; cA = nA; cB = nB; ++ui;
        if (wr == 1) PG8_BAR;
    }
    PG8_WAIT_V(0);
    PG8_BAR;
#undef PG8_SA
#undef PG8_SB
#undef PG8_STAGE
#undef PG8_LDA
#undef PG8_LDB
#undef PG8_MMA
#undef PG8_WAIT_V
#undef PG8_WAIT_L
#undef PG8_BAR
#undef PG8_SCHED
}
}

struct Args { const float* in[33]; float* out; unsigned char* ws; int ph_lo, ph_hi, li, pad; };
enum { I_X = 0, I_C, I_CTX, I_CCTX, I_ADAW, I_ADAB, I_NMG, I_NFG, I_EWIN, I_EBIN, I_ECW, I_ECB, I_ELNG, I_ELNB, I_QNG, I_KNG, I_SINK, I_EWOUT, I_EBOUT,
       I_OWIN, I_OBIN, I_OLNG, I_OLNB, I_OWS, I_OBS, I_OWOUT, I_OBOUT, I_RW, I_RB, I_W1, I_B1, I_W2, I_B2 };

typedef const __attribute__((address_space(4))) unsigned long long* kargp_t;
struct Ctx {
    LAS unsigned char* lds; int tid, lane, wave, G, vcu, gw, NGW; unsigned char* ws; kargp_t kp;
};
__device__ __forceinline__ const float* in_ptr(const Ctx& X, int i) { return (const float*)(const __attribute__((address_space(1))) float*)X.kp[i]; }
#define IN(i) in_ptr(X, (i))

struct DenseSched {
    static constexpr bool GATHER = false;
    const bf16* A; const bf16* Bt; int nM, nN, nwg, G, c;
    const bf16* A2; const bf16* Bt2; int nM2;
    __device__ __forceinline__ void init(const bf16* A_, const bf16* Bt_, int M, int N, int G_, int c_) { A = A_; Bt = Bt_; nM = M / 256; nN = N / 256; nwg = nM * nN; G = G_; c = c_; A2 = nullptr; Bt2 = nullptr; nM2 = 0; }
    __device__ __forceinline__ bool next(int i, pg8::Unit& u) const {
        const int L = i * G + c; if (L >= nwg + nM2) return false;
        if (L >= nwg) { u.pm = L - nwg; u.pn = 0; u.e = 1; u.cnt = 256; return true; }
        int wgid = L; { const int q = nwg / 8, r = nwg % 8, xcd = wgid % 8, off = wgid / 8; wgid = (xcd < r ? xcd * (q + 1) : r * (q + 1) + (xcd - r) * q) + off; }
        const int nig = 8 * nN, gid = wgid / nig, fm = gid * 8, gsz = (nM - fm) < 8 ? (nM - fm) : 8;
        u.pm = fm + ((wgid % nig) % gsz); u.pn = (wgid % nig) / gsz; u.e = 0; u.cnt = 256; return true;
    }
    __device__ __forceinline__ const char* a_ptr(const pg8::Unit& u) const { return (const char*)(u.e ? A2 : A) + (size_t)u.pm * 256 * pg8::KD * 2; }
    __device__ __forceinline__ const char* b_ptr(const pg8::Unit& u) const { return (const char*)(u.e ? Bt2 : Bt) + (size_t)u.pn * 256 * pg8::KD * 2; }
    __device__ __forceinline__ void a_voff(const pg8::Unit&, unsigned (&v)[2][2], const int (&R)[2], const int (&C)[2]) const {
#pragma unroll
        for (int i = 0; i < 2; ++i) { v[0][i] = (unsigned)(R[i] * pg8::KD + C[i]) * 2u; v[1][i] = v[0][i] + (unsigned)(pg8::HALF * pg8::KD * 2); }
    }
};
struct MoeSched {
    const LAS int* tab; int NT, G, c; bool gather;
};
template <bool GATHER_, int NTILE_N>
struct MoeSchedT {
    static constexpr bool GATHER = GATHER_;
    const LAS int* tab; int G, c;
    const bf16* A;
    const bf16* Bt;
    const int* list;
    __device__ __forceinline__ bool next(int i, pg8::Unit& u) const {
        const int L = i * G + c; const int T = tab[0];
        if (L >= T * NTILE_N) return false;
        const int mt = L / NTILE_N; u.pn = L % NTILE_N;
        const int w = __builtin_amdgcn_readfirstlane(tab[1 + mt]); u.e = w >> 16; const int tl = w & 0xffff;
        const int cnt = __builtin_amdgcn_readfirstlane(tab[512 + u.e]), pb = __builtin_amdgcn_readfirstlane(tab[544 + u.e]);
        u.pm = pb + tl * 256; u.cnt = cnt - tl * 256;
        return true;
    }
    __device__ __forceinline__ const char* a_ptr(const pg8::Unit& u) const { return GATHER ? (const char*)A : (const char*)A + (size_t)u.pm * pg8::KD * 2; }
    __device__ __forceinline__ const char* b_ptr(const pg8::Unit& u) const { return (const char*)Bt + ((size_t)u.e * NTILE_N + u.pn) * 256 * pg8::KD * 2; }
    __device__ __forceinline__ void a_voff(const pg8::Unit& u, unsigned (&v)[2][2], const int (&R)[2], const int (&C)[2]) const {
        if (GATHER) {
            const int slot0 = u.pm - tab[544 + u.e];
            const int* lp = list + (size_t)u.e * NTOK + slot0;
#pragma unroll
            for (int h = 0; h < 2; ++h)
#pragma unroll
                for (int i = 0; i < 2; ++i) { const int r = h * 128 + R[i]; const int tok = lp[r < u.cnt ? r : u.cnt - 1] >> 2; v[h][i] = (unsigned)(tok * pg8::KD + C[i]) * 2u; }
        } else {
#pragma unroll
            for (int i = 0; i < 2; ++i) { v[0][i] = (unsigned)(R[i] * pg8::KD + C[i]) * 2u; v[1][i] = v[0][i] + (unsigned)(pg8::HALF * pg8::KD * 2); }
        }
    }
};
__device__ __forceinline__ void moe_build_table(const Ctx& X, const int* cnt  ) {
    LAS int* tab = (LAS int*)(X.lds + TAB_OFF);
    __syncthreads();
    if (X.tid == 0) {
        int T = 0, pb = 0;
        for (int e = 0; e < NE; ++e) { const int c = __hip_atomic_load(cnt + e, __ATOMIC_RELAXED, __HIP_MEMORY_SCOPE_AGENT); const int mt = (c + 255) >> 8;
            tab[512 + e] = c; tab[544 + e] = pb; for (int t = 0; t < mt; ++t) tab[1 + T + t] = (e << 16) | t; T += mt; pb += mt * 256; }
        tab[0] = T;
    }
    __syncthreads();
}

__device__ __forceinline__ f32x2 gelu_pk(f32x2 v) {
    const f32x2 av = __builtin_elementwise_abs(v), d = av * 0.2316418882f + 1.0f;
    f32x2 t; t.x = __builtin_amdgcn_rcpf(d.x); t.y = __builtin_amdgcn_rcpf(d.y);
    f32x2 q = t * 0.5307027145f + (-0.7265760135f); q = q * t + 0.7107068705f; q = q * t + (-0.142248368f); q = q * t + 0.127414796f; q = q * t;
    const f32x2 s = (v * v) * (-0.72134752044f);
    f32x2 e; e.x = __builtin_amdgcn_exp2f(s.x); e.y = __builtin_amdgcn_exp2f(s.y);
    const f32x2 m = v * (q * e), r = v - m;
    f32x2 o; o.x = v.x < 0.f ? m.x : r.x; o.y = v.y < 0.f ? m.y : r.y; return o;
}
__device__ __forceinline__ u32x4 pack8(f32x4 a, f32x4 b) { u32x4 w; w.x = pk2(a[0], a[1]); w.y = pk2(a[2], a[3]); w.z = pk2(b[0], b[1]); w.w = pk2(b[2], b[3]); return w; }

struct EpiIn {
    static constexpr bool PERM = true;
    bf16 *GLU, *Q, *Kb, *Vb, *KC, *VC; const float* bias;
    __device__ __forceinline__ void operator()(const f32x4 (&acc)[2][2][4][2], const pg8::Unit& u, int wr, int wc, int fr, int fq) const {
        const int row0 = u.pm * 256 + wr * 64 + fr; const int c8 = wc * 32 + 8 * fq;
        if (u.e == 0 && u.pn < 4) {
            const int j0 = u.pn * 128 + c8;
            f32x4 bu[2], bg[2];
#pragma unroll
            for (int n = 0; n < 2; ++n) { bu[n] = *(const f32x4*)(bias + j0 + 4 * n); bg[n] = *(const f32x4*)(bias + 512 + j0 + 4 * n); }
#pragma unroll
            for (int ai = 0; ai < 2; ++ai)
#pragma unroll
                for (int m = 0; m < 4; ++m) { f32x4 o[2];
#pragma unroll
                    for (int n = 0; n < 2; ++n) { const f32x4 uu = acc[ai][0][m][n] + bu[n], gg = acc[ai][1][m][n] + bg[n];
#pragma unroll
                        for (int k = 0; k < 4; ++k) o[n][k] = uu[k] * sigmoidf_(gg[k]); }
                    *(u32x4*)(GLU + (size_t)(row0 + ai * 128 + m * 16) * 512 + j0) = pack8(o[0], o[1]); }
        } else {
#pragma unroll
            for (int bj = 0; bj < 2; ++bj) {
                bf16* dst; int ld, col, bcol;
                if (u.pn >= 6 || u.e) { dst = u.e ? (bj ? VC : KC) : (bj ? Vb : Kb); ld = 128; col = c8; bcol = KV_COL + bj * 128 + c8; }
                else { dst = Q; ld = 512; col = (u.pn - 4) * 256 + bj * 128 + c8; bcol = 1024 + col; }
                f32x4 bv[2];
#pragma unroll
                for (int n = 0; n < 2; ++n) bv[n] = *(const f32x4*)(bias + bcol + 4 * n);
#pragma unroll
                for (int ai = 0; ai < 2; ++ai)
#pragma unroll
                    for (int m = 0; m < 4; ++m) *(u32x4*)(dst + (size_t)(row0 + ai * 128 + m * 16) * ld + col) = pack8(acc[ai][bj][m][0] + bv[0], acc[ai][bj][m][1] + bv[1]);
            }
        }
    }
};
struct EpiRes {
    static constexpr bool PERM = false;
    const float* base; float* out; const float* bias; const float* gate;
    __device__ __forceinline__ void operator()(const f32x4 (&acc)[2][2][4][2], const pg8::Unit& u, int wr, int wc, int fr, int fq) const {
        const int col0 = u.pn * 256 + wc * 32 + 4 * fq; const int b = (u.pm * 256) / SEQ;
        f32x4 bv[2][2], gv[2][2];
#pragma unroll
        for (int bj = 0; bj < 2; ++bj)
#pragma unroll
            for (int n = 0; n < 2; ++n) { bv[bj][n] = *(const f32x4*)(bias + col0 + bj * 128 + n * 16); gv[bj][n] = *(const f32x4*)(gate + (size_t)b * MODW + col0 + bj * 128 + n * 16); }
#pragma unroll
        for (int ai = 0; ai < 2; ++ai)
#pragma unroll
            for (int m = 0; m < 4; ++m) { const size_t off = (size_t)(u.pm * 256 + ai * 128 + wr * 64 + m * 16 + fr) * D + col0;
#pragma unroll
                for (int bj = 0; bj < 2; ++bj)
#pragma unroll
                    for (int n = 0; n < 2; ++n) { const f32x4 bs = *(const f32x4*)(base + off + bj * 128 + n * 16); *(f32x4*)(out + off + bj * 128 + n * 16) = bs + gv[bj][n] * (acc[ai][bj][m][n] + bv[bj][n]); } }
    }
};
struct EpiGelu {
    static constexpr bool PERM = true;
    bf16 *U, *V; const float* bias;
    __device__ __forceinline__ void operator()(const f32x4 (&acc)[2][2][4][2], const pg8::Unit& u, int wr, int wc, int fr, int fq) const {
        const int row0 = u.pm * 256 + wr * 64 + fr; const int colt = u.pn * 256; bf16* base = colt >= 1024 ? V : U; const int cb = (colt & 1023) + wc * 32 + 8 * fq, bcol = colt + wc * 32 + 8 * fq;
        f32x4 bv[2][2];
#pragma unroll
        for (int bj = 0; bj < 2; ++bj)
#pragma unroll
            for (int n = 0; n < 2; ++n) bv[bj][n] = *(const f32x4*)(bias + bcol + bj * 128 + 4 * n);
#pragma unroll
        for (int ai = 0; ai < 2; ++ai)
#pragma unroll
            for (int m = 0; m < 4; ++m) { bf16* rowp = base + (size_t)(row0 + ai * 128 + m * 16) * D + cb;
#pragma unroll
                for (int bj = 0; bj < 2; ++bj) { f32x4 v0 = acc[ai][bj][m][0] + bv[bj][0], v1 = acc[ai][bj][m][1] + bv[bj][1];
                    f32x2 a = gelu_pk((f32x2){v0[0], v0[1]}), b = gelu_pk((f32x2){v0[2], v0[3]}), c = gelu_pk((f32x2){v1[0], v1[1]}), d = gelu_pk((f32x2){v1[2], v1[3]});
                    *(u32x4*)(rowp + bj * 128) = pack8((f32x4){a.x, a.y, b.x, b.y}, (f32x4){c.x, c.y, d.x, d.y}); } }
    }
};
struct EpiSwiglu {
    static constexpr bool PERM = true;
    bf16* ACT; const float* b1;
    __device__ __forceinline__ void operator()(const f32x4 (&acc)[2][2][4][2], const pg8::Unit& u, int wr, int wc, int fr, int fq) const {
        const int j0 = u.pn * 128 + wc * 32 + 8 * fq; const float* bb = b1 + (size_t)u.e * 2048;
        f32x4 bg[2], bu[2];
#pragma unroll
        for (int n = 0; n < 2; ++n) { bg[n] = *(const f32x4*)(bb + j0 + 4 * n); bu[n] = *(const f32x4*)(bb + 1024 + j0 + 4 * n); }
#pragma unroll
        for (int ai = 0; ai < 2; ++ai)
#pragma unroll
            for (int m = 0; m < 4; ++m) { f32x4 o[2];
#pragma unroll
                for (int n = 0; n < 2; ++n) { const f32x4 g4 = acc[ai][0][m][n] + bg[n], u4 = acc[ai][1][m][n] + bu[n];
#pragma unroll
                    for (int k = 0; k < 4; ++k) { const float g = fminf(g4[k], 7.0f), up = fminf(fmaxf(u4[k], -7.0f), 7.0f); o[n][k] = (up + 1.0f) * g * sigmoidf_(g * 1.702f); } }
                *(u32x4*)(ACT + (size_t)(u.pm + ai * 128 + wr * 64 + m * 16 + fr) * D + j0) = pack8(o[0], o[1]); }
    }
};
struct EpiDown {
    static constexpr bool PERM = true;
    bf16* Y; const float* b2; const int* list; const float* gatew; const LAS int* tab;
    __device__ __forceinline__ void operator()(const f32x4 (&acc)[2][2][4][2], const pg8::Unit& u, int wr, int wc, int fr, int fq) const {
        const int c8 = u.pn * 256 + wc * 32 + 8 * fq; const float* bb = b2 + (size_t)u.e * D;
        const int slot0 = u.pm - tab[544 + u.e]; const int* lp = list + (size_t)u.e * NTOK + slot0;
        int aid[2][4]; float gw[2][4];
#pragma unroll
        for (int ai = 0; ai < 2; ++ai)
#pragma unroll
            for (int m = 0; m < 4; ++m) { const int r = ai * 128 + wr * 64 + m * 16 + fr; aid[ai][m] = lp[r < u.cnt ? r : u.cnt - 1]; }
#pragma unroll
        for (int ai = 0; ai < 2; ++ai)
#pragma unroll
            for (int m = 0; m < 4; ++m) { gw[ai][m] = gatew[aid[ai][m]]; }
#pragma unroll
        for (int ai = 0; ai < 2; ++ai)
#pragma unroll
            for (int m = 0; m < 4; ++m) asm volatile("" : "+v"(aid[ai][m]), "+v"(gw[ai][m]));
#pragma unroll
        for (int bj = 0; bj < 2; ++bj) {
            f32x4 bv[2];
#pragma unroll
            for (int n = 0; n < 2; ++n) bv[n] = *(const f32x4*)(bb + c8 + bj * 128 + 4 * n);
            asm volatile("" : "+v"(bv[0]), "+v"(bv[1]));
#pragma unroll
            for (int ai = 0; ai < 2; ++ai)
#pragma unroll
                for (int m = 0; m < 4; ++m) { const int r = ai * 128 + wr * 64 + m * 16 + fr; const float g = gw[ai][m];
                    const u32x4 w = pack8((acc[ai][bj][m][0] + bv[0]) * g, (acc[ai][bj][m][1] + bv[1]) * g);
                    if (r < u.cnt) *(u32x4*)(Y + (size_t)aid[ai][m] * D + c8 + bj * 128) = w; }
        }
    }
};

__device__ __forceinline__ void transpose_item(const float* __restrict__ W, int K, int N, bf16* __restrict__ WT, int dst_n0, int src_n0, int k0, LAS float* scr, int lane) {
#pragma unroll 16
    for (int i = 0; i < 32; ++i) { const int kk = 2 * i + (lane >> 5); scr[kk * 33 + (lane & 31)] = W[(size_t)(k0 + kk) * N + src_n0 + (lane & 31)]; }
    LDS_WAIT();
    const int c = lane & 7;
#pragma unroll
    for (int j = 0; j < 4; ++j) { const int n = (lane >> 3) + 8 * j; const LAS float* s = scr + (8 * c) * 33 + n;
        u32x4 o; o.x = pk2(s[0 * 33], s[1 * 33]); o.y = pk2(s[2 * 33], s[3 * 33]); o.z = pk2(s[4 * 33], s[5 * 33]); o.w = pk2(s[6 * 33], s[7 * 33]);
        *(u32x4*)(WT + (size_t)(dst_n0 + n) * K + k0 + 8 * c) = o; }
    LDS_WAIT();
}
__device__ __forceinline__ int pair_src(int nd, int halfw) { return ((nd & 255) >> 7) * halfw + (nd >> 8) * 128 + (nd & 127); }

__device__ __forceinline__ void phase_prologue(const Args& a, const Ctx& X) {
    {
        LAS float* sc = (LAS float*)X.lds;
        LAS float* red = (LAS float*)(X.lds + 36864);
        float* MOD = (float*)(X.ws + WS_MOD);
        for (int item = blockIdx.x; item < 2 * 96; item += X.G) {
            const int l = item / 96, j0 = (item % 96) * 64;
            for (int idx = X.tid; idx < 9 * 1024; idx += NTHREADS) { const int r = idx >> 10, k = idx & 1023; const float v = r < 8 ? IN(I_C)[r * 1024 + k] : IN(I_CCTX)[k]; sc[idx] = v * sigmoidf_(v); }
            __syncthreads();
            float acc[9];
#pragma unroll
            for (int r = 0; r < 9; ++r) acc[r] = 0.f;
            const float* w = IN(I_ADAW) + (size_t)l * 1024 * MODW + j0 + X.lane;
#pragma unroll 8
            for (int k = X.wave * 128; k < X.wave * 128 + 128; ++k) { const float wv = w[(size_t)k * MODW];
#pragma unroll
                for (int r = 0; r < 9; ++r) acc[r] += sc[r * 1024 + k] * wv; }
#pragma unroll
            for (int r = 0; r < 9; ++r) red[(X.wave * 9 + r) * 64 + X.lane] = acc[r];
            __syncthreads();
            for (int t = X.tid; t < 9 * 64; t += NTHREADS) { const int r = t >> 6, cidx = t & 63; float s = 0.f;
#pragma unroll
                for (int w8 = 0; w8 < 8; ++w8) s += red[(w8 * 9 + r) * 64 + cidx];
                MOD[((size_t)l * 9 + r) * MODW + j0 + cidx] = s + IN(I_ADAB)[l * MODW + j0 + cidx]; }
            __syncthreads();
        }
    }
    LAS float* scr = (LAS float*)(X.lds + X.wave * 16384);
    bf16* WinT = (bf16*)(X.ws + WS_WINT); bf16* WoutT = (bf16*)(X.ws + WS_WOUTT); bf16* GWinT = (bf16*)(X.ws + WS_GWINT); bf16* GWoutT = (bf16*)(X.ws + WS_GWOUTT);
    bf16* W1T = (bf16*)(X.ws + WS_W1T); bf16* W2T = (bf16*)(X.ws + WS_W2T);
    constexpr int I_IN = 16 * (EVEN_IN / 32), I_OUT = 16 * 32, I_GIN = 16 * 64, I_GOUT = 16 * 32, I_M1 = 64 * 16 * 64, I_M2 = 64 * 16 * 32;
    constexpr int NITEMS = I_IN + I_OUT + I_GIN + I_GOUT + I_M1 + I_M2;
    for (int it = X.gw; it < NITEMS; it += X.NGW) {
        int r = it;
        if (r < I_M1) { const int mat = r >> 10, q = r & 1023, kb = q >> 6, nb = q & 63; const int nd = nb * 32;
            transpose_item(IN(I_W1) + (size_t)mat * 1024 * 2048, 1024, 2048, W1T + (size_t)mat * 2048 * 1024, nd, pair_src(nd, 1024), kb * 64, scr, X.lane); continue; } r -= I_M1;
        if (r < I_M2) { const int mat = r >> 9, q = r & 511, kb = q >> 5, nb = q & 31;
            transpose_item(IN(I_W2) + (size_t)mat * 1024 * 1024, 1024, 1024, W2T + (size_t)mat * 1024 * 1024, nb * 32, nb * 32, kb * 64, scr, X.lane); continue; } r -= I_M2;
        if (r < I_IN) { const int kb = r / 56, nb = r % 56; const int nd = nb * 32; const int ns = nd < 1024 ? pair_src(nd, 512) : nd;
            transpose_item(IN(I_EWIN), 1024, EVEN_IN, WinT, nd, ns, kb * 64, scr, X.lane); continue; } r -= I_IN;
        if (r < I_OUT) { const int kb = r >> 5, nb = r & 31; transpose_item(IN(I_EWOUT), 1024, 1024, WoutT, nb * 32, nb * 32, kb * 64, scr, X.lane); continue; } r -= I_OUT;
        if (r < I_GIN) { const int kb = r >> 6, nb = r & 63; transpose_item(IN(I_OWIN), 1024, 2048, GWinT, nb * 32, nb * 32, kb * 64, scr, X.lane); continue; } r -= I_GIN;
        { const int kb = r >> 5, nb = r & 31; transpose_item(IN(I_OWOUT), 1024, 1024, GWoutT, nb * 32, nb * 32, kb * 64, scr, X.lane); }
    }
    { bf16* WsB = (bf16*)(X.ws + WS_WSB); const float* ws = IN(I_OWS);
      for (int i = (X.gw * 64 + X.lane) * 4; i < 8 * 128 * 128; i += X.NGW * 64 * 4) { const f32x4 v = *(const f32x4*)(ws + i); u32x2 o; o.x = pk2(v[0], v[1]); o.y = pk2(v[2], v[3]); *(u32x2*)(WsB + i) = o; } }
}

__device__ __forceinline__ void modulate_row(const float* xrow, const float* g, const float* sh, const float* sc, bf16* orow, int lane, f32x4 (&y)[4]) {
    const f32x4* xr = (const f32x4*)xrow + lane; f32x4 v[4]; float ss = 0.f;
#pragma unroll
    for (int j = 0; j < 4; ++j) { v[j] = xr[64 * j]; ss += (v[j][0] * v[j][0] + v[j][1] * v[j][1]) + (v[j][2] * v[j][2] + v[j][3] * v[j][3]); }
    const float rstd = rsqrtf(wave_sum(ss) * (1.0f / D) + EPS);
#pragma unroll
    for (int j = 0; j < 4; ++j) { const f32x4 gk = ((const f32x4*)g)[lane + 64 * j], sk = ((const f32x4*)sc)[lane + 64 * j], hk = ((const f32x4*)sh)[lane + 64 * j];
        y[j] = v[j] * rstd * gk * (1.0f + sk) + hk;
        u32x2 o; o.x = pk2(y[j][0], y[j][1]); o.y = pk2(y[j][2], y[j][3]); *((u32x2*)orow + lane + 64 * j) = o; }
}
__device__ __forceinline__ void phase_modulate0(const Args& a, const Ctx& X) {
    const float* MOD0 = (const float*)(X.ws + WS_MOD); f32x4 y[4];
    bf16* XA = (bf16*)(X.ws + WS_XA); bf16* GM = (bf16*)(X.ws + WS_GM);
    for (int row = X.gw; row < NTOK + NCTX; row += X.NGW) {
        if (row < NTOK) { const float* m = MOD0 + (size_t)(row / SEQ) * MODW; modulate_row(IN(I_X) + (size_t)row * D, IN(I_NMG), m, m + 1024, XA + (size_t)row * D, X.lane, y); }
        else { const int r = row - NTOK; const float* m = MOD0 + (size_t)8 * MODW; modulate_row(IN(I_CTX) + (size_t)r * D, IN(I_NMG), m, m + 1024, GM + (size_t)r * D, X.lane, y); }
    }
}

__device__ __forceinline__ void qk_chunks(bf16* buf, int nchunks, int rowlen, const float* gn, bool rope, float oscale, const Ctx& X) {
    for (int ch = X.gw; ch < nchunks; ch += X.NGW) {
        const int e0 = ch * 512 + 8 * X.lane; const int token = e0 / rowlen; const int d0 = e0 & 63;
        u32x4 raw = *(const u32x4*)(buf + e0); float v[8];
#pragma unroll
        for (int i = 0; i < 4; ++i) { v[2 * i] = bf2f(raw[i] & 0xffffu); v[2 * i + 1] = bf2f(raw[i] >> 16); }
        float ss = 0.f;
#pragma unroll
        for (int i = 0; i < 8; ++i) ss += v[i] * v[i];
        ss += __shfl_xor(ss, 1); ss += __shfl_xor(ss, 2); ss += __shfl_xor(ss, 4);
        const float rstd = rsqrtf(ss * (1.0f / 64.0f) + EPS);
#pragma unroll
        for (int i = 0; i < 8; ++i) v[i] = v[i] * rstd * gn[d0 + i];
        if (rope) {
            const int t = token % SEQ; const float rowp = (float)(t >> 6), colp = (float)(t & 63);
#pragma unroll
            for (int i = 0; i < 8; ++i) { const float pv = __shfl_xor(v[i], 4); const int dd = (d0 + i) & 31;
                const float inv = exp2f(-(float)(dd & 15) * (13.287712379549449f / 16.0f)); const float ang = (dd < 16 ? rowp : colp) * inv;
                float sn, cs; sincosf(ang, &sn, &cs);
                v[i] = (d0 < 32) ? (v[i] * cs - pv * sn) : (v[i] * cs + pv * sn); }
        }
        u32x4 o; o.x = pk2(v[0] * oscale, v[1] * oscale); o.y = pk2(v[2] * oscale, v[3] * oscale); o.z = pk2(v[4] * oscale, v[5] * oscale); o.w = pk2(v[6] * oscale, v[7] * oscale);
        *(u32x4*)(buf + e0) = o;
    }
}
__device__ __forceinline__ void phase_conv_qk(const Args& a, const Ctx& X) {
    qk_chunks((bf16*)(X.ws + WS_Q), NTOK, 512, IN(I_QNG), true, QSCALE, X);
    qk_chunks((bf16*)(X.ws + WS_K), NTOK / 4, 128, IN(I_KNG), true, 1.0f, X);
    qk_chunks((bf16*)(X.ws + WS_KC), NCTX / 4, 128, IN(I_KNG), false, 1.0f, X);
    const bf16* GLU = (const bf16*)(X.ws + WS_GLU); bf16* MIX = (bf16*)(X.ws + WS_MIX);
    LAS unsigned* tin = (LAS unsigned*)X.lds;
    LAS float* tout = (LAS float*)(X.lds + 65536);
    const int cp = X.tid & 255, th = X.tid >> 8;
    float w0[31], w1[31];
#pragma unroll
    for (int j = 0; j < 31; ++j) { const f32x2 w = *(const f32x2*)(IN(I_ECW) + j * 512 + 2 * cp); w0[j] = w.x; w1[j] = w.y; }
    const f32x2 cb = *(const f32x2*)(IN(I_ECB) + 2 * cp);
    for (int tile = blockIdx.x; tile < NTOK / 32; tile += X.G) {
        const int row0 = tile * 32; const int t0 = row0 % SEQ;
        __syncthreads();
        for (int c = X.tid; c < 62 * 64; c += NTHREADS) { const int lr = c >> 6, cc = c & 63; const int t = t0 - 15 + lr;
            u32x4 v = (u32x4){0u, 0u, 0u, 0u}; if (t >= 0 && t < SEQ) v = *(const u32x4*)(GLU + (size_t)(row0 - 15 + lr) * 512 + cc * 8);
            *(LAS u32x4*)(tin + lr * 256 + cc * 4) = v; }
        __syncthreads();
        float a0[16], a1[16];
#pragma unroll
        for (int o = 0; o < 16; ++o) { a0[o] = cb.x; a1[o] = cb.y; }
#pragma unroll
        for (int rr = 0; rr < 46; ++rr) { const unsigned pv = tin[(16 * th + rr) * 256 + cp]; const float x0 = bf2f(pv & 0xffffu), x1 = bf2f(pv >> 16);
#pragma unroll
            for (int o = 0; o < 16; ++o) { const int j = rr - o; if (j >= 0 && j <= 30) { a0[o] += x0 * w0[j]; a1[o] += x1 * w1[j]; } } }
#pragma unroll
        for (int o = 0; o < 16; ++o) *(LAS f32x2*)(tout + (16 * th + o) * 512 + 2 * cp) = (f32x2){a0[o], a1[o]};
        __syncthreads();
#pragma unroll
        for (int q = 0; q < 4; ++q) { const int tl = X.wave * 4 + q; f32x4 v[2]; float s = 0.f;
#pragma unroll
            for (int j = 0; j < 2; ++j) { v[j] = *(const LAS f32x4*)(tout + tl * 512 + 4 * X.lane + 256 * j); s += (v[j][0] + v[j][1]) + (v[j][2] + v[j][3]); }
            const float mean = wave_sum(s) * (1.0f / 512.0f); float s2 = 0.f;
#pragma unroll
            for (int j = 0; j < 2; ++j) { v[j] = v[j] - mean; s2 += (v[j][0] * v[j][0] + v[j][1] * v[j][1]) + (v[j][2] * v[j][2] + v[j][3] * v[j][3]); }
            const float rstd = rsqrtf(wave_sum(s2) * (1.0f / 512.0f) + EPS);
#pragma unroll
            for (int j = 0; j < 2; ++j) { const f32x4 g = *(const f32x4*)(IN(I_ELNG) + 4 * X.lane + 256 * j), b = *(const f32x4*)(IN(I_ELNB) + 4 * X.lane + 256 * j);
                f32x4 y = v[j] * rstd * g + b;
#pragma unroll
                for (int k = 0; k < 4; ++k) y[k] = y[k] * sigmoidf_(y[k]);
                u32x2 o; o.x = pk2(y[0], y[1]); o.y = pk2(y[2], y[3]); *(u32x2*)(MIX + (size_t)(row0 + tl) * D + 4 * X.lane + 256 * j) = o; } }
    }
}

__device__ __forceinline__ void phase_attention(const Args& a, const Ctx& X) {
    const bf16* QN = (const bf16*)(X.ws + WS_Q); const bf16* KN = (const bf16*)(X.ws + WS_K); const bf16* VV = (const bf16*)(X.ws + WS_V);
    const bf16* KC = (const bf16*)(X.ws + WS_KC); const bf16* VC = (const bf16*)(X.ws + WS_VC); bf16* MIX = (bf16*)(X.ws + WS_MIX);
    LAS unsigned char* Ks = X.lds;
    LAS unsigned char* Vt = X.lds + 16384;
    const int lane = X.lane, l15 = lane & 15, g4 = lane >> 4;
    for (int unit = blockIdx.x; unit < NB * 2 * 32; unit += X.G) {
        const int b = unit >> 6, kh = (unit >> 5) & 1, qb = unit & 31; const int q0 = qb * 64;
        const int hq = kh * 4 + (X.wave >> 1), tq = (X.wave & 1) * 32;
        bf16x8 Qf[2][2];
#pragma unroll
        for (int qi = 0; qi < 2; ++qi)
#pragma unroll
            for (int s = 0; s < 2; ++s) Qf[qi][s] = *(const bf16x8*)(QN + (size_t)(b * SEQ + q0 + tq + 16 * qi + l15) * 512 + hq * 64 + 32 * s + 8 * g4);
        const float sink2 = IN(I_SINK)[hq] * LOG2E;
        float mrun[2], lrun[2]; f32x4 O[2][4];
#pragma unroll
        for (int qi = 0; qi < 2; ++qi) { mrun[qi] = sink2; lrun[qi] = (g4 == 0) ? 1.0f : 0.0f;
#pragma unroll
            for (int db = 0; db < 4; ++db) O[qi][db] = (f32x4){0.f, 0.f, 0.f, 0.f}; }
        for (int t = 0; t < 9; ++t) {
            const bf16* kp; const bf16* vp; int mode = 0;
            if (t < 5) { const int ks = q0 - 128 + 64 * t; if (ks < 0 || ks >= SEQ) continue; kp = KN + (size_t)(b * SEQ + ks) * 128 + kh * 64; vp = VV + (size_t)(b * SEQ + ks) * 128 + kh * 64; mode = (t == 0) ? 1 : (t == 4 ? 2 : 0); }
            else { const int ks = (t - 5) * 64; kp = KC + (size_t)(b * CTXL + ks) * 128 + kh * 64; vp = VC + (size_t)(b * CTXL + ks) * 128 + kh * 64; }
            __syncthreads();
            { const int key = X.tid >> 3, ch = X.tid & 7;
              const u32x4 kv = *(const u32x4*)(kp + (size_t)key * 128 + ch * 8); *(LAS u32x4*)(Ks + key * 144 + ch * 16) = kv;
              const u32x4 vv = *(const u32x4*)(vp + (size_t)key * 128 + ch * 8);
#pragma unroll
              for (int i = 0; i < 4; ++i) { *(LAS unsigned short*)(Vt + (8 * ch + 2 * i) * 136 + key * 2) = (unsigned short)(vv[i] & 0xffffu); *(LAS unsigned short*)(Vt + (8 * ch + 2 * i + 1) * 136 + key * 2) = (unsigned short)(vv[i] >> 16); } }
            __syncthreads();
            bf16x8 kf[4][2];
#pragma unroll
            for (int kb = 0; kb < 4; ++kb)
#pragma unroll
                for (int s = 0; s < 2; ++s) kf[kb][s] = *(const LAS bf16x8*)(Ks + (16 * kb + l15) * 144 + (32 * s + 8 * g4) * 2);
            bf16x8 vf[4][2];
#pragma unroll
            for (int db = 0; db < 4; ++db)
#pragma unroll
                for (int ks2 = 0; ks2 < 2; ++ks2) { const LAS unsigned char* p = Vt + (16 * db + l15) * 136 + (32 * ks2 + 4 * g4) * 2;
                    const u32x2 lo = *(const LAS u32x2*)p, hi = *(const LAS u32x2*)(p + 32);
                    u32x4 w; w.x = lo.x; w.y = lo.y; w.z = hi.x; w.w = hi.y; vf[db][ks2] = __builtin_bit_cast(bf16x8, w); }
#pragma unroll
            for (int qi = 0; qi < 2; ++qi) {
                f32x4 st[4];
#pragma unroll
                for (int kb = 0; kb < 4; ++kb) { st[kb] = (f32x4){0.f, 0.f, 0.f, 0.f};
#pragma unroll
                    for (int s = 0; s < 2; ++s) st[kb] = __builtin_amdgcn_mfma_f32_16x16x32_bf16(kf[kb][s], Qf[qi][s], st[kb], 0, 0, 0); }
                if (mode) { const int qloc = tq + 16 * qi + l15;
#pragma unroll
                    for (int kb = 0; kb < 4; ++kb)
#pragma unroll
                        for (int r = 0; r < 4; ++r) { const int kk = 16 * kb + 4 * g4 + r; const bool keep = (mode == 1) ? (kk >= qloc) : (kk <= qloc); if (!keep) st[kb][r] = -1e30f; } }
                float mx = st[0][0];
#pragma unroll
                for (int kb = 0; kb < 4; ++kb)
#pragma unroll
                    for (int r = 0; r < 4; ++r) mx = fmaxf(mx, st[kb][r]);
                mx = fmaxf(mx, __shfl_xor(mx, 16)); mx = fmaxf(mx, __shfl_xor(mx, 32));
                const float mnew = fmaxf(mrun[qi], mx); const float alpha = __builtin_amdgcn_exp2f(mrun[qi] - mnew); mrun[qi] = mnew;
                float ps = 0.f;
#pragma unroll
                for (int kb = 0; kb < 4; ++kb)
#pragma unroll
                    for (int r = 0; r < 4; ++r) { st[kb][r] = __builtin_amdgcn_exp2f(st[kb][r] - mnew); ps += st[kb][r]; }
                lrun[qi] = lrun[qi] * alpha + ps;
#pragma unroll
                for (int db = 0; db < 4; ++db) O[qi][db] = O[qi][db] * alpha;
#pragma unroll
                for (int ks2 = 0; ks2 < 2; ++ks2) { u32x4 w; w.x = pk2(st[2 * ks2][0], st[2 * ks2][1]); w.y = pk2(st[2 * ks2][2], st[2 * ks2][3]); w.z = pk2(st[2 * ks2 + 1][0], st[2 * ks2 + 1][1]); w.w = pk2(st[2 * ks2 + 1][2], st[2 * ks2 + 1][3]);
                    const bf16x8 pf = __builtin_bit_cast(bf16x8, w);
#pragma unroll
                    for (int db = 0; db < 4; ++db) O[qi][db] = __builtin_amdgcn_mfma_f32_16x16x32_bf16(vf[db][ks2], pf, O[qi][db], 0, 0, 0); }
            }
        }
#pragma unroll
        for (int qi = 0; qi < 2; ++qi) { float l = lrun[qi]; l += __shfl_xor(l, 16); l += __shfl_xor(l, 32); const float inv = 1.0f / l;
            bf16* orow = MIX + (size_t)(b * SEQ + q0 + tq + 16 * qi + l15) * D + 512 + hq * 64 + 4 * g4;
#pragma unroll
            for (int db = 0; db < 4; ++db) { u32x2 o; o.x = pk2(O[qi][db][0] * inv, O[qi][db][1] * inv); o.y = pk2(O[qi][db][2] * inv, O[qi][db][3] * inv); *(u32x2*)(orow + 16 * db) = o; } }
    }
}

__device__ __forceinline__ void phase_router(const Args& a, const Ctx& X, int layer) {
    const float* H = (const float*)(X.ws + WS_H); bf16* XA = (bf16*)(X.ws + WS_XA);
    const float* MODl = (const float*)(X.ws + WS_MOD) + (size_t)layer * 9 * MODW; const float* gn = IN(I_NFG) + layer * D;
    const float* rw = IN(I_RW) + (size_t)layer * D * NE; const float* rb = IN(I_RB) + layer * NE;
    int* cntg = (int*)(X.ws + WS_CTL) + CW_CNT + layer * NE; int* list = (int*)(X.ws + WS_LIST); float* gatew = (float*)(X.ws + WS_GATE);
    LAS float* ybuf = (LAS float*)X.lds;
    LAS float* part = (LAS float*)(X.lds + 65536);
    LAS float* lg = (LAS float*)(X.lds + 65536 + 16384);
    LAS int* sel = (LAS int*)(X.lds + 65536 + 16384 + 2048);
    LAS int* lcnt = (LAS int*)(X.lds + 65536 + 16384 + 2048 + 1024);
    const int e = X.lane & 31, hf = X.lane >> 5;
    float wreg[64];
#pragma unroll
    for (int i = 0; i < 64; ++i) wreg[i] = rw[(size_t)(128 * X.wave + 64 * hf + i) * NE + e];
    for (int blk = blockIdx.x; blk < NTOK / 64; blk += X.G) {
        const int rowbase = blk * 64;
        __syncthreads();
        if (X.tid < 64) lcnt[X.tid] = 0;
        for (int bt = 0; bt < 4; ++bt) {
            __syncthreads();
#pragma unroll
            for (int i = 0; i < 2; ++i) { const int rl = 2 * X.wave + i, row = rowbase + 16 * bt + rl; const float* m = MODl + (size_t)(row / SEQ) * MODW; f32x4 y[4];
                modulate_row(H + (size_t)row * D, gn, m + 3 * 1024, m + 4 * 1024, XA + (size_t)row * D, X.lane, y);
#pragma unroll
                for (int j = 0; j < 4; ++j) *(LAS f32x4*)(ybuf + rl * 1024 + 4 * X.lane + 256 * j) = y[j]; }
            __syncthreads();
            for (int r = 0; r < 16; ++r) { float acc = 0.f; const LAS float* yp = ybuf + r * 1024 + 128 * X.wave + 64 * hf;
#pragma unroll
                for (int i4 = 0; i4 < 16; ++i4) { const f32x4 yv = *(const LAS f32x4*)(yp + 4 * i4); acc += yv[0] * wreg[4 * i4] + yv[1] * wreg[4 * i4 + 1] + yv[2] * wreg[4 * i4 + 2] + yv[3] * wreg[4 * i4 + 3]; }
                acc += __shfl_xor(acc, 32);
                if (hf == 0) part[(r * 8 + X.wave) * 32 + e] = acc; }
            __syncthreads();
            { const int r = X.tid >> 5, ee = X.tid & 31; float s = rb[ee];
#pragma unroll
              for (int w8 = 0; w8 < 8; ++w8) s += part[(r * 8 + w8) * 32 + ee];
              lg[r * 32 + ee] = s; }
            __syncthreads();
            if (X.tid < 16) { const int r = X.tid, rl = 16 * bt + r; unsigned used = 0u; float tv[4]; int ti[4];
#pragma unroll
                for (int k = 0; k < 4; ++k) { float best = -3.0e38f; int bi = 0;
                    for (int ee = 0; ee < 32; ++ee) { const float v = lg[r * 32 + ee]; if (!((used >> ee) & 1u) && v > best) { best = v; bi = ee; } }
                    used |= 1u << bi; tv[k] = best; ti[k] = bi; }
                float ex[4], sum = 0.f;
#pragma unroll
                for (int k = 0; k < 4; ++k) { ex[k] = __expf(tv[k] - tv[0]); sum += ex[k]; }
                const float inv = 1.0f / sum;
#pragma unroll
                for (int k = 0; k < 4; ++k) { const int rank = atomicAdd((int*)&lcnt[ti[k]], 1); sel[rl * 4 + k] = (ti[k] << 16) | rank; gatew[(size_t)(rowbase + rl) * 4 + k] = ex[k] * inv; } }
        }
        __syncthreads();
        if (X.tid < 32) lcnt[32 + X.tid] = atomicAdd(cntg + X.tid, lcnt[X.tid]);
        __syncthreads();
        if (X.tid < 256) { const int w = sel[X.tid]; const int ee = w >> 16, rank = w & 0xffff; list[(size_t)ee * NTOK + lcnt[32 + ee] + rank] = rowbase * 4 + X.tid; }
    }
}

__device__ __forceinline__ void phase_combine(const Args& a, const Ctx& X, int layer) {
    float* H = (float*)(X.ws + WS_H); const bf16* Y = (const bf16*)(X.ws + WS_Y); bf16* XA = (bf16*)(X.ws + WS_XA);
    const float* MODl = (const float*)(X.ws + WS_MOD) + (size_t)layer * 9 * MODW;
    for (int row = X.gw; row < NTOK; row += X.NGW) {
        const float* gt = MODl + (size_t)(row / SEQ) * MODW + 5 * 1024; f32x4 h[4];
#pragma unroll
        for (int j = 0; j < 4; ++j) { h[j] = ((const f32x4*)(H + (size_t)row * D))[X.lane + 64 * j]; f32x4 s = (f32x4){0.f, 0.f, 0.f, 0.f};
#pragma unroll
            for (int k = 0; k < 4; ++k) { const u32x2 w = ((const u32x2*)(Y + ((size_t)row * 4 + k) * D))[X.lane + 64 * j]; s += (f32x4){bf2f(w.x & 0xffffu), bf2f(w.x >> 16), bf2f(w.y & 0xffffu), bf2f(w.y >> 16)}; }
            h[j] = h[j] + ((const f32x4*)gt)[X.lane + 64 * j] * s; }
        if (layer == 1) {
#pragma unroll
            for (int j = 0; j < 4; ++j) ((f32x4*)(((float*)(__attribute__((address_space(1))) float*)X.kp[33]) + (size_t)row * D))[X.lane + 64 * j] = h[j];
        } else {
            float ss = 0.f;
#pragma unroll
            for (int j = 0; j < 4; ++j) { ((f32x4*)(H + (size_t)row * D))[X.lane + 64 * j] = h[j]; ss += (h[j][0] * h[j][0] + h[j][1] * h[j][1]) + (h[j][2] * h[j][2] + h[j][3] * h[j][3]); }
            const float rstd = rsqrtf(wave_sum(ss) * (1.0f / D) + EPS);
            const float* m1 = (const float*)(X.ws + WS_MOD) + (size_t)9 * MODW + (size_t)(row / SEQ) * MODW; const float* g = IN(I_NMG) + D;
#pragma unroll
            for (int j = 0; j < 4; ++j) { const f32x4 gk = ((const f32x4*)g)[X.lane + 64 * j], hk = ((const f32x4*)m1)[X.lane + 64 * j], sk = ((const f32x4*)(m1 + 1024))[X.lane + 64 * j];
                const f32x4 y = h[j] * rstd * gk * (1.0f + sk) + hk; u32x2 o; o.x = pk2(y[0], y[1]); o.y = pk2(y[2], y[3]); ((u32x2*)(XA + (size_t)row * D))[X.lane + 64 * j] = o; }
        }
    }
}

__device__ __forceinline__ void phase_spatial(const Args& a, const Ctx& X) {
    const bf16* U = (const bf16*)(X.ws + WS_U); const bf16* VB = (const bf16*)(X.ws + WS_VB); bf16* SG = (bf16*)(X.ws + WS_MIX); const bf16* WsB = (const bf16*)(X.ws + WS_WSB);
    LAS float* stat = (LAS float*)X.lds;
    LAS unsigned char* Vt = X.lds + 4096;
    const int lane = X.lane, l15 = lane & 15, g4 = lane >> 4;
    for (int item = blockIdx.x; item < 128 * 8; item += X.G) {
        const int chunk = item >> 3, g = item & 7; const int row0 = chunk * 128;
        __syncthreads();
        for (int i = 0; i < 16; ++i) { const int r = X.wave * 16 + i; const u32x4* vr = (const u32x4*)(VB + (size_t)(row0 + r) * D); float s = 0.f, s2 = 0.f;
#pragma unroll
            for (int j = 0; j < 2; ++j) { const u32x4 w = vr[lane + 64 * j];
#pragma unroll
                for (int k = 0; k < 4; ++k) { const float x0 = bf2f(w[k] & 0xffffu), x1 = bf2f(w[k] >> 16); s += x0 + x1; s2 += x0 * x0 + x1 * x1; } }
            s = wave_sum(s); s2 = wave_sum(s2); const float mean = s * (1.0f / D); const float var = fmaxf(s2 * (1.0f / D) - mean * mean, 0.f);
            if (lane == 0) { stat[2 * r] = mean; stat[2 * r + 1] = rsqrtf(var + EPS); } }
        __syncthreads();
        for (int c = X.tid; c < 128 * 16; c += NTHREADS) { const int q = c >> 4, cc = c & 15; const u32x4 w = *(const u32x4*)(VB + (size_t)(row0 + q) * D + g * 128 + cc * 8);
            const float mean = stat[2 * q], rstd = stat[2 * q + 1]; const float* lg_ = IN(I_OLNG) + g * 128 + cc * 8; const float* lb_ = IN(I_OLNB) + g * 128 + cc * 8;
#pragma unroll
            for (int k = 0; k < 4; ++k) { const float y0 = (bf2f(w[k] & 0xffffu) - mean) * rstd * lg_[2 * k] + lb_[2 * k], y1 = (bf2f(w[k] >> 16) - mean) * rstd * lg_[2 * k + 1] + lb_[2 * k + 1];
                const unsigned pk = pk2(y0, y1);
                *(LAS unsigned short*)(Vt + (cc * 8 + 2 * k) * 272 + q * 2) = (unsigned short)(pk & 0xffffu); *(LAS unsigned short*)(Vt + (cc * 8 + 2 * k + 1) * 272 + q * 2) = (unsigned short)(pk >> 16); } }
        __syncthreads();
        f32x4 acc[8];
#pragma unroll
        for (int pb = 0; pb < 8; ++pb) acc[pb] = (f32x4){0.f, 0.f, 0.f, 0.f};
#pragma unroll
        for (int s = 0; s < 4; ++s) { const bf16x8 af = *(const LAS bf16x8*)(Vt + (16 * X.wave + l15) * 272 + (32 * s + 8 * g4) * 2);
#pragma unroll
            for (int pb = 0; pb < 8; ++pb) { const bf16x8 bfr = *(const bf16x8*)(WsB + ((size_t)g * 128 + 16 * pb + l15) * 128 + 32 * s + 8 * g4); acc[pb] = __builtin_amdgcn_mfma_f32_16x16x32_bf16(af, bfr, acc[pb], 0, 0, 0); } }
#pragma unroll
        for (int pb = 0; pb < 8; ++pb) { const int p = 16 * pb + l15; const float bs = IN(I_OBS)[g * 128 + p]; const size_t off = (size_t)(row0 + p) * D + g * 128 + 16 * X.wave + 4 * g4;
            const u32x2 uw = *(const u32x2*)(U + off);
            u32x2 o; o.x = pk2(bf2f(uw.x & 0xffffu) * (acc[pb][0] + bs), bf2f(uw.x >> 16) * (acc[pb][1] + bs)); o.y = pk2(bf2f(uw.y & 0xffffu) * (acc[pb][2] + bs), bf2f(uw.y >> 16) * (acc[pb][3] + bs));
            *(u32x2*)(SG + off) = o; }
    }
}

enum { PH_PRO = 0, PH_MOD0, PH_GIN, PH_CONV, PH_ATT, PH_GOUT, PH_RT0, PH_M1_0, PH_M2_0, PH_CMB0, PH_GMI, PH_SPA, PH_GMO, PH_RT1, PH_M1_1, PH_M2_1, PH_CMB1, NPHASE };

__global__ void __launch_bounds__(NTHREADS, 2) mega(Args a) {
    extern __shared__ __attribute__((aligned(16))) unsigned char lds_raw[];
    Ctx X; X.lds = (LAS unsigned char*)lds_raw;
    const int wave0 = __builtin_amdgcn_readfirstlane((int)threadIdx.x >> 6);
    X.G = gridDim.x; { const int bx = blockIdx.x; X.vcu = (X.G % 8 == 0) ? (bx % 8) * (X.G / 8) + bx / 8 : bx; }
    X.NGW = X.G * NWAVES; X.wave = wave0;
    volatile LAS unsigned* MISC = (volatile LAS unsigned*)(X.lds + MISC_OFF);
    if (threadIdx.x < 64) MISC[threadIdx.x] = 0u;
    __syncthreads();
    XcdBarrier bar = xcd_barrier_post((unsigned*)(a.ws + WS_CTL) + CW_BAR + a.li * XCD_BAR_WORDS, MISC + 8);
    const int ph_lo = a.ph_lo, ph_hi = a.ph_hi;
#define PH_ENTER() int z; asm volatile("s_mov_b32 %0, 0" : "=s"(z)); \
        X.lane = (int)__builtin_amdgcn_mbcnt_hi(~0u, __builtin_amdgcn_mbcnt_lo(~0u, (unsigned)z)); X.tid = wave0 * 64 + X.lane; X.gw = X.vcu * NWAVES + wave0; \
        { kargp_t kp = (kargp_t)__builtin_amdgcn_kernarg_segment_ptr(); asm volatile("" : "+s"(kp)); X.kp = kp; } \
        unsigned char* ws = (unsigned char*)(__attribute__((address_space(1))) unsigned char*)X.kp[34] + z; X.ws = ws;
    for (int ph = ph_lo; ph < ph_hi; ++ph) {
        if (ph != ph_lo) { const int l0 = (int)__builtin_amdgcn_mbcnt_hi(~0u, __builtin_amdgcn_mbcnt_lo(~0u, 0u)); xcd_barrier(bar, wave0 * 64 + l0); }
        switch (ph) {
        case PH_PRO: { PH_ENTER(); phase_prologue(a, X); } break;
        case PH_MOD0: { PH_ENTER(); phase_modulate0(a, X); } break;
        case PH_GIN: { PH_ENTER(); DenseSched S; S.init((const bf16*)(ws + WS_XA), (const bf16*)(ws + WS_WINT), NTOK, EVEN_IN, X.G, (int)blockIdx.x);
            S.A2 = (const bf16*)(ws + WS_GM); S.Bt2 = (const bf16*)(ws + WS_WINT) + (size_t)KV_COL * D; S.nM2 = NCTX / 256;
            EpiIn E{(bf16*)(ws + WS_GLU), (bf16*)(ws + WS_Q), (bf16*)(ws + WS_K), (bf16*)(ws + WS_V), (bf16*)(ws + WS_KC), (bf16*)(ws + WS_VC), IN(I_EBIN)};
            pg8::gemm_phase<EpiIn, DenseSched>(X.lds, S, E, X.tid); } break;
        case PH_CONV: { PH_ENTER(); phase_conv_qk(a, X); } break;
        case PH_ATT: { PH_ENTER(); phase_attention(a, X); } break;
        case PH_GOUT: { PH_ENTER(); DenseSched S; S.init((const bf16*)(ws + WS_MIX), (const bf16*)(ws + WS_WOUTT), NTOK, D, X.G, (int)blockIdx.x);
            EpiRes E{IN(I_X), (float*)(ws + WS_H), IN(I_EBOUT), (const float*)(ws + WS_MOD) + 2 * 1024};
            pg8::gemm_phase<EpiRes, DenseSched>(X.lds, S, E, X.tid); } break;
        case PH_RT0: { PH_ENTER(); phase_router(a, X, 0); } break;
        case PH_RT1: { PH_ENTER(); phase_router(a, X, 1); } break;
        case PH_M1_0: case PH_M1_1: { PH_ENTER(); const int l = (ph == PH_M1_1); moe_build_table(X, (const int*)(ws + WS_CTL) + CW_CNT + l * NE);
            MoeSchedT<true, 8> S; S.tab = (const LAS int*)(X.lds + TAB_OFF); S.G = X.G; S.c = X.vcu; S.A = (const bf16*)(ws + WS_XA); S.Bt = (const bf16*)(ws + WS_W1T) + (size_t)l * NE * 2048 * 1024; S.list = (const int*)(ws + WS_LIST);
            EpiSwiglu E{(bf16*)(ws + WS_ACT), IN(I_B1) + (size_t)l * NE * 2048};
            pg8::gemm_phase<EpiSwiglu, MoeSchedT<true, 8>>(X.lds, S, E, X.tid); } break;
        case PH_M2_0: case PH_M2_1: { PH_ENTER(); const int l = (ph == PH_M2_1); moe_build_table(X, (const int*)(ws + WS_CTL) + CW_CNT + l * NE);
            MoeSchedT<false, 4> S; S.tab = (const LAS int*)(X.lds + TAB_OFF); S.G = X.G; S.c = X.vcu; S.A = (const bf16*)(ws + WS_ACT); S.Bt = (const bf16*)(ws + WS_W2T) + (size_t)l * NE * 1024 * 1024; S.list = (const int*)(ws + WS_LIST);
            EpiDown E{(bf16*)(ws + WS_Y), IN(I_B2) + (size_t)l * NE * D, (const int*)(ws + WS_LIST), (const float*)(ws + WS_GATE), (const LAS int*)(X.lds + TAB_OFF)};
            pg8::gemm_phase<EpiDown, MoeSchedT<false, 4>>(X.lds, S, E, X.tid); } break;
        case PH_CMB0: { PH_ENTER(); phase_combine(a, X, 0); } break;
        case PH_CMB1: { PH_ENTER(); phase_combine(a, X, 1); } break;
        case PH_GMI: { PH_ENTER(); DenseSched S; S.init((const bf16*)(ws + WS_XA), (const bf16*)(ws + WS_GWINT), NTOK, 2048, X.G, (int)blockIdx.x);
            EpiGelu E{(bf16*)(ws + WS_U), (bf16*)(ws + WS_VB), IN(I_OBIN)};
            pg8::gemm_phase<EpiGelu, DenseSched>(X.lds, S, E, X.tid); } break;
        case PH_SPA: { PH_ENTER(); phase_spatial(a, X); } break;
        case PH_GMO: { PH_ENTER(); DenseSched S; S.init((const bf16*)(ws + WS_MIX), (const bf16*)(ws + WS_GWOUTT), NTOK, D, X.G, (int)blockIdx.x);
            EpiRes E{(const float*)(ws + WS_H), (float*)(ws + WS_H), IN(I_OBOUT), (const float*)(ws + WS_MOD) + (size_t)9 * MODW + 2 * 1024};
            pg8::gemm_phase<EpiRes, DenseSched>(X.lds, S, E, X.tid); } break;
        default: break;
        }
    }
}

__device__ __forceinline__ bool find_expert(const int* cnt, int s, int& e, int& slot) {
    int pb = 0;
    for (int i = 0; i < NE; ++i) { const int c = cnt[i]; const int pr = ((c + 255) >> 8) << 8; if (s < pb + pr) { e = i; slot = s - pb; return true; } pb += pr; }
    return false;
}
__global__ void __launch_bounds__(256) slow_gemm(const bf16* A, const int* arow, const bf16* Bt, float* C, int N, const int* cnt, size_t bstride) {
    __shared__ float As[16][65], Bs[16][65];
    const int tx = threadIdx.x & 15, ty = threadIdx.x >> 4; const int m0 = blockIdx.y * 64, n0 = blockIdx.x * 64;
    if (cnt) { int e, slot; if (!find_expert(cnt, m0, e, slot)) return; Bt += (size_t)e * bstride; }
    float acc[4][4];
    for (int i = 0; i < 4; ++i) for (int j = 0; j < 4; ++j) acc[i][j] = 0.f;
    for (int k0 = 0; k0 < 1024; k0 += 16) {
        for (int i = 0; i < 4; ++i) { const int idx = threadIdx.x + 256 * i; const int r = idx >> 4, kk = idx & 15; const int gm = m0 + r; const int ar = arow ? arow[gm] : gm;
            As[kk][r] = bf2f(A[(size_t)ar * 1024 + k0 + kk]); Bs[kk][r] = bf2f(Bt[(size_t)(n0 + r) * 1024 + k0 + kk]); }
        __syncthreads();
        for (int kk = 0; kk < 16; ++kk) { float av[4], bv[4];
            for (int i = 0; i < 4; ++i) { av[i] = As[kk][ty * 4 + i]; bv[i] = Bs[kk][tx * 4 + i]; }
            for (int i = 0; i < 4; ++i) for (int j = 0; j < 4; ++j) acc[i][j] += av[i] * bv[j]; }
        __syncthreads();
    }
    for (int i = 0; i < 4; ++i) for (int j = 0; j < 4; ++j) C[(size_t)(m0 + ty * 4 + i) * N + n0 + tx * 4 + j] = acc[i][j];
}
__device__ __forceinline__ unsigned short f2bf_s(float f) { return (unsigned short)(pk2(f, 0.f) & 0xffffu); }
__global__ void slow_epi_in(const float* C, const float* C2, const float* bias, bf16* GLU, bf16* Q, bf16* Kb, bf16* Vb, bf16* KC, bf16* VC) {
    const size_t i = (size_t)blockIdx.x * blockDim.x + threadIdx.x;
    if (i < (size_t)NTOK * 512) { const int row = (int)(i >> 9), j = (int)(i & 511); const int t = j >> 7, ii = j & 127; const float* cr = C + (size_t)row * EVEN_IN;
        const float u = cr[t * 256 + ii] + bias[j], g = cr[t * 256 + 128 + ii] + bias[512 + j];
        GLU[i] = f2bf_s(u / (1.0f + expf(-g)));
        Q[i] = f2bf_s(cr[1024 + j] + bias[1024 + j]);
        if (j < 128) { Kb[(size_t)row * 128 + j] = f2bf_s(cr[1536 + j] + bias[1536 + j]); Vb[(size_t)row * 128 + j] = f2bf_s(cr[1664 + j] + bias[1664 + j]); }
        if (row < NCTX && j < 128) { KC[(size_t)row * 128 + j] = f2bf_s(C2[(size_t)row * 256 + j] + bias[1536 + j]); VC[(size_t)row * 128 + j] = f2bf_s(C2[(size_t)row * 256 + 128 + j] + bias[1664 + j]); } }
}
__global__ void slow_epi_res(const float* C, const float* base, float* out, const float* bias, const float* gate) {
    const size_t i = (size_t)blockIdx.x * blockDim.x + threadIdx.x;
    if (i < (size_t)NTOK * D) { const int row = (int)(i >> 10), col = (int)(i & 1023); out[i] = base[i] + gate[(size_t)(row / SEQ) * MODW + col] * (C[i] + bias[col]); }
}
__global__ void slow_epi_gelu(const float* C, const float* bias, bf16* U, bf16* V) {
    const size_t i = (size_t)blockIdx.x * blockDim.x + threadIdx.x;
    if (i < (size_t)NTOK * 2048) { const int row = (int)(i >> 11), col = (int)(i & 2047); const float x = C[i] + bias[col]; const float y = 0.5f * x * (1.0f + erff(x * 0.70710678118654752f));
        if (col < 1024) U[(size_t)row * D + col] = f2bf_s(y); else V[(size_t)row * D + col - 1024] = f2bf_s(y); }
}
__global__ void slow_arow(const int* cnt, const int* list, int* arow) {
    const int s = blockIdx.x * blockDim.x + threadIdx.x; if (s >= ACT_ROWS) return;
    int e, slot; int r = 0; if (find_expert(cnt, s, e, slot) && slot < cnt[e]) r = list[(size_t)e * NTOK + slot] >> 2;
    arow[s] = r;
}
__global__ void slow_epi_swiglu(const float* C, const int* cnt, const float* b1, bf16* ACT) {
    const size_t i = (size_t)blockIdx.x * blockDim.x + threadIdx.x;
    if (i < (size_t)ACT_ROWS * 1024) { const int s = (int)(i >> 10), j = (int)(i & 1023); int e, slot; if (!find_expert(cnt, s, e, slot)) return;
        const int t = j >> 7, ii = j & 127; const float* cr = C + (size_t)s * 2048;
        float g = cr[t * 256 + ii] + b1[(size_t)e * 2048 + j], up = cr[t * 256 + 128 + ii] + b1[(size_t)e * 2048 + 1024 + j];
        g = fminf(g, 7.0f); up = fminf(fmaxf(up, -7.0f), 7.0f);
        ACT[i] = f2bf_s((up + 1.0f) * g / (1.0f + expf(-1.702f * g))); }
}
__global__ void slow_epi_down(const float* C, const int* cnt, const int* list, const float* gatew, const float* b2, bf16* Y) {
    const size_t i = (size_t)blockIdx.x * blockDim.x + threadIdx.x;
    if (i < (size_t)ACT_ROWS * 1024) { const int s = (int)(i >> 10), col = (int)(i & 1023); int e, slot; if (!find_expert(cnt, s, e, slot) || slot >= cnt[e]) return;
        const int aid = list[(size_t)e * NTOK + slot]; Y[(size_t)aid * D + col] = f2bf_s((C[i] + b2[(size_t)e * D + col]) * gatew[aid]); }
}
__global__ void __launch_bounds__(64) slow_attention(const bf16* QN, const bf16* KN, const bf16* VV, const bf16* KC, const bf16* VC, const float* sink, bf16* MIX) {
    const int i = blockIdx.x * blockDim.x + threadIdx.x; if (i >= NTOK * 8) return;
    const int row = i >> 3, h = i & 7, kh = h >> 2, b = row / SEQ, t = row % SEQ;
    float q[64], o[64];
    for (int d = 0; d < 64; ++d) { q[d] = bf2f(QN[(size_t)row * 512 + h * 64 + d]); o[d] = 0.f; }
    float m = sink[h] * LOG2E, l = 1.0f;
    const int j0 = t - 128 < 0 ? 0 : t - 128, j1 = t + 128 > SEQ - 1 ? SEQ - 1 : t + 128;
    for (int jj = j0; jj <= j1 + CTXL; ++jj) {
        const bf16* kp; const bf16* vp;
        if (jj <= j1) { kp = KN + (size_t)(b * SEQ + jj) * 128 + kh * 64; vp = VV + (size_t)(b * SEQ + jj) * 128 + kh * 64; }
        else { const int c = jj - j1 - 1; kp = KC + (size_t)(b * CTXL + c) * 128 + kh * 64; vp = VC + (size_t)(b * CTXL + c) * 128 + kh * 64; }
        float s = 0.f; for (int d = 0; d < 64; ++d) s += q[d] * bf2f(kp[d]);
        const float mn = fmaxf(m, s), al = exp2f(m - mn), p = exp2f(s - mn); m = mn; l = l * al + p;
        for (int d = 0; d < 64; ++d) o[d] = o[d] * al + p * bf2f(vp[d]);
    }
    for (int d = 0; d < 64; ++d) MIX[(size_t)row * D + 512 + h * 64 + d] = f2bf_s(o[d] / l);
}
__global__ void slow_vstats(const bf16* VB, float* stat) {
    const int row = blockIdx.x * blockDim.x + threadIdx.x; if (row >= NTOK) return;
    float s = 0.f; for (int c = 0; c < D; ++c) s += bf2f(VB[(size_t)row * D + c]); const float mean = s / D;
    float s2 = 0.f; for (int c = 0; c < D; ++c) { const float d = bf2f(VB[(size_t)row * D + c]) - mean; s2 += d * d; }
    stat[2 * row] = mean; stat[2 * row + 1] = rsqrtf(s2 / D + EPS);
}
__global__ void slow_spatial(const bf16* U, const bf16* VB, const float* stat, const float* ws, const float* bs, const float* lng, const float* lnb, bf16* SG) {
    const size_t i = (size_t)blockIdx.x * blockDim.x + threadIdx.x;
    if (i < (size_t)NTOK * D) { const int row = (int)(i >> 10), ch = (int)(i & 1023); const int g = ch >> 7, p = row & 127, r0 = row - p;
        float s = 0.f;
        for (int q = 0; q < 128; ++q) { const float vn = (bf2f(VB[(size_t)(r0 + q) * D + ch]) - stat[2 * (r0 + q)]) * stat[2 * (r0 + q) + 1] * lng[ch] + lnb[ch]; s += ws[((size_t)g * 128 + p) * 128 + q] * vn; }
        SG[i] = f2bf_s(bf2f(U[i]) * (s + bs[g * 128 + p])); }
}

static void launch_mega(Args& a, int lo, int hi, int& li, int grid, hipStream_t stream) {
    a.ph_lo = lo; a.ph_hi = hi; a.li = li++;
    hipLaunchKernelGGL(mega, dim3(grid), dim3(NTHREADS), LDS_BYTES, stream, a);
}
extern "C" void kernel_launch(void* const* d_in, const int* in_sizes, int n_in, void* d_out, int out_size, void* d_ws, size_t ws_size, hipStream_t stream) {
    static int grid = 0;
    if (grid == 0) {
        if (n_in != 33 || out_size != NTOK * D || ws_size < WS_END) { fprintf(stderr, "kernel_launch: unexpected problem (n_in %d, out %d, ws %zu)\n", n_in, out_size, ws_size); grid = -1; return; }
        int dev = 0, cus = 0, per_cu = 0;
        if (hipGetDevice(&dev) != hipSuccess || hipDeviceGetAttribute(&cus, hipDeviceAttributeMultiprocessorCount, dev) != hipSuccess) { grid = -1; return; }
        if (hipFuncSetAttribute((const void*)mega, hipFuncAttributeMaxDynamicSharedMemorySize, LDS_BYTES) != hipSuccess) { fprintf(stderr, "kernel_launch: hipFuncSetAttribute failed\n"); grid = -1; return; }
        if (hipOccupancyMaxActiveBlocksPerMultiprocessor(&per_cu, (const void*)mega, NTHREADS, LDS_BYTES) != hipSuccess || per_cu < 1) { fprintf(stderr, "kernel_launch: occupancy query says %d blocks per CU\n", per_cu); per_cu = 1; }
        (void)hipGetLastError();
        grid = cus;
    }
    if (grid < 0) return;
    unsigned char* ws = (unsigned char*)d_ws;
    (void)hipMemsetAsync(ws + WS_CTL, 0, CTL_ZERO_BYTES, stream);
    Args a{};
    for (int i = 0; i < 33; ++i) a.in[i] = (const float*)d_in[i];
    a.out = (float*)d_out; a.ws = ws;
    int li = 0;
    const float* in_[33]; for (int i = 0; i < 33; ++i) in_[i] = (const float*)d_in[i];
    float* CF = (float*)(ws + WS_CF); float* MOD = (float*)(ws + WS_MOD); int* CNT = (int*)(ws + WS_CTL) + CW_CNT;
    int lo = 0;
    auto flush = [&](int upto) { if (upto > lo) launch_mega(a, lo, upto, li, grid, stream); };
    for (int ph = 0; ph < NPHASE; ++ph) {
        bool slow = false;
        switch (ph) {
        case PH_GIN: slow = SLOW_MASK & 1; break;
        case PH_ATT: slow = SLOW_MASK & 2; break;
        case PH_GOUT: case PH_GMO: slow = SLOW_MASK & 4; break;
        case PH_M1_0: case PH_M1_1: slow = SLOW_MASK & 8; break;
        case PH_M2_0: case PH_M2_1: slow = SLOW_MASK & 16; break;
        case PH_GMI: slow = SLOW_MASK & 32; break;
        case PH_SPA: slow = SLOW_MASK & 64; break;
        default: break;
        }
        if (!slow) continue;
        flush(ph); lo = ph + 1;
        const int l = (ph == PH_M1_1 || ph == PH_M2_1) ? 1 : 0;
        switch (ph) {
        case PH_GIN:
            hipLaunchKernelGGL(slow_gemm, dim3(EVEN_IN / 64, NTOK / 64), dim3(256), 0, stream, (const bf16*)(ws + WS_XA), (const int*)nullptr, (const bf16*)(ws + WS_WINT), CF, EVEN_IN, (const int*)nullptr, (size_t)0);
            hipLaunchKernelGGL(slow_gemm, dim3(256 / 64, NCTX / 64), dim3(256), 0, stream, (const bf16*)(ws + WS_GM), (const int*)nullptr, (const bf16*)(ws + WS_WINT) + (size_t)KV_COL * D, CF + (size_t)NTOK * EVEN_IN, 256, (const int*)nullptr, (size_t)0);
            hipLaunchKernelGGL(slow_epi_in, dim3(NTOK * 512 / 256), dim3(256), 0, stream, (const float*)CF, (const float*)(CF + (size_t)NTOK * EVEN_IN), in_[I_EBIN], (bf16*)(ws + WS_GLU), (bf16*)(ws + WS_Q), (bf16*)(ws + WS_K), (bf16*)(ws + WS_V), (bf16*)(ws + WS_KC), (bf16*)(ws + WS_VC));
            break;
        case PH_ATT:
            hipLaunchKernelGGL(slow_attention, dim3(NTOK * 8 / 64), dim3(64), 0, stream, (const bf16*)(ws + WS_Q), (const bf16*)(ws + WS_K), (const bf16*)(ws + WS_V), (const bf16*)(ws + WS_KC), (const bf16*)(ws + WS_VC), in_[I_SINK], (bf16*)(ws + WS_MIX));
            break;
        case PH_GOUT:
            hipLaunchKernelGGL(slow_gemm, dim3(D / 64, NTOK / 64), dim3(256), 0, stream, (const bf16*)(ws + WS_MIX), (const int*)nullptr, (const bf16*)(ws + WS_WOUTT), CF, D, (const int*)nullptr, (size_t)0);
            hipLaunchKernelGGL(slow_epi_res, dim3(NTOK * D / 256), dim3(256), 0, stream, (const float*)CF, in_[I_X], (float*)(ws + WS_H), in_[I_EBOUT], (const float*)(MOD + 2 * 1024));
            break;
        case PH_GMO:
            hipLaunchKernelGGL(slow_gemm, dim3(D / 64, NTOK / 64), dim3(256), 0, stream, (const bf16*)(ws + WS_MIX), (const int*)nullptr, (const bf16*)(ws + WS_GWOUTT), CF, D, (const int*)nullptr, (size_t)0);
            hipLaunchKernelGGL(slow_epi_res, dim3(NTOK * D / 256), dim3(256), 0, stream, (const float*)CF, (const float*)(ws + WS_H), (float*)(ws + WS_H), in_[I_OBOUT], (const float*)(MOD + (size_t)9 * MODW + 2 * 1024));
            break;
        case PH_M1_0: case PH_M1_1:
            hipLaunchKernelGGL(slow_arow, dim3(ACT_ROWS / 256), dim3(256), 0, stream, (const int*)(CNT + l * NE), (const int*)(ws + WS_LIST), (int*)(ws + WS_AROW));
            hipLaunchKernelGGL(slow_gemm, dim3(2048 / 64, ACT_ROWS / 64), dim3(256), 0, stream, (const bf16*)(ws + WS_XA), (const int*)(ws + WS_AROW), (const bf16*)(ws + WS_W1T) + (size_t)l * NE * 2048 * 1024, CF, 2048, (const int*)(CNT + l * NE), (size_t)2048 * 1024);
            hipLaunchKernelGGL(slow_epi_swiglu, dim3(ACT_ROWS * 1024 / 256), dim3(256), 0, stream, (const float*)CF, (const int*)(CNT + l * NE), in_[I_B1] + (size_t)l * NE * 2048, (bf16*)(ws + WS_ACT));
            break;
        case PH_M2_0: case PH_M2_1:
            hipLaunchKernelGGL(slow_gemm, dim3(1024 / 64, ACT_ROWS / 64), dim3(256), 0, stream, (const bf16*)(ws + WS_ACT), (const int*)nullptr, (const bf16*)(ws + WS_W2T) + (size_t)l * NE * 1024 * 1024, CF, 1024, (const int*)(CNT + l * NE), (size_t)1024 * 1024);
            hipLaunchKernelGGL(slow_epi_down, dim3(ACT_ROWS * 1024 / 256), dim3(256), 0, stream, (const float*)CF, (const int*)(CNT + l * NE), (const int*)(ws + WS_LIST), (const float*)(ws + WS_GATE), in_[I_B2] + (size_t)l * NE * D, (bf16*)(ws + WS_Y));
            break;
        case PH_GMI:
            hipLaunchKernelGGL(slow_gemm, dim3(2048 / 64, NTOK / 64), dim3(256), 0, stream, (const bf16*)(ws + WS_XA), (const int*)nullptr, (const bf16*)(ws + WS_GWINT), CF, 2048, (const int*)nullptr, (size_t)0);
            hipLaunchKernelGGL(slow_epi_gelu, dim3(NTOK * 2048 / 256), dim3(256), 0, stream, (const float*)CF, in_[I_OBIN], (bf16*)(ws + WS_U), (bf16*)(ws + WS_VB));
            break;
        case PH_SPA:
            hipLaunchKernelGGL(slow_vstats, dim3(NTOK / 64), dim3(64), 0, stream, (const bf16*)(ws + WS_VB), CF);
            hipLaunchKernelGGL(slow_spatial, dim3(NTOK * D / 256), dim3(256), 0, stream, (const bf16*)(ws + WS_U), (const bf16*)(ws + WS_VB), (const float*)CF, in_[I_OWS], in_[I_OBS], in_[I_OLNG], in_[I_OLNB], (bf16*)(ws + WS_MIX));
            break;
        default: break;
        }
    }
    flush(NPHASE);
}
```

```cpp
#include <hip/hip_runtime.h>
#include <cstdio>
#include <cstdint>

#ifndef SLOW_MASK
#define SLOW_MASK 0x00
#endif

#ifndef PROBE_PH
#define PROBE_PH (-1)
#endif
#ifndef PROBE_END
#define PROBE_END (PROBE_PH + 1)
#endif
#ifndef PROBE_MULT
#define PROBE_MULT 4
#endif

#define LAS __attribute__((address_space(3)))
typedef unsigned short bf16;
typedef short bf16x8 __attribute__((ext_vector_type(8)));
typedef float f32x4 __attribute__((ext_vector_type(4)));
typedef float f32x2 __attribute__((ext_vector_type(2)));
typedef unsigned u32x4 __attribute__((ext_vector_type(4)));
typedef unsigned u32x2 __attribute__((ext_vector_type(2)));
typedef __bf16 bf16x2_t __attribute__((ext_vector_type(2)));

constexpr int NB = 8, SEQ = 2048, D = 1024, NTOK = NB * SEQ, CTXL = 256, NCTX = NB * CTXL;
constexpr int NE = 32, TOPK = 4, NASSIGN = NTOK * TOPK, ACT_ROWS = NASSIGN + NE * 256;
constexpr int EVEN_IN = 1792, KV_COL = 1536;
constexpr float EPS = 1e-6f, LOG2E = 1.4426950408889634f;
constexpr float QSCALE = 0.125f * LOG2E;
constexpr int MODW = 6 * D;
constexpr int NWAVES = 8, NTHREADS = 512;

constexpr size_t MiB = 1u << 20;
constexpr size_t WS_CTL = 0, CTL_ZERO_BYTES = 1 * MiB;
constexpr size_t WS_MOD = 1 * MiB;
constexpr size_t WS_LIST = 2 * MiB;
constexpr size_t WS_GATE = 4 * MiB;
constexpr size_t WS_WSB = 5 * MiB;
constexpr size_t WS_WINT = 6 * MiB;
constexpr size_t WS_WOUTT = 10 * MiB;
constexpr size_t WS_GWINT = 12 * MiB;
constexpr size_t WS_GWOUTT = 16 * MiB;
constexpr size_t WS_KC = 18 * MiB;
constexpr size_t WS_VC = 18 * MiB + 512 * 1024;
constexpr size_t WS_K = 19 * MiB;
constexpr size_t WS_V = 23 * MiB;
constexpr size_t WS_GM = 27 * MiB;
constexpr size_t WS_AROW = 31 * MiB;
constexpr size_t WS_Q = 32 * MiB;
constexpr size_t WS_GLU = 48 * MiB;
constexpr size_t WS_XA = 64 * MiB;
constexpr size_t WS_MIX = 96 * MiB;
constexpr size_t WS_H = 128 * MiB;
constexpr size_t WS_U = 192 * MiB;
constexpr size_t WS_VB = 224 * MiB;
constexpr size_t WS_W1T = 256 * MiB;
constexpr size_t WS_W2T = 512 * MiB;
constexpr size_t WS_ACT = 640 * MiB;
constexpr size_t WS_Y = 784 * MiB;
constexpr size_t WS_CF = 912 * MiB;
constexpr size_t WS_END = 1488 * MiB;
constexpr int CW_BAR = 4096, CW_CNT = 131072, CW_VSTAT = 147456;
constexpr int MAX_LAUNCH = 20;

constexpr int RING_BYTES = 131072;
constexpr int MISC_OFF = RING_BYTES;
constexpr int TAB_OFF = RING_BYTES + 256;
constexpr int LDS_BYTES = 147456;

#define LDS_WAIT() asm volatile("s_waitcnt lgkmcnt(0)" ::: "memory")
#define VM_WAIT() asm volatile("s_waitcnt vmcnt(0)" ::: "memory")

__device__ __forceinline__ float bf2f(unsigned b) { return __uint_as_float(b << 16); }
__device__ __forceinline__ unsigned pk2(float lo, float hi) { f32x2 v = {lo, hi}; bf16x2_t b = __builtin_convertvector(v, bf16x2_t); return __builtin_bit_cast(unsigned, b); }
__device__ __forceinline__ float wave_sum(float v) {
#pragma unroll
    for (int o = 1; o < 64; o <<= 1) v += __shfl_xor(v, o);
    return v;
}
__device__ __forceinline__ float sigmoidf_(float x) { return __builtin_amdgcn_rcpf(1.0f + __builtin_amdgcn_exp2f(-x * LOG2E)); }

#define XB_TMO      128
#define XB_XCNT(j)  (256  + 64 * (j))
#define XB_XSUB(j)  (1280 + 64 * (j))
#define XB_XGEN(j)  (2304 + 64 * (j))
#define XB_TOP      3328
#define XB_TOPGEN   3392
#define XCD_BAR_WORDS 3456
#define XB_SPIN_CAP (1u << 20)
__device__ __forceinline__ unsigned xb_ld(unsigned* p)              { return __hip_atomic_load(p, __ATOMIC_RELAXED, __HIP_MEMORY_SCOPE_AGENT); }
__device__ __forceinline__ unsigned xb_add(unsigned* p, unsigned v) { return __hip_atomic_fetch_add(p, v, __ATOMIC_RELAXED, __HIP_MEMORY_SCOPE_AGENT); }
__device__ __forceinline__ unsigned xb_xcc_id() { return (unsigned)__builtin_amdgcn_s_getreg((3 << 11) | 20) & 0xFu; }
#define XB_SPIN(cond, bar) do { unsigned _sp = 0; while (cond) { __builtin_amdgcn_s_sleep(1); \
    if ((++_sp & 255u) == 0u) { if (xb_ld(&(bar)[XB_TMO])) break; if (_sp > XB_SPIN_CAP) { atomicAdd(&(bar)[XB_TMO], 1u); break; } } } } while (0)
struct XcdBarrier { unsigned* bar; unsigned x; volatile LAS unsigned* st; };
__device__ __forceinline__ XcdBarrier xcd_barrier_post(unsigned* bar, volatile LAS unsigned* st) {
    XcdBarrier b; b.bar = bar; b.x = xb_xcc_id(); b.st = st;
    if (threadIdx.x == 0) (void)xb_add(&bar[XB_XCNT(b.x)], 1u);
    return b;
}
__device__ __forceinline__ void xcd_barrier_complete(unsigned* bar, unsigned x, unsigned& nloc, unsigned& nx) {
    const unsigned G = gridDim.x * gridDim.y * gridDim.z;
    unsigned sum, cnt, mine, sp = 0u;
    for (;;) {
        sum = 0u; cnt = 0u; mine = 0u;
#pragma unroll
        for (unsigned j = 0; j < 16; ++j) { const unsigned c = xb_ld(&bar[XB_XCNT(j)]); sum += c; cnt += (c > 0u) ? 1u : 0u; mine = (j == x) ? c : mine; }
        if (sum == G) break;
        __builtin_amdgcn_s_sleep(1);
        if ((++sp & 255u) == 0u) { if (xb_ld(&bar[XB_TMO])) break; if (sp > XB_SPIN_CAP) { atomicAdd(&bar[XB_TMO], 1u); break; } }
    }
    nloc = mine > 0u ? mine : 1u; nx = cnt > 0u ? cnt : 1u;
}
__device__ __forceinline__ void xcd_barrier(const XcdBarrier& b, const int tid) {
    asm volatile("s_waitcnt vmcnt(0)" ::: "memory");
    __syncthreads();
    if (tid == 0) {
        unsigned* bar = b.bar;
        __builtin_amdgcn_s_waitcnt(0);
        unsigned nloc = b.st[0], nx = b.st[1];
        if (nloc == 0u) { xcd_barrier_complete(bar, b.x, nloc, nx); b.st[0] = nloc; b.st[1] = nx; }
        const unsigned old = xb_add(&bar[XB_XSUB(b.x)], 1u);
        const unsigned gen = old / nloc;
        if (old + 1u == (gen + 1u) * nloc) {
            __builtin_amdgcn_fence(__ATOMIC_RELEASE, "agent");
            asm volatile("s_waitcnt vmcnt(0)" ::: "memory");
            const unsigned og = xb_add(&bar[XB_TOP], 1u);
            const unsigned tg = og / nx;
            if (og + 1u == (tg + 1u) * nx) xb_add(&bar[XB_TOPGEN], 1u);
            else XB_SPIN(xb_ld(&bar[XB_TOPGEN]) == tg, bar);
            __builtin_amdgcn_fence(__ATOMIC_ACQUIRE, "agent");
            xb_add(&bar[XB_XGEN(b.x)], 1u);
            asm volatile("s_waitcnt vmcnt(0)" ::: "memory");
        } else {
            XB_SPIN(xb_ld(&bar[XB_XGEN(b.x)]) == gen, bar);
            __builtin_amdgcn_fence(__ATOMIC_ACQUIRE, "agent");
            asm volatile("s_waitcnt vmcnt(0)" ::: "memory");
        }
    }
    __syncthreads();
}

namespace pg8 {
constexpr int BM = 256, BK = 64, HALF = 128, HTB = HALF * BK * 2, STAGE_BYTES = 8 * HTB, KD = 1024  ;
__host__ __device__ __forceinline__ int lds_byte(int r, int c) { const int st = (r >> 4) * 2 + (c >> 5), rr = r & 15, cc = c & 31, ob = rr * 64 + cc * 2; return st * 1024 + (ob ^ (((ob >> 9) & 1) << 5)); }
__host__ __device__ __forceinline__ void stage_rc(int b, int& R, int& C) { const int st = b / 1024, sb = b % 1024, swz = sb ^ (((sb >> 9) & 1) << 5); R = (st >> 1) * 16 + swz / 64; C = (st & 1) * 32 + (swz % 64) / 2; }
__host__ __device__ __forceinline__ int perm32(int rho) { const int n = rho >> 4, i = rho & 15; return 8 * (i >> 2) + 4 * n + (i & 3); }

struct Unit { int pm, pn, e, cnt; };

template <class Epi, class Sched>
__device__ __forceinline__ void gemm_phase(LAS unsigned char* lds, const Sched& S, const Epi& E, const int tid) {
    const int wid = __builtin_amdgcn_readfirstlane(tid >> 6), lane = tid & 63, wr = wid >> 2, wc = wid & 3, fr = lane & 15, fq = lane >> 4;
    constexpr int K = KD, nt = K / BK;
    int Rr[2], Cc[2];
    unsigned voffA[2][2], voffB[2];
#pragma unroll
    for (int i = 0; i < 2; ++i) { stage_rc(tid * 16 + i * 8192, Rr[i], Cc[i]); const int Rb = Epi::PERM ? ((Rr[i] & ~31) + perm32(Rr[i] & 31)) : Rr[i];
        voffB[i] = (unsigned)(Rb * K + Cc[i]) * 2u; }
    constexpr size_t kstep = (size_t)(BK * 2);
    constexpr size_t hstep = (size_t)HALF * K * 2;
    const unsigned ldsw = (unsigned)wid * 1024u;
    const int aoff = lds_byte(wr * 64 + fr, fq * 8), boff = lds_byte(wc * 32 + fr, fq * 8);
#define PG8_SA(b, h) (((b) * 2 + (h)) * HTB)
#define PG8_SB(b, h) ((4 + (b) * 2 + (h)) * HTB)
#define PG8_STAGE(bufoff, gbase, voff) do { _Pragma("unroll") for (int _i = 0; _i < 2; ++_i) \
        __builtin_amdgcn_global_load_lds((const unsigned*)((const char*)(gbase) + (voff)[_i]), (LAS unsigned*)(lds + (bufoff) + ldsw + _i * 8192), 16, 0, 0); } while (0)
#define PG8_LDA(dst, b, h) do { _Pragma("unroll") for (int m = 0; m < 4; ++m) _Pragma("unroll") for (int k = 0; k < 2; ++k) dst[m][k] = *(const LAS bf16x8*)(lds + PG8_SA(b, h) + aoff + m * 2048 + k * 1024); } while (0)
#define PG8_LDB(dst, b, h) do { _Pragma("unroll") for (int n = 0; n < 2; ++n) _Pragma("unroll") for (int k = 0; k < 2; ++k) dst[n][k] = *(const LAS bf16x8*)(lds + PG8_SB(b, h) + boff + n * 2048 + k * 1024); } while (0)
#define PG8_MMA(ai, bj, At, Bt) do { __builtin_amdgcn_s_setprio(1); _Pragma("unroll") for (int m = 0; m < 4; ++m) _Pragma("unroll") for (int n = 0; n < 2; ++n) _Pragma("unroll") for (int k = 0; k < 2; ++k) \
        acc[ai][bj][m][n] = __builtin_amdgcn_mfma_f32_16x16x32_bf16(Bt[n][k], At[m][k], acc[ai][bj][m][n], 0, 0, 0); __builtin_amdgcn_s_setprio(0); } while (0)
#define PG8_WAIT_V(n) asm volatile("s_waitcnt vmcnt(" #n ")" ::: "memory")
#define PG8_WAIT_L(n) asm volatile("s_waitcnt lgkmcnt(" #n ")" ::: "memory")
#define PG8_BAR __builtin_amdgcn_s_barrier()
#define PG8_SCHED __builtin_amdgcn_sched_barrier(0)
    Unit cur, nxt; int ui = 0;
    if (!S.next(0, cur)) return;
    S.a_voff(cur, voffA, Rr, Cc);
    f32x4 acc[2][2][4][2];
#pragma unroll
    for (int a = 0; a < 2; ++a)
#pragma unroll
        for (int b = 0; b < 2; ++b)
#pragma unroll
            for (int m = 0; m < 4; ++m)
#pragma unroll
                for (int n = 0; n < 2; ++n) acc[a][b][m][n] = (f32x4){0.f, 0.f, 0.f, 0.f};
    bf16x8 At[4][2], B0[2][2], B1[2][2];
    const char* cA = S.a_ptr(cur); const char* cB = S.b_ptr(cur);
    PG8_STAGE(PG8_SB(0, 0), cB, voffB); PG8_STAGE(PG8_SB(0, 1), cB + hstep, voffB); PG8_STAGE(PG8_SA(0, 0), cA, voffA[0]); PG8_STAGE(PG8_SA(0, 1), cA, voffA[1]);
    if (wr == 1) PG8_BAR;
    PG8_WAIT_V(2); PG8_BAR;
    PG8_STAGE(PG8_SB(1, 0), cB + kstep, voffB); PG8_STAGE(PG8_SA(1, 0), cA + kstep, voffA[0]); PG8_STAGE(PG8_SB(1, 1), cB + hstep + kstep, voffB);
    PG8_WAIT_V(6); PG8_BAR;
    for (;;) {
        const bool has_next = S.next(ui + 1, nxt);
        const char* nA = has_next ? S.a_ptr(nxt) : cA; const char* nB = has_next ? S.b_ptr(nxt) : cB;
        for (int t = 0; t < nt; t += 2) {
            const bool last = (t == nt - 2);
            const char* a1 = cA + (size_t)(t + 1) * kstep;
            const char* a2 = last ? nA : cA + (size_t)(t + 2) * kstep; const char* b2 = last ? nB : cB + (size_t)(t + 2) * kstep;
            const char* a3 = a2 + kstep; const char* b3 = b2 + kstep;
            PG8_LDB(B0, 0, 0); PG8_LDB(B1, 0, 1); PG8_SCHED; PG8_LDA(At, 0, 0); PG8_STAGE(PG8_SA(1, 1), a1, voffA[1]);
            if (Sched::GATHER) { if (last && has_next) S.a_voff(nxt, voffA, Rr, Cc); }
            PG8_WAIT_V(8); PG8_WAIT_L(0); PG8_BAR; PG8_MMA(0, 0, At, B0); PG8_MMA(0, 1, At, B1); PG8_BAR; PG8_SCHED;
            PG8_LDA(At, 0, 1); PG8_STAGE(PG8_SB(0, 0), b2, voffB); PG8_STAGE(PG8_SB(0, 1), b2 + hstep, voffB); PG8_STAGE(PG8_SA(0, 0), a2, voffA[0]);
            PG8_WAIT_V(8); PG8_WAIT_L(0); PG8_BAR; PG8_MMA(1, 0, At, B0); PG8_MMA(1, 1, At, B1); PG8_BAR; PG8_SCHED;
            PG8_LDB(B0, 1, 0); PG8_LDB(B1, 1, 1); PG8_SCHED; PG8_LDA(At, 1, 0); PG8_STAGE(PG8_SA(0, 1), a2, voffA[1]);
            PG8_WAIT_V(8); PG8_WAIT_L(0); PG8_BAR; PG8_MMA(0, 0, At, B0); PG8_MMA(0, 1, At, B1); PG8_BAR; PG8_SCHED;
            PG8_LDA(At, 1, 1); PG8_STAGE(PG8_SB(1, 0), b3, voffB); PG8_STAGE(PG8_SB(1, 1), b3 + hstep, voffB); PG8_STAGE(PG8_SA(1, 0), a3, voffA[0]);
            PG8_WAIT_V(8); PG8_WAIT_L(0); PG8_BAR; PG8_MMA(1, 0, At, B0); PG8_MMA(1, 1, At, B1); PG8_BAR; PG8_SCHED;
        }
        if (wr == 0) PG8_BAR;
        E(acc, cur, wr, wc, fr, fq);
        if (!has_next) break;
#pragma unroll
        for (int a = 0; a < 2; ++a)
#pragma unroll
            for (int b = 0; b < 2; ++b)
#pragma unroll
                for (int m = 0; m < 4; ++m)
#pragma unroll
                    for (int n = 0; n < 2; ++n) acc[a][b][m][n] = (f32x4){0.f, 0.f, 0.f, 0.f};
        cur = nxt; cA = nA; cB = nB; ++ui;
        if (wr == 1) PG8_BAR;
    }
    PG8_WAIT_V(0);
    PG8_BAR;
#undef PG8_SA
#undef PG8_SB
#undef PG8_STAGE
#undef PG8_LDA
#undef PG8_LDB
#undef PG8_MMA
#undef PG8_WAIT_V
#undef PG8_WAIT_L
#undef PG8_BAR
#undef PG8_SCHED
}
}

struct Args { const float* in[33]; float* out; unsigned char* ws; int ph_lo, ph_hi, li, pad; };
enum { I_X = 0, I_C, I_CTX, I_CCTX, I_ADAW, I_ADAB, I_NMG, I_NFG, I_EWIN, I_EBIN, I_ECW, I_ECB, I_ELNG, I_ELNB, I_QNG, I_KNG, I_SINK, I_EWOUT, I_EBOUT,
       I_OWIN, I_OBIN, I_OLNG, I_OLNB, I_OWS, I_OBS, I_OWOUT, I_OBOUT, I_RW, I_RB, I_W1, I_B1, I_W2, I_B2 };

typedef const __attribute__((address_space(4))) unsigned long long* kargp_t;
struct Ctx {
    LAS unsigned char* lds; int tid, lane, wave, G, vcu, gw, NGW; unsigned char* ws; kargp_t kp;
};
__device__ __forceinline__ const float* in_ptr(const Ctx& X, int i) { return (const float*)(const __attribute__((address_space(1))) float*)X.kp[i]; }
#define IN(i) in_ptr(X, (i))

struct DenseSched {
    static constexpr bool GATHER = false;
    const bf16* A; const bf16* Bt; int nM, nN, nwg, G, c;
    const bf16* A2; const bf16* Bt2; int nM2;
    __device__ __forceinline__ void init(const bf16* A_, const bf16* Bt_, int M, int N, int G_, int c_) { A = A_; Bt = Bt_; nM = M / 256; nN = N / 256; nwg = nM * nN; G = G_; c = c_; A2 = nullptr; Bt2 = nullptr; nM2 = 0; }
    __device__ __forceinline__ bool next(int i, pg8::Unit& u) const {
        const int L = i * G + c; if (L >= nwg + nM2) return false;
        if (L >= nwg) { u.pm = L - nwg; u.pn = 0; u.e = 1; u.cnt = 256; return true; }
        int wgid = L; { const int q = nwg / 8, r = nwg % 8, xcd = wgid % 8, off = wgid / 8; wgid = (xcd < r ? xcd * (q + 1) : r * (q + 1) + (xcd - r) * q) + off; }
        const int nig = 8 * nN, gid = wgid / nig, fm = gid * 8, gsz = (nM - fm) < 8 ? (nM - fm) : 8;
        u.pm = fm + ((wgid % nig) % gsz); u.pn = (wgid % nig) / gsz; u.e = 0; u.cnt = 256; return true;
    }
    __device__ __forceinline__ const char* a_ptr(const pg8::Unit& u) const { return (const char*)(u.e ? A2 : A) + (size_t)u.pm * 256 * pg8::KD * 2; }
    __device__ __forceinline__ const char* b_ptr(const pg8::Unit& u) const { return (const char*)(u.e ? Bt2 : Bt) + (size_t)u.pn * 256 * pg8::KD * 2; }
    __device__ __forceinline__ void a_voff(const pg8::Unit&, unsigned (&v)[2][2], const int (&R)[2], const int (&C)[2]) const {
#pragma unroll
        for (int i = 0; i < 2; ++i) { v[0][i] = (unsigned)(R[i] * pg8::KD + C[i]) * 2u; v[1][i] = v[0][i] + (unsigned)(pg8::HALF * pg8::KD * 2); }
    }
};
struct MoeSched {
    const LAS int* tab; int NT, G, c; bool gather;
};
template <bool GATHER_, int NTILE_N>
struct MoeSchedT {
    static constexpr bool GATHER = GATHER_;
    const LAS int* tab; int G, c;
    const bf16* A;
    const bf16* Bt;
    const int* list;
    __device__ __forceinline__ bool next(int i, pg8::Unit& u) const {
        const int L = i * G + c; const int T = tab[0];
        if (L >= T * NTILE_N) return false;
        const int mt = L / NTILE_N; u.pn = L % NTILE_N;
        const int w = __builtin_amdgcn_readfirstlane(tab[1 + mt]); u.e = w >> 16; const int tl = w & 0xffff;
        const int cnt = __builtin_amdgcn_readfirstlane(tab[512 + u.e]), pb = __builtin_amdgcn_readfirstlane(tab[544 + u.e]);
        u.pm = pb + tl * 256; u.cnt = cnt - tl * 256;
        return true;
    }
    __device__ __forceinline__ const char* a_ptr(const pg8::Unit& u) const { return GATHER ? (const char*)A : (const char*)A + (size_t)u.pm * pg8::KD * 2; }
    __device__ __forceinline__ const char* b_ptr(const pg8::Unit& u) const { return (const char*)Bt + ((size_t)u.e * NTILE_N + u.pn) * 256 * pg8::KD * 2; }
    __device__ __forceinline__ void a_voff(const pg8::Unit& u, unsigned (&v)[2][2], const int (&R)[2], const int (&C)[2]) const {
        if (GATHER) {
            const int slot0 = u.pm - tab[544 + u.e];
            const int* lp = list + (size_t)u.e * NTOK + slot0;
#pragma unroll
            for (int h = 0; h < 2; ++h)
#pragma unroll
                for (int i = 0; i < 2; ++i) { const int r = h * 128 + R[i]; const int tok = lp[r < u.cnt ? r : u.cnt - 1] >> 2; v[h][i] = (unsigned)(tok * pg8::KD + C[i]) * 2u; }
        } else {
#pragma unroll
            for (int i = 0; i < 2; ++i) { v[0][i] = (unsigned)(R[i] * pg8::KD + C[i]) * 2u; v[1][i] = v[0][i] + (unsigned)(pg8::HALF * pg8::KD * 2); }
        }
    }
};
__device__ __forceinline__ void moe_build_table(const Ctx& X, const int* cnt  ) {
    LAS int* tab = (LAS int*)(X.lds + TAB_OFF);
    __syncthreads();
    if (X.tid == 0) {
        int T = 0, pb = 0;
        for (int e = 0; e < NE; ++e) { const int c = __hip_atomic_load(cnt + e, __ATOMIC_RELAXED, __HIP_MEMORY_SCOPE_AGENT); const int mt = (c + 255) >> 8;
            tab[512 + e] = c; tab[544 + e] = pb; for (int t = 0; t < mt; ++t) tab[1 + T + t] = (e << 16) | t; T += mt; pb += mt * 256; }
        tab[0] = T;
    }
    __syncthreads();
}

__device__ __forceinline__ f32x2 gelu_pk(f32x2 v) {
    const f32x2 av = __builtin_elementwise_abs(v), d = av * 0.2316418882f + 1.0f;
    f32x2 t; t.x = __builtin_amdgcn_rcpf(d.x); t.y = __builtin_amdgcn_rcpf(d.y);
    f32x2 q = t * 0.5307027145f + (-0.7265760135f); q = q * t + 0.7107068705f; q = q * t + (-0.142248368f); q = q * t + 0.127414796f; q = q * t;
    const f32x2 s = (v * v) * (-0.72134752044f);
    f32x2 e; e.x = __builtin_amdgcn_exp2f(s.x); e.y = __builtin_amdgcn_exp2f(s.y);
    const f32x2 m = v * (q * e), r = v - m;
    f32x2 o; o.x = v.x < 0.f ? m.x : r.x; o.y = v.y < 0.f ? m.y : r.y; return o;
}
__device__ __forceinline__ u32x4 pack8(f32x4 a, f32x4 b) { u32x4 w; w.x = pk2(a[0], a[1]); w.y = pk2(a[2], a[3]); w.z = pk2(b[0], b[1]); w.w = pk2(b[2], b[3]); return w; }

struct EpiIn {
    static constexpr bool PERM = true;
    bf16 *GLU, *Q, *Kb, *Vb, *KC, *VC; const float* bias;
    __device__ __forceinline__ void operator()(const f32x4 (&acc)[2][2][4][2], const pg8::Unit& u, int wr, int wc, int fr, int fq) const {
        const int row0 = u.pm * 256 + wr * 64 + fr; const int c8 = wc * 32 + 8 * fq;
        if (u.e == 0 && u.pn < 4) {
            const int j0 = u.pn * 128 + c8;
            f32x4 bu[2], bg[2];
#pragma unroll
            for (int n = 0; n < 2; ++n) { bu[n] = *(const f32x4*)(bias + j0 + 4 * n); bg[n] = *(const f32x4*)(bias + 512 + j0 + 4 * n); }
#pragma unroll
            for (int ai = 0; ai < 2; ++ai)
#pragma unroll
                for (int m = 0; m < 4; ++m) { f32x4 o[2];
#pragma unroll
                    for (int n = 0; n < 2; ++n) { const f32x4 uu = acc[ai][0][m][n] + bu[n], gg = acc[ai][1][m][n] + bg[n];
#pragma unroll
                        for (int k = 0; k < 4; ++k) o[n][k] = uu[k] * sigmoidf_(gg[k]); }
                    *(u32x4*)(GLU + (size_t)(row0 + ai * 128 + m * 16) * 512 + j0) = pack8(o[0], o[1]); }
        } else {
#pragma unroll
            for (int bj = 0; bj < 2; ++bj) {
                bf16* dst; int ld, col, bcol;
                if (u.pn >= 6 || u.e) { dst = u.e ? (bj ? VC : KC) : (bj ? Vb : Kb); ld = 128; col = c8; bcol = KV_COL + bj * 128 + c8; }
                else { dst = Q; ld = 512; col = (u.pn - 4) * 256 + bj * 128 + c8; bcol = 1024 + col; }
                f32x4 bv[2];
#pragma unroll
                for (int n = 0; n < 2; ++n) bv[n] = *(const f32x4*)(bias + bcol + 4 * n);
#pragma unroll
                for (int ai = 0; ai < 2; ++ai)
#pragma unroll
                    for (int m = 0; m < 4; ++m) *(u32x4*)(dst + (size_t)(row0 + ai * 128 + m * 16) * ld + col) = pack8(acc[ai][bj][m][0] + bv[0], acc[ai][bj][m][1] + bv[1]);
            }
        }
    }
};
struct EpiRes {
    static constexpr bool PERM = false;
    const float* base; float* out; const float* bias; const float* gate;
    __device__ __forceinline__ void operator()(const f32x4 (&acc)[2][2][4][2], const pg8::Unit& u, int wr, int wc, int fr, int fq) const {
        const int col0 = u.pn * 256 + wc * 32 + 4 * fq; const int b = (u.pm * 256) / SEQ;
        f32x4 bv[2][2], gv[2][2];
#pragma unroll
        for (int bj = 0; bj < 2; ++bj)
#pragma unroll
            for (int n = 0; n < 2; ++n) { bv[bj][n] = *(const f32x4*)(bias + col0 + bj * 128 + n * 16); gv[bj][n] = *(const f32x4*)(gate + (size_t)b * MODW + col0 + bj * 128 + n * 16); }
#pragma unroll
        for (int ai = 0; ai < 2; ++ai)
#pragma unroll
            for (int m = 0; m < 4; ++m) { const size_t off = (size_t)(u.pm * 256 + ai * 128 + wr * 64 + m * 16 + fr) * D + col0;
#pragma unroll
                for (int bj = 0; bj < 2; ++bj)
#pragma unroll
                    for (int n = 0; n < 2; ++n) { const f32x4 bs = *(const f32x4*)(base + off + bj * 128 + n * 16); *(f32x4*)(out + off + bj * 128 + n * 16) = bs + gv[bj][n] * (acc[ai][bj][m][n] + bv[bj][n]); } }
    }
};
struct EpiGelu {
    static constexpr bool PERM = true;
    bf16 *U, *V; const float* bias; float* vstat;
    __device__ __forceinline__ void operator()(const f32x4 (&acc)[2][2][4][2], const pg8::Unit& u, int wr, int wc, int fr, int fq) const {
        const int row0 = u.pm * 256 + wr * 64 + fr; const int colt = u.pn * 256; const bool isv = colt >= 1024; bf16* base = isv ? V : U; const int cb = (colt & 1023) + wc * 32 + 8 * fq, bcol = colt + wc * 32 + 8 * fq;
        f32x4 bv[2][2];
#pragma unroll
        for (int bj = 0; bj < 2; ++bj)
#pragma unroll
            for (int n = 0; n < 2; ++n) bv[bj][n] = *(const f32x4*)(bias + bcol + bj * 128 + 4 * n);
#pragma unroll
        for (int ai = 0; ai < 2; ++ai)
#pragma unroll
            for (int m = 0; m < 4; ++m) { const int row = row0 + ai * 128 + m * 16; bf16* rowp = base + (size_t)row * D + cb; float s = 0.f, s2 = 0.f;
#pragma unroll
                for (int bj = 0; bj < 2; ++bj) { f32x4 v0 = acc[ai][bj][m][0] + bv[bj][0], v1 = acc[ai][bj][m][1] + bv[bj][1];
                    f32x2 a = gelu_pk((f32x2){v0[0], v0[1]}), b = gelu_pk((f32x2){v0[2], v0[3]}), c = gelu_pk((f32x2){v1[0], v1[1]}), d = gelu_pk((f32x2){v1[2], v1[3]});
                    s += (a.x + a.y) + (b.x + b.y) + (c.x + c.y) + (d.x + d.y); s2 += (a.x * a.x + a.y * a.y) + (b.x * b.x + b.y * b.y) + (c.x * c.x + c.y * c.y) + (d.x * d.x + d.y * d.y);
                    *(u32x4*)(rowp + bj * 128) = pack8((f32x4){a.x, a.y, b.x, b.y}, (f32x4){c.x, c.y, d.x, d.y}); }
                if (isv) { s += __shfl_xor(s, 16); s += __shfl_xor(s, 32); s2 += __shfl_xor(s2, 16); s2 += __shfl_xor(s2, 32);
                    if (fq == 0) { unsafeAtomicAdd(vstat + 2 * row, s); unsafeAtomicAdd(vstat + 2 * row + 1, s2); } } }
    }
};
struct EpiSwiglu {
    static constexpr bool PERM = true;
    bf16* ACT; const float* b1;
    __device__ __forceinline__ void operator()(const f32x4 (&acc)[2][2][4][2], const pg8::Unit& u, int wr, int wc, int fr, int fq) const {
        const int j0 = u.pn * 128 + wc * 32 + 8 * fq; const float* bb = b1 + (size_t)u.e * 2048;
        f32x4 bg[2], bu[2];
#pragma unroll
        for (int n = 0; n < 2; ++n) { bg[n] = *(const f32x4*)(bb + j0 + 4 * n); bu[n] = *(const f32x4*)(bb + 1024 + j0 + 4 * n); }
#pragma unroll
        for (int ai = 0; ai < 2; ++ai)
#pragma unroll
            for (int m = 0; m < 4; ++m) { f32x4 o[2];
#pragma unroll
                for (int n = 0; n < 2; ++n) { const f32x4 g4 = acc[ai][0][m][n] + bg[n], u4 = acc[ai][1][m][n] + bu[n];
#pragma unroll
                    for (int k = 0; k < 4; ++k) { const float g = fminf(g4[k], 7.0f), up = fminf(fmaxf(u4[k], -7.0f), 7.0f); o[n][k] = (up + 1.0f) * g * sigmoidf_(g * 1.702f); } }
                *(u32x4*)(ACT + (size_t)(u.pm + ai * 128 + wr * 64 + m * 16 + fr) * D + j0) = pack8(o[0], o[1]); }
    }
};
struct EpiDown {
    static constexpr bool PERM = true;
    bf16* Y; const float* b2; const int* list; const float* gatew; const LAS int* tab;
    __device__ __forceinline__ void operator()(const f32x4 (&acc)[2][2][4][2], const pg8::Unit& u, int wr, int wc, int fr, int fq) const {
        const int c8 = u.pn * 256 + wc * 32 + 8 * fq; const float* bb = b2 + (size_t)u.e * D;
        const int slot0 = u.pm - tab[544 + u.e]; const int* lp = list + (size_t)u.e * NTOK + slot0;
        int aid[2][4]; float gw[2][4];
#pragma unroll
        for (int ai = 0; ai < 2; ++ai)
#pragma unroll
            for (int m = 0; m < 4; ++m) { const int r = ai * 128 + wr * 64 + m * 16 + fr; aid[ai][m] = lp[r < u.cnt ? r : u.cnt - 1]; }
#pragma unroll
        for (int ai = 0; ai < 2; ++ai)
#pragma unroll
            for (int m = 0; m < 4; ++m) { gw[ai][m] = gatew[aid[ai][m]]; }
#pragma unroll
        for (int ai = 0; ai < 2; ++ai)
#pragma unroll
            for (int m = 0; m < 4; ++m) asm volatile("" : "+v"(aid[ai][m]), "+v"(gw[ai][m]));
#pragma unroll
        for (int bj = 0; bj < 2; ++bj) {
            f32x4 bv[2];
#pragma unroll
            for (int n = 0; n < 2; ++n) bv[n] = *(const f32x4*)(bb + c8 + bj * 128 + 4 * n);
            asm volatile("" : "+v"(bv[0]), "+v"(bv[1]));
#pragma unroll
            for (int ai = 0; ai < 2; ++ai)
#pragma unroll
                for (int m = 0; m < 4; ++m) { const int r = ai * 128 + wr * 64 + m * 16 + fr; const float g = gw[ai][m];
                    const u32x4 w = pack8((acc[ai][bj][m][0] + bv[0]) * g, (acc[ai][bj][m][1] + bv[1]) * g);
                    if (r < u.cnt) *(u32x4*)(Y + (size_t)aid[ai][m] * D + c8 + bj * 128) = w; }
        }
    }
};

struct TrItem { const float* src; bf16* dst; int N; };
__device__ __forceinline__ void tr_load(const TrItem& t, float (&v)[32], int lane) {
#pragma unroll
    for (int i = 0; i < 32; ++i) v[i] = t.src[(size_t)(2 * i + (lane >> 5)) * t.N + (lane & 31)];
}
__device__ __forceinline__ void tr_store(const TrItem& t, const float (&v)[32], LAS float* scr, int lane) {
#pragma unroll
    for (int i = 0; i < 32; ++i) scr[(2 * i + (lane >> 5)) * 33 + (lane & 31)] = v[i];
    LDS_WAIT();
    const int c = lane & 7;
#pragma unroll
    for (int j = 0; j < 4; ++j) { const int n = (lane >> 3) + 8 * j; const LAS float* s = scr + (8 * c) * 33 + n;
        u32x4 o; o.x = pk2(s[0 * 33], s[1 * 33]); o.y = pk2(s[2 * 33], s[3 * 33]); o.z = pk2(s[4 * 33], s[5 * 33]); o.w = pk2(s[6 * 33], s[7 * 33]);
        *(u32x4*)(t.dst + (size_t)n * 1024 + 8 * c) = o; }
    LDS_WAIT();
}
__device__ __forceinline__ int pair_src(int nd, int halfw) { return ((nd & 255) >> 7) * halfw + (nd >> 8) * 128 + (nd & 127); }

__device__ __forceinline__ void phase_prologue(const Args& a, const Ctx& X) {
    {
        LAS float* sc = (LAS float*)X.lds;
        LAS float* red = (LAS float*)(X.lds + 36864);
        float* MOD = (float*)(X.ws + WS_MOD);
        for (int item = blockIdx.x; item < 2 * 96; item += X.G) {
            const int l = item / 96, j0 = (item % 96) * 64;
            for (int idx = X.tid; idx < 9 * 1024; idx += NTHREADS) { const int r = idx >> 10, k = idx & 1023; const float v = r < 8 ? IN(I_C)[r * 1024 + k] : IN(I_CCTX)[k]; sc[idx] = v * sigmoidf_(v); }
            __syncthreads();
            float acc[9];
#pragma unroll
            for (int r = 0; r < 9; ++r) acc[r] = 0.f;
            const float* w = IN(I_ADAW) + (size_t)l * 1024 * MODW + j0 + X.lane;
#pragma unroll 8
            for (int k = X.wave * 128; k < X.wave * 128 + 128; ++k) { const float wv = w[(size_t)k * MODW];
#pragma unroll
                for (int r = 0; r < 9; ++r) acc[r] += sc[r * 1024 + k] * wv; }
#pragma unroll
            for (int r = 0; r < 9; ++r) red[(X.wave * 9 + r) * 64 + X.lane] = acc[r];
            __syncthreads();
            for (int t = X.tid; t < 9 * 64; t += NTHREADS) { const int r = t >> 6, cidx = t & 63; float s = 0.f;
#pragma unroll
                for (int w8 = 0; w8 < 8; ++w8) s += red[(w8 * 9 + r) * 64 + cidx];
                MOD[((size_t)l * 9 + r) * MODW + j0 + cidx] = s + IN(I_ADAB)[l * MODW + j0 + cidx]; }
            __syncthreads();
        }
    }
    LAS float* scr = (LAS float*)(X.lds + X.wave * 16384);
    bf16* WinT = (bf16*)(X.ws + WS_WINT); bf16* WoutT = (bf16*)(X.ws + WS_WOUTT); bf16* GWinT = (bf16*)(X.ws + WS_GWINT); bf16* GWoutT = (bf16*)(X.ws + WS_GWOUTT);
    bf16* W1T = (bf16*)(X.ws + WS_W1T); bf16* W2T = (bf16*)(X.ws + WS_W2T);
    constexpr int I_IN = 16 * (EVEN_IN / 32), I_OUT = 16 * 32, I_GIN = 16 * 64, I_GOUT = 16 * 32, I_M1 = 64 * 16 * 64, I_M2 = 64 * 16 * 32;
    constexpr int NITEMS = I_IN + I_OUT + I_GIN + I_GOUT + I_M1 + I_M2;
    auto item_of = [&](int it) -> TrItem {
        int r = it; TrItem t;
        if (r < I_M1) { const int mat = r >> 10, q = r & 1023, kb = q >> 6, nd = (q & 63) * 32; t.N = 2048; t.src = IN(I_W1) + (size_t)mat * 1024 * 2048 + (size_t)kb * 64 * 2048 + pair_src(nd, 1024); t.dst = W1T + (size_t)mat * 2048 * 1024 + (size_t)nd * 1024 + kb * 64; return t; } r -= I_M1;
        if (r < I_M2) { const int mat = r >> 9, q = r & 511, kb = q >> 5, nd = (q & 31) * 32; t.N = 1024; t.src = IN(I_W2) + (size_t)mat * 1024 * 1024 + (size_t)kb * 64 * 1024 + nd; t.dst = W2T + (size_t)mat * 1024 * 1024 + (size_t)nd * 1024 + kb * 64; return t; } r -= I_M2;
        if (r < I_IN) { const int kb = r / 56, nd = (r % 56) * 32; const int ns = nd < 1024 ? pair_src(nd, 512) : nd; t.N = EVEN_IN; t.src = IN(I_EWIN) + (size_t)kb * 64 * EVEN_IN + ns; t.dst = WinT + (size_t)nd * 1024 + kb * 64; return t; } r -= I_IN;
        if (r < I_OUT) { const int kb = r >> 5, nd = (r & 31) * 32; t.N = 1024; t.src = IN(I_EWOUT) + (size_t)kb * 64 * 1024 + nd; t.dst = WoutT + (size_t)nd * 1024 + kb * 64; return t; } r -= I_OUT;
        if (r < I_GIN) { const int kb = r >> 6, nd = (r & 63) * 32; t.N = 2048; t.src = IN(I_OWIN) + (size_t)kb * 64 * 2048 + nd; t.dst = GWinT + (size_t)nd * 1024 + kb * 64; return t; } r -= I_GIN;
        { const int kb = r >> 5, nd = (r & 31) * 32; t.N = 1024; t.src = IN(I_OWOUT) + (size_t)kb * 64 * 1024 + nd; t.dst = GWoutT + (size_t)nd * 1024 + kb * 64; return t; }
    };
    {
        float va[32], vb[32]; int it = X.gw;
        TrItem ta, tb; if (it < NITEMS) { ta = item_of(it); tr_load(ta, va, X.lane); }
        while (it < NITEMS) {
            const int it1 = it + X.NGW; if (it1 < NITEMS) { tb = item_of(it1); tr_load(tb, vb, X.lane); }
            tr_store(ta, va, scr, X.lane);
            if (it1 >= NITEMS) break;
            const int it2 = it1 + X.NGW; if (it2 < NITEMS) { ta = item_of(it2); tr_load(ta, va, X.lane); }
            tr_store(tb, vb, scr, X.lane);
            it = it2;
        }
    }
    { bf16* WsB = (bf16*)(X.ws + WS_WSB); const float* ws = IN(I_OWS);
      for (int i = (X.gw * 64 + X.lane) * 4; i < 8 * 128 * 128; i += X.NGW * 64 * 4) { const f32x4 v = *(const f32x4*)(ws + i); u32x2 o; o.x = pk2(v[0], v[1]); o.y = pk2(v[2], v[3]); *(u32x2*)(WsB + i) = o; } }
}

__device__ __forceinline__ void modulate_row(const float* xrow, const float* g, const float* sh, const float* sc, bf16* orow, int lane, f32x4 (&y)[4]) {
    const f32x4* xr = (const f32x4*)xrow + lane; f32x4 v[4]; float ss = 0.f;
#pragma unroll
    for (int j = 0; j < 4; ++j) { v[j] = xr[64 * j]; ss += (v[j][0] * v[j][0] + v[j][1] * v[j][1]) + (v[j][2] * v[j][2] + v[j][3] * v[j][3]); }
    const float rstd = rsqrtf(wave_sum(ss) * (1.0f / D) + EPS);
#pragma unroll
    for (int j = 0; j < 4; ++j) { const f32x4 gk = ((const f32x4*)g)[lane + 64 * j], sk = ((const f32x4*)sc)[lane + 64 * j], hk = ((const f32x4*)sh)[lane + 64 * j];
        y[j] = v[j] * rstd * gk * (1.0f + sk) + hk;
        u32x2 o; o.x = pk2(y[j][0], y[j][1]); o.y = pk2(y[j][2], y[j][3]); *((u32x2*)orow + lane + 64 * j) = o; }
}
__device__ __forceinline__ void phase_modulate0(const Args& a, const Ctx& X) {
    const float* MOD0 = (const float*)(X.ws + WS_MOD); f32x4 y[4];
    bf16* XA = (bf16*)(X.ws + WS_XA); bf16* GM = (bf16*)(X.ws + WS_GM);
    for (int row = X.gw; row < NTOK + NCTX; row += X.NGW) {
        if (row < NTOK) { const float* m = MOD0 + (size_t)(row / SEQ) * MODW; modulate_row(IN(I_X) + (size_t)row * D, IN(I_NMG), m, m + 1024, XA + (size_t)row * D, X.lane, y); }
        else { const int r = row - NTOK; const float* m = MOD0 + (size_t)8 * MODW; modulate_row(IN(I_CTX) + (size_t)r * D, IN(I_NMG), m, m + 1024, GM + (size_t)r * D, X.lane, y); }
    }
}

__device__ __forceinline__ void qk_chunks(bf16* buf, int nchunks, int rowlen, const float* gn, bool rope, float oscale, const Ctx& X) {
    for (int ch = X.gw; ch < nchunks; ch += X.NGW) {
        const int e0 = ch * 512 + 8 * X.lane; const int token = e0 / rowlen; const int d0 = e0 & 63;
        u32x4 raw = *(const u32x4*)(buf + e0); float v[8];
#pragma unroll
        for (int i = 0; i < 4; ++i) { v[2 * i] = bf2f(raw[i] & 0xffffu); v[2 * i + 1] = bf2f(raw[i] >> 16); }
        float ss = 0.f;
#pragma unroll
        for (int i = 0; i < 8; ++i) ss += v[i] * v[i];
        ss += __shfl_xor(ss, 1); ss += __shfl_xor(ss, 2); ss += __shfl_xor(ss, 4);
        const float rstd = rsqrtf(ss * (1.0f / 64.0f) + EPS);
#pragma unroll
        for (int i = 0; i < 8; ++i) v[i] = v[i] * rstd * gn[d0 + i];
        if (rope) {
            const int t = token % SEQ; const float rowp = (float)(t >> 6), colp = (float)(t & 63);
#pragma unroll
            for (int i = 0; i < 8; ++i) { const float pv = __shfl_xor(v[i], 4); const int dd = (d0 + i) & 31;
                const float inv = exp2f(-(float)(dd & 15) * (13.287712379549449f / 16.0f)); const float ang = (dd < 16 ? rowp : colp) * inv;
                float sn, cs; sincosf(ang, &sn, &cs);
                v[i] = (d0 < 32) ? (v[i] * cs - pv * sn) : (v[i] * cs + pv * sn); }
        }
        u32x4 o; o.x = pk2(v[0] * oscale, v[1] * oscale); o.y = pk2(v[2] * oscale, v[3] * oscale); o.z = pk2(v[4] * oscale, v[5] * oscale); o.w = pk2(v[6] * oscale, v[7] * oscale);
        *(u32x4*)(buf + e0) = o;
    }
}
__device__ __forceinline__ void phase_conv_qk(const Args& a, const Ctx& X) {
    qk_chunks((bf16*)(X.ws + WS_Q), NTOK, 512, IN(I_QNG), true, QSCALE, X);
    qk_chunks((bf16*)(X.ws + WS_K), NTOK / 4, 128, IN(I_KNG), true, 1.0f, X);
    qk_chunks((bf16*)(X.ws + WS_KC), NCTX / 4, 128, IN(I_KNG), false, 1.0f, X);
    const bf16* GLU = (const bf16*)(X.ws + WS_GLU); bf16* MIX = (bf16*)(X.ws + WS_MIX);
    LAS unsigned* tin = (LAS unsigned*)X.lds;
    LAS float* tout = (LAS float*)(X.lds + 65536);
    const int cp = X.tid & 255, th = X.tid >> 8;
    float w0[31], w1[31];
#pragma unroll
    for (int j = 0; j < 31; ++j) { const f32x2 w = *(const f32x2*)(IN(I_ECW) + j * 512 + 2 * cp); w0[j] = w.x; w1[j] = w.y; }
    const f32x2 cb = *(const f32x2*)(IN(I_ECB) + 2 * cp);
    for (int tile = blockIdx.x; tile < NTOK / 32; tile += X.G) {
        const int row0 = tile * 32; const int t0 = row0 % SEQ;
        __syncthreads();
        for (int c = X.tid; c < 62 * 64; c += NTHREADS) { const int lr = c >> 6, cc = c & 63; const int t = t0 - 15 + lr;
            u32x4 v = (u32x4){0u, 0u, 0u, 0u}; if (t >= 0 && t < SEQ) v = *(const u32x4*)(GLU + (size_t)(row0 - 15 + lr) * 512 + cc * 8);
            *(LAS u32x4*)(tin + lr * 256 + cc * 4) = v; }
        __syncthreads();
        float a0[16], a1[16];
#pragma unroll
        for (int o = 0; o < 16; ++o) { a0[o] = cb.x; a1[o] = cb.y; }
#pragma unroll
        for (int rr = 0; rr < 46; ++rr) { const unsigned pv = tin[(16 * th + rr) * 256 + cp]; const float x0 = bf2f(pv & 0xffffu), x1 = bf2f(pv >> 16);
#pragma unroll
            for (int o = 0; o < 16; ++o) { const int j = rr - o; if (j >= 0 && j <= 30) { a0[o] += x0 * w0[j]; a1[o] += x1 * w1[j]; } } }
#pragma unroll
        for (int o = 0; o < 16; ++o) *(LAS f32x2*)(tout + (16 * th + o) * 512 + 2 * cp) = (f32x2){a0[o], a1[o]};
        __syncthreads();
#pragma unroll
        for (int q = 0; q < 4; ++q) { const int tl = X.wave * 4 + q; f32x4 v[2]; float s = 0.f;
#pragma unroll
            for (int j = 0; j < 2; ++j) { v[j] = *(const LAS f32x4*)(tout + tl * 512 + 4 * X.lane + 256 * j); s += (v[j][0] + v[j][1]) + (v[j][2] + v[j][3]); }
            const float mean = wave_sum(s) * (1.0f / 512.0f); float s2 = 0.f;
#pragma unroll
            for (int j = 0; j < 2; ++j) { v[j] = v[j] - mean; s2 += (v[j][0] * v[j][0] + v[j][1] * v[j][1]) + (v[j][2] * v[j][2] + v[j][3] * v[j][3]); }
            const float rstd = rsqrtf(wave_sum(s2) * (1.0f / 512.0f) + EPS);
#pragma unroll
            for (int j = 0; j < 2; ++j) { const f32x4 g = *(const f32x4*)(IN(I_ELNG) + 4 * X.lane + 256 * j), b = *(const f32x4*)(IN(I_ELNB) + 4 * X.lane + 256 * j);
                f32x4 y = v[j] * rstd * g + b;
#pragma unroll
                for (int k = 0; k < 4; ++k) y[k] = y[k] * sigmoidf_(y[k]);
                u32x2 o; o.x = pk2(y[0], y[1]); o.y = pk2(y[2], y[3]); *(u32x2*)(MIX + (size_t)(row0 + tl) * D + 4 * X.lane + 256 * j) = o; } }
    }
}

__device__ __forceinline__ void phase_attention(const Args& a, const Ctx& X) {
    const bf16* QN = (const bf16*)(X.ws + WS_Q); const bf16* KN = (const bf16*)(X.ws + WS_K); const bf16* VV = (const bf16*)(X.ws + WS_V);
    const bf16* KC = (const bf16*)(X.ws + WS_KC); const bf16* VC = (const bf16*)(X.ws + WS_VC); bf16* MIX = (bf16*)(X.ws + WS_MIX);
    LAS unsigned char* Ks = X.lds;
    LAS unsigned char* Vt = X.lds + 16384;
    const int lane = X.lane, l15 = lane & 15, g4 = lane >> 4;
    for (int unit = blockIdx.x; unit < NB * 2 * 32; unit += X.G) {
        const int b = unit >> 6, kh = (unit >> 5) & 1, qb = unit & 31; const int q0 = qb * 64;
        const int hq = kh * 4 + (X.wave >> 1), tq = (X.wave & 1) * 32;
        bf16x8 Qf[2][2];
#pragma unroll
        for (int qi = 0; qi < 2; ++qi)
#pragma unroll
            for (int s = 0; s < 2; ++s) Qf[qi][s] = *(const bf16x8*)(QN + (size_t)(b * SEQ + q0 + tq + 16 * qi + l15) * 512 + hq * 64 + 32 * s + 8 * g4);
        const float sink2 = IN(I_SINK)[hq] * LOG2E;
        float mrun[2], lrun[2]; f32x4 O[2][4];
#pragma unroll
        for (int qi = 0; qi < 2; ++qi) { mrun[qi] = sink2; lrun[qi] = (g4 == 0) ? 1.0f : 0.0f;
#pragma unroll
            for (int db = 0; db < 4; ++db) O[qi][db] = (f32x4){0.f, 0.f, 0.f, 0.f}; }
        for (int t = 0; t < 9; ++t) {
            const bf16* kp; const bf16* vp; int mode = 0;
            if (t < 5) { const int ks = q0 - 128 + 64 * t; if (ks < 0 || ks >= SEQ) continue; kp = KN + (size_t)(b * SEQ + ks) * 128 + kh * 64; vp = VV + (size_t)(b * SEQ + ks) * 128 + kh * 64; mode = (t == 0) ? 1 : (t == 4 ? 2 : 0); }
            else { const int ks = (t - 5) * 64; kp = KC + (size_t)(b * CTXL + ks) * 128 + kh * 64; vp = VC + (size_t)(b * CTXL + ks) * 128 + kh * 64; }
            __syncthreads();
            { const int key = X.tid >> 3, ch = X.tid & 7;
              const u32x4 kv = *(const u32x4*)(kp + (size_t)key * 128 + ch * 8); *(LAS u32x4*)(Ks + key * 144 + ch * 16) = kv;
              const u32x4 vv = *(const u32x4*)(vp + (size_t)key * 128 + ch * 8);
#pragma unroll
              for (int i = 0; i < 4; ++i) { *(LAS unsigned short*)(Vt + (8 * ch + 2 * i) * 136 + key * 2) = (unsigned short)(vv[i] & 0xffffu); *(LAS unsigned short*)(Vt + (8 * ch + 2 * i + 1) * 136 + key * 2) = (unsigned short)(vv[i] >> 16); } }
            __syncthreads();
            bf16x8 kf[4][2];
#pragma unroll
            for (int kb = 0; kb < 4; ++kb)
#pragma unroll
                for (int s = 0; s < 2; ++s) kf[kb][s] = *(const LAS bf16x8*)(Ks + (16 * kb + l15) * 144 + (32 * s + 8 * g4) * 2);
            bf16x8 vf[4][2];
#pragma unroll
            for (int db = 0; db < 4; ++db)
#pragma unroll
                for (int ks2 = 0; ks2 < 2; ++ks2) { const LAS unsigned char* p = Vt + (16 * db + l15) * 136 + (32 * ks2 + 4 * g4) * 2;
                    const u32x2 lo = *(const LAS u32x2*)p, hi = *(const LAS u32x2*)(p + 32);
                    u32x4 w; w.x = lo.x; w.y = lo.y; w.z = hi.x; w.w = hi.y; vf[db][ks2] = __builtin_bit_cast(bf16x8, w); }
#pragma unroll
            for (int qi = 0; qi < 2; ++qi) {
                f32x4 st[4];
#pragma unroll
                for (int kb = 0; kb < 4; ++kb) { st[kb] = (f32x4){0.f, 0.f, 0.f, 0.f};
#pragma unroll
                    for (int s = 0; s < 2; ++s) st[kb] = __builtin_amdgcn_mfma_f32_16x16x32_bf16(kf[kb][s], Qf[qi][s], st[kb], 0, 0, 0); }
                if (mode) { const int qloc = tq + 16 * qi + l15;
#pragma unroll
                    for (int kb = 0; kb < 4; ++kb)
#pragma unroll
                        for (int r = 0; r < 4; ++r) { const int kk = 16 * kb + 4 * g4 + r; const bool keep = (mode == 1) ? (kk >= qloc) : (kk <= qloc); if (!keep) st[kb][r] = -1e30f; } }
                float mx = st[0][0];
#pragma unroll
                for (int kb = 0; kb < 4; ++kb)
#pragma unroll
                    for (int r = 0; r < 4; ++r) mx = fmaxf(mx, st[kb][r]);
                mx = fmaxf(mx, __shfl_xor(mx, 16)); mx = fmaxf(mx, __shfl_xor(mx, 32));
                const float mnew = fmaxf(mrun[qi], mx); const float alpha = __builtin_amdgcn_exp2f(mrun[qi] - mnew); mrun[qi] = mnew;
                float ps = 0.f;
#pragma unroll
                for (int kb = 0; kb < 4; ++kb)
#pragma unroll
                    for (int r = 0; r < 4; ++r) { st[kb][r] = __builtin_amdgcn_exp2f(st[kb][r] - mnew); ps += st[kb][r]; }
                lrun[qi] = lrun[qi] * alpha + ps;
#pragma unroll
                for (int db = 0; db < 4; ++db) O[qi][db] = O[qi][db] * alpha;
#pragma unroll
                for (int ks2 = 0; ks2 < 2; ++ks2) { u32x4 w; w.x = pk2(st[2 * ks2][0], st[2 * ks2][1]); w.y = pk2(st[2 * ks2][2], st[2 * ks2][3]); w.z = pk2(st[2 * ks2 + 1][0], st[2 * ks2 + 1][1]); w.w = pk2(st[2 * ks2 + 1][2], st[2 * ks2 + 1][3]);
                    const bf16x8 pf = __builtin_bit_cast(bf16x8, w);
#pragma unroll
                    for (int db = 0; db < 4; ++db) O[qi][db] = __builtin_amdgcn_mfma_f32_16x16x32_bf16(vf[db][ks2], pf, O[qi][db], 0, 0, 0); }
            }
        }
#pragma unroll
        for (int qi = 0; qi < 2; ++qi) { float l = lrun[qi]; l += __shfl_xor(l, 16); l += __shfl_xor(l, 32); const float inv = 1.0f / l;
            bf16* orow = MIX + (size_t)(b * SEQ + q0 + tq + 16 * qi + l15) * D + 512 + hq * 64 + 4 * g4;
#pragma unroll
            for (int db = 0; db < 4; ++db) { u32x2 o; o.x = pk2(O[qi][db][0] * inv, O[qi][db][1] * inv); o.y = pk2(O[qi][db][2] * inv, O[qi][db][3] * inv); *(u32x2*)(orow + 16 * db) = o; } }
    }
}

__device__ __forceinline__ void phase_router(const Args& a, const Ctx& X, int layer) {
    const float* H = (const float*)(X.ws + WS_H); bf16* XA = (bf16*)(X.ws + WS_XA);
    const float* MODl = (const float*)(X.ws + WS_MOD) + (size_t)layer * 9 * MODW; const float* gn = IN(I_NFG) + layer * D;
    const float* rw = IN(I_RW) + (size_t)layer * D * NE; const float* rb = IN(I_RB) + layer * NE;
    int* cntg = (int*)(X.ws + WS_CTL) + CW_CNT + layer * NE; int* list = (int*)(X.ws + WS_LIST); float* gatew = (float*)(X.ws + WS_GATE);
    LAS float* ybuf = (LAS float*)X.lds;
    LAS float* part = (LAS float*)(X.lds + 65536);
    LAS float* lg = (LAS float*)(X.lds + 65536 + 16384);
    LAS int* sel = (LAS int*)(X.lds + 65536 + 16384 + 2048);
    LAS int* lcnt = (LAS int*)(X.lds + 65536 + 16384 + 2048 + 1024);
    const int e = X.lane & 31, hf = X.lane >> 5;
    float wreg[64];
#pragma unroll
    for (int i = 0; i < 64; ++i) wreg[i] = rw[(size_t)(128 * X.wave + 64 * hf + i) * NE + e];
    for (int blk = blockIdx.x; blk < NTOK / 64; blk += X.G) {
        const int rowbase = blk * 64;
        __syncthreads();
        if (X.tid < 64) lcnt[X.tid] = 0;
        for (int bt = 0; bt < 4; ++bt) {
            __syncthreads();
#pragma unroll
            for (int i = 0; i < 2; ++i) { const int rl = 2 * X.wave + i, row = rowbase + 16 * bt + rl; const float* m = MODl + (size_t)(row / SEQ) * MODW; f32x4 y[4];
                modulate_row(H + (size_t)row * D, gn, m + 3 * 1024, m + 4 * 1024, XA + (size_t)row * D, X.lane, y);
#pragma unroll
                for (int j = 0; j < 4; ++j) *(LAS f32x4*)(ybuf + rl * 1024 + 4 * X.lane + 256 * j) = y[j]; }
            __syncthreads();
            for (int r = 0; r < 16; ++r) { float acc = 0.f; const LAS float* yp = ybuf + r * 1024 + 128 * X.wave + 64 * hf;
#pragma unroll
                for (int i4 = 0; i4 < 16; ++i4) { const f32x4 yv = *(const LAS f32x4*)(yp + 4 * i4); acc += yv[0] * wreg[4 * i4] + yv[1] * wreg[4 * i4 + 1] + yv[2] * wreg[4 * i4 + 2] + yv[3] * wreg[4 * i4 + 3]; }
                acc += __shfl_xor(acc, 32);
                if (hf == 0) part[(r * 8 + X.wave) * 32 + e] = acc; }
            __syncthreads();
            { const int r = X.tid >> 5, ee = X.tid & 31; float s = rb[ee];
#pragma unroll
              for (int w8 = 0; w8 < 8; ++w8) s += part[(r * 8 + w8) * 32 + ee];
              lg[r * 32 + ee] = s; }
            __syncthreads();
            if (X.tid < 16) { const int r = X.tid, rl = 16 * bt + r; unsigned used = 0u; float tv[4]; int ti[4];
#pragma unroll
                for (int k = 0; k < 4; ++k) { float best = -3.0e38f; int bi = 0;
                    for (int ee = 0; ee < 32; ++ee) { const float v = lg[r * 32 + ee]; if (!((used >> ee) & 1u) && v > best) { best = v; bi = ee; } }
                    used |= 1u << bi; tv[k] = best; ti[k] = bi; }
                float ex[4], sum = 0.f;
#pragma unroll
                for (int k = 0; k < 4; ++k) { ex[k] = __expf(tv[k] - tv[0]); sum += ex[k]; }
                const float inv = 1.0f / sum;
#pragma unroll
                for (int k = 0; k < 4; ++k) { const int rank = atomicAdd((int*)&lcnt[ti[k]], 1); sel[rl * 4 + k] = (ti[k] << 16) | rank; gatew[(size_t)(rowbase + rl) * 4 + k] = ex[k] * inv; } }
        }
        __syncthreads();
        if (X.tid < 32) lcnt[32 + X.tid] = atomicAdd(cntg + X.tid, lcnt[X.tid]);
        __syncthreads();
        if (X.tid < 256) { const int w = sel[X.tid]; const int ee = w >> 16, rank = w & 0xffff; list[(size_t)ee * NTOK + lcnt[32 + ee] + rank] = rowbase * 4 + X.tid; }
    }
}

__device__ __forceinline__ void phase_combine(const Args& a, const Ctx& X, int layer) {
    float* H = (float*)(X.ws + WS_H); const bf16* __restrict__ Y = (const bf16*)(X.ws + WS_Y); bf16* XA = (bf16*)(X.ws + WS_XA);
    const float* __restrict__ MODl = (const float*)(X.ws + WS_MOD) + (size_t)layer * 9 * MODW;
    float* outp = (float*)(__attribute__((address_space(1))) float*)X.kp[33];
    for (int row = X.gw; row < NTOK; row += X.NGW) {
        const float* gt = MODl + (size_t)(row / SEQ) * MODW + 5 * 1024; f32x4 h[2][2], g[2][2]; u32x4 yw[2][4];
#pragma unroll
        for (int j = 0; j < 2; ++j) { const int c0 = 8 * X.lane + 512 * j;
#pragma unroll
            for (int q = 0; q < 2; ++q) { h[j][q] = *(const f32x4*)(H + (size_t)row * D + c0 + 4 * q); g[j][q] = *(const f32x4*)(gt + c0 + 4 * q); }
#pragma unroll
            for (int k = 0; k < 4; ++k) yw[j][k] = *(const u32x4*)(Y + ((size_t)row * 4 + k) * D + c0); }
        float ss = 0.f;
#pragma unroll
        for (int j = 0; j < 2; ++j) { f32x4 s0 = (f32x4){0.f, 0.f, 0.f, 0.f}, s1 = s0;
#pragma unroll
            for (int k = 0; k < 4; ++k) { const u32x4 w = yw[j][k]; s0 += (f32x4){bf2f(w.x & 0xffffu), bf2f(w.x >> 16), bf2f(w.y & 0xffffu), bf2f(w.y >> 16)}; s1 += (f32x4){bf2f(w.z & 0xffffu), bf2f(w.z >> 16), bf2f(w.w & 0xffffu), bf2f(w.w >> 16)}; }
            h[j][0] = h[j][0] + g[j][0] * s0; h[j][1] = h[j][1] + g[j][1] * s1;
#pragma unroll
            for (int q = 0; q < 2; ++q) ss += (h[j][q][0] * h[j][q][0] + h[j][q][1] * h[j][q][1]) + (h[j][q][2] * h[j][q][2] + h[j][q][3] * h[j][q][3]); }
        if (layer == 1) {
#pragma unroll
            for (int j = 0; j < 2; ++j)
#pragma unroll
                for (int q = 0; q < 2; ++q) *(f32x4*)(outp + (size_t)row * D + 8 * X.lane + 512 * j + 4 * q) = h[j][q];
        } else {
            const float* m1 = (const float*)(X.ws + WS_MOD) + (size_t)9 * MODW + (size_t)(row / SEQ) * MODW; const float* gn = IN(I_NMG) + D;
            f32x4 gk[2][2], hk[2][2], sk[2][2];
#pragma unroll
            for (int j = 0; j < 2; ++j)
#pragma unroll
                for (int q = 0; q < 2; ++q) { const int c0 = 8 * X.lane + 512 * j + 4 * q; gk[j][q] = *(const f32x4*)(gn + c0); hk[j][q] = *(const f32x4*)(m1 + c0); sk[j][q] = *(const f32x4*)(m1 + 1024 + c0); }
            const float rstd = rsqrtf(wave_sum(ss) * (1.0f / D) + EPS);
#pragma unroll
            for (int j = 0; j < 2; ++j) { const int c0 = 8 * X.lane + 512 * j;
                const f32x4 y0 = h[j][0] * rstd * gk[j][0] * (1.0f + sk[j][0]) + hk[j][0], y1 = h[j][1] * rstd * gk[j][1] * (1.0f + sk[j][1]) + hk[j][1];
                *(f32x4*)(H + (size_t)row * D + c0) = h[j][0]; *(f32x4*)(H + (size_t)row * D + c0 + 4) = h[j][1];
                *(u32x4*)(XA + (size_t)row * D + c0) = pack8(y0, y1); }
        }
    }
}

__device__ __forceinline__ void phase_spatial(const Args& a, const Ctx& X) {
    const bf16* U = (const bf16*)(X.ws + WS_U); const bf16* VB = (const bf16*)(X.ws + WS_VB); bf16* SG = (bf16*)(X.ws + WS_MIX); const bf16* WsB = (const bf16*)(X.ws + WS_WSB); const float* vstat = (const float*)(X.ws + WS_CTL) + CW_VSTAT;
    LAS float* stat = (LAS float*)X.lds;
    LAS unsigned char* Vt = X.lds + 4096;
    const int lane = X.lane, l15 = lane & 15, g4 = lane >> 4;
    for (int item = blockIdx.x; item < 128 * 8; item += X.G) {
        const int chunk = item >> 3, g = item & 7; const int row0 = chunk * 128;
        __syncthreads();
        if (X.tid < 128) { const f32x2 sv = *(const f32x2*)(vstat + 2 * (row0 + X.tid)); const float mean = sv.x * (1.0f / D); const float var = fmaxf(sv.y * (1.0f / D) - mean * mean, 0.f);
            stat[2 * X.tid] = mean; stat[2 * X.tid + 1] = rsqrtf(var + EPS); }
        __syncthreads();
#pragma unroll
        for (int c = X.tid; c < 128 * 16; c += NTHREADS) { const int q = c >> 4, cc = c & 15; const u32x4 w = *(const u32x4*)(VB + (size_t)(row0 + q) * D + g * 128 + cc * 8);
            const float mean = stat[2 * q], rstd = stat[2 * q + 1]; const float* lg_ = IN(I_OLNG) + g * 128 + cc * 8; const float* lb_ = IN(I_OLNB) + g * 128 + cc * 8;
#pragma unroll
            for (int k = 0; k < 4; ++k) { const float y0 = (bf2f(w[k] & 0xffffu) - mean) * rstd * lg_[2 * k] + lb_[2 * k], y1 = (bf2f(w[k] >> 16) - mean) * rstd * lg_[2 * k + 1] + lb_[2 * k + 1];
                const unsigned pk = pk2(y0, y1);
                *(LAS unsigned short*)(Vt + (cc * 8 + 2 * k) * 272 + q * 2) = (unsigned short)(pk & 0xffffu); *(LAS unsigned short*)(Vt + (cc * 8 + 2 * k + 1) * 272 + q * 2) = (unsigned short)(pk >> 16); } }
        __syncthreads();
        f32x4 acc[8];
#pragma unroll
        for (int pb = 0; pb < 8; ++pb) acc[pb] = (f32x4){0.f, 0.f, 0.f, 0.f};
#pragma unroll
        for (int s = 0; s < 4; ++s) { const bf16x8 af = *(const LAS bf16x8*)(Vt + (16 * X.wave + l15) * 272 + (32 * s + 8 * g4) * 2);
#pragma unroll
            for (int pb = 0; pb < 8; ++pb) { const bf16x8 bfr = *(const bf16x8*)(WsB + ((size_t)g * 128 + 16 * pb + l15) * 128 + 32 * s + 8 * g4); acc[pb] = __builtin_amdgcn_mfma_f32_16x16x32_bf16(af, bfr, acc[pb], 0, 0, 0); } }
#pragma unroll
        for (int pb = 0; pb < 8; ++pb) { const int p = 16 * pb + l15; const float bs = IN(I_OBS)[g * 128 + p]; const size_t off = (size_t)(row0 + p) * D + g * 128 + 16 * X.wave + 4 * g4;
            const u32x2 uw = *(const u32x2*)(U + off);
            u32x2 o; o.x = pk2(bf2f(uw.x & 0xffffu) * (acc[pb][0] + bs), bf2f(uw.x >> 16) * (acc[pb][1] + bs)); o.y = pk2(bf2f(uw.y & 0xffffu) * (acc[pb][2] + bs), bf2f(uw.y >> 16) * (acc[pb][3] + bs));
            *(u32x2*)(SG + off) = o; }
    }
}

enum { PH_PRO = 0, PH_MOD0, PH_GIN, PH_CONV, PH_ATT, PH_GOUT, PH_RT0, PH_M1_0, PH_M2_0, PH_CMB0, PH_GMI, PH_SPA, PH_GMO, PH_RT1, PH_M1_1, PH_M2_1, PH_CMB1, NPHASE };

__global__ void __launch_bounds__(NTHREADS, 2) mega(Args a) {
    extern __shared__ __attribute__((aligned(16))) unsigned char lds_raw[];
    Ctx X; X.lds = (LAS unsigned char*)lds_raw;
    const int wave0 = __builtin_amdgcn_readfirstlane((int)threadIdx.x >> 6);
    X.G = gridDim.x; { const int bx = blockIdx.x; X.vcu = (X.G % 8 == 0) ? (bx % 8) * (X.G / 8) + bx / 8 : bx; }
    X.NGW = X.G * NWAVES; X.wave = wave0;
    volatile LAS unsigned* MISC = (volatile LAS unsigned*)(X.lds + MISC_OFF);
    if (threadIdx.x < 64) MISC[threadIdx.x] = 0u;
    __syncthreads();
    XcdBarrier bar = xcd_barrier_post((unsigned*)(a.ws + WS_CTL) + CW_BAR + a.li * XCD_BAR_WORDS, MISC + 8);
    const int ph_lo = a.ph_lo, ph_hi = a.ph_hi;
#define PH_ENTER() int z; asm volatile("s_mov_b32 %0, 0" : "=s"(z)); \
        X.lane = (int)__builtin_amdgcn_mbcnt_hi(~0u, __builtin_amdgcn_mbcnt_lo(~0u, (unsigned)z)); X.tid = wave0 * 64 + X.lane; X.gw = X.vcu * NWAVES + wave0; \
        { kargp_t kp = (kargp_t)__builtin_amdgcn_kernarg_segment_ptr(); asm volatile("" : "+s"(kp)); X.kp = kp; } \
        unsigned char* ws = (unsigned char*)(__attribute__((address_space(1))) unsigned char*)X.kp[34] + z; X.ws = ws;
#if PROBE_PH >= 0
    unsigned long long pr_t0 = 0, pr_t1 = 0;
#endif
    for (int ph = ph_lo; ph < ph_hi; ++ph) {
        if (ph != ph_lo) { const int l0 = (int)__builtin_amdgcn_mbcnt_hi(~0u, __builtin_amdgcn_mbcnt_lo(~0u, 0u)); xcd_barrier(bar, wave0 * 64 + l0); }
#if PROBE_PH >= 0
        if (ph == PROBE_PH) pr_t0 = __builtin_amdgcn_s_memrealtime();
        if (ph == PROBE_END) pr_t1 = __builtin_amdgcn_s_memrealtime();
#endif
        switch (ph) {
        case PH_PRO: { PH_ENTER(); phase_prologue(a, X); } break;
        case PH_MOD0: { PH_ENTER(); phase_modulate0(a, X); } break;
        case PH_GIN: { PH_ENTER(); DenseSched S; S.init((const bf16*)(ws + WS_XA), (const bf16*)(ws + WS_WINT), NTOK, EVEN_IN, X.G, (int)blockIdx.x);
            S.A2 = (const bf16*)(ws + WS_GM); S.Bt2 = (const bf16*)(ws + WS_WINT) + (size_t)KV_COL * D; S.nM2 = NCTX / 256;
            EpiIn E{(bf16*)(ws + WS_GLU), (bf16*)(ws + WS_Q), (bf16*)(ws + WS_K), (bf16*)(ws + WS_V), (bf16*)(ws + WS_KC), (bf16*)(ws + WS_VC), IN(I_EBIN)};
            pg8::gemm_phase<EpiIn, DenseSched>(X.lds, S, E, X.tid); } break;
        case PH_CONV: { PH_ENTER(); phase_conv_qk(a, X); } break;
        case PH_ATT: { PH_ENTER(); phase_attention(a, X); } break;
        case PH_GOUT: { PH_ENTER(); DenseSched S; S.init((const bf16*)(ws + WS_MIX), (const bf16*)(ws + WS_WOUTT), NTOK, D, X.G, (int)blockIdx.x);
            EpiRes E{IN(I_X), (float*)(ws + WS_H), IN(I_EBOUT), (const float*)(ws + WS_MOD) + 2 * 1024};
            pg8::gemm_phase<EpiRes, DenseSched>(X.lds, S, E, X.tid); } break;
        case PH_RT0: { PH_ENTER(); phase_router(a, X, 0); } break;
        case PH_RT1: { PH_ENTER(); phase_router(a, X, 1); } break;
        case PH_M1_0: case PH_M1_1: { PH_ENTER(); const int l = (ph == PH_M1_1); moe_build_table(X, (const int*)(ws + WS_CTL) + CW_CNT + l * NE);
            MoeSchedT<true, 8> S; S.tab = (const LAS int*)(X.lds + TAB_OFF); S.G = X.G; S.c = X.vcu; S.A = (const bf16*)(ws + WS_XA); S.Bt = (const bf16*)(ws + WS_W1T) + (size_t)l * NE * 2048 * 1024; S.list = (const int*)(ws + WS_LIST);
            EpiSwiglu E{(bf16*)(ws + WS_ACT), IN(I_B1) + (size_t)l * NE * 2048};
            pg8::gemm_phase<EpiSwiglu, MoeSchedT<true, 8>>(X.lds, S, E, X.tid); } break;
        case PH_M2_0: case PH_M2_1: { PH_ENTER(); const int l = (ph == PH_M2_1); moe_build_table(X, (const int*)(ws + WS_CTL) + CW_CNT + l * NE);
            MoeSchedT<false, 4> S; S.tab = (const LAS int*)(X.lds + TAB_OFF); S.G = X.G; S.c = X.vcu; S.A = (const bf16*)(ws + WS_ACT); S.Bt = (const bf16*)(ws + WS_W2T) + (size_t)l * NE * 1024 * 1024; S.list = (const int*)(ws + WS_LIST);
            EpiDown E{(bf16*)(ws + WS_Y), IN(I_B2) + (size_t)l * NE * D, (const int*)(ws + WS_LIST), (const float*)(ws + WS_GATE), (const LAS int*)(X.lds + TAB_OFF)};
            pg8::gemm_phase<EpiDown, MoeSchedT<false, 4>>(X.lds, S, E, X.tid); } break;
        case PH_CMB0: { PH_ENTER(); phase_combine(a, X, 0); } break;
        case PH_CMB1: { PH_ENTER(); phase_combine(a, X, 1); } break;
        case PH_GMI: { PH_ENTER(); DenseSched S; S.init((const bf16*)(ws + WS_XA), (const bf16*)(ws + WS_GWINT), NTOK, 2048, X.G, (int)blockIdx.x);
            EpiGelu E{(bf16*)(ws + WS_U), (bf16*)(ws + WS_VB), IN(I_OBIN), (float*)(ws + WS_CTL) + CW_VSTAT};
            pg8::gemm_phase<EpiGelu, DenseSched>(X.lds, S, E, X.tid); } break;
        case PH_SPA: { PH_ENTER(); phase_spatial(a, X); } break;
        case PH_GMO: { PH_ENTER(); DenseSched S; S.init((const bf16*)(ws + WS_MIX), (const bf16*)(ws + WS_GWOUTT), NTOK, D, X.G, (int)blockIdx.x);
            EpiRes E{(const float*)(ws + WS_H), (float*)(ws + WS_H), IN(I_OBOUT), (const float*)(ws + WS_MOD) + (size_t)9 * MODW + 2 * 1024};
            pg8::gemm_phase<EpiRes, DenseSched>(X.lds, S, E, X.tid); } break;
        default: break;
        }
    }
#if PROBE_PH >= 0
    if (pr_t1 == 0) pr_t1 = __builtin_amdgcn_s_memrealtime();
    if (blockIdx.x == 0 && wave0 == 0) { const unsigned long long te = __builtin_amdgcn_s_memrealtime(); const unsigned long long span = (pr_t1 - pr_t0) * PROBE_MULT;
        while (__builtin_amdgcn_s_memrealtime() - te < span) __builtin_amdgcn_s_sleep(8); }
#endif
}

__device__ __forceinline__ bool find_expert(const int* cnt, int s, int& e, int& slot) {
    int pb = 0;
    for (int i = 0; i < NE; ++i) { const int c = cnt[i]; const int pr = ((c + 255) >> 8) << 8; if (s < pb + pr) { e = i; slot = s - pb; return true; } pb += pr; }
    return false;
}
__global__ void __launch_bounds__(256) slow_gemm(const bf16* A, const int* arow, const bf16* Bt, float* C, int N, const int* cnt, size_t bstride) {
    __shared__ float As[16][65], Bs[16][65];
    const int tx = threadIdx.x & 15, ty = threadIdx.x >> 4; const int m0 = blockIdx.y * 64, n0 = blockIdx.x * 64;
    if (cnt) { int e, slot; if (!find_expert(cnt, m0, e, slot)) return; Bt += (size_t)e * bstride; }
    float acc[4][4];
    for (int i = 0; i < 4; ++i) for (int j = 0; j < 4; ++j) acc[i][j] = 0.f;
    for (int k0 = 0; k0 < 1024; k0 += 16) {
        for (int i = 0; i < 4; ++i) { const int idx = threadIdx.x + 256 * i; const int r = idx >> 4, kk = idx & 15; const int gm = m0 + r; const int ar = arow ? arow[gm] : gm;
            As[kk][r] = bf2f(A[(size_t)ar * 1024 + k0 + kk]); Bs[kk][r] = bf2f(Bt[(size_t)(n0 + r) * 1024 + k0 + kk]); }
        __syncthreads();
        for (int kk = 0; kk < 16; ++kk) { float av[4], bv[4];
            for (int i = 0; i < 4; ++i) { av[i] = As[kk][ty * 4 + i]; bv[i] = Bs[kk][tx * 4 + i]; }
            for (int i = 0; i < 4; ++i) for (int j = 0; j < 4; ++j) acc[i][j] += av[i] * bv[j]; }
        __syncthreads();
    }
    for (int i = 0; i < 4; ++i) for (int j = 0; j < 4; ++j) C[(size_t)(m0 + ty * 4 + i) * N + n0 + tx * 4 + j] = acc[i][j];
}
__device__ __forceinline__ unsigned short f2bf_s(float f) { return (unsigned short)(pk2(f, 0.f) & 0xffffu); }
__global__ void slow_epi_in(const float* C, const float* C2, const float* bias, bf16* GLU, bf16* Q, bf16* Kb, bf16* Vb, bf16* KC, bf16* VC) {
    const size_t i = (size_t)blockIdx.x * blockDim.x + threadIdx.x;
    if (i < (size_t)NTOK * 512) { const int row = (int)(i >> 9), j = (int)(i & 511); const int t = j >> 7, ii = j & 127; const float* cr = C + (size_t)row * EVEN_IN;
        const float u = cr[t * 256 + ii] + bias[j], g = cr[t * 256 + 128 + ii] + bias[512 + j];
        GLU[i] = f2bf_s(u / (1.0f + expf(-g)));
        Q[i] = f2bf_s(cr[1024 + j] + bias[1024 + j]);
        if (j < 128) { Kb[(size_t)row * 128 + j] = f2bf_s(cr[1536 + j] + bias[1536 + j]); Vb[(size_t)row * 128 + j] = f2bf_s(cr[1664 + j] + bias[1664 + j]); }
        if (row < NCTX && j < 128) { KC[(size_t)row * 128 + j] = f2bf_s(C2[(size_t)row * 256 + j] + bias[1536 + j]); VC[(size_t)row * 128 + j] = f2bf_s(C2[(size_t)row * 256 + 128 + j] + bias[1664 + j]); } }
}
__global__ void slow_epi_res(const float* C, const float* base, float* out, const float* bias, const float* gate) {
    const size_t i = (size_t)blockIdx.x * blockDim.x + threadIdx.x;
    if (i < (size_t)NTOK * D) { const int row = (int)(i >> 10), col = (int)(i & 1023); out[i] = base[i] + gate[(size_t)(row / SEQ) * MODW + col] * (C[i] + bias[col]); }
}
__global__ void slow_epi_gelu(const float* C, const float* bias, bf16* U, bf16* V) {
    const size_t i = (size_t)blockIdx.x * blockDim.x + threadIdx.x;
    if (i < (size_t)NTOK * 2048) { const int row = (int)(i >> 11), col = (int)(i & 2047); const float x = C[i] + bias[col]; const float y = 0.5f * x * (1.0f + erff(x * 0.70710678118654752f));
        if (col < 1024) U[(size_t)row * D + col] = f2bf_s(y); else V[(size_t)row * D + col - 1024] = f2bf_s(y); }
}
__global__ void slow_arow(const int* cnt, const int* list, int* arow) {
    const int s = blockIdx.x * blockDim.x + threadIdx.x; if (s >= ACT_ROWS) return;
    int e, slot; int r = 0; if (find_expert(cnt, s, e, slot) && slot < cnt[e]) r = list[(size_t)e * NTOK + slot] >> 2;
    arow[s] = r;
}
__global__ void slow_epi_swiglu(const float* C, const int* cnt, const float* b1, bf16* ACT) {
    const size_t i = (size_t)blockIdx.x * blockDim.x + threadIdx.x;
    if (i < (size_t)ACT_ROWS * 1024) { const int s = (int)(i >> 10), j = (int)(i & 1023); int e, slot; if (!find_expert(cnt, s, e, slot)) return;
        const int t = j >> 7, ii = j & 127; const float* cr = C + (size_t)s * 2048;
        float g = cr[t * 256 + ii] + b1[(size_t)e * 2048 + j], up = cr[t * 256 + 128 + ii] + b1[(size_t)e * 2048 + 1024 + j];
        g = fminf(g, 7.0f); up = fminf(fmaxf(up, -7.0f), 7.0f);
        ACT[i] = f2bf_s((up + 1.0f) * g / (1.0f + expf(-1.702f * g))); }
}
__global__ void slow_epi_down(const float* C, const int* cnt, const int* list, const float* gatew, const float* b2, bf16* Y) {
    const size_t i = (size_t)blockIdx.x * blockDim.x + threadIdx.x;
    if (i < (size_t)ACT_ROWS * 1024) { const int s = (int)(i >> 10), col = (int)(i & 1023); int e, slot; if (!find_expert(cnt, s, e, slot) || slot >= cnt[e]) return;
        const int aid = list[(size_t)e * NTOK + slot]; Y[(size_t)aid * D + col] = f2bf_s((C[i] + b2[(size_t)e * D + col]) * gatew[aid]); }
}
__global__ void __launch_bounds__(64) slow_attention(const bf16* QN, const bf16* KN, const bf16* VV, const bf16* KC, const bf16* VC, const float* sink, bf16* MIX) {
    const int i = blockIdx.x * blockDim.x + threadIdx.x; if (i >= NTOK * 8) return;
    const int row = i >> 3, h = i & 7, kh = h >> 2, b = row / SEQ, t = row % SEQ;
    float q[64], o[64];
    for (int d = 0; d < 64; ++d) { q[d] = bf2f(QN[(size_t)row * 512 + h * 64 + d]); o[d] = 0.f; }
    float m = sink[h] * LOG2E, l = 1.0f;
    const int j0 = t - 128 < 0 ? 0 : t - 128, j1 = t + 128 > SEQ - 1 ? SEQ - 1 : t + 128;
    for (int jj = j0; jj <= j1 + CTXL; ++jj) {
        const bf16* kp; const bf16* vp;
        if (jj <= j1) { kp = KN + (size_t)(b * SEQ + jj) * 128 + kh * 64; vp = VV + (size_t)(b * SEQ + jj) * 128 + kh * 64; }
        else { const int c = jj - j1 - 1; kp = KC + (size_t)(b * CTXL + c) * 128 + kh * 64; vp = VC + (size_t)(b * CTXL + c) * 128 + kh * 64; }
        float s = 0.f; for (int d = 0; d < 64; ++d) s += q[d] * bf2f(kp[d]);
        const float mn = fmaxf(m, s), al = exp2f(m - mn), p = exp2f(s - mn); m = mn; l = l * al + p;
        for (int d = 0; d < 64; ++d) o[d] = o[d] * al + p * bf2f(vp[d]);
    }
    for (int d = 0; d < 64; ++d) MIX[(size_t)row * D + 512 + h * 64 + d] = f2bf_s(o[d] / l);
}
__global__ void slow_vstats(const bf16* VB, float* stat) {
    const int row = blockIdx.x * blockDim.x + threadIdx.x; if (row >= NTOK) return;
    float s = 0.f; for (int c = 0; c < D; ++c) s += bf2f(VB[(size_t)row * D + c]); const float mean = s / D;
    float s2 = 0.f; for (int c = 0; c < D; ++c) { const float d = bf2f(VB[(size_t)row * D + c]) - mean; s2 += d * d; }
    stat[2 * row] = mean; stat[2 * row + 1] = rsqrtf(s2 / D + EPS);
}
__global__ void slow_spatial(const bf16* U, const bf16* VB, const float* stat, const float* ws, const float* bs, const float* lng, const float* lnb, bf16* SG) {
    const size_t i = (size_t)blockIdx.x * blockDim.x + threadIdx.x;
    if (i < (size_t)NTOK * D) { const int row = (int)(i >> 10), ch = (int)(i & 1023); const int g = ch >> 7, p = row & 127, r0 = row - p;
        float s = 0.f;
        for (int q = 0; q < 128; ++q) { const float vn = (bf2f(VB[(size_t)(r0 + q) * D + ch]) - stat[2 * (r0 + q)]) * stat[2 * (r0 + q) + 1] * lng[ch] + lnb[ch]; s += ws[((size_t)g * 128 + p) * 128 + q] * vn; }
        SG[i] = f2bf_s(bf2f(U[i]) * (s + bs[g * 128 + p])); }
}

static void launch_mega(Args& a, int lo, int hi, int& li, int grid, hipStream_t stream) {
    a.ph_lo = lo; a.ph_hi = hi; a.li = li++;
    hipLaunchKernelGGL(mega, dim3(grid), dim3(NTHREADS), LDS_BYTES, stream, a);
}
extern "C" void kernel_launch(void* const* d_in, const int* in_sizes, int n_in, void* d_out, int out_size, void* d_ws, size_t ws_size, hipStream_t stream) {
    static int grid = 0;
    if (grid == 0) {
        if (n_in != 33 || out_size != NTOK * D || ws_size < WS_END) { fprintf(stderr, "kernel_launch: unexpected problem (n_in %d, out %d, ws %zu)\n", n_in, out_size, ws_size); grid = -1; return; }
        int dev = 0, cus = 0, per_cu = 0;
        if (hipGetDevice(&dev) != hipSuccess || hipDeviceGetAttribute(&cus, hipDeviceAttributeMultiprocessorCount, dev) != hipSuccess) { grid = -1; return; }
        if (hipFuncSetAttribute((const void*)mega, hipFuncAttributeMaxDynamicSharedMemorySize, LDS_BYTES) != hipSuccess) { fprintf(stderr, "kernel_launch: hipFuncSetAttribute failed\n"); grid = -1; return; }
        if (hipOccupancyMaxActiveBlocksPerMultiprocessor(&per_cu, (const void*)mega, NTHREADS, LDS_BYTES) != hipSuccess || per_cu < 1) { fprintf(stderr, "kernel_launch: occupancy query says %d blocks per CU\n", per_cu); per_cu = 1; }
        (void)hipGetLastError();
        grid = cus;
    }
    if (grid < 0) return;
    unsigned char* ws = (unsigned char*)d_ws;
    (void)hipMemsetAsync(ws + WS_CTL, 0, CTL_ZERO_BYTES, stream);
    Args a{};
    for (int i = 0; i < 33; ++i) a.in[i] = (const float*)d_in[i];
    a.out = (float*)d_out; a.ws = ws;
    int li = 0;
    const float* in_[33]; for (int i = 0; i < 33; ++i) in_[i] = (const float*)d_in[i];
    float* CF = (float*)(ws + WS_CF); float* MOD = (float*)(ws + WS_MOD); int* CNT = (int*)(ws + WS_CTL) + CW_CNT;
    int lo = 0;
    auto flush = [&](int upto) { if (upto > lo) launch_mega(a, lo, upto, li, grid, stream); };
    for (int ph = 0; ph < NPHASE; ++ph) {
        bool slow = false;
        switch (ph) {
        case PH_GIN: slow = SLOW_MASK & 1; break;
        case PH_ATT: slow = SLOW_MASK & 2; break;
        case PH_GOUT: case PH_GMO: slow = SLOW_MASK & 4; break;
        case PH_M1_0: case PH_M1_1: slow = SLOW_MASK & 8; break;
        case PH_M2_0: case PH_M2_1: slow = SLOW_MASK & 16; break;
        case PH_GMI: slow = SLOW_MASK & 32; break;
        case PH_SPA: slow = SLOW_MASK & 64; break;
        default: break;
        }
        if (!slow) continue;
        flush(ph); lo = ph + 1;
        const int l = (ph == PH_M1_1 || ph == PH_M2_1) ? 1 : 0;
        switch (ph) {
        case PH_GIN:
            hipLaunchKernelGGL(slow_gemm, dim3(EVEN_IN / 64, NTOK / 64), dim3(256), 0, stream, (const bf16*)(ws + WS_XA), (const int*)nullptr, (const bf16*)(ws + WS_WINT), CF, EVEN_IN, (const int*)nullptr, (size_t)0);
            hipLaunchKernelGGL(slow_gemm, dim3(256 / 64, NCTX / 64), dim3(256), 0, stream, (const bf16*)(ws + WS_GM), (const int*)nullptr, (const bf16*)(ws + WS_WINT) + (size_t)KV_COL * D, CF + (size_t)NTOK * EVEN_IN, 256, (const int*)nullptr, (size_t)0);
            hipLaunchKernelGGL(slow_epi_in, dim3(NTOK * 512 / 256), dim3(256), 0, stream, (const float*)CF, (const float*)(CF + (size_t)NTOK * EVEN_IN), in_[I_EBIN], (bf16*)(ws + WS_GLU), (bf16*)(ws + WS_Q), (bf16*)(ws + WS_K), (bf16*)(ws + WS_V), (bf16*)(ws + WS_KC), (bf16*)(ws + WS_VC));
            break;
        case PH_ATT:
            hipLaunchKernelGGL(slow_attention, dim3(NTOK * 8 / 64), dim3(64), 0, stream, (const bf16*)(ws + WS_Q), (const bf16*)(ws + WS_K), (const bf16*)(ws + WS_V), (const bf16*)(ws + WS_KC), (const bf16*)(ws + WS_VC), in_[I_SINK], (bf16*)(ws + WS_MIX));
            break;
        case PH_GOUT:
            hipLaunchKernelGGL(slow_gemm, dim3(D / 64, NTOK / 64), dim3(256), 0, stream, (const bf16*)(ws + WS_MIX), (const int*)nullptr, (const bf16*)(ws + WS_WOUTT), CF, D, (const int*)nullptr, (size_t)0);
            hipLaunchKernelGGL(slow_epi_res, dim3(NTOK * D / 256), dim3(256), 0, stream, (const float*)CF, in_[I_X], (float*)(ws + WS_H), in_[I_EBOUT], (const float*)(MOD + 2 * 1024));
            break;
        case PH_GMO:
            hipLaunchKernelGGL(slow_gemm, dim3(D / 64, NTOK / 64), dim3(256), 0, stream, (const bf16*)(ws + WS_MIX), (const int*)nullptr, (const bf16*)(ws + WS_GWOUTT), CF, D, (const int*)nullptr, (size_t)0);
            hipLaunchKernelGGL(slow_epi_res, dim3(NTOK * D / 256), dim3(256), 0, stream, (const float*)CF, (const float*)(ws + WS_H), (float*)(ws + WS_H), in_[I_OBOUT], (const float*)(MOD + (size_t)9 * MODW + 2 * 1024));
            break;
        case PH_M1_0: case PH_M1_1:
            hipLaunchKernelGGL(slow_arow, dim3(ACT_ROWS / 256), dim3(256), 0, stream, (const int*)(CNT + l * NE), (const int*)(ws + WS_LIST), (int*)(ws + WS_AROW));
            hipLaunchKernelGGL(slow_gemm, dim3(2048 / 64, ACT_ROWS / 64), dim3(256), 0, stream, (const bf16*)(ws + WS_XA), (const int*)(ws + WS_AROW), (const bf16*)(ws + WS_W1T) + (size_t)l * NE * 2048 * 1024, CF, 2048, (const int*)(CNT + l * NE), (size_t)2048 * 1024);
            hipLaunchKernelGGL(slow_epi_swiglu, dim3(ACT_ROWS * 1024 / 256), dim3(256), 0, stream, (const float*)CF, (const int*)(CNT + l * NE), in_[I_B1] + (size_t)l * NE * 2048, (bf16*)(ws + WS_ACT));
            break;
        case PH_M2_0: case PH_M2_1:
            hipLaunchKernelGGL(slow_gemm, dim3(1024 / 64, ACT_ROWS / 64), dim3(256), 0, stream, (const bf16*)(ws + WS_ACT), (const int*)nullptr, (const bf16*)(ws + WS_W2T) + (size_t)l * NE * 1024 * 1024, CF, 1024, (const int*)(CNT + l * NE), (size_t)1024 * 1024);
            hipLaunchKernelGGL(slow_epi_down, dim3(ACT_ROWS * 1024 / 256), dim3(256), 0, stream, (const float*)CF, (const int*)(CNT + l * NE), (const int*)(ws + WS_LIST), (const float*)(ws + WS_GATE), in_[I_B2] + (size_t)l * NE * D, (bf16*)(ws + WS_Y));
            break;
        case PH_GMI:
            hipLaunchKernelGGL(slow_gemm, dim3(2048 / 64, NTOK / 64), dim3(256), 0, stream, (const bf16*)(ws + WS_XA), (const int*)nullptr, (const bf16*)(ws + WS_GWINT), CF, 2048, (const int*)nullptr, (size_t)0);
            hipLaunchKernelGGL(slow_epi_gelu, dim3(NTOK * 2048 / 256), dim3(256), 0, stream, (const float*)CF, in_[I_OBIN], (bf16*)(ws + WS_U), (bf16*)(ws + WS_VB));
            break;
        case PH_SPA:
            hipLaunchKernelGGL(slow_vstats, dim3(NTOK / 64), dim3(64), 0, stream, (const bf16*)(ws + WS_VB), CF);
            hipLaunchKernelGGL(slow_spatial, dim3(NTOK * D / 256), dim3(256), 0, stream, (const bf16*)(ws + WS_U), (const bf16*)(ws + WS_VB), (const float*)CF, in_[I_OWS], in_[I_OBS], in_[I_OLNG], in_[I_OLNB], (bf16*)(ws + WS_MIX));
            break;
        default: break;
        }
    }
    flush(NPHASE);
}
```

```cpp
#include <hip/hip_runtime.h>
#include <cstdio>
#include <cstdint>

#ifndef SLOW_MASK
#define SLOW_MASK 0x00
#endif

#ifndef PROBE_PH
#define PROBE_PH (-1)
#endif
#ifndef PROBE_END
#define PROBE_END (PROBE_PH + 1)
#endif
#ifndef PROBE_MULT
#define PROBE_MULT 4
#endif

#define LAS __attribute__((address_space(3)))
typedef unsigned short bf16;
typedef short bf16x8 __attribute__((ext_vector_type(8)));
typedef float f32x4 __attribute__((ext_vector_type(4)));
typedef float f32x2 __attribute__((ext_vector_type(2)));
typedef unsigned u32x4 __attribute__((ext_vector_type(4)));
typedef unsigned u32x2 __attribute__((ext_vector_type(2)));
typedef __bf16 bf16x2_t __attribute__((ext_vector_type(2)));

constexpr int NB = 8, SEQ = 2048, D = 1024, NTOK = NB * SEQ, CTXL = 256, NCTX = NB * CTXL;
constexpr int NE = 32, TOPK = 4, NASSIGN = NTOK * TOPK, ACT_ROWS = NASSIGN + NE * 256;
constexpr int EVEN_IN = 1792, KV_COL = 1536;
constexpr float EPS = 1e-6f, LOG2E = 1.4426950408889634f;
constexpr float QSCALE = 0.125f * LOG2E;
constexpr int MODW = 6 * D;
constexpr int NWAVES = 8, NTHREADS = 512;

constexpr size_t MiB = 1u << 20;
constexpr size_t WS_CTL = 0, CTL_ZERO_BYTES = 1 * MiB;
constexpr size_t WS_MOD = 1 * MiB;
constexpr size_t WS_LIST = 2 * MiB;
constexpr size_t WS_GATE = 4 * MiB;
constexpr size_t WS_WSB = 5 * MiB;
constexpr size_t WS_WINT = 6 * MiB;
constexpr size_t WS_WOUTT = 10 * MiB;
constexpr size_t WS_GWINT = 12 * MiB;
constexpr size_t WS_GWOUTT = 16 * MiB;
constexpr size_t WS_KC = 18 * MiB;
constexpr size_t WS_VC = 18 * MiB + 512 * 1024;
constexpr size_t WS_K = 19 * MiB;
constexpr size_t WS_V = 23 * MiB;
constexpr size_t WS_GM = 27 * MiB;
constexpr size_t WS_AROW = 31 * MiB;
constexpr size_t WS_Q = 32 * MiB;
constexpr size_t WS_GLU = 48 * MiB;
constexpr size_t WS_XA = 64 * MiB;
constexpr size_t WS_MIX = 96 * MiB;
constexpr size_t WS_H = 128 * MiB;
constexpr size_t WS_U = 192 * MiB;
constexpr size_t WS_VB = 224 * MiB;
constexpr size_t WS_W1T = 256 * MiB;
constexpr size_t WS_W2T = 512 * MiB;
constexpr size_t WS_ACT = 640 * MiB;
constexpr size_t WS_Y = 784 * MiB;
constexpr size_t WS_CF = 912 * MiB;
constexpr size_t WS_END = 1488 * MiB;
constexpr int CW_BAR = 4096, CW_CNT = 131072, CW_VSTAT = 147456;
constexpr int MAX_LAUNCH = 20;

constexpr int RING_BYTES = 131072;
constexpr int MISC_OFF = RING_BYTES;
constexpr int TAB_OFF = RING_BYTES + 256;
constexpr int LDS_BYTES = 147456;

#define LDS_WAIT() asm volatile("s_waitcnt lgkmcnt(0)" ::: "memory")
#define VM_WAIT() asm volatile("s_waitcnt vmcnt(0)" ::: "memory")

__device__ __forceinline__ float bf2f(unsigned b) { return __uint_as_float(b << 16); }
__device__ __forceinline__ unsigned pk2(float lo, float hi) { f32x2 v = {lo, hi}; bf16x2_t b = __builtin_convertvector(v, bf16x2_t); return __builtin_bit_cast(unsigned, b); }
__device__ __forceinline__ float wave_sum(float v) {
#pragma unroll
    for (int o = 1; o < 64; o <<= 1) v += __shfl_xor(v, o);
    return v;
}
__device__ __forceinline__ float sigmoidf_(float x) { return __builtin_amdgcn_rcpf(1.0f + __builtin_amdgcn_exp2f(-x * LOG2E)); }

#define XB_TMO      128
#define XB_XCNT(j)  (256  + 64 * (j))
#define XB_XSUB(j)  (1280 + 64 * (j))
#define XB_XGEN(j)  (2304 + 64 * (j))
#define XB_TOP      3328
#define XB_TOPGEN   3392
#define XCD_BAR_WORDS 3456
#define XB_SPIN_CAP (1u << 20)
__device__ __forceinline__ unsigned xb_ld(unsigned* p)              { return __hip_atomic_load(p, __ATOMIC_RELAXED, __HIP_MEMORY_SCOPE_AGENT); }
__device__ __forceinline__ unsigned xb_add(unsigned* p, unsigned v) { return __hip_atomic_fetch_add(p, v, __ATOMIC_RELAXED, __HIP_MEMORY_SCOPE_AGENT); }
__device__ __forceinline__ unsigned xb_xcc_id() { return (unsigned)__builtin_amdgcn_s_getreg((3 << 11) | 20) & 0xFu; }
#define XB_SPIN(cond, bar) do { unsigned _sp = 0; while (cond) { __builtin_amdgcn_s_sleep(1); \
    if ((++_sp & 255u) == 0u) { if (xb_ld(&(bar)[XB_TMO])) break; if (_sp > XB_SPIN_CAP) { atomicAdd(&(bar)[XB_TMO], 1u); break; } } } } while (0)
struct XcdBarrier { unsigned* bar; unsigned x; volatile LAS unsigned* st; };
__device__ __forceinline__ XcdBarrier xcd_barrier_post(unsigned* bar, volatile LAS unsigned* st) {
    XcdBarrier b; b.bar = bar; b.x = xb_xcc_id(); b.st = st;
    if (threadIdx.x == 0) (void)xb_add(&bar[XB_XCNT(b.x)], 1u);
    return b;
}
__device__ __forceinline__ void xcd_barrier_complete(unsigned* bar, unsigned x, unsigned& nloc, unsigned& nx) {
    const unsigned G = gridDim.x * gridDim.y * gridDim.z;
    unsigned sum, cnt, mine, sp = 0u;
    for (;;) {
        sum = 0u; cnt = 0u; mine = 0u;
#pragma unroll
        for (unsigned j = 0; j < 16; ++j) { const unsigned c = xb_ld(&bar[XB_XCNT(j)]); sum += c; cnt += (c > 0u) ? 1u : 0u; mine = (j == x) ? c : mine; }
        if (sum == G) break;
        __builtin_amdgcn_s_sleep(1);
        if ((++sp & 255u) == 0u) { if (xb_ld(&bar[XB_TMO])) break; if (sp > XB_SPIN_CAP) { atomicAdd(&bar[XB_TMO], 1u); break; } }
    }
    nloc = mine > 0u ? mine : 1u; nx = cnt > 0u ? cnt : 1u;
}
__device__ __forceinline__ void xcd_barrier(const XcdBarrier& b, const int tid) {
    asm volatile("s_waitcnt vmcnt(0)" ::: "memory");
    __syncthreads();
    if (tid == 0) {
        unsigned* bar = b.bar;
        __builtin_amdgcn_s_waitcnt(0);
        unsigned nloc = b.st[0], nx = b.st[1];
        if (nloc == 0u) { xcd_barrier_complete(bar, b.x, nloc, nx); b.st[0] = nloc; b.st[1] = nx; }
        const unsigned old = xb_add(&bar[XB_XSUB(b.x)], 1u);
        const unsigned gen = old / nloc;
        if (old + 1u == (gen + 1u) * nloc) {
            __builtin_amdgcn_fence(__ATOMIC_RELEASE, "agent");
            asm volatile("s_waitcnt vmcnt(0)" ::: "memory");
            const unsigned og = xb_add(&bar[XB_TOP], 1u);
            const unsigned tg = og / nx;
            if (og + 1u == (tg + 1u) * nx) xb_add(&bar[XB_TOPGEN], 1u);
            else XB_SPIN(xb_ld(&bar[XB_TOPGEN]) == tg, bar);
            __builtin_amdgcn_fence(__ATOMIC_ACQUIRE, "agent");
            xb_add(&bar[XB_XGEN(b.x)], 1u);
            asm volatile("s_waitcnt vmcnt(0)" ::: "memory");
        } else {
            XB_SPIN(xb_ld(&bar[XB_XGEN(b.x)]) == gen, bar);
            __builtin_amdgcn_fence(__ATOMIC_ACQUIRE, "agent");
            asm volatile("s_waitcnt vmcnt(0)" ::: "memory");
        }
    }
    __syncthreads();
}

namespace pg8 {
constexpr int BM = 256, BK = 64, HALF = 128, HTB = HALF * BK * 2, STAGE_BYTES = 8 * HTB, KD = 1024  ;
__host__ __device__ __forceinline__ int lds_byte(int r, int c) { const int st = (r >> 4) * 2 + (c >> 5), rr = r & 15, cc = c & 31, ob = rr * 64 + cc * 2; return st * 1024 + (ob ^ (((ob >> 9) & 1) << 5)); }
__host__ __device__ __forceinline__ void stage_rc(int b, int& R, int& C) { const int st = b / 1024, sb = b % 1024, swz = sb ^ (((sb >> 9) & 1) << 5); R = (st >> 1) * 16 + swz / 64; C = (st & 1) * 32 + (swz % 64) / 2; }
__host__ __device__ __forceinline__ int perm32(int rho) { const int n = rho >> 4, i = rho & 15; return 8 * (i >> 2) + 4 * n + (i & 3); }

struct Unit { int pm, pn, e, cnt; };

template <class Epi, class Sched>
__device__ __forceinline__ void gemm_phase(LAS unsigned char* lds, const Sched& S, const Epi& E, const int tid) {
    const int wid = __builtin_amdgcn_readfirstlane(tid >> 6), lane = tid & 63, wr = wid >> 2, wc = wid & 3, fr = lane & 15, fq = lane >> 4;
    constexpr int K = KD, nt = K / BK;
    int Rr[2], Cc[2];
    unsigned voffA[2][2], voffB[2];
#pragma unroll
    for (int i = 0; i < 2; ++i) { stage_rc(tid * 16 + i * 8192, Rr[i], Cc[i]); const int Rb = Epi::PERM ? ((Rr[i] & ~31) + perm32(Rr[i] & 31)) : Rr[i];
        voffB[i] = (unsigned)(Rb * K + Cc[i]) * 2u; }
    constexpr size_t kstep = (size_t)(BK * 2);
    constexpr size_t hstep = (size_t)HALF * K * 2;
    const unsigned ldsw = (unsigned)wid * 1024u;
    const int aoff = lds_byte(wr * 64 + fr, fq * 8), boff = lds_byte(wc * 32 + fr, fq * 8);
#define PG8_SA(b, h) (((b) * 2 + (h)) * HTB)
#define PG8_SB(b, h) ((4 + (b) * 2 + (h)) * HTB)
#define PG8_STAGE(bufoff, gbase, voff) do { _Pragma("unroll") for (int _i = 0; _i < 2; ++_i) \
        __builtin_amdgcn_global_load_lds((const unsigned*)((const char*)(gbase) + (voff)[_i]), (LAS unsigned*)(lds + (bufoff) + ldsw + _i * 8192), 16, 0, 0); } while (0)
#define PG8_LDA(dst, b, h) do { _Pragma("unroll") for (int m = 0; m < 4; ++m) _Pragma("unroll") for (int k = 0; k < 2; ++k) dst[m][k] = *(const LAS bf16x8*)(lds + PG8_SA(b, h) + aoff + m * 2048 + k * 1024); } while (0)
#define PG8_LDB(dst, b, h) do { _Pragma("unroll") for (int n = 0; n < 2; ++n) _Pragma("unroll") for (int k = 0; k < 2; ++k) dst[n][k] = *(const LAS bf16x8*)(lds + PG8_SB(b, h) + boff + n * 2048 + k * 1024); } while (0)
#define PG8_MMA(ai, bj, At, Bt) do { __builtin_amdgcn_s_setprio(1); _Pragma("unroll") for (int m = 0; m < 4; ++m) _Pragma("unroll") for (int n = 0; n < 2; ++n) _Pragma("unroll") for (int k = 0; k < 2; ++k) \
        acc[ai][bj][m][n] = __builtin_amdgcn_mfma_f32_16x16x32_bf16(Bt[n][k], At[m][k], acc[ai][bj][m][n], 0, 0, 0); __builtin_amdgcn_s_setprio(0); } while (0)
#define PG8_WAIT_V(n) asm volatile("s_waitcnt vmcnt(" #n ")" ::: "memory")
#define PG8_WAIT_L(n) asm volatile("s_waitcnt lgkmcnt(" #n ")" ::: "memory")
#define PG8_BAR __builtin_amdgcn_s_barrier()
#define PG8_SCHED __builtin_amdgcn_sched_barrier(0)
    Unit cur, nxt; int ui = 0;
    if (!S.next(0, cur)) return;
    S.a_voff(cur, voffA, Rr, Cc);
    f32x4 acc[2][2][4][2];
#pragma unroll
    for (int a = 0; a < 2; ++a)
#pragma unroll
        for (int b = 0; b < 2; ++b)
#pragma unroll
            for (int m = 0; m < 4; ++m)
#pragma unroll
                for (int n = 0; n < 2; ++n) acc[a][b][m][n] = (f32x4){0.f, 0.f, 0.f, 0.f};
    bf16x8 At[4][2], B0[2][2], B1[2][2];
    const char* cA = S.a_ptr(cur); const char* cB = S.b_ptr(cur);
    PG8_STAGE(PG8_SB(0, 0), cB, voffB); PG8_STAGE(PG8_SB(0, 1), cB + hstep, voffB); PG8_STAGE(PG8_SA(0, 0), cA, voffA[0]); PG8_STAGE(PG8_SA(0, 1), cA, voffA[1]);
    if (wr == 1) PG8_BAR;
    PG8_WAIT_V(2); PG8_BAR;
    PG8_STAGE(PG8_SB(1, 0), cB + kstep, voffB); PG8_STAGE(PG8_SA(1, 0), cA + kstep, voffA[0]); PG8_STAGE(PG8_SB(1, 1), cB + hstep + kstep, voffB);
    PG8_WAIT_V(6); PG8_BAR;
    for (;;) {
        const bool has_next = S.next(ui + 1, nxt);
        const char* nA = has_next ? S.a_ptr(nxt) : cA; const char* nB = has_next ? S.b_ptr(nxt) : cB;
        for (int t = 0; t < nt; t += 2) {
            const bool last = (t == nt - 2);
            const char* a1 = cA + (size_t)(t + 1) * kstep;
            const char* a2 = last ? nA : cA + (size_t)(t + 2) * kstep; const char* b2 = last ? nB : cB + (size_t)(t + 2) * kstep;
            const char* a3 = a2 + kstep; const char* b3 = b2 + kstep;
            PG8_LDB(B0, 0, 0); PG8_LDB(B1, 0, 1); PG8_SCHED; PG8_LDA(At, 0, 0); PG8_STAGE(PG8_SA(1, 1), a1, voffA[1]);
            if (Sched::GATHER) { if (last && has_next) S.a_voff(nxt, voffA, Rr, Cc); }
            PG8_WAIT_V(8); PG8_WAIT_L(0); PG8_BAR; PG8_MMA(0, 0, At, B0); PG8_MMA(0, 1, At, B1); PG8_BAR; PG8_SCHED;
            PG8_LDA(At, 0, 1); PG8_STAGE(PG8_SB(0, 0), b2, voffB); PG8_STAGE(PG8_SB(0, 1), b2 + hstep, voffB); PG8_STAGE(PG8_SA(0, 0), a2, voffA[0]);
            PG8_WAIT_V(8); PG8_WAIT_L(0); PG8_BAR; PG8_MMA(1, 0, At, B0); PG8_MMA(1, 1, At, B1); PG8_BAR; PG8_SCHED;
            PG8_LDB(B0, 1, 0); PG8_LDB(B1, 1, 1); PG8_SCHED; PG8_LDA(At, 1, 0); PG8_STAGE(PG8_SA(0, 1), a2, voffA[1]);
            PG8_WAIT_V(8); PG8_WAIT_L(0); PG8_BAR; PG8_MMA(0, 0, At, B0); PG8_MMA(0, 1, At, B1); PG8_BAR; PG8_SCHED;
            PG8_LDA(At, 1, 1); PG8_STAGE(PG8_SB(1, 0), b3, voffB); PG8_STAGE(PG8_SB(1, 1), b3 + hstep, voffB); PG8_STAGE(PG8_SA(1, 0), a3, voffA[0]);
            PG8_WAIT_V(8); PG8_WAIT_L(0); PG8_BAR; PG8_MMA(1, 0, At, B0); PG8_MMA(1, 1, At, B1); PG8_BAR; PG8_SCHED;
        }
        if (wr == 0) PG8_BAR;
        E(acc, cur, wr, wc, fr, fq);
        if (!has_next) break;
#pragma unroll
        for (int a = 0; a < 2; ++a)
#pragma unroll
            for (int b = 0; b < 2; ++b)
#pragma unroll
                for (int m = 0; m < 4; ++m)
#pragma unroll
                    for (int n = 0; n < 2; ++n) acc[a][b][m][n] = (f32x4){0.f, 0.f, 0.f, 0.f};
        cur = nxt; cA = nA; cB = nB; ++ui;
        if (wr == 1) PG8_BAR;
    }
    PG8_WAIT_V(0);
    PG8_BAR;
#undef PG8_SA
#undef PG8_SB
#undef PG8_STAGE
#undef PG8_LDA
#undef PG8_LDB
#undef PG8_MMA
#undef PG8_WAIT_V
#undef PG8_WAIT_L
#undef PG8_BAR
#undef PG8_SCHED
}
}

struct Args { const float* in[33]; float* out; unsigned char* ws; int ph_lo, ph_hi, li, pad; };
enum { I_X = 0, I_C, I_CTX, I_CCTX, I_ADAW, I_ADAB, I_NMG, I_NFG, I_EWIN, I_EBIN, I_ECW, I_ECB, I_ELNG, I_ELNB, I_QNG, I_KNG, I_SINK, I_EWOUT, I_EBOUT,
       I_OWIN, I_OBIN, I_OLNG, I_OLNB, I_OWS, I_OBS, I_OWOUT, I_OBOUT, I_RW, I_RB, I_W1, I_B1, I_W2, I_B2 };

typedef const __attribute__((address_space(4))) unsigned long long* kargp_t;
struct Ctx {
    LAS unsigned char* lds; int tid, lane, wave, G, vcu, gw, NGW; unsigned char* ws; kargp_t kp;
};
__device__ __forceinline__ const float* in_ptr(const Ctx& X, int i) { return (const float*)(const __attribute__((address_space(1))) float*)X.kp[i]; }
#define IN(i) in_ptr(X, (i))

struct DenseSched {
    static constexpr bool GATHER = false;
    const bf16* A; const bf16* Bt; int nM, nN, nwg, G, c;
    const bf16* A2; const bf16* Bt2; int nM2;
    __device__ __forceinline__ void init(const bf16* A_, const bf16* Bt_, int M, int N, int G_, int c_) { A = A_; Bt = Bt_; nM = M / 256; nN = N / 256; nwg = nM * nN; G = G_; c = c_; A2 = nullptr; Bt2 = nullptr; nM2 = 0; }
    __device__ __forceinline__ bool next(int i, pg8::Unit& u) const {
        const int L = i * G + c; if (L >= nwg + nM2) return false;
        if (L >= nwg) { u.pm = L - nwg; u.pn = 0; u.e = 1; u.cnt = 256; return true; }
        int wgid = L; { const int q = nwg / 8, r = nwg % 8, xcd = wgid % 8, off = wgid / 8; wgid = (xcd < r ? xcd * (q + 1) : r * (q + 1) + (xcd - r) * q) + off; }
        const int nig = 8 * nN, gid = wgid / nig, fm = gid * 8, gsz = (nM - fm) < 8 ? (nM - fm) : 8;
        u.pm = fm + ((wgid % nig) % gsz); u.pn = (wgid % nig) / gsz; u.e = 0; u.cnt = 256; return true;
    }
    __device__ __forceinline__ const char* a_ptr(const pg8::Unit& u) const { return (const char*)(u.e ? A2 : A) + (size_t)u.pm * 256 * pg8::KD * 2; }
    __device__ __forceinline__ const char* b_ptr(const pg8::Unit& u) const { return (const char*)(u.e ? Bt2 : Bt) + (size_t)u.pn * 256 * pg8::KD * 2; }
    __device__ __forceinline__ void a_voff(const pg8::Unit&, unsigned (&v)[2][2], const int (&R)[2], const int (&C)[2]) const {
#pragma unroll
        for (int i = 0; i < 2; ++i) { v[0][i] = (unsigned)(R[i] * pg8::KD + C[i]) * 2u; v[1][i] = v[0][i] + (unsigned)(pg8::HALF * pg8::KD * 2); }
    }
};
struct MoeSched {
    const LAS int* tab; int NT, G, c; bool gather;
};
template <bool GATHER_, int NTILE_N>
struct MoeSchedT {
    static constexpr bool GATHER = GATHER_;
    const LAS int* tab; int G, c;
    const bf16* A;
    const bf16* Bt;
    const int* list;
    __device__ __forceinline__ bool next(int i, pg8::Unit& u) const {
        const int L = i * G + c; const int T = tab[0];
        if (L >= T * NTILE_N) return false;
        const int mt = L / NTILE_N; u.pn = L % NTILE_N;
        const int w = __builtin_amdgcn_readfirstlane(tab[1 + mt]); u.e = w >> 16; const int tl = w & 0xffff;
        const int cnt = __builtin_amdgcn_readfirstlane(tab[512 + u.e]), pb = __builtin_amdgcn_readfirstlane(tab[544 + u.e]);
        u.pm = pb + tl * 256; u.cnt = cnt - tl * 256;
        return true;
    }
    __device__ __forceinline__ const char* a_ptr(const pg8::Unit& u) const { return GATHER ? (const char*)A : (const char*)A + (size_t)u.pm * pg8::KD * 2; }
    __device__ __forceinline__ const char* b_ptr(const pg8::Unit& u) const { return (const char*)Bt + ((size_t)u.e * NTILE_N + u.pn) * 256 * pg8::KD * 2; }
    __device__ __forceinline__ void a_voff(const pg8::Unit& u, unsigned (&v)[2][2], const int (&R)[2], const int (&C)[2]) const {
        if (GATHER) {
            const int slot0 = u.pm - tab[544 + u.e];
            const int* lp = list + (size_t)u.e * NTOK + slot0;
#pragma unroll
            for (int h = 0; h < 2; ++h)
#pragma unroll
                for (int i = 0; i < 2; ++i) { const int r = h * 128 + R[i]; const int tok = lp[r < u.cnt ? r : u.cnt - 1] >> 2; v[h][i] = (unsigned)(tok * pg8::KD + C[i]) * 2u; }
        } else {
#pragma unroll
            for (int i = 0; i < 2; ++i) { v[0][i] = (unsigned)(R[i] * pg8::KD + C[i]) * 2u; v[1][i] = v[0][i] + (unsigned)(pg8::HALF * pg8::KD * 2); }
        }
    }
};
__device__ __forceinline__ void moe_build_table(const Ctx& X, const int* cnt  ) {
    LAS int* tab = (LAS int*)(X.lds + TAB_OFF);
    __syncthreads();
    if (X.tid == 0) {
        int T = 0, pb = 0;
        for (int e = 0; e < NE; ++e) { const int c = __hip_atomic_load(cnt + e, __ATOMIC_RELAXED, __HIP_MEMORY_SCOPE_AGENT); const int mt = (c + 255) >> 8;
            tab[512 + e] = c; tab[544 + e] = pb; for (int t = 0; t < mt; ++t) tab[1 + T + t] = (e << 16) | t; T += mt; pb += mt * 256; }
        tab[0] = T;
    }
    __syncthreads();
}

__device__ __forceinline__ f32x2 gelu_pk(f32x2 v) {
    const f32x2 av = __builtin_elementwise_abs(v), d = av * 0.2316418882f + 1.0f;
    f32x2 t; t.x = __builtin_amdgcn_rcpf(d.x); t.y = __builtin_amdgcn_rcpf(d.y);
    f32x2 q = t * 0.5307027145f + (-0.7265760135f); q = q * t + 0.7107068705f; q = q * t + (-0.142248368f); q = q * t + 0.127414796f; q = q * t;
    const f32x2 s = (v * v) * (-0.72134752044f);
    f32x2 e; e.x = __builtin_amdgcn_exp2f(s.x); e.y = __builtin_amdgcn_exp2f(s.y);
    const f32x2 m = v * (q * e), r = v - m;
    f32x2 o; o.x = v.x < 0.f ? m.x : r.x; o.y = v.y < 0.f ? m.y : r.y; return o;
}
__device__ __forceinline__ u32x4 pack8(f32x4 a, f32x4 b) { u32x4 w; w.x = pk2(a[0], a[1]); w.y = pk2(a[2], a[3]); w.z = pk2(b[0], b[1]); w.w = pk2(b[2], b[3]); return w; }

struct EpiIn {
    static constexpr bool PERM = true;
    bf16 *GLU, *Q, *Kb, *Vb, *KC, *VC; const float* bias;
    __device__ __forceinline__ void operator()(const f32x4 (&acc)[2][2][4][2], const pg8::Unit& u, int wr, int wc, int fr, int fq) const {
        const int row0 = u.pm * 256 + wr * 64 + fr; const int c8 = wc * 32 + 8 * fq;
        if (u.e == 0 && u.pn < 4) {
            const int j0 = u.pn * 128 + c8;
            f32x4 bu[2], bg[2];
#pragma unroll
            for (int n = 0; n < 2; ++n) { bu[n] = *(const f32x4*)(bias + j0 + 4 * n); bg[n] = *(const f32x4*)(bias + 512 + j0 + 4 * n); }
#pragma unroll
            for (int ai = 0; ai < 2; ++ai)
#pragma unroll
                for (int m = 0; m < 4; ++m) { f32x4 o[2];
#pragma unroll
                    for (int n = 0; n < 2; ++n) { const f32x4 uu = acc[ai][0][m][n] + bu[n], gg = acc[ai][1][m][n] + bg[n];
#pragma unroll
                        for (int k = 0; k < 4; ++k) o[n][k] = uu[k] * sigmoidf_(gg[k]); }
                    *(u32x4*)(GLU + (size_t)(row0 + ai * 128 + m * 16) * 512 + j0) = pack8(o[0], o[1]); }
        } else {
#pragma unroll
            for (int bj = 0; bj < 2; ++bj) {
                bf16* dst; int ld, col, bcol;
                if (u.pn >= 6 || u.e) { dst = u.e ? (bj ? VC : KC) : (bj ? Vb : Kb); ld = 128; col = c8; bcol = KV_COL + bj * 128 + c8; }
                else { dst = Q; ld = 512; col = (u.pn - 4) * 256 + bj * 128 + c8; bcol = 1024 + col; }
                f32x4 bv[2];
#pragma unroll
                for (int n = 0; n < 2; ++n) bv[n] = *(const f32x4*)(bias + bcol + 4 * n);
#pragma unroll
                for (int ai = 0; ai < 2; ++ai)
#pragma unroll
                    for (int m = 0; m < 4; ++m) *(u32x4*)(dst + (size_t)(row0 + ai * 128 + m * 16) * ld + col) = pack8(acc[ai][bj][m][0] + bv[0], acc[ai][bj][m][1] + bv[1]);
            }
        }
    }
};
struct EpiRes {
    static constexpr bool PERM = false;
    const float* base; float* out; const float* bias; const float* gate;
    __device__ __forceinline__ void operator()(const f32x4 (&acc)[2][2][4][2], const pg8::Unit& u, int wr, int wc, int fr, int fq) const {
        const int col0 = u.pn * 256 + wc * 32 + 4 * fq; const int b = (u.pm * 256) / SEQ;
        f32x4 bv[2][2], gv[2][2];
#pragma unroll
        for (int bj = 0; bj < 2; ++bj)
#pragma unroll
            for (int n = 0; n < 2; ++n) { bv[bj][n] = *(const f32x4*)(bias + col0 + bj * 128 + n * 16); gv[bj][n] = *(const f32x4*)(gate + (size_t)b * MODW + col0 + bj * 128 + n * 16); }
#pragma unroll
        for (int ai = 0; ai < 2; ++ai)
#pragma unroll
            for (int m = 0; m < 4; ++m) { const size_t off = (size_t)(u.pm * 256 + ai * 128 + wr * 64 + m * 16 + fr) * D + col0;
#pragma unroll
                for (int bj = 0; bj < 2; ++bj)
#pragma unroll
                    for (int n = 0; n < 2; ++n) { const f32x4 bs = *(const f32x4*)(base + off + bj * 128 + n * 16); *(f32x4*)(out + off + bj * 128 + n * 16) = bs + gv[bj][n] * (acc[ai][bj][m][n] + bv[bj][n]); } }
    }
};
struct EpiGelu {
    static constexpr bool PERM = true;
    bf16 *U, *V; const float* bias; float* vstat;
    __device__ __forceinline__ void operator()(const f32x4 (&acc)[2][2][4][2], const pg8::Unit& u, int wr, int wc, int fr, int fq) const {
        const int row0 = u.pm * 256 + wr * 64 + fr; const int colt = u.pn * 256; const bool isv = colt >= 1024; bf16* base = isv ? V : U; const int cb = (colt & 1023) + wc * 32 + 8 * fq, bcol = colt + wc * 32 + 8 * fq;
        f32x4 bv[2][2];
#pragma unroll
        for (int bj = 0; bj < 2; ++bj)
#pragma unroll
            for (int n = 0; n < 2; ++n) bv[bj][n] = *(const f32x4*)(bias + bcol + bj * 128 + 4 * n);
#pragma unroll
        for (int ai = 0; ai < 2; ++ai)
#pragma unroll
            for (int m = 0; m < 4; ++m) { const int row = row0 + ai * 128 + m * 16; bf16* rowp = base + (size_t)row * D + cb; float s = 0.f, s2 = 0.f;
#pragma unroll
                for (int bj = 0; bj < 2; ++bj) { f32x4 v0 = acc[ai][bj][m][0] + bv[bj][0], v1 = acc[ai][bj][m][1] + bv[bj][1];
                    f32x2 a = gelu_pk((f32x2){v0[0], v0[1]}), b = gelu_pk((f32x2){v0[2], v0[3]}), c = gelu_pk((f32x2){v1[0], v1[1]}), d = gelu_pk((f32x2){v1[2], v1[3]});
                    s += (a.x + a.y) + (b.x + b.y) + (c.x + c.y) + (d.x + d.y); s2 += (a.x * a.x + a.y * a.y) + (b.x * b.x + b.y * b.y) + (c.x * c.x + c.y * c.y) + (d.x * d.x + d.y * d.y);
                    *(u32x4*)(rowp + bj * 128) = pack8((f32x4){a.x, a.y, b.x, b.y}, (f32x4){c.x, c.y, d.x, d.y}); }
                if (isv) { s += __shfl_xor(s, 16); s += __shfl_xor(s, 32); s2 += __shfl_xor(s2, 16); s2 += __shfl_xor(s2, 32);
                    if (fq == 0) { unsafeAtomicAdd(vstat + 2 * row, s); unsafeAtomicAdd(vstat + 2 * row + 1, s2); } } }
    }
};
struct EpiSwiglu {
    static constexpr bool PERM = true;
    bf16* ACT; const float* b1;
    __device__ __forceinline__ void operator()(const f32x4 (&acc)[2][2][4][2], const pg8::Unit& u, int wr, int wc, int fr, int fq) const {
        const int j0 = u.pn * 128 + wc * 32 + 8 * fq; const float* bb = b1 + (size_t)u.e * 2048;
        f32x4 bg[2], bu[2];
#pragma unroll
        for (int n = 0; n < 2; ++n) { bg[n] = *(const f32x4*)(bb + j0 + 4 * n); bu[n] = *(const f32x4*)(bb + 1024 + j0 + 4 * n); }
#pragma unroll
        for (int ai = 0; ai < 2; ++ai)
#pragma unroll
            for (int m = 0; m < 4; ++m) { f32x4 o[2];
#pragma unroll
                for (int n = 0; n < 2; ++n) { const f32x4 g4 = acc[ai][0][m][n] + bg[n], u4 = acc[ai][1][m][n] + bu[n];
#pragma unroll
                    for (int k = 0; k < 4; ++k) { const float g = fminf(g4[k], 7.0f), up = fminf(fmaxf(u4[k], -7.0f), 7.0f); o[n][k] = (up + 1.0f) * g * sigmoidf_(g * 1.702f); } }
                *(u32x4*)(ACT + (size_t)(u.pm + ai * 128 + wr * 64 + m * 16 + fr) * D + j0) = pack8(o[0], o[1]); }
    }
};
struct EpiDown {
    static constexpr bool PERM = true;
    bf16* Y; const float* b2; const int* list; const float* gatew; const LAS int* tab;
    __device__ __forceinline__ void operator()(const f32x4 (&acc)[2][2][4][2], const pg8::Unit& u, int wr, int wc, int fr, int fq) const {
        const int c8 = u.pn * 256 + wc * 32 + 8 * fq; const float* bb = b2 + (size_t)u.e * D;
        const int slot0 = u.pm - tab[544 + u.e]; const int* lp = list + (size_t)u.e * NTOK + slot0;
        int aid[2][4]; float gw[2][4];
#pragma unroll
        for (int ai = 0; ai < 2; ++ai)
#pragma unroll
            for (int m = 0; m < 4; ++m) { const int r = ai * 128 + wr * 64 + m * 16 + fr; aid[ai][m] = lp[r < u.cnt ? r : u.cnt - 1]; }
#pragma unroll
        for (int ai = 0; ai < 2; ++ai)
#pragma unroll
            for (int m = 0; m < 4; ++m) { gw[ai][m] = gatew[aid[ai][m]]; }
#pragma unroll
        for (int ai = 0; ai < 2; ++ai)
#pragma unroll
            for (int m = 0; m < 4; ++m) asm volatile("" : "+v"(aid[ai][m]), "+v"(gw[ai][m]));
#pragma unroll
        for (int bj = 0; bj < 2; ++bj) {
            f32x4 bv[2];
#pragma unroll
            for (int n = 0; n < 2; ++n) bv[n] = *(const f32x4*)(bb + c8 + bj * 128 + 4 * n);
            asm volatile("" : "+v"(bv[0]), "+v"(bv[1]));
#pragma unroll
            for (int ai = 0; ai < 2; ++ai)
#pragma unroll
                for (int m = 0; m < 4; ++m) { const int r = ai * 128 + wr * 64 + m * 16 + fr; const float g = gw[ai][m];
                    const u32x4 w = pack8((acc[ai][bj][m][0] + bv[0]) * g, (acc[ai][bj][m][1] + bv[1]) * g);
                    if (r < u.cnt) *(u32x4*)(Y + (size_t)aid[ai][m] * D + c8 + bj * 128) = w; }
        }
    }
};

struct TrItem { const float* src; bf16* dst; int N; };
__device__ __forceinline__ void tr_load(const TrItem& t, float (&v)[32], int lane) {
#pragma unroll
    for (int i = 0; i < 32; ++i) v[i] = t.src[(size_t)(2 * i + (lane >> 5)) * t.N + (lane & 31)];
}
__device__ __forceinline__ void tr_store(const TrItem& t, const float (&v)[32], LAS float* scr, int lane) {
#pragma unroll
    for (int i = 0; i < 32; ++i) scr[(2 * i + (lane >> 5)) * 33 + (lane & 31)] = v[i];
    LDS_WAIT();
    const int c = lane & 7;
#pragma unroll
    for (int j = 0; j < 4; ++j) { const int n = (lane >> 3) + 8 * j; const LAS float* s = scr + (8 * c) * 33 + n;
        u32x4 o; o.x = pk2(s[0 * 33], s[1 * 33]); o.y = pk2(s[2 * 33], s[3 * 33]); o.z = pk2(s[4 * 33], s[5 * 33]); o.w = pk2(s[6 * 33], s[7 * 33]);
        *(u32x4*)(t.dst + (size_t)n * 1024 + 8 * c) = o; }
    LDS_WAIT();
}
__device__ __forceinline__ int pair_src(int nd, int halfw) { return ((nd & 255) >> 7) * halfw + (nd >> 8) * 128 + (nd & 127); }

__device__ __forceinline__ void phase_prologue(const Args& a, const Ctx& X) {
    {
        LAS float* sc = (LAS float*)X.lds;
        LAS float* red = (LAS float*)(X.lds + 36864);
        float* MOD = (float*)(X.ws + WS_MOD);
        for (int item = blockIdx.x; item < 2 * 96; item += X.G) {
            const int l = item / 96, j0 = (item % 96) * 64;
            for (int idx = X.tid; idx < 9 * 1024; idx += NTHREADS) { const int r = idx >> 10, k = idx & 1023; const float v = r < 8 ? IN(I_C)[r * 1024 + k] : IN(I_CCTX)[k]; sc[idx] = v * sigmoidf_(v); }
            __syncthreads();
            float acc[9];
#pragma unroll
            for (int r = 0; r < 9; ++r) acc[r] = 0.f;
            const float* w = IN(I_ADAW) + (size_t)l * 1024 * MODW + j0 + X.lane;
#pragma unroll 8
            for (int k = X.wave * 128; k < X.wave * 128 + 128; ++k) { const float wv = w[(size_t)k * MODW];
#pragma unroll
                for (int r = 0; r < 9; ++r) acc[r] += sc[r * 1024 + k] * wv; }
#pragma unroll
            for (int r = 0; r < 9; ++r) red[(X.wave * 9 + r) * 64 + X.lane] = acc[r];
            __syncthreads();
            for (int t = X.tid; t < 9 * 64; t += NTHREADS) { const int r = t >> 6, cidx = t & 63; float s = 0.f;
#pragma unroll
                for (int w8 = 0; w8 < 8; ++w8) s += red[(w8 * 9 + r) * 64 + cidx];
                MOD[((size_t)l * 9 + r) * MODW + j0 + cidx] = s + IN(I_ADAB)[l * MODW + j0 + cidx]; }
            __syncthreads();
        }
    }
    LAS float* scr = (LAS float*)(X.lds + X.wave * 16384);
    bf16* WinT = (bf16*)(X.ws + WS_WINT); bf16* WoutT = (bf16*)(X.ws + WS_WOUTT); bf16* GWinT = (bf16*)(X.ws + WS_GWINT); bf16* GWoutT = (bf16*)(X.ws + WS_GWOUTT);
    bf16* W1T = (bf16*)(X.ws + WS_W1T); bf16* W2T = (bf16*)(X.ws + WS_W2T);
    constexpr int I_IN = 16 * (EVEN_IN / 32), I_OUT = 16 * 32, I_GIN = 16 * 64, I_GOUT = 16 * 32, I_M1 = 64 * 16 * 64, I_M2 = 64 * 16 * 32;
    constexpr int NITEMS = I_IN + I_OUT + I_GIN + I_GOUT + I_M1 + I_M2;
    auto item_of = [&](int it) -> TrItem {
        int r = it; TrItem t;
        if (r < I_M1) { const int mat = r >> 10, q = r & 1023, kb = q >> 6, nd = (q & 63) * 32; t.N = 2048; t.src = IN(I_W1) + (size_t)mat * 1024 * 2048 + (size_t)kb * 64 * 2048 + pair_src(nd, 1024); t.dst = W1T + (size_t)mat * 2048 * 1024 + (size_t)nd * 1024 + kb * 64; return t; } r -= I_M1;
        if (r < I_M2) { const int mat = r >> 9, q = r & 511, kb = q >> 5, nd = (q & 31) * 32; t.N = 1024; t.src = IN(I_W2) + (size_t)mat * 1024 * 1024 + (size_t)kb * 64 * 1024 + nd; t.dst = W2T + (size_t)mat * 1024 * 1024 + (size_t)nd * 1024 + kb * 64; return t; } r -= I_M2;
        if (r < I_IN) { const int kb = r / 56, nd = (r % 56) * 32; const int ns = nd < 1024 ? pair_src(nd, 512) : nd; t.N = EVEN_IN; t.src = IN(I_EWIN) + (size_t)kb * 64 * EVEN_IN + ns; t.dst = WinT + (size_t)nd * 1024 + kb * 64; return t; } r -= I_IN;
        if (r < I_OUT) { const int kb = r >> 5, nd = (r & 31) * 32; t.N = 1024; t.src = IN(I_EWOUT) + (size_t)kb * 64 * 1024 + nd; t.dst = WoutT + (size_t)nd * 1024 + kb * 64; return t; } r -= I_OUT;
        if (r < I_GIN) { const int kb = r >> 6, nd = (r & 63) * 32; t.N = 2048; t.src = IN(I_OWIN) + (size_t)kb * 64 * 2048 + nd; t.dst = GWinT + (size_t)nd * 1024 + kb * 64; return t; } r -= I_GIN;
        { const int kb = r >> 5, nd = (r & 31) * 32; t.N = 1024; t.src = IN(I_OWOUT) + (size_t)kb * 64 * 1024 + nd; t.dst = GWoutT + (size_t)nd * 1024 + kb * 64; return t; }
    };
    {
        float va[32], vb[32]; int it = X.gw;
        TrItem ta, tb; if (it < NITEMS) { ta = item_of(it); tr_load(ta, va, X.lane); }
        while (it < NITEMS) {
            const int it1 = it + X.NGW; if (it1 < NITEMS) { tb = item_of(it1); tr_load(tb, vb, X.lane); }
            tr_store(ta, va, scr, X.lane);
            if (it1 >= NITEMS) break;
            const int it2 = it1 + X.NGW; if (it2 < NITEMS) { ta = item_of(it2); tr_load(ta, va, X.lane); }
            tr_store(tb, vb, scr, X.lane);
            it = it2;
        }
    }
    { bf16* WsB = (bf16*)(X.ws + WS_WSB); const float* ws = IN(I_OWS);
      for (int i = (X.gw * 64 + X.lane) * 4; i < 8 * 128 * 128; i += X.NGW * 64 * 4) { const f32x4 v = *(const f32x4*)(ws + i); u32x2 o; o.x = pk2(v[0], v[1]); o.y = pk2(v[2], v[3]); *(u32x2*)(WsB + i) = o; } }
}

__device__ __forceinline__ void modulate_row(const float* xrow, const float* g, const float* sh, const float* sc, bf16* orow, int lane, f32x4 (&y)[4]) {
    const f32x4* xr = (const f32x4*)xrow + lane; f32x4 v[4]; float ss = 0.f;
#pragma unroll
    for (int j = 0; j < 4; ++j) { v[j] = xr[64 * j]; ss += (v[j][0] * v[j][0] + v[j][1] * v[j][1]) + (v[j][2] * v[j][2] + v[j][3] * v[j][3]); }
    const float rstd = rsqrtf(wave_sum(ss) * (1.0f / D) + EPS);
#pragma unroll
    for (int j = 0; j < 4; ++j) { const f32x4 gk = ((const f32x4*)g)[lane + 64 * j], sk = ((const f32x4*)sc)[lane + 64 * j], hk = ((const f32x4*)sh)[lane + 64 * j];
        y[j] = v[j] * rstd * gk * (1.0f + sk) + hk;
        u32x2 o; o.x = pk2(y[j][0], y[j][1]); o.y = pk2(y[j][2], y[j][3]); *((u32x2*)orow + lane + 64 * j) = o; }
}
__device__ __forceinline__ void phase_modulate0(const Args& a, const Ctx& X) {
    const float* MOD0 = (const float*)(X.ws + WS_MOD); f32x4 y[4];
    bf16* XA = (bf16*)(X.ws + WS_XA); bf16* GM = (bf16*)(X.ws + WS_GM);
    for (int row = X.gw; row < NTOK + NCTX; row += X.NGW) {
        if (row < NTOK) { const float* m = MOD0 + (size_t)(row / SEQ) * MODW; modulate_row(IN(I_X) + (size_t)row * D, IN(I_NMG), m, m + 1024, XA + (size_t)row * D, X.lane, y); }
        else { const int r = row - NTOK; const float* m = MOD0 + (size_t)8 * MODW; modulate_row(IN(I_CTX) + (size_t)r * D, IN(I_NMG), m, m + 1024, GM + (size_t)r * D, X.lane, y); }
    }
}

__device__ __forceinline__ void qk_chunks(bf16* buf, int nchunks, int rowlen, const float* gn, bool rope, float oscale, const Ctx& X) {
    for (int ch = X.gw; ch < nchunks; ch += X.NGW) {
        const int e0 = ch * 512 + 8 * X.lane; const int token = e0 / rowlen; const int d0 = e0 & 63;
        u32x4 raw = *(const u32x4*)(buf + e0); float v[8];
#pragma unroll
        for (int i = 0; i < 4; ++i) { v[2 * i] = bf2f(raw[i] & 0xffffu); v[2 * i + 1] = bf2f(raw[i] >> 16); }
        float ss = 0.f;
#pragma unroll
        for (int i = 0; i < 8; ++i) ss += v[i] * v[i];
        ss += __shfl_xor(ss, 1); ss += __shfl_xor(ss, 2); ss += __shfl_xor(ss, 4);
        const float rstd = rsqrtf(ss * (1.0f / 64.0f) + EPS);
#pragma unroll
        for (int i = 0; i < 8; ++i) v[i] = v[i] * rstd * gn[d0 + i];
        if (rope) {
            const int t = token % SEQ; const float rowp = (float)(t >> 6), colp = (float)(t & 63);
#pragma unroll
            for (int i = 0; i < 8; ++i) { const float pv = __shfl_xor(v[i], 4); const int dd = (d0 + i) & 31;
                const float inv = exp2f(-(float)(dd & 15) * (13.287712379549449f / 16.0f)); const float ang = (dd < 16 ? rowp : colp) * inv;
                float sn, cs; sincosf(ang, &sn, &cs);
                v[i] = (d0 < 32) ? (v[i] * cs - pv * sn) : (v[i] * cs + pv * sn); }
        }
        u32x4 o; o.x = pk2(v[0] * oscale, v[1] * oscale); o.y = pk2(v[2] * oscale, v[3] * oscale); o.z = pk2(v[4] * oscale, v[5] * oscale); o.w = pk2(v[6] * oscale, v[7] * oscale);
        *(u32x4*)(buf + e0) = o;
    }
}
__device__ __forceinline__ void phase_conv_qk(const Args& a, const Ctx& X) {
    qk_chunks((bf16*)(X.ws + WS_Q), NTOK, 512, IN(I_QNG), true, QSCALE, X);
    qk_chunks((bf16*)(X.ws + WS_K), NTOK / 4, 128, IN(I_KNG), true, 1.0f, X);
    qk_chunks((bf16*)(X.ws + WS_KC), NCTX / 4, 128, IN(I_KNG), false, 1.0f, X);
    const bf16* GLU = (const bf16*)(X.ws + WS_GLU); bf16* MIX = (bf16*)(X.ws + WS_MIX);
    LAS unsigned* tin = (LAS unsigned*)X.lds;
    LAS float* tout = (LAS float*)(X.lds + 65536);
    const int cp = X.tid & 255, th = X.tid >> 8;
    float w0[31], w1[31];
#pragma unroll
    for (int j = 0; j < 31; ++j) { const f32x2 w = *(const f32x2*)(IN(I_ECW) + j * 512 + 2 * cp); w0[j] = w.x; w1[j] = w.y; }
    const f32x2 cb = *(const f32x2*)(IN(I_ECB) + 2 * cp);
    for (int tile = blockIdx.x; tile < NTOK / 32; tile += X.G) {
        const int row0 = tile * 32; const int t0 = row0 % SEQ;
        __syncthreads();
        for (int c = X.tid; c < 62 * 64; c += NTHREADS) { const int lr = c >> 6, cc = c & 63; const int t = t0 - 15 + lr;
            u32x4 v = (u32x4){0u, 0u, 0u, 0u}; if (t >= 0 && t < SEQ) v = *(const u32x4*)(GLU + (size_t)(row0 - 15 + lr) * 512 + cc * 8);
            *(LAS u32x4*)(tin + lr * 256 + cc * 4) = v; }
        __syncthreads();
        float a0[16], a1[16];
#pragma unroll
        for (int o = 0; o < 16; ++o) { a0[o] = cb.x; a1[o] = cb.y; }
#pragma unroll
        for (int rr = 0; rr < 46; ++rr) { const unsigned pv = tin[(16 * th + rr) * 256 + cp]; const float x0 = bf2f(pv & 0xffffu), x1 = bf2f(pv >> 16);
#pragma unroll
            for (int o = 0; o < 16; ++o) { const int j = rr - o; if (j >= 0 && j <= 30) { a0[o] += x0 * w0[j]; a1[o] += x1 * w1[j]; } } }
#pragma unroll
        for (int o = 0; o < 16; ++o) *(LAS f32x2*)(tout + (16 * th + o) * 512 + 2 * cp) = (f32x2){a0[o], a1[o]};
        __syncthreads();
#pragma unroll
        for (int q = 0; q < 4; ++q) { const int tl = X.wave * 4 + q; f32x4 v[2]; float s = 0.f;
#pragma unroll
            for (int j = 0; j < 2; ++j) { v[j] = *(const LAS f32x4*)(tout + tl * 512 + 4 * X.lane + 256 * j); s += (v[j][0] + v[j][1]) + (v[j][2] + v[j][3]); }
            const float mean = wave_sum(s) * (1.0f / 512.0f); float s2 = 0.f;
#pragma unroll
            for (int j = 0; j < 2; ++j) { v[j] = v[j] - mean; s2 += (v[j][0] * v[j][0] + v[j][1] * v[j][1]) + (v[j][2] * v[j][2] + v[j][3] * v[j][3]); }
            const float rstd = rsqrtf(wave_sum(s2) * (1.0f / 512.0f) + EPS);
#pragma unroll
            for (int j = 0; j < 2; ++j) { const f32x4 g = *(const f32x4*)(IN(I_ELNG) + 4 * X.lane + 256 * j), b = *(const f32x4*)(IN(I_ELNB) + 4 * X.lane + 256 * j);
                f32x4 y = v[j] * rstd * g + b;
#pragma unroll
                for (int k = 0; k < 4; ++k) y[k] = y[k] * sigmoidf_(y[k]);
                u32x2 o; o.x = pk2(y[0], y[1]); o.y = pk2(y[2], y[3]); *(u32x2*)(MIX + (size_t)(row0 + tl) * D + 4 * X.lane + 256 * j) = o; } }
    }
}

__device__ __forceinline__ void phase_attention(const Args& a, const Ctx& X) {
    const bf16* QN = (const bf16*)(X.ws + WS_Q); const bf16* KN = (const bf16*)(X.ws + WS_K); const bf16* VV = (const bf16*)(X.ws + WS_V);
    const bf16* KC = (const bf16*)(X.ws + WS_KC); const bf16* VC = (const bf16*)(X.ws + WS_VC); bf16* MIX = (bf16*)(X.ws + WS_MIX);
    LAS unsigned char* Ks = X.lds;
    LAS unsigned char* Vt = X.lds + 16384;
    const int lane = X.lane, l15 = lane & 15, g4 = lane >> 4;
    for (int unit = blockIdx.x; unit < NB * 2 * 32; unit += X.G) {
        const int b = unit >> 6, kh = (unit >> 5) & 1, qb = unit & 31; const int q0 = qb * 64;
        const int hq = kh * 4 + (X.wave >> 1), tq = (X.wave & 1) * 32;
        bf16x8 Qf[2][2];
#pragma unroll
        for (int qi = 0; qi < 2; ++qi)
#pragma unroll
            for (int s = 0; s < 2; ++s) Qf[qi][s] = *(const bf16x8*)(QN + (size_t)(b * SEQ + q0 + tq + 16 * qi + l15) * 512 + hq * 64 + 32 * s + 8 * g4);
        const float sink2 = IN(I_SINK)[hq] * LOG2E;
        float mrun[2], lrun[2]; f32x4 O[2][4];
#pragma unroll
        for (int qi = 0; qi < 2; ++qi) { mrun[qi] = sink2; lrun[qi] = (g4 == 0) ? 1.0f : 0.0f;
#pragma unroll
            for (int db = 0; db < 4; ++db) O[qi][db] = (f32x4){0.f, 0.f, 0.f, 0.f}; }
        for (int t = 0; t < 9; ++t) {
            const bf16* kp; const bf16* vp; int mode = 0;
            if (t < 5) { const int ks = q0 - 128 + 64 * t; if (ks < 0 || ks >= SEQ) continue; kp = KN + (size_t)(b * SEQ + ks) * 128 + kh * 64; vp = VV + (size_t)(b * SEQ + ks) * 128 + kh * 64; mode = (t == 0) ? 1 : (t == 4 ? 2 : 0); }
            else { const int ks = (t - 5) * 64; kp = KC + (size_t)(b * CTXL + ks) * 128 + kh * 64; vp = VC + (size_t)(b * CTXL + ks) * 128 + kh * 64; }
            __syncthreads();
            { const int key = X.tid >> 3, ch = X.tid & 7;
              const u32x4 kv = *(const u32x4*)(kp + (size_t)key * 128 + ch * 8); *(LAS u32x4*)(Ks + key * 144 + ch * 16) = kv;
              const u32x4 vv = *(const u32x4*)(vp + (size_t)key * 128 + ch * 8);
#pragma unroll
              for (int i = 0; i < 4; ++i) { *(LAS unsigned short*)(Vt + (8 * ch + 2 * i) * 136 + key * 2) = (unsigned short)(vv[i] & 0xffffu); *(LAS unsigned short*)(Vt + (8 * ch + 2 * i + 1) * 136 + key * 2) = (unsigned short)(vv[i] >> 16); } }
            __syncthreads();
            bf16x8 kf[4][2];
#pragma unroll
            for (int kb = 0; kb < 4; ++kb)
#pragma unroll
                for (int s = 0; s < 2; ++s) kf[kb][s] = *(const LAS bf16x8*)(Ks + (16 * kb + l15) * 144 + (32 * s + 8 * g4) * 2);
            bf16x8 vf[4][2];
#pragma unroll
            for (int db = 0; db < 4; ++db)
#pragma unroll
                for (int ks2 = 0; ks2 < 2; ++ks2) { const LAS unsigned char* p = Vt + (16 * db + l15) * 136 + (32 * ks2 + 4 * g4) * 2;
                    const u32x2 lo = *(const LAS u32x2*)p, hi = *(const LAS u32x2*)(p + 32);
                    u32x4 w; w.x = lo.x; w.y = lo.y; w.z = hi.x; w.w = hi.y; vf[db][ks2] = __builtin_bit_cast(bf16x8, w); }
#pragma unroll
            for (int qi = 0; qi < 2; ++qi) {
                f32x4 st[4];
#pragma unroll
                for (int kb = 0; kb < 4; ++kb) { st[kb] = (f32x4){0.f, 0.f, 0.f, 0.f};
#pragma unroll
                    for (int s = 0; s < 2; ++s) st[kb] = __builtin_amdgcn_mfma_f32_16x16x32_bf16(kf[kb][s], Qf[qi][s], st[kb], 0, 0, 0); }
                if (mode) { const int qloc = tq + 16 * qi + l15;
#pragma unroll
                    for (int kb = 0; kb < 4; ++kb)
#pragma unroll
                        for (int r = 0; r < 4; ++r) { const int kk = 16 * kb + 4 * g4 + r; const bool keep = (mode == 1) ? (kk >= qloc) : (kk <= qloc); if (!keep) st[kb][r] = -1e30f; } }
                float mx = st[0][0];
#pragma unroll
                for (int kb = 0; kb < 4; ++kb)
#pragma unroll
                    for (int r = 0; r < 4; ++r) mx = fmaxf(mx, st[kb][r]);
                mx = fmaxf(mx, __shfl_xor(mx, 16)); mx = fmaxf(mx, __shfl_xor(mx, 32));
                const float mnew = fmaxf(mrun[qi], mx); const float alpha = __builtin_amdgcn_exp2f(mrun[qi] - mnew); mrun[qi] = mnew;
                float ps = 0.f;
#pragma unroll
                for (int kb = 0; kb < 4; ++kb)
#pragma unroll
                    for (int r = 0; r < 4; ++r) { st[kb][r] = __builtin_amdgcn_exp2f(st[kb][r] - mnew); ps += st[kb][r]; }
                lrun[qi] = lrun[qi] * alpha + ps;
#pragma unroll
                for (int db = 0; db < 4; ++db) O[qi][db] = O[qi][db] * alpha;
#pragma unroll
                for (int ks2 = 0; ks2 < 2; ++ks2) { u32x4 w; w.x = pk2(st[2 * ks2][0], st[2 * ks2][1]); w.y = pk2(st[2 * ks2][2], st[2 * ks2][3]); w.z = pk2(st[2 * ks2 + 1][0], st[2 * ks2 + 1][1]); w.w = pk2(st[2 * ks2 + 1][2], st[2 * ks2 + 1][3]);
                    const bf16x8 pf = __builtin_bit_cast(bf16x8, w);
#pragma unroll
                    for (int db = 0; db < 4; ++db) O[qi][db] = __builtin_amdgcn_mfma_f32_16x16x32_bf16(vf[db][ks2], pf, O[qi][db], 0, 0, 0); }
            }
        }
#pragma unroll
        for (int qi = 0; qi < 2; ++qi) { float l = lrun[qi]; l += __shfl_xor(l, 16); l += __shfl_xor(l, 32); const float inv = 1.0f / l;
            bf16* orow = MIX + (size_t)(b * SEQ + q0 + tq + 16 * qi + l15) * D + 512 + hq * 64 + 4 * g4;
#pragma unroll
            for (int db = 0; db < 4; ++db) { u32x2 o; o.x = pk2(O[qi][db][0] * inv, O[qi][db][1] * inv); o.y = pk2(O[qi][db][2] * inv, O[qi][db][3] * inv); *(u32x2*)(orow + 16 * db) = o; } }
    }
}

__device__ __forceinline__ void phase_router(const Args& a, const Ctx& X, int layer) {
    const float* __restrict__ H = (const float*)(X.ws + WS_H); bf16* XA = (bf16*)(X.ws + WS_XA);
    const float* MODl = (const float*)(X.ws + WS_MOD) + (size_t)layer * 9 * MODW; const float* gn = IN(I_NFG) + layer * D;
    const float* rw = IN(I_RW) + (size_t)layer * D * NE; const float* rb = IN(I_RB) + layer * NE;
    int* cntg = (int*)(X.ws + WS_CTL) + CW_CNT + layer * NE; int* list = (int*)(X.ws + WS_LIST); float* gatew = (float*)(X.ws + WS_GATE);
    LAS float* ybuf = (LAS float*)X.lds;
    LAS float* part = (LAS float*)(X.lds + 65536);
    LAS int* sel = (LAS int*)(X.lds + 65536 + 16384);
    LAS int* lcnt = (LAS int*)(X.lds + 65536 + 16384 + 1024);
    const int e = X.lane & 31, hf = X.lane >> 5;
    float wreg[64];
#pragma unroll
    for (int i = 0; i < 64; ++i) wreg[i] = rw[(size_t)(128 * X.wave + 64 * hf + i) * NE + e];
    const float rbe = rb[e];
    for (int blk = blockIdx.x; blk < NTOK / 64; blk += X.G) {
        const int rowbase = blk * 64; const float* m = MODl + (size_t)(rowbase / SEQ) * MODW;
        f32x4 gk[4], sk[4], hk[4], xv[2][4];
#pragma unroll
        for (int j = 0; j < 4; ++j) { gk[j] = ((const f32x4*)gn)[X.lane + 64 * j]; hk[j] = ((const f32x4*)(m + 3 * 1024))[X.lane + 64 * j]; sk[j] = ((const f32x4*)(m + 4 * 1024))[X.lane + 64 * j]; }
#pragma unroll
        for (int i = 0; i < 2; ++i)
#pragma unroll
            for (int j = 0; j < 4; ++j) xv[i][j] = ((const f32x4*)(H + (size_t)(rowbase + 2 * X.wave + i) * D))[X.lane + 64 * j];
        __syncthreads();
        if (X.tid < 64) lcnt[X.tid] = 0;
        for (int bt = 0; bt < 4; ++bt) {
#pragma unroll
            for (int i = 0; i < 2; ++i) { const int rl = 2 * X.wave + i, row = rowbase + 16 * bt + rl; float ss = 0.f;
#pragma unroll
                for (int j = 0; j < 4; ++j) ss += (xv[i][j][0] * xv[i][j][0] + xv[i][j][1] * xv[i][j][1]) + (xv[i][j][2] * xv[i][j][2] + xv[i][j][3] * xv[i][j][3]);
                const float rstd = rsqrtf(wave_sum(ss) * (1.0f / D) + EPS);
#pragma unroll
                for (int j = 0; j < 4; ++j) { const f32x4 y = xv[i][j] * rstd * gk[j] * (1.0f + sk[j]) + hk[j];
                    u32x2 o; o.x = pk2(y[0], y[1]); o.y = pk2(y[2], y[3]); *((u32x2*)(XA + (size_t)row * D) + X.lane + 64 * j) = o;
                    *(LAS f32x4*)(ybuf + rl * 1024 + 4 * X.lane + 256 * j) = y; } }
            if (bt < 3) {
#pragma unroll
                for (int i = 0; i < 2; ++i)
#pragma unroll
                    for (int j = 0; j < 4; ++j) xv[i][j] = ((const f32x4*)(H + (size_t)(rowbase + 16 * (bt + 1) + 2 * X.wave + i) * D))[X.lane + 64 * j];
            }
            __syncthreads();
            for (int r = 0; r < 16; ++r) { float acc = 0.f; const LAS float* yp = ybuf + r * 1024 + 128 * X.wave + 64 * hf;
#pragma unroll
                for (int i4 = 0; i4 < 16; ++i4) { const f32x4 yv = *(const LAS f32x4*)(yp + 4 * i4); acc += yv[0] * wreg[4 * i4] + yv[1] * wreg[4 * i4 + 1] + yv[2] * wreg[4 * i4 + 2] + yv[3] * wreg[4 * i4 + 3]; }
                acc += __shfl_xor(acc, 32);
                if (hf == 0) part[(r * 8 + X.wave) * 32 + e] = acc; }
            __syncthreads();
            { const int r = 2 * X.wave + hf, rl = 16 * bt + r;
              float v = rbe;
#pragma unroll
              for (int w8 = 0; w8 < 8; ++w8) v += part[(r * 8 + w8) * 32 + e];
              float tv[4]; int ti[4];
#pragma unroll
              for (int k = 0; k < 4; ++k) { float bv = v; int bi = e;
#pragma unroll
                  for (int off = 16; off >= 1; off >>= 1) { const float ov = __shfl_xor(bv, off); const int oi = __shfl_xor(bi, off); if (ov > bv || (ov == bv && oi < bi)) { bv = ov; bi = oi; } }
                  tv[k] = bv; ti[k] = bi; if (e == bi) v = -3.0e38f; }
              float ex[4], sum = 0.f;
#pragma unroll
              for (int k = 0; k < 4; ++k) { ex[k] = __expf(tv[k] - tv[0]); sum += ex[k]; }
              const float inv = 1.0f / sum;
              if (e < 4) { const int ek = e == 0 ? ti[0] : e == 1 ? ti[1] : e == 2 ? ti[2] : ti[3]; const float gk_ = (e == 0 ? ex[0] : e == 1 ? ex[1] : e == 2 ? ex[2] : ex[3]) * inv;
                  const int rank = atomicAdd((int*)&lcnt[ek], 1); sel[rl * 4 + e] = (ek << 16) | rank; gatew[(size_t)(rowbase + rl) * 4 + e] = gk_; } }
        }
        __syncthreads();
        if (X.tid < 32) lcnt[32 + X.tid] = atomicAdd(cntg + X.tid, lcnt[X.tid]);
        __syncthreads();
        if (X.tid < 256) { const int w = sel[X.tid]; const int ee = w >> 16, rank = w & 0xffff; list[(size_t)ee * NTOK + lcnt[32 + ee] + rank] = rowbase * 4 + X.tid; }
    }
}

__device__ __forceinline__ void phase_combine(const Args& a, const Ctx& X, int layer) {
    float* H = (float*)(X.ws + WS_H); const bf16* __restrict__ Y = (const bf16*)(X.ws + WS_Y); bf16* XA = (bf16*)(X.ws + WS_XA);
    const float* __restrict__ MODl = (const float*)(X.ws + WS_MOD) + (size_t)layer * 9 * MODW;
    float* outp = (float*)(__attribute__((address_space(1))) float*)X.kp[33];
    for (int row = X.gw; row < NTOK; row += X.NGW) {
        const float* gt = MODl + (size_t)(row / SEQ) * MODW + 5 * 1024; f32x4 h[2][2], g[2][2]; u32x4 yw[2][4];
#pragma unroll
        for (int j = 0; j < 2; ++j) { const int c0 = 8 * X.lane + 512 * j;
#pragma unroll
            for (int q = 0; q < 2; ++q) { h[j][q] = *(const f32x4*)(H + (size_t)row * D + c0 + 4 * q); g[j][q] = *(const f32x4*)(gt + c0 + 4 * q); }
#pragma unroll
            for (int k = 0; k < 4; ++k) yw[j][k] = *(const u32x4*)(Y + ((size_t)row * 4 + k) * D + c0); }
        float ss = 0.f;
#pragma unroll
        for (int j = 0; j < 2; ++j) { f32x4 s0 = (f32x4){0.f, 0.f, 0.f, 0.f}, s1 = s0;
#pragma unroll
            for (int k = 0; k < 4; ++k) { const u32x4 w = yw[j][k]; s0 += (f32x4){bf2f(w.x & 0xffffu), bf2f(w.x >> 16), bf2f(w.y & 0xffffu), bf2f(w.y >> 16)}; s1 += (f32x4){bf2f(w.z & 0xffffu), bf2f(w.z >> 16), bf2f(w.w & 0xffffu), bf2f(w.w >> 16)}; }
            h[j][0] = h[j][0] + g[j][0] * s0; h[j][1] = h[j][1] + g[j][1] * s1;
#pragma unroll
            for (int q = 0; q < 2; ++q) ss += (h[j][q][0] * h[j][q][0] + h[j][q][1] * h[j][q][1]) + (h[j][q][2] * h[j][q][2] + h[j][q][3] * h[j][q][3]); }
        if (layer == 1) {
#pragma unroll
            for (int j = 0; j < 2; ++j)
#pragma unroll
                for (int q = 0; q < 2; ++q) *(f32x4*)(outp + (size_t)row * D + 8 * X.lane + 512 * j + 4 * q) = h[j][q];
        } else {
            const float* m1 = (const float*)(X.ws + WS_MOD) + (size_t)9 * MODW + (size_t)(row / SEQ) * MODW; const float* gn = IN(I_NMG) + D;
            f32x4 gk[2][2], hk[2][2], sk[2][2];
#pragma unroll
            for (int j = 0; j < 2; ++j)
#pragma unroll
                for (int q = 0; q < 2; ++q) { const int c0 = 8 * X.lane + 512 * j + 4 * q; gk[j][q] = *(const f32x4*)(gn + c0); hk[j][q] = *(const f32x4*)(m1 + c0); sk[j][q] = *(const f32x4*)(m1 + 1024 + c0); }
            const float rstd = rsqrtf(wave_sum(ss) * (1.0f / D) + EPS);
#pragma unroll
            for (int j = 0; j < 2; ++j) { const int c0 = 8 * X.lane + 512 * j;
                const f32x4 y0 = h[j][0] * rstd * gk[j][0] * (1.0f + sk[j][0]) + hk[j][0], y1 = h[j][1] * rstd * gk[j][1] * (1.0f + sk[j][1]) + hk[j][1];
                *(f32x4*)(H + (size_t)row * D + c0) = h[j][0]; *(f32x4*)(H + (size_t)row * D + c0 + 4) = h[j][1];
                *(u32x4*)(XA + (size_t)row * D + c0) = pack8(y0, y1); }
        }
    }
}

__device__ __forceinline__ void phase_spatial(const Args& a, const Ctx& X) {
    const bf16* U = (const bf16*)(X.ws + WS_U); const bf16* VB = (const bf16*)(X.ws + WS_VB); bf16* SG = (bf16*)(X.ws + WS_MIX); const bf16* WsB = (const bf16*)(X.ws + WS_WSB); const float* vstat = (const float*)(X.ws + WS_CTL) + CW_VSTAT;
    LAS float* stat = (LAS float*)X.lds;
    LAS unsigned char* Vt = X.lds + 4096;
    const int lane = X.lane, l15 = lane & 15, g4 = lane >> 4;
    for (int item = blockIdx.x; item < 128 * 8; item += X.G) {
        const int chunk = item >> 3, g = item & 7; const int row0 = chunk * 128;
        __syncthreads();
        if (X.tid < 128) { const f32x2 sv = *(const f32x2*)(vstat + 2 * (row0 + X.tid)); const float mean = sv.x * (1.0f / D); const float var = fmaxf(sv.y * (1.0f / D) - mean * mean, 0.f);
            stat[2 * X.tid] = mean; stat[2 * X.tid + 1] = rsqrtf(var + EPS); }
        __syncthreads();
#pragma unroll
        for (int c = X.tid; c < 128 * 16; c += NTHREADS) { const int q = c >> 4, cc = c & 15; const u32x4 w = *(const u32x4*)(VB + (size_t)(row0 + q) * D + g * 128 + cc * 8);
            const float mean = stat[2 * q], rstd = stat[2 * q + 1]; const float* lg_ = IN(I_OLNG) + g * 128 + cc * 8; const float* lb_ = IN(I_OLNB) + g * 128 + cc * 8;
#pragma unroll
            for (int k = 0; k < 4; ++k) { const float y0 = (bf2f(w[k] & 0xffffu) - mean) * rstd * lg_[2 * k] + lb_[2 * k], y1 = (bf2f(w[k] >> 16) - mean) * rstd * lg_[2 * k + 1] + lb_[2 * k + 1];
                const unsigned pk = pk2(y0, y1);
                *(LAS unsigned short*)(Vt + (cc * 8 + 2 * k) * 272 + q * 2) = (unsigned short)(pk & 0xffffu); *(LAS unsigned short*)(Vt + (cc * 8 + 2 * k + 1) * 272 + q * 2) = (unsigned short)(pk >> 16); } }
        __syncthreads();
        f32x4 acc[8];
#pragma unroll
        for (int pb = 0; pb < 8; ++pb) acc[pb] = (f32x4){0.f, 0.f, 0.f, 0.f};
#pragma unroll
        for (int s = 0; s < 4; ++s) { const bf16x8 af = *(const LAS bf16x8*)(Vt + (16 * X.wave + l15) * 272 + (32 * s + 8 * g4) * 2);
#pragma unroll
            for (int pb = 0; pb < 8; ++pb) { const bf16x8 bfr = *(const bf16x8*)(WsB + ((size_t)g * 128 + 16 * pb + l15) * 128 + 32 * s + 8 * g4); acc[pb] = __builtin_amdgcn_mfma_f32_16x16x32_bf16(af, bfr, acc[pb], 0, 0, 0); } }
#pragma unroll
        for (int pb = 0; pb < 8; ++pb) { const int p = 16 * pb + l15; const float bs = IN(I_OBS)[g * 128 + p]; const size_t off = (size_t)(row0 + p) * D + g * 128 + 16 * X.wave + 4 * g4;
            const u32x2 uw = *(const u32x2*)(U + off);
            u32x2 o; o.x = pk2(bf2f(uw.x & 0xffffu) * (acc[pb][0] + bs), bf2f(uw.x >> 16) * (acc[pb][1] + bs)); o.y = pk2(bf2f(uw.y & 0xffffu) * (acc[pb][2] + bs), bf2f(uw.y >> 16) * (acc[pb][3] + bs));
            *(u32x2*)(SG + off) = o; }
    }
}

enum { PH_PRO = 0, PH_MOD0, PH_GIN, PH_CONV, PH_ATT, PH_GOUT, PH_RT0, PH_M1_0, PH_M2_0, PH_CMB0, PH_GMI, PH_SPA, PH_GMO, PH_RT1, PH_M1_1, PH_M2_1, PH_CMB1, NPHASE };

__global__ void __launch_bounds__(NTHREADS, 2) mega(Args a) {
    extern __shared__ __attribute__((aligned(16))) unsigned char lds_raw[];
    Ctx X; X.lds = (LAS unsigned char*)lds_raw;
    const int wave0 = __builtin_amdgcn_readfirstlane((int)threadIdx.x >> 6);
    X.G = gridDim.x; { const int bx = blockIdx.x; X.vcu = (X.G % 8 == 0) ? (bx % 8) * (X.G / 8) + bx / 8 : bx; }
    X.NGW = X.G * NWAVES; X.wave = wave0;
    volatile LAS unsigned* MISC = (volatile LAS unsigned*)(X.lds + MISC_OFF);
    if (threadIdx.x < 64) MISC[threadIdx.x] = 0u;
    __syncthreads();
    XcdBarrier bar = xcd_barrier_post((unsigned*)(a.ws + WS_CTL) + CW_BAR + a.li * XCD_BAR_WORDS, MISC + 8);
    const int ph_lo = a.ph_lo, ph_hi = a.ph_hi;
#define PH_ENTER() int z; asm volatile("s_mov_b32 %0, 0" : "=s"(z)); \
        X.lane = (int)__builtin_amdgcn_mbcnt_hi(~0u, __builtin_amdgcn_mbcnt_lo(~0u, (unsigned)z)); X.tid = wave0 * 64 + X.lane; X.gw = X.vcu * NWAVES + wave0; \
        { kargp_t kp = (kargp_t)__builtin_amdgcn_kernarg_segment_ptr(); asm volatile("" : "+s"(kp)); X.kp = kp; } \
        unsigned char* ws = (unsigned char*)(__attribute__((address_space(1))) unsigned char*)X.kp[34] + z; X.ws = ws;
#if PROBE_PH >= 0
    unsigned long long pr_t0 = 0, pr_t1 = 0;
#endif
    for (int ph = ph_lo; ph < ph_hi; ++ph) {
        if (ph != ph_lo) { const int l0 = (int)__builtin_amdgcn_mbcnt_hi(~0u, __builtin_amdgcn_mbcnt_lo(~0u, 0u)); xcd_barrier(bar, wave0 * 64 + l0); }
#if PROBE_PH >= 0
        if (ph == PROBE_PH) pr_t0 = __builtin_amdgcn_s_memrealtime();
        if (ph == PROBE_END) pr_t1 = __builtin_amdgcn_s_memrealtime();
#endif
        switch (ph) {
        case PH_PRO: { PH_ENTER(); phase_prologue(a, X); } break;
        case PH_MOD0: { PH_ENTER(); phase_modulate0(a, X); } break;
        case PH_GIN: { PH_ENTER(); DenseSched S; S.init((const bf16*)(ws + WS_XA), (const bf16*)(ws + WS_WINT), NTOK, EVEN_IN, X.G, (int)blockIdx.x);
            S.A2 = (const bf16*)(ws + WS_GM); S.Bt2 = (const bf16*)(ws + WS_WINT) + (size_t)KV_COL * D; S.nM2 = NCTX / 256;
            EpiIn E{(bf16*)(ws + WS_GLU), (bf16*)(ws + WS_Q), (bf16*)(ws + WS_K), (bf16*)(ws + WS_V), (bf16*)(ws + WS_KC), (bf16*)(ws + WS_VC), IN(I_EBIN)};
            pg8::gemm_phase<EpiIn, DenseSched>(X.lds, S, E, X.tid); } break;
        case PH_CONV: { PH_ENTER(); phase_conv_qk(a, X); } break;
        case PH_ATT: { PH_ENTER(); phase_attention(a, X); } break;
        case PH_GOUT: { PH_ENTER(); DenseSched S; S.init((const bf16*)(ws + WS_MIX), (const bf16*)(ws + WS_WOUTT), NTOK, D, X.G, (int)blockIdx.x);
            EpiRes E{IN(I_X), (float*)(ws + WS_H), IN(I_EBOUT), (const float*)(ws + WS_MOD) + 2 * 1024};
            pg8::gemm_phase<EpiRes, DenseSched>(X.lds, S, E, X.tid); } break;
        case PH_RT0: { PH_ENTER(); phase_router(a, X, 0); } break;
        case PH_RT1: { PH_ENTER(); phase_router(a, X, 1); } break;
        case PH_M1_0: case PH_M1_1: { PH_ENTER(); const int l = (ph == PH_M1_1); moe_build_table(X, (const int*)(ws + WS_CTL) + CW_CNT + l * NE);
            MoeSchedT<true, 8> S; S.tab = (const LAS int*)(X.lds + TAB_OFF); S.G = X.G; S.c = X.vcu; S.A = (const bf16*)(ws + WS_XA); S.Bt = (const bf16*)(ws + WS_W1T) + (size_t)l * NE * 2048 * 1024; S.list = (const int*)(ws + WS_LIST);
            EpiSwiglu E{(bf16*)(ws + WS_ACT), IN(I_B1) + (size_t)l * NE * 2048};
            pg8::gemm_phase<EpiSwiglu, MoeSchedT<true, 8>>(X.lds, S, E, X.tid); } break;
        case PH_M2_0: case PH_M2_1: { PH_ENTER(); const int l = (ph == PH_M2_1); moe_build_table(X, (const int*)(ws + WS_CTL) + CW_CNT + l * NE);
            MoeSchedT<false, 4> S; S.tab = (const LAS int*)(X.lds + TAB_OFF); S.G = X.G; S.c = X.vcu; S.A = (const bf16*)(ws + WS_ACT); S.Bt = (const bf16*)(ws + WS_W2T) + (size_t)l * NE * 1024 * 1024; S.list = (const int*)(ws + WS_LIST);
            EpiDown E{(bf16*)(ws + WS_Y), IN(I_B2) + (size_t)l * NE * D, (const int*)(ws + WS_LIST), (const float*)(ws + WS_GATE), (const LAS int*)(X.lds + TAB_OFF)};
            pg8::gemm_phase<EpiDown, MoeSchedT<false, 4>>(X.lds, S, E, X.tid); } break;
        case PH_CMB0: { PH_ENTER(); phase_combine(a, X, 0); } break;
        case PH_CMB1: { PH_ENTER(); phase_combine(a, X, 1); } break;
        case PH_GMI: { PH_ENTER(); DenseSched S; S.init((const bf16*)(ws + WS_XA), (const bf16*)(ws + WS_GWINT), NTOK, 2048, X.G, (int)blockIdx.x);
            EpiGelu E{(bf16*)(ws + WS_U), (bf16*)(ws + WS_VB), IN(I_OBIN), (float*)(ws + WS_CTL) + CW_VSTAT};
            pg8::gemm_phase<EpiGelu, DenseSched>(X.lds, S, E, X.tid); } break;
        case PH_SPA: { PH_ENTER(); phase_spatial(a, X); } break;
        case PH_GMO: { PH_ENTER(); DenseSched S; S.init((const bf16*)(ws + WS_MIX), (const bf16*)(ws + WS_GWOUTT), NTOK, D, X.G, (int)blockIdx.x);
            EpiRes E{(const float*)(ws + WS_H), (float*)(ws + WS_H), IN(I_OBOUT), (const float*)(ws + WS_MOD) + (size_t)9 * MODW + 2 * 1024};
            pg8::gemm_phase<EpiRes, DenseSched>(X.lds, S, E, X.tid); } break;
        default: break;
        }
    }
#if PROBE_PH >= 0
    if (pr_t1 == 0) pr_t1 = __builtin_amdgcn_s_memrealtime();
    if (blockIdx.x == 0 && wave0 == 0) { const unsigned long long te = __builtin_amdgcn_s_memrealtime(); const unsigned long long span = (pr_t1 - pr_t0) * PROBE_MULT;
        while (__builtin_amdgcn_s_memrealtime() - te < span) __builtin_amdgcn_s_sleep(8); }
#endif
}

__device__ __forceinline__ bool find_expert(const int* cnt, int s, int& e, int& slot) {
    int pb = 0;
    for (int i = 0; i < NE; ++i) { const int c = cnt[i]; const int pr = ((c + 255) >> 8) << 8; if (s < pb + pr) { e = i; slot = s - pb; return true; } pb += pr; }
    return false;
}
__global__ void __launch_bounds__(256) slow_gemm(const bf16* A, const int* arow, const bf16* Bt, float* C, int N, const int* cnt, size_t bstride) {
    __shared__ float As[16][65], Bs[16][65];
    const int tx = threadIdx.x & 15, ty = threadIdx.x >> 4; const int m0 = blockIdx.y * 64, n0 = blockIdx.x * 64;
    if (cnt) { int e, slot; if (!find_expert(cnt, m0, e, slot)) return; Bt += (size_t)e * bstride; }
    float acc[4][4];
    for (int i = 0; i < 4; ++i) for (int j = 0; j < 4; ++j) acc[i][j] = 0.f;
    for (int k0 = 0; k0 < 1024; k0 += 16) {
        for (int i = 0; i < 4; ++i) { const int idx = threadIdx.x + 256 * i; const int r = idx >> 4, kk = idx & 15; const int gm = m0 + r; const int ar = arow ? arow[gm] : gm;
            As[kk][r] = bf2f(A[(size_t)ar * 1024 + k0 + kk]); Bs[kk][r] = bf2f(Bt[(size_t)(n0 + r) * 1024 + k0 + kk]); }
        __syncthreads();
        for (int kk = 0; kk < 16; ++kk) { float av[4], bv[4];
            for (int i = 0; i < 4; ++i) { av[i] = As[kk][ty * 4 + i]; bv[i] = Bs[kk][tx * 4 + i]; }
            for (int i = 0; i < 4; ++i) for (int j = 0; j < 4; ++j) acc[i][j] += av[i] * bv[j]; }
        __syncthreads();
    }
    for (int i = 0; i < 4; ++i) for (int j = 0; j < 4; ++j) C[(size_t)(m0 + ty * 4 + i) * N + n0 + tx * 4 + j] = acc[i][j];
}
__device__ __forceinline__ unsigned short f2bf_s(float f) { return (unsigned short)(pk2(f, 0.f) & 0xffffu); }
__global__ void slow_epi_in(const float* C, const float* C2, const float* bias, bf16* GLU, bf16* Q, bf16* Kb, bf16* Vb, bf16* KC, bf16* VC) {
    const size_t i = (size_t)blockIdx.x * blockDim.x + threadIdx.x;
    if (i < (size_t)NTOK * 512) { const int row = (int)(i >> 9), j = (int)(i & 511); const int t = j >> 7, ii = j & 127; const float* cr = C + (size_t)row * EVEN_IN;
        const float u = cr[t * 256 + ii] + bias[j], g = cr[t * 256 + 128 + ii] + bias[512 + j];
        GLU[i] = f2bf_s(u / (1.0f + expf(-g)));
        Q[i] = f2bf_s(cr[1024 + j] + bias[1024 + j]);
        if (j < 128) { Kb[(size_t)row * 128 + j] = f2bf_s(cr[1536 + j] + bias[1536 + j]); Vb[(size_t)row * 128 + j] = f2bf_s(cr[1664 + j] + bias[1664 + j]); }
        if (row < NCTX && j < 128) { KC[(size_t)row * 128 + j] = f2bf_s(C2[(size_t)row * 256 + j] + bias[1536 + j]); VC[(size_t)row * 128 + j] = f2bf_s(C2[(size_t)row * 256 + 128 + j] + bias[1664 + j]); } }
}
__global__ void slow_epi_res(const float* C, const float* base, float* out, const float* bias, const float* gate) {
    const size_t i = (size_t)blockIdx.x * blockDim.x + threadIdx.x;
    if (i < (size_t)NTOK * D) { const int row = (int)(i >> 10), col = (int)(i & 1023); out[i] = base[i] + gate[(size_t)(row / SEQ) * MODW + col] * (C[i] + bias[col]); }
}
__global__ void slow_epi_gelu(const float* C, const float* bias, bf16* U, bf16* V) {
    const size_t i = (size_t)blockIdx.x * blockDim.x + threadIdx.x;
    if (i < (size_t)NTOK * 2048) { const int row = (int)(i >> 11), col = (int)(i & 2047); const float x = C[i] + bias[col]; const float y = 0.5f * x * (1.0f + erff(x * 0.70710678118654752f));
        if (col < 1024) U[(size_t)row * D + col] = f2bf_s(y); else V[(size_t)row * D + col - 1024] = f2bf_s(y); }
}
__global__ void slow_arow(const int* cnt, const int* list, int* arow) {
    const int s = blockIdx.x * blockDim.x + threadIdx.x; if (s >= ACT_ROWS) return;
    int e, slot; int r = 0; if (find_expert(cnt, s, e, slot) && slot < cnt[e]) r = list[(size_t)e * NTOK + slot] >> 2;
    arow[s] = r;
}
__global__ void slow_epi_swiglu(const float* C, const int* cnt, const float* b1, bf16* ACT) {
    const size_t i = (size_t)blockIdx.x * blockDim.x + threadIdx.x;
    if (i < (size_t)ACT_ROWS * 1024) { const int s = (int)(i >> 10), j = (int)(i & 1023); int e, slot; if (!find_expert(cnt, s, e, slot)) return;
        const int t = j >> 7, ii = j & 127; const float* cr = C + (size_t)s * 2048;
        float g = cr[t * 256 + ii] + b1[(size_t)e * 2048 + j], up = cr[t * 256 + 128 + ii] + b1[(size_t)e * 2048 + 1024 + j];
        g = fminf(g, 7.0f); up = fminf(fmaxf(up, -7.0f), 7.0f);
        ACT[i] = f2bf_s((up + 1.0f) * g / (1.0f + expf(-1.702f * g))); }
}
__global__ void slow_epi_down(const float* C, const int* cnt, const int* list, const float* gatew, const float* b2, bf16* Y) {
    const size_t i = (size_t)blockIdx.x * blockDim.x + threadIdx.x;
    if (i < (size_t)ACT_ROWS * 1024) { const int s = (int)(i >> 10), col = (int)(i & 1023); int e, slot; if (!find_expert(cnt, s, e, slot) || slot >= cnt[e]) return;
        const int aid = list[(size_t)e * NTOK + slot]; Y[(size_t)aid * D + col] = f2bf_s((C[i] + b2[(size_t)e * D + col]) * gatew[aid]); }
}
__global__ void __launch_bounds__(64) slow_attention(const bf16* QN, const bf16* KN, const bf16* VV, const bf16* KC, const bf16* VC, const float* sink, bf16* MIX) {
    const int i = blockIdx.x * blockDim.x + threadIdx.x; if (i >= NTOK * 8) return;
    const int row = i >> 3, h = i & 7, kh = h >> 2, b = row / SEQ, t = row % SEQ;
    float q[64], o[64];
    for (int d = 0; d < 64; ++d) { q[d] = bf2f(QN[(size_t)row * 512 + h * 64 + d]); o[d] = 0.f; }
    float m = sink[h] * LOG2E, l = 1.0f;
    const int j0 = t - 128 < 0 ? 0 : t - 128, j1 = t + 128 > SEQ - 1 ? SEQ - 1 : t + 128;
    for (int jj = j0; jj <= j1 + CTXL; ++jj) {
        const bf16* kp; const bf16* vp;
        if (jj <= j1) { kp = KN + (size_t)(b * SEQ + jj) * 128 + kh * 64; vp = VV + (size_t)(b * SEQ + jj) * 128 + kh * 64; }
        else { const int c = jj - j1 - 1; kp = KC + (size_t)(b * CTXL + c) * 128 + kh * 64; vp = VC + (size_t)(b * CTXL + c) * 128 + kh * 64; }
        float s = 0.f; for (int d = 0; d < 64; ++d) s += q[d] * bf2f(kp[d]);
        const float mn = fmaxf(m, s), al = exp2f(m - mn), p = exp2f(s - mn); m = mn; l = l * al + p;
        for (int d = 0; d < 64; ++d) o[d] = o[d] * al + p * bf2f(vp[d]);
    }
    for (int d = 0; d < 64; ++d) MIX[(size_t)row * D + 512 + h * 64 + d] = f2bf_s(o[d] / l);
}
__global__ void slow_vstats(const bf16* VB, float* stat) {
    const int row = blockIdx.x * blockDim.x + threadIdx.x; if (row >= NTOK) return;
    float s = 0.f; for (int c = 0; c < D; ++c) s += bf2f(VB[(size_t)row * D + c]); const float mean = s / D;
    float s2 = 0.f; for (int c = 0; c < D; ++c) { const float d = bf2f(VB[(size_t)row * D + c]) - mean; s2 += d * d; }
    stat[2 * row] = mean; stat[2 * row + 1] = rsqrtf(s2 / D + EPS);
}
__global__ void slow_spatial(const bf16* U, const bf16* VB, const float* stat, const float* ws, const float* bs, const float* lng, const float* lnb, bf16* SG) {
    const size_t i = (size_t)blockIdx.x * blockDim.x + threadIdx.x;
    if (i < (size_t)NTOK * D) { const int row = (int)(i >> 10), ch = (int)(i & 1023); const int g = ch >> 7, p = row & 127, r0 = row - p;
        float s = 0.f;
        for (int q = 0; q < 128; ++q) { const float vn = (bf2f(VB[(size_t)(r0 + q) * D + ch]) - stat[2 * (r0 + q)]) * stat[2 * (r0 + q) + 1] * lng[ch] + lnb[ch]; s += ws[((size_t)g * 128 + p) * 128 + q] * vn; }
        SG[i] = f2bf_s(bf2f(U[i]) * (s + bs[g * 128 + p])); }
}

static void launch_mega(Args& a, int lo, int hi, int& li, int grid, hipStream_t stream) {
    a.ph_lo = lo; a.ph_hi = hi; a.li = li++;
    hipLaunchKernelGGL(mega, dim3(grid), dim3(NTHREADS), LDS_BYTES, stream, a);
}
extern "C" void kernel_launch(void* const* d_in, const int* in_sizes, int n_in, void* d_out, int out_size, void* d_ws, size_t ws_size, hipStream_t stream) {
    static int grid = 0;
    if (grid == 0) {
        if (n_in != 33 || out_size != NTOK * D || ws_size < WS_END) { fprintf(stderr, "kernel_launch: unexpected problem (n_in %d, out %d, ws %zu)\n", n_in, out_size, ws_size); grid = -1; return; }
        int dev = 0, cus = 0, per_cu = 0;
        if (hipGetDevice(&dev) != hipSuccess || hipDeviceGetAttribute(&cus, hipDeviceAttributeMultiprocessorCount, dev) != hipSuccess) { grid = -1; return; }
        if (hipFuncSetAttribute((const void*)mega, hipFuncAttributeMaxDynamicSharedMemorySize, LDS_BYTES) != hipSuccess) { fprintf(stderr, "kernel_launch: hipFuncSetAttribute failed\n"); grid = -1; return; }
        if (hipOccupancyMaxActiveBlocksPerMultiprocessor(&per_cu, (const void*)mega, NTHREADS, LDS_BYTES) != hipSuccess || per_cu < 1) { fprintf(stderr, "kernel_launch: occupancy query says %d blocks per CU\n", per_cu); per_cu = 1; }
        (void)hipGetLastError();
        grid = cus;
    }
    if (grid < 0) return;
    unsigned char* ws = (unsigned char*)d_ws;
    (void)hipMemsetAsync(ws + WS_CTL, 0, CTL_ZERO_BYTES, stream);
    Args a{};
    for (int i = 0; i < 33; ++i) a.in[i] = (const float*)d_in[i];
    a.out = (float*)d_out; a.ws = ws;
    int li = 0;
    const float* in_[33]; for (int i = 0; i < 33; ++i) in_[i] = (const float*)d_in[i];
    float* CF = (float*)(ws + WS_CF); float* MOD = (float*)(ws + WS_MOD); int* CNT = (int*)(ws + WS_CTL) + CW_CNT;
    int lo = 0;
    auto flush = [&](int upto) { if (upto > lo) launch_mega(a, lo, upto, li, grid, stream); };
    for (int ph = 0; ph < NPHASE; ++ph) {
        bool slow = false;
        switch (ph) {
        case PH_GIN: slow = SLOW_MASK & 1; break;
        case PH_ATT: slow = SLOW_MASK & 2; break;
        case PH_GOUT: case PH_GMO: slow = SLOW_MASK & 4; break;
        case PH_M1_0: case PH_M1_1: slow = SLOW_MASK & 8; break;
        case PH_M2_0: case PH_M2_1: slow = SLOW_MASK & 16; break;
        case PH_GMI: slow = SLOW_MASK & 32; break;
        case PH_SPA: slow = SLOW_MASK & 64; break;
        default: break;
        }
        if (!slow) continue;
        flush(ph); lo = ph + 1;
        const int l = (ph == PH_M1_1 || ph == PH_M2_1) ? 1 : 0;
        switch (ph) {
        case PH_GIN:
            hipLaunchKernelGGL(slow_gemm, dim3(EVEN_IN / 64, NTOK / 64), dim3(256), 0, stream, (const bf16*)(ws + WS_XA), (const int*)nullptr, (const bf16*)(ws + WS_WINT), CF, EVEN_IN, (const int*)nullptr, (size_t)0);
            hipLaunchKernelGGL(slow_gemm, dim3(256 / 64, NCTX / 64), dim3(256), 0, stream, (const bf16*)(ws + WS_GM), (const int*)nullptr, (const bf16*)(ws + WS_WINT) + (size_t)KV_COL * D, CF + (size_t)NTOK * EVEN_IN, 256, (const int*)nullptr, (size_t)0);
            hipLaunchKernelGGL(slow_epi_in, dim3(NTOK * 512 / 256), dim3(256), 0, stream, (const float*)CF, (const float*)(CF + (size_t)NTOK * EVEN_IN), in_[I_EBIN], (bf16*)(ws + WS_GLU), (bf16*)(ws + WS_Q), (bf16*)(ws + WS_K), (bf16*)(ws + WS_V), (bf16*)(ws + WS_KC), (bf16*)(ws + WS_VC));
            break;
        case PH_ATT:
            hipLaunchKernelGGL(slow_attention, dim3(NTOK * 8 / 64), dim3(64), 0, stream, (const bf16*)(ws + WS_Q), (const bf16*)(ws + WS_K), (const bf16*)(ws + WS_V), (const bf16*)(ws + WS_KC), (const bf16*)(ws + WS_VC), in_[I_SINK], (bf16*)(ws + WS_MIX));
            break;
        case PH_GOUT:
            hipLaunchKernelGGL(slow_gemm, dim3(D / 64, NTOK / 64), dim3(256), 0, stream, (const bf16*)(ws + WS_MIX), (const int*)nullptr, (const bf16*)(ws + WS_WOUTT), CF, D, (const int*)nullptr, (size_t)0);
            hipLaunchKernelGGL(slow_epi_res, dim3(NTOK * D / 256), dim3(256), 0, stream, (const float*)CF, in_[I_X], (float*)(ws + WS_H), in_[I_EBOUT], (const float*)(MOD + 2 * 1024));
            break;
        case PH_GMO:
            hipLaunchKernelGGL(slow_gemm, dim3(D / 64, NTOK / 64), dim3(256), 0, stream, (const bf16*)(ws + WS_MIX), (const int*)nullptr, (const bf16*)(ws + WS_GWOUTT), CF, D, (const int*)nullptr, (size_t)0);
            hipLaunchKernelGGL(slow_epi_res, dim3(NTOK * D / 256), dim3(256), 0, stream, (const float*)CF, (const float*)(ws + WS_H), (float*)(ws + WS_H), in_[I_OBOUT], (const float*)(MOD + (size_t)9 * MODW + 2 * 1024));
            break;
        case PH_M1_0: case PH_M1_1:
            hipLaunchKernelGGL(slow_arow, dim3(ACT_ROWS / 256), dim3(256), 0, stream, (const int*)(CNT + l * NE), (const int*)(ws + WS_LIST), (int*)(ws + WS_AROW));
            hipLaunchKernelGGL(slow_gemm, dim3(2048 / 64, ACT_ROWS / 64), dim3(256), 0, stream, (const bf16*)(ws + WS_XA), (const int*)(ws + WS_AROW), (const bf16*)(ws + WS_W1T) + (size_t)l * NE * 2048 * 1024, CF, 2048, (const int*)(CNT + l * NE), (size_t)2048 * 1024);
            hipLaunchKernelGGL(slow_epi_swiglu, dim3(ACT_ROWS * 1024 / 256), dim3(256), 0, stream, (const float*)CF, (const int*)(CNT + l * NE), in_[I_B1] + (size_t)l * NE * 2048, (bf16*)(ws + WS_ACT));
            break;
        case PH_M2_0: case PH_M2_1:
            hipLaunchKernelGGL(slow_gemm, dim3(1024 / 64, ACT_ROWS / 64), dim3(256), 0, stream, (const bf16*)(ws + WS_ACT), (const int*)nullptr, (const bf16*)(ws + WS_W2T) + (size_t)l * NE * 1024 * 1024, CF, 1024, (const int*)(CNT + l * NE), (size_t)1024 * 1024);
            hipLaunchKernelGGL(slow_epi_down, dim3(ACT_ROWS * 1024 / 256), dim3(256), 0, stream, (const float*)CF, (const int*)(CNT + l * NE), (const int*)(ws + WS_LIST), (const float*)(ws + WS_GATE), in_[I_B2] + (size_t)l * NE * D, (bf16*)(ws + WS_Y));
            break;
        case PH_GMI:
            hipLaunchKernelGGL(slow_gemm, dim3(2048 / 64, NTOK / 64), dim3(256), 0, stream, (const bf16*)(ws + WS_XA), (const int*)nullptr, (const bf16*)(ws + WS_GWINT), CF, 2048, (const int*)nullptr, (size_t)0);
            hipLaunchKernelGGL(slow_epi_gelu, dim3(NTOK * 2048 / 256), dim3(256), 0, stream, (const float*)CF, in_[I_OBIN], (bf16*)(ws + WS_U), (bf16*)(ws + WS_VB));
            break;
        case PH_SPA:
            hipLaunchKernelGGL(slow_vstats, dim3(NTOK / 64), dim3(64), 0, stream, (const bf16*)(ws + WS_VB), CF);
            hipLaunchKernelGGL(slow_spatial, dim3(NTOK * D / 256), dim3(256), 0, stream, (const bf16*)(ws + WS_U), (const bf16*)(ws + WS_VB), (const float*)CF, in_[I_OWS], in_[I_OBS], in_[I_OLNG], in_[I_OLNB], (bf16*)(ws + WS_MIX));
            break;
        default: break;
        }
    }
    flush(NPHASE);
}
```

```cpp
#include <hip/hip_runtime.h>
#include <cstdio>
#include <cstdint>

#ifndef SLOW_MASK
#define SLOW_MASK 0x00
#endif

#ifndef PROBE_PH
#define PROBE_PH (-1)
#endif
#ifndef PROBE_END
#define PROBE_END (PROBE_PH + 1)
#endif
#ifndef PROBE_MULT
#define PROBE_MULT 4
#endif

#define LAS __attribute__((address_space(3)))
typedef unsigned short bf16;
typedef short bf16x8 __attribute__((ext_vector_type(8)));
typedef float f32x4 __attribute__((ext_vector_type(4)));
typedef float f32x2 __attribute__((ext_vector_type(2)));
typedef unsigned u32x4 __attribute__((ext_vector_type(4)));
typedef unsigned u32x2 __attribute__((ext_vector_type(2)));
typedef __bf16 bf16x2_t __attribute__((ext_vector_type(2)));

constexpr int NB = 8, SEQ = 2048, D = 1024, NTOK = NB * SEQ, CTXL = 256, NCTX = NB * CTXL;
constexpr int NE = 32, TOPK = 4, NASSIGN = NTOK * TOPK, ACT_ROWS = NASSIGN + NE * 256;
constexpr int EVEN_IN = 1792, KV_COL = 1536;
constexpr float EPS = 1e-6f, LOG2E = 1.4426950408889634f;
constexpr float QSCALE = 0.125f * LOG2E;
constexpr int MODW = 6 * D;
constexpr int NWAVES = 8, NTHREADS = 512;

constexpr size_t MiB = 1u << 20;
constexpr size_t WS_CTL = 0, CTL_ZERO_BYTES = 1 * MiB;
constexpr size_t WS_MOD = 1 * MiB;
constexpr size_t WS_LIST = 2 * MiB;
constexpr size_t WS_GATE = 4 * MiB;
constexpr size_t WS_WSB = 5 * MiB;
constexpr size_t WS_WINT = 6 * MiB;
constexpr size_t WS_WOUTT = 10 * MiB;
constexpr size_t WS_GWINT = 12 * MiB;
constexpr size_t WS_GWOUTT = 16 * MiB;
constexpr size_t WS_KC = 18 * MiB;
constexpr size_t WS_VC = 18 * MiB + 512 * 1024;
constexpr size_t WS_K = 19 * MiB;
constexpr size_t WS_V = 23 * MiB;
constexpr size_t WS_GM = 27 * MiB;
constexpr size_t WS_AROW = 31 * MiB;
constexpr size_t WS_Q = 32 * MiB;
constexpr size_t WS_GLU = 48 * MiB;
constexpr size_t WS_XA = 64 * MiB;
constexpr size_t WS_MIX = 96 * MiB;
constexpr size_t WS_H = 128 * MiB;
constexpr size_t WS_U = 192 * MiB;
constexpr size_t WS_VB = 224 * MiB;
constexpr size_t WS_W1T = 256 * MiB;
constexpr size_t WS_W2T = 512 * MiB;
constexpr size_t WS_ACT = 640 * MiB;
constexpr size_t WS_Y = 784 * MiB;
constexpr size_t WS_CF = 912 * MiB;
constexpr size_t WS_END = 1488 * MiB;
constexpr int CW_BAR = 4096, CW_CNT = 131072, CW_VSTAT = 147456;
constexpr int MAX_LAUNCH = 20;

constexpr int RING_BYTES = 131072;
constexpr int MISC_OFF = RING_BYTES;
constexpr int TAB_OFF = RING_BYTES + 256;
constexpr int LDS_BYTES = 147456;

#define LDS_WAIT() asm volatile("s_waitcnt lgkmcnt(0)" ::: "memory")
#define VM_WAIT() asm volatile("s_waitcnt vmcnt(0)" ::: "memory")

__device__ __forceinline__ float bf2f(unsigned b) { return __uint_as_float(b << 16); }
__device__ __forceinline__ unsigned pk2(float lo, float hi) { f32x2 v = {lo, hi}; bf16x2_t b = __builtin_convertvector(v, bf16x2_t); return __builtin_bit_cast(unsigned, b); }
__device__ __forceinline__ float wave_sum(float v) {
#pragma unroll
    for (int o = 1; o < 64; o <<= 1) v += __shfl_xor(v, o);
    return v;
}
__device__ __forceinline__ float sigmoidf_(float x) { return __builtin_amdgcn_rcpf(1.0f + __builtin_amdgcn_exp2f(-x * LOG2E)); }

#define XB_TMO      128
#define XB_XCNT(j)  (256  + 64 * (j))
#define XB_XSUB(j)  (1280 + 64 * (j))
#define XB_XGEN(j)  (2304 + 64 * (j))
#define XB_TOP      3328
#define XB_TOPGEN   3392
#define XCD_BAR_WORDS 3456
#define XB_SPIN_CAP (1u << 20)
__device__ __forceinline__ unsigned xb_ld(unsigned* p)              { return __hip_atomic_load(p, __ATOMIC_RELAXED, __HIP_MEMORY_SCOPE_AGENT); }
__device__ __forceinline__ unsigned xb_add(unsigned* p, unsigned v) { return __hip_atomic_fetch_add(p, v, __ATOMIC_RELAXED, __HIP_MEMORY_SCOPE_AGENT); }
__device__ __forceinline__ unsigned xb_xcc_id() { return (unsigned)__builtin_amdgcn_s_getreg((3 << 11) | 20) & 0xFu; }
#define XB_SPIN(cond, bar) do { unsigned _sp = 0; while (cond) { __builtin_amdgcn_s_sleep(1); \
    if ((++_sp & 255u) == 0u) { if (xb_ld(&(bar)[XB_TMO])) break; if (_sp > XB_SPIN_CAP) { atomicAdd(&(bar)[XB_TMO], 1u); break; } } } } while (0)
struct XcdBarrier { unsigned* bar; unsigned x; volatile LAS unsigned* st; };
__device__ __forceinline__ XcdBarrier xcd_barrier_post(unsigned* bar, volatile LAS unsigned* st) {
    XcdBarrier b; b.bar = bar; b.x = xb_xcc_id(); b.st = st;
    if (threadIdx.x == 0) (void)xb_add(&bar[XB_XCNT(b.x)], 1u);
    return b;
}
__device__ __forceinline__ void xcd_barrier_complete(unsigned* bar, unsigned x, unsigned& nloc, unsigned& nx) {
    const unsigned G = gridDim.x * gridDim.y * gridDim.z;
    unsigned sum, cnt, mine, sp = 0u;
    for (;;) {
        sum = 0u; cnt = 0u; mine = 0u;
#pragma unroll
        for (unsigned j = 0; j < 16; ++j) { const unsigned c = xb_ld(&bar[XB_XCNT(j)]); sum += c; cnt += (c > 0u) ? 1u : 0u; mine = (j == x) ? c : mine; }
        if (sum == G) break;
        __builtin_amdgcn_s_sleep(1);
        if ((++sp & 255u) == 0u) { if (xb_ld(&bar[XB_TMO])) break; if (sp > XB_SPIN_CAP) { atomicAdd(&bar[XB_TMO], 1u); break; } }
    }
    nloc = mine > 0u ? mine : 1u; nx = cnt > 0u ? cnt : 1u;
}
__device__ __forceinline__ void xcd_barrier(const XcdBarrier& b, const int tid) {
    asm volatile("s_waitcnt vmcnt(0)" ::: "memory");
    __syncthreads();
    if (tid == 0) {
        unsigned* bar = b.bar;
        __builtin_amdgcn_s_waitcnt(0);
        unsigned nloc = b.st[0], nx = b.st[1];
        if (nloc == 0u) { xcd_barrier_complete(bar, b.x, nloc, nx); b.st[0] = nloc; b.st[1] = nx; }
        const unsigned old = xb_add(&bar[XB_XSUB(b.x)], 1u);
        const unsigned gen = old / nloc;
        if (old + 1u == (gen + 1u) * nloc) {
            __builtin_amdgcn_fence(__ATOMIC_RELEASE, "agent");
            asm volatile("s_waitcnt vmcnt(0)" ::: "memory");
            const unsigned og = xb_add(&bar[XB_TOP], 1u);
            const unsigned tg = og / nx;
            if (og + 1u == (tg + 1u) * nx) xb_add(&bar[XB_TOPGEN], 1u);
            else XB_SPIN(xb_ld(&bar[XB_TOPGEN]) == tg, bar);
            __builtin_amdgcn_fence(__ATOMIC_ACQUIRE, "agent");
            xb_add(&bar[XB_XGEN(b.x)], 1u);
            asm volatile("s_waitcnt vmcnt(0)" ::: "memory");
        } else {
            XB_SPIN(xb_ld(&bar[XB_XGEN(b.x)]) == gen, bar);
            __builtin_amdgcn_fence(__ATOMIC_ACQUIRE, "agent");
            asm volatile("s_waitcnt vmcnt(0)" ::: "memory");
        }
    }
    __syncthreads();
}

namespace pg8 {
constexpr int BM = 256, BK = 64, HALF = 128, HTB = HALF * BK * 2, STAGE_BYTES = 8 * HTB, KD = 1024  ;
__host__ __device__ __forceinline__ int lds_byte(int r, int c) { const int st = (r >> 4) * 2 + (c >> 5), rr = r & 15, cc = c & 31, ob = rr * 64 + cc * 2; return st * 1024 + (ob ^ (((ob >> 9) & 1) << 5)); }
__host__ __device__ __forceinline__ void stage_rc(int b, int& R, int& C) { const int st = b / 1024, sb = b % 1024, swz = sb ^ (((sb >> 9) & 1) << 5); R = (st >> 1) * 16 + swz / 64; C = (st & 1) * 32 + (swz % 64) / 2; }
__host__ __device__ __forceinline__ int perm32(int rho) { const int n = rho >> 4, i = rho & 15; return 8 * (i >> 2) + 4 * n + (i & 3); }

struct Unit { int pm, pn, e, cnt; };

template <class Epi, class Sched>
__device__ __forceinline__ void gemm_phase(LAS unsigned char* lds, const Sched& S, const Epi& E, const int tid) {
    const int wid = __builtin_amdgcn_readfirstlane(tid >> 6), lane = tid & 63, wr = wid >> 2, wc = wid & 3, fr = lane & 15, fq = lane >> 4;
    constexpr int K = KD, nt = K / BK;
    int Rr[2], Cc[2];
    unsigned voffA[2][2], voffB[2];
#pragma unroll
    for (int i = 0; i < 2; ++i) { stage_rc(tid * 16 + i * 8192, Rr[i], Cc[i]); const int Rb = Epi::PERM ? ((Rr[i] & ~31) + perm32(Rr[i] & 31)) : Rr[i];
        voffB[i] = (unsigned)(Rb * K + Cc[i]) * 2u; }
    constexpr size_t kstep = (size_t)(BK * 2);
    constexpr size_t hstep = (size_t)HALF * K * 2;
    const unsigned ldsw = (unsigned)wid * 1024u;
    const int aoff = lds_byte(wr * 64 + fr, fq * 8), boff = lds_byte(wc * 32 + fr, fq * 8);
#define PG8_SA(b, h) (((b) * 2 + (h)) * HTB)
#define PG8_SB(b, h) ((4 + (b) * 2 + (h)) * HTB)
#define PG8_STAGE(bufoff, gbase, voff) do { _Pragma("unroll") for (int _i = 0; _i < 2; ++_i) \
        __builtin_amdgcn_global_load_lds((const unsigned*)((const char*)(gbase) + (voff)[_i]), (LAS unsigned*)(lds + (bufoff) + ldsw + _i * 8192), 16, 0, 0); } while (0)
#define PG8_LDA(dst, b, h) do { _Pragma("unroll") for (int m = 0; m < 4; ++m) _Pragma("unroll") for (int k = 0; k < 2; ++k) dst[m][k] = *(const LAS bf16x8*)(lds + PG8_SA(b, h) + aoff + m * 2048 + k * 1024); } while (0)
#define PG8_LDB(dst, b, h) do { _Pragma("unroll") for (int n = 0; n < 2; ++n) _Pragma("unroll") for (int k = 0; k < 2; ++k) dst[n][k] = *(const LAS bf16x8*)(lds + PG8_SB(b, h) + boff + n * 2048 + k * 1024); } while (0)
#define PG8_MMA(ai, bj, At, Bt) do { __builtin_amdgcn_s_setprio(1); _Pragma("unroll") for (int m = 0; m < 4; ++m) _Pragma("unroll") for (int n = 0; n < 2; ++n) _Pragma("unroll") for (int k = 0; k < 2; ++k) \
        acc[ai][bj][m][n] = __builtin_amdgcn_mfma_f32_16x16x32_bf16(Bt[n][k], At[m][k], acc[ai][bj][m][n], 0, 0, 0); __builtin_amdgcn_s_setprio(0); } while (0)
#define PG8_WAIT_V(n) asm volatile("s_waitcnt vmcnt(" #n ")" ::: "memory")
#define PG8_WAIT_L(n) asm volatile("s_waitcnt lgkmcnt(" #n ")" ::: "memory")
#define PG8_BAR __builtin_amdgcn_s_barrier()
#define PG8_SCHED __builtin_amdgcn_sched_barrier(0)
    Unit cur, nxt; int ui = 0;
    if (!S.next(0, cur)) return;
    S.a_voff(cur, voffA, Rr, Cc);
    f32x4 acc[2][2][4][2];
#pragma unroll
    for (int a = 0; a < 2; ++a)
#pragma unroll
        for (int b = 0; b < 2; ++b)
#pragma unroll
            for (int m = 0; m < 4; ++m)
#pragma unroll
                for (int n = 0; n < 2; ++n) acc[a][b][m][n] = (f32x4){0.f, 0.f, 0.f, 0.f};
    bf16x8 At[4][2], B0[2][2], B1[2][2];
    const char* cA = S.a_ptr(cur); const char* cB = S.b_ptr(cur);
    PG8_STAGE(PG8_SB(0, 0), cB, voffB); PG8_STAGE(PG8_SB(0, 1), cB + hstep, voffB); PG8_STAGE(PG8_SA(0, 0), cA, voffA[0]); PG8_STAGE(PG8_SA(0, 1), cA, voffA[1]);
    if (wr == 1) PG8_BAR;
    PG8_WAIT_V(2); PG8_BAR;
    PG8_STAGE(PG8_SB(1, 0), cB + kstep, voffB); PG8_STAGE(PG8_SA(1, 0), cA + kstep, voffA[0]); PG8_STAGE(PG8_SB(1, 1), cB + hstep + kstep, voffB);
    PG8_WAIT_V(6); PG8_BAR;
    for (;;) {
        const bool has_next = S.next(ui + 1, nxt);
        const char* nA = has_next ? S.a_ptr(nxt) : cA; const char* nB = has_next ? S.b_ptr(nxt) : cB;
        for (int t = 0; t < nt; t += 2) {
            const bool last = (t == nt - 2);
            const char* a1 = cA + (size_t)(t + 1) * kstep;
            const char* a2 = last ? nA : cA + (size_t)(t + 2) * kstep; const char* b2 = last ? nB : cB + (size_t)(t + 2) * kstep;
            const char* a3 = a2 + kstep; const char* b3 = b2 + kstep;
            PG8_LDB(B0, 0, 0); PG8_LDB(B1, 0, 1); PG8_SCHED; PG8_LDA(At, 0, 0); PG8_STAGE(PG8_SA(1, 1), a1, voffA[1]);
            if (Sched::GATHER) { if (last && has_next) S.a_voff(nxt, voffA, Rr, Cc); }
            PG8_WAIT_V(8); PG8_WAIT_L(0); PG8_BAR; PG8_MMA(0, 0, At, B0); PG8_MMA(0, 1, At, B1); PG8_BAR; PG8_SCHED;
            PG8_LDA(At, 0, 1); PG8_STAGE(PG8_SB(0, 0), b2, voffB); PG8_STAGE(PG8_SB(0, 1), b2 + hstep, voffB); PG8_STAGE(PG8_SA(0, 0), a2, voffA[0]);
            PG8_WAIT_V(8); PG8_WAIT_L(0); PG8_BAR; PG8_MMA(1, 0, At, B0); PG8_MMA(1, 1, At, B1); PG8_BAR; PG8_SCHED;
            PG8_LDB(B0, 1, 0); PG8_LDB(B1, 1, 1); PG8_SCHED; PG8_LDA(At, 1, 0); PG8_STAGE(PG8_SA(0, 1), a2, voffA[1]);
            PG8_WAIT_V(8); PG8_WAIT_L(0); PG8_BAR; PG8_MMA(0, 0, At, B0); PG8_MMA(0, 1, At, B1); PG8_BAR; PG8_SCHED;
            PG8_LDA(At, 1, 1); PG8_STAGE(PG8_SB(1, 0), b3, voffB); PG8_STAGE(PG8_SB(1, 1), b3 + hstep, voffB); PG8_STAGE(PG8_SA(1, 0), a3, voffA[0]);
            PG8_WAIT_V(8); PG8_WAIT_L(0); PG8_BAR; PG8_MMA(1, 0, At, B0); PG8_MMA(1, 1, At, B1); PG8_BAR; PG8_SCHED;
        }
        if (wr == 0) PG8_BAR;
        E(acc, cur, wr, wc, fr, fq);
        if (!has_next) break;
#pragma unroll
        for (int a = 0; a < 2; ++a)
#pragma unroll
            for (int b = 0; b < 2; ++b)
#pragma unroll
                for (int m = 0; m < 4; ++m)
#pragma unroll
                    for (int n = 0; n < 2; ++n) acc[a][b][m][n] = (f32x4){0.f, 0.f, 0.f, 0.f};
        cur = nxt; cA = nA; cB = nB; ++ui;
        if (wr == 1) PG8_BAR;
    }
    PG8_WAIT_V(0);
    PG8_BAR;
#undef PG8_SA
#undef PG8_SB
#undef PG8_STAGE
#undef PG8_LDA
#undef PG8_LDB
#undef PG8_MMA
#undef PG8_WAIT_V
#undef PG8_WAIT_L
#undef PG8_BAR
#undef PG8_SCHED
}
}

struct Args { const float* in[33]; float* out; unsigned char* ws; int ph_lo, ph_hi, li, pad; };
enum { I_X = 0, I_C, I_CTX, I_CCTX, I_ADAW, I_ADAB, I_NMG, I_NFG, I_EWIN, I_EBIN, I_ECW, I_ECB, I_ELNG, I_ELNB, I_QNG, I_KNG, I_SINK, I_EWOUT, I_EBOUT,
       I_OWIN, I_OBIN, I_OLNG, I_OLNB, I_OWS, I_OBS, I_OWOUT, I_OBOUT, I_RW, I_RB, I_W1, I_B1, I_W2, I_B2 };

typedef const __attribute__((address_space(4))) unsigned long long* kargp_t;
struct Ctx {
    LAS unsigned char* lds; int tid, lane, wave, G, vcu, gw, NGW; unsigned char* ws; kargp_t kp;
};
__device__ __forceinline__ const float* in_ptr(const Ctx& X, int i) { return (const float*)(const __attribute__((address_space(1))) float*)X.kp[i]; }
#define IN(i) in_ptr(X, (i))

struct DenseSched {
    static constexpr bool GATHER = false;
    const bf16* A; const bf16* Bt; int nM, nN, nwg, G, c;
    const bf16* A2; const bf16* Bt2; int nM2;
    __device__ __forceinline__ void init(const bf16* A_, const bf16* Bt_, int M, int N, int G_, int c_) { A = A_; Bt = Bt_; nM = M / 256; nN = N / 256; nwg = nM * nN; G = G_; c = c_; A2 = nullptr; Bt2 = nullptr; nM2 = 0; }
    __device__ __forceinline__ bool next(int i, pg8::Unit& u) const {
        const int L = i * G + c; if (L >= nwg + nM2) return false;
        if (L >= nwg) { u.pm = L - nwg; u.pn = 0; u.e = 1; u.cnt = 256; return true; }
        int wgid = L; { const int q = nwg / 8, r = nwg % 8, xcd = wgid % 8, off = wgid / 8; wgid = (xcd < r ? xcd * (q + 1) : r * (q + 1) + (xcd - r) * q) + off; }
        const int nig = 8 * nN, gid = wgid / nig, fm = gid * 8, gsz = (nM - fm) < 8 ? (nM - fm) : 8;
        u.pm = fm + ((wgid % nig) % gsz); u.pn = (wgid % nig) / gsz; u.e = 0; u.cnt = 256; return true;
    }
    __device__ __forceinline__ const char* a_ptr(const pg8::Unit& u) const { return (const char*)(u.e ? A2 : A) + (size_t)u.pm * 256 * pg8::KD * 2; }
    __device__ __forceinline__ const char* b_ptr(const pg8::Unit& u) const { return (const char*)(u.e ? Bt2 : Bt) + (size_t)u.pn * 256 * pg8::KD * 2; }
    __device__ __forceinline__ void a_voff(const pg8::Unit&, unsigned (&v)[2][2], const int (&R)[2], const int (&C)[2]) const {
#pragma unroll
        for (int i = 0; i < 2; ++i) { v[0][i] = (unsigned)(R[i] * pg8::KD + C[i]) * 2u; v[1][i] = v[0][i] + (unsigned)(pg8::HALF * pg8::KD * 2); }
    }
};
struct MoeSched {
    const LAS int* tab; int NT, G, c; bool gather;
};
template <bool GATHER_, int NTILE_N>
struct MoeSchedT {
    static constexpr bool GATHER = GATHER_;
    const LAS int* tab; int G, c;
    const bf16* A;
    const bf16* Bt;
    const int* list;
    __device__ __forceinline__ bool next(int i, pg8::Unit& u) const {
        const int L = i * G + c; const int T = tab[0];
        if (L >= T * NTILE_N) return false;
        const int mt = L / NTILE_N; u.pn = L % NTILE_N;
        const int w = __builtin_amdgcn_readfirstlane(tab[1 + mt]); u.e = w >> 16; const int tl = w & 0xffff;
        const int cnt = __builtin_amdgcn_readfirstlane(tab[512 + u.e]), pb = __builtin_amdgcn_readfirstlane(tab[544 + u.e]);
        u.pm = pb + tl * 256; u.cnt = cnt - tl * 256;
        return true;
    }
    __device__ __forceinline__ const char* a_ptr(const pg8::Unit& u) const { return GATHER ? (const char*)A : (const char*)A + (size_t)u.pm * pg8::KD * 2; }
    __device__ __forceinline__ const char* b_ptr(const pg8::Unit& u) const { return (const char*)Bt + ((size_t)u.e * NTILE_N + u.pn) * 256 * pg8::KD * 2; }
    __device__ __forceinline__ void a_voff(const pg8::Unit& u, unsigned (&v)[2][2], const int (&R)[2], const int (&C)[2]) const {
        if (GATHER) {
            const int slot0 = u.pm - tab[544 + u.e];
            const int* lp = list + (size_t)u.e * NTOK + slot0;
#pragma unroll
            for (int h = 0; h < 2; ++h)
#pragma unroll
                for (int i = 0; i < 2; ++i) { const int r = h * 128 + R[i]; const int tok = lp[r < u.cnt ? r : u.cnt - 1] >> 2; v[h][i] = (unsigned)(tok * pg8::KD + C[i]) * 2u; }
        } else {
#pragma unroll
            for (int i = 0; i < 2; ++i) { v[0][i] = (unsigned)(R[i] * pg8::KD + C[i]) * 2u; v[1][i] = v[0][i] + (unsigned)(pg8::HALF * pg8::KD * 2); }
        }
    }
};
__device__ __forceinline__ void moe_build_table(const Ctx& X, const int* cnt  ) {
    LAS int* tab = (LAS int*)(X.lds + TAB_OFF);
    __syncthreads();
    if (X.tid == 0) {
        int T = 0, pb = 0;
        for (int e = 0; e < NE; ++e) { const int c = __hip_atomic_load(cnt + e, __ATOMIC_RELAXED, __HIP_MEMORY_SCOPE_AGENT); const int mt = (c + 255) >> 8;
            tab[512 + e] = c; tab[544 + e] = pb; for (int t = 0; t < mt; ++t) tab[1 + T + t] = (e << 16) | t; T += mt; pb += mt * 256; }
        tab[0] = T;
    }
    __syncthreads();
}

__device__ __forceinline__ f32x2 gelu_pk(f32x2 v) {
    const f32x2 av = __builtin_elementwise_abs(v), d = av * 0.2316418882f + 1.0f;
    f32x2 t; t.x = __builtin_amdgcn_rcpf(d.x); t.y = __builtin_amdgcn_rcpf(d.y);
    f32x2 q = t * 0.5307027145f + (-0.7265760135f); q = q * t + 0.7107068705f; q = q * t + (-0.142248368f); q = q * t + 0.127414796f; q = q * t;
    const f32x2 s = (v * v) * (-0.72134752044f);
    f32x2 e; e.x = __builtin_amdgcn_exp2f(s.x); e.y = __builtin_amdgcn_exp2f(s.y);
    const f32x2 m = v * (q * e), r = v - m;
    f32x2 o; o.x = v.x < 0.f ? m.x : r.x; o.y = v.y < 0.f ? m.y : r.y; return o;
}
__device__ __forceinline__ u32x4 pack8(f32x4 a, f32x4 b) { u32x4 w; w.x = pk2(a[0], a[1]); w.y = pk2(a[2], a[3]); w.z = pk2(b[0], b[1]); w.w = pk2(b[2], b[3]); return w; }

struct EpiIn {
    static constexpr bool PERM = true;
    bf16 *GLU, *Q, *Kb, *Vb, *KC, *VC; const float* bias;
    __device__ __forceinline__ void operator()(const f32x4 (&acc)[2][2][4][2], const pg8::Unit& u, int wr, int wc, int fr, int fq) const {
        const int row0 = u.pm * 256 + wr * 64 + fr; const int c8 = wc * 32 + 8 * fq;
        if (u.e == 0 && u.pn < 4) {
            const int j0 = u.pn * 128 + c8;
            f32x4 bu[2], bg[2];
#pragma unroll
            for (int n = 0; n < 2; ++n) { bu[n] = *(const f32x4*)(bias + j0 + 4 * n); bg[n] = *(const f32x4*)(bias + 512 + j0 + 4 * n); }
#pragma unroll
            for (int ai = 0; ai < 2; ++ai)
#pragma unroll
                for (int m = 0; m < 4; ++m) { f32x4 o[2];
#pragma unroll
                    for (int n = 0; n < 2; ++n) { const f32x4 uu = acc[ai][0][m][n] + bu[n], gg = acc[ai][1][m][n] + bg[n];
#pragma unroll
                        for (int k = 0; k < 4; ++k) o[n][k] = uu[k] * sigmoidf_(gg[k]); }
                    *(u32x4*)(GLU + (size_t)(row0 + ai * 128 + m * 16) * 512 + j0) = pack8(o[0], o[1]); }
        } else {
#pragma unroll
            for (int bj = 0; bj < 2; ++bj) {
                bf16* dst; int ld, col, bcol;
                if (u.pn >= 6 || u.e) { dst = u.e ? (bj ? VC : KC) : (bj ? Vb : Kb); ld = 128; col = c8; bcol = KV_COL + bj * 128 + c8; }
                else { dst = Q; ld = 512; col = (u.pn - 4) * 256 + bj * 128 + c8; bcol = 1024 + col; }
                f32x4 bv[2];
#pragma unroll
                for (int n = 0; n < 2; ++n) bv[n] = *(const f32x4*)(bias + bcol + 4 * n);
#pragma unroll
                for (int ai = 0; ai < 2; ++ai)
#pragma unroll
                    for (int m = 0; m < 4; ++m) *(u32x4*)(dst + (size_t)(row0 + ai * 128 + m * 16) * ld + col) = pack8(acc[ai][bj][m][0] + bv[0], acc[ai][bj][m][1] + bv[1]);
            }
        }
    }
};
struct EpiRes {
    static constexpr bool PERM = false;
    const float* base; float* out; const float* bias; const float* gate;
    __device__ __forceinline__ void operator()(const f32x4 (&acc)[2][2][4][2], const pg8::Unit& u, int wr, int wc, int fr, int fq) const {
        const int col0 = u.pn * 256 + wc * 32 + 4 * fq; const int b = (u.pm * 256) / SEQ;
        f32x4 bv[2][2], gv[2][2];
#pragma unroll
        for (int bj = 0; bj < 2; ++bj)
#pragma unroll
            for (int n = 0; n < 2; ++n) { bv[bj][n] = *(const f32x4*)(bias + col0 + bj * 128 + n * 16); gv[bj][n] = *(const f32x4*)(gate + (size_t)b * MODW + col0 + bj * 128 + n * 16); }
#pragma unroll
        for (int ai = 0; ai < 2; ++ai)
#pragma unroll
            for (int m = 0; m < 4; ++m) { const size_t off = (size_t)(u.pm * 256 + ai * 128 + wr * 64 + m * 16 + fr) * D + col0;
#pragma unroll
                for (int bj = 0; bj < 2; ++bj)
#pragma unroll
                    for (int n = 0; n < 2; ++n) { const f32x4 bs = *(const f32x4*)(base + off + bj * 128 + n * 16); *(f32x4*)(out + off + bj * 128 + n * 16) = bs + gv[bj][n] * (acc[ai][bj][m][n] + bv[bj][n]); } }
    }
};
struct EpiGelu {
    static constexpr bool PERM = true;
    bf16 *U, *V; const float* bias; float* vstat;
    __device__ __forceinline__ void operator()(const f32x4 (&acc)[2][2][4][2], const pg8::Unit& u, int wr, int wc, int fr, int fq) const {
        const int row0 = u.pm * 256 + wr * 64 + fr; const int colt = u.pn * 256; const bool isv = colt >= 1024; bf16* base = isv ? V : U; const int cb = (colt & 1023) + wc * 32 + 8 * fq, bcol = colt + wc * 32 + 8 * fq;
        f32x4 bv[2][2];
#pragma unroll
        for (int bj = 0; bj < 2; ++bj)
#pragma unroll
            for (int n = 0; n < 2; ++n) bv[bj][n] = *(const f32x4*)(bias + bcol + bj * 128 + 4 * n);
#pragma unroll
        for (int ai = 0; ai < 2; ++ai)
#pragma unroll
            for (int m = 0; m < 4; ++m) { const int row = row0 + ai * 128 + m * 16; bf16* rowp = base + (size_t)row * D + cb; float s = 0.f, s2 = 0.f;
#pragma unroll
                for (int bj = 0; bj < 2; ++bj) { f32x4 v0 = acc[ai][bj][m][0] + bv[bj][0], v1 = acc[ai][bj][m][1] + bv[bj][1];
                    f32x2 a = gelu_pk((f32x2){v0[0], v0[1]}), b = gelu_pk((f32x2){v0[2], v0[3]}), c = gelu_pk((f32x2){v1[0], v1[1]}), d = gelu_pk((f32x2){v1[2], v1[3]});
                    s += (a.x + a.y) + (b.x + b.y) + (c.x + c.y) + (d.x + d.y); s2 += (a.x * a.x + a.y * a.y) + (b.x * b.x + b.y * b.y) + (c.x * c.x + c.y * c.y) + (d.x * d.x + d.y * d.y);
                    *(u32x4*)(rowp + bj * 128) = pack8((f32x4){a.x, a.y, b.x, b.y}, (f32x4){c.x, c.y, d.x, d.y}); }
                if (isv) { s += __shfl_xor(s, 16); s += __shfl_xor(s, 32); s2 += __shfl_xor(s2, 16); s2 += __shfl_xor(s2, 32);
                    if (fq == 0) { unsafeAtomicAdd(vstat + 2 * row, s); unsafeAtomicAdd(vstat + 2 * row + 1, s2); } } }
    }
};
struct EpiSwiglu {
    static constexpr bool PERM = true;
    bf16* ACT; const float* b1;
    __device__ __forceinline__ void operator()(const f32x4 (&acc)[2][2][4][2], const pg8::Unit& u, int wr, int wc, int fr, int fq) const {
        const int j0 = u.pn * 128 + wc * 32 + 8 * fq; const float* bb = b1 + (size_t)u.e * 2048;
        f32x4 bg[2], bu[2];
#pragma unroll
        for (int n = 0; n < 2; ++n) { bg[n] = *(const f32x4*)(bb + j0 + 4 * n); bu[n] = *(const f32x4*)(bb + 1024 + j0 + 4 * n); }
#pragma unroll
        for (int ai = 0; ai < 2; ++ai)
#pragma unroll
            for (int m = 0; m < 4; ++m) { f32x4 o[2];
#pragma unroll
                for (int n = 0; n < 2; ++n) { const f32x4 g4 = acc[ai][0][m][n] + bg[n], u4 = acc[ai][1][m][n] + bu[n];
#pragma unroll
                    for (int k = 0; k < 4; ++k) { const float g = fminf(g4[k], 7.0f), up = fminf(fmaxf(u4[k], -7.0f), 7.0f); o[n][k] = (up + 1.0f) * g * sigmoidf_(g * 1.702f); } }
                *(u32x4*)(ACT + (size_t)(u.pm + ai * 128 + wr * 64 + m * 16 + fr) * D + j0) = pack8(o[0], o[1]); }
    }
};
struct EpiDown {
    static constexpr bool PERM = true;
    bf16* Y; const float* b2; const int* list; const float* gatew; const LAS int* tab;
    __device__ __forceinline__ void operator()(const f32x4 (&acc)[2][2][4][2], const pg8::Unit& u, int wr, int wc, int fr, int fq) const {
        const int c8 = u.pn * 256 + wc * 32 + 8 * fq; const float* bb = b2 + (size_t)u.e * D;
        const int slot0 = u.pm - tab[544 + u.e]; const int* lp = list + (size_t)u.e * NTOK + slot0;
        int aid[2][4]; float gw[2][4];
#pragma unroll
        for (int ai = 0; ai < 2; ++ai)
#pragma unroll
            for (int m = 0; m < 4; ++m) { const int r = ai * 128 + wr * 64 + m * 16 + fr; aid[ai][m] = lp[r < u.cnt ? r : u.cnt - 1]; }
#pragma unroll
        for (int ai = 0; ai < 2; ++ai)
#pragma unroll
            for (int m = 0; m < 4; ++m) { gw[ai][m] = gatew[aid[ai][m]]; }
#pragma unroll
        for (int ai = 0; ai < 2; ++ai)
#pragma unroll
            for (int m = 0; m < 4; ++m) asm volatile("" : "+v"(aid[ai][m]), "+v"(gw[ai][m]));
#pragma unroll
        for (int bj = 0; bj < 2; ++bj) {
            f32x4 bv[2];
#pragma unroll
            for (int n = 0; n < 2; ++n) bv[n] = *(const f32x4*)(bb + c8 + bj * 128 + 4 * n);
            asm volatile("" : "+v"(bv[0]), "+v"(bv[1]));
#pragma unroll
            for (int ai = 0; ai < 2; ++ai)
#pragma unroll
                for (int m = 0; m < 4; ++m) { const int r = ai * 128 + wr * 64 + m * 16 + fr; const float g = gw[ai][m];
                    const u32x4 w = pack8((acc[ai][bj][m][0] + bv[0]) * g, (acc[ai][bj][m][1] + bv[1]) * g);
                    if (r < u.cnt) *(u32x4*)(Y + (size_t)aid[ai][m] * D + c8 + bj * 128) = w; }
        }
    }
};

struct TrItem { const float* src; bf16* dst; int N; };
__device__ __forceinline__ void tr_load(const TrItem& t, float (&v)[32], int lane) {
#pragma unroll
    for (int i = 0; i < 32; ++i) v[i] = t.src[(size_t)(2 * i + (lane >> 5)) * t.N + (lane & 31)];
}
__device__ __forceinline__ void tr_store(const TrItem& t, const float (&v)[32], LAS float* scr, int lane) {
#pragma unroll
    for (int i = 0; i < 32; ++i) scr[(2 * i + (lane >> 5)) * 33 + (lane & 31)] = v[i];
    LDS_WAIT();
    const int c = lane & 7;
#pragma unroll
    for (int j = 0; j < 4; ++j) { const int n = (lane >> 3) + 8 * j; const LAS float* s = scr + (8 * c) * 33 + n;
        u32x4 o; o.x = pk2(s[0 * 33], s[1 * 33]); o.y = pk2(s[2 * 33], s[3 * 33]); o.z = pk2(s[4 * 33], s[5 * 33]); o.w = pk2(s[6 * 33], s[7 * 33]);
        *(u32x4*)(t.dst + (size_t)n * 1024 + 8 * c) = o; }
    LDS_WAIT();
}
__device__ __forceinline__ int pair_src(int nd, int halfw) { return ((nd & 255) >> 7) * halfw + (nd >> 8) * 128 + (nd & 127); }

__device__ __forceinline__ void phase_prologue(const Args& a, const Ctx& X) {
    {
        LAS float* sc = (LAS float*)X.lds;
        LAS float* red = (LAS float*)(X.lds + 36864);
        float* MOD = (float*)(X.ws + WS_MOD);
        for (int item = blockIdx.x; item < 2 * 96; item += X.G) {
            const int l = item / 96, j0 = (item % 96) * 64;
            for (int idx = X.tid; idx < 9 * 1024; idx += NTHREADS) { const int r = idx >> 10, k = idx & 1023; const float v = r < 8 ? IN(I_C)[r * 1024 + k] : IN(I_CCTX)[k]; sc[idx] = v * sigmoidf_(v); }
            __syncthreads();
            float acc[9];
#pragma unroll
            for (int r = 0; r < 9; ++r) acc[r] = 0.f;
            const float* w = IN(I_ADAW) + (size_t)l * 1024 * MODW + j0 + X.lane;
#pragma unroll 8
            for (int k = X.wave * 128; k < X.wave * 128 + 128; ++k) { const float wv = w[(size_t)k * MODW];
#pragma unroll
                for (int r = 0; r < 9; ++r) acc[r] += sc[r * 1024 + k] * wv; }
#pragma unroll
            for (int r = 0; r < 9; ++r) red[(X.wave * 9 + r) * 64 + X.lane] = acc[r];
            __syncthreads();
            for (int t = X.tid; t < 9 * 64; t += NTHREADS) { const int r = t >> 6, cidx = t & 63; float s = 0.f;
#pragma unroll
                for (int w8 = 0; w8 < 8; ++w8) s += red[(w8 * 9 + r) * 64 + cidx];
                MOD[((size_t)l * 9 + r) * MODW + j0 + cidx] = s + IN(I_ADAB)[l * MODW + j0 + cidx]; }
            __syncthreads();
        }
    }
    LAS float* scr = (LAS float*)(X.lds + X.wave * 16384);
    bf16* WinT = (bf16*)(X.ws + WS_WINT); bf16* WoutT = (bf16*)(X.ws + WS_WOUTT); bf16* GWinT = (bf16*)(X.ws + WS_GWINT); bf16* GWoutT = (bf16*)(X.ws + WS_GWOUTT);
    bf16* W1T = (bf16*)(X.ws + WS_W1T); bf16* W2T = (bf16*)(X.ws + WS_W2T);
    constexpr int I_IN = 16 * (EVEN_IN / 32), I_OUT = 16 * 32, I_GIN = 16 * 64, I_GOUT = 16 * 32, I_M1 = 64 * 16 * 64, I_M2 = 64 * 16 * 32;
    constexpr int NITEMS = I_IN + I_OUT + I_GIN + I_GOUT + I_M1 + I_M2;
    auto item_of = [&](int it) -> TrItem {
        int r = it; TrItem t;
        if (r < I_M1) { const int mat = r >> 10, q = r & 1023, kb = q >> 6, nd = (q & 63) * 32; t.N = 2048; t.src = IN(I_W1) + (size_t)mat * 1024 * 2048 + (size_t)kb * 64 * 2048 + pair_src(nd, 1024); t.dst = W1T + (size_t)mat * 2048 * 1024 + (size_t)nd * 1024 + kb * 64; return t; } r -= I_M1;
        if (r < I_M2) { const int mat = r >> 9, q = r & 511, kb = q >> 5, nd = (q & 31) * 32; t.N = 1024; t.src = IN(I_W2) + (size_t)mat * 1024 * 1024 + (size_t)kb * 64 * 1024 + nd; t.dst = W2T + (size_t)mat * 1024 * 1024 + (size_t)nd * 1024 + kb * 64; return t; } r -= I_M2;
        if (r < I_IN) { const int kb = r / 56, nd = (r % 56) * 32; const int ns = nd < 1024 ? pair_src(nd, 512) : nd; t.N = EVEN_IN; t.src = IN(I_EWIN) + (size_t)kb * 64 * EVEN_IN + ns; t.dst = WinT + (size_t)nd * 1024 + kb * 64; return t; } r -= I_IN;
        if (r < I_OUT) { const int kb = r >> 5, nd = (r & 31) * 32; t.N = 1024; t.src = IN(I_EWOUT) + (size_t)kb * 64 * 1024 + nd; t.dst = WoutT + (size_t)nd * 1024 + kb * 64; return t; } r -= I_OUT;
        if (r < I_GIN) { const int kb = r >> 6, nd = (r & 63) * 32; t.N = 2048; t.src = IN(I_OWIN) + (size_t)kb * 64 * 2048 + nd; t.dst = GWinT + (size_t)nd * 1024 + kb * 64; return t; } r -= I_GIN;
        { const int kb = r >> 5, nd = (r & 31) * 32; t.N = 1024; t.src = IN(I_OWOUT) + (size_t)kb * 64 * 1024 + nd; t.dst = GWoutT + (size_t)nd * 1024 + kb * 64; return t; }
    };
    {
        float va[32], vb[32]; int it = X.gw;
        TrItem ta, tb; if (it < NITEMS) { ta = item_of(it); tr_load(ta, va, X.lane); }
        while (it < NITEMS) {
            const int it1 = it + X.NGW; if (it1 < NITEMS) { tb = item_of(it1); tr_load(tb, vb, X.lane); }
            tr_store(ta, va, scr, X.lane);
            if (it1 >= NITEMS) break;
            const int it2 = it1 + X.NGW; if (it2 < NITEMS) { ta = item_of(it2); tr_load(ta, va, X.lane); }
            tr_store(tb, vb, scr, X.lane);
            it = it2;
        }
    }
    { bf16* WsB = (bf16*)(X.ws + WS_WSB); const float* ws = IN(I_OWS);
      for (int i = (X.gw * 64 + X.lane) * 4; i < 8 * 128 * 128; i += X.NGW * 64 * 4) { const f32x4 v = *(const f32x4*)(ws + i); u32x2 o; o.x = pk2(v[0], v[1]); o.y = pk2(v[2], v[3]); *(u32x2*)(WsB + i) = o; } }
}

__device__ __forceinline__ void modulate_row(const float* xrow, const float* g, const float* sh, const float* sc, bf16* orow, int lane, f32x4 (&y)[4]) {
    const f32x4* xr = (const f32x4*)xrow + lane; f32x4 v[4]; float ss = 0.f;
#pragma unroll
    for (int j = 0; j < 4; ++j) { v[j] = xr[64 * j]; ss += (v[j][0] * v[j][0] + v[j][1] * v[j][1]) + (v[j][2] * v[j][2] + v[j][3] * v[j][3]); }
    const float rstd = rsqrtf(wave_sum(ss) * (1.0f / D) + EPS);
#pragma unroll
    for (int j = 0; j < 4; ++j) { const f32x4 gk = ((const f32x4*)g)[lane + 64 * j], sk = ((const f32x4*)sc)[lane + 64 * j], hk = ((const f32x4*)sh)[lane + 64 * j];
        y[j] = v[j] * rstd * gk * (1.0f + sk) + hk;
        u32x2 o; o.x = pk2(y[j][0], y[j][1]); o.y = pk2(y[j][2], y[j][3]); *((u32x2*)orow + lane + 64 * j) = o; }
}
__device__ __forceinline__ void phase_modulate0(const Args& a, const Ctx& X) {
    const float* MOD0 = (const float*)(X.ws + WS_MOD); f32x4 y[4];
    bf16* XA = (bf16*)(X.ws + WS_XA); bf16* GM = (bf16*)(X.ws + WS_GM);
    for (int row = X.gw; row < NTOK + NCTX; row += X.NGW) {
        if (row < NTOK) { const float* m = MOD0 + (size_t)(row / SEQ) * MODW; modulate_row(IN(I_X) + (size_t)row * D, IN(I_NMG), m, m + 1024, XA + (size_t)row * D, X.lane, y); }
        else { const int r = row - NTOK; const float* m = MOD0 + (size_t)8 * MODW; modulate_row(IN(I_CTX) + (size_t)r * D, IN(I_NMG), m, m + 1024, GM + (size_t)r * D, X.lane, y); }
    }
}

__device__ __forceinline__ void qk_chunks(bf16* buf, int nchunks, int rowlen, const float* gn, bool rope, float oscale, const Ctx& X, const LAS f32x2* cs) {
    for (int ch = X.gw; ch < nchunks; ch += X.NGW) {
        const int e0 = ch * 512 + 8 * X.lane; const int token = e0 / rowlen; const int d0 = e0 & 63;
        u32x4 raw = *(const u32x4*)(buf + e0); float v[8];
#pragma unroll
        for (int i = 0; i < 4; ++i) { v[2 * i] = bf2f(raw[i] & 0xffffu); v[2 * i + 1] = bf2f(raw[i] >> 16); }
        float ss = 0.f;
#pragma unroll
        for (int i = 0; i < 8; ++i) ss += v[i] * v[i];
        ss += __shfl_xor(ss, 1); ss += __shfl_xor(ss, 2); ss += __shfl_xor(ss, 4);
        const float rstd = rsqrtf(ss * (1.0f / 64.0f) + EPS);
        const f32x4 g0 = *(const f32x4*)(gn + d0), g1 = *(const f32x4*)(gn + d0 + 4);
#pragma unroll
        for (int i = 0; i < 4; ++i) { v[i] = v[i] * rstd * g0[i]; v[4 + i] = v[4 + i] * rstd * g1[i]; }
        if (rope) {
            const int t = token % SEQ; const int dd0 = d0 & 31; const int pos = dd0 < 16 ? (t >> 6) : (t & 63);
            const LAS f32x2* cp = cs + pos * 16 + (dd0 & 15);
#pragma unroll
            for (int i = 0; i < 8; ++i) { const float pv = __shfl_xor(v[i], 4); const f32x2 c = cp[i];
                v[i] = (d0 < 32) ? (v[i] * c.x - pv * c.y) : (v[i] * c.x + pv * c.y); }
        }
        u32x4 o; o.x = pk2(v[0] * oscale, v[1] * oscale); o.y = pk2(v[2] * oscale, v[3] * oscale); o.z = pk2(v[4] * oscale, v[5] * oscale); o.w = pk2(v[6] * oscale, v[7] * oscale);
        *(u32x4*)(buf + e0) = o;
    }
}
__device__ __forceinline__ void phase_conv_qk(const Args& a, const Ctx& X) {
    LAS f32x2* cs = (LAS f32x2*)(X.lds + 65536);
    for (int i = X.tid; i < 1024; i += NTHREADS) { const float inv = exp2f(-(float)(i & 15) * (13.287712379549449f / 16.0f)); float sn, csn; sincosf((float)(i >> 4) * inv, &sn, &csn); cs[i] = (f32x2){csn, sn}; }
    __syncthreads();
    qk_chunks((bf16*)(X.ws + WS_Q), NTOK, 512, IN(I_QNG), true, QSCALE, X, cs);
    qk_chunks((bf16*)(X.ws + WS_K), NTOK / 4, 128, IN(I_KNG), true, 1.0f, X, cs);
    qk_chunks((bf16*)(X.ws + WS_KC), NCTX / 4, 128, IN(I_KNG), false, 1.0f, X, cs);
    const bf16* GLU = (const bf16*)(X.ws + WS_GLU); bf16* MIX = (bf16*)(X.ws + WS_MIX);
    LAS unsigned* tin = (LAS unsigned*)X.lds;
    LAS float* tout = (LAS float*)(X.lds + 65536);
    const int cp = X.tid & 255, th = X.tid >> 8;
    float w0[31], w1[31];
#pragma unroll
    for (int j = 0; j < 31; ++j) { const f32x2 w = *(const f32x2*)(IN(I_ECW) + j * 512 + 2 * cp); w0[j] = w.x; w1[j] = w.y; }
    const f32x2 cb = *(const f32x2*)(IN(I_ECB) + 2 * cp);
    for (int tile = blockIdx.x; tile < NTOK / 32; tile += X.G) {
        const int row0 = tile * 32; const int t0 = row0 % SEQ;
        __syncthreads();
        for (int c = X.tid; c < 62 * 64; c += NTHREADS) { const int lr = c >> 6, cc = c & 63; const int t = t0 - 15 + lr;
            u32x4 v = (u32x4){0u, 0u, 0u, 0u}; if (t >= 0 && t < SEQ) v = *(const u32x4*)(GLU + (size_t)(row0 - 15 + lr) * 512 + cc * 8);
            *(LAS u32x4*)(tin + lr * 256 + cc * 4) = v; }
        __syncthreads();
        float a0[16], a1[16];
#pragma unroll
        for (int o = 0; o < 16; ++o) { a0[o] = cb.x; a1[o] = cb.y; }
#pragma unroll
        for (int rr = 0; rr < 46; ++rr) { const unsigned pv = tin[(16 * th + rr) * 256 + cp]; const float x0 = bf2f(pv & 0xffffu), x1 = bf2f(pv >> 16);
#pragma unroll
            for (int o = 0; o < 16; ++o) { const int j = rr - o; if (j >= 0 && j <= 30) { a0[o] += x0 * w0[j]; a1[o] += x1 * w1[j]; } } }
#pragma unroll
        for (int o = 0; o < 16; ++o) *(LAS f32x2*)(tout + (16 * th + o) * 512 + 2 * cp) = (f32x2){a0[o], a1[o]};
        __syncthreads();
#pragma unroll
        for (int q = 0; q < 4; ++q) { const int tl = X.wave * 4 + q; f32x4 v[2]; float s = 0.f;
#pragma unroll
            for (int j = 0; j < 2; ++j) { v[j] = *(const LAS f32x4*)(tout + tl * 512 + 4 * X.lane + 256 * j); s += (v[j][0] + v[j][1]) + (v[j][2] + v[j][3]); }
            const float mean = wave_sum(s) * (1.0f / 512.0f); float s2 = 0.f;
#pragma unroll
            for (int j = 0; j < 2; ++j) { v[j] = v[j] - mean; s2 += (v[j][0] * v[j][0] + v[j][1] * v[j][1]) + (v[j][2] * v[j][2] + v[j][3] * v[j][3]); }
            const float rstd = rsqrtf(wave_sum(s2) * (1.0f / 512.0f) + EPS);
#pragma unroll
            for (int j = 0; j < 2; ++j) { const f32x4 g = *(const f32x4*)(IN(I_ELNG) + 4 * X.lane + 256 * j), b = *(const f32x4*)(IN(I_ELNB) + 4 * X.lane + 256 * j);
                f32x4 y = v[j] * rstd * g + b;
#pragma unroll
                for (int k = 0; k < 4; ++k) y[k] = y[k] * sigmoidf_(y[k]);
                u32x2 o; o.x = pk2(y[0], y[1]); o.y = pk2(y[2], y[3]); *(u32x2*)(MIX + (size_t)(row0 + tl) * D + 4 * X.lane + 256 * j) = o; } }
    }
}

__device__ __forceinline__ void phase_attention(const Args& a, const Ctx& X) {
    const bf16* QN = (const bf16*)(X.ws + WS_Q); const bf16* KN = (const bf16*)(X.ws + WS_K); const bf16* VV = (const bf16*)(X.ws + WS_V);
    const bf16* KC = (const bf16*)(X.ws + WS_KC); const bf16* VC = (const bf16*)(X.ws + WS_VC); bf16* MIX = (bf16*)(X.ws + WS_MIX);
    LAS unsigned char* Ks = X.lds;
    LAS unsigned char* Vt = X.lds + 16384;
    const int lane = X.lane, l15 = lane & 15, g4 = lane >> 4;
    for (int unit = blockIdx.x; unit < NB * 2 * 32; unit += X.G) {
        const int b = unit >> 6, kh = (unit >> 5) & 1, qb = unit & 31; const int q0 = qb * 64;
        const int hq = kh * 4 + (X.wave >> 1), tq = (X.wave & 1) * 32;
        bf16x8 Qf[2][2];
#pragma unroll
        for (int qi = 0; qi < 2; ++qi)
#pragma unroll
            for (int s = 0; s < 2; ++s) Qf[qi][s] = *(const bf16x8*)(QN + (size_t)(b * SEQ + q0 + tq + 16 * qi + l15) * 512 + hq * 64 + 32 * s + 8 * g4);
        const float sink2 = IN(I_SINK)[hq] * LOG2E;
        float mrun[2], lrun[2]; f32x4 O[2][4];
#pragma unroll
        for (int qi = 0; qi < 2; ++qi) { mrun[qi] = sink2; lrun[qi] = (g4 == 0) ? 1.0f : 0.0f;
#pragma unroll
            for (int db = 0; db < 4; ++db) O[qi][db] = (f32x4){0.f, 0.f, 0.f, 0.f}; }
        const int t_first = (q0 >= 128) ? 0 : (q0 >= 64 ? 1 : 2), t_skip_lo = (q0 + 128 < SEQ) ? 5 : (q0 + 64 < SEQ ? 4 : 3);
        const int key = X.tid >> 3, ch = X.tid & 7;
        auto tile_ptrs = [&](int t, const bf16*& kp, const bf16*& vp) {
            if (t < 5) { const int ks = q0 - 128 + 64 * t; kp = KN + (size_t)(b * SEQ + ks) * 128 + kh * 64; vp = VV + (size_t)(b * SEQ + ks) * 128 + kh * 64; }
            else { const int ks = (t - 5) * 64; kp = KC + (size_t)(b * CTXL + ks) * 128 + kh * 64; vp = VC + (size_t)(b * CTXL + ks) * 128 + kh * 64; } };
        auto lds_put = [&](int buf, const u32x4& kv, const u32x4& vv) {
            LAS unsigned char* Kd = Ks + buf * 32768; LAS unsigned char* Vd = Vt + buf * 32768;
            *(LAS u32x4*)(Kd + key * 144 + ch * 16) = kv;
#pragma unroll
            for (int i = 0; i < 4; ++i) { *(LAS unsigned short*)(Vd + (8 * ch + 2 * i) * 136 + key * 2) = (unsigned short)(vv[i] & 0xffffu); *(LAS unsigned short*)(Vd + (8 * ch + 2 * i + 1) * 136 + key * 2) = (unsigned short)(vv[i] >> 16); } };
        u32x4 kreg, vreg;
        { const bf16 *kp, *vp; tile_ptrs(t_first, kp, vp); kreg = *(const u32x4*)(kp + (size_t)key * 128 + ch * 8); vreg = *(const u32x4*)(vp + (size_t)key * 128 + ch * 8); }
        __syncthreads();
        lds_put(0, kreg, vreg);
        int bufi = 0;
        for (int t = t_first; t < 9; ++t) {
            if (t >= t_skip_lo && t < 5) continue;
            int tn = t + 1; if (tn >= t_skip_lo && tn < 5) tn = 5;
            if (tn < 9) { const bf16 *kp, *vp; tile_ptrs(tn, kp, vp); kreg = *(const u32x4*)(kp + (size_t)key * 128 + ch * 8); vreg = *(const u32x4*)(vp + (size_t)key * 128 + ch * 8); }
            const int mode = (t == 0) ? 1 : (t == 4 ? 2 : 0);
            __syncthreads();
            const LAS unsigned char* Kc = Ks + bufi * 32768; const LAS unsigned char* Vc = Vt + bufi * 32768;
            bf16x8 kf[4][2];
#pragma unroll
            for (int kb = 0; kb < 4; ++kb)
#pragma unroll
                for (int s = 0; s < 2; ++s) kf[kb][s] = *(const LAS bf16x8*)(Kc + (16 * kb + l15) * 144 + (32 * s + 8 * g4) * 2);
            bf16x8 vf[4][2];
#pragma unroll
            for (int db = 0; db < 4; ++db)
#pragma unroll
                for (int ks2 = 0; ks2 < 2; ++ks2) { const LAS unsigned char* p = Vc + (16 * db + l15) * 136 + (32 * ks2 + 4 * g4) * 2;
                    const u32x2 lo = *(const LAS u32x2*)p, hi = *(const LAS u32x2*)(p + 32);
                    u32x4 w; w.x = lo.x; w.y = lo.y; w.z = hi.x; w.w = hi.y; vf[db][ks2] = __builtin_bit_cast(bf16x8, w); }
#pragma unroll
            for (int qi = 0; qi < 2; ++qi) {
                f32x4 st[4];
#pragma unroll
                for (int kb = 0; kb < 4; ++kb) { st[kb] = (f32x4){0.f, 0.f, 0.f, 0.f};
#pragma unroll
                    for (int s = 0; s < 2; ++s) st[kb] = __builtin_amdgcn_mfma_f32_16x16x32_bf16(kf[kb][s], Qf[qi][s], st[kb], 0, 0, 0); }
                if (mode) { const int qloc = tq + 16 * qi + l15;
#pragma unroll
                    for (int kb = 0; kb < 4; ++kb)
#pragma unroll
                        for (int r = 0; r < 4; ++r) { const int kk = 16 * kb + 4 * g4 + r; const bool keep = (mode == 1) ? (kk >= qloc) : (kk <= qloc); if (!keep) st[kb][r] = -1e30f; } }
                float mx = st[0][0];
#pragma unroll
                for (int kb = 0; kb < 4; ++kb)
#pragma unroll
                    for (int r = 0; r < 4; ++r) mx = fmaxf(mx, st[kb][r]);
                mx = fmaxf(mx, __shfl_xor(mx, 16)); mx = fmaxf(mx, __shfl_xor(mx, 32));
                const float mnew = fmaxf(mrun[qi], mx); const float alpha = __builtin_amdgcn_exp2f(mrun[qi] - mnew); mrun[qi] = mnew;
                float ps = 0.f;
#pragma unroll
                for (int kb = 0; kb < 4; ++kb)
#pragma unroll
                    for (int r = 0; r < 4; ++r) { st[kb][r] = __builtin_amdgcn_exp2f(st[kb][r] - mnew); ps += st[kb][r]; }
                lrun[qi] = lrun[qi] * alpha + ps;
#pragma unroll
                for (int db = 0; db < 4; ++db) O[qi][db] = O[qi][db] * alpha;
#pragma unroll
                for (int ks2 = 0; ks2 < 2; ++ks2) { u32x4 w; w.x = pk2(st[2 * ks2][0], st[2 * ks2][1]); w.y = pk2(st[2 * ks2][2], st[2 * ks2][3]); w.z = pk2(st[2 * ks2 + 1][0], st[2 * ks2 + 1][1]); w.w = pk2(st[2 * ks2 + 1][2], st[2 * ks2 + 1][3]);
                    const bf16x8 pf = __builtin_bit_cast(bf16x8, w);
#pragma unroll
                    for (int db = 0; db < 4; ++db) O[qi][db] = __builtin_amdgcn_mfma_f32_16x16x32_bf16(vf[db][ks2], pf, O[qi][db], 0, 0, 0); }
            }
            if (tn < 9) lds_put(bufi ^ 1, kreg, vreg);
            bufi ^= 1;
        }
#pragma unroll
        for (int qi = 0; qi < 2; ++qi) { float l = lrun[qi]; l += __shfl_xor(l, 16); l += __shfl_xor(l, 32); const float inv = 1.0f / l;
            bf16* orow = MIX + (size_t)(b * SEQ + q0 + tq + 16 * qi + l15) * D + 512 + hq * 64 + 4 * g4;
#pragma unroll
            for (int db = 0; db < 4; ++db) { u32x2 o; o.x = pk2(O[qi][db][0] * inv, O[qi][db][1] * inv); o.y = pk2(O[qi][db][2] * inv, O[qi][db][3] * inv); *(u32x2*)(orow + 16 * db) = o; } }
    }
}

__device__ __forceinline__ void phase_router(const Args& a, const Ctx& X, int layer) {
    const float* __restrict__ H = (const float*)(X.ws + WS_H); bf16* XA = (bf16*)(X.ws + WS_XA);
    const float* MODl = (const float*)(X.ws + WS_MOD) + (size_t)layer * 9 * MODW; const float* gn = IN(I_NFG) + layer * D;
    const float* rw = IN(I_RW) + (size_t)layer * D * NE; const float* rb = IN(I_RB) + layer * NE;
    int* cntg = (int*)(X.ws + WS_CTL) + CW_CNT + layer * NE; int* list = (int*)(X.ws + WS_LIST); float* gatew = (float*)(X.ws + WS_GATE);
    LAS float* ybuf = (LAS float*)X.lds;
    LAS float* part = (LAS float*)(X.lds + 65536);
    LAS int* sel = (LAS int*)(X.lds + 65536 + 16384);
    LAS int* lcnt = (LAS int*)(X.lds + 65536 + 16384 + 1024);
    const int e = X.lane & 31, hf = X.lane >> 5;
    float wreg[64];
#pragma unroll
    for (int i = 0; i < 64; ++i) wreg[i] = rw[(size_t)(128 * X.wave + 64 * hf + i) * NE + e];
    const float rbe = rb[e];
    for (int blk = blockIdx.x; blk < NTOK / 64; blk += X.G) {
        const int rowbase = blk * 64; const float* m = MODl + (size_t)(rowbase / SEQ) * MODW;
        f32x4 gk[4], sk[4], hk[4], xv[2][4];
#pragma unroll
        for (int j = 0; j < 4; ++j) { gk[j] = ((const f32x4*)gn)[X.lane + 64 * j]; hk[j] = ((const f32x4*)(m + 3 * 1024))[X.lane + 64 * j]; sk[j] = ((const f32x4*)(m + 4 * 1024))[X.lane + 64 * j]; }
#pragma unroll
        for (int i = 0; i < 2; ++i)
#pragma unroll
            for (int j = 0; j < 4; ++j) xv[i][j] = ((const f32x4*)(H + (size_t)(rowbase + 2 * X.wave + i) * D))[X.lane + 64 * j];
        __syncthreads();
        if (X.tid < 64) lcnt[X.tid] = 0;
        for (int bt = 0; bt < 4; ++bt) {
#pragma unroll
            for (int i = 0; i < 2; ++i) { const int rl = 2 * X.wave + i, row = rowbase + 16 * bt + rl; float ss = 0.f;
#pragma unroll
                for (int j = 0; j < 4; ++j) ss += (xv[i][j][0] * xv[i][j][0] + xv[i][j][1] * xv[i][j][1]) + (xv[i][j][2] * xv[i][j][2] + xv[i][j][3] * xv[i][j][3]);
                const float rstd = rsqrtf(wave_sum(ss) * (1.0f / D) + EPS);
#pragma unroll
                for (int j = 0; j < 4; ++j) { const f32x4 y = xv[i][j] * rstd * gk[j] * (1.0f + sk[j]) + hk[j];
                    u32x2 o; o.x = pk2(y[0], y[1]); o.y = pk2(y[2], y[3]); *((u32x2*)(XA + (size_t)row * D) + X.lane + 64 * j) = o;
                    *(LAS f32x4*)(ybuf + rl * 1024 + 4 * X.lane + 256 * j) = y; } }
            if (bt < 3) {
#pragma unroll
                for (int i = 0; i < 2; ++i)
#pragma unroll
                    for (int j = 0; j < 4; ++j) xv[i][j] = ((const f32x4*)(H + (size_t)(rowbase + 16 * (bt + 1) + 2 * X.wave + i) * D))[X.lane + 64 * j];
            }
            __syncthreads();
            for (int r = 0; r < 16; ++r) { float acc = 0.f; const LAS float* yp = ybuf + r * 1024 + 128 * X.wave + 64 * hf;
#pragma unroll
                for (int i4 = 0; i4 < 16; ++i4) { const f32x4 yv = *(const LAS f32x4*)(yp + 4 * i4); acc += yv[0] * wreg[4 * i4] + yv[1] * wreg[4 * i4 + 1] + yv[2] * wreg[4 * i4 + 2] + yv[3] * wreg[4 * i4 + 3]; }
                acc += __shfl_xor(acc, 32);
                if (hf == 0) part[(r * 8 + X.wave) * 32 + e] = acc; }
            __syncthreads();
            { const int r = 2 * X.wave + hf, rl = 16 * bt + r;
              float v = rbe;
#pragma unroll
              for (int w8 = 0; w8 < 8; ++w8) v += part[(r * 8 + w8) * 32 + e];
              float tv[4]; int ti[4];
#pragma unroll
              for (int k = 0; k < 4; ++k) { float bv = v; int bi = e;
#pragma unroll
                  for (int off = 16; off >= 1; off >>= 1) { const float ov = __shfl_xor(bv, off); const int oi = __shfl_xor(bi, off); if (ov > bv || (ov == bv && oi < bi)) { bv = ov; bi = oi; } }
                  tv[k] = bv; ti[k] = bi; if (e == bi) v = -3.0e38f; }
              float ex[4], sum = 0.f;
#pragma unroll
              for (int k = 0; k < 4; ++k) { ex[k] = __expf(tv[k] - tv[0]); sum += ex[k]; }
              const float inv = 1.0f / sum;
              if (e < 4) { const int ek = e == 0 ? ti[0] : e == 1 ? ti[1] : e == 2 ? ti[2] : ti[3]; const float gk_ = (e == 0 ? ex[0] : e == 1 ? ex[1] : e == 2 ? ex[2] : ex[3]) * inv;
                  const int rank = atomicAdd((int*)&lcnt[ek], 1); sel[rl * 4 + e] = (ek << 16) | rank; gatew[(size_t)(rowbase + rl) * 4 + e] = gk_; } }
        }
        __syncthreads();
        if (X.tid < 32) lcnt[32 + X.tid] = atomicAdd(cntg + X.tid, lcnt[X.tid]);
        __syncthreads();
        if (X.tid < 256) { const int w = sel[X.tid]; const int ee = w >> 16, rank = w & 0xffff; list[(size_t)ee * NTOK + lcnt[32 + ee] + rank] = rowbase * 4 + X.tid; }
    }
}

__device__ __forceinline__ void phase_combine(const Args& a, const Ctx& X, int layer) {
    float* H = (float*)(X.ws + WS_H); const bf16* __restrict__ Y = (const bf16*)(X.ws + WS_Y); bf16* XA = (bf16*)(X.ws + WS_XA);
    const float* __restrict__ MODl = (const float*)(X.ws + WS_MOD) + (size_t)layer * 9 * MODW;
    float* outp = (float*)(__attribute__((address_space(1))) float*)X.kp[33];
    for (int row = X.gw; row < NTOK; row += X.NGW) {
        const float* gt = MODl + (size_t)(row / SEQ) * MODW + 5 * 1024; f32x4 h[2][2], g[2][2]; u32x4 yw[2][4];
#pragma unroll
        for (int j = 0; j < 2; ++j) { const int c0 = 8 * X.lane + 512 * j;
#pragma unroll
            for (int q = 0; q < 2; ++q) { h[j][q] = *(const f32x4*)(H + (size_t)row * D + c0 + 4 * q); g[j][q] = *(const f32x4*)(gt + c0 + 4 * q); }
#pragma unroll
            for (int k = 0; k < 4; ++k) yw[j][k] = *(const u32x4*)(Y + ((size_t)row * 4 + k) * D + c0); }
        float ss = 0.f;
#pragma unroll
        for (int j = 0; j < 2; ++j) { f32x4 s0 = (f32x4){0.f, 0.f, 0.f, 0.f}, s1 = s0;
#pragma unroll
            for (int k = 0; k < 4; ++k) { const u32x4 w = yw[j][k]; s0 += (f32x4){bf2f(w.x & 0xffffu), bf2f(w.x >> 16), bf2f(w.y & 0xffffu), bf2f(w.y >> 16)}; s1 += (f32x4){bf2f(w.z & 0xffffu), bf2f(w.z >> 16), bf2f(w.w & 0xffffu), bf2f(w.w >> 16)}; }
            h[j][0] = h[j][0] + g[j][0] * s0; h[j][1] = h[j][1] + g[j][1] * s1;
#pragma unroll
            for (int q = 0; q < 2; ++q) ss += (h[j][q][0] * h[j][q][0] + h[j][q][1] * h[j][q][1]) + (h[j][q][2] * h[j][q][2] + h[j][q][3] * h[j][q][3]); }
        if (layer == 1) {
#pragma unroll
            for (int j = 0; j < 2; ++j)
#pragma unroll
                for (int q = 0; q < 2; ++q) *(f32x4*)(outp + (size_t)row * D + 8 * X.lane + 512 * j + 4 * q) = h[j][q];
        } else {
            const float* m1 = (const float*)(X.ws + WS_MOD) + (size_t)9 * MODW + (size_t)(row / SEQ) * MODW; const float* gn = IN(I_NMG) + D;
            f32x4 gk[2][2], hk[2][2], sk[2][2];
#pragma unroll
            for (int j = 0; j < 2; ++j)
#pragma unroll
                for (int q = 0; q < 2; ++q) { const int c0 = 8 * X.lane + 512 * j + 4 * q; gk[j][q] = *(const f32x4*)(gn + c0); hk[j][q] = *(const f32x4*)(m1 + c0); sk[j][q] = *(const f32x4*)(m1 + 1024 + c0); }
            const float rstd = rsqrtf(wave_sum(ss) * (1.0f / D) + EPS);
#pragma unroll
            for (int j = 0; j < 2; ++j) { const int c0 = 8 * X.lane + 512 * j;
                const f32x4 y0 = h[j][0] * rstd * gk[j][0] * (1.0f + sk[j][0]) + hk[j][0], y1 = h[j][1] * rstd * gk[j][1] * (1.0f + sk[j][1]) + hk[j][1];
                *(f32x4*)(H + (size_t)row * D + c0) = h[j][0]; *(f32x4*)(H + (size_t)row * D + c0 + 4) = h[j][1];
                *(u32x4*)(XA + (size_t)row * D + c0) = pack8(y0, y1); }
        }
    }
}

__device__ __forceinline__ void phase_spatial(const Args& a, const Ctx& X) {
    const bf16* U = (const bf16*)(X.ws + WS_U); const bf16* VB = (const bf16*)(X.ws + WS_VB); bf16* SG = (bf16*)(X.ws + WS_MIX); const bf16* WsB = (const bf16*)(X.ws + WS_WSB); const float* vstat = (const float*)(X.ws + WS_CTL) + CW_VSTAT;
    LAS float* stat = (LAS float*)X.lds;
    LAS unsigned char* Vt = X.lds + 4096;
    const int lane = X.lane, l15 = lane & 15, g4 = lane >> 4;
    for (int item = blockIdx.x; item < 128 * 8; item += X.G) {
        const int chunk = item >> 3, g = item & 7; const int row0 = chunk * 128;
        __syncthreads();
        if (X.tid < 128) { const f32x2 sv = *(const f32x2*)(vstat + 2 * (row0 + X.tid)); const float mean = sv.x * (1.0f / D); const float var = fmaxf(sv.y * (1.0f / D) - mean * mean, 0.f);
            stat[2 * X.tid] = mean; stat[2 * X.tid + 1] = rsqrtf(var + EPS); }
        __syncthreads();
#pragma unroll
        for (int c = X.tid; c < 128 * 16; c += NTHREADS) { const int q = c >> 4, cc = c & 15; const u32x4 w = *(const u32x4*)(VB + (size_t)(row0 + q) * D + g * 128 + cc * 8);
            const float mean = stat[2 * q], rstd = stat[2 * q + 1]; const float* lg_ = IN(I_OLNG) + g * 128 + cc * 8; const float* lb_ = IN(I_OLNB) + g * 128 + cc * 8;
#pragma unroll
            for (int k = 0; k < 4; ++k) { const float y0 = (bf2f(w[k] & 0xffffu) - mean) * rstd * lg_[2 * k] + lb_[2 * k], y1 = (bf2f(w[k] >> 16) - mean) * rstd * lg_[2 * k + 1] + lb_[2 * k + 1];
                const unsigned pk = pk2(y0, y1);
                *(LAS unsigned short*)(Vt + ((2 * k) * 17 + cc) * 272 + q * 2) = (unsigned short)(pk & 0xffffu); *(LAS unsigned short*)(Vt + ((2 * k + 1) * 17 + cc) * 272 + q * 2) = (unsigned short)(pk >> 16); } }
        __syncthreads();
        f32x4 acc[8];
#pragma unroll
        for (int pb = 0; pb < 8; ++pb) acc[pb] = (f32x4){0.f, 0.f, 0.f, 0.f};
#pragma unroll
        for (int s = 0; s < 4; ++s) { const bf16x8 af = *(const LAS bf16x8*)(Vt + ((l15 & 7) * 17 + 2 * X.wave + (l15 >> 3)) * 272 + (32 * s + 8 * g4) * 2);
#pragma unroll
            for (int pb = 0; pb < 8; ++pb) { const bf16x8 bfr = *(const bf16x8*)(WsB + ((size_t)g * 128 + 16 * pb + l15) * 128 + 32 * s + 8 * g4); acc[pb] = __builtin_amdgcn_mfma_f32_16x16x32_bf16(af, bfr, acc[pb], 0, 0, 0); } }
#pragma unroll
        for (int pb = 0; pb < 8; ++pb) { const int p = 16 * pb + l15; const float bs = IN(I_OBS)[g * 128 + p]; const size_t off = (size_t)(row0 + p) * D + g * 128 + 16 * X.wave + 4 * g4;
            const u32x2 uw = *(const u32x2*)(U + off);
            u32x2 o; o.x = pk2(bf2f(uw.x & 0xffffu) * (acc[pb][0] + bs), bf2f(uw.x >> 16) * (acc[pb][1] + bs)); o.y = pk2(bf2f(uw.y & 0xffffu) * (acc[pb][2] + bs), bf2f(uw.y >> 16) * (acc[pb][3] + bs));
            *(u32x2*)(SG + off) = o; }
    }
}

enum { PH_PRO = 0, PH_MOD0, PH_GIN, PH_CONV, PH_ATT, PH_GOUT, PH_RT0, PH_M1_0, PH_M2_0, PH_CMB0, PH_GMI, PH_SPA, PH_GMO, PH_RT1, PH_M1_1, PH_M2_1, PH_CMB1, NPHASE };

__global__ void __launch_bounds__(NTHREADS, 2) mega(Args a) {
    extern __shared__ __attribute__((aligned(16))) unsigned char lds_raw[];
    Ctx X; X.lds = (LAS unsigned char*)lds_raw;
    const int wave0 = __builtin_amdgcn_readfirstlane((int)threadIdx.x >> 6);
    X.G = gridDim.x; { const int bx = blockIdx.x; X.vcu = (X.G % 8 == 0) ? (bx % 8) * (X.G / 8) + bx / 8 : bx; }
    X.NGW = X.G * NWAVES; X.wave = wave0;
    volatile LAS unsigned* MISC = (volatile LAS unsigned*)(X.lds + MISC_OFF);
    if (threadIdx.x < 64) MISC[threadIdx.x] = 0u;
    __syncthreads();
    XcdBarrier bar = xcd_barrier_post((unsigned*)(a.ws + WS_CTL) + CW_BAR + a.li * XCD_BAR_WORDS, MISC + 8);
    const int ph_lo = a.ph_lo, ph_hi = a.ph_hi;
#define PH_ENTER() int z; asm volatile("s_mov_b32 %0, 0" : "=s"(z)); \
        X.lane = (int)__builtin_amdgcn_mbcnt_hi(~0u, __builtin_amdgcn_mbcnt_lo(~0u, (unsigned)z)); X.tid = wave0 * 64 + X.lane; X.gw = X.vcu * NWAVES + wave0; \
        { kargp_t kp = (kargp_t)__builtin_amdgcn_kernarg_segment_ptr(); asm volatile("" : "+s"(kp)); X.kp = kp; } \
        unsigned char* ws = (unsigned char*)(__attribute__((address_space(1))) unsigned char*)X.kp[34] + z; X.ws = ws;
#if PROBE_PH >= 0
    unsigned long long pr_t0 = 0, pr_t1 = 0;
#endif
    for (int ph = ph_lo; ph < ph_hi; ++ph) {
        if (ph != ph_lo) { const int l0 = (int)__builtin_amdgcn_mbcnt_hi(~0u, __builtin_amdgcn_mbcnt_lo(~0u, 0u)); xcd_barrier(bar, wave0 * 64 + l0); }
#if PROBE_PH >= 0
        if (ph == PROBE_PH) pr_t0 = __builtin_amdgcn_s_memrealtime();
        if (ph == PROBE_END) pr_t1 = __builtin_amdgcn_s_memrealtime();
#endif
        switch (ph) {
        case PH_PRO: { PH_ENTER(); phase_prologue(a, X); } break;
        case PH_MOD0: { PH_ENTER(); phase_modulate0(a, X); } break;
        case PH_GIN: { PH_ENTER(); DenseSched S; S.init((const bf16*)(ws + WS_XA), (const bf16*)(ws + WS_WINT), NTOK, EVEN_IN, X.G, (int)blockIdx.x);
            S.A2 = (const bf16*)(ws + WS_GM); S.Bt2 = (const bf16*)(ws + WS_WINT) + (size_t)KV_COL * D; S.nM2 = NCTX / 256;
            EpiIn E{(bf16*)(ws + WS_GLU), (bf16*)(ws + WS_Q), (bf16*)(ws + WS_K), (bf16*)(ws + WS_V), (bf16*)(ws + WS_KC), (bf16*)(ws + WS_VC), IN(I_EBIN)};
            pg8::gemm_phase<EpiIn, DenseSched>(X.lds, S, E, X.tid); } break;
        case PH_CONV: { PH_ENTER(); phase_conv_qk(a, X); } break;
        case PH_ATT: { PH_ENTER(); phase_attention(a, X); } break;
        case PH_GOUT: { PH_ENTER(); DenseSched S; S.init((const bf16*)(ws + WS_MIX), (const bf16*)(ws + WS_WOUTT), NTOK, D, X.G, (int)blockIdx.x);
            EpiRes E{IN(I_X), (float*)(ws + WS_H), IN(I_EBOUT), (const float*)(ws + WS_MOD) + 2 * 1024};
            pg8::gemm_phase<EpiRes, DenseSched>(X.lds, S, E, X.tid); } break;
        case PH_RT0: { PH_ENTER(); phase_router(a, X, 0); } break;
        case PH_RT1: { PH_ENTER(); phase_router(a, X, 1); } break;
        case PH_M1_0: case PH_M1_1: { PH_ENTER(); const int l = (ph == PH_M1_1); moe_build_table(X, (const int*)(ws + WS_CTL) + CW_CNT + l * NE);
            MoeSchedT<true, 8> S; S.tab = (const LAS int*)(X.lds + TAB_OFF); S.G = X.G; S.c = X.vcu; S.A = (const bf16*)(ws + WS_XA); S.Bt = (const bf16*)(ws + WS_W1T) + (size_t)l * NE * 2048 * 1024; S.list = (const int*)(ws + WS_LIST);
            EpiSwiglu E{(bf16*)(ws + WS_ACT), IN(I_B1) + (size_t)l * NE * 2048};
            pg8::gemm_phase<EpiSwiglu, MoeSchedT<true, 8>>(X.lds, S, E, X.tid); } break;
        case PH_M2_0: case PH_M2_1: { PH_ENTER(); const int l = (ph == PH_M2_1); moe_build_table(X, (const int*)(ws + WS_CTL) + CW_CNT + l * NE);
            MoeSchedT<false, 4> S; S.tab = (const LAS int*)(X.lds + TAB_OFF); S.G = X.G; S.c = X.vcu; S.A = (const bf16*)(ws + WS_ACT); S.Bt = (const bf16*)(ws + WS_W2T) + (size_t)l * NE * 1024 * 1024; S.list = (const int*)(ws + WS_LIST);
            EpiDown E{(bf16*)(ws + WS_Y), IN(I_B2) + (size_t)l * NE * D, (const int*)(ws + WS_LIST), (const float*)(ws + WS_GATE), (const LAS int*)(X.lds + TAB_OFF)};
            pg8::gemm_phase<EpiDown, MoeSchedT<false, 4>>(X.lds, S, E, X.tid); } break;
        case PH_CMB0: { PH_ENTER(); phase_combine(a, X, 0); } break;
        case PH_CMB1: { PH_ENTER(); phase_combine(a, X, 1); } break;
        case PH_GMI: { PH_ENTER(); DenseSched S; S.init((const bf16*)(ws + WS_XA), (const bf16*)(ws + WS_GWINT), NTOK, 2048, X.G, (int)blockIdx.x);
            EpiGelu E{(bf16*)(ws + WS_U), (bf16*)(ws + WS_VB), IN(I_OBIN), (float*)(ws + WS_CTL) + CW_VSTAT};
            pg8::gemm_phase<EpiGelu, DenseSched>(X.lds, S, E, X.tid); } break;
        case PH_SPA: { PH_ENTER(); phase_spatial(a, X); } break;
        case PH_GMO: { PH_ENTER(); DenseSched S; S.init((const bf16*)(ws + WS_MIX), (const bf16*)(ws + WS_GWOUTT), NTOK, D, X.G, (int)blockIdx.x);
            EpiRes E{(const float*)(ws + WS_H), (float*)(ws + WS_H), IN(I_OBOUT), (const float*)(ws + WS_MOD) + (size_t)9 * MODW + 2 * 1024};
            pg8::gemm_phase<EpiRes, DenseSched>(X.lds, S, E, X.tid); } break;
        default: break;
        }
    }
#if PROBE_PH >= 0
    if (pr_t1 == 0) pr_t1 = __builtin_amdgcn_s_memrealtime();
    if (blockIdx.x == 0 && wave0 == 0) { const unsigned long long te = __builtin_amdgcn_s_memrealtime(); const unsigned long long span = (pr_t1 - pr_t0) * PROBE_MULT;
        while (__builtin_amdgcn_s_memrealtime() - te < span) __builtin_amdgcn_s_sleep(8); }
#endif
}

__device__ __forceinline__ bool find_expert(const int* cnt, int s, int& e, int& slot) {
    int pb = 0;
    for (int i = 0; i < NE; ++i) { const int c = cnt[i]; const int pr = ((c + 255) >> 8) << 8; if (s < pb + pr) { e = i; slot = s - pb; return true; } pb += pr; }
    return false;
}
__global__ void __launch_bounds__(256) slow_gemm(const bf16* A, const int* arow, const bf16* Bt, float* C, int N, const int* cnt, size_t bstride) {
    __shared__ float As[16][65], Bs[16][65];
    const int tx = threadIdx.x & 15, ty = threadIdx.x >> 4; const int m0 = blockIdx.y * 64, n0 = blockIdx.x * 64;
    if (cnt) { int e, slot; if (!find_expert(cnt, m0, e, slot)) return; Bt += (size_t)e * bstride; }
    float acc[4][4];
    for (int i = 0; i < 4; ++i) for (int j = 0; j < 4; ++j) acc[i][j] = 0.f;
    for (int k0 = 0; k0 < 1024; k0 += 16) {
        for (int i = 0; i < 4; ++i) { const int idx = threadIdx.x + 256 * i; const int r = idx >> 4, kk = idx & 15; const int gm = m0 + r; const int ar = arow ? arow[gm] : gm;
            As[kk][r] = bf2f(A[(size_t)ar * 1024 + k0 + kk]); Bs[kk][r] = bf2f(Bt[(size_t)(n0 + r) * 1024 + k0 + kk]); }
        __syncthreads();
        for (int kk = 0; kk < 16; ++kk) { float av[4], bv[4];
            for (int i = 0; i < 4; ++i) { av[i] = As[kk][ty * 4 + i]; bv[i] = Bs[kk][tx * 4 + i]; }
            for (int i = 0; i < 4; ++i) for (int j = 0; j < 4; ++j) acc[i][j] += av[i] * bv[j]; }
        __syncthreads();
    }
    for (int i = 0; i < 4; ++i) for (int j = 0; j < 4; ++j) C[(size_t)(m0 + ty * 4 + i) * N + n0 + tx * 4 + j] = acc[i][j];
}
__device__ __forceinline__ unsigned short f2bf_s(float f) { return (unsigned short)(pk2(f, 0.f) & 0xffffu); }
__global__ void slow_epi_in(const float* C, const float* C2, const float* bias, bf16* GLU, bf16* Q, bf16* Kb, bf16* Vb, bf16* KC, bf16* VC) {
    const size_t i = (size_t)blockIdx.x * blockDim.x + threadIdx.x;
    if (i < (size_t)NTOK * 512) { const int row = (int)(i >> 9), j = (int)(i & 511); const int t = j >> 7, ii = j & 127; const float* cr = C + (size_t)row * EVEN_IN;
        const float u = cr[t * 256 + ii] + bias[j], g = cr[t * 256 + 128 + ii] + bias[512 + j];
        GLU[i] = f2bf_s(u / (1.0f + expf(-g)));
        Q[i] = f2bf_s(cr[1024 + j] + bias[1024 + j]);
        if (j < 128) { Kb[(size_t)row * 128 + j] = f2bf_s(cr[1536 + j] + bias[1536 + j]); Vb[(size_t)row * 128 + j] = f2bf_s(cr[1664 + j] + bias[1664 + j]); }
        if (row < NCTX && j < 128) { KC[(size_t)row * 128 + j] = f2bf_s(C2[(size_t)row * 256 + j] + bias[1536 + j]); VC[(size_t)row * 128 + j] = f2bf_s(C2[(size_t)row * 256 + 128 + j] + bias[1664 + j]); } }
}
__global__ void slow_epi_res(const float* C, const float* base, float* out, const float* bias, const float* gate) {
    const size_t i = (size_t)blockIdx.x * blockDim.x + threadIdx.x;
    if (i < (size_t)NTOK * D) { const int row = (int)(i >> 10), col = (int)(i & 1023); out[i] = base[i] + gate[(size_t)(row / SEQ) * MODW + col] * (C[i] + bias[col]); }
}
__global__ void slow_epi_gelu(const float* C, const float* bias, bf16* U, bf16* V) {
    const size_t i = (size_t)blockIdx.x * blockDim.x + threadIdx.x;
    if (i < (size_t)NTOK * 2048) { const int row = (int)(i >> 11), col = (int)(i & 2047); const float x = C[i] + bias[col]; const float y = 0.5f * x * (1.0f + erff(x * 0.70710678118654752f));
        if (col < 1024) U[(size_t)row * D + col] = f2bf_s(y); else V[(size_t)row * D + col - 1024] = f2bf_s(y); }
}
__global__ void slow_arow(const int* cnt, const int* list, int* arow) {
    const int s = blockIdx.x * blockDim.x + threadIdx.x; if (s >= ACT_ROWS) return;
    int e, slot; int r = 0; if (find_expert(cnt, s, e, slot) && slot < cnt[e]) r = list[(size_t)e * NTOK + slot] >> 2;
    arow[s] = r;
}
__global__ void slow_epi_swiglu(const float* C, const int* cnt, const float* b1, bf16* ACT) {
    const size_t i = (size_t)blockIdx.x * blockDim.x + threadIdx.x;
    if (i < (size_t)ACT_ROWS * 1024) { const int s = (int)(i >> 10), j = (int)(i & 1023); int e, slot; if (!find_expert(cnt, s, e, slot)) return;
        const int t = j >> 7, ii = j & 127; const float* cr = C + (size_t)s * 2048;
        float g = cr[t * 256 + ii] + b1[(size_t)e * 2048 + j], up = cr[t * 256 + 128 + ii] + b1[(size_t)e * 2048 + 1024 + j];
        g = fminf(g, 7.0f); up = fminf(fmaxf(up, -7.0f), 7.0f);
        ACT[i] = f2bf_s((up + 1.0f) * g / (1.0f + expf(-1.702f * g))); }
}
__global__ void slow_epi_down(const float* C, const int* cnt, const int* list, const float* gatew, const float* b2, bf16* Y) {
    const size_t i = (size_t)blockIdx.x * blockDim.x + threadIdx.x;
    if (i < (size_t)ACT_ROWS * 1024) { const int s = (int)(i >> 10), col = (int)(i & 1023); int e, slot; if (!find_expert(cnt, s, e, slot) || slot >= cnt[e]) return;
        const int aid = list[(size_t)e * NTOK + slot]; Y[(size_t)aid * D + col] = f2bf_s((C[i] + b2[(size_t)e * D + col]) * gatew[aid]); }
}
__global__ void __launch_bounds__(64) slow_attention(const bf16* QN, const bf16* KN, const bf16* VV, const bf16* KC, const bf16* VC, const float* sink, bf16* MIX) {
    const int i = blockIdx.x * blockDim.x + threadIdx.x; if (i >= NTOK * 8) return;
    const int row = i >> 3, h = i & 7, kh = h >> 2, b = row / SEQ, t = row % SEQ;
    float q[64], o[64];
    for (int d = 0; d < 64; ++d) { q[d] = bf2f(QN[(size_t)row * 512 + h * 64 + d]); o[d] = 0.f; }
    float m = sink[h] * LOG2E, l = 1.0f;
    const int j0 = t - 128 < 0 ? 0 : t - 128, j1 = t + 128 > SEQ - 1 ? SEQ - 1 : t + 128;
    for (int jj = j0; jj <= j1 + CTXL; ++jj) {
        const bf16* kp; const bf16* vp;
        if (jj <= j1) { kp = KN + (size_t)(b * SEQ + jj) * 128 + kh * 64; vp = VV + (size_t)(b * SEQ + jj) * 128 + kh * 64; }
        else { const int c = jj - j1 - 1; kp = KC + (size_t)(b * CTXL + c) * 128 + kh * 64; vp = VC + (size_t)(b * CTXL + c) * 128 + kh * 64; }
        float s = 0.f; for (int d = 0; d < 64; ++d) s += q[d] * bf2f(kp[d]);
        const float mn = fmaxf(m, s), al = exp2f(m - mn), p = exp2f(s - mn); m = mn; l = l * al + p;
        for (int d = 0; d < 64; ++d) o[d] = o[d] * al + p * bf2f(vp[d]);
    }
    for (int d = 0; d < 64; ++d) MIX[(size_t)row * D + 512 + h * 64 + d] = f2bf_s(o[d] / l);
}
__global__ void slow_vstats(const bf16* VB, float* stat) {
    const int row = blockIdx.x * blockDim.x + threadIdx.x; if (row >= NTOK) return;
    float s = 0.f; for (int c = 0; c < D; ++c) s += bf2f(VB[(size_t)row * D + c]); const float mean = s / D;
    float s2 = 0.f; for (int c = 0; c < D; ++c) { const float d = bf2f(VB[(size_t)row * D + c]) - mean; s2 += d * d; }
    stat[2 * row] = mean; stat[2 * row + 1] = rsqrtf(s2 / D + EPS);
}
__global__ void slow_spatial(const bf16* U, const bf16* VB, const float* stat, const float* ws, const float* bs, const float* lng, const float* lnb, bf16* SG) {
    const size_t i = (size_t)blockIdx.x * blockDim.x + threadIdx.x;
    if (i < (size_t)NTOK * D) { const int row = (int)(i >> 10), ch = (int)(i & 1023); const int g = ch >> 7, p = row & 127, r0 = row - p;
        float s = 0.f;
        for (int q = 0; q < 128; ++q) { const float vn = (bf2f(VB[(size_t)(r0 + q) * D + ch]) - stat[2 * (r0 + q)]) * stat[2 * (r0 + q) + 1] * lng[ch] + lnb[ch]; s += ws[((size_t)g * 128 + p) * 128 + q] * vn; }
        SG[i] = f2bf_s(bf2f(U[i]) * (s + bs[g * 128 + p])); }
}

static void launch_mega(Args& a, int lo, int hi, int& li, int grid, hipStream_t stream) {
    a.ph_lo = lo; a.ph_hi = hi; a.li = li++;
    hipLaunchKernelGGL(mega, dim3(grid), dim3(NTHREADS), LDS_BYTES, stream, a);
}
extern "C" void kernel_launch(void* const* d_in, const int* in_sizes, int n_in, void* d_out, int out_size, void* d_ws, size_t ws_size, hipStream_t stream) {
    static int grid = 0;
    if (grid == 0) {
        if (n_in != 33 || out_size != NTOK * D || ws_size < WS_END) { fprintf(stderr, "kernel_launch: unexpected problem (n_in %d, out %d, ws %zu)\n", n_in, out_size, ws_size); grid = -1; return; }
        int dev = 0, cus = 0, per_cu = 0;
        if (hipGetDevice(&dev) != hipSuccess || hipDeviceGetAttribute(&cus, hipDeviceAttributeMultiprocessorCount, dev) != hipSuccess) { grid = -1; return; }
        if (hipFuncSetAttribute((const void*)mega, hipFuncAttributeMaxDynamicSharedMemorySize, LDS_BYTES) != hipSuccess) { fprintf(stderr, "kernel_launch: hipFuncSetAttribute failed\n"); grid = -1; return; }
        if (hipOccupancyMaxActiveBlocksPerMultiprocessor(&per_cu, (const void*)mega, NTHREADS, LDS_BYTES) != hipSuccess || per_cu < 1) { fprintf(stderr, "kernel_launch: occupancy query says %d blocks per CU\n", per_cu); per_cu = 1; }
        (void)hipGetLastError();
        grid = cus;
    }
    if (grid < 0) return;
    unsigned char* ws = (unsigned char*)d_ws;
    (void)hipMemsetAsync(ws + WS_CTL, 0, CTL_ZERO_BYTES, stream);
    Args a{};
    for (int i = 0; i < 33; ++i) a.in[i] = (const float*)d_in[i];
    a.out = (float*)d_out; a.ws = ws;
    int li = 0;
    const float* in_[33]; for (int i = 0; i < 33; ++i) in_[i] = (const float*)d_in[i];
    float* CF = (float*)(ws + WS_CF); float* MOD = (float*)(ws + WS_MOD); int* CNT = (int*)(ws + WS_CTL) + CW_CNT;
    int lo = 0;
    auto flush = [&](int upto) { if (upto > lo) launch_mega(a, lo, upto, li, grid, stream); };
    for (int ph = 0; ph < NPHASE; ++ph) {
        bool slow = false;
        switch (ph) {
        case PH_GIN: slow = SLOW_MASK & 1; break;
        case PH_ATT: slow = SLOW_MASK & 2; break;
        case PH_GOUT: case PH_GMO: slow = SLOW_MASK & 4; break;
        case PH_M1_0: case PH_M1_1: slow = SLOW_MASK & 8; break;
        case PH_M2_0: case PH_M2_1: slow = SLOW_MASK & 16; break;
        case PH_GMI: slow = SLOW_MASK & 32; break;
        case PH_SPA: slow = SLOW_MASK & 64; break;
        default: break;
        }
        if (!slow) continue;
        flush(ph); lo = ph + 1;
        const int l = (ph == PH_M1_1 || ph == PH_M2_1) ? 1 : 0;
        switch (ph) {
        case PH_GIN:
            hipLaunchKernelGGL(slow_gemm, dim3(EVEN_IN / 64, NTOK / 64), dim3(256), 0, stream, (const bf16*)(ws + WS_XA), (const int*)nullptr, (const bf16*)(ws + WS_WINT), CF, EVEN_IN, (const int*)nullptr, (size_t)0);
            hipLaunchKernelGGL(slow_gemm, dim3(256 / 64, NCTX / 64), dim3(256), 0, stream, (const bf16*)(ws + WS_GM), (const int*)nullptr, (const bf16*)(ws + WS_WINT) + (size_t)KV_COL * D, CF + (size_t)NTOK * EVEN_IN, 256, (const int*)nullptr, (size_t)0);
            hipLaunchKernelGGL(slow_epi_in, dim3(NTOK * 512 / 256), dim3(256), 0, stream, (const float*)CF, (const float*)(CF + (size_t)NTOK * EVEN_IN), in_[I_EBIN], (bf16*)(ws + WS_GLU), (bf16*)(ws + WS_Q), (bf16*)(ws + WS_K), (bf16*)(ws + WS_V), (bf16*)(ws + WS_KC), (bf16*)(ws + WS_VC));
            break;
        case PH_ATT:
            hipLaunchKernelGGL(slow_attention, dim3(NTOK * 8 / 64), dim3(64), 0, stream, (const bf16*)(ws + WS_Q), (const bf16*)(ws + WS_K), (const bf16*)(ws + WS_V), (const bf16*)(ws + WS_KC), (const bf16*)(ws + WS_VC), in_[I_SINK], (bf16*)(ws + WS_MIX));
            break;
        case PH_GOUT:
            hipLaunchKernelGGL(slow_gemm, dim3(D / 64, NTOK / 64), dim3(256), 0, stream, (const bf16*)(ws + WS_MIX), (const int*)nullptr, (const bf16*)(ws + WS_WOUTT), CF, D, (const int*)nullptr, (size_t)0);
            hipLaunchKernelGGL(slow_epi_res, dim3(NTOK * D / 256), dim3(256), 0, stream, (const float*)CF, in_[I_X], (float*)(ws + WS_H), in_[I_EBOUT], (const float*)(MOD + 2 * 1024));
            break;
        case PH_GMO:
            hipLaunchKernelGGL(slow_gemm, dim3(D / 64, NTOK / 64), dim3(256), 0, stream, (const bf16*)(ws + WS_MIX), (const int*)nullptr, (const bf16*)(ws + WS_GWOUTT), CF, D, (const int*)nullptr, (size_t)0);
            hipLaunchKernelGGL(slow_epi_res, dim3(NTOK * D / 256), dim3(256), 0, stream, (const float*)CF, (const float*)(ws + WS_H), (float*)(ws + WS_H), in_[I_OBOUT], (const float*)(MOD + (size_t)9 * MODW + 2 * 1024));
            break;
        case PH_M1_0: case PH_M1_1:
            hipLaunchKernelGGL(slow_arow, dim3(ACT_ROWS / 256), dim3(256), 0, stream, (const int*)(CNT + l * NE), (const int*)(ws + WS_LIST), (int*)(ws + WS_AROW));
            hipLaunchKernelGGL(slow_gemm, dim3(2048 / 64, ACT_ROWS / 64), dim3(256), 0, stream, (const bf16*)(ws + WS_XA), (const int*)(ws + WS_AROW), (const bf16*)(ws + WS_W1T) + (size_t)l * NE * 2048 * 1024, CF, 2048, (const int*)(CNT + l * NE), (size_t)2048 * 1024);
            hipLaunchKernelGGL(slow_epi_swiglu, dim3(ACT_ROWS * 1024 / 256), dim3(256), 0, stream, (const float*)CF, (const int*)(CNT + l * NE), in_[I_B1] + (size_t)l * NE * 2048, (bf16*)(ws + WS_ACT));
            break;
        case PH_M2_0: case PH_M2_1:
            hipLaunchKernelGGL(slow_gemm, dim3(1024 / 64, ACT_ROWS / 64), dim3(256), 0, stream, (const bf16*)(ws + WS_ACT), (const int*)nullptr, (const bf16*)(ws + WS_W2T) + (size_t)l * NE * 1024 * 1024, CF, 1024, (const int*)(CNT + l * NE), (size_t)1024 * 1024);
            hipLaunchKernelGGL(slow_epi_down, dim3(ACT_ROWS * 1024 / 256), dim3(256), 0, stream, (const float*)CF, (const int*)(CNT + l * NE), (const int*)(ws + WS_LIST), (const float*)(ws + WS_GATE), in_[I_B2] + (size_t)l * NE * D, (bf16*)(ws + WS_Y));
            break;
        case PH_GMI:
            hipLaunchKernelGGL(slow_gemm, dim3(2048 / 64, NTOK / 64), dim3(256), 0, stream, (const bf16*)(ws + WS_XA), (const int*)nullptr, (const bf16*)(ws + WS_GWINT), CF, 2048, (const int*)nullptr, (size_t)0);
            hipLaunchKernelGGL(slow_epi_gelu, dim3(NTOK * 2048 / 256), dim3(256), 0, stream, (const float*)CF, in_[I_OBIN], (bf16*)(ws + WS_U), (bf16*)(ws + WS_VB));
            break;
        case PH_SPA:
            hipLaunchKernelGGL(slow_vstats, dim3(NTOK / 64), dim3(64), 0, stream, (const bf16*)(ws + WS_VB), CF);
            hipLaunchKernelGGL(slow_spatial, dim3(NTOK * D / 256), dim3(256), 0, stream, (const bf16*)(ws + WS_U), (const bf16*)(ws + WS_VB), (const float*)CF, in_[I_OWS], in_[I_OBS], in_[I_OLNG], in_[I_OLNB], (bf16*)(ws + WS_MIX));
            break;
        default: break;
        }
    }
    flush(NPHASE);
}
```

```cpp
#include <hip/hip_runtime.h>
#include <cstdio>
#include <cstdint>

#ifndef SLOW_MASK
#define SLOW_MASK 0x00
#endif

#ifndef PROBE_PH
#define PROBE_PH (-1)
#endif
#ifndef PROBE_END
#define PROBE_END (PROBE_PH + 1)
#endif
#ifndef PROBE_A
#define PROBE_A (-1)
#define PROBE_B (-1)
#endif
#ifndef PROBE_MULT
#define PROBE_MULT 4
#endif

#define LAS __attribute__((address_space(3)))
typedef unsigned short bf16;
typedef short bf16x8 __attribute__((ext_vector_type(8)));
typedef float f32x4 __attribute__((ext_vector_type(4)));
typedef float f32x2 __attribute__((ext_vector_type(2)));
typedef unsigned u32x4 __attribute__((ext_vector_type(4)));
typedef unsigned u32x2 __attribute__((ext_vector_type(2)));
typedef __bf16 bf16x2_t __attribute__((ext_vector_type(2)));

constexpr int NB = 8, SEQ = 2048, D = 1024, NTOK = NB * SEQ, CTXL = 256, NCTX = NB * CTXL;
constexpr int NE = 32, TOPK = 4, NASSIGN = NTOK * TOPK, ACT_ROWS = NASSIGN + NE * 256;
constexpr int EVEN_IN = 1792, KV_COL = 1536;
constexpr float EPS = 1e-6f, LOG2E = 1.4426950408889634f;
constexpr float QSCALE = 0.125f * LOG2E;
constexpr int MODW = 6 * D;
constexpr int NWAVES = 8, NTHREADS = 512;

constexpr size_t MiB = 1u << 20;
constexpr size_t WS_CTL = 0, CTL_ZERO_BYTES = 1 * MiB;
constexpr size_t WS_MOD = 1 * MiB;
constexpr size_t WS_LIST = 2 * MiB;
constexpr size_t WS_GATE = 4 * MiB;
constexpr size_t WS_WSB = 5 * MiB;
constexpr size_t WS_WINT = 6 * MiB;
constexpr size_t WS_WOUTT = 10 * MiB;
constexpr size_t WS_GWINT = 12 * MiB;
constexpr size_t WS_GWOUTT = 16 * MiB;
constexpr size_t WS_KC = 18 * MiB;
constexpr size_t WS_VC = 18 * MiB + 512 * 1024;
constexpr size_t WS_K = 19 * MiB;
constexpr size_t WS_V = 23 * MiB;
constexpr size_t WS_GM = 27 * MiB;
constexpr size_t WS_AROW = 31 * MiB;
constexpr size_t WS_Q = 32 * MiB;
constexpr size_t WS_GLU = 48 * MiB;
constexpr size_t WS_XA = 64 * MiB;
constexpr size_t WS_MIX = 96 * MiB;
constexpr size_t WS_H = 128 * MiB;
constexpr size_t WS_U = 192 * MiB;
constexpr size_t WS_VB = 224 * MiB;
constexpr size_t WS_W1T = 256 * MiB;
constexpr size_t WS_W2T = 512 * MiB;
constexpr size_t WS_ACT = 640 * MiB;
constexpr size_t WS_Y = 784 * MiB;
constexpr size_t WS_XA8 = 912 * MiB;
constexpr size_t WS_CF = 928 * MiB;
constexpr size_t WS_END = 1504 * MiB;
constexpr int CW_BAR = 4096, CW_CNT = 131072, CNT_STRIDE = 64  , CW_VSTAT = 147456;
constexpr int MAX_LAUNCH = 20;

constexpr int RING_BYTES = 131072;
constexpr int MISC_OFF = RING_BYTES;
constexpr int TAB_OFF = RING_BYTES + 256;
constexpr int LDS_BYTES = 147456;

#define LDS_WAIT() asm volatile("s_waitcnt lgkmcnt(0)" ::: "memory")
#define VM_WAIT() asm volatile("s_waitcnt vmcnt(0)" ::: "memory")

__device__ __forceinline__ float bf2f(unsigned b) { return __uint_as_float(b << 16); }
__device__ __forceinline__ unsigned pk2(float lo, float hi) { f32x2 v = {lo, hi}; bf16x2_t b = __builtin_convertvector(v, bf16x2_t); return __builtin_bit_cast(unsigned, b); }
template <int CTRL, int ROW_MASK> __device__ __forceinline__ float dpp_f(float old, float src) { return __builtin_bit_cast(float, __builtin_amdgcn_update_dpp(__builtin_bit_cast(int, old), __builtin_bit_cast(int, src), CTRL, ROW_MASK, 0xf, false)); }
__device__ __forceinline__ unsigned pk4_fp8(float a, float b, float c, float d) { int w = 0; w = __builtin_amdgcn_cvt_pk_fp8_f32(a, b, w, false); w = __builtin_amdgcn_cvt_pk_fp8_f32(c, d, w, true); return (unsigned)w; }
__device__ __forceinline__ float wave_sum(float v) {
    v += dpp_f<0xB1, 0xf>(0.f, v);
    v += dpp_f<0x4E, 0xf>(0.f, v);
    v += dpp_f<0x141, 0xf>(0.f, v);
    v += dpp_f<0x140, 0xf>(0.f, v);
    v += dpp_f<0x142, 0xa>(0.f, v);
    v += dpp_f<0x143, 0xc>(0.f, v);
    return __builtin_bit_cast(float, __builtin_amdgcn_readlane(__builtin_bit_cast(int, v), 63));
}
__device__ __forceinline__ float dpp_swap32(float v) { return __shfl_xor(v, 32); }
__device__ __forceinline__ float sigmoidf_(float x) { return __builtin_amdgcn_rcpf(1.0f + __builtin_amdgcn_exp2f(-x * LOG2E)); }

#define XB_TMO      128
#define XB_XCNT(j)  (256  + 64 * (j))
#define XB_XSUB(j)  (1280 + 64 * (j))
#define XB_XGEN(j)  (2304 + 64 * (j))
#define XB_TOP      3328
#define XB_TOPGEN   3392
#define XCD_BAR_WORDS 3456
#define XB_SPIN_CAP (1u << 20)
__device__ __forceinline__ unsigned xb_ld(unsigned* p)              { return __hip_atomic_load(p, __ATOMIC_RELAXED, __HIP_MEMORY_SCOPE_AGENT); }
__device__ __forceinline__ unsigned xb_add(unsigned* p, unsigned v) { return __hip_atomic_fetch_add(p, v, __ATOMIC_RELAXED, __HIP_MEMORY_SCOPE_AGENT); }
__device__ __forceinline__ unsigned xb_xcc_id() { return (unsigned)__builtin_amdgcn_s_getreg((3 << 11) | 20) & 0xFu; }
#define XB_SPIN(cond, bar) do { unsigned _sp = 0; while (cond) { __builtin_amdgcn_s_sleep(1); \
    if ((++_sp & 255u) == 0u) { if (xb_ld(&(bar)[XB_TMO])) break; if (_sp > XB_SPIN_CAP) { atomicAdd(&(bar)[XB_TMO], 1u); break; } } } } while (0)
struct XcdBarrier { unsigned* bar; unsigned x; volatile LAS unsigned* st; };
__device__ __forceinline__ XcdBarrier xcd_barrier_post(unsigned* bar, volatile LAS unsigned* st) {
    XcdBarrier b; b.bar = bar; b.x = xb_xcc_id(); b.st = st;
    if (threadIdx.x == 0) (void)xb_add(&bar[XB_XCNT(b.x)], 1u);
    return b;
}
__device__ __forceinline__ void xcd_barrier_complete(unsigned* bar, unsigned x, unsigned& nloc, unsigned& nx) {
    const unsigned G = gridDim.x * gridDim.y * gridDim.z;
    unsigned sum, cnt, mine, sp = 0u;
    for (;;) {
        sum = 0u; cnt = 0u; mine = 0u;
#pragma unroll
        for (unsigned j = 0; j < 16; ++j) { const unsigned c = xb_ld(&bar[XB_XCNT(j)]); sum += c; cnt += (c > 0u) ? 1u : 0u; mine = (j == x) ? c : mine; }
        if (sum == G) break;
        __builtin_amdgcn_s_sleep(1);
        if ((++sp & 255u) == 0u) { if (xb_ld(&bar[XB_TMO])) break; if (sp > XB_SPIN_CAP) { atomicAdd(&bar[XB_TMO], 1u); break; } }
    }
    nloc = mine > 0u ? mine : 1u; nx = cnt > 0u ? cnt : 1u;
}
__device__ __forceinline__ void xcd_barrier(const XcdBarrier& b, const int tid) {
    asm volatile("s_waitcnt vmcnt(0)" ::: "memory");
    __syncthreads();
    if (tid == 0) {
        unsigned* bar = b.bar;
        __builtin_amdgcn_s_waitcnt(0);
        unsigned nloc = b.st[0], nx = b.st[1];
        if (nloc == 0u) { xcd_barrier_complete(bar, b.x, nloc, nx); b.st[0] = nloc; b.st[1] = nx; }
        const unsigned old = xb_add(&bar[XB_XSUB(b.x)], 1u);
        const unsigned gen = old / nloc;
        if (old + 1u == (gen + 1u) * nloc) {
            __builtin_amdgcn_fence(__ATOMIC_RELEASE, "agent");
            asm volatile("s_waitcnt vmcnt(0)" ::: "memory");
            const unsigned og = xb_add(&bar[XB_TOP], 1u);
            const unsigned tg = og / nx;
            if (og + 1u == (tg + 1u) * nx) xb_add(&bar[XB_TOPGEN], 1u);
            else XB_SPIN(xb_ld(&bar[XB_TOPGEN]) == tg, bar);
            __builtin_amdgcn_fence(__ATOMIC_ACQUIRE, "agent");
            xb_add(&bar[XB_XGEN(b.x)], 1u);
            asm volatile("s_waitcnt vmcnt(0)" ::: "memory");
        } else {
            XB_SPIN(xb_ld(&bar[XB_XGEN(b.x)]) == gen, bar);
            __builtin_amdgcn_fence(__ATOMIC_ACQUIRE, "agent");
            asm volatile("s_waitcnt vmcnt(0)" ::: "memory");
        }
    }
    __syncthreads();
}

constexpr float FP8_WMUL = 32.0f, FP8_AMUL = 4.0f, FP8_DESCALE = 1.0f / (32.0f * 4.0f);
namespace pg8 {
constexpr int BM = 256, BK = 64, HALF = 128, HTB = HALF * BK * 2, STAGE_BYTES = 8 * HTB, KD = 1024  ;
__host__ __device__ __forceinline__ int lds_byte(int r, int c) { const int st = (r >> 4) * 2 + (c >> 5), rr = r & 15, cc = c & 31, ob = rr * 64 + cc * 2; return st * 1024 + (ob ^ (((ob >> 9) & 1) << 5)); }
__host__ __device__ __forceinline__ void stage_rc(int b, int& R, int& C) { const int st = b / 1024, sb = b % 1024, swz = sb ^ (((sb >> 9) & 1) << 5); R = (st >> 1) * 16 + swz / 64; C = (st & 1) * 32 + (swz % 64) / 2; }
__host__ __device__ __forceinline__ int perm32(int rho) { const int n = rho >> 4, i = rho & 15; return 8 * (i >> 2) + 4 * n + (i & 3); }

typedef int v8i_t __attribute__((ext_vector_type(8)));
__device__ __forceinline__ v8i_t cat8(bf16x8 a, bf16x8 b) { typedef int v4i_t __attribute__((ext_vector_type(4))); const v4i_t x = __builtin_bit_cast(v4i_t, a), y = __builtin_bit_cast(v4i_t, b); return __builtin_shufflevector(x, y, 0, 1, 2, 3, 4, 5, 6, 7); }
struct Unit { int pm, pn, e, cnt; };

template <class Epi, class Sched>
__device__ __forceinline__ void gemm_phase(LAS unsigned char* lds, const Sched& S, const Epi& E, const int tid) {
    const int wid = __builtin_amdgcn_readfirstlane(tid >> 6), lane = tid & 63, wr = wid >> 2, wc = wid & 3, fr = lane & 15, fq = lane >> 4;
    constexpr int RP = Sched::FP8 ? 1024 : 2048  , nt = RP / 128;
    int Rr[2], Cc[2];
    unsigned voffA[2][2], voffB[2];
#pragma unroll
    for (int i = 0; i < 2; ++i) { stage_rc(tid * 16 + i * 8192, Rr[i], Cc[i]); const int Rb = Epi::PERM ? ((Rr[i] & ~31) + perm32(Rr[i] & 31)) : Rr[i];
        voffB[i] = (unsigned)(Rb * RP + Cc[i] * 2); }
    constexpr size_t kstep = (size_t)(BK * 2);
    constexpr size_t hstep = (size_t)HALF * RP;
    const unsigned ldsw = (unsigned)wid * 1024u;
    const int aoff = lds_byte(wr * 64 + fr, fq * 8), boff = lds_byte(wc * 32 + fr, fq * 8);
#define PG8_SA(b, h) (((b) * 2 + (h)) * HTB)
#define PG8_SB(b, h) ((4 + (b) * 2 + (h)) * HTB)
#define PG8_STAGE(bufoff, gbase, voff) do { _Pragma("unroll") for (int _i = 0; _i < 2; ++_i) \
        __builtin_amdgcn_global_load_lds((const unsigned*)((const char*)(gbase) + (voff)[_i]), (LAS unsigned*)(lds + (bufoff) + ldsw + _i * 8192), 16, 0, 0); } while (0)
#define PG8_STAGEA1(bufoff, gbase) do { if constexpr (Sched::GATHER) { PG8_STAGE(bufoff, gbase, voffA[1]); } else { PG8_STAGE(bufoff, (gbase) + hstep, voffA[0]); } } while (0)
#define PG8_LDA(dst, b, h) do { _Pragma("unroll") for (int m = 0; m < 4; ++m) _Pragma("unroll") for (int k = 0; k < 2; ++k) dst[m][k] = *(const LAS bf16x8*)(lds + PG8_SA(b, h) + aoff + m * 2048 + k * 1024); } while (0)
#define PG8_LDB(dst, b, h) do { _Pragma("unroll") for (int n = 0; n < 2; ++n) _Pragma("unroll") for (int k = 0; k < 2; ++k) dst[n][k] = *(const LAS bf16x8*)(lds + PG8_SB(b, h) + boff + n * 2048 + k * 1024); } while (0)
#define PG8_MMA(ai, bj, At, Bt) do { __builtin_amdgcn_s_setprio(1); _Pragma("unroll") for (int m = 0; m < 4; ++m) _Pragma("unroll") for (int n = 0; n < 2; ++n) { \
        if constexpr (Sched::FP8) { acc[ai][bj][m][n] = __builtin_amdgcn_mfma_scale_f32_16x16x128_f8f6f4(cat8(Bt[n][0], Bt[n][1]), cat8(At[m][0], At[m][1]), acc[ai][bj][m][n], 0, 0, 0, 0, 0, 0); } \
        else { _Pragma("unroll") for (int k = 0; k < 2; ++k) acc[ai][bj][m][n] = __builtin_amdgcn_mfma_f32_16x16x32_bf16(Bt[n][k], At[m][k], acc[ai][bj][m][n], 0, 0, 0); } } \
        __builtin_amdgcn_s_setprio(0); } while (0)
#define PG8_WAIT_V(n) asm volatile("s_waitcnt vmcnt(" #n ")" ::: "memory")
#define PG8_WAIT_L(n) asm volatile("s_waitcnt lgkmcnt(" #n ")" ::: "memory")
#define PG8_BAR __builtin_amdgcn_s_barrier()
#define PG8_SCHED __builtin_amdgcn_sched_barrier(0)
    Unit cur, nxt; int ui = 0;
    if (!S.next(0, cur)) return;
    S.a_voff(cur, voffA, Rr, Cc);
    f32x4 acc[2][2][4][2];
#pragma unroll
    for (int a = 0; a < 2; ++a)
#pragma unroll
        for (int b = 0; b < 2; ++b)
#pragma unroll
            for (int m = 0; m < 4; ++m)
#pragma unroll
                for (int n = 0; n < 2; ++n) acc[a][b][m][n] = (f32x4){0.f, 0.f, 0.f, 0.f};
    bf16x8 At[4][2], B0[2][2], B1[2][2];
    const char* cA = S.a_ptr(cur); const char* cB = S.b_ptr(cur);
    PG8_STAGE(PG8_SB(0, 0), cB, voffB); PG8_STAGE(PG8_SB(0, 1), cB + hstep, voffB); PG8_STAGE(PG8_SA(0, 0), cA, voffA[0]); PG8_STAGEA1(PG8_SA(0, 1), cA);
    if (wr == 1) PG8_BAR;
    PG8_WAIT_V(2); PG8_BAR;
    PG8_STAGE(PG8_SB(1, 0), cB + kstep, voffB); PG8_STAGE(PG8_SA(1, 0), cA + kstep, voffA[0]); PG8_STAGE(PG8_SB(1, 1), cB + hstep + kstep, voffB);
    PG8_WAIT_V(6); PG8_BAR;
    for (;;) {
        const bool has_next = S.next(ui + 1, nxt);
        const char* nA = has_next ? S.a_ptr(nxt) : cA; const char* nB = has_next ? S.b_ptr(nxt) : cB;
#pragma unroll 1
        for (int t = 0; t < nt; t += 2) {
            const bool last = (t == nt - 2);
            const char* a1 = cA + (size_t)(t + 1) * kstep;
            const char* a2 = last ? nA : cA + (size_t)(t + 2) * kstep; const char* b2 = last ? nB : cB + (size_t)(t + 2) * kstep;
            const char* a3 = a2 + kstep; const char* b3 = b2 + kstep;
            asm volatile("" : "+s"(a1), "+s"(a2), "+s"(a3), "+s"(b2), "+s"(b3));
            PG8_LDB(B0, 0, 0); PG8_LDB(B1, 0, 1); PG8_SCHED; PG8_LDA(At, 0, 0); PG8_STAGEA1(PG8_SA(1, 1), a1);
            if (Sched::GATHER) { if (last && has_next) S.a_voff(nxt, voffA, Rr, Cc); }
            PG8_WAIT_V(8); PG8_WAIT_L(0); PG8_BAR; PG8_MMA(0, 0, At, B0); PG8_MMA(0, 1, At, B1); PG8_BAR; PG8_SCHED;
            PG8_LDA(At, 0, 1); PG8_STAGE(PG8_SB(0, 0), b2, voffB); PG8_STAGE(PG8_SB(0, 1), b2 + hstep, voffB); PG8_STAGE(PG8_SA(0, 0), a2, voffA[0]);
            PG8_WAIT_V(8); PG8_WAIT_L(0); PG8_BAR; PG8_MMA(1, 0, At, B0); PG8_MMA(1, 1, At, B1); PG8_BAR; PG8_SCHED;
            PG8_LDB(B0, 1, 0); PG8_LDB(B1, 1, 1); PG8_SCHED; PG8_LDA(At, 1, 0); PG8_STAGEA1(PG8_SA(0, 1), a2);
            PG8_WAIT_V(8); PG8_WAIT_L(0); PG8_BAR; PG8_MMA(0, 0, At, B0); PG8_MMA(0, 1, At, B1); PG8_BAR; PG8_SCHED;
            PG8_LDA(At, 1, 1); PG8_STAGE(PG8_SB(1, 0), b3, voffB); PG8_STAGE(PG8_SB(1, 1), b3 + hstep, voffB); PG8_STAGE(PG8_SA(1, 0), a3, voffA[0]);
            PG8_WAIT_V(8); PG8_WAIT_L(0); PG8_BAR; PG8_MMA(1, 0, At, B0); PG8_MMA(1, 1, At, B1); PG8_BAR; PG8_SCHED;
        }
        if (wr == 0) PG8_BAR;
        E(acc, cur, wr, wc, fr, fq);
        if (!has_next) break;
#pragma unroll
        for (int a = 0; a < 2; ++a)
#pragma unroll
            for (int b = 0; b < 2; ++b)
#pragma unroll
                for (int m = 0; m < 4; ++m)
#pragma unroll
                    for (int n = 0; n < 2; ++n) acc[a][b][m][n] = (f32x4){0.f, 0.f, 0.f, 0.f};
        cur = nxt; cA = nA; cB = nB; ++ui;
        if (wr == 1) PG8_BAR;
    }
    PG8_WAIT_V(0);
    PG8_BAR;
#undef PG8_SA
#undef PG8_SB
#undef PG8_STAGE
#undef PG8_STAGEA1
#undef PG8_LDA
#undef PG8_LDB
#undef PG8_MMA
#undef PG8_WAIT_V
#undef PG8_WAIT_L
#undef PG8_BAR
#undef PG8_SCHED
}
}

struct Args { const float* in[33]; float* out; unsigned char* ws; int ph_lo, ph_hi, li, pad; };
enum { I_X = 0, I_C, I_CTX, I_CCTX, I_ADAW, I_ADAB, I_NMG, I_NFG, I_EWIN, I_EBIN, I_ECW, I_ECB, I_ELNG, I_ELNB, I_QNG, I_KNG, I_SINK, I_EWOUT, I_EBOUT,
       I_OWIN, I_OBIN, I_OLNG, I_OLNB, I_OWS, I_OBS, I_OWOUT, I_OBOUT, I_RW, I_RB, I_W1, I_B1, I_W2, I_B2 };

typedef const __attribute__((address_space(4))) unsigned long long* kargp_t;
struct Ctx {
    LAS unsigned char* lds; int tid, lane, wave, G, vcu, gw, NGW, bid; unsigned char* ws; kargp_t kp;
};
__device__ __forceinline__ const float* in_ptr(const Ctx& X, int i) { return (const float*)(const __attribute__((address_space(1))) float*)X.kp[i]; }
#define IN(i) in_ptr(X, (i))
#if PROBE_PH == -2
#define PMARK(k) do { if (X.bid == 0 && X.tid == 0) { volatile LAS unsigned long long* pm_ = (volatile LAS unsigned long long*)(X.lds + MISC_OFF + 128); \
    if ((k) == PROBE_A) pm_[0] = __builtin_amdgcn_s_memrealtime(); if ((k) == PROBE_B) pm_[1] = __builtin_amdgcn_s_memrealtime(); } } while (0)
#else
#define PMARK(k) do { } while (0)
#endif

struct DenseSched {
    static constexpr bool GATHER = false, FP8 = false;
    const bf16* A; const bf16* Bt; int nM, nN, nwg, G, c;
    const bf16* A2; const bf16* Bt2; int nM2;
    __device__ __forceinline__ void init(const bf16* A_, const bf16* Bt_, int M, int N, int G_, int c_) { A = A_; Bt = Bt_; nM = M / 256; nN = N / 256; nwg = nM * nN; G = G_; c = c_; A2 = nullptr; Bt2 = nullptr; nM2 = 0; }
    __device__ __forceinline__ bool next(int i, pg8::Unit& u) const {
        const int L = i * G + c; if (L >= nwg + nM2) return false;
        if (L >= nwg) { u.pm = L - nwg; u.pn = 0; u.e = 1; u.cnt = 256; return true; }
        int wgid = L; { const int q = nwg / 8, r = nwg % 8, xcd = wgid % 8, off = wgid / 8; wgid = (xcd < r ? xcd * (q + 1) : r * (q + 1) + (xcd - r) * q) + off; }
        const int nig = 8 * nN, gid = wgid / nig, fm = gid * 8, gsz = (nM - fm) < 8 ? (nM - fm) : 8;
        u.pm = fm + ((wgid % nig) % gsz); u.pn = (wgid % nig) / gsz; u.e = 0; u.cnt = 256; return true;
    }
    __device__ __forceinline__ const char* a_ptr(const pg8::Unit& u) const { return (const char*)(u.e ? A2 : A) + (size_t)u.pm * 256 * pg8::KD * 2; }
    __device__ __forceinline__ const char* b_ptr(const pg8::Unit& u) const { return (const char*)(u.e ? Bt2 : Bt) + (size_t)u.pn * 256 * pg8::KD * 2; }
    __device__ __forceinline__ void a_voff(const pg8::Unit&, unsigned (&v)[2][2], const int (&R)[2], const int (&C)[2]) const {
#pragma unroll
        for (int i = 0; i < 2; ++i) { v[0][i] = (unsigned)(R[i] * pg8::KD + C[i]) * 2u; v[1][i] = v[0][i] + (unsigned)(pg8::HALF * pg8::KD * 2); }
    }
};
template <bool GATHER_, int NTILE_N>
struct MoeSchedT {
    static constexpr bool GATHER = GATHER_, FP8 = true; static constexpr int RP = 1024;
    const LAS int* tab; int G, c;
    const unsigned char* A;
    const unsigned char* Bt;
    const int* list;
    __device__ __forceinline__ bool next(int i, pg8::Unit& u) const {
        const int L = i * G + c; const int T = tab[0];
        if (L >= T * NTILE_N) return false;
        const int mt = L / NTILE_N; u.pn = L % NTILE_N;
        const int w = __builtin_amdgcn_readfirstlane(tab[1 + mt]); u.e = w >> 16; const int tl = w & 0xffff;
        const int cnt = __builtin_amdgcn_readfirstlane(tab[512 + u.e]), pb = __builtin_amdgcn_readfirstlane(tab[544 + u.e]);
        u.pm = pb + tl * 256; u.cnt = cnt - tl * 256;
        return true;
    }
    __device__ __forceinline__ const char* a_ptr(const pg8::Unit& u) const { return GATHER ? (const char*)A : (const char*)A + (size_t)u.pm * RP; }
    __device__ __forceinline__ const char* b_ptr(const pg8::Unit& u) const { return (const char*)Bt + ((size_t)u.e * NTILE_N + u.pn) * 256 * RP; }
    __device__ __forceinline__ void a_voff(const pg8::Unit& u, unsigned (&v)[2][2], const int (&R)[2], const int (&C)[2]) const {
        if (GATHER) {
            const int slot0 = u.pm - tab[544 + u.e];
            const int* lp = list + (size_t)u.e * NTOK + slot0;
#pragma unroll
            for (int h = 0; h < 2; ++h)
#pragma unroll
                for (int i = 0; i < 2; ++i) { const int r = h * 128 + R[i]; const int tok = lp[r < u.cnt ? r : u.cnt - 1] >> 2; v[h][i] = (unsigned)(tok * RP + C[i] * 2); }
        } else {
#pragma unroll
            for (int i = 0; i < 2; ++i) { v[0][i] = (unsigned)(R[i] * RP + C[i] * 2); v[1][i] = v[0][i] + (unsigned)(pg8::HALF * RP); }
        }
    }
};
__device__ __forceinline__ void moe_build_table(const Ctx& X, const int* cnt  ) {
    LAS int* tab = (LAS int*)(X.lds + TAB_OFF);
    __syncthreads();
    if (X.tid == 0) {
        int T = 0, pb = 0;
        for (int e = 0; e < NE; ++e) { const int c = __hip_atomic_load(cnt + e * CNT_STRIDE, __ATOMIC_RELAXED, __HIP_MEMORY_SCOPE_AGENT); const int mt = (c + 255) >> 8;
            tab[512 + e] = c; tab[544 + e] = pb; for (int t = 0; t < mt; ++t) tab[1 + T + t] = (e << 16) | t; T += mt; pb += mt * 256; }
        tab[0] = T;
    }
    __syncthreads();
}

__device__ __forceinline__ f32x2 gelu_pk(f32x2 v) {
    const f32x2 av = __builtin_elementwise_abs(v), d = av * 0.2316418882f + 1.0f;
    f32x2 t; t.x = __builtin_amdgcn_rcpf(d.x); t.y = __builtin_amdgcn_rcpf(d.y);
    f32x2 q = t * 0.5307027145f + (-0.7265760135f); q = q * t + 0.7107068705f; q = q * t + (-0.142248368f); q = q * t + 0.127414796f; q = q * t;
    const f32x2 s = (v * v) * (-0.72134752044f);
    f32x2 e; e.x = __builtin_amdgcn_exp2f(s.x); e.y = __builtin_amdgcn_exp2f(s.y);
    const f32x2 m = v * (q * e), r = v - m;
    f32x2 o; o.x = v.x < 0.f ? m.x : r.x; o.y = v.y < 0.f ? m.y : r.y; return o;
}
__device__ __forceinline__ u32x4 pack8(f32x4 a, f32x4 b) { u32x4 w; w.x = pk2(a[0], a[1]); w.y = pk2(a[2], a[3]); w.z = pk2(b[0], b[1]); w.w = pk2(b[2], b[3]); return w; }

struct EpiIn {
    static constexpr bool PERM = true;
    bf16 *GLU, *Q, *Kb, *Vb, *KC, *VC; const float* bias;
    __device__ __forceinline__ void operator()(const f32x4 (&acc)[2][2][4][2], const pg8::Unit& u, int wr, int wc, int fr, int fq) const {
        const int row0 = u.pm * 256 + wr * 64 + fr; const int c8 = wc * 32 + 8 * fq;
        if (u.e == 0 && u.pn < 4) {
            const int j0 = u.pn * 128 + c8;
            f32x4 bu[2], bg[2];
#pragma unroll
            for (int n = 0; n < 2; ++n) { bu[n] = *(const f32x4*)(bias + j0 + 4 * n); bg[n] = *(const f32x4*)(bias + 512 + j0 + 4 * n); }
#pragma unroll
            for (int ai = 0; ai < 2; ++ai)
#pragma unroll
                for (int m = 0; m < 4; ++m) { f32x4 o[2];
#pragma unroll
                    for (int n = 0; n < 2; ++n) { const f32x4 uu = acc[ai][0][m][n] + bu[n], gg = acc[ai][1][m][n] + bg[n];
#pragma unroll
                        for (int k = 0; k < 4; ++k) o[n][k] = uu[k] * sigmoidf_(gg[k]); }
                    *(u32x4*)(GLU + (size_t)(row0 + ai * 128 + m * 16) * 512 + j0) = pack8(o[0], o[1]); }
        } else {
#pragma unroll
            for (int bj = 0; bj < 2; ++bj) {
                bf16* dst; int ld, col, bcol;
                if (u.pn >= 6 || u.e) { dst = u.e ? (bj ? VC : KC) : (bj ? Vb : Kb); ld = 128; col = c8; bcol = KV_COL + bj * 128 + c8; }
                else { dst = Q; ld = 512; col = (u.pn - 4) * 256 + bj * 128 + c8; bcol = 1024 + col; }
                f32x4 bv[2];
#pragma unroll
                for (int n = 0; n < 2; ++n) bv[n] = *(const f32x4*)(bias + bcol + 4 * n);
#pragma unroll
                for (int ai = 0; ai < 2; ++ai)
#pragma unroll
                    for (int m = 0; m < 4; ++m) *(u32x4*)(dst + (size_t)(row0 + ai * 128 + m * 16) * ld + col) = pack8(acc[ai][bj][m][0] + bv[0], acc[ai][bj][m][1] + bv[1]);
            }
        }
    }
};
struct EpiRes {
    static constexpr bool PERM = false;
    const float* base; float* out; const float* bias; const float* gate;
    __device__ __forceinline__ void operator()(const f32x4 (&acc)[2][2][4][2], const pg8::Unit& u, int wr, int wc, int fr, int fq) const {
        const int col0 = u.pn * 256 + wc * 32 + 4 * fq; const int b = (u.pm * 256) / SEQ;
#pragma unroll
        for (int bj = 0; bj < 2; ++bj) {
            f32x4 bv[2], gv[2];
#pragma unroll
            for (int n = 0; n < 2; ++n) { bv[n] = *(const f32x4*)(bias + col0 + bj * 128 + n * 16); gv[n] = *(const f32x4*)(gate + (size_t)b * MODW + col0 + bj * 128 + n * 16); }
#pragma unroll
            for (int ai = 0; ai < 2; ++ai)
#pragma unroll
                for (int m = 0; m < 4; ++m) { const size_t off = (size_t)(u.pm * 256 + ai * 128 + wr * 64 + m * 16 + fr) * D + col0 + bj * 128;
#pragma unroll
                    for (int n = 0; n < 2; ++n) { const f32x4 bs = *(const f32x4*)(base + off + n * 16); *(f32x4*)(out + off + n * 16) = bs + gv[n] * (acc[ai][bj][m][n] + bv[n]); } }
        }
    }
};
struct EpiGelu {
    static constexpr bool PERM = true;
    bf16 *U, *V; const float* bias; float* vstat;
    __device__ __forceinline__ void operator()(const f32x4 (&acc)[2][2][4][2], const pg8::Unit& u, int wr, int wc, int fr, int fq) const {
        const int row0 = u.pm * 256 + wr * 64 + fr; const int colt = u.pn * 256; const bool isv = colt >= 1024; bf16* base = isv ? V : U; const int cb = (colt & 1023) + wc * 32 + 8 * fq, bcol = colt + wc * 32 + 8 * fq;
        f32x4 bv[2][2];
#pragma unroll
        for (int bj = 0; bj < 2; ++bj)
#pragma unroll
            for (int n = 0; n < 2; ++n) bv[bj][n] = *(const f32x4*)(bias + bcol + bj * 128 + 4 * n);
#pragma unroll
        for (int ai = 0; ai < 2; ++ai)
#pragma unroll
            for (int m = 0; m < 4; ++m) { const int row = row0 + ai * 128 + m * 16; bf16* rowp = base + (size_t)row * D + cb; float s = 0.f, s2 = 0.f;
#pragma unroll
                for (int bj = 0; bj < 2; ++bj) { f32x4 v0 = acc[ai][bj][m][0] + bv[bj][0], v1 = acc[ai][bj][m][1] + bv[bj][1];
                    f32x2 a = gelu_pk((f32x2){v0[0], v0[1]}), b = gelu_pk((f32x2){v0[2], v0[3]}), c = gelu_pk((f32x2){v1[0], v1[1]}), d = gelu_pk((f32x2){v1[2], v1[3]});
                    s += (a.x + a.y) + (b.x + b.y) + (c.x + c.y) + (d.x + d.y); s2 += (a.x * a.x + a.y * a.y) + (b.x * b.x + b.y * b.y) + (c.x * c.x + c.y * c.y) + (d.x * d.x + d.y * d.y);
                    *(u32x4*)(rowp + bj * 128) = pack8((f32x4){a.x, a.y, b.x, b.y}, (f32x4){c.x, c.y, d.x, d.y}); }
                if (isv) { s += __shfl_xor(s, 16); s += __shfl_xor(s, 32); s2 += __shfl_xor(s2, 16); s2 += __shfl_xor(s2, 32);
                    if (fq == 0) { unsafeAtomicAdd(vstat + 2 * row, s); unsafeAtomicAdd(vstat + 2 * row + 1, s2); } } }
    }
};
struct EpiSwiglu {
    static constexpr bool PERM = true;
    unsigned char* ACT; const float* b1;
    __device__ __forceinline__ void operator()(const f32x4 (&acc)[2][2][4][2], const pg8::Unit& u, int wr, int wc, int fr, int fq) const {
        const int j0 = u.pn * 128 + wc * 32 + 8 * fq; const float* bb = b1 + (size_t)u.e * 2048;
        f32x4 bg[2], bu[2];
#pragma unroll
        for (int n = 0; n < 2; ++n) { bg[n] = *(const f32x4*)(bb + j0 + 4 * n); bu[n] = *(const f32x4*)(bb + 1024 + j0 + 4 * n); }
#pragma unroll
        for (int ai = 0; ai < 2; ++ai)
#pragma unroll
            for (int m = 0; m < 4; ++m) { f32x4 o[2];
#pragma unroll
                for (int n = 0; n < 2; ++n) { const f32x4 g4 = acc[ai][0][m][n] * FP8_DESCALE + bg[n], u4 = acc[ai][1][m][n] * FP8_DESCALE + bu[n];
#pragma unroll
                    for (int k = 0; k < 4; ++k) { const float g = fminf(g4[k], 7.0f), up = fminf(fmaxf(u4[k], -7.0f), 7.0f); o[n][k] = (up + 1.0f) * g * sigmoidf_(g * 1.702f); } }
                u32x2 w8; w8.x = pk4_fp8(o[0][0] * FP8_AMUL, o[0][1] * FP8_AMUL, o[0][2] * FP8_AMUL, o[0][3] * FP8_AMUL); w8.y = pk4_fp8(o[1][0] * FP8_AMUL, o[1][1] * FP8_AMUL, o[1][2] * FP8_AMUL, o[1][3] * FP8_AMUL);
                *(u32x2*)(ACT + (size_t)(u.pm + ai * 128 + wr * 64 + m * 16 + fr) * D + j0) = w8; }
    }
};
struct EpiDown {
    static constexpr bool PERM = true;
    bf16* Y; const float* b2; const int* list; const float* gatew; const LAS int* tab;
    __device__ __forceinline__ void operator()(const f32x4 (&acc)[2][2][4][2], const pg8::Unit& u, int wr, int wc, int fr, int fq) const {
        const int c8 = u.pn * 256 + wc * 32 + 8 * fq; const float* bb = b2 + (size_t)u.e * D;
        const int slot0 = u.pm - tab[544 + u.e]; const int* lp = list + (size_t)u.e * NTOK + slot0;
#pragma unroll
        for (int bj = 0; bj < 2; ++bj) {
            f32x4 bv[2];
#pragma unroll
            for (int n = 0; n < 2; ++n) bv[n] = *(const f32x4*)(bb + c8 + bj * 128 + 4 * n);
            asm volatile("" : "+v"(bv[0]), "+v"(bv[1]));
#pragma unroll
            for (int ai = 0; ai < 2; ++ai)
#pragma unroll
                for (int m = 0; m < 4; ++m) { const int r = ai * 128 + wr * 64 + m * 16 + fr; int aid = lp[r < u.cnt ? r : u.cnt - 1]; float g = gatew[aid];
                    asm volatile("" : "+v"(aid), "+v"(g));
                    const u32x4 w = pack8((acc[ai][bj][m][0] * FP8_DESCALE + bv[0]) * g, (acc[ai][bj][m][1] * FP8_DESCALE + bv[1]) * g);
                    if (r < u.cnt) *(u32x4*)(Y + (size_t)aid * D + c8 + bj * 128) = w; }
        }
    }
};

struct TrItem { const float* src; bf16* dst; int N; int fp8; };
__device__ __forceinline__ void tr_load(const TrItem& t, float (&v)[32], int lane) {
#pragma unroll
    for (int i = 0; i < 32; ++i) v[i] = t.src[(size_t)(2 * i + (lane >> 5)) * t.N + (lane & 31)];
}
__device__ __forceinline__ void tr_store(const TrItem& t, const float (&v)[32], LAS float* scr, int lane) {
#pragma unroll
    for (int i = 0; i < 32; ++i) scr[(2 * i + (lane >> 5)) * 33 + (lane & 31)] = v[i];
    LDS_WAIT();
    if (t.fp8) {
        const int q = lane & 3;
#pragma unroll
        for (int j = 0; j < 2; ++j) { const int n = (lane >> 2) + 16 * j; const LAS float* s = scr + (16 * q) * 33 + n; u32x4 o;
#pragma unroll
            for (int c = 0; c < 4; ++c) o[c] = pk4_fp8(s[(4 * c) * 33] * FP8_WMUL, s[(4 * c + 1) * 33] * FP8_WMUL, s[(4 * c + 2) * 33] * FP8_WMUL, s[(4 * c + 3) * 33] * FP8_WMUL);
            *(u32x4*)((unsigned char*)t.dst + (size_t)n * 1024 + 16 * q) = o; }
    } else {
        const int c = lane & 7;
#pragma unroll
        for (int j = 0; j < 4; ++j) { const int n = (lane >> 3) + 8 * j; const LAS float* s = scr + (8 * c) * 33 + n;
            u32x4 o; o.x = pk2(s[0 * 33], s[1 * 33]); o.y = pk2(s[2 * 33], s[3 * 33]); o.z = pk2(s[4 * 33], s[5 * 33]); o.w = pk2(s[6 * 33], s[7 * 33]);
            *(u32x4*)(t.dst + (size_t)n * 1024 + 8 * c) = o; }
    }
    LDS_WAIT();
}
__device__ __forceinline__ int pair_src(int nd, int halfw) { return ((nd & 255) >> 7) * halfw + (nd >> 8) * 128 + (nd & 127); }

__device__ __forceinline__ void phase_prologue(const Args& a, const Ctx& X) {
    {
        LAS float* sc = (LAS float*)X.lds;
        LAS float* red = (LAS float*)(X.lds + 36864);
        float* MOD = (float*)(X.ws + WS_MOD);
        for (int item = X.bid; item < 2 * 96; item += X.G) {
            const int l = item / 96, j0 = (item % 96) * 64;
            for (int idx = X.tid; idx < 9 * 1024; idx += NTHREADS) { const int r = idx >> 10, k = idx & 1023; const float v = r < 8 ? IN(I_C)[r * 1024 + k] : IN(I_CCTX)[k]; sc[idx] = v * sigmoidf_(v); }
            __syncthreads();
            float acc[9];
#pragma unroll
            for (int r = 0; r < 9; ++r) acc[r] = 0.f;
            const float* w = IN(I_ADAW) + (size_t)l * 1024 * MODW + j0 + X.lane;
#pragma unroll 8
            for (int k = X.wave * 128; k < X.wave * 128 + 128; ++k) { const float wv = w[(size_t)k * MODW];
#pragma unroll
                for (int r = 0; r < 9; ++r) acc[r] += sc[r * 1024 + k] * wv; }
#pragma unroll
            for (int r = 0; r < 9; ++r) red[(X.wave * 9 + r) * 64 + X.lane] = acc[r];
            __syncthreads();
            for (int t = X.tid; t < 9 * 64; t += NTHREADS) { const int r = t >> 6, cidx = t & 63; float s = 0.f;
#pragma unroll
                for (int w8 = 0; w8 < 8; ++w8) s += red[(w8 * 9 + r) * 64 + cidx];
                MOD[((size_t)l * 9 + r) * MODW + j0 + cidx] = s + IN(I_ADAB)[l * MODW + j0 + cidx]; }
            __syncthreads();
        }
    }
    LAS float* scr = (LAS float*)(X.lds + X.wave * 16384);
    bf16* WinT = (bf16*)(X.ws + WS_WINT); bf16* WoutT = (bf16*)(X.ws + WS_WOUTT); bf16* GWinT = (bf16*)(X.ws + WS_GWINT); bf16* GWoutT = (bf16*)(X.ws + WS_GWOUTT);
    bf16* W1T = (bf16*)(X.ws + WS_W1T); bf16* W2T = (bf16*)(X.ws + WS_W2T);
    constexpr int I_IN = 16 * (EVEN_IN / 32), I_OUT = 16 * 32, I_GIN = 16 * 64, I_GOUT = 16 * 32, I_M1 = 64 * 16 * 64, I_M2 = 64 * 16 * 32;
    constexpr int NITEMS = I_IN + I_OUT + I_GIN + I_GOUT + I_M1 + I_M2;
    auto item_of = [&](int it) -> TrItem {
        int r = it; TrItem t; t.fp8 = 0;
        if (r < I_M1) { const int mat = r >> 10, q = r & 1023, kb = q >> 6, nd = (q & 63) * 32; t.N = 2048; t.fp8 = 1; t.src = IN(I_W1) + (size_t)mat * 1024 * 2048 + (size_t)kb * 64 * 2048 + pair_src(nd, 1024); t.dst = (bf16*)((unsigned char*)W1T + (size_t)mat * 2048 * 1024 + (size_t)nd * 1024 + kb * 64); return t; } r -= I_M1;
        if (r < I_M2) { const int mat = r >> 9, q = r & 511, kb = q >> 5, nd = (q & 31) * 32; t.N = 1024; t.fp8 = 1; t.src = IN(I_W2) + (size_t)mat * 1024 * 1024 + (size_t)kb * 64 * 1024 + nd; t.dst = (bf16*)((unsigned char*)W2T + (size_t)mat * 1024 * 1024 + (size_t)nd * 1024 + kb * 64); return t; } r -= I_M2;
        if (r < I_IN) { const int kb = r / 56, nd = (r % 56) * 32; const int ns = nd < 1024 ? pair_src(nd, 512) : nd; t.N = EVEN_IN; t.src = IN(I_EWIN) + (size_t)kb * 64 * EVEN_IN + ns; t.dst = WinT + (size_t)nd * 1024 + kb * 64; return t; } r -= I_IN;
        if (r < I_OUT) { const int kb = r >> 5, nd = (r & 31) * 32; t.N = 1024; t.src = IN(I_EWOUT) + (size_t)kb * 64 * 1024 + nd; t.dst = WoutT + (size_t)nd * 1024 + kb * 64; return t; } r -= I_OUT;
        if (r < I_GIN) { const int kb = r >> 6, nd = (r & 63) * 32; t.N = 2048; t.src = IN(I_OWIN) + (size_t)kb * 64 * 2048 + nd; t.dst = GWinT + (size_t)nd * 1024 + kb * 64; return t; } r -= I_GIN;
        { const int kb = r >> 5, nd = (r & 31) * 32; t.N = 1024; t.src = IN(I_OWOUT) + (size_t)kb * 64 * 1024 + nd; t.dst = GWoutT + (size_t)nd * 1024 + kb * 64; return t; }
    };
    {
        float va[32], vb[32]; int it = X.gw;
        TrItem ta, tb; if (it < NITEMS) { ta = item_of(it); tr_load(ta, va, X.lane); }
        while (it < NITEMS) {
            const int it1 = it + X.NGW; if (it1 < NITEMS) { tb = item_of(it1); tr_load(tb, vb, X.lane); }
            tr_store(ta, va, scr, X.lane);
            if (it1 >= NITEMS) break;
            const int it2 = it1 + X.NGW; if (it2 < NITEMS) { ta = item_of(it2); tr_load(ta, va, X.lane); }
            tr_store(tb, vb, scr, X.lane);
            it = it2;
        }
    }
    { bf16* WsB = (bf16*)(X.ws + WS_WSB); const float* ws = IN(I_OWS);
      for (int i = (X.gw * 64 + X.lane) * 4; i < 8 * 128 * 128; i += X.NGW * 64 * 4) { const f32x4 v = *(const f32x4*)(ws + i); u32x2 o; o.x = pk2(v[0], v[1]); o.y = pk2(v[2], v[3]); *(u32x2*)(WsB + i) = o; } }
}

__device__ __forceinline__ void modulate_row(const float* xrow, const float* g, const float* sh, const float* sc, bf16* orow, int lane, f32x4 (&y)[4]) {
    const f32x4* xr = (const f32x4*)xrow + lane; f32x4 v[4]; float ss = 0.f;
#pragma unroll
    for (int j = 0; j < 4; ++j) { v[j] = xr[64 * j]; ss += (v[j][0] * v[j][0] + v[j][1] * v[j][1]) + (v[j][2] * v[j][2] + v[j][3] * v[j][3]); }
    const float rstd = rsqrtf(wave_sum(ss) * (1.0f / D) + EPS);
#pragma unroll
    for (int j = 0; j < 4; ++j) { const f32x4 gk = ((const f32x4*)g)[lane + 64 * j], sk = ((const f32x4*)sc)[lane + 64 * j], hk = ((const f32x4*)sh)[lane + 64 * j];
        y[j] = v[j] * rstd * gk * (1.0f + sk) + hk;
        u32x2 o; o.x = pk2(y[j][0], y[j][1]); o.y = pk2(y[j][2], y[j][3]); *((u32x2*)orow + lane + 64 * j) = o; }
}
__device__ __forceinline__ void mod0_load(const Ctx& X, int row, f32x4 (&v)[4]) {
    const float* xrow = row < NTOK ? IN(I_X) + (size_t)row * D : IN(I_CTX) + (size_t)(row - NTOK) * D;
#pragma unroll
    for (int j = 0; j < 4; ++j) v[j] = ((const f32x4*)xrow)[X.lane + 64 * j];
}
__device__ __forceinline__ void mod0_finish(const Ctx& X, int row, const f32x4 (&v)[4]) {
    const float* m = (const float*)(X.ws + WS_MOD) + (size_t)(row < NTOK ? row / SEQ : 8) * MODW; const float* g = IN(I_NMG);
    bf16* orow = row < NTOK ? (bf16*)(X.ws + WS_XA) + (size_t)row * D : (bf16*)(X.ws + WS_GM) + (size_t)(row - NTOK) * D;
    f32x4 gk[4], hk[4], sk[4]; float ss = 0.f;
#pragma unroll
    for (int j = 0; j < 4; ++j) { gk[j] = ((const f32x4*)g)[X.lane + 64 * j]; hk[j] = ((const f32x4*)m)[X.lane + 64 * j]; sk[j] = ((const f32x4*)(m + 1024))[X.lane + 64 * j];
        ss += (v[j][0] * v[j][0] + v[j][1] * v[j][1]) + (v[j][2] * v[j][2] + v[j][3] * v[j][3]); }
    const float rstd = rsqrtf(wave_sum(ss) * (1.0f / D) + EPS);
#pragma unroll
    for (int j = 0; j < 4; ++j) { const f32x4 y = v[j] * rstd * gk[j] * (1.0f + sk[j]) + hk[j]; u32x2 o; o.x = pk2(y[0], y[1]); o.y = pk2(y[2], y[3]); *((u32x2*)orow + X.lane + 64 * j) = o; }
}
__device__ __forceinline__ void phase_modulate0(const Args& a, const Ctx& X) {
    constexpr int NR = NTOK + NCTX; f32x4 va[4], vb[4];
    int row = X.gw; if (row < NR) mod0_load(X, row, va);
    while (row < NR) {
        const int r1 = row + X.NGW; if (r1 < NR) mod0_load(X, r1, vb);
        mod0_finish(X, row, va);
        if (r1 >= NR) break;
        const int r2 = r1 + X.NGW; if (r2 < NR) mod0_load(X, r2, va);
        mod0_finish(X, r1, vb);
        row = r2;
    }
}

__device__ __forceinline__ void qk_chunks(bf16* buf, int nchunks, int rowlen, const float* gn, bool rope, float oscale, const Ctx& X, const LAS f32x2* cs) {
    for (int ch = X.gw; ch < nchunks; ch += X.NGW) {
        const int e0 = ch * 512 + 8 * X.lane; const int token = e0 / rowlen; const int d0 = e0 & 63;
        u32x4 raw = *(const u32x4*)(buf + e0); float v[8];
#pragma unroll
        for (int i = 0; i < 4; ++i) { v[2 * i] = bf2f(raw[i] & 0xffffu); v[2 * i + 1] = bf2f(raw[i] >> 16); }
        float ss = 0.f;
#pragma unroll
        for (int i = 0; i < 8; ++i) ss += v[i] * v[i];
        ss += __shfl_xor(ss, 1); ss += __shfl_xor(ss, 2); ss += __shfl_xor(ss, 4);
        const float rstd = rsqrtf(ss * (1.0f / 64.0f) + EPS);
        const f32x4 g0 = *(const f32x4*)(gn + d0), g1 = *(const f32x4*)(gn + d0 + 4);
#pragma unroll
        for (int i = 0; i < 4; ++i) { v[i] = v[i] * rstd * g0[i]; v[4 + i] = v[4 + i] * rstd * g1[i]; }
        if (rope) {
            const int t = token % SEQ; const int dd0 = d0 & 31; const int pos = dd0 < 16 ? (t >> 6) : (t & 63);
            const LAS f32x2* cp = cs + pos * 16 + (dd0 & 15);
#pragma unroll
            for (int i = 0; i < 8; ++i) { const float pv = __shfl_xor(v[i], 4); const f32x2 c = cp[i];
                v[i] = (d0 < 32) ? (v[i] * c.x - pv * c.y) : (v[i] * c.x + pv * c.y); }
        }
        u32x4 o; o.x = pk2(v[0] * oscale, v[1] * oscale); o.y = pk2(v[2] * oscale, v[3] * oscale); o.z = pk2(v[4] * oscale, v[5] * oscale); o.w = pk2(v[6] * oscale, v[7] * oscale);
        *(u32x4*)(buf + e0) = o;
    }
}
__device__ __forceinline__ void phase_conv_qk(const Args& a, const Ctx& X) {
    LAS f32x2* cs = (LAS f32x2*)(X.lds + 65536);
    for (int i = X.tid; i < 1024; i += NTHREADS) { const float inv = exp2f(-(float)(i & 15) * (13.287712379549449f / 16.0f)); float sn, csn; sincosf((float)(i >> 4) * inv, &sn, &csn); cs[i] = (f32x2){csn, sn}; }
    __syncthreads();
    qk_chunks((bf16*)(X.ws + WS_Q), NTOK, 512, IN(I_QNG), true, QSCALE, X, cs);
    qk_chunks((bf16*)(X.ws + WS_K), NTOK / 4, 128, IN(I_KNG), true, 1.0f, X, cs);
    qk_chunks((bf16*)(X.ws + WS_KC), NCTX / 4, 128, IN(I_KNG), false, 1.0f, X, cs);
    const bf16* GLU = (const bf16*)(X.ws + WS_GLU); bf16* MIX = (bf16*)(X.ws + WS_MIX);
    LAS unsigned* tin = (LAS unsigned*)X.lds;
    LAS float* tout = (LAS float*)(X.lds + 65536);
    const int cp = X.tid & 255, th = X.tid >> 8;
    float w0[31], w1[31];
#pragma unroll
    for (int j = 0; j < 31; ++j) { const f32x2 w = *(const f32x2*)(IN(I_ECW) + j * 512 + 2 * cp); w0[j] = w.x; w1[j] = w.y; }
    const f32x2 cb = *(const f32x2*)(IN(I_ECB) + 2 * cp);
    for (int tile = X.bid; tile < NTOK / 32; tile += X.G) {
        const int row0 = tile * 32; const int t0 = row0 % SEQ;
        __syncthreads();
        for (int c = X.tid; c < 62 * 64; c += NTHREADS) { const int lr = c >> 6, cc = c & 63; const int t = t0 - 15 + lr;
            u32x4 v = (u32x4){0u, 0u, 0u, 0u}; if (t >= 0 && t < SEQ) v = *(const u32x4*)(GLU + (size_t)(row0 - 15 + lr) * 512 + cc * 8);
            *(LAS u32x4*)(tin + lr * 256 + cc * 4) = v; }
        __syncthreads();
        float a0[16], a1[16];
#pragma unroll
        for (int o = 0; o < 16; ++o) { a0[o] = cb.x; a1[o] = cb.y; }
#pragma unroll
        for (int rr = 0; rr < 46; ++rr) { const unsigned pv = tin[(16 * th + rr) * 256 + cp]; const float x0 = bf2f(pv & 0xffffu), x1 = bf2f(pv >> 16);
#pragma unroll
            for (int o = 0; o < 16; ++o) { const int j = rr - o; if (j >= 0 && j <= 30) { a0[o] += x0 * w0[j]; a1[o] += x1 * w1[j]; } } }
#pragma unroll
        for (int o = 0; o < 16; ++o) *(LAS f32x2*)(tout + (16 * th + o) * 512 + 2 * cp) = (f32x2){a0[o], a1[o]};
        __syncthreads();
#pragma unroll
        for (int q = 0; q < 4; ++q) { const int tl = X.wave * 4 + q; f32x4 v[2]; float s = 0.f;
#pragma unroll
            for (int j = 0; j < 2; ++j) { v[j] = *(const LAS f32x4*)(tout + tl * 512 + 4 * X.lane + 256 * j); s += (v[j][0] + v[j][1]) + (v[j][2] + v[j][3]); }
            const float mean = wave_sum(s) * (1.0f / 512.0f); float s2 = 0.f;
#pragma unroll
            for (int j = 0; j < 2; ++j) { v[j] = v[j] - mean; s2 += (v[j][0] * v[j][0] + v[j][1] * v[j][1]) + (v[j][2] * v[j][2] + v[j][3] * v[j][3]); }
            const float rstd = rsqrtf(wave_sum(s2) * (1.0f / 512.0f) + EPS);
#pragma unroll
            for (int j = 0; j < 2; ++j) { const f32x4 g = *(const f32x4*)(IN(I_ELNG) + 4 * X.lane + 256 * j), b = *(const f32x4*)(IN(I_ELNB) + 4 * X.lane + 256 * j);
                f32x4 y = v[j] * rstd * g + b;
#pragma unroll
                for (int k = 0; k < 4; ++k) y[k] = y[k] * sigmoidf_(y[k]);
                u32x2 o; o.x = pk2(y[0], y[1]); o.y = pk2(y[2], y[3]); *(u32x2*)(MIX + (size_t)(row0 + tl) * D + 4 * X.lane + 256 * j) = o; } }
    }
}

__device__ __forceinline__ void phase_attention(const Args& a, const Ctx& X) {
    const bf16* QN = (const bf16*)(X.ws + WS_Q); const bf16* KN = (const bf16*)(X.ws + WS_K); const bf16* VV = (const bf16*)(X.ws + WS_V);
    const bf16* KC = (const bf16*)(X.ws + WS_KC); const bf16* VC = (const bf16*)(X.ws + WS_VC); bf16* MIX = (bf16*)(X.ws + WS_MIX);
    LAS unsigned char* Ks = X.lds;
    LAS unsigned char* Vt = X.lds + 16384;
    const int lane = X.lane, l15 = lane & 15, g4 = lane >> 4;
    for (int unit = X.bid; unit < NB * 2 * 32; unit += X.G) {
        const int b = unit >> 6, kh = (unit >> 5) & 1, qb = unit & 31; const int q0 = qb * 64;
        const int hq = kh * 4 + (X.wave >> 1), tq = (X.wave & 1) * 32;
        bf16x8 Qf[2][2];
#pragma unroll
        for (int qi = 0; qi < 2; ++qi)
#pragma unroll
            for (int s = 0; s < 2; ++s) Qf[qi][s] = *(const bf16x8*)(QN + (size_t)(b * SEQ + q0 + tq + 16 * qi + l15) * 512 + hq * 64 + 32 * s + 8 * g4);
        const float sink2 = IN(I_SINK)[hq] * LOG2E;
        float mrun[2], lrun[2]; f32x4 O[2][4];
#pragma unroll
        for (int qi = 0; qi < 2; ++qi) { mrun[qi] = sink2; lrun[qi] = (g4 == 0) ? 1.0f : 0.0f;
#pragma unroll
            for (int db = 0; db < 4; ++db) O[qi][db] = (f32x4){0.f, 0.f, 0.f, 0.f}; }
        const int t_first = (q0 >= 128) ? 0 : (q0 >= 64 ? 1 : 2), t_skip_lo = (q0 + 128 < SEQ) ? 5 : (q0 + 64 < SEQ ? 4 : 3);
        const int key = X.tid >> 3, ch = X.tid & 7;
        auto tile_ptrs = [&](int t, const bf16*& kp, const bf16*& vp) {
            if (t < 5) { const int ks = q0 - 128 + 64 * t; kp = KN + (size_t)(b * SEQ + ks) * 128 + kh * 64; vp = VV + (size_t)(b * SEQ + ks) * 128 + kh * 64; }
            else { const int ks = (t - 5) * 64; kp = KC + (size_t)(b * CTXL + ks) * 128 + kh * 64; vp = VC + (size_t)(b * CTXL + ks) * 128 + kh * 64; } };
        auto lds_put = [&](int buf, const u32x4& kv, const u32x4& vv) {
            LAS unsigned char* Kd = Ks + buf * 32768; LAS unsigned char* Vd = Vt + buf * 32768;
            *(LAS u32x4*)(Kd + key * 144 + ch * 16) = kv;
#pragma unroll
            for (int i = 0; i < 4; ++i) { *(LAS unsigned short*)(Vd + (8 * ch + 2 * i) * 136 + key * 2) = (unsigned short)(vv[i] & 0xffffu); *(LAS unsigned short*)(Vd + (8 * ch + 2 * i + 1) * 136 + key * 2) = (unsigned short)(vv[i] >> 16); } };
        u32x4 kreg, vreg;
        { const bf16 *kp, *vp; tile_ptrs(t_first, kp, vp); kreg = *(const u32x4*)(kp + (size_t)key * 128 + ch * 8); vreg = *(const u32x4*)(vp + (size_t)key * 128 + ch * 8); }
        __syncthreads();
        lds_put(0, kreg, vreg);
        int bufi = 0;
        for (int t = t_first; t < 9; ++t) {
            if (t >= t_skip_lo && t < 5) continue;
            int tn = t + 1; if (tn >= t_skip_lo && tn < 5) tn = 5;
            if (tn < 9) { const bf16 *kp, *vp; tile_ptrs(tn, kp, vp); kreg = *(const u32x4*)(kp + (size_t)key * 128 + ch * 8); vreg = *(const u32x4*)(vp + (size_t)key * 128 + ch * 8); }
            const int mode = (t == 0) ? 1 : (t == 4 ? 2 : 0);
            __syncthreads();
            const LAS unsigned char* Kc = Ks + bufi * 32768; const LAS unsigned char* Vc = Vt + bufi * 32768;
            bf16x8 kf[4][2];
#pragma unroll
            for (int kb = 0; kb < 4; ++kb)
#pragma unroll
                for (int s = 0; s < 2; ++s) kf[kb][s] = *(const LAS bf16x8*)(Kc + (16 * kb + l15) * 144 + (32 * s + 8 * g4) * 2);
            bf16x8 vf[4][2];
#pragma unroll
            for (int db = 0; db < 4; ++db)
#pragma unroll
                for (int ks2 = 0; ks2 < 2; ++ks2) { const LAS unsigned char* p = Vc + (16 * db + l15) * 136 + (32 * ks2 + 4 * g4) * 2;
                    const u32x2 lo = *(const LAS u32x2*)p, hi = *(const LAS u32x2*)(p + 32);
                    u32x4 w; w.x = lo.x; w.y = lo.y; w.z = hi.x; w.w = hi.y; vf[db][ks2] = __builtin_bit_cast(bf16x8, w); }
#pragma unroll
            for (int qi = 0; qi < 2; ++qi) {
                f32x4 st[4];
#pragma unroll
                for (int kb = 0; kb < 4; ++kb) { st[kb] = (f32x4){0.f, 0.f, 0.f, 0.f};
#pragma unroll
                    for (int s = 0; s < 2; ++s) st[kb] = __builtin_amdgcn_mfma_f32_16x16x32_bf16(kf[kb][s], Qf[qi][s], st[kb], 0, 0, 0); }
                if (mode) { const int qloc = tq + 16 * qi + l15;
#pragma unroll
                    for (int kb = 0; kb < 4; ++kb)
#pragma unroll
                        for (int r = 0; r < 4; ++r) { const int kk = 16 * kb + 4 * g4 + r; const bool keep = (mode == 1) ? (kk >= qloc) : (kk <= qloc); if (!keep) st[kb][r] = -1e30f; } }
                float mx = st[0][0];
#pragma unroll
                for (int kb = 0; kb < 4; ++kb)
#pragma unroll
                    for (int r = 0; r < 4; ++r) mx = fmaxf(mx, st[kb][r]);
                mx = fmaxf(mx, __shfl_xor(mx, 16)); mx = fmaxf(mx, __shfl_xor(mx, 32));
                const float mnew = fmaxf(mrun[qi], mx); const float alpha = __builtin_amdgcn_exp2f(mrun[qi] - mnew); mrun[qi] = mnew;
                float ps = 0.f;
#pragma unroll
                for (int kb = 0; kb < 4; ++kb)
#pragma unroll
                    for (int r = 0; r < 4; ++r) { st[kb][r] = __builtin_amdgcn_exp2f(st[kb][r] - mnew); ps += st[kb][r]; }
                lrun[qi] = lrun[qi] * alpha + ps;
#pragma unroll
                for (int db = 0; db < 4; ++db) O[qi][db] = O[qi][db] * alpha;
#pragma unroll
                for (int ks2 = 0; ks2 < 2; ++ks2) { u32x4 w; w.x = pk2(st[2 * ks2][0], st[2 * ks2][1]); w.y = pk2(st[2 * ks2][2], st[2 * ks2][3]); w.z = pk2(st[2 * ks2 + 1][0], st[2 * ks2 + 1][1]); w.w = pk2(st[2 * ks2 + 1][2], st[2 * ks2 + 1][3]);
                    const bf16x8 pf = __builtin_bit_cast(bf16x8, w);
#pragma unroll
                    for (int db = 0; db < 4; ++db) O[qi][db] = __builtin_amdgcn_mfma_f32_16x16x32_bf16(vf[db][ks2], pf, O[qi][db], 0, 0, 0); }
            }
            if (tn < 9) lds_put(bufi ^ 1, kreg, vreg);
            bufi ^= 1;
        }
#pragma unroll
        for (int qi = 0; qi < 2; ++qi) { float l = lrun[qi]; l += __shfl_xor(l, 16); l += __shfl_xor(l, 32); const float inv = 1.0f / l;
            bf16* orow = MIX + (size_t)(b * SEQ + q0 + tq + 16 * qi + l15) * D + 512 + hq * 64 + 4 * g4;
#pragma unroll
            for (int db = 0; db < 4; ++db) { u32x2 o; o.x = pk2(O[qi][db][0] * inv, O[qi][db][1] * inv); o.y = pk2(O[qi][db][2] * inv, O[qi][db][3] * inv); *(u32x2*)(orow + 16 * db) = o; } }
    }
}

__device__ __forceinline__ void phase_router(const Args& a, const Ctx& X, int layer) {
    const float* __restrict__ H = (const float*)(X.ws + WS_H); unsigned char* XA8 = (unsigned char*)(X.ws + WS_XA8);
    const float* MODl = (const float*)(X.ws + WS_MOD) + (size_t)layer * 9 * MODW; const float* gn = IN(I_NFG) + layer * D;
    const float* rw = IN(I_RW) + (size_t)layer * D * NE; const float* rb = IN(I_RB) + layer * NE;
    int* cntg = (int*)(X.ws + WS_CTL) + CW_CNT + layer * NE * CNT_STRIDE; int* list = (int*)(X.ws + WS_LIST); float* gatew = (float*)(X.ws + WS_GATE);
    LAS float* ybuf = (LAS float*)X.lds;
    LAS float* part = (LAS float*)(X.lds + 65536);
    LAS int* sel = (LAS int*)(X.lds + 65536 + 16384);
    LAS int* lcnt = (LAS int*)(X.lds + 65536 + 16384 + 1024);
    LAS float* lgs = (LAS float*)(X.lds + 65536 + 16384 + 2048);
    LAS float* tvs = lgs + 512;
    LAS float* exs = lgs + 528;
    PMARK(0);
    const int e = X.lane & 31, hf = X.lane >> 5;
    float wreg[64];
#pragma unroll
    for (int i = 0; i < 64; ++i) wreg[i] = rw[(size_t)(128 * X.wave + 64 * hf + i) * NE + e];
    const float rbe = rb[e];
    for (int blk = X.bid; blk < NTOK / 64; blk += X.G) {
        const int rowbase = blk * 64; const float* m = MODl + (size_t)(rowbase / SEQ) * MODW;
        f32x4 gk[4], hk[4], xv[2][4];
#pragma unroll
        for (int j = 0; j < 4; ++j) { gk[j] = ((const f32x4*)gn)[X.lane + 64 * j]; hk[j] = ((const f32x4*)(m + 3 * 1024))[X.lane + 64 * j]; const f32x4 s_ = ((const f32x4*)(m + 4 * 1024))[X.lane + 64 * j]; gk[j] = gk[j] * (1.0f + s_); }
#pragma unroll
        for (int i = 0; i < 2; ++i)
#pragma unroll
            for (int j = 0; j < 4; ++j) xv[i][j] = ((const f32x4*)(H + (size_t)(rowbase + 2 * X.wave + i) * D))[X.lane + 64 * j];
        __syncthreads();
        if (X.tid < 64) lcnt[X.tid] = 0;
        PMARK(1);
#pragma unroll 1
        for (int bt = 0; bt < 4; ++bt) {
#pragma unroll
            for (int i = 0; i < 2; ++i) { const int rl = 2 * X.wave + i, row = rowbase + 16 * bt + rl; float ss = 0.f;
#pragma unroll
                for (int j = 0; j < 4; ++j) ss += (xv[i][j][0] * xv[i][j][0] + xv[i][j][1] * xv[i][j][1]) + (xv[i][j][2] * xv[i][j][2] + xv[i][j][3] * xv[i][j][3]);
                const float rstd = rsqrtf(wave_sum(ss) * (1.0f / D) + EPS);
#pragma unroll
                for (int j = 0; j < 4; ++j) { const f32x4 y = xv[i][j] * rstd * gk[j] + hk[j];
                    *((unsigned*)(XA8 + (size_t)row * D) + X.lane + 64 * j) = pk4_fp8(y[0] * FP8_AMUL, y[1] * FP8_AMUL, y[2] * FP8_AMUL, y[3] * FP8_AMUL);
                    *(LAS f32x4*)(ybuf + rl * 1024 + 4 * X.lane + 256 * j) = y; } }
            if (bt < 3) {
#pragma unroll
                for (int i = 0; i < 2; ++i)
#pragma unroll
                    for (int j = 0; j < 4; ++j) xv[i][j] = ((const f32x4*)(H + (size_t)(rowbase + 16 * (bt + 1) + 2 * X.wave + i) * D))[X.lane + 64 * j];
            }
            __syncthreads();
#pragma unroll 2
            for (int r = 0; r < 16; ++r) { float acc[4] = {0.f, 0.f, 0.f, 0.f}; const LAS float* yp = ybuf + r * 1024 + 128 * X.wave + 64 * hf;
#pragma unroll
                for (int i4 = 0; i4 < 16; ++i4) { const f32x4 yv = *(const LAS f32x4*)(yp + 4 * i4);
                    acc[i4 & 3] += yv[0] * wreg[4 * i4] + yv[1] * wreg[4 * i4 + 1] + yv[2] * wreg[4 * i4 + 2] + yv[3] * wreg[4 * i4 + 3]; }
                const float t0 = (acc[0] + acc[1]) + (acc[2] + acc[3]); const float t = t0 + dpp_swap32(t0);
                if (hf == 0) part[(r * 8 + X.wave) * 32 + e] = t; }
            __syncthreads();
            { const int r = 2 * X.wave + hf, rl = 16 * bt + r;
              float v = rbe;
#pragma unroll
              for (int w8 = 0; w8 < 8; ++w8) v += part[(r * 8 + w8) * 32 + e];
              lgs[r * 32 + e] = v; LDS_WAIT();
              int ez = e; asm volatile("" : "+v"(ez));
              int rank = 0;
#pragma unroll
              for (int j4 = 0; j4 < 8; ++j4) { const f32x4 o = *(const LAS f32x4*)(lgs + r * 32 + 4 * j4);
#pragma unroll
                  for (int c = 0; c < 4; ++c) rank += (o[c] > v || (o[c] == v && (4 * j4 + c) < ez)) ? 1 : 0; }
              if (rank == 0) tvs[r] = v;
              LDS_WAIT();
              const float ex = __expf(v - tvs[r]);
              if (rank < 4) exs[r * 4 + rank] = ex;
              LDS_WAIT();
              const f32x4 e4 = *(const LAS f32x4*)(exs + r * 4); const float inv = 1.0f / ((e4[0] + e4[1]) + (e4[2] + e4[3]));
              if (rank < 4) { const int slot = atomicAdd((int*)&lcnt[e], 1); sel[rl * 4 + rank] = (e << 16) | slot; gatew[(size_t)(rowbase + rl) * 4 + rank] = ex * inv; } }
        }
        __syncthreads();
        PMARK(2);
        if (X.tid < 32) lcnt[32 + X.tid] = atomicAdd(cntg + X.tid * CNT_STRIDE, lcnt[X.tid]);
        __syncthreads();
        if (X.tid < 256) { const int w = sel[X.tid]; const int ee = w >> 16, rank = w & 0xffff; list[(size_t)ee * NTOK + lcnt[32 + ee] + rank] = rowbase * 4 + X.tid; }
    }
    PMARK(3);
}

__device__ __forceinline__ void phase_combine(const Args& a, const Ctx& X, int layer) {
    float* H = (float*)(X.ws + WS_H); const bf16* __restrict__ Y = (const bf16*)(X.ws + WS_Y); bf16* XA = (bf16*)(X.ws + WS_XA);
    const float* __restrict__ MODl = (const float*)(X.ws + WS_MOD) + (size_t)layer * 9 * MODW;
    float* outp = (float*)(__attribute__((address_space(1))) float*)X.kp[33];
    for (int row = X.gw; row < NTOK; row += X.NGW) {
        const float* gt = MODl + (size_t)(row / SEQ) * MODW + 5 * 1024; f32x4 h[2][2], g[2][2]; u32x4 yw[2][4];
#pragma unroll
        for (int j = 0; j < 2; ++j) { const int c0 = 8 * X.lane + 512 * j;
#pragma unroll
            for (int q = 0; q < 2; ++q) { h[j][q] = *(const f32x4*)(H + (size_t)row * D + c0 + 4 * q); g[j][q] = *(const f32x4*)(gt + c0 + 4 * q); }
#pragma unroll
            for (int k = 0; k < 4; ++k) yw[j][k] = *(const u32x4*)(Y + ((size_t)row * 4 + k) * D + c0); }
        float ss = 0.f;
#pragma unroll
        for (int j = 0; j < 2; ++j) { f32x4 s0 = (f32x4){0.f, 0.f, 0.f, 0.f}, s1 = s0;
#pragma unroll
            for (int k = 0; k < 4; ++k) { const u32x4 w = yw[j][k]; s0 += (f32x4){bf2f(w.x & 0xffffu), bf2f(w.x >> 16), bf2f(w.y & 0xffffu), bf2f(w.y >> 16)}; s1 += (f32x4){bf2f(w.z & 0xffffu), bf2f(w.z >> 16), bf2f(w.w & 0xffffu), bf2f(w.w >> 16)}; }
            h[j][0] = h[j][0] + g[j][0] * s0; h[j][1] = h[j][1] + g[j][1] * s1;
#pragma unroll
            for (int q = 0; q < 2; ++q) ss += (h[j][q][0] * h[j][q][0] + h[j][q][1] * h[j][q][1]) + (h[j][q][2] * h[j][q][2] + h[j][q][3] * h[j][q][3]); }
        if (layer == 1) {
#pragma unroll
            for (int j = 0; j < 2; ++j)
#pragma unroll
                for (int q = 0; q < 2; ++q) *(f32x4*)(outp + (size_t)row * D + 8 * X.lane + 512 * j + 4 * q) = h[j][q];
        } else {
            const float* m1 = (const float*)(X.ws + WS_MOD) + (size_t)9 * MODW + (size_t)(row / SEQ) * MODW; const float* gn = IN(I_NMG) + D;
            f32x4 gk[2][2], hk[2][2], sk[2][2];
#pragma unroll
            for (int j = 0; j < 2; ++j)
#pragma unroll
                for (int q = 0; q < 2; ++q) { const int c0 = 8 * X.lane + 512 * j + 4 * q; gk[j][q] = *(const f32x4*)(gn + c0); hk[j][q] = *(const f32x4*)(m1 + c0); sk[j][q] = *(const f32x4*)(m1 + 1024 + c0); }
            const float rstd = rsqrtf(wave_sum(ss) * (1.0f / D) + EPS);
#pragma unroll
            for (int j = 0; j < 2; ++j) { const int c0 = 8 * X.lane + 512 * j;
                const f32x4 y0 = h[j][0] * rstd * gk[j][0] * (1.0f + sk[j][0]) + hk[j][0], y1 = h[j][1] * rstd * gk[j][1] * (1.0f + sk[j][1]) + hk[j][1];
                *(f32x4*)(H + (size_t)row * D + c0) = h[j][0]; *(f32x4*)(H + (size_t)row * D + c0 + 4) = h[j][1];
                *(u32x4*)(XA + (size_t)row * D + c0) = pack8(y0, y1); }
        }
    }
}

__device__ __forceinline__ void phase_spatial(const Args& a, const Ctx& X) {
    const bf16* U = (const bf16*)(X.ws + WS_U); const bf16* VB = (const bf16*)(X.ws + WS_VB); bf16* SG = (bf16*)(X.ws + WS_MIX); const bf16* WsB = (const bf16*)(X.ws + WS_WSB); const float* vstat = (const float*)(X.ws + WS_CTL) + CW_VSTAT;
    LAS float* stat = (LAS float*)X.lds;
    LAS unsigned char* Vt = X.lds + 4096;
    const int lane = X.lane, l15 = lane & 15, g4 = lane >> 4;
    for (int item = X.bid; item < 128 * 8; item += X.G) {
        const int chunk = item >> 3, g = item & 7; const int row0 = chunk * 128;
        __syncthreads();
        if (X.tid < 128) { const f32x2 sv = *(const f32x2*)(vstat + 2 * (row0 + X.tid)); const float mean = sv.x * (1.0f / D); const float var = fmaxf(sv.y * (1.0f / D) - mean * mean, 0.f);
            stat[2 * X.tid] = mean; stat[2 * X.tid + 1] = rsqrtf(var + EPS); }
        __syncthreads();
#pragma unroll
        for (int c = X.tid; c < 128 * 16; c += NTHREADS) { const int q = c >> 4, cc = c & 15; const u32x4 w = *(const u32x4*)(VB + (size_t)(row0 + q) * D + g * 128 + cc * 8);
            const float mean = stat[2 * q], rstd = stat[2 * q + 1]; const float* lg_ = IN(I_OLNG) + g * 128 + cc * 8; const float* lb_ = IN(I_OLNB) + g * 128 + cc * 8;
#pragma unroll
            for (int k = 0; k < 4; ++k) { const float y0 = (bf2f(w[k] & 0xffffu) - mean) * rstd * lg_[2 * k] + lb_[2 * k], y1 = (bf2f(w[k] >> 16) - mean) * rstd * lg_[2 * k + 1] + lb_[2 * k + 1];
                const unsigned pk = pk2(y0, y1);
                *(LAS unsigned short*)(Vt + ((2 * k) * 17 + cc) * 272 + q * 2) = (unsigned short)(pk & 0xffffu); *(LAS unsigned short*)(Vt + ((2 * k + 1) * 17 + cc) * 272 + q * 2) = (unsigned short)(pk >> 16); } }
        __syncthreads();
        f32x4 acc[8];
#pragma unroll
        for (int pb = 0; pb < 8; ++pb) acc[pb] = (f32x4){0.f, 0.f, 0.f, 0.f};
#pragma unroll
        for (int s = 0; s < 4; ++s) { const bf16x8 af = *(const LAS bf16x8*)(Vt + ((l15 & 7) * 17 + 2 * X.wave + (l15 >> 3)) * 272 + (32 * s + 8 * g4) * 2);
#pragma unroll
            for (int pb = 0; pb < 8; ++pb) { const bf16x8 bfr = *(const bf16x8*)(WsB + ((size_t)g * 128 + 16 * pb + l15) * 128 + 32 * s + 8 * g4); acc[pb] = __builtin_amdgcn_mfma_f32_16x16x32_bf16(af, bfr, acc[pb], 0, 0, 0); } }
#pragma unroll
        for (int pb = 0; pb < 8; ++pb) { const int p = 16 * pb + l15; const float bs = IN(I_OBS)[g * 128 + p]; const size_t off = (size_t)(row0 + p) * D + g * 128 + 16 * X.wave + 4 * g4;
            const u32x2 uw = *(const u32x2*)(U + off);
            u32x2 o; o.x = pk2(bf2f(uw.x & 0xffffu) * (acc[pb][0] + bs), bf2f(uw.x >> 16) * (acc[pb][1] + bs)); o.y = pk2(bf2f(uw.y & 0xffffu) * (acc[pb][2] + bs), bf2f(uw.y >> 16) * (acc[pb][3] + bs));
            *(u32x2*)(SG + off) = o; }
    }
}

enum { PH_PRO = 0, PH_MOD0, PH_GIN, PH_CONV, PH_ATT, PH_GOUT, PH_RT0, PH_M1_0, PH_M2_0, PH_CMB0, PH_GMI, PH_SPA, PH_GMO, PH_RT1, PH_M1_1, PH_M2_1, PH_CMB1, NPHASE };

__global__ void __launch_bounds__(NTHREADS, 2) mega(Args a) {
    extern __shared__ __attribute__((aligned(16))) unsigned char lds_raw[];
    Ctx X; X.lds = (LAS unsigned char*)lds_raw;
    const int wave0 = __builtin_amdgcn_readfirstlane((int)threadIdx.x >> 6);
    const int G0 = gridDim.x, bid0 = blockIdx.x; const int vcu0 = (G0 % 8 == 0) ? (bid0 % 8) * (G0 / 8) + bid0 / 8 : bid0;
    X.wave = wave0;
    volatile LAS unsigned* MISC = (volatile LAS unsigned*)(X.lds + MISC_OFF);
    if (threadIdx.x < 64) MISC[threadIdx.x] = 0u;
    __syncthreads();
    XcdBarrier bar = xcd_barrier_post((unsigned*)(a.ws + WS_CTL) + CW_BAR + a.li * XCD_BAR_WORDS, MISC + 8);
    const int ph_lo = a.ph_lo, ph_hi = a.ph_hi;
#if PROBE_PH >= 0
#define PROBE_STAMP(p) do { if ((p) == PROBE_PH) pr_t0 = __builtin_amdgcn_s_memrealtime(); if ((p) == PROBE_END) pr_t1 = __builtin_amdgcn_s_memrealtime(); } while (0)
#else
#define PROBE_STAMP(p) do { } while (0)
#endif
#define PH_ENTER() int z; asm volatile("s_mov_b32 %0, 0" : "=s"(z)); \
        X.lane = (int)__builtin_amdgcn_mbcnt_hi(~0u, __builtin_amdgcn_mbcnt_lo(~0u, (unsigned)z)); X.tid = wave0 * 64 + X.lane; \
        X.G = G0 + z; X.vcu = vcu0 + z; X.bid = bid0 + z; X.NGW = X.G * NWAVES; X.gw = X.vcu * NWAVES + wave0; \
        { kargp_t kp = (kargp_t)__builtin_amdgcn_kernarg_segment_ptr(); asm volatile("" : "+s"(kp)); X.kp = kp; } \
        unsigned char* ws = (unsigned char*)(__attribute__((address_space(1))) unsigned char*)X.kp[34] + z; X.ws = ws;
#if PROBE_PH >= 0
    unsigned long long pr_t0 = 0, pr_t1 = 0;
#endif
#define PH_RUN(PHK, ...) if (ph_lo <= (PHK) && (PHK) < ph_hi) { const int ph = (PHK); \
        if (ph != ph_lo) { const int l0 = (int)__builtin_amdgcn_mbcnt_hi(~0u, __builtin_amdgcn_mbcnt_lo(~0u, 0u)); xcd_barrier(bar, wave0 * 64 + l0); } \
        PROBE_STAMP(ph); __VA_ARGS__ }
    PH_RUN(PH_PRO, { PH_ENTER(); phase_prologue(a, X); })
    PH_RUN(PH_MOD0, { PH_ENTER(); phase_modulate0(a, X); })
    PH_RUN(PH_GIN, { PH_ENTER(); DenseSched S; S.init((const bf16*)(ws + WS_XA), (const bf16*)(ws + WS_WINT), NTOK, EVEN_IN, X.G, X.bid);
            S.A2 = (const bf16*)(ws + WS_GM); S.Bt2 = (const bf16*)(ws + WS_WINT) + (size_t)KV_COL * D; S.nM2 = NCTX / 256;
            EpiIn E{(bf16*)(ws + WS_GLU), (bf16*)(ws + WS_Q), (bf16*)(ws + WS_K), (bf16*)(ws + WS_V), (bf16*)(ws + WS_KC), (bf16*)(ws + WS_VC), IN(I_EBIN)};
            pg8::gemm_phase<EpiIn, DenseSched>(X.lds, S, E, X.tid); })
    PH_RUN(PH_CONV, { PH_ENTER(); phase_conv_qk(a, X); })
    PH_RUN(PH_ATT, { PH_ENTER(); phase_attention(a, X); })
    PH_RUN(PH_GOUT, { PH_ENTER(); DenseSched S; S.init((const bf16*)(ws + WS_MIX), (const bf16*)(ws + WS_WOUTT), NTOK, D, X.G, X.bid);
            EpiRes E{IN(I_X), (float*)(ws + WS_H), IN(I_EBOUT), (const float*)(ws + WS_MOD) + 2 * 1024};
            pg8::gemm_phase<EpiRes, DenseSched>(X.lds, S, E, X.tid); })
    PH_RUN(PH_RT0, { PH_ENTER(); phase_router(a, X, 0); })
    PH_RUN(PH_M1_0, { PH_ENTER(); const int l = (ph == PH_M1_1); moe_build_table(X, (const int*)(ws + WS_CTL) + CW_CNT + l * NE * CNT_STRIDE);
            MoeSchedT<true, 8> S; S.tab = (const LAS int*)(X.lds + TAB_OFF); S.G = X.G; S.c = X.vcu; S.A = (const unsigned char*)(ws + WS_XA8); S.Bt = (const unsigned char*)(ws + WS_W1T) + (size_t)l * NE * 2048 * 1024; S.list = (const int*)(ws + WS_LIST);
            EpiSwiglu E{(unsigned char*)(ws + WS_ACT), IN(I_B1) + (size_t)l * NE * 2048};
            pg8::gemm_phase<EpiSwiglu, MoeSchedT<true, 8>>(X.lds, S, E, X.tid); })
    PH_RUN(PH_M2_0, { PH_ENTER(); const int l = (ph == PH_M2_1); moe_build_table(X, (const int*)(ws + WS_CTL) + CW_CNT + l * NE * CNT_STRIDE);
            MoeSchedT<false, 4> S; S.tab = (const LAS int*)(X.lds + TAB_OFF); S.G = X.G; S.c = X.vcu; S.A = (const unsigned char*)(ws + WS_ACT); S.Bt = (const unsigned char*)(ws + WS_W2T) + (size_t)l * NE * 1024 * 1024; S.list = (const int*)(ws + WS_LIST);
            EpiDown E{(bf16*)(ws + WS_Y), IN(I_B2) + (size_t)l * NE * D, (const int*)(ws + WS_LIST), (const float*)(ws + WS_GATE), (const LAS int*)(X.lds + TAB_OFF)};
            pg8::gemm_phase<EpiDown, MoeSchedT<false, 4>>(X.lds, S, E, X.tid); })
    PH_RUN(PH_CMB0, { PH_ENTER(); phase_combine(a, X, 0); })
    PH_RUN(PH_GMI, { PH_ENTER(); DenseSched S; S.init((const bf16*)(ws + WS_XA), (const bf16*)(ws + WS_GWINT), NTOK, 2048, X.G, X.bid);
            EpiGelu E{(bf16*)(ws + WS_U), (bf16*)(ws + WS_VB), IN(I_OBIN), (float*)(ws + WS_CTL) + CW_VSTAT};
            pg8::gemm_phase<EpiGelu, DenseSched>(X.lds, S, E, X.tid); })
    PH_RUN(PH_SPA, { PH_ENTER(); phase_spatial(a, X); })
    PH_RUN(PH_GMO, { PH_ENTER(); DenseSched S; S.init((const bf16*)(ws + WS_MIX), (const bf16*)(ws + WS_GWOUTT), NTOK, D, X.G, X.bid);
            EpiRes E{(const float*)(ws + WS_H), (float*)(ws + WS_H), IN(I_OBOUT), (const float*)(ws + WS_MOD) + (size_t)9 * MODW + 2 * 1024};
            pg8::gemm_phase<EpiRes, DenseSched>(X.lds, S, E, X.tid); })
    PH_RUN(PH_RT1, { PH_ENTER(); phase_router(a, X, 1); })
    PH_RUN(PH_M1_1, { PH_ENTER(); const int l = (ph == PH_M1_1); moe_build_table(X, (const int*)(ws + WS_CTL) + CW_CNT + l * NE * CNT_STRIDE);
            MoeSchedT<true, 8> S; S.tab = (const LAS int*)(X.lds + TAB_OFF); S.G = X.G; S.c = X.vcu; S.A = (const unsigned char*)(ws + WS_XA8); S.Bt = (const unsigned char*)(ws + WS_W1T) + (size_t)l * NE * 2048 * 1024; S.list = (const int*)(ws + WS_LIST);
            EpiSwiglu E{(unsigned char*)(ws + WS_ACT), IN(I_B1) + (size_t)l * NE * 2048};
            pg8::gemm_phase<EpiSwiglu, MoeSchedT<true, 8>>(X.lds, S, E, X.tid); })
    PH_RUN(PH_M2_1, { PH_ENTER(); const int l = (ph == PH_M2_1); moe_build_table(X, (const int*)(ws + WS_CTL) + CW_CNT + l * NE * CNT_STRIDE);
            MoeSchedT<false, 4> S; S.tab = (const LAS int*)(X.lds + TAB_OFF); S.G = X.G; S.c = X.vcu; S.A = (const unsigned char*)(ws + WS_ACT); S.Bt = (const unsigned char*)(ws + WS_W2T) + (size_t)l * NE * 1024 * 1024; S.list = (const int*)(ws + WS_LIST);
            EpiDown E{(bf16*)(ws + WS_Y), IN(I_B2) + (size_t)l * NE * D, (const int*)(ws + WS_LIST), (const float*)(ws + WS_GATE), (const LAS int*)(X.lds + TAB_OFF)};
            pg8::gemm_phase<EpiDown, MoeSchedT<false, 4>>(X.lds, S, E, X.tid); })
    PH_RUN(PH_CMB1, { PH_ENTER(); phase_combine(a, X, 1); })
#if PROBE_PH == -2
    if (blockIdx.x == 0 && threadIdx.x == 0) { volatile LAS unsigned long long* pm_ = (volatile LAS unsigned long long*)(X.lds + MISC_OFF + 128); const unsigned long long te = __builtin_amdgcn_s_memrealtime(); const unsigned long long span = (pm_[1] - pm_[0]) * PROBE_MULT;
        while (__builtin_amdgcn_s_memrealtime() - te < span) __builtin_amdgcn_s_sleep(8); }
#endif
#if PROBE_PH >= 0
    if (pr_t1 == 0) pr_t1 = __builtin_amdgcn_s_memrealtime();
    if (blockIdx.x == 0 && wave0 == 0) { const unsigned long long te = __builtin_amdgcn_s_memrealtime(); const unsigned long long span = (pr_t1 - pr_t0) * PROBE_MULT;
        while (__builtin_amdgcn_s_memrealtime() - te < span) __builtin_amdgcn_s_sleep(8); }
#endif
}

__device__ __forceinline__ bool find_expert(const int* cnt, int s, int& e, int& slot) {
    int pb = 0;
    for (int i = 0; i < NE; ++i) { const int c = cnt[i * CNT_STRIDE]; const int pr = ((c + 255) >> 8) << 8; if (s < pb + pr) { e = i; slot = s - pb; return true; } pb += pr; }
    return false;
}
__global__ void __launch_bounds__(256) slow_gemm(const bf16* A, const int* arow, const bf16* Bt, float* C, int N, const int* cnt, size_t bstride) {
    __shared__ float As[16][65], Bs[16][65];
    const int tx = threadIdx.x & 15, ty = threadIdx.x >> 4; const int m0 = blockIdx.y * 64, n0 = blockIdx.x * 64;
    if (cnt) { int e, slot; if (!find_expert(cnt, m0, e, slot)) return; Bt += (size_t)e * bstride; }
    float acc[4][4];
    for (int i = 0; i < 4; ++i) for (int j = 0; j < 4; ++j) acc[i][j] = 0.f;
    for (int k0 = 0; k0 < 1024; k0 += 16) {
        for (int i = 0; i < 4; ++i) { const int idx = threadIdx.x + 256 * i; const int r = idx >> 4, kk = idx & 15; const int gm = m0 + r; const int ar = arow ? arow[gm] : gm;
            As[kk][r] = bf2f(A[(size_t)ar * 1024 + k0 + kk]); Bs[kk][r] = bf2f(Bt[(size_t)(n0 + r) * 1024 + k0 + kk]); }
        __syncthreads();
        for (int kk = 0; kk < 16; ++kk) { float av[4], bv[4];
            for (int i = 0; i < 4; ++i) { av[i] = As[kk][ty * 4 + i]; bv[i] = Bs[kk][tx * 4 + i]; }
            for (int i = 0; i < 4; ++i) for (int j = 0; j < 4; ++j) acc[i][j] += av[i] * bv[j]; }
        __syncthreads();
    }
    for (int i = 0; i < 4; ++i) for (int j = 0; j < 4; ++j) C[(size_t)(m0 + ty * 4 + i) * N + n0 + tx * 4 + j] = acc[i][j];
}
__device__ __forceinline__ unsigned short f2bf_s(float f) { return (unsigned short)(pk2(f, 0.f) & 0xffffu); }
__global__ void slow_epi_in(const float* C, const float* C2, const float* bias, bf16* GLU, bf16* Q, bf16* Kb, bf16* Vb, bf16* KC, bf16* VC) {
    const size_t i = (size_t)blockIdx.x * blockDim.x + threadIdx.x;
    if (i < (size_t)NTOK * 512) { const int row = (int)(i >> 9), j = (int)(i & 511); const int t = j >> 7, ii = j & 127; const float* cr = C + (size_t)row * EVEN_IN;
        const float u = cr[t * 256 + ii] + bias[j], g = cr[t * 256 + 128 + ii] + bias[512 + j];
        GLU[i] = f2bf_s(u / (1.0f + expf(-g)));
        Q[i] = f2bf_s(cr[1024 + j] + bias[1024 + j]);
        if (j < 128) { Kb[(size_t)row * 128 + j] = f2bf_s(cr[1536 + j] + bias[1536 + j]); Vb[(size_t)row * 128 + j] = f2bf_s(cr[1664 + j] + bias[1664 + j]); }
        if (row < NCTX && j < 128) { KC[(size_t)row * 128 + j] = f2bf_s(C2[(size_t)row * 256 + j] + bias[1536 + j]); VC[(size_t)row * 128 + j] = f2bf_s(C2[(size_t)row * 256 + 128 + j] + bias[1664 + j]); } }
}
__global__ void slow_epi_res(const float* C, const float* base, float* out, const float* bias, const float* gate) {
    const size_t i = (size_t)blockIdx.x * blockDim.x + threadIdx.x;
    if (i < (size_t)NTOK * D) { const int row = (int)(i >> 10), col = (int)(i & 1023); out[i] = base[i] + gate[(size_t)(row / SEQ) * MODW + col] * (C[i] + bias[col]); }
}
__global__ void slow_epi_gelu(const float* C, const float* bias, bf16* U, bf16* V) {
    const size_t i = (size_t)blockIdx.x * blockDim.x + threadIdx.x;
    if (i < (size_t)NTOK * 2048) { const int row = (int)(i >> 11), col = (int)(i & 2047); const float x = C[i] + bias[col]; const float y = 0.5f * x * (1.0f + erff(x * 0.70710678118654752f));
        if (col < 1024) U[(size_t)row * D + col] = f2bf_s(y); else V[(size_t)row * D + col - 1024] = f2bf_s(y); }
}
__global__ void slow_arow(const int* cnt, const int* list, int* arow) {
    const int s = blockIdx.x * blockDim.x + threadIdx.x; if (s >= ACT_ROWS) return;
    int e, slot; int r = 0; if (find_expert(cnt, s, e, slot) && slot < cnt[e * CNT_STRIDE]) r = list[(size_t)e * NTOK + slot] >> 2;
    arow[s] = r;
}
__global__ void slow_epi_swiglu(const float* C, const int* cnt, const float* b1, bf16* ACT) {
    const size_t i = (size_t)blockIdx.x * blockDim.x + threadIdx.x;
    if (i < (size_t)ACT_ROWS * 1024) { const int s = (int)(i >> 10), j = (int)(i & 1023); int e, slot; if (!find_expert(cnt, s, e, slot)) return;
        const int t = j >> 7, ii = j & 127; const float* cr = C + (size_t)s * 2048;
        float g = cr[t * 256 + ii] + b1[(size_t)e * 2048 + j], up = cr[t * 256 + 128 + ii] + b1[(size_t)e * 2048 + 1024 + j];
        g = fminf(g, 7.0f); up = fminf(fmaxf(up, -7.0f), 7.0f);
        ACT[i] = f2bf_s((up + 1.0f) * g / (1.0f + expf(-1.702f * g))); }
}
__global__ void slow_epi_down(const float* C, const int* cnt, const int* list, const float* gatew, const float* b2, bf16* Y) {
    const size_t i = (size_t)blockIdx.x * blockDim.x + threadIdx.x;
    if (i < (size_t)ACT_ROWS * 1024) { const int s = (int)(i >> 10), col = (int)(i & 1023); int e, slot; if (!find_expert(cnt, s, e, slot) || slot >= cnt[e * CNT_STRIDE]) return;
        const int aid = list[(size_t)e * NTOK + slot]; Y[(size_t)aid * D + col] = f2bf_s((C[i] + b2[(size_t)e * D + col]) * gatew[aid]); }
}
__global__ void __launch_bounds__(64) slow_attention(const bf16* QN, const bf16* KN, const bf16* VV, const bf16* KC, const bf16* VC, const float* sink, bf16* MIX) {
    const int i = blockIdx.x * blockDim.x + threadIdx.x; if (i >= NTOK * 8) return;
    const int row = i >> 3, h = i & 7, kh = h >> 2, b = row / SEQ, t = row % SEQ;
    float q[64], o[64];
    for (int d = 0; d < 64; ++d) { q[d] = bf2f(QN[(size_t)row * 512 + h * 64 + d]); o[d] = 0.f; }
    float m = sink[h] * LOG2E, l = 1.0f;
    const int j0 = t - 128 < 0 ? 0 : t - 128, j1 = t + 128 > SEQ - 1 ? SEQ - 1 : t + 128;
    for (int jj = j0; jj <= j1 + CTXL; ++jj) {
        const bf16* kp; const bf16* vp;
        if (jj <= j1) { kp = KN + (size_t)(b * SEQ + jj) * 128 + kh * 64; vp = VV + (size_t)(b * SEQ + jj) * 128 + kh * 64; }
        else { const int c = jj - j1 - 1; kp = KC + (size_t)(b * CTXL + c) * 128 + kh * 64; vp = VC + (size_t)(b * CTXL + c) * 128 + kh * 64; }
        float s = 0.f; for (int d = 0; d < 64; ++d) s += q[d] * bf2f(kp[d]);
        const float mn = fmaxf(m, s), al = exp2f(m - mn), p = exp2f(s - mn); m = mn; l = l * al + p;
        for (int d = 0; d < 64; ++d) o[d] = o[d] * al + p * bf2f(vp[d]);
    }
    for (int d = 0; d < 64; ++d) MIX[(size_t)row * D + 512 + h * 64 + d] = f2bf_s(o[d] / l);
}
__global__ void slow_vstats(const bf16* VB, float* stat) {
    const int row = blockIdx.x * blockDim.x + threadIdx.x; if (row >= NTOK) return;
    float s = 0.f; for (int c = 0; c < D; ++c) s += bf2f(VB[(size_t)row * D + c]); const float mean = s / D;
    float s2 = 0.f; for (int c = 0; c < D; ++c) { const float d = bf2f(VB[(size_t)row * D + c]) - mean; s2 += d * d; }
    stat[2 * row] = mean; stat[2 * row + 1] = rsqrtf(s2 / D + EPS);
}
__global__ void slow_spatial(const bf16* U, const bf16* VB, const float* stat, const float* ws, const float* bs, const float* lng, const float* lnb, bf16* SG) {
    const size_t i = (size_t)blockIdx.x * blockDim.x + threadIdx.x;
    if (i < (size_t)NTOK * D) { const int row = (int)(i >> 10), ch = (int)(i & 1023); const int g = ch >> 7, p = row & 127, r0 = row - p;
        float s = 0.f;
        for (int q = 0; q < 128; ++q) { const float vn = (bf2f(VB[(size_t)(r0 + q) * D + ch]) - stat[2 * (r0 + q)]) * stat[2 * (r0 + q) + 1] * lng[ch] + lnb[ch]; s += ws[((size_t)g * 128 + p) * 128 + q] * vn; }
        SG[i] = f2bf_s(bf2f(U[i]) * (s + bs[g * 128 + p])); }
}

static void launch_mega(Args& a, int lo, int hi, int& li, int grid, hipStream_t stream) {
    a.ph_lo = lo; a.ph_hi = hi; a.li = li++;
    hipLaunchKernelGGL(mega, dim3(grid), dim3(NTHREADS), LDS_BYTES, stream, a);
}
extern "C" void kernel_launch(void* const* d_in, const int* in_sizes, int n_in, void* d_out, int out_size, void* d_ws, size_t ws_size, hipStream_t stream) {
    static int grid = 0;
    if (grid == 0) {
        if (n_in != 33 || out_size != NTOK * D || ws_size < WS_END) { fprintf(stderr, "kernel_launch: unexpected problem (n_in %d, out %d, ws %zu)\n", n_in, out_size, ws_size); grid = -1; return; }
        int dev = 0, cus = 0, per_cu = 0;
        if (hipGetDevice(&dev) != hipSuccess || hipDeviceGetAttribute(&cus, hipDeviceAttributeMultiprocessorCount, dev) != hipSuccess) { grid = -1; return; }
        if (hipFuncSetAttribute((const void*)mega, hipFuncAttributeMaxDynamicSharedMemorySize, LDS_BYTES) != hipSuccess) { fprintf(stderr, "kernel_launch: hipFuncSetAttribute failed\n"); grid = -1; return; }
        if (hipOccupancyMaxActiveBlocksPerMultiprocessor(&per_cu, (const void*)mega, NTHREADS, LDS_BYTES) != hipSuccess || per_cu < 1) { fprintf(stderr, "kernel_launch: occupancy query says %d blocks per CU\n", per_cu); per_cu = 1; }
        (void)hipGetLastError();
        grid = cus;
    }
    if (grid < 0) return;
    unsigned char* ws = (unsigned char*)d_ws;
    (void)hipMemsetAsync(ws + WS_CTL, 0, CTL_ZERO_BYTES, stream);
    Args a{};
    for (int i = 0; i < 33; ++i) a.in[i] = (const float*)d_in[i];
    a.out = (float*)d_out; a.ws = ws;
    int li = 0;
    const float* in_[33]; for (int i = 0; i < 33; ++i) in_[i] = (const float*)d_in[i];
    float* CF = (float*)(ws + WS_CF); float* MOD = (float*)(ws + WS_MOD); int* CNT = (int*)(ws + WS_CTL) + CW_CNT;
    int lo = 0;
    auto flush = [&](int upto) { if (upto > lo) launch_mega(a, lo, upto, li, grid, stream); };
    for (int ph = 0; ph < NPHASE; ++ph) {
        bool slow = false;
        switch (ph) {
        case PH_GIN: slow = SLOW_MASK & 1; break;
        case PH_ATT: slow = SLOW_MASK & 2; break;
        case PH_GOUT: case PH_GMO: slow = SLOW_MASK & 4; break;
        case PH_M1_0: case PH_M1_1: slow = SLOW_MASK & 8; break;
        case PH_M2_0: case PH_M2_1: slow = SLOW_MASK & 16; break;
        case PH_GMI: slow = SLOW_MASK & 32; break;
        case PH_SPA: slow = SLOW_MASK & 64; break;
        default: break;
        }
        if (!slow) continue;
        flush(ph); lo = ph + 1;
        const int l = (ph == PH_M1_1 || ph == PH_M2_1) ? 1 : 0;
        switch (ph) {
        case PH_GIN:
            hipLaunchKernelGGL(slow_gemm, dim3(EVEN_IN / 64, NTOK / 64), dim3(256), 0, stream, (const bf16*)(ws + WS_XA), (const int*)nullptr, (const bf16*)(ws + WS_WINT), CF, EVEN_IN, (const int*)nullptr, (size_t)0);
            hipLaunchKernelGGL(slow_gemm, dim3(256 / 64, NCTX / 64), dim3(256), 0, stream, (const bf16*)(ws + WS_GM), (const int*)nullptr, (const bf16*)(ws + WS_WINT) + (size_t)KV_COL * D, CF + (size_t)NTOK * EVEN_IN, 256, (const int*)nullptr, (size_t)0);
            hipLaunchKernelGGL(slow_epi_in, dim3(NTOK * 512 / 256), dim3(256), 0, stream, (const float*)CF, (const float*)(CF + (size_t)NTOK * EVEN_IN), in_[I_EBIN], (bf16*)(ws + WS_GLU), (bf16*)(ws + WS_Q), (bf16*)(ws + WS_K), (bf16*)(ws + WS_V), (bf16*)(ws + WS_KC), (bf16*)(ws + WS_VC));
            break;
        case PH_ATT:
            hipLaunchKernelGGL(slow_attention, dim3(NTOK * 8 / 64), dim3(64), 0, stream, (const bf16*)(ws + WS_Q), (const bf16*)(ws + WS_K), (const bf16*)(ws + WS_V), (const bf16*)(ws + WS_KC), (const bf16*)(ws + WS_VC), in_[I_SINK], (bf16*)(ws + WS_MIX));
            break;
        case PH_GOUT:
            hipLaunchKernelGGL(slow_gemm, dim3(D / 64, NTOK / 64), dim3(256), 0, stream, (const bf16*)(ws + WS_MIX), (const int*)nullptr, (const bf16*)(ws + WS_WOUTT), CF, D, (const int*)nullptr, (size_t)0);
            hipLaunchKernelGGL(slow_epi_res, dim3(NTOK * D / 256), dim3(256), 0, stream, (const float*)CF, in_[I_X], (float*)(ws + WS_H), in_[I_EBOUT], (const float*)(MOD + 2 * 1024));
            break;
        case PH_GMO:
            hipLaunchKernelGGL(slow_gemm, dim3(D / 64, NTOK / 64), dim3(256), 0, stream, (const bf16*)(ws + WS_MIX), (const int*)nullptr, (const bf16*)(ws + WS_GWOUTT), CF, D, (const int*)nullptr, (size_t)0);
            hipLaunchKernelGGL(slow_epi_res, dim3(NTOK * D / 256), dim3(256), 0, stream, (const float*)CF, (const float*)(ws + WS_H), (float*)(ws + WS_H), in_[I_OBOUT], (const float*)(MOD + (size_t)9 * MODW + 2 * 1024));
            break;
        case PH_M1_0: case PH_M1_1:
            hipLaunchKernelGGL(slow_arow, dim3(ACT_ROWS / 256), dim3(256), 0, stream, (const int*)(CNT + l * NE * CNT_STRIDE), (const int*)(ws + WS_LIST), (int*)(ws + WS_AROW));
            hipLaunchKernelGGL(slow_gemm, dim3(2048 / 64, ACT_ROWS / 64), dim3(256), 0, stream, (const bf16*)(ws + WS_XA), (const int*)(ws + WS_AROW), (const bf16*)(ws + WS_W1T) + (size_t)l * NE * 2048 * 1024, CF, 2048, (const int*)(CNT + l * NE * CNT_STRIDE), (size_t)2048 * 1024);
            hipLaunchKernelGGL(slow_epi_swiglu, dim3(ACT_ROWS * 1024 / 256), dim3(256), 0, stream, (const float*)CF, (const int*)(CNT + l * NE * CNT_STRIDE), in_[I_B1] + (size_t)l * NE * 2048, (bf16*)(ws + WS_ACT));
            break;
        case PH_M2_0: case PH_M2_1:
            hipLaunchKernelGGL(slow_gemm, dim3(1024 / 64, ACT_ROWS / 64), dim3(256), 0, stream, (const bf16*)(ws + WS_ACT), (const int*)nullptr, (const bf16*)(ws + WS_W2T) + (size_t)l * NE * 1024 * 1024, CF, 1024, (const int*)(CNT + l * NE * CNT_STRIDE), (size_t)1024 * 1024);
            hipLaunchKernelGGL(slow_epi_down, dim3(ACT_ROWS * 1024 / 256), dim3(256), 0, stream, (const float*)CF, (const int*)(CNT + l * NE * CNT_STRIDE), (const int*)(ws + WS_LIST), (const float*)(ws + WS_GATE), in_[I_B2] + (size_t)l * NE * D, (bf16*)(ws + WS_Y));
            break;
        case PH_GMI:
            hipLaunchKernelGGL(slow_gemm, dim3(2048 / 64, NTOK / 64), dim3(256), 0, stream, (const bf16*)(ws + WS_XA), (const int*)nullptr, (const bf16*)(ws + WS_GWINT), CF, 2048, (const int*)nullptr, (size_t)0);
            hipLaunchKernelGGL(slow_epi_gelu, dim3(NTOK * 2048 / 256), dim3(256), 0, stream, (const float*)CF, in_[I_OBIN], (bf16*)(ws + WS_U), (bf16*)(ws + WS_VB));
            break;
        case PH_SPA:
            hipLaunchKernelGGL(slow_vstats, dim3(NTOK / 64), dim3(64), 0, stream, (const bf16*)(ws + WS_VB), CF);
            hipLaunchKernelGGL(slow_spatial, dim3(NTOK * D / 256), dim3(256), 0, stream, (const bf16*)(ws + WS_U), (const bf16*)(ws + WS_VB), (const float*)CF, in_[I_OWS], in_[I_OBS], in_[I_OLNG], in_[I_OLNB], (bf16*)(ws + WS_MIX));
            break;
        default: break;
        }
    }
    flush(NPHASE);
}
```

```cpp
#include <hip/hip_runtime.h>
#include <cstdio>
#include <cstdint>

#ifndef SLOW_MASK
#define SLOW_MASK 0x00
#endif

#ifndef EXP_STREAM
#define EXP_STREAM 0
#endif
#ifndef PROBE_PH
#define PROBE_PH (-1)
#endif
#ifndef PROBE_END
#define PROBE_END (PROBE_PH + 1)
#endif
#ifndef PROBE_A
#define PROBE_A (-1)
#define PROBE_B (-1)
#endif
#ifndef PROBE_MULT
#define PROBE_MULT 4
#endif

#define LAS __attribute__((address_space(3)))
typedef unsigned short bf16;
typedef short bf16x8 __attribute__((ext_vector_type(8)));
typedef float f32x4 __attribute__((ext_vector_type(4)));
typedef float f32x2 __attribute__((ext_vector_type(2)));
typedef unsigned u32x4 __attribute__((ext_vector_type(4)));
typedef unsigned u32x2 __attribute__((ext_vector_type(2)));
typedef __bf16 bf16x2_t __attribute__((ext_vector_type(2)));

constexpr int NB = 8, SEQ = 2048, D = 1024, NTOK = NB * SEQ, CTXL = 256, NCTX = NB * CTXL;
constexpr int NE = 32, TOPK = 4, NASSIGN = NTOK * TOPK, ACT_ROWS = NASSIGN + NE * 256;
constexpr int EVEN_IN = 1792, KV_COL = 1536;
constexpr float EPS = 1e-6f, LOG2E = 1.4426950408889634f;
constexpr float QSCALE = 0.125f * LOG2E;
constexpr int MODW = 6 * D;
constexpr int NWAVES = 8, NTHREADS = 512;

constexpr size_t MiB = 1u << 20;
constexpr size_t WS_CTL = 0, CTL_ZERO_BYTES = 1 * MiB;
constexpr size_t WS_MOD = 1 * MiB;
constexpr size_t WS_LIST = 2 * MiB;
constexpr size_t WS_GATE = 4 * MiB;
constexpr size_t WS_WSB = 5 * MiB;
constexpr size_t WS_WINT = 6 * MiB;
constexpr size_t WS_WOUTT = 10 * MiB;
constexpr size_t WS_GWINT = 12 * MiB;
constexpr size_t WS_GWOUTT = 16 * MiB;
constexpr size_t WS_KC = 18 * MiB;
constexpr size_t WS_VC = 18 * MiB + 512 * 1024;
constexpr size_t WS_K = 19 * MiB;
constexpr size_t WS_V = 23 * MiB;
constexpr size_t WS_GM = 27 * MiB;
constexpr size_t WS_AROW = 31 * MiB;
constexpr size_t WS_Q = 32 * MiB;
constexpr size_t WS_GLU = 48 * MiB;
constexpr size_t WS_XA = 64 * MiB;
constexpr size_t WS_MIX = 96 * MiB;
constexpr size_t WS_H = 128 * MiB;
constexpr size_t WS_U = 192 * MiB;
constexpr size_t WS_VB = 224 * MiB;
constexpr size_t WS_W1T = 256 * MiB;
constexpr size_t WS_W2T = 512 * MiB;
constexpr size_t WS_ACT = 640 * MiB;
constexpr size_t WS_Y = 784 * MiB;
constexpr size_t WS_XA8 = 912 * MiB;
constexpr size_t WS_CF = 928 * MiB;
constexpr size_t WS_END = 1504 * MiB;
constexpr int CW_BAR = 4096, CW_CNT = 131072, CNT_STRIDE = 64  , CW_VSTAT = 147456;
constexpr int MAX_LAUNCH = 20;

constexpr int RING_BYTES = 131072;
constexpr int MISC_OFF = RING_BYTES;
constexpr int TAB_OFF = RING_BYTES + 256;
constexpr int META_OFF = RING_BYTES + 3072;
constexpr int LDS_BYTES = 147456;

#define LDS_WAIT() asm volatile("s_waitcnt lgkmcnt(0)" ::: "memory")
#define VM_WAIT() asm volatile("s_waitcnt vmcnt(0)" ::: "memory")

__device__ __forceinline__ float bf2f(unsigned b) { return __uint_as_float(b << 16); }
__device__ __forceinline__ unsigned pk2(float lo, float hi) { f32x2 v = {lo, hi}; bf16x2_t b = __builtin_convertvector(v, bf16x2_t); return __builtin_bit_cast(unsigned, b); }
template <int CTRL, int ROW_MASK> __device__ __forceinline__ float dpp_f(float old, float src) { return __builtin_bit_cast(float, __builtin_amdgcn_update_dpp(__builtin_bit_cast(int, old), __builtin_bit_cast(int, src), CTRL, ROW_MASK, 0xf, false)); }
__device__ __forceinline__ unsigned pk4_fp8(float a, float b, float c, float d) { int w = 0; w = __builtin_amdgcn_cvt_pk_fp8_f32(a, b, w, false); w = __builtin_amdgcn_cvt_pk_fp8_f32(c, d, w, true); return (unsigned)w; }
__device__ __forceinline__ float wave_sum(float v) {
    v += dpp_f<0xB1, 0xf>(0.f, v);
    v += dpp_f<0x4E, 0xf>(0.f, v);
    v += dpp_f<0x141, 0xf>(0.f, v);
    v += dpp_f<0x140, 0xf>(0.f, v);
    v += dpp_f<0x142, 0xa>(0.f, v);
    v += dpp_f<0x143, 0xc>(0.f, v);
    return __builtin_bit_cast(float, __builtin_amdgcn_readlane(__builtin_bit_cast(int, v), 63));
}
__device__ __forceinline__ float dpp_swap32(float v) { return __shfl_xor(v, 32); }
__device__ __forceinline__ float sigmoidf_(float x) { return __builtin_amdgcn_rcpf(1.0f + __builtin_amdgcn_exp2f(-x * LOG2E)); }

#define XB_TMO      128
#define XB_XCNT(j)  (256  + 64 * (j))
#define XB_XSUB(j)  (1280 + 64 * (j))
#define XB_XGEN(j)  (2304 + 64 * (j))
#define XB_TOP      3328
#define XB_TOPGEN   3392
#define XCD_BAR_WORDS 3456
#define XB_SPIN_CAP (1u << 20)
__device__ __forceinline__ unsigned xb_ld(unsigned* p)              { return __hip_atomic_load(p, __ATOMIC_RELAXED, __HIP_MEMORY_SCOPE_AGENT); }
__device__ __forceinline__ unsigned xb_add(unsigned* p, unsigned v) { return __hip_atomic_fetch_add(p, v, __ATOMIC_RELAXED, __HIP_MEMORY_SCOPE_AGENT); }
__device__ __forceinline__ unsigned xb_xcc_id() { return (unsigned)__builtin_amdgcn_s_getreg((3 << 11) | 20) & 0xFu; }
#define XB_SPIN(cond, bar) do { unsigned _sp = 0; while (cond) { __builtin_amdgcn_s_sleep(1); \
    if ((++_sp & 255u) == 0u) { if (xb_ld(&(bar)[XB_TMO])) break; if (_sp > XB_SPIN_CAP) { atomicAdd(&(bar)[XB_TMO], 1u); break; } } } } while (0)
struct XcdBarrier { unsigned* bar; unsigned x; volatile LAS unsigned* st; };
__device__ __forceinline__ XcdBarrier xcd_barrier_post(unsigned* bar, volatile LAS unsigned* st) {
    XcdBarrier b; b.bar = bar; b.x = xb_xcc_id(); b.st = st;
    if (threadIdx.x == 0) (void)xb_add(&bar[XB_XCNT(b.x)], 1u);
    return b;
}
__device__ __forceinline__ void xcd_barrier_complete(unsigned* bar, unsigned x, unsigned& nloc, unsigned& nx) {
    const unsigned G = gridDim.x * gridDim.y * gridDim.z;
    unsigned sum, cnt, mine, sp = 0u;
    for (;;) {
        sum = 0u; cnt = 0u; mine = 0u;
#pragma unroll
        for (unsigned j = 0; j < 16; ++j) { const unsigned c = xb_ld(&bar[XB_XCNT(j)]); sum += c; cnt += (c > 0u) ? 1u : 0u; mine = (j == x) ? c : mine; }
        if (sum == G) break;
        __builtin_amdgcn_s_sleep(1);
        if ((++sp & 255u) == 0u) { if (xb_ld(&bar[XB_TMO])) break; if (sp > XB_SPIN_CAP) { atomicAdd(&bar[XB_TMO], 1u); break; } }
    }
    nloc = mine > 0u ? mine : 1u; nx = cnt > 0u ? cnt : 1u;
}
__device__ __forceinline__ void xcd_barrier(const XcdBarrier& b, const int tid) {
    asm volatile("s_waitcnt vmcnt(0)" ::: "memory");
    __syncthreads();
    if (tid == 0) {
        unsigned* bar = b.bar;
        __builtin_amdgcn_s_waitcnt(0);
        unsigned nloc = b.st[0], nx = b.st[1];
        if (nloc == 0u) { xcd_barrier_complete(bar, b.x, nloc, nx); b.st[0] = nloc; b.st[1] = nx; }
        const unsigned old = xb_add(&bar[XB_XSUB(b.x)], 1u);
        const unsigned gen = old / nloc;
        if (old + 1u == (gen + 1u) * nloc) {
            __builtin_amdgcn_fence(__ATOMIC_RELEASE, "agent");
            asm volatile("s_waitcnt vmcnt(0)" ::: "memory");
            const unsigned og = xb_add(&bar[XB_TOP], 1u);
            const unsigned tg = og / nx;
            if (og + 1u == (tg + 1u) * nx) xb_add(&bar[XB_TOPGEN], 1u);
            else XB_SPIN(xb_ld(&bar[XB_TOPGEN]) == tg, bar);
            __builtin_amdgcn_fence(__ATOMIC_ACQUIRE, "agent");
            xb_add(&bar[XB_XGEN(b.x)], 1u);
            asm volatile("s_waitcnt vmcnt(0)" ::: "memory");
        } else {
            XB_SPIN(xb_ld(&bar[XB_XGEN(b.x)]) == gen, bar);
            __builtin_amdgcn_fence(__ATOMIC_ACQUIRE, "agent");
            asm volatile("s_waitcnt vmcnt(0)" ::: "memory");
        }
    }
    __syncthreads();
}

constexpr float FP8_WMUL = 32.0f, FP8_AMUL = 4.0f, FP8_DESCALE = 1.0f / (32.0f * 4.0f);
namespace pg8 {
constexpr int BM = 256, BK = 64, HALF = 128, HTB = HALF * BK * 2, STAGE_BYTES = 8 * HTB, KD = 1024  ;
__host__ __device__ __forceinline__ int lds_byte(int r, int c) { const int st = (r >> 4) * 2 + (c >> 5), rr = r & 15, cc = c & 31, ob = rr * 64 + cc * 2; return st * 1024 + (ob ^ (((ob >> 9) & 1) << 5)); }
__host__ __device__ __forceinline__ void stage_rc(int b, int& R, int& C) { const int st = b / 1024, sb = b % 1024, swz = sb ^ (((sb >> 9) & 1) << 5); R = (st >> 1) * 16 + swz / 64; C = (st & 1) * 32 + (swz % 64) / 2; }
__host__ __device__ __forceinline__ int perm32(int rho) { const int n = rho >> 4, i = rho & 15; return 8 * (i >> 2) + 4 * n + (i & 3); }

typedef int v8i_t __attribute__((ext_vector_type(8)));
__device__ __forceinline__ v8i_t cat8(bf16x8 a, bf16x8 b) { typedef int v4i_t __attribute__((ext_vector_type(4))); const v4i_t x = __builtin_bit_cast(v4i_t, a), y = __builtin_bit_cast(v4i_t, b); return __builtin_shufflevector(x, y, 0, 1, 2, 3, 4, 5, 6, 7); }
struct Unit { int pm, pn, e, cnt, idx; };

template <class Epi, class Sched>
__device__ __forceinline__ void gemm_phase(LAS unsigned char* lds, const Sched& S, const Epi& E, const int tid) {
    const int wid = __builtin_amdgcn_readfirstlane(tid >> 6), lane = tid & 63, wr = wid >> 2, wc = wid & 3, fr = lane & 15, fq = lane >> 4;
    constexpr int RP = Sched::FP8 ? 1024 : 2048  , nt = RP / 128;
    int Rr[2], Cc[2];
    unsigned voffA[2][2], voffB[2];
#pragma unroll
    for (int i = 0; i < 2; ++i) { stage_rc(tid * 16 + i * 8192, Rr[i], Cc[i]); const int Rb = Epi::PERM ? ((Rr[i] & ~31) + perm32(Rr[i] & 31)) : Rr[i];
        voffB[i] = (unsigned)(Rb * RP + Cc[i] * 2); }
    constexpr size_t kstep = (size_t)(BK * 2);
    constexpr size_t hstep = (size_t)HALF * RP;
    const unsigned ldsw = (unsigned)wid * 1024u;
    const int aoff = lds_byte(wr * 64 + fr, fq * 8), boff = lds_byte(wc * 32 + fr, fq * 8);
#define PG8_SA(b, h) (((b) * 2 + (h)) * HTB)
#define PG8_SB(b, h) ((4 + (b) * 2 + (h)) * HTB)
#define PG8_STAGE(bufoff, gbase, voff) do { _Pragma("unroll") for (int _i = 0; _i < 2; ++_i) \
        __builtin_amdgcn_global_load_lds((const unsigned*)((const char*)(gbase) + (voff)[_i]), (LAS unsigned*)(lds + (bufoff) + ldsw + _i * 8192), 16, 0, 0); } while (0)
#define PG8_STAGEA1(bufoff, gbase) do { if constexpr (Sched::GATHER) { PG8_STAGE(bufoff, gbase, voffA[1]); } else { PG8_STAGE(bufoff, (gbase) + hstep, voffA[0]); } } while (0)
#define PG8_LDA(dst, b, h) do { _Pragma("unroll") for (int m = 0; m < 4; ++m) _Pragma("unroll") for (int k = 0; k < 2; ++k) dst[m][k] = *(const LAS bf16x8*)(lds + PG8_SA(b, h) + aoff + m * 2048 + k * 1024); } while (0)
#define PG8_LDB(dst, b, h) do { _Pragma("unroll") for (int n = 0; n < 2; ++n) _Pragma("unroll") for (int k = 0; k < 2; ++k) dst[n][k] = *(const LAS bf16x8*)(lds + PG8_SB(b, h) + boff + n * 2048 + k * 1024); } while (0)
#define PG8_MMA(ai, bj, At, Bt) do { __builtin_amdgcn_s_setprio(1); _Pragma("unroll") for (int m = 0; m < 4; ++m) _Pragma("unroll") for (int n = 0; n < 2; ++n) { \
        if constexpr (Sched::FP8) { acc[ai][bj][m][n] = __builtin_amdgcn_mfma_scale_f32_16x16x128_f8f6f4(cat8(Bt[n][0], Bt[n][1]), cat8(At[m][0], At[m][1]), acc[ai][bj][m][n], 0, 0, 0, 0, 0, 0); } \
        else { _Pragma("unroll") for (int k = 0; k < 2; ++k) acc[ai][bj][m][n] = __builtin_amdgcn_mfma_f32_16x16x32_bf16(Bt[n][k], At[m][k], acc[ai][bj][m][n], 0, 0, 0); } } \
        __builtin_amdgcn_s_setprio(0); } while (0)
#define PG8_WAIT_V(n) asm volatile("s_waitcnt vmcnt(" #n ")" ::: "memory")
#define PG8_WAIT_L(n) asm volatile("s_waitcnt lgkmcnt(" #n ")" ::: "memory")
#define PG8_BAR __builtin_amdgcn_s_barrier()
#define PG8_SCHED __builtin_amdgcn_sched_barrier(0)
    Unit cur, nxt; int ui = 0;
    if (!S.next(0, cur)) return;
    S.a_voff(cur, voffA, Rr, Cc);
    f32x4 acc[2][2][4][2];
#pragma unroll
    for (int a = 0; a < 2; ++a)
#pragma unroll
        for (int b = 0; b < 2; ++b)
#pragma unroll
            for (int m = 0; m < 4; ++m)
#pragma unroll
                for (int n = 0; n < 2; ++n) acc[a][b][m][n] = (f32x4){0.f, 0.f, 0.f, 0.f};
    bf16x8 At[4][2], B0[2][2], B1[2][2];
    const char* cA = S.a_ptr(cur); const char* cB = S.b_ptr(cur);
    PG8_STAGE(PG8_SB(0, 0), cB, voffB); PG8_STAGE(PG8_SB(0, 1), cB + hstep, voffB); PG8_STAGE(PG8_SA(0, 0), cA, voffA[0]); PG8_STAGEA1(PG8_SA(0, 1), cA);
    if (wr == 1) PG8_BAR;
    PG8_WAIT_V(2); PG8_BAR;
    PG8_STAGE(PG8_SB(1, 0), cB + kstep, voffB); PG8_STAGE(PG8_SA(1, 0), cA + kstep, voffA[0]); PG8_STAGE(PG8_SB(1, 1), cB + hstep + kstep, voffB);
    PG8_WAIT_V(6); PG8_BAR;
    for (;;) {
        const bool has_next = S.next(ui + 1, nxt);
        const char* nA = has_next ? S.a_ptr(nxt) : cA; const char* nB = has_next ? S.b_ptr(nxt) : cB;
#pragma unroll 1
        for (int t = 0; t < nt; t += 2) {
            const bool last = (t == nt - 2);
            const char* a1 = cA + (size_t)(t + 1) * kstep;
            const char* a2 = last ? nA : cA + (size_t)(t + 2) * kstep; const char* b2 = last ? nB : cB + (size_t)(t + 2) * kstep;
            const char* a3 = a2 + kstep; const char* b3 = b2 + kstep;
            asm volatile("" : "+s"(a1), "+s"(a2), "+s"(a3), "+s"(b2), "+s"(b3));
            PG8_LDB(B0, 0, 0); PG8_LDB(B1, 0, 1); PG8_SCHED; PG8_LDA(At, 0, 0); PG8_STAGEA1(PG8_SA(1, 1), a1);
            if (Sched::GATHER) { if (last && has_next) S.a_voff(nxt, voffA, Rr, Cc); }
            PG8_WAIT_V(8); PG8_WAIT_L(0); PG8_BAR; PG8_MMA(0, 0, At, B0); PG8_MMA(0, 1, At, B1); PG8_BAR; PG8_SCHED;
            PG8_LDA(At, 0, 1); PG8_STAGE(PG8_SB(0, 0), b2, voffB); PG8_STAGE(PG8_SB(0, 1), b2 + hstep, voffB); PG8_STAGE(PG8_SA(0, 0), a2, voffA[0]);
            PG8_WAIT_V(8); PG8_WAIT_L(0); PG8_BAR; PG8_MMA(1, 0, At, B0); PG8_MMA(1, 1, At, B1); PG8_BAR; PG8_SCHED;
            PG8_LDB(B0, 1, 0); PG8_LDB(B1, 1, 1); PG8_SCHED; PG8_LDA(At, 1, 0); PG8_STAGEA1(PG8_SA(0, 1), a2);
            PG8_WAIT_V(8); PG8_WAIT_L(0); PG8_BAR; PG8_MMA(0, 0, At, B0); PG8_MMA(0, 1, At, B1); PG8_BAR; PG8_SCHED;
            PG8_LDA(At, 1, 1); PG8_STAGE(PG8_SB(1, 0), b3, voffB); PG8_STAGE(PG8_SB(1, 1), b3 + hstep, voffB); PG8_STAGE(PG8_SA(1, 0), a3, voffA[0]);
            PG8_WAIT_V(8); PG8_WAIT_L(0); PG8_BAR; PG8_MMA(1, 0, At, B0); PG8_MMA(1, 1, At, B1); PG8_BAR; PG8_SCHED;
        }
        if (wr == 0) PG8_BAR;
        E(acc, cur, wr, wc, fr, fq);
        if (!has_next) break;
#pragma unroll
        for (int a = 0; a < 2; ++a)
#pragma unroll
            for (int b = 0; b < 2; ++b)
#pragma unroll
                for (int m = 0; m < 4; ++m)
#pragma unroll
                    for (int n = 0; n < 2; ++n) acc[a][b][m][n] = (f32x4){0.f, 0.f, 0.f, 0.f};
        cur = nxt; cA = nA; cB = nB; ++ui;
        if (wr == 1) PG8_BAR;
    }
    PG8_WAIT_V(0);
    PG8_BAR;
#undef PG8_SA
#undef PG8_SB
#undef PG8_STAGE
#undef PG8_STAGEA1
#undef PG8_LDA
#undef PG8_LDB
#undef PG8_MMA
#undef PG8_WAIT_V
#undef PG8_WAIT_L
#undef PG8_BAR
#undef PG8_SCHED
}
}

struct Args { const float* in[33]; float* out; unsigned char* ws; int ph_lo, ph_hi, li, pad; };
enum { I_X = 0, I_C, I_CTX, I_CCTX, I_ADAW, I_ADAB, I_NMG, I_NFG, I_EWIN, I_EBIN, I_ECW, I_ECB, I_ELNG, I_ELNB, I_QNG, I_KNG, I_SINK, I_EWOUT, I_EBOUT,
       I_OWIN, I_OBIN, I_OLNG, I_OLNB, I_OWS, I_OBS, I_OWOUT, I_OBOUT, I_RW, I_RB, I_W1, I_B1, I_W2, I_B2 };

typedef const __attribute__((address_space(4))) unsigned long long* kargp_t;
struct Ctx {
    LAS unsigned char* lds; int tid, lane, wave, G, vcu, gw, NGW, bid; unsigned char* ws; kargp_t kp;
};
__device__ __forceinline__ const float* in_ptr(const Ctx& X, int i) { return (const float*)(const __attribute__((address_space(1))) float*)X.kp[i]; }
#define IN(i) in_ptr(X, (i))
#if PROBE_PH == -2
#define PMARK(k) do { if (X.bid == 0 && X.tid == 0) { volatile LAS unsigned long long* pm_ = (volatile LAS unsigned long long*)(X.lds + MISC_OFF + 128); \
    if ((k) == PROBE_A) pm_[0] = __builtin_amdgcn_s_memrealtime(); if ((k) == PROBE_B) pm_[1] = __builtin_amdgcn_s_memrealtime(); } } while (0)
#else
#define PMARK(k) do { } while (0)
#endif

struct DenseSched {
    static constexpr bool GATHER = false, FP8 = false;
    const bf16* A; const bf16* Bt; int nM, nN, nwg, G, c;
    const bf16* A2; const bf16* Bt2; int nM2;
    __device__ __forceinline__ void init(const bf16* A_, const bf16* Bt_, int M, int N, int G_, int c_) { A = A_; Bt = Bt_; nM = M / 256; nN = N / 256; nwg = nM * nN; G = G_; c = c_; A2 = nullptr; Bt2 = nullptr; nM2 = 0; }
    __device__ __forceinline__ bool next(int i, pg8::Unit& u) const {
        const int L = i * G + c; if (L >= nwg + nM2) return false; u.idx = i;
        if (L >= nwg) { u.pm = L - nwg; u.pn = 0; u.e = 1; u.cnt = 256; return true; }
        int wgid = L; { const int q = nwg / 8, r = nwg % 8, xcd = wgid % 8, off = wgid / 8; wgid = (xcd < r ? xcd * (q + 1) : r * (q + 1) + (xcd - r) * q) + off; }
        const int nig = 8 * nN, gid = wgid / nig, fm = gid * 8, gsz = (nM - fm) < 8 ? (nM - fm) : 8;
        u.pm = fm + ((wgid % nig) % gsz); u.pn = (wgid % nig) / gsz; u.e = 0; u.cnt = 256; return true;
    }
    __device__ __forceinline__ const char* a_ptr(const pg8::Unit& u) const { return (const char*)(u.e ? A2 : A) + (size_t)u.pm * 256 * pg8::KD * 2; }
    __device__ __forceinline__ const char* b_ptr(const pg8::Unit& u) const { return (const char*)(u.e ? Bt2 : Bt) + (size_t)u.pn * 256 * pg8::KD * 2; }
    __device__ __forceinline__ void a_voff(const pg8::Unit&, unsigned (&v)[2][2], const int (&R)[2], const int (&C)[2]) const {
#pragma unroll
        for (int i = 0; i < 2; ++i) { v[0][i] = (unsigned)(R[i] * pg8::KD + C[i]) * 2u; v[1][i] = v[0][i] + (unsigned)(pg8::HALF * pg8::KD * 2); }
    }
};
template <bool GATHER_, int NTILE_N>
struct MoeSchedT {
    static constexpr bool GATHER = GATHER_, FP8 = true; static constexpr int RP = 1024;
    const LAS int* tab; int G, c;
    const unsigned char* A;
    const unsigned char* Bt;
    const int* list;
    const LAS int* meta;
    __device__ __forceinline__ bool next(int i, pg8::Unit& u) const {
        const int L = i * G + c; const int T = tab[0];
        if (L >= T * NTILE_N) return false;
        u.idx = i;
        const int mt = L / NTILE_N; u.pn = L % NTILE_N;
        const int w = __builtin_amdgcn_readfirstlane(tab[1 + mt]); u.e = w >> 16; const int tl = w & 0xffff;
        const int cnt = __builtin_amdgcn_readfirstlane(tab[512 + u.e]), pb = __builtin_amdgcn_readfirstlane(tab[544 + u.e]);
        u.pm = pb + tl * 256; u.cnt = cnt - tl * 256;
        return true;
    }
    __device__ __forceinline__ const char* a_ptr(const pg8::Unit& u) const { return GATHER ? (const char*)A : (const char*)A + (size_t)u.pm * RP; }
    __device__ __forceinline__ const char* b_ptr(const pg8::Unit& u) const { return (const char*)Bt + ((size_t)u.e * NTILE_N + u.pn) * 256 * RP; }
    __device__ __forceinline__ void a_voff(const pg8::Unit& u, unsigned (&v)[2][2], const int (&R)[2], const int (&C)[2]) const {
        if (GATHER) {
#pragma unroll
            for (int h = 0; h < 2; ++h)
#pragma unroll
                for (int i = 0; i < 2; ++i) { const int tok = meta[u.idx * 256 + h * 128 + R[i]]; v[h][i] = (unsigned)(tok * RP + C[i] * 2); }
        } else {
#pragma unroll
            for (int i = 0; i < 2; ++i) { v[0][i] = (unsigned)(R[i] * RP + C[i] * 2); v[1][i] = v[0][i] + (unsigned)(pg8::HALF * RP); }
        }
    }
};
__device__ __forceinline__ void moe_build_table(const Ctx& X, const int* cnt  ) {
    LAS int* tab = (LAS int*)(X.lds + TAB_OFF);
    __syncthreads();
    if (X.tid == 0) {
        int T = 0, pb = 0;
        for (int e = 0; e < NE; ++e) { const int c = __hip_atomic_load(cnt + e * CNT_STRIDE, __ATOMIC_RELAXED, __HIP_MEMORY_SCOPE_AGENT); const int mt = (c + 255) >> 8;
            tab[512 + e] = c; tab[544 + e] = pb; for (int t = 0; t < mt; ++t) tab[1 + T + t] = (e << 16) | t; T += mt; pb += mt * 256; }
        tab[0] = T;
    }
    __syncthreads();
}

template <bool WITH_GATE, class Sched>
__device__ __forceinline__ void moe_stage_meta(const Ctx& X, const Sched& S, const int* list, const float* gatew, LAS int* meta) {
    if (X.tid < 256) { pg8::Unit u;
        for (int i = 0; S.next(i, u); ++i) { const int slot0 = u.pm - S.tab[544 + u.e]; const int r = X.tid < u.cnt ? X.tid : u.cnt - 1;
            const int aid = list[(size_t)u.e * NTOK + slot0 + r];
            if (WITH_GATE) { const float g = gatew[aid]; *(LAS u32x2*)(meta + (i * 256 + X.tid) * 2) = (u32x2){(unsigned)aid, __float_as_uint(g)}; }
            else meta[i * 256 + X.tid] = aid >> 2; } }
    __syncthreads();
}

__device__ __forceinline__ f32x2 gelu_pk(f32x2 v) {
    const f32x2 av = __builtin_elementwise_abs(v), d = av * 0.2316418882f + 1.0f;
    f32x2 t; t.x = __builtin_amdgcn_rcpf(d.x); t.y = __builtin_amdgcn_rcpf(d.y);
    f32x2 q = t * 0.5307027145f + (-0.7265760135f); q = q * t + 0.7107068705f; q = q * t + (-0.142248368f); q = q * t + 0.127414796f; q = q * t;
    const f32x2 s = (v * v) * (-0.72134752044f);
    f32x2 e; e.x = __builtin_amdgcn_exp2f(s.x); e.y = __builtin_amdgcn_exp2f(s.y);
    const f32x2 m = v * (q * e), r = v - m;
    f32x2 o; o.x = v.x < 0.f ? m.x : r.x; o.y = v.y < 0.f ? m.y : r.y; return o;
}
__device__ __forceinline__ u32x4 pack8(f32x4 a, f32x4 b) { u32x4 w; w.x = pk2(a[0], a[1]); w.y = pk2(a[2], a[3]); w.z = pk2(b[0], b[1]); w.w = pk2(b[2], b[3]); return w; }

struct EpiIn {
    static constexpr bool PERM = true;
    bf16 *GLU, *Q, *Kb, *Vb, *KC, *VC; const float* bias;
    __device__ __forceinline__ void operator()(const f32x4 (&acc)[2][2][4][2], const pg8::Unit& u, int wr, int wc, int fr, int fq) const {
        asm volatile("" : "+v"(fr), "+v"(fq));
        const int row0 = u.pm * 256 + wr * 64 + fr; const int c8 = wc * 32 + 8 * fq;
        if (u.e == 0 && u.pn < 4) {
            const int j0 = u.pn * 128 + c8;
            f32x4 bu[2], bg[2];
#pragma unroll
            for (int n = 0; n < 2; ++n) { bu[n] = *(const f32x4*)(bias + j0 + 4 * n); bg[n] = *(const f32x4*)(bias + 512 + j0 + 4 * n); }
#pragma unroll
            for (int ai = 0; ai < 2; ++ai)
#pragma unroll
                for (int m = 0; m < 4; ++m) { f32x4 o[2];
#pragma unroll
                    for (int n = 0; n < 2; ++n) { const f32x4 uu = acc[ai][0][m][n] + bu[n], gg = acc[ai][1][m][n] + bg[n];
#pragma unroll
                        for (int k = 0; k < 4; ++k) o[n][k] = uu[k] * sigmoidf_(gg[k]); }
                    *(u32x4*)(GLU + (size_t)(row0 + ai * 128 + m * 16) * 512 + j0) = pack8(o[0], o[1]); }
        } else {
#pragma unroll
            for (int bj = 0; bj < 2; ++bj) {
                bf16* dst; int ld, col, bcol;
                if (u.pn >= 6 || u.e) { dst = u.e ? (bj ? VC : KC) : (bj ? Vb : Kb); ld = 128; col = c8; bcol = KV_COL + bj * 128 + c8; }
                else { dst = Q; ld = 512; col = (u.pn - 4) * 256 + bj * 128 + c8; bcol = 1024 + col; }
                f32x4 bv[2];
#pragma unroll
                for (int n = 0; n < 2; ++n) bv[n] = *(const f32x4*)(bias + bcol + 4 * n);
#pragma unroll
                for (int ai = 0; ai < 2; ++ai)
#pragma unroll
                    for (int m = 0; m < 4; ++m) *(u32x4*)(dst + (size_t)(row0 + ai * 128 + m * 16) * ld + col) = pack8(acc[ai][bj][m][0] + bv[0], acc[ai][bj][m][1] + bv[1]);
            }
        }
    }
};
struct EpiRes {
    static constexpr bool PERM = false;
    const float* base; float* out; const float* bias; const float* gate;
    __device__ __forceinline__ void operator()(const f32x4 (&acc)[2][2][4][2], const pg8::Unit& u, int wr, int wc, int fr, int fq) const {
        asm volatile("" : "+v"(fr), "+v"(fq));
        const int col0 = u.pn * 256 + wc * 32 + 4 * fq; const int b = (u.pm * 256) / SEQ;
#pragma unroll
        for (int bj = 0; bj < 2; ++bj) {
            f32x4 bv[2], gv[2];
#pragma unroll
            for (int n = 0; n < 2; ++n) { bv[n] = *(const f32x4*)(bias + col0 + bj * 128 + n * 16); gv[n] = *(const f32x4*)(gate + (size_t)b * MODW + col0 + bj * 128 + n * 16); }
#pragma unroll
            for (int ai = 0; ai < 2; ++ai)
#pragma unroll
                for (int m = 0; m < 4; ++m) { const size_t off = (size_t)(u.pm * 256 + ai * 128 + wr * 64 + m * 16 + fr) * D + col0 + bj * 128;
#pragma unroll
                    for (int n = 0; n < 2; ++n) { const f32x4 bs = *(const f32x4*)(base + off + n * 16); *(f32x4*)(out + off + n * 16) = bs + gv[n] * (acc[ai][bj][m][n] + bv[n]); } }
        }
    }
};
struct EpiGelu {
    static constexpr bool PERM = true;
    bf16 *U, *V; const float* bias; float* vstat;
    __device__ __forceinline__ void operator()(const f32x4 (&acc)[2][2][4][2], const pg8::Unit& u, int wr, int wc, int fr, int fq) const {
        asm volatile("" : "+v"(fr), "+v"(fq));
        const int row0 = u.pm * 256 + wr * 64 + fr; const int colt = u.pn * 256; const bool isv = colt >= 1024; bf16* base = isv ? V : U; const int cb = (colt & 1023) + wc * 32 + 8 * fq, bcol = colt + wc * 32 + 8 * fq;
        f32x4 bv[2][2];
#pragma unroll
        for (int bj = 0; bj < 2; ++bj)
#pragma unroll
            for (int n = 0; n < 2; ++n) bv[bj][n] = *(const f32x4*)(bias + bcol + bj * 128 + 4 * n);
#pragma unroll
        for (int ai = 0; ai < 2; ++ai)
#pragma unroll
            for (int m = 0; m < 4; ++m) { const int row = row0 + ai * 128 + m * 16; bf16* rowp = base + (size_t)row * D + cb; float s = 0.f, s2 = 0.f;
#pragma unroll
                for (int bj = 0; bj < 2; ++bj) { f32x4 v0 = acc[ai][bj][m][0] + bv[bj][0], v1 = acc[ai][bj][m][1] + bv[bj][1];
                    f32x2 a = gelu_pk((f32x2){v0[0], v0[1]}), b = gelu_pk((f32x2){v0[2], v0[3]}), c = gelu_pk((f32x2){v1[0], v1[1]}), d = gelu_pk((f32x2){v1[2], v1[3]});
                    s += (a.x + a.y) + (b.x + b.y) + (c.x + c.y) + (d.x + d.y); s2 += (a.x * a.x + a.y * a.y) + (b.x * b.x + b.y * b.y) + (c.x * c.x + c.y * c.y) + (d.x * d.x + d.y * d.y);
                    *(u32x4*)(rowp + bj * 128) = pack8((f32x4){a.x, a.y, b.x, b.y}, (f32x4){c.x, c.y, d.x, d.y}); }
                if (isv) { s += __shfl_xor(s, 16); s += __shfl_xor(s, 32); s2 += __shfl_xor(s2, 16); s2 += __shfl_xor(s2, 32);
                    if (fq == 0) { unsafeAtomicAdd(vstat + 2 * row, s); unsafeAtomicAdd(vstat + 2 * row + 1, s2); } } }
    }
};
struct EpiSwiglu {
    static constexpr bool PERM = true;
    unsigned char* ACT; const float* b1;
    __device__ __forceinline__ void operator()(const f32x4 (&acc)[2][2][4][2], const pg8::Unit& u, int wr, int wc, int fr, int fq) const {
        asm volatile("" : "+v"(fr), "+v"(fq));
        const int j0 = u.pn * 128 + wc * 32 + 8 * fq; const float* bb = b1 + (size_t)u.e * 2048;
        f32x4 bg[2], bu[2];
#pragma unroll
        for (int n = 0; n < 2; ++n) { bg[n] = *(const f32x4*)(bb + j0 + 4 * n); bu[n] = *(const f32x4*)(bb + 1024 + j0 + 4 * n); }
#pragma unroll
        for (int ai = 0; ai < 2; ++ai)
#pragma unroll
            for (int m = 0; m < 4; ++m) { f32x4 o[2];
#pragma unroll
                for (int n = 0; n < 2; ++n) { const f32x4 g4 = acc[ai][0][m][n] * FP8_DESCALE + bg[n], u4 = acc[ai][1][m][n] * FP8_DESCALE + bu[n];
#pragma unroll
                    for (int k = 0; k < 4; ++k) { const float g = fminf(g4[k], 7.0f), up = fminf(fmaxf(u4[k], -7.0f), 7.0f); o[n][k] = (up + 1.0f) * g * sigmoidf_(g * 1.702f); } }
                u32x2 w8; w8.x = pk4_fp8(o[0][0] * FP8_AMUL, o[0][1] * FP8_AMUL, o[0][2] * FP8_AMUL, o[0][3] * FP8_AMUL); w8.y = pk4_fp8(o[1][0] * FP8_AMUL, o[1][1] * FP8_AMUL, o[1][2] * FP8_AMUL, o[1][3] * FP8_AMUL);
                *(u32x2*)(ACT + (size_t)(u.pm + ai * 128 + wr * 64 + m * 16 + fr) * D + j0) = w8; }
    }
};
struct EpiDown {
    static constexpr bool PERM = true;
    bf16* Y; const float* b2; const LAS int* meta;
    __device__ __forceinline__ void operator()(const f32x4 (&acc)[2][2][4][2], const pg8::Unit& u, int wr, int wc, int fr, int fq) const {
        asm volatile("" : "+v"(fr), "+v"(fq));
        const int c8 = u.pn * 256 + wc * 32 + 8 * fq; const float* bb = b2 + (size_t)u.e * D;
#pragma unroll
        for (int bj = 0; bj < 2; ++bj) {
            f32x4 bv[2];
#pragma unroll
            for (int n = 0; n < 2; ++n) bv[n] = *(const f32x4*)(bb + c8 + bj * 128 + 4 * n);
            asm volatile("" : "+v"(bv[0]), "+v"(bv[1]));
#pragma unroll
            for (int ai = 0; ai < 2; ++ai)
#pragma unroll
                for (int m = 0; m < 4; ++m) { const int r = ai * 128 + wr * 64 + m * 16 + fr; const u32x2 mg = *(const LAS u32x2*)(meta + (u.idx * 256 + r) * 2); const int aid = (int)mg.x; const float g = __uint_as_float(mg.y);
                    const u32x4 w = pack8((acc[ai][bj][m][0] * FP8_DESCALE + bv[0]) * g, (acc[ai][bj][m][1] * FP8_DESCALE + bv[1]) * g);
                    if (r < u.cnt) *(u32x4*)(Y + (size_t)aid * D + c8 + bj * 128) = w; }
        }
    }
};

struct TrItem { const float* src; bf16* dst; int N; int fp8; };
__device__ __forceinline__ void tr_load(const TrItem& t, float (&v)[32], int lane) {
#pragma unroll
    for (int i = 0; i < 32; ++i) v[i] = t.src[(size_t)(2 * i + (lane >> 5)) * t.N + (lane & 31)];
}
__device__ __forceinline__ void tr_store(const TrItem& t, const float (&v)[32], LAS float* scr, int lane) {
#pragma unroll
    for (int i = 0; i < 32; ++i) scr[(2 * i + (lane >> 5)) * 33 + (lane & 31)] = v[i];
    LDS_WAIT();
    if (t.fp8) {
        const int q = lane & 3;
#pragma unroll
        for (int j = 0; j < 2; ++j) { const int n = (lane >> 2) + 16 * j; const LAS float* s = scr + (16 * q) * 33 + n; u32x4 o;
#pragma unroll
            for (int c = 0; c < 4; ++c) o[c] = pk4_fp8(s[(4 * c) * 33] * FP8_WMUL, s[(4 * c + 1) * 33] * FP8_WMUL, s[(4 * c + 2) * 33] * FP8_WMUL, s[(4 * c + 3) * 33] * FP8_WMUL);
            *(u32x4*)((unsigned char*)t.dst + (size_t)n * 1024 + 16 * q) = o; }
    } else {
        const int c = lane & 7;
#pragma unroll
        for (int j = 0; j < 4; ++j) { const int n = (lane >> 3) + 8 * j; const LAS float* s = scr + (8 * c) * 33 + n;
            u32x4 o; o.x = pk2(s[0 * 33], s[1 * 33]); o.y = pk2(s[2 * 33], s[3 * 33]); o.z = pk2(s[4 * 33], s[5 * 33]); o.w = pk2(s[6 * 33], s[7 * 33]);
            *(u32x4*)(t.dst + (size_t)n * 1024 + 8 * c) = o; }
    }
    LDS_WAIT();
}
__device__ __forceinline__ int pair_src(int nd, int halfw) { return ((nd & 255) >> 7) * halfw + (nd >> 8) * 128 + (nd & 127); }

__device__ __forceinline__ void phase_prologue(const Args& a, const Ctx& X) {
    PMARK(20);
    {
        LAS float* sc = (LAS float*)X.lds;
        LAS float* red = (LAS float*)(X.lds + 36864);
        float* MOD = (float*)(X.ws + WS_MOD);
        for (int item = X.bid; item < 2 * 96; item += X.G) {
            const int l = item / 96, j0 = (item % 96) * 64;
            for (int idx = X.tid; idx < 9 * 1024; idx += NTHREADS) { const int r = idx >> 10, k = idx & 1023; const float v = r < 8 ? IN(I_C)[r * 1024 + k] : IN(I_CCTX)[k]; sc[idx] = v * sigmoidf_(v); }
            __syncthreads();
            float acc[9];
#pragma unroll
            for (int r = 0; r < 9; ++r) acc[r] = 0.f;
            const float* w = IN(I_ADAW) + (size_t)l * 1024 * MODW + j0 + X.lane;
#pragma unroll 8
            for (int k = X.wave * 128; k < X.wave * 128 + 128; ++k) { const float wv = w[(size_t)k * MODW];
#pragma unroll
                for (int r = 0; r < 9; ++r) acc[r] += sc[r * 1024 + k] * wv; }
#pragma unroll
            for (int r = 0; r < 9; ++r) red[(X.wave * 9 + r) * 64 + X.lane] = acc[r];
            __syncthreads();
            for (int t = X.tid; t < 9 * 64; t += NTHREADS) { const int r = t >> 6, cidx = t & 63; float s = 0.f;
#pragma unroll
                for (int w8 = 0; w8 < 8; ++w8) s += red[(w8 * 9 + r) * 64 + cidx];
                MOD[((size_t)l * 9 + r) * MODW + j0 + cidx] = s + IN(I_ADAB)[l * MODW + j0 + cidx]; }
            __syncthreads();
        }
    }
    PMARK(21);
    LAS float* scr = (LAS float*)(X.lds + X.wave * 16384);
    bf16* WinT = (bf16*)(X.ws + WS_WINT); bf16* WoutT = (bf16*)(X.ws + WS_WOUTT); bf16* GWinT = (bf16*)(X.ws + WS_GWINT); bf16* GWoutT = (bf16*)(X.ws + WS_GWOUTT);
    bf16* W1T = (bf16*)(X.ws + WS_W1T); bf16* W2T = (bf16*)(X.ws + WS_W2T);
    constexpr int I_IN = 16 * (EVEN_IN / 32), I_OUT = 16 * 32, I_GIN = 16 * 64, I_GOUT = 16 * 32, I_M1 = 64 * 16 * 64, I_M2 = 64 * 16 * 32;
    constexpr int NITEMS = I_IN + I_OUT + I_GIN + I_GOUT + I_M1 + I_M2;
    auto item_of = [&](int it) -> TrItem {
        int r = it; TrItem t; t.fp8 = 0;
        if (r < I_M1) { const int mat = r >> 10, q = r & 1023, kb = q >> 6, nd = (q & 63) * 32; t.N = 2048; t.fp8 = 1; t.src = IN(I_W1) + (size_t)mat * 1024 * 2048 + (size_t)kb * 64 * 2048 + pair_src(nd, 1024); t.dst = (bf16*)((unsigned char*)W1T + (size_t)mat * 2048 * 1024 + (size_t)nd * 1024 + kb * 64); return t; } r -= I_M1;
        if (r < I_M2) { const int mat = r >> 9, q = r & 511, kb = q >> 5, nd = (q & 31) * 32; t.N = 1024; t.fp8 = 1; t.src = IN(I_W2) + (size_t)mat * 1024 * 1024 + (size_t)kb * 64 * 1024 + nd; t.dst = (bf16*)((unsigned char*)W2T + (size_t)mat * 1024 * 1024 + (size_t)nd * 1024 + kb * 64); return t; } r -= I_M2;
        if (r < I_IN) { const int kb = r / 56, nd = (r % 56) * 32; const int ns = nd < 1024 ? pair_src(nd, 512) : nd; t.N = EVEN_IN; t.src = IN(I_EWIN) + (size_t)kb * 64 * EVEN_IN + ns; t.dst = WinT + (size_t)nd * 1024 + kb * 64; return t; } r -= I_IN;
        if (r < I_OUT) { const int kb = r >> 5, nd = (r & 31) * 32; t.N = 1024; t.src = IN(I_EWOUT) + (size_t)kb * 64 * 1024 + nd; t.dst = WoutT + (size_t)nd * 1024 + kb * 64; return t; } r -= I_OUT;
        if (r < I_GIN) { const int kb = r >> 6, nd = (r & 63) * 32; t.N = 2048; t.src = IN(I_OWIN) + (size_t)kb * 64 * 2048 + nd; t.dst = GWinT + (size_t)nd * 1024 + kb * 64; return t; } r -= I_GIN;
        { const int kb = r >> 5, nd = (r & 31) * 32; t.N = 1024; t.src = IN(I_OWOUT) + (size_t)kb * 64 * 1024 + nd; t.dst = GWoutT + (size_t)nd * 1024 + kb * 64; return t; }
    };
    {
        float va[32], vb[32]; int it = X.gw;
        TrItem ta, tb; if (it < NITEMS) { ta = item_of(it); tr_load(ta, va, X.lane); }
        while (it < NITEMS) {
            const int it1 = it + X.NGW; if (it1 < NITEMS) { tb = item_of(it1); tr_load(tb, vb, X.lane); }
            tr_store(ta, va, scr, X.lane);
            if (it1 >= NITEMS) break;
            const int it2 = it1 + X.NGW; if (it2 < NITEMS) { ta = item_of(it2); tr_load(ta, va, X.lane); }
            tr_store(tb, vb, scr, X.lane);
            it = it2;
        }
    }
#if EXP_STREAM
    {
        unsigned char* dstb = (unsigned char*)(X.ws + WS_CF);
        const size_t n1 = (size_t)2 * 32 * 1024 * 2048, n2 = (size_t)2 * 32 * 1024 * 1024;
        for (size_t i = ((size_t)X.gw * 64 + X.lane) * 16; i < n1 + n2; i += (size_t)X.NGW * 64 * 16) {
            const float* s = i < n1 ? IN(I_W1) + i : IN(I_W2) + (i - n1);
            const f32x4 a0 = ((const f32x4*)s)[0], a1 = ((const f32x4*)s)[1], a2 = ((const f32x4*)s)[2], a3 = ((const f32x4*)s)[3];
            u32x4 o; o.x = pk4_fp8(a0[0], a0[1], a0[2], a0[3]); o.y = pk4_fp8(a1[0], a1[1], a1[2], a1[3]); o.z = pk4_fp8(a2[0], a2[1], a2[2], a2[3]); o.w = pk4_fp8(a3[0], a3[1], a3[2], a3[3]);
            *(u32x4*)(dstb + i) = o; }
    }
#endif
    PMARK(22);
    { bf16* WsB = (bf16*)(X.ws + WS_WSB); const float* ws = IN(I_OWS);
      for (int i = (X.gw * 64 + X.lane) * 4; i < 8 * 128 * 128; i += X.NGW * 64 * 4) { const f32x4 v = *(const f32x4*)(ws + i); u32x2 o; o.x = pk2(v[0], v[1]); o.y = pk2(v[2], v[3]); *(u32x2*)(WsB + i) = o; } }
}

__device__ __forceinline__ void modulate_row(const float* xrow, const float* g, const float* sh, const float* sc, bf16* orow, int lane, f32x4 (&y)[4]) {
    const f32x4* xr = (const f32x4*)xrow + lane; f32x4 v[4]; float ss = 0.f;
#pragma unroll
    for (int j = 0; j < 4; ++j) { v[j] = xr[64 * j]; ss += (v[j][0] * v[j][0] + v[j][1] * v[j][1]) + (v[j][2] * v[j][2] + v[j][3] * v[j][3]); }
    const float rstd = rsqrtf(wave_sum(ss) * (1.0f / D) + EPS);
#pragma unroll
    for (int j = 0; j < 4; ++j) { const f32x4 gk = ((const f32x4*)g)[lane + 64 * j], sk = ((const f32x4*)sc)[lane + 64 * j], hk = ((const f32x4*)sh)[lane + 64 * j];
        y[j] = v[j] * rstd * gk * (1.0f + sk) + hk;
        u32x2 o; o.x = pk2(y[j][0], y[j][1]); o.y = pk2(y[j][2], y[j][3]); *((u32x2*)orow + lane + 64 * j) = o; }
}
__device__ __forceinline__ void mod0_load(const Ctx& X, int row, f32x4 (&v)[4]) {
    const float* xrow = row < NTOK ? IN(I_X) + (size_t)row * D : IN(I_CTX) + (size_t)(row - NTOK) * D;
#pragma unroll
    for (int j = 0; j < 4; ++j) v[j] = ((const f32x4*)xrow)[X.lane + 64 * j];
}
__device__ __forceinline__ void mod0_finish(const Ctx& X, int row, const f32x4 (&v)[4]) {
    const float* m = (const float*)(X.ws + WS_MOD) + (size_t)(row < NTOK ? row / SEQ : 8) * MODW; const float* g = IN(I_NMG);
    bf16* orow = row < NTOK ? (bf16*)(X.ws + WS_XA) + (size_t)row * D : (bf16*)(X.ws + WS_GM) + (size_t)(row - NTOK) * D;
    f32x4 gk[4], hk[4], sk[4]; float ss = 0.f;
#pragma unroll
    for (int j = 0; j < 4; ++j) { gk[j] = ((const f32x4*)g)[X.lane + 64 * j]; hk[j] = ((const f32x4*)m)[X.lane + 64 * j]; sk[j] = ((const f32x4*)(m + 1024))[X.lane + 64 * j];
        ss += (v[j][0] * v[j][0] + v[j][1] * v[j][1]) + (v[j][2] * v[j][2] + v[j][3] * v[j][3]); }
    const float rstd = rsqrtf(wave_sum(ss) * (1.0f / D) + EPS);
#pragma unroll
    for (int j = 0; j < 4; ++j) { const f32x4 y = v[j] * rstd * gk[j] * (1.0f + sk[j]) + hk[j]; u32x2 o; o.x = pk2(y[0], y[1]); o.y = pk2(y[2], y[3]); *((u32x2*)orow + X.lane + 64 * j) = o; }
}
__device__ __forceinline__ void phase_modulate0(const Args& a, const Ctx& X) {
    constexpr int NR = NTOK + NCTX; f32x4 va[4], vb[4];
    int row = X.gw; if (row < NR) mod0_load(X, row, va);
    while (row < NR) {
        const int r1 = row + X.NGW; if (r1 < NR) mod0_load(X, r1, vb);
        mod0_finish(X, row, va);
        if (r1 >= NR) break;
        const int r2 = r1 + X.NGW; if (r2 < NR) mod0_load(X, r2, va);
        mod0_finish(X, r1, vb);
        row = r2;
    }
}

__device__ __forceinline__ void qk_chunks(bf16* buf, int nchunks, int rowlen, const float* gn, bool rope, float oscale, const Ctx& X, const LAS f32x2* cs) {
    for (int ch = X.gw; ch < nchunks; ch += X.NGW) {
        const int e0 = ch * 512 + 8 * X.lane; const int token = e0 / rowlen; const int d0 = e0 & 63;
        u32x4 raw = *(const u32x4*)(buf + e0); float v[8];
#pragma unroll
        for (int i = 0; i < 4; ++i) { v[2 * i] = bf2f(raw[i] & 0xffffu); v[2 * i + 1] = bf2f(raw[i] >> 16); }
        float ss = 0.f;
#pragma unroll
        for (int i = 0; i < 8; ++i) ss += v[i] * v[i];
        ss += __shfl_xor(ss, 1); ss += __shfl_xor(ss, 2); ss += __shfl_xor(ss, 4);
        const float rstd = rsqrtf(ss * (1.0f / 64.0f) + EPS);
        const f32x4 g0 = *(const f32x4*)(gn + d0), g1 = *(const f32x4*)(gn + d0 + 4);
#pragma unroll
        for (int i = 0; i < 4; ++i) { v[i] = v[i] * rstd * g0[i]; v[4 + i] = v[4 + i] * rstd * g1[i]; }
        if (rope) {
            const int t = token % SEQ; const int dd0 = d0 & 31; const int pos = dd0 < 16 ? (t >> 6) : (t & 63);
            const LAS f32x2* cp = cs + pos * 16 + (dd0 & 15);
#pragma unroll
            for (int i = 0; i < 8; ++i) { const float pv = __shfl_xor(v[i], 4); const f32x2 c = cp[i];
                v[i] = (d0 < 32) ? (v[i] * c.x - pv * c.y) : (v[i] * c.x + pv * c.y); }
        }
        u32x4 o; o.x = pk2(v[0] * oscale, v[1] * oscale); o.y = pk2(v[2] * oscale, v[3] * oscale); o.z = pk2(v[4] * oscale, v[5] * oscale); o.w = pk2(v[6] * oscale, v[7] * oscale);
        *(u32x4*)(buf + e0) = o;
    }
}
__device__ __forceinline__ void phase_conv_qk(const Args& a, const Ctx& X) {
    LAS f32x2* cs = (LAS f32x2*)(X.lds + 65536);
    for (int i = X.tid; i < 1024; i += NTHREADS) { const float inv = exp2f(-(float)(i & 15) * (13.287712379549449f / 16.0f)); float sn, csn; sincosf((float)(i >> 4) * inv, &sn, &csn); cs[i] = (f32x2){csn, sn}; }
    __syncthreads();
    qk_chunks((bf16*)(X.ws + WS_Q), NTOK, 512, IN(I_QNG), true, QSCALE, X, cs);
    qk_chunks((bf16*)(X.ws + WS_K), NTOK / 4, 128, IN(I_KNG), true, 1.0f, X, cs);
    qk_chunks((bf16*)(X.ws + WS_KC), NCTX / 4, 128, IN(I_KNG), false, 1.0f, X, cs);
    const bf16* GLU = (const bf16*)(X.ws + WS_GLU); bf16* MIX = (bf16*)(X.ws + WS_MIX);
    LAS unsigned* tin = (LAS unsigned*)X.lds;
    LAS float* tout = (LAS float*)(X.lds + 65536);
    const int cp = X.tid & 255, th = X.tid >> 8;
    float w0[31], w1[31];
#pragma unroll
    for (int j = 0; j < 31; ++j) { const f32x2 w = *(const f32x2*)(IN(I_ECW) + j * 512 + 2 * cp); w0[j] = w.x; w1[j] = w.y; }
    const f32x2 cb = *(const f32x2*)(IN(I_ECB) + 2 * cp);
    for (int tile = X.bid; tile < NTOK / 32; tile += X.G) {
        const int row0 = tile * 32; const int t0 = row0 % SEQ;
        __syncthreads();
        for (int c = X.tid; c < 62 * 64; c += NTHREADS) { const int lr = c >> 6, cc = c & 63; const int t = t0 - 15 + lr;
            u32x4 v = (u32x4){0u, 0u, 0u, 0u}; if (t >= 0 && t < SEQ) v = *(const u32x4*)(GLU + (size_t)(row0 - 15 + lr) * 512 + cc * 8);
            *(LAS u32x4*)(tin + lr * 256 + cc * 4) = v; }
        __syncthreads();
        float a0[16], a1[16];
#pragma unroll
        for (int o = 0; o < 16; ++o) { a0[o] = cb.x; a1[o] = cb.y; }
#pragma unroll
        for (int rr = 0; rr < 46; ++rr) { const unsigned pv = tin[(16 * th + rr) * 256 + cp]; const float x0 = bf2f(pv & 0xffffu), x1 = bf2f(pv >> 16);
#pragma unroll
            for (int o = 0; o < 16; ++o) { const int j = rr - o; if (j >= 0 && j <= 30) { a0[o] += x0 * w0[j]; a1[o] += x1 * w1[j]; } } }
#pragma unroll
        for (int o = 0; o < 16; ++o) *(LAS f32x2*)(tout + (16 * th + o) * 512 + 2 * cp) = (f32x2){a0[o], a1[o]};
        __syncthreads();
#pragma unroll
        for (int q = 0; q < 4; ++q) { const int tl = X.wave * 4 + q; f32x4 v[2]; float s = 0.f;
#pragma unroll
            for (int j = 0; j < 2; ++j) { v[j] = *(const LAS f32x4*)(tout + tl * 512 + 4 * X.lane + 256 * j); s += (v[j][0] + v[j][1]) + (v[j][2] + v[j][3]); }
            const float mean = wave_sum(s) * (1.0f / 512.0f); float s2 = 0.f;
#pragma unroll
            for (int j = 0; j < 2; ++j) { v[j] = v[j] - mean; s2 += (v[j][0] * v[j][0] + v[j][1] * v[j][1]) + (v[j][2] * v[j][2] + v[j][3] * v[j][3]); }
            const float rstd = rsqrtf(wave_sum(s2) * (1.0f / 512.0f) + EPS);
#pragma unroll
            for (int j = 0; j < 2; ++j) { const f32x4 g = *(const f32x4*)(IN(I_ELNG) + 4 * X.lane + 256 * j), b = *(const f32x4*)(IN(I_ELNB) + 4 * X.lane + 256 * j);
                f32x4 y = v[j] * rstd * g + b;
#pragma unroll
                for (int k = 0; k < 4; ++k) y[k] = y[k] * sigmoidf_(y[k]);
                u32x2 o; o.x = pk2(y[0], y[1]); o.y = pk2(y[2], y[3]); *(u32x2*)(MIX + (size_t)(row0 + tl) * D + 4 * X.lane + 256 * j) = o; } }
    }
}

__device__ __forceinline__ void phase_attention(const Args& a, const Ctx& X) {
    unsigned char* const wsb = X.ws;
    LAS unsigned char* Ks = X.lds;
    LAS unsigned char* Vt = X.lds + 16384;
    const int lane = X.lane, l15 = lane & 15, g4 = lane >> 4;
    for (int unit = X.bid; unit < NB * 2 * 32; unit += X.G) {
        const int b = unit >> 6, kh = (unit >> 5) & 1, qb = unit & 31; const int q0 = qb * 64;
        const int hq = kh * 4 + (X.wave >> 1), tq = (X.wave & 1) * 32;
        bf16x8 Qf[2][2];
#pragma unroll
        for (int qi = 0; qi < 2; ++qi)
#pragma unroll
            for (int s = 0; s < 2; ++s) Qf[qi][s] = *(const bf16x8*)(wsb + (unsigned)(WS_Q + 2u * (unsigned)((b * SEQ + q0 + tq + 16 * qi + l15) * 512 + hq * 64 + 32 * s + 8 * g4)));
        const float sink2 = IN(I_SINK)[hq] * LOG2E;
        float mrun[2], lrun[2]; f32x4 O[2][4];
#pragma unroll
        for (int qi = 0; qi < 2; ++qi) { mrun[qi] = sink2; lrun[qi] = (g4 == 0) ? 1.0f : 0.0f;
#pragma unroll
            for (int db = 0; db < 4; ++db) O[qi][db] = (f32x4){0.f, 0.f, 0.f, 0.f}; }
        const int t_first = (q0 >= 128) ? 0 : (q0 >= 64 ? 1 : 2), t_skip_lo = (q0 + 128 < SEQ) ? 5 : (q0 + 64 < SEQ ? 4 : 3);
        const int key = X.tid >> 3, ch = X.tid & 7;
        auto tile_offs = [&](int t, unsigned& ko, unsigned& vo) {
            if (t < 5) { const unsigned e = (unsigned)((b * SEQ + q0 - 128 + 64 * t) * 128 + kh * 64) * 2u; ko = (unsigned)WS_K + e; vo = (unsigned)WS_V + e; }
            else { const unsigned e = (unsigned)((b * CTXL + (t - 5) * 64) * 128 + kh * 64) * 2u; ko = (unsigned)WS_KC + e; vo = (unsigned)WS_VC + e; } };
        const unsigned lane_off = (unsigned)(key * 128 + ch * 8) * 2u;
        auto lds_put = [&](int buf, const u32x4& kv, const u32x4& vv) {
            LAS unsigned char* Kd = Ks + buf * 32768; LAS unsigned char* Vd = Vt + buf * 32768;
            *(LAS u32x4*)(Kd + key * 144 + ch * 16) = kv;
#pragma unroll
            for (int i = 0; i < 4; ++i) { *(LAS unsigned short*)(Vd + (8 * ch + 2 * i) * 136 + key * 2) = (unsigned short)(vv[i] & 0xffffu); *(LAS unsigned short*)(Vd + (8 * ch + 2 * i + 1) * 136 + key * 2) = (unsigned short)(vv[i] >> 16); } };
        u32x4 kreg, vreg;
        { unsigned ko, vo; tile_offs(t_first, ko, vo); kreg = *(const u32x4*)(wsb + (ko + lane_off)); vreg = *(const u32x4*)(wsb + (vo + lane_off)); }
        __syncthreads();
        lds_put(0, kreg, vreg);
        int bufi = 0;
        for (int t = t_first; t < 9; ++t) {
            if (t >= t_skip_lo && t < 5) continue;
            int tn = t + 1; if (tn >= t_skip_lo && tn < 5) tn = 5;
            if (tn < 9) { unsigned ko, vo; tile_offs(tn, ko, vo); kreg = *(const u32x4*)(wsb + (ko + lane_off)); vreg = *(const u32x4*)(wsb + (vo + lane_off)); }
            const int mode = (t == 0) ? 1 : (t == 4 ? 2 : 0);
            __syncthreads();
            const LAS unsigned char* Kc = Ks + bufi * 32768; const LAS unsigned char* Vc = Vt + bufi * 32768;
            bf16x8 kf[4][2];
#pragma unroll
            for (int kb = 0; kb < 4; ++kb)
#pragma unroll
                for (int s = 0; s < 2; ++s) kf[kb][s] = *(const LAS bf16x8*)(Kc + (16 * kb + l15) * 144 + (32 * s + 8 * g4) * 2);
            bf16x8 vf[4][2];
#pragma unroll
            for (int db = 0; db < 4; ++db)
#pragma unroll
                for (int ks2 = 0; ks2 < 2; ++ks2) { const LAS unsigned char* p = Vc + (16 * db + l15) * 136 + (32 * ks2 + 4 * g4) * 2;
                    const u32x2 lo = *(const LAS u32x2*)p, hi = *(const LAS u32x2*)(p + 32);
                    u32x4 w; w.x = lo.x; w.y = lo.y; w.z = hi.x; w.w = hi.y; vf[db][ks2] = __builtin_bit_cast(bf16x8, w); }
#pragma unroll
            for (int qi = 0; qi < 2; ++qi) {
                f32x4 st[4];
#pragma unroll
                for (int kb = 0; kb < 4; ++kb) { st[kb] = (f32x4){0.f, 0.f, 0.f, 0.f};
#pragma unroll
                    for (int s = 0; s < 2; ++s) st[kb] = __builtin_amdgcn_mfma_f32_16x16x32_bf16(kf[kb][s], Qf[qi][s], st[kb], 0, 0, 0); }
                if (mode) { int qloc = tq + 16 * qi + l15; asm volatile("" : "+v"(qloc));
#pragma unroll
                    for (int kb = 0; kb < 4; ++kb)
#pragma unroll
                        for (int r = 0; r < 4; ++r) { const int kk = 16 * kb + 4 * g4 + r; const bool keep = (mode == 1) ? (kk >= qloc) : (kk <= qloc); if (!keep) st[kb][r] = -1e30f; } }
                float mx = st[0][0];
#pragma unroll
                for (int kb = 0; kb < 4; ++kb)
#pragma unroll
                    for (int r = 0; r < 4; ++r) mx = fmaxf(mx, st[kb][r]);
                mx = fmaxf(mx, __shfl_xor(mx, 16)); mx = fmaxf(mx, __shfl_xor(mx, 32));
                const float mnew = fmaxf(mrun[qi], mx); const float alpha = __builtin_amdgcn_exp2f(mrun[qi] - mnew); mrun[qi] = mnew;
                float ps = 0.f;
#pragma unroll
                for (int kb = 0; kb < 4; ++kb)
#pragma unroll
                    for (int r = 0; r < 4; ++r) { st[kb][r] = __builtin_amdgcn_exp2f(st[kb][r] - mnew); ps += st[kb][r]; }
                lrun[qi] = lrun[qi] * alpha + ps;
#pragma unroll
                for (int db = 0; db < 4; ++db) O[qi][db] = O[qi][db] * alpha;
#pragma unroll
                for (int ks2 = 0; ks2 < 2; ++ks2) { u32x4 w; w.x = pk2(st[2 * ks2][0], st[2 * ks2][1]); w.y = pk2(st[2 * ks2][2], st[2 * ks2][3]); w.z = pk2(st[2 * ks2 + 1][0], st[2 * ks2 + 1][1]); w.w = pk2(st[2 * ks2 + 1][2], st[2 * ks2 + 1][3]);
                    const bf16x8 pf = __builtin_bit_cast(bf16x8, w);
#pragma unroll
                    for (int db = 0; db < 4; ++db) O[qi][db] = __builtin_amdgcn_mfma_f32_16x16x32_bf16(vf[db][ks2], pf, O[qi][db], 0, 0, 0); }
            }
            if (tn < 9) lds_put(bufi ^ 1, kreg, vreg);
            bufi ^= 1;
        }
#pragma unroll
        for (int qi = 0; qi < 2; ++qi) { float l = lrun[qi]; l += __shfl_xor(l, 16); l += __shfl_xor(l, 32); const float inv = 1.0f / l;
            bf16* orow = (bf16*)(wsb + (unsigned)(WS_MIX + 2u * (unsigned)((b * SEQ + q0 + tq + 16 * qi + l15) * D + 512 + hq * 64 + 4 * g4)));
#pragma unroll
            for (int db = 0; db < 4; ++db) { u32x2 o; o.x = pk2(O[qi][db][0] * inv, O[qi][db][1] * inv); o.y = pk2(O[qi][db][2] * inv, O[qi][db][3] * inv); *(u32x2*)(orow + 16 * db) = o; } }
    }
}

__device__ __forceinline__ void phase_router(const Args& a, const Ctx& X, int layer) {
    const float* __restrict__ H = (const float*)(X.ws + WS_H); unsigned char* XA8 = (unsigned char*)(X.ws + WS_XA8);
    const float* MODl = (const float*)(X.ws + WS_MOD) + (size_t)layer * 9 * MODW; const float* gn = IN(I_NFG) + layer * D;
    const float* rw = IN(I_RW) + (size_t)layer * D * NE; const float* rb = IN(I_RB) + layer * NE;
    int* cntg = (int*)(X.ws + WS_CTL) + CW_CNT + layer * NE * CNT_STRIDE; int* list = (int*)(X.ws + WS_LIST); float* gatew = (float*)(X.ws + WS_GATE);
    LAS float* ybuf = (LAS float*)X.lds;
    LAS float* part = (LAS float*)(X.lds + 65536);
    LAS int* sel = (LAS int*)(X.lds + 65536 + 16384);
    LAS int* lcnt = (LAS int*)(X.lds + 65536 + 16384 + 1024);
    LAS float* lgs = (LAS float*)(X.lds + 65536 + 16384 + 2048);
    LAS float* tvs = lgs + 512;
    LAS float* exs = lgs + 528;
    PMARK(0);
    const int e = X.lane & 31, hf = X.lane >> 5;
    float wreg[64];
#pragma unroll
    for (int i = 0; i < 64; ++i) wreg[i] = rw[(size_t)(128 * X.wave + 64 * hf + i) * NE + e];
    const float rbe = rb[e];
    for (int blk = X.bid; blk < NTOK / 64; blk += X.G) {
        const int rowbase = blk * 64; const float* m = MODl + (size_t)(rowbase / SEQ) * MODW;
        f32x4 gk[4], hk[4], xv[2][4];
#pragma unroll
        for (int j = 0; j < 4; ++j) { gk[j] = ((const f32x4*)gn)[X.lane + 64 * j]; hk[j] = ((const f32x4*)(m + 3 * 1024))[X.lane + 64 * j]; const f32x4 s_ = ((const f32x4*)(m + 4 * 1024))[X.lane + 64 * j]; gk[j] = gk[j] * (1.0f + s_); }
#pragma unroll
        for (int i = 0; i < 2; ++i)
#pragma unroll
            for (int j = 0; j < 4; ++j) xv[i][j] = ((const f32x4*)(H + (size_t)(rowbase + 2 * X.wave + i) * D))[X.lane + 64 * j];
        __syncthreads();
        if (X.tid < 64) lcnt[X.tid] = 0;
        PMARK(1);
#pragma unroll 1
        for (int bt = 0; bt < 4; ++bt) {
#pragma unroll
            for (int i = 0; i < 2; ++i) { const int rl = 2 * X.wave + i, row = rowbase + 16 * bt + rl; float ss = 0.f;
#pragma unroll
                for (int j = 0; j < 4; ++j) ss += (xv[i][j][0] * xv[i][j][0] + xv[i][j][1] * xv[i][j][1]) + (xv[i][j][2] * xv[i][j][2] + xv[i][j][3] * xv[i][j][3]);
                const float rstd = rsqrtf(wave_sum(ss) * (1.0f / D) + EPS);
#pragma unroll
                for (int j = 0; j < 4; ++j) { const f32x4 y = xv[i][j] * rstd * gk[j] + hk[j];
                    *((unsigned*)(XA8 + (size_t)row * D) + X.lane + 64 * j) = pk4_fp8(y[0] * FP8_AMUL, y[1] * FP8_AMUL, y[2] * FP8_AMUL, y[3] * FP8_AMUL);
                    *(LAS f32x4*)(ybuf + rl * 1024 + 4 * X.lane + 256 * j) = y; } }
            if (bt < 3) {
#pragma unroll
                for (int i = 0; i < 2; ++i)
#pragma unroll
                    for (int j = 0; j < 4; ++j) xv[i][j] = ((const f32x4*)(H + (size_t)(rowbase + 16 * (bt + 1) + 2 * X.wave + i) * D))[X.lane + 64 * j];
            }
            __syncthreads();
#pragma unroll 2
            for (int r = 0; r < 16; ++r) { float acc[4] = {0.f, 0.f, 0.f, 0.f}; const LAS float* yp = ybuf + r * 1024 + 128 * X.wave + 64 * hf;
#pragma unroll
                for (int i4 = 0; i4 < 16; ++i4) { const f32x4 yv = *(const LAS f32x4*)(yp + 4 * i4);
                    acc[i4 & 3] += yv[0] * wreg[4 * i4] + yv[1] * wreg[4 * i4 + 1] + yv[2] * wreg[4 * i4 + 2] + yv[3] * wreg[4 * i4 + 3]; }
                const float t0 = (acc[0] + acc[1]) + (acc[2] + acc[3]); const float t = t0 + dpp_swap32(t0);
                if (hf == 0) part[(r * 8 + X.wave) * 32 + e] = t; }
            __syncthreads();
            { const int r = 2 * X.wave + hf, rl = 16 * bt + r;
              float v = rbe;
#pragma unroll
              for (int w8 = 0; w8 < 8; ++w8) v += part[(r * 8 + w8) * 32 + e];
              lgs[r * 32 + e] = v; LDS_WAIT();
              int ez = e; asm volatile("" : "+v"(ez));
              int rank = 0;
#pragma unroll
              for (int j4 = 0; j4 < 8; ++j4) { const f32x4 o = *(const LAS f32x4*)(lgs + r * 32 + 4 * j4);
#pragma unroll
                  for (int c = 0; c < 4; ++c) rank += (o[c] > v || (o[c] == v && (4 * j4 + c) < ez)) ? 1 : 0; }
              if (rank == 0) tvs[r] = v;
              LDS_WAIT();
              const float ex = __expf(v - tvs[r]);
              if (rank < 4) exs[r * 4 + rank] = ex;
              LDS_WAIT();
              const f32x4 e4 = *(const LAS f32x4*)(exs + r * 4); const float inv = 1.0f / ((e4[0] + e4[1]) + (e4[2] + e4[3]));
              if (rank < 4) { const int slot = atomicAdd((int*)&lcnt[e], 1); sel[rl * 4 + rank] = (e << 16) | slot; gatew[(size_t)(rowbase + rl) * 4 + rank] = ex * inv; } }
        }
        __syncthreads();
        PMARK(2);
        if (X.tid < 32) lcnt[32 + X.tid] = atomicAdd(cntg + X.tid * CNT_STRIDE, lcnt[X.tid]);
        __syncthreads();
        if (X.tid < 256) { const int w = sel[X.tid]; const int ee = w >> 16, rank = w & 0xffff; list[(size_t)ee * NTOK + lcnt[32 + ee] + rank] = rowbase * 4 + X.tid; }
    }
    PMARK(3);
}

__device__ __forceinline__ void phase_combine(const Args& a, const Ctx& X, int layer) {
    float* H = (float*)(X.ws + WS_H); const bf16* __restrict__ Y = (const bf16*)(X.ws + WS_Y); bf16* XA = (bf16*)(X.ws + WS_XA);
    const float* __restrict__ MODl = (const float*)(X.ws + WS_MOD) + (size_t)layer * 9 * MODW;
    float* outp = (float*)(__attribute__((address_space(1))) float*)X.kp[33];
    for (int row = X.gw; row < NTOK; row += X.NGW) {
        const float* gt = MODl + (size_t)(row / SEQ) * MODW + 5 * 1024; f32x4 h[2][2], g[2][2]; u32x4 yw[2][4];
#pragma unroll
        for (int j = 0; j < 2; ++j) { const int c0 = 8 * X.lane + 512 * j;
#pragma unroll
            for (int q = 0; q < 2; ++q) { h[j][q] = *(const f32x4*)(H + (size_t)row * D + c0 + 4 * q); g[j][q] = *(const f32x4*)(gt + c0 + 4 * q); }
#pragma unroll
            for (int k = 0; k < 4; ++k) yw[j][k] = *(const u32x4*)(Y + ((size_t)row * 4 + k) * D + c0); }
        float ss = 0.f;
#pragma unroll
        for (int j = 0; j < 2; ++j) { f32x4 s0 = (f32x4){0.f, 0.f, 0.f, 0.f}, s1 = s0;
#pragma unroll
            for (int k = 0; k < 4; ++k) { const u32x4 w = yw[j][k]; s0 += (f32x4){bf2f(w.x & 0xffffu), bf2f(w.x >> 16), bf2f(w.y & 0xffffu), bf2f(w.y >> 16)}; s1 += (f32x4){bf2f(w.z & 0xffffu), bf2f(w.z >> 16), bf2f(w.w & 0xffffu), bf2f(w.w >> 16)}; }
            h[j][0] = h[j][0] + g[j][0] * s0; h[j][1] = h[j][1] + g[j][1] * s1;
#pragma unroll
            for (int q = 0; q < 2; ++q) ss += (h[j][q][0] * h[j][q][0] + h[j][q][1] * h[j][q][1]) + (h[j][q][2] * h[j][q][2] + h[j][q][3] * h[j][q][3]); }
        if (layer == 1) {
#pragma unroll
            for (int j = 0; j < 2; ++j)
#pragma unroll
                for (int q = 0; q < 2; ++q) *(f32x4*)(outp + (size_t)row * D + 8 * X.lane + 512 * j + 4 * q) = h[j][q];
        } else {
            const float* m1 = (const float*)(X.ws + WS_MOD) + (size_t)9 * MODW + (size_t)(row / SEQ) * MODW; const float* gn = IN(I_NMG) + D;
            f32x4 gk[2][2], hk[2][2], sk[2][2];
#pragma unroll
            for (int j = 0; j < 2; ++j)
#pragma unroll
                for (int q = 0; q < 2; ++q) { const int c0 = 8 * X.lane + 512 * j + 4 * q; gk[j][q] = *(const f32x4*)(gn + c0); hk[j][q] = *(const f32x4*)(m1 + c0); sk[j][q] = *(const f32x4*)(m1 + 1024 + c0); }
            const float rstd = rsqrtf(wave_sum(ss) * (1.0f / D) + EPS);
#pragma unroll
            for (int j = 0; j < 2; ++j) { const int c0 = 8 * X.lane + 512 * j;
                const f32x4 y0 = h[j][0] * rstd * gk[j][0] * (1.0f + sk[j][0]) + hk[j][0], y1 = h[j][1] * rstd * gk[j][1] * (1.0f + sk[j][1]) + hk[j][1];
                *(f32x4*)(H + (size_t)row * D + c0) = h[j][0]; *(f32x4*)(H + (size_t)row * D + c0 + 4) = h[j][1];
                *(u32x4*)(XA + (size_t)row * D + c0) = pack8(y0, y1); }
        }
    }
}

__device__ __forceinline__ void phase_spatial(const Args& a, const Ctx& X) {
    const bf16* U = (const bf16*)(X.ws + WS_U); const bf16* VB = (const bf16*)(X.ws + WS_VB); bf16* SG = (bf16*)(X.ws + WS_MIX); const bf16* WsB = (const bf16*)(X.ws + WS_WSB); const float* vstat = (const float*)(X.ws + WS_CTL) + CW_VSTAT;
    LAS float* stat = (LAS float*)X.lds;
    LAS unsigned char* Vt = X.lds + 4096;
    const int lane = X.lane, l15 = lane & 15, g4 = lane >> 4;
    for (int item = X.bid; item < 128 * 8; item += X.G) {
        const int chunk = item >> 3, g = item & 7; const int row0 = chunk * 128;
        __syncthreads();
        if (X.tid < 128) { const f32x2 sv = *(const f32x2*)(vstat + 2 * (row0 + X.tid)); const float mean = sv.x * (1.0f / D); const float var = fmaxf(sv.y * (1.0f / D) - mean * mean, 0.f);
            stat[2 * X.tid] = mean; stat[2 * X.tid + 1] = rsqrtf(var + EPS); }
        __syncthreads();
#pragma unroll
        for (int c = X.tid; c < 128 * 16; c += NTHREADS) { const int q = c >> 4, cc = c & 15; const u32x4 w = *(const u32x4*)(VB + (size_t)(row0 + q) * D + g * 128 + cc * 8);
            const float mean = stat[2 * q], rstd = stat[2 * q + 1]; const float* lg_ = IN(I_OLNG) + g * 128 + cc * 8; const float* lb_ = IN(I_OLNB) + g * 128 + cc * 8;
#pragma unroll
            for (int k = 0; k < 4; ++k) { const float y0 = (bf2f(w[k] & 0xffffu) - mean) * rstd * lg_[2 * k] + lb_[2 * k], y1 = (bf2f(w[k] >> 16) - mean) * rstd * lg_[2 * k + 1] + lb_[2 * k + 1];
                const unsigned pk = pk2(y0, y1);
                *(LAS unsigned short*)(Vt + ((2 * k) * 17 + cc) * 272 + q * 2) = (unsigned short)(pk & 0xffffu); *(LAS unsigned short*)(Vt + ((2 * k + 1) * 17 + cc) * 272 + q * 2) = (unsigned short)(pk >> 16); } }
        __syncthreads();
        f32x4 acc[8];
#pragma unroll
        for (int pb = 0; pb < 8; ++pb) acc[pb] = (f32x4){0.f, 0.f, 0.f, 0.f};
#pragma unroll
        for (int s = 0; s < 4; ++s) { const bf16x8 af = *(const LAS bf16x8*)(Vt + ((l15 & 7) * 17 + 2 * X.wave + (l15 >> 3)) * 272 + (32 * s + 8 * g4) * 2);
#pragma unroll
            for (int pb = 0; pb < 8; ++pb) { const bf16x8 bfr = *(const bf16x8*)(WsB + ((size_t)g * 128 + 16 * pb + l15) * 128 + 32 * s + 8 * g4); acc[pb] = __builtin_amdgcn_mfma_f32_16x16x32_bf16(af, bfr, acc[pb], 0, 0, 0); } }
#pragma unroll
        for (int pb = 0; pb < 8; ++pb) { const int p = 16 * pb + l15; const float bs = IN(I_OBS)[g * 128 + p]; const size_t off = (size_t)(row0 + p) * D + g * 128 + 16 * X.wave + 4 * g4;
            const u32x2 uw = *(const u32x2*)(U + off);
            u32x2 o; o.x = pk2(bf2f(uw.x & 0xffffu) * (acc[pb][0] + bs), bf2f(uw.x >> 16) * (acc[pb][1] + bs)); o.y = pk2(bf2f(uw.y & 0xffffu) * (acc[pb][2] + bs), bf2f(uw.y >> 16) * (acc[pb][3] + bs));
            *(u32x2*)(SG + off) = o; }
    }
}

enum { PH_PRO = 0, PH_MOD0, PH_GIN, PH_CONV, PH_ATT, PH_GOUT, PH_RT0, PH_M1_0, PH_M2_0, PH_CMB0, PH_GMI, PH_SPA, PH_GMO, PH_RT1, PH_M1_1, PH_M2_1, PH_CMB1, NPHASE };

__global__ void __launch_bounds__(NTHREADS, 2) mega(Args a) {
    extern __shared__ __attribute__((aligned(16))) unsigned char lds_raw[];
    Ctx X; X.lds = (LAS unsigned char*)lds_raw;
    const int wave0 = __builtin_amdgcn_readfirstlane((int)threadIdx.x >> 6);
    const int G0 = gridDim.x, bid0 = blockIdx.x; const int vcu0 = (G0 % 8 == 0) ? (bid0 % 8) * (G0 / 8) + bid0 / 8 : bid0;
    X.wave = wave0;
    volatile LAS unsigned* MISC = (volatile LAS unsigned*)(X.lds + MISC_OFF);
    if (threadIdx.x < 64) MISC[threadIdx.x] = 0u;
    __syncthreads();
    XcdBarrier bar = xcd_barrier_post((unsigned*)(a.ws + WS_CTL) + CW_BAR + a.li * XCD_BAR_WORDS, MISC + 8);
    const int ph_lo = a.ph_lo, ph_hi = a.ph_hi;
#if PROBE_PH >= 0
#define PROBE_STAMP(p) do { if ((p) == PROBE_PH) pr_t0 = __builtin_amdgcn_s_memrealtime(); if ((p) == PROBE_END) pr_t1 = __builtin_amdgcn_s_memrealtime(); } while (0)
#else
#define PROBE_STAMP(p) do { } while (0)
#endif
#define PH_ENTER() int z; asm volatile("s_mov_b32 %0, 0" : "=s"(z)); \
        X.lane = (int)__builtin_amdgcn_mbcnt_hi(~0u, __builtin_amdgcn_mbcnt_lo(~0u, (unsigned)z)); X.tid = wave0 * 64 + X.lane; \
        X.G = G0 + z; X.vcu = vcu0 + z; X.bid = bid0 + z; X.NGW = X.G * NWAVES; X.gw = X.vcu * NWAVES + wave0; \
        { kargp_t kp = (kargp_t)__builtin_amdgcn_kernarg_segment_ptr(); asm volatile("" : "+s"(kp)); X.kp = kp; } \
        unsigned char* ws = (unsigned char*)(__attribute__((address_space(1))) unsigned char*)X.kp[34] + z; X.ws = ws;
#if PROBE_PH >= 0
    unsigned long long pr_t0 = 0, pr_t1 = 0;
#endif
#define PH_RUN(PHK, ...) if (ph_lo <= (PHK) && (PHK) < ph_hi) { const int ph = (PHK); \
        if (ph != ph_lo) { const int l0 = (int)__builtin_amdgcn_mbcnt_hi(~0u, __builtin_amdgcn_mbcnt_lo(~0u, 0u)); xcd_barrier(bar, wave0 * 64 + l0); } \
        PROBE_STAMP(ph); __VA_ARGS__ }
    PH_RUN(PH_PRO, { PH_ENTER(); phase_prologue(a, X); })
    PH_RUN(PH_MOD0, { PH_ENTER(); phase_modulate0(a, X); })
    PH_RUN(PH_GIN, { PH_ENTER(); DenseSched S; S.init((const bf16*)(ws + WS_XA), (const bf16*)(ws + WS_WINT), NTOK, EVEN_IN, X.G, X.bid);
            S.A2 = (const bf16*)(ws + WS_GM); S.Bt2 = (const bf16*)(ws + WS_WINT) + (size_t)KV_COL * D; S.nM2 = NCTX / 256;
            EpiIn E{(bf16*)(ws + WS_GLU), (bf16*)(ws + WS_Q), (bf16*)(ws + WS_K), (bf16*)(ws + WS_V), (bf16*)(ws + WS_KC), (bf16*)(ws + WS_VC), IN(I_EBIN)};
            pg8::gemm_phase<EpiIn, DenseSched>(X.lds, S, E, X.tid); })
    PH_RUN(PH_CONV, { PH_ENTER(); phase_conv_qk(a, X); })
    PH_RUN(PH_ATT, { PH_ENTER(); phase_attention(a, X); })
    PH_RUN(PH_GOUT, { PH_ENTER(); DenseSched S; S.init((const bf16*)(ws + WS_MIX), (const bf16*)(ws + WS_WOUTT), NTOK, D, X.G, X.bid);
            EpiRes E{IN(I_X), (float*)(ws + WS_H), IN(I_EBOUT), (const float*)(ws + WS_MOD) + 2 * 1024};
            pg8::gemm_phase<EpiRes, DenseSched>(X.lds, S, E, X.tid); })
    PH_RUN(PH_RT0, { PH_ENTER(); phase_router(a, X, 0); })
    PH_RUN(PH_M1_0, { PH_ENTER(); const int l = (ph == PH_M1_1); moe_build_table(X, (const int*)(ws + WS_CTL) + CW_CNT + l * NE * CNT_STRIDE);
            MoeSchedT<true, 8> S; S.tab = (const LAS int*)(X.lds + TAB_OFF); S.G = X.G; S.c = X.vcu; S.A = (const unsigned char*)(ws + WS_XA8); S.Bt = (const unsigned char*)(ws + WS_W1T) + (size_t)l * NE * 2048 * 1024; S.list = (const int*)(ws + WS_LIST); S.meta = (const LAS int*)(X.lds + META_OFF);
            moe_stage_meta<false>(X, S, S.list, (const float*)nullptr, (LAS int*)(X.lds + META_OFF));
            EpiSwiglu E{(unsigned char*)(ws + WS_ACT), IN(I_B1) + (size_t)l * NE * 2048};
            pg8::gemm_phase<EpiSwiglu, MoeSchedT<true, 8>>(X.lds, S, E, X.tid); })
    PH_RUN(PH_M2_0, { PH_ENTER(); const int l = (ph == PH_M2_1); moe_build_table(X, (const int*)(ws + WS_CTL) + CW_CNT + l * NE * CNT_STRIDE);
            MoeSchedT<false, 4> S; S.tab = (const LAS int*)(X.lds + TAB_OFF); S.G = X.G; S.c = X.vcu; S.A = (const unsigned char*)(ws + WS_ACT); S.Bt = (const unsigned char*)(ws + WS_W2T) + (size_t)l * NE * 1024 * 1024; S.list = (const int*)(ws + WS_LIST); S.meta = (const LAS int*)(X.lds + META_OFF);
            moe_stage_meta<true>(X, S, S.list, (const float*)(ws + WS_GATE), (LAS int*)(X.lds + META_OFF));
            EpiDown E{(bf16*)(ws + WS_Y), IN(I_B2) + (size_t)l * NE * D, (const LAS int*)(X.lds + META_OFF)};
            pg8::gemm_phase<EpiDown, MoeSchedT<false, 4>>(X.lds, S, E, X.tid); })
    PH_RUN(PH_CMB0, { PH_ENTER(); phase_combine(a, X, 0); })
    PH_RUN(PH_GMI, { PH_ENTER(); DenseSched S; S.init((const bf16*)(ws + WS_XA), (const bf16*)(ws + WS_GWINT), NTOK, 2048, X.G, X.bid);
            EpiGelu E{(bf16*)(ws + WS_U), (bf16*)(ws + WS_VB), IN(I_OBIN), (float*)(ws + WS_CTL) + CW_VSTAT};
            pg8::gemm_phase<EpiGelu, DenseSched>(X.lds, S, E, X.tid); })
    PH_RUN(PH_SPA, { PH_ENTER(); phase_spatial(a, X); })
    PH_RUN(PH_GMO, { PH_ENTER(); DenseSched S; S.init((const bf16*)(ws + WS_MIX), (const bf16*)(ws + WS_GWOUTT), NTOK, D, X.G, X.bid);
            EpiRes E{(const float*)(ws + WS_H), (float*)(ws + WS_H), IN(I_OBOUT), (const float*)(ws + WS_MOD) + (size_t)9 * MODW + 2 * 1024};
            pg8::gemm_phase<EpiRes, DenseSched>(X.lds, S, E, X.tid); })
    PH_RUN(PH_RT1, { PH_ENTER(); phase_router(a, X, 1); })
    PH_RUN(PH_M1_1, { PH_ENTER(); const int l = (ph == PH_M1_1); moe_build_table(X, (const int*)(ws + WS_CTL) + CW_CNT + l * NE * CNT_STRIDE);
            MoeSchedT<true, 8> S; S.tab = (const LAS int*)(X.lds + TAB_OFF); S.G = X.G; S.c = X.vcu; S.A = (const unsigned char*)(ws + WS_XA8); S.Bt = (const unsigned char*)(ws + WS_W1T) + (size_t)l * NE * 2048 * 1024; S.list = (const int*)(ws + WS_LIST); S.meta = (const LAS int*)(X.lds + META_OFF);
            moe_stage_meta<false>(X, S, S.list, (const float*)nullptr, (LAS int*)(X.lds + META_OFF));
            EpiSwiglu E{(unsigned char*)(ws + WS_ACT), IN(I_B1) + (size_t)l * NE * 2048};
            pg8::gemm_phase<EpiSwiglu, MoeSchedT<true, 8>>(X.lds, S, E, X.tid); })
    PH_RUN(PH_M2_1, { PH_ENTER(); const int l = (ph == PH_M2_1); moe_build_table(X, (const int*)(ws + WS_CTL) + CW_CNT + l * NE * CNT_STRIDE);
            MoeSchedT<false, 4> S; S.tab = (const LAS int*)(X.lds + TAB_OFF); S.G = X.G; S.c = X.vcu; S.A = (const unsigned char*)(ws + WS_ACT); S.Bt = (const unsigned char*)(ws + WS_W2T) + (size_t)l * NE * 1024 * 1024; S.list = (const int*)(ws + WS_LIST); S.meta = (const LAS int*)(X.lds + META_OFF);
            moe_stage_meta<true>(X, S, S.list, (const float*)(ws + WS_GATE), (LAS int*)(X.lds + META_OFF));
            EpiDown E{(bf16*)(ws + WS_Y), IN(I_B2) + (size_t)l * NE * D, (const LAS int*)(X.lds + META_OFF)};
            pg8::gemm_phase<EpiDown, MoeSchedT<false, 4>>(X.lds, S, E, X.tid); })
    PH_RUN(PH_CMB1, { PH_ENTER(); phase_combine(a, X, 1); })
#if PROBE_PH == -2
    if (blockIdx.x == 0 && threadIdx.x == 0) { volatile LAS unsigned long long* pm_ = (volatile LAS unsigned long long*)(X.lds + MISC_OFF + 128); const unsigned long long te = __builtin_amdgcn_s_memrealtime(); const unsigned long long span = (pm_[1] - pm_[0]) * PROBE_MULT;
        while (__builtin_amdgcn_s_memrealtime() - te < span) __builtin_amdgcn_s_sleep(8); }
#endif
#if PROBE_PH >= 0
    if (pr_t1 == 0) pr_t1 = __builtin_amdgcn_s_memrealtime();
    if (blockIdx.x == 0 && wave0 == 0) { const unsigned long long te = __builtin_amdgcn_s_memrealtime(); const unsigned long long span = (pr_t1 - pr_t0) * PROBE_MULT;
        while (__builtin_amdgcn_s_memrealtime() - te < span) __builtin_amdgcn_s_sleep(8); }
#endif
}

__device__ __forceinline__ bool find_expert(const int* cnt, int s, int& e, int& slot) {
    int pb = 0;
    for (int i = 0; i < NE; ++i) { const int c = cnt[i * CNT_STRIDE]; const int pr = ((c + 255) >> 8) << 8; if (s < pb + pr) { e = i; slot = s - pb; return true; } pb += pr; }
    return false;
}
__global__ void __launch_bounds__(256) slow_gemm(const bf16* A, const int* arow, const bf16* Bt, float* C, int N, const int* cnt, size_t bstride) {
    __shared__ float As[16][65], Bs[16][65];
    const int tx = threadIdx.x & 15, ty = threadIdx.x >> 4; const int m0 = blockIdx.y * 64, n0 = blockIdx.x * 64;
    if (cnt) { int e, slot; if (!find_expert(cnt, m0, e, slot)) return; Bt += (size_t)e * bstride; }
    float acc[4][4];
    for (int i = 0; i < 4; ++i) for (int j = 0; j < 4; ++j) acc[i][j] = 0.f;
    for (int k0 = 0; k0 < 1024; k0 += 16) {
        for (int i = 0; i < 4; ++i) { const int idx = threadIdx.x + 256 * i; const int r = idx >> 4, kk = idx & 15; const int gm = m0 + r; const int ar = arow ? arow[gm] : gm;
            As[kk][r] = bf2f(A[(size_t)ar * 1024 + k0 + kk]); Bs[kk][r] = bf2f(Bt[(size_t)(n0 + r) * 1024 + k0 + kk]); }
        __syncthreads();
        for (int kk = 0; kk < 16; ++kk) { float av[4], bv[4];
            for (int i = 0; i < 4; ++i) { av[i] = As[kk][ty * 4 + i]; bv[i] = Bs[kk][tx * 4 + i]; }
            for (int i = 0; i < 4; ++i) for (int j = 0; j < 4; ++j) acc[i][j] += av[i] * bv[j]; }
        __syncthreads();
    }
    for (int i = 0; i < 4; ++i) for (int j = 0; j < 4; ++j) C[(size_t)(m0 + ty * 4 + i) * N + n0 + tx * 4 + j] = acc[i][j];
}
__device__ __forceinline__ unsigned short f2bf_s(float f) { return (unsigned short)(pk2(f, 0.f) & 0xffffu); }
__global__ void slow_epi_in(const float* C, const float* C2, const float* bias, bf16* GLU, bf16* Q, bf16* Kb, bf16* Vb, bf16* KC, bf16* VC) {
    const size_t i = (size_t)blockIdx.x * blockDim.x + threadIdx.x;
    if (i < (size_t)NTOK * 512) { const int row = (int)(i >> 9), j = (int)(i & 511); const int t = j >> 7, ii = j & 127; const float* cr = C + (size_t)row * EVEN_IN;
        const float u = cr[t * 256 + ii] + bias[j], g = cr[t * 256 + 128 + ii] + bias[512 + j];
        GLU[i] = f2bf_s(u / (1.0f + expf(-g)));
        Q[i] = f2bf_s(cr[1024 + j] + bias[1024 + j]);
        if (j < 128) { Kb[(size_t)row * 128 + j] = f2bf_s(cr[1536 + j] + bias[1536 + j]); Vb[(size_t)row * 128 + j] = f2bf_s(cr[1664 + j] + bias[1664 + j]); }
        if (row < NCTX && j < 128) { KC[(size_t)row * 128 + j] = f2bf_s(C2[(size_t)row * 256 + j] + bias[1536 + j]); VC[(size_t)row * 128 + j] = f2bf_s(C2[(size_t)row * 256 + 128 + j] + bias[1664 + j]); } }
}
__global__ void slow_epi_res(const float* C, const float* base, float* out, const float* bias, const float* gate) {
    const size_t i = (size_t)blockIdx.x * blockDim.x + threadIdx.x;
    if (i < (size_t)NTOK * D) { const int row = (int)(i >> 10), col = (int)(i & 1023); out[i] = base[i] + gate[(size_t)(row / SEQ) * MODW + col] * (C[i] + bias[col]); }
}
__global__ void slow_epi_gelu(const float* C, const float* bias, bf16* U, bf16* V) {
    const size_t i = (size_t)blockIdx.x * blockDim.x + threadIdx.x;
    if (i < (size_t)NTOK * 2048) { const int row = (int)(i >> 11), col = (int)(i & 2047); const float x = C[i] + bias[col]; const float y = 0.5f * x * (1.0f + erff(x * 0.70710678118654752f));
        if (col < 1024) U[(size_t)row * D + col] = f2bf_s(y); else V[(size_t)row * D + col - 1024] = f2bf_s(y); }
}
__global__ void slow_arow(const int* cnt, const int* list, int* arow) {
    const int s = blockIdx.x * blockDim.x + threadIdx.x; if (s >= ACT_ROWS) return;
    int e, slot; int r = 0; if (find_expert(cnt, s, e, slot) && slot < cnt[e * CNT_STRIDE]) r = list[(size_t)e * NTOK + slot] >> 2;
    arow[s] = r;
}
__global__ void slow_epi_swiglu(const float* C, const int* cnt, const float* b1, bf16* ACT) {
    const size_t i = (size_t)blockIdx.x * blockDim.x + threadIdx.x;
    if (i < (size_t)ACT_ROWS * 1024) { const int s = (int)(i >> 10), j = (int)(i & 1023); int e, slot; if (!find_expert(cnt, s, e, slot)) return;
        const int t = j >> 7, ii = j & 127; const float* cr = C + (size_t)s * 2048;
        float g = cr[t * 256 + ii] + b1[(size_t)e * 2048 + j], up = cr[t * 256 + 128 + ii] + b1[(size_t)e * 2048 + 1024 + j];
        g = fminf(g, 7.0f); up = fminf(fmaxf(up, -7.0f), 7.0f);
        ACT[i] = f2bf_s((up + 1.0f) * g / (1.0f + expf(-1.702f * g))); }
}
__global__ void slow_epi_down(const float* C, const int* cnt, const int* list, const float* gatew, const float* b2, bf16* Y) {
    const size_t i = (size_t)blockIdx.x * blockDim.x + threadIdx.x;
    if (i < (size_t)ACT_ROWS * 1024) { const int s = (int)(i >> 10), col = (int)(i & 1023); int e, slot; if (!find_expert(cnt, s, e, slot) || slot >= cnt[e * CNT_STRIDE]) return;
        const int aid = list[(size_t)e * NTOK + slot]; Y[(size_t)aid * D + col] = f2bf_s((C[i] + b2[(size_t)e * D + col]) * gatew[aid]); }
}
__global__ void __launch_bounds__(64) slow_attention(const bf16* QN, const bf16* KN, const bf16* VV, const bf16* KC, const bf16* VC, const float* sink, bf16* MIX) {
    const int i = blockIdx.x * blockDim.x + threadIdx.x; if (i >= NTOK * 8) return;
    const int row = i >> 3, h = i & 7, kh = h >> 2, b = row / SEQ, t = row % SEQ;
    float q[64], o[64];
    for (int d = 0; d < 64; ++d) { q[d] = bf2f(QN[(size_t)row * 512 + h * 64 + d]); o[d] = 0.f; }
    float m = sink[h] * LOG2E, l = 1.0f;
    const int j0 = t - 128 < 0 ? 0 : t - 128, j1 = t + 128 > SEQ - 1 ? SEQ - 1 : t + 128;
    for (int jj = j0; jj <= j1 + CTXL; ++jj) {
        const bf16* kp; const bf16* vp;
        if (jj <= j1) { kp = KN + (size_t)(b * SEQ + jj) * 128 + kh * 64; vp = VV + (size_t)(b * SEQ + jj) * 128 + kh * 64; }
        else { const int c = jj - j1 - 1; kp = KC + (size_t)(b * CTXL + c) * 128 + kh * 64; vp = VC + (size_t)(b * CTXL + c) * 128 + kh * 64; }
        float s = 0.f; for (int d = 0; d < 64; ++d) s += q[d] * bf2f(kp[d]);
        const float mn = fmaxf(m, s), al = exp2f(m - mn), p = exp2f(s - mn); m = mn; l = l * al + p;
        for (int d = 0; d < 64; ++d) o[d] = o[d] * al + p * bf2f(vp[d]);
    }
    for (int d = 0; d < 64; ++d) MIX[(size_t)row * D + 512 + h * 64 + d] = f2bf_s(o[d] / l);
}
__global__ void slow_vstats(const bf16* VB, float* stat) {
    const int row = blockIdx.x * blockDim.x + threadIdx.x; if (row >= NTOK) return;
    float s = 0.f; for (int c = 0; c < D; ++c) s += bf2f(VB[(size_t)row * D + c]); const float mean = s / D;
    float s2 = 0.f; for (int c = 0; c < D; ++c) { const float d = bf2f(VB[(size_t)row * D + c]) - mean; s2 += d * d; }
    stat[2 * row] = mean; stat[2 * row + 1] = rsqrtf(s2 / D + EPS);
}
__global__ void slow_spatial(const bf16* U, const bf16* VB, const float* stat, const float* ws, const float* bs, const float* lng, const float* lnb, bf16* SG) {
    const size_t i = (size_t)blockIdx.x * blockDim.x + threadIdx.x;
    if (i < (size_t)NTOK * D) { const int row = (int)(i >> 10), ch = (int)(i & 1023); const int g = ch >> 7, p = row & 127, r0 = row - p;
        float s = 0.f;
        for (int q = 0; q < 128; ++q) { const float vn = (bf2f(VB[(size_t)(r0 + q) * D + ch]) - stat[2 * (r0 + q)]) * stat[2 * (r0 + q) + 1] * lng[ch] + lnb[ch]; s += ws[((size_t)g * 128 + p) * 128 + q] * vn; }
        SG[i] = f2bf_s(bf2f(U[i]) * (s + bs[g * 128 + p])); }
}

static void launch_mega(Args& a, int lo, int hi, int& li, int grid, hipStream_t stream) {
    a.ph_lo = lo; a.ph_hi = hi; a.li = li++;
    hipLaunchKernelGGL(mega, dim3(grid), dim3(NTHREADS), LDS_BYTES, stream, a);
}
extern "C" void kernel_launch(void* const* d_in, const int* in_sizes, int n_in, void* d_out, int out_size, void* d_ws, size_t ws_size, hipStream_t stream) {
    static int grid = 0;
    if (grid == 0) {
        if (n_in != 33 || out_size != NTOK * D || ws_size < WS_END) { fprintf(stderr, "kernel_launch: unexpected problem (n_in %d, out %d, ws %zu)\n", n_in, out_size, ws_size); grid = -1; return; }
        int dev = 0, cus = 0, per_cu = 0;
        if (hipGetDevice(&dev) != hipSuccess || hipDeviceGetAttribute(&cus, hipDeviceAttributeMultiprocessorCount, dev) != hipSuccess) { grid = -1; return; }
        if (hipFuncSetAttribute((const void*)mega, hipFuncAttributeMaxDynamicSharedMemorySize, LDS_BYTES) != hipSuccess) { fprintf(stderr, "kernel_launch: hipFuncSetAttribute failed\n"); grid = -1; return; }
        if (hipOccupancyMaxActiveBlocksPerMultiprocessor(&per_cu, (const void*)mega, NTHREADS, LDS_BYTES) != hipSuccess || per_cu < 1) { fprintf(stderr, "kernel_launch: occupancy query says %d blocks per CU\n", per_cu); per_cu = 1; }
        (void)hipGetLastError();
        grid = cus;
    }
    if (grid < 0) return;
    unsigned char* ws = (unsigned char*)d_ws;
    (void)hipMemsetAsync(ws + WS_CTL, 0, CTL_ZERO_BYTES, stream);
    Args a{};
    for (int i = 0; i < 33; ++i) a.in[i] = (const float*)d_in[i];
    a.out = (float*)d_out; a.ws = ws;
    int li = 0;
    const float* in_[33]; for (int i = 0; i < 33; ++i) in_[i] = (const float*)d_in[i];
    float* CF = (float*)(ws + WS_CF); float* MOD = (float*)(ws + WS_MOD); int* CNT = (int*)(ws + WS_CTL) + CW_CNT;
    int lo = 0;
    auto flush = [&](int upto) { if (upto > lo) launch_mega(a, lo, upto, li, grid, stream); };
    for (int ph = 0; ph < NPHASE; ++ph) {
        bool slow = false;
        switch (ph) {
        case PH_GIN: slow = SLOW_MASK & 1; break;
        case PH_ATT: slow = SLOW_MASK & 2; break;
        case PH_GOUT: case PH_GMO: slow = SLOW_MASK & 4; break;
        case PH_M1_0: case PH_M1_1: slow = SLOW_MASK & 8; break;
        case PH_M2_0: case PH_M2_1: slow = SLOW_MASK & 16; break;
        case PH_GMI: slow = SLOW_MASK & 32; break;
        case PH_SPA: slow = SLOW_MASK & 64; break;
        default: break;
        }
        if (!slow) continue;
        flush(ph); lo = ph + 1;
        const int l = (ph == PH_M1_1 || ph == PH_M2_1) ? 1 : 0;
        switch (ph) {
        case PH_GIN:
            hipLaunchKernelGGL(slow_gemm, dim3(EVEN_IN / 64, NTOK / 64), dim3(256), 0, stream, (const bf16*)(ws + WS_XA), (const int*)nullptr, (const bf16*)(ws + WS_WINT), CF, EVEN_IN, (const int*)nullptr, (size_t)0);
            hipLaunchKernelGGL(slow_gemm, dim3(256 / 64, NCTX / 64), dim3(256), 0, stream, (const bf16*)(ws + WS_GM), (const int*)nullptr, (const bf16*)(ws + WS_WINT) + (size_t)KV_COL * D, CF + (size_t)NTOK * EVEN_IN, 256, (const int*)nullptr, (size_t)0);
            hipLaunchKernelGGL(slow_epi_in, dim3(NTOK * 512 / 256), dim3(256), 0, stream, (const float*)CF, (const float*)(CF + (size_t)NTOK * EVEN_IN), in_[I_EBIN], (bf16*)(ws + WS_GLU), (bf16*)(ws + WS_Q), (bf16*)(ws + WS_K), (bf16*)(ws + WS_V), (bf16*)(ws + WS_KC), (bf16*)(ws + WS_VC));
            break;
        case PH_ATT:
            hipLaunchKernelGGL(slow_attention, dim3(NTOK * 8 / 64), dim3(64), 0, stream, (const bf16*)(ws + WS_Q), (const bf16*)(ws + WS_K), (const bf16*)(ws + WS_V), (const bf16*)(ws + WS_KC), (const bf16*)(ws + WS_VC), in_[I_SINK], (bf16*)(ws + WS_MIX));
            break;
        case PH_GOUT:
            hipLaunchKernelGGL(slow_gemm, dim3(D / 64, NTOK / 64), dim3(256), 0, stream, (const bf16*)(ws + WS_MIX), (const int*)nullptr, (const bf16*)(ws + WS_WOUTT), CF, D, (const int*)nullptr, (size_t)0);
            hipLaunchKernelGGL(slow_epi_res, dim3(NTOK * D / 256), dim3(256), 0, stream, (const float*)CF, in_[I_X], (float*)(ws + WS_H), in_[I_EBOUT], (const float*)(MOD + 2 * 1024));
            break;
        case PH_GMO:
            hipLaunchKernelGGL(slow_gemm, dim3(D / 64, NTOK / 64), dim3(256), 0, stream, (const bf16*)(ws + WS_MIX), (const int*)nullptr, (const bf16*)(ws + WS_GWOUTT), CF, D, (const int*)nullptr, (size_t)0);
            hipLaunchKernelGGL(slow_epi_res, dim3(NTOK * D / 256), dim3(256), 0, stream, (const float*)CF, (const float*)(ws + WS_H), (float*)(ws + WS_H), in_[I_OBOUT], (const float*)(MOD + (size_t)9 * MODW + 2 * 1024));
            break;
        case PH_M1_0: case PH_M1_1:
            hipLaunchKernelGGL(slow_arow, dim3(ACT_ROWS / 256), dim3(256), 0, stream, (const int*)(CNT + l * NE * CNT_STRIDE), (const int*)(ws + WS_LIST), (int*)(ws + WS_AROW));
            hipLaunchKernelGGL(slow_gemm, dim3(2048 / 64, ACT_ROWS / 64), dim3(256), 0, stream, (const bf16*)(ws + WS_XA), (const int*)(ws + WS_AROW), (const bf16*)(ws + WS_W1T) + (size_t)l * NE * 2048 * 1024, CF, 2048, (const int*)(CNT + l * NE * CNT_STRIDE), (size_t)2048 * 1024);
            hipLaunchKernelGGL(slow_epi_swiglu, dim3(ACT_ROWS * 1024 / 256), dim3(256), 0, stream, (const float*)CF, (const int*)(CNT + l * NE * CNT_STRIDE), in_[I_B1] + (size_t)l * NE * 2048, (bf16*)(ws + WS_ACT));
            break;
        case PH_M2_0: case PH_M2_1:
            hipLaunchKernelGGL(slow_gemm, dim3(1024 / 64, ACT_ROWS / 64), dim3(256), 0, stream, (const bf16*)(ws + WS_ACT), (const int*)nullptr, (const bf16*)(ws + WS_W2T) + (size_t)l * NE * 1024 * 1024, CF, 1024, (const int*)(CNT + l * NE * CNT_STRIDE), (size_t)1024 * 1024);
            hipLaunchKernelGGL(slow_epi_down, dim3(ACT_ROWS * 1024 / 256), dim3(256), 0, stream, (const float*)CF, (const int*)(CNT + l * NE * CNT_STRIDE), (const int*)(ws + WS_LIST), (const float*)(ws + WS_GATE), in_[I_B2] + (size_t)l * NE * D, (bf16*)(ws + WS_Y));
            break;
        case PH_GMI:
            hipLaunchKernelGGL(slow_gemm, dim3(2048 / 64, NTOK / 64), dim3(256), 0, stream, (const bf16*)(ws + WS_XA), (const int*)nullptr, (const bf16*)(ws + WS_GWINT), CF, 2048, (const int*)nullptr, (size_t)0);
            hipLaunchKernelGGL(slow_epi_gelu, dim3(NTOK * 2048 / 256), dim3(256), 0, stream, (const float*)CF, in_[I_OBIN], (bf16*)(ws + WS_U), (bf16*)(ws + WS_VB));
            break;
        case PH_SPA:
            hipLaunchKernelGGL(slow_vstats, dim3(NTOK / 64), dim3(64), 0, stream, (const bf16*)(ws + WS_VB), CF);
            hipLaunchKernelGGL(slow_spatial, dim3(NTOK * D / 256), dim3(256), 0, stream, (const bf16*)(ws + WS_U), (const bf16*)(ws + WS_VB), (const float*)CF, in_[I_OWS], in_[I_OBS], in_[I_OLNG], in_[I_OLNB], (bf16*)(ws + WS_MIX));
            break;
        default: break;
        }
    }
    flush(NPHASE);
}
```

```cpp
#include <hip/hip_runtime.h>
#include <cstdio>
#include <cstdint>

#ifndef SLOW_MASK
#define SLOW_MASK 0x00
#endif

#ifndef EXP_STREAM
#define EXP_STREAM 0
#endif
#ifndef PROBE_PH
#define PROBE_PH (-1)
#endif
#ifndef PROBE_END
#define PROBE_END (PROBE_PH + 1)
#endif
#ifndef PROBE_A
#define PROBE_A (-1)
#define PROBE_B (-1)
#endif
#ifndef PROBE_MULT
#define PROBE_MULT 4
#endif

#define LAS __attribute__((address_space(3)))
typedef unsigned short bf16;
typedef short bf16x8 __attribute__((ext_vector_type(8)));
typedef float f32x4 __attribute__((ext_vector_type(4)));
typedef float f32x2 __attribute__((ext_vector_type(2)));
typedef unsigned u32x4 __attribute__((ext_vector_type(4)));
typedef unsigned u32x2 __attribute__((ext_vector_type(2)));
typedef __bf16 bf16x2_t __attribute__((ext_vector_type(2)));

constexpr int NB = 8, SEQ = 2048, D = 1024, NTOK = NB * SEQ, CTXL = 256, NCTX = NB * CTXL;
constexpr int NE = 32, TOPK = 4, NASSIGN = NTOK * TOPK, ACT_ROWS = NASSIGN + NE * 256;
constexpr int EVEN_IN = 1792, KV_COL = 1536;
constexpr float EPS = 1e-6f, LOG2E = 1.4426950408889634f;
constexpr float QSCALE = 0.125f * LOG2E;
constexpr int MODW = 6 * D;
constexpr int NWAVES = 8, NTHREADS = 512;

constexpr size_t MiB = 1u << 20;
constexpr size_t WS_CTL = 0, CTL_ZERO_BYTES = 1 * MiB;
constexpr size_t WS_MOD = 1 * MiB;
constexpr size_t WS_LIST = 2 * MiB;
constexpr size_t WS_GATE = 4 * MiB;
constexpr size_t WS_WSB = 5 * MiB;
constexpr size_t WS_WINT = 6 * MiB;
constexpr size_t WS_WOUTT = 10 * MiB;
constexpr size_t WS_GWINT = 12 * MiB;
constexpr size_t WS_GWOUTT = 16 * MiB;
constexpr size_t WS_KC = 18 * MiB;
constexpr size_t WS_VC = 18 * MiB + 512 * 1024;
constexpr size_t WS_K = 19 * MiB;
constexpr size_t WS_V = 23 * MiB;
constexpr size_t WS_GM = 27 * MiB;
constexpr size_t WS_AROW = 31 * MiB;
constexpr size_t WS_Q = 32 * MiB;
constexpr size_t WS_GLU = 48 * MiB;
constexpr size_t WS_XA = 64 * MiB;
constexpr size_t WS_MIX = 96 * MiB;
constexpr size_t WS_H = 128 * MiB;
constexpr size_t WS_U = 192 * MiB;
constexpr size_t WS_VB = 224 * MiB;
constexpr size_t WS_W1T = 256 * MiB;
constexpr size_t WS_W2T = 512 * MiB;
constexpr size_t WS_ACT = 640 * MiB;
constexpr size_t WS_Y = 784 * MiB;
constexpr size_t WS_XA8 = 912 * MiB;
constexpr size_t WS_CF = 928 * MiB;
constexpr size_t WS_END = 1504 * MiB;
constexpr int CW_BAR = 4096, CW_CNT = 131072, CNT_STRIDE = 64  , CW_VSTAT = 147456;
constexpr int MAX_LAUNCH = 20;

constexpr int RING_BYTES = 131072;
constexpr int MISC_OFF = RING_BYTES;
constexpr int TAB_OFF = RING_BYTES + 256;
constexpr int META_OFF = RING_BYTES + 3072;
constexpr int BIAS_OFF = META_OFF + 10240;
constexpr int LDS_BYTES = 163840;

#define LDS_WAIT() asm volatile("s_waitcnt lgkmcnt(0)" ::: "memory")
#define VM_WAIT() asm volatile("s_waitcnt vmcnt(0)" ::: "memory")

__device__ __forceinline__ float bf2f(unsigned b) { return __uint_as_float(b << 16); }
__device__ __forceinline__ unsigned pk2(float lo, float hi) { f32x2 v = {lo, hi}; bf16x2_t b = __builtin_convertvector(v, bf16x2_t); return __builtin_bit_cast(unsigned, b); }
template <int CTRL, int ROW_MASK> __device__ __forceinline__ float dpp_f(float old, float src) { return __builtin_bit_cast(float, __builtin_amdgcn_update_dpp(__builtin_bit_cast(int, old), __builtin_bit_cast(int, src), CTRL, ROW_MASK, 0xf, false)); }
__device__ __forceinline__ unsigned pk4_fp8(float a, float b, float c, float d) { int w = 0; w = __builtin_amdgcn_cvt_pk_fp8_f32(a, b, w, false); w = __builtin_amdgcn_cvt_pk_fp8_f32(c, d, w, true); return (unsigned)w; }
__device__ __forceinline__ float wave_sum(float v) {
    v += dpp_f<0xB1, 0xf>(0.f, v);
    v += dpp_f<0x4E, 0xf>(0.f, v);
    v += dpp_f<0x141, 0xf>(0.f, v);
    v += dpp_f<0x140, 0xf>(0.f, v);
    v += dpp_f<0x142, 0xa>(0.f, v);
    v += dpp_f<0x143, 0xc>(0.f, v);
    return __builtin_bit_cast(float, __builtin_amdgcn_readlane(__builtin_bit_cast(int, v), 63));
}
__device__ __forceinline__ float dpp_swap32(float v) { return __shfl_xor(v, 32); }
__device__ __forceinline__ float sigmoidf_(float x) { return __builtin_amdgcn_rcpf(1.0f + __builtin_amdgcn_exp2f(-x * LOG2E)); }

#define XB_TMO      128
#define XB_XCNT(j)  (256  + 64 * (j))
#define XB_XSUB(j)  (1280 + 64 * (j))
#define XB_XGEN(j)  (2304 + 64 * (j))
#define XB_TOP      3328
#define XB_TOPGEN   3392
#define XCD_BAR_WORDS 3456
#define XB_SPIN_CAP (1u << 20)
__device__ __forceinline__ unsigned xb_ld(unsigned* p)              { return __hip_atomic_load(p, __ATOMIC_RELAXED, __HIP_MEMORY_SCOPE_AGENT); }
__device__ __forceinline__ unsigned xb_add(unsigned* p, unsigned v) { return __hip_atomic_fetch_add(p, v, __ATOMIC_RELAXED, __HIP_MEMORY_SCOPE_AGENT); }
__device__ __forceinline__ unsigned xb_xcc_id() { return (unsigned)__builtin_amdgcn_s_getreg((3 << 11) | 20) & 0xFu; }
#define XB_SPIN(cond, bar) do { unsigned _sp = 0; while (cond) { __builtin_amdgcn_s_sleep(1); \
    if ((++_sp & 255u) == 0u) { if (xb_ld(&(bar)[XB_TMO])) break; if (_sp > XB_SPIN_CAP) { atomicAdd(&(bar)[XB_TMO], 1u); break; } } } } while (0)
struct XcdBarrier { unsigned* bar; unsigned x; volatile LAS unsigned* st; };
__device__ __forceinline__ XcdBarrier xcd_barrier_post(unsigned* bar, volatile LAS unsigned* st) {
    XcdBarrier b; b.bar = bar; b.x = xb_xcc_id(); b.st = st;
    if (threadIdx.x == 0) (void)xb_add(&bar[XB_XCNT(b.x)], 1u);
    return b;
}
__device__ __forceinline__ void xcd_barrier_complete(unsigned* bar, unsigned x, unsigned& nloc, unsigned& nx) {
    const unsigned G = gridDim.x * gridDim.y * gridDim.z;
    unsigned sum, cnt, mine, sp = 0u;
    for (;;) {
        sum = 0u; cnt = 0u; mine = 0u;
#pragma unroll
        for (unsigned j = 0; j < 16; ++j) { const unsigned c = xb_ld(&bar[XB_XCNT(j)]); sum += c; cnt += (c > 0u) ? 1u : 0u; mine = (j == x) ? c : mine; }
        if (sum == G) break;
        __builtin_amdgcn_s_sleep(1);
        if ((++sp & 255u) == 0u) { if (xb_ld(&bar[XB_TMO])) break; if (sp > XB_SPIN_CAP) { atomicAdd(&bar[XB_TMO], 1u); break; } }
    }
    nloc = mine > 0u ? mine : 1u; nx = cnt > 0u ? cnt : 1u;
}
__device__ __forceinline__ void xcd_barrier(const XcdBarrier& b, const int tid) {
    asm volatile("s_waitcnt vmcnt(0)" ::: "memory");
    __syncthreads();
    if (tid == 0) {
        unsigned* bar = b.bar;
        __builtin_amdgcn_s_waitcnt(0);
        unsigned nloc = b.st[0], nx = b.st[1];
        if (nloc == 0u) { xcd_barrier_complete(bar, b.x, nloc, nx); b.st[0] = nloc; b.st[1] = nx; }
        const unsigned old = xb_add(&bar[XB_XSUB(b.x)], 1u);
        const unsigned gen = old / nloc;
        if (old + 1u == (gen + 1u) * nloc) {
            __builtin_amdgcn_fence(__ATOMIC_RELEASE, "agent");
            asm volatile("s_waitcnt vmcnt(0)" ::: "memory");
            const unsigned og = xb_add(&bar[XB_TOP], 1u);
            const unsigned tg = og / nx;
            if (og + 1u == (tg + 1u) * nx) xb_add(&bar[XB_TOPGEN], 1u);
            else XB_SPIN(xb_ld(&bar[XB_TOPGEN]) == tg, bar);
            __builtin_amdgcn_fence(__ATOMIC_ACQUIRE, "agent");
            xb_add(&bar[XB_XGEN(b.x)], 1u);
            asm volatile("s_waitcnt vmcnt(0)" ::: "memory");
        } else {
            XB_SPIN(xb_ld(&bar[XB_XGEN(b.x)]) == gen, bar);
            __builtin_amdgcn_fence(__ATOMIC_ACQUIRE, "agent");
            asm volatile("s_waitcnt vmcnt(0)" ::: "memory");
        }
    }
    __syncthreads();
}

constexpr float FP8_WMUL = 32.0f, FP8_AMUL = 4.0f, FP8_DESCALE = 1.0f / (32.0f * 4.0f);
#if PROBE_PH == -2
#define GMARK(k) do { if (Sched::GATHER && ui == 0 && blockIdx.x == 0 && tid == 0) { volatile LAS unsigned long long* pm_ = (volatile LAS unsigned long long*)(lds + MISC_OFF + 128); \
    if ((k) == PROBE_A) pm_[0] = __builtin_amdgcn_s_memrealtime(); if ((k) == PROBE_B) pm_[1] = __builtin_amdgcn_s_memrealtime(); } } while (0)
#define GMARK1(k) do { if (Sched::GATHER && ui == 1 && blockIdx.x == 0 && tid == 0) { volatile LAS unsigned long long* pm_ = (volatile LAS unsigned long long*)(lds + MISC_OFF + 128); \
    if ((k) == PROBE_A) pm_[0] = __builtin_amdgcn_s_memrealtime(); if ((k) == PROBE_B) pm_[1] = __builtin_amdgcn_s_memrealtime(); } } while (0)
#else
#define GMARK(k) do { } while (0)
#define GMARK1(k) do { } while (0)
#endif
namespace pg8 {
constexpr int BM = 256, BK = 64, HALF = 128, HTB = HALF * BK * 2, STAGE_BYTES = 8 * HTB, KD = 1024  ;
__host__ __device__ __forceinline__ int lds_byte(int r, int c) { const int st = (r >> 4) * 2 + (c >> 5), rr = r & 15, cc = c & 31, ob = rr * 64 + cc * 2; return st * 1024 + (ob ^ (((ob >> 9) & 1) << 5)); }
__host__ __device__ __forceinline__ void stage_rc(int b, int& R, int& C) { const int st = b / 1024, sb = b % 1024, swz = sb ^ (((sb >> 9) & 1) << 5); R = (st >> 1) * 16 + swz / 64; C = (st & 1) * 32 + (swz % 64) / 2; }
__host__ __device__ __forceinline__ int perm32(int rho) { const int n = rho >> 4, i = rho & 15; return 8 * (i >> 2) + 4 * n + (i & 3); }

typedef int v8i_t __attribute__((ext_vector_type(8)));
__device__ __forceinline__ v8i_t cat8(bf16x8 a, bf16x8 b) { typedef int v4i_t __attribute__((ext_vector_type(4))); const v4i_t x = __builtin_bit_cast(v4i_t, a), y = __builtin_bit_cast(v4i_t, b); return __builtin_shufflevector(x, y, 0, 1, 2, 3, 4, 5, 6, 7); }
struct Unit { int pm, pn, e, cnt, idx; };

template <class Epi, class Sched>
__device__ __forceinline__ void gemm_phase(LAS unsigned char* lds, const Sched& S, const Epi& E, const int tid) {
    const int wid = __builtin_amdgcn_readfirstlane(tid >> 6), lane = tid & 63, wr = wid >> 2, wc = wid & 3, fr = lane & 15, fq = lane >> 4;
    constexpr int RP = Sched::FP8 ? 1024 : 2048  , nt = RP / 128;
    int Rr[2], Cc[2];
    unsigned voffA[2][2], voffB[2];
#pragma unroll
    for (int i = 0; i < 2; ++i) { stage_rc(tid * 16 + i * 8192, Rr[i], Cc[i]); const int Rb = Epi::PERM ? ((Rr[i] & ~31) + perm32(Rr[i] & 31)) : Rr[i];
        voffB[i] = (unsigned)(Rb * RP + Cc[i] * 2); }
    constexpr size_t kstep = (size_t)(BK * 2);
    constexpr size_t hstep = (size_t)HALF * RP;
    const unsigned ldsw = (unsigned)wid * 1024u;
    const int aoff = lds_byte(wr * 64 + fr, fq * 8), boff = lds_byte(wc * 32 + fr, fq * 8);
#define PG8_SA(b, h) (((b) * 2 + (h)) * HTB)
#define PG8_SB(b, h) ((4 + (b) * 2 + (h)) * HTB)
#define PG8_STAGE(bufoff, gbase, voff) do { _Pragma("unroll") for (int _i = 0; _i < 2; ++_i) \
        __builtin_amdgcn_global_load_lds((const unsigned*)((const char*)(gbase) + (voff)[_i]), (LAS unsigned*)(lds + (bufoff) + ldsw + _i * 8192), 16, 0, 0); } while (0)
#define PG8_STAGEA1(bufoff, gbase) do { if constexpr (Sched::GATHER) { PG8_STAGE(bufoff, gbase, voffA[1]); } else { PG8_STAGE(bufoff, (gbase) + hstep, voffA[0]); } } while (0)
#define PG8_LDA(dst, b, h) do { _Pragma("unroll") for (int m = 0; m < 4; ++m) _Pragma("unroll") for (int k = 0; k < 2; ++k) dst[m][k] = *(const LAS bf16x8*)(lds + PG8_SA(b, h) + aoff + m * 2048 + k * 1024); } while (0)
#define PG8_LDB(dst, b, h) do { _Pragma("unroll") for (int n = 0; n < 2; ++n) _Pragma("unroll") for (int k = 0; k < 2; ++k) dst[n][k] = *(const LAS bf16x8*)(lds + PG8_SB(b, h) + boff + n * 2048 + k * 1024); } while (0)
#define PG8_MMA(ai, bj, At, Bt) do { __builtin_amdgcn_s_setprio(1); _Pragma("unroll") for (int m = 0; m < 4; ++m) _Pragma("unroll") for (int n = 0; n < 2; ++n) { \
        if constexpr (Sched::FP8) { acc[ai][bj][m][n] = __builtin_amdgcn_mfma_scale_f32_16x16x128_f8f6f4(cat8(Bt[n][0], Bt[n][1]), cat8(At[m][0], At[m][1]), acc[ai][bj][m][n], 0, 0, 0, 0, 0, 0); } \
        else { _Pragma("unroll") for (int k = 0; k < 2; ++k) acc[ai][bj][m][n] = __builtin_amdgcn_mfma_f32_16x16x32_bf16(Bt[n][k], At[m][k], acc[ai][bj][m][n], 0, 0, 0); } } \
        __builtin_amdgcn_s_setprio(0); } while (0)
#define PG8_WAIT_V(n) asm volatile("s_waitcnt vmcnt(" #n ")" ::: "memory")
#define PG8_WAIT_L(n) asm volatile("s_waitcnt lgkmcnt(" #n ")" ::: "memory")
#define PG8_BAR __builtin_amdgcn_s_barrier()
#define PG8_SCHED __builtin_amdgcn_sched_barrier(0)
    Unit cur, nxt; int ui = 0;
    if (!S.next(0, cur)) return;
    S.a_voff(cur, voffA, Rr, Cc);
    f32x4 acc[2][2][4][2];
#pragma unroll
    for (int a = 0; a < 2; ++a)
#pragma unroll
        for (int b = 0; b < 2; ++b)
#pragma unroll
            for (int m = 0; m < 4; ++m)
#pragma unroll
                for (int n = 0; n < 2; ++n) acc[a][b][m][n] = (f32x4){0.f, 0.f, 0.f, 0.f};
    bf16x8 At[4][2], B0[2][2], B1[2][2];
    const char* cA = S.a_ptr(cur); const char* cB = S.b_ptr(cur);
    PG8_STAGE(PG8_SB(0, 0), cB, voffB); PG8_STAGE(PG8_SB(0, 1), cB + hstep, voffB); PG8_STAGE(PG8_SA(0, 0), cA, voffA[0]); PG8_STAGEA1(PG8_SA(0, 1), cA);
    if (wr == 1) PG8_BAR;
    PG8_WAIT_V(2); PG8_BAR;
    PG8_STAGE(PG8_SB(1, 0), cB + kstep, voffB); PG8_STAGE(PG8_SA(1, 0), cA + kstep, voffA[0]); PG8_STAGE(PG8_SB(1, 1), cB + hstep + kstep, voffB);
    PG8_WAIT_V(6); PG8_BAR;
    for (;;) {
        const bool has_next = S.next(ui + 1, nxt);
        const char* nA = has_next ? S.a_ptr(nxt) : cA; const char* nB = has_next ? S.b_ptr(nxt) : cB;
#pragma unroll 1
        for (int t = 0; t < nt; t += 2) {
            const bool last = (t == nt - 2);
            if (last) GMARK(40); if (t == 2) GMARK1(45);
            const char* a1 = cA + (size_t)(t + 1) * kstep;
            const char* a2 = last ? nA : cA + (size_t)(t + 2) * kstep; const char* b2 = last ? nB : cB + (size_t)(t + 2) * kstep;
            const char* a3 = a2 + kstep; const char* b3 = b2 + kstep;
            asm volatile("" : "+s"(a1), "+s"(a2), "+s"(a3), "+s"(b2), "+s"(b3));
            PG8_LDB(B0, 0, 0); PG8_LDB(B1, 0, 1); PG8_SCHED; PG8_LDA(At, 0, 0); PG8_STAGEA1(PG8_SA(1, 1), a1);
            if (Sched::GATHER) { if (last && has_next) S.a_voff(nxt, voffA, Rr, Cc); }
            PG8_WAIT_V(8); PG8_WAIT_L(0); PG8_BAR; PG8_MMA(0, 0, At, B0); PG8_MMA(0, 1, At, B1); PG8_BAR; PG8_SCHED;
            PG8_LDA(At, 0, 1); PG8_STAGE(PG8_SB(0, 0), b2, voffB); PG8_STAGE(PG8_SB(0, 1), b2 + hstep, voffB); PG8_STAGE(PG8_SA(0, 0), a2, voffA[0]);
            PG8_WAIT_V(8); PG8_WAIT_L(0); PG8_BAR; PG8_MMA(1, 0, At, B0); PG8_MMA(1, 1, At, B1); PG8_BAR; PG8_SCHED;
            PG8_LDB(B0, 1, 0); PG8_LDB(B1, 1, 1); PG8_SCHED; PG8_LDA(At, 1, 0); PG8_STAGEA1(PG8_SA(0, 1), a2);
            PG8_WAIT_V(8); PG8_WAIT_L(0); PG8_BAR; PG8_MMA(0, 0, At, B0); PG8_MMA(0, 1, At, B1); PG8_BAR; PG8_SCHED;
            PG8_LDA(At, 1, 1); PG8_STAGE(PG8_SB(1, 0), b3, voffB); PG8_STAGE(PG8_SB(1, 1), b3 + hstep, voffB); PG8_STAGE(PG8_SA(1, 0), a3, voffA[0]);
            PG8_WAIT_V(8); PG8_WAIT_L(0); PG8_BAR; PG8_MMA(1, 0, At, B0); PG8_MMA(1, 1, At, B1); PG8_BAR; PG8_SCHED;
        }
        GMARK(41);
        if (wr == 0) PG8_BAR;
        GMARK(42);
        E(acc, cur, wr, wc, fr, fq);
        GMARK(43);
        if (!has_next) break;
#pragma unroll
        for (int a = 0; a < 2; ++a)
#pragma unroll
            for (int b = 0; b < 2; ++b)
#pragma unroll
                for (int m = 0; m < 4; ++m)
#pragma unroll
                    for (int n = 0; n < 2; ++n) acc[a][b][m][n] = (f32x4){0.f, 0.f, 0.f, 0.f};
        cur = nxt; cA = nA; cB = nB; ++ui;
        if (wr == 1) PG8_BAR;
    }
    PG8_WAIT_V(0);
    PG8_BAR;
#undef PG8_SA
#undef PG8_SB
#undef PG8_STAGE
#undef PG8_STAGEA1
#undef PG8_LDA
#undef PG8_LDB
#undef PG8_MMA
#undef PG8_WAIT_V
#undef PG8_WAIT_L
#undef PG8_BAR
#undef PG8_SCHED
}
}

struct Args { const float* in[33]; float* out; unsigned char* ws; int ph_lo, ph_hi, li, pad; };
enum { I_X = 0, I_C, I_CTX, I_CCTX, I_ADAW, I_ADAB, I_NMG, I_NFG, I_EWIN, I_EBIN, I_ECW, I_ECB, I_ELNG, I_ELNB, I_QNG, I_KNG, I_SINK, I_EWOUT, I_EBOUT,
       I_OWIN, I_OBIN, I_OLNG, I_OLNB, I_OWS, I_OBS, I_OWOUT, I_OBOUT, I_RW, I_RB, I_W1, I_B1, I_W2, I_B2 };

typedef const __attribute__((address_space(4))) unsigned long long* kargp_t;
struct Ctx {
    LAS unsigned char* lds; int tid, lane, wave, G, vcu, gw, NGW, bid; unsigned char* ws; kargp_t kp;
};
__device__ __forceinline__ const float* in_ptr(const Ctx& X, int i) { return (const float*)(const __attribute__((address_space(1))) float*)X.kp[i]; }
#define IN(i) in_ptr(X, (i))
#if PROBE_PH == -2
#define PMARK(k) do { if (X.bid == 0 && X.tid == 0) { volatile LAS unsigned long long* pm_ = (volatile LAS unsigned long long*)(X.lds + MISC_OFF + 128); \
    if ((k) == PROBE_A) pm_[0] = __builtin_amdgcn_s_memrealtime(); if ((k) == PROBE_B) pm_[1] = __builtin_amdgcn_s_memrealtime(); } } while (0)
#else
#define PMARK(k) do { } while (0)
#endif

struct DenseSched {
    static constexpr bool GATHER = false, FP8 = false;
    const bf16* A; const bf16* Bt; int nM, nN, nwg, G, c;
    const bf16* A2; const bf16* Bt2; int nM2;
    __device__ __forceinline__ void init(const bf16* A_, const bf16* Bt_, int M, int N, int G_, int c_) { A = A_; Bt = Bt_; nM = M / 256; nN = N / 256; nwg = nM * nN; G = G_; c = c_; A2 = nullptr; Bt2 = nullptr; nM2 = 0; }
    __device__ __forceinline__ bool next(int i, pg8::Unit& u) const {
        const int L = i * G + c; if (L >= nwg + nM2) return false; u.idx = i;
        if (L >= nwg) { u.pm = L - nwg; u.pn = 0; u.e = 1; u.cnt = 256; return true; }
        int wgid = L; { const int q = nwg / 8, r = nwg % 8, xcd = wgid % 8, off = wgid / 8; wgid = (xcd < r ? xcd * (q + 1) : r * (q + 1) + (xcd - r) * q) + off; }
        const int nig = 8 * nN, gid = wgid / nig, fm = gid * 8, gsz = (nM - fm) < 8 ? (nM - fm) : 8;
        u.pm = fm + ((wgid % nig) % gsz); u.pn = (wgid % nig) / gsz; u.e = 0; u.cnt = 256; return true;
    }
    __device__ __forceinline__ const char* a_ptr(const pg8::Unit& u) const { return (const char*)(u.e ? A2 : A) + (size_t)u.pm * 256 * pg8::KD * 2; }
    __device__ __forceinline__ const char* b_ptr(const pg8::Unit& u) const { return (const char*)(u.e ? Bt2 : Bt) + (size_t)u.pn * 256 * pg8::KD * 2; }
    __device__ __forceinline__ void a_voff(const pg8::Unit&, unsigned (&v)[2][2], const int (&R)[2], const int (&C)[2]) const {
#pragma unroll
        for (int i = 0; i < 2; ++i) { v[0][i] = (unsigned)(R[i] * pg8::KD + C[i]) * 2u; v[1][i] = v[0][i] + (unsigned)(pg8::HALF * pg8::KD * 2); }
    }
};
template <bool GATHER_, int NTILE_N>
struct MoeSchedT {
    static constexpr bool GATHER = GATHER_, FP8 = true; static constexpr int RP = 1024;
    const LAS int* tab; int G, c;
    const unsigned char* A;
    const unsigned char* Bt;
    const int* list;
    const LAS int* meta;
    __device__ __forceinline__ bool next(int i, pg8::Unit& u) const {
        const int L = i * G + c; const int T = tab[0];
        if (L >= T * NTILE_N) return false;
        u.idx = i;
        const int mt = L / NTILE_N; u.pn = L % NTILE_N;
        const int w = __builtin_amdgcn_readfirstlane(tab[1 + mt]); u.e = w >> 16; const int tl = w & 0xffff;
        const int cnt = __builtin_amdgcn_readfirstlane(tab[512 + u.e]), pb = __builtin_amdgcn_readfirstlane(tab[544 + u.e]);
        u.pm = pb + tl * 256; u.cnt = cnt - tl * 256;
        return true;
    }
    __device__ __forceinline__ const char* a_ptr(const pg8::Unit& u) const { return GATHER ? (const char*)A : (const char*)A + (size_t)u.pm * RP; }
    __device__ __forceinline__ const char* b_ptr(const pg8::Unit& u) const { return (const char*)Bt + ((size_t)u.e * NTILE_N + u.pn) * 256 * RP; }
    __device__ __forceinline__ void a_voff(const pg8::Unit& u, unsigned (&v)[2][2], const int (&R)[2], const int (&C)[2]) const {
        if (GATHER) {
#pragma unroll
            for (int h = 0; h < 2; ++h)
#pragma unroll
                for (int i = 0; i < 2; ++i) { const int tok = meta[u.idx * 256 + h * 128 + R[i]]; v[h][i] = (unsigned)(tok * RP + C[i] * 2); }
        } else {
#pragma unroll
            for (int i = 0; i < 2; ++i) { v[0][i] = (unsigned)(R[i] * RP + C[i] * 2); v[1][i] = v[0][i] + (unsigned)(pg8::HALF * RP); }
        }
    }
};
__device__ __forceinline__ void moe_build_table(const Ctx& X, const int* cnt  ) {
    LAS int* tab = (LAS int*)(X.lds + TAB_OFF);
    __syncthreads();
    if (X.tid < 64) {
        const int e = X.lane; int c = 0; if (e < NE) c = __hip_atomic_load(cnt + e * CNT_STRIDE, __ATOMIC_RELAXED, __HIP_MEMORY_SCOPE_AGENT);
        const int mt = (c + 255) >> 8; int incl = mt;
#pragma unroll
        for (int off = 1; off < 32; off <<= 1) { const int v = __shfl_up(incl, off); if (X.lane >= off) incl += v; }
        const int start = incl - mt;
        if (e < NE) { tab[512 + e] = c; tab[544 + e] = start * 256; for (int t = 0; t < mt; ++t) tab[1 + start + t] = (e << 16) | t; if (e == NE - 1) tab[0] = incl; }
    }
    __syncthreads();
}
template <bool WITH_GATE, class Sched>
__device__ __forceinline__ void moe_stage_meta(const Ctx& X, const Sched& S, const int* list, const float* gatew, LAS int* meta, const float* bias, LAS float* lbias) {
    if (X.tid < 256) { pg8::Unit u;
        for (int i = 0; S.next(i, u); ++i) { const int slot0 = u.pm - S.tab[544 + u.e]; const int r = X.tid < u.cnt ? X.tid : u.cnt - 1;
            const int aid = list[(size_t)u.e * NTOK + slot0 + r];
            if (WITH_GATE) { const float g = gatew[aid]; *(LAS u32x2*)(meta + (i * 256 + X.tid) * 2) = (u32x2){(unsigned)aid, __float_as_uint(g)}; }
            else meta[i * 256 + X.tid] = aid >> 2; } }
    else { const int c = X.tid - 256; pg8::Unit u;
        for (int i = 0; S.next(i, u); ++i) lbias[i * 256 + c] = WITH_GATE ? bias[(size_t)u.e * D + u.pn * 256 + c] : bias[(size_t)u.e * 2048 + (c >> 7) * 1024 + u.pn * 128 + (c & 127)]; }
    __syncthreads();
}

__device__ __forceinline__ f32x2 gelu_pk(f32x2 v) {
    const f32x2 av = __builtin_elementwise_abs(v), d = av * 0.2316418882f + 1.0f;
    f32x2 t; t.x = __builtin_amdgcn_rcpf(d.x); t.y = __builtin_amdgcn_rcpf(d.y);
    f32x2 q = t * 0.5307027145f + (-0.7265760135f); q = q * t + 0.7107068705f; q = q * t + (-0.142248368f); q = q * t + 0.127414796f; q = q * t;
    const f32x2 s = (v * v) * (-0.72134752044f);
    f32x2 e; e.x = __builtin_amdgcn_exp2f(s.x); e.y = __builtin_amdgcn_exp2f(s.y);
    const f32x2 m = v * (q * e), r = v - m;
    f32x2 o; o.x = v.x < 0.f ? m.x : r.x; o.y = v.y < 0.f ? m.y : r.y; return o;
}
__device__ __forceinline__ u32x4 pack8(f32x4 a, f32x4 b) { u32x4 w; w.x = pk2(a[0], a[1]); w.y = pk2(a[2], a[3]); w.z = pk2(b[0], b[1]); w.w = pk2(b[2], b[3]); return w; }

struct EpiIn {
    static constexpr bool PERM = true;
    bf16 *GLU, *Q, *Kb, *Vb, *KC, *VC; const float* bias;
    __device__ __forceinline__ void operator()(const f32x4 (&acc)[2][2][4][2], const pg8::Unit& u, int wr, int wc, int fr, int fq) const {
        asm volatile("" : "+v"(fr), "+v"(fq));
        const int row0 = u.pm * 256 + wr * 64 + fr; const int c8 = wc * 32 + 8 * fq;
        if (u.e == 0 && u.pn < 4) {
            const int j0 = u.pn * 128 + c8;
            f32x4 bu[2], bg[2];
#pragma unroll
            for (int n = 0; n < 2; ++n) { bu[n] = *(const f32x4*)(bias + j0 + 4 * n); bg[n] = *(const f32x4*)(bias + 512 + j0 + 4 * n); }
#pragma unroll
            for (int ai = 0; ai < 2; ++ai)
#pragma unroll
                for (int m = 0; m < 4; ++m) { f32x4 o[2];
#pragma unroll
                    for (int n = 0; n < 2; ++n) { const f32x4 uu = acc[ai][0][m][n] + bu[n], gg = acc[ai][1][m][n] + bg[n];
#pragma unroll
                        for (int k = 0; k < 4; ++k) o[n][k] = uu[k] * sigmoidf_(gg[k]); }
                    *(u32x4*)(GLU + (size_t)(row0 + ai * 128 + m * 16) * 512 + j0) = pack8(o[0], o[1]); }
        } else {
#pragma unroll
            for (int bj = 0; bj < 2; ++bj) {
                bf16* dst; int ld, col, bcol;
                if (u.pn >= 6 || u.e) { dst = u.e ? (bj ? VC : KC) : (bj ? Vb : Kb); ld = 128; col = c8; bcol = KV_COL + bj * 128 + c8; }
                else { dst = Q; ld = 512; col = (u.pn - 4) * 256 + bj * 128 + c8; bcol = 1024 + col; }
                f32x4 bv[2];
#pragma unroll
                for (int n = 0; n < 2; ++n) bv[n] = *(const f32x4*)(bias + bcol + 4 * n);
#pragma unroll
                for (int ai = 0; ai < 2; ++ai)
#pragma unroll
                    for (int m = 0; m < 4; ++m) *(u32x4*)(dst + (size_t)(row0 + ai * 128 + m * 16) * ld + col) = pack8(acc[ai][bj][m][0] + bv[0], acc[ai][bj][m][1] + bv[1]);
            }
        }
    }
};
struct EpiRes {
    static constexpr bool PERM = false;
    const float* base; float* out; const float* bias; const float* gate;
    __device__ __forceinline__ void operator()(const f32x4 (&acc)[2][2][4][2], const pg8::Unit& u, int wr, int wc, int fr, int fq) const {
        asm volatile("" : "+v"(fr), "+v"(fq));
        const int col0 = u.pn * 256 + wc * 32 + 4 * fq; const int b = (u.pm * 256) / SEQ;
#pragma unroll
        for (int bj = 0; bj < 2; ++bj) {
            f32x4 bv[2], gv[2];
#pragma unroll
            for (int n = 0; n < 2; ++n) { bv[n] = *(const f32x4*)(bias + col0 + bj * 128 + n * 16); gv[n] = *(const f32x4*)(gate + (size_t)b * MODW + col0 + bj * 128 + n * 16); }
#pragma unroll
            for (int ai = 0; ai < 2; ++ai)
#pragma unroll
                for (int m = 0; m < 4; ++m) { const size_t off = (size_t)(u.pm * 256 + ai * 128 + wr * 64 + m * 16 + fr) * D + col0 + bj * 128;
#pragma unroll
                    for (int n = 0; n < 2; ++n) { const f32x4 bs = *(const f32x4*)(base + off + n * 16); *(f32x4*)(out + off + n * 16) = bs + gv[n] * (acc[ai][bj][m][n] + bv[n]); } }
        }
    }
};
struct EpiGelu {
    static constexpr bool PERM = true;
    bf16 *U, *V; const float* bias; float* vstat;
    __device__ __forceinline__ void operator()(const f32x4 (&acc)[2][2][4][2], const pg8::Unit& u, int wr, int wc, int fr, int fq) const {
        asm volatile("" : "+v"(fr), "+v"(fq));
        const int row0 = u.pm * 256 + wr * 64 + fr; const int colt = u.pn * 256; const bool isv = colt >= 1024; bf16* base = isv ? V : U; const int cb = (colt & 1023) + wc * 32 + 8 * fq, bcol = colt + wc * 32 + 8 * fq;
        f32x4 bv[2][2];
#pragma unroll
        for (int bj = 0; bj < 2; ++bj)
#pragma unroll
            for (int n = 0; n < 2; ++n) bv[bj][n] = *(const f32x4*)(bias + bcol + bj * 128 + 4 * n);
#pragma unroll
        for (int ai = 0; ai < 2; ++ai)
#pragma unroll
            for (int m = 0; m < 4; ++m) { const int row = row0 + ai * 128 + m * 16; bf16* rowp = base + (size_t)row * D + cb; float s = 0.f, s2 = 0.f;
#pragma unroll
                for (int bj = 0; bj < 2; ++bj) { f32x4 v0 = acc[ai][bj][m][0] + bv[bj][0], v1 = acc[ai][bj][m][1] + bv[bj][1];
                    f32x2 a = gelu_pk((f32x2){v0[0], v0[1]}), b = gelu_pk((f32x2){v0[2], v0[3]}), c = gelu_pk((f32x2){v1[0], v1[1]}), d = gelu_pk((f32x2){v1[2], v1[3]});
                    s += (a.x + a.y) + (b.x + b.y) + (c.x + c.y) + (d.x + d.y); s2 += (a.x * a.x + a.y * a.y) + (b.x * b.x + b.y * b.y) + (c.x * c.x + c.y * c.y) + (d.x * d.x + d.y * d.y);
                    *(u32x4*)(rowp + bj * 128) = pack8((f32x4){a.x, a.y, b.x, b.y}, (f32x4){c.x, c.y, d.x, d.y}); }
                if (isv) { s += __shfl_xor(s, 16); s += __shfl_xor(s, 32); s2 += __shfl_xor(s2, 16); s2 += __shfl_xor(s2, 32);
                    if (fq == 0) { unsafeAtomicAdd(vstat + 2 * row, s); unsafeAtomicAdd(vstat + 2 * row + 1, s2); } } }
    }
};
struct EpiSwiglu {
    static constexpr bool PERM = true;
    unsigned char* ACT; const LAS float* lbias;
    __device__ __forceinline__ void operator()(const f32x4 (&acc)[2][2][4][2], const pg8::Unit& u, int wr, int wc, int fr, int fq) const {
        asm volatile("" : "+v"(fr), "+v"(fq));
        const int j0 = u.pn * 128 + wc * 32 + 8 * fq; const LAS float* bb = lbias + u.idx * 256 + wc * 32 + 8 * fq;
        f32x4 bg[2], bu[2];
#pragma unroll
        for (int n = 0; n < 2; ++n) { bg[n] = *(const LAS f32x4*)(bb + 4 * n); bu[n] = *(const LAS f32x4*)(bb + 128 + 4 * n); }
#pragma unroll
        for (int ai = 0; ai < 2; ++ai)
#pragma unroll
            for (int m = 0; m < 4; ++m) { f32x4 o[2];
#pragma unroll
                for (int n = 0; n < 2; ++n) { const f32x4 g4 = acc[ai][0][m][n] * FP8_DESCALE + bg[n], u4 = acc[ai][1][m][n] * FP8_DESCALE + bu[n];
#pragma unroll
                    for (int k = 0; k < 4; ++k) { const float g = fminf(g4[k], 7.0f), up = fminf(fmaxf(u4[k], -7.0f), 7.0f); o[n][k] = (up + 1.0f) * g * sigmoidf_(g * 1.702f); } }
                u32x2 w8; w8.x = pk4_fp8(o[0][0] * FP8_AMUL, o[0][1] * FP8_AMUL, o[0][2] * FP8_AMUL, o[0][3] * FP8_AMUL); w8.y = pk4_fp8(o[1][0] * FP8_AMUL, o[1][1] * FP8_AMUL, o[1][2] * FP8_AMUL, o[1][3] * FP8_AMUL);
                *(u32x2*)(ACT + (size_t)(u.pm + ai * 128 + wr * 64 + m * 16 + fr) * D + j0) = w8; }
    }
};
struct EpiDown {
    static constexpr bool PERM = true;
    bf16* Y; const LAS float* lbias; const LAS int* meta;
    __device__ __forceinline__ void operator()(const f32x4 (&acc)[2][2][4][2], const pg8::Unit& u, int wr, int wc, int fr, int fq) const {
        asm volatile("" : "+v"(fr), "+v"(fq));
        const int c8 = u.pn * 256 + wc * 32 + 8 * fq; const LAS float* bb = lbias + u.idx * 256 + wc * 32 + 8 * fq;
#pragma unroll
        for (int bj = 0; bj < 2; ++bj) {
            f32x4 bv[2];
#pragma unroll
            for (int n = 0; n < 2; ++n) bv[n] = *(const LAS f32x4*)(bb + bj * 128 + 4 * n);
#pragma unroll
            for (int ai = 0; ai < 2; ++ai)
#pragma unroll
                for (int m = 0; m < 4; ++m) { const int r = ai * 128 + wr * 64 + m * 16 + fr; const u32x2 mg = *(const LAS u32x2*)(meta + (u.idx * 256 + r) * 2); const int aid = (int)mg.x; const float g = __uint_as_float(mg.y);
                    const u32x4 w = pack8((acc[ai][bj][m][0] * FP8_DESCALE + bv[0]) * g, (acc[ai][bj][m][1] * FP8_DESCALE + bv[1]) * g);
                    if (r < u.cnt) *(u32x4*)(Y + (size_t)aid * D + c8 + bj * 128) = w; }
        }
    }
};

struct TrItem { const float* src; bf16* dst; int N; int fp8; };
__device__ __forceinline__ void tr_load(const TrItem& t, float (&v)[32], int lane) {
#pragma unroll
    for (int i = 0; i < 32; ++i) v[i] = t.src[(size_t)(2 * i + (lane >> 5)) * t.N + (lane & 31)];
}
__device__ __forceinline__ void tr_store(const TrItem& t, const float (&v)[32], LAS float* scr, int lane) {
#pragma unroll
    for (int i = 0; i < 32; ++i) scr[(2 * i + (lane >> 5)) * 33 + (lane & 31)] = v[i];
    LDS_WAIT();
    if (t.fp8) {
        const int q = lane & 3;
#pragma unroll
        for (int j = 0; j < 2; ++j) { const int n = (lane >> 2) + 16 * j; const LAS float* s = scr + (16 * q) * 33 + n; u32x4 o;
#pragma unroll
            for (int c = 0; c < 4; ++c) o[c] = pk4_fp8(s[(4 * c) * 33] * FP8_WMUL, s[(4 * c + 1) * 33] * FP8_WMUL, s[(4 * c + 2) * 33] * FP8_WMUL, s[(4 * c + 3) * 33] * FP8_WMUL);
            *(u32x4*)((unsigned char*)t.dst + (size_t)n * 1024 + 16 * q) = o; }
    } else {
        const int c = lane & 7;
#pragma unroll
        for (int j = 0; j < 4; ++j) { const int n = (lane >> 3) + 8 * j; const LAS float* s = scr + (8 * c) * 33 + n;
            u32x4 o; o.x = pk2(s[0 * 33], s[1 * 33]); o.y = pk2(s[2 * 33], s[3 * 33]); o.z = pk2(s[4 * 33], s[5 * 33]); o.w = pk2(s[6 * 33], s[7 * 33]);
            *(u32x4*)(t.dst + (size_t)n * 1024 + 8 * c) = o; }
    }
    LDS_WAIT();
}
__device__ __forceinline__ int pair_src(int nd, int halfw) { return ((nd & 255) >> 7) * halfw + (nd >> 8) * 128 + (nd & 127); }

__device__ __forceinline__ void phase_prologue(const Args& a, const Ctx& X) {
    PMARK(20);
    {
        LAS float* sc = (LAS float*)X.lds;
        LAS float* red = (LAS float*)(X.lds + 36864);
        float* MOD = (float*)(X.ws + WS_MOD);
        for (int item = X.bid; item < 2 * 96; item += X.G) {
            const int l = item / 96, j0 = (item % 96) * 64;
            for (int idx = X.tid; idx < 9 * 1024; idx += NTHREADS) { const int r = idx >> 10, k = idx & 1023; const float v = r < 8 ? IN(I_C)[r * 1024 + k] : IN(I_CCTX)[k]; sc[idx] = v * sigmoidf_(v); }
            __syncthreads();
            float acc[9];
#pragma unroll
            for (int r = 0; r < 9; ++r) acc[r] = 0.f;
            const float* w = IN(I_ADAW) + (size_t)l * 1024 * MODW + j0 + X.lane;
#pragma unroll 8
            for (int k = X.wave * 128; k < X.wave * 128 + 128; ++k) { const float wv = w[(size_t)k * MODW];
#pragma unroll
                for (int r = 0; r < 9; ++r) acc[r] += sc[r * 1024 + k] * wv; }
#pragma unroll
            for (int r = 0; r < 9; ++r) red[(X.wave * 9 + r) * 64 + X.lane] = acc[r];
            __syncthreads();
            for (int t = X.tid; t < 9 * 64; t += NTHREADS) { const int r = t >> 6, cidx = t & 63; float s = 0.f;
#pragma unroll
                for (int w8 = 0; w8 < 8; ++w8) s += red[(w8 * 9 + r) * 64 + cidx];
                MOD[((size_t)l * 9 + r) * MODW + j0 + cidx] = s + IN(I_ADAB)[l * MODW + j0 + cidx]; }
            __syncthreads();
        }
    }
    PMARK(21);
    LAS float* scr = (LAS float*)(X.lds + X.wave * 16384);
    bf16* WinT = (bf16*)(X.ws + WS_WINT); bf16* WoutT = (bf16*)(X.ws + WS_WOUTT); bf16* GWinT = (bf16*)(X.ws + WS_GWINT); bf16* GWoutT = (bf16*)(X.ws + WS_GWOUTT);
    bf16* W1T = (bf16*)(X.ws + WS_W1T); bf16* W2T = (bf16*)(X.ws + WS_W2T);
    constexpr int I_IN = 16 * (EVEN_IN / 32), I_OUT = 16 * 32, I_GIN = 16 * 64, I_GOUT = 16 * 32, I_M1 = 64 * 16 * 64, I_M2 = 64 * 16 * 32;
    constexpr int NITEMS = I_IN + I_OUT + I_GIN + I_GOUT + I_M1 + I_M2;
    auto item_of = [&](int it) -> TrItem {
        int r = it; TrItem t; t.fp8 = 0;
        if (r < I_M1) { const int mat = r >> 10, q = r & 1023, kb = q >> 6, nd = (q & 63) * 32; t.N = 2048; t.fp8 = 1; t.src = IN(I_W1) + (size_t)mat * 1024 * 2048 + (size_t)kb * 64 * 2048 + pair_src(nd, 1024); t.dst = (bf16*)((unsigned char*)W1T + (size_t)mat * 2048 * 1024 + (size_t)nd * 1024 + kb * 64); return t; } r -= I_M1;
        if (r < I_M2) { const int mat = r >> 9, q = r & 511, kb = q >> 5, nd = (q & 31) * 32; t.N = 1024; t.fp8 = 1; t.src = IN(I_W2) + (size_t)mat * 1024 * 1024 + (size_t)kb * 64 * 1024 + nd; t.dst = (bf16*)((unsigned char*)W2T + (size_t)mat * 1024 * 1024 + (size_t)nd * 1024 + kb * 64); return t; } r -= I_M2;
        if (r < I_IN) { const int kb = r / 56, nd = (r % 56) * 32; const int ns = nd < 1024 ? pair_src(nd, 512) : nd; t.N = EVEN_IN; t.src = IN(I_EWIN) + (size_t)kb * 64 * EVEN_IN + ns; t.dst = WinT + (size_t)nd * 1024 + kb * 64; return t; } r -= I_IN;
        if (r < I_OUT) { const int kb = r >> 5, nd = (r & 31) * 32; t.N = 1024; t.src = IN(I_EWOUT) + (size_t)kb * 64 * 1024 + nd; t.dst = WoutT + (size_t)nd * 1024 + kb * 64; return t; } r -= I_OUT;
        if (r < I_GIN) { const int kb = r >> 6, nd = (r & 63) * 32; t.N = 2048; t.src = IN(I_OWIN) + (size_t)kb * 64 * 2048 + nd; t.dst = GWinT + (size_t)nd * 1024 + kb * 64; return t; } r -= I_GIN;
        { const int kb = r >> 5, nd = (r & 31) * 32; t.N = 1024; t.src = IN(I_OWOUT) + (size_t)kb * 64 * 1024 + nd; t.dst = GWoutT + (size_t)nd * 1024 + kb * 64; return t; }
    };
    {
        float va[32], vb[32]; int it = X.gw;
        TrItem ta, tb; if (it < NITEMS) { ta = item_of(it); tr_load(ta, va, X.lane); }
        while (it < NITEMS) {
            const int it1 = it + X.NGW; if (it1 < NITEMS) { tb = item_of(it1); tr_load(tb, vb, X.lane); }
            tr_store(ta, va, scr, X.lane);
            if (it1 >= NITEMS) break;
            const int it2 = it1 + X.NGW; if (it2 < NITEMS) { ta = item_of(it2); tr_load(ta, va, X.lane); }
            tr_store(tb, vb, scr, X.lane);
            it = it2;
        }
    }
#if EXP_STREAM
    {
        unsigned char* dstb = (unsigned char*)(X.ws + WS_CF);
        const size_t n1 = (size_t)2 * 32 * 1024 * 2048, n2 = (size_t)2 * 32 * 1024 * 1024;
        for (size_t i = ((size_t)X.gw * 64 + X.lane) * 16; i < n1 + n2; i += (size_t)X.NGW * 64 * 16) {
            const float* s = i < n1 ? IN(I_W1) + i : IN(I_W2) + (i - n1);
            const f32x4 a0 = ((const f32x4*)s)[0], a1 = ((const f32x4*)s)[1], a2 = ((const f32x4*)s)[2], a3 = ((const f32x4*)s)[3];
            u32x4 o; o.x = pk4_fp8(a0[0], a0[1], a0[2], a0[3]); o.y = pk4_fp8(a1[0], a1[1], a1[2], a1[3]); o.z = pk4_fp8(a2[0], a2[1], a2[2], a2[3]); o.w = pk4_fp8(a3[0], a3[1], a3[2], a3[3]);
            *(u32x4*)(dstb + i) = o; }
    }
#endif
    PMARK(22);
    { bf16* WsB = (bf16*)(X.ws + WS_WSB); const float* ws = IN(I_OWS);
      for (int i = (X.gw * 64 + X.lane) * 4; i < 8 * 128 * 128; i += X.NGW * 64 * 4) { const f32x4 v = *(const f32x4*)(ws + i); u32x2 o; o.x = pk2(v[0], v[1]); o.y = pk2(v[2], v[3]); *(u32x2*)(WsB + i) = o; } }
}

__device__ __forceinline__ void modulate_row(const float* xrow, const float* g, const float* sh, const float* sc, bf16* orow, int lane, f32x4 (&y)[4]) {
    const f32x4* xr = (const f32x4*)xrow + lane; f32x4 v[4]; float ss = 0.f;
#pragma unroll
    for (int j = 0; j < 4; ++j) { v[j] = xr[64 * j]; ss += (v[j][0] * v[j][0] + v[j][1] * v[j][1]) + (v[j][2] * v[j][2] + v[j][3] * v[j][3]); }
    const float rstd = rsqrtf(wave_sum(ss) * (1.0f / D) + EPS);
#pragma unroll
    for (int j = 0; j < 4; ++j) { const f32x4 gk = ((const f32x4*)g)[lane + 64 * j], sk = ((const f32x4*)sc)[lane + 64 * j], hk = ((const f32x4*)sh)[lane + 64 * j];
        y[j] = v[j] * rstd * gk * (1.0f + sk) + hk;
        u32x2 o; o.x = pk2(y[j][0], y[j][1]); o.y = pk2(y[j][2], y[j][3]); *((u32x2*)orow + lane + 64 * j) = o; }
}
__device__ __forceinline__ void mod0_load(const Ctx& X, int row, f32x4 (&v)[4]) {
    const float* xrow = row < NTOK ? IN(I_X) + (size_t)row * D : IN(I_CTX) + (size_t)(row - NTOK) * D;
#pragma unroll
    for (int j = 0; j < 4; ++j) v[j] = ((const f32x4*)xrow)[X.lane + 64 * j];
}
__device__ __forceinline__ void mod0_finish(const Ctx& X, int row, const f32x4 (&v)[4]) {
    const float* m = (const float*)(X.ws + WS_MOD) + (size_t)(row < NTOK ? row / SEQ : 8) * MODW; const float* g = IN(I_NMG);
    bf16* orow = row < NTOK ? (bf16*)(X.ws + WS_XA) + (size_t)row * D : (bf16*)(X.ws + WS_GM) + (size_t)(row - NTOK) * D;
    f32x4 gk[4], hk[4], sk[4]; float ss = 0.f;
#pragma unroll
    for (int j = 0; j < 4; ++j) { gk[j] = ((const f32x4*)g)[X.lane + 64 * j]; hk[j] = ((const f32x4*)m)[X.lane + 64 * j]; sk[j] = ((const f32x4*)(m + 1024))[X.lane + 64 * j];
        ss += (v[j][0] * v[j][0] + v[j][1] * v[j][1]) + (v[j][2] * v[j][2] + v[j][3] * v[j][3]); }
    const float rstd = rsqrtf(wave_sum(ss) * (1.0f / D) + EPS);
#pragma unroll
    for (int j = 0; j < 4; ++j) { const f32x4 y = v[j] * rstd * gk[j] * (1.0f + sk[j]) + hk[j]; u32x2 o; o.x = pk2(y[0], y[1]); o.y = pk2(y[2], y[3]); *((u32x2*)orow + X.lane + 64 * j) = o; }
}
__device__ __forceinline__ void phase_modulate0(const Args& a, const Ctx& X) {
    constexpr int NR = NTOK + NCTX; f32x4 va[4], vb[4];
    int row = X.gw; if (row < NR) mod0_load(X, row, va);
    while (row < NR) {
        const int r1 = row + X.NGW; if (r1 < NR) mod0_load(X, r1, vb);
        mod0_finish(X, row, va);
        if (r1 >= NR) break;
        const int r2 = r1 + X.NGW; if (r2 < NR) mod0_load(X, r2, va);
        mod0_finish(X, r1, vb);
        row = r2;
    }
}

__device__ __forceinline__ void qk_chunks(bf16* buf, int nchunks, int rowlen, const float* gn, bool rope, float oscale, const Ctx& X, const LAS f32x2* cs) {
    for (int ch = X.gw; ch < nchunks; ch += X.NGW) {
        const int e0 = ch * 512 + 8 * X.lane; const int token = e0 / rowlen; const int d0 = e0 & 63;
        u32x4 raw = *(const u32x4*)(buf + e0); float v[8];
#pragma unroll
        for (int i = 0; i < 4; ++i) { v[2 * i] = bf2f(raw[i] & 0xffffu); v[2 * i + 1] = bf2f(raw[i] >> 16); }
        float ss = 0.f;
#pragma unroll
        for (int i = 0; i < 8; ++i) ss += v[i] * v[i];
        ss += __shfl_xor(ss, 1); ss += __shfl_xor(ss, 2); ss += __shfl_xor(ss, 4);
        const float rstd = rsqrtf(ss * (1.0f / 64.0f) + EPS);
        const f32x4 g0 = *(const f32x4*)(gn + d0), g1 = *(const f32x4*)(gn + d0 + 4);
#pragma unroll
        for (int i = 0; i < 4; ++i) { v[i] = v[i] * rstd * g0[i]; v[4 + i] = v[4 + i] * rstd * g1[i]; }
        if (rope) {
            const int t = token % SEQ; const int dd0 = d0 & 31; const int pos = dd0 < 16 ? (t >> 6) : (t & 63);
            const LAS f32x2* cp = cs + pos * 16 + (dd0 & 15);
#pragma unroll
            for (int i = 0; i < 8; ++i) { const float pv = __shfl_xor(v[i], 4); const f32x2 c = cp[i];
                v[i] = (d0 < 32) ? (v[i] * c.x - pv * c.y) : (v[i] * c.x + pv * c.y); }
        }
        u32x4 o; o.x = pk2(v[0] * oscale, v[1] * oscale); o.y = pk2(v[2] * oscale, v[3] * oscale); o.z = pk2(v[4] * oscale, v[5] * oscale); o.w = pk2(v[6] * oscale, v[7] * oscale);
        *(u32x4*)(buf + e0) = o;
    }
}
__device__ __forceinline__ void phase_conv_qk(const Args& a, const Ctx& X) {
    LAS f32x2* cs = (LAS f32x2*)(X.lds + 65536);
    for (int i = X.tid; i < 1024; i += NTHREADS) { const float inv = exp2f(-(float)(i & 15) * (13.287712379549449f / 16.0f)); float sn, csn; sincosf((float)(i >> 4) * inv, &sn, &csn); cs[i] = (f32x2){csn, sn}; }
    __syncthreads();
    qk_chunks((bf16*)(X.ws + WS_Q), NTOK, 512, IN(I_QNG), true, QSCALE, X, cs);
    qk_chunks((bf16*)(X.ws + WS_K), NTOK / 4, 128, IN(I_KNG), true, 1.0f, X, cs);
    qk_chunks((bf16*)(X.ws + WS_KC), NCTX / 4, 128, IN(I_KNG), false, 1.0f, X, cs);
    const bf16* GLU = (const bf16*)(X.ws + WS_GLU); bf16* MIX = (bf16*)(X.ws + WS_MIX);
    LAS unsigned* tin = (LAS unsigned*)X.lds;
    LAS float* tout = (LAS float*)(X.lds + 65536);
    const int cp = X.tid & 255, th = X.tid >> 8;
    float w0[31], w1[31];
#pragma unroll
    for (int j = 0; j < 31; ++j) { const f32x2 w = *(const f32x2*)(IN(I_ECW) + j * 512 + 2 * cp); w0[j] = w.x; w1[j] = w.y; }
    const f32x2 cb = *(const f32x2*)(IN(I_ECB) + 2 * cp);
    for (int tile = X.bid; tile < NTOK / 32; tile += X.G) {
        const int row0 = tile * 32; const int t0 = row0 % SEQ;
        __syncthreads();
        for (int c = X.tid; c < 62 * 64; c += NTHREADS) { const int lr = c >> 6, cc = c & 63; const int t = t0 - 15 + lr;
            u32x4 v = (u32x4){0u, 0u, 0u, 0u}; if (t >= 0 && t < SEQ) v = *(const u32x4*)(GLU + (size_t)(row0 - 15 + lr) * 512 + cc * 8);
            *(LAS u32x4*)(tin + lr * 256 + cc * 4) = v; }
        __syncthreads();
        float a0[16], a1[16];
#pragma unroll
        for (int o = 0; o < 16; ++o) { a0[o] = cb.x; a1[o] = cb.y; }
#pragma unroll
        for (int rr = 0; rr < 46; ++rr) { const unsigned pv = tin[(16 * th + rr) * 256 + cp]; const float x0 = bf2f(pv & 0xffffu), x1 = bf2f(pv >> 16);
#pragma unroll
            for (int o = 0; o < 16; ++o) { const int j = rr - o; if (j >= 0 && j <= 30) { a0[o] += x0 * w0[j]; a1[o] += x1 * w1[j]; } } }
#pragma unroll
        for (int o = 0; o < 16; ++o) *(LAS f32x2*)(tout + (16 * th + o) * 512 + 2 * cp) = (f32x2){a0[o], a1[o]};
        __syncthreads();
#pragma unroll
        for (int q = 0; q < 4; ++q) { const int tl = X.wave * 4 + q; f32x4 v[2]; float s = 0.f;
#pragma unroll
            for (int j = 0; j < 2; ++j) { v[j] = *(const LAS f32x4*)(tout + tl * 512 + 4 * X.lane + 256 * j); s += (v[j][0] + v[j][1]) + (v[j][2] + v[j][3]); }
            const float mean = wave_sum(s) * (1.0f / 512.0f); float s2 = 0.f;
#pragma unroll
            for (int j = 0; j < 2; ++j) { v[j] = v[j] - mean; s2 += (v[j][0] * v[j][0] + v[j][1] * v[j][1]) + (v[j][2] * v[j][2] + v[j][3] * v[j][3]); }
            const float rstd = rsqrtf(wave_sum(s2) * (1.0f / 512.0f) + EPS);
#pragma unroll
            for (int j = 0; j < 2; ++j) { const f32x4 g = *(const f32x4*)(IN(I_ELNG) + 4 * X.lane + 256 * j), b = *(const f32x4*)(IN(I_ELNB) + 4 * X.lane + 256 * j);
                f32x4 y = v[j] * rstd * g + b;
#pragma unroll
                for (int k = 0; k < 4; ++k) y[k] = y[k] * sigmoidf_(y[k]);
                u32x2 o; o.x = pk2(y[0], y[1]); o.y = pk2(y[2], y[3]); *(u32x2*)(MIX + (size_t)(row0 + tl) * D + 4 * X.lane + 256 * j) = o; } }
    }
}

__device__ __forceinline__ void phase_attention(const Args& a, const Ctx& X) {
    unsigned char* const wsb = X.ws;
    LAS unsigned char* Ks = X.lds;
    LAS unsigned char* Vt = X.lds + 16384;
    const int lane = X.lane, l15 = lane & 15, g4 = lane >> 4;
    for (int unit = X.bid; unit < NB * 2 * 32; unit += X.G) {
        const int b = unit >> 6, kh = (unit >> 5) & 1, qb = unit & 31; const int q0 = qb * 64;
        const int hq = kh * 4 + (X.wave >> 1), tq = (X.wave & 1) * 32;
        bf16x8 Qf[2][2];
#pragma unroll
        for (int qi = 0; qi < 2; ++qi)
#pragma unroll
            for (int s = 0; s < 2; ++s) Qf[qi][s] = *(const bf16x8*)(wsb + (unsigned)(WS_Q + 2u * (unsigned)((b * SEQ + q0 + tq + 16 * qi + l15) * 512 + hq * 64 + 32 * s + 8 * g4)));
        const float sink2 = IN(I_SINK)[hq] * LOG2E;
        float mrun[2], lrun[2]; f32x4 O[2][4];
#pragma unroll
        for (int qi = 0; qi < 2; ++qi) { mrun[qi] = sink2; lrun[qi] = (g4 == 0) ? 1.0f : 0.0f;
#pragma unroll
            for (int db = 0; db < 4; ++db) O[qi][db] = (f32x4){0.f, 0.f, 0.f, 0.f}; }
        const int t_first = (q0 >= 128) ? 0 : (q0 >= 64 ? 1 : 2), t_skip_lo = (q0 + 128 < SEQ) ? 5 : (q0 + 64 < SEQ ? 4 : 3);
        const int key = X.tid >> 3, ch = X.tid & 7;
        auto tile_offs = [&](int t, unsigned& ko, unsigned& vo) {
            if (t < 5) { const unsigned e = (unsigned)((b * SEQ + q0 - 128 + 64 * t) * 128 + kh * 64) * 2u; ko = (unsigned)WS_K + e; vo = (unsigned)WS_V + e; }
            else { const unsigned e = (unsigned)((b * CTXL + (t - 5) * 64) * 128 + kh * 64) * 2u; ko = (unsigned)WS_KC + e; vo = (unsigned)WS_VC + e; } };
        const unsigned lane_off = (unsigned)(key * 128 + ch * 8) * 2u;
        auto lds_put = [&](int buf, const u32x4& kv, const u32x4& vv) {
            LAS unsigned char* Kd = Ks + buf * 32768; LAS unsigned char* Vd = Vt + buf * 32768;
            *(LAS u32x4*)(Kd + key * 144 + ch * 16) = kv;
#pragma unroll
            for (int i = 0; i < 4; ++i) { *(LAS unsigned short*)(Vd + (8 * ch + 2 * i) * 136 + key * 2) = (unsigned short)(vv[i] & 0xffffu); *(LAS unsigned short*)(Vd + (8 * ch + 2 * i + 1) * 136 + key * 2) = (unsigned short)(vv[i] >> 16); } };
        u32x4 kreg, vreg;
        { unsigned ko, vo; tile_offs(t_first, ko, vo); kreg = *(const u32x4*)(wsb + (ko + lane_off)); vreg = *(const u32x4*)(wsb + (vo + lane_off)); }
        __syncthreads();
        lds_put(0, kreg, vreg);
        int bufi = 0;
        for (int t = t_first; t < 9; ++t) {
            if (t >= t_skip_lo && t < 5) continue;
            int tn = t + 1; if (tn >= t_skip_lo && tn < 5) tn = 5;
            if (tn < 9) { unsigned ko, vo; tile_offs(tn, ko, vo); kreg = *(const u32x4*)(wsb + (ko + lane_off)); vreg = *(const u32x4*)(wsb + (vo + lane_off)); }
            const int mode = (t == 0) ? 1 : (t == 4 ? 2 : 0);
            __syncthreads();
            const LAS unsigned char* Kc = Ks + bufi * 32768; const LAS unsigned char* Vc = Vt + bufi * 32768;
            bf16x8 kf[4][2];
#pragma unroll
            for (int kb = 0; kb < 4; ++kb)
#pragma unroll
                for (int s = 0; s < 2; ++s) kf[kb][s] = *(const LAS bf16x8*)(Kc + (16 * kb + l15) * 144 + (32 * s + 8 * g4) * 2);
            bf16x8 vf[4][2];
#pragma unroll
            for (int db = 0; db < 4; ++db)
#pragma unroll
                for (int ks2 = 0; ks2 < 2; ++ks2) { const LAS unsigned char* p = Vc + (16 * db + l15) * 136 + (32 * ks2 + 4 * g4) * 2;
                    const u32x2 lo = *(const LAS u32x2*)p, hi = *(const LAS u32x2*)(p + 32);
                    u32x4 w; w.x = lo.x; w.y = lo.y; w.z = hi.x; w.w = hi.y; vf[db][ks2] = __builtin_bit_cast(bf16x8, w); }
#pragma unroll
            for (int qi = 0; qi < 2; ++qi) {
                f32x4 st[4];
#pragma unroll
                for (int kb = 0; kb < 4; ++kb) { st[kb] = (f32x4){0.f, 0.f, 0.f, 0.f};
#pragma unroll
                    for (int s = 0; s < 2; ++s) st[kb] = __builtin_amdgcn_mfma_f32_16x16x32_bf16(kf[kb][s], Qf[qi][s], st[kb], 0, 0, 0); }
                if (mode) { int qloc = tq + 16 * qi + l15; asm volatile("" : "+v"(qloc));
#pragma unroll
                    for (int kb = 0; kb < 4; ++kb)
#pragma unroll
                        for (int r = 0; r < 4; ++r) { const int kk = 16 * kb + 4 * g4 + r; const bool keep = (mode == 1) ? (kk >= qloc) : (kk <= qloc); if (!keep) st[kb][r] = -1e30f; } }
                float mx = st[0][0];
#pragma unroll
                for (int kb = 0; kb < 4; ++kb)
#pragma unroll
                    for (int r = 0; r < 4; ++r) mx = fmaxf(mx, st[kb][r]);
                mx = fmaxf(mx, __shfl_xor(mx, 16)); mx = fmaxf(mx, __shfl_xor(mx, 32));
                const float mnew = fmaxf(mrun[qi], mx); const float alpha = __builtin_amdgcn_exp2f(mrun[qi] - mnew); mrun[qi] = mnew;
                float ps = 0.f;
#pragma unroll
                for (int kb = 0; kb < 4; ++kb)
#pragma unroll
                    for (int r = 0; r < 4; ++r) { st[kb][r] = __builtin_amdgcn_exp2f(st[kb][r] - mnew); ps += st[kb][r]; }
                lrun[qi] = lrun[qi] * alpha + ps;
#pragma unroll
                for (int db = 0; db < 4; ++db) O[qi][db] = O[qi][db] * alpha;
#pragma unroll
                for (int ks2 = 0; ks2 < 2; ++ks2) { u32x4 w; w.x = pk2(st[2 * ks2][0], st[2 * ks2][1]); w.y = pk2(st[2 * ks2][2], st[2 * ks2][3]); w.z = pk2(st[2 * ks2 + 1][0], st[2 * ks2 + 1][1]); w.w = pk2(st[2 * ks2 + 1][2], st[2 * ks2 + 1][3]);
                    const bf16x8 pf = __builtin_bit_cast(bf16x8, w);
#pragma unroll
                    for (int db = 0; db < 4; ++db) O[qi][db] = __builtin_amdgcn_mfma_f32_16x16x32_bf16(vf[db][ks2], pf, O[qi][db], 0, 0, 0); }
            }
            if (tn < 9) lds_put(bufi ^ 1, kreg, vreg);
            bufi ^= 1;
        }
#pragma unroll
        for (int qi = 0; qi < 2; ++qi) { float l = lrun[qi]; l += __shfl_xor(l, 16); l += __shfl_xor(l, 32); const float inv = 1.0f / l;
            bf16* orow = (bf16*)(wsb + (unsigned)(WS_MIX + 2u * (unsigned)((b * SEQ + q0 + tq + 16 * qi + l15) * D + 512 + hq * 64 + 4 * g4)));
#pragma unroll
            for (int db = 0; db < 4; ++db) { u32x2 o; o.x = pk2(O[qi][db][0] * inv, O[qi][db][1] * inv); o.y = pk2(O[qi][db][2] * inv, O[qi][db][3] * inv); *(u32x2*)(orow + 16 * db) = o; } }
    }
}

__device__ __forceinline__ void phase_router(const Args& a, const Ctx& X, int layer) {
    const float* __restrict__ H = (const float*)(X.ws + WS_H); unsigned char* XA8 = (unsigned char*)(X.ws + WS_XA8);
    const float* MODl = (const float*)(X.ws + WS_MOD) + (size_t)layer * 9 * MODW; const float* gn = IN(I_NFG) + layer * D;
    const float* rw = IN(I_RW) + (size_t)layer * D * NE; const float* rb = IN(I_RB) + layer * NE;
    int* cntg = (int*)(X.ws + WS_CTL) + CW_CNT + layer * NE * CNT_STRIDE; int* list = (int*)(X.ws + WS_LIST); float* gatew = (float*)(X.ws + WS_GATE);
    LAS float* ybuf = (LAS float*)X.lds;
    LAS float* part = (LAS float*)(X.lds + 65536);
    LAS int* sel = (LAS int*)(X.lds + 65536 + 16384);
    LAS int* lcnt = (LAS int*)(X.lds + 65536 + 16384 + 1024);
    LAS float* lgs = (LAS float*)(X.lds + 65536 + 16384 + 2048);
    LAS float* tvs = lgs + 512;
    LAS float* exs = lgs + 528;
    PMARK(0);
    const int e = X.lane & 31, hf = X.lane >> 5;
    float wreg[64];
#pragma unroll
    for (int i = 0; i < 64; ++i) wreg[i] = rw[(size_t)(128 * X.wave + 64 * hf + i) * NE + e];
    const float rbe = rb[e];
    for (int blk = X.bid; blk < NTOK / 64; blk += X.G) {
        const int rowbase = blk * 64; const float* m = MODl + (size_t)(rowbase / SEQ) * MODW;
        f32x4 gk[4], hk[4], xv[2][4];
#pragma unroll
        for (int j = 0; j < 4; ++j) { gk[j] = ((const f32x4*)gn)[X.lane + 64 * j]; hk[j] = ((const f32x4*)(m + 3 * 1024))[X.lane + 64 * j]; const f32x4 s_ = ((const f32x4*)(m + 4 * 1024))[X.lane + 64 * j]; gk[j] = gk[j] * (1.0f + s_); }
#pragma unroll
        for (int i = 0; i < 2; ++i)
#pragma unroll
            for (int j = 0; j < 4; ++j) xv[i][j] = ((const f32x4*)(H + (size_t)(rowbase + 2 * X.wave + i) * D))[X.lane + 64 * j];
        __syncthreads();
        if (X.tid < 64) lcnt[X.tid] = 0;
        PMARK(1);
#pragma unroll 1
        for (int bt = 0; bt < 4; ++bt) {
#pragma unroll
            for (int i = 0; i < 2; ++i) { const int rl = 2 * X.wave + i, row = rowbase + 16 * bt + rl; float ss = 0.f;
#pragma unroll
                for (int j = 0; j < 4; ++j) ss += (xv[i][j][0] * xv[i][j][0] + xv[i][j][1] * xv[i][j][1]) + (xv[i][j][2] * xv[i][j][2] + xv[i][j][3] * xv[i][j][3]);
                const float rstd = rsqrtf(wave_sum(ss) * (1.0f / D) + EPS);
#pragma unroll
                for (int j = 0; j < 4; ++j) { const f32x4 y = xv[i][j] * rstd * gk[j] + hk[j];
                    *((unsigned*)(XA8 + (size_t)row * D) + X.lane + 64 * j) = pk4_fp8(y[0] * FP8_AMUL, y[1] * FP8_AMUL, y[2] * FP8_AMUL, y[3] * FP8_AMUL);
                    *(LAS f32x4*)(ybuf + rl * 1024 + 4 * X.lane + 256 * j) = y; } }
            if (bt < 3) {
#pragma unroll
                for (int i = 0; i < 2; ++i)
#pragma unroll
                    for (int j = 0; j < 4; ++j) xv[i][j] = ((const f32x4*)(H + (size_t)(rowbase + 16 * (bt + 1) + 2 * X.wave + i) * D))[X.lane + 64 * j];
            }
            __syncthreads();
#pragma unroll 2
            for (int r = 0; r < 16; ++r) { float acc[4] = {0.f, 0.f, 0.f, 0.f}; const LAS float* yp = ybuf + r * 1024 + 128 * X.wave + 64 * hf;
#pragma unroll
                for (int i4 = 0; i4 < 16; ++i4) { const f32x4 yv = *(const LAS f32x4*)(yp + 4 * i4);
                    acc[i4 & 3] += yv[0] * wreg[4 * i4] + yv[1] * wreg[4 * i4 + 1] + yv[2] * wreg[4 * i4 + 2] + yv[3] * wreg[4 * i4 + 3]; }
                const float t0 = (acc[0] + acc[1]) + (acc[2] + acc[3]); const float t = t0 + dpp_swap32(t0);
                if (hf == 0) part[(r * 8 + X.wave) * 32 + e] = t; }
            __syncthreads();
            { const int r = 2 * X.wave + hf, rl = 16 * bt + r;
              float v = rbe;
#pragma unroll
              for (int w8 = 0; w8 < 8; ++w8) v += part[(r * 8 + w8) * 32 + e];
              lgs[r * 32 + e] = v; LDS_WAIT();
              int ez = e; asm volatile("" : "+v"(ez));
              int rank = 0;
#pragma unroll
              for (int j4 = 0; j4 < 8; ++j4) { const f32x4 o = *(const LAS f32x4*)(lgs + r * 32 + 4 * j4);
#pragma unroll
                  for (int c = 0; c < 4; ++c) rank += (o[c] > v || (o[c] == v && (4 * j4 + c) < ez)) ? 1 : 0; }
              if (rank == 0) tvs[r] = v;
              LDS_WAIT();
              const float ex = __expf(v - tvs[r]);
              if (rank < 4) exs[r * 4 + rank] = ex;
              LDS_WAIT();
              const f32x4 e4 = *(const LAS f32x4*)(exs + r * 4); const float inv = 1.0f / ((e4[0] + e4[1]) + (e4[2] + e4[3]));
              if (rank < 4) { const int slot = atomicAdd((int*)&lcnt[e], 1); sel[rl * 4 + rank] = (e << 16) | slot; gatew[(size_t)(rowbase + rl) * 4 + rank] = ex * inv; } }
        }
        __syncthreads();
        PMARK(2);
        if (X.tid < 32) lcnt[32 + X.tid] = atomicAdd(cntg + X.tid * CNT_STRIDE, lcnt[X.tid]);
        __syncthreads();
        if (X.tid < 256) { const int w = sel[X.tid]; const int ee = w >> 16, rank = w & 0xffff; list[(size_t)ee * NTOK + lcnt[32 + ee] + rank] = rowbase * 4 + X.tid; }
    }
    PMARK(3);
}

__device__ __forceinline__ void phase_combine(const Args& a, const Ctx& X, int layer) {
    float* H = (float*)(X.ws + WS_H); const bf16* __restrict__ Y = (const bf16*)(X.ws + WS_Y); bf16* XA = (bf16*)(X.ws + WS_XA);
    const float* __restrict__ MODl = (const float*)(X.ws + WS_MOD) + (size_t)layer * 9 * MODW;
    float* outp = (float*)(__attribute__((address_space(1))) float*)X.kp[33];
    for (int row = X.gw; row < NTOK; row += X.NGW) {
        const float* gt = MODl + (size_t)(row / SEQ) * MODW + 5 * 1024; f32x4 h[2][2], g[2][2]; u32x4 yw[2][4];
#pragma unroll
        for (int j = 0; j < 2; ++j) { const int c0 = 8 * X.lane + 512 * j;
#pragma unroll
            for (int q = 0; q < 2; ++q) { h[j][q] = *(const f32x4*)(H + (size_t)row * D + c0 + 4 * q); g[j][q] = *(const f32x4*)(gt + c0 + 4 * q); }
#pragma unroll
            for (int k = 0; k < 4; ++k) yw[j][k] = *(const u32x4*)(Y + ((size_t)row * 4 + k) * D + c0); }
        float ss = 0.f;
#pragma unroll
        for (int j = 0; j < 2; ++j) { f32x4 s0 = (f32x4){0.f, 0.f, 0.f, 0.f}, s1 = s0;
#pragma unroll
            for (int k = 0; k < 4; ++k) { const u32x4 w = yw[j][k]; s0 += (f32x4){bf2f(w.x & 0xffffu), bf2f(w.x >> 16), bf2f(w.y & 0xffffu), bf2f(w.y >> 16)}; s1 += (f32x4){bf2f(w.z & 0xffffu), bf2f(w.z >> 16), bf2f(w.w & 0xffffu), bf2f(w.w >> 16)}; }
            h[j][0] = h[j][0] + g[j][0] * s0; h[j][1] = h[j][1] + g[j][1] * s1;
#pragma unroll
            for (int q = 0; q < 2; ++q) ss += (h[j][q][0] * h[j][q][0] + h[j][q][1] * h[j][q][1]) + (h[j][q][2] * h[j][q][2] + h[j][q][3] * h[j][q][3]); }
        if (layer == 1) {
#pragma unroll
            for (int j = 0; j < 2; ++j)
#pragma unroll
                for (int q = 0; q < 2; ++q) *(f32x4*)(outp + (size_t)row * D + 8 * X.lane + 512 * j + 4 * q) = h[j][q];
        } else {
            const float* m1 = (const float*)(X.ws + WS_MOD) + (size_t)9 * MODW + (size_t)(row / SEQ) * MODW; const float* gn = IN(I_NMG) + D;
            f32x4 gk[2][2], hk[2][2], sk[2][2];
#pragma unroll
            for (int j = 0; j < 2; ++j)
#pragma unroll
                for (int q = 0; q < 2; ++q) { const int c0 = 8 * X.lane + 512 * j + 4 * q; gk[j][q] = *(const f32x4*)(gn + c0); hk[j][q] = *(const f32x4*)(m1 + c0); sk[j][q] = *(const f32x4*)(m1 + 1024 + c0); }
            const float rstd = rsqrtf(wave_sum(ss) * (1.0f / D) + EPS);
#pragma unroll
            for (int j = 0; j < 2; ++j) { const int c0 = 8 * X.lane + 512 * j;
                const f32x4 y0 = h[j][0] * rstd * gk[j][0] * (1.0f + sk[j][0]) + hk[j][0], y1 = h[j][1] * rstd * gk[j][1] * (1.0f + sk[j][1]) + hk[j][1];
                *(f32x4*)(H + (size_t)row * D + c0) = h[j][0]; *(f32x4*)(H + (size_t)row * D + c0 + 4) = h[j][1];
                *(u32x4*)(XA + (size_t)row * D + c0) = pack8(y0, y1); }
        }
    }
}

__device__ __forceinline__ void phase_spatial(const Args& a, const Ctx& X) {
    const bf16* U = (const bf16*)(X.ws + WS_U); const bf16* VB = (const bf16*)(X.ws + WS_VB); bf16* SG = (bf16*)(X.ws + WS_MIX); const bf16* WsB = (const bf16*)(X.ws + WS_WSB); const float* vstat = (const float*)(X.ws + WS_CTL) + CW_VSTAT;
    LAS float* stat = (LAS float*)X.lds;
    LAS unsigned char* Vt = X.lds + 4096;
    const int lane = X.lane, l15 = lane & 15, g4 = lane >> 4;
    for (int item = X.bid; item < 128 * 8; item += X.G) {
        const int chunk = item >> 3, g = item & 7; const int row0 = chunk * 128;
        __syncthreads();
        if (X.tid < 128) { const f32x2 sv = *(const f32x2*)(vstat + 2 * (row0 + X.tid)); const float mean = sv.x * (1.0f / D); const float var = fmaxf(sv.y * (1.0f / D) - mean * mean, 0.f);
            stat[2 * X.tid] = mean; stat[2 * X.tid + 1] = rsqrtf(var + EPS); }
        __syncthreads();
#pragma unroll
        for (int c = X.tid; c < 128 * 16; c += NTHREADS) { const int q = c >> 4, cc = c & 15; const u32x4 w = *(const u32x4*)(VB + (size_t)(row0 + q) * D + g * 128 + cc * 8);
            const float mean = stat[2 * q], rstd = stat[2 * q + 1]; const float* lg_ = IN(I_OLNG) + g * 128 + cc * 8; const float* lb_ = IN(I_OLNB) + g * 128 + cc * 8;
#pragma unroll
            for (int k = 0; k < 4; ++k) { const float y0 = (bf2f(w[k] & 0xffffu) - mean) * rstd * lg_[2 * k] + lb_[2 * k], y1 = (bf2f(w[k] >> 16) - mean) * rstd * lg_[2 * k + 1] + lb_[2 * k + 1];
                const unsigned pk = pk2(y0, y1);
                *(LAS unsigned short*)(Vt + ((2 * k) * 17 + cc) * 272 + q * 2) = (unsigned short)(pk & 0xffffu); *(LAS unsigned short*)(Vt + ((2 * k + 1) * 17 + cc) * 272 + q * 2) = (unsigned short)(pk >> 16); } }
        __syncthreads();
        f32x4 acc[8];
#pragma unroll
        for (int pb = 0; pb < 8; ++pb) acc[pb] = (f32x4){0.f, 0.f, 0.f, 0.f};
#pragma unroll
        for (int s = 0; s < 4; ++s) { const bf16x8 af = *(const LAS bf16x8*)(Vt + ((l15 & 7) * 17 + 2 * X.wave + (l15 >> 3)) * 272 + (32 * s + 8 * g4) * 2);
#pragma unroll
            for (int pb = 0; pb < 8; ++pb) { const bf16x8 bfr = *(const bf16x8*)(WsB + ((size_t)g * 128 + 16 * pb + l15) * 128 + 32 * s + 8 * g4); acc[pb] = __builtin_amdgcn_mfma_f32_16x16x32_bf16(af, bfr, acc[pb], 0, 0, 0); } }
#pragma unroll
        for (int pb = 0; pb < 8; ++pb) { const int p = 16 * pb + l15; const float bs = IN(I_OBS)[g * 128 + p]; const size_t off = (size_t)(row0 + p) * D + g * 128 + 16 * X.wave + 4 * g4;
            const u32x2 uw = *(const u32x2*)(U + off);
            u32x2 o; o.x = pk2(bf2f(uw.x & 0xffffu) * (acc[pb][0] + bs), bf2f(uw.x >> 16) * (acc[pb][1] + bs)); o.y = pk2(bf2f(uw.y & 0xffffu) * (acc[pb][2] + bs), bf2f(uw.y >> 16) * (acc[pb][3] + bs));
            *(u32x2*)(SG + off) = o; }
    }
}

enum { PH_PRO = 0, PH_MOD0, PH_GIN, PH_CONV, PH_ATT, PH_GOUT, PH_RT0, PH_M1_0, PH_M2_0, PH_CMB0, PH_GMI, PH_SPA, PH_GMO, PH_RT1, PH_M1_1, PH_M2_1, PH_CMB1, NPHASE };

__global__ void __launch_bounds__(NTHREADS, 2) mega(Args a) {
    extern __shared__ __attribute__((aligned(16))) unsigned char lds_raw[];
    Ctx X; X.lds = (LAS unsigned char*)lds_raw;
    const int wave0 = __builtin_amdgcn_readfirstlane((int)threadIdx.x >> 6);
    const int G0 = gridDim.x, bid0 = blockIdx.x; const int vcu0 = (G0 % 8 == 0) ? (bid0 % 8) * (G0 / 8) + bid0 / 8 : bid0;
    X.wave = wave0;
    volatile LAS unsigned* MISC = (volatile LAS unsigned*)(X.lds + MISC_OFF);
    if (threadIdx.x < 64) MISC[threadIdx.x] = 0u;
    __syncthreads();
    XcdBarrier bar = xcd_barrier_post((unsigned*)(a.ws + WS_CTL) + CW_BAR + a.li * XCD_BAR_WORDS, MISC + 8);
    const int ph_lo = a.ph_lo, ph_hi = a.ph_hi;
#if PROBE_PH >= 0
#define PROBE_STAMP(p) do { if ((p) == PROBE_PH) pr_t0 = __builtin_amdgcn_s_memrealtime(); if ((p) == PROBE_END) pr_t1 = __builtin_amdgcn_s_memrealtime(); } while (0)
#else
#define PROBE_STAMP(p) do { } while (0)
#endif
#define PH_ENTER() int z; asm volatile("s_mov_b32 %0, 0" : "=s"(z)); \
        X.lane = (int)__builtin_amdgcn_mbcnt_hi(~0u, __builtin_amdgcn_mbcnt_lo(~0u, (unsigned)z)); X.tid = wave0 * 64 + X.lane; \
        X.G = G0 + z; X.vcu = vcu0 + z; X.bid = bid0 + z; X.NGW = X.G * NWAVES; X.gw = X.vcu * NWAVES + wave0; \
        { kargp_t kp = (kargp_t)__builtin_amdgcn_kernarg_segment_ptr(); asm volatile("" : "+s"(kp)); X.kp = kp; } \
        unsigned char* ws = (unsigned char*)(__attribute__((address_space(1))) unsigned char*)X.kp[34] + z; X.ws = ws;
#if PROBE_PH >= 0
    unsigned long long pr_t0 = 0, pr_t1 = 0;
#endif
#define PH_RUN(PHK, ...) if (ph_lo <= (PHK) && (PHK) < ph_hi) { const int ph = (PHK); \
        if (ph != ph_lo) { const int l0 = (int)__builtin_amdgcn_mbcnt_hi(~0u, __builtin_amdgcn_mbcnt_lo(~0u, 0u)); xcd_barrier(bar, wave0 * 64 + l0); } \
        PROBE_STAMP(ph); __VA_ARGS__ }
    PH_RUN(PH_PRO, { PH_ENTER(); phase_prologue(a, X); })
    PH_RUN(PH_MOD0, { PH_ENTER(); phase_modulate0(a, X); })
    PH_RUN(PH_GIN, { PH_ENTER(); DenseSched S; S.init((const bf16*)(ws + WS_XA), (const bf16*)(ws + WS_WINT), NTOK, EVEN_IN, X.G, X.bid);
            S.A2 = (const bf16*)(ws + WS_GM); S.Bt2 = (const bf16*)(ws + WS_WINT) + (size_t)KV_COL * D; S.nM2 = NCTX / 256;
            EpiIn E{(bf16*)(ws + WS_GLU), (bf16*)(ws + WS_Q), (bf16*)(ws + WS_K), (bf16*)(ws + WS_V), (bf16*)(ws + WS_KC), (bf16*)(ws + WS_VC), IN(I_EBIN)};
            pg8::gemm_phase<EpiIn, DenseSched>(X.lds, S, E, X.tid); })
    PH_RUN(PH_CONV, { PH_ENTER(); phase_conv_qk(a, X); })
    PH_RUN(PH_ATT, { PH_ENTER(); phase_attention(a, X); })
    PH_RUN(PH_GOUT, { PH_ENTER(); DenseSched S; S.init((const bf16*)(ws + WS_MIX), (const bf16*)(ws + WS_WOUTT), NTOK, D, X.G, X.bid);
            EpiRes E{IN(I_X), (float*)(ws + WS_H), IN(I_EBOUT), (const float*)(ws + WS_MOD) + 2 * 1024};
            pg8::gemm_phase<EpiRes, DenseSched>(X.lds, S, E, X.tid); })
    PH_RUN(PH_RT0, { PH_ENTER(); phase_router(a, X, 0); })
    PH_RUN(PH_M1_0, { PH_ENTER(); const int l = (ph == PH_M1_1); moe_build_table(X, (const int*)(ws + WS_CTL) + CW_CNT + l * NE * CNT_STRIDE);
            MoeSchedT<true, 8> S; S.tab = (const LAS int*)(X.lds + TAB_OFF); S.G = X.G; S.c = X.vcu; S.A = (const unsigned char*)(ws + WS_XA8); S.Bt = (const unsigned char*)(ws + WS_W1T) + (size_t)l * NE * 2048 * 1024; S.list = (const int*)(ws + WS_LIST); S.meta = (const LAS int*)(X.lds + META_OFF);
            moe_stage_meta<false>(X, S, S.list, (const float*)nullptr, (LAS int*)(X.lds + META_OFF), IN(I_B1) + (size_t)l * NE * 2048, (LAS float*)(X.lds + BIAS_OFF));
            EpiSwiglu E{(unsigned char*)(ws + WS_ACT), (const LAS float*)(X.lds + BIAS_OFF)};
            pg8::gemm_phase<EpiSwiglu, MoeSchedT<true, 8>>(X.lds, S, E, X.tid); })
    PH_RUN(PH_M2_0, { PH_ENTER(); const int l = (ph == PH_M2_1); moe_build_table(X, (const int*)(ws + WS_CTL) + CW_CNT + l * NE * CNT_STRIDE);
            MoeSchedT<false, 4> S; S.tab = (const LAS int*)(X.lds + TAB_OFF); S.G = X.G; S.c = X.vcu; S.A = (const unsigned char*)(ws + WS_ACT); S.Bt = (const unsigned char*)(ws + WS_W2T) + (size_t)l * NE * 1024 * 1024; S.list = (const int*)(ws + WS_LIST); S.meta = (const LAS int*)(X.lds + META_OFF);
            moe_stage_meta<true>(X, S, S.list, (const float*)(ws + WS_GATE), (LAS int*)(X.lds + META_OFF), IN(I_B2) + (size_t)l * NE * D, (LAS float*)(X.lds + BIAS_OFF));
            EpiDown E{(bf16*)(ws + WS_Y), (const LAS float*)(X.lds + BIAS_OFF), (const LAS int*)(X.lds + META_OFF)};
            pg8::gemm_phase<EpiDown, MoeSchedT<false, 4>>(X.lds, S, E, X.tid); })
    PH_RUN(PH_CMB0, { PH_ENTER(); phase_combine(a, X, 0); })
    PH_RUN(PH_GMI, { PH_ENTER(); DenseSched S; S.init((const bf16*)(ws + WS_XA), (const bf16*)(ws + WS_GWINT), NTOK, 2048, X.G, X.bid);
            EpiGelu E{(bf16*)(ws + WS_U), (bf16*)(ws + WS_VB), IN(I_OBIN), (float*)(ws + WS_CTL) + CW_VSTAT};
            pg8::gemm_phase<EpiGelu, DenseSched>(X.lds, S, E, X.tid); })
    PH_RUN(PH_SPA, { PH_ENTER(); phase_spatial(a, X); })
    PH_RUN(PH_GMO, { PH_ENTER(); DenseSched S; S.init((const bf16*)(ws + WS_MIX), (const bf16*)(ws + WS_GWOUTT), NTOK, D, X.G, X.bid);
            EpiRes E{(const float*)(ws + WS_H), (float*)(ws + WS_H), IN(I_OBOUT), (const float*)(ws + WS_MOD) + (size_t)9 * MODW + 2 * 1024};
            pg8::gemm_phase<EpiRes, DenseSched>(X.lds, S, E, X.tid); })
    PH_RUN(PH_RT1, { PH_ENTER(); phase_router(a, X, 1); })
    PH_RUN(PH_M1_1, { PH_ENTER(); PMARK(50); const int l = (ph == PH_M1_1); moe_build_table(X, (const int*)(ws + WS_CTL) + CW_CNT + l * NE * CNT_STRIDE);
            MoeSchedT<true, 8> S; S.tab = (const LAS int*)(X.lds + TAB_OFF); S.G = X.G; S.c = X.vcu; S.A = (const unsigned char*)(ws + WS_XA8); S.Bt = (const unsigned char*)(ws + WS_W1T) + (size_t)l * NE * 2048 * 1024; S.list = (const int*)(ws + WS_LIST); S.meta = (const LAS int*)(X.lds + META_OFF);
            moe_stage_meta<false>(X, S, S.list, (const float*)nullptr, (LAS int*)(X.lds + META_OFF), IN(I_B1) + (size_t)l * NE * 2048, (LAS float*)(X.lds + BIAS_OFF));
            PMARK(51); EpiSwiglu E{(unsigned char*)(ws + WS_ACT), (const LAS float*)(X.lds + BIAS_OFF)};
            pg8::gemm_phase<EpiSwiglu, MoeSchedT<true, 8>>(X.lds, S, E, X.tid); PMARK(53); })
    PH_RUN(PH_M2_1, { PH_ENTER(); PMARK(54); const int l = (ph == PH_M2_1); moe_build_table(X, (const int*)(ws + WS_CTL) + CW_CNT + l * NE * CNT_STRIDE);
            MoeSchedT<false, 4> S; S.tab = (const LAS int*)(X.lds + TAB_OFF); S.G = X.G; S.c = X.vcu; S.A = (const unsigned char*)(ws + WS_ACT); S.Bt = (const unsigned char*)(ws + WS_W2T) + (size_t)l * NE * 1024 * 1024; S.list = (const int*)(ws + WS_LIST); S.meta = (const LAS int*)(X.lds + META_OFF);
            moe_stage_meta<true>(X, S, S.list, (const float*)(ws + WS_GATE), (LAS int*)(X.lds + META_OFF), IN(I_B2) + (size_t)l * NE * D, (LAS float*)(X.lds + BIAS_OFF));
            EpiDown E{(bf16*)(ws + WS_Y), (const LAS float*)(X.lds + BIAS_OFF), (const LAS int*)(X.lds + META_OFF)};
            pg8::gemm_phase<EpiDown, MoeSchedT<false, 4>>(X.lds, S, E, X.tid); })
    PH_RUN(PH_CMB1, { PH_ENTER(); phase_combine(a, X, 1); })
#if PROBE_PH == -2
    if (blockIdx.x == 0 && threadIdx.x == 0) { volatile LAS unsigned long long* pm_ = (volatile LAS unsigned long long*)(X.lds + MISC_OFF + 128); const unsigned long long te = __builtin_amdgcn_s_memrealtime(); const unsigned long long span = (pm_[1] - pm_[0]) * PROBE_MULT;
        while (__builtin_amdgcn_s_memrealtime() - te < span) __builtin_amdgcn_s_sleep(8); }
#endif
#if PROBE_PH >= 0
    if (pr_t1 == 0) pr_t1 = __builtin_amdgcn_s_memrealtime();
    if (blockIdx.x == 0 && wave0 == 0) { const unsigned long long te = __builtin_amdgcn_s_memrealtime(); const unsigned long long span = (pr_t1 - pr_t0) * PROBE_MULT;
        while (__builtin_amdgcn_s_memrealtime() - te < span) __builtin_amdgcn_s_sleep(8); }
#endif
}

__device__ __forceinline__ bool find_expert(const int* cnt, int s, int& e, int& slot) {
    int pb = 0;
    for (int i = 0; i < NE; ++i) { const int c = cnt[i * CNT_STRIDE]; const int pr = ((c + 255) >> 8) << 8; if (s < pb + pr) { e = i; slot = s - pb; return true; } pb += pr; }
    return false;
}
__global__ void __launch_bounds__(256) slow_gemm(const bf16* A, const int* arow, const bf16* Bt, float* C, int N, const int* cnt, size_t bstride) {
    __shared__ float As[16][65], Bs[16][65];
    const int tx = threadIdx.x & 15, ty = threadIdx.x >> 4; const int m0 = blockIdx.y * 64, n0 = blockIdx.x * 64;
    if (cnt) { int e, slot; if (!find_expert(cnt, m0, e, slot)) return; Bt += (size_t)e * bstride; }
    float acc[4][4];
    for (int i = 0; i < 4; ++i) for (int j = 0; j < 4; ++j) acc[i][j] = 0.f;
    for (int k0 = 0; k0 < 1024; k0 += 16) {
        for (int i = 0; i < 4; ++i) { const int idx = threadIdx.x + 256 * i; const int r = idx >> 4, kk = idx & 15; const int gm = m0 + r; const int ar = arow ? arow[gm] : gm;
            As[kk][r] = bf2f(A[(size_t)ar * 1024 + k0 + kk]); Bs[kk][r] = bf2f(Bt[(size_t)(n0 + r) * 1024 + k0 + kk]); }
        __syncthreads();
        for (int kk = 0; kk < 16; ++kk) { float av[4], bv[4];
            for (int i = 0; i < 4; ++i) { av[i] = As[kk][ty * 4 + i]; bv[i] = Bs[kk][tx * 4 + i]; }
            for (int i = 0; i < 4; ++i) for (int j = 0; j < 4; ++j) acc[i][j] += av[i] * bv[j]; }
        __syncthreads();
    }
    for (int i = 0; i < 4; ++i) for (int j = 0; j < 4; ++j) C[(size_t)(m0 + ty * 4 + i) * N + n0 + tx * 4 + j] = acc[i][j];
}
__device__ __forceinline__ unsigned short f2bf_s(float f) { return (unsigned short)(pk2(f, 0.f) & 0xffffu); }
__global__ void slow_epi_in(const float* C, const float* C2, const float* bias, bf16* GLU, bf16* Q, bf16* Kb, bf16* Vb, bf16* KC, bf16* VC) {
    const size_t i = (size_t)blockIdx.x * blockDim.x + threadIdx.x;
    if (i < (size_t)NTOK * 512) { const int row = (int)(i >> 9), j = (int)(i & 511); const int t = j >> 7, ii = j & 127; const float* cr = C + (size_t)row * EVEN_IN;
        const float u = cr[t * 256 + ii] + bias[j], g = cr[t * 256 + 128 + ii] + bias[512 + j];
        GLU[i] = f2bf_s(u / (1.0f + expf(-g)));
        Q[i] = f2bf_s(cr[1024 + j] + bias[1024 + j]);
        if (j < 128) { Kb[(size_t)row * 128 + j] = f2bf_s(cr[1536 + j] + bias[1536 + j]); Vb[(size_t)row * 128 + j] = f2bf_s(cr[1664 + j] + bias[1664 + j]); }
        if (row < NCTX && j < 128) { KC[(size_t)row * 128 + j] = f2bf_s(C2[(size_t)row * 256 + j] + bias[1536 + j]); VC[(size_t)row * 128 + j] = f2bf_s(C2[(size_t)row * 256 + 128 + j] + bias[1664 + j]); } }
}
__global__ void slow_epi_res(const float* C, const float* base, float* out, const float* bias, const float* gate) {
    const size_t i = (size_t)blockIdx.x * blockDim.x + threadIdx.x;
    if (i < (size_t)NTOK * D) { const int row = (int)(i >> 10), col = (int)(i & 1023); out[i] = base[i] + gate[(size_t)(row / SEQ) * MODW + col] * (C[i] + bias[col]); }
}
__global__ void slow_epi_gelu(const float* C, const float* bias, bf16* U, bf16* V) {
    const size_t i = (size_t)blockIdx.x * blockDim.x + threadIdx.x;
    if (i < (size_t)NTOK * 2048) { const int row = (int)(i >> 11), col = (int)(i & 2047); const float x = C[i] + bias[col]; const float y = 0.5f * x * (1.0f + erff(x * 0.70710678118654752f));
        if (col < 1024) U[(size_t)row * D + col] = f2bf_s(y); else V[(size_t)row * D + col - 1024] = f2bf_s(y); }
}
__global__ void slow_arow(const int* cnt, const int* list, int* arow) {
    const int s = blockIdx.x * blockDim.x + threadIdx.x; if (s >= ACT_ROWS) return;
    int e, slot; int r = 0; if (find_expert(cnt, s, e, slot) && slot < cnt[e * CNT_STRIDE]) r = list[(size_t)e * NTOK + slot] >> 2;
    arow[s] = r;
}
__global__ void slow_epi_swiglu(const float* C, const int* cnt, const float* b1, bf16* ACT) {
    const size_t i = (size_t)blockIdx.x * blockDim.x + threadIdx.x;
    if (i < (size_t)ACT_ROWS * 1024) { const int s = (int)(i >> 10), j = (int)(i & 1023); int e, slot; if (!find_expert(cnt, s, e, slot)) return;
        const int t = j >> 7, ii = j & 127; const float* cr = C + (size_t)s * 2048;
        float g = cr[t * 256 + ii] + b1[(size_t)e * 2048 + j], up = cr[t * 256 + 128 + ii] + b1[(size_t)e * 2048 + 1024 + j];
        g = fminf(g, 7.0f); up = fminf(fmaxf(up, -7.0f), 7.0f);
        ACT[i] = f2bf_s((up + 1.0f) * g / (1.0f + expf(-1.702f * g))); }
}
__global__ void slow_epi_down(const float* C, const int* cnt, const int* list, const float* gatew, const float* b2, bf16* Y) {
    const size_t i = (size_t)blockIdx.x * blockDim.x + threadIdx.x;
    if (i < (size_t)ACT_ROWS * 1024) { const int s = (int)(i >> 10), col = (int)(i & 1023); int e, slot; if (!find_expert(cnt, s, e, slot) || slot >= cnt[e * CNT_STRIDE]) return;
        const int aid = list[(size_t)e * NTOK + slot]; Y[(size_t)aid * D + col] = f2bf_s((C[i] + b2[(size_t)e * D + col]) * gatew[aid]); }
}
__global__ void __launch_bounds__(64) slow_attention(const bf16* QN, const bf16* KN, const bf16* VV, const bf16* KC, const bf16* VC, const float* sink, bf16* MIX) {
    const int i = blockIdx.x * blockDim.x + threadIdx.x; if (i >= NTOK * 8) return;
    const int row = i >> 3, h = i & 7, kh = h >> 2, b = row / SEQ, t = row % SEQ;
    float q[64], o[64];
    for (int d = 0; d < 64; ++d) { q[d] = bf2f(QN[(size_t)row * 512 + h * 64 + d]); o[d] = 0.f; }
    float m = sink[h] * LOG2E, l = 1.0f;
    const int j0 = t - 128 < 0 ? 0 : t - 128, j1 = t + 128 > SEQ - 1 ? SEQ - 1 : t + 128;
    for (int jj = j0; jj <= j1 + CTXL; ++jj) {
        const bf16* kp; const bf16* vp;
        if (jj <= j1) { kp = KN + (size_t)(b * SEQ + jj) * 128 + kh * 64; vp = VV + (size_t)(b * SEQ + jj) * 128 + kh * 64; }
        else { const int c = jj - j1 - 1; kp = KC + (size_t)(b * CTXL + c) * 128 + kh * 64; vp = VC + (size_t)(b * CTXL + c) * 128 + kh * 64; }
        float s = 0.f; for (int d = 0; d < 64; ++d) s += q[d] * bf2f(kp[d]);
        const float mn = fmaxf(m, s), al = exp2f(m - mn), p = exp2f(s - mn); m = mn; l = l * al + p;
        for (int d = 0; d < 64; ++d) o[d] = o[d] * al + p * bf2f(vp[d]);
    }
    for (int d = 0; d < 64; ++d) MIX[(size_t)row * D + 512 + h * 64 + d] = f2bf_s(o[d] / l);
}
__global__ void slow_vstats(const bf16* VB, float* stat) {
    const int row = blockIdx.x * blockDim.x + threadIdx.x; if (row >= NTOK) return;
    float s = 0.f; for (int c = 0; c < D; ++c) s += bf2f(VB[(size_t)row * D + c]); const float mean = s / D;
    float s2 = 0.f; for (int c = 0; c < D; ++c) { const float d = bf2f(VB[(size_t)row * D + c]) - mean; s2 += d * d; }
    stat[2 * row] = mean; stat[2 * row + 1] = rsqrtf(s2 / D + EPS);
}
__global__ void slow_spatial(const bf16* U, const bf16* VB, const float* stat, const float* ws, const float* bs, const float* lng, const float* lnb, bf16* SG) {
    const size_t i = (size_t)blockIdx.x * blockDim.x + threadIdx.x;
    if (i < (size_t)NTOK * D) { const int row = (int)(i >> 10), ch = (int)(i & 1023); const int g = ch >> 7, p = row & 127, r0 = row - p;
        float s = 0.f;
        for (int q = 0; q < 128; ++q) { const float vn = (bf2f(VB[(size_t)(r0 + q) * D + ch]) - stat[2 * (r0 + q)]) * stat[2 * (r0 + q) + 1] * lng[ch] + lnb[ch]; s += ws[((size_t)g * 128 + p) * 128 + q] * vn; }
        SG[i] = f2bf_s(bf2f(U[i]) * (s + bs[g * 128 + p])); }
}

static void launch_mega(Args& a, int lo, int hi, int& li, int grid, hipStream_t stream) {
    a.ph_lo = lo; a.ph_hi = hi; a.li = li++;
    hipLaunchKernelGGL(mega, dim3(grid), dim3(NTHREADS), LDS_BYTES, stream, a);
}
extern "C" void kernel_launch(void* const* d_in, const int* in_sizes, int n_in, void* d_out, int out_size, void* d_ws, size_t ws_size, hipStream_t stream) {
    static int grid = 0;
    if (grid == 0) {
        if (n_in != 33 || out_size != NTOK * D || ws_size < WS_END) { fprintf(stderr, "kernel_launch: unexpected problem (n_in %d, out %d, ws %zu)\n", n_in, out_size, ws_size); grid = -1; return; }
        int dev = 0, cus = 0, per_cu = 0;
        if (hipGetDevice(&dev) != hipSuccess || hipDeviceGetAttribute(&cus, hipDeviceAttributeMultiprocessorCount, dev) != hipSuccess) { grid = -1; return; }
        if (hipFuncSetAttribute((const void*)mega, hipFuncAttributeMaxDynamicSharedMemorySize, LDS_BYTES) != hipSuccess) { fprintf(stderr, "kernel_launch: hipFuncSetAttribute failed\n"); grid = -1; return; }
        if (hipOccupancyMaxActiveBlocksPerMultiprocessor(&per_cu, (const void*)mega, NTHREADS, LDS_BYTES) != hipSuccess || per_cu < 1) { fprintf(stderr, "kernel_launch: occupancy query says %d blocks per CU\n", per_cu); per_cu = 1; }
        (void)hipGetLastError();
        grid = cus;
    }
    if (grid < 0) return;
    unsigned char* ws = (unsigned char*)d_ws;
    (void)hipMemsetAsync(ws + WS_CTL, 0, CTL_ZERO_BYTES, stream);
    Args a{};
    for (int i = 0; i < 33; ++i) a.in[i] = (const float*)d_in[i];
    a.out = (float*)d_out; a.ws = ws;
    int li = 0;
    const float* in_[33]; for (int i = 0; i < 33; ++i) in_[i] = (const float*)d_in[i];
    float* CF = (float*)(ws + WS_CF); float* MOD = (float*)(ws + WS_MOD); int* CNT = (int*)(ws + WS_CTL) + CW_CNT;
    int lo = 0;
    auto flush = [&](int upto) { if (upto > lo) launch_mega(a, lo, upto, li, grid, stream); };
    for (int ph = 0; ph < NPHASE; ++ph) {
        bool slow = false;
        switch (ph) {
        case PH_GIN: slow = SLOW_MASK & 1; break;
        case PH_ATT: slow = SLOW_MASK & 2; break;
        case PH_GOUT: case PH_GMO: slow = SLOW_MASK & 4; break;
        case PH_M1_0: case PH_M1_1: slow = SLOW_MASK & 8; break;
        case PH_M2_0: case PH_M2_1: slow = SLOW_MASK & 16; break;
        case PH_GMI: slow = SLOW_MASK & 32; break;
        case PH_SPA: slow = SLOW_MASK & 64; break;
        default: break;
        }
        if (!slow) continue;
        flush(ph); lo = ph + 1;
        const int l = (ph == PH_M1_1 || ph == PH_M2_1) ? 1 : 0;
        switch (ph) {
        case PH_GIN:
            hipLaunchKernelGGL(slow_gemm, dim3(EVEN_IN / 64, NTOK / 64), dim3(256), 0, stream, (const bf16*)(ws + WS_XA), (const int*)nullptr, (const bf16*)(ws + WS_WINT), CF, EVEN_IN, (const int*)nullptr, (size_t)0);
            hipLaunchKernelGGL(slow_gemm, dim3(256 / 64, NCTX / 64), dim3(256), 0, stream, (const bf16*)(ws + WS_GM), (const int*)nullptr, (const bf16*)(ws + WS_WINT) + (size_t)KV_COL * D, CF + (size_t)NTOK * EVEN_IN, 256, (const int*)nullptr, (size_t)0);
            hipLaunchKernelGGL(slow_epi_in, dim3(NTOK * 512 / 256), dim3(256), 0, stream, (const float*)CF, (const float*)(CF + (size_t)NTOK * EVEN_IN), in_[I_EBIN], (bf16*)(ws + WS_GLU), (bf16*)(ws + WS_Q), (bf16*)(ws + WS_K), (bf16*)(ws + WS_V), (bf16*)(ws + WS_KC), (bf16*)(ws + WS_VC));
            break;
        case PH_ATT:
            hipLaunchKernelGGL(slow_attention, dim3(NTOK * 8 / 64), dim3(64), 0, stream, (const bf16*)(ws + WS_Q), (const bf16*)(ws + WS_K), (const bf16*)(ws + WS_V), (const bf16*)(ws + WS_KC), (const bf16*)(ws + WS_VC), in_[I_SINK], (bf16*)(ws + WS_MIX));
            break;
        case PH_GOUT:
            hipLaunchKernelGGL(slow_gemm, dim3(D / 64, NTOK / 64), dim3(256), 0, stream, (const bf16*)(ws + WS_MIX), (const int*)nullptr, (const bf16*)(ws + WS_WOUTT), CF, D, (const int*)nullptr, (size_t)0);
            hipLaunchKernelGGL(slow_epi_res, dim3(NTOK * D / 256), dim3(256), 0, stream, (const float*)CF, in_[I_X], (float*)(ws + WS_H), in_[I_EBOUT], (const float*)(MOD + 2 * 1024));
            break;
        case PH_GMO:
            hipLaunchKernelGGL(slow_gemm, dim3(D / 64, NTOK / 64), dim3(256), 0, stream, (const bf16*)(ws + WS_MIX), (const int*)nullptr, (const bf16*)(ws + WS_GWOUTT), CF, D, (const int*)nullptr, (size_t)0);
            hipLaunchKernelGGL(slow_epi_res, dim3(NTOK * D / 256), dim3(256), 0, stream, (const float*)CF, (const float*)(ws + WS_H), (float*)(ws + WS_H), in_[I_OBOUT], (const float*)(MOD + (size_t)9 * MODW + 2 * 1024));
            break;
        case PH_M1_0: case PH_M1_1:
            hipLaunchKernelGGL(slow_arow, dim3(ACT_ROWS / 256), dim3(256), 0, stream, (const int*)(CNT + l * NE * CNT_STRIDE), (const int*)(ws + WS_LIST), (int*)(ws + WS_AROW));
            hipLaunchKernelGGL(slow_gemm, dim3(2048 / 64, ACT_ROWS / 64), dim3(256), 0, stream, (const bf16*)(ws + WS_XA), (const int*)(ws + WS_AROW), (const bf16*)(ws + WS_W1T) + (size_t)l * NE * 2048 * 1024, CF, 2048, (const int*)(CNT + l * NE * CNT_STRIDE), (size_t)2048 * 1024);
            hipLaunchKernelGGL(slow_epi_swiglu, dim3(ACT_ROWS * 1024 / 256), dim3(256), 0, stream, (const float*)CF, (const int*)(CNT + l * NE * CNT_STRIDE), in_[I_B1] + (size_t)l * NE * 2048, (bf16*)(ws + WS_ACT));
            break;
        case PH_M2_0: case PH_M2_1:
            hipLaunchKernelGGL(slow_gemm, dim3(1024 / 64, ACT_ROWS / 64), dim3(256), 0, stream, (const bf16*)(ws + WS_ACT), (const int*)nullptr, (const bf16*)(ws + WS_W2T) + (size_t)l * NE * 1024 * 1024, CF, 1024, (const int*)(CNT + l * NE * CNT_STRIDE), (size_t)1024 * 1024);
            hipLaunchKernelGGL(slow_epi_down, dim3(ACT_ROWS * 1024 / 256), dim3(256), 0, stream, (const float*)CF, (const int*)(CNT + l * NE * CNT_STRIDE), (const int*)(ws + WS_LIST), (const float*)(ws + WS_GATE), in_[I_B2] + (size_t)l * NE * D, (bf16*)(ws + WS_Y));
            break;
        case PH_GMI:
            hipLaunchKernelGGL(slow_gemm, dim3(2048 / 64, NTOK / 64), dim3(256), 0, stream, (const bf16*)(ws + WS_XA), (const int*)nullptr, (const bf16*)(ws + WS_GWINT), CF, 2048, (const int*)nullptr, (size_t)0);
            hipLaunchKernelGGL(slow_epi_gelu, dim3(NTOK * 2048 / 256), dim3(256), 0, stream, (const float*)CF, in_[I_OBIN], (bf16*)(ws + WS_U), (bf16*)(ws + WS_VB));
            break;
        case PH_SPA:
            hipLaunchKernelGGL(slow_vstats, dim3(NTOK / 64), dim3(64), 0, stream, (const bf16*)(ws + WS_VB), CF);
            hipLaunchKernelGGL(slow_spatial, dim3(NTOK * D / 256), dim3(256), 0, stream, (const bf16*)(ws + WS_U), (const bf16*)(ws + WS_VB), (const float*)CF, in_[I_OWS], in_[I_OBS], in_[I_OLNG], in_[I_OLNB], (bf16*)(ws + WS_MIX));
            break;
        default: break;
        }
    }
    flush(NPHASE);
}
```

```cpp
#include <hip/hip_runtime.h>
#include <cstdio>
#include <cstdint>

#ifndef SLOW_MASK
#define SLOW_MASK 0x00
#endif

#ifndef EXP_STREAM
#define EXP_STREAM 0
#endif
#ifndef PROBE_PH
#define PROBE_PH (-1)
#endif
#ifndef PROBE_END
#define PROBE_END (PROBE_PH + 1)
#endif
#ifndef PROBE_A
#define PROBE_A (-1)
#define PROBE_B (-1)
#endif
#ifndef PROBE_MULT
#define PROBE_MULT 4
#endif

#define LAS __attribute__((address_space(3)))
typedef unsigned short bf16;
typedef short bf16x8 __attribute__((ext_vector_type(8)));
typedef float f32x4 __attribute__((ext_vector_type(4)));
typedef float f32x2 __attribute__((ext_vector_type(2)));
typedef unsigned u32x4 __attribute__((ext_vector_type(4)));
typedef unsigned u32x2 __attribute__((ext_vector_type(2)));
typedef __bf16 bf16x2_t __attribute__((ext_vector_type(2)));

constexpr int NB = 8, SEQ = 2048, D = 1024, NTOK = NB * SEQ, CTXL = 256, NCTX = NB * CTXL;
constexpr int NE = 32, TOPK = 4, NASSIGN = NTOK * TOPK, ACT_ROWS = NASSIGN + NE * 256;
constexpr int EVEN_IN = 1792, KV_COL = 1536;
constexpr float EPS = 1e-6f, LOG2E = 1.4426950408889634f;
constexpr float QSCALE = 0.125f * LOG2E;
constexpr int MODW = 6 * D;
constexpr int NWAVES = 8, NTHREADS = 512;

constexpr size_t MiB = 1u << 20;
constexpr size_t WS_CTL = 0, CTL_ZERO_BYTES = 1 * MiB;
constexpr size_t WS_MOD = 1 * MiB;
constexpr size_t WS_LIST = 2 * MiB;
constexpr size_t WS_GATE = 4 * MiB;
constexpr size_t WS_WSB = 5 * MiB;
constexpr size_t WS_WINT = 6 * MiB;
constexpr size_t WS_WOUTT = 10 * MiB;
constexpr size_t WS_GWINT = 12 * MiB;
constexpr size_t WS_GWOUTT = 16 * MiB;
constexpr size_t WS_KC = 18 * MiB;
constexpr size_t WS_VC = 18 * MiB + 512 * 1024;
constexpr size_t WS_K = 19 * MiB;
constexpr size_t WS_V = 23 * MiB;
constexpr size_t WS_GM = 27 * MiB;
constexpr size_t WS_AROW = 31 * MiB;
constexpr size_t WS_Q = 32 * MiB;
constexpr size_t WS_GLU = 48 * MiB;
constexpr size_t WS_XA = 64 * MiB;
constexpr size_t WS_MIX = 96 * MiB;
constexpr size_t WS_H = 128 * MiB;
constexpr size_t WS_U = 192 * MiB;
constexpr size_t WS_VB = 224 * MiB;
constexpr size_t WS_W1T = 256 * MiB;
constexpr size_t WS_W2T = 512 * MiB;
constexpr size_t WS_ACT = 640 * MiB;
constexpr size_t WS_Y = 784 * MiB;
constexpr size_t WS_XA8 = 912 * MiB;
constexpr size_t WS_CF = 928 * MiB;
constexpr size_t WS_END = 1504 * MiB;
constexpr int CW_BAR = 4096, CW_CNT = 131072, CNT_STRIDE = 64  , CW_VSTAT = 147456;
constexpr int MAX_LAUNCH = 20;

constexpr int RING_BYTES = 131072;
constexpr int MISC_OFF = RING_BYTES;
constexpr int TAB_OFF = RING_BYTES + 256;
constexpr int META_OFF = RING_BYTES + 3072;
constexpr int BIAS_OFF = META_OFF + 10240;
constexpr int LDS_BYTES = 163840;

#define LDS_WAIT() asm volatile("s_waitcnt lgkmcnt(0)" ::: "memory")
#define VM_WAIT() asm volatile("s_waitcnt vmcnt(0)" ::: "memory")

__device__ __forceinline__ float bf2f(unsigned b) { return __uint_as_float(b << 16); }
__device__ __forceinline__ unsigned pk2(float lo, float hi) { f32x2 v = {lo, hi}; bf16x2_t b = __builtin_convertvector(v, bf16x2_t); return __builtin_bit_cast(unsigned, b); }
template <int CTRL, int ROW_MASK> __device__ __forceinline__ float dpp_f(float old, float src) { return __builtin_bit_cast(float, __builtin_amdgcn_update_dpp(__builtin_bit_cast(int, old), __builtin_bit_cast(int, src), CTRL, ROW_MASK, 0xf, false)); }
__device__ __forceinline__ unsigned pk4_fp8(float a, float b, float c, float d) { int w = 0; w = __builtin_amdgcn_cvt_pk_fp8_f32(a, b, w, false); w = __builtin_amdgcn_cvt_pk_fp8_f32(c, d, w, true); return (unsigned)w; }
__device__ __forceinline__ float wave_sum(float v) {
    v += dpp_f<0xB1, 0xf>(0.f, v);
    v += dpp_f<0x4E, 0xf>(0.f, v);
    v += dpp_f<0x141, 0xf>(0.f, v);
    v += dpp_f<0x140, 0xf>(0.f, v);
    v += dpp_f<0x142, 0xa>(0.f, v);
    v += dpp_f<0x143, 0xc>(0.f, v);
    return __builtin_bit_cast(float, __builtin_amdgcn_readlane(__builtin_bit_cast(int, v), 63));
}
__device__ __forceinline__ float dpp_swap32(float v) { return __shfl_xor(v, 32); }
__device__ __forceinline__ float sigmoidf_(float x) { return __builtin_amdgcn_rcpf(1.0f + __builtin_amdgcn_exp2f(-x * LOG2E)); }

#define XB_TMO      128
#define XB_XCNT(j)  (256  + 64 * (j))
#define XB_XSUB(j)  (1280 + 64 * (j))
#define XB_XGEN(j)  (2304 + 64 * (j))
#define XB_TOP      3328
#define XB_TOPGEN   3392
#define XCD_BAR_WORDS 3456
#define XB_SPIN_CAP (1u << 20)
__device__ __forceinline__ unsigned xb_ld(unsigned* p)              { return __hip_atomic_load(p, __ATOMIC_RELAXED, __HIP_MEMORY_SCOPE_AGENT); }
__device__ __forceinline__ unsigned xb_add(unsigned* p, unsigned v) { return __hip_atomic_fetch_add(p, v, __ATOMIC_RELAXED, __HIP_MEMORY_SCOPE_AGENT); }
__device__ __forceinline__ unsigned xb_xcc_id() { return (unsigned)__builtin_amdgcn_s_getreg((3 << 11) | 20) & 0xFu; }
#define XB_SPIN(cond, bar) do { unsigned _sp = 0; while (cond) { __builtin_amdgcn_s_sleep(1); \
    if ((++_sp & 255u) == 0u) { if (xb_ld(&(bar)[XB_TMO])) break; if (_sp > XB_SPIN_CAP) { atomicAdd(&(bar)[XB_TMO], 1u); break; } } } } while (0)
struct XcdBarrier { unsigned* bar; unsigned x; volatile LAS unsigned* st; };
__device__ __forceinline__ XcdBarrier xcd_barrier_post(unsigned* bar, volatile LAS unsigned* st) {
    XcdBarrier b; b.bar = bar; b.x = xb_xcc_id(); b.st = st;
    if (threadIdx.x == 0) (void)xb_add(&bar[XB_XCNT(b.x)], 1u);
    return b;
}
__device__ __forceinline__ void xcd_barrier_complete(unsigned* bar, unsigned x, unsigned& nloc, unsigned& nx) {
    const unsigned G = gridDim.x * gridDim.y * gridDim.z;
    unsigned sum, cnt, mine, sp = 0u;
    for (;;) {
        sum = 0u; cnt = 0u; mine = 0u;
#pragma unroll
        for (unsigned j = 0; j < 16; ++j) { const unsigned c = xb_ld(&bar[XB_XCNT(j)]); sum += c; cnt += (c > 0u) ? 1u : 0u; mine = (j == x) ? c : mine; }
        if (sum == G) break;
        __builtin_amdgcn_s_sleep(1);
        if ((++sp & 255u) == 0u) { if (xb_ld(&bar[XB_TMO])) break; if (sp > XB_SPIN_CAP) { atomicAdd(&bar[XB_TMO], 1u); break; } }
    }
    nloc = mine > 0u ? mine : 1u; nx = cnt > 0u ? cnt : 1u;
}
__device__ __forceinline__ void xcd_barrier(const XcdBarrier& b, const int tid) {
    asm volatile("s_waitcnt vmcnt(0)" ::: "memory");
    __syncthreads();
    if (tid == 0) {
        unsigned* bar = b.bar;
        __builtin_amdgcn_s_waitcnt(0);
        unsigned nloc = b.st[0], nx = b.st[1];
        if (nloc == 0u) { xcd_barrier_complete(bar, b.x, nloc, nx); b.st[0] = nloc; b.st[1] = nx; }
        const unsigned old = xb_add(&bar[XB_XSUB(b.x)], 1u);
        const unsigned gen = old / nloc;
        if (old + 1u == (gen + 1u) * nloc) {
            __builtin_amdgcn_fence(__ATOMIC_RELEASE, "agent");
            asm volatile("s_waitcnt vmcnt(0)" ::: "memory");
            const unsigned og = xb_add(&bar[XB_TOP], 1u);
            const unsigned tg = og / nx;
            if (og + 1u == (tg + 1u) * nx) xb_add(&bar[XB_TOPGEN], 1u);
            else XB_SPIN(xb_ld(&bar[XB_TOPGEN]) == tg, bar);
            __builtin_amdgcn_fence(__ATOMIC_ACQUIRE, "agent");
            xb_add(&bar[XB_XGEN(b.x)], 1u);
            asm volatile("s_waitcnt vmcnt(0)" ::: "memory");
        } else {
            XB_SPIN(xb_ld(&bar[XB_XGEN(b.x)]) == gen, bar);
            __builtin_amdgcn_fence(__ATOMIC_ACQUIRE, "agent");
            asm volatile("s_waitcnt vmcnt(0)" ::: "memory");
        }
    }
    __syncthreads();
}

constexpr float FP8_WMUL = 32.0f, FP8_AMUL = 4.0f, FP8_DESCALE = 1.0f / (32.0f * 4.0f);
#if PROBE_PH == -2
#define GMARK(k) do { if (Sched::GATHER && ui == 0 && blockIdx.x == 0 && tid == 0) { volatile LAS unsigned long long* pm_ = (volatile LAS unsigned long long*)(lds + MISC_OFF + 128); \
    if ((k) == PROBE_A) pm_[0] = __builtin_amdgcn_s_memrealtime(); if ((k) == PROBE_B) pm_[1] = __builtin_amdgcn_s_memrealtime(); } } while (0)
#define GMARK1(k) do { if (Sched::GATHER && ui == 1 && blockIdx.x == 0 && tid == 0) { volatile LAS unsigned long long* pm_ = (volatile LAS unsigned long long*)(lds + MISC_OFF + 128); \
    if ((k) == PROBE_A) pm_[0] = __builtin_amdgcn_s_memrealtime(); if ((k) == PROBE_B) pm_[1] = __builtin_amdgcn_s_memrealtime(); } } while (0)
#else
#define GMARK(k) do { } while (0)
#define GMARK1(k) do { } while (0)
#endif
namespace pg8 {
constexpr int BM = 256, BK = 64, HALF = 128, HTB = HALF * BK * 2, STAGE_BYTES = 8 * HTB, KD = 1024  ;
__host__ __device__ __forceinline__ int lds_byte(int r, int c) { const int st = (r >> 4) * 2 + (c >> 5), rr = r & 15, cc = c & 31, ob = rr * 64 + cc * 2; return st * 1024 + (ob ^ (((ob >> 9) & 1) << 5)); }
__host__ __device__ __forceinline__ void stage_rc(int b, int& R, int& C) { const int st = b / 1024, sb = b % 1024, swz = sb ^ (((sb >> 9) & 1) << 5); R = (st >> 1) * 16 + swz / 64; C = (st & 1) * 32 + (swz % 64) / 2; }
__host__ __device__ __forceinline__ int perm32(int rho) { const int n = rho >> 4, i = rho & 15; return 8 * (i >> 2) + 4 * n + (i & 3); }

typedef int v8i_t __attribute__((ext_vector_type(8)));
__device__ __forceinline__ v8i_t cat8(bf16x8 a, bf16x8 b) { typedef int v4i_t __attribute__((ext_vector_type(4))); const v4i_t x = __builtin_bit_cast(v4i_t, a), y = __builtin_bit_cast(v4i_t, b); return __builtin_shufflevector(x, y, 0, 1, 2, 3, 4, 5, 6, 7); }
struct Unit { int pm, pn, e, cnt, idx; };

template <class Epi, class Sched>
__device__ __forceinline__ void gemm_phase(LAS unsigned char* lds, const Sched& S, const Epi& E, const int tid) {
    const int wid = __builtin_amdgcn_readfirstlane(tid >> 6), lane = tid & 63, wr = wid >> 2, wc = wid & 3, fr = lane & 15, fq = lane >> 4;
    constexpr int RP = Sched::FP8 ? 1024 : 2048  , nt = RP / 128;
    int Rr[2], Cc[2];
    unsigned voffA[2][2], voffB[2];
#pragma unroll
    for (int i = 0; i < 2; ++i) { stage_rc(tid * 16 + i * 8192, Rr[i], Cc[i]); const int Rb = Epi::PERM ? ((Rr[i] & ~31) + perm32(Rr[i] & 31)) : Rr[i];
        voffB[i] = (unsigned)(Rb * RP + Cc[i] * 2); }
    constexpr size_t kstep = (size_t)(BK * 2);
    constexpr size_t hstep = (size_t)HALF * RP;
    const unsigned ldsw = (unsigned)wid * 1024u;
    const int aoff = lds_byte(wr * 64 + fr, fq * 8), boff = lds_byte(wc * 32 + fr, fq * 8);
#define PG8_SA(b, h) (((b) * 2 + (h)) * HTB)
#define PG8_SB(b, h) ((4 + (b) * 2 + (h)) * HTB)
#define PG8_STAGE(bufoff, gbase, voff) do { _Pragma("unroll") for (int _i = 0; _i < 2; ++_i) \
        __builtin_amdgcn_global_load_lds((const unsigned*)((const char*)(gbase) + (voff)[_i]), (LAS unsigned*)(lds + (bufoff) + ldsw + _i * 8192), 16, 0, 0); } while (0)
#define PG8_STAGEA1(bufoff, gbase) do { if constexpr (Sched::GATHER) { PG8_STAGE(bufoff, gbase, voffA[1]); } else { PG8_STAGE(bufoff, (gbase) + hstep, voffA[0]); } } while (0)
#define PG8_LDA(dst, b, h) do { _Pragma("unroll") for (int m = 0; m < 4; ++m) _Pragma("unroll") for (int k = 0; k < 2; ++k) dst[m][k] = *(const LAS bf16x8*)(lds + PG8_SA(b, h) + aoff + m * 2048 + k * 1024); } while (0)
#define PG8_LDB(dst, b, h) do { _Pragma("unroll") for (int n = 0; n < 2; ++n) _Pragma("unroll") for (int k = 0; k < 2; ++k) dst[n][k] = *(const LAS bf16x8*)(lds + PG8_SB(b, h) + boff + n * 2048 + k * 1024); } while (0)
#define PG8_MMA(ai, bj, At, Bt) do { __builtin_amdgcn_s_setprio(1); _Pragma("unroll") for (int m = 0; m < 4; ++m) _Pragma("unroll") for (int n = 0; n < 2; ++n) { \
        if constexpr (Sched::FP8) { acc[ai][bj][m][n] = __builtin_amdgcn_mfma_scale_f32_16x16x128_f8f6f4(cat8(Bt[n][0], Bt[n][1]), cat8(At[m][0], At[m][1]), acc[ai][bj][m][n], 0, 0, 0, 0, 0, 0); } \
        else { _Pragma("unroll") for (int k = 0; k < 2; ++k) acc[ai][bj][m][n] = __builtin_amdgcn_mfma_f32_16x16x32_bf16(Bt[n][k], At[m][k], acc[ai][bj][m][n], 0, 0, 0); } } \
        __builtin_amdgcn_s_setprio(0); } while (0)
#define PG8_WAIT_V(n) asm volatile("s_waitcnt vmcnt(" #n ")" ::: "memory")
#define PG8_WAIT_L(n) asm volatile("s_waitcnt lgkmcnt(" #n ")" ::: "memory")
#define PG8_BAR __builtin_amdgcn_s_barrier()
#define PG8_SCHED __builtin_amdgcn_sched_barrier(0)
    Unit cur, nxt; int ui = 0;
    if (!S.next(0, cur)) return;
    S.a_voff(cur, voffA, Rr, Cc);
    f32x4 acc[2][2][4][2];
#pragma unroll
    for (int a = 0; a < 2; ++a)
#pragma unroll
        for (int b = 0; b < 2; ++b)
#pragma unroll
            for (int m = 0; m < 4; ++m)
#pragma unroll
                for (int n = 0; n < 2; ++n) acc[a][b][m][n] = (f32x4){0.f, 0.f, 0.f, 0.f};
    bf16x8 At[4][2], B0[2][2], B1[2][2];
    const char* cA = S.a_ptr(cur); const char* cB = S.b_ptr(cur);
    PG8_STAGE(PG8_SB(0, 0), cB, voffB); PG8_STAGE(PG8_SB(0, 1), cB + hstep, voffB); PG8_STAGE(PG8_SA(0, 0), cA, voffA[0]); PG8_STAGEA1(PG8_SA(0, 1), cA);
    if (wr == 1) PG8_BAR;
    PG8_WAIT_V(2); PG8_BAR;
    PG8_STAGE(PG8_SB(1, 0), cB + kstep, voffB); PG8_STAGE(PG8_SA(1, 0), cA + kstep, voffA[0]); PG8_STAGE(PG8_SB(1, 1), cB + hstep + kstep, voffB);
    PG8_WAIT_V(6); PG8_BAR;
    for (;;) {
        const bool has_next = S.next(ui + 1, nxt);
        const char* nA = has_next ? S.a_ptr(nxt) : cA; const char* nB = has_next ? S.b_ptr(nxt) : cB;
#pragma unroll 1
        for (int t = 0; t < nt; t += 2) {
            const bool last = (t == nt - 2);
            if (last) GMARK(40); if (t == 2) GMARK1(45);
            const char* a1 = cA + (size_t)(t + 1) * kstep;
            const char* a2 = last ? nA : cA + (size_t)(t + 2) * kstep; const char* b2 = last ? nB : cB + (size_t)(t + 2) * kstep;
            const char* a3 = a2 + kstep; const char* b3 = b2 + kstep;
            asm volatile("" : "+s"(a1), "+s"(a2), "+s"(a3), "+s"(b2), "+s"(b3));
            PG8_LDB(B0, 0, 0); PG8_LDB(B1, 0, 1); PG8_SCHED; PG8_LDA(At, 0, 0); PG8_STAGEA1(PG8_SA(1, 1), a1);
            if (Sched::GATHER) { if (last && has_next) S.a_voff(nxt, voffA, Rr, Cc); }
            PG8_WAIT_V(8); PG8_WAIT_L(0); PG8_BAR; PG8_MMA(0, 0, At, B0); PG8_MMA(0, 1, At, B1); PG8_BAR; PG8_SCHED;
            PG8_LDA(At, 0, 1); PG8_STAGE(PG8_SB(0, 0), b2, voffB); PG8_STAGE(PG8_SB(0, 1), b2 + hstep, voffB); PG8_STAGE(PG8_SA(0, 0), a2, voffA[0]);
            PG8_WAIT_V(8); PG8_WAIT_L(0); PG8_BAR; PG8_MMA(1, 0, At, B0); PG8_MMA(1, 1, At, B1); PG8_BAR; PG8_SCHED;
            PG8_LDB(B0, 1, 0); PG8_LDB(B1, 1, 1); PG8_SCHED; PG8_LDA(At, 1, 0); PG8_STAGEA1(PG8_SA(0, 1), a2);
            PG8_WAIT_V(8); PG8_WAIT_L(0); PG8_BAR; PG8_MMA(0, 0, At, B0); PG8_MMA(0, 1, At, B1); PG8_BAR; PG8_SCHED;
            PG8_LDA(At, 1, 1); PG8_STAGE(PG8_SB(1, 0), b3, voffB); PG8_STAGE(PG8_SB(1, 1), b3 + hstep, voffB); PG8_STAGE(PG8_SA(1, 0), a3, voffA[0]);
            PG8_WAIT_V(8); PG8_WAIT_L(0); PG8_BAR; PG8_MMA(1, 0, At, B0); PG8_MMA(1, 1, At, B1); PG8_BAR; PG8_SCHED;
        }
        GMARK(41);
        if (wr == 0) PG8_BAR;
        GMARK(42);
        E(acc, cur, wr, wc, fr, fq);
        GMARK(43);
        if (!has_next) break;
#pragma unroll
        for (int a = 0; a < 2; ++a)
#pragma unroll
            for (int b = 0; b < 2; ++b)
#pragma unroll
                for (int m = 0; m < 4; ++m)
#pragma unroll
                    for (int n = 0; n < 2; ++n) acc[a][b][m][n] = (f32x4){0.f, 0.f, 0.f, 0.f};
        cur = nxt; cA = nA; cB = nB; ++ui;
        if (wr == 1) PG8_BAR;
    }
    PG8_WAIT_V(0);
    PG8_BAR;
#undef PG8_SA
#undef PG8_SB
#undef PG8_STAGE
#undef PG8_STAGEA1
#undef PG8_LDA
#undef PG8_LDB
#undef PG8_MMA
#undef PG8_WAIT_V
#undef PG8_WAIT_L
#undef PG8_BAR
#undef PG8_SCHED
}
}

struct Args { const float* in[33]; float* out; unsigned char* ws; int ph_lo, ph_hi, li, pad; };
enum { I_X = 0, I_C, I_CTX, I_CCTX, I_ADAW, I_ADAB, I_NMG, I_NFG, I_EWIN, I_EBIN, I_ECW, I_ECB, I_ELNG, I_ELNB, I_QNG, I_KNG, I_SINK, I_EWOUT, I_EBOUT,
       I_OWIN, I_OBIN, I_OLNG, I_OLNB, I_OWS, I_OBS, I_OWOUT, I_OBOUT, I_RW, I_RB, I_W1, I_B1, I_W2, I_B2 };

typedef const __attribute__((address_space(4))) unsigned long long* kargp_t;
struct Ctx {
    LAS unsigned char* lds; int tid, lane, wave, G, vcu, gw, NGW, bid; unsigned char* ws; kargp_t kp;
};
__device__ __forceinline__ const float* in_ptr(const Ctx& X, int i) { return (const float*)(const __attribute__((address_space(1))) float*)X.kp[i]; }
#define IN(i) in_ptr(X, (i))
#if PROBE_PH == -2
#define PMARK(k) do { if (X.bid == 0 && X.tid == 0) { volatile LAS unsigned long long* pm_ = (volatile LAS unsigned long long*)(X.lds + MISC_OFF + 128); \
    if ((k) == PROBE_A) pm_[0] = __builtin_amdgcn_s_memrealtime(); if ((k) == PROBE_B) pm_[1] = __builtin_amdgcn_s_memrealtime(); } } while (0)
#else
#define PMARK(k) do { } while (0)
#endif

struct DenseSched {
    static constexpr bool GATHER = false, FP8 = false;
    const bf16* A; const bf16* Bt; int nM, nN, nwg, G, c;
    const bf16* A2; const bf16* Bt2; int nM2;
    __device__ __forceinline__ void init(const bf16* A_, const bf16* Bt_, int M, int N, int G_, int c_) { A = A_; Bt = Bt_; nM = M / 256; nN = N / 256; nwg = nM * nN; G = G_; c = c_; A2 = nullptr; Bt2 = nullptr; nM2 = 0; }
    __device__ __forceinline__ bool next(int i, pg8::Unit& u) const {
        const int L = i * G + c; if (L >= nwg + nM2) return false; u.idx = i;
        if (L >= nwg) { u.pm = L - nwg; u.pn = 0; u.e = 1; u.cnt = 256; return true; }
        int wgid = L; { const int q = nwg / 8, r = nwg % 8, xcd = wgid % 8, off = wgid / 8; wgid = (xcd < r ? xcd * (q + 1) : r * (q + 1) + (xcd - r) * q) + off; }
        const int nig = 8 * nN, gid = wgid / nig, fm = gid * 8, gsz = (nM - fm) < 8 ? (nM - fm) : 8;
        u.pm = fm + ((wgid % nig) % gsz); u.pn = (wgid % nig) / gsz; u.e = 0; u.cnt = 256; return true;
    }
    __device__ __forceinline__ const char* a_ptr(const pg8::Unit& u) const { return (const char*)(u.e ? A2 : A) + (size_t)u.pm * 256 * pg8::KD * 2; }
    __device__ __forceinline__ const char* b_ptr(const pg8::Unit& u) const { return (const char*)(u.e ? Bt2 : Bt) + (size_t)u.pn * 256 * pg8::KD * 2; }
    __device__ __forceinline__ void a_voff(const pg8::Unit&, unsigned (&v)[2][2], const int (&R)[2], const int (&C)[2]) const {
#pragma unroll
        for (int i = 0; i < 2; ++i) { v[0][i] = (unsigned)(R[i] * pg8::KD + C[i]) * 2u; v[1][i] = v[0][i] + (unsigned)(pg8::HALF * pg8::KD * 2); }
    }
};
template <bool GATHER_, int NTILE_N>
struct MoeSchedT {
    static constexpr bool GATHER = GATHER_, FP8 = true; static constexpr int RP = 1024;
    const LAS int* tab; int G, c;
    const unsigned char* A;
    const unsigned char* Bt;
    const int* list;
    const LAS int* meta;
    __device__ __forceinline__ bool next(int i, pg8::Unit& u) const {
        const int L = i * G + c; const int T = tab[0];
        if (L >= T * NTILE_N) return false;
        u.idx = i;
        const int mt = L / NTILE_N; u.pn = L % NTILE_N;
        const int w = __builtin_amdgcn_readfirstlane(tab[1 + mt]); u.e = w >> 16; const int tl = w & 0xffff;
        const int cnt = __builtin_amdgcn_readfirstlane(tab[512 + u.e]), pb = __builtin_amdgcn_readfirstlane(tab[544 + u.e]);
        u.pm = pb + tl * 256; u.cnt = cnt - tl * 256;
        return true;
    }
    __device__ __forceinline__ const char* a_ptr(const pg8::Unit& u) const { return GATHER ? (const char*)A : (const char*)A + (size_t)u.pm * RP; }
    __device__ __forceinline__ const char* b_ptr(const pg8::Unit& u) const { return (const char*)Bt + ((size_t)u.e * NTILE_N + u.pn) * 256 * RP; }
    __device__ __forceinline__ void a_voff(const pg8::Unit& u, unsigned (&v)[2][2], const int (&R)[2], const int (&C)[2]) const {
        if (GATHER) {
#pragma unroll
            for (int h = 0; h < 2; ++h)
#pragma unroll
                for (int i = 0; i < 2; ++i) { const int tok = meta[u.idx * 256 + h * 128 + R[i]]; v[h][i] = (unsigned)(tok * RP + C[i] * 2); }
        } else {
#pragma unroll
            for (int i = 0; i < 2; ++i) { v[0][i] = (unsigned)(R[i] * RP + C[i] * 2); v[1][i] = v[0][i] + (unsigned)(pg8::HALF * RP); }
        }
    }
};
__device__ __forceinline__ void moe_build_table(const Ctx& X, const int* cnt  ) {
    LAS int* tab = (LAS int*)(X.lds + TAB_OFF);
    __syncthreads();
    if (X.tid < 64) {
        const int e = X.lane; int c = 0; if (e < NE) c = __hip_atomic_load(cnt + e * CNT_STRIDE, __ATOMIC_RELAXED, __HIP_MEMORY_SCOPE_AGENT);
        const int mt = (c + 255) >> 8; int incl = mt;
#pragma unroll
        for (int off = 1; off < 32; off <<= 1) { const int v = __shfl_up(incl, off); if (X.lane >= off) incl += v; }
        const int start = incl - mt;
        if (e < NE) { tab[512 + e] = c; tab[544 + e] = start * 256; for (int t = 0; t < mt; ++t) tab[1 + start + t] = (e << 16) | t; if (e == NE - 1) tab[0] = incl; }
    }
    __syncthreads();
}
template <bool WITH_GATE, class Sched>
__device__ __forceinline__ void moe_stage_meta(const Ctx& X, const Sched& S, const int* list, const float* gatew, LAS int* meta, const float* bias, LAS float* lbias) {
    if (X.tid < 256) { pg8::Unit u;
        for (int i = 0; S.next(i, u); ++i) { const int slot0 = u.pm - S.tab[544 + u.e]; const int r = X.tid < u.cnt ? X.tid : u.cnt - 1;
            const int aid = list[(size_t)u.e * NTOK + slot0 + r];
            if (WITH_GATE) { const float g = gatew[aid]; *(LAS u32x2*)(meta + (i * 256 + X.tid) * 2) = (u32x2){(unsigned)aid, __float_as_uint(g)}; }
            else meta[i * 256 + X.tid] = aid >> 2; } }
    else { const int c = X.tid - 256; pg8::Unit u;
        for (int i = 0; S.next(i, u); ++i) lbias[i * 256 + c] = WITH_GATE ? bias[(size_t)u.e * D + u.pn * 256 + c] : bias[(size_t)u.e * 2048 + (c >> 7) * 1024 + u.pn * 128 + (c & 127)]; }
    __syncthreads();
}

__device__ __forceinline__ f32x2 gelu_pk(f32x2 v) {
    const f32x2 av = __builtin_elementwise_abs(v), d = av * 0.2316418882f + 1.0f;
    f32x2 t; t.x = __builtin_amdgcn_rcpf(d.x); t.y = __builtin_amdgcn_rcpf(d.y);
    f32x2 q = t * 0.5307027145f + (-0.7265760135f); q = q * t + 0.7107068705f; q = q * t + (-0.142248368f); q = q * t + 0.127414796f; q = q * t;
    const f32x2 s = (v * v) * (-0.72134752044f);
    f32x2 e; e.x = __builtin_amdgcn_exp2f(s.x); e.y = __builtin_amdgcn_exp2f(s.y);
    const f32x2 m = v * (q * e), r = v - m;
    f32x2 o; o.x = v.x < 0.f ? m.x : r.x; o.y = v.y < 0.f ? m.y : r.y; return o;
}
__device__ __forceinline__ u32x4 pack8(f32x4 a, f32x4 b) { u32x4 w; w.x = pk2(a[0], a[1]); w.y = pk2(a[2], a[3]); w.z = pk2(b[0], b[1]); w.w = pk2(b[2], b[3]); return w; }

struct EpiIn {
    static constexpr bool PERM = true;
    bf16 *GLU, *Q, *Kb, *Vb, *KC, *VC; const float* bias;
    __device__ __forceinline__ void operator()(const f32x4 (&acc)[2][2][4][2], const pg8::Unit& u, int wr, int wc, int fr, int fq) const {
        asm volatile("" : "+v"(fr), "+v"(fq));
        const int row0 = u.pm * 256 + wr * 64 + fr; const int c8 = wc * 32 + 8 * fq;
        if (u.e == 0 && u.pn < 4) {
            const int j0 = u.pn * 128 + c8;
            f32x4 bu[2], bg[2];
#pragma unroll
            for (int n = 0; n < 2; ++n) { bu[n] = *(const f32x4*)(bias + j0 + 4 * n); bg[n] = *(const f32x4*)(bias + 512 + j0 + 4 * n); }
#pragma unroll
            for (int ai = 0; ai < 2; ++ai)
#pragma unroll
                for (int m = 0; m < 4; ++m) { f32x4 o[2];
#pragma unroll
                    for (int n = 0; n < 2; ++n) { const f32x4 uu = acc[ai][0][m][n] + bu[n], gg = acc[ai][1][m][n] + bg[n];
#pragma unroll
                        for (int k = 0; k < 4; ++k) o[n][k] = uu[k] * sigmoidf_(gg[k]); }
                    *(u32x4*)(GLU + (size_t)(row0 + ai * 128 + m * 16) * 512 + j0) = pack8(o[0], o[1]); }
        } else {
#pragma unroll
            for (int bj = 0; bj < 2; ++bj) {
                bf16* dst; int ld, col, bcol;
                if (u.pn >= 6 || u.e) { dst = u.e ? (bj ? VC : KC) : (bj ? Vb : Kb); ld = 128; col = c8; bcol = KV_COL + bj * 128 + c8; }
                else { dst = Q; ld = 512; col = (u.pn - 4) * 256 + bj * 128 + c8; bcol = 1024 + col; }
                f32x4 bv[2];
#pragma unroll
                for (int n = 0; n < 2; ++n) bv[n] = *(const f32x4*)(bias + bcol + 4 * n);
#pragma unroll
                for (int ai = 0; ai < 2; ++ai)
#pragma unroll
                    for (int m = 0; m < 4; ++m) *(u32x4*)(dst + (size_t)(row0 + ai * 128 + m * 16) * ld + col) = pack8(acc[ai][bj][m][0] + bv[0], acc[ai][bj][m][1] + bv[1]);
            }
        }
    }
};
struct EpiRes {
    static constexpr bool PERM = false;
    const float* base; float* out; const float* bias; const float* gate;
    __device__ __forceinline__ void operator()(const f32x4 (&acc)[2][2][4][2], const pg8::Unit& u, int wr, int wc, int fr, int fq) const {
        asm volatile("" : "+v"(fr), "+v"(fq));
        const int col0 = u.pn * 256 + wc * 32 + 4 * fq; const int b = (u.pm * 256) / SEQ;
#pragma unroll
        for (int bj = 0; bj < 2; ++bj) {
            f32x4 bv[2], gv[2];
#pragma unroll
            for (int n = 0; n < 2; ++n) { bv[n] = *(const f32x4*)(bias + col0 + bj * 128 + n * 16); gv[n] = *(const f32x4*)(gate + (size_t)b * MODW + col0 + bj * 128 + n * 16); }
#pragma unroll
            for (int ai = 0; ai < 2; ++ai)
#pragma unroll
                for (int m = 0; m < 4; ++m) { const size_t off = (size_t)(u.pm * 256 + ai * 128 + wr * 64 + m * 16 + fr) * D + col0 + bj * 128;
#pragma unroll
                    for (int n = 0; n < 2; ++n) { const f32x4 bs = *(const f32x4*)(base + off + n * 16); *(f32x4*)(out + off + n * 16) = bs + gv[n] * (acc[ai][bj][m][n] + bv[n]); } }
        }
    }
};
struct EpiGelu {
    static constexpr bool PERM = true;
    bf16 *U, *V; const float* bias; float* vstat;
    __device__ __forceinline__ void operator()(const f32x4 (&acc)[2][2][4][2], const pg8::Unit& u, int wr, int wc, int fr, int fq) const {
        asm volatile("" : "+v"(fr), "+v"(fq));
        const int row0 = u.pm * 256 + wr * 64 + fr; const int colt = u.pn * 256; const bool isv = colt >= 1024; bf16* base = isv ? V : U; const int cb = (colt & 1023) + wc * 32 + 8 * fq, bcol = colt + wc * 32 + 8 * fq;
        f32x4 bv[2][2];
#pragma unroll
        for (int bj = 0; bj < 2; ++bj)
#pragma unroll
            for (int n = 0; n < 2; ++n) bv[bj][n] = *(const f32x4*)(bias + bcol + bj * 128 + 4 * n);
#pragma unroll
        for (int ai = 0; ai < 2; ++ai)
#pragma unroll
            for (int m = 0; m < 4; ++m) { const int row = row0 + ai * 128 + m * 16; bf16* rowp = base + (size_t)row * D + cb; float s = 0.f, s2 = 0.f;
#pragma unroll
                for (int bj = 0; bj < 2; ++bj) { f32x4 v0 = acc[ai][bj][m][0] + bv[bj][0], v1 = acc[ai][bj][m][1] + bv[bj][1];
                    f32x2 a = gelu_pk((f32x2){v0[0], v0[1]}), b = gelu_pk((f32x2){v0[2], v0[3]}), c = gelu_pk((f32x2){v1[0], v1[1]}), d = gelu_pk((f32x2){v1[2], v1[3]});
                    s += (a.x + a.y) + (b.x + b.y) + (c.x + c.y) + (d.x + d.y); s2 += (a.x * a.x + a.y * a.y) + (b.x * b.x + b.y * b.y) + (c.x * c.x + c.y * c.y) + (d.x * d.x + d.y * d.y);
                    *(u32x4*)(rowp + bj * 128) = pack8((f32x4){a.x, a.y, b.x, b.y}, (f32x4){c.x, c.y, d.x, d.y}); }
                if (isv) { s += __shfl_xor(s, 16); s += __shfl_xor(s, 32); s2 += __shfl_xor(s2, 16); s2 += __shfl_xor(s2, 32);
                    if (fq == 0) { unsafeAtomicAdd(vstat + 2 * row, s); unsafeAtomicAdd(vstat + 2 * row + 1, s2); } } }
    }
};
struct EpiSwiglu {
    static constexpr bool PERM = true;
    unsigned char* ACT; const LAS float* lbias;
    __device__ __forceinline__ void operator()(const f32x4 (&acc)[2][2][4][2], const pg8::Unit& u, int wr, int wc, int fr, int fq) const {
        asm volatile("" : "+v"(fr), "+v"(fq));
        const int j0 = u.pn * 128 + wc * 32 + 8 * fq; const LAS float* bb = lbias + u.idx * 256 + wc * 32 + 8 * fq;
        f32x4 bg[2], bu[2];
#pragma unroll
        for (int n = 0; n < 2; ++n) { bg[n] = *(const LAS f32x4*)(bb + 4 * n); bu[n] = *(const LAS f32x4*)(bb + 128 + 4 * n); }
#pragma unroll
        for (int ai = 0; ai < 2; ++ai)
#pragma unroll
            for (int m = 0; m < 4; ++m) { f32x4 o[2];
#pragma unroll
                for (int n = 0; n < 2; ++n) { const f32x4 g4 = acc[ai][0][m][n] * FP8_DESCALE + bg[n], u4 = acc[ai][1][m][n] * FP8_DESCALE + bu[n];
#pragma unroll
                    for (int k = 0; k < 4; ++k) { const float g = fminf(g4[k], 7.0f), up = fminf(fmaxf(u4[k], -7.0f), 7.0f); o[n][k] = (up + 1.0f) * g * sigmoidf_(g * 1.702f); } }
                u32x2 w8; w8.x = pk4_fp8(o[0][0] * FP8_AMUL, o[0][1] * FP8_AMUL, o[0][2] * FP8_AMUL, o[0][3] * FP8_AMUL); w8.y = pk4_fp8(o[1][0] * FP8_AMUL, o[1][1] * FP8_AMUL, o[1][2] * FP8_AMUL, o[1][3] * FP8_AMUL);
                *(u32x2*)(ACT + (size_t)(u.pm + ai * 128 + wr * 64 + m * 16 + fr) * D + j0) = w8; }
    }
};
struct EpiDown {
    static constexpr bool PERM = true;
    bf16* Y; const LAS float* lbias; const LAS int* meta;
    __device__ __forceinline__ void operator()(const f32x4 (&acc)[2][2][4][2], const pg8::Unit& u, int wr, int wc, int fr, int fq) const {
        asm volatile("" : "+v"(fr), "+v"(fq));
        const int c8 = u.pn * 256 + wc * 32 + 8 * fq; const LAS float* bb = lbias + u.idx * 256 + wc * 32 + 8 * fq;
#pragma unroll
        for (int bj = 0; bj < 2; ++bj) {
            f32x4 bv[2];
#pragma unroll
            for (int n = 0; n < 2; ++n) bv[n] = *(const LAS f32x4*)(bb + bj * 128 + 4 * n);
#pragma unroll
            for (int ai = 0; ai < 2; ++ai)
#pragma unroll
                for (int m = 0; m < 4; ++m) { const int r = ai * 128 + wr * 64 + m * 16 + fr; const u32x2 mg = *(const LAS u32x2*)(meta + (u.idx * 256 + r) * 2); const int aid = (int)mg.x; const float g = __uint_as_float(mg.y);
                    const u32x4 w = pack8((acc[ai][bj][m][0] * FP8_DESCALE + bv[0]) * g, (acc[ai][bj][m][1] * FP8_DESCALE + bv[1]) * g);
                    if (r < u.cnt) *(u32x4*)(Y + (size_t)aid * D + c8 + bj * 128) = w; }
        }
    }
};

struct TrItem { const float* src; bf16* dst; int N; int fp8; };
__device__ __forceinline__ void tr_load(const TrItem& t, float (&v)[32], int lane) {
#pragma unroll
    for (int i = 0; i < 32; ++i) v[i] = t.src[(size_t)(2 * i + (lane >> 5)) * t.N + (lane & 31)];
}
__device__ __forceinline__ void tr_store(const TrItem& t, const float (&v)[32], LAS float* scr, int lane) {
#pragma unroll
    for (int i = 0; i < 32; ++i) scr[(2 * i + (lane >> 5)) * 33 + (lane & 31)] = v[i];
    LDS_WAIT();
    if (t.fp8) {
        const int q = lane & 3;
#pragma unroll
        for (int j = 0; j < 2; ++j) { const int n = (lane >> 2) + 16 * j; const LAS float* s = scr + (16 * q) * 33 + n; u32x4 o;
#pragma unroll
            for (int c = 0; c < 4; ++c) o[c] = pk4_fp8(s[(4 * c) * 33] * FP8_WMUL, s[(4 * c + 1) * 33] * FP8_WMUL, s[(4 * c + 2) * 33] * FP8_WMUL, s[(4 * c + 3) * 33] * FP8_WMUL);
            *(u32x4*)((unsigned char*)t.dst + (size_t)n * 1024 + 16 * q) = o; }
    } else {
        const int c = lane & 7;
#pragma unroll
        for (int j = 0; j < 4; ++j) { const int n = (lane >> 3) + 8 * j; const LAS float* s = scr + (8 * c) * 33 + n;
            u32x4 o; o.x = pk2(s[0 * 33], s[1 * 33]); o.y = pk2(s[2 * 33], s[3 * 33]); o.z = pk2(s[4 * 33], s[5 * 33]); o.w = pk2(s[6 * 33], s[7 * 33]);
            *(u32x4*)(t.dst + (size_t)n * 1024 + 8 * c) = o; }
    }
    LDS_WAIT();
}
template <int N, bool PAIR> struct MoeCvt {
    static constexpr int STRIPS = N / 512, ITEMS_PER_MAT = 8 * STRIPS;
    static __device__ __forceinline__ void load(const float* W, int item, f32x4 (&v)[4][2][4], int wave, int lane) {
        const int mat = item / ITEMS_PER_MAT, q = item % ITEMS_PER_MAT, kb = q / STRIPS, sb = q % STRIPS;
        const float* s = W + (size_t)mat * 1024 * N + (size_t)(128 * kb + 16 * wave) * N + 512 * sb + 4 * lane;
#pragma unroll
        for (int g = 0; g < 4; ++g)
#pragma unroll
            for (int hh = 0; hh < 2; ++hh)
#pragma unroll
                for (int r = 0; r < 4; ++r) v[g][hh][r] = *(const f32x4*)(s + (size_t)(4 * g + r) * N + 256 * hh);
    }
    static __device__ __forceinline__ void to_lds(const f32x4 (&v)[4][2][4], LAS unsigned* img, int wave, int lane) {
#pragma unroll
        for (int g = 0; g < 4; ++g) { const int kq = 4 * wave + g;
#pragma unroll
            for (int hh = 0; hh < 2; ++hh)
#pragma unroll
                for (int j = 0; j < 4; ++j) { const int rho = 64 * hh + lane + 128 * j;
                    img[rho * 32 + ((kq ^ rho) & 31)] = pk4_fp8(v[g][hh][0][j] * FP8_WMUL, v[g][hh][1][j] * FP8_WMUL, v[g][hh][2][j] * FP8_WMUL, v[g][hh][3][j] * FP8_WMUL); } }
    }
    static __device__ __forceinline__ void store(unsigned char* WT, int item, const LAS unsigned* img, int wave, int lane) {
        const int mat = item / ITEMS_PER_MAT, q = item % ITEMS_PER_MAT, kb = q / STRIPS, sb = q % STRIPS;
        unsigned char* d = WT + (size_t)mat * N * 1024 + 128 * kb;
        const int mi = lane >> 3, c = lane & 7;
#pragma unroll
        for (int st = 0; st < 2; ++st)
#pragma unroll
            for (int j = 0; j < 4; ++j) { const int m = 16 * wave + 8 * st + mi, rho = m + 128 * j, n = 4 * m + j;
                u32x4 o;
#pragma unroll
                for (int i = 0; i < 4; ++i) o[i] = img[rho * 32 + (((4 * c + i) ^ rho) & 31)];
                int drow;
                if (PAIR) { const int h = sb >> 1, rem = 512 * (sb & 1) + n; drow = (rem >> 7) * 256 + h * 128 + (rem & 127); } else drow = 512 * sb + n;
                *(u32x4*)(d + (size_t)drow * 1024 + 16 * c) = o; }
    }
    static __device__ __forceinline__ void run(const float* W, unsigned char* WT, int nitems, int first, int stride, LAS unsigned char* lds, int wave, int lane) {
        f32x4 v[4][2][4]; int it = first, buf = 0;
        if (it < nitems) load(W, it, v, wave, lane);
        while (it < nitems) {
            LAS unsigned* img = (LAS unsigned*)(lds + buf * 65536);
            to_lds(v, img, wave, lane);
            __syncthreads();
            const int nx = it + stride; if (nx < nitems) load(W, nx, v, wave, lane);
            store(WT, it, img, wave, lane);
            it = nx; buf ^= 1;
        }
        __syncthreads();
    }
};

__device__ __forceinline__ int pair_src(int nd, int halfw) { return ((nd & 255) >> 7) * halfw + (nd >> 8) * 128 + (nd & 127); }

__device__ __forceinline__ void phase_prologue(const Args& a, const Ctx& X) {
    PMARK(20);
    {
        LAS float* sc = (LAS float*)X.lds;
        LAS float* red = (LAS float*)(X.lds + 36864);
        float* MOD = (float*)(X.ws + WS_MOD);
        for (int item = X.bid; item < 2 * 96; item += X.G) {
            const int l = item / 96, j0 = (item % 96) * 64;
            for (int idx = X.tid; idx < 9 * 1024; idx += NTHREADS) { const int r = idx >> 10, k = idx & 1023; const float v = r < 8 ? IN(I_C)[r * 1024 + k] : IN(I_CCTX)[k]; sc[idx] = v * sigmoidf_(v); }
            __syncthreads();
            float acc[9];
#pragma unroll
            for (int r = 0; r < 9; ++r) acc[r] = 0.f;
            const float* w = IN(I_ADAW) + (size_t)l * 1024 * MODW + j0 + X.lane;
#pragma unroll 8
            for (int k = X.wave * 128; k < X.wave * 128 + 128; ++k) { const float wv = w[(size_t)k * MODW];
#pragma unroll
                for (int r = 0; r < 9; ++r) acc[r] += sc[r * 1024 + k] * wv; }
#pragma unroll
            for (int r = 0; r < 9; ++r) red[(X.wave * 9 + r) * 64 + X.lane] = acc[r];
            __syncthreads();
            for (int t = X.tid; t < 9 * 64; t += NTHREADS) { const int r = t >> 6, cidx = t & 63; float s = 0.f;
#pragma unroll
                for (int w8 = 0; w8 < 8; ++w8) s += red[(w8 * 9 + r) * 64 + cidx];
                MOD[((size_t)l * 9 + r) * MODW + j0 + cidx] = s + IN(I_ADAB)[l * MODW + j0 + cidx]; }
            __syncthreads();
        }
    }
    PMARK(21);
    LAS float* scr = (LAS float*)(X.lds + X.wave * 16384);
    bf16* WinT = (bf16*)(X.ws + WS_WINT); bf16* WoutT = (bf16*)(X.ws + WS_WOUTT); bf16* GWinT = (bf16*)(X.ws + WS_GWINT); bf16* GWoutT = (bf16*)(X.ws + WS_GWOUTT);
    bf16* W1T = (bf16*)(X.ws + WS_W1T); bf16* W2T = (bf16*)(X.ws + WS_W2T);
    constexpr int I_IN = 16 * (EVEN_IN / 32), I_OUT = 16 * 32, I_GIN = 16 * 64, I_GOUT = 16 * 32;
    constexpr int NITEMS = I_IN + I_OUT + I_GIN + I_GOUT;
    auto item_of = [&](int it) -> TrItem {
        int r = it; TrItem t; t.fp8 = 0;
        if (r < I_IN) { const int kb = r / 56, nd = (r % 56) * 32; const int ns = nd < 1024 ? pair_src(nd, 512) : nd; t.N = EVEN_IN; t.src = IN(I_EWIN) + (size_t)kb * 64 * EVEN_IN + ns; t.dst = WinT + (size_t)nd * 1024 + kb * 64; return t; } r -= I_IN;
        if (r < I_OUT) { const int kb = r >> 5, nd = (r & 31) * 32; t.N = 1024; t.src = IN(I_EWOUT) + (size_t)kb * 64 * 1024 + nd; t.dst = WoutT + (size_t)nd * 1024 + kb * 64; return t; } r -= I_OUT;
        if (r < I_GIN) { const int kb = r >> 6, nd = (r & 63) * 32; t.N = 2048; t.src = IN(I_OWIN) + (size_t)kb * 64 * 2048 + nd; t.dst = GWinT + (size_t)nd * 1024 + kb * 64; return t; } r -= I_GIN;
        { const int kb = r >> 5, nd = (r & 31) * 32; t.N = 1024; t.src = IN(I_OWOUT) + (size_t)kb * 64 * 1024 + nd; t.dst = GWoutT + (size_t)nd * 1024 + kb * 64; return t; }
    };
    {
        float va[32], vb[32]; int it = X.gw;
        TrItem ta, tb; if (it < NITEMS) { ta = item_of(it); tr_load(ta, va, X.lane); }
        while (it < NITEMS) {
            const int it1 = it + X.NGW; if (it1 < NITEMS) { tb = item_of(it1); tr_load(tb, vb, X.lane); }
            tr_store(ta, va, scr, X.lane);
            if (it1 >= NITEMS) break;
            const int it2 = it1 + X.NGW; if (it2 < NITEMS) { ta = item_of(it2); tr_load(ta, va, X.lane); }
            tr_store(tb, vb, scr, X.lane);
            it = it2;
        }
    }
    __syncthreads();
    MoeCvt<2048, true>::run(IN(I_W1), (unsigned char*)W1T, 64 * MoeCvt<2048, true>::ITEMS_PER_MAT, X.vcu, X.G, X.lds, X.wave, X.lane);
    MoeCvt<1024, false>::run(IN(I_W2), (unsigned char*)W2T, 64 * MoeCvt<1024, false>::ITEMS_PER_MAT, X.vcu, X.G, X.lds, X.wave, X.lane);
    PMARK(22);
    { bf16* WsB = (bf16*)(X.ws + WS_WSB); const float* ws = IN(I_OWS);
      for (int i = (X.gw * 64 + X.lane) * 4; i < 8 * 128 * 128; i += X.NGW * 64 * 4) { const f32x4 v = *(const f32x4*)(ws + i); u32x2 o; o.x = pk2(v[0], v[1]); o.y = pk2(v[2], v[3]); *(u32x2*)(WsB + i) = o; } }
}

__device__ __forceinline__ void modulate_row(const float* xrow, const float* g, const float* sh, const float* sc, bf16* orow, int lane, f32x4 (&y)[4]) {
    const f32x4* xr = (const f32x4*)xrow + lane; f32x4 v[4]; float ss = 0.f;
#pragma unroll
    for (int j = 0; j < 4; ++j) { v[j] = xr[64 * j]; ss += (v[j][0] * v[j][0] + v[j][1] * v[j][1]) + (v[j][2] * v[j][2] + v[j][3] * v[j][3]); }
    const float rstd = rsqrtf(wave_sum(ss) * (1.0f / D) + EPS);
#pragma unroll
    for (int j = 0; j < 4; ++j) { const f32x4 gk = ((const f32x4*)g)[lane + 64 * j], sk = ((const f32x4*)sc)[lane + 64 * j], hk = ((const f32x4*)sh)[lane + 64 * j];
        y[j] = v[j] * rstd * gk * (1.0f + sk) + hk;
        u32x2 o; o.x = pk2(y[j][0], y[j][1]); o.y = pk2(y[j][2], y[j][3]); *((u32x2*)orow + lane + 64 * j) = o; }
}
__device__ __forceinline__ void mod0_load(const Ctx& X, int row, f32x4 (&v)[4]) {
    const float* xrow = row < NTOK ? IN(I_X) + (size_t)row * D : IN(I_CTX) + (size_t)(row - NTOK) * D;
#pragma unroll
    for (int j = 0; j < 4; ++j) v[j] = ((const f32x4*)xrow)[X.lane + 64 * j];
}
__device__ __forceinline__ void mod0_finish(const Ctx& X, int row, const f32x4 (&v)[4]) {
    const float* m = (const float*)(X.ws + WS_MOD) + (size_t)(row < NTOK ? row / SEQ : 8) * MODW; const float* g = IN(I_NMG);
    bf16* orow = row < NTOK ? (bf16*)(X.ws + WS_XA) + (size_t)row * D : (bf16*)(X.ws + WS_GM) + (size_t)(row - NTOK) * D;
    f32x4 gk[4], hk[4], sk[4]; float ss = 0.f;
#pragma unroll
    for (int j = 0; j < 4; ++j) { gk[j] = ((const f32x4*)g)[X.lane + 64 * j]; hk[j] = ((const f32x4*)m)[X.lane + 64 * j]; sk[j] = ((const f32x4*)(m + 1024))[X.lane + 64 * j];
        ss += (v[j][0] * v[j][0] + v[j][1] * v[j][1]) + (v[j][2] * v[j][2] + v[j][3] * v[j][3]); }
    const float rstd = rsqrtf(wave_sum(ss) * (1.0f / D) + EPS);
#pragma unroll
    for (int j = 0; j < 4; ++j) { const f32x4 y = v[j] * rstd * gk[j] * (1.0f + sk[j]) + hk[j]; u32x2 o; o.x = pk2(y[0], y[1]); o.y = pk2(y[2], y[3]); *((u32x2*)orow + X.lane + 64 * j) = o; }
}
__device__ __forceinline__ void phase_modulate0(const Args& a, const Ctx& X) {
    constexpr int NR = NTOK + NCTX; f32x4 va[4], vb[4];
    int row = X.gw; if (row < NR) mod0_load(X, row, va);
    while (row < NR) {
        const int r1 = row + X.NGW; if (r1 < NR) mod0_load(X, r1, vb);
        mod0_finish(X, row, va);
        if (r1 >= NR) break;
        const int r2 = r1 + X.NGW; if (r2 < NR) mod0_load(X, r2, va);
        mod0_finish(X, r1, vb);
        row = r2;
    }
}

__device__ __forceinline__ void qk_chunks(bf16* buf, int nchunks, int rowlen, const float* gn, bool rope, float oscale, const Ctx& X, const LAS f32x2* cs) {
    for (int ch = X.gw; ch < nchunks; ch += X.NGW) {
        const int e0 = ch * 512 + 8 * X.lane; const int token = e0 / rowlen; const int d0 = e0 & 63;
        u32x4 raw = *(const u32x4*)(buf + e0); float v[8];
#pragma unroll
        for (int i = 0; i < 4; ++i) { v[2 * i] = bf2f(raw[i] & 0xffffu); v[2 * i + 1] = bf2f(raw[i] >> 16); }
        float ss = 0.f;
#pragma unroll
        for (int i = 0; i < 8; ++i) ss += v[i] * v[i];
        ss += __shfl_xor(ss, 1); ss += __shfl_xor(ss, 2); ss += __shfl_xor(ss, 4);
        const float rstd = rsqrtf(ss * (1.0f / 64.0f) + EPS);
        const f32x4 g0 = *(const f32x4*)(gn + d0), g1 = *(const f32x4*)(gn + d0 + 4);
#pragma unroll
        for (int i = 0; i < 4; ++i) { v[i] = v[i] * rstd * g0[i]; v[4 + i] = v[4 + i] * rstd * g1[i]; }
        if (rope) {
            const int t = token % SEQ; const int dd0 = d0 & 31; const int pos = dd0 < 16 ? (t >> 6) : (t & 63);
            const LAS f32x2* cp = cs + pos * 16 + (dd0 & 15);
#pragma unroll
            for (int i = 0; i < 8; ++i) { const float pv = __shfl_xor(v[i], 4); const f32x2 c = cp[i];
                v[i] = (d0 < 32) ? (v[i] * c.x - pv * c.y) : (v[i] * c.x + pv * c.y); }
        }
        u32x4 o; o.x = pk2(v[0] * oscale, v[1] * oscale); o.y = pk2(v[2] * oscale, v[3] * oscale); o.z = pk2(v[4] * oscale, v[5] * oscale); o.w = pk2(v[6] * oscale, v[7] * oscale);
        *(u32x4*)(buf + e0) = o;
    }
}
__device__ __forceinline__ void phase_conv_qk(const Args& a, const Ctx& X) {
    LAS f32x2* cs = (LAS f32x2*)(X.lds + 65536);
    for (int i = X.tid; i < 1024; i += NTHREADS) { const float inv = exp2f(-(float)(i & 15) * (13.287712379549449f / 16.0f)); float sn, csn; sincosf((float)(i >> 4) * inv, &sn, &csn); cs[i] = (f32x2){csn, sn}; }
    __syncthreads();
    qk_chunks((bf16*)(X.ws + WS_Q), NTOK, 512, IN(I_QNG), true, QSCALE, X, cs);
    qk_chunks((bf16*)(X.ws + WS_K), NTOK / 4, 128, IN(I_KNG), true, 1.0f, X, cs);
    qk_chunks((bf16*)(X.ws + WS_KC), NCTX / 4, 128, IN(I_KNG), false, 1.0f, X, cs);
    const bf16* GLU = (const bf16*)(X.ws + WS_GLU); bf16* MIX = (bf16*)(X.ws + WS_MIX);
    LAS unsigned* tin = (LAS unsigned*)X.lds;
    LAS float* tout = (LAS float*)(X.lds + 65536);
    const int cp = X.tid & 255, th = X.tid >> 8;
    float w0[31], w1[31];
#pragma unroll
    for (int j = 0; j < 31; ++j) { const f32x2 w = *(const f32x2*)(IN(I_ECW) + j * 512 + 2 * cp); w0[j] = w.x; w1[j] = w.y; }
    const f32x2 cb = *(const f32x2*)(IN(I_ECB) + 2 * cp);
    for (int tile = X.bid; tile < NTOK / 32; tile += X.G) {
        const int row0 = tile * 32; const int t0 = row0 % SEQ;
        __syncthreads();
        for (int c = X.tid; c < 62 * 64; c += NTHREADS) { const int lr = c >> 6, cc = c & 63; const int t = t0 - 15 + lr;
            u32x4 v = (u32x4){0u, 0u, 0u, 0u}; if (t >= 0 && t < SEQ) v = *(const u32x4*)(GLU + (size_t)(row0 - 15 + lr) * 512 + cc * 8);
            *(LAS u32x4*)(tin + lr * 256 + cc * 4) = v; }
        __syncthreads();
        float a0[16], a1[16];
#pragma unroll
        for (int o = 0; o < 16; ++o) { a0[o] = cb.x; a1[o] = cb.y; }
#pragma unroll
        for (int rr = 0; rr < 46; ++rr) { const unsigned pv = tin[(16 * th + rr) * 256 + cp]; const float x0 = bf2f(pv & 0xffffu), x1 = bf2f(pv >> 16);
#pragma unroll
            for (int o = 0; o < 16; ++o) { const int j = rr - o; if (j >= 0 && j <= 30) { a0[o] += x0 * w0[j]; a1[o] += x1 * w1[j]; } } }
#pragma unroll
        for (int o = 0; o < 16; ++o) *(LAS f32x2*)(tout + (16 * th + o) * 512 + 2 * cp) = (f32x2){a0[o], a1[o]};
        __syncthreads();
#pragma unroll
        for (int q = 0; q < 4; ++q) { const int tl = X.wave * 4 + q; f32x4 v[2]; float s = 0.f;
#pragma unroll
            for (int j = 0; j < 2; ++j) { v[j] = *(const LAS f32x4*)(tout + tl * 512 + 4 * X.lane + 256 * j); s += (v[j][0] + v[j][1]) + (v[j][2] + v[j][3]); }
            const float mean = wave_sum(s) * (1.0f / 512.0f); float s2 = 0.f;
#pragma unroll
            for (int j = 0; j < 2; ++j) { v[j] = v[j] - mean; s2 += (v[j][0] * v[j][0] + v[j][1] * v[j][1]) + (v[j][2] * v[j][2] + v[j][3] * v[j][3]); }
            const float rstd = rsqrtf(wave_sum(s2) * (1.0f / 512.0f) + EPS);
#pragma unroll
            for (int j = 0; j < 2; ++j) { const f32x4 g = *(const f32x4*)(IN(I_ELNG) + 4 * X.lane + 256 * j), b = *(const f32x4*)(IN(I_ELNB) + 4 * X.lane + 256 * j);
                f32x4 y = v[j] * rstd * g + b;
#pragma unroll
                for (int k = 0; k < 4; ++k) y[k] = y[k] * sigmoidf_(y[k]);
                u32x2 o; o.x = pk2(y[0], y[1]); o.y = pk2(y[2], y[3]); *(u32x2*)(MIX + (size_t)(row0 + tl) * D + 4 * X.lane + 256 * j) = o; } }
    }
}

__device__ __forceinline__ void phase_attention(const Args& a, const Ctx& X) {
    unsigned char* const wsb = X.ws;
    LAS unsigned char* Ks = X.lds;
    LAS unsigned char* Vt = X.lds + 16384;
    const int lane = X.lane, l15 = lane & 15, g4 = lane >> 4;
    for (int unit = X.bid; unit < NB * 2 * 32; unit += X.G) {
        const int b = unit >> 6, kh = (unit >> 5) & 1, qb = unit & 31; const int q0 = qb * 64;
        const int hq = kh * 4 + (X.wave >> 1), tq = (X.wave & 1) * 32;
        bf16x8 Qf[2][2];
#pragma unroll
        for (int qi = 0; qi < 2; ++qi)
#pragma unroll
            for (int s = 0; s < 2; ++s) Qf[qi][s] = *(const bf16x8*)(wsb + (unsigned)(WS_Q + 2u * (unsigned)((b * SEQ + q0 + tq + 16 * qi + l15) * 512 + hq * 64 + 32 * s + 8 * g4)));
        const float sink2 = IN(I_SINK)[hq] * LOG2E;
        float mrun[2], lrun[2]; f32x4 O[2][4];
#pragma unroll
        for (int qi = 0; qi < 2; ++qi) { mrun[qi] = sink2; lrun[qi] = (g4 == 0) ? 1.0f : 0.0f;
#pragma unroll
            for (int db = 0; db < 4; ++db) O[qi][db] = (f32x4){0.f, 0.f, 0.f, 0.f}; }
        const int t_first = (q0 >= 128) ? 0 : (q0 >= 64 ? 1 : 2), t_skip_lo = (q0 + 128 < SEQ) ? 5 : (q0 + 64 < SEQ ? 4 : 3);
        const int key = X.tid >> 3, ch = X.tid & 7;
        auto tile_offs = [&](int t, unsigned& ko, unsigned& vo) {
            if (t < 5) { const unsigned e = (unsigned)((b * SEQ + q0 - 128 + 64 * t) * 128 + kh * 64) * 2u; ko = (unsigned)WS_K + e; vo = (unsigned)WS_V + e; }
            else { const unsigned e = (unsigned)((b * CTXL + (t - 5) * 64) * 128 + kh * 64) * 2u; ko = (unsigned)WS_KC + e; vo = (unsigned)WS_VC + e; } };
        const unsigned lane_off = (unsigned)(key * 128 + ch * 8) * 2u;
        auto lds_put = [&](int buf, const u32x4& kv, const u32x4& vv) {
            LAS unsigned char* Kd = Ks + buf * 32768; LAS unsigned char* Vd = Vt + buf * 32768;
            *(LAS u32x4*)(Kd + key * 144 + ch * 16) = kv;
#pragma unroll
            for (int i = 0; i < 4; ++i) { *(LAS unsigned short*)(Vd + (8 * ch + 2 * i) * 136 + key * 2) = (unsigned short)(vv[i] & 0xffffu); *(LAS unsigned short*)(Vd + (8 * ch + 2 * i + 1) * 136 + key * 2) = (unsigned short)(vv[i] >> 16); } };
        u32x4 kreg, vreg;
        { unsigned ko, vo; tile_offs(t_first, ko, vo); kreg = *(const u32x4*)(wsb + (ko + lane_off)); vreg = *(const u32x4*)(wsb + (vo + lane_off)); }
        __syncthreads();
        lds_put(0, kreg, vreg);
        int bufi = 0;
        for (int t = t_first; t < 9; ++t) {
            if (t >= t_skip_lo && t < 5) continue;
            int tn = t + 1; if (tn >= t_skip_lo && tn < 5) tn = 5;
            if (tn < 9) { unsigned ko, vo; tile_offs(tn, ko, vo); kreg = *(const u32x4*)(wsb + (ko + lane_off)); vreg = *(const u32x4*)(wsb + (vo + lane_off)); }
            const int mode = (t == 0) ? 1 : (t == 4 ? 2 : 0);
            __syncthreads();
            const LAS unsigned char* Kc = Ks + bufi * 32768; const LAS unsigned char* Vc = Vt + bufi * 32768;
            bf16x8 kf[4][2];
#pragma unroll
            for (int kb = 0; kb < 4; ++kb)
#pragma unroll
                for (int s = 0; s < 2; ++s) kf[kb][s] = *(const LAS bf16x8*)(Kc + (16 * kb + l15) * 144 + (32 * s + 8 * g4) * 2);
            bf16x8 vf[4][2];
#pragma unroll
            for (int db = 0; db < 4; ++db)
#pragma unroll
                for (int ks2 = 0; ks2 < 2; ++ks2) { const LAS unsigned char* p = Vc + (16 * db + l15) * 136 + (32 * ks2 + 4 * g4) * 2;
                    const u32x2 lo = *(const LAS u32x2*)p, hi = *(const LAS u32x2*)(p + 32);
                    u32x4 w; w.x = lo.x; w.y = lo.y; w.z = hi.x; w.w = hi.y; vf[db][ks2] = __builtin_bit_cast(bf16x8, w); }
#pragma unroll
            for (int qi = 0; qi < 2; ++qi) {
                f32x4 st[4];
#pragma unroll
                for (int kb = 0; kb < 4; ++kb) { st[kb] = (f32x4){0.f, 0.f, 0.f, 0.f};
#pragma unroll
                    for (int s = 0; s < 2; ++s) st[kb] = __builtin_amdgcn_mfma_f32_16x16x32_bf16(kf[kb][s], Qf[qi][s], st[kb], 0, 0, 0); }
                if (mode) { int qloc = tq + 16 * qi + l15; asm volatile("" : "+v"(qloc));
#pragma unroll
                    for (int kb = 0; kb < 4; ++kb)
#pragma unroll
                        for (int r = 0; r < 4; ++r) { const int kk = 16 * kb + 4 * g4 + r; const bool keep = (mode == 1) ? (kk >= qloc) : (kk <= qloc); if (!keep) st[kb][r] = -1e30f; } }
                float mx = st[0][0];
#pragma unroll
                for (int kb = 0; kb < 4; ++kb)
#pragma unroll
                    for (int r = 0; r < 4; ++r) mx = fmaxf(mx, st[kb][r]);
                mx = fmaxf(mx, __shfl_xor(mx, 16)); mx = fmaxf(mx, __shfl_xor(mx, 32));
                const float mnew = fmaxf(mrun[qi], mx); const float alpha = __builtin_amdgcn_exp2f(mrun[qi] - mnew); mrun[qi] = mnew;
                float ps = 0.f;
#pragma unroll
                for (int kb = 0; kb < 4; ++kb)
#pragma unroll
                    for (int r = 0; r < 4; ++r) { st[kb][r] = __builtin_amdgcn_exp2f(st[kb][r] - mnew); ps += st[kb][r]; }
                lrun[qi] = lrun[qi] * alpha + ps;
#pragma unroll
                for (int db = 0; db < 4; ++db) O[qi][db] = O[qi][db] * alpha;
#pragma unroll
                for (int ks2 = 0; ks2 < 2; ++ks2) { u32x4 w; w.x = pk2(st[2 * ks2][0], st[2 * ks2][1]); w.y = pk2(st[2 * ks2][2], st[2 * ks2][3]); w.z = pk2(st[2 * ks2 + 1][0], st[2 * ks2 + 1][1]); w.w = pk2(st[2 * ks2 + 1][2], st[2 * ks2 + 1][3]);
                    const bf16x8 pf = __builtin_bit_cast(bf16x8, w);
#pragma unroll
                    for (int db = 0; db < 4; ++db) O[qi][db] = __builtin_amdgcn_mfma_f32_16x16x32_bf16(vf[db][ks2], pf, O[qi][db], 0, 0, 0); }
            }
            if (tn < 9) lds_put(bufi ^ 1, kreg, vreg);
            bufi ^= 1;
        }
#pragma unroll
        for (int qi = 0; qi < 2; ++qi) { float l = lrun[qi]; l += __shfl_xor(l, 16); l += __shfl_xor(l, 32); const float inv = 1.0f / l;
            bf16* orow = (bf16*)(wsb + (unsigned)(WS_MIX + 2u * (unsigned)((b * SEQ + q0 + tq + 16 * qi + l15) * D + 512 + hq * 64 + 4 * g4)));
#pragma unroll
            for (int db = 0; db < 4; ++db) { u32x2 o; o.x = pk2(O[qi][db][0] * inv, O[qi][db][1] * inv); o.y = pk2(O[qi][db][2] * inv, O[qi][db][3] * inv); *(u32x2*)(orow + 16 * db) = o; } }
    }
}

__device__ __forceinline__ void phase_router(const Args& a, const Ctx& X, int layer) {
    const float* __restrict__ H = (const float*)(X.ws + WS_H); unsigned char* XA8 = (unsigned char*)(X.ws + WS_XA8);
    const float* MODl = (const float*)(X.ws + WS_MOD) + (size_t)layer * 9 * MODW; const float* gn = IN(I_NFG) + layer * D;
    const float* rw = IN(I_RW) + (size_t)layer * D * NE; const float* rb = IN(I_RB) + layer * NE;
    int* cntg = (int*)(X.ws + WS_CTL) + CW_CNT + layer * NE * CNT_STRIDE; int* list = (int*)(X.ws + WS_LIST); float* gatew = (float*)(X.ws + WS_GATE);
    LAS float* ybuf = (LAS float*)X.lds;
    LAS float* part = (LAS float*)(X.lds + 65536);
    LAS int* sel = (LAS int*)(X.lds + 65536 + 16384);
    LAS int* lcnt = (LAS int*)(X.lds + 65536 + 16384 + 1024);
    LAS float* lgs = (LAS float*)(X.lds + 65536 + 16384 + 2048);
    LAS float* tvs = lgs + 512;
    LAS float* exs = lgs + 528;
    PMARK(0);
    const int e = X.lane & 31, hf = X.lane >> 5;
    float wreg[64];
#pragma unroll
    for (int i = 0; i < 64; ++i) wreg[i] = rw[(size_t)(128 * X.wave + 64 * hf + i) * NE + e];
    const float rbe = rb[e];
    for (int blk = X.bid; blk < NTOK / 64; blk += X.G) {
        const int rowbase = blk * 64; const float* m = MODl + (size_t)(rowbase / SEQ) * MODW;
        f32x4 gk[4], hk[4], xv[2][4];
#pragma unroll
        for (int j = 0; j < 4; ++j) { gk[j] = ((const f32x4*)gn)[X.lane + 64 * j]; hk[j] = ((const f32x4*)(m + 3 * 1024))[X.lane + 64 * j]; const f32x4 s_ = ((const f32x4*)(m + 4 * 1024))[X.lane + 64 * j]; gk[j] = gk[j] * (1.0f + s_); }
#pragma unroll
        for (int i = 0; i < 2; ++i)
#pragma unroll
            for (int j = 0; j < 4; ++j) xv[i][j] = ((const f32x4*)(H + (size_t)(rowbase + 2 * X.wave + i) * D))[X.lane + 64 * j];
        __syncthreads();
        if (X.tid < 64) lcnt[X.tid] = 0;
        PMARK(1);
#pragma unroll 1
        for (int bt = 0; bt < 4; ++bt) {
#pragma unroll
            for (int i = 0; i < 2; ++i) { const int rl = 2 * X.wave + i, row = rowbase + 16 * bt + rl; float ss = 0.f;
#pragma unroll
                for (int j = 0; j < 4; ++j) ss += (xv[i][j][0] * xv[i][j][0] + xv[i][j][1] * xv[i][j][1]) + (xv[i][j][2] * xv[i][j][2] + xv[i][j][3] * xv[i][j][3]);
                const float rstd = rsqrtf(wave_sum(ss) * (1.0f / D) + EPS);
#pragma unroll
                for (int j = 0; j < 4; ++j) { const f32x4 y = xv[i][j] * rstd * gk[j] + hk[j];
                    *((unsigned*)(XA8 + (size_t)row * D) + X.lane + 64 * j) = pk4_fp8(y[0] * FP8_AMUL, y[1] * FP8_AMUL, y[2] * FP8_AMUL, y[3] * FP8_AMUL);
                    *(LAS f32x4*)(ybuf + rl * 1024 + 4 * X.lane + 256 * j) = y; } }
            if (bt < 3) {
#pragma unroll
                for (int i = 0; i < 2; ++i)
#pragma unroll
                    for (int j = 0; j < 4; ++j) xv[i][j] = ((const f32x4*)(H + (size_t)(rowbase + 16 * (bt + 1) + 2 * X.wave + i) * D))[X.lane + 64 * j];
            }
            __syncthreads();
#pragma unroll 2
            for (int r = 0; r < 16; ++r) { float acc[4] = {0.f, 0.f, 0.f, 0.f}; const LAS float* yp = ybuf + r * 1024 + 128 * X.wave + 64 * hf;
#pragma unroll
                for (int i4 = 0; i4 < 16; ++i4) { const f32x4 yv = *(const LAS f32x4*)(yp + 4 * i4);
                    acc[i4 & 3] += yv[0] * wreg[4 * i4] + yv[1] * wreg[4 * i4 + 1] + yv[2] * wreg[4 * i4 + 2] + yv[3] * wreg[4 * i4 + 3]; }
                const float t0 = (acc[0] + acc[1]) + (acc[2] + acc[3]); const float t = t0 + dpp_swap32(t0);
                if (hf == 0) part[(r * 8 + X.wave) * 32 + e] = t; }
            __syncthreads();
            { const int r = 2 * X.wave + hf, rl = 16 * bt + r;
              float v = rbe;
#pragma unroll
              for (int w8 = 0; w8 < 8; ++w8) v += part[(r * 8 + w8) * 32 + e];
              lgs[r * 32 + e] = v; LDS_WAIT();
              int ez = e; asm volatile("" : "+v"(ez));
              int rank = 0;
#pragma unroll
              for (int j4 = 0; j4 < 8; ++j4) { const f32x4 o = *(const LAS f32x4*)(lgs + r * 32 + 4 * j4);
#pragma unroll
                  for (int c = 0; c < 4; ++c) rank += (o[c] > v || (o[c] == v && (4 * j4 + c) < ez)) ? 1 : 0; }
              if (rank == 0) tvs[r] = v;
              LDS_WAIT();
              const float ex = __expf(v - tvs[r]);
              if (rank < 4) exs[r * 4 + rank] = ex;
              LDS_WAIT();
              const f32x4 e4 = *(const LAS f32x4*)(exs + r * 4); const float inv = 1.0f / ((e4[0] + e4[1]) + (e4[2] + e4[3]));
              if (rank < 4) { const int slot = atomicAdd((int*)&lcnt[e], 1); sel[rl * 4 + rank] = (e << 16) | slot; gatew[(size_t)(rowbase + rl) * 4 + rank] = ex * inv; } }
        }
        __syncthreads();
        PMARK(2);
        if (X.tid < 32) lcnt[32 + X.tid] = atomicAdd(cntg + X.tid * CNT_STRIDE, lcnt[X.tid]);
        __syncthreads();
        if (X.tid < 256) { const int w = sel[X.tid]; const int ee = w >> 16, rank = w & 0xffff; list[(size_t)ee * NTOK + lcnt[32 + ee] + rank] = rowbase * 4 + X.tid; }
    }
    PMARK(3);
}

__device__ __forceinline__ void phase_combine(const Args& a, const Ctx& X, int layer) {
    float* H = (float*)(X.ws + WS_H); const bf16* __restrict__ Y = (const bf16*)(X.ws + WS_Y); bf16* XA = (bf16*)(X.ws + WS_XA);
    const float* __restrict__ MODl = (const float*)(X.ws + WS_MOD) + (size_t)layer * 9 * MODW;
    float* outp = (float*)(__attribute__((address_space(1))) float*)X.kp[33];
    for (int row = X.gw; row < NTOK; row += X.NGW) {
        const float* gt = MODl + (size_t)(row / SEQ) * MODW + 5 * 1024; f32x4 h[2][2], g[2][2]; u32x4 yw[2][4];
#pragma unroll
        for (int j = 0; j < 2; ++j) { const int c0 = 8 * X.lane + 512 * j;
#pragma unroll
            for (int q = 0; q < 2; ++q) { h[j][q] = *(const f32x4*)(H + (size_t)row * D + c0 + 4 * q); g[j][q] = *(const f32x4*)(gt + c0 + 4 * q); }
#pragma unroll
            for (int k = 0; k < 4; ++k) yw[j][k] = *(const u32x4*)(Y + ((size_t)row * 4 + k) * D + c0); }
        float ss = 0.f;
#pragma unroll
        for (int j = 0; j < 2; ++j) { f32x4 s0 = (f32x4){0.f, 0.f, 0.f, 0.f}, s1 = s0;
#pragma unroll
            for (int k = 0; k < 4; ++k) { const u32x4 w = yw[j][k]; s0 += (f32x4){bf2f(w.x & 0xffffu), bf2f(w.x >> 16), bf2f(w.y & 0xffffu), bf2f(w.y >> 16)}; s1 += (f32x4){bf2f(w.z & 0xffffu), bf2f(w.z >> 16), bf2f(w.w & 0xffffu), bf2f(w.w >> 16)}; }
            h[j][0] = h[j][0] + g[j][0] * s0; h[j][1] = h[j][1] + g[j][1] * s1;
#pragma unroll
            for (int q = 0; q < 2; ++q) ss += (h[j][q][0] * h[j][q][0] + h[j][q][1] * h[j][q][1]) + (h[j][q][2] * h[j][q][2] + h[j][q][3] * h[j][q][3]); }
        if (layer == 1) {
#pragma unroll
            for (int j = 0; j < 2; ++j)
#pragma unroll
                for (int q = 0; q < 2; ++q) *(f32x4*)(outp + (size_t)row * D + 8 * X.lane + 512 * j + 4 * q) = h[j][q];
        } else {
            const float* m1 = (const float*)(X.ws + WS_MOD) + (size_t)9 * MODW + (size_t)(row / SEQ) * MODW; const float* gn = IN(I_NMG) + D;
            f32x4 gk[2][2], hk[2][2], sk[2][2];
#pragma unroll
            for (int j = 0; j < 2; ++j)
#pragma unroll
                for (int q = 0; q < 2; ++q) { const int c0 = 8 * X.lane + 512 * j + 4 * q; gk[j][q] = *(const f32x4*)(gn + c0); hk[j][q] = *(const f32x4*)(m1 + c0); sk[j][q] = *(const f32x4*)(m1 + 1024 + c0); }
            const float rstd = rsqrtf(wave_sum(ss) * (1.0f / D) + EPS);
#pragma unroll
            for (int j = 0; j < 2; ++j) { const int c0 = 8 * X.lane + 512 * j;
                const f32x4 y0 = h[j][0] * rstd * gk[j][0] * (1.0f + sk[j][0]) + hk[j][0], y1 = h[j][1] * rstd * gk[j][1] * (1.0f + sk[j][1]) + hk[j][1];
                *(f32x4*)(H + (size_t)row * D + c0) = h[j][0]; *(f32x4*)(H + (size_t)row * D + c0 + 4) = h[j][1];
                *(u32x4*)(XA + (size_t)row * D + c0) = pack8(y0, y1); }
        }
    }
}

__device__ __forceinline__ void phase_spatial(const Args& a, const Ctx& X) {
    const bf16* U = (const bf16*)(X.ws + WS_U); const bf16* VB = (const bf16*)(X.ws + WS_VB); bf16* SG = (bf16*)(X.ws + WS_MIX); const bf16* WsB = (const bf16*)(X.ws + WS_WSB); const float* vstat = (const float*)(X.ws + WS_CTL) + CW_VSTAT;
    LAS float* stat = (LAS float*)X.lds;
    LAS unsigned char* Vt = X.lds + 4096;
    const int lane = X.lane, l15 = lane & 15, g4 = lane >> 4;
    for (int item = X.bid; item < 128 * 8; item += X.G) {
        const int chunk = item >> 3, g = item & 7; const int row0 = chunk * 128;
        __syncthreads();
        if (X.tid < 128) { const f32x2 sv = *(const f32x2*)(vstat + 2 * (row0 + X.tid)); const float mean = sv.x * (1.0f / D); const float var = fmaxf(sv.y * (1.0f / D) - mean * mean, 0.f);
            stat[2 * X.tid] = mean; stat[2 * X.tid + 1] = rsqrtf(var + EPS); }
        __syncthreads();
#pragma unroll
        for (int c = X.tid; c < 128 * 16; c += NTHREADS) { const int q = c >> 4, cc = c & 15; const u32x4 w = *(const u32x4*)(VB + (size_t)(row0 + q) * D + g * 128 + cc * 8);
            const float mean = stat[2 * q], rstd = stat[2 * q + 1]; const float* lg_ = IN(I_OLNG) + g * 128 + cc * 8; const float* lb_ = IN(I_OLNB) + g * 128 + cc * 8;
#pragma unroll
            for (int k = 0; k < 4; ++k) { const float y0 = (bf2f(w[k] & 0xffffu) - mean) * rstd * lg_[2 * k] + lb_[2 * k], y1 = (bf2f(w[k] >> 16) - mean) * rstd * lg_[2 * k + 1] + lb_[2 * k + 1];
                const unsigned pk = pk2(y0, y1);
                *(LAS unsigned short*)(Vt + ((2 * k) * 17 + cc) * 272 + q * 2) = (unsigned short)(pk & 0xffffu); *(LAS unsigned short*)(Vt + ((2 * k + 1) * 17 + cc) * 272 + q * 2) = (unsigned short)(pk >> 16); } }
        __syncthreads();
        f32x4 acc[8];
#pragma unroll
        for (int pb = 0; pb < 8; ++pb) acc[pb] = (f32x4){0.f, 0.f, 0.f, 0.f};
#pragma unroll
        for (int s = 0; s < 4; ++s) { const bf16x8 af = *(const LAS bf16x8*)(Vt + ((l15 & 7) * 17 + 2 * X.wave + (l15 >> 3)) * 272 + (32 * s + 8 * g4) * 2);
#pragma unroll
            for (int pb = 0; pb < 8; ++pb) { const bf16x8 bfr = *(const bf16x8*)(WsB + ((size_t)g * 128 + 16 * pb + l15) * 128 + 32 * s + 8 * g4); acc[pb] = __builtin_amdgcn_mfma_f32_16x16x32_bf16(af, bfr, acc[pb], 0, 0, 0); } }
#pragma unroll
        for (int pb = 0; pb < 8; ++pb) { const int p = 16 * pb + l15; const float bs = IN(I_OBS)[g * 128 + p]; const size_t off = (size_t)(row0 + p) * D + g * 128 + 16 * X.wave + 4 * g4;
            const u32x2 uw = *(const u32x2*)(U + off);
            u32x2 o; o.x = pk2(bf2f(uw.x & 0xffffu) * (acc[pb][0] + bs), bf2f(uw.x >> 16) * (acc[pb][1] + bs)); o.y = pk2(bf2f(uw.y & 0xffffu) * (acc[pb][2] + bs), bf2f(uw.y >> 16) * (acc[pb][3] + bs));
            *(u32x2*)(SG + off) = o; }
    }
}

enum { PH_PRO = 0, PH_MOD0, PH_GIN, PH_CONV, PH_ATT, PH_GOUT, PH_RT0, PH_M1_0, PH_M2_0, PH_CMB0, PH_GMI, PH_SPA, PH_GMO, PH_RT1, PH_M1_1, PH_M2_1, PH_CMB1, NPHASE };

__global__ void __launch_bounds__(NTHREADS, 2) mega(Args a) {
    extern __shared__ __attribute__((aligned(16))) unsigned char lds_raw[];
    Ctx X; X.lds = (LAS unsigned char*)lds_raw;
    const int wave0 = __builtin_amdgcn_readfirstlane((int)threadIdx.x >> 6);
    const int G0 = gridDim.x, bid0 = blockIdx.x; const int vcu0 = (G0 % 8 == 0) ? (bid0 % 8) * (G0 / 8) + bid0 / 8 : bid0;
    X.wave = wave0;
    volatile LAS unsigned* MISC = (volatile LAS unsigned*)(X.lds + MISC_OFF);
    if (threadIdx.x < 64) MISC[threadIdx.x] = 0u;
    __syncthreads();
    XcdBarrier bar = xcd_barrier_post((unsigned*)(a.ws + WS_CTL) + CW_BAR + a.li * XCD_BAR_WORDS, MISC + 8);
    const int ph_lo = a.ph_lo, ph_hi = a.ph_hi;
#if PROBE_PH >= 0
#define PROBE_STAMP(p) do { if ((p) == PROBE_PH) pr_t0 = __builtin_amdgcn_s_memrealtime(); if ((p) == PROBE_END) pr_t1 = __builtin_amdgcn_s_memrealtime(); } while (0)
#else
#define PROBE_STAMP(p) do { } while (0)
#endif
#define PH_ENTER() int z; asm volatile("s_mov_b32 %0, 0" : "=s"(z)); \
        X.lane = (int)__builtin_amdgcn_mbcnt_hi(~0u, __builtin_amdgcn_mbcnt_lo(~0u, (unsigned)z)); X.tid = wave0 * 64 + X.lane; \
        X.G = G0 + z; X.vcu = vcu0 + z; X.bid = bid0 + z; X.NGW = X.G * NWAVES; X.gw = X.vcu * NWAVES + wave0; \
        { kargp_t kp = (kargp_t)__builtin_amdgcn_kernarg_segment_ptr(); asm volatile("" : "+s"(kp)); X.kp = kp; } \
        unsigned char* ws = (unsigned char*)(__attribute__((address_space(1))) unsigned char*)X.kp[34] + z; X.ws = ws;
#if PROBE_PH >= 0
    unsigned long long pr_t0 = 0, pr_t1 = 0;
#endif
#define PH_RUN(PHK, ...) if (ph_lo <= (PHK) && (PHK) < ph_hi) { const int ph = (PHK); \
        if (ph != ph_lo) { const int l0 = (int)__builtin_amdgcn_mbcnt_hi(~0u, __builtin_amdgcn_mbcnt_lo(~0u, 0u)); xcd_barrier(bar, wave0 * 64 + l0); } \
        PROBE_STAMP(ph); __VA_ARGS__ }
    PH_RUN(PH_PRO, { PH_ENTER(); phase_prologue(a, X); })
    PH_RUN(PH_MOD0, { PH_ENTER(); phase_modulate0(a, X); })
    PH_RUN(PH_GIN, { PH_ENTER(); DenseSched S; S.init((const bf16*)(ws + WS_XA), (const bf16*)(ws + WS_WINT), NTOK, EVEN_IN, X.G, X.bid);
            S.A2 = (const bf16*)(ws + WS_GM); S.Bt2 = (const bf16*)(ws + WS_WINT) + (size_t)KV_COL * D; S.nM2 = NCTX / 256;
            EpiIn E{(bf16*)(ws + WS_GLU), (bf16*)(ws + WS_Q), (bf16*)(ws + WS_K), (bf16*)(ws + WS_V), (bf16*)(ws + WS_KC), (bf16*)(ws + WS_VC), IN(I_EBIN)};
            pg8::gemm_phase<EpiIn, DenseSched>(X.lds, S, E, X.tid); })
    PH_RUN(PH_CONV, { PH_ENTER(); phase_conv_qk(a, X); })
    PH_RUN(PH_ATT, { PH_ENTER(); phase_attention(a, X); })
    PH_RUN(PH_GOUT, { PH_ENTER(); DenseSched S; S.init((const bf16*)(ws + WS_MIX), (const bf16*)(ws + WS_WOUTT), NTOK, D, X.G, X.bid);
            EpiRes E{IN(I_X), (float*)(ws + WS_H), IN(I_EBOUT), (const float*)(ws + WS_MOD) + 2 * 1024};
            pg8::gemm_phase<EpiRes, DenseSched>(X.lds, S, E, X.tid); })
    PH_RUN(PH_RT0, { PH_ENTER(); phase_router(a, X, 0); })
    PH_RUN(PH_M1_0, { PH_ENTER(); const int l = (ph == PH_M1_1); moe_build_table(X, (const int*)(ws + WS_CTL) + CW_CNT + l * NE * CNT_STRIDE);
            MoeSchedT<true, 8> S; S.tab = (const LAS int*)(X.lds + TAB_OFF); S.G = X.G; S.c = X.vcu; S.A = (const unsigned char*)(ws + WS_XA8); S.Bt = (const unsigned char*)(ws + WS_W1T) + (size_t)l * NE * 2048 * 1024; S.list = (const int*)(ws + WS_LIST); S.meta = (const LAS int*)(X.lds + META_OFF);
            moe_stage_meta<false>(X, S, S.list, (const float*)nullptr, (LAS int*)(X.lds + META_OFF), IN(I_B1) + (size_t)l * NE * 2048, (LAS float*)(X.lds + BIAS_OFF));
            EpiSwiglu E{(unsigned char*)(ws + WS_ACT), (const LAS float*)(X.lds + BIAS_OFF)};
            pg8::gemm_phase<EpiSwiglu, MoeSchedT<true, 8>>(X.lds, S, E, X.tid); })
    PH_RUN(PH_M2_0, { PH_ENTER(); const int l = (ph == PH_M2_1); moe_build_table(X, (const int*)(ws + WS_CTL) + CW_CNT + l * NE * CNT_STRIDE);
            MoeSchedT<false, 4> S; S.tab = (const LAS int*)(X.lds + TAB_OFF); S.G = X.G; S.c = X.vcu; S.A = (const unsigned char*)(ws + WS_ACT); S.Bt = (const unsigned char*)(ws + WS_W2T) + (size_t)l * NE * 1024 * 1024; S.list = (const int*)(ws + WS_LIST); S.meta = (const LAS int*)(X.lds + META_OFF);
            moe_stage_meta<true>(X, S, S.list, (const float*)(ws + WS_GATE), (LAS int*)(X.lds + META_OFF), IN(I_B2) + (size_t)l * NE * D, (LAS float*)(X.lds + BIAS_OFF));
            EpiDown E{(bf16*)(ws + WS_Y), (const LAS float*)(X.lds + BIAS_OFF), (const LAS int*)(X.lds + META_OFF)};
            pg8::gemm_phase<EpiDown, MoeSchedT<false, 4>>(X.lds, S, E, X.tid); })
    PH_RUN(PH_CMB0, { PH_ENTER(); phase_combine(a, X, 0); })
    PH_RUN(PH_GMI, { PH_ENTER(); DenseSched S; S.init((const bf16*)(ws + WS_XA), (const bf16*)(ws + WS_GWINT), NTOK, 2048, X.G, X.bid);
            EpiGelu E{(bf16*)(ws + WS_U), (bf16*)(ws + WS_VB), IN(I_OBIN), (float*)(ws + WS_CTL) + CW_VSTAT};
            pg8::gemm_phase<EpiGelu, DenseSched>(X.lds, S, E, X.tid); })
    PH_RUN(PH_SPA, { PH_ENTER(); phase_spatial(a, X); })
    PH_RUN(PH_GMO, { PH_ENTER(); DenseSched S; S.init((const bf16*)(ws + WS_MIX), (const bf16*)(ws + WS_GWOUTT), NTOK, D, X.G, X.bid);
            EpiRes E{(const float*)(ws + WS_H), (float*)(ws + WS_H), IN(I_OBOUT), (const float*)(ws + WS_MOD) + (size_t)9 * MODW + 2 * 1024};
            pg8::gemm_phase<EpiRes, DenseSched>(X.lds, S, E, X.tid); })
    PH_RUN(PH_RT1, { PH_ENTER(); phase_router(a, X, 1); })
    PH_RUN(PH_M1_1, { PH_ENTER(); PMARK(50); const int l = (ph == PH_M1_1); moe_build_table(X, (const int*)(ws + WS_CTL) + CW_CNT + l * NE * CNT_STRIDE);
            MoeSchedT<true, 8> S; S.tab = (const LAS int*)(X.lds + TAB_OFF); S.G = X.G; S.c = X.vcu; S.A = (const unsigned char*)(ws + WS_XA8); S.Bt = (const unsigned char*)(ws + WS_W1T) + (size_t)l * NE * 2048 * 1024; S.list = (const int*)(ws + WS_LIST); S.meta = (const LAS int*)(X.lds + META_OFF);
            moe_stage_meta<false>(X, S, S.list, (const float*)nullptr, (LAS int*)(X.lds + META_OFF), IN(I_B1) + (size_t)l * NE * 2048, (LAS float*)(X.lds + BIAS_OFF));
            PMARK(51); EpiSwiglu E{(unsigned char*)(ws + WS_ACT), (const LAS float*)(X.lds + BIAS_OFF)};
            pg8::gemm_phase<EpiSwiglu, MoeSchedT<true, 8>>(X.lds, S, E, X.tid); PMARK(53); })
    PH_RUN(PH_M2_1, { PH_ENTER(); PMARK(54); const int l = (ph == PH_M2_1); moe_build_table(X, (const int*)(ws + WS_CTL) + CW_CNT + l * NE * CNT_STRIDE);
            MoeSchedT<false, 4> S; S.tab = (const LAS int*)(X.lds + TAB_OFF); S.G = X.G; S.c = X.vcu; S.A = (const unsigned char*)(ws + WS_ACT); S.Bt = (const unsigned char*)(ws + WS_W2T) + (size_t)l * NE * 1024 * 1024; S.list = (const int*)(ws + WS_LIST); S.meta = (const LAS int*)(X.lds + META_OFF);
            moe_stage_meta<true>(X, S, S.list, (const float*)(ws + WS_GATE), (LAS int*)(X.lds + META_OFF), IN(I_B2) + (size_t)l * NE * D, (LAS float*)(X.lds + BIAS_OFF));
            EpiDown E{(bf16*)(ws + WS_Y), (const LAS float*)(X.lds + BIAS_OFF), (const LAS int*)(X.lds + META_OFF)};
            pg8::gemm_phase<EpiDown, MoeSchedT<false, 4>>(X.lds, S, E, X.tid); })
    PH_RUN(PH_CMB1, { PH_ENTER(); phase_combine(a, X, 1); })
#if PROBE_PH == -2
    if (blockIdx.x == 0 && threadIdx.x == 0) { volatile LAS unsigned long long* pm_ = (volatile LAS unsigned long long*)(X.lds + MISC_OFF + 128); const unsigned long long te = __builtin_amdgcn_s_memrealtime(); const unsigned long long span = (pm_[1] - pm_[0]) * PROBE_MULT;
        while (__builtin_amdgcn_s_memrealtime() - te < span) __builtin_amdgcn_s_sleep(8); }
#endif
#if PROBE_PH >= 0
    if (pr_t1 == 0) pr_t1 = __builtin_amdgcn_s_memrealtime();
    if (blockIdx.x == 0 && wave0 == 0) { const unsigned long long te = __builtin_amdgcn_s_memrealtime(); const unsigned long long span = (pr_t1 - pr_t0) * PROBE_MULT;
        while (__builtin_amdgcn_s_memrealtime() - te < span) __builtin_amdgcn_s_sleep(8); }
#endif
}

__device__ __forceinline__ bool find_expert(const int* cnt, int s, int& e, int& slot) {
    int pb = 0;
    for (int i = 0; i < NE; ++i) { const int c = cnt[i * CNT_STRIDE]; const int pr = ((c + 255) >> 8) << 8; if (s < pb + pr) { e = i; slot = s - pb; return true; } pb += pr; }
    return false;
}
__global__ void __launch_bounds__(256) slow_gemm(const bf16* A, const int* arow, const bf16* Bt, float* C, int N, const int* cnt, size_t bstride) {
    __shared__ float As[16][65], Bs[16][65];
    const int tx = threadIdx.x & 15, ty = threadIdx.x >> 4; const int m0 = blockIdx.y * 64, n0 = blockIdx.x * 64;
    if (cnt) { int e, slot; if (!find_expert(cnt, m0, e, slot)) return; Bt += (size_t)e * bstride; }
    float acc[4][4];
    for (int i = 0; i < 4; ++i) for (int j = 0; j < 4; ++j) acc[i][j] = 0.f;
    for (int k0 = 0; k0 < 1024; k0 += 16) {
        for (int i = 0; i < 4; ++i) { const int idx = threadIdx.x + 256 * i; const int r = idx >> 4, kk = idx & 15; const int gm = m0 + r; const int ar = arow ? arow[gm] : gm;
            As[kk][r] = bf2f(A[(size_t)ar * 1024 + k0 + kk]); Bs[kk][r] = bf2f(Bt[(size_t)(n0 + r) * 1024 + k0 + kk]); }
        __syncthreads();
        for (int kk = 0; kk < 16; ++kk) { float av[4], bv[4];
            for (int i = 0; i < 4; ++i) { av[i] = As[kk][ty * 4 + i]; bv[i] = Bs[kk][tx * 4 + i]; }
            for (int i = 0; i < 4; ++i) for (int j = 0; j < 4; ++j) acc[i][j] += av[i] * bv[j]; }
        __syncthreads();
    }
    for (int i = 0; i < 4; ++i) for (int j = 0; j < 4; ++j) C[(size_t)(m0 + ty * 4 + i) * N + n0 + tx * 4 + j] = acc[i][j];
}
__device__ __forceinline__ unsigned short f2bf_s(float f) { return (unsigned short)(pk2(f, 0.f) & 0xffffu); }
__global__ void slow_epi_in(const float* C, const float* C2, const float* bias, bf16* GLU, bf16* Q, bf16* Kb, bf16* Vb, bf16* KC, bf16* VC) {
    const size_t i = (size_t)blockIdx.x * blockDim.x + threadIdx.x;
    if (i < (size_t)NTOK * 512) { const int row = (int)(i >> 9), j = (int)(i & 511); const int t = j >> 7, ii = j & 127; const float* cr = C + (size_t)row * EVEN_IN;
        const float u = cr[t * 256 + ii] + bias[j], g = cr[t * 256 + 128 + ii] + bias[512 + j];
        GLU[i] = f2bf_s(u / (1.0f + expf(-g)));
        Q[i] = f2bf_s(cr[1024 + j] + bias[1024 + j]);
        if (j < 128) { Kb[(size_t)row * 128 + j] = f2bf_s(cr[1536 + j] + bias[1536 + j]); Vb[(size_t)row * 128 + j] = f2bf_s(cr[1664 + j] + bias[1664 + j]); }
        if (row < NCTX && j < 128) { KC[(size_t)row * 128 + j] = f2bf_s(C2[(size_t)row * 256 + j] + bias[1536 + j]); VC[(size_t)row * 128 + j] = f2bf_s(C2[(size_t)row * 256 + 128 + j] + bias[1664 + j]); } }
}
__global__ void slow_epi_res(const float* C, const float* base, float* out, const float* bias, const float* gate) {
    const size_t i = (size_t)blockIdx.x * blockDim.x + threadIdx.x;
    if (i < (size_t)NTOK * D) { const int row = (int)(i >> 10), col = (int)(i & 1023); out[i] = base[i] + gate[(size_t)(row / SEQ) * MODW + col] * (C[i] + bias[col]); }
}
__global__ void slow_epi_gelu(const float* C, const float* bias, bf16* U, bf16* V) {
    const size_t i = (size_t)blockIdx.x * blockDim.x + threadIdx.x;
    if (i < (size_t)NTOK * 2048) { const int row = (int)(i >> 11), col = (int)(i & 2047); const float x = C[i] + bias[col]; const float y = 0.5f * x * (1.0f + erff(x * 0.70710678118654752f));
        if (col < 1024) U[(size_t)row * D + col] = f2bf_s(y); else V[(size_t)row * D + col - 1024] = f2bf_s(y); }
}
__global__ void slow_arow(const int* cnt, const int* list, int* arow) {
    const int s = blockIdx.x * blockDim.x + threadIdx.x; if (s >= ACT_ROWS) return;
    int e, slot; int r = 0; if (find_expert(cnt, s, e, slot) && slot < cnt[e * CNT_STRIDE]) r = list[(size_t)e * NTOK + slot] >> 2;
    arow[s] = r;
}
__global__ void slow_epi_swiglu(const float* C, const int* cnt, const float* b1, bf16* ACT) {
    const size_t i = (size_t)blockIdx.x * blockDim.x + threadIdx.x;
    if (i < (size_t)ACT_ROWS * 1024) { const int s = (int)(i >> 10), j = (int)(i & 1023); int e, slot; if (!find_expert(cnt, s, e, slot)) return;
        const int t = j >> 7, ii = j & 127; const float* cr = C + (size_t)s * 2048;
        float g = cr[t * 256 + ii] + b1[(size_t)e * 2048 + j], up = cr[t * 256 + 128 + ii] + b1[(size_t)e * 2048 + 1024 + j];
        g = fminf(g, 7.0f); up = fminf(fmaxf(up, -7.0f), 7.0f);
        ACT[i] = f2bf_s((up + 1.0f) * g / (1.0f + expf(-1.702f * g))); }
}
__global__ void slow_epi_down(const float* C, const int* cnt, const int* list, const float* gatew, const float* b2, bf16* Y) {
    const size_t i = (size_t)blockIdx.x * blockDim.x + threadIdx.x;
    if (i < (size_t)ACT_ROWS * 1024) { const int s = (int)(i >> 10), col = (int)(i & 1023); int e, slot; if (!find_expert(cnt, s, e, slot) || slot >= cnt[e * CNT_STRIDE]) return;
        const int aid = list[(size_t)e * NTOK + slot]; Y[(size_t)aid * D + col] = f2bf_s((C[i] + b2[(size_t)e * D + col]) * gatew[aid]); }
}
__global__ void __launch_bounds__(64) slow_attention(const bf16* QN, const bf16* KN, const bf16* VV, const bf16* KC, const bf16* VC, const float* sink, bf16* MIX) {
    const int i = blockIdx.x * blockDim.x + threadIdx.x; if (i >= NTOK * 8) return;
    const int row = i >> 3, h = i & 7, kh = h >> 2, b = row / SEQ, t = row % SEQ;
    float q[64], o[64];
    for (int d = 0; d < 64; ++d) { q[d] = bf2f(QN[(size_t)row * 512 + h * 64 + d]); o[d] = 0.f; }
    float m = sink[h] * LOG2E, l = 1.0f;
    const int j0 = t - 128 < 0 ? 0 : t - 128, j1 = t + 128 > SEQ - 1 ? SEQ - 1 : t + 128;
    for (int jj = j0; jj <= j1 + CTXL; ++jj) {
        const bf16* kp; const bf16* vp;
        if (jj <= j1) { kp = KN + (size_t)(b * SEQ + jj) * 128 + kh * 64; vp = VV + (size_t)(b * SEQ + jj) * 128 + kh * 64; }
        else { const int c = jj - j1 - 1; kp = KC + (size_t)(b * CTXL + c) * 128 + kh * 64; vp = VC + (size_t)(b * CTXL + c) * 128 + kh * 64; }
        float s = 0.f; for (int d = 0; d < 64; ++d) s += q[d] * bf2f(kp[d]);
        const float mn = fmaxf(m, s), al = exp2f(m - mn), p = exp2f(s - mn); m = mn; l = l * al + p;
        for (int d = 0; d < 64; ++d) o[d] = o[d] * al + p * bf2f(vp[d]);
    }
    for (int d = 0; d < 64; ++d) MIX[(size_t)row * D + 512 + h * 64 + d] = f2bf_s(o[d] / l);
}
__global__ void slow_vstats(const bf16* VB, float* stat) {
    const int row = blockIdx.x * blockDim.x + threadIdx.x; if (row >= NTOK) return;
    float s = 0.f; for (int c = 0; c < D; ++c) s += bf2f(VB[(size_t)row * D + c]); const float mean = s / D;
    float s2 = 0.f; for (int c = 0; c < D; ++c) { const float d = bf2f(VB[(size_t)row * D + c]) - mean; s2 += d * d; }
    stat[2 * row] = mean; stat[2 * row + 1] = rsqrtf(s2 / D + EPS);
}
__global__ void slow_spatial(const bf16* U, const bf16* VB, const float* stat, const float* ws, const float* bs, const float* lng, const float* lnb, bf16* SG) {
    const size_t i = (size_t)blockIdx.x * blockDim.x + threadIdx.x;
    if (i < (size_t)NTOK * D) { const int row = (int)(i >> 10), ch = (int)(i & 1023); const int g = ch >> 7, p = row & 127, r0 = row - p;
        float s = 0.f;
        for (int q = 0; q < 128; ++q) { const float vn = (bf2f(VB[(size_t)(r0 + q) * D + ch]) - stat[2 * (r0 + q)]) * stat[2 * (r0 + q) + 1] * lng[ch] + lnb[ch]; s += ws[((size_t)g * 128 + p) * 128 + q] * vn; }
        SG[i] = f2bf_s(bf2f(U[i]) * (s + bs[g * 128 + p])); }
}

static void launch_mega(Args& a, int lo, int hi, int& li, int grid, hipStream_t stream) {
    a.ph_lo = lo; a.ph_hi = hi; a.li = li++;
    hipLaunchKernelGGL(mega, dim3(grid), dim3(NTHREADS), LDS_BYTES, stream, a);
}
extern "C" void kernel_launch(void* const* d_in, const int* in_sizes, int n_in, void* d_out, int out_size, void* d_ws, size_t ws_size, hipStream_t stream) {
    static int grid = 0;
    if (grid == 0) {
        if (n_in != 33 || out_size != NTOK * D || ws_size < WS_END) { fprintf(stderr, "kernel_launch: unexpected problem (n_in %d, out %d, ws %zu)\n", n_in, out_size, ws_size); grid = -1; return; }
        int dev = 0, cus = 0, per_cu = 0;
        if (hipGetDevice(&dev) != hipSuccess || hipDeviceGetAttribute(&cus, hipDeviceAttributeMultiprocessorCount, dev) != hipSuccess) { grid = -1; return; }
        if (hipFuncSetAttribute((const void*)mega, hipFuncAttributeMaxDynamicSharedMemorySize, LDS_BYTES) != hipSuccess) { fprintf(stderr, "kernel_launch: hipFuncSetAttribute failed\n"); grid = -1; return; }
        if (hipOccupancyMaxActiveBlocksPerMultiprocessor(&per_cu, (const void*)mega, NTHREADS, LDS_BYTES) != hipSuccess || per_cu < 1) { fprintf(stderr, "kernel_launch: occupancy query says %d blocks per CU\n", per_cu); per_cu = 1; }
        (void)hipGetLastError();
        grid = cus;
    }
    if (grid < 0) return;
    unsigned char* ws = (unsigned char*)d_ws;
    (void)hipMemsetAsync(ws + WS_CTL, 0, CTL_ZERO_BYTES, stream);
    Args a{};
    for (int i = 0; i < 33; ++i) a.in[i] = (const float*)d_in[i];
    a.out = (float*)d_out; a.ws = ws;
    int li = 0;
    const float* in_[33]; for (int i = 0; i < 33; ++i) in_[i] = (const float*)d_in[i];
    float* CF = (float*)(ws + WS_CF); float* MOD = (float*)(ws + WS_MOD); int* CNT = (int*)(ws + WS_CTL) + CW_CNT;
    int lo = 0;
    auto flush = [&](int upto) { if (upto > lo) launch_mega(a, lo, upto, li, grid, stream); };
    for (int ph = 0; ph < NPHASE; ++ph) {
        bool slow = false;
        switch (ph) {
        case PH_GIN: slow = SLOW_MASK & 1; break;
        case PH_ATT: slow = SLOW_MASK & 2; break;
        case PH_GOUT: case PH_GMO: slow = SLOW_MASK & 4; break;
        case PH_M1_0: case PH_M1_1: slow = SLOW_MASK & 8; break;
        case PH_M2_0: case PH_M2_1: slow = SLOW_MASK & 16; break;
        case PH_GMI: slow = SLOW_MASK & 32; break;
        case PH_SPA: slow = SLOW_MASK & 64; break;
        default: break;
        }
        if (!slow) continue;
        flush(ph); lo = ph + 1;
        const int l = (ph == PH_M1_1 || ph == PH_M2_1) ? 1 : 0;
        switch (ph) {
        case PH_GIN:
            hipLaunchKernelGGL(slow_gemm, dim3(EVEN_IN / 64, NTOK / 64), dim3(256), 0, stream, (const bf16*)(ws + WS_XA), (const int*)nullptr, (const bf16*)(ws + WS_WINT), CF, EVEN_IN, (const int*)nullptr, (size_t)0);
            hipLaunchKernelGGL(slow_gemm, dim3(256 / 64, NCTX / 64), dim3(256), 0, stream, (const bf16*)(ws + WS_GM), (const int*)nullptr, (const bf16*)(ws + WS_WINT) + (size_t)KV_COL * D, CF + (size_t)NTOK * EVEN_IN, 256, (const int*)nullptr, (size_t)0);
            hipLaunchKernelGGL(slow_epi_in, dim3(NTOK * 512 / 256), dim3(256), 0, stream, (const float*)CF, (const float*)(CF + (size_t)NTOK * EVEN_IN), in_[I_EBIN], (bf16*)(ws + WS_GLU), (bf16*)(ws + WS_Q), (bf16*)(ws + WS_K), (bf16*)(ws + WS_V), (bf16*)(ws + WS_KC), (bf16*)(ws + WS_VC));
            break;
        case PH_ATT:
            hipLaunchKernelGGL(slow_attention, dim3(NTOK * 8 / 64), dim3(64), 0, stream, (const bf16*)(ws + WS_Q), (const bf16*)(ws + WS_K), (const bf16*)(ws + WS_V), (const bf16*)(ws + WS_KC), (const bf16*)(ws + WS_VC), in_[I_SINK], (bf16*)(ws + WS_MIX));
            break;
        case PH_GOUT:
            hipLaunchKernelGGL(slow_gemm, dim3(D / 64, NTOK / 64), dim3(256), 0, stream, (const bf16*)(ws + WS_MIX), (const int*)nullptr, (const bf16*)(ws + WS_WOUTT), CF, D, (const int*)nullptr, (size_t)0);
            hipLaunchKernelGGL(slow_epi_res, dim3(NTOK * D / 256), dim3(256), 0, stream, (const float*)CF, in_[I_X], (float*)(ws + WS_H), in_[I_EBOUT], (const float*)(MOD + 2 * 1024));
            break;
        case PH_GMO:
            hipLaunchKernelGGL(slow_gemm, dim3(D / 64, NTOK / 64), dim3(256), 0, stream, (const bf16*)(ws + WS_MIX), (const int*)nullptr, (const bf16*)(ws + WS_GWOUTT), CF, D, (const int*)nullptr, (size_t)0);
            hipLaunchKernelGGL(slow_epi_res, dim3(NTOK * D / 256), dim3(256), 0, stream, (const float*)CF, (const float*)(ws + WS_H), (float*)(ws + WS_H), in_[I_OBOUT], (const float*)(MOD + (size_t)9 * MODW + 2 * 1024));
            break;
        case PH_M1_0: case PH_M1_1:
            hipLaunchKernelGGL(slow_arow, dim3(ACT_ROWS / 256), dim3(256), 0, stream, (const int*)(CNT + l * NE * CNT_STRIDE), (const int*)(ws + WS_LIST), (int*)(ws + WS_AROW));
            hipLaunchKernelGGL(slow_gemm, dim3(2048 / 64, ACT_ROWS / 64), dim3(256), 0, stream, (const bf16*)(ws + WS_XA), (const int*)(ws + WS_AROW), (const bf16*)(ws + WS_W1T) + (size_t)l * NE * 2048 * 1024, CF, 2048, (const int*)(CNT + l * NE * CNT_STRIDE), (size_t)2048 * 1024);
            hipLaunchKernelGGL(slow_epi_swiglu, dim3(ACT_ROWS * 1024 / 256), dim3(256), 0, stream, (const float*)CF, (const int*)(CNT + l * NE * CNT_STRIDE), in_[I_B1] + (size_t)l * NE * 2048, (bf16*)(ws + WS_ACT));
            break;
        case PH_M2_0: case PH_M2_1:
            hipLaunchKernelGGL(slow_gemm, dim3(1024 / 64, ACT_ROWS / 64), dim3(256), 0, stream, (const bf16*)(ws + WS_ACT), (const int*)nullptr, (const bf16*)(ws + WS_W2T) + (size_t)l * NE * 1024 * 1024, CF, 1024, (const int*)(CNT + l * NE * CNT_STRIDE), (size_t)1024 * 1024);
            hipLaunchKernelGGL(slow_epi_down, dim3(ACT_ROWS * 1024 / 256), dim3(256), 0, stream, (const float*)CF, (const int*)(CNT + l * NE * CNT_STRIDE), (const int*)(ws + WS_LIST), (const float*)(ws + WS_GATE), in_[I_B2] + (size_t)l * NE * D, (bf16*)(ws + WS_Y));
            break;
        case PH_GMI:
            hipLaunchKernelGGL(slow_gemm, dim3(2048 / 64, NTOK / 64), dim3(256), 0, stream, (const bf16*)(ws + WS_XA), (const int*)nullptr, (const bf16*)(ws + WS_GWINT), CF, 2048, (const int*)nullptr, (size_t)0);
            hipLaunchKernelGGL(slow_epi_gelu, dim3(NTOK * 2048 / 256), dim3(256), 0, stream, (const float*)CF, in_[I_OBIN], (bf16*)(ws + WS_U), (bf16*)(ws + WS_VB));
            break;
        case PH_SPA:
            hipLaunchKernelGGL(slow_vstats, dim3(NTOK / 64), dim3(64), 0, stream, (const bf16*)(ws + WS_VB), CF);
            hipLaunchKernelGGL(slow_spatial, dim3(NTOK * D / 256), dim3(256), 0, stream, (const bf16*)(ws + WS_U), (const bf16*)(ws + WS_VB), (const float*)CF, in_[I_OWS], in_[I_OBS], in_[I_OLNG], in_[I_OLNB], (bf16*)(ws + WS_MIX));
            break;
        default: break;
        }
    }
    flush(NPHASE);
}
```

```cpp
#include <hip/hip_runtime.h>
#include <cstdio>
#include <cstdint>

#ifndef SLOW_MASK
#define SLOW_MASK 0x00
#endif

#ifndef EXP_STREAM
#define EXP_STREAM 0
#endif
#ifndef PROBE_PH
#define PROBE_PH (-1)
#endif
#ifndef PROBE_END
#define PROBE_END (PROBE_PH + 1)
#endif
#ifndef PROBE_A
#define PROBE_A (-1)
#define PROBE_B (-1)
#endif
#ifndef PROBE_MULT
#define PROBE_MULT 4
#endif

#define LAS __attribute__((address_space(3)))
typedef unsigned short bf16;
typedef short bf16x8 __attribute__((ext_vector_type(8)));
typedef float f32x4 __attribute__((ext_vector_type(4)));
typedef float f32x2 __attribute__((ext_vector_type(2)));
typedef unsigned u32x4 __attribute__((ext_vector_type(4)));
typedef unsigned u32x2 __attribute__((ext_vector_type(2)));
typedef __bf16 bf16x2_t __attribute__((ext_vector_type(2)));

constexpr int NB = 8, SEQ = 2048, D = 1024, NTOK = NB * SEQ, CTXL = 256, NCTX = NB * CTXL;
constexpr int NE = 32, TOPK = 4, NASSIGN = NTOK * TOPK, ACT_ROWS = NASSIGN + NE * 256;
constexpr int EVEN_IN = 1792, KV_COL = 1536;
constexpr float EPS = 1e-6f, LOG2E = 1.4426950408889634f;
constexpr float QSCALE = 0.125f * LOG2E;
constexpr int MODW = 6 * D;
constexpr int NWAVES = 8, NTHREADS = 512;

constexpr size_t MiB = 1u << 20;
constexpr size_t WS_CTL = 0, CTL_ZERO_BYTES = 1 * MiB;
constexpr size_t WS_MOD = 1 * MiB;
constexpr size_t WS_LIST = 2 * MiB;
constexpr size_t WS_GATE = 4 * MiB;
constexpr size_t WS_WSB = 5 * MiB;
constexpr size_t WS_WINT = 6 * MiB;
constexpr size_t WS_WOUTT = 10 * MiB;
constexpr size_t WS_GWINT = 12 * MiB;
constexpr size_t WS_GWOUTT = 16 * MiB;
constexpr size_t WS_KC = 18 * MiB;
constexpr size_t WS_VC = 18 * MiB + 512 * 1024;
constexpr size_t WS_K = 19 * MiB;
constexpr size_t WS_V = 23 * MiB;
constexpr size_t WS_GM = 27 * MiB;
constexpr size_t WS_AROW = 31 * MiB;
constexpr size_t WS_Q = 32 * MiB;
constexpr size_t WS_GLU = 48 * MiB;
constexpr size_t WS_XA = 64 * MiB;
constexpr size_t WS_MIX = 96 * MiB;
constexpr size_t WS_H = 128 * MiB;
constexpr size_t WS_U = 192 * MiB;
constexpr size_t WS_VB = 224 * MiB;
constexpr size_t WS_W1T = 256 * MiB;
constexpr size_t WS_W2T = 512 * MiB;
constexpr size_t WS_ACT = 640 * MiB;
constexpr size_t WS_Y = 784 * MiB;
constexpr size_t WS_XA8 = 912 * MiB;
constexpr size_t WS_CF = 928 * MiB;
constexpr size_t WS_END = 1504 * MiB;
constexpr int CW_BAR = 4096, CW_CNT = 131072, CNT_STRIDE = 64  , CW_VSTAT = 147456;
constexpr int MAX_LAUNCH = 20;

constexpr int RING_BYTES = 131072;
constexpr int MISC_OFF = RING_BYTES;
constexpr int TAB_OFF = RING_BYTES + 256;
constexpr int META_OFF = RING_BYTES + 3072;
constexpr int BIAS_OFF = META_OFF + 10240;
constexpr int LDS_BYTES = 163840;

#define LDS_WAIT() asm volatile("s_waitcnt lgkmcnt(0)" ::: "memory")
#define VM_WAIT() asm volatile("s_waitcnt vmcnt(0)" ::: "memory")

__device__ __forceinline__ float bf2f(unsigned b) { return __uint_as_float(b << 16); }
__device__ __forceinline__ unsigned pk2(float lo, float hi) { f32x2 v = {lo, hi}; bf16x2_t b = __builtin_convertvector(v, bf16x2_t); return __builtin_bit_cast(unsigned, b); }
template <int CTRL, int ROW_MASK> __device__ __forceinline__ float dpp_f(float old, float src) { return __builtin_bit_cast(float, __builtin_amdgcn_update_dpp(__builtin_bit_cast(int, old), __builtin_bit_cast(int, src), CTRL, ROW_MASK, 0xf, false)); }
__device__ __forceinline__ unsigned pk4_fp8(float a, float b, float c, float d) { int w = 0; w = __builtin_amdgcn_cvt_pk_fp8_f32(a, b, w, false); w = __builtin_amdgcn_cvt_pk_fp8_f32(c, d, w, true); return (unsigned)w; }
__device__ __forceinline__ float wave_sum(float v) {
    v += dpp_f<0xB1, 0xf>(0.f, v);
    v += dpp_f<0x4E, 0xf>(0.f, v);
    v += dpp_f<0x141, 0xf>(0.f, v);
    v += dpp_f<0x140, 0xf>(0.f, v);
    v += dpp_f<0x142, 0xa>(0.f, v);
    v += dpp_f<0x143, 0xc>(0.f, v);
    return __builtin_bit_cast(float, __builtin_amdgcn_readlane(__builtin_bit_cast(int, v), 63));
}
__device__ __forceinline__ float dpp_swap32(float v) { return __shfl_xor(v, 32); }
__device__ __forceinline__ float sigmoidf_(float x) { return __builtin_amdgcn_rcpf(1.0f + __builtin_amdgcn_exp2f(-x * LOG2E)); }

#define XB_TMO      128
#define XB_XCNT(j)  (256  + 64 * (j))
#define XB_XSUB(j)  (1280 + 64 * (j))
#define XB_XGEN(j)  (2304 + 64 * (j))
#define XB_TOP      3328
#define XB_TOPGEN   3392
#define XCD_BAR_WORDS 3456
#define XB_SPIN_CAP (1u << 20)
__device__ __forceinline__ unsigned xb_ld(unsigned* p)              { return __hip_atomic_load(p, __ATOMIC_RELAXED, __HIP_MEMORY_SCOPE_AGENT); }
__device__ __forceinline__ unsigned xb_add(unsigned* p, unsigned v) { return __hip_atomic_fetch_add(p, v, __ATOMIC_RELAXED, __HIP_MEMORY_SCOPE_AGENT); }
__device__ __forceinline__ unsigned xb_xcc_id() { return (unsigned)__builtin_amdgcn_s_getreg((3 << 11) | 20) & 0xFu; }
#define XB_SPIN(cond, bar) do { unsigned _sp = 0; while (cond) { __builtin_amdgcn_s_sleep(1); \
    if ((++_sp & 255u) == 0u) { if (xb_ld(&(bar)[XB_TMO])) break; if (_sp > XB_SPIN_CAP) { atomicAdd(&(bar)[XB_TMO], 1u); break; } } } } while (0)
struct XcdBarrier { unsigned* bar; unsigned x; volatile LAS unsigned* st; };
__device__ __forceinline__ XcdBarrier xcd_barrier_post(unsigned* bar, volatile LAS unsigned* st) {
    XcdBarrier b; b.bar = bar; b.x = xb_xcc_id(); b.st = st;
    if (threadIdx.x == 0) (void)xb_add(&bar[XB_XCNT(b.x)], 1u);
    return b;
}
__device__ __forceinline__ void xcd_barrier_complete(unsigned* bar, unsigned x, unsigned& nloc, unsigned& nx) {
    const unsigned G = gridDim.x * gridDim.y * gridDim.z;
    unsigned sum, cnt, mine, sp = 0u;
    for (;;) {
        sum = 0u; cnt = 0u; mine = 0u;
#pragma unroll
        for (unsigned j = 0; j < 16; ++j) { const unsigned c = xb_ld(&bar[XB_XCNT(j)]); sum += c; cnt += (c > 0u) ? 1u : 0u; mine = (j == x) ? c : mine; }
        if (sum == G) break;
        __builtin_amdgcn_s_sleep(1);
        if ((++sp & 255u) == 0u) { if (xb_ld(&bar[XB_TMO])) break; if (sp > XB_SPIN_CAP) { atomicAdd(&bar[XB_TMO], 1u); break; } }
    }
    nloc = mine > 0u ? mine : 1u; nx = cnt > 0u ? cnt : 1u;
}
__device__ __forceinline__ void xcd_barrier(const XcdBarrier& b, const int tid) {
    asm volatile("s_waitcnt vmcnt(0)" ::: "memory");
    __syncthreads();
    if (tid == 0) {
        unsigned* bar = b.bar;
        __builtin_amdgcn_s_waitcnt(0);
        unsigned nloc = b.st[0], nx = b.st[1];
        if (nloc == 0u) { xcd_barrier_complete(bar, b.x, nloc, nx); b.st[0] = nloc; b.st[1] = nx; }
        const unsigned old = xb_add(&bar[XB_XSUB(b.x)], 1u);
        const unsigned gen = old / nloc;
        if (old + 1u == (gen + 1u) * nloc) {
            __builtin_amdgcn_fence(__ATOMIC_RELEASE, "agent");
            asm volatile("s_waitcnt vmcnt(0)" ::: "memory");
            const unsigned og = xb_add(&bar[XB_TOP], 1u);
            const unsigned tg = og / nx;
            if (og + 1u == (tg + 1u) * nx) xb_add(&bar[XB_TOPGEN], 1u);
            else XB_SPIN(xb_ld(&bar[XB_TOPGEN]) == tg, bar);
            __builtin_amdgcn_fence(__ATOMIC_ACQUIRE, "agent");
            xb_add(&bar[XB_XGEN(b.x)], 1u);
            asm volatile("s_waitcnt vmcnt(0)" ::: "memory");
        } else {
            XB_SPIN(xb_ld(&bar[XB_XGEN(b.x)]) == gen, bar);
            __builtin_amdgcn_fence(__ATOMIC_ACQUIRE, "agent");
            asm volatile("s_waitcnt vmcnt(0)" ::: "memory");
        }
    }
    __syncthreads();
}

constexpr float FP8_WMUL = 32.0f, FP8_AMUL = 4.0f, FP8_DESCALE = 1.0f / (32.0f * 4.0f);
#if PROBE_PH == -2
#define GMARK(k) do { if (Sched::GATHER && ui == 0 && blockIdx.x == 0 && tid == 0) { volatile LAS unsigned long long* pm_ = (volatile LAS unsigned long long*)(lds + MISC_OFF + 128); \
    if ((k) == PROBE_A) pm_[0] = __builtin_amdgcn_s_memrealtime(); if ((k) == PROBE_B) pm_[1] = __builtin_amdgcn_s_memrealtime(); } } while (0)
#define GMARK1(k) do { if (Sched::GATHER && ui == 1 && blockIdx.x == 0 && tid == 0) { volatile LAS unsigned long long* pm_ = (volatile LAS unsigned long long*)(lds + MISC_OFF + 128); \
    if ((k) == PROBE_A) pm_[0] = __builtin_amdgcn_s_memrealtime(); if ((k) == PROBE_B) pm_[1] = __builtin_amdgcn_s_memrealtime(); } } while (0)
#else
#define GMARK(k) do { } while (0)
#define GMARK1(k) do { } while (0)
#endif
namespace pg8 {
constexpr int BM = 256, BK = 64, HALF = 128, HTB = HALF * BK * 2, STAGE_BYTES = 8 * HTB, KD = 1024  ;
__host__ __device__ __forceinline__ int lds_byte(int r, int c) { const int st = (r >> 4) * 2 + (c >> 5), rr = r & 15, cc = c & 31, ob = rr * 64 + cc * 2; return st * 1024 + (ob ^ (((ob >> 9) & 1) << 5)); }
__host__ __device__ __forceinline__ void stage_rc(int b, int& R, int& C) { const int st = b / 1024, sb = b % 1024, swz = sb ^ (((sb >> 9) & 1) << 5); R = (st >> 1) * 16 + swz / 64; C = (st & 1) * 32 + (swz % 64) / 2; }
__host__ __device__ __forceinline__ int perm32(int rho) { const int n = rho >> 4, i = rho & 15; return 8 * (i >> 2) + 4 * n + (i & 3); }

typedef int v8i_t __attribute__((ext_vector_type(8)));
__device__ __forceinline__ v8i_t cat8(bf16x8 a, bf16x8 b) { typedef int v4i_t __attribute__((ext_vector_type(4))); const v4i_t x = __builtin_bit_cast(v4i_t, a), y = __builtin_bit_cast(v4i_t, b); return __builtin_shufflevector(x, y, 0, 1, 2, 3, 4, 5, 6, 7); }
struct Unit { int pm, pn, e, cnt, idx; };

template <class Epi, class Sched>
__device__ __forceinline__ void gemm_phase(LAS unsigned char* lds, const Sched& S, const Epi& E, const int tid) {
    const int wid = __builtin_amdgcn_readfirstlane(tid >> 6), lane = tid & 63, wr = wid >> 2, wc = wid & 3, fr = lane & 15, fq = lane >> 4;
    constexpr int RP = Sched::FP8 ? 1024 : 2048  , nt = RP / 128;
    int Rr[2], Cc[2];
    unsigned voffA[2][2], voffB[2];
#pragma unroll
    for (int i = 0; i < 2; ++i) { stage_rc(tid * 16 + i * 8192, Rr[i], Cc[i]); const int Rb = Epi::PERM ? ((Rr[i] & ~31) + perm32(Rr[i] & 31)) : Rr[i];
        voffB[i] = (unsigned)(Rb * RP + Cc[i] * 2); }
    constexpr size_t kstep = (size_t)(BK * 2);
    constexpr size_t hstep = (size_t)HALF * RP;
    const unsigned ldsw = (unsigned)wid * 1024u;
    const int aoff = lds_byte(wr * 64 + fr, fq * 8), boff = lds_byte(wc * 32 + fr, fq * 8);
#define PG8_SA(b, h) (((b) * 2 + (h)) * HTB)
#define PG8_SB(b, h) ((4 + (b) * 2 + (h)) * HTB)
#define PG8_STAGE(bufoff, gbase, voff) do { _Pragma("unroll") for (int _i = 0; _i < 2; ++_i) \
        __builtin_amdgcn_global_load_lds((const unsigned*)((const char*)(gbase) + (voff)[_i]), (LAS unsigned*)(lds + (bufoff) + ldsw + _i * 8192), 16, 0, 0); } while (0)
#define PG8_STAGEA1(bufoff, gbase) do { if constexpr (Sched::GATHER) { PG8_STAGE(bufoff, gbase, voffA[1]); } else { PG8_STAGE(bufoff, (gbase) + hstep, voffA[0]); } } while (0)
#define PG8_LDA(dst, b, h) do { _Pragma("unroll") for (int m = 0; m < 4; ++m) _Pragma("unroll") for (int k = 0; k < 2; ++k) dst[m][k] = *(const LAS bf16x8*)(lds + PG8_SA(b, h) + aoff + m * 2048 + k * 1024); } while (0)
#define PG8_LDB(dst, b, h) do { _Pragma("unroll") for (int n = 0; n < 2; ++n) _Pragma("unroll") for (int k = 0; k < 2; ++k) dst[n][k] = *(const LAS bf16x8*)(lds + PG8_SB(b, h) + boff + n * 2048 + k * 1024); } while (0)
#define PG8_MMA(ai, bj, At, Bt) do { __builtin_amdgcn_s_setprio(1); _Pragma("unroll") for (int m = 0; m < 4; ++m) _Pragma("unroll") for (int n = 0; n < 2; ++n) { \
        if constexpr (Sched::FP8) { acc[ai][bj][m][n] = __builtin_amdgcn_mfma_scale_f32_16x16x128_f8f6f4(cat8(Bt[n][0], Bt[n][1]), cat8(At[m][0], At[m][1]), acc[ai][bj][m][n], 0, 0, 0, 0, 0, 0); } \
        else { _Pragma("unroll") for (int k = 0; k < 2; ++k) acc[ai][bj][m][n] = __builtin_amdgcn_mfma_f32_16x16x32_bf16(Bt[n][k], At[m][k], acc[ai][bj][m][n], 0, 0, 0); } } \
        __builtin_amdgcn_s_setprio(0); } while (0)
#define PG8_WAIT_V(n) asm volatile("s_waitcnt vmcnt(" #n ")" ::: "memory")
#define PG8_WAIT_L(n) asm volatile("s_waitcnt lgkmcnt(" #n ")" ::: "memory")
#define PG8_BAR __builtin_amdgcn_s_barrier()
#define PG8_SCHED __builtin_amdgcn_sched_barrier(0)
    Unit cur, nxt; int ui = 0;
    if (!S.next(0, cur)) return;
    S.a_voff(cur, voffA, Rr, Cc);
    f32x4 acc[2][2][4][2];
#pragma unroll
    for (int a = 0; a < 2; ++a)
#pragma unroll
        for (int b = 0; b < 2; ++b)
#pragma unroll
            for (int m = 0; m < 4; ++m)
#pragma unroll
                for (int n = 0; n < 2; ++n) acc[a][b][m][n] = (f32x4){0.f, 0.f, 0.f, 0.f};
    bf16x8 At[4][2], B0[2][2], B1[2][2];
    const char* cA = S.a_ptr(cur); const char* cB = S.b_ptr(cur);
    PG8_STAGE(PG8_SB(0, 0), cB, voffB); PG8_STAGE(PG8_SB(0, 1), cB + hstep, voffB); PG8_STAGE(PG8_SA(0, 0), cA, voffA[0]); PG8_STAGEA1(PG8_SA(0, 1), cA);
    if (wr == 1) PG8_BAR;
    PG8_WAIT_V(2); PG8_BAR;
    PG8_STAGE(PG8_SB(1, 0), cB + kstep, voffB); PG8_STAGE(PG8_SA(1, 0), cA + kstep, voffA[0]); PG8_STAGE(PG8_SB(1, 1), cB + hstep + kstep, voffB);
    PG8_WAIT_V(6); PG8_BAR;
    for (;;) {
        const bool has_next = S.next(ui + 1, nxt);
        const char* nA = has_next ? S.a_ptr(nxt) : cA; const char* nB = has_next ? S.b_ptr(nxt) : cB;
#pragma unroll 1
        for (int t = 0; t < nt; t += 2) {
            const bool last = (t == nt - 2);
            if (last) GMARK(40); if (t == 2) GMARK1(45);
            const char* a1 = cA + (size_t)(t + 1) * kstep;
            const char* a2 = last ? nA : cA + (size_t)(t + 2) * kstep; const char* b2 = last ? nB : cB + (size_t)(t + 2) * kstep;
            const char* a3 = a2 + kstep; const char* b3 = b2 + kstep;
            asm volatile("" : "+s"(a1), "+s"(a2), "+s"(a3), "+s"(b2), "+s"(b3));
            PG8_LDB(B0, 0, 0); PG8_LDB(B1, 0, 1); PG8_SCHED; PG8_LDA(At, 0, 0); PG8_STAGEA1(PG8_SA(1, 1), a1);
            if (Sched::GATHER) { if (last && has_next) S.a_voff(nxt, voffA, Rr, Cc); }
            PG8_WAIT_V(8); PG8_WAIT_L(0); PG8_BAR; PG8_MMA(0, 0, At, B0); PG8_MMA(0, 1, At, B1); PG8_BAR; PG8_SCHED;
            PG8_LDA(At, 0, 1); PG8_STAGE(PG8_SB(0, 0), b2, voffB); PG8_STAGE(PG8_SB(0, 1), b2 + hstep, voffB); PG8_STAGE(PG8_SA(0, 0), a2, voffA[0]);
            PG8_WAIT_V(8); PG8_WAIT_L(0); PG8_BAR; PG8_MMA(1, 0, At, B0); PG8_MMA(1, 1, At, B1); PG8_BAR; PG8_SCHED;
            PG8_LDB(B0, 1, 0); PG8_LDB(B1, 1, 1); PG8_SCHED; PG8_LDA(At, 1, 0); PG8_STAGEA1(PG8_SA(0, 1), a2);
            PG8_WAIT_V(8); PG8_WAIT_L(0); PG8_BAR; PG8_MMA(0, 0, At, B0); PG8_MMA(0, 1, At, B1); PG8_BAR; PG8_SCHED;
            PG8_LDA(At, 1, 1); PG8_STAGE(PG8_SB(1, 0), b3, voffB); PG8_STAGE(PG8_SB(1, 1), b3 + hstep, voffB); PG8_STAGE(PG8_SA(1, 0), a3, voffA[0]);
            PG8_WAIT_V(8); PG8_WAIT_L(0); PG8_BAR; PG8_MMA(1, 0, At, B0); PG8_MMA(1, 1, At, B1); PG8_BAR; PG8_SCHED;
        }
        GMARK(41);
        if (wr == 0) PG8_BAR;
        GMARK(42);
        E(acc, cur, wr, wc, fr, fq);
        GMARK(43);
        if (!has_next) break;
#pragma unroll
        for (int a = 0; a < 2; ++a)
#pragma unroll
            for (int b = 0; b < 2; ++b)
#pragma unroll
                for (int m = 0; m < 4; ++m)
#pragma unroll
                    for (int n = 0; n < 2; ++n) acc[a][b][m][n] = (f32x4){0.f, 0.f, 0.f, 0.f};
        cur = nxt; cA = nA; cB = nB; ++ui;
        if (wr == 1) PG8_BAR;
    }
    PG8_WAIT_V(0);
    PG8_BAR;
#undef PG8_SA
#undef PG8_SB
#undef PG8_STAGE
#undef PG8_STAGEA1
#undef PG8_LDA
#undef PG8_LDB
#undef PG8_MMA
#undef PG8_WAIT_V
#undef PG8_WAIT_L
#undef PG8_BAR
#undef PG8_SCHED
}
}

struct Args { const float* in[33]; float* out; unsigned char* ws; int ph_lo, ph_hi, li, pad; };
enum { I_X = 0, I_C, I_CTX, I_CCTX, I_ADAW, I_ADAB, I_NMG, I_NFG, I_EWIN, I_EBIN, I_ECW, I_ECB, I_ELNG, I_ELNB, I_QNG, I_KNG, I_SINK, I_EWOUT, I_EBOUT,
       I_OWIN, I_OBIN, I_OLNG, I_OLNB, I_OWS, I_OBS, I_OWOUT, I_OBOUT, I_RW, I_RB, I_W1, I_B1, I_W2, I_B2 };

typedef const __attribute__((address_space(4))) unsigned long long* kargp_t;
struct Ctx {
    LAS unsigned char* lds; int tid, lane, wave, G, vcu, gw, NGW, bid; unsigned char* ws; kargp_t kp;
};
__device__ __forceinline__ const float* in_ptr(const Ctx& X, int i) { return (const float*)(const __attribute__((address_space(1))) float*)X.kp[i]; }
#define IN(i) in_ptr(X, (i))
#if PROBE_PH == -2
#define PMARK(k) do { if (X.bid == 0 && X.tid == 0) { volatile LAS unsigned long long* pm_ = (volatile LAS unsigned long long*)(X.lds + MISC_OFF + 128); \
    if ((k) == PROBE_A) pm_[0] = __builtin_amdgcn_s_memrealtime(); if ((k) == PROBE_B) pm_[1] = __builtin_amdgcn_s_memrealtime(); } } while (0)
#else
#define PMARK(k) do { } while (0)
#endif

struct DenseSched {
    static constexpr bool GATHER = false, FP8 = false;
    const bf16* A; const bf16* Bt; int nM, nN, nwg, G, c;
    const bf16* A2; const bf16* Bt2; int nM2;
    __device__ __forceinline__ void init(const bf16* A_, const bf16* Bt_, int M, int N, int G_, int c_) { A = A_; Bt = Bt_; nM = M / 256; nN = N / 256; nwg = nM * nN; G = G_; c = c_; A2 = nullptr; Bt2 = nullptr; nM2 = 0; }
    __device__ __forceinline__ bool next(int i, pg8::Unit& u) const {
        const int L = i * G + c; if (L >= nwg + nM2) return false; u.idx = i;
        if (L >= nwg) { u.pm = L - nwg; u.pn = 0; u.e = 1; u.cnt = 256; return true; }
        int wgid = L; { const int q = nwg / 8, r = nwg % 8, xcd = wgid % 8, off = wgid / 8; wgid = (xcd < r ? xcd * (q + 1) : r * (q + 1) + (xcd - r) * q) + off; }
        const int nig = 8 * nN, gid = wgid / nig, fm = gid * 8, gsz = (nM - fm) < 8 ? (nM - fm) : 8;
        u.pm = fm + ((wgid % nig) % gsz); u.pn = (wgid % nig) / gsz; u.e = 0; u.cnt = 256; return true;
    }
    __device__ __forceinline__ const char* a_ptr(const pg8::Unit& u) const { return (const char*)(u.e ? A2 : A) + (size_t)u.pm * 256 * pg8::KD * 2; }
    __device__ __forceinline__ const char* b_ptr(const pg8::Unit& u) const { return (const char*)(u.e ? Bt2 : Bt) + (size_t)u.pn * 256 * pg8::KD * 2; }
    __device__ __forceinline__ void a_voff(const pg8::Unit&, unsigned (&v)[2][2], const int (&R)[2], const int (&C)[2]) const {
#pragma unroll
        for (int i = 0; i < 2; ++i) { v[0][i] = (unsigned)(R[i] * pg8::KD + C[i]) * 2u; v[1][i] = v[0][i] + (unsigned)(pg8::HALF * pg8::KD * 2); }
    }
};
template <bool GATHER_, int NTILE_N>
struct MoeSchedT {
    static constexpr bool GATHER = GATHER_, FP8 = true; static constexpr int RP = 1024;
    const LAS int* tab; int G, c;
    const unsigned char* A;
    const unsigned char* Bt;
    const int* list;
    const LAS int* meta;
    __device__ __forceinline__ bool next(int i, pg8::Unit& u) const {
        const int L = i * G + c; const int T = tab[0];
        if (L >= T * NTILE_N) return false;
        u.idx = i;
        const int mt = L / NTILE_N; u.pn = L % NTILE_N;
        const int w = __builtin_amdgcn_readfirstlane(tab[1 + mt]); u.e = w >> 16; const int tl = w & 0xffff;
        const int cnt = __builtin_amdgcn_readfirstlane(tab[512 + u.e]), pb = __builtin_amdgcn_readfirstlane(tab[544 + u.e]);
        u.pm = pb + tl * 256; u.cnt = cnt - tl * 256;
        return true;
    }
    __device__ __forceinline__ const char* a_ptr(const pg8::Unit& u) const { return GATHER ? (const char*)A : (const char*)A + (size_t)u.pm * RP; }
    __device__ __forceinline__ const char* b_ptr(const pg8::Unit& u) const { return (const char*)Bt + ((size_t)u.e * NTILE_N + u.pn) * 256 * RP; }
    __device__ __forceinline__ void a_voff(const pg8::Unit& u, unsigned (&v)[2][2], const int (&R)[2], const int (&C)[2]) const {
        if (GATHER) {
#pragma unroll
            for (int h = 0; h < 2; ++h)
#pragma unroll
                for (int i = 0; i < 2; ++i) { const int tok = meta[u.idx * 256 + h * 128 + R[i]]; v[h][i] = (unsigned)(tok * RP + C[i] * 2); }
        } else {
#pragma unroll
            for (int i = 0; i < 2; ++i) { v[0][i] = (unsigned)(R[i] * RP + C[i] * 2); v[1][i] = v[0][i] + (unsigned)(pg8::HALF * RP); }
        }
    }
};
__device__ __forceinline__ void moe_build_table(const Ctx& X, const int* cnt  ) {
    LAS int* tab = (LAS int*)(X.lds + TAB_OFF);
    __syncthreads();
    if (X.tid < 64) {
        const int e = X.lane; int c = 0; if (e < NE) c = __hip_atomic_load(cnt + e * CNT_STRIDE, __ATOMIC_RELAXED, __HIP_MEMORY_SCOPE_AGENT);
        const int mt = (c + 255) >> 8; int incl = mt;
#pragma unroll
        for (int off = 1; off < 32; off <<= 1) { const int v = __shfl_up(incl, off); if (X.lane >= off) incl += v; }
        const int start = incl - mt;
        if (e < NE) { tab[512 + e] = c; tab[544 + e] = start * 256; for (int t = 0; t < mt; ++t) tab[1 + start + t] = (e << 16) | t; if (e == NE - 1) tab[0] = incl; }
    }
    __syncthreads();
}
template <bool WITH_GATE, class Sched>
__device__ __forceinline__ void moe_stage_meta(const Ctx& X, const Sched& S, const int* list, const float* gatew, LAS int* meta, const float* bias, LAS float* lbias) {
    if (X.tid < 256) { pg8::Unit u;
        for (int i = 0; S.next(i, u); ++i) { const int slot0 = u.pm - S.tab[544 + u.e]; const int r = X.tid < u.cnt ? X.tid : u.cnt - 1;
            const int aid = list[(size_t)u.e * NTOK + slot0 + r];
            if (WITH_GATE) { const float g = gatew[aid]; *(LAS u32x2*)(meta + (i * 256 + X.tid) * 2) = (u32x2){(unsigned)aid, __float_as_uint(g)}; }
            else meta[i * 256 + X.tid] = aid >> 2; } }
    else { const int c = X.tid - 256; pg8::Unit u;
        for (int i = 0; S.next(i, u); ++i) lbias[i * 256 + c] = WITH_GATE ? bias[(size_t)u.e * D + u.pn * 256 + c] : bias[(size_t)u.e * 2048 + (c >> 7) * 1024 + u.pn * 128 + (c & 127)]; }
    __syncthreads();
}

__device__ __forceinline__ f32x2 gelu_pk(f32x2 v) {
    const f32x2 av = __builtin_elementwise_abs(v), d = av * 0.2316418882f + 1.0f;
    f32x2 t; t.x = __builtin_amdgcn_rcpf(d.x); t.y = __builtin_amdgcn_rcpf(d.y);
    f32x2 q = t * 0.5307027145f + (-0.7265760135f); q = q * t + 0.7107068705f; q = q * t + (-0.142248368f); q = q * t + 0.127414796f; q = q * t;
    const f32x2 s = (v * v) * (-0.72134752044f);
    f32x2 e; e.x = __builtin_amdgcn_exp2f(s.x); e.y = __builtin_amdgcn_exp2f(s.y);
    const f32x2 m = v * (q * e), r = v - m;
    f32x2 o; o.x = v.x < 0.f ? m.x : r.x; o.y = v.y < 0.f ? m.y : r.y; return o;
}
__device__ __forceinline__ u32x4 pack8(f32x4 a, f32x4 b) { u32x4 w; w.x = pk2(a[0], a[1]); w.y = pk2(a[2], a[3]); w.z = pk2(b[0], b[1]); w.w = pk2(b[2], b[3]); return w; }

struct EpiIn {
    static constexpr bool PERM = true;
    bf16 *GLU, *Q, *Kb, *Vb, *KC, *VC; const float* bias;
    __device__ __forceinline__ void operator()(const f32x4 (&acc)[2][2][4][2], const pg8::Unit& u, int wr, int wc, int fr, int fq) const {
        asm volatile("" : "+v"(fr), "+v"(fq));
        const int row0 = u.pm * 256 + wr * 64 + fr; const int c8 = wc * 32 + 8 * fq;
        if (u.e == 0 && u.pn < 4) {
            const int j0 = u.pn * 128 + c8;
            f32x4 bu[2], bg[2];
#pragma unroll
            for (int n = 0; n < 2; ++n) { bu[n] = *(const f32x4*)(bias + j0 + 4 * n); bg[n] = *(const f32x4*)(bias + 512 + j0 + 4 * n); }
#pragma unroll
            for (int ai = 0; ai < 2; ++ai)
#pragma unroll
                for (int m = 0; m < 4; ++m) { f32x4 o[2];
#pragma unroll
                    for (int n = 0; n < 2; ++n) { const f32x4 uu = acc[ai][0][m][n] + bu[n], gg = acc[ai][1][m][n] + bg[n];
#pragma unroll
                        for (int k = 0; k < 4; ++k) o[n][k] = uu[k] * sigmoidf_(gg[k]); }
                    *(u32x4*)(GLU + (size_t)(row0 + ai * 128 + m * 16) * 512 + j0) = pack8(o[0], o[1]); }
        } else {
#pragma unroll
            for (int bj = 0; bj < 2; ++bj) {
                bf16* dst; int ld, col, bcol;
                if (u.pn >= 6 || u.e) { dst = u.e ? (bj ? VC : KC) : (bj ? Vb : Kb); ld = 128; col = c8; bcol = KV_COL + bj * 128 + c8; }
                else { dst = Q; ld = 512; col = (u.pn - 4) * 256 + bj * 128 + c8; bcol = 1024 + col; }
                f32x4 bv[2];
#pragma unroll
                for (int n = 0; n < 2; ++n) bv[n] = *(const f32x4*)(bias + bcol + 4 * n);
#pragma unroll
                for (int ai = 0; ai < 2; ++ai)
#pragma unroll
                    for (int m = 0; m < 4; ++m) *(u32x4*)(dst + (size_t)(row0 + ai * 128 + m * 16) * ld + col) = pack8(acc[ai][bj][m][0] + bv[0], acc[ai][bj][m][1] + bv[1]);
            }
        }
    }
};
struct EpiRes {
    static constexpr bool PERM = false;
    const float* base; float* out; const float* bias; const float* gate;
    __device__ __forceinline__ void operator()(const f32x4 (&acc)[2][2][4][2], const pg8::Unit& u, int wr, int wc, int fr, int fq) const {
        asm volatile("" : "+v"(fr), "+v"(fq));
        const int col0 = u.pn * 256 + wc * 32 + 4 * fq; const int b = (u.pm * 256) / SEQ;
#pragma unroll
        for (int bj = 0; bj < 2; ++bj) {
            f32x4 bv[2], gv[2];
#pragma unroll
            for (int n = 0; n < 2; ++n) { bv[n] = *(const f32x4*)(bias + col0 + bj * 128 + n * 16); gv[n] = *(const f32x4*)(gate + (size_t)b * MODW + col0 + bj * 128 + n * 16); }
#pragma unroll
            for (int ai = 0; ai < 2; ++ai)
#pragma unroll
                for (int m = 0; m < 4; ++m) { const size_t off = (size_t)(u.pm * 256 + ai * 128 + wr * 64 + m * 16 + fr) * D + col0 + bj * 128;
#pragma unroll
                    for (int n = 0; n < 2; ++n) { const f32x4 bs = *(const f32x4*)(base + off + n * 16); *(f32x4*)(out + off + n * 16) = bs + gv[n] * (acc[ai][bj][m][n] + bv[n]); } }
        }
    }
};
struct EpiGelu {
    static constexpr bool PERM = true;
    bf16 *U, *V; const float* bias; float* vstat;
    __device__ __forceinline__ void operator()(const f32x4 (&acc)[2][2][4][2], const pg8::Unit& u, int wr, int wc, int fr, int fq) const {
        asm volatile("" : "+v"(fr), "+v"(fq));
        const int row0 = u.pm * 256 + wr * 64 + fr; const int colt = u.pn * 256; const bool isv = colt >= 1024; bf16* base = isv ? V : U; const int cb = (colt & 1023) + wc * 32 + 8 * fq, bcol = colt + wc * 32 + 8 * fq;
        f32x4 bv[2][2];
#pragma unroll
        for (int bj = 0; bj < 2; ++bj)
#pragma unroll
            for (int n = 0; n < 2; ++n) bv[bj][n] = *(const f32x4*)(bias + bcol + bj * 128 + 4 * n);
#pragma unroll
        for (int ai = 0; ai < 2; ++ai)
#pragma unroll
            for (int m = 0; m < 4; ++m) { const int row = row0 + ai * 128 + m * 16; bf16* rowp = base + (size_t)row * D + cb; float s = 0.f, s2 = 0.f;
#pragma unroll
                for (int bj = 0; bj < 2; ++bj) { f32x4 v0 = acc[ai][bj][m][0] + bv[bj][0], v1 = acc[ai][bj][m][1] + bv[bj][1];
                    f32x2 a = gelu_pk((f32x2){v0[0], v0[1]}), b = gelu_pk((f32x2){v0[2], v0[3]}), c = gelu_pk((f32x2){v1[0], v1[1]}), d = gelu_pk((f32x2){v1[2], v1[3]});
                    s += (a.x + a.y) + (b.x + b.y) + (c.x + c.y) + (d.x + d.y); s2 += (a.x * a.x + a.y * a.y) + (b.x * b.x + b.y * b.y) + (c.x * c.x + c.y * c.y) + (d.x * d.x + d.y * d.y);
                    *(u32x4*)(rowp + bj * 128) = pack8((f32x4){a.x, a.y, b.x, b.y}, (f32x4){c.x, c.y, d.x, d.y}); }
                if (isv) { s += __shfl_xor(s, 16); s += __shfl_xor(s, 32); s2 += __shfl_xor(s2, 16); s2 += __shfl_xor(s2, 32);
                    if (fq == 0) { unsafeAtomicAdd(vstat + 2 * row, s); unsafeAtomicAdd(vstat + 2 * row + 1, s2); } } }
    }
};
struct EpiSwiglu {
    static constexpr bool PERM = true;
    unsigned char* ACT; const LAS float* lbias;
    __device__ __forceinline__ void operator()(const f32x4 (&acc)[2][2][4][2], const pg8::Unit& u, int wr, int wc, int fr, int fq) const {
        asm volatile("" : "+v"(fr), "+v"(fq));
        const int j0 = u.pn * 128 + wc * 32 + 8 * fq; const LAS float* bb = lbias + u.idx * 256 + wc * 32 + 8 * fq;
        f32x4 bg[2], bu[2];
#pragma unroll
        for (int n = 0; n < 2; ++n) { bg[n] = *(const LAS f32x4*)(bb + 4 * n); bu[n] = *(const LAS f32x4*)(bb + 128 + 4 * n); }
#pragma unroll
        for (int ai = 0; ai < 2; ++ai)
#pragma unroll
            for (int m = 0; m < 4; ++m) { f32x4 o[2];
#pragma unroll
                for (int n = 0; n < 2; ++n) { const f32x4 g4 = acc[ai][0][m][n] * FP8_DESCALE + bg[n], u4 = acc[ai][1][m][n] * FP8_DESCALE + bu[n];
#pragma unroll
                    for (int k = 0; k < 4; ++k) { const float g = fminf(g4[k], 7.0f), up = fminf(fmaxf(u4[k], -7.0f), 7.0f); o[n][k] = (up + 1.0f) * g * sigmoidf_(g * 1.702f); } }
                u32x2 w8; w8.x = pk4_fp8(o[0][0] * FP8_AMUL, o[0][1] * FP8_AMUL, o[0][2] * FP8_AMUL, o[0][3] * FP8_AMUL); w8.y = pk4_fp8(o[1][0] * FP8_AMUL, o[1][1] * FP8_AMUL, o[1][2] * FP8_AMUL, o[1][3] * FP8_AMUL);
                *(u32x2*)(ACT + (size_t)(u.pm + ai * 128 + wr * 64 + m * 16 + fr) * D + j0) = w8; }
    }
};
struct EpiDown {
    static constexpr bool PERM = true;
    bf16* Y; const LAS float* lbias; const LAS int* meta;
    __device__ __forceinline__ void operator()(const f32x4 (&acc)[2][2][4][2], const pg8::Unit& u, int wr, int wc, int fr, int fq) const {
        asm volatile("" : "+v"(fr), "+v"(fq));
        const int c8 = u.pn * 256 + wc * 32 + 8 * fq; const LAS float* bb = lbias + u.idx * 256 + wc * 32 + 8 * fq;
#pragma unroll
        for (int bj = 0; bj < 2; ++bj) {
            f32x4 bv[2];
#pragma unroll
            for (int n = 0; n < 2; ++n) bv[n] = *(const LAS f32x4*)(bb + bj * 128 + 4 * n);
#pragma unroll
            for (int ai = 0; ai < 2; ++ai)
#pragma unroll
                for (int m = 0; m < 4; ++m) { const int r = ai * 128 + wr * 64 + m * 16 + fr; const u32x2 mg = *(const LAS u32x2*)(meta + (u.idx * 256 + r) * 2); const int aid = (int)mg.x; const float g = __uint_as_float(mg.y);
                    const u32x4 w = pack8((acc[ai][bj][m][0] * FP8_DESCALE + bv[0]) * g, (acc[ai][bj][m][1] * FP8_DESCALE + bv[1]) * g);
                    if (r < u.cnt) *(u32x4*)(Y + (size_t)aid * D + c8 + bj * 128) = w; }
        }
    }
};

struct TrItem { const float* src; bf16* dst; int N; int fp8; };
__device__ __forceinline__ void tr_load(const TrItem& t, float (&v)[32], int lane) {
#pragma unroll
    for (int i = 0; i < 32; ++i) v[i] = t.src[(size_t)(2 * i + (lane >> 5)) * t.N + (lane & 31)];
}
__device__ __forceinline__ void tr_store(const TrItem& t, const float (&v)[32], LAS float* scr, int lane) {
#pragma unroll
    for (int i = 0; i < 32; ++i) scr[(2 * i + (lane >> 5)) * 33 + (lane & 31)] = v[i];
    LDS_WAIT();
    if (t.fp8) {
        const int q = lane & 3;
#pragma unroll
        for (int j = 0; j < 2; ++j) { const int n = (lane >> 2) + 16 * j; const LAS float* s = scr + (16 * q) * 33 + n; u32x4 o;
#pragma unroll
            for (int c = 0; c < 4; ++c) o[c] = pk4_fp8(s[(4 * c) * 33] * FP8_WMUL, s[(4 * c + 1) * 33] * FP8_WMUL, s[(4 * c + 2) * 33] * FP8_WMUL, s[(4 * c + 3) * 33] * FP8_WMUL);
            *(u32x4*)((unsigned char*)t.dst + (size_t)n * 1024 + 16 * q) = o; }
    } else {
        const int c = lane & 7;
#pragma unroll
        for (int j = 0; j < 4; ++j) { const int n = (lane >> 3) + 8 * j; const LAS float* s = scr + (8 * c) * 33 + n;
            u32x4 o; o.x = pk2(s[0 * 33], s[1 * 33]); o.y = pk2(s[2 * 33], s[3 * 33]); o.z = pk2(s[4 * 33], s[5 * 33]); o.w = pk2(s[6 * 33], s[7 * 33]);
            *(u32x4*)(t.dst + (size_t)n * 1024 + 8 * c) = o; }
    }
    LDS_WAIT();
}
template <int N, bool PAIR> struct MoeCvt {
    static constexpr int STRIPS = N / 512, ITEMS_PER_MAT = 8 * STRIPS;
    static __device__ __forceinline__ void load(const float* W, int item, f32x4 (&v)[4][2][4], int wave, int lane) {
        const int mat = item / ITEMS_PER_MAT, q = item % ITEMS_PER_MAT, kb = q / STRIPS, sb = q % STRIPS;
        const float* s = W + (size_t)mat * 1024 * N + (size_t)(128 * kb + 16 * wave) * N + 512 * sb + 4 * lane;
#pragma unroll
        for (int g = 0; g < 4; ++g)
#pragma unroll
            for (int hh = 0; hh < 2; ++hh)
#pragma unroll
                for (int r = 0; r < 4; ++r) v[g][hh][r] = __builtin_nontemporal_load((const f32x4*)(s + (size_t)(4 * g + r) * N + 256 * hh));
    }
    static __device__ __forceinline__ void to_lds(const f32x4 (&v)[4][2][4], LAS unsigned* img, int wave, int lane) {
#pragma unroll
        for (int g = 0; g < 4; ++g) { const int kq = 4 * wave + g;
#pragma unroll
            for (int hh = 0; hh < 2; ++hh)
#pragma unroll
                for (int j = 0; j < 4; ++j) { const int rho = 64 * hh + lane + 128 * j;
                    img[rho * 32 + ((kq ^ rho) & 31)] = pk4_fp8(v[g][hh][0][j] * FP8_WMUL, v[g][hh][1][j] * FP8_WMUL, v[g][hh][2][j] * FP8_WMUL, v[g][hh][3][j] * FP8_WMUL); } }
    }
    static __device__ __forceinline__ void store(unsigned char* WT, int item, const LAS unsigned* img, int wave, int lane) {
        const int mat = item / ITEMS_PER_MAT, q = item % ITEMS_PER_MAT, kb = q / STRIPS, sb = q % STRIPS;
        unsigned char* d = WT + (size_t)mat * N * 1024 + 128 * kb;
        const int mi = lane >> 3, c = lane & 7;
#pragma unroll
        for (int st = 0; st < 2; ++st)
#pragma unroll
            for (int j = 0; j < 4; ++j) { const int m = 16 * wave + 8 * st + mi, rho = m + 128 * j, n = 4 * m + j;
                u32x4 o;
#pragma unroll
                for (int i = 0; i < 4; ++i) o[i] = img[rho * 32 + (((4 * c + i) ^ rho) & 31)];
                int drow;
                if (PAIR) { const int h = sb >> 1, rem = 512 * (sb & 1) + n; drow = (rem >> 7) * 256 + h * 128 + (rem & 127); } else drow = 512 * sb + n;
                __builtin_nontemporal_store(o, (u32x4*)(d + (size_t)drow * 1024 + 16 * c)); }
    }
    static __device__ __forceinline__ void run(const float* W, unsigned char* WT, int nitems, int first, int stride, LAS unsigned char* lds, int wave, int lane) {
        f32x4 v[4][2][4]; int it = first, buf = 0;
        if (it < nitems) load(W, it, v, wave, lane);
        while (it < nitems) {
            LAS unsigned* img = (LAS unsigned*)(lds + buf * 65536);
            to_lds(v, img, wave, lane);
            __syncthreads();
            const int nx = it + stride; if (nx < nitems) load(W, nx, v, wave, lane);
            store(WT, it, img, wave, lane);
            it = nx; buf ^= 1;
        }
        __syncthreads();
    }
};

__device__ __forceinline__ int pair_src(int nd, int halfw) { return ((nd & 255) >> 7) * halfw + (nd >> 8) * 128 + (nd & 127); }

__device__ __forceinline__ void phase_prologue(const Args& a, const Ctx& X) {
    PMARK(20);
    {
        LAS float* sc = (LAS float*)X.lds;
        LAS float* red = (LAS float*)(X.lds + 36864);
        float* MOD = (float*)(X.ws + WS_MOD);
        for (int item = X.bid; item < 2 * 96; item += X.G) {
            const int l = item / 96, j0 = (item % 96) * 64;
            for (int idx = X.tid; idx < 9 * 1024; idx += NTHREADS) { const int r = idx >> 10, k = idx & 1023; const float v = r < 8 ? IN(I_C)[r * 1024 + k] : IN(I_CCTX)[k]; sc[idx] = v * sigmoidf_(v); }
            __syncthreads();
            float acc[9];
#pragma unroll
            for (int r = 0; r < 9; ++r) acc[r] = 0.f;
            const float* w = IN(I_ADAW) + (size_t)l * 1024 * MODW + j0 + X.lane;
#pragma unroll 8
            for (int k = X.wave * 128; k < X.wave * 128 + 128; ++k) { const float wv = w[(size_t)k * MODW];
#pragma unroll
                for (int r = 0; r < 9; ++r) acc[r] += sc[r * 1024 + k] * wv; }
#pragma unroll
            for (int r = 0; r < 9; ++r) red[(X.wave * 9 + r) * 64 + X.lane] = acc[r];
            __syncthreads();
            for (int t = X.tid; t < 9 * 64; t += NTHREADS) { const int r = t >> 6, cidx = t & 63; float s = 0.f;
#pragma unroll
                for (int w8 = 0; w8 < 8; ++w8) s += red[(w8 * 9 + r) * 64 + cidx];
                MOD[((size_t)l * 9 + r) * MODW + j0 + cidx] = s + IN(I_ADAB)[l * MODW + j0 + cidx]; }
            __syncthreads();
        }
    }
    PMARK(21);
    LAS float* scr = (LAS float*)(X.lds + X.wave * 16384);
    bf16* WinT = (bf16*)(X.ws + WS_WINT); bf16* WoutT = (bf16*)(X.ws + WS_WOUTT); bf16* GWinT = (bf16*)(X.ws + WS_GWINT); bf16* GWoutT = (bf16*)(X.ws + WS_GWOUTT);
    bf16* W1T = (bf16*)(X.ws + WS_W1T); bf16* W2T = (bf16*)(X.ws + WS_W2T);
    constexpr int I_IN = 16 * (EVEN_IN / 32), I_OUT = 16 * 32, I_GIN = 16 * 64, I_GOUT = 16 * 32;
    constexpr int NITEMS = I_IN + I_OUT + I_GIN + I_GOUT;
    auto item_of = [&](int it) -> TrItem {
        int r = it; TrItem t; t.fp8 = 0;
        if (r < I_IN) { const int kb = r / 56, nd = (r % 56) * 32; const int ns = nd < 1024 ? pair_src(nd, 512) : nd; t.N = EVEN_IN; t.src = IN(I_EWIN) + (size_t)kb * 64 * EVEN_IN + ns; t.dst = WinT + (size_t)nd * 1024 + kb * 64; return t; } r -= I_IN;
        if (r < I_OUT) { const int kb = r >> 5, nd = (r & 31) * 32; t.N = 1024; t.src = IN(I_EWOUT) + (size_t)kb * 64 * 1024 + nd; t.dst = WoutT + (size_t)nd * 1024 + kb * 64; return t; } r -= I_OUT;
        if (r < I_GIN) { const int kb = r >> 6, nd = (r & 63) * 32; t.N = 2048; t.src = IN(I_OWIN) + (size_t)kb * 64 * 2048 + nd; t.dst = GWinT + (size_t)nd * 1024 + kb * 64; return t; } r -= I_GIN;
        { const int kb = r >> 5, nd = (r & 31) * 32; t.N = 1024; t.src = IN(I_OWOUT) + (size_t)kb * 64 * 1024 + nd; t.dst = GWoutT + (size_t)nd * 1024 + kb * 64; return t; }
    };
    {
        float va[32], vb[32]; int it = X.gw;
        TrItem ta, tb; if (it < NITEMS) { ta = item_of(it); tr_load(ta, va, X.lane); }
        while (it < NITEMS) {
            const int it1 = it + X.NGW; if (it1 < NITEMS) { tb = item_of(it1); tr_load(tb, vb, X.lane); }
            tr_store(ta, va, scr, X.lane);
            if (it1 >= NITEMS) break;
            const int it2 = it1 + X.NGW; if (it2 < NITEMS) { ta = item_of(it2); tr_load(ta, va, X.lane); }
            tr_store(tb, vb, scr, X.lane);
            it = it2;
        }
    }
    __syncthreads();
    MoeCvt<2048, true>::run(IN(I_W1), (unsigned char*)W1T, 64 * MoeCvt<2048, true>::ITEMS_PER_MAT, X.vcu, X.G, X.lds, X.wave, X.lane);
    MoeCvt<1024, false>::run(IN(I_W2), (unsigned char*)W2T, 64 * MoeCvt<1024, false>::ITEMS_PER_MAT, X.vcu, X.G, X.lds, X.wave, X.lane);
    PMARK(22);
    { bf16* WsB = (bf16*)(X.ws + WS_WSB); const float* ws = IN(I_OWS);
      for (int i = (X.gw * 64 + X.lane) * 4; i < 8 * 128 * 128; i += X.NGW * 64 * 4) { const f32x4 v = *(const f32x4*)(ws + i); u32x2 o; o.x = pk2(v[0], v[1]); o.y = pk2(v[2], v[3]); *(u32x2*)(WsB + i) = o; } }
}

__device__ __forceinline__ void modulate_row(const float* xrow, const float* g, const float* sh, const float* sc, bf16* orow, int lane, f32x4 (&y)[4]) {
    const f32x4* xr = (const f32x4*)xrow + lane; f32x4 v[4]; float ss = 0.f;
#pragma unroll
    for (int j = 0; j < 4; ++j) { v[j] = xr[64 * j]; ss += (v[j][0] * v[j][0] + v[j][1] * v[j][1]) + (v[j][2] * v[j][2] + v[j][3] * v[j][3]); }
    const float rstd = rsqrtf(wave_sum(ss) * (1.0f / D) + EPS);
#pragma unroll
    for (int j = 0; j < 4; ++j) { const f32x4 gk = ((const f32x4*)g)[lane + 64 * j], sk = ((const f32x4*)sc)[lane + 64 * j], hk = ((const f32x4*)sh)[lane + 64 * j];
        y[j] = v[j] * rstd * gk * (1.0f + sk) + hk;
        u32x2 o; o.x = pk2(y[j][0], y[j][1]); o.y = pk2(y[j][2], y[j][3]); *((u32x2*)orow + lane + 64 * j) = o; }
}
__device__ __forceinline__ void mod0_load(const Ctx& X, int row, f32x4 (&v)[4]) {
    const float* xrow = row < NTOK ? IN(I_X) + (size_t)row * D : IN(I_CTX) + (size_t)(row - NTOK) * D;
#pragma unroll
    for (int j = 0; j < 4; ++j) v[j] = ((const f32x4*)xrow)[X.lane + 64 * j];
}
__device__ __forceinline__ void mod0_finish(const Ctx& X, int row, const f32x4 (&v)[4]) {
    const float* m = (const float*)(X.ws + WS_MOD) + (size_t)(row < NTOK ? row / SEQ : 8) * MODW; const float* g = IN(I_NMG);
    bf16* orow = row < NTOK ? (bf16*)(X.ws + WS_XA) + (size_t)row * D : (bf16*)(X.ws + WS_GM) + (size_t)(row - NTOK) * D;
    f32x4 gk[4], hk[4], sk[4]; float ss = 0.f;
#pragma unroll
    for (int j = 0; j < 4; ++j) { gk[j] = ((const f32x4*)g)[X.lane + 64 * j]; hk[j] = ((const f32x4*)m)[X.lane + 64 * j]; sk[j] = ((const f32x4*)(m + 1024))[X.lane + 64 * j];
        ss += (v[j][0] * v[j][0] + v[j][1] * v[j][1]) + (v[j][2] * v[j][2] + v[j][3] * v[j][3]); }
    const float rstd = rsqrtf(wave_sum(ss) * (1.0f / D) + EPS);
#pragma unroll
    for (int j = 0; j < 4; ++j) { const f32x4 y = v[j] * rstd * gk[j] * (1.0f + sk[j]) + hk[j]; u32x2 o; o.x = pk2(y[0], y[1]); o.y = pk2(y[2], y[3]); *((u32x2*)orow + X.lane + 64 * j) = o; }
}
__device__ __forceinline__ void phase_modulate0(const Args& a, const Ctx& X) {
    constexpr int NR = NTOK + NCTX; f32x4 va[4], vb[4];
    int row = X.gw; if (row < NR) mod0_load(X, row, va);
    while (row < NR) {
        const int r1 = row + X.NGW; if (r1 < NR) mod0_load(X, r1, vb);
        mod0_finish(X, row, va);
        if (r1 >= NR) break;
        const int r2 = r1 + X.NGW; if (r2 < NR) mod0_load(X, r2, va);
        mod0_finish(X, r1, vb);
        row = r2;
    }
}

__device__ __forceinline__ void qk_chunks(bf16* buf, int nchunks, int rowlen, const float* gn, bool rope, float oscale, const Ctx& X, const LAS f32x2* cs) {
    for (int ch = X.gw; ch < nchunks; ch += X.NGW) {
        const int e0 = ch * 512 + 8 * X.lane; const int token = e0 / rowlen; const int d0 = e0 & 63;
        u32x4 raw = *(const u32x4*)(buf + e0); float v[8];
#pragma unroll
        for (int i = 0; i < 4; ++i) { v[2 * i] = bf2f(raw[i] & 0xffffu); v[2 * i + 1] = bf2f(raw[i] >> 16); }
        float ss = 0.f;
#pragma unroll
        for (int i = 0; i < 8; ++i) ss += v[i] * v[i];
        ss += __shfl_xor(ss, 1); ss += __shfl_xor(ss, 2); ss += __shfl_xor(ss, 4);
        const float rstd = rsqrtf(ss * (1.0f / 64.0f) + EPS);
        const f32x4 g0 = *(const f32x4*)(gn + d0), g1 = *(const f32x4*)(gn + d0 + 4);
#pragma unroll
        for (int i = 0; i < 4; ++i) { v[i] = v[i] * rstd * g0[i]; v[4 + i] = v[4 + i] * rstd * g1[i]; }
        if (rope) {
            const int t = token % SEQ; const int dd0 = d0 & 31; const int pos = dd0 < 16 ? (t >> 6) : (t & 63);
            const LAS f32x2* cp = cs + pos * 16 + (dd0 & 15);
#pragma unroll
            for (int i = 0; i < 8; ++i) { const float pv = __shfl_xor(v[i], 4); const f32x2 c = cp[i];
                v[i] = (d0 < 32) ? (v[i] * c.x - pv * c.y) : (v[i] * c.x + pv * c.y); }
        }
        u32x4 o; o.x = pk2(v[0] * oscale, v[1] * oscale); o.y = pk2(v[2] * oscale, v[3] * oscale); o.z = pk2(v[4] * oscale, v[5] * oscale); o.w = pk2(v[6] * oscale, v[7] * oscale);
        *(u32x4*)(buf + e0) = o;
    }
}
__device__ __forceinline__ void phase_conv_qk(const Args& a, const Ctx& X) {
    LAS f32x2* cs = (LAS f32x2*)(X.lds + 65536);
    for (int i = X.tid; i < 1024; i += NTHREADS) { const float inv = exp2f(-(float)(i & 15) * (13.287712379549449f / 16.0f)); float sn, csn; sincosf((float)(i >> 4) * inv, &sn, &csn); cs[i] = (f32x2){csn, sn}; }
    __syncthreads();
    qk_chunks((bf16*)(X.ws + WS_Q), NTOK, 512, IN(I_QNG), true, QSCALE, X, cs);
    qk_chunks((bf16*)(X.ws + WS_K), NTOK / 4, 128, IN(I_KNG), true, 1.0f, X, cs);
    qk_chunks((bf16*)(X.ws + WS_KC), NCTX / 4, 128, IN(I_KNG), false, 1.0f, X, cs);
    const bf16* GLU = (const bf16*)(X.ws + WS_GLU); bf16* MIX = (bf16*)(X.ws + WS_MIX);
    LAS unsigned* tin = (LAS unsigned*)X.lds;
    LAS float* tout = (LAS float*)(X.lds + 65536);
    const int cp = X.tid & 255, th = X.tid >> 8;
    float w0[31], w1[31];
#pragma unroll
    for (int j = 0; j < 31; ++j) { const f32x2 w = *(const f32x2*)(IN(I_ECW) + j * 512 + 2 * cp); w0[j] = w.x; w1[j] = w.y; }
    const f32x2 cb = *(const f32x2*)(IN(I_ECB) + 2 * cp);
    for (int tile = X.bid; tile < NTOK / 32; tile += X.G) {
        const int row0 = tile * 32; const int t0 = row0 % SEQ;
        __syncthreads();
        for (int c = X.tid; c < 62 * 64; c += NTHREADS) { const int lr = c >> 6, cc = c & 63; const int t = t0 - 15 + lr;
            u32x4 v = (u32x4){0u, 0u, 0u, 0u}; if (t >= 0 && t < SEQ) v = *(const u32x4*)(GLU + (size_t)(row0 - 15 + lr) * 512 + cc * 8);
            *(LAS u32x4*)(tin + lr * 256 + cc * 4) = v; }
        __syncthreads();
        float a0[16], a1[16];
#pragma unroll
        for (int o = 0; o < 16; ++o) { a0[o] = cb.x; a1[o] = cb.y; }
#pragma unroll
        for (int rr = 0; rr < 46; ++rr) { const unsigned pv = tin[(16 * th + rr) * 256 + cp]; const float x0 = bf2f(pv & 0xffffu), x1 = bf2f(pv >> 16);
#pragma unroll
            for (int o = 0; o < 16; ++o) { const int j = rr - o; if (j >= 0 && j <= 30) { a0[o] += x0 * w0[j]; a1[o] += x1 * w1[j]; } } }
#pragma unroll
        for (int o = 0; o < 16; ++o) *(LAS f32x2*)(tout + (16 * th + o) * 512 + 2 * cp) = (f32x2){a0[o], a1[o]};
        __syncthreads();
#pragma unroll
        for (int q = 0; q < 4; ++q) { const int tl = X.wave * 4 + q; f32x4 v[2]; float s = 0.f;
#pragma unroll
            for (int j = 0; j < 2; ++j) { v[j] = *(const LAS f32x4*)(tout + tl * 512 + 4 * X.lane + 256 * j); s += (v[j][0] + v[j][1]) + (v[j][2] + v[j][3]); }
            const float mean = wave_sum(s) * (1.0f / 512.0f); float s2 = 0.f;
#pragma unroll
            for (int j = 0; j < 2; ++j) { v[j] = v[j] - mean; s2 += (v[j][0] * v[j][0] + v[j][1] * v[j][1]) + (v[j][2] * v[j][2] + v[j][3] * v[j][3]); }
            const float rstd = rsqrtf(wave_sum(s2) * (1.0f / 512.0f) + EPS);
#pragma unroll
            for (int j = 0; j < 2; ++j) { const f32x4 g = *(const f32x4*)(IN(I_ELNG) + 4 * X.lane + 256 * j), b = *(const f32x4*)(IN(I_ELNB) + 4 * X.lane + 256 * j);
                f32x4 y = v[j] * rstd * g + b;
#pragma unroll
                for (int k = 0; k < 4; ++k) y[k] = y[k] * sigmoidf_(y[k]);
                u32x2 o; o.x = pk2(y[0], y[1]); o.y = pk2(y[2], y[3]); *(u32x2*)(MIX + (size_t)(row0 + tl) * D + 4 * X.lane + 256 * j) = o; } }
    }
}

__device__ __forceinline__ void phase_attention(const Args& a, const Ctx& X) {
    unsigned char* const wsb = X.ws;
    LAS unsigned char* Ks = X.lds;
    LAS unsigned char* Vt = X.lds + 16384;
    const int lane = X.lane, l15 = lane & 15, g4 = lane >> 4;
    for (int unit = X.bid; unit < NB * 2 * 32; unit += X.G) {
        const int b = unit >> 6, kh = (unit >> 5) & 1, qb = unit & 31; const int q0 = qb * 64;
        const int hq = kh * 4 + (X.wave >> 1), tq = (X.wave & 1) * 32;
        bf16x8 Qf[2][2];
#pragma unroll
        for (int qi = 0; qi < 2; ++qi)
#pragma unroll
            for (int s = 0; s < 2; ++s) Qf[qi][s] = *(const bf16x8*)(wsb + (unsigned)(WS_Q + 2u * (unsigned)((b * SEQ + q0 + tq + 16 * qi + l15) * 512 + hq * 64 + 32 * s + 8 * g4)));
        const float sink2 = IN(I_SINK)[hq] * LOG2E;
        float mrun[2], lrun[2]; f32x4 O[2][4];
#pragma unroll
        for (int qi = 0; qi < 2; ++qi) { mrun[qi] = sink2; lrun[qi] = (g4 == 0) ? 1.0f : 0.0f;
#pragma unroll
            for (int db = 0; db < 4; ++db) O[qi][db] = (f32x4){0.f, 0.f, 0.f, 0.f}; }
        const int t_first = (q0 >= 128) ? 0 : (q0 >= 64 ? 1 : 2), t_skip_lo = (q0 + 128 < SEQ) ? 5 : (q0 + 64 < SEQ ? 4 : 3);
        const int key = X.tid >> 3, ch = X.tid & 7;
        auto tile_offs = [&](int t, unsigned& ko, unsigned& vo) {
            if (t < 5) { const unsigned e = (unsigned)((b * SEQ + q0 - 128 + 64 * t) * 128 + kh * 64) * 2u; ko = (unsigned)WS_K + e; vo = (unsigned)WS_V + e; }
            else { const unsigned e = (unsigned)((b * CTXL + (t - 5) * 64) * 128 + kh * 64) * 2u; ko = (unsigned)WS_KC + e; vo = (unsigned)WS_VC + e; } };
        const unsigned lane_off = (unsigned)(key * 128 + ch * 8) * 2u;
        auto lds_put = [&](int buf, const u32x4& kv, const u32x4& vv) {
            LAS unsigned char* Kd = Ks + buf * 32768; LAS unsigned char* Vd = Vt + buf * 32768;
            *(LAS u32x4*)(Kd + key * 144 + ch * 16) = kv;
#pragma unroll
            for (int i = 0; i < 4; ++i) { *(LAS unsigned short*)(Vd + (8 * ch + 2 * i) * 136 + key * 2) = (unsigned short)(vv[i] & 0xffffu); *(LAS unsigned short*)(Vd + (8 * ch + 2 * i + 1) * 136 + key * 2) = (unsigned short)(vv[i] >> 16); } };
        u32x4 kreg, vreg;
        { unsigned ko, vo; tile_offs(t_first, ko, vo); kreg = *(const u32x4*)(wsb + (ko + lane_off)); vreg = *(const u32x4*)(wsb + (vo + lane_off)); }
        __syncthreads();
        lds_put(0, kreg, vreg);
        int bufi = 0;
        for (int t = t_first; t < 9; ++t) {
            if (t >= t_skip_lo && t < 5) continue;
            int tn = t + 1; if (tn >= t_skip_lo && tn < 5) tn = 5;
            if (tn < 9) { unsigned ko, vo; tile_offs(tn, ko, vo); kreg = *(const u32x4*)(wsb + (ko + lane_off)); vreg = *(const u32x4*)(wsb + (vo + lane_off)); }
            const int mode = (t == 0) ? 1 : (t == 4 ? 2 : 0);
            __syncthreads();
            const LAS unsigned char* Kc = Ks + bufi * 32768; const LAS unsigned char* Vc = Vt + bufi * 32768;
            bf16x8 kf[4][2];
#pragma unroll
            for (int kb = 0; kb < 4; ++kb)
#pragma unroll
                for (int s = 0; s < 2; ++s) kf[kb][s] = *(const LAS bf16x8*)(Kc + (16 * kb + l15) * 144 + (32 * s + 8 * g4) * 2);
            bf16x8 vf[4][2];
#pragma unroll
            for (int db = 0; db < 4; ++db)
#pragma unroll
                for (int ks2 = 0; ks2 < 2; ++ks2) { const LAS unsigned char* p = Vc + (16 * db + l15) * 136 + (32 * ks2 + 4 * g4) * 2;
                    const u32x2 lo = *(const LAS u32x2*)p, hi = *(const LAS u32x2*)(p + 32);
                    u32x4 w; w.x = lo.x; w.y = lo.y; w.z = hi.x; w.w = hi.y; vf[db][ks2] = __builtin_bit_cast(bf16x8, w); }
#pragma unroll
            for (int qi = 0; qi < 2; ++qi) {
                f32x4 st[4];
#pragma unroll
                for (int kb = 0; kb < 4; ++kb) { st[kb] = (f32x4){0.f, 0.f, 0.f, 0.f};
#pragma unroll
                    for (int s = 0; s < 2; ++s) st[kb] = __builtin_amdgcn_mfma_f32_16x16x32_bf16(kf[kb][s], Qf[qi][s], st[kb], 0, 0, 0); }
                if (mode) { int qloc = tq + 16 * qi + l15; asm volatile("" : "+v"(qloc));
#pragma unroll
                    for (int kb = 0; kb < 4; ++kb)
#pragma unroll
                        for (int r = 0; r < 4; ++r) { const int kk = 16 * kb + 4 * g4 + r; const bool keep = (mode == 1) ? (kk >= qloc) : (kk <= qloc); if (!keep) st[kb][r] = -1e30f; } }
                float mx = st[0][0];
#pragma unroll
                for (int kb = 0; kb < 4; ++kb)
#pragma unroll
                    for (int r = 0; r < 4; ++r) mx = fmaxf(mx, st[kb][r]);
                mx = fmaxf(mx, __shfl_xor(mx, 16)); mx = fmaxf(mx, __shfl_xor(mx, 32));
                const float mnew = fmaxf(mrun[qi], mx); const float alpha = __builtin_amdgcn_exp2f(mrun[qi] - mnew); mrun[qi] = mnew;
                float ps = 0.f;
#pragma unroll
                for (int kb = 0; kb < 4; ++kb)
#pragma unroll
                    for (int r = 0; r < 4; ++r) { st[kb][r] = __builtin_amdgcn_exp2f(st[kb][r] - mnew); ps += st[kb][r]; }
                lrun[qi] = lrun[qi] * alpha + ps;
#pragma unroll
                for (int db = 0; db < 4; ++db) O[qi][db] = O[qi][db] * alpha;
#pragma unroll
                for (int ks2 = 0; ks2 < 2; ++ks2) { u32x4 w; w.x = pk2(st[2 * ks2][0], st[2 * ks2][1]); w.y = pk2(st[2 * ks2][2], st[2 * ks2][3]); w.z = pk2(st[2 * ks2 + 1][0], st[2 * ks2 + 1][1]); w.w = pk2(st[2 * ks2 + 1][2], st[2 * ks2 + 1][3]);
                    const bf16x8 pf = __builtin_bit_cast(bf16x8, w);
#pragma unroll
                    for (int db = 0; db < 4; ++db) O[qi][db] = __builtin_amdgcn_mfma_f32_16x16x32_bf16(vf[db][ks2], pf, O[qi][db], 0, 0, 0); }
            }
            if (tn < 9) lds_put(bufi ^ 1, kreg, vreg);
            bufi ^= 1;
        }
#pragma unroll
        for (int qi = 0; qi < 2; ++qi) { float l = lrun[qi]; l += __shfl_xor(l, 16); l += __shfl_xor(l, 32); const float inv = 1.0f / l;
            bf16* orow = (bf16*)(wsb + (unsigned)(WS_MIX + 2u * (unsigned)((b * SEQ + q0 + tq + 16 * qi + l15) * D + 512 + hq * 64 + 4 * g4)));
#pragma unroll
            for (int db = 0; db < 4; ++db) { u32x2 o; o.x = pk2(O[qi][db][0] * inv, O[qi][db][1] * inv); o.y = pk2(O[qi][db][2] * inv, O[qi][db][3] * inv); *(u32x2*)(orow + 16 * db) = o; } }
    }
}

__device__ __forceinline__ void phase_router(const Args& a, const Ctx& X, int layer) {
    const float* __restrict__ H = (const float*)(X.ws + WS_H); unsigned char* XA8 = (unsigned char*)(X.ws + WS_XA8);
    const float* MODl = (const float*)(X.ws + WS_MOD) + (size_t)layer * 9 * MODW; const float* gn = IN(I_NFG) + layer * D;
    const float* rw = IN(I_RW) + (size_t)layer * D * NE; const float* rb = IN(I_RB) + layer * NE;
    int* cntg = (int*)(X.ws + WS_CTL) + CW_CNT + layer * NE * CNT_STRIDE; int* list = (int*)(X.ws + WS_LIST); float* gatew = (float*)(X.ws + WS_GATE);
    LAS float* ybuf = (LAS float*)X.lds;
    LAS float* part = (LAS float*)(X.lds + 65536);
    LAS int* sel = (LAS int*)(X.lds + 65536 + 16384);
    LAS int* lcnt = (LAS int*)(X.lds + 65536 + 16384 + 1024);
    LAS float* lgs = (LAS float*)(X.lds + 65536 + 16384 + 2048);
    LAS float* tvs = lgs + 512;
    LAS float* exs = lgs + 528;
    PMARK(0);
    const int e = X.lane & 31, hf = X.lane >> 5;
    float wreg[64];
#pragma unroll
    for (int i = 0; i < 64; ++i) wreg[i] = rw[(size_t)(128 * X.wave + 64 * hf + i) * NE + e];
    const float rbe = rb[e];
    for (int blk = X.bid; blk < NTOK / 64; blk += X.G) {
        const int rowbase = blk * 64; const float* m = MODl + (size_t)(rowbase / SEQ) * MODW;
        f32x4 gk[4], hk[4], xv[2][4];
#pragma unroll
        for (int j = 0; j < 4; ++j) { gk[j] = ((const f32x4*)gn)[X.lane + 64 * j]; hk[j] = ((const f32x4*)(m + 3 * 1024))[X.lane + 64 * j]; const f32x4 s_ = ((const f32x4*)(m + 4 * 1024))[X.lane + 64 * j]; gk[j] = gk[j] * (1.0f + s_); }
#pragma unroll
        for (int i = 0; i < 2; ++i)
#pragma unroll
            for (int j = 0; j < 4; ++j) xv[i][j] = ((const f32x4*)(H + (size_t)(rowbase + 2 * X.wave + i) * D))[X.lane + 64 * j];
        __syncthreads();
        if (X.tid < 64) lcnt[X.tid] = 0;
        PMARK(1);
#pragma unroll 1
        for (int bt = 0; bt < 4; ++bt) {
#pragma unroll
            for (int i = 0; i < 2; ++i) { const int rl = 2 * X.wave + i, row = rowbase + 16 * bt + rl; float ss = 0.f;
#pragma unroll
                for (int j = 0; j < 4; ++j) ss += (xv[i][j][0] * xv[i][j][0] + xv[i][j][1] * xv[i][j][1]) + (xv[i][j][2] * xv[i][j][2] + xv[i][j][3] * xv[i][j][3]);
                const float rstd = rsqrtf(wave_sum(ss) * (1.0f / D) + EPS);
#pragma unroll
                for (int j = 0; j < 4; ++j) { const f32x4 y = xv[i][j] * rstd * gk[j] + hk[j];
                    *((unsigned*)(XA8 + (size_t)row * D) + X.lane + 64 * j) = pk4_fp8(y[0] * FP8_AMUL, y[1] * FP8_AMUL, y[2] * FP8_AMUL, y[3] * FP8_AMUL);
                    *(LAS f32x4*)(ybuf + rl * 1024 + 4 * X.lane + 256 * j) = y; } }
            if (bt < 3) {
#pragma unroll
                for (int i = 0; i < 2; ++i)
#pragma unroll
                    for (int j = 0; j < 4; ++j) xv[i][j] = ((const f32x4*)(H + (size_t)(rowbase + 16 * (bt + 1) + 2 * X.wave + i) * D))[X.lane + 64 * j];
            }
            __syncthreads();
#pragma unroll 2
            for (int r = 0; r < 16; ++r) { float acc[4] = {0.f, 0.f, 0.f, 0.f}; const LAS float* yp = ybuf + r * 1024 + 128 * X.wave + 64 * hf;
#pragma unroll
                for (int i4 = 0; i4 < 16; ++i4) { const f32x4 yv = *(const LAS f32x4*)(yp + 4 * i4);
                    acc[i4 & 3] += yv[0] * wreg[4 * i4] + yv[1] * wreg[4 * i4 + 1] + yv[2] * wreg[4 * i4 + 2] + yv[3] * wreg[4 * i4 + 3]; }
                const float t0 = (acc[0] + acc[1]) + (acc[2] + acc[3]); const float t = t0 + dpp_swap32(t0);
                if (hf == 0) part[(r * 8 + X.wave) * 32 + e] = t; }
            __syncthreads();
            { const int r = 2 * X.wave + hf, rl = 16 * bt + r;
              float v = rbe;
#pragma unroll
              for (int w8 = 0; w8 < 8; ++w8) v += part[(r * 8 + w8) * 32 + e];
              lgs[r * 32 + e] = v; LDS_WAIT();
              int ez = e; asm volatile("" : "+v"(ez));
              int rank = 0;
#pragma unroll
              for (int j4 = 0; j4 < 8; ++j4) { const f32x4 o = *(const LAS f32x4*)(lgs + r * 32 + 4 * j4);
#pragma unroll
                  for (int c = 0; c < 4; ++c) rank += (o[c] > v || (o[c] == v && (4 * j4 + c) < ez)) ? 1 : 0; }
              if (rank == 0) tvs[r] = v;
              LDS_WAIT();
              const float ex = __expf(v - tvs[r]);
              if (rank < 4) exs[r * 4 + rank] = ex;
              LDS_WAIT();
              const f32x4 e4 = *(const LAS f32x4*)(exs + r * 4); const float inv = 1.0f / ((e4[0] + e4[1]) + (e4[2] + e4[3]));
              if (rank < 4) { const int slot = atomicAdd((int*)&lcnt[e], 1); sel[rl * 4 + rank] = (e << 16) | slot; gatew[(size_t)(rowbase + rl) * 4 + rank] = ex * inv; } }
        }
        __syncthreads();
        PMARK(2);
        if (X.tid < 32) lcnt[32 + X.tid] = atomicAdd(cntg + X.tid * CNT_STRIDE, lcnt[X.tid]);
        __syncthreads();
        if (X.tid < 256) { const int w = sel[X.tid]; const int ee = w >> 16, rank = w & 0xffff; list[(size_t)ee * NTOK + lcnt[32 + ee] + rank] = rowbase * 4 + X.tid; }
    }
    PMARK(3);
}

__device__ __forceinline__ void phase_combine(const Args& a, const Ctx& X, int layer) {
    float* H = (float*)(X.ws + WS_H); const bf16* __restrict__ Y = (const bf16*)(X.ws + WS_Y); bf16* XA = (bf16*)(X.ws + WS_XA);
    const float* __restrict__ MODl = (const float*)(X.ws + WS_MOD) + (size_t)layer * 9 * MODW;
    float* outp = (float*)(__attribute__((address_space(1))) float*)X.kp[33];
    for (int row = X.gw; row < NTOK; row += X.NGW) {
        const float* gt = MODl + (size_t)(row / SEQ) * MODW + 5 * 1024; f32x4 h[2][2], g[2][2]; u32x4 yw[2][4];
#pragma unroll
        for (int j = 0; j < 2; ++j) { const int c0 = 8 * X.lane + 512 * j;
#pragma unroll
            for (int q = 0; q < 2; ++q) { h[j][q] = *(const f32x4*)(H + (size_t)row * D + c0 + 4 * q); g[j][q] = *(const f32x4*)(gt + c0 + 4 * q); }
#pragma unroll
            for (int k = 0; k < 4; ++k) yw[j][k] = *(const u32x4*)(Y + ((size_t)row * 4 + k) * D + c0); }
        float ss = 0.f;
#pragma unroll
        for (int j = 0; j < 2; ++j) { f32x4 s0 = (f32x4){0.f, 0.f, 0.f, 0.f}, s1 = s0;
#pragma unroll
            for (int k = 0; k < 4; ++k) { const u32x4 w = yw[j][k]; s0 += (f32x4){bf2f(w.x & 0xffffu), bf2f(w.x >> 16), bf2f(w.y & 0xffffu), bf2f(w.y >> 16)}; s1 += (f32x4){bf2f(w.z & 0xffffu), bf2f(w.z >> 16), bf2f(w.w & 0xffffu), bf2f(w.w >> 16)}; }
            h[j][0] = h[j][0] + g[j][0] * s0; h[j][1] = h[j][1] + g[j][1] * s1;
#pragma unroll
            for (int q = 0; q < 2; ++q) ss += (h[j][q][0] * h[j][q][0] + h[j][q][1] * h[j][q][1]) + (h[j][q][2] * h[j][q][2] + h[j][q][3] * h[j][q][3]); }
        if (layer == 1) {
#pragma unroll
            for (int j = 0; j < 2; ++j)
#pragma unroll
                for (int q = 0; q < 2; ++q) *(f32x4*)(outp + (size_t)row * D + 8 * X.lane + 512 * j + 4 * q) = h[j][q];
        } else {
            const float* m1 = (const float*)(X.ws + WS_MOD) + (size_t)9 * MODW + (size_t)(row / SEQ) * MODW; const float* gn = IN(I_NMG) + D;
            f32x4 gk[2][2], hk[2][2], sk[2][2];
#pragma unroll
            for (int j = 0; j < 2; ++j)
#pragma unroll
                for (int q = 0; q < 2; ++q) { const int c0 = 8 * X.lane + 512 * j + 4 * q; gk[j][q] = *(const f32x4*)(gn + c0); hk[j][q] = *(const f32x4*)(m1 + c0); sk[j][q] = *(const f32x4*)(m1 + 1024 + c0); }
            const float rstd = rsqrtf(wave_sum(ss) * (1.0f / D) + EPS);
#pragma unroll
            for (int j = 0; j < 2; ++j) { const int c0 = 8 * X.lane + 512 * j;
                const f32x4 y0 = h[j][0] * rstd * gk[j][0] * (1.0f + sk[j][0]) + hk[j][0], y1 = h[j][1] * rstd * gk[j][1] * (1.0f + sk[j][1]) + hk[j][1];
                *(f32x4*)(H + (size_t)row * D + c0) = h[j][0]; *(f32x4*)(H + (size_t)row * D + c0 + 4) = h[j][1];
                *(u32x4*)(XA + (size_t)row * D + c0) = pack8(y0, y1); }
        }
    }
}

__device__ __forceinline__ void phase_spatial(const Args& a, const Ctx& X) {
    const bf16* U = (const bf16*)(X.ws + WS_U); const bf16* VB = (const bf16*)(X.ws + WS_VB); bf16* SG = (bf16*)(X.ws + WS_MIX); const bf16* WsB = (const bf16*)(X.ws + WS_WSB); const float* vstat = (const float*)(X.ws + WS_CTL) + CW_VSTAT;
    LAS float* stat = (LAS float*)X.lds;
    LAS unsigned char* Vt = X.lds + 4096;
    const int lane = X.lane, l15 = lane & 15, g4 = lane >> 4;
    for (int item = X.bid; item < 128 * 8; item += X.G) {
        const int chunk = item >> 3, g = item & 7; const int row0 = chunk * 128;
        __syncthreads();
        if (X.tid < 128) { const f32x2 sv = *(const f32x2*)(vstat + 2 * (row0 + X.tid)); const float mean = sv.x * (1.0f / D); const float var = fmaxf(sv.y * (1.0f / D) - mean * mean, 0.f);
            stat[2 * X.tid] = mean; stat[2 * X.tid + 1] = rsqrtf(var + EPS); }
        __syncthreads();
#pragma unroll
        for (int c = X.tid; c < 128 * 16; c += NTHREADS) { const int q = c >> 4, cc = c & 15; const u32x4 w = *(const u32x4*)(VB + (size_t)(row0 + q) * D + g * 128 + cc * 8);
            const float mean = stat[2 * q], rstd = stat[2 * q + 1]; const float* lg_ = IN(I_OLNG) + g * 128 + cc * 8; const float* lb_ = IN(I_OLNB) + g * 128 + cc * 8;
#pragma unroll
            for (int k = 0; k < 4; ++k) { const float y0 = (bf2f(w[k] & 0xffffu) - mean) * rstd * lg_[2 * k] + lb_[2 * k], y1 = (bf2f(w[k] >> 16) - mean) * rstd * lg_[2 * k + 1] + lb_[2 * k + 1];
                const unsigned pk = pk2(y0, y1);
                *(LAS unsigned short*)(Vt + ((2 * k) * 17 + cc) * 272 + q * 2) = (unsigned short)(pk & 0xffffu); *(LAS unsigned short*)(Vt + ((2 * k + 1) * 17 + cc) * 272 + q * 2) = (unsigned short)(pk >> 16); } }
        __syncthreads();
        f32x4 acc[8];
#pragma unroll
        for (int pb = 0; pb < 8; ++pb) acc[pb] = (f32x4){0.f, 0.f, 0.f, 0.f};
#pragma unroll
        for (int s = 0; s < 4; ++s) { const bf16x8 af = *(const LAS bf16x8*)(Vt + ((l15 & 7) * 17 + 2 * X.wave + (l15 >> 3)) * 272 + (32 * s + 8 * g4) * 2);
#pragma unroll
            for (int pb = 0; pb < 8; ++pb) { const bf16x8 bfr = *(const bf16x8*)(WsB + ((size_t)g * 128 + 16 * pb + l15) * 128 + 32 * s + 8 * g4); acc[pb] = __builtin_amdgcn_mfma_f32_16x16x32_bf16(af, bfr, acc[pb], 0, 0, 0); } }
#pragma unroll
        for (int pb = 0; pb < 8; ++pb) { const int p = 16 * pb + l15; const float bs = IN(I_OBS)[g * 128 + p]; const size_t off = (size_t)(row0 + p) * D + g * 128 + 16 * X.wave + 4 * g4;
            const u32x2 uw = *(const u32x2*)(U + off);
            u32x2 o; o.x = pk2(bf2f(uw.x & 0xffffu) * (acc[pb][0] + bs), bf2f(uw.x >> 16) * (acc[pb][1] + bs)); o.y = pk2(bf2f(uw.y & 0xffffu) * (acc[pb][2] + bs), bf2f(uw.y >> 16) * (acc[pb][3] + bs));
            *(u32x2*)(SG + off) = o; }
    }
}

enum { PH_PRO = 0, PH_MOD0, PH_GIN, PH_CONV, PH_ATT, PH_GOUT, PH_RT0, PH_M1_0, PH_M2_0, PH_CMB0, PH_GMI, PH_SPA, PH_GMO, PH_RT1, PH_M1_1, PH_M2_1, PH_CMB1, NPHASE };

__global__ void __launch_bounds__(NTHREADS, 2) mega(Args a) {
    extern __shared__ __attribute__((aligned(16))) unsigned char lds_raw[];
    Ctx X; X.lds = (LAS unsigned char*)lds_raw;
    const int wave0 = __builtin_amdgcn_readfirstlane((int)threadIdx.x >> 6);
    const int G0 = gridDim.x, bid0 = blockIdx.x; const int vcu0 = (G0 % 8 == 0) ? (bid0 % 8) * (G0 / 8) + bid0 / 8 : bid0;
    X.wave = wave0;
    volatile LAS unsigned* MISC = (volatile LAS unsigned*)(X.lds + MISC_OFF);
    if (threadIdx.x < 64) MISC[threadIdx.x] = 0u;
    __syncthreads();
    XcdBarrier bar = xcd_barrier_post((unsigned*)(a.ws + WS_CTL) + CW_BAR + a.li * XCD_BAR_WORDS, MISC + 8);
    const int ph_lo = a.ph_lo, ph_hi = a.ph_hi;
#if PROBE_PH >= 0
#define PROBE_STAMP(p) do { if ((p) == PROBE_PH) pr_t0 = __builtin_amdgcn_s_memrealtime(); if ((p) == PROBE_END) pr_t1 = __builtin_amdgcn_s_memrealtime(); } while (0)
#else
#define PROBE_STAMP(p) do { } while (0)
#endif
#define PH_ENTER() int z; asm volatile("s_mov_b32 %0, 0" : "=s"(z)); \
        X.lane = (int)__builtin_amdgcn_mbcnt_hi(~0u, __builtin_amdgcn_mbcnt_lo(~0u, (unsigned)z)); X.tid = wave0 * 64 + X.lane; \
        X.G = G0 + z; X.vcu = vcu0 + z; X.bid = bid0 + z; X.NGW = X.G * NWAVES; X.gw = X.vcu * NWAVES + wave0; \
        { kargp_t kp = (kargp_t)__builtin_amdgcn_kernarg_segment_ptr(); asm volatile("" : "+s"(kp)); X.kp = kp; } \
        unsigned char* ws = (unsigned char*)(__attribute__((address_space(1))) unsigned char*)X.kp[34] + z; X.ws = ws;
#if PROBE_PH >= 0
    unsigned long long pr_t0 = 0, pr_t1 = 0;
#endif
#define PH_RUN(PHK, ...) if (ph_lo <= (PHK) && (PHK) < ph_hi) { const int ph = (PHK); \
        if (ph != ph_lo) { const int l0 = (int)__builtin_amdgcn_mbcnt_hi(~0u, __builtin_amdgcn_mbcnt_lo(~0u, 0u)); xcd_barrier(bar, wave0 * 64 + l0); } \
        PROBE_STAMP(ph); __VA_ARGS__ }
    PH_RUN(PH_PRO, { PH_ENTER(); phase_prologue(a, X); })
    PH_RUN(PH_MOD0, { PH_ENTER(); phase_modulate0(a, X); })
    PH_RUN(PH_GIN, { PH_ENTER(); DenseSched S; S.init((const bf16*)(ws + WS_XA), (const bf16*)(ws + WS_WINT), NTOK, EVEN_IN, X.G, X.bid);
            S.A2 = (const bf16*)(ws + WS_GM); S.Bt2 = (const bf16*)(ws + WS_WINT) + (size_t)KV_COL * D; S.nM2 = NCTX / 256;
            EpiIn E{(bf16*)(ws + WS_GLU), (bf16*)(ws + WS_Q), (bf16*)(ws + WS_K), (bf16*)(ws + WS_V), (bf16*)(ws + WS_KC), (bf16*)(ws + WS_VC), IN(I_EBIN)};
            pg8::gemm_phase<EpiIn, DenseSched>(X.lds, S, E, X.tid); })
    PH_RUN(PH_CONV, { PH_ENTER(); phase_conv_qk(a, X); })
    PH_RUN(PH_ATT, { PH_ENTER(); phase_attention(a, X); })
    PH_RUN(PH_GOUT, { PH_ENTER(); DenseSched S; S.init((const bf16*)(ws + WS_MIX), (const bf16*)(ws + WS_WOUTT), NTOK, D, X.G, X.bid);
            EpiRes E{IN(I_X), (float*)(ws + WS_H), IN(I_EBOUT), (const float*)(ws + WS_MOD) + 2 * 1024};
            pg8::gemm_phase<EpiRes, DenseSched>(X.lds, S, E, X.tid); })
    PH_RUN(PH_RT0, { PH_ENTER(); phase_router(a, X, 0); })
    PH_RUN(PH_M1_0, { PH_ENTER(); const int l = (ph == PH_M1_1); moe_build_table(X, (const int*)(ws + WS_CTL) + CW_CNT + l * NE * CNT_STRIDE);
            MoeSchedT<true, 8> S; S.tab = (const LAS int*)(X.lds + TAB_OFF); S.G = X.G; S.c = X.vcu; S.A = (const unsigned char*)(ws + WS_XA8); S.Bt = (const unsigned char*)(ws + WS_W1T) + (size_t)l * NE * 2048 * 1024; S.list = (const int*)(ws + WS_LIST); S.meta = (const LAS int*)(X.lds + META_OFF);
            moe_stage_meta<false>(X, S, S.list, (const float*)nullptr, (LAS int*)(X.lds + META_OFF), IN(I_B1) + (size_t)l * NE * 2048, (LAS float*)(X.lds + BIAS_OFF));
            EpiSwiglu E{(unsigned char*)(ws + WS_ACT), (const LAS float*)(X.lds + BIAS_OFF)};
            pg8::gemm_phase<EpiSwiglu, MoeSchedT<true, 8>>(X.lds, S, E, X.tid); })
    PH_RUN(PH_M2_0, { PH_ENTER(); const int l = (ph == PH_M2_1); moe_build_table(X, (const int*)(ws + WS_CTL) + CW_CNT + l * NE * CNT_STRIDE);
            MoeSchedT<false, 4> S; S.tab = (const LAS int*)(X.lds + TAB_OFF); S.G = X.G; S.c = X.vcu; S.A = (const unsigned char*)(ws + WS_ACT); S.Bt = (const unsigned char*)(ws + WS_W2T) + (size_t)l * NE * 1024 * 1024; S.list = (const int*)(ws + WS_LIST); S.meta = (const LAS int*)(X.lds + META_OFF);
            moe_stage_meta<true>(X, S, S.list, (const float*)(ws + WS_GATE), (LAS int*)(X.lds + META_OFF), IN(I_B2) + (size_t)l * NE * D, (LAS float*)(X.lds + BIAS_OFF));
            EpiDown E{(bf16*)(ws + WS_Y), (const LAS float*)(X.lds + BIAS_OFF), (const LAS int*)(X.lds + META_OFF)};
            pg8::gemm_phase<EpiDown, MoeSchedT<false, 4>>(X.lds, S, E, X.tid); })
    PH_RUN(PH_CMB0, { PH_ENTER(); phase_combine(a, X, 0); })
    PH_RUN(PH_GMI, { PH_ENTER(); DenseSched S; S.init((const bf16*)(ws + WS_XA), (const bf16*)(ws + WS_GWINT), NTOK, 2048, X.G, X.bid);
            EpiGelu E{(bf16*)(ws + WS_U), (bf16*)(ws + WS_VB), IN(I_OBIN), (float*)(ws + WS_CTL) + CW_VSTAT};
            pg8::gemm_phase<EpiGelu, DenseSched>(X.lds, S, E, X.tid); })
    PH_RUN(PH_SPA, { PH_ENTER(); phase_spatial(a, X); })
    PH_RUN(PH_GMO, { PH_ENTER(); DenseSched S; S.init((const bf16*)(ws + WS_MIX), (const bf16*)(ws + WS_GWOUTT), NTOK, D, X.G, X.bid);
            EpiRes E{(const float*)(ws + WS_H), (float*)(ws + WS_H), IN(I_OBOUT), (const float*)(ws + WS_MOD) + (size_t)9 * MODW + 2 * 1024};
            pg8::gemm_phase<EpiRes, DenseSched>(X.lds, S, E, X.tid); })
    PH_RUN(PH_RT1, { PH_ENTER(); phase_router(a, X, 1); })
    PH_RUN(PH_M1_1, { PH_ENTER(); PMARK(50); const int l = (ph == PH_M1_1); moe_build_table(X, (const int*)(ws + WS_CTL) + CW_CNT + l * NE * CNT_STRIDE);
            MoeSchedT<true, 8> S; S.tab = (const LAS int*)(X.lds + TAB_OFF); S.G = X.G; S.c = X.vcu; S.A = (const unsigned char*)(ws + WS_XA8); S.Bt = (const unsigned char*)(ws + WS_W1T) + (size_t)l * NE * 2048 * 1024; S.list = (const int*)(ws + WS_LIST); S.meta = (const LAS int*)(X.lds + META_OFF);
            moe_stage_meta<false>(X, S, S.list, (const float*)nullptr, (LAS int*)(X.lds + META_OFF), IN(I_B1) + (size_t)l * NE * 2048, (LAS float*)(X.lds + BIAS_OFF));
            PMARK(51); EpiSwiglu E{(unsigned char*)(ws + WS_ACT), (const LAS float*)(X.lds + BIAS_OFF)};
            pg8::gemm_phase<EpiSwiglu, MoeSchedT<true, 8>>(X.lds, S, E, X.tid); PMARK(53); })
    PH_RUN(PH_M2_1, { PH_ENTER(); PMARK(54); const int l = (ph == PH_M2_1); moe_build_table(X, (const int*)(ws + WS_CTL) + CW_CNT + l * NE * CNT_STRIDE);
            MoeSchedT<false, 4> S; S.tab = (const LAS int*)(X.lds + TAB_OFF); S.G = X.G; S.c = X.vcu; S.A = (const unsigned char*)(ws + WS_ACT); S.Bt = (const unsigned char*)(ws + WS_W2T) + (size_t)l * NE * 1024 * 1024; S.list = (const int*)(ws + WS_LIST); S.meta = (const LAS int*)(X.lds + META_OFF);
            moe_stage_meta<true>(X, S, S.list, (const float*)(ws + WS_GATE), (LAS int*)(X.lds + META_OFF), IN(I_B2) + (size_t)l * NE * D, (LAS float*)(X.lds + BIAS_OFF));
            EpiDown E{(bf16*)(ws + WS_Y), (const LAS float*)(X.lds + BIAS_OFF), (const LAS int*)(X.lds + META_OFF)};
            pg8::gemm_phase<EpiDown, MoeSchedT<false, 4>>(X.lds, S, E, X.tid); })
    PH_RUN(PH_CMB1, { PH_ENTER(); phase_combine(a, X, 1); })
#if PROBE_PH == -2
    if (blockIdx.x == 0 && threadIdx.x == 0) { volatile LAS unsigned long long* pm_ = (volatile LAS unsigned long long*)(X.lds + MISC_OFF + 128); const unsigned long long te = __builtin_amdgcn_s_memrealtime(); const unsigned long long span = (pm_[1] - pm_[0]) * PROBE_MULT;
        while (__builtin_amdgcn_s_memrealtime() - te < span) __builtin_amdgcn_s_sleep(8); }
#endif
#if PROBE_PH >= 0
    if (pr_t1 == 0) pr_t1 = __builtin_amdgcn_s_memrealtime();
    if (blockIdx.x == 0 && wave0 == 0) { const unsigned long long te = __builtin_amdgcn_s_memrealtime(); const unsigned long long span = (pr_t1 - pr_t0) * PROBE_MULT;
        while (__builtin_amdgcn_s_memrealtime() - te < span) __builtin_amdgcn_s_sleep(8); }
#endif
}

__device__ __forceinline__ bool find_expert(const int* cnt, int s, int& e, int& slot) {
    int pb = 0;
    for (int i = 0; i < NE; ++i) { const int c = cnt[i * CNT_STRIDE]; const int pr = ((c + 255) >> 8) << 8; if (s < pb + pr) { e = i; slot = s - pb; return true; } pb += pr; }
    return false;
}
__global__ void __launch_bounds__(256) slow_gemm(const bf16* A, const int* arow, const bf16* Bt, float* C, int N, const int* cnt, size_t bstride) {
    __shared__ float As[16][65], Bs[16][65];
    const int tx = threadIdx.x & 15, ty = threadIdx.x >> 4; const int m0 = blockIdx.y * 64, n0 = blockIdx.x * 64;
    if (cnt) { int e, slot; if (!find_expert(cnt, m0, e, slot)) return; Bt += (size_t)e * bstride; }
    float acc[4][4];
    for (int i = 0; i < 4; ++i) for (int j = 0; j < 4; ++j) acc[i][j] = 0.f;
    for (int k0 = 0; k0 < 1024; k0 += 16) {
        for (int i = 0; i < 4; ++i) { const int idx = threadIdx.x + 256 * i; const int r = idx >> 4, kk = idx & 15; const int gm = m0 + r; const int ar = arow ? arow[gm] : gm;
            As[kk][r] = bf2f(A[(size_t)ar * 1024 + k0 + kk]); Bs[kk][r] = bf2f(Bt[(size_t)(n0 + r) * 1024 + k0 + kk]); }
        __syncthreads();
        for (int kk = 0; kk < 16; ++kk) { float av[4], bv[4];
            for (int i = 0; i < 4; ++i) { av[i] = As[kk][ty * 4 + i]; bv[i] = Bs[kk][tx * 4 + i]; }
            for (int i = 0; i < 4; ++i) for (int j = 0; j < 4; ++j) acc[i][j] += av[i] * bv[j]; }
        __syncthreads();
    }
    for (int i = 0; i < 4; ++i) for (int j = 0; j < 4; ++j) C[(size_t)(m0 + ty * 4 + i) * N + n0 + tx * 4 + j] = acc[i][j];
}
__device__ __forceinline__ unsigned short f2bf_s(float f) { return (unsigned short)(pk2(f, 0.f) & 0xffffu); }
__global__ void slow_epi_in(const float* C, const float* C2, const float* bias, bf16* GLU, bf16* Q, bf16* Kb, bf16* Vb, bf16* KC, bf16* VC) {
    const size_t i = (size_t)blockIdx.x * blockDim.x + threadIdx.x;
    if (i < (size_t)NTOK * 512) { const int row = (int)(i >> 9), j = (int)(i & 511); const int t = j >> 7, ii = j & 127; const float* cr = C + (size_t)row * EVEN_IN;
        const float u = cr[t * 256 + ii] + bias[j], g = cr[t * 256 + 128 + ii] + bias[512 + j];
        GLU[i] = f2bf_s(u / (1.0f + expf(-g)));
        Q[i] = f2bf_s(cr[1024 + j] + bias[1024 + j]);
        if (j < 128) { Kb[(size_t)row * 128 + j] = f2bf_s(cr[1536 + j] + bias[1536 + j]); Vb[(size_t)row * 128 + j] = f2bf_s(cr[1664 + j] + bias[1664 + j]); }
        if (row < NCTX && j < 128) { KC[(size_t)row * 128 + j] = f2bf_s(C2[(size_t)row * 256 + j] + bias[1536 + j]); VC[(size_t)row * 128 + j] = f2bf_s(C2[(size_t)row * 256 + 128 + j] + bias[1664 + j]); } }
}
__global__ void slow_epi_res(const float* C, const float* base, float* out, const float* bias, const float* gate) {
    const size_t i = (size_t)blockIdx.x * blockDim.x + threadIdx.x;
    if (i < (size_t)NTOK * D) { const int row = (int)(i >> 10), col = (int)(i & 1023); out[i] = base[i] + gate[(size_t)(row / SEQ) * MODW + col] * (C[i] + bias[col]); }
}
__global__ void slow_epi_gelu(const float* C, const float* bias, bf16* U, bf16* V) {
    const size_t i = (size_t)blockIdx.x * blockDim.x + threadIdx.x;
    if (i < (size_t)NTOK * 2048) { const int row = (int)(i >> 11), col = (int)(i & 2047); const float x = C[i] + bias[col]; const float y = 0.5f * x * (1.0f + erff(x * 0.70710678118654752f));
        if (col < 1024) U[(size_t)row * D + col] = f2bf_s(y); else V[(size_t)row * D + col - 1024] = f2bf_s(y); }
}
__global__ void slow_arow(const int* cnt, const int* list, int* arow) {
    const int s = blockIdx.x * blockDim.x + threadIdx.x; if (s >= ACT_ROWS) return;
    int e, slot; int r = 0; if (find_expert(cnt, s, e, slot) && slot < cnt[e * CNT_STRIDE]) r = list[(size_t)e * NTOK + slot] >> 2;
    arow[s] = r;
}
__global__ void slow_epi_swiglu(const float* C, const int* cnt, const float* b1, bf16* ACT) {
    const size_t i = (size_t)blockIdx.x * blockDim.x + threadIdx.x;
    if (i < (size_t)ACT_ROWS * 1024) { const int s = (int)(i >> 10), j = (int)(i & 1023); int e, slot; if (!find_expert(cnt, s, e, slot)) return;
        const int t = j >> 7, ii = j & 127; const float* cr = C + (size_t)s * 2048;
        float g = cr[t * 256 + ii] + b1[(size_t)e * 2048 + j], up = cr[t * 256 + 128 + ii] + b1[(size_t)e * 2048 + 1024 + j];
        g = fminf(g, 7.0f); up = fminf(fmaxf(up, -7.0f), 7.0f);
        ACT[i] = f2bf_s((up + 1.0f) * g / (1.0f + expf(-1.702f * g))); }
}
__global__ void slow_epi_down(const float* C, const int* cnt, const int* list, const float* gatew, const float* b2, bf16* Y) {
    const size_t i = (size_t)blockIdx.x * blockDim.x + threadIdx.x;
    if (i < (size_t)ACT_ROWS * 1024) { const int s = (int)(i >> 10), col = (int)(i & 1023); int e, slot; if (!find_expert(cnt, s, e, slot) || slot >= cnt[e * CNT_STRIDE]) return;
        const int aid = list[(size_t)e * NTOK + slot]; Y[(size_t)aid * D + col] = f2bf_s((C[i] + b2[(size_t)e * D + col]) * gatew[aid]); }
}
__global__ void __launch_bounds__(64) slow_attention(const bf16* QN, const bf16* KN, const bf16* VV, const bf16* KC, const bf16* VC, const float* sink, bf16* MIX) {
    const int i = blockIdx.x * blockDim.x + threadIdx.x; if (i >= NTOK * 8) return;
    const int row = i >> 3, h = i & 7, kh = h >> 2, b = row / SEQ, t = row % SEQ;
    float q[64], o[64];
    for (int d = 0; d < 64; ++d) { q[d] = bf2f(QN[(size_t)row * 512 + h * 64 + d]); o[d] = 0.f; }
    float m = sink[h] * LOG2E, l = 1.0f;
    const int j0 = t - 128 < 0 ? 0 : t - 128, j1 = t + 128 > SEQ - 1 ? SEQ - 1 : t + 128;
    for (int jj = j0; jj <= j1 + CTXL; ++jj) {
        const bf16* kp; const bf16* vp;
        if (jj <= j1) { kp = KN + (size_t)(b * SEQ + jj) * 128 + kh * 64; vp = VV + (size_t)(b * SEQ + jj) * 128 + kh * 64; }
        else { const int c = jj - j1 - 1; kp = KC + (size_t)(b * CTXL + c) * 128 + kh * 64; vp = VC + (size_t)(b * CTXL + c) * 128 + kh * 64; }
        float s = 0.f; for (int d = 0; d < 64; ++d) s += q[d] * bf2f(kp[d]);
        const float mn = fmaxf(m, s), al = exp2f(m - mn), p = exp2f(s - mn); m = mn; l = l * al + p;
        for (int d = 0; d < 64; ++d) o[d] = o[d] * al + p * bf2f(vp[d]);
    }
    for (int d = 0; d < 64; ++d) MIX[(size_t)row * D + 512 + h * 64 + d] = f2bf_s(o[d] / l);
}
__global__ void slow_vstats(const bf16* VB, float* stat) {
    const int row = blockIdx.x * blockDim.x + threadIdx.x; if (row >= NTOK) return;
    float s = 0.f; for (int c = 0; c < D; ++c) s += bf2f(VB[(size_t)row * D + c]); const float mean = s / D;
    float s2 = 0.f; for (int c = 0; c < D; ++c) { const float d = bf2f(VB[(size_t)row * D + c]) - mean; s2 += d * d; }
    stat[2 * row] = mean; stat[2 * row + 1] = rsqrtf(s2 / D + EPS);
}
__global__ void slow_spatial(const bf16* U, const bf16* VB, const float* stat, const float* ws, const float* bs, const float* lng, const float* lnb, bf16* SG) {
    const size_t i = (size_t)blockIdx.x * blockDim.x + threadIdx.x;
    if (i < (size_t)NTOK * D) { const int row = (int)(i >> 10), ch = (int)(i & 1023); const int g = ch >> 7, p = row & 127, r0 = row - p;
        float s = 0.f;
        for (int q = 0; q < 128; ++q) { const float vn = (bf2f(VB[(size_t)(r0 + q) * D + ch]) - stat[2 * (r0 + q)]) * stat[2 * (r0 + q) + 1] * lng[ch] + lnb[ch]; s += ws[((size_t)g * 128 + p) * 128 + q] * vn; }
        SG[i] = f2bf_s(bf2f(U[i]) * (s + bs[g * 128 + p])); }
}

static void launch_mega(Args& a, int lo, int hi, int& li, int grid, hipStream_t stream) {
    a.ph_lo = lo; a.ph_hi = hi; a.li = li++;
    hipLaunchKernelGGL(mega, dim3(grid), dim3(NTHREADS), LDS_BYTES, stream, a);
}
extern "C" void kernel_launch(void* const* d_in, const int* in_sizes, int n_in, void* d_out, int out_size, void* d_ws, size_t ws_size, hipStream_t stream) {
    static int grid = 0;
    if (grid == 0) {
        if (n_in != 33 || out_size != NTOK * D || ws_size < WS_END) { fprintf(stderr, "kernel_launch: unexpected problem (n_in %d, out %d, ws %zu)\n", n_in, out_size, ws_size); grid = -1; return; }
        int dev = 0, cus = 0, per_cu = 0;
        if (hipGetDevice(&dev) != hipSuccess || hipDeviceGetAttribute(&cus, hipDeviceAttributeMultiprocessorCount, dev) != hipSuccess) { grid = -1; return; }
        if (hipFuncSetAttribute((const void*)mega, hipFuncAttributeMaxDynamicSharedMemorySize, LDS_BYTES) != hipSuccess) { fprintf(stderr, "kernel_launch: hipFuncSetAttribute failed\n"); grid = -1; return; }
        if (hipOccupancyMaxActiveBlocksPerMultiprocessor(&per_cu, (const void*)mega, NTHREADS, LDS_BYTES) != hipSuccess || per_cu < 1) { fprintf(stderr, "kernel_launch: occupancy query says %d blocks per CU\n", per_cu); per_cu = 1; }
        (void)hipGetLastError();
        grid = cus;
    }
    if (grid < 0) return;
    unsigned char* ws = (unsigned char*)d_ws;
    (void)hipMemsetAsync(ws + WS_CTL, 0, CTL_ZERO_BYTES, stream);
    Args a{};
    for (int i = 0; i < 33; ++i) a.in[i] = (const float*)d_in[i];
    a.out = (float*)d_out; a.ws = ws;
    int li = 0;
    const float* in_[33]; for (int i = 0; i < 33; ++i) in_[i] = (const float*)d_in[i];
    float* CF = (float*)(ws + WS_CF); float* MOD = (float*)(ws + WS_MOD); int* CNT = (int*)(ws + WS_CTL) + CW_CNT;
    int lo = 0;
    auto flush = [&](int upto) { if (upto > lo) launch_mega(a, lo, upto, li, grid, stream); };
    for (int ph = 0; ph < NPHASE; ++ph) {
        bool slow = false;
        switch (ph) {
        case PH_GIN: slow = SLOW_MASK & 1; break;
        case PH_ATT: slow = SLOW_MASK & 2; break;
        case PH_GOUT: case PH_GMO: slow = SLOW_MASK & 4; break;
        case PH_M1_0: case PH_M1_1: slow = SLOW_MASK & 8; break;
        case PH_M2_0: case PH_M2_1: slow = SLOW_MASK & 16; break;
        case PH_GMI: slow = SLOW_MASK & 32; break;
        case PH_SPA: slow = SLOW_MASK & 64; break;
        default: break;
        }
        if (!slow) continue;
        flush(ph); lo = ph + 1;
        const int l = (ph == PH_M1_1 || ph == PH_M2_1) ? 1 : 0;
        switch (ph) {
        case PH_GIN:
            hipLaunchKernelGGL(slow_gemm, dim3(EVEN_IN / 64, NTOK / 64), dim3(256), 0, stream, (const bf16*)(ws + WS_XA), (const int*)nullptr, (const bf16*)(ws + WS_WINT), CF, EVEN_IN, (const int*)nullptr, (size_t)0);
            hipLaunchKernelGGL(slow_gemm, dim3(256 / 64, NCTX / 64), dim3(256), 0, stream, (const bf16*)(ws + WS_GM), (const int*)nullptr, (const bf16*)(ws + WS_WINT) + (size_t)KV_COL * D, CF + (size_t)NTOK * EVEN_IN, 256, (const int*)nullptr, (size_t)0);
            hipLaunchKernelGGL(slow_epi_in, dim3(NTOK * 512 / 256), dim3(256), 0, stream, (const float*)CF, (const float*)(CF + (size_t)NTOK * EVEN_IN), in_[I_EBIN], (bf16*)(ws + WS_GLU), (bf16*)(ws + WS_Q), (bf16*)(ws + WS_K), (bf16*)(ws + WS_V), (bf16*)(ws + WS_KC), (bf16*)(ws + WS_VC));
            break;
        case PH_ATT:
            hipLaunchKernelGGL(slow_attention, dim3(NTOK * 8 / 64), dim3(64), 0, stream, (const bf16*)(ws + WS_Q), (const bf16*)(ws + WS_K), (const bf16*)(ws + WS_V), (const bf16*)(ws + WS_KC), (const bf16*)(ws + WS_VC), in_[I_SINK], (bf16*)(ws + WS_MIX));
            break;
        case PH_GOUT:
            hipLaunchKernelGGL(slow_gemm, dim3(D / 64, NTOK / 64), dim3(256), 0, stream, (const bf16*)(ws + WS_MIX), (const int*)nullptr, (const bf16*)(ws + WS_WOUTT), CF, D, (const int*)nullptr, (size_t)0);
            hipLaunchKernelGGL(slow_epi_res, dim3(NTOK * D / 256), dim3(256), 0, stream, (const float*)CF, in_[I_X], (float*)(ws + WS_H), in_[I_EBOUT], (const float*)(MOD + 2 * 1024));
            break;
        case PH_GMO:
            hipLaunchKernelGGL(slow_gemm, dim3(D / 64, NTOK / 64), dim3(256), 0, stream, (const bf16*)(ws + WS_MIX), (const int*)nullptr, (const bf16*)(ws + WS_GWOUTT), CF, D, (const int*)nullptr, (size_t)0);
            hipLaunchKernelGGL(slow_epi_res, dim3(NTOK * D / 256), dim3(256), 0, stream, (const float*)CF, (const float*)(ws + WS_H), (float*)(ws + WS_H), in_[I_OBOUT], (const float*)(MOD + (size_t)9 * MODW + 2 * 1024));
            break;
        case PH_M1_0: case PH_M1_1:
            hipLaunchKernelGGL(slow_arow, dim3(ACT_ROWS / 256), dim3(256), 0, stream, (const int*)(CNT + l * NE * CNT_STRIDE), (const int*)(ws + WS_LIST), (int*)(ws + WS_AROW));
            hipLaunchKernelGGL(slow_gemm, dim3(2048 / 64, ACT_ROWS / 64), dim3(256), 0, stream, (const bf16*)(ws + WS_XA), (const int*)(ws + WS_AROW), (const bf16*)(ws + WS_W1T) + (size_t)l * NE * 2048 * 1024, CF, 2048, (const int*)(CNT + l * NE * CNT_STRIDE), (size_t)2048 * 1024);
            hipLaunchKernelGGL(slow_epi_swiglu, dim3(ACT_ROWS * 1024 / 256), dim3(256), 0, stream, (const float*)CF, (const int*)(CNT + l * NE * CNT_STRIDE), in_[I_B1] + (size_t)l * NE * 2048, (bf16*)(ws + WS_ACT));
            break;
        case PH_M2_0: case PH_M2_1:
            hipLaunchKernelGGL(slow_gemm, dim3(1024 / 64, ACT_ROWS / 64), dim3(256), 0, stream, (const bf16*)(ws + WS_ACT), (const int*)nullptr, (const bf16*)(ws + WS_W2T) + (size_t)l * NE * 1024 * 1024, CF, 1024, (const int*)(CNT + l * NE * CNT_STRIDE), (size_t)1024 * 1024);
            hipLaunchKernelGGL(slow_epi_down, dim3(ACT_ROWS * 1024 / 256), dim3(256), 0, stream, (const float*)CF, (const int*)(CNT + l * NE * CNT_STRIDE), (const int*)(ws + WS_LIST), (const float*)(ws + WS_GATE), in_[I_B2] + (size_t)l * NE * D, (bf16*)(ws + WS_Y));
            break;
        case PH_GMI:
            hipLaunchKernelGGL(slow_gemm, dim3(2048 / 64, NTOK / 64), dim3(256), 0, stream, (const bf16*)(ws + WS_XA), (const int*)nullptr, (const bf16*)(ws + WS_GWINT), CF, 2048, (const int*)nullptr, (size_t)0);
            hipLaunchKernelGGL(slow_epi_gelu, dim3(NTOK * 2048 / 256), dim3(256), 0, stream, (const float*)CF, in_[I_OBIN], (bf16*)(ws + WS_U), (bf16*)(ws + WS_VB));
            break;
        case PH_SPA:
            hipLaunchKernelGGL(slow_vstats, dim3(NTOK / 64), dim3(64), 0, stream, (const bf16*)(ws + WS_VB), CF);
            hipLaunchKernelGGL(slow_spatial, dim3(NTOK * D / 256), dim3(256), 0, stream, (const bf16*)(ws + WS_U), (const bf16*)(ws + WS_VB), (const float*)CF, in_[I_OWS], in_[I_OBS], in_[I_OLNG], in_[I_OLNB], (bf16*)(ws + WS_MIX));
            break;
        default: break;
        }
    }
    flush(NPHASE);
}
```

```cpp
#include <hip/hip_runtime.h>
#include <cstdio>
#include <cstdint>

#ifndef SLOW_MASK
#define SLOW_MASK 0x00
#endif

#ifndef EXP_STREAM
#define EXP_STREAM 0
#endif
#ifndef PROBE_PH
#define PROBE_PH (-1)
#endif
#ifndef PROBE_END
#define PROBE_END (PROBE_PH + 1)
#endif
#ifndef PROBE_A
#define PROBE_A (-1)
#define PROBE_B (-1)
#endif
#ifndef PROBE_MULT
#define PROBE_MULT 4
#endif

#define LAS __attribute__((address_space(3)))
typedef unsigned short bf16;
typedef short bf16x8 __attribute__((ext_vector_type(8)));
typedef float f32x4 __attribute__((ext_vector_type(4)));
typedef float f32x2 __attribute__((ext_vector_type(2)));
typedef unsigned u32x4 __attribute__((ext_vector_type(4)));
typedef unsigned u32x2 __attribute__((ext_vector_type(2)));
typedef __bf16 bf16x2_t __attribute__((ext_vector_type(2)));

constexpr int NB = 8, SEQ = 2048, D = 1024, NTOK = NB * SEQ, CTXL = 256, NCTX = NB * CTXL;
constexpr int NE = 32, TOPK = 4, NASSIGN = NTOK * TOPK, ACT_ROWS = NASSIGN + NE * 256;
constexpr int EVEN_IN = 1792, KV_COL = 1536;
constexpr float EPS = 1e-6f, LOG2E = 1.4426950408889634f;
constexpr float QSCALE = 0.125f * LOG2E;
constexpr int MODW = 6 * D;
constexpr int NWAVES = 8, NTHREADS = 512;

constexpr size_t MiB = 1u << 20;
constexpr size_t WS_CTL = 0, CTL_ZERO_BYTES = 1 * MiB;
constexpr size_t WS_MOD = 1 * MiB;
constexpr size_t WS_LIST = 2 * MiB;
constexpr size_t WS_GATE = 4 * MiB;
constexpr size_t WS_WSB = 5 * MiB;
constexpr size_t WS_WINT = 6 * MiB;
constexpr size_t WS_WOUTT = 10 * MiB;
constexpr size_t WS_GWINT = 12 * MiB;
constexpr size_t WS_GWOUTT = 16 * MiB;
constexpr size_t WS_KC = 18 * MiB;
constexpr size_t WS_VC = 18 * MiB + 512 * 1024;
constexpr size_t WS_K = 19 * MiB;
constexpr size_t WS_V = 23 * MiB;
constexpr size_t WS_GM = 27 * MiB;
constexpr size_t WS_AROW = 31 * MiB;
constexpr size_t WS_Q = 32 * MiB;
constexpr size_t WS_GLU = 48 * MiB;
constexpr size_t WS_XA = 64 * MiB;
constexpr size_t WS_MIX = 96 * MiB;
constexpr size_t WS_H = 128 * MiB;
constexpr size_t WS_U = 192 * MiB;
constexpr size_t WS_VB = 224 * MiB;
constexpr size_t WS_W1T = 256 * MiB;
constexpr size_t WS_W2T = 512 * MiB;
constexpr size_t WS_ACT = 640 * MiB;
constexpr size_t WS_Y = 784 * MiB;
constexpr size_t WS_XA8 = 912 * MiB;
constexpr size_t WS_CF = 928 * MiB;
constexpr size_t WS_END = 1504 * MiB;
constexpr int CW_BAR = 4096, CW_CNT = 131072, CNT_STRIDE = 64  , CW_VSTAT = 147456;
constexpr int MAX_LAUNCH = 20;

constexpr int RING_BYTES = 131072;
constexpr int MISC_OFF = RING_BYTES;
constexpr int TAB_OFF = RING_BYTES + 256;
constexpr int META_OFF = RING_BYTES + 3072;
constexpr int BIAS_OFF = META_OFF + 10240;
constexpr int LDS_BYTES = 163840;

#define LDS_WAIT() asm volatile("s_waitcnt lgkmcnt(0)" ::: "memory")
#define VM_WAIT() asm volatile("s_waitcnt vmcnt(0)" ::: "memory")

__device__ __forceinline__ float bf2f(unsigned b) { return __uint_as_float(b << 16); }
__device__ __forceinline__ unsigned pk2(float lo, float hi) { f32x2 v = {lo, hi}; bf16x2_t b = __builtin_convertvector(v, bf16x2_t); return __builtin_bit_cast(unsigned, b); }
template <int CTRL, int ROW_MASK> __device__ __forceinline__ float dpp_f(float old, float src) { return __builtin_bit_cast(float, __builtin_amdgcn_update_dpp(__builtin_bit_cast(int, old), __builtin_bit_cast(int, src), CTRL, ROW_MASK, 0xf, false)); }
__device__ __forceinline__ unsigned pk4_fp8(float a, float b, float c, float d) { int w = 0; w = __builtin_amdgcn_cvt_pk_fp8_f32(a, b, w, false); w = __builtin_amdgcn_cvt_pk_fp8_f32(c, d, w, true); return (unsigned)w; }
__device__ __forceinline__ float wave_sum(float v) {
    v += dpp_f<0xB1, 0xf>(0.f, v);
    v += dpp_f<0x4E, 0xf>(0.f, v);
    v += dpp_f<0x141, 0xf>(0.f, v);
    v += dpp_f<0x140, 0xf>(0.f, v);
    v += dpp_f<0x142, 0xa>(0.f, v);
    v += dpp_f<0x143, 0xc>(0.f, v);
    return __builtin_bit_cast(float, __builtin_amdgcn_readlane(__builtin_bit_cast(int, v), 63));
}
__device__ __forceinline__ float dpp_swap32(float v) { return __shfl_xor(v, 32); }
__device__ __forceinline__ float sigmoidf_(float x) { return __builtin_amdgcn_rcpf(1.0f + __builtin_amdgcn_exp2f(-x * LOG2E)); }

#define XB_TMO      128
#define XB_XCNT(j)  (256  + 64 * (j))
#define XB_XSUB(j)  (1280 + 64 * (j))
#define XB_XGEN(j)  (2304 + 64 * (j))
#define XB_TOP      3328
#define XB_TOPGEN   3392
#define XCD_BAR_WORDS 3456
#define XB_SPIN_CAP (1u << 20)
__device__ __forceinline__ unsigned xb_ld(unsigned* p)              { return __hip_atomic_load(p, __ATOMIC_RELAXED, __HIP_MEMORY_SCOPE_AGENT); }
__device__ __forceinline__ unsigned xb_add(unsigned* p, unsigned v) { return __hip_atomic_fetch_add(p, v, __ATOMIC_RELAXED, __HIP_MEMORY_SCOPE_AGENT); }
__device__ __forceinline__ unsigned xb_xcc_id() { return (unsigned)__builtin_amdgcn_s_getreg((3 << 11) | 20) & 0xFu; }
#define XB_SPIN(cond, bar) do { unsigned _sp = 0; while (cond) { __builtin_amdgcn_s_sleep(1); \
    if ((++_sp & 255u) == 0u) { if (xb_ld(&(bar)[XB_TMO])) break; if (_sp > XB_SPIN_CAP) { atomicAdd(&(bar)[XB_TMO], 1u); break; } } } } while (0)
struct XcdBarrier { unsigned* bar; unsigned x; volatile LAS unsigned* st; };
__device__ __forceinline__ XcdBarrier xcd_barrier_post(unsigned* bar, volatile LAS unsigned* st) {
    XcdBarrier b; b.bar = bar; b.x = xb_xcc_id(); b.st = st;
    if (threadIdx.x == 0) (void)xb_add(&bar[XB_XCNT(b.x)], 1u);
    return b;
}
__device__ __forceinline__ void xcd_barrier_complete(unsigned* bar, unsigned x, unsigned& nloc, unsigned& nx) {
    const unsigned G = gridDim.x * gridDim.y * gridDim.z;
    unsigned sum, cnt, mine, sp = 0u;
    for (;;) {
        sum = 0u; cnt = 0u; mine = 0u;
#pragma unroll
        for (unsigned j = 0; j < 16; ++j) { const unsigned c = xb_ld(&bar[XB_XCNT(j)]); sum += c; cnt += (c > 0u) ? 1u : 0u; mine = (j == x) ? c : mine; }
        if (sum == G) break;
        __builtin_amdgcn_s_sleep(1);
        if ((++sp & 255u) == 0u) { if (xb_ld(&bar[XB_TMO])) break; if (sp > XB_SPIN_CAP) { atomicAdd(&bar[XB_TMO], 1u); break; } }
    }
    nloc = mine > 0u ? mine : 1u; nx = cnt > 0u ? cnt : 1u;
}
__device__ __forceinline__ void xcd_barrier(const XcdBarrier& b, const int tid) {
    asm volatile("s_waitcnt vmcnt(0)" ::: "memory");
    __syncthreads();
    if (tid == 0) {
        unsigned* bar = b.bar;
        __builtin_amdgcn_s_waitcnt(0);
        unsigned nloc = b.st[0], nx = b.st[1];
        if (nloc == 0u) { xcd_barrier_complete(bar, b.x, nloc, nx); b.st[0] = nloc; b.st[1] = nx; }
        const unsigned old = xb_add(&bar[XB_XSUB(b.x)], 1u);
        const unsigned gen = old / nloc;
        if (old + 1u == (gen + 1u) * nloc) {
            __builtin_amdgcn_fence(__ATOMIC_RELEASE, "agent");
            asm volatile("s_waitcnt vmcnt(0)" ::: "memory");
            const unsigned og = xb_add(&bar[XB_TOP], 1u);
            const unsigned tg = og / nx;
            if (og + 1u == (tg + 1u) * nx) xb_add(&bar[XB_TOPGEN], 1u);
            else XB_SPIN(xb_ld(&bar[XB_TOPGEN]) == tg, bar);
            __builtin_amdgcn_fence(__ATOMIC_ACQUIRE, "agent");
            xb_add(&bar[XB_XGEN(b.x)], 1u);
            asm volatile("s_waitcnt vmcnt(0)" ::: "memory");
        } else {
            XB_SPIN(xb_ld(&bar[XB_XGEN(b.x)]) == gen, bar);
            __builtin_amdgcn_fence(__ATOMIC_ACQUIRE, "agent");
            asm volatile("s_waitcnt vmcnt(0)" ::: "memory");
        }
    }
    __syncthreads();
}

constexpr float FP8_WMUL = 32.0f, FP8_AMUL = 4.0f, FP8_DESCALE = 1.0f / (32.0f * 4.0f);
#if PROBE_PH == -2
#define GMARK(k) do { if (Sched::GATHER && ui == 0 && blockIdx.x == 0 && tid == 0) { volatile LAS unsigned long long* pm_ = (volatile LAS unsigned long long*)(lds + MISC_OFF + 128); \
    if ((k) == PROBE_A) pm_[0] = __builtin_amdgcn_s_memrealtime(); if ((k) == PROBE_B) pm_[1] = __builtin_amdgcn_s_memrealtime(); } } while (0)
#define GMARK1(k) do { if (Sched::GATHER && ui == 1 && blockIdx.x == 0 && tid == 0) { volatile LAS unsigned long long* pm_ = (volatile LAS unsigned long long*)(lds + MISC_OFF + 128); \
    if ((k) == PROBE_A) pm_[0] = __builtin_amdgcn_s_memrealtime(); if ((k) == PROBE_B) pm_[1] = __builtin_amdgcn_s_memrealtime(); } } while (0)
#else
#define GMARK(k) do { } while (0)
#define GMARK1(k) do { } while (0)
#endif
namespace pg8 {
constexpr int BM = 256, BK = 64, HALF = 128, HTB = HALF * BK * 2, STAGE_BYTES = 8 * HTB, KD = 1024  ;
__host__ __device__ __forceinline__ int lds_byte(int r, int c) { const int st = (r >> 4) * 2 + (c >> 5), rr = r & 15, cc = c & 31, ob = rr * 64 + cc * 2; return st * 1024 + (ob ^ (((ob >> 9) & 1) << 5)); }
__host__ __device__ __forceinline__ void stage_rc(int b, int& R, int& C) { const int st = b / 1024, sb = b % 1024, swz = sb ^ (((sb >> 9) & 1) << 5); R = (st >> 1) * 16 + swz / 64; C = (st & 1) * 32 + (swz % 64) / 2; }
__host__ __device__ __forceinline__ int perm32(int rho) { const int n = rho >> 4, i = rho & 15; return 8 * (i >> 2) + 4 * n + (i & 3); }

typedef int v8i_t __attribute__((ext_vector_type(8)));
__device__ __forceinline__ v8i_t cat8(bf16x8 a, bf16x8 b) { typedef int v4i_t __attribute__((ext_vector_type(4))); const v4i_t x = __builtin_bit_cast(v4i_t, a), y = __builtin_bit_cast(v4i_t, b); return __builtin_shufflevector(x, y, 0, 1, 2, 3, 4, 5, 6, 7); }
struct Unit { int pm, pn, e, cnt, idx; };

template <class Epi, class Sched>
__device__ __forceinline__ void gemm_phase(LAS unsigned char* lds, const Sched& S, const Epi& E, const int tid) {
    const int wid = __builtin_amdgcn_readfirstlane(tid >> 6), lane = tid & 63, wr = wid >> 2, wc = wid & 3, fr = lane & 15, fq = lane >> 4;
    constexpr int RP = Sched::FP8 ? 1024 : 2048  , nt = RP / 128;
    int Rr[2], Cc[2];
    unsigned voffA[2][2], voffB[2];
#pragma unroll
    for (int i = 0; i < 2; ++i) { stage_rc(tid * 16 + i * 8192, Rr[i], Cc[i]); const int Rb = Epi::PERM ? ((Rr[i] & ~31) + perm32(Rr[i] & 31)) : Rr[i];
        voffB[i] = (unsigned)(Rb * RP + Cc[i] * 2); }
    constexpr size_t kstep = (size_t)(BK * 2);
    constexpr size_t hstep = (size_t)HALF * RP;
    const unsigned ldsw = (unsigned)wid * 1024u;
    const int aoff = lds_byte(wr * 64 + fr, fq * 8), boff = lds_byte(wc * 32 + fr, fq * 8);
#define PG8_SA(b, h) (((b) * 2 + (h)) * HTB)
#define PG8_SB(b, h) ((4 + (b) * 2 + (h)) * HTB)
#define PG8_STAGE(bufoff, gbase, voff) do { _Pragma("unroll") for (int _i = 0; _i < 2; ++_i) \
        __builtin_amdgcn_global_load_lds((const unsigned*)((const char*)(gbase) + (voff)[_i]), (LAS unsigned*)(lds + (bufoff) + ldsw + _i * 8192), 16, 0, 0); } while (0)
#define PG8_STAGEA1(bufoff, gbase) do { if constexpr (Sched::GATHER) { PG8_STAGE(bufoff, gbase, voffA[1]); } else { PG8_STAGE(bufoff, (gbase) + hstep, voffA[0]); } } while (0)
#define PG8_LDA(dst, b, h) do { _Pragma("unroll") for (int m = 0; m < 4; ++m) _Pragma("unroll") for (int k = 0; k < 2; ++k) dst[m][k] = *(const LAS bf16x8*)(lds + PG8_SA(b, h) + aoff + m * 2048 + k * 1024); } while (0)
#define PG8_LDB(dst, b, h) do { _Pragma("unroll") for (int n = 0; n < 2; ++n) _Pragma("unroll") for (int k = 0; k < 2; ++k) dst[n][k] = *(const LAS bf16x8*)(lds + PG8_SB(b, h) + boff + n * 2048 + k * 1024); } while (0)
#define PG8_MMA(ai, bj, At, Bt) do { __builtin_amdgcn_s_setprio(1); _Pragma("unroll") for (int m = 0; m < 4; ++m) _Pragma("unroll") for (int n = 0; n < 2; ++n) { \
        if constexpr (Sched::FP8) { acc[ai][bj][m][n] = __builtin_amdgcn_mfma_scale_f32_16x16x128_f8f6f4(cat8(Bt[n][0], Bt[n][1]), cat8(At[m][0], At[m][1]), acc[ai][bj][m][n], 0, 0, 0, 0, 0, 0); } \
        else { _Pragma("unroll") for (int k = 0; k < 2; ++k) acc[ai][bj][m][n] = __builtin_amdgcn_mfma_f32_16x16x32_bf16(Bt[n][k], At[m][k], acc[ai][bj][m][n], 0, 0, 0); } } \
        __builtin_amdgcn_s_setprio(0); } while (0)
#define PG8_WAIT_V(n) asm volatile("s_waitcnt vmcnt(" #n ")" ::: "memory")
#define PG8_WAIT_L(n) asm volatile("s_waitcnt lgkmcnt(" #n ")" ::: "memory")
#define PG8_BAR __builtin_amdgcn_s_barrier()
#define PG8_SCHED __builtin_amdgcn_sched_barrier(0)
    Unit cur, nxt; int ui = 0;
    if (!S.next(0, cur)) return;
    S.a_voff(cur, voffA, Rr, Cc);
    f32x4 acc[2][2][4][2];
#pragma unroll
    for (int a = 0; a < 2; ++a)
#pragma unroll
        for (int b = 0; b < 2; ++b)
#pragma unroll
            for (int m = 0; m < 4; ++m)
#pragma unroll
                for (int n = 0; n < 2; ++n) acc[a][b][m][n] = (f32x4){0.f, 0.f, 0.f, 0.f};
    bf16x8 At[4][2], B0[2][2], B1[2][2];
    const char* cA = S.a_ptr(cur); const char* cB = S.b_ptr(cur);
    PG8_STAGE(PG8_SB(0, 0), cB, voffB); PG8_STAGE(PG8_SB(0, 1), cB + hstep, voffB); PG8_STAGE(PG8_SA(0, 0), cA, voffA[0]); PG8_STAGEA1(PG8_SA(0, 1), cA);
    if (wr == 1) PG8_BAR;
    PG8_WAIT_V(2); PG8_BAR;
    PG8_STAGE(PG8_SB(1, 0), cB + kstep, voffB); PG8_STAGE(PG8_SA(1, 0), cA + kstep, voffA[0]); PG8_STAGE(PG8_SB(1, 1), cB + hstep + kstep, voffB);
    PG8_WAIT_V(6); PG8_BAR;
    for (;;) {
        const bool has_next = S.next(ui + 1, nxt);
        const char* nA = has_next ? S.a_ptr(nxt) : cA; const char* nB = has_next ? S.b_ptr(nxt) : cB;
#pragma unroll 1
        for (int t = 0; t < nt; t += 2) {
            const bool last = (t == nt - 2);
            if (last) GMARK(40); if (t == 2) GMARK1(45);
            const char* a1 = cA + (size_t)(t + 1) * kstep;
            const char* a2 = last ? nA : cA + (size_t)(t + 2) * kstep; const char* b2 = last ? nB : cB + (size_t)(t + 2) * kstep;
            const char* a3 = a2 + kstep; const char* b3 = b2 + kstep;
            asm volatile("" : "+s"(a1), "+s"(a2), "+s"(a3), "+s"(b2), "+s"(b3));
            PG8_LDB(B0, 0, 0); PG8_LDB(B1, 0, 1); PG8_SCHED; PG8_LDA(At, 0, 0); PG8_STAGEA1(PG8_SA(1, 1), a1);
            if (Sched::GATHER) { if (last && has_next) S.a_voff(nxt, voffA, Rr, Cc); }
            PG8_WAIT_V(8); PG8_WAIT_L(0); PG8_BAR; PG8_MMA(0, 0, At, B0); PG8_MMA(0, 1, At, B1); PG8_BAR; PG8_SCHED;
            PG8_LDA(At, 0, 1); PG8_STAGE(PG8_SB(0, 0), b2, voffB); PG8_STAGE(PG8_SB(0, 1), b2 + hstep, voffB); PG8_STAGE(PG8_SA(0, 0), a2, voffA[0]);
            PG8_WAIT_V(8); PG8_WAIT_L(0); PG8_BAR; PG8_MMA(1, 0, At, B0); PG8_MMA(1, 1, At, B1); PG8_BAR; PG8_SCHED;
            PG8_LDB(B0, 1, 0); PG8_LDB(B1, 1, 1); PG8_SCHED; PG8_LDA(At, 1, 0); PG8_STAGEA1(PG8_SA(0, 1), a2);
            PG8_WAIT_V(8); PG8_WAIT_L(0); PG8_BAR; PG8_MMA(0, 0, At, B0); PG8_MMA(0, 1, At, B1); PG8_BAR; PG8_SCHED;
            PG8_LDA(At, 1, 1); PG8_STAGE(PG8_SB(1, 0), b3, voffB); PG8_STAGE(PG8_SB(1, 1), b3 + hstep, voffB); PG8_STAGE(PG8_SA(1, 0), a3, voffA[0]);
            PG8_WAIT_V(8); PG8_WAIT_L(0); PG8_BAR; PG8_MMA(1, 0, At, B0); PG8_MMA(1, 1, At, B1); PG8_BAR; PG8_SCHED;
        }
        GMARK(41);
        if (wr == 0) PG8_BAR;
        GMARK(42);
        E(acc, cur, wr, wc, fr, fq);
        GMARK(43);
        if (!has_next) break;
#pragma unroll
        for (int a = 0; a < 2; ++a)
#pragma unroll
            for (int b = 0; b < 2; ++b)
#pragma unroll
                for (int m = 0; m < 4; ++m)
#pragma unroll
                    for (int n = 0; n < 2; ++n) acc[a][b][m][n] = (f32x4){0.f, 0.f, 0.f, 0.f};
        cur = nxt; cA = nA; cB = nB; ++ui;
        if (wr == 1) PG8_BAR;
    }
    PG8_WAIT_V(0);
    PG8_BAR;
#undef PG8_SA
#undef PG8_SB
#undef PG8_STAGE
#undef PG8_STAGEA1
#undef PG8_LDA
#undef PG8_LDB
#undef PG8_MMA
#undef PG8_WAIT_V
#undef PG8_WAIT_L
#undef PG8_BAR
#undef PG8_SCHED
}
}

struct Args { const float* in[33]; float* out; unsigned char* ws; int ph_lo, ph_hi, li, pad; };
enum { I_X = 0, I_C, I_CTX, I_CCTX, I_ADAW, I_ADAB, I_NMG, I_NFG, I_EWIN, I_EBIN, I_ECW, I_ECB, I_ELNG, I_ELNB, I_QNG, I_KNG, I_SINK, I_EWOUT, I_EBOUT,
       I_OWIN, I_OBIN, I_OLNG, I_OLNB, I_OWS, I_OBS, I_OWOUT, I_OBOUT, I_RW, I_RB, I_W1, I_B1, I_W2, I_B2 };

typedef const __attribute__((address_space(4))) unsigned long long* kargp_t;
struct Ctx {
    LAS unsigned char* lds; int tid, lane, wave, G, vcu, gw, NGW, bid; unsigned char* ws; kargp_t kp;
};
__device__ __forceinline__ const float* in_ptr(const Ctx& X, int i) { return (const float*)(const __attribute__((address_space(1))) float*)X.kp[i]; }
#define IN(i) in_ptr(X, (i))
#if PROBE_PH == -2
#define PMARK(k) do { if (X.bid == 0 && X.tid == 0) { volatile LAS unsigned long long* pm_ = (volatile LAS unsigned long long*)(X.lds + MISC_OFF + 128); \
    if ((k) == PROBE_A) pm_[0] = __builtin_amdgcn_s_memrealtime(); if ((k) == PROBE_B) pm_[1] = __builtin_amdgcn_s_memrealtime(); } } while (0)
#else
#define PMARK(k) do { } while (0)
#endif

struct DenseSched {
    static constexpr bool GATHER = false, FP8 = false;
    const bf16* A; const bf16* Bt; int nM, nN, nwg, G, c;
    const bf16* A2; const bf16* Bt2; int nM2;
    __device__ __forceinline__ void init(const bf16* A_, const bf16* Bt_, int M, int N, int G_, int c_) { A = A_; Bt = Bt_; nM = M / 256; nN = N / 256; nwg = nM * nN; G = G_; c = c_; A2 = nullptr; Bt2 = nullptr; nM2 = 0; }
    __device__ __forceinline__ bool next(int i, pg8::Unit& u) const {
        const int L = i * G + c; if (L >= nwg + nM2) return false; u.idx = i;
        if (L >= nwg) { u.pm = L - nwg; u.pn = 0; u.e = 1; u.cnt = 256; return true; }
        int wgid = L; { const int q = nwg / 8, r = nwg % 8, xcd = wgid % 8, off = wgid / 8; wgid = (xcd < r ? xcd * (q + 1) : r * (q + 1) + (xcd - r) * q) + off; }
        const int nig = 8 * nN, gid = wgid / nig, fm = gid * 8, gsz = (nM - fm) < 8 ? (nM - fm) : 8;
        u.pm = fm + ((wgid % nig) % gsz); u.pn = (wgid % nig) / gsz; u.e = 0; u.cnt = 256; return true;
    }
    __device__ __forceinline__ const char* a_ptr(const pg8::Unit& u) const { return (const char*)(u.e ? A2 : A) + (size_t)u.pm * 256 * pg8::KD * 2; }
    __device__ __forceinline__ const char* b_ptr(const pg8::Unit& u) const { return (const char*)(u.e ? Bt2 : Bt) + (size_t)u.pn * 256 * pg8::KD * 2; }
    __device__ __forceinline__ void a_voff(const pg8::Unit&, unsigned (&v)[2][2], const int (&R)[2], const int (&C)[2]) const {
#pragma unroll
        for (int i = 0; i < 2; ++i) { v[0][i] = (unsigned)(R[i] * pg8::KD + C[i]) * 2u; v[1][i] = v[0][i] + (unsigned)(pg8::HALF * pg8::KD * 2); }
    }
};
template <bool GATHER_, int NTILE_N>
struct MoeSchedT {
    static constexpr bool GATHER = GATHER_, FP8 = true; static constexpr int RP = 1024;
    const LAS int* tab; int G, c;
    const unsigned char* A;
    const unsigned char* Bt;
    const int* list;
    const LAS int* meta;
    __device__ __forceinline__ bool next(int i, pg8::Unit& u) const {
        const int L = i * G + c; const int T = tab[0];
        if (L >= T * NTILE_N) return false;
        u.idx = i;
        const int mt = L / NTILE_N; u.pn = L % NTILE_N;
        const int w = __builtin_amdgcn_readfirstlane(tab[1 + mt]); u.e = w >> 16; const int tl = w & 0xffff;
        const int cnt = __builtin_amdgcn_readfirstlane(tab[512 + u.e]), pb = __builtin_amdgcn_readfirstlane(tab[544 + u.e]);
        u.pm = pb + tl * 256; u.cnt = cnt - tl * 256;
        return true;
    }
    __device__ __forceinline__ const char* a_ptr(const pg8::Unit& u) const { return GATHER ? (const char*)A : (const char*)A + (size_t)u.pm * RP; }
    __device__ __forceinline__ const char* b_ptr(const pg8::Unit& u) const { return (const char*)Bt + ((size_t)u.e * NTILE_N + u.pn) * 256 * RP; }
    __device__ __forceinline__ void a_voff(const pg8::Unit& u, unsigned (&v)[2][2], const int (&R)[2], const int (&C)[2]) const {
        if (GATHER) {
#pragma unroll
            for (int h = 0; h < 2; ++h)
#pragma unroll
                for (int i = 0; i < 2; ++i) { const int tok = meta[u.idx * 256 + h * 128 + R[i]]; v[h][i] = (unsigned)(tok * RP + C[i] * 2); }
        } else {
#pragma unroll
            for (int i = 0; i < 2; ++i) { v[0][i] = (unsigned)(R[i] * RP + C[i] * 2); v[1][i] = v[0][i] + (unsigned)(pg8::HALF * RP); }
        }
    }
};
__device__ __forceinline__ void moe_build_table(const Ctx& X, const int* cnt  ) {
    LAS int* tab = (LAS int*)(X.lds + TAB_OFF);
    __syncthreads();
    if (X.tid < 64) {
        const int e = X.lane; int c = 0; if (e < NE) c = __hip_atomic_load(cnt + e * CNT_STRIDE, __ATOMIC_RELAXED, __HIP_MEMORY_SCOPE_AGENT);
        const int mt = (c + 255) >> 8; int incl = mt;
#pragma unroll
        for (int off = 1; off < 32; off <<= 1) { const int v = __shfl_up(incl, off); if (X.lane >= off) incl += v; }
        const int start = incl - mt;
        if (e < NE) { tab[512 + e] = c; tab[544 + e] = start * 256; for (int t = 0; t < mt; ++t) tab[1 + start + t] = (e << 16) | t; if (e == NE - 1) tab[0] = incl; }
    }
    __syncthreads();
}
template <bool WITH_GATE, class Sched>
__device__ __forceinline__ void moe_stage_meta(const Ctx& X, const Sched& S, const int* list, const float* gatew, LAS int* meta, const float* bias, LAS float* lbias) {
    if (X.tid < 256) { pg8::Unit u;
        for (int i = 0; S.next(i, u); ++i) { const int slot0 = u.pm - S.tab[544 + u.e]; const int r = X.tid < u.cnt ? X.tid : u.cnt - 1;
            const int aid = list[(size_t)u.e * NTOK + slot0 + r];
            if (WITH_GATE) { const float g = gatew[aid]; *(LAS u32x2*)(meta + (i * 256 + X.tid) * 2) = (u32x2){(unsigned)aid, __float_as_uint(g)}; }
            else meta[i * 256 + X.tid] = aid >> 2; } }
    else { const int c = X.tid - 256; pg8::Unit u;
        for (int i = 0; S.next(i, u); ++i) lbias[i * 256 + c] = WITH_GATE ? bias[(size_t)u.e * D + u.pn * 256 + c] : bias[(size_t)u.e * 2048 + (c >> 7) * 1024 + u.pn * 128 + (c & 127)]; }
    __syncthreads();
}

__device__ __forceinline__ f32x2 gelu_pk(f32x2 v) {
    const f32x2 av = __builtin_elementwise_abs(v), d = av * 0.2316418882f + 1.0f;
    f32x2 t; t.x = __builtin_amdgcn_rcpf(d.x); t.y = __builtin_amdgcn_rcpf(d.y);
    f32x2 q = t * 0.5307027145f + (-0.7265760135f); q = q * t + 0.7107068705f; q = q * t + (-0.142248368f); q = q * t + 0.127414796f; q = q * t;
    const f32x2 s = (v * v) * (-0.72134752044f);
    f32x2 e; e.x = __builtin_amdgcn_exp2f(s.x); e.y = __builtin_amdgcn_exp2f(s.y);
    const f32x2 m = v * (q * e), r = v - m;
    f32x2 o; o.x = v.x < 0.f ? m.x : r.x; o.y = v.y < 0.f ? m.y : r.y; return o;
}
__device__ __forceinline__ u32x4 pack8(f32x4 a, f32x4 b) { u32x4 w; w.x = pk2(a[0], a[1]); w.y = pk2(a[2], a[3]); w.z = pk2(b[0], b[1]); w.w = pk2(b[2], b[3]); return w; }

struct EpiIn {
    static constexpr bool PERM = true;
    bf16 *GLU, *Q, *Kb, *Vb, *KC, *VC; const float* bias;
    __device__ __forceinline__ void operator()(const f32x4 (&acc)[2][2][4][2], const pg8::Unit& u, int wr, int wc, int fr, int fq) const {
        asm volatile("" : "+v"(fr), "+v"(fq));
        const int row0 = u.pm * 256 + wr * 64 + fr; const int c8 = wc * 32 + 8 * fq;
        if (u.e == 0 && u.pn < 4) {
            const int j0 = u.pn * 128 + c8;
            f32x4 bu[2], bg[2];
#pragma unroll
            for (int n = 0; n < 2; ++n) { bu[n] = *(const f32x4*)(bias + j0 + 4 * n); bg[n] = *(const f32x4*)(bias + 512 + j0 + 4 * n); }
#pragma unroll
            for (int ai = 0; ai < 2; ++ai)
#pragma unroll
                for (int m = 0; m < 4; ++m) { f32x4 o[2];
#pragma unroll
                    for (int n = 0; n < 2; ++n) { const f32x4 uu = acc[ai][0][m][n] + bu[n], gg = acc[ai][1][m][n] + bg[n];
#pragma unroll
                        for (int k = 0; k < 4; ++k) o[n][k] = uu[k] * sigmoidf_(gg[k]); }
                    *(u32x4*)(GLU + (size_t)(row0 + ai * 128 + m * 16) * 512 + j0) = pack8(o[0], o[1]); }
        } else {
#pragma unroll
            for (int bj = 0; bj < 2; ++bj) {
                bf16* dst; int ld, col, bcol;
                if (u.pn >= 6 || u.e) { dst = u.e ? (bj ? VC : KC) : (bj ? Vb : Kb); ld = 128; col = c8; bcol = KV_COL + bj * 128 + c8; }
                else { dst = Q; ld = 512; col = (u.pn - 4) * 256 + bj * 128 + c8; bcol = 1024 + col; }
                f32x4 bv[2];
#pragma unroll
                for (int n = 0; n < 2; ++n) bv[n] = *(const f32x4*)(bias + bcol + 4 * n);
#pragma unroll
                for (int ai = 0; ai < 2; ++ai)
#pragma unroll
                    for (int m = 0; m < 4; ++m) *(u32x4*)(dst + (size_t)(row0 + ai * 128 + m * 16) * ld + col) = pack8(acc[ai][bj][m][0] + bv[0], acc[ai][bj][m][1] + bv[1]);
            }
        }
    }
};
template <bool BASE_F32> struct EpiRes {
    static constexpr bool PERM = true;
    const void* base; bf16* out; const float* bias; const float* gate;
    __device__ __forceinline__ void operator()(const f32x4 (&acc)[2][2][4][2], const pg8::Unit& u, int wr, int wc, int fr, int fq) const {
        asm volatile("" : "+v"(fr), "+v"(fq));
        const int col0 = u.pn * 256 + wc * 32 + 8 * fq; const int b = (u.pm * 256) / SEQ;
#pragma unroll
        for (int bj = 0; bj < 2; ++bj) {
            f32x4 bv[2], gv[2];
#pragma unroll
            for (int n = 0; n < 2; ++n) { bv[n] = *(const f32x4*)(bias + col0 + bj * 128 + 4 * n); gv[n] = *(const f32x4*)(gate + (size_t)b * MODW + col0 + bj * 128 + 4 * n); }
#pragma unroll
            for (int ai = 0; ai < 2; ++ai)
#pragma unroll
                for (int m = 0; m < 4; ++m) { const size_t off = (size_t)(u.pm * 256 + ai * 128 + wr * 64 + m * 16 + fr) * D + col0 + bj * 128;
                    f32x4 b0, b1;
                    if (BASE_F32) { b0 = *(const f32x4*)((const float*)base + off); b1 = *(const f32x4*)((const float*)base + off + 4); }
                    else { const u32x4 w = *(const u32x4*)((const bf16*)base + off); b0 = (f32x4){bf2f(w.x & 0xffffu), bf2f(w.x >> 16), bf2f(w.y & 0xffffu), bf2f(w.y >> 16)}; b1 = (f32x4){bf2f(w.z & 0xffffu), bf2f(w.z >> 16), bf2f(w.w & 0xffffu), bf2f(w.w >> 16)}; }
                    *(u32x4*)(out + off) = pack8(b0 + gv[0] * (acc[ai][bj][m][0] + bv[0]), b1 + gv[1] * (acc[ai][bj][m][1] + bv[1])); }
        }
    }
};
struct EpiGelu {
    static constexpr bool PERM = true;
    bf16 *U, *V; const float* bias; float* vstat;
    __device__ __forceinline__ void operator()(const f32x4 (&acc)[2][2][4][2], const pg8::Unit& u, int wr, int wc, int fr, int fq) const {
        asm volatile("" : "+v"(fr), "+v"(fq));
        const int row0 = u.pm * 256 + wr * 64 + fr; const int colt = u.pn * 256; const bool isv = colt >= 1024; bf16* base = isv ? V : U; const int cb = (colt & 1023) + wc * 32 + 8 * fq, bcol = colt + wc * 32 + 8 * fq;
        f32x4 bv[2][2];
#pragma unroll
        for (int bj = 0; bj < 2; ++bj)
#pragma unroll
            for (int n = 0; n < 2; ++n) bv[bj][n] = *(const f32x4*)(bias + bcol + bj * 128 + 4 * n);
#pragma unroll
        for (int ai = 0; ai < 2; ++ai)
#pragma unroll
            for (int m = 0; m < 4; ++m) { const int row = row0 + ai * 128 + m * 16; bf16* rowp = base + (size_t)row * D + cb; float s = 0.f, s2 = 0.f;
#pragma unroll
                for (int bj = 0; bj < 2; ++bj) { f32x4 v0 = acc[ai][bj][m][0] + bv[bj][0], v1 = acc[ai][bj][m][1] + bv[bj][1];
                    f32x2 a = gelu_pk((f32x2){v0[0], v0[1]}), b = gelu_pk((f32x2){v0[2], v0[3]}), c = gelu_pk((f32x2){v1[0], v1[1]}), d = gelu_pk((f32x2){v1[2], v1[3]});
                    s += (a.x + a.y) + (b.x + b.y) + (c.x + c.y) + (d.x + d.y); s2 += (a.x * a.x + a.y * a.y) + (b.x * b.x + b.y * b.y) + (c.x * c.x + c.y * c.y) + (d.x * d.x + d.y * d.y);
                    *(u32x4*)(rowp + bj * 128) = pack8((f32x4){a.x, a.y, b.x, b.y}, (f32x4){c.x, c.y, d.x, d.y}); }
                if (isv) { s += __shfl_xor(s, 16); s += __shfl_xor(s, 32); s2 += __shfl_xor(s2, 16); s2 += __shfl_xor(s2, 32);
                    if (fq == 0) { unsafeAtomicAdd(vstat + 2 * row, s); unsafeAtomicAdd(vstat + 2 * row + 1, s2); } } }
    }
};
struct EpiSwiglu {
    static constexpr bool PERM = true;
    unsigned char* ACT; const LAS float* lbias;
    __device__ __forceinline__ void operator()(const f32x4 (&acc)[2][2][4][2], const pg8::Unit& u, int wr, int wc, int fr, int fq) const {
        asm volatile("" : "+v"(fr), "+v"(fq));
        const int j0 = u.pn * 128 + wc * 32 + 8 * fq; const LAS float* bb = lbias + u.idx * 256 + wc * 32 + 8 * fq;
        f32x4 bg[2], bu[2];
#pragma unroll
        for (int n = 0; n < 2; ++n) { bg[n] = *(const LAS f32x4*)(bb + 4 * n); bu[n] = *(const LAS f32x4*)(bb + 128 + 4 * n); }
#pragma unroll
        for (int ai = 0; ai < 2; ++ai)
#pragma unroll
            for (int m = 0; m < 4; ++m) { f32x4 o[2];
#pragma unroll
                for (int n = 0; n < 2; ++n) { const f32x4 g4 = acc[ai][0][m][n] * FP8_DESCALE + bg[n], u4 = acc[ai][1][m][n] * FP8_DESCALE + bu[n];
#pragma unroll
                    for (int k = 0; k < 4; ++k) { const float g = fminf(g4[k], 7.0f), up = fminf(fmaxf(u4[k], -7.0f), 7.0f); o[n][k] = (up + 1.0f) * g * sigmoidf_(g * 1.702f); } }
                u32x2 w8; w8.x = pk4_fp8(o[0][0] * FP8_AMUL, o[0][1] * FP8_AMUL, o[0][2] * FP8_AMUL, o[0][3] * FP8_AMUL); w8.y = pk4_fp8(o[1][0] * FP8_AMUL, o[1][1] * FP8_AMUL, o[1][2] * FP8_AMUL, o[1][3] * FP8_AMUL);
                *(u32x2*)(ACT + (size_t)(u.pm + ai * 128 + wr * 64 + m * 16 + fr) * D + j0) = w8; }
    }
};
struct EpiDown {
    static constexpr bool PERM = true;
    bf16* Y; const LAS float* lbias; const LAS int* meta;
    __device__ __forceinline__ void operator()(const f32x4 (&acc)[2][2][4][2], const pg8::Unit& u, int wr, int wc, int fr, int fq) const {
        asm volatile("" : "+v"(fr), "+v"(fq));
        const int c8 = u.pn * 256 + wc * 32 + 8 * fq; const LAS float* bb = lbias + u.idx * 256 + wc * 32 + 8 * fq;
#pragma unroll
        for (int bj = 0; bj < 2; ++bj) {
            f32x4 bv[2];
#pragma unroll
            for (int n = 0; n < 2; ++n) bv[n] = *(const LAS f32x4*)(bb + bj * 128 + 4 * n);
#pragma unroll
            for (int ai = 0; ai < 2; ++ai)
#pragma unroll
                for (int m = 0; m < 4; ++m) { const int r = ai * 128 + wr * 64 + m * 16 + fr; const u32x2 mg = *(const LAS u32x2*)(meta + (u.idx * 256 + r) * 2); const int aid = (int)mg.x; const float g = __uint_as_float(mg.y);
                    const u32x4 w = pack8((acc[ai][bj][m][0] * FP8_DESCALE + bv[0]) * g, (acc[ai][bj][m][1] * FP8_DESCALE + bv[1]) * g);
                    if (r < u.cnt) *(u32x4*)(Y + (size_t)aid * D + c8 + bj * 128) = w; }
        }
    }
};

struct TrItem { const float* src; bf16* dst; int N; int fp8; };
__device__ __forceinline__ void tr_load(const TrItem& t, float (&v)[32], int lane) {
#pragma unroll
    for (int i = 0; i < 32; ++i) v[i] = __builtin_nontemporal_load(t.src + (size_t)(2 * i + (lane >> 5)) * t.N + (lane & 31));
}
__device__ __forceinline__ void tr_store(const TrItem& t, const float (&v)[32], LAS float* scr, int lane) {
#pragma unroll
    for (int i = 0; i < 32; ++i) scr[(2 * i + (lane >> 5)) * 33 + (lane & 31)] = v[i];
    LDS_WAIT();
    if (t.fp8) {
        const int q = lane & 3;
#pragma unroll
        for (int j = 0; j < 2; ++j) { const int n = (lane >> 2) + 16 * j; const LAS float* s = scr + (16 * q) * 33 + n; u32x4 o;
#pragma unroll
            for (int c = 0; c < 4; ++c) o[c] = pk4_fp8(s[(4 * c) * 33] * FP8_WMUL, s[(4 * c + 1) * 33] * FP8_WMUL, s[(4 * c + 2) * 33] * FP8_WMUL, s[(4 * c + 3) * 33] * FP8_WMUL);
            *(u32x4*)((unsigned char*)t.dst + (size_t)n * 1024 + 16 * q) = o; }
    } else {
        const int c = lane & 7;
#pragma unroll
        for (int j = 0; j < 4; ++j) { const int n = (lane >> 3) + 8 * j; const LAS float* s = scr + (8 * c) * 33 + n;
            u32x4 o; o.x = pk2(s[0 * 33], s[1 * 33]); o.y = pk2(s[2 * 33], s[3 * 33]); o.z = pk2(s[4 * 33], s[5 * 33]); o.w = pk2(s[6 * 33], s[7 * 33]);
            *(u32x4*)(t.dst + (size_t)n * 1024 + 8 * c) = o; }
    }
    LDS_WAIT();
}
template <int N, bool PAIR> struct MoeCvt {
    static constexpr int STRIPS = N / 512, ITEMS_PER_MAT = 8 * STRIPS;
    static __device__ __forceinline__ void load(const float* W, int item, f32x4 (&v)[4][2][4], int wave, int lane) {
        const int mat = item / ITEMS_PER_MAT, q = item % ITEMS_PER_MAT, kb = q / STRIPS, sb = q % STRIPS;
        const float* s = W + (size_t)mat * 1024 * N + (size_t)(128 * kb + 16 * wave) * N + 512 * sb + 4 * lane;
#pragma unroll
        for (int g = 0; g < 4; ++g)
#pragma unroll
            for (int hh = 0; hh < 2; ++hh)
#pragma unroll
                for (int r = 0; r < 4; ++r) v[g][hh][r] = __builtin_nontemporal_load((const f32x4*)(s + (size_t)(4 * g + r) * N + 256 * hh));
    }
    static __device__ __forceinline__ void to_lds(const f32x4 (&v)[4][2][4], LAS unsigned* img, int wave, int lane) {
#pragma unroll
        for (int g = 0; g < 4; ++g) { const int kq = 4 * wave + g;
#pragma unroll
            for (int hh = 0; hh < 2; ++hh)
#pragma unroll
                for (int j = 0; j < 4; ++j) { const int rho = 64 * hh + lane + 128 * j;
                    img[rho * 32 + ((kq ^ rho) & 31)] = pk4_fp8(v[g][hh][0][j] * FP8_WMUL, v[g][hh][1][j] * FP8_WMUL, v[g][hh][2][j] * FP8_WMUL, v[g][hh][3][j] * FP8_WMUL); } }
    }
    static __device__ __forceinline__ void store(unsigned char* WT, int item, const LAS unsigned* img, int wave, int lane) {
        const int mat = item / ITEMS_PER_MAT, q = item % ITEMS_PER_MAT, kb = q / STRIPS, sb = q % STRIPS;
        unsigned char* d = WT + (size_t)mat * N * 1024 + 128 * kb;
        const int mi = lane >> 3, c = lane & 7;
#pragma unroll
        for (int st = 0; st < 2; ++st)
#pragma unroll
            for (int j = 0; j < 4; ++j) { const int m = 16 * wave + 8 * st + mi, rho = m + 128 * j, n = 4 * m + j;
                u32x4 o;
#pragma unroll
                for (int i = 0; i < 4; ++i) o[i] = img[rho * 32 + (((4 * c + i) ^ rho) & 31)];
                int drow;
                if (PAIR) { const int h = sb >> 1, rem = 512 * (sb & 1) + n; drow = (rem >> 7) * 256 + h * 128 + (rem & 127); } else drow = 512 * sb + n;
                __builtin_nontemporal_store(o, (u32x4*)(d + (size_t)drow * 1024 + 16 * c)); }
    }
    static __device__ __forceinline__ void run(const float* W, unsigned char* WT, int nitems, int first, int stride, LAS unsigned char* lds, int wave, int lane) {
        f32x4 v[4][2][4]; int it = first, buf = 0;
        if (it < nitems) load(W, it, v, wave, lane);
        while (it < nitems) {
            LAS unsigned* img = (LAS unsigned*)(lds + buf * 65536);
            to_lds(v, img, wave, lane);
            __syncthreads();
            const int nx = it + stride; if (nx < nitems) load(W, nx, v, wave, lane);
            store(WT, it, img, wave, lane);
            it = nx; buf ^= 1;
        }
        __syncthreads();
    }
};

__device__ __forceinline__ int pair_src(int nd, int halfw) { return ((nd & 255) >> 7) * halfw + (nd >> 8) * 128 + (nd & 127); }

__device__ __forceinline__ void phase_prologue(const Args& a, const Ctx& X) {
    PMARK(20);
    {
        LAS float* sc = (LAS float*)X.lds;
        LAS float* red = (LAS float*)(X.lds + 36864);
        float* MOD = (float*)(X.ws + WS_MOD);
        for (int item = X.bid; item < 2 * 96; item += X.G) {
            const int l = item / 96, j0 = (item % 96) * 64;
            for (int idx = X.tid; idx < 9 * 1024; idx += NTHREADS) { const int r = idx >> 10, k = idx & 1023; const float v = r < 8 ? IN(I_C)[r * 1024 + k] : IN(I_CCTX)[k]; sc[idx] = v * sigmoidf_(v); }
            __syncthreads();
            float acc[9];
#pragma unroll
            for (int r = 0; r < 9; ++r) acc[r] = 0.f;
            const float* w = IN(I_ADAW) + (size_t)l * 1024 * MODW + j0 + X.lane;
#pragma unroll 8
            for (int k = X.wave * 128; k < X.wave * 128 + 128; ++k) { const float wv = __builtin_nontemporal_load(w + (size_t)k * MODW);
#pragma unroll
                for (int r = 0; r < 9; ++r) acc[r] += sc[r * 1024 + k] * wv; }
#pragma unroll
            for (int r = 0; r < 9; ++r) red[(X.wave * 9 + r) * 64 + X.lane] = acc[r];
            __syncthreads();
            for (int t = X.tid; t < 9 * 64; t += NTHREADS) { const int r = t >> 6, cidx = t & 63; float s = 0.f;
#pragma unroll
                for (int w8 = 0; w8 < 8; ++w8) s += red[(w8 * 9 + r) * 64 + cidx];
                MOD[((size_t)l * 9 + r) * MODW + j0 + cidx] = s + IN(I_ADAB)[l * MODW + j0 + cidx]; }
            __syncthreads();
        }
    }
    PMARK(21);
    LAS float* scr = (LAS float*)(X.lds + X.wave * 16384);
    bf16* WinT = (bf16*)(X.ws + WS_WINT); bf16* WoutT = (bf16*)(X.ws + WS_WOUTT); bf16* GWinT = (bf16*)(X.ws + WS_GWINT); bf16* GWoutT = (bf16*)(X.ws + WS_GWOUTT);
    bf16* W1T = (bf16*)(X.ws + WS_W1T); bf16* W2T = (bf16*)(X.ws + WS_W2T);
    constexpr int I_IN = 16 * (EVEN_IN / 32), I_OUT = 16 * 32, I_GIN = 16 * 64, I_GOUT = 16 * 32;
    constexpr int NITEMS = I_IN + I_OUT + I_GIN + I_GOUT;
    auto item_of = [&](int it) -> TrItem {
        int r = it; TrItem t; t.fp8 = 0;
        if (r < I_IN) { const int kb = r / 56, nd = (r % 56) * 32; const int ns = nd < 1024 ? pair_src(nd, 512) : nd; t.N = EVEN_IN; t.src = IN(I_EWIN) + (size_t)kb * 64 * EVEN_IN + ns; t.dst = WinT + (size_t)nd * 1024 + kb * 64; return t; } r -= I_IN;
        if (r < I_OUT) { const int kb = r >> 5, nd = (r & 31) * 32; t.N = 1024; t.src = IN(I_EWOUT) + (size_t)kb * 64 * 1024 + nd; t.dst = WoutT + (size_t)nd * 1024 + kb * 64; return t; } r -= I_OUT;
        if (r < I_GIN) { const int kb = r >> 6, nd = (r & 63) * 32; t.N = 2048; t.src = IN(I_OWIN) + (size_t)kb * 64 * 2048 + nd; t.dst = GWinT + (size_t)nd * 1024 + kb * 64; return t; } r -= I_GIN;
        { const int kb = r >> 5, nd = (r & 31) * 32; t.N = 1024; t.src = IN(I_OWOUT) + (size_t)kb * 64 * 1024 + nd; t.dst = GWoutT + (size_t)nd * 1024 + kb * 64; return t; }
    };
    {
        float va[32], vb[32]; int it = X.gw;
        TrItem ta, tb; if (it < NITEMS) { ta = item_of(it); tr_load(ta, va, X.lane); }
        while (it < NITEMS) {
            const int it1 = it + X.NGW; if (it1 < NITEMS) { tb = item_of(it1); tr_load(tb, vb, X.lane); }
            tr_store(ta, va, scr, X.lane);
            if (it1 >= NITEMS) break;
            const int it2 = it1 + X.NGW; if (it2 < NITEMS) { ta = item_of(it2); tr_load(ta, va, X.lane); }
            tr_store(tb, vb, scr, X.lane);
            it = it2;
        }
    }
    __syncthreads();
    MoeCvt<2048, true>::run(IN(I_W1), (unsigned char*)W1T, 64 * MoeCvt<2048, true>::ITEMS_PER_MAT, X.vcu, X.G, X.lds, X.wave, X.lane);
    MoeCvt<1024, false>::run(IN(I_W2), (unsigned char*)W2T, 64 * MoeCvt<1024, false>::ITEMS_PER_MAT, X.vcu, X.G, X.lds, X.wave, X.lane);
    PMARK(22);
    { bf16* WsB = (bf16*)(X.ws + WS_WSB); const float* ws = IN(I_OWS);
      for (int i = (X.gw * 64 + X.lane) * 4; i < 8 * 128 * 128; i += X.NGW * 64 * 4) { const f32x4 v = *(const f32x4*)(ws + i); u32x2 o; o.x = pk2(v[0], v[1]); o.y = pk2(v[2], v[3]); *(u32x2*)(WsB + i) = o; } }
}

__device__ __forceinline__ void modulate_row(const float* xrow, const float* g, const float* sh, const float* sc, bf16* orow, int lane, f32x4 (&y)[4]) {
    const f32x4* xr = (const f32x4*)xrow + lane; f32x4 v[4]; float ss = 0.f;
#pragma unroll
    for (int j = 0; j < 4; ++j) { v[j] = xr[64 * j]; ss += (v[j][0] * v[j][0] + v[j][1] * v[j][1]) + (v[j][2] * v[j][2] + v[j][3] * v[j][3]); }
    const float rstd = rsqrtf(wave_sum(ss) * (1.0f / D) + EPS);
#pragma unroll
    for (int j = 0; j < 4; ++j) { const f32x4 gk = ((const f32x4*)g)[lane + 64 * j], sk = ((const f32x4*)sc)[lane + 64 * j], hk = ((const f32x4*)sh)[lane + 64 * j];
        y[j] = v[j] * rstd * gk * (1.0f + sk) + hk;
        u32x2 o; o.x = pk2(y[j][0], y[j][1]); o.y = pk2(y[j][2], y[j][3]); *((u32x2*)orow + lane + 64 * j) = o; }
}
__device__ __forceinline__ void mod0_load(const Ctx& X, int row, f32x4 (&v)[4]) {
    const float* xrow = row < NTOK ? IN(I_X) + (size_t)row * D : IN(I_CTX) + (size_t)(row - NTOK) * D;
#pragma unroll
    for (int j = 0; j < 4; ++j) v[j] = ((const f32x4*)xrow)[X.lane + 64 * j];
}
__device__ __forceinline__ void mod0_finish(const Ctx& X, int row, const f32x4 (&v)[4]) {
    const float* m = (const float*)(X.ws + WS_MOD) + (size_t)(row < NTOK ? row / SEQ : 8) * MODW; const float* g = IN(I_NMG);
    bf16* orow = row < NTOK ? (bf16*)(X.ws + WS_XA) + (size_t)row * D : (bf16*)(X.ws + WS_GM) + (size_t)(row - NTOK) * D;
    f32x4 gk[4], hk[4], sk[4]; float ss = 0.f;
#pragma unroll
    for (int j = 0; j < 4; ++j) { gk[j] = ((const f32x4*)g)[X.lane + 64 * j]; hk[j] = ((const f32x4*)m)[X.lane + 64 * j]; sk[j] = ((const f32x4*)(m + 1024))[X.lane + 64 * j];
        ss += (v[j][0] * v[j][0] + v[j][1] * v[j][1]) + (v[j][2] * v[j][2] + v[j][3] * v[j][3]); }
    const float rstd = rsqrtf(wave_sum(ss) * (1.0f / D) + EPS);
#pragma unroll
    for (int j = 0; j < 4; ++j) { const f32x4 y = v[j] * rstd * gk[j] * (1.0f + sk[j]) + hk[j]; u32x2 o; o.x = pk2(y[0], y[1]); o.y = pk2(y[2], y[3]); *((u32x2*)orow + X.lane + 64 * j) = o; }
}
__device__ __forceinline__ void phase_modulate0(const Args& a, const Ctx& X) {
    constexpr int NR = NTOK + NCTX; f32x4 va[4], vb[4];
    int row = X.gw; if (row < NR) mod0_load(X, row, va);
    while (row < NR) {
        const int r1 = row + X.NGW; if (r1 < NR) mod0_load(X, r1, vb);
        mod0_finish(X, row, va);
        if (r1 >= NR) break;
        const int r2 = r1 + X.NGW; if (r2 < NR) mod0_load(X, r2, va);
        mod0_finish(X, r1, vb);
        row = r2;
    }
}

__device__ __forceinline__ void qk_chunks(bf16* buf, int nchunks, int rowlen, const float* gn, bool rope, float oscale, const Ctx& X, const LAS f32x2* cs) {
    for (int ch = X.gw; ch < nchunks; ch += X.NGW) {
        const int e0 = ch * 512 + 8 * X.lane; const int token = e0 / rowlen; const int d0 = e0 & 63;
        u32x4 raw = *(const u32x4*)(buf + e0); float v[8];
#pragma unroll
        for (int i = 0; i < 4; ++i) { v[2 * i] = bf2f(raw[i] & 0xffffu); v[2 * i + 1] = bf2f(raw[i] >> 16); }
        float ss = 0.f;
#pragma unroll
        for (int i = 0; i < 8; ++i) ss += v[i] * v[i];
        ss += __shfl_xor(ss, 1); ss += __shfl_xor(ss, 2); ss += __shfl_xor(ss, 4);
        const float rstd = rsqrtf(ss * (1.0f / 64.0f) + EPS);
        const f32x4 g0 = *(const f32x4*)(gn + d0), g1 = *(const f32x4*)(gn + d0 + 4);
#pragma unroll
        for (int i = 0; i < 4; ++i) { v[i] = v[i] * rstd * g0[i]; v[4 + i] = v[4 + i] * rstd * g1[i]; }
        if (rope) {
            const int t = token % SEQ; const int dd0 = d0 & 31; const int pos = dd0 < 16 ? (t >> 6) : (t & 63);
            const LAS f32x2* cp = cs + pos * 16 + (dd0 & 15);
#pragma unroll
            for (int i = 0; i < 8; ++i) { const float pv = __shfl_xor(v[i], 4); const f32x2 c = cp[i];
                v[i] = (d0 < 32) ? (v[i] * c.x - pv * c.y) : (v[i] * c.x + pv * c.y); }
        }
        u32x4 o; o.x = pk2(v[0] * oscale, v[1] * oscale); o.y = pk2(v[2] * oscale, v[3] * oscale); o.z = pk2(v[4] * oscale, v[5] * oscale); o.w = pk2(v[6] * oscale, v[7] * oscale);
        *(u32x4*)(buf + e0) = o;
    }
}
__device__ __forceinline__ void phase_conv_qk(const Args& a, const Ctx& X) {
    LAS f32x2* cs = (LAS f32x2*)(X.lds + 65536);
    for (int i = X.tid; i < 1024; i += NTHREADS) { const float inv = exp2f(-(float)(i & 15) * (13.287712379549449f / 16.0f)); float sn, csn; sincosf((float)(i >> 4) * inv, &sn, &csn); cs[i] = (f32x2){csn, sn}; }
    __syncthreads();
    qk_chunks((bf16*)(X.ws + WS_Q), NTOK, 512, IN(I_QNG), true, QSCALE, X, cs);
    qk_chunks((bf16*)(X.ws + WS_K), NTOK / 4, 128, IN(I_KNG), true, 1.0f, X, cs);
    qk_chunks((bf16*)(X.ws + WS_KC), NCTX / 4, 128, IN(I_KNG), false, 1.0f, X, cs);
    const bf16* GLU = (const bf16*)(X.ws + WS_GLU); bf16* MIX = (bf16*)(X.ws + WS_MIX);
    LAS unsigned* tin = (LAS unsigned*)X.lds;
    LAS float* tout = (LAS float*)(X.lds + 65536);
    const int cp = X.tid & 255, th = X.tid >> 8;
    float w0[31], w1[31];
#pragma unroll
    for (int j = 0; j < 31; ++j) { const f32x2 w = *(const f32x2*)(IN(I_ECW) + j * 512 + 2 * cp); w0[j] = w.x; w1[j] = w.y; }
    const f32x2 cb = *(const f32x2*)(IN(I_ECB) + 2 * cp);
    for (int tile = X.bid; tile < NTOK / 32; tile += X.G) {
        const int row0 = tile * 32; const int t0 = row0 % SEQ;
        __syncthreads();
        for (int c = X.tid; c < 62 * 64; c += NTHREADS) { const int lr = c >> 6, cc = c & 63; const int t = t0 - 15 + lr;
            u32x4 v = (u32x4){0u, 0u, 0u, 0u}; if (t >= 0 && t < SEQ) v = *(const u32x4*)(GLU + (size_t)(row0 - 15 + lr) * 512 + cc * 8);
            *(LAS u32x4*)(tin + lr * 256 + cc * 4) = v; }
        __syncthreads();
        float a0[16], a1[16];
#pragma unroll
        for (int o = 0; o < 16; ++o) { a0[o] = cb.x; a1[o] = cb.y; }
#pragma unroll
        for (int rr = 0; rr < 46; ++rr) { const unsigned pv = tin[(16 * th + rr) * 256 + cp]; const float x0 = bf2f(pv & 0xffffu), x1 = bf2f(pv >> 16);
#pragma unroll
            for (int o = 0; o < 16; ++o) { const int j = rr - o; if (j >= 0 && j <= 30) { a0[o] += x0 * w0[j]; a1[o] += x1 * w1[j]; } } }
#pragma unroll
        for (int o = 0; o < 16; ++o) *(LAS f32x2*)(tout + (16 * th + o) * 512 + 2 * cp) = (f32x2){a0[o], a1[o]};
        __syncthreads();
#pragma unroll
        for (int q = 0; q < 4; ++q) { const int tl = X.wave * 4 + q; f32x4 v[2]; float s = 0.f;
#pragma unroll
            for (int j = 0; j < 2; ++j) { v[j] = *(const LAS f32x4*)(tout + tl * 512 + 4 * X.lane + 256 * j); s += (v[j][0] + v[j][1]) + (v[j][2] + v[j][3]); }
            const float mean = wave_sum(s) * (1.0f / 512.0f); float s2 = 0.f;
#pragma unroll
            for (int j = 0; j < 2; ++j) { v[j] = v[j] - mean; s2 += (v[j][0] * v[j][0] + v[j][1] * v[j][1]) + (v[j][2] * v[j][2] + v[j][3] * v[j][3]); }
            const float rstd = rsqrtf(wave_sum(s2) * (1.0f / 512.0f) + EPS);
#pragma unroll
            for (int j = 0; j < 2; ++j) { const f32x4 g = *(const f32x4*)(IN(I_ELNG) + 4 * X.lane + 256 * j), b = *(const f32x4*)(IN(I_ELNB) + 4 * X.lane + 256 * j);
                f32x4 y = v[j] * rstd * g + b;
#pragma unroll
                for (int k = 0; k < 4; ++k) y[k] = y[k] * sigmoidf_(y[k]);
                u32x2 o; o.x = pk2(y[0], y[1]); o.y = pk2(y[2], y[3]); *(u32x2*)(MIX + (size_t)(row0 + tl) * D + 4 * X.lane + 256 * j) = o; } }
    }
}

__device__ __forceinline__ void phase_attention(const Args& a, const Ctx& X) {
    unsigned char* const wsb = X.ws;
    LAS unsigned char* Ks = X.lds;
    LAS unsigned char* Vt = X.lds + 16384;
    const int lane = X.lane, l15 = lane & 15, g4 = lane >> 4;
    for (int unit = X.bid; unit < NB * 2 * 32; unit += X.G) {
        const int b = unit >> 6, kh = (unit >> 5) & 1, qb = unit & 31; const int q0 = qb * 64;
        const int hq = kh * 4 + (X.wave >> 1), tq = (X.wave & 1) * 32;
        bf16x8 Qf[2][2];
#pragma unroll
        for (int qi = 0; qi < 2; ++qi)
#pragma unroll
            for (int s = 0; s < 2; ++s) Qf[qi][s] = *(const bf16x8*)(wsb + (unsigned)(WS_Q + 2u * (unsigned)((b * SEQ + q0 + tq + 16 * qi + l15) * 512 + hq * 64 + 32 * s + 8 * g4)));
        const float sink2 = IN(I_SINK)[hq] * LOG2E;
        float mrun[2], lrun[2]; f32x4 O[2][4];
#pragma unroll
        for (int qi = 0; qi < 2; ++qi) { mrun[qi] = sink2; lrun[qi] = (g4 == 0) ? 1.0f : 0.0f;
#pragma unroll
            for (int db = 0; db < 4; ++db) O[qi][db] = (f32x4){0.f, 0.f, 0.f, 0.f}; }
        const int t_first = (q0 >= 128) ? 0 : (q0 >= 64 ? 1 : 2), t_skip_lo = (q0 + 128 < SEQ) ? 5 : (q0 + 64 < SEQ ? 4 : 3);
        const int key = X.tid >> 3, ch = X.tid & 7;
        auto tile_offs = [&](int t, unsigned& ko, unsigned& vo) {
            if (t < 5) { const unsigned e = (unsigned)((b * SEQ + q0 - 128 + 64 * t) * 128 + kh * 64) * 2u; ko = (unsigned)WS_K + e; vo = (unsigned)WS_V + e; }
            else { const unsigned e = (unsigned)((b * CTXL + (t - 5) * 64) * 128 + kh * 64) * 2u; ko = (unsigned)WS_KC + e; vo = (unsigned)WS_VC + e; } };
        const unsigned lane_off = (unsigned)(key * 128 + ch * 8) * 2u;
        auto lds_put = [&](int buf, const u32x4& kv, const u32x4& vv) {
            LAS unsigned char* Kd = Ks + buf * 32768; LAS unsigned char* Vd = Vt + buf * 32768;
            *(LAS u32x4*)(Kd + key * 144 + ch * 16) = kv;
#pragma unroll
            for (int i = 0; i < 4; ++i) { *(LAS unsigned short*)(Vd + (8 * ch + 2 * i) * 136 + key * 2) = (unsigned short)(vv[i] & 0xffffu); *(LAS unsigned short*)(Vd + (8 * ch + 2 * i + 1) * 136 + key * 2) = (unsigned short)(vv[i] >> 16); } };
        u32x4 kreg, vreg;
        { unsigned ko, vo; tile_offs(t_first, ko, vo); kreg = *(const u32x4*)(wsb + (ko + lane_off)); vreg = *(const u32x4*)(wsb + (vo + lane_off)); }
        __syncthreads();
        lds_put(0, kreg, vreg);
        int bufi = 0;
        for (int t = t_first; t < 9; ++t) {
            if (t >= t_skip_lo && t < 5) continue;
            int tn = t + 1; if (tn >= t_skip_lo && tn < 5) tn = 5;
            if (tn < 9) { unsigned ko, vo; tile_offs(tn, ko, vo); kreg = *(const u32x4*)(wsb + (ko + lane_off)); vreg = *(const u32x4*)(wsb + (vo + lane_off)); }
            const int mode = (t == 0) ? 1 : (t == 4 ? 2 : 0);
            __syncthreads();
            const LAS unsigned char* Kc = Ks + bufi * 32768; const LAS unsigned char* Vc = Vt + bufi * 32768;
            bf16x8 kf[4][2];
#pragma unroll
            for (int kb = 0; kb < 4; ++kb)
#pragma unroll
                for (int s = 0; s < 2; ++s) kf[kb][s] = *(const LAS bf16x8*)(Kc + (16 * kb + l15) * 144 + (32 * s + 8 * g4) * 2);
            bf16x8 vf[4][2];
#pragma unroll
            for (int db = 0; db < 4; ++db)
#pragma unroll
                for (int ks2 = 0; ks2 < 2; ++ks2) { const LAS unsigned char* p = Vc + (16 * db + l15) * 136 + (32 * ks2 + 4 * g4) * 2;
                    const u32x2 lo = *(const LAS u32x2*)p, hi = *(const LAS u32x2*)(p + 32);
                    u32x4 w; w.x = lo.x; w.y = lo.y; w.z = hi.x; w.w = hi.y; vf[db][ks2] = __builtin_bit_cast(bf16x8, w); }
#pragma unroll
            for (int qi = 0; qi < 2; ++qi) {
                f32x4 st[4];
#pragma unroll
                for (int kb = 0; kb < 4; ++kb) { st[kb] = (f32x4){0.f, 0.f, 0.f, 0.f};
#pragma unroll
                    for (int s = 0; s < 2; ++s) st[kb] = __builtin_amdgcn_mfma_f32_16x16x32_bf16(kf[kb][s], Qf[qi][s], st[kb], 0, 0, 0); }
                if (mode) { int qloc = tq + 16 * qi + l15; asm volatile("" : "+v"(qloc));
#pragma unroll
                    for (int kb = 0; kb < 4; ++kb)
#pragma unroll
                        for (int r = 0; r < 4; ++r) { const int kk = 16 * kb + 4 * g4 + r; const bool keep = (mode == 1) ? (kk >= qloc) : (kk <= qloc); if (!keep) st[kb][r] = -1e30f; } }
                float mx = st[0][0];
#pragma unroll
                for (int kb = 0; kb < 4; ++kb)
#pragma unroll
                    for (int r = 0; r < 4; ++r) mx = fmaxf(mx, st[kb][r]);
                mx = fmaxf(mx, __shfl_xor(mx, 16)); mx = fmaxf(mx, __shfl_xor(mx, 32));
                const float mnew = fmaxf(mrun[qi], mx); const float alpha = __builtin_amdgcn_exp2f(mrun[qi] - mnew); mrun[qi] = mnew;
                float ps = 0.f;
#pragma unroll
                for (int kb = 0; kb < 4; ++kb)
#pragma unroll
                    for (int r = 0; r < 4; ++r) { st[kb][r] = __builtin_amdgcn_exp2f(st[kb][r] - mnew); ps += st[kb][r]; }
                lrun[qi] = lrun[qi] * alpha + ps;
#pragma unroll
                for (int db = 0; db < 4; ++db) O[qi][db] = O[qi][db] * alpha;
#pragma unroll
                for (int ks2 = 0; ks2 < 2; ++ks2) { u32x4 w; w.x = pk2(st[2 * ks2][0], st[2 * ks2][1]); w.y = pk2(st[2 * ks2][2], st[2 * ks2][3]); w.z = pk2(st[2 * ks2 + 1][0], st[2 * ks2 + 1][1]); w.w = pk2(st[2 * ks2 + 1][2], st[2 * ks2 + 1][3]);
                    const bf16x8 pf = __builtin_bit_cast(bf16x8, w);
#pragma unroll
                    for (int db = 0; db < 4; ++db) O[qi][db] = __builtin_amdgcn_mfma_f32_16x16x32_bf16(vf[db][ks2], pf, O[qi][db], 0, 0, 0); }
            }
            if (tn < 9) lds_put(bufi ^ 1, kreg, vreg);
            bufi ^= 1;
        }
#pragma unroll
        for (int qi = 0; qi < 2; ++qi) { float l = lrun[qi]; l += __shfl_xor(l, 16); l += __shfl_xor(l, 32); const float inv = 1.0f / l;
            bf16* orow = (bf16*)(wsb + (unsigned)(WS_MIX + 2u * (unsigned)((b * SEQ + q0 + tq + 16 * qi + l15) * D + 512 + hq * 64 + 4 * g4)));
#pragma unroll
            for (int db = 0; db < 4; ++db) { u32x2 o; o.x = pk2(O[qi][db][0] * inv, O[qi][db][1] * inv); o.y = pk2(O[qi][db][2] * inv, O[qi][db][3] * inv); *(u32x2*)(orow + 16 * db) = o; } }
    }
}

__device__ __forceinline__ void phase_router(const Args& a, const Ctx& X, int layer) {
    const bf16* __restrict__ H = (const bf16*)(X.ws + WS_H); unsigned char* XA8 = (unsigned char*)(X.ws + WS_XA8);
    const float* MODl = (const float*)(X.ws + WS_MOD) + (size_t)layer * 9 * MODW; const float* gn = IN(I_NFG) + layer * D;
    const float* rw = IN(I_RW) + (size_t)layer * D * NE; const float* rb = IN(I_RB) + layer * NE;
    int* cntg = (int*)(X.ws + WS_CTL) + CW_CNT + layer * NE * CNT_STRIDE; int* list = (int*)(X.ws + WS_LIST); float* gatew = (float*)(X.ws + WS_GATE);
    LAS float* ybuf = (LAS float*)X.lds;
    LAS float* part = (LAS float*)(X.lds + 65536);
    LAS int* sel = (LAS int*)(X.lds + 65536 + 16384);
    LAS int* lcnt = (LAS int*)(X.lds + 65536 + 16384 + 1024);
    LAS float* lgs = (LAS float*)(X.lds + 65536 + 16384 + 2048);
    LAS float* tvs = lgs + 512;
    LAS float* exs = lgs + 528;
    PMARK(0);
    const int e = X.lane & 31, hf = X.lane >> 5;
    float wreg[64];
#pragma unroll
    for (int i = 0; i < 64; ++i) wreg[i] = rw[(size_t)(128 * X.wave + 64 * hf + i) * NE + e];
    const float rbe = rb[e];
    for (int blk = X.bid; blk < NTOK / 64; blk += X.G) {
        const int rowbase = blk * 64; const float* m = MODl + (size_t)(rowbase / SEQ) * MODW;
        f32x4 gk[4], hk[4], xv[2][4];
#pragma unroll
        for (int j = 0; j < 4; ++j) { gk[j] = ((const f32x4*)gn)[X.lane + 64 * j]; hk[j] = ((const f32x4*)(m + 3 * 1024))[X.lane + 64 * j]; const f32x4 s_ = ((const f32x4*)(m + 4 * 1024))[X.lane + 64 * j]; gk[j] = gk[j] * (1.0f + s_); }
#pragma unroll
        for (int i = 0; i < 2; ++i)
#pragma unroll
            for (int j = 0; j < 4; ++j) { const u32x2 w = ((const u32x2*)(H + (size_t)(rowbase + 2 * X.wave + i) * D))[X.lane + 64 * j]; xv[i][j] = (f32x4){bf2f(w.x & 0xffffu), bf2f(w.x >> 16), bf2f(w.y & 0xffffu), bf2f(w.y >> 16)}; }
        __syncthreads();
        if (X.tid < 64) lcnt[X.tid] = 0;
        PMARK(1);
#pragma unroll 1
        for (int bt = 0; bt < 4; ++bt) {
#pragma unroll
            for (int i = 0; i < 2; ++i) { const int rl = 2 * X.wave + i, row = rowbase + 16 * bt + rl; float ss = 0.f;
#pragma unroll
                for (int j = 0; j < 4; ++j) ss += (xv[i][j][0] * xv[i][j][0] + xv[i][j][1] * xv[i][j][1]) + (xv[i][j][2] * xv[i][j][2] + xv[i][j][3] * xv[i][j][3]);
                const float rstd = rsqrtf(wave_sum(ss) * (1.0f / D) + EPS);
#pragma unroll
                for (int j = 0; j < 4; ++j) { const f32x4 y = xv[i][j] * rstd * gk[j] + hk[j];
                    *((unsigned*)(XA8 + (size_t)row * D) + X.lane + 64 * j) = pk4_fp8(y[0] * FP8_AMUL, y[1] * FP8_AMUL, y[2] * FP8_AMUL, y[3] * FP8_AMUL);
                    *(LAS f32x4*)(ybuf + rl * 1024 + 4 * X.lane + 256 * j) = y; } }
            if (bt < 3) {
#pragma unroll
                for (int i = 0; i < 2; ++i)
#pragma unroll
                    for (int j = 0; j < 4; ++j) { const u32x2 w = ((const u32x2*)(H + (size_t)(rowbase + 16 * (bt + 1) + 2 * X.wave + i) * D))[X.lane + 64 * j]; xv[i][j] = (f32x4){bf2f(w.x & 0xffffu), bf2f(w.x >> 16), bf2f(w.y & 0xffffu), bf2f(w.y >> 16)}; }
            }
            __syncthreads();
#pragma unroll 2
            for (int r = 0; r < 16; ++r) { float acc[4] = {0.f, 0.f, 0.f, 0.f}; const LAS float* yp = ybuf + r * 1024 + 128 * X.wave + 64 * hf;
#pragma unroll
                for (int i4 = 0; i4 < 16; ++i4) { const f32x4 yv = *(const LAS f32x4*)(yp + 4 * i4);
                    acc[i4 & 3] += yv[0] * wreg[4 * i4] + yv[1] * wreg[4 * i4 + 1] + yv[2] * wreg[4 * i4 + 2] + yv[3] * wreg[4 * i4 + 3]; }
                const float t0 = (acc[0] + acc[1]) + (acc[2] + acc[3]); const float t = t0 + dpp_swap32(t0);
                if (hf == 0) part[(r * 8 + X.wave) * 32 + e] = t; }
            __syncthreads();
            { const int r = 2 * X.wave + hf, rl = 16 * bt + r;
              float v = rbe;
#pragma unroll
              for (int w8 = 0; w8 < 8; ++w8) v += part[(r * 8 + w8) * 32 + e];
              lgs[r * 32 + e] = v; LDS_WAIT();
              int ez = e; asm volatile("" : "+v"(ez));
              int rank = 0;
#pragma unroll
              for (int j4 = 0; j4 < 8; ++j4) { const f32x4 o = *(const LAS f32x4*)(lgs + r * 32 + 4 * j4);
#pragma unroll
                  for (int c = 0; c < 4; ++c) rank += (o[c] > v || (o[c] == v && (4 * j4 + c) < ez)) ? 1 : 0; }
              if (rank == 0) tvs[r] = v;
              LDS_WAIT();
              const float ex = __expf(v - tvs[r]);
              if (rank < 4) exs[r * 4 + rank] = ex;
              LDS_WAIT();
              const f32x4 e4 = *(const LAS f32x4*)(exs + r * 4); const float inv = 1.0f / ((e4[0] + e4[1]) + (e4[2] + e4[3]));
              if (rank < 4) { const int slot = atomicAdd((int*)&lcnt[e], 1); sel[rl * 4 + rank] = (e << 16) | slot; gatew[(size_t)(rowbase + rl) * 4 + rank] = ex * inv; } }
        }
        __syncthreads();
        PMARK(2);
        if (X.tid < 32) lcnt[32 + X.tid] = atomicAdd(cntg + X.tid * CNT_STRIDE, lcnt[X.tid]);
        __syncthreads();
        if (X.tid < 256) { const int w = sel[X.tid]; const int ee = w >> 16, rank = w & 0xffff; list[(size_t)ee * NTOK + lcnt[32 + ee] + rank] = rowbase * 4 + X.tid; }
    }
    PMARK(3);
}

__device__ __forceinline__ void phase_combine(const Args& a, const Ctx& X, int layer) {
    bf16* H = (bf16*)(X.ws + WS_H); const bf16* __restrict__ Y = (const bf16*)(X.ws + WS_Y); bf16* XA = (bf16*)(X.ws + WS_XA);
    const float* __restrict__ MODl = (const float*)(X.ws + WS_MOD) + (size_t)layer * 9 * MODW;
    float* outp = (float*)(__attribute__((address_space(1))) float*)X.kp[33];
    for (int row = X.gw; row < NTOK; row += X.NGW) {
        const float* gt = MODl + (size_t)(row / SEQ) * MODW + 5 * 1024; f32x4 h[2][2], g[2][2]; u32x4 yw[2][4];
#pragma unroll
        for (int j = 0; j < 2; ++j) { const int c0 = 8 * X.lane + 512 * j;
#pragma unroll
            for (int q = 0; q < 2; ++q) g[j][q] = *(const f32x4*)(gt + c0 + 4 * q);
            { const u32x4 w = *(const u32x4*)(H + (size_t)row * D + c0); h[j][0] = (f32x4){bf2f(w.x & 0xffffu), bf2f(w.x >> 16), bf2f(w.y & 0xffffu), bf2f(w.y >> 16)}; h[j][1] = (f32x4){bf2f(w.z & 0xffffu), bf2f(w.z >> 16), bf2f(w.w & 0xffffu), bf2f(w.w >> 16)}; }
#pragma unroll
            for (int k = 0; k < 4; ++k) yw[j][k] = *(const u32x4*)(Y + ((size_t)row * 4 + k) * D + c0); }
        float ss = 0.f;
#pragma unroll
        for (int j = 0; j < 2; ++j) { f32x4 s0 = (f32x4){0.f, 0.f, 0.f, 0.f}, s1 = s0;
#pragma unroll
            for (int k = 0; k < 4; ++k) { const u32x4 w = yw[j][k]; s0 += (f32x4){bf2f(w.x & 0xffffu), bf2f(w.x >> 16), bf2f(w.y & 0xffffu), bf2f(w.y >> 16)}; s1 += (f32x4){bf2f(w.z & 0xffffu), bf2f(w.z >> 16), bf2f(w.w & 0xffffu), bf2f(w.w >> 16)}; }
            h[j][0] = h[j][0] + g[j][0] * s0; h[j][1] = h[j][1] + g[j][1] * s1;
#pragma unroll
            for (int q = 0; q < 2; ++q) ss += (h[j][q][0] * h[j][q][0] + h[j][q][1] * h[j][q][1]) + (h[j][q][2] * h[j][q][2] + h[j][q][3] * h[j][q][3]); }
        if (layer == 1) {
#pragma unroll
            for (int j = 0; j < 2; ++j)
#pragma unroll
                for (int q = 0; q < 2; ++q) *(f32x4*)(outp + (size_t)row * D + 8 * X.lane + 512 * j + 4 * q) = h[j][q];
        } else {
            const float* m1 = (const float*)(X.ws + WS_MOD) + (size_t)9 * MODW + (size_t)(row / SEQ) * MODW; const float* gn = IN(I_NMG) + D;
            f32x4 gk[2][2], hk[2][2], sk[2][2];
#pragma unroll
            for (int j = 0; j < 2; ++j)
#pragma unroll
                for (int q = 0; q < 2; ++q) { const int c0 = 8 * X.lane + 512 * j + 4 * q; gk[j][q] = *(const f32x4*)(gn + c0); hk[j][q] = *(const f32x4*)(m1 + c0); sk[j][q] = *(const f32x4*)(m1 + 1024 + c0); }
            const float rstd = rsqrtf(wave_sum(ss) * (1.0f / D) + EPS);
#pragma unroll
            for (int j = 0; j < 2; ++j) { const int c0 = 8 * X.lane + 512 * j;
                const f32x4 y0 = h[j][0] * rstd * gk[j][0] * (1.0f + sk[j][0]) + hk[j][0], y1 = h[j][1] * rstd * gk[j][1] * (1.0f + sk[j][1]) + hk[j][1];
                *(u32x4*)(H + (size_t)row * D + c0) = pack8(h[j][0], h[j][1]);
                *(u32x4*)(XA + (size_t)row * D + c0) = pack8(y0, y1); }
        }
    }
}

__device__ __forceinline__ void phase_spatial(const Args& a, const Ctx& X) {
    const bf16* U = (const bf16*)(X.ws + WS_U); const bf16* VB = (const bf16*)(X.ws + WS_VB); bf16* SG = (bf16*)(X.ws + WS_MIX); const bf16* WsB = (const bf16*)(X.ws + WS_WSB); const float* vstat = (const float*)(X.ws + WS_CTL) + CW_VSTAT;
    LAS float* stat = (LAS float*)X.lds;
    LAS unsigned char* Vt = X.lds + 4096;
    const int lane = X.lane, l15 = lane & 15, g4 = lane >> 4;
    for (int item = X.bid; item < 128 * 8; item += X.G) {
        const int chunk = item >> 3, g = item & 7; const int row0 = chunk * 128;
        __syncthreads();
        if (X.tid < 128) { const f32x2 sv = *(const f32x2*)(vstat + 2 * (row0 + X.tid)); const float mean = sv.x * (1.0f / D); const float var = fmaxf(sv.y * (1.0f / D) - mean * mean, 0.f);
            stat[2 * X.tid] = mean; stat[2 * X.tid + 1] = rsqrtf(var + EPS); }
        __syncthreads();
#pragma unroll
        for (int c = X.tid; c < 128 * 16; c += NTHREADS) { const int q = c >> 4, cc = c & 15; const u32x4 w = *(const u32x4*)(VB + (size_t)(row0 + q) * D + g * 128 + cc * 8);
            const float mean = stat[2 * q], rstd = stat[2 * q + 1]; const float* lg_ = IN(I_OLNG) + g * 128 + cc * 8; const float* lb_ = IN(I_OLNB) + g * 128 + cc * 8;
#pragma unroll
            for (int k = 0; k < 4; ++k) { const float y0 = (bf2f(w[k] & 0xffffu) - mean) * rstd * lg_[2 * k] + lb_[2 * k], y1 = (bf2f(w[k] >> 16) - mean) * rstd * lg_[2 * k + 1] + lb_[2 * k + 1];
                const unsigned pk = pk2(y0, y1);
                *(LAS unsigned short*)(Vt + ((2 * k) * 17 + cc) * 272 + q * 2) = (unsigned short)(pk & 0xffffu); *(LAS unsigned short*)(Vt + ((2 * k + 1) * 17 + cc) * 272 + q * 2) = (unsigned short)(pk >> 16); } }
        __syncthreads();
        f32x4 acc[8];
#pragma unroll
        for (int pb = 0; pb < 8; ++pb) acc[pb] = (f32x4){0.f, 0.f, 0.f, 0.f};
#pragma unroll
        for (int s = 0; s < 4; ++s) { const bf16x8 af = *(const LAS bf16x8*)(Vt + ((l15 & 7) * 17 + 2 * X.wave + (l15 >> 3)) * 272 + (32 * s + 8 * g4) * 2);
#pragma unroll
            for (int pb = 0; pb < 8; ++pb) { const bf16x8 bfr = *(const bf16x8*)(WsB + ((size_t)g * 128 + 16 * pb + l15) * 128 + 32 * s + 8 * g4); acc[pb] = __builtin_amdgcn_mfma_f32_16x16x32_bf16(af, bfr, acc[pb], 0, 0, 0); } }
#pragma unroll
        for (int pb = 0; pb < 8; ++pb) { const int p = 16 * pb + l15; const float bs = IN(I_OBS)[g * 128 + p]; const size_t off = (size_t)(row0 + p) * D + g * 128 + 16 * X.wave + 4 * g4;
            const u32x2 uw = *(const u32x2*)(U + off);
            u32x2 o; o.x = pk2(bf2f(uw.x & 0xffffu) * (acc[pb][0] + bs), bf2f(uw.x >> 16) * (acc[pb][1] + bs)); o.y = pk2(bf2f(uw.y & 0xffffu) * (acc[pb][2] + bs), bf2f(uw.y >> 16) * (acc[pb][3] + bs));
            *(u32x2*)(SG + off) = o; }
    }
}

enum { PH_PRO = 0, PH_MOD0, PH_GIN, PH_CONV, PH_ATT, PH_GOUT, PH_RT0, PH_M1_0, PH_M2_0, PH_CMB0, PH_GMI, PH_SPA, PH_GMO, PH_RT1, PH_M1_1, PH_M2_1, PH_CMB1, NPHASE };

__global__ void __launch_bounds__(NTHREADS, 2) mega(Args a) {
    extern __shared__ __attribute__((aligned(16))) unsigned char lds_raw[];
    Ctx X; X.lds = (LAS unsigned char*)lds_raw;
    const int wave0 = __builtin_amdgcn_readfirstlane((int)threadIdx.x >> 6);
    const int G0 = gridDim.x, bid0 = blockIdx.x; const int vcu0 = (G0 % 8 == 0) ? (bid0 % 8) * (G0 / 8) + bid0 / 8 : bid0;
    X.wave = wave0;
    volatile LAS unsigned* MISC = (volatile LAS unsigned*)(X.lds + MISC_OFF);
    if (threadIdx.x < 64) MISC[threadIdx.x] = 0u;
    __syncthreads();
    XcdBarrier bar = xcd_barrier_post((unsigned*)(a.ws + WS_CTL) + CW_BAR + a.li * XCD_BAR_WORDS, MISC + 8);
    const int ph_lo = a.ph_lo, ph_hi = a.ph_hi;
#if PROBE_PH >= 0
#define PROBE_STAMP(p) do { if ((p) == PROBE_PH) pr_t0 = __builtin_amdgcn_s_memrealtime(); if ((p) == PROBE_END) pr_t1 = __builtin_amdgcn_s_memrealtime(); } while (0)
#else
#define PROBE_STAMP(p) do { } while (0)
#endif
#define PH_ENTER() int z; asm volatile("s_mov_b32 %0, 0" : "=s"(z)); \
        X.lane = (int)__builtin_amdgcn_mbcnt_hi(~0u, __builtin_amdgcn_mbcnt_lo(~0u, (unsigned)z)); X.tid = wave0 * 64 + X.lane; \
        X.G = G0 + z; X.vcu = vcu0 + z; X.bid = bid0 + z; X.NGW = X.G * NWAVES; X.gw = X.vcu * NWAVES + wave0; \
        { kargp_t kp = (kargp_t)__builtin_amdgcn_kernarg_segment_ptr(); asm volatile("" : "+s"(kp)); X.kp = kp; } \
        unsigned char* ws = (unsigned char*)(__attribute__((address_space(1))) unsigned char*)X.kp[34] + z; X.ws = ws;
#if PROBE_PH >= 0
    unsigned long long pr_t0 = 0, pr_t1 = 0;
#endif
#define PH_RUN(PHK, ...) if (ph_lo <= (PHK) && (PHK) < ph_hi) { const int ph = (PHK); \
        if (ph != ph_lo) { const int l0 = (int)__builtin_amdgcn_mbcnt_hi(~0u, __builtin_amdgcn_mbcnt_lo(~0u, 0u)); xcd_barrier(bar, wave0 * 64 + l0); } \
        PROBE_STAMP(ph); __VA_ARGS__ }
    PH_RUN(PH_PRO, { PH_ENTER(); phase_prologue(a, X); })
    PH_RUN(PH_MOD0, { PH_ENTER(); phase_modulate0(a, X); })
    PH_RUN(PH_GIN, { PH_ENTER(); DenseSched S; S.init((const bf16*)(ws + WS_XA), (const bf16*)(ws + WS_WINT), NTOK, EVEN_IN, X.G, X.bid);
            S.A2 = (const bf16*)(ws + WS_GM); S.Bt2 = (const bf16*)(ws + WS_WINT) + (size_t)KV_COL * D; S.nM2 = NCTX / 256;
            EpiIn E{(bf16*)(ws + WS_GLU), (bf16*)(ws + WS_Q), (bf16*)(ws + WS_K), (bf16*)(ws + WS_V), (bf16*)(ws + WS_KC), (bf16*)(ws + WS_VC), IN(I_EBIN)};
            pg8::gemm_phase<EpiIn, DenseSched>(X.lds, S, E, X.tid); })
    PH_RUN(PH_CONV, { PH_ENTER(); phase_conv_qk(a, X); })
    PH_RUN(PH_ATT, { PH_ENTER(); phase_attention(a, X); })
    PH_RUN(PH_GOUT, { PH_ENTER(); DenseSched S; S.init((const bf16*)(ws + WS_MIX), (const bf16*)(ws + WS_WOUTT), NTOK, D, X.G, X.bid);
            EpiRes<true> E{IN(I_X), (bf16*)(ws + WS_H), IN(I_EBOUT), (const float*)(ws + WS_MOD) + 2 * 1024};
            pg8::gemm_phase<EpiRes<true>, DenseSched>(X.lds, S, E, X.tid); })
    PH_RUN(PH_RT0, { PH_ENTER(); phase_router(a, X, 0); })
    PH_RUN(PH_M1_0, { PH_ENTER(); const int l = (ph == PH_M1_1); moe_build_table(X, (const int*)(ws + WS_CTL) + CW_CNT + l * NE * CNT_STRIDE);
            MoeSchedT<true, 8> S; S.tab = (const LAS int*)(X.lds + TAB_OFF); S.G = X.G; S.c = X.vcu; S.A = (const unsigned char*)(ws + WS_XA8); S.Bt = (const unsigned char*)(ws + WS_W1T) + (size_t)l * NE * 2048 * 1024; S.list = (const int*)(ws + WS_LIST); S.meta = (const LAS int*)(X.lds + META_OFF);
            moe_stage_meta<false>(X, S, S.list, (const float*)nullptr, (LAS int*)(X.lds + META_OFF), IN(I_B1) + (size_t)l * NE * 2048, (LAS float*)(X.lds + BIAS_OFF));
            EpiSwiglu E{(unsigned char*)(ws + WS_ACT), (const LAS float*)(X.lds + BIAS_OFF)};
            pg8::gemm_phase<EpiSwiglu, MoeSchedT<true, 8>>(X.lds, S, E, X.tid); })
    PH_RUN(PH_M2_0, { PH_ENTER(); const int l = (ph == PH_M2_1); moe_build_table(X, (const int*)(ws + WS_CTL) + CW_CNT + l * NE * CNT_STRIDE);
            MoeSchedT<false, 4> S; S.tab = (const LAS int*)(X.lds + TAB_OFF); S.G = X.G; S.c = X.vcu; S.A = (const unsigned char*)(ws + WS_ACT); S.Bt = (const unsigned char*)(ws + WS_W2T) + (size_t)l * NE * 1024 * 1024; S.list = (const int*)(ws + WS_LIST); S.meta = (const LAS int*)(X.lds + META_OFF);
            moe_stage_meta<true>(X, S, S.list, (const float*)(ws + WS_GATE), (LAS int*)(X.lds + META_OFF), IN(I_B2) + (size_t)l * NE * D, (LAS float*)(X.lds + BIAS_OFF));
            EpiDown E{(bf16*)(ws + WS_Y), (const LAS float*)(X.lds + BIAS_OFF), (const LAS int*)(X.lds + META_OFF)};
            pg8::gemm_phase<EpiDown, MoeSchedT<false, 4>>(X.lds, S, E, X.tid); })
    PH_RUN(PH_CMB0, { PH_ENTER(); phase_combine(a, X, 0); })
    PH_RUN(PH_GMI, { PH_ENTER(); DenseSched S; S.init((const bf16*)(ws + WS_XA), (const bf16*)(ws + WS_GWINT), NTOK, 2048, X.G, X.bid);
            EpiGelu E{(bf16*)(ws + WS_U), (bf16*)(ws + WS_VB), IN(I_OBIN), (float*)(ws + WS_CTL) + CW_VSTAT};
            pg8::gemm_phase<EpiGelu, DenseSched>(X.lds, S, E, X.tid); })
    PH_RUN(PH_SPA, { PH_ENTER(); phase_spatial(a, X); })
    PH_RUN(PH_GMO, { PH_ENTER(); DenseSched S; S.init((const bf16*)(ws + WS_MIX), (const bf16*)(ws + WS_GWOUTT), NTOK, D, X.G, X.bid);
            EpiRes<false> E{(const bf16*)(ws + WS_H), (bf16*)(ws + WS_H), IN(I_OBOUT), (const float*)(ws + WS_MOD) + (size_t)9 * MODW + 2 * 1024};
            pg8::gemm_phase<EpiRes<false>, DenseSched>(X.lds, S, E, X.tid); })
    PH_RUN(PH_RT1, { PH_ENTER(); phase_router(a, X, 1); })
    PH_RUN(PH_M1_1, { PH_ENTER(); PMARK(50); const int l = (ph == PH_M1_1); moe_build_table(X, (const int*)(ws + WS_CTL) + CW_CNT + l * NE * CNT_STRIDE);
            MoeSchedT<true, 8> S; S.tab = (const LAS int*)(X.lds + TAB_OFF); S.G = X.G; S.c = X.vcu; S.A = (const unsigned char*)(ws + WS_XA8); S.Bt = (const unsigned char*)(ws + WS_W1T) + (size_t)l * NE * 2048 * 1024; S.list = (const int*)(ws + WS_LIST); S.meta = (const LAS int*)(X.lds + META_OFF);
            moe_stage_meta<false>(X, S, S.list, (const float*)nullptr, (LAS int*)(X.lds + META_OFF), IN(I_B1) + (size_t)l * NE * 2048, (LAS float*)(X.lds + BIAS_OFF));
            PMARK(51); EpiSwiglu E{(unsigned char*)(ws + WS_ACT), (const LAS float*)(X.lds + BIAS_OFF)};
            pg8::gemm_phase<EpiSwiglu, MoeSchedT<true, 8>>(X.lds, S, E, X.tid); PMARK(53); })
    PH_RUN(PH_M2_1, { PH_ENTER(); PMARK(54); const int l = (ph == PH_M2_1); moe_build_table(X, (const int*)(ws + WS_CTL) + CW_CNT + l * NE * CNT_STRIDE);
            MoeSchedT<false, 4> S; S.tab = (const LAS int*)(X.lds + TAB_OFF); S.G = X.G; S.c = X.vcu; S.A = (const unsigned char*)(ws + WS_ACT); S.Bt = (const unsigned char*)(ws + WS_W2T) + (size_t)l * NE * 1024 * 1024; S.list = (const int*)(ws + WS_LIST); S.meta = (const LAS int*)(X.lds + META_OFF);
            moe_stage_meta<true>(X, S, S.list, (const float*)(ws + WS_GATE), (LAS int*)(X.lds + META_OFF), IN(I_B2) + (size_t)l * NE * D, (LAS float*)(X.lds + BIAS_OFF));
            EpiDown E{(bf16*)(ws + WS_Y), (const LAS float*)(X.lds + BIAS_OFF), (const LAS int*)(X.lds + META_OFF)};
            pg8::gemm_phase<EpiDown, MoeSchedT<false, 4>>(X.lds, S, E, X.tid); })
    PH_RUN(PH_CMB1, { PH_ENTER(); phase_combine(a, X, 1); })
#if PROBE_PH == -2
    if (blockIdx.x == 0 && threadIdx.x == 0) { volatile LAS unsigned long long* pm_ = (volatile LAS unsigned long long*)(X.lds + MISC_OFF + 128); const unsigned long long te = __builtin_amdgcn_s_memrealtime(); const unsigned long long span = (pm_[1] - pm_[0]) * PROBE_MULT;
        while (__builtin_amdgcn_s_memrealtime() - te < span) __builtin_amdgcn_s_sleep(8); }
#endif
#if PROBE_PH >= 0
    if (pr_t1 == 0) pr_t1 = __builtin_amdgcn_s_memrealtime();
    if (blockIdx.x == 0 && wave0 == 0) { const unsigned long long te = __builtin_amdgcn_s_memrealtime(); const unsigned long long span = (pr_t1 - pr_t0) * PROBE_MULT;
        while (__builtin_amdgcn_s_memrealtime() - te < span) __builtin_amdgcn_s_sleep(8); }
#endif
}

__device__ __forceinline__ bool find_expert(const int* cnt, int s, int& e, int& slot) {
    int pb = 0;
    for (int i = 0; i < NE; ++i) { const int c = cnt[i * CNT_STRIDE]; const int pr = ((c + 255) >> 8) << 8; if (s < pb + pr) { e = i; slot = s - pb; return true; } pb += pr; }
    return false;
}
__global__ void __launch_bounds__(256) slow_gemm(const bf16* A, const int* arow, const bf16* Bt, float* C, int N, const int* cnt, size_t bstride) {
    __shared__ float As[16][65], Bs[16][65];
    const int tx = threadIdx.x & 15, ty = threadIdx.x >> 4; const int m0 = blockIdx.y * 64, n0 = blockIdx.x * 64;
    if (cnt) { int e, slot; if (!find_expert(cnt, m0, e, slot)) return; Bt += (size_t)e * bstride; }
    float acc[4][4];
    for (int i = 0; i < 4; ++i) for (int j = 0; j < 4; ++j) acc[i][j] = 0.f;
    for (int k0 = 0; k0 < 1024; k0 += 16) {
        for (int i = 0; i < 4; ++i) { const int idx = threadIdx.x + 256 * i; const int r = idx >> 4, kk = idx & 15; const int gm = m0 + r; const int ar = arow ? arow[gm] : gm;
            As[kk][r] = bf2f(A[(size_t)ar * 1024 + k0 + kk]); Bs[kk][r] = bf2f(Bt[(size_t)(n0 + r) * 1024 + k0 + kk]); }
        __syncthreads();
        for (int kk = 0; kk < 16; ++kk) { float av[4], bv[4];
            for (int i = 0; i < 4; ++i) { av[i] = As[kk][ty * 4 + i]; bv[i] = Bs[kk][tx * 4 + i]; }
            for (int i = 0; i < 4; ++i) for (int j = 0; j < 4; ++j) acc[i][j] += av[i] * bv[j]; }
        __syncthreads();
    }
    for (int i = 0; i < 4; ++i) for (int j = 0; j < 4; ++j) C[(size_t)(m0 + ty * 4 + i) * N + n0 + tx * 4 + j] = acc[i][j];
}
__device__ __forceinline__ unsigned short f2bf_s(float f) { return (unsigned short)(pk2(f, 0.f) & 0xffffu); }
__global__ void slow_epi_in(const float* C, const float* C2, const float* bias, bf16* GLU, bf16* Q, bf16* Kb, bf16* Vb, bf16* KC, bf16* VC) {
    const size_t i = (size_t)blockIdx.x * blockDim.x + threadIdx.x;
    if (i < (size_t)NTOK * 512) { const int row = (int)(i >> 9), j = (int)(i & 511); const int t = j >> 7, ii = j & 127; const float* cr = C + (size_t)row * EVEN_IN;
        const float u = cr[t * 256 + ii] + bias[j], g = cr[t * 256 + 128 + ii] + bias[512 + j];
        GLU[i] = f2bf_s(u / (1.0f + expf(-g)));
        Q[i] = f2bf_s(cr[1024 + j] + bias[1024 + j]);
        if (j < 128) { Kb[(size_t)row * 128 + j] = f2bf_s(cr[1536 + j] + bias[1536 + j]); Vb[(size_t)row * 128 + j] = f2bf_s(cr[1664 + j] + bias[1664 + j]); }
        if (row < NCTX && j < 128) { KC[(size_t)row * 128 + j] = f2bf_s(C2[(size_t)row * 256 + j] + bias[1536 + j]); VC[(size_t)row * 128 + j] = f2bf_s(C2[(size_t)row * 256 + 128 + j] + bias[1664 + j]); } }
}
__global__ void slow_epi_res(const float* C, const float* basef, const bf16* baseb, bf16* out, const float* bias, const float* gate) {
    const size_t i = (size_t)blockIdx.x * blockDim.x + threadIdx.x;
    if (i < (size_t)NTOK * D) { const int row = (int)(i >> 10), col = (int)(i & 1023); const float b = basef ? basef[i] : bf2f(baseb[i]); out[i] = f2bf_s(b + gate[(size_t)(row / SEQ) * MODW + col] * (C[i] + bias[col])); }
}
__global__ void slow_epi_gelu(const float* C, const float* bias, bf16* U, bf16* V) {
    const size_t i = (size_t)blockIdx.x * blockDim.x + threadIdx.x;
    if (i < (size_t)NTOK * 2048) { const int row = (int)(i >> 11), col = (int)(i & 2047); const float x = C[i] + bias[col]; const float y = 0.5f * x * (1.0f + erff(x * 0.70710678118654752f));
        if (col < 1024) U[(size_t)row * D + col] = f2bf_s(y); else V[(size_t)row * D + col - 1024] = f2bf_s(y); }
}
__global__ void slow_arow(const int* cnt, const int* list, int* arow) {
    const int s = blockIdx.x * blockDim.x + threadIdx.x; if (s >= ACT_ROWS) return;
    int e, slot; int r = 0; if (find_expert(cnt, s, e, slot) && slot < cnt[e * CNT_STRIDE]) r = list[(size_t)e * NTOK + slot] >> 2;
    arow[s] = r;
}
__global__ void slow_epi_swiglu(const float* C, const int* cnt, const float* b1, bf16* ACT) {
    const size_t i = (size_t)blockIdx.x * blockDim.x + threadIdx.x;
    if (i < (size_t)ACT_ROWS * 1024) { const int s = (int)(i >> 10), j = (int)(i & 1023); int e, slot; if (!find_expert(cnt, s, e, slot)) return;
        const int t = j >> 7, ii = j & 127; const float* cr = C + (size_t)s * 2048;
        float g = cr[t * 256 + ii] + b1[(size_t)e * 2048 + j], up = cr[t * 256 + 128 + ii] + b1[(size_t)e * 2048 + 1024 + j];
        g = fminf(g, 7.0f); up = fminf(fmaxf(up, -7.0f), 7.0f);
        ACT[i] = f2bf_s((up + 1.0f) * g / (1.0f + expf(-1.702f * g))); }
}
__global__ void slow_epi_down(const float* C, const int* cnt, const int* list, const float* gatew, const float* b2, bf16* Y) {
    const size_t i = (size_t)blockIdx.x * blockDim.x + threadIdx.x;
    if (i < (size_t)ACT_ROWS * 1024) { const int s = (int)(i >> 10), col = (int)(i & 1023); int e, slot; if (!find_expert(cnt, s, e, slot) || slot >= cnt[e * CNT_STRIDE]) return;
        const int aid = list[(size_t)e * NTOK + slot]; Y[(size_t)aid * D + col] = f2bf_s((C[i] + b2[(size_t)e * D + col]) * gatew[aid]); }
}
__global__ void __launch_bounds__(64) slow_attention(const bf16* QN, const bf16* KN, const bf16* VV, const bf16* KC, const bf16* VC, const float* sink, bf16* MIX) {
    const int i = blockIdx.x * blockDim.x + threadIdx.x; if (i >= NTOK * 8) return;
    const int row = i >> 3, h = i & 7, kh = h >> 2, b = row / SEQ, t = row % SEQ;
    float q[64], o[64];
    for (int d = 0; d < 64; ++d) { q[d] = bf2f(QN[(size_t)row * 512 + h * 64 + d]); o[d] = 0.f; }
    float m = sink[h] * LOG2E, l = 1.0f;
    const int j0 = t - 128 < 0 ? 0 : t - 128, j1 = t + 128 > SEQ - 1 ? SEQ - 1 : t + 128;
    for (int jj = j0; jj <= j1 + CTXL; ++jj) {
        const bf16* kp; const bf16* vp;
        if (jj <= j1) { kp = KN + (size_t)(b * SEQ + jj) * 128 + kh * 64; vp = VV + (size_t)(b * SEQ + jj) * 128 + kh * 64; }
        else { const int c = jj - j1 - 1; kp = KC + (size_t)(b * CTXL + c) * 128 + kh * 64; vp = VC + (size_t)(b * CTXL + c) * 128 + kh * 64; }
        float s = 0.f; for (int d = 0; d < 64; ++d) s += q[d] * bf2f(kp[d]);
        const float mn = fmaxf(m, s), al = exp2f(m - mn), p = exp2f(s - mn); m = mn; l = l * al + p;
        for (int d = 0; d < 64; ++d) o[d] = o[d] * al + p * bf2f(vp[d]);
    }
    for (int d = 0; d < 64; ++d) MIX[(size_t)row * D + 512 + h * 64 + d] = f2bf_s(o[d] / l);
}
__global__ void slow_vstats(const bf16* VB, float* stat) {
    const int row = blockIdx.x * blockDim.x + threadIdx.x; if (row >= NTOK) return;
    float s = 0.f; for (int c = 0; c < D; ++c) s += bf2f(VB[(size_t)row * D + c]); const float mean = s / D;
    float s2 = 0.f; for (int c = 0; c < D; ++c) { const float d = bf2f(VB[(size_t)row * D + c]) - mean; s2 += d * d; }
    stat[2 * row] = mean; stat[2 * row + 1] = rsqrtf(s2 / D + EPS);
}
__global__ void slow_spatial(const bf16* U, const bf16* VB, const float* stat, const float* ws, const float* bs, const float* lng, const float* lnb, bf16* SG) {
    const size_t i = (size_t)blockIdx.x * blockDim.x + threadIdx.x;
    if (i < (size_t)NTOK * D) { const int row = (int)(i >> 10), ch = (int)(i & 1023); const int g = ch >> 7, p = row & 127, r0 = row - p;
        float s = 0.f;
        for (int q = 0; q < 128; ++q) { const float vn = (bf2f(VB[(size_t)(r0 + q) * D + ch]) - stat[2 * (r0 + q)]) * stat[2 * (r0 + q) + 1] * lng[ch] + lnb[ch]; s += ws[((size_t)g * 128 + p) * 128 + q] * vn; }
        SG[i] = f2bf_s(bf2f(U[i]) * (s + bs[g * 128 + p])); }
}

static void launch_mega(Args& a, int lo, int hi, int& li, int grid, hipStream_t stream) {
    a.ph_lo = lo; a.ph_hi = hi; a.li = li++;
    hipLaunchKernelGGL(mega, dim3(grid), dim3(NTHREADS), LDS_BYTES, stream, a);
}
extern "C" void kernel_launch(void* const* d_in, const int* in_sizes, int n_in, void* d_out, int out_size, void* d_ws, size_t ws_size, hipStream_t stream) {
    static int grid = 0;
    if (grid == 0) {
        if (n_in != 33 || out_size != NTOK * D || ws_size < WS_END) { fprintf(stderr, "kernel_launch: unexpected problem (n_in %d, out %d, ws %zu)\n", n_in, out_size, ws_size); grid = -1; return; }
        int dev = 0, cus = 0, per_cu = 0;
        if (hipGetDevice(&dev) != hipSuccess || hipDeviceGetAttribute(&cus, hipDeviceAttributeMultiprocessorCount, dev) != hipSuccess) { grid = -1; return; }
        if (hipFuncSetAttribute((const void*)mega, hipFuncAttributeMaxDynamicSharedMemorySize, LDS_BYTES) != hipSuccess) { fprintf(stderr, "kernel_launch: hipFuncSetAttribute failed\n"); grid = -1; return; }
        if (hipOccupancyMaxActiveBlocksPerMultiprocessor(&per_cu, (const void*)mega, NTHREADS, LDS_BYTES) != hipSuccess || per_cu < 1) { fprintf(stderr, "kernel_launch: occupancy query says %d blocks per CU\n", per_cu); per_cu = 1; }
        (void)hipGetLastError();
        grid = cus;
    }
    if (grid < 0) return;
    unsigned char* ws = (unsigned char*)d_ws;
    (void)hipMemsetAsync(ws + WS_CTL, 0, CTL_ZERO_BYTES, stream);
    Args a{};
    for (int i = 0; i < 33; ++i) a.in[i] = (const float*)d_in[i];
    a.out = (float*)d_out; a.ws = ws;
    int li = 0;
    const float* in_[33]; for (int i = 0; i < 33; ++i) in_[i] = (const float*)d_in[i];
    float* CF = (float*)(ws + WS_CF); float* MOD = (float*)(ws + WS_MOD); int* CNT = (int*)(ws + WS_CTL) + CW_CNT;
    int lo = 0;
    auto flush = [&](int upto) { if (upto > lo) launch_mega(a, lo, upto, li, grid, stream); };
    for (int ph = 0; ph < NPHASE; ++ph) {
        bool slow = false;
        switch (ph) {
        case PH_GIN: slow = SLOW_MASK & 1; break;
        case PH_ATT: slow = SLOW_MASK & 2; break;
        case PH_GOUT: case PH_GMO: slow = SLOW_MASK & 4; break;
        case PH_M1_0: case PH_M1_1: slow = SLOW_MASK & 8; break;
        case PH_M2_0: case PH_M2_1: slow = SLOW_MASK & 16; break;
        case PH_GMI: slow = SLOW_MASK & 32; break;
        case PH_SPA: slow = SLOW_MASK & 64; break;
        default: break;
        }
        if (!slow) continue;
        flush(ph); lo = ph + 1;
        const int l = (ph == PH_M1_1 || ph == PH_M2_1) ? 1 : 0;
        switch (ph) {
        case PH_GIN:
            hipLaunchKernelGGL(slow_gemm, dim3(EVEN_IN / 64, NTOK / 64), dim3(256), 0, stream, (const bf16*)(ws + WS_XA), (const int*)nullptr, (const bf16*)(ws + WS_WINT), CF, EVEN_IN, (const int*)nullptr, (size_t)0);
            hipLaunchKernelGGL(slow_gemm, dim3(256 / 64, NCTX / 64), dim3(256), 0, stream, (const bf16*)(ws + WS_GM), (const int*)nullptr, (const bf16*)(ws + WS_WINT) + (size_t)KV_COL * D, CF + (size_t)NTOK * EVEN_IN, 256, (const int*)nullptr, (size_t)0);
            hipLaunchKernelGGL(slow_epi_in, dim3(NTOK * 512 / 256), dim3(256), 0, stream, (const float*)CF, (const float*)(CF + (size_t)NTOK * EVEN_IN), in_[I_EBIN], (bf16*)(ws + WS_GLU), (bf16*)(ws + WS_Q), (bf16*)(ws + WS_K), (bf16*)(ws + WS_V), (bf16*)(ws + WS_KC), (bf16*)(ws + WS_VC));
            break;
        case PH_ATT:
            hipLaunchKernelGGL(slow_attention, dim3(NTOK * 8 / 64), dim3(64), 0, stream, (const bf16*)(ws + WS_Q), (const bf16*)(ws + WS_K), (const bf16*)(ws + WS_V), (const bf16*)(ws + WS_KC), (const bf16*)(ws + WS_VC), in_[I_SINK], (bf16*)(ws + WS_MIX));
            break;
        case PH_GOUT:
            hipLaunchKernelGGL(slow_gemm, dim3(D / 64, NTOK / 64), dim3(256), 0, stream, (const bf16*)(ws + WS_MIX), (const int*)nullptr, (const bf16*)(ws + WS_WOUTT), CF, D, (const int*)nullptr, (size_t)0);
            hipLaunchKernelGGL(slow_epi_res, dim3(NTOK * D / 256), dim3(256), 0, stream, (const float*)CF, in_[I_X], (const bf16*)nullptr, (bf16*)(ws + WS_H), in_[I_EBOUT], (const float*)(MOD + 2 * 1024));
            break;
        case PH_GMO:
            hipLaunchKernelGGL(slow_gemm, dim3(D / 64, NTOK / 64), dim3(256), 0, stream, (const bf16*)(ws + WS_MIX), (const int*)nullptr, (const bf16*)(ws + WS_GWOUTT), CF, D, (const int*)nullptr, (size_t)0);
            hipLaunchKernelGGL(slow_epi_res, dim3(NTOK * D / 256), dim3(256), 0, stream, (const float*)CF, (const float*)nullptr, (const bf16*)(ws + WS_H), (bf16*)(ws + WS_H), in_[I_OBOUT], (const float*)(MOD + (size_t)9 * MODW + 2 * 1024));
            break;
        case PH_M1_0: case PH_M1_1:
            hipLaunchKernelGGL(slow_arow, dim3(ACT_ROWS / 256), dim3(256), 0, stream, (const int*)(CNT + l * NE * CNT_STRIDE), (const int*)(ws + WS_LIST), (int*)(ws + WS_AROW));
            hipLaunchKernelGGL(slow_gemm, dim3(2048 / 64, ACT_ROWS / 64), dim3(256), 0, stream, (const bf16*)(ws + WS_XA), (const int*)(ws + WS_AROW), (const bf16*)(ws + WS_W1T) + (size_t)l * NE * 2048 * 1024, CF, 2048, (const int*)(CNT + l * NE * CNT_STRIDE), (size_t)2048 * 1024);
            hipLaunchKernelGGL(slow_epi_swiglu, dim3(ACT_ROWS * 1024 / 256), dim3(256), 0, stream, (const float*)CF, (const int*)(CNT + l * NE * CNT_STRIDE), in_[I_B1] + (size_t)l * NE * 2048, (bf16*)(ws + WS_ACT));
            break;
        case PH_M2_0: case PH_M2_1:
            hipLaunchKernelGGL(slow_gemm, dim3(1024 / 64, ACT_ROWS / 64), dim3(256), 0, stream, (const bf16*)(ws + WS_ACT), (const int*)nullptr, (const bf16*)(ws + WS_W2T) + (size_t)l * NE * 1024 * 1024, CF, 1024, (const int*)(CNT + l * NE * CNT_STRIDE), (size_t)1024 * 1024);
            hipLaunchKernelGGL(slow_epi_down, dim3(ACT_ROWS * 1024 / 256), dim3(256), 0, stream, (const float*)CF, (const int*)(CNT + l * NE * CNT_STRIDE), (const int*)(ws + WS_LIST), (const float*)(ws + WS_GATE), in_[I_B2] + (size_t)l * NE * D, (bf16*)(ws + WS_Y));
            break;
        case PH_GMI:
            hipLaunchKernelGGL(slow_gemm, dim3(2048 / 64, NTOK / 64), dim3(256), 0, stream, (const bf16*)(ws + WS_XA), (const int*)nullptr, (const bf16*)(ws + WS_GWINT), CF, 2048, (const int*)nullptr, (size_t)0);
            hipLaunchKernelGGL(slow_epi_gelu, dim3(NTOK * 2048 / 256), dim3(256), 0, stream, (const float*)CF, in_[I_OBIN], (bf16*)(ws + WS_U), (bf16*)(ws + WS_VB));
            break;
        case PH_SPA:
            hipLaunchKernelGGL(slow_vstats, dim3(NTOK / 64), dim3(64), 0, stream, (const bf16*)(ws + WS_VB), CF);
            hipLaunchKernelGGL(slow_spatial, dim3(NTOK * D / 256), dim3(256), 0, stream, (const bf16*)(ws + WS_U), (const bf16*)(ws + WS_VB), (const float*)CF, in_[I_OWS], in_[I_OBS], in_[I_OLNG], in_[I_OLNB], (bf16*)(ws + WS_MIX));
            break;
        default: break;
        }
    }
    flush(NPHASE);
}
```

```cpp
#include <hip/hip_runtime.h>
#include <cstdio>
#include <cstdint>

#ifndef SLOW_MASK
#define SLOW_MASK 0x00
#endif

#ifndef EXP_STREAM
#define EXP_STREAM 0
#endif
#ifndef PROBE_PH
#define PROBE_PH (-1)
#endif
#ifndef PROBE_END
#define PROBE_END (PROBE_PH + 1)
#endif
#ifndef PROBE_A
#define PROBE_A (-1)
#define PROBE_B (-1)
#endif
#ifndef PROBE_MULT
#define PROBE_MULT 4
#endif

#define LAS __attribute__((address_space(3)))
typedef unsigned short bf16;
typedef short bf16x8 __attribute__((ext_vector_type(8)));
typedef float f32x4 __attribute__((ext_vector_type(4)));
typedef float f32x2 __attribute__((ext_vector_type(2)));
typedef unsigned u32x4 __attribute__((ext_vector_type(4)));
typedef unsigned u32x2 __attribute__((ext_vector_type(2)));
typedef __bf16 bf16x2_t __attribute__((ext_vector_type(2)));

constexpr int NB = 8, SEQ = 2048, D = 1024, NTOK = NB * SEQ, CTXL = 256, NCTX = NB * CTXL;
constexpr int NE = 32, TOPK = 4, NASSIGN = NTOK * TOPK, ACT_ROWS = NASSIGN + NE * 256;
constexpr int EVEN_IN = 1792, KV_COL = 1536;
constexpr float EPS = 1e-6f, LOG2E = 1.4426950408889634f;
constexpr float QSCALE = 0.125f * LOG2E;
constexpr int MODW = 6 * D;
constexpr int NWAVES = 8, NTHREADS = 512;

constexpr size_t MiB = 1u << 20;
constexpr size_t WS_CTL = 0, CTL_ZERO_BYTES = 1 * MiB;
constexpr size_t WS_MOD = 1 * MiB;
constexpr size_t WS_LIST = 2 * MiB;
constexpr size_t WS_GATE = 4 * MiB;
constexpr size_t WS_WSB = 5 * MiB;
constexpr size_t WS_WINT = 6 * MiB;
constexpr size_t WS_WOUTT = 10 * MiB;
constexpr size_t WS_GWINT = 12 * MiB;
constexpr size_t WS_GWOUTT = 16 * MiB;
constexpr size_t WS_KC = 18 * MiB;
constexpr size_t WS_VC = 18 * MiB + 512 * 1024;
constexpr size_t WS_K = 19 * MiB;
constexpr size_t WS_V = 23 * MiB;
constexpr size_t WS_GM = 27 * MiB;
constexpr size_t WS_AROW = 31 * MiB;
constexpr size_t WS_Q = 32 * MiB;
constexpr size_t WS_GLU = 48 * MiB;
constexpr size_t WS_XA = 64 * MiB;
constexpr size_t WS_MIX = 96 * MiB;
constexpr size_t WS_H = 128 * MiB;
constexpr size_t WS_U = 192 * MiB;
constexpr size_t WS_VB = 224 * MiB;
constexpr size_t WS_W1T = 256 * MiB;
constexpr size_t WS_W2T = 512 * MiB;
constexpr size_t WS_ACT = 640 * MiB;
constexpr size_t WS_Y = 784 * MiB;
constexpr size_t WS_XA8 = 912 * MiB;
constexpr size_t WS_CF = 928 * MiB;
constexpr size_t WS_END = 1504 * MiB;
constexpr int CW_BAR = 4096, CW_CNT = 131072, CNT_STRIDE = 64  , CW_VSTAT = 147456;
constexpr int MAX_LAUNCH = 20;

constexpr int RING_BYTES = 131072;
constexpr int MISC_OFF = RING_BYTES;
constexpr int TAB_OFF = RING_BYTES + 256;
constexpr int META_OFF = RING_BYTES + 3072;
constexpr int BIAS_OFF = META_OFF + 10240;
constexpr int LDS_BYTES = 163840;

#define LDS_WAIT() asm volatile("s_waitcnt lgkmcnt(0)" ::: "memory")
#define VM_WAIT() asm volatile("s_waitcnt vmcnt(0)" ::: "memory")

__device__ __forceinline__ float bf2f(unsigned b) { return __uint_as_float(b << 16); }
__device__ __forceinline__ unsigned pk2(float lo, float hi) { f32x2 v = {lo, hi}; bf16x2_t b = __builtin_convertvector(v, bf16x2_t); return __builtin_bit_cast(unsigned, b); }
template <int CTRL, int ROW_MASK> __device__ __forceinline__ float dpp_f(float old, float src) { return __builtin_bit_cast(float, __builtin_amdgcn_update_dpp(__builtin_bit_cast(int, old), __builtin_bit_cast(int, src), CTRL, ROW_MASK, 0xf, false)); }
__device__ __forceinline__ unsigned pk4_fp8(float a, float b, float c, float d) { int w = 0; w = __builtin_amdgcn_cvt_pk_fp8_f32(a, b, w, false); w = __builtin_amdgcn_cvt_pk_fp8_f32(c, d, w, true); return (unsigned)w; }
__device__ __forceinline__ float wave_sum(float v) {
    v += dpp_f<0xB1, 0xf>(0.f, v);
    v += dpp_f<0x4E, 0xf>(0.f, v);
    v += dpp_f<0x141, 0xf>(0.f, v);
    v += dpp_f<0x140, 0xf>(0.f, v);
    v += dpp_f<0x142, 0xa>(0.f, v);
    v += dpp_f<0x143, 0xc>(0.f, v);
    return __builtin_bit_cast(float, __builtin_amdgcn_readlane(__builtin_bit_cast(int, v), 63));
}
__device__ __forceinline__ float dpp_swap32(float v) { return __shfl_xor(v, 32); }
__device__ __forceinline__ float sigmoidf_(float x) { return __builtin_amdgcn_rcpf(1.0f + __builtin_amdgcn_exp2f(-x * LOG2E)); }

#define XB_TMO      128
#define XB_XCNT(j)  (256  + 64 * (j))
#define XB_XSUB(j)  (1280 + 64 * (j))
#define XB_XGEN(j)  (2304 + 64 * (j))
#define XB_TOP      3328
#define XB_TOPGEN   3392
#define XCD_BAR_WORDS 3456
#define XB_SPIN_CAP (1u << 20)
__device__ __forceinline__ unsigned xb_ld(unsigned* p)              { return __hip_atomic_load(p, __ATOMIC_RELAXED, __HIP_MEMORY_SCOPE_AGENT); }
__device__ __forceinline__ unsigned xb_add(unsigned* p, unsigned v) { return __hip_atomic_fetch_add(p, v, __ATOMIC_RELAXED, __HIP_MEMORY_SCOPE_AGENT); }
__device__ __forceinline__ unsigned xb_xcc_id() { return (unsigned)__builtin_amdgcn_s_getreg((3 << 11) | 20) & 0xFu; }
#define XB_SPIN(cond, bar) do { unsigned _sp = 0; while (cond) { __builtin_amdgcn_s_sleep(1); \
    if ((++_sp & 255u) == 0u) { if (xb_ld(&(bar)[XB_TMO])) break; if (_sp > XB_SPIN_CAP) { atomicAdd(&(bar)[XB_TMO], 1u); break; } } } } while (0)
struct XcdBarrier { unsigned* bar; unsigned x; volatile LAS unsigned* st; };
__device__ __forceinline__ XcdBarrier xcd_barrier_post(unsigned* bar, volatile LAS unsigned* st) {
    XcdBarrier b; b.bar = bar; b.x = xb_xcc_id(); b.st = st;
    if (threadIdx.x == 0) (void)xb_add(&bar[XB_XCNT(b.x)], 1u);
    return b;
}
__device__ __forceinline__ void xcd_barrier_complete(unsigned* bar, unsigned x, unsigned& nloc, unsigned& nx) {
    const unsigned G = gridDim.x * gridDim.y * gridDim.z;
    unsigned sum, cnt, mine, sp = 0u;
    for (;;) {
        sum = 0u; cnt = 0u; mine = 0u;
#pragma unroll
        for (unsigned j = 0; j < 16; ++j) { const unsigned c = xb_ld(&bar[XB_XCNT(j)]); sum += c; cnt += (c > 0u) ? 1u : 0u; mine = (j == x) ? c : mine; }
        if (sum == G) break;
        __builtin_amdgcn_s_sleep(1);
        if ((++sp & 255u) == 0u) { if (xb_ld(&bar[XB_TMO])) break; if (sp > XB_SPIN_CAP) { atomicAdd(&bar[XB_TMO], 1u); break; } }
    }
    nloc = mine > 0u ? mine : 1u; nx = cnt > 0u ? cnt : 1u;
}
__device__ __forceinline__ void xcd_barrier(const XcdBarrier& b, const int tid) {
    asm volatile("s_waitcnt vmcnt(0)" ::: "memory");
    __syncthreads();
    if (tid == 0) {
        unsigned* bar = b.bar;
        __builtin_amdgcn_s_waitcnt(0);
        unsigned nloc = b.st[0], nx = b.st[1];
        if (nloc == 0u) { xcd_barrier_complete(bar, b.x, nloc, nx); b.st[0] = nloc; b.st[1] = nx; }
        const unsigned old = xb_add(&bar[XB_XSUB(b.x)], 1u);
        const unsigned gen = old / nloc;
        if (old + 1u == (gen + 1u) * nloc) {
            __builtin_amdgcn_fence(__ATOMIC_RELEASE, "agent");
            asm volatile("s_waitcnt vmcnt(0)" ::: "memory");
            const unsigned og = xb_add(&bar[XB_TOP], 1u);
            const unsigned tg = og / nx;
            if (og + 1u == (tg + 1u) * nx) xb_add(&bar[XB_TOPGEN], 1u);
            else XB_SPIN(xb_ld(&bar[XB_TOPGEN]) == tg, bar);
            __builtin_amdgcn_fence(__ATOMIC_ACQUIRE, "agent");
            xb_add(&bar[XB_XGEN(b.x)], 1u);
            asm volatile("s_waitcnt vmcnt(0)" ::: "memory");
        } else {
            XB_SPIN(xb_ld(&bar[XB_XGEN(b.x)]) == gen, bar);
            __builtin_amdgcn_fence(__ATOMIC_ACQUIRE, "agent");
            asm volatile("s_waitcnt vmcnt(0)" ::: "memory");
        }
    }
    __syncthreads();
}

constexpr float FP8_WMUL = 32.0f, FP8_AMUL = 4.0f, FP8_DESCALE = 1.0f / (32.0f * 4.0f);
#if PROBE_PH == -2
#define GMARK(k) do { if (Sched::GATHER && ui == 0 && blockIdx.x == 0 && tid == 0) { volatile LAS unsigned long long* pm_ = (volatile LAS unsigned long long*)(lds + MISC_OFF + 128); \
    if ((k) == PROBE_A) pm_[0] = __builtin_amdgcn_s_memrealtime(); if ((k) == PROBE_B) pm_[1] = __builtin_amdgcn_s_memrealtime(); } } while (0)
#define GMARK1(k) do { if (Sched::GATHER && ui == 1 && blockIdx.x == 0 && tid == 0) { volatile LAS unsigned long long* pm_ = (volatile LAS unsigned long long*)(lds + MISC_OFF + 128); \
    if ((k) == PROBE_A) pm_[0] = __builtin_amdgcn_s_memrealtime(); if ((k) == PROBE_B) pm_[1] = __builtin_amdgcn_s_memrealtime(); } } while (0)
#else
#define GMARK(k) do { } while (0)
#define GMARK1(k) do { } while (0)
#endif
namespace pg8 {
constexpr int BM = 256, BK = 64, HALF = 128, HTB = HALF * BK * 2, STAGE_BYTES = 8 * HTB, KD = 1024  ;
__host__ __device__ __forceinline__ int lds_byte(int r, int c) { const int st = (r >> 4) * 2 + (c >> 5), rr = r & 15, cc = c & 31, ob = rr * 64 + cc * 2; return st * 1024 + (ob ^ (((ob >> 9) & 1) << 5)); }
__host__ __device__ __forceinline__ void stage_rc(int b, int& R, int& C) { const int st = b / 1024, sb = b % 1024, swz = sb ^ (((sb >> 9) & 1) << 5); R = (st >> 1) * 16 + swz / 64; C = (st & 1) * 32 + (swz % 64) / 2; }
__host__ __device__ __forceinline__ int perm32(int rho) { const int n = rho >> 4, i = rho & 15; return 8 * (i >> 2) + 4 * n + (i & 3); }

typedef int v8i_t __attribute__((ext_vector_type(8)));
__device__ __forceinline__ v8i_t cat8(bf16x8 a, bf16x8 b) { typedef int v4i_t __attribute__((ext_vector_type(4))); const v4i_t x = __builtin_bit_cast(v4i_t, a), y = __builtin_bit_cast(v4i_t, b); return __builtin_shufflevector(x, y, 0, 1, 2, 3, 4, 5, 6, 7); }
struct Unit { int pm, pn, e, cnt, idx; };

template <class Epi, class Sched>
__device__ __forceinline__ void gemm_phase(LAS unsigned char* lds, const Sched& S, const Epi& E, const int tid) {
    const int wid = __builtin_amdgcn_readfirstlane(tid >> 6), lane = tid & 63, wr = wid >> 2, wc = wid & 3, fr = lane & 15, fq = lane >> 4;
    constexpr int RP = Sched::FP8 ? 1024 : 2048  , nt = RP / 128;
    int Rr[2], Cc[2];
    unsigned voffA[2][2], voffB[2];
#pragma unroll
    for (int i = 0; i < 2; ++i) { stage_rc(tid * 16 + i * 8192, Rr[i], Cc[i]); const int Rb = Epi::PERM ? ((Rr[i] & ~31) + perm32(Rr[i] & 31)) : Rr[i];
        voffB[i] = (unsigned)(Rb * RP + Cc[i] * 2); }
    constexpr size_t kstep = (size_t)(BK * 2);
    constexpr size_t hstep = (size_t)HALF * RP;
    const unsigned ldsw = (unsigned)wid * 1024u;
    const int aoff = lds_byte(wr * 64 + fr, fq * 8), boff = lds_byte(wc * 32 + fr, fq * 8);
#define PG8_SA(b, h) (((b) * 2 + (h)) * HTB)
#define PG8_SB(b, h) ((4 + (b) * 2 + (h)) * HTB)
#define PG8_STAGE(bufoff, gbase, voff) do { _Pragma("unroll") for (int _i = 0; _i < 2; ++_i) \
        __builtin_amdgcn_global_load_lds((const unsigned*)((const char*)(gbase) + (voff)[_i]), (LAS unsigned*)(lds + (bufoff) + ldsw + _i * 8192), 16, 0, 0); } while (0)
#define PG8_STAGEA1(bufoff, gbase) do { if constexpr (Sched::GATHER) { PG8_STAGE(bufoff, gbase, voffA[1]); } else { PG8_STAGE(bufoff, (gbase) + hstep, voffA[0]); } } while (0)
#define PG8_LDA(dst, b, h) do { _Pragma("unroll") for (int m = 0; m < 4; ++m) _Pragma("unroll") for (int k = 0; k < 2; ++k) dst[m][k] = *(const LAS bf16x8*)(lds + PG8_SA(b, h) + aoff + m * 2048 + k * 1024); } while (0)
#define PG8_LDB(dst, b, h) do { _Pragma("unroll") for (int n = 0; n < 2; ++n) _Pragma("unroll") for (int k = 0; k < 2; ++k) dst[n][k] = *(const LAS bf16x8*)(lds + PG8_SB(b, h) + boff + n * 2048 + k * 1024); } while (0)
#define PG8_MMA(ai, bj, At, Bt) do { __builtin_amdgcn_s_setprio(1); _Pragma("unroll") for (int m = 0; m < 4; ++m) _Pragma("unroll") for (int n = 0; n < 2; ++n) { \
        if constexpr (Sched::FP8) { acc[ai][bj][m][n] = __builtin_amdgcn_mfma_scale_f32_16x16x128_f8f6f4(cat8(Bt[n][0], Bt[n][1]), cat8(At[m][0], At[m][1]), acc[ai][bj][m][n], 0, 0, 0, 0, 0, 0); } \
        else { _Pragma("unroll") for (int k = 0; k < 2; ++k) acc[ai][bj][m][n] = __builtin_amdgcn_mfma_f32_16x16x32_bf16(Bt[n][k], At[m][k], acc[ai][bj][m][n], 0, 0, 0); } } \
        __builtin_amdgcn_s_setprio(0); } while (0)
#define PG8_WAIT_V(n) asm volatile("s_waitcnt vmcnt(" #n ")" ::: "memory")
#define PG8_WAIT_L(n) asm volatile("s_waitcnt lgkmcnt(" #n ")" ::: "memory")
#define PG8_BAR __builtin_amdgcn_s_barrier()
#define PG8_SCHED __builtin_amdgcn_sched_barrier(0)
    Unit cur, nxt; int ui = 0;
    if (!S.next(0, cur)) return;
    S.a_voff(cur, voffA, Rr, Cc);
    f32x4 acc[2][2][4][2];
#pragma unroll
    for (int a = 0; a < 2; ++a)
#pragma unroll
        for (int b = 0; b < 2; ++b)
#pragma unroll
            for (int m = 0; m < 4; ++m)
#pragma unroll
                for (int n = 0; n < 2; ++n) acc[a][b][m][n] = (f32x4){0.f, 0.f, 0.f, 0.f};
    bf16x8 At[4][2], B0[2][2], B1[2][2];
    const char* cA = S.a_ptr(cur); const char* cB = S.b_ptr(cur);
    PG8_STAGE(PG8_SB(0, 0), cB, voffB); PG8_STAGE(PG8_SB(0, 1), cB + hstep, voffB); PG8_STAGE(PG8_SA(0, 0), cA, voffA[0]); PG8_STAGEA1(PG8_SA(0, 1), cA);
    if (wr == 1) PG8_BAR;
    PG8_WAIT_V(2); PG8_BAR;
    PG8_STAGE(PG8_SB(1, 0), cB + kstep, voffB); PG8_STAGE(PG8_SA(1, 0), cA + kstep, voffA[0]); PG8_STAGE(PG8_SB(1, 1), cB + hstep + kstep, voffB);
    PG8_WAIT_V(6); PG8_BAR;
    for (;;) {
        const bool has_next = S.next(ui + 1, nxt);
        const char* nA = has_next ? S.a_ptr(nxt) : cA; const char* nB = has_next ? S.b_ptr(nxt) : cB;
#pragma unroll 1
        for (int t = 0; t < nt; t += 2) {
            const bool last = (t == nt - 2);
            if (last) GMARK(40); if (t == 2) GMARK1(45);
            const char* a1 = cA + (size_t)(t + 1) * kstep;
            const char* a2 = last ? nA : cA + (size_t)(t + 2) * kstep; const char* b2 = last ? nB : cB + (size_t)(t + 2) * kstep;
            const char* a3 = a2 + kstep; const char* b3 = b2 + kstep;
            asm volatile("" : "+s"(a1), "+s"(a2), "+s"(a3), "+s"(b2), "+s"(b3));
            PG8_LDB(B0, 0, 0); PG8_LDB(B1, 0, 1); PG8_SCHED; PG8_LDA(At, 0, 0); PG8_STAGEA1(PG8_SA(1, 1), a1);
            if (Sched::GATHER) { if (last && has_next) S.a_voff(nxt, voffA, Rr, Cc); }
            PG8_WAIT_V(8); PG8_WAIT_L(0); PG8_BAR; PG8_MMA(0, 0, At, B0); PG8_MMA(0, 1, At, B1); PG8_BAR; PG8_SCHED;
            PG8_LDA(At, 0, 1); PG8_STAGE(PG8_SB(0, 0), b2, voffB); PG8_STAGE(PG8_SB(0, 1), b2 + hstep, voffB); PG8_STAGE(PG8_SA(0, 0), a2, voffA[0]);
            PG8_WAIT_V(8); PG8_WAIT_L(0); PG8_BAR; PG8_MMA(1, 0, At, B0); PG8_MMA(1, 1, At, B1); PG8_BAR; PG8_SCHED;
            PG8_LDB(B0, 1, 0); PG8_LDB(B1, 1, 1); PG8_SCHED; PG8_LDA(At, 1, 0); PG8_STAGEA1(PG8_SA(0, 1), a2);
            PG8_WAIT_V(8); PG8_WAIT_L(0); PG8_BAR; PG8_MMA(0, 0, At, B0); PG8_MMA(0, 1, At, B1); PG8_BAR; PG8_SCHED;
            PG8_LDA(At, 1, 1); PG8_STAGE(PG8_SB(1, 0), b3, voffB); PG8_STAGE(PG8_SB(1, 1), b3 + hstep, voffB); PG8_STAGE(PG8_SA(1, 0), a3, voffA[0]);
            PG8_WAIT_V(8); PG8_WAIT_L(0); PG8_BAR; PG8_MMA(1, 0, At, B0); PG8_MMA(1, 1, At, B1); PG8_BAR; PG8_SCHED;
        }
        GMARK(41);
        if (wr == 0) PG8_BAR;
        GMARK(42);
        E(acc, cur, wr, wc, fr, fq);
        GMARK(43);
        if (!has_next) break;
#pragma unroll
        for (int a = 0; a < 2; ++a)
#pragma unroll
            for (int b = 0; b < 2; ++b)
#pragma unroll
                for (int m = 0; m < 4; ++m)
#pragma unroll
                    for (int n = 0; n < 2; ++n) acc[a][b][m][n] = (f32x4){0.f, 0.f, 0.f, 0.f};
        cur = nxt; cA = nA; cB = nB; ++ui;
        if (wr == 1) PG8_BAR;
    }
    PG8_WAIT_V(0);
    PG8_BAR;
#undef PG8_SA
#undef PG8_SB
#undef PG8_STAGE
#undef PG8_STAGEA1
#undef PG8_LDA
#undef PG8_LDB
#undef PG8_MMA
#undef PG8_WAIT_V
#undef PG8_WAIT_L
#undef PG8_BAR
#undef PG8_SCHED
}
}

struct Args { const float* in[33]; float* out; unsigned char* ws; int ph_lo, ph_hi, li, pad; };
enum { I_X = 0, I_C, I_CTX, I_CCTX, I_ADAW, I_ADAB, I_NMG, I_NFG, I_EWIN, I_EBIN, I_ECW, I_ECB, I_ELNG, I_ELNB, I_QNG, I_KNG, I_SINK, I_EWOUT, I_EBOUT,
       I_OWIN, I_OBIN, I_OLNG, I_OLNB, I_OWS, I_OBS, I_OWOUT, I_OBOUT, I_RW, I_RB, I_W1, I_B1, I_W2, I_B2 };

typedef const __attribute__((address_space(4))) unsigned long long* kargp_t;
struct Ctx {
    LAS unsigned char* lds; int tid, lane, wave, G, vcu, gw, NGW, bid; unsigned char* ws; kargp_t kp;
};
__device__ __forceinline__ const float* in_ptr(const Ctx& X, int i) { return (const float*)(const __attribute__((address_space(1))) float*)X.kp[i]; }
#define IN(i) in_ptr(X, (i))
#if PROBE_PH == -2
#define PMARK(k) do { if (X.bid == 0 && X.tid == 0) { volatile LAS unsigned long long* pm_ = (volatile LAS unsigned long long*)(X.lds + MISC_OFF + 128); \
    if ((k) == PROBE_A) pm_[0] = __builtin_amdgcn_s_memrealtime(); if ((k) == PROBE_B) pm_[1] = __builtin_amdgcn_s_memrealtime(); } } while (0)
#else
#define PMARK(k) do { } while (0)
#endif

struct DenseSched {
    static constexpr bool GATHER = false, FP8 = false;
    const bf16* A; const bf16* Bt; int nM, nN, nwg, G, c;
    const bf16* A2; const bf16* Bt2; int nM2;
    __device__ __forceinline__ void init(const bf16* A_, const bf16* Bt_, int M, int N, int G_, int c_) { A = A_; Bt = Bt_; nM = M / 256; nN = N / 256; nwg = nM * nN; G = G_; c = c_; A2 = nullptr; Bt2 = nullptr; nM2 = 0; }
    __device__ __forceinline__ bool next(int i, pg8::Unit& u) const {
        const int L = i * G + c; if (L >= nwg + nM2) return false; u.idx = i;
        if (L >= nwg) { u.pm = L - nwg; u.pn = 0; u.e = 1; u.cnt = 256; return true; }
        int wgid = L; { const int q = nwg / 8, r = nwg % 8, xcd = wgid % 8, off = wgid / 8; wgid = (xcd < r ? xcd * (q + 1) : r * (q + 1) + (xcd - r) * q) + off; }
        const int nig = 8 * nN, gid = wgid / nig, fm = gid * 8, gsz = (nM - fm) < 8 ? (nM - fm) : 8;
        u.pm = fm + ((wgid % nig) % gsz); u.pn = (wgid % nig) / gsz; u.e = 0; u.cnt = 256; return true;
    }
    __device__ __forceinline__ const char* a_ptr(const pg8::Unit& u) const { return (const char*)(u.e ? A2 : A) + (size_t)u.pm * 256 * pg8::KD * 2; }
    __device__ __forceinline__ const char* b_ptr(const pg8::Unit& u) const { return (const char*)(u.e ? Bt2 : Bt) + (size_t)u.pn * 256 * pg8::KD * 2; }
    __device__ __forceinline__ void a_voff(const pg8::Unit&, unsigned (&v)[2][2], const int (&R)[2], const int (&C)[2]) const {
#pragma unroll
        for (int i = 0; i < 2; ++i) { v[0][i] = (unsigned)(R[i] * pg8::KD + C[i]) * 2u; v[1][i] = v[0][i] + (unsigned)(pg8::HALF * pg8::KD * 2); }
    }
};
template <bool GATHER_, int NTILE_N>
struct MoeSchedT {
    static constexpr bool GATHER = GATHER_, FP8 = true; static constexpr int RP = 1024;
    const LAS int* tab; int G, c;
    const unsigned char* A;
    const unsigned char* Bt;
    const int* list;
    const LAS int* meta;
    __device__ __forceinline__ bool next(int i, pg8::Unit& u) const {
        const int L = i * G + c; const int T = tab[0];
        if (L >= T * NTILE_N) return false;
        u.idx = i;
        const int mt = L / NTILE_N; u.pn = L % NTILE_N;
        const int w = __builtin_amdgcn_readfirstlane(tab[1 + mt]); u.e = w >> 16; const int tl = w & 0xffff;
        const int cnt = __builtin_amdgcn_readfirstlane(tab[512 + u.e]), pb = __builtin_amdgcn_readfirstlane(tab[544 + u.e]);
        u.pm = pb + tl * 256; u.cnt = cnt - tl * 256;
        return true;
    }
    __device__ __forceinline__ const char* a_ptr(const pg8::Unit& u) const { return GATHER ? (const char*)A : (const char*)A + (size_t)u.pm * RP; }
    __device__ __forceinline__ const char* b_ptr(const pg8::Unit& u) const { return (const char*)Bt + ((size_t)u.e * NTILE_N + u.pn) * 256 * RP; }
    __device__ __forceinline__ void a_voff(const pg8::Unit& u, unsigned (&v)[2][2], const int (&R)[2], const int (&C)[2]) const {
        if (GATHER) {
#pragma unroll
            for (int h = 0; h < 2; ++h)
#pragma unroll
                for (int i = 0; i < 2; ++i) { const int tok = meta[u.idx * 256 + h * 128 + R[i]]; v[h][i] = (unsigned)(tok * RP + C[i] * 2); }
        } else {
#pragma unroll
            for (int i = 0; i < 2; ++i) { v[0][i] = (unsigned)(R[i] * RP + C[i] * 2); v[1][i] = v[0][i] + (unsigned)(pg8::HALF * RP); }
        }
    }
};
__device__ __forceinline__ void moe_build_table(const Ctx& X, const int* cnt  ) {
    LAS int* tab = (LAS int*)(X.lds + TAB_OFF);
    __syncthreads();
    if (X.tid < 64) {
        const int e = X.lane; int c = 0; if (e < NE) c = __hip_atomic_load(cnt + e * CNT_STRIDE, __ATOMIC_RELAXED, __HIP_MEMORY_SCOPE_AGENT);
        const int mt = (c + 255) >> 8; int incl = mt;
#pragma unroll
        for (int off = 1; off < 32; off <<= 1) { const int v = __shfl_up(incl, off); if (X.lane >= off) incl += v; }
        const int start = incl - mt;
        if (e < NE) { tab[512 + e] = c; tab[544 + e] = start * 256; for (int t = 0; t < mt; ++t) tab[1 + start + t] = (e << 16) | t; if (e == NE - 1) tab[0] = incl; }
    }
    __syncthreads();
}
template <bool WITH_GATE, class Sched>
__device__ __forceinline__ void moe_stage_meta(const Ctx& X, const Sched& S, const int* list, const float* gatew, LAS int* meta, const float* bias, LAS float* lbias) {
    if (X.tid < 256) { pg8::Unit u;
        for (int i = 0; S.next(i, u); ++i) { const int slot0 = u.pm - S.tab[544 + u.e]; const int r = X.tid < u.cnt ? X.tid : u.cnt - 1;
            const int aid = list[(size_t)u.e * NTOK + slot0 + r];
            if (WITH_GATE) { const float g = gatew[aid]; *(LAS u32x2*)(meta + (i * 256 + X.tid) * 2) = (u32x2){(unsigned)aid, __float_as_uint(g)}; }
            else meta[i * 256 + X.tid] = aid >> 2; } }
    else { const int c = X.tid - 256; pg8::Unit u;
        for (int i = 0; S.next(i, u); ++i) lbias[i * 256 + c] = WITH_GATE ? bias[(size_t)u.e * D + u.pn * 256 + c] : bias[(size_t)u.e * 2048 + (c >> 7) * 1024 + u.pn * 128 + (c & 127)]; }
    __syncthreads();
}

__device__ __forceinline__ f32x2 gelu_pk(f32x2 v) {
    const f32x2 av = __builtin_elementwise_abs(v), d = av * 0.2316418882f + 1.0f;
    f32x2 t; t.x = __builtin_amdgcn_rcpf(d.x); t.y = __builtin_amdgcn_rcpf(d.y);
    f32x2 q = t * 0.5307027145f + (-0.7265760135f); q = q * t + 0.7107068705f; q = q * t + (-0.142248368f); q = q * t + 0.127414796f; q = q * t;
    const f32x2 s = (v * v) * (-0.72134752044f);
    f32x2 e; e.x = __builtin_amdgcn_exp2f(s.x); e.y = __builtin_amdgcn_exp2f(s.y);
    const f32x2 m = v * (q * e), r = v - m;
    f32x2 o; o.x = v.x < 0.f ? m.x : r.x; o.y = v.y < 0.f ? m.y : r.y; return o;
}
__device__ __forceinline__ u32x4 pack8(f32x4 a, f32x4 b) { u32x4 w; w.x = pk2(a[0], a[1]); w.y = pk2(a[2], a[3]); w.z = pk2(b[0], b[1]); w.w = pk2(b[2], b[3]); return w; }

struct EpiIn {
    static constexpr bool PERM = true;
    bf16 *GLU, *Q, *Kb, *Vb, *KC, *VC; const float* bias;
    __device__ __forceinline__ void operator()(const f32x4 (&acc)[2][2][4][2], const pg8::Unit& u, int wr, int wc, int fr, int fq) const {
        asm volatile("" : "+v"(fr), "+v"(fq));
        const int row0 = u.pm * 256 + wr * 64 + fr; const int c8 = wc * 32 + 8 * fq;
        if (u.e == 0 && u.pn < 4) {
            const int j0 = u.pn * 128 + c8;
            f32x4 bu[2], bg[2];
#pragma unroll
            for (int n = 0; n < 2; ++n) { bu[n] = *(const f32x4*)(bias + j0 + 4 * n); bg[n] = *(const f32x4*)(bias + 512 + j0 + 4 * n); }
#pragma unroll
            for (int ai = 0; ai < 2; ++ai)
#pragma unroll
                for (int m = 0; m < 4; ++m) { f32x4 o[2];
#pragma unroll
                    for (int n = 0; n < 2; ++n) { const f32x4 uu = acc[ai][0][m][n] + bu[n], gg = acc[ai][1][m][n] + bg[n];
#pragma unroll
                        for (int k = 0; k < 4; ++k) o[n][k] = uu[k] * sigmoidf_(gg[k]); }
                    *(u32x4*)(GLU + (size_t)(row0 + ai * 128 + m * 16) * 512 + j0) = pack8(o[0], o[1]); }
        } else {
#pragma unroll
            for (int bj = 0; bj < 2; ++bj) {
                bf16* dst; int ld, col, bcol;
                if (u.pn >= 6 || u.e) { dst = u.e ? (bj ? VC : KC) : (bj ? Vb : Kb); ld = 128; col = c8; bcol = KV_COL + bj * 128 + c8; }
                else { dst = Q; ld = 512; col = (u.pn - 4) * 256 + bj * 128 + c8; bcol = 1024 + col; }
                f32x4 bv[2];
#pragma unroll
                for (int n = 0; n < 2; ++n) bv[n] = *(const f32x4*)(bias + bcol + 4 * n);
#pragma unroll
                for (int ai = 0; ai < 2; ++ai)
#pragma unroll
                    for (int m = 0; m < 4; ++m) *(u32x4*)(dst + (size_t)(row0 + ai * 128 + m * 16) * ld + col) = pack8(acc[ai][bj][m][0] + bv[0], acc[ai][bj][m][1] + bv[1]);
            }
        }
    }
};
template <bool BASE_F32> struct EpiRes {
    static constexpr bool PERM = true;
    const void* base; bf16* out; const float* bias; const float* gate;
    __device__ __forceinline__ void operator()(const f32x4 (&acc)[2][2][4][2], const pg8::Unit& u, int wr, int wc, int fr, int fq) const {
        asm volatile("" : "+v"(fr), "+v"(fq));
        const int col0 = u.pn * 256 + wc * 32 + 8 * fq; const int b = (u.pm * 256) / SEQ;
#pragma unroll
        for (int bj = 0; bj < 2; ++bj) {
            f32x4 bv[2], gv[2];
#pragma unroll
            for (int n = 0; n < 2; ++n) { bv[n] = *(const f32x4*)(bias + col0 + bj * 128 + 4 * n); gv[n] = *(const f32x4*)(gate + (size_t)b * MODW + col0 + bj * 128 + 4 * n); }
#pragma unroll
            for (int ai = 0; ai < 2; ++ai)
#pragma unroll
                for (int m = 0; m < 4; ++m) { const size_t off = (size_t)(u.pm * 256 + ai * 128 + wr * 64 + m * 16 + fr) * D + col0 + bj * 128;
                    f32x4 b0, b1;
                    if (BASE_F32) { b0 = *(const f32x4*)((const float*)base + off); b1 = *(const f32x4*)((const float*)base + off + 4); }
                    else { const u32x4 w = *(const u32x4*)((const bf16*)base + off); b0 = (f32x4){bf2f(w.x & 0xffffu), bf2f(w.x >> 16), bf2f(w.y & 0xffffu), bf2f(w.y >> 16)}; b1 = (f32x4){bf2f(w.z & 0xffffu), bf2f(w.z >> 16), bf2f(w.w & 0xffffu), bf2f(w.w >> 16)}; }
                    *(u32x4*)(out + off) = pack8(b0 + gv[0] * (acc[ai][bj][m][0] + bv[0]), b1 + gv[1] * (acc[ai][bj][m][1] + bv[1])); }
        }
    }
};
struct EpiGelu {
    static constexpr bool PERM = true;
    bf16 *U, *V; const float* bias; float* vstat;
    __device__ __forceinline__ void operator()(const f32x4 (&acc)[2][2][4][2], const pg8::Unit& u, int wr, int wc, int fr, int fq) const {
        asm volatile("" : "+v"(fr), "+v"(fq));
        const int row0 = u.pm * 256 + wr * 64 + fr; const int colt = u.pn * 256; const bool isv = colt >= 1024; bf16* base = isv ? V : U; const int cb = (colt & 1023) + wc * 32 + 8 * fq, bcol = colt + wc * 32 + 8 * fq;
        f32x4 bv[2][2];
#pragma unroll
        for (int bj = 0; bj < 2; ++bj)
#pragma unroll
            for (int n = 0; n < 2; ++n) bv[bj][n] = *(const f32x4*)(bias + bcol + bj * 128 + 4 * n);
#pragma unroll
        for (int ai = 0; ai < 2; ++ai)
#pragma unroll
            for (int m = 0; m < 4; ++m) { const int row = row0 + ai * 128 + m * 16; bf16* rowp = base + (size_t)row * D + cb; float s = 0.f, s2 = 0.f;
#pragma unroll
                for (int bj = 0; bj < 2; ++bj) { f32x4 v0 = acc[ai][bj][m][0] + bv[bj][0], v1 = acc[ai][bj][m][1] + bv[bj][1];
                    f32x2 a = gelu_pk((f32x2){v0[0], v0[1]}), b = gelu_pk((f32x2){v0[2], v0[3]}), c = gelu_pk((f32x2){v1[0], v1[1]}), d = gelu_pk((f32x2){v1[2], v1[3]});
                    s += (a.x + a.y) + (b.x + b.y) + (c.x + c.y) + (d.x + d.y); s2 += (a.x * a.x + a.y * a.y) + (b.x * b.x + b.y * b.y) + (c.x * c.x + c.y * c.y) + (d.x * d.x + d.y * d.y);
                    *(u32x4*)(rowp + bj * 128) = pack8((f32x4){a.x, a.y, b.x, b.y}, (f32x4){c.x, c.y, d.x, d.y}); }
                if (isv) { s += __shfl_xor(s, 16); s += __shfl_xor(s, 32); s2 += __shfl_xor(s2, 16); s2 += __shfl_xor(s2, 32);
                    if (fq == 0) { unsafeAtomicAdd(vstat + 2 * row, s); unsafeAtomicAdd(vstat + 2 * row + 1, s2); } } }
    }
};
struct EpiSwiglu {
    static constexpr bool PERM = true;
    unsigned char* ACT; const LAS float* lbias;
    __device__ __forceinline__ void operator()(const f32x4 (&acc)[2][2][4][2], const pg8::Unit& u, int wr, int wc, int fr, int fq) const {
        asm volatile("" : "+v"(fr), "+v"(fq));
        const int j0 = u.pn * 128 + wc * 32 + 8 * fq; const LAS float* bb = lbias + u.idx * 256 + wc * 32 + 8 * fq;
        f32x4 bg[2], bu[2];
#pragma unroll
        for (int n = 0; n < 2; ++n) { bg[n] = *(const LAS f32x4*)(bb + 4 * n); bu[n] = *(const LAS f32x4*)(bb + 128 + 4 * n); }
#pragma unroll
        for (int ai = 0; ai < 2; ++ai)
#pragma unroll
            for (int m = 0; m < 4; ++m) { f32x4 o[2];
#pragma unroll
                for (int n = 0; n < 2; ++n) { const f32x4 g4 = acc[ai][0][m][n] * FP8_DESCALE + bg[n], u4 = acc[ai][1][m][n] * FP8_DESCALE + bu[n];
#pragma unroll
                    for (int k = 0; k < 4; ++k) { const float g = fminf(g4[k], 7.0f), up = fminf(fmaxf(u4[k], -7.0f), 7.0f); o[n][k] = (up + 1.0f) * g * sigmoidf_(g * 1.702f); } }
                u32x2 w8; w8.x = pk4_fp8(o[0][0] * FP8_AMUL, o[0][1] * FP8_AMUL, o[0][2] * FP8_AMUL, o[0][3] * FP8_AMUL); w8.y = pk4_fp8(o[1][0] * FP8_AMUL, o[1][1] * FP8_AMUL, o[1][2] * FP8_AMUL, o[1][3] * FP8_AMUL);
                *(u32x2*)(ACT + (size_t)(u.pm + ai * 128 + wr * 64 + m * 16 + fr) * D + j0) = w8; }
    }
};
struct EpiDown {
    static constexpr bool PERM = true;
    bf16* Y; const LAS float* lbias; const LAS int* meta;
    __device__ __forceinline__ void operator()(const f32x4 (&acc)[2][2][4][2], const pg8::Unit& u, int wr, int wc, int fr, int fq) const {
        asm volatile("" : "+v"(fr), "+v"(fq));
        const int c8 = u.pn * 256 + wc * 32 + 8 * fq; const LAS float* bb = lbias + u.idx * 256 + wc * 32 + 8 * fq;
#pragma unroll
        for (int bj = 0; bj < 2; ++bj) {
            f32x4 bv[2];
#pragma unroll
            for (int n = 0; n < 2; ++n) bv[n] = *(const LAS f32x4*)(bb + bj * 128 + 4 * n);
#pragma unroll
            for (int ai = 0; ai < 2; ++ai)
#pragma unroll
                for (int m = 0; m < 4; ++m) { const int r = ai * 128 + wr * 64 + m * 16 + fr; const u32x2 mg = *(const LAS u32x2*)(meta + (u.idx * 256 + r) * 2); const int aid = (int)mg.x; const float g = __uint_as_float(mg.y);
                    const u32x4 w = pack8((acc[ai][bj][m][0] * FP8_DESCALE + bv[0]) * g, (acc[ai][bj][m][1] * FP8_DESCALE + bv[1]) * g);
                    if (r < u.cnt) *(u32x4*)(Y + (size_t)aid * D + c8 + bj * 128) = w; }
        }
    }
};

struct TrItem { const float* src; bf16* dst; int N; int fp8; };
__device__ __forceinline__ void tr_load(const TrItem& t, float (&v)[32], int lane) {
#pragma unroll
    for (int i = 0; i < 32; ++i) v[i] = __builtin_nontemporal_load(t.src + (size_t)(2 * i + (lane >> 5)) * t.N + (lane & 31));
}
__device__ __forceinline__ void tr_store(const TrItem& t, const float (&v)[32], LAS float* scr, int lane) {
#pragma unroll
    for (int i = 0; i < 32; ++i) scr[(2 * i + (lane >> 5)) * 33 + (lane & 31)] = v[i];
    LDS_WAIT();
    if (t.fp8) {
        const int q = lane & 3;
#pragma unroll
        for (int j = 0; j < 2; ++j) { const int n = (lane >> 2) + 16 * j; const LAS float* s = scr + (16 * q) * 33 + n; u32x4 o;
#pragma unroll
            for (int c = 0; c < 4; ++c) o[c] = pk4_fp8(s[(4 * c) * 33] * FP8_WMUL, s[(4 * c + 1) * 33] * FP8_WMUL, s[(4 * c + 2) * 33] * FP8_WMUL, s[(4 * c + 3) * 33] * FP8_WMUL);
            *(u32x4*)((unsigned char*)t.dst + (size_t)n * 1024 + 16 * q) = o; }
    } else {
        const int c = lane & 7;
#pragma unroll
        for (int j = 0; j < 4; ++j) { const int n = (lane >> 3) + 8 * j; const LAS float* s = scr + (8 * c) * 33 + n;
            u32x4 o; o.x = pk2(s[0 * 33], s[1 * 33]); o.y = pk2(s[2 * 33], s[3 * 33]); o.z = pk2(s[4 * 33], s[5 * 33]); o.w = pk2(s[6 * 33], s[7 * 33]);
            *(u32x4*)(t.dst + (size_t)n * 1024 + 8 * c) = o; }
    }
    LDS_WAIT();
}
template <int N, bool PAIR> struct MoeCvt {
    static constexpr int STRIPS = N / 512, ITEMS_PER_MAT = 8 * STRIPS;
    static __device__ __forceinline__ void load(const float* W, int item, f32x4 (&v)[4][2][4], int wave, int lane) {
        const int mat = item / ITEMS_PER_MAT, q = item % ITEMS_PER_MAT, kb = q / STRIPS, sb = q % STRIPS;
        const float* s = W + (size_t)mat * 1024 * N + (size_t)(128 * kb + 16 * wave) * N + 512 * sb + 4 * lane;
#pragma unroll
        for (int g = 0; g < 4; ++g)
#pragma unroll
            for (int hh = 0; hh < 2; ++hh)
#pragma unroll
                for (int r = 0; r < 4; ++r) v[g][hh][r] = __builtin_nontemporal_load((const f32x4*)(s + (size_t)(4 * g + r) * N + 256 * hh));
    }
    static __device__ __forceinline__ void to_lds(const f32x4 (&v)[4][2][4], LAS unsigned* img, int wave, int lane) {
#pragma unroll
        for (int g = 0; g < 4; ++g) { const int kq = 4 * wave + g;
#pragma unroll
            for (int hh = 0; hh < 2; ++hh)
#pragma unroll
                for (int j = 0; j < 4; ++j) { const int rho = 64 * hh + lane + 128 * j;
                    img[rho * 32 + ((kq ^ rho) & 31)] = pk4_fp8(v[g][hh][0][j] * FP8_WMUL, v[g][hh][1][j] * FP8_WMUL, v[g][hh][2][j] * FP8_WMUL, v[g][hh][3][j] * FP8_WMUL); } }
    }
    static __device__ __forceinline__ void store(unsigned char* WT, int item, const LAS unsigned* img, int wave, int lane) {
        const int mat = item / ITEMS_PER_MAT, q = item % ITEMS_PER_MAT, kb = q / STRIPS, sb = q % STRIPS;
        unsigned char* d = WT + (size_t)mat * N * 1024 + 128 * kb;
        const int mi = lane >> 3, c = lane & 7;
#pragma unroll
        for (int st = 0; st < 2; ++st)
#pragma unroll
            for (int j = 0; j < 4; ++j) { const int m = 16 * wave + 8 * st + mi, rho = m + 128 * j, n = 4 * m + j;
                u32x4 o;
#pragma unroll
                for (int i = 0; i < 4; ++i) o[i] = img[rho * 32 + (((4 * c + i) ^ rho) & 31)];
                int drow;
                if (PAIR) { const int h = sb >> 1, rem = 512 * (sb & 1) + n; drow = (rem >> 7) * 256 + h * 128 + (rem & 127); } else drow = 512 * sb + n;
                __builtin_nontemporal_store(o, (u32x4*)(d + (size_t)drow * 1024 + 16 * c)); }
    }
    static __device__ __forceinline__ void run(const float* W, unsigned char* WT, int nitems, int first, int stride, LAS unsigned char* lds, int wave, int lane) {
        f32x4 v[4][2][4]; int it = first, buf = 0;
        if (it < nitems) load(W, it, v, wave, lane);
        while (it < nitems) {
            LAS unsigned* img = (LAS unsigned*)(lds + buf * 65536);
            to_lds(v, img, wave, lane);
            __syncthreads();
            const int nx = it + stride; if (nx < nitems) load(W, nx, v, wave, lane);
            store(WT, it, img, wave, lane);
            it = nx; buf ^= 1;
        }
        __syncthreads();
    }
};

__device__ __forceinline__ int pair_src(int nd, int halfw) { return ((nd & 255) >> 7) * halfw + (nd >> 8) * 128 + (nd & 127); }

__device__ __forceinline__ void phase_prologue(const Args& a, const Ctx& X) {
    PMARK(20);
    {
        LAS float* sc = (LAS float*)X.lds;
        LAS float* red = (LAS float*)(X.lds + 36864);
        float* MOD = (float*)(X.ws + WS_MOD);
        for (int item = X.bid; item < 2 * 96; item += X.G) {
            const int l = item / 96, j0 = (item % 96) * 64;
            for (int idx = X.tid; idx < 9 * 1024; idx += NTHREADS) { const int r = idx >> 10, k = idx & 1023; const float v = r < 8 ? IN(I_C)[r * 1024 + k] : IN(I_CCTX)[k]; sc[idx] = v * sigmoidf_(v); }
            __syncthreads();
            float acc[9];
#pragma unroll
            for (int r = 0; r < 9; ++r) acc[r] = 0.f;
            const float* w = IN(I_ADAW) + (size_t)l * 1024 * MODW + j0 + X.lane;
#pragma unroll 8
            for (int k = X.wave * 128; k < X.wave * 128 + 128; ++k) { const float wv = __builtin_nontemporal_load(w + (size_t)k * MODW);
#pragma unroll
                for (int r = 0; r < 9; ++r) acc[r] += sc[r * 1024 + k] * wv; }
#pragma unroll
            for (int r = 0; r < 9; ++r) red[(X.wave * 9 + r) * 64 + X.lane] = acc[r];
            __syncthreads();
            for (int t = X.tid; t < 9 * 64; t += NTHREADS) { const int r = t >> 6, cidx = t & 63; float s = 0.f;
#pragma unroll
                for (int w8 = 0; w8 < 8; ++w8) s += red[(w8 * 9 + r) * 64 + cidx];
                MOD[((size_t)l * 9 + r) * MODW + j0 + cidx] = s + IN(I_ADAB)[l * MODW + j0 + cidx]; }
            __syncthreads();
        }
    }
    PMARK(21);
    LAS float* scr = (LAS float*)(X.lds + X.wave * 16384);
    bf16* WinT = (bf16*)(X.ws + WS_WINT); bf16* WoutT = (bf16*)(X.ws + WS_WOUTT); bf16* GWinT = (bf16*)(X.ws + WS_GWINT); bf16* GWoutT = (bf16*)(X.ws + WS_GWOUTT);
    bf16* W1T = (bf16*)(X.ws + WS_W1T); bf16* W2T = (bf16*)(X.ws + WS_W2T);
    constexpr int I_IN = 16 * (EVEN_IN / 32), I_OUT = 16 * 32, I_GIN = 16 * 64, I_GOUT = 16 * 32;
    constexpr int NITEMS = I_IN + I_OUT + I_GIN + I_GOUT;
    auto item_of = [&](int it) -> TrItem {
        int r = it; TrItem t; t.fp8 = 0;
        if (r < I_IN) { const int kb = r / 56, nd = (r % 56) * 32; const int ns = nd < 1024 ? pair_src(nd, 512) : nd; t.N = EVEN_IN; t.src = IN(I_EWIN) + (size_t)kb * 64 * EVEN_IN + ns; t.dst = WinT + (size_t)nd * 1024 + kb * 64; return t; } r -= I_IN;
        if (r < I_OUT) { const int kb = r >> 5, nd = (r & 31) * 32; t.N = 1024; t.src = IN(I_EWOUT) + (size_t)kb * 64 * 1024 + nd; t.dst = WoutT + (size_t)nd * 1024 + kb * 64; return t; } r -= I_OUT;
        if (r < I_GIN) { const int kb = r >> 6, nd = (r & 63) * 32; t.N = 2048; t.src = IN(I_OWIN) + (size_t)kb * 64 * 2048 + nd; t.dst = GWinT + (size_t)nd * 1024 + kb * 64; return t; } r -= I_GIN;
        { const int kb = r >> 5, nd = (r & 31) * 32; t.N = 1024; t.src = IN(I_OWOUT) + (size_t)kb * 64 * 1024 + nd; t.dst = GWoutT + (size_t)nd * 1024 + kb * 64; return t; }
    };
    {
        float va[32], vb[32]; int it = X.gw;
        TrItem ta, tb; if (it < NITEMS) { ta = item_of(it); tr_load(ta, va, X.lane); }
        while (it < NITEMS) {
            const int it1 = it + X.NGW; if (it1 < NITEMS) { tb = item_of(it1); tr_load(tb, vb, X.lane); }
            tr_store(ta, va, scr, X.lane);
            if (it1 >= NITEMS) break;
            const int it2 = it1 + X.NGW; if (it2 < NITEMS) { ta = item_of(it2); tr_load(ta, va, X.lane); }
            tr_store(tb, vb, scr, X.lane);
            it = it2;
        }
    }
    __syncthreads();
    MoeCvt<2048, true>::run(IN(I_W1), (unsigned char*)W1T, 64 * MoeCvt<2048, true>::ITEMS_PER_MAT, X.vcu, X.G, X.lds, X.wave, X.lane);
    MoeCvt<1024, false>::run(IN(I_W2), (unsigned char*)W2T, 64 * MoeCvt<1024, false>::ITEMS_PER_MAT, X.vcu, X.G, X.lds, X.wave, X.lane);
    PMARK(22);
    { bf16* WsB = (bf16*)(X.ws + WS_WSB); const float* ws = IN(I_OWS);
      for (int i = (X.gw * 64 + X.lane) * 4; i < 8 * 128 * 128; i += X.NGW * 64 * 4) { const f32x4 v = *(const f32x4*)(ws + i); u32x2 o; o.x = pk2(v[0], v[1]); o.y = pk2(v[2], v[3]); *(u32x2*)(WsB + i) = o; } }
}

__device__ __forceinline__ void modulate_row(const float* xrow, const float* g, const float* sh, const float* sc, bf16* orow, int lane, f32x4 (&y)[4]) {
    const f32x4* xr = (const f32x4*)xrow + lane; f32x4 v[4]; float ss = 0.f;
#pragma unroll
    for (int j = 0; j < 4; ++j) { v[j] = xr[64 * j]; ss += (v[j][0] * v[j][0] + v[j][1] * v[j][1]) + (v[j][2] * v[j][2] + v[j][3] * v[j][3]); }
    const float rstd = rsqrtf(wave_sum(ss) * (1.0f / D) + EPS);
#pragma unroll
    for (int j = 0; j < 4; ++j) { const f32x4 gk = ((const f32x4*)g)[lane + 64 * j], sk = ((const f32x4*)sc)[lane + 64 * j], hk = ((const f32x4*)sh)[lane + 64 * j];
        y[j] = v[j] * rstd * gk * (1.0f + sk) + hk;
        u32x2 o; o.x = pk2(y[j][0], y[j][1]); o.y = pk2(y[j][2], y[j][3]); *((u32x2*)orow + lane + 64 * j) = o; }
}
__device__ __forceinline__ void mod0_load(const Ctx& X, int row, f32x4 (&v)[4]) {
    const float* xrow = row < NTOK ? IN(I_X) + (size_t)row * D : IN(I_CTX) + (size_t)(row - NTOK) * D;
#pragma unroll
    for (int j = 0; j < 4; ++j) v[j] = ((const f32x4*)xrow)[X.lane + 64 * j];
}
__device__ __forceinline__ void mod0_finish(const Ctx& X, int row, const f32x4 (&v)[4]) {
    const float* m = (const float*)(X.ws + WS_MOD) + (size_t)(row < NTOK ? row / SEQ : 8) * MODW; const float* g = IN(I_NMG);
    bf16* orow = row < NTOK ? (bf16*)(X.ws + WS_XA) + (size_t)row * D : (bf16*)(X.ws + WS_GM) + (size_t)(row - NTOK) * D;
    f32x4 gk[4], hk[4], sk[4]; float ss = 0.f;
#pragma unroll
    for (int j = 0; j < 4; ++j) { gk[j] = ((const f32x4*)g)[X.lane + 64 * j]; hk[j] = ((const f32x4*)m)[X.lane + 64 * j]; sk[j] = ((const f32x4*)(m + 1024))[X.lane + 64 * j];
        ss += (v[j][0] * v[j][0] + v[j][1] * v[j][1]) + (v[j][2] * v[j][2] + v[j][3] * v[j][3]); }
    const float rstd = rsqrtf(wave_sum(ss) * (1.0f / D) + EPS);
#pragma unroll
    for (int j = 0; j < 4; ++j) { const f32x4 y = v[j] * rstd * gk[j] * (1.0f + sk[j]) + hk[j]; u32x2 o; o.x = pk2(y[0], y[1]); o.y = pk2(y[2], y[3]); *((u32x2*)orow + X.lane + 64 * j) = o; }
}
__device__ __forceinline__ void phase_modulate0(const Args& a, const Ctx& X) {
    constexpr int NR = NTOK + NCTX; f32x4 va[4], vb[4];
    int row = X.gw; if (row < NR) mod0_load(X, row, va);
    while (row < NR) {
        const int r1 = row + X.NGW; if (r1 < NR) mod0_load(X, r1, vb);
        mod0_finish(X, row, va);
        if (r1 >= NR) break;
        const int r2 = r1 + X.NGW; if (r2 < NR) mod0_load(X, r2, va);
        mod0_finish(X, r1, vb);
        row = r2;
    }
}

__device__ __forceinline__ void qk_chunks(bf16* buf, int nchunks, int rowlen, const float* gn, bool rope, float oscale, const Ctx& X, const LAS f32x2* cs) {
    for (int ch = X.gw; ch < nchunks; ch += X.NGW) {
        const int e0 = ch * 512 + 8 * X.lane; const int token = e0 / rowlen; const int d0 = e0 & 63;
        u32x4 raw = *(const u32x4*)(buf + e0); float v[8];
#pragma unroll
        for (int i = 0; i < 4; ++i) { v[2 * i] = bf2f(raw[i] & 0xffffu); v[2 * i + 1] = bf2f(raw[i] >> 16); }
        float ss = 0.f;
#pragma unroll
        for (int i = 0; i < 8; ++i) ss += v[i] * v[i];
        ss += __shfl_xor(ss, 1); ss += __shfl_xor(ss, 2); ss += __shfl_xor(ss, 4);
        const float rstd = rsqrtf(ss * (1.0f / 64.0f) + EPS);
        const f32x4 g0 = *(const f32x4*)(gn + d0), g1 = *(const f32x4*)(gn + d0 + 4);
#pragma unroll
        for (int i = 0; i < 4; ++i) { v[i] = v[i] * rstd * g0[i]; v[4 + i] = v[4 + i] * rstd * g1[i]; }
        if (rope) {
            const int t = token % SEQ; const int dd0 = d0 & 31; const int pos = dd0 < 16 ? (t >> 6) : (t & 63);
            const LAS f32x2* cp = cs + pos * 16 + (dd0 & 15);
#pragma unroll
            for (int i = 0; i < 8; ++i) { const float pv = __shfl_xor(v[i], 4); const f32x2 c = cp[i];
                v[i] = (d0 < 32) ? (v[i] * c.x - pv * c.y) : (v[i] * c.x + pv * c.y); }
        }
        u32x4 o; o.x = pk2(v[0] * oscale, v[1] * oscale); o.y = pk2(v[2] * oscale, v[3] * oscale); o.z = pk2(v[4] * oscale, v[5] * oscale); o.w = pk2(v[6] * oscale, v[7] * oscale);
        *(u32x4*)(buf + e0) = o;
    }
}
__device__ __forceinline__ void phase_conv_qk(const Args& a, const Ctx& X) {
    LAS f32x2* cs = (LAS f32x2*)(X.lds + 65536);
    for (int i = X.tid; i < 1024; i += NTHREADS) { const float inv = exp2f(-(float)(i & 15) * (13.287712379549449f / 16.0f)); float sn, csn; sincosf((float)(i >> 4) * inv, &sn, &csn); cs[i] = (f32x2){csn, sn}; }
    __syncthreads();
    qk_chunks((bf16*)(X.ws + WS_Q), NTOK, 512, IN(I_QNG), true, QSCALE, X, cs);
    qk_chunks((bf16*)(X.ws + WS_K), NTOK / 4, 128, IN(I_KNG), true, 1.0f, X, cs);
    qk_chunks((bf16*)(X.ws + WS_KC), NCTX / 4, 128, IN(I_KNG), false, 1.0f, X, cs);
    const bf16* GLU = (const bf16*)(X.ws + WS_GLU); bf16* MIX = (bf16*)(X.ws + WS_MIX);
    LAS unsigned* tin = (LAS unsigned*)X.lds;
    LAS float* tout = (LAS float*)(X.lds + 65536);
    const int cp = X.tid & 255, th = X.tid >> 8;
    float w0[31], w1[31];
#pragma unroll
    for (int j = 0; j < 31; ++j) { const f32x2 w = *(const f32x2*)(IN(I_ECW) + j * 512 + 2 * cp); w0[j] = w.x; w1[j] = w.y; }
    const f32x2 cb = *(const f32x2*)(IN(I_ECB) + 2 * cp);
    for (int tile = X.bid; tile < NTOK / 32; tile += X.G) {
        const int row0 = tile * 32; const int t0 = row0 % SEQ;
        __syncthreads();
        for (int c = X.tid; c < 62 * 64; c += NTHREADS) { const int lr = c >> 6, cc = c & 63; const int t = t0 - 15 + lr;
            u32x4 v = (u32x4){0u, 0u, 0u, 0u}; if (t >= 0 && t < SEQ) v = *(const u32x4*)(GLU + (size_t)(row0 - 15 + lr) * 512 + cc * 8);
            *(LAS u32x4*)(tin + lr * 256 + cc * 4) = v; }
        __syncthreads();
        float a0[16], a1[16];
#pragma unroll
        for (int o = 0; o < 16; ++o) { a0[o] = cb.x; a1[o] = cb.y; }
#pragma unroll
        for (int rr = 0; rr < 46; ++rr) { const unsigned pv = tin[(16 * th + rr) * 256 + cp]; const float x0 = bf2f(pv & 0xffffu), x1 = bf2f(pv >> 16);
#pragma unroll
            for (int o = 0; o < 16; ++o) { const int j = rr - o; if (j >= 0 && j <= 30) { a0[o] += x0 * w0[j]; a1[o] += x1 * w1[j]; } } }
#pragma unroll
        for (int o = 0; o < 16; ++o) *(LAS f32x2*)(tout + (16 * th + o) * 512 + 2 * cp) = (f32x2){a0[o], a1[o]};
        __syncthreads();
#pragma unroll
        for (int q = 0; q < 4; ++q) { const int tl = X.wave * 4 + q; f32x4 v[2]; float s = 0.f;
#pragma unroll
            for (int j = 0; j < 2; ++j) { v[j] = *(const LAS f32x4*)(tout + tl * 512 + 4 * X.lane + 256 * j); s += (v[j][0] + v[j][1]) + (v[j][2] + v[j][3]); }
            const float mean = wave_sum(s) * (1.0f / 512.0f); float s2 = 0.f;
#pragma unroll
            for (int j = 0; j < 2; ++j) { v[j] = v[j] - mean; s2 += (v[j][0] * v[j][0] + v[j][1] * v[j][1]) + (v[j][2] * v[j][2] + v[j][3] * v[j][3]); }
            const float rstd = rsqrtf(wave_sum(s2) * (1.0f / 512.0f) + EPS);
#pragma unroll
            for (int j = 0; j < 2; ++j) { const f32x4 g = *(const f32x4*)(IN(I_ELNG) + 4 * X.lane + 256 * j), b = *(const f32x4*)(IN(I_ELNB) + 4 * X.lane + 256 * j);
                f32x4 y = v[j] * rstd * g + b;
#pragma unroll
                for (int k = 0; k < 4; ++k) y[k] = y[k] * sigmoidf_(y[k]);
                u32x2 o; o.x = pk2(y[0], y[1]); o.y = pk2(y[2], y[3]); *(u32x2*)(MIX + (size_t)(row0 + tl) * D + 4 * X.lane + 256 * j) = o; } }
    }
}

__device__ __forceinline__ void phase_attention(const Args& a, const Ctx& X) {
    unsigned char* const wsb = X.ws;
    LAS unsigned char* Ks = X.lds;
    LAS unsigned char* Vt = X.lds + 16384;
    const int lane = X.lane, l15 = lane & 15, g4 = lane >> 4;
    for (int unit = X.bid; unit < NB * 2 * 32; unit += X.G) {
        const int b = unit >> 6, kh = (unit >> 5) & 1, qb = unit & 31; const int q0 = qb * 64;
        const int hq = kh * 4 + (X.wave >> 1), tq = (X.wave & 1) * 32;
        bf16x8 Qf[2][2];
#pragma unroll
        for (int qi = 0; qi < 2; ++qi)
#pragma unroll
            for (int s = 0; s < 2; ++s) Qf[qi][s] = *(const bf16x8*)(wsb + (unsigned)(WS_Q + 2u * (unsigned)((b * SEQ + q0 + tq + 16 * qi + l15) * 512 + hq * 64 + 32 * s + 8 * g4)));
        const float sink2 = IN(I_SINK)[hq] * LOG2E;
        float mrun[2], lrun[2]; f32x4 O[2][4];
#pragma unroll
        for (int qi = 0; qi < 2; ++qi) { mrun[qi] = sink2; lrun[qi] = (g4 == 0) ? 1.0f : 0.0f;
#pragma unroll
            for (int db = 0; db < 4; ++db) O[qi][db] = (f32x4){0.f, 0.f, 0.f, 0.f}; }
        const int t_first = (q0 >= 128) ? 0 : (q0 >= 64 ? 1 : 2), t_skip_lo = (q0 + 128 < SEQ) ? 5 : (q0 + 64 < SEQ ? 4 : 3);
        const int key = X.tid >> 3, ch = X.tid & 7;
        auto tile_offs = [&](int t, unsigned& ko, unsigned& vo) {
            if (t < 5) { const unsigned e = (unsigned)((b * SEQ + q0 - 128 + 64 * t) * 128 + kh * 64) * 2u; ko = (unsigned)WS_K + e; vo = (unsigned)WS_V + e; }
            else { const unsigned e = (unsigned)((b * CTXL + (t - 5) * 64) * 128 + kh * 64) * 2u; ko = (unsigned)WS_KC + e; vo = (unsigned)WS_VC + e; } };
        const unsigned lane_off = (unsigned)(key * 128 + ch * 8) * 2u;
        auto lds_put = [&](int buf, const u32x4& kv, const u32x4& vv) {
            LAS unsigned char* Kd = Ks + buf * 32768; LAS unsigned char* Vd = Vt + buf * 32768;
            *(LAS u32x4*)(Kd + key * 144 + ch * 16) = kv;
#pragma unroll
            for (int i = 0; i < 4; ++i) { *(LAS unsigned short*)(Vd + (8 * ch + 2 * i) * 136 + key * 2) = (unsigned short)(vv[i] & 0xffffu); *(LAS unsigned short*)(Vd + (8 * ch + 2 * i + 1) * 136 + key * 2) = (unsigned short)(vv[i] >> 16); } };
        u32x4 kreg, vreg;
        { unsigned ko, vo; tile_offs(t_first, ko, vo); kreg = *(const u32x4*)(wsb + (ko + lane_off)); vreg = *(const u32x4*)(wsb + (vo + lane_off)); }
        __syncthreads();
        lds_put(0, kreg, vreg);
        int bufi = 0;
        for (int t = t_first; t < 9; ++t) {
            if (t >= t_skip_lo && t < 5) continue;
            int tn = t + 1; if (tn >= t_skip_lo && tn < 5) tn = 5;
            if (tn < 9) { unsigned ko, vo; tile_offs(tn, ko, vo); kreg = *(const u32x4*)(wsb + (ko + lane_off)); vreg = *(const u32x4*)(wsb + (vo + lane_off)); }
            const int mode = (t == 0) ? 1 : (t == 4 ? 2 : 0);
            __syncthreads();
            const LAS unsigned char* Kc = Ks + bufi * 32768; const LAS unsigned char* Vc = Vt + bufi * 32768;
            bf16x8 kf[4][2];
#pragma unroll
            for (int kb = 0; kb < 4; ++kb)
#pragma unroll
                for (int s = 0; s < 2; ++s) kf[kb][s] = *(const LAS bf16x8*)(Kc + (16 * kb + l15) * 144 + (32 * s + 8 * g4) * 2);
            bf16x8 vf[4][2];
#pragma unroll
            for (int db = 0; db < 4; ++db)
#pragma unroll
                for (int ks2 = 0; ks2 < 2; ++ks2) { const LAS unsigned char* p = Vc + (16 * db + l15) * 136 + (32 * ks2 + 4 * g4) * 2;
                    const u32x2 lo = *(const LAS u32x2*)p, hi = *(const LAS u32x2*)(p + 32);
                    u32x4 w; w.x = lo.x; w.y = lo.y; w.z = hi.x; w.w = hi.y; vf[db][ks2] = __builtin_bit_cast(bf16x8, w); }
#pragma unroll
            for (int qi = 0; qi < 2; ++qi) {
                f32x4 st[4];
#pragma unroll
                for (int kb = 0; kb < 4; ++kb) { st[kb] = (f32x4){0.f, 0.f, 0.f, 0.f};
#pragma unroll
                    for (int s = 0; s < 2; ++s) st[kb] = __builtin_amdgcn_mfma_f32_16x16x32_bf16(kf[kb][s], Qf[qi][s], st[kb], 0, 0, 0); }
                if (mode) { int qloc = tq + 16 * qi + l15; asm volatile("" : "+v"(qloc));
#pragma unroll
                    for (int kb = 0; kb < 4; ++kb)
#pragma unroll
                        for (int r = 0; r < 4; ++r) { const int kk = 16 * kb + 4 * g4 + r; const bool keep = (mode == 1) ? (kk >= qloc) : (kk <= qloc); if (!keep) st[kb][r] = -1e30f; } }
                float mx = st[0][0];
#pragma unroll
                for (int kb = 0; kb < 4; ++kb)
#pragma unroll
                    for (int r = 0; r < 4; ++r) mx = fmaxf(mx, st[kb][r]);
                mx = fmaxf(mx, __shfl_xor(mx, 16)); mx = fmaxf(mx, __shfl_xor(mx, 32));
                const float mnew = fmaxf(mrun[qi], mx); const float alpha = __builtin_amdgcn_exp2f(mrun[qi] - mnew); mrun[qi] = mnew;
                float ps = 0.f;
#pragma unroll
                for (int kb = 0; kb < 4; ++kb)
#pragma unroll
                    for (int r = 0; r < 4; ++r) { st[kb][r] = __builtin_amdgcn_exp2f(st[kb][r] - mnew); ps += st[kb][r]; }
                lrun[qi] = lrun[qi] * alpha + ps;
#pragma unroll
                for (int db = 0; db < 4; ++db) O[qi][db] = O[qi][db] * alpha;
#pragma unroll
                for (int ks2 = 0; ks2 < 2; ++ks2) { u32x4 w; w.x = pk2(st[2 * ks2][0], st[2 * ks2][1]); w.y = pk2(st[2 * ks2][2], st[2 * ks2][3]); w.z = pk2(st[2 * ks2 + 1][0], st[2 * ks2 + 1][1]); w.w = pk2(st[2 * ks2 + 1][2], st[2 * ks2 + 1][3]);
                    const bf16x8 pf = __builtin_bit_cast(bf16x8, w);
#pragma unroll
                    for (int db = 0; db < 4; ++db) O[qi][db] = __builtin_amdgcn_mfma_f32_16x16x32_bf16(vf[db][ks2], pf, O[qi][db], 0, 0, 0); }
            }
            if (tn < 9) lds_put(bufi ^ 1, kreg, vreg);
            bufi ^= 1;
        }
#pragma unroll
        for (int qi = 0; qi < 2; ++qi) { float l = lrun[qi]; l += __shfl_xor(l, 16); l += __shfl_xor(l, 32); const float inv = 1.0f / l;
            bf16* orow = (bf16*)(wsb + (unsigned)(WS_MIX + 2u * (unsigned)((b * SEQ + q0 + tq + 16 * qi + l15) * D + 512 + hq * 64 + 4 * g4)));
#pragma unroll
            for (int db = 0; db < 4; ++db) { u32x2 o; o.x = pk2(O[qi][db][0] * inv, O[qi][db][1] * inv); o.y = pk2(O[qi][db][2] * inv, O[qi][db][3] * inv); *(u32x2*)(orow + 16 * db) = o; } }
    }
}

__device__ __forceinline__ void phase_router(const Args& a, const Ctx& X, int layer) {
    const bf16* __restrict__ H = (const bf16*)(X.ws + WS_H); unsigned char* XA8 = (unsigned char*)(X.ws + WS_XA8);
    const float* MODl = (const float*)(X.ws + WS_MOD) + (size_t)layer * 9 * MODW; const float* gn = IN(I_NFG) + layer * D;
    const float* rw = IN(I_RW) + (size_t)layer * D * NE; const float* rb = IN(I_RB) + layer * NE;
    int* cntg = (int*)(X.ws + WS_CTL) + CW_CNT + layer * NE * CNT_STRIDE; int* list = (int*)(X.ws + WS_LIST); float* gatew = (float*)(X.ws + WS_GATE);
    constexpr int YS = 1028;
    LAS float* ybuf = (LAS float*)X.lds;
    LAS float* part = (LAS float*)(X.lds + 66048);
    LAS int* sel = (LAS int*)(X.lds + 66048 + 16384);
    LAS int* lcnt = (LAS int*)(X.lds + 66048 + 16384 + 1024);
    LAS float* lgs = (LAS float*)(X.lds + 66048 + 16384 + 2048);
    LAS float* tvs = lgs + 512;
    LAS float* exs = lgs + 528;
    PMARK(0);
    const int e = X.lane & 31, hf = X.lane >> 5;
    const int e16 = X.lane & 15, kq = X.lane >> 4;
    float wreg[32][2];
#pragma unroll
    for (int s = 0; s < 32; ++s)
#pragma unroll
        for (int nb = 0; nb < 2; ++nb) wreg[s][nb] = rw[(size_t)(128 * X.wave + 4 * s + kq) * NE + 16 * nb + e16];
    const float rbe = rb[e];
    for (int blk = X.bid; blk < NTOK / 64; blk += X.G) {
        const int rowbase = blk * 64; const float* m = MODl + (size_t)(rowbase / SEQ) * MODW;
        f32x4 gk[4], hk[4], xv[2][4];
#pragma unroll
        for (int j = 0; j < 4; ++j) { gk[j] = ((const f32x4*)gn)[X.lane + 64 * j]; hk[j] = ((const f32x4*)(m + 3 * 1024))[X.lane + 64 * j]; const f32x4 s_ = ((const f32x4*)(m + 4 * 1024))[X.lane + 64 * j]; gk[j] = gk[j] * (1.0f + s_); }
#pragma unroll
        for (int i = 0; i < 2; ++i)
#pragma unroll
            for (int j = 0; j < 4; ++j) { const u32x2 w = ((const u32x2*)(H + (size_t)(rowbase + 2 * X.wave + i) * D))[X.lane + 64 * j]; xv[i][j] = (f32x4){bf2f(w.x & 0xffffu), bf2f(w.x >> 16), bf2f(w.y & 0xffffu), bf2f(w.y >> 16)}; }
        __syncthreads();
        if (X.tid < 64) lcnt[X.tid] = 0;
        PMARK(1);
#pragma unroll 1
        for (int bt = 0; bt < 4; ++bt) {
#pragma unroll
            for (int i = 0; i < 2; ++i) { const int rl = 2 * X.wave + i, row = rowbase + 16 * bt + rl; float ss = 0.f;
#pragma unroll
                for (int j = 0; j < 4; ++j) ss += (xv[i][j][0] * xv[i][j][0] + xv[i][j][1] * xv[i][j][1]) + (xv[i][j][2] * xv[i][j][2] + xv[i][j][3] * xv[i][j][3]);
                const float rstd = rsqrtf(wave_sum(ss) * (1.0f / D) + EPS);
#pragma unroll
                for (int j = 0; j < 4; ++j) { const f32x4 y = xv[i][j] * rstd * gk[j] + hk[j];
                    *((unsigned*)(XA8 + (size_t)row * D) + X.lane + 64 * j) = pk4_fp8(y[0] * FP8_AMUL, y[1] * FP8_AMUL, y[2] * FP8_AMUL, y[3] * FP8_AMUL);
                    *(LAS f32x4*)(ybuf + rl * YS + 4 * X.lane + 256 * j) = y; } }
            if (bt < 3) {
#pragma unroll
                for (int i = 0; i < 2; ++i)
#pragma unroll
                    for (int j = 0; j < 4; ++j) { const u32x2 w = ((const u32x2*)(H + (size_t)(rowbase + 16 * (bt + 1) + 2 * X.wave + i) * D))[X.lane + 64 * j]; xv[i][j] = (f32x4){bf2f(w.x & 0xffffu), bf2f(w.x >> 16), bf2f(w.y & 0xffffu), bf2f(w.y >> 16)}; }
            }
            __syncthreads();
            { f32x4 acc0 = (f32x4){0.f, 0.f, 0.f, 0.f}, acc1 = acc0; const LAS float* yp = ybuf + e16 * YS + 128 * X.wave + kq;
#pragma unroll
              for (int s = 0; s < 32; ++s) { const float av = yp[4 * s];
                  acc0 = __builtin_amdgcn_mfma_f32_16x16x4f32(av, wreg[s][0], acc0, 0, 0, 0); acc1 = __builtin_amdgcn_mfma_f32_16x16x4f32(av, wreg[s][1], acc1, 0, 0, 0); }
#pragma unroll
              for (int r = 0; r < 4; ++r) { part[((4 * kq + r) * 8 + X.wave) * 32 + e16] = acc0[r]; part[((4 * kq + r) * 8 + X.wave) * 32 + 16 + e16] = acc1[r]; } }
            __syncthreads();
            { const int r = 2 * X.wave + hf, rl = 16 * bt + r;
              float v = rbe;
#pragma unroll
              for (int w8 = 0; w8 < 8; ++w8) v += part[(r * 8 + w8) * 32 + e];
              lgs[r * 32 + e] = v; LDS_WAIT();
              int ez = e; asm volatile("" : "+v"(ez));
              int rank = 0;
#pragma unroll
              for (int j4 = 0; j4 < 8; ++j4) { const f32x4 o = *(const LAS f32x4*)(lgs + r * 32 + 4 * j4);
#pragma unroll
                  for (int c = 0; c < 4; ++c) rank += (o[c] > v || (o[c] == v && (4 * j4 + c) < ez)) ? 1 : 0; }
              if (rank == 0) tvs[r] = v;
              LDS_WAIT();
              const float ex = __expf(v - tvs[r]);
              if (rank < 4) exs[r * 4 + rank] = ex;
              LDS_WAIT();
              const f32x4 e4 = *(const LAS f32x4*)(exs + r * 4); const float inv = 1.0f / ((e4[0] + e4[1]) + (e4[2] + e4[3]));
              if (rank < 4) { const int slot = atomicAdd((int*)&lcnt[e], 1); sel[rl * 4 + rank] = (e << 16) | slot; gatew[(size_t)(rowbase + rl) * 4 + rank] = ex * inv; } }
        }
        __syncthreads();
        PMARK(2);
        if (X.tid < 32) lcnt[32 + X.tid] = atomicAdd(cntg + X.tid * CNT_STRIDE, lcnt[X.tid]);
        __syncthreads();
        if (X.tid < 256) { const int w = sel[X.tid]; const int ee = w >> 16, rank = w & 0xffff; list[(size_t)ee * NTOK + lcnt[32 + ee] + rank] = rowbase * 4 + X.tid; }
    }
    PMARK(3);
}

__device__ __forceinline__ void phase_combine(const Args& a, const Ctx& X, int layer) {
    bf16* H = (bf16*)(X.ws + WS_H); const bf16* __restrict__ Y = (const bf16*)(X.ws + WS_Y); bf16* XA = (bf16*)(X.ws + WS_XA);
    const float* __restrict__ MODl = (const float*)(X.ws + WS_MOD) + (size_t)layer * 9 * MODW;
    float* outp = (float*)(__attribute__((address_space(1))) float*)X.kp[33];
    for (int row = X.gw; row < NTOK; row += X.NGW) {
        const float* gt = MODl + (size_t)(row / SEQ) * MODW + 5 * 1024; f32x4 h[2][2], g[2][2]; u32x4 yw[2][4];
#pragma unroll
        for (int j = 0; j < 2; ++j) { const int c0 = 8 * X.lane + 512 * j;
#pragma unroll
            for (int q = 0; q < 2; ++q) g[j][q] = *(const f32x4*)(gt + c0 + 4 * q);
            { const u32x4 w = *(const u32x4*)(H + (size_t)row * D + c0); h[j][0] = (f32x4){bf2f(w.x & 0xffffu), bf2f(w.x >> 16), bf2f(w.y & 0xffffu), bf2f(w.y >> 16)}; h[j][1] = (f32x4){bf2f(w.z & 0xffffu), bf2f(w.z >> 16), bf2f(w.w & 0xffffu), bf2f(w.w >> 16)}; }
#pragma unroll
            for (int k = 0; k < 4; ++k) yw[j][k] = *(const u32x4*)(Y + ((size_t)row * 4 + k) * D + c0); }
        float ss = 0.f;
#pragma unroll
        for (int j = 0; j < 2; ++j) { f32x4 s0 = (f32x4){0.f, 0.f, 0.f, 0.f}, s1 = s0;
#pragma unroll
            for (int k = 0; k < 4; ++k) { const u32x4 w = yw[j][k]; s0 += (f32x4){bf2f(w.x & 0xffffu), bf2f(w.x >> 16), bf2f(w.y & 0xffffu), bf2f(w.y >> 16)}; s1 += (f32x4){bf2f(w.z & 0xffffu), bf2f(w.z >> 16), bf2f(w.w & 0xffffu), bf2f(w.w >> 16)}; }
            h[j][0] = h[j][0] + g[j][0] * s0; h[j][1] = h[j][1] + g[j][1] * s1;
#pragma unroll
            for (int q = 0; q < 2; ++q) ss += (h[j][q][0] * h[j][q][0] + h[j][q][1] * h[j][q][1]) + (h[j][q][2] * h[j][q][2] + h[j][q][3] * h[j][q][3]); }
        if (layer == 1) {
#pragma unroll
            for (int j = 0; j < 2; ++j)
#pragma unroll
                for (int q = 0; q < 2; ++q) *(f32x4*)(outp + (size_t)row * D + 8 * X.lane + 512 * j + 4 * q) = h[j][q];
        } else {
            const float* m1 = (const float*)(X.ws + WS_MOD) + (size_t)9 * MODW + (size_t)(row / SEQ) * MODW; const float* gn = IN(I_NMG) + D;
            f32x4 gk[2][2], hk[2][2], sk[2][2];
#pragma unroll
            for (int j = 0; j < 2; ++j)
#pragma unroll
                for (int q = 0; q < 2; ++q) { const int c0 = 8 * X.lane + 512 * j + 4 * q; gk[j][q] = *(const f32x4*)(gn + c0); hk[j][q] = *(const f32x4*)(m1 + c0); sk[j][q] = *(const f32x4*)(m1 + 1024 + c0); }
            const float rstd = rsqrtf(wave_sum(ss) * (1.0f / D) + EPS);
#pragma unroll
            for (int j = 0; j < 2; ++j) { const int c0 = 8 * X.lane + 512 * j;
                const f32x4 y0 = h[j][0] * rstd * gk[j][0] * (1.0f + sk[j][0]) + hk[j][0], y1 = h[j][1] * rstd * gk[j][1] * (1.0f + sk[j][1]) + hk[j][1];
                *(u32x4*)(H + (size_t)row * D + c0) = pack8(h[j][0], h[j][1]);
                *(u32x4*)(XA + (size_t)row * D + c0) = pack8(y0, y1); }
        }
    }
}

__device__ __forceinline__ void phase_spatial(const Args& a, const Ctx& X) {
    const bf16* U = (const bf16*)(X.ws + WS_U); const bf16* VB = (const bf16*)(X.ws + WS_VB); bf16* SG = (bf16*)(X.ws + WS_MIX); const bf16* WsB = (const bf16*)(X.ws + WS_WSB); const float* vstat = (const float*)(X.ws + WS_CTL) + CW_VSTAT;
    LAS float* stat = (LAS float*)X.lds;
    LAS unsigned char* Vt = X.lds + 4096;
    const int lane = X.lane, l15 = lane & 15, g4 = lane >> 4;
    for (int item = X.bid; item < 128 * 8; item += X.G) {
        const int chunk = item >> 3, g = item & 7; const int row0 = chunk * 128;
        __syncthreads();
        if (X.tid < 128) { const f32x2 sv = *(const f32x2*)(vstat + 2 * (row0 + X.tid)); const float mean = sv.x * (1.0f / D); const float var = fmaxf(sv.y * (1.0f / D) - mean * mean, 0.f);
            stat[2 * X.tid] = mean; stat[2 * X.tid + 1] = rsqrtf(var + EPS); }
        __syncthreads();
#pragma unroll
        for (int c = X.tid; c < 128 * 16; c += NTHREADS) { const int q = c >> 4, cc = c & 15; const u32x4 w = *(const u32x4*)(VB + (size_t)(row0 + q) * D + g * 128 + cc * 8);
            const float mean = stat[2 * q], rstd = stat[2 * q + 1]; const float* lg_ = IN(I_OLNG) + g * 128 + cc * 8; const float* lb_ = IN(I_OLNB) + g * 128 + cc * 8;
#pragma unroll
            for (int k = 0; k < 4; ++k) { const float y0 = (bf2f(w[k] & 0xffffu) - mean) * rstd * lg_[2 * k] + lb_[2 * k], y1 = (bf2f(w[k] >> 16) - mean) * rstd * lg_[2 * k + 1] + lb_[2 * k + 1];
                const unsigned pk = pk2(y0, y1);
                *(LAS unsigned short*)(Vt + ((2 * k) * 17 + cc) * 272 + q * 2) = (unsigned short)(pk & 0xffffu); *(LAS unsigned short*)(Vt + ((2 * k + 1) * 17 + cc) * 272 + q * 2) = (unsigned short)(pk >> 16); } }
        __syncthreads();
        f32x4 acc[8];
#pragma unroll
        for (int pb = 0; pb < 8; ++pb) acc[pb] = (f32x4){0.f, 0.f, 0.f, 0.f};
#pragma unroll
        for (int s = 0; s < 4; ++s) { const bf16x8 af = *(const LAS bf16x8*)(Vt + ((l15 & 7) * 17 + 2 * X.wave + (l15 >> 3)) * 272 + (32 * s + 8 * g4) * 2);
#pragma unroll
            for (int pb = 0; pb < 8; ++pb) { const bf16x8 bfr = *(const bf16x8*)(WsB + ((size_t)g * 128 + 16 * pb + l15) * 128 + 32 * s + 8 * g4); acc[pb] = __builtin_amdgcn_mfma_f32_16x16x32_bf16(af, bfr, acc[pb], 0, 0, 0); } }
#pragma unroll
        for (int pb = 0; pb < 8; ++pb) { const int p = 16 * pb + l15; const float bs = IN(I_OBS)[g * 128 + p]; const size_t off = (size_t)(row0 + p) * D + g * 128 + 16 * X.wave + 4 * g4;
            const u32x2 uw = *(const u32x2*)(U + off);
            u32x2 o; o.x = pk2(bf2f(uw.x & 0xffffu) * (acc[pb][0] + bs), bf2f(uw.x >> 16) * (acc[pb][1] + bs)); o.y = pk2(bf2f(uw.y & 0xffffu) * (acc[pb][2] + bs), bf2f(uw.y >> 16) * (acc[pb][3] + bs));
            *(u32x2*)(SG + off) = o; }
    }
}

enum { PH_PRO = 0, PH_MOD0, PH_GIN, PH_CONV, PH_ATT, PH_GOUT, PH_RT0, PH_M1_0, PH_M2_0, PH_CMB0, PH_GMI, PH_SPA, PH_GMO, PH_RT1, PH_M1_1, PH_M2_1, PH_CMB1, NPHASE };

__global__ void __launch_bounds__(NTHREADS, 2) mega(Args a) {
    extern __shared__ __attribute__((aligned(16))) unsigned char lds_raw[];
    Ctx X; X.lds = (LAS unsigned char*)lds_raw;
    const int wave0 = __builtin_amdgcn_readfirstlane((int)threadIdx.x >> 6);
    const int G0 = gridDim.x, bid0 = blockIdx.x; const int vcu0 = (G0 % 8 == 0) ? (bid0 % 8) * (G0 / 8) + bid0 / 8 : bid0;
    X.wave = wave0;
    volatile LAS unsigned* MISC = (volatile LAS unsigned*)(X.lds + MISC_OFF);
    if (threadIdx.x < 64) MISC[threadIdx.x] = 0u;
    __syncthreads();
    XcdBarrier bar = xcd_barrier_post((unsigned*)(a.ws + WS_CTL) + CW_BAR + a.li * XCD_BAR_WORDS, MISC + 8);
    const int ph_lo = a.ph_lo, ph_hi = a.ph_hi;
#if PROBE_PH >= 0
#define PROBE_STAMP(p) do { if ((p) == PROBE_PH) pr_t0 = __builtin_amdgcn_s_memrealtime(); if ((p) == PROBE_END) pr_t1 = __builtin_amdgcn_s_memrealtime(); } while (0)
#else
#define PROBE_STAMP(p) do { } while (0)
#endif
#define PH_ENTER() int z; asm volatile("s_mov_b32 %0, 0" : "=s"(z)); \
        X.lane = (int)__builtin_amdgcn_mbcnt_hi(~0u, __builtin_amdgcn_mbcnt_lo(~0u, (unsigned)z)); X.tid = wave0 * 64 + X.lane; \
        X.G = G0 + z; X.vcu = vcu0 + z; X.bid = bid0 + z; X.NGW = X.G * NWAVES; X.gw = X.vcu * NWAVES + wave0; \
        { kargp_t kp = (kargp_t)__builtin_amdgcn_kernarg_segment_ptr(); asm volatile("" : "+s"(kp)); X.kp = kp; } \
        unsigned char* ws = (unsigned char*)(__attribute__((address_space(1))) unsigned char*)X.kp[34] + z; X.ws = ws;
#if PROBE_PH >= 0
    unsigned long long pr_t0 = 0, pr_t1 = 0;
#endif
#define PH_RUN(PHK, ...) if (ph_lo <= (PHK) && (PHK) < ph_hi) { const int ph = (PHK); \
        if (ph != ph_lo) { const int l0 = (int)__builtin_amdgcn_mbcnt_hi(~0u, __builtin_amdgcn_mbcnt_lo(~0u, 0u)); xcd_barrier(bar, wave0 * 64 + l0); } \
        PROBE_STAMP(ph); __VA_ARGS__ }
    PH_RUN(PH_PRO, { PH_ENTER(); phase_prologue(a, X); })
    PH_RUN(PH_MOD0, { PH_ENTER(); phase_modulate0(a, X); })
    PH_RUN(PH_GIN, { PH_ENTER(); DenseSched S; S.init((const bf16*)(ws + WS_XA), (const bf16*)(ws + WS_WINT), NTOK, EVEN_IN, X.G, X.bid);
            S.A2 = (const bf16*)(ws + WS_GM); S.Bt2 = (const bf16*)(ws + WS_WINT) + (size_t)KV_COL * D; S.nM2 = NCTX / 256;
            EpiIn E{(bf16*)(ws + WS_GLU), (bf16*)(ws + WS_Q), (bf16*)(ws + WS_K), (bf16*)(ws + WS_V), (bf16*)(ws + WS_KC), (bf16*)(ws + WS_VC), IN(I_EBIN)};
            pg8::gemm_phase<EpiIn, DenseSched>(X.lds, S, E, X.tid); })
    PH_RUN(PH_CONV, { PH_ENTER(); phase_conv_qk(a, X); })
    PH_RUN(PH_ATT, { PH_ENTER(); phase_attention(a, X); })
    PH_RUN(PH_GOUT, { PH_ENTER(); DenseSched S; S.init((const bf16*)(ws + WS_MIX), (const bf16*)(ws + WS_WOUTT), NTOK, D, X.G, X.bid);
            EpiRes<true> E{IN(I_X), (bf16*)(ws + WS_H), IN(I_EBOUT), (const float*)(ws + WS_MOD) + 2 * 1024};
            pg8::gemm_phase<EpiRes<true>, DenseSched>(X.lds, S, E, X.tid); })
    PH_RUN(PH_RT0, { PH_ENTER(); phase_router(a, X, 0); })
    PH_RUN(PH_M1_0, { PH_ENTER(); const int l = (ph == PH_M1_1); moe_build_table(X, (const int*)(ws + WS_CTL) + CW_CNT + l * NE * CNT_STRIDE);
            MoeSchedT<true, 8> S; S.tab = (const LAS int*)(X.lds + TAB_OFF); S.G = X.G; S.c = X.vcu; S.A = (const unsigned char*)(ws + WS_XA8); S.Bt = (const unsigned char*)(ws + WS_W1T) + (size_t)l * NE * 2048 * 1024; S.list = (const int*)(ws + WS_LIST); S.meta = (const LAS int*)(X.lds + META_OFF);
            moe_stage_meta<false>(X, S, S.list, (const float*)nullptr, (LAS int*)(X.lds + META_OFF), IN(I_B1) + (size_t)l * NE * 2048, (LAS float*)(X.lds + BIAS_OFF));
            EpiSwiglu E{(unsigned char*)(ws + WS_ACT), (const LAS float*)(X.lds + BIAS_OFF)};
            pg8::gemm_phase<EpiSwiglu, MoeSchedT<true, 8>>(X.lds, S, E, X.tid); })
    PH_RUN(PH_M2_0, { PH_ENTER(); const int l = (ph == PH_M2_1); moe_build_table(X, (const int*)(ws + WS_CTL) + CW_CNT + l * NE * CNT_STRIDE);
            MoeSchedT<false, 4> S; S.tab = (const LAS int*)(X.lds + TAB_OFF); S.G = X.G; S.c = X.vcu; S.A = (const unsigned char*)(ws + WS_ACT); S.Bt = (const unsigned char*)(ws + WS_W2T) + (size_t)l * NE * 1024 * 1024; S.list = (const int*)(ws + WS_LIST); S.meta = (const LAS int*)(X.lds + META_OFF);
            moe_stage_meta<true>(X, S, S.list, (const float*)(ws + WS_GATE), (LAS int*)(X.lds + META_OFF), IN(I_B2) + (size_t)l * NE * D, (LAS float*)(X.lds + BIAS_OFF));
            EpiDown E{(bf16*)(ws + WS_Y), (const LAS float*)(X.lds + BIAS_OFF), (const LAS int*)(X.lds + META_OFF)};
            pg8::gemm_phase<EpiDown, MoeSchedT<false, 4>>(X.lds, S, E, X.tid); })
    PH_RUN(PH_CMB0, { PH_ENTER(); phase_combine(a, X, 0); })
    PH_RUN(PH_GMI, { PH_ENTER(); DenseSched S; S.init((const bf16*)(ws + WS_XA), (const bf16*)(ws + WS_GWINT), NTOK, 2048, X.G, X.bid);
            EpiGelu E{(bf16*)(ws + WS_U), (bf16*)(ws + WS_VB), IN(I_OBIN), (float*)(ws + WS_CTL) + CW_VSTAT};
            pg8::gemm_phase<EpiGelu, DenseSched>(X.lds, S, E, X.tid); })
    PH_RUN(PH_SPA, { PH_ENTER(); phase_spatial(a, X); })
    PH_RUN(PH_GMO, { PH_ENTER(); DenseSched S; S.init((const bf16*)(ws + WS_MIX), (const bf16*)(ws + WS_GWOUTT), NTOK, D, X.G, X.bid);
            EpiRes<false> E{(const bf16*)(ws + WS_H), (bf16*)(ws + WS_H), IN(I_OBOUT), (const float*)(ws + WS_MOD) + (size_t)9 * MODW + 2 * 1024};
            pg8::gemm_phase<EpiRes<false>, DenseSched>(X.lds, S, E, X.tid); })
    PH_RUN(PH_RT1, { PH_ENTER(); phase_router(a, X, 1); })
    PH_RUN(PH_M1_1, { PH_ENTER(); PMARK(50); const int l = (ph == PH_M1_1); moe_build_table(X, (const int*)(ws + WS_CTL) + CW_CNT + l * NE * CNT_STRIDE);
            MoeSchedT<true, 8> S; S.tab = (const LAS int*)(X.lds + TAB_OFF); S.G = X.G; S.c = X.vcu; S.A = (const unsigned char*)(ws + WS_XA8); S.Bt = (const unsigned char*)(ws + WS_W1T) + (size_t)l * NE * 2048 * 1024; S.list = (const int*)(ws + WS_LIST); S.meta = (const LAS int*)(X.lds + META_OFF);
            moe_stage_meta<false>(X, S, S.list, (const float*)nullptr, (LAS int*)(X.lds + META_OFF), IN(I_B1) + (size_t)l * NE * 2048, (LAS float*)(X.lds + BIAS_OFF));
            PMARK(51); EpiSwiglu E{(unsigned char*)(ws + WS_ACT), (const LAS float*)(X.lds + BIAS_OFF)};
            pg8::gemm_phase<EpiSwiglu, MoeSchedT<true, 8>>(X.lds, S, E, X.tid); PMARK(53); })
    PH_RUN(PH_M2_1, { PH_ENTER(); PMARK(54); const int l = (ph == PH_M2_1); moe_build_table(X, (const int*)(ws + WS_CTL) + CW_CNT + l * NE * CNT_STRIDE);
            MoeSchedT<false, 4> S; S.tab = (const LAS int*)(X.lds + TAB_OFF); S.G = X.G; S.c = X.vcu; S.A = (const unsigned char*)(ws + WS_ACT); S.Bt = (const unsigned char*)(ws + WS_W2T) + (size_t)l * NE * 1024 * 1024; S.list = (const int*)(ws + WS_LIST); S.meta = (const LAS int*)(X.lds + META_OFF);
            moe_stage_meta<true>(X, S, S.list, (const float*)(ws + WS_GATE), (LAS int*)(X.lds + META_OFF), IN(I_B2) + (size_t)l * NE * D, (LAS float*)(X.lds + BIAS_OFF));
            EpiDown E{(bf16*)(ws + WS_Y), (const LAS float*)(X.lds + BIAS_OFF), (const LAS int*)(X.lds + META_OFF)};
            pg8::gemm_phase<EpiDown, MoeSchedT<false, 4>>(X.lds, S, E, X.tid); })
    PH_RUN(PH_CMB1, { PH_ENTER(); phase_combine(a, X, 1); })
#if PROBE_PH == -2
    if (blockIdx.x == 0 && threadIdx.x == 0) { volatile LAS unsigned long long* pm_ = (volatile LAS unsigned long long*)(X.lds + MISC_OFF + 128); const unsigned long long te = __builtin_amdgcn_s_memrealtime(); const unsigned long long span = (pm_[1] - pm_[0]) * PROBE_MULT;
        while (__builtin_amdgcn_s_memrealtime() - te < span) __builtin_amdgcn_s_sleep(8); }
#endif
#if PROBE_PH >= 0
    if (pr_t1 == 0) pr_t1 = __builtin_amdgcn_s_memrealtime();
    if (blockIdx.x == 0 && wave0 == 0) { const unsigned long long te = __builtin_amdgcn_s_memrealtime(); const unsigned long long span = (pr_t1 - pr_t0) * PROBE_MULT;
        while (__builtin_amdgcn_s_memrealtime() - te < span) __builtin_amdgcn_s_sleep(8); }
#endif
}

__device__ __forceinline__ bool find_expert(const int* cnt, int s, int& e, int& slot) {
    int pb = 0;
    for (int i = 0; i < NE; ++i) { const int c = cnt[i * CNT_STRIDE]; const int pr = ((c + 255) >> 8) << 8; if (s < pb + pr) { e = i; slot = s - pb; return true; } pb += pr; }
    return false;
}
__global__ void __launch_bounds__(256) slow_gemm(const bf16* A, const int* arow, const bf16* Bt, float* C, int N, const int* cnt, size_t bstride) {
    __shared__ float As[16][65], Bs[16][65];
    const int tx = threadIdx.x & 15, ty = threadIdx.x >> 4; const int m0 = blockIdx.y * 64, n0 = blockIdx.x * 64;
    if (cnt) { int e, slot; if (!find_expert(cnt, m0, e, slot)) return; Bt += (size_t)e * bstride; }
    float acc[4][4];
    for (int i = 0; i < 4; ++i) for (int j = 0; j < 4; ++j) acc[i][j] = 0.f;
    for (int k0 = 0; k0 < 1024; k0 += 16) {
        for (int i = 0; i < 4; ++i) { const int idx = threadIdx.x + 256 * i; const int r = idx >> 4, kk = idx & 15; const int gm = m0 + r; const int ar = arow ? arow[gm] : gm;
            As[kk][r] = bf2f(A[(size_t)ar * 1024 + k0 + kk]); Bs[kk][r] = bf2f(Bt[(size_t)(n0 + r) * 1024 + k0 + kk]); }
        __syncthreads();
        for (int kk = 0; kk < 16; ++kk) { float av[4], bv[4];
            for (int i = 0; i < 4; ++i) { av[i] = As[kk][ty * 4 + i]; bv[i] = Bs[kk][tx * 4 + i]; }
            for (int i = 0; i < 4; ++i) for (int j = 0; j < 4; ++j) acc[i][j] += av[i] * bv[j]; }
        __syncthreads();
    }
    for (int i = 0; i < 4; ++i) for (int j = 0; j < 4; ++j) C[(size_t)(m0 + ty * 4 + i) * N + n0 + tx * 4 + j] = acc[i][j];
}
__device__ __forceinline__ unsigned short f2bf_s(float f) { return (unsigned short)(pk2(f, 0.f) & 0xffffu); }
__global__ void slow_epi_in(const float* C, const float* C2, const float* bias, bf16* GLU, bf16* Q, bf16* Kb, bf16* Vb, bf16* KC, bf16* VC) {
    const size_t i = (size_t)blockIdx.x * blockDim.x + threadIdx.x;
    if (i < (size_t)NTOK * 512) { const int row = (int)(i >> 9), j = (int)(i & 511); const int t = j >> 7, ii = j & 127; const float* cr = C + (size_t)row * EVEN_IN;
        const float u = cr[t * 256 + ii] + bias[j], g = cr[t * 256 + 128 + ii] + bias[512 + j];
        GLU[i] = f2bf_s(u / (1.0f + expf(-g)));
        Q[i] = f2bf_s(cr[1024 + j] + bias[1024 + j]);
        if (j < 128) { Kb[(size_t)row * 128 + j] = f2bf_s(cr[1536 + j] + bias[1536 + j]); Vb[(size_t)row * 128 + j] = f2bf_s(cr[1664 + j] + bias[1664 + j]); }
        if (row < NCTX && j < 128) { KC[(size_t)row * 128 + j] = f2bf_s(C2[(size_t)row * 256 + j] + bias[1536 + j]); VC[(size_t)row * 128 + j] = f2bf_s(C2[(size_t)row * 256 + 128 + j] + bias[1664 + j]); } }
}
__global__ void slow_epi_res(const float* C, const float* basef, const bf16* baseb, bf16* out, const float* bias, const float* gate) {
    const size_t i = (size_t)blockIdx.x * blockDim.x + threadIdx.x;
    if (i < (size_t)NTOK * D) { const int row = (int)(i >> 10), col = (int)(i & 1023); const float b = basef ? basef[i] : bf2f(baseb[i]); out[i] = f2bf_s(b + gate[(size_t)(row / SEQ) * MODW + col] * (C[i] + bias[col])); }
}
__global__ void slow_epi_gelu(const float* C, const float* bias, bf16* U, bf16* V) {
    const size_t i = (size_t)blockIdx.x * blockDim.x + threadIdx.x;
    if (i < (size_t)NTOK * 2048) { const int row = (int)(i >> 11), col = (int)(i & 2047); const float x = C[i] + bias[col]; const float y = 0.5f * x * (1.0f + erff(x * 0.70710678118654752f));
        if (col < 1024) U[(size_t)row * D + col] = f2bf_s(y); else V[(size_t)row * D + col - 1024] = f2bf_s(y); }
}
__global__ void slow_arow(const int* cnt, const int* list, int* arow) {
    const int s = blockIdx.x * blockDim.x + threadIdx.x; if (s >= ACT_ROWS) return;
    int e, slot; int r = 0; if (find_expert(cnt, s, e, slot) && slot < cnt[e * CNT_STRIDE]) r = list[(size_t)e * NTOK + slot] >> 2;
    arow[s] = r;
}
__global__ void slow_epi_swiglu(const float* C, const int* cnt, const float* b1, bf16* ACT) {
    const size_t i = (size_t)blockIdx.x * blockDim.x + threadIdx.x;
    if (i < (size_t)ACT_ROWS * 1024) { const int s = (int)(i >> 10), j = (int)(i & 1023); int e, slot; if (!find_expert(cnt, s, e, slot)) return;
        const int t = j >> 7, ii = j & 127; const float* cr = C + (size_t)s * 2048;
        float g = cr[t * 256 + ii] + b1[(size_t)e * 2048 + j], up = cr[t * 256 + 128 + ii] + b1[(size_t)e * 2048 + 1024 + j];
        g = fminf(g, 7.0f); up = fminf(fmaxf(up, -7.0f), 7.0f);
        ACT[i] = f2bf_s((up + 1.0f) * g / (1.0f + expf(-1.702f * g))); }
}
__global__ void slow_epi_down(const float* C, const int* cnt, const int* list, const float* gatew, const float* b2, bf16* Y) {
    const size_t i = (size_t)blockIdx.x * blockDim.x + threadIdx.x;
    if (i < (size_t)ACT_ROWS * 1024) { const int s = (int)(i >> 10), col = (int)(i & 1023); int e, slot; if (!find_expert(cnt, s, e, slot) || slot >= cnt[e * CNT_STRIDE]) return;
        const int aid = list[(size_t)e * NTOK + slot]; Y[(size_t)aid * D + col] = f2bf_s((C[i] + b2[(size_t)e * D + col]) * gatew[aid]); }
}
__global__ void __launch_bounds__(64) slow_attention(const bf16* QN, const bf16* KN, const bf16* VV, const bf16* KC, const bf16* VC, const float* sink, bf16* MIX) {
    const int i = blockIdx.x * blockDim.x + threadIdx.x; if (i >= NTOK * 8) return;
    const int row = i >> 3, h = i & 7, kh = h >> 2, b = row / SEQ, t = row % SEQ;
    float q[64], o[64];
    for (int d = 0; d < 64; ++d) { q[d] = bf2f(QN[(size_t)row * 512 + h * 64 + d]); o[d] = 0.f; }
    float m = sink[h] * LOG2E, l = 1.0f;
    const int j0 = t - 128 < 0 ? 0 : t - 128, j1 = t + 128 > SEQ - 1 ? SEQ - 1 : t + 128;
    for (int jj = j0; jj <= j1 + CTXL; ++jj) {
        const bf16* kp; const bf16* vp;
        if (jj <= j1) { kp = KN + (size_t)(b * SEQ + jj) * 128 + kh * 64; vp = VV + (size_t)(b * SEQ + jj) * 128 + kh * 64; }
        else { const int c = jj - j1 - 1; kp = KC + (size_t)(b * CTXL + c) * 128 + kh * 64; vp = VC + (size_t)(b * CTXL + c) * 128 + kh * 64; }
        float s = 0.f; for (int d = 0; d < 64; ++d) s += q[d] * bf2f(kp[d]);
        const float mn = fmaxf(m, s), al = exp2f(m - mn), p = exp2f(s - mn); m = mn; l = l * al + p;
        for (int d = 0; d < 64; ++d) o[d] = o[d] * al + p * bf2f(vp[d]);
    }
    for (int d = 0; d < 64; ++d) MIX[(size_t)row * D + 512 + h * 64 + d] = f2bf_s(o[d] / l);
}
__global__ void slow_vstats(const bf16* VB, float* stat) {
    const int row = blockIdx.x * blockDim.x + threadIdx.x; if (row >= NTOK) return;
    float s = 0.f; for (int c = 0; c < D; ++c) s += bf2f(VB[(size_t)row * D + c]); const float mean = s / D;
    float s2 = 0.f; for (int c = 0; c < D; ++c) { const float d = bf2f(VB[(size_t)row * D + c]) - mean; s2 += d * d; }
    stat[2 * row] = mean; stat[2 * row + 1] = rsqrtf(s2 / D + EPS);
}
__global__ void slow_spatial(const bf16* U, const bf16* VB, const float* stat, const float* ws, const float* bs, const float* lng, const float* lnb, bf16* SG) {
    const size_t i = (size_t)blockIdx.x * blockDim.x + threadIdx.x;
    if (i < (size_t)NTOK * D) { const int row = (int)(i >> 10), ch = (int)(i & 1023); const int g = ch >> 7, p = row & 127, r0 = row - p;
        float s = 0.f;
        for (int q = 0; q < 128; ++q) { const float vn = (bf2f(VB[(size_t)(r0 + q) * D + ch]) - stat[2 * (r0 + q)]) * stat[2 * (r0 + q) + 1] * lng[ch] + lnb[ch]; s += ws[((size_t)g * 128 + p) * 128 + q] * vn; }
        SG[i] = f2bf_s(bf2f(U[i]) * (s + bs[g * 128 + p])); }
}

static void launch_mega(Args& a, int lo, int hi, int& li, int grid, hipStream_t stream) {
    a.ph_lo = lo; a.ph_hi = hi; a.li = li++;
    hipLaunchKernelGGL(mega, dim3(grid), dim3(NTHREADS), LDS_BYTES, stream, a);
}
extern "C" void kernel_launch(void* const* d_in, const int* in_sizes, int n_in, void* d_out, int out_size, void* d_ws, size_t ws_size, hipStream_t stream) {
    static int grid = 0;
    if (grid == 0) {
        if (n_in != 33 || out_size != NTOK * D || ws_size < WS_END) { fprintf(stderr, "kernel_launch: unexpected problem (n_in %d, out %d, ws %zu)\n", n_in, out_size, ws_size); grid = -1; return; }
        int dev = 0, cus = 0, per_cu = 0;
        if (hipGetDevice(&dev) != hipSuccess || hipDeviceGetAttribute(&cus, hipDeviceAttributeMultiprocessorCount, dev) != hipSuccess) { grid = -1; return; }
        if (hipFuncSetAttribute((const void*)mega, hipFuncAttributeMaxDynamicSharedMemorySize, LDS_BYTES) != hipSuccess) { fprintf(stderr, "kernel_launch: hipFuncSetAttribute failed\n"); grid = -1; return; }
        if (hipOccupancyMaxActiveBlocksPerMultiprocessor(&per_cu, (const void*)mega, NTHREADS, LDS_BYTES) != hipSuccess || per_cu < 1) { fprintf(stderr, "kernel_launch: occupancy query says %d blocks per CU\n", per_cu); per_cu = 1; }
        (void)hipGetLastError();
        grid = cus;
    }
    if (grid < 0) return;
    unsigned char* ws = (unsigned char*)d_ws;
    (void)hipMemsetAsync(ws + WS_CTL, 0, CTL_ZERO_BYTES, stream);
    Args a{};
    for (int i = 0; i < 33; ++i) a.in[i] = (const float*)d_in[i];
    a.out = (float*)d_out; a.ws = ws;
    int li = 0;
    const float* in_[33]; for (int i = 0; i < 33; ++i) in_[i] = (const float*)d_in[i];
    float* CF = (float*)(ws + WS_CF); float* MOD = (float*)(ws + WS_MOD); int* CNT = (int*)(ws + WS_CTL) + CW_CNT;
    int lo = 0;
    auto flush = [&](int upto) { if (upto > lo) launch_mega(a, lo, upto, li, grid, stream); };
    for (int ph = 0; ph < NPHASE; ++ph) {
        bool slow = false;
        switch (ph) {
        case PH_GIN: slow = SLOW_MASK & 1; break;
        case PH_ATT: slow = SLOW_MASK & 2; break;
        case PH_GOUT: case PH_GMO: slow = SLOW_MASK & 4; break;
        case PH_M1_0: case PH_M1_1: slow = SLOW_MASK & 8; break;
        case PH_M2_0: case PH_M2_1: slow = SLOW_MASK & 16; break;
        case PH_GMI: slow = SLOW_MASK & 32; break;
        case PH_SPA: slow = SLOW_MASK & 64; break;
        default: break;
        }
        if (!slow) continue;
        flush(ph); lo = ph + 1;
        const int l = (ph == PH_M1_1 || ph == PH_M2_1) ? 1 : 0;
        switch (ph) {
        case PH_GIN:
            hipLaunchKernelGGL(slow_gemm, dim3(EVEN_IN / 64, NTOK / 64), dim3(256), 0, stream, (const bf16*)(ws + WS_XA), (const int*)nullptr, (const bf16*)(ws + WS_WINT), CF, EVEN_IN, (const int*)nullptr, (size_t)0);
            hipLaunchKernelGGL(slow_gemm, dim3(256 / 64, NCTX / 64), dim3(256), 0, stream, (const bf16*)(ws + WS_GM), (const int*)nullptr, (const bf16*)(ws + WS_WINT) + (size_t)KV_COL * D, CF + (size_t)NTOK * EVEN_IN, 256, (const int*)nullptr, (size_t)0);
            hipLaunchKernelGGL(slow_epi_in, dim3(NTOK * 512 / 256), dim3(256), 0, stream, (const float*)CF, (const float*)(CF + (size_t)NTOK * EVEN_IN), in_[I_EBIN], (bf16*)(ws + WS_GLU), (bf16*)(ws + WS_Q), (bf16*)(ws + WS_K), (bf16*)(ws + WS_V), (bf16*)(ws + WS_KC), (bf16*)(ws + WS_VC));
            break;
        case PH_ATT:
            hipLaunchKernelGGL(slow_attention, dim3(NTOK * 8 / 64), dim3(64), 0, stream, (const bf16*)(ws + WS_Q), (const bf16*)(ws + WS_K), (const bf16*)(ws + WS_V), (const bf16*)(ws + WS_KC), (const bf16*)(ws + WS_VC), in_[I_SINK], (bf16*)(ws + WS_MIX));
            break;
        case PH_GOUT:
            hipLaunchKernelGGL(slow_gemm, dim3(D / 64, NTOK / 64), dim3(256), 0, stream, (const bf16*)(ws + WS_MIX), (const int*)nullptr, (const bf16*)(ws + WS_WOUTT), CF, D, (const int*)nullptr, (size_t)0);
            hipLaunchKernelGGL(slow_epi_res, dim3(NTOK * D / 256), dim3(256), 0, stream, (const float*)CF, in_[I_X], (const bf16*)nullptr, (bf16*)(ws + WS_H), in_[I_EBOUT], (const float*)(MOD + 2 * 1024));
            break;
        case PH_GMO:
            hipLaunchKernelGGL(slow_gemm, dim3(D / 64, NTOK / 64), dim3(256), 0, stream, (const bf16*)(ws + WS_MIX), (const int*)nullptr, (const bf16*)(ws + WS_GWOUTT), CF, D, (const int*)nullptr, (size_t)0);
            hipLaunchKernelGGL(slow_epi_res, dim3(NTOK * D / 256), dim3(256), 0, stream, (const float*)CF, (const float*)nullptr, (const bf16*)(ws + WS_H), (bf16*)(ws + WS_H), in_[I_OBOUT], (const float*)(MOD + (size_t)9 * MODW + 2 * 1024));
            break;
        case PH_M1_0: case PH_M1_1:
            hipLaunchKernelGGL(slow_arow, dim3(ACT_ROWS / 256), dim3(256), 0, stream, (const int*)(CNT + l * NE * CNT_STRIDE), (const int*)(ws + WS_LIST), (int*)(ws + WS_AROW));
            hipLaunchKernelGGL(slow_gemm, dim3(2048 / 64, ACT_ROWS / 64), dim3(256), 0, stream, (const bf16*)(ws + WS_XA), (const int*)(ws + WS_AROW), (const bf16*)(ws + WS_W1T) + (size_t)l * NE * 2048 * 1024, CF, 2048, (const int*)(CNT + l * NE * CNT_STRIDE), (size_t)2048 * 1024);
            hipLaunchKernelGGL(slow_epi_swiglu, dim3(ACT_ROWS * 1024 / 256), dim3(256), 0, stream, (const float*)CF, (const int*)(CNT + l * NE * CNT_STRIDE), in_[I_B1] + (size_t)l * NE * 2048, (bf16*)(ws + WS_ACT));
            break;
        case PH_M2_0: case PH_M2_1:
            hipLaunchKernelGGL(slow_gemm, dim3(1024 / 64, ACT_ROWS / 64), dim3(256), 0, stream, (const bf16*)(ws + WS_ACT), (const int*)nullptr, (const bf16*)(ws + WS_W2T) + (size_t)l * NE * 1024 * 1024, CF, 1024, (const int*)(CNT + l * NE * CNT_STRIDE), (size_t)1024 * 1024);
            hipLaunchKernelGGL(slow_epi_down, dim3(ACT_ROWS * 1024 / 256), dim3(256), 0, stream, (const float*)CF, (const int*)(CNT + l * NE * CNT_STRIDE), (const int*)(ws + WS_LIST), (const float*)(ws + WS_GATE), in_[I_B2] + (size_t)l * NE * D, (bf16*)(ws + WS_Y));
            break;
        case PH_GMI:
            hipLaunchKernelGGL(slow_gemm, dim3(2048 / 64, NTOK / 64), dim3(256), 0, stream, (const bf16*)(ws + WS_XA), (const int*)nullptr, (const bf16*)(ws + WS_GWINT), CF, 2048, (const int*)nullptr, (size_t)0);
            hipLaunchKernelGGL(slow_epi_gelu, dim3(NTOK * 2048 / 256), dim3(256), 0, stream, (const float*)CF, in_[I_OBIN], (bf16*)(ws + WS_U), (bf16*)(ws + WS_VB));
            break;
        case PH_SPA:
            hipLaunchKernelGGL(slow_vstats, dim3(NTOK / 64), dim3(64), 0, stream, (const bf16*)(ws + WS_VB), CF);
            hipLaunchKernelGGL(slow_spatial, dim3(NTOK * D / 256), dim3(256), 0, stream, (const bf16*)(ws + WS_U), (const bf16*)(ws + WS_VB), (const float*)CF, in_[I_OWS], in_[I_OBS], in_[I_OLNG], in_[I_OLNB], (bf16*)(ws + WS_MIX));
            break;
        default: break;
        }
    }
    flush(NPHASE);
}
```

```cpp
#include <hip/hip_runtime.h>
#include <cstdio>
#include <cstdint>

#ifndef SLOW_MASK
#define SLOW_MASK 0x00
#endif

#ifndef EXP_BAR2
#define EXP_BAR2 0
#endif
#ifndef EXP_STREAM
#define EXP_STREAM 0
#endif
#ifndef PROBE_PH
#define PROBE_PH (-1)
#endif
#ifndef PROBE_END
#define PROBE_END (PROBE_PH + 1)
#endif
#ifndef PROBE_A
#define PROBE_A (-1)
#define PROBE_B (-1)
#endif
#ifndef PROBE_MULT
#define PROBE_MULT 4
#endif

#define LAS __attribute__((address_space(3)))
typedef unsigned short bf16;
typedef short bf16x8 __attribute__((ext_vector_type(8)));
typedef float f32x4 __attribute__((ext_vector_type(4)));
typedef float f32x2 __attribute__((ext_vector_type(2)));
typedef unsigned u32x4 __attribute__((ext_vector_type(4)));
typedef unsigned u32x2 __attribute__((ext_vector_type(2)));
typedef __bf16 bf16x2_t __attribute__((ext_vector_type(2)));

constexpr int NB = 8, SEQ = 2048, D = 1024, NTOK = NB * SEQ, CTXL = 256, NCTX = NB * CTXL;
constexpr int NE = 32, TOPK = 4, NASSIGN = NTOK * TOPK, ACT_ROWS = NASSIGN + NE * 256;
constexpr int EVEN_IN = 1792, KV_COL = 1536;
constexpr float EPS = 1e-6f, LOG2E = 1.4426950408889634f;
constexpr float QSCALE = 0.125f * LOG2E;
constexpr int MODW = 6 * D;
constexpr int NWAVES = 8, NTHREADS = 512;

constexpr size_t MiB = 1u << 20;
constexpr size_t WS_CTL = 0, CTL_ZERO_BYTES = 1 * MiB;
constexpr size_t WS_MOD = 1 * MiB;
constexpr size_t WS_LIST = 2 * MiB;
constexpr size_t WS_GATE = 4 * MiB;
constexpr size_t WS_WSB = 5 * MiB;
constexpr size_t WS_WINT = 6 * MiB;
constexpr size_t WS_WOUTT = 10 * MiB;
constexpr size_t WS_GWINT = 12 * MiB;
constexpr size_t WS_GWOUTT = 16 * MiB;
constexpr size_t WS_KC = 18 * MiB;
constexpr size_t WS_VC = 18 * MiB + 512 * 1024;
constexpr size_t WS_K = 19 * MiB;
constexpr size_t WS_V = 23 * MiB;
constexpr size_t WS_GM = 27 * MiB;
constexpr size_t WS_AROW = 31 * MiB;
constexpr size_t WS_Q = 32 * MiB;
constexpr size_t WS_GLU = 48 * MiB;
constexpr size_t WS_XA = 64 * MiB;
constexpr size_t WS_MIX = 96 * MiB;
constexpr size_t WS_H = 128 * MiB;
constexpr size_t WS_U = 192 * MiB;
constexpr size_t WS_VB = 224 * MiB;
constexpr size_t WS_W1T = 256 * MiB;
constexpr size_t WS_W2T = 512 * MiB;
constexpr size_t WS_ACT = 640 * MiB;
constexpr size_t WS_Y = 784 * MiB;
constexpr size_t WS_XA8 = 912 * MiB;
constexpr size_t WS_CF = 928 * MiB;
constexpr size_t WS_END = 1504 * MiB;
constexpr int CW_BAR = 4096, CW_CNT = 131072, CNT_STRIDE = 64  , CW_VSTAT = 147456;
constexpr int MAX_LAUNCH = 20;

constexpr int RING_BYTES = 131072;
constexpr int MISC_OFF = RING_BYTES;
constexpr int TAB_OFF = RING_BYTES + 256;
constexpr int META_OFF = RING_BYTES + 3072;
constexpr int BIAS_OFF = META_OFF + 10240;
constexpr int LDS_BYTES = 163840;

#define LDS_WAIT() asm volatile("s_waitcnt lgkmcnt(0)" ::: "memory")
#define VM_WAIT() asm volatile("s_waitcnt vmcnt(0)" ::: "memory")

__device__ __forceinline__ float bf2f(unsigned b) { return __uint_as_float(b << 16); }
__device__ __forceinline__ unsigned pk2(float lo, float hi) { f32x2 v = {lo, hi}; bf16x2_t b = __builtin_convertvector(v, bf16x2_t); return __builtin_bit_cast(unsigned, b); }
template <int CTRL, int ROW_MASK> __device__ __forceinline__ float dpp_f(float old, float src) { return __builtin_bit_cast(float, __builtin_amdgcn_update_dpp(__builtin_bit_cast(int, old), __builtin_bit_cast(int, src), CTRL, ROW_MASK, 0xf, false)); }
__device__ __forceinline__ unsigned pk4_fp8(float a, float b, float c, float d) { int w = 0; w = __builtin_amdgcn_cvt_pk_fp8_f32(a, b, w, false); w = __builtin_amdgcn_cvt_pk_fp8_f32(c, d, w, true); return (unsigned)w; }
__device__ __forceinline__ float wave_sum(float v) {
    v += dpp_f<0xB1, 0xf>(0.f, v);
    v += dpp_f<0x4E, 0xf>(0.f, v);
    v += dpp_f<0x141, 0xf>(0.f, v);
    v += dpp_f<0x140, 0xf>(0.f, v);
    v += dpp_f<0x142, 0xa>(0.f, v);
    v += dpp_f<0x143, 0xc>(0.f, v);
    return __builtin_bit_cast(float, __builtin_amdgcn_readlane(__builtin_bit_cast(int, v), 63));
}
__device__ __forceinline__ float dpp_swap32(float v) { return __shfl_xor(v, 32); }
__device__ __forceinline__ float sigmoidf_(float x) { return __builtin_amdgcn_rcpf(1.0f + __builtin_amdgcn_exp2f(-x * LOG2E)); }

#define XB_TMO      128
#define XB_XCNT(j)  (256  + 64 * (j))
#define XB_XSUB(j)  (1280 + 64 * (j))
#define XB_XGEN(j)  (2304 + 64 * (j))
#define XB_TOP      3328
#define XB_TOPGEN   3392
#define XCD_BAR_WORDS 3456
#define XB_SPIN_CAP (1u << 20)
__device__ __forceinline__ unsigned xb_ld(unsigned* p)              { return __hip_atomic_load(p, __ATOMIC_RELAXED, __HIP_MEMORY_SCOPE_AGENT); }
__device__ __forceinline__ unsigned xb_add(unsigned* p, unsigned v) { return __hip_atomic_fetch_add(p, v, __ATOMIC_RELAXED, __HIP_MEMORY_SCOPE_AGENT); }
__device__ __forceinline__ unsigned xb_xcc_id() { return (unsigned)__builtin_amdgcn_s_getreg((3 << 11) | 20) & 0xFu; }
#define XB_SPIN(cond, bar) do { unsigned _sp = 0; while (cond) { __builtin_amdgcn_s_sleep(1); \
    if ((++_sp & 255u) == 0u) { if (xb_ld(&(bar)[XB_TMO])) break; if (_sp > XB_SPIN_CAP) { atomicAdd(&(bar)[XB_TMO], 1u); break; } } } } while (0)
struct XcdBarrier { unsigned* bar; unsigned x; volatile LAS unsigned* st; };
__device__ __forceinline__ XcdBarrier xcd_barrier_post(unsigned* bar, volatile LAS unsigned* st) {
    XcdBarrier b; b.bar = bar; b.x = xb_xcc_id(); b.st = st;
    if (threadIdx.x == 0) (void)xb_add(&bar[XB_XCNT(b.x)], 1u);
    return b;
}
__device__ __forceinline__ void xcd_barrier_complete(unsigned* bar, unsigned x, unsigned& nloc, unsigned& nx) {
    const unsigned G = gridDim.x * gridDim.y * gridDim.z;
    unsigned sum, cnt, mine, sp = 0u;
    for (;;) {
        sum = 0u; cnt = 0u; mine = 0u;
#pragma unroll
        for (unsigned j = 0; j < 16; ++j) { const unsigned c = xb_ld(&bar[XB_XCNT(j)]); sum += c; cnt += (c > 0u) ? 1u : 0u; mine = (j == x) ? c : mine; }
        if (sum == G) break;
        __builtin_amdgcn_s_sleep(1);
        if ((++sp & 255u) == 0u) { if (xb_ld(&bar[XB_TMO])) break; if (sp > XB_SPIN_CAP) { atomicAdd(&bar[XB_TMO], 1u); break; } }
    }
    nloc = mine > 0u ? mine : 1u; nx = cnt > 0u ? cnt : 1u;
}
__device__ __forceinline__ void xcd_barrier(const XcdBarrier& b, const int tid) {
    asm volatile("s_waitcnt vmcnt(0)" ::: "memory");
    __syncthreads();
    if (tid == 0) {
        unsigned* bar = b.bar;
        __builtin_amdgcn_s_waitcnt(0);
        unsigned nloc = b.st[0], nx = b.st[1];
        if (nloc == 0u) { xcd_barrier_complete(bar, b.x, nloc, nx); b.st[0] = nloc; b.st[1] = nx; }
        const unsigned old = xb_add(&bar[XB_XSUB(b.x)], 1u);
        const unsigned gen = old / nloc;
        if (old + 1u == (gen + 1u) * nloc) {
            __builtin_amdgcn_fence(__ATOMIC_RELEASE, "agent");
            asm volatile("s_waitcnt vmcnt(0)" ::: "memory");
            const unsigned og = xb_add(&bar[XB_TOP], 1u);
            const unsigned tg = og / nx;
            if (og + 1u == (tg + 1u) * nx) xb_add(&bar[XB_TOPGEN], 1u);
            else XB_SPIN(xb_ld(&bar[XB_TOPGEN]) == tg, bar);
            __builtin_amdgcn_fence(__ATOMIC_ACQUIRE, "agent");
            xb_add(&bar[XB_XGEN(b.x)], 1u);
            asm volatile("s_waitcnt vmcnt(0)" ::: "memory");
        } else {
            XB_SPIN(xb_ld(&bar[XB_XGEN(b.x)]) == gen, bar);
            __builtin_amdgcn_fence(__ATOMIC_ACQUIRE, "agent");
            asm volatile("s_waitcnt vmcnt(0)" ::: "memory");
        }
    }
    __syncthreads();
}

constexpr float FP8_WMUL = 32.0f, FP8_AMUL = 4.0f, FP8_DESCALE = 1.0f / (32.0f * 4.0f);
#if PROBE_PH == -2
#define GMARK(k) do { if (Sched::GATHER && ui == 0 && blockIdx.x == 0 && tid == 0) { volatile LAS unsigned long long* pm_ = (volatile LAS unsigned long long*)(lds + MISC_OFF + 128); \
    if ((k) == PROBE_A) pm_[0] = __builtin_amdgcn_s_memrealtime(); if ((k) == PROBE_B) pm_[1] = __builtin_amdgcn_s_memrealtime(); } } while (0)
#define GMARK1(k) do { if (Sched::GATHER && ui == 1 && blockIdx.x == 0 && tid == 0) { volatile LAS unsigned long long* pm_ = (volatile LAS unsigned long long*)(lds + MISC_OFF + 128); \
    if ((k) == PROBE_A) pm_[0] = __builtin_amdgcn_s_memrealtime(); if ((k) == PROBE_B) pm_[1] = __builtin_amdgcn_s_memrealtime(); } } while (0)
#else
#define GMARK(k) do { } while (0)
#define GMARK1(k) do { } while (0)
#endif
namespace pg8 {
constexpr int BM = 256, BK = 64, HALF = 128, HTB = HALF * BK * 2, STAGE_BYTES = 8 * HTB, KD = 1024  ;
__host__ __device__ __forceinline__ int lds_byte(int r, int c) { const int st = (r >> 4) * 2 + (c >> 5), rr = r & 15, cc = c & 31, ob = rr * 64 + cc * 2; return st * 1024 + (ob ^ (((ob >> 9) & 1) << 5)); }
__host__ __device__ __forceinline__ void stage_rc(int b, int& R, int& C) { const int st = b / 1024, sb = b % 1024, swz = sb ^ (((sb >> 9) & 1) << 5); R = (st >> 1) * 16 + swz / 64; C = (st & 1) * 32 + (swz % 64) / 2; }
__host__ __device__ __forceinline__ int perm32(int rho) { const int n = rho >> 4, i = rho & 15; return 8 * (i >> 2) + 4 * n + (i & 3); }

typedef int v8i_t __attribute__((ext_vector_type(8)));
__device__ __forceinline__ v8i_t cat8(bf16x8 a, bf16x8 b) { typedef int v4i_t __attribute__((ext_vector_type(4))); const v4i_t x = __builtin_bit_cast(v4i_t, a), y = __builtin_bit_cast(v4i_t, b); return __builtin_shufflevector(x, y, 0, 1, 2, 3, 4, 5, 6, 7); }
struct Unit { int pm, pn, e, cnt, idx; };

template <class Epi, class Sched>
__device__ __forceinline__ void gemm_phase(LAS unsigned char* lds, const Sched& S, const Epi& E, const int tid) {
    const int wid = __builtin_amdgcn_readfirstlane(tid >> 6), lane = tid & 63, wr = wid >> 2, wc = wid & 3, fr = lane & 15, fq = lane >> 4;
    constexpr int RP = Sched::FP8 ? 1024 : 2048  , nt = RP / 128;
    int Rr[2], Cc[2];
    unsigned voffA[2][2], voffB[2];
#pragma unroll
    for (int i = 0; i < 2; ++i) { stage_rc(tid * 16 + i * 8192, Rr[i], Cc[i]); const int Rb = Epi::PERM ? ((Rr[i] & ~31) + perm32(Rr[i] & 31)) : Rr[i];
        voffB[i] = (unsigned)(Rb * RP + Cc[i] * 2); }
    constexpr size_t kstep = (size_t)(BK * 2);
    constexpr size_t hstep = (size_t)HALF * RP;
    const unsigned ldsw = (unsigned)wid * 1024u;
    const int aoff = lds_byte(wr * 64 + fr, fq * 8), boff = lds_byte(wc * 32 + fr, fq * 8);
#define PG8_SA(b, h) (((b) * 2 + (h)) * HTB)
#define PG8_SB(b, h) ((4 + (b) * 2 + (h)) * HTB)
#define PG8_STAGE(bufoff, gbase, voff) do { _Pragma("unroll") for (int _i = 0; _i < 2; ++_i) \
        __builtin_amdgcn_global_load_lds((const unsigned*)((const char*)(gbase) + (voff)[_i]), (LAS unsigned*)(lds + (bufoff) + ldsw + _i * 8192), 16, 0, 0); } while (0)
#define PG8_STAGEA1(bufoff, gbase) do { if constexpr (Sched::GATHER) { PG8_STAGE(bufoff, gbase, voffA[1]); } else { PG8_STAGE(bufoff, (gbase) + hstep, voffA[0]); } } while (0)
#define PG8_LDA(dst, b, h) do { _Pragma("unroll") for (int m = 0; m < 4; ++m) _Pragma("unroll") for (int k = 0; k < 2; ++k) dst[m][k] = *(const LAS bf16x8*)(lds + PG8_SA(b, h) + aoff + m * 2048 + k * 1024); } while (0)
#define PG8_LDB(dst, b, h) do { _Pragma("unroll") for (int n = 0; n < 2; ++n) _Pragma("unroll") for (int k = 0; k < 2; ++k) dst[n][k] = *(const LAS bf16x8*)(lds + PG8_SB(b, h) + boff + n * 2048 + k * 1024); } while (0)
#define PG8_MMA(ai, bj, At, Bt) do { __builtin_amdgcn_s_setprio(1); _Pragma("unroll") for (int m = 0; m < 4; ++m) _Pragma("unroll") for (int n = 0; n < 2; ++n) { \
        if constexpr (Sched::FP8) { acc[ai][bj][m][n] = __builtin_amdgcn_mfma_scale_f32_16x16x128_f8f6f4(cat8(Bt[n][0], Bt[n][1]), cat8(At[m][0], At[m][1]), acc[ai][bj][m][n], 0, 0, 0, 0, 0, 0); } \
        else { _Pragma("unroll") for (int k = 0; k < 2; ++k) acc[ai][bj][m][n] = __builtin_amdgcn_mfma_f32_16x16x32_bf16(Bt[n][k], At[m][k], acc[ai][bj][m][n], 0, 0, 0); } } \
        __builtin_amdgcn_s_setprio(0); } while (0)
#define PG8_WAIT_V(n) asm volatile("s_waitcnt vmcnt(" #n ")" ::: "memory")
#define PG8_WAIT_L(n) asm volatile("s_waitcnt lgkmcnt(" #n ")" ::: "memory")
#define PG8_BAR __builtin_amdgcn_s_barrier()
#define PG8_SCHED __builtin_amdgcn_sched_barrier(0)
    Unit cur, nxt; int ui = 0;
    if (!S.next(0, cur)) return;
    S.a_voff(cur, voffA, Rr, Cc);
    f32x4 acc[2][2][4][2];
#pragma unroll
    for (int a = 0; a < 2; ++a)
#pragma unroll
        for (int b = 0; b < 2; ++b)
#pragma unroll
            for (int m = 0; m < 4; ++m)
#pragma unroll
                for (int n = 0; n < 2; ++n) acc[a][b][m][n] = (f32x4){0.f, 0.f, 0.f, 0.f};
    bf16x8 At[4][2], B0[2][2], B1[2][2];
    const char* cA = S.a_ptr(cur); const char* cB = S.b_ptr(cur);
    PG8_STAGE(PG8_SB(0, 0), cB, voffB); PG8_STAGE(PG8_SB(0, 1), cB + hstep, voffB); PG8_STAGE(PG8_SA(0, 0), cA, voffA[0]); PG8_STAGEA1(PG8_SA(0, 1), cA);
    if (wr == 1) PG8_BAR;
    PG8_WAIT_V(2); PG8_BAR;
    PG8_STAGE(PG8_SB(1, 0), cB + kstep, voffB); PG8_STAGE(PG8_SA(1, 0), cA + kstep, voffA[0]); PG8_STAGE(PG8_SB(1, 1), cB + hstep + kstep, voffB);
    PG8_WAIT_V(6); PG8_BAR;
    for (;;) {
        const bool has_next = S.next(ui + 1, nxt);
        const char* nA = has_next ? S.a_ptr(nxt) : cA; const char* nB = has_next ? S.b_ptr(nxt) : cB;
#pragma unroll 1
        for (int t = 0; t < nt; t += 2) {
            const bool last = (t == nt - 2);
            if (last) GMARK(40); if (t == 2) GMARK1(45);
            const char* a1 = cA + (size_t)(t + 1) * kstep;
            const char* a2 = last ? nA : cA + (size_t)(t + 2) * kstep; const char* b2 = last ? nB : cB + (size_t)(t + 2) * kstep;
            const char* a3 = a2 + kstep; const char* b3 = b2 + kstep;
            asm volatile("" : "+s"(a1), "+s"(a2), "+s"(a3), "+s"(b2), "+s"(b3));
            PG8_LDB(B0, 0, 0); PG8_LDB(B1, 0, 1); PG8_SCHED; PG8_LDA(At, 0, 0); PG8_STAGEA1(PG8_SA(1, 1), a1);
            if (Sched::GATHER) { if (last && has_next) S.a_voff(nxt, voffA, Rr, Cc); }
            PG8_WAIT_V(8); PG8_WAIT_L(0); PG8_BAR; PG8_MMA(0, 0, At, B0); PG8_MMA(0, 1, At, B1); PG8_BAR; PG8_SCHED;
            PG8_LDA(At, 0, 1); PG8_STAGE(PG8_SB(0, 0), b2, voffB); PG8_STAGE(PG8_SB(0, 1), b2 + hstep, voffB); PG8_STAGE(PG8_SA(0, 0), a2, voffA[0]);
            PG8_WAIT_V(8); PG8_WAIT_L(0); PG8_BAR; PG8_MMA(1, 0, At, B0); PG8_MMA(1, 1, At, B1); PG8_BAR; PG8_SCHED;
            PG8_LDB(B0, 1, 0); PG8_LDB(B1, 1, 1); PG8_SCHED; PG8_LDA(At, 1, 0); PG8_STAGEA1(PG8_SA(0, 1), a2);
            PG8_WAIT_V(8); PG8_WAIT_L(0); PG8_BAR; PG8_MMA(0, 0, At, B0); PG8_MMA(0, 1, At, B1); PG8_BAR; PG8_SCHED;
            PG8_LDA(At, 1, 1); PG8_STAGE(PG8_SB(1, 0), b3, voffB); PG8_STAGE(PG8_SB(1, 1), b3 + hstep, voffB); PG8_STAGE(PG8_SA(1, 0), a3, voffA[0]);
            PG8_WAIT_V(8); PG8_WAIT_L(0); PG8_BAR; PG8_MMA(1, 0, At, B0); PG8_MMA(1, 1, At, B1); PG8_BAR; PG8_SCHED;
        }
        GMARK(41);
        if (wr == 0) PG8_BAR;
        GMARK(42);
        E(acc, cur, wr, wc, fr, fq);
        GMARK(43);
        if (!has_next) break;
#pragma unroll
        for (int a = 0; a < 2; ++a)
#pragma unroll
            for (int b = 0; b < 2; ++b)
#pragma unroll
                for (int m = 0; m < 4; ++m)
#pragma unroll
                    for (int n = 0; n < 2; ++n) acc[a][b][m][n] = (f32x4){0.f, 0.f, 0.f, 0.f};
        cur = nxt; cA = nA; cB = nB; ++ui;
        if (wr == 1) PG8_BAR;
    }
    PG8_WAIT_V(0);
    PG8_BAR;
#undef PG8_SA
#undef PG8_SB
#undef PG8_STAGE
#undef PG8_STAGEA1
#undef PG8_LDA
#undef PG8_LDB
#undef PG8_MMA
#undef PG8_WAIT_V
#undef PG8_WAIT_L
#undef PG8_BAR
#undef PG8_SCHED
}
}

struct Args { const float* in[33]; float* out; unsigned char* ws; int ph_lo, ph_hi, li, pad; };
enum { I_X = 0, I_C, I_CTX, I_CCTX, I_ADAW, I_ADAB, I_NMG, I_NFG, I_EWIN, I_EBIN, I_ECW, I_ECB, I_ELNG, I_ELNB, I_QNG, I_KNG, I_SINK, I_EWOUT, I_EBOUT,
       I_OWIN, I_OBIN, I_OLNG, I_OLNB, I_OWS, I_OBS, I_OWOUT, I_OBOUT, I_RW, I_RB, I_W1, I_B1, I_W2, I_B2 };

typedef const __attribute__((address_space(4))) unsigned long long* kargp_t;
struct Ctx {
    LAS unsigned char* lds; int tid, lane, wave, G, vcu, gw, NGW, bid; unsigned char* ws; kargp_t kp;
};
__device__ __forceinline__ const float* in_ptr(const Ctx& X, int i) { return (const float*)(const __attribute__((address_space(1))) float*)X.kp[i]; }
#define IN(i) in_ptr(X, (i))
#if PROBE_PH == -2
#define PMARK(k) do { if (X.bid == 0 && X.tid == 0) { volatile LAS unsigned long long* pm_ = (volatile LAS unsigned long long*)(X.lds + MISC_OFF + 128); \
    if ((k) == PROBE_A) pm_[0] = __builtin_amdgcn_s_memrealtime(); if ((k) == PROBE_B) pm_[1] = __builtin_amdgcn_s_memrealtime(); } } while (0)
#else
#define PMARK(k) do { } while (0)
#endif

struct DenseSched {
    static constexpr bool GATHER = false, FP8 = false;
    const bf16* A; const bf16* Bt; int nM, nN, nwg, G, c;
    const bf16* A2; const bf16* Bt2; int nM2;
    __device__ __forceinline__ void init(const bf16* A_, const bf16* Bt_, int M, int N, int G_, int c_) { A = A_; Bt = Bt_; nM = M / 256; nN = N / 256; nwg = nM * nN; G = G_; c = c_; A2 = nullptr; Bt2 = nullptr; nM2 = 0; }
    __device__ __forceinline__ bool next(int i, pg8::Unit& u) const {
        const int L = i * G + c; if (L >= nwg + nM2) return false; u.idx = i;
        if (L >= nwg) { u.pm = L - nwg; u.pn = 0; u.e = 1; u.cnt = 256; return true; }
        int wgid = L; { const int q = nwg / 8, r = nwg % 8, xcd = wgid % 8, off = wgid / 8; wgid = (xcd < r ? xcd * (q + 1) : r * (q + 1) + (xcd - r) * q) + off; }
        const int nig = 8 * nN, gid = wgid / nig, fm = gid * 8, gsz = (nM - fm) < 8 ? (nM - fm) : 8;
        u.pm = fm + ((wgid % nig) % gsz); u.pn = (wgid % nig) / gsz; u.e = 0; u.cnt = 256; return true;
    }
    __device__ __forceinline__ const char* a_ptr(const pg8::Unit& u) const { return (const char*)(u.e ? A2 : A) + (size_t)u.pm * 256 * pg8::KD * 2; }
    __device__ __forceinline__ const char* b_ptr(const pg8::Unit& u) const { return (const char*)(u.e ? Bt2 : Bt) + (size_t)u.pn * 256 * pg8::KD * 2; }
    __device__ __forceinline__ void a_voff(const pg8::Unit&, unsigned (&v)[2][2], const int (&R)[2], const int (&C)[2]) const {
#pragma unroll
        for (int i = 0; i < 2; ++i) { v[0][i] = (unsigned)(R[i] * pg8::KD + C[i]) * 2u; v[1][i] = v[0][i] + (unsigned)(pg8::HALF * pg8::KD * 2); }
    }
};
template <bool GATHER_, int NTILE_N>
struct MoeSchedT {
    static constexpr bool GATHER = GATHER_, FP8 = true; static constexpr int RP = 1024;
    const LAS int* tab; int G, c;
    const unsigned char* A;
    const unsigned char* Bt;
    const int* list;
    const LAS int* meta;
    __device__ __forceinline__ bool next(int i, pg8::Unit& u) const {
        const int L = i * G + c; const int T = tab[0];
        if (L >= T * NTILE_N) return false;
        u.idx = i;
        const int mt = L / NTILE_N; u.pn = L % NTILE_N;
        const int w = __builtin_amdgcn_readfirstlane(tab[1 + mt]); u.e = w >> 16; const int tl = w & 0xffff;
        const int cnt = __builtin_amdgcn_readfirstlane(tab[512 + u.e]), pb = __builtin_amdgcn_readfirstlane(tab[544 + u.e]);
        u.pm = pb + tl * 256; u.cnt = cnt - tl * 256;
        return true;
    }
    __device__ __forceinline__ const char* a_ptr(const pg8::Unit& u) const { return GATHER ? (const char*)A : (const char*)A + (size_t)u.pm * RP; }
    __device__ __forceinline__ const char* b_ptr(const pg8::Unit& u) const { return (const char*)Bt + ((size_t)u.e * NTILE_N + u.pn) * 256 * RP; }
    __device__ __forceinline__ void a_voff(const pg8::Unit& u, unsigned (&v)[2][2], const int (&R)[2], const int (&C)[2]) const {
        if (GATHER) {
#pragma unroll
            for (int h = 0; h < 2; ++h)
#pragma unroll
                for (int i = 0; i < 2; ++i) { const int tok = meta[u.idx * 256 + h * 128 + R[i]]; v[h][i] = (unsigned)(tok * RP + C[i] * 2); }
        } else {
#pragma unroll
            for (int i = 0; i < 2; ++i) { v[0][i] = (unsigned)(R[i] * RP + C[i] * 2); v[1][i] = v[0][i] + (unsigned)(pg8::HALF * RP); }
        }
    }
};
__device__ __forceinline__ void moe_build_table(const Ctx& X, const int* cnt  ) {
    LAS int* tab = (LAS int*)(X.lds + TAB_OFF);
    __syncthreads();
    if (X.tid < 64) {
        const int e = X.lane; int c = 0; if (e < NE) c = __hip_atomic_load(cnt + e * CNT_STRIDE, __ATOMIC_RELAXED, __HIP_MEMORY_SCOPE_AGENT);
        const int mt = (c + 255) >> 8; int incl = mt;
#pragma unroll
        for (int off = 1; off < 32; off <<= 1) { const int v = __shfl_up(incl, off); if (X.lane >= off) incl += v; }
        const int start = incl - mt;
        if (e < NE) { tab[512 + e] = c; tab[544 + e] = start * 256; for (int t = 0; t < mt; ++t) tab[1 + start + t] = (e << 16) | t; if (e == NE - 1) tab[0] = incl; }
    }
    __syncthreads();
}
template <bool WITH_GATE, class Sched>
__device__ __forceinline__ void moe_stage_meta(const Ctx& X, const Sched& S, const int* list, const float* gatew, LAS int* meta, const float* bias, LAS float* lbias) {
    if (X.tid < 256) { pg8::Unit u;
        for (int i = 0; S.next(i, u); ++i) { const int slot0 = u.pm - S.tab[544 + u.e]; const int r = X.tid < u.cnt ? X.tid : u.cnt - 1;
            const int aid = list[(size_t)u.e * NTOK + slot0 + r];
            if (WITH_GATE) { const float g = gatew[aid]; *(LAS u32x2*)(meta + (i * 256 + X.tid) * 2) = (u32x2){(unsigned)aid, __float_as_uint(g)}; }
            else meta[i * 256 + X.tid] = aid >> 2; } }
    else { const int c = X.tid - 256; pg8::Unit u;
        for (int i = 0; S.next(i, u); ++i) lbias[i * 256 + c] = WITH_GATE ? bias[(size_t)u.e * D + u.pn * 256 + c] : bias[(size_t)u.e * 2048 + (c >> 7) * 1024 + u.pn * 128 + (c & 127)]; }
    __syncthreads();
}

__device__ __forceinline__ f32x2 gelu_pk(f32x2 v) {
    const f32x2 av = __builtin_elementwise_abs(v), d = av * 0.2316418882f + 1.0f;
    f32x2 t; t.x = __builtin_amdgcn_rcpf(d.x); t.y = __builtin_amdgcn_rcpf(d.y);
    f32x2 q = t * 0.5307027145f + (-0.7265760135f); q = q * t + 0.7107068705f; q = q * t + (-0.142248368f); q = q * t + 0.127414796f; q = q * t;
    const f32x2 s = (v * v) * (-0.72134752044f);
    f32x2 e; e.x = __builtin_amdgcn_exp2f(s.x); e.y = __builtin_amdgcn_exp2f(s.y);
    const f32x2 m = v * (q * e), r = v - m;
    f32x2 o; o.x = v.x < 0.f ? m.x : r.x; o.y = v.y < 0.f ? m.y : r.y; return o;
}
__device__ __forceinline__ u32x4 pack8(f32x4 a, f32x4 b) { u32x4 w; w.x = pk2(a[0], a[1]); w.y = pk2(a[2], a[3]); w.z = pk2(b[0], b[1]); w.w = pk2(b[2], b[3]); return w; }

struct EpiIn {
    static constexpr bool PERM = true;
    bf16 *GLU, *Q, *Kb, *Vb, *KC, *VC; const float* bias;
    __device__ __forceinline__ void operator()(const f32x4 (&acc)[2][2][4][2], const pg8::Unit& u, int wr, int wc, int fr, int fq) const {
        asm volatile("" : "+v"(fr), "+v"(fq));
        const int row0 = u.pm * 256 + wr * 64 + fr; const int c8 = wc * 32 + 8 * fq;
        if (u.e == 0 && u.pn < 4) {
            const int j0 = u.pn * 128 + c8;
            f32x4 bu[2], bg[2];
#pragma unroll
            for (int n = 0; n < 2; ++n) { bu[n] = *(const f32x4*)(bias + j0 + 4 * n); bg[n] = *(const f32x4*)(bias + 512 + j0 + 4 * n); }
#pragma unroll
            for (int ai = 0; ai < 2; ++ai)
#pragma unroll
                for (int m = 0; m < 4; ++m) { f32x4 o[2];
#pragma unroll
                    for (int n = 0; n < 2; ++n) { const f32x4 uu = acc[ai][0][m][n] + bu[n], gg = acc[ai][1][m][n] + bg[n];
#pragma unroll
                        for (int k = 0; k < 4; ++k) o[n][k] = uu[k] * sigmoidf_(gg[k]); }
                    *(u32x4*)(GLU + (size_t)(row0 + ai * 128 + m * 16) * 512 + j0) = pack8(o[0], o[1]); }
        } else {
#pragma unroll
            for (int bj = 0; bj < 2; ++bj) {
                bf16* dst; int ld, col, bcol;
                if (u.pn >= 6 || u.e) { dst = u.e ? (bj ? VC : KC) : (bj ? Vb : Kb); ld = 128; col = c8; bcol = KV_COL + bj * 128 + c8; }
                else { dst = Q; ld = 512; col = (u.pn - 4) * 256 + bj * 128 + c8; bcol = 1024 + col; }
                f32x4 bv[2];
#pragma unroll
                for (int n = 0; n < 2; ++n) bv[n] = *(const f32x4*)(bias + bcol + 4 * n);
#pragma unroll
                for (int ai = 0; ai < 2; ++ai)
#pragma unroll
                    for (int m = 0; m < 4; ++m) *(u32x4*)(dst + (size_t)(row0 + ai * 128 + m * 16) * ld + col) = pack8(acc[ai][bj][m][0] + bv[0], acc[ai][bj][m][1] + bv[1]);
            }
        }
    }
};
template <bool BASE_F32> struct EpiRes {
    static constexpr bool PERM = true;
    const void* base; bf16* out; const float* bias; const float* gate;
    __device__ __forceinline__ void operator()(const f32x4 (&acc)[2][2][4][2], const pg8::Unit& u, int wr, int wc, int fr, int fq) const {
        asm volatile("" : "+v"(fr), "+v"(fq));
        const int col0 = u.pn * 256 + wc * 32 + 8 * fq; const int b = (u.pm * 256) / SEQ;
#pragma unroll
        for (int bj = 0; bj < 2; ++bj) {
            f32x4 bv[2], gv[2];
#pragma unroll
            for (int n = 0; n < 2; ++n) { bv[n] = *(const f32x4*)(bias + col0 + bj * 128 + 4 * n); gv[n] = *(const f32x4*)(gate + (size_t)b * MODW + col0 + bj * 128 + 4 * n); }
#pragma unroll
            for (int ai = 0; ai < 2; ++ai)
#pragma unroll
                for (int m = 0; m < 4; ++m) { const size_t off = (size_t)(u.pm * 256 + ai * 128 + wr * 64 + m * 16 + fr) * D + col0 + bj * 128;
                    f32x4 b0, b1;
                    if (BASE_F32) { b0 = *(const f32x4*)((const float*)base + off); b1 = *(const f32x4*)((const float*)base + off + 4); }
                    else { const u32x4 w = *(const u32x4*)((const bf16*)base + off); b0 = (f32x4){bf2f(w.x & 0xffffu), bf2f(w.x >> 16), bf2f(w.y & 0xffffu), bf2f(w.y >> 16)}; b1 = (f32x4){bf2f(w.z & 0xffffu), bf2f(w.z >> 16), bf2f(w.w & 0xffffu), bf2f(w.w >> 16)}; }
                    *(u32x4*)(out + off) = pack8(b0 + gv[0] * (acc[ai][bj][m][0] + bv[0]), b1 + gv[1] * (acc[ai][bj][m][1] + bv[1])); }
        }
    }
};
struct EpiGelu {
    static constexpr bool PERM = true;
    bf16 *U, *V; const float* bias; float* vstat;
    __device__ __forceinline__ void operator()(const f32x4 (&acc)[2][2][4][2], const pg8::Unit& u, int wr, int wc, int fr, int fq) const {
        asm volatile("" : "+v"(fr), "+v"(fq));
        const int row0 = u.pm * 256 + wr * 64 + fr; const int colt = u.pn * 256; const bool isv = colt >= 1024; bf16* base = isv ? V : U; const int cb = (colt & 1023) + wc * 32 + 8 * fq, bcol = colt + wc * 32 + 8 * fq;
        f32x4 bv[2][2];
#pragma unroll
        for (int bj = 0; bj < 2; ++bj)
#pragma unroll
            for (int n = 0; n < 2; ++n) bv[bj][n] = *(const f32x4*)(bias + bcol + bj * 128 + 4 * n);
#pragma unroll
        for (int ai = 0; ai < 2; ++ai)
#pragma unroll
            for (int m = 0; m < 4; ++m) { const int row = row0 + ai * 128 + m * 16; bf16* rowp = base + (size_t)row * D + cb; float s = 0.f, s2 = 0.f;
#pragma unroll
                for (int bj = 0; bj < 2; ++bj) { f32x4 v0 = acc[ai][bj][m][0] + bv[bj][0], v1 = acc[ai][bj][m][1] + bv[bj][1];
                    f32x2 a = gelu_pk((f32x2){v0[0], v0[1]}), b = gelu_pk((f32x2){v0[2], v0[3]}), c = gelu_pk((f32x2){v1[0], v1[1]}), d = gelu_pk((f32x2){v1[2], v1[3]});
                    s += (a.x + a.y) + (b.x + b.y) + (c.x + c.y) + (d.x + d.y); s2 += (a.x * a.x + a.y * a.y) + (b.x * b.x + b.y * b.y) + (c.x * c.x + c.y * c.y) + (d.x * d.x + d.y * d.y);
                    *(u32x4*)(rowp + bj * 128) = pack8((f32x4){a.x, a.y, b.x, b.y}, (f32x4){c.x, c.y, d.x, d.y}); }
                if (isv) { s += __shfl_xor(s, 16); s += __shfl_xor(s, 32); s2 += __shfl_xor(s2, 16); s2 += __shfl_xor(s2, 32);
                    if (fq == 0) { unsafeAtomicAdd(vstat + 2 * row, s); unsafeAtomicAdd(vstat + 2 * row + 1, s2); } } }
    }
};
struct EpiSwiglu {
    static constexpr bool PERM = true;
    unsigned char* ACT; const LAS float* lbias;
    __device__ __forceinline__ void operator()(const f32x4 (&acc)[2][2][4][2], const pg8::Unit& u, int wr, int wc, int fr, int fq) const {
        asm volatile("" : "+v"(fr), "+v"(fq));
        const int j0 = u.pn * 128 + wc * 32 + 8 * fq; const LAS float* bb = lbias + u.idx * 256 + wc * 32 + 8 * fq;
        f32x4 bg[2], bu[2];
#pragma unroll
        for (int n = 0; n < 2; ++n) { bg[n] = *(const LAS f32x4*)(bb + 4 * n); bu[n] = *(const LAS f32x4*)(bb + 128 + 4 * n); }
#pragma unroll
        for (int ai = 0; ai < 2; ++ai)
#pragma unroll
            for (int m = 0; m < 4; ++m) { f32x4 o[2];
#pragma unroll
                for (int n = 0; n < 2; ++n) { const f32x4 g4 = acc[ai][0][m][n] * FP8_DESCALE + bg[n], u4 = acc[ai][1][m][n] * FP8_DESCALE + bu[n];
#pragma unroll
                    for (int k = 0; k < 4; ++k) { const float g = fminf(g4[k], 7.0f), up = fminf(fmaxf(u4[k], -7.0f), 7.0f); o[n][k] = (up + 1.0f) * g * sigmoidf_(g * 1.702f); } }
                u32x2 w8; w8.x = pk4_fp8(o[0][0] * FP8_AMUL, o[0][1] * FP8_AMUL, o[0][2] * FP8_AMUL, o[0][3] * FP8_AMUL); w8.y = pk4_fp8(o[1][0] * FP8_AMUL, o[1][1] * FP8_AMUL, o[1][2] * FP8_AMUL, o[1][3] * FP8_AMUL);
                *(u32x2*)(ACT + (size_t)(u.pm + ai * 128 + wr * 64 + m * 16 + fr) * D + j0) = w8; }
    }
};
struct EpiDown {
    static constexpr bool PERM = true;
    bf16* Y; const LAS float* lbias; const LAS int* meta;
    __device__ __forceinline__ void operator()(const f32x4 (&acc)[2][2][4][2], const pg8::Unit& u, int wr, int wc, int fr, int fq) const {
        asm volatile("" : "+v"(fr), "+v"(fq));
        const int c8 = u.pn * 256 + wc * 32 + 8 * fq; const LAS float* bb = lbias + u.idx * 256 + wc * 32 + 8 * fq;
#pragma unroll
        for (int bj = 0; bj < 2; ++bj) {
            f32x4 bv[2];
#pragma unroll
            for (int n = 0; n < 2; ++n) bv[n] = *(const LAS f32x4*)(bb + bj * 128 + 4 * n);
#pragma unroll
            for (int ai = 0; ai < 2; ++ai)
#pragma unroll
                for (int m = 0; m < 4; ++m) { const int r = ai * 128 + wr * 64 + m * 16 + fr; const u32x2 mg = *(const LAS u32x2*)(meta + (u.idx * 256 + r) * 2); const int aid = (int)mg.x; const float g = __uint_as_float(mg.y);
                    const u32x4 w = pack8((acc[ai][bj][m][0] * FP8_DESCALE + bv[0]) * g, (acc[ai][bj][m][1] * FP8_DESCALE + bv[1]) * g);
                    if (r < u.cnt) *(u32x4*)(Y + (size_t)aid * D + c8 + bj * 128) = w; }
        }
    }
};

struct TrItem { const float* src; bf16* dst; int N; int fp8; };
__device__ __forceinline__ void tr_load(const TrItem& t, float (&v)[32], int lane) {
#pragma unroll
    for (int i = 0; i < 32; ++i) v[i] = __builtin_nontemporal_load(t.src + (size_t)(2 * i + (lane >> 5)) * t.N + (lane & 31));
}
__device__ __forceinline__ void tr_store(const TrItem& t, const float (&v)[32], LAS float* scr, int lane) {
#pragma unroll
    for (int i = 0; i < 32; ++i) scr[(2 * i + (lane >> 5)) * 33 + (lane & 31)] = v[i];
    LDS_WAIT();
    if (t.fp8) {
        const int q = lane & 3;
#pragma unroll
        for (int j = 0; j < 2; ++j) { const int n = (lane >> 2) + 16 * j; const LAS float* s = scr + (16 * q) * 33 + n; u32x4 o;
#pragma unroll
            for (int c = 0; c < 4; ++c) o[c] = pk4_fp8(s[(4 * c) * 33] * FP8_WMUL, s[(4 * c + 1) * 33] * FP8_WMUL, s[(4 * c + 2) * 33] * FP8_WMUL, s[(4 * c + 3) * 33] * FP8_WMUL);
            *(u32x4*)((unsigned char*)t.dst + (size_t)n * 1024 + 16 * q) = o; }
    } else {
        const int c = lane & 7;
#pragma unroll
        for (int j = 0; j < 4; ++j) { const int n = (lane >> 3) + 8 * j; const LAS float* s = scr + (8 * c) * 33 + n;
            u32x4 o; o.x = pk2(s[0 * 33], s[1 * 33]); o.y = pk2(s[2 * 33], s[3 * 33]); o.z = pk2(s[4 * 33], s[5 * 33]); o.w = pk2(s[6 * 33], s[7 * 33]);
            *(u32x4*)(t.dst + (size_t)n * 1024 + 8 * c) = o; }
    }
    LDS_WAIT();
}
template <int N, bool PAIR> struct MoeCvt {
    static constexpr int STRIPS = N / 512, ITEMS_PER_MAT = 8 * STRIPS;
    static __device__ __forceinline__ void load(const float* W, int item, f32x4 (&v)[4][2][4], int wave, int lane) {
        const int mat = item / ITEMS_PER_MAT, q = item % ITEMS_PER_MAT, kb = q / STRIPS, sb = q % STRIPS;
        const float* s = W + (size_t)mat * 1024 * N + (size_t)(128 * kb + 16 * wave) * N + 512 * sb + 4 * lane;
#pragma unroll
        for (int g = 0; g < 4; ++g)
#pragma unroll
            for (int hh = 0; hh < 2; ++hh)
#pragma unroll
                for (int r = 0; r < 4; ++r) v[g][hh][r] = __builtin_nontemporal_load((const f32x4*)(s + (size_t)(4 * g + r) * N + 256 * hh));
    }
    static __device__ __forceinline__ void to_lds(const f32x4 (&v)[4][2][4], LAS unsigned* img, int wave, int lane) {
#pragma unroll
        for (int g = 0; g < 4; ++g) { const int kq = 4 * wave + g;
#pragma unroll
            for (int hh = 0; hh < 2; ++hh)
#pragma unroll
                for (int j = 0; j < 4; ++j) { const int rho = 64 * hh + lane + 128 * j;
                    img[rho * 32 + ((kq ^ rho) & 31)] = pk4_fp8(v[g][hh][0][j] * FP8_WMUL, v[g][hh][1][j] * FP8_WMUL, v[g][hh][2][j] * FP8_WMUL, v[g][hh][3][j] * FP8_WMUL); } }
    }
    static __device__ __forceinline__ void store(unsigned char* WT, int item, const LAS unsigned* img, int wave, int lane) {
        const int mat = item / ITEMS_PER_MAT, q = item % ITEMS_PER_MAT, kb = q / STRIPS, sb = q % STRIPS;
        unsigned char* d = WT + (size_t)mat * N * 1024 + 128 * kb;
        const int mi = lane >> 3, c = lane & 7;
#pragma unroll
        for (int st = 0; st < 2; ++st)
#pragma unroll
            for (int j = 0; j < 4; ++j) { const int m = 16 * wave + 8 * st + mi, rho = m + 128 * j, n = 4 * m + j;
                u32x4 o;
#pragma unroll
                for (int i = 0; i < 4; ++i) o[i] = img[rho * 32 + (((4 * c + i) ^ rho) & 31)];
                int drow;
                if (PAIR) { const int h = sb >> 1, rem = 512 * (sb & 1) + n; drow = (rem >> 7) * 256 + h * 128 + (rem & 127); } else drow = 512 * sb + n;
                __builtin_nontemporal_store(o, (u32x4*)(d + (size_t)drow * 1024 + 16 * c)); }
    }
    static __device__ __forceinline__ void run(const float* W, unsigned char* WT, int nitems, int first, int stride, LAS unsigned char* lds, int wave, int lane) {
        f32x4 v[4][2][4]; int it = first, buf = 0;
        if (it < nitems) load(W, it, v, wave, lane);
        while (it < nitems) {
            LAS unsigned* img = (LAS unsigned*)(lds + buf * 65536);
            to_lds(v, img, wave, lane);
            __syncthreads();
            const int nx = it + stride; if (nx < nitems) load(W, nx, v, wave, lane);
            store(WT, it, img, wave, lane);
            it = nx; buf ^= 1;
        }
        __syncthreads();
    }
};

__device__ __forceinline__ int pair_src(int nd, int halfw) { return ((nd & 255) >> 7) * halfw + (nd >> 8) * 128 + (nd & 127); }

__device__ __forceinline__ void phase_prologue(const Args& a, const Ctx& X) {
    PMARK(20);
    {
        LAS float* sc = (LAS float*)X.lds;
        LAS float* red = (LAS float*)(X.lds + 36864);
        float* MOD = (float*)(X.ws + WS_MOD);
        for (int item = X.bid; item < 2 * 96; item += X.G) {
            const int l = item / 96, j0 = (item % 96) * 64;
            for (int idx = X.tid; idx < 9 * 1024; idx += NTHREADS) { const int r = idx >> 10, k = idx & 1023; const float v = r < 8 ? IN(I_C)[r * 1024 + k] : IN(I_CCTX)[k]; sc[idx] = v * sigmoidf_(v); }
            __syncthreads();
            float acc[9];
#pragma unroll
            for (int r = 0; r < 9; ++r) acc[r] = 0.f;
            const float* w = IN(I_ADAW) + (size_t)l * 1024 * MODW + j0 + X.lane;
#pragma unroll 8
            for (int k = X.wave * 128; k < X.wave * 128 + 128; ++k) { const float wv = __builtin_nontemporal_load(w + (size_t)k * MODW);
#pragma unroll
                for (int r = 0; r < 9; ++r) acc[r] += sc[r * 1024 + k] * wv; }
#pragma unroll
            for (int r = 0; r < 9; ++r) red[(X.wave * 9 + r) * 64 + X.lane] = acc[r];
            __syncthreads();
            for (int t = X.tid; t < 9 * 64; t += NTHREADS) { const int r = t >> 6, cidx = t & 63; float s = 0.f;
#pragma unroll
                for (int w8 = 0; w8 < 8; ++w8) s += red[(w8 * 9 + r) * 64 + cidx];
                MOD[((size_t)l * 9 + r) * MODW + j0 + cidx] = s + IN(I_ADAB)[l * MODW + j0 + cidx]; }
            __syncthreads();
        }
    }
    PMARK(21);
    LAS float* scr = (LAS float*)(X.lds + X.wave * 16384);
    bf16* WinT = (bf16*)(X.ws + WS_WINT); bf16* WoutT = (bf16*)(X.ws + WS_WOUTT); bf16* GWinT = (bf16*)(X.ws + WS_GWINT); bf16* GWoutT = (bf16*)(X.ws + WS_GWOUTT);
    bf16* W1T = (bf16*)(X.ws + WS_W1T); bf16* W2T = (bf16*)(X.ws + WS_W2T);
    constexpr int I_IN = 16 * (EVEN_IN / 32), I_OUT = 16 * 32, I_GIN = 16 * 64, I_GOUT = 16 * 32;
    constexpr int NITEMS = I_IN + I_OUT + I_GIN + I_GOUT;
    auto item_of = [&](int it) -> TrItem {
        int r = it; TrItem t; t.fp8 = 0;
        if (r < I_IN) { const int kb = r / 56, nd = (r % 56) * 32; const int ns = nd < 1024 ? pair_src(nd, 512) : nd; t.N = EVEN_IN; t.src = IN(I_EWIN) + (size_t)kb * 64 * EVEN_IN + ns; t.dst = WinT + (size_t)nd * 1024 + kb * 64; return t; } r -= I_IN;
        if (r < I_OUT) { const int kb = r >> 5, nd = (r & 31) * 32; t.N = 1024; t.src = IN(I_EWOUT) + (size_t)kb * 64 * 1024 + nd; t.dst = WoutT + (size_t)nd * 1024 + kb * 64; return t; } r -= I_OUT;
        if (r < I_GIN) { const int kb = r >> 6, nd = (r & 63) * 32; t.N = 2048; t.src = IN(I_OWIN) + (size_t)kb * 64 * 2048 + nd; t.dst = GWinT + (size_t)nd * 1024 + kb * 64; return t; } r -= I_GIN;
        { const int kb = r >> 5, nd = (r & 31) * 32; t.N = 1024; t.src = IN(I_OWOUT) + (size_t)kb * 64 * 1024 + nd; t.dst = GWoutT + (size_t)nd * 1024 + kb * 64; return t; }
    };
    {
        float va[32], vb[32]; int it = X.gw;
        TrItem ta, tb; if (it < NITEMS) { ta = item_of(it); tr_load(ta, va, X.lane); }
        while (it < NITEMS) {
            const int it1 = it + X.NGW; if (it1 < NITEMS) { tb = item_of(it1); tr_load(tb, vb, X.lane); }
            tr_store(ta, va, scr, X.lane);
            if (it1 >= NITEMS) break;
            const int it2 = it1 + X.NGW; if (it2 < NITEMS) { ta = item_of(it2); tr_load(ta, va, X.lane); }
            tr_store(tb, vb, scr, X.lane);
            it = it2;
        }
    }
    __syncthreads();
    MoeCvt<2048, true>::run(IN(I_W1), (unsigned char*)W1T, 64 * MoeCvt<2048, true>::ITEMS_PER_MAT, X.vcu, X.G, X.lds, X.wave, X.lane);
    MoeCvt<1024, false>::run(IN(I_W2), (unsigned char*)W2T, 64 * MoeCvt<1024, false>::ITEMS_PER_MAT, X.vcu, X.G, X.lds, X.wave, X.lane);
    PMARK(22);
    { bf16* WsB = (bf16*)(X.ws + WS_WSB); const float* ws = IN(I_OWS);
      for (int i = (X.gw * 64 + X.lane) * 4; i < 8 * 128 * 128; i += X.NGW * 64 * 4) { const f32x4 v = *(const f32x4*)(ws + i); u32x2 o; o.x = pk2(v[0], v[1]); o.y = pk2(v[2], v[3]); *(u32x2*)(WsB + i) = o; } }
}

__device__ __forceinline__ void modulate_row(const float* xrow, const float* g, const float* sh, const float* sc, bf16* orow, int lane, f32x4 (&y)[4]) {
    const f32x4* xr = (const f32x4*)xrow + lane; f32x4 v[4]; float ss = 0.f;
#pragma unroll
    for (int j = 0; j < 4; ++j) { v[j] = xr[64 * j]; ss += (v[j][0] * v[j][0] + v[j][1] * v[j][1]) + (v[j][2] * v[j][2] + v[j][3] * v[j][3]); }
    const float rstd = rsqrtf(wave_sum(ss) * (1.0f / D) + EPS);
#pragma unroll
    for (int j = 0; j < 4; ++j) { const f32x4 gk = ((const f32x4*)g)[lane + 64 * j], sk = ((const f32x4*)sc)[lane + 64 * j], hk = ((const f32x4*)sh)[lane + 64 * j];
        y[j] = v[j] * rstd * gk * (1.0f + sk) + hk;
        u32x2 o; o.x = pk2(y[j][0], y[j][1]); o.y = pk2(y[j][2], y[j][3]); *((u32x2*)orow + lane + 64 * j) = o; }
}
__device__ __forceinline__ void mod0_load(const Ctx& X, int row, f32x4 (&v)[4]) {
    const float* xrow = row < NTOK ? IN(I_X) + (size_t)row * D : IN(I_CTX) + (size_t)(row - NTOK) * D;
#pragma unroll
    for (int j = 0; j < 4; ++j) v[j] = ((const f32x4*)xrow)[X.lane + 64 * j];
}
__device__ __forceinline__ void mod0_finish(const Ctx& X, int row, const f32x4 (&v)[4]) {
    const float* m = (const float*)(X.ws + WS_MOD) + (size_t)(row < NTOK ? row / SEQ : 8) * MODW; const float* g = IN(I_NMG);
    bf16* orow = row < NTOK ? (bf16*)(X.ws + WS_XA) + (size_t)row * D : (bf16*)(X.ws + WS_GM) + (size_t)(row - NTOK) * D;
    f32x4 gk[4], hk[4], sk[4]; float ss = 0.f;
#pragma unroll
    for (int j = 0; j < 4; ++j) { gk[j] = ((const f32x4*)g)[X.lane + 64 * j]; hk[j] = ((const f32x4*)m)[X.lane + 64 * j]; sk[j] = ((const f32x4*)(m + 1024))[X.lane + 64 * j];
        ss += (v[j][0] * v[j][0] + v[j][1] * v[j][1]) + (v[j][2] * v[j][2] + v[j][3] * v[j][3]); }
    const float rstd = rsqrtf(wave_sum(ss) * (1.0f / D) + EPS);
#pragma unroll
    for (int j = 0; j < 4; ++j) { const f32x4 y = v[j] * rstd * gk[j] * (1.0f + sk[j]) + hk[j]; u32x2 o; o.x = pk2(y[0], y[1]); o.y = pk2(y[2], y[3]); *((u32x2*)orow + X.lane + 64 * j) = o; }
}
__device__ __forceinline__ void phase_modulate0(const Args& a, const Ctx& X) {
    constexpr int NR = NTOK + NCTX; f32x4 va[4], vb[4];
    int row = X.gw; if (row < NR) mod0_load(X, row, va);
    while (row < NR) {
        const int r1 = row + X.NGW; if (r1 < NR) mod0_load(X, r1, vb);
        mod0_finish(X, row, va);
        if (r1 >= NR) break;
        const int r2 = r1 + X.NGW; if (r2 < NR) mod0_load(X, r2, va);
        mod0_finish(X, r1, vb);
        row = r2;
    }
}

__device__ __forceinline__ void qk_chunks(bf16* buf, int nchunks, int rowlen, const float* gn, bool rope, float oscale, const Ctx& X, const LAS f32x2* cs) {
    for (int ch = X.gw; ch < nchunks; ch += X.NGW) {
        const int e0 = ch * 512 + 8 * X.lane; const int token = e0 / rowlen; const int d0 = e0 & 63;
        u32x4 raw = *(const u32x4*)(buf + e0); float v[8];
#pragma unroll
        for (int i = 0; i < 4; ++i) { v[2 * i] = bf2f(raw[i] & 0xffffu); v[2 * i + 1] = bf2f(raw[i] >> 16); }
        float ss = 0.f;
#pragma unroll
        for (int i = 0; i < 8; ++i) ss += v[i] * v[i];
        ss += __shfl_xor(ss, 1); ss += __shfl_xor(ss, 2); ss += __shfl_xor(ss, 4);
        const float rstd = rsqrtf(ss * (1.0f / 64.0f) + EPS);
        const f32x4 g0 = *(const f32x4*)(gn + d0), g1 = *(const f32x4*)(gn + d0 + 4);
#pragma unroll
        for (int i = 0; i < 4; ++i) { v[i] = v[i] * rstd * g0[i]; v[4 + i] = v[4 + i] * rstd * g1[i]; }
        if (rope) {
            const int t = token % SEQ; const int dd0 = d0 & 31; const int pos = dd0 < 16 ? (t >> 6) : (t & 63);
            const LAS f32x2* cp = cs + pos * 16 + (dd0 & 15);
#pragma unroll
            for (int i = 0; i < 8; ++i) { const float pv = __shfl_xor(v[i], 4); const f32x2 c = cp[i];
                v[i] = (d0 < 32) ? (v[i] * c.x - pv * c.y) : (v[i] * c.x + pv * c.y); }
        }
        u32x4 o; o.x = pk2(v[0] * oscale, v[1] * oscale); o.y = pk2(v[2] * oscale, v[3] * oscale); o.z = pk2(v[4] * oscale, v[5] * oscale); o.w = pk2(v[6] * oscale, v[7] * oscale);
        *(u32x4*)(buf + e0) = o;
    }
}
__device__ __forceinline__ void phase_conv_qk(const Args& a, const Ctx& X) {
    LAS f32x2* cs = (LAS f32x2*)(X.lds + 65536);
    for (int i = X.tid; i < 1024; i += NTHREADS) { const float inv = exp2f(-(float)(i & 15) * (13.287712379549449f / 16.0f)); float sn, csn; sincosf((float)(i >> 4) * inv, &sn, &csn); cs[i] = (f32x2){csn, sn}; }
    __syncthreads();
    qk_chunks((bf16*)(X.ws + WS_Q), NTOK, 512, IN(I_QNG), true, QSCALE, X, cs);
    qk_chunks((bf16*)(X.ws + WS_K), NTOK / 4, 128, IN(I_KNG), true, 1.0f, X, cs);
    qk_chunks((bf16*)(X.ws + WS_KC), NCTX / 4, 128, IN(I_KNG), false, 1.0f, X, cs);
    const bf16* GLU = (const bf16*)(X.ws + WS_GLU); bf16* MIX = (bf16*)(X.ws + WS_MIX);
    LAS unsigned* tin = (LAS unsigned*)X.lds;
    LAS float* tout = (LAS float*)(X.lds + 65536);
    const int cp = X.tid & 255, th = X.tid >> 8;
    float w0[31], w1[31];
#pragma unroll
    for (int j = 0; j < 31; ++j) { const f32x2 w = *(const f32x2*)(IN(I_ECW) + j * 512 + 2 * cp); w0[j] = w.x; w1[j] = w.y; }
    const f32x2 cb = *(const f32x2*)(IN(I_ECB) + 2 * cp);
    for (int tile = X.bid; tile < NTOK / 32; tile += X.G) {
        const int row0 = tile * 32; const int t0 = row0 % SEQ;
        __syncthreads();
        for (int c = X.tid; c < 62 * 64; c += NTHREADS) { const int lr = c >> 6, cc = c & 63; const int t = t0 - 15 + lr;
            u32x4 v = (u32x4){0u, 0u, 0u, 0u}; if (t >= 0 && t < SEQ) v = *(const u32x4*)(GLU + (size_t)(row0 - 15 + lr) * 512 + cc * 8);
            *(LAS u32x4*)(tin + lr * 256 + cc * 4) = v; }
        __syncthreads();
        float a0[16], a1[16];
#pragma unroll
        for (int o = 0; o < 16; ++o) { a0[o] = cb.x; a1[o] = cb.y; }
#pragma unroll
        for (int rr = 0; rr < 46; ++rr) { const unsigned pv = tin[(16 * th + rr) * 256 + cp]; const float x0 = bf2f(pv & 0xffffu), x1 = bf2f(pv >> 16);
#pragma unroll
            for (int o = 0; o < 16; ++o) { const int j = rr - o; if (j >= 0 && j <= 30) { a0[o] += x0 * w0[j]; a1[o] += x1 * w1[j]; } } }
#pragma unroll
        for (int o = 0; o < 16; ++o) *(LAS f32x2*)(tout + (16 * th + o) * 512 + 2 * cp) = (f32x2){a0[o], a1[o]};
        __syncthreads();
#pragma unroll
        for (int q = 0; q < 4; ++q) { const int tl = X.wave * 4 + q; f32x4 v[2]; float s = 0.f;
#pragma unroll
            for (int j = 0; j < 2; ++j) { v[j] = *(const LAS f32x4*)(tout + tl * 512 + 4 * X.lane + 256 * j); s += (v[j][0] + v[j][1]) + (v[j][2] + v[j][3]); }
            const float mean = wave_sum(s) * (1.0f / 512.0f); float s2 = 0.f;
#pragma unroll
            for (int j = 0; j < 2; ++j) { v[j] = v[j] - mean; s2 += (v[j][0] * v[j][0] + v[j][1] * v[j][1]) + (v[j][2] * v[j][2] + v[j][3] * v[j][3]); }
            const float rstd = rsqrtf(wave_sum(s2) * (1.0f / 512.0f) + EPS);
#pragma unroll
            for (int j = 0; j < 2; ++j) { const f32x4 g = *(const f32x4*)(IN(I_ELNG) + 4 * X.lane + 256 * j), b = *(const f32x4*)(IN(I_ELNB) + 4 * X.lane + 256 * j);
                f32x4 y = v[j] * rstd * g + b;
#pragma unroll
                for (int k = 0; k < 4; ++k) y[k] = y[k] * sigmoidf_(y[k]);
                u32x2 o; o.x = pk2(y[0], y[1]); o.y = pk2(y[2], y[3]); *(u32x2*)(MIX + (size_t)(row0 + tl) * D + 4 * X.lane + 256 * j) = o; } }
    }
}

__device__ __forceinline__ void phase_attention(const Args& a, const Ctx& X) {
    unsigned char* const wsb = X.ws;
    LAS unsigned char* Ks = X.lds;
    LAS unsigned char* Vt = X.lds + 16384;
    const int lane = X.lane, l15 = lane & 15, g4 = lane >> 4;
    for (int unit = X.bid; unit < NB * 2 * 32; unit += X.G) {
        const int b = unit >> 6, kh = (unit >> 5) & 1, qb = unit & 31; const int q0 = qb * 64;
        const int hq = kh * 4 + (X.wave >> 1), tq = (X.wave & 1) * 32;
        bf16x8 Qf[2][2];
#pragma unroll
        for (int qi = 0; qi < 2; ++qi)
#pragma unroll
            for (int s = 0; s < 2; ++s) Qf[qi][s] = *(const bf16x8*)(wsb + (unsigned)(WS_Q + 2u * (unsigned)((b * SEQ + q0 + tq + 16 * qi + l15) * 512 + hq * 64 + 32 * s + 8 * g4)));
        const float sink2 = IN(I_SINK)[hq] * LOG2E;
        float mrun[2], lrun[2]; f32x4 O[2][4];
#pragma unroll
        for (int qi = 0; qi < 2; ++qi) { mrun[qi] = sink2; lrun[qi] = (g4 == 0) ? 1.0f : 0.0f;
#pragma unroll
            for (int db = 0; db < 4; ++db) O[qi][db] = (f32x4){0.f, 0.f, 0.f, 0.f}; }
        const int t_first = (q0 >= 128) ? 0 : (q0 >= 64 ? 1 : 2), t_skip_lo = (q0 + 128 < SEQ) ? 5 : (q0 + 64 < SEQ ? 4 : 3);
        const int key = X.tid >> 3, ch = X.tid & 7;
        auto tile_offs = [&](int t, unsigned& ko, unsigned& vo) {
            if (t < 5) { const unsigned e = (unsigned)((b * SEQ + q0 - 128 + 64 * t) * 128 + kh * 64) * 2u; ko = (unsigned)WS_K + e; vo = (unsigned)WS_V + e; }
            else { const unsigned e = (unsigned)((b * CTXL + (t - 5) * 64) * 128 + kh * 64) * 2u; ko = (unsigned)WS_KC + e; vo = (unsigned)WS_VC + e; } };
        const unsigned lane_off = (unsigned)(key * 128 + ch * 8) * 2u;
        auto lds_put = [&](int buf, const u32x4& kv, const u32x4& vv) {
            LAS unsigned char* Kd = Ks + buf * 32768; LAS unsigned char* Vd = Vt + buf * 32768;
            *(LAS u32x4*)(Kd + key * 144 + ch * 16) = kv;
#pragma unroll
            for (int i = 0; i < 4; ++i) { *(LAS unsigned short*)(Vd + (8 * ch + 2 * i) * 136 + key * 2) = (unsigned short)(vv[i] & 0xffffu); *(LAS unsigned short*)(Vd + (8 * ch + 2 * i + 1) * 136 + key * 2) = (unsigned short)(vv[i] >> 16); } };
        u32x4 kreg, vreg;
        { unsigned ko, vo; tile_offs(t_first, ko, vo); kreg = *(const u32x4*)(wsb + (ko + lane_off)); vreg = *(const u32x4*)(wsb + (vo + lane_off)); }
        __syncthreads();
        lds_put(0, kreg, vreg);
        int bufi = 0;
        for (int t = t_first; t < 9; ++t) {
            if (t >= t_skip_lo && t < 5) continue;
            int tn = t + 1; if (tn >= t_skip_lo && tn < 5) tn = 5;
            if (tn < 9) { unsigned ko, vo; tile_offs(tn, ko, vo); kreg = *(const u32x4*)(wsb + (ko + lane_off)); vreg = *(const u32x4*)(wsb + (vo + lane_off)); }
            const int mode = (t == 0) ? 1 : (t == 4 ? 2 : 0);
            __syncthreads();
            const LAS unsigned char* Kc = Ks + bufi * 32768; const LAS unsigned char* Vc = Vt + bufi * 32768;
            bf16x8 kf[4][2];
#pragma unroll
            for (int kb = 0; kb < 4; ++kb)
#pragma unroll
                for (int s = 0; s < 2; ++s) kf[kb][s] = *(const LAS bf16x8*)(Kc + (16 * kb + l15) * 144 + (32 * s + 8 * g4) * 2);
            bf16x8 vf[4][2];
#pragma unroll
            for (int db = 0; db < 4; ++db)
#pragma unroll
                for (int ks2 = 0; ks2 < 2; ++ks2) { const LAS unsigned char* p = Vc + (16 * db + l15) * 136 + (32 * ks2 + 4 * g4) * 2;
                    const u32x2 lo = *(const LAS u32x2*)p, hi = *(const LAS u32x2*)(p + 32);
                    u32x4 w; w.x = lo.x; w.y = lo.y; w.z = hi.x; w.w = hi.y; vf[db][ks2] = __builtin_bit_cast(bf16x8, w); }
#pragma unroll
            for (int qi = 0; qi < 2; ++qi) {
                f32x4 st[4];
#pragma unroll
                for (int kb = 0; kb < 4; ++kb) { st[kb] = (f32x4){0.f, 0.f, 0.f, 0.f};
#pragma unroll
                    for (int s = 0; s < 2; ++s) st[kb] = __builtin_amdgcn_mfma_f32_16x16x32_bf16(kf[kb][s], Qf[qi][s], st[kb], 0, 0, 0); }
                if (mode) { int qloc = tq + 16 * qi + l15; asm volatile("" : "+v"(qloc));
#pragma unroll
                    for (int kb = 0; kb < 4; ++kb)
#pragma unroll
                        for (int r = 0; r < 4; ++r) { const int kk = 16 * kb + 4 * g4 + r; const bool keep = (mode == 1) ? (kk >= qloc) : (kk <= qloc); if (!keep) st[kb][r] = -1e30f; } }
                float mx = st[0][0];
#pragma unroll
                for (int kb = 0; kb < 4; ++kb)
#pragma unroll
                    for (int r = 0; r < 4; ++r) mx = fmaxf(mx, st[kb][r]);
                mx = fmaxf(mx, __shfl_xor(mx, 16)); mx = fmaxf(mx, __shfl_xor(mx, 32));
                const float mnew = fmaxf(mrun[qi], mx); const float alpha = __builtin_amdgcn_exp2f(mrun[qi] - mnew); mrun[qi] = mnew;
                float ps = 0.f;
#pragma unroll
                for (int kb = 0; kb < 4; ++kb)
#pragma unroll
                    for (int r = 0; r < 4; ++r) { st[kb][r] = __builtin_amdgcn_exp2f(st[kb][r] - mnew); ps += st[kb][r]; }
                lrun[qi] = lrun[qi] * alpha + ps;
#pragma unroll
                for (int db = 0; db < 4; ++db) O[qi][db] = O[qi][db] * alpha;
#pragma unroll
                for (int ks2 = 0; ks2 < 2; ++ks2) { u32x4 w; w.x = pk2(st[2 * ks2][0], st[2 * ks2][1]); w.y = pk2(st[2 * ks2][2], st[2 * ks2][3]); w.z = pk2(st[2 * ks2 + 1][0], st[2 * ks2 + 1][1]); w.w = pk2(st[2 * ks2 + 1][2], st[2 * ks2 + 1][3]);
                    const bf16x8 pf = __builtin_bit_cast(bf16x8, w);
#pragma unroll
                    for (int db = 0; db < 4; ++db) O[qi][db] = __builtin_amdgcn_mfma_f32_16x16x32_bf16(vf[db][ks2], pf, O[qi][db], 0, 0, 0); }
            }
            if (tn < 9) lds_put(bufi ^ 1, kreg, vreg);
            bufi ^= 1;
        }
#pragma unroll
        for (int qi = 0; qi < 2; ++qi) { float l = lrun[qi]; l += __shfl_xor(l, 16); l += __shfl_xor(l, 32); const float inv = 1.0f / l;
            bf16* orow = (bf16*)(wsb + (unsigned)(WS_MIX + 2u * (unsigned)((b * SEQ + q0 + tq + 16 * qi + l15) * D + 512 + hq * 64 + 4 * g4)));
#pragma unroll
            for (int db = 0; db < 4; ++db) { u32x2 o; o.x = pk2(O[qi][db][0] * inv, O[qi][db][1] * inv); o.y = pk2(O[qi][db][2] * inv, O[qi][db][3] * inv); *(u32x2*)(orow + 16 * db) = o; } }
    }
}

__device__ __forceinline__ void phase_router(const Args& a, const Ctx& X, int layer) {
    const bf16* __restrict__ H = (const bf16*)(X.ws + WS_H); unsigned char* XA8 = (unsigned char*)(X.ws + WS_XA8);
    const float* MODl = (const float*)(X.ws + WS_MOD) + (size_t)layer * 9 * MODW; const float* gn = IN(I_NFG) + layer * D;
    const float* rw = IN(I_RW) + (size_t)layer * D * NE; const float* rb = IN(I_RB) + layer * NE;
    int* cntg = (int*)(X.ws + WS_CTL) + CW_CNT + layer * NE * CNT_STRIDE; int* list = (int*)(X.ws + WS_LIST); float* gatew = (float*)(X.ws + WS_GATE);
    constexpr int YS = 1028;
    LAS float* ybuf = (LAS float*)X.lds;
    LAS float* part = (LAS float*)(X.lds + 66048);
    LAS int* sel = (LAS int*)(X.lds + 66048 + 16384);
    LAS int* lcnt = (LAS int*)(X.lds + 66048 + 16384 + 1024);
    LAS float* lgs = (LAS float*)(X.lds + 66048 + 16384 + 2048);
    LAS float* tvs = lgs + 512;
    LAS float* exs = lgs + 528;
    PMARK(0);
    const int e = X.lane & 31, hf = X.lane >> 5;
    const int e16 = X.lane & 15, kq = X.lane >> 4;
    float wreg[32][2];
#pragma unroll
    for (int s = 0; s < 32; ++s)
#pragma unroll
        for (int nb = 0; nb < 2; ++nb) wreg[s][nb] = rw[(size_t)(128 * X.wave + 4 * s + kq) * NE + 16 * nb + e16];
    const float rbe = rb[e];
    for (int blk = X.bid; blk < NTOK / 64; blk += X.G) {
        const int rowbase = blk * 64; const float* m = MODl + (size_t)(rowbase / SEQ) * MODW;
        f32x4 gk[4], hk[4], xv[2][4];
#pragma unroll
        for (int j = 0; j < 4; ++j) { gk[j] = ((const f32x4*)gn)[X.lane + 64 * j]; hk[j] = ((const f32x4*)(m + 3 * 1024))[X.lane + 64 * j]; const f32x4 s_ = ((const f32x4*)(m + 4 * 1024))[X.lane + 64 * j]; gk[j] = gk[j] * (1.0f + s_); }
#pragma unroll
        for (int i = 0; i < 2; ++i)
#pragma unroll
            for (int j = 0; j < 4; ++j) { const u32x2 w = ((const u32x2*)(H + (size_t)(rowbase + 2 * X.wave + i) * D))[X.lane + 64 * j]; xv[i][j] = (f32x4){bf2f(w.x & 0xffffu), bf2f(w.x >> 16), bf2f(w.y & 0xffffu), bf2f(w.y >> 16)}; }
        __syncthreads();
        if (X.tid < 64) lcnt[X.tid] = 0;
        PMARK(1);
#pragma unroll 1
        for (int bt = 0; bt < 4; ++bt) {
#pragma unroll
            for (int i = 0; i < 2; ++i) { const int rl = 2 * X.wave + i, row = rowbase + 16 * bt + rl; float ss = 0.f;
#pragma unroll
                for (int j = 0; j < 4; ++j) ss += (xv[i][j][0] * xv[i][j][0] + xv[i][j][1] * xv[i][j][1]) + (xv[i][j][2] * xv[i][j][2] + xv[i][j][3] * xv[i][j][3]);
                const float rstd = rsqrtf(wave_sum(ss) * (1.0f / D) + EPS);
#pragma unroll
                for (int j = 0; j < 4; ++j) { const f32x4 y = xv[i][j] * rstd * gk[j] + hk[j];
                    *((unsigned*)(XA8 + (size_t)row * D) + X.lane + 64 * j) = pk4_fp8(y[0] * FP8_AMUL, y[1] * FP8_AMUL, y[2] * FP8_AMUL, y[3] * FP8_AMUL);
                    *(LAS f32x4*)(ybuf + rl * YS + 4 * X.lane + 256 * j) = y; } }
            if (bt < 3) {
#pragma unroll
                for (int i = 0; i < 2; ++i)
#pragma unroll
                    for (int j = 0; j < 4; ++j) { const u32x2 w = ((const u32x2*)(H + (size_t)(rowbase + 16 * (bt + 1) + 2 * X.wave + i) * D))[X.lane + 64 * j]; xv[i][j] = (f32x4){bf2f(w.x & 0xffffu), bf2f(w.x >> 16), bf2f(w.y & 0xffffu), bf2f(w.y >> 16)}; }
            }
            __syncthreads();
            { f32x4 acc0 = (f32x4){0.f, 0.f, 0.f, 0.f}, acc1 = acc0; const LAS float* yp = ybuf + e16 * YS + 128 * X.wave + kq;
#pragma unroll
              for (int s = 0; s < 32; ++s) { const float av = yp[4 * s];
                  acc0 = __builtin_amdgcn_mfma_f32_16x16x4f32(av, wreg[s][0], acc0, 0, 0, 0); acc1 = __builtin_amdgcn_mfma_f32_16x16x4f32(av, wreg[s][1], acc1, 0, 0, 0); }
#pragma unroll
              for (int r = 0; r < 4; ++r) { part[((4 * kq + r) * 8 + X.wave) * 32 + e16] = acc0[r]; part[((4 * kq + r) * 8 + X.wave) * 32 + 16 + e16] = acc1[r]; } }
            __syncthreads();
            { const int r = 2 * X.wave + hf, rl = 16 * bt + r;
              float v = rbe;
#pragma unroll
              for (int w8 = 0; w8 < 8; ++w8) v += part[(r * 8 + w8) * 32 + e];
              lgs[r * 32 + e] = v; LDS_WAIT();
              int ez = e; asm volatile("" : "+v"(ez));
              int rank = 0;
#pragma unroll
              for (int j4 = 0; j4 < 8; ++j4) { const f32x4 o = *(const LAS f32x4*)(lgs + r * 32 + 4 * j4);
#pragma unroll
                  for (int c = 0; c < 4; ++c) rank += (o[c] > v || (o[c] == v && (4 * j4 + c) < ez)) ? 1 : 0; }
              if (rank == 0) tvs[r] = v;
              LDS_WAIT();
              const float ex = __expf(v - tvs[r]);
              if (rank < 4) exs[r * 4 + rank] = ex;
              LDS_WAIT();
              const f32x4 e4 = *(const LAS f32x4*)(exs + r * 4); const float inv = 1.0f / ((e4[0] + e4[1]) + (e4[2] + e4[3]));
              if (rank < 4) { const int slot = atomicAdd((int*)&lcnt[e], 1); sel[rl * 4 + rank] = (e << 16) | slot; gatew[(size_t)(rowbase + rl) * 4 + rank] = ex * inv; } }
        }
        __syncthreads();
        PMARK(2);
        if (X.tid < 32) lcnt[32 + X.tid] = atomicAdd(cntg + X.tid * CNT_STRIDE, lcnt[X.tid]);
        __syncthreads();
        if (X.tid < 256) { const int w = sel[X.tid]; const int ee = w >> 16, rank = w & 0xffff; list[(size_t)ee * NTOK + lcnt[32 + ee] + rank] = rowbase * 4 + X.tid; }
    }
    PMARK(3);
}

__device__ __forceinline__ void phase_combine(const Args& a, const Ctx& X, int layer) {
    bf16* H = (bf16*)(X.ws + WS_H); const bf16* __restrict__ Y = (const bf16*)(X.ws + WS_Y); bf16* XA = (bf16*)(X.ws + WS_XA);
    const float* __restrict__ MODl = (const float*)(X.ws + WS_MOD) + (size_t)layer * 9 * MODW;
    float* outp = (float*)(__attribute__((address_space(1))) float*)X.kp[33];
    for (int row = X.gw; row < NTOK; row += X.NGW) {
        const float* gt = MODl + (size_t)(row / SEQ) * MODW + 5 * 1024; f32x4 h[2][2], g[2][2]; u32x4 yw[2][4];
#pragma unroll
        for (int j = 0; j < 2; ++j) { const int c0 = 8 * X.lane + 512 * j;
#pragma unroll
            for (int q = 0; q < 2; ++q) g[j][q] = *(const f32x4*)(gt + c0 + 4 * q);
            { const u32x4 w = *(const u32x4*)(H + (size_t)row * D + c0); h[j][0] = (f32x4){bf2f(w.x & 0xffffu), bf2f(w.x >> 16), bf2f(w.y & 0xffffu), bf2f(w.y >> 16)}; h[j][1] = (f32x4){bf2f(w.z & 0xffffu), bf2f(w.z >> 16), bf2f(w.w & 0xffffu), bf2f(w.w >> 16)}; }
#pragma unroll
            for (int k = 0; k < 4; ++k) yw[j][k] = *(const u32x4*)(Y + ((size_t)row * 4 + k) * D + c0); }
        float ss = 0.f;
#pragma unroll
        for (int j = 0; j < 2; ++j) { f32x4 s0 = (f32x4){0.f, 0.f, 0.f, 0.f}, s1 = s0;
#pragma unroll
            for (int k = 0; k < 4; ++k) { const u32x4 w = yw[j][k]; s0 += (f32x4){bf2f(w.x & 0xffffu), bf2f(w.x >> 16), bf2f(w.y & 0xffffu), bf2f(w.y >> 16)}; s1 += (f32x4){bf2f(w.z & 0xffffu), bf2f(w.z >> 16), bf2f(w.w & 0xffffu), bf2f(w.w >> 16)}; }
            h[j][0] = h[j][0] + g[j][0] * s0; h[j][1] = h[j][1] + g[j][1] * s1;
#pragma unroll
            for (int q = 0; q < 2; ++q) ss += (h[j][q][0] * h[j][q][0] + h[j][q][1] * h[j][q][1]) + (h[j][q][2] * h[j][q][2] + h[j][q][3] * h[j][q][3]); }
        if (layer == 1) {
#pragma unroll
            for (int j = 0; j < 2; ++j)
#pragma unroll
                for (int q = 0; q < 2; ++q) *(f32x4*)(outp + (size_t)row * D + 8 * X.lane + 512 * j + 4 * q) = h[j][q];
        } else {
            const float* m1 = (const float*)(X.ws + WS_MOD) + (size_t)9 * MODW + (size_t)(row / SEQ) * MODW; const float* gn = IN(I_NMG) + D;
            f32x4 gk[2][2], hk[2][2], sk[2][2];
#pragma unroll
            for (int j = 0; j < 2; ++j)
#pragma unroll
                for (int q = 0; q < 2; ++q) { const int c0 = 8 * X.lane + 512 * j + 4 * q; gk[j][q] = *(const f32x4*)(gn + c0); hk[j][q] = *(const f32x4*)(m1 + c0); sk[j][q] = *(const f32x4*)(m1 + 1024 + c0); }
            const float rstd = rsqrtf(wave_sum(ss) * (1.0f / D) + EPS);
#pragma unroll
            for (int j = 0; j < 2; ++j) { const int c0 = 8 * X.lane + 512 * j;
                const f32x4 y0 = h[j][0] * rstd * gk[j][0] * (1.0f + sk[j][0]) + hk[j][0], y1 = h[j][1] * rstd * gk[j][1] * (1.0f + sk[j][1]) + hk[j][1];
                *(u32x4*)(H + (size_t)row * D + c0) = pack8(h[j][0], h[j][1]);
                *(u32x4*)(XA + (size_t)row * D + c0) = pack8(y0, y1); }
        }
    }
}

__device__ __forceinline__ void phase_spatial(const Args& a, const Ctx& X) {
    const bf16* U = (const bf16*)(X.ws + WS_U); const bf16* VB = (const bf16*)(X.ws + WS_VB); bf16* SG = (bf16*)(X.ws + WS_MIX); const bf16* WsB = (const bf16*)(X.ws + WS_WSB); const float* vstat = (const float*)(X.ws + WS_CTL) + CW_VSTAT;
    LAS unsigned char* Vt = X.lds + 4096;
    const int lane = X.lane, l15 = lane & 15, g4 = lane >> 4;
    const int q0 = X.tid >> 4, cc = X.tid & 15;
    int item = X.bid; const int nitems = 128 * 8;
    const bool same_g = (X.G & 7) == 0;
    bf16x8 bfr[4][8]; int gcur = -1;
    u32x4 vraw[4]; f32x2 st[4];
    auto fetch = [&](int it) { const int chunk = it >> 3, g = it & 7; const int row0 = chunk * 128;
#pragma unroll
        for (int i = 0; i < 4; ++i) { const int q = q0 + 32 * i; vraw[i] = *(const u32x4*)(VB + (size_t)(row0 + q) * D + g * 128 + cc * 8); st[i] = *(const f32x2*)(vstat + 2 * (row0 + q)); } };
    if (item < nitems) fetch(item);
    for (; item < nitems; item += X.G) {
        const int chunk = item >> 3, g = item & 7; const int row0 = chunk * 128;
        if (g != gcur) { gcur = g;
#pragma unroll
            for (int s = 0; s < 4; ++s)
#pragma unroll
                for (int pb = 0; pb < 8; ++pb) bfr[s][pb] = *(const bf16x8*)(WsB + ((size_t)g * 128 + 16 * pb + l15) * 128 + 32 * s + 8 * g4); }
        const float* lg_ = IN(I_OLNG) + g * 128 + cc * 8; const float* lb_ = IN(I_OLNB) + g * 128 + cc * 8;
        __syncthreads();
        float mean[4], rstd[4];
#pragma unroll
        for (int i = 0; i < 4; ++i) { mean[i] = st[i].x * (1.0f / D); const float var = fmaxf(st[i].y * (1.0f / D) - mean[i] * mean[i], 0.f); rstd[i] = rsqrtf(var + EPS); }
#pragma unroll
        for (int kh = 0; kh < 2; ++kh) { const f32x4 lgv = *(const f32x4*)(lg_ + 4 * kh), lbv = *(const f32x4*)(lb_ + 4 * kh);
#pragma unroll
            for (int i = 0; i < 4; ++i) { const int q = q0 + 32 * i;
#pragma unroll
                for (int k2 = 0; k2 < 2; ++k2) { const int k = 2 * kh + k2; const unsigned wv = vraw[i][k];
                    const float y0 = (bf2f(wv & 0xffffu) - mean[i]) * rstd[i] * lgv[2 * k2] + lbv[2 * k2], y1 = (bf2f(wv >> 16) - mean[i]) * rstd[i] * lgv[2 * k2 + 1] + lbv[2 * k2 + 1];
                    const unsigned pk = pk2(y0, y1);
                    *(LAS unsigned short*)(Vt + ((2 * k) * 17 + cc) * 272 + q * 2) = (unsigned short)(pk & 0xffffu); *(LAS unsigned short*)(Vt + ((2 * k + 1) * 17 + cc) * 272 + q * 2) = (unsigned short)(pk >> 16); } } }
        if (item + X.G < nitems) fetch(item + X.G);
        __syncthreads();
#pragma unroll
        for (int hp = 0; hp < 2; ++hp) {
            u32x2 uw[4];
#pragma unroll
            for (int pq = 0; pq < 4; ++pq) uw[pq] = *(const u32x2*)(U + (size_t)(row0 + 16 * (4 * hp + pq) + l15) * D + g * 128 + 16 * X.wave + 4 * g4);
            f32x4 acc[4];
#pragma unroll
            for (int pq = 0; pq < 4; ++pq) acc[pq] = (f32x4){0.f, 0.f, 0.f, 0.f};
#pragma unroll
            for (int s = 0; s < 4; ++s) { const bf16x8 af = *(const LAS bf16x8*)(Vt + ((l15 & 7) * 17 + 2 * X.wave + (l15 >> 3)) * 272 + (32 * s + 8 * g4) * 2);
#pragma unroll
                for (int pq = 0; pq < 4; ++pq) acc[pq] = __builtin_amdgcn_mfma_f32_16x16x32_bf16(af, bfr[s][4 * hp + pq], acc[pq], 0, 0, 0); }
#pragma unroll
            for (int pq = 0; pq < 4; ++pq) { const int p = 16 * (4 * hp + pq) + l15; const float bs = IN(I_OBS)[g * 128 + p]; const size_t off = (size_t)(row0 + p) * D + g * 128 + 16 * X.wave + 4 * g4;
                u32x2 o; o.x = pk2(bf2f(uw[pq].x & 0xffffu) * (acc[pq][0] + bs), bf2f(uw[pq].x >> 16) * (acc[pq][1] + bs)); o.y = pk2(bf2f(uw[pq].y & 0xffffu) * (acc[pq][2] + bs), bf2f(uw[pq].y >> 16) * (acc[pq][3] + bs));
                *(u32x2*)(SG + off) = o; }
        }
    }
    (void)same_g;
}

enum { PH_PRO = 0, PH_MOD0, PH_GIN, PH_CONV, PH_ATT, PH_GOUT, PH_RT0, PH_M1_0, PH_M2_0, PH_CMB0, PH_GMI, PH_SPA, PH_GMO, PH_RT1, PH_M1_1, PH_M2_1, PH_CMB1, NPHASE };

__global__ void __launch_bounds__(NTHREADS, 2) mega(Args a) {
    extern __shared__ __attribute__((aligned(16))) unsigned char lds_raw[];
    Ctx X; X.lds = (LAS unsigned char*)lds_raw;
    const int wave0 = __builtin_amdgcn_readfirstlane((int)threadIdx.x >> 6);
    const int G0 = gridDim.x, bid0 = blockIdx.x; const int vcu0 = (G0 % 8 == 0) ? (bid0 % 8) * (G0 / 8) + bid0 / 8 : bid0;
    X.wave = wave0;
    volatile LAS unsigned* MISC = (volatile LAS unsigned*)(X.lds + MISC_OFF);
    if (threadIdx.x < 64) MISC[threadIdx.x] = 0u;
    __syncthreads();
    XcdBarrier bar = xcd_barrier_post((unsigned*)(a.ws + WS_CTL) + CW_BAR + a.li * XCD_BAR_WORDS, MISC + 8);
    const int ph_lo = a.ph_lo, ph_hi = a.ph_hi;
#if PROBE_PH >= 0
#define PROBE_STAMP(p) do { if ((p) == PROBE_PH) pr_t0 = __builtin_amdgcn_s_memrealtime(); if ((p) == PROBE_END) pr_t1 = __builtin_amdgcn_s_memrealtime(); } while (0)
#else
#define PROBE_STAMP(p) do { } while (0)
#endif
#define PH_ENTER() int z; asm volatile("s_mov_b32 %0, 0" : "=s"(z)); \
        X.lane = (int)__builtin_amdgcn_mbcnt_hi(~0u, __builtin_amdgcn_mbcnt_lo(~0u, (unsigned)z)); X.tid = wave0 * 64 + X.lane; \
        X.G = G0 + z; X.vcu = vcu0 + z; X.bid = bid0 + z; X.NGW = X.G * NWAVES; X.gw = X.vcu * NWAVES + wave0; \
        { kargp_t kp = (kargp_t)__builtin_amdgcn_kernarg_segment_ptr(); asm volatile("" : "+s"(kp)); X.kp = kp; } \
        unsigned char* ws = (unsigned char*)(__attribute__((address_space(1))) unsigned char*)X.kp[34] + z; X.ws = ws;
#if PROBE_PH >= 0
    unsigned long long pr_t0 = 0, pr_t1 = 0;
#endif
#define PH_RUN(PHK, ...) if (ph_lo <= (PHK) && (PHK) < ph_hi) { const int ph = (PHK); \
        if (ph != ph_lo) { const int l0 = (int)__builtin_amdgcn_mbcnt_hi(~0u, __builtin_amdgcn_mbcnt_lo(~0u, 0u)); xcd_barrier(bar, wave0 * 64 + l0); if (EXP_BAR2 && (ph & 3) == 1) xcd_barrier(bar, wave0 * 64 + l0); } \
        PROBE_STAMP(ph); __VA_ARGS__ }
    PH_RUN(PH_PRO, { PH_ENTER(); phase_prologue(a, X); })
    PH_RUN(PH_MOD0, { PH_ENTER(); phase_modulate0(a, X); })
    PH_RUN(PH_GIN, { PH_ENTER(); DenseSched S; S.init((const bf16*)(ws + WS_XA), (const bf16*)(ws + WS_WINT), NTOK, EVEN_IN, X.G, X.bid);
            S.A2 = (const bf16*)(ws + WS_GM); S.Bt2 = (const bf16*)(ws + WS_WINT) + (size_t)KV_COL * D; S.nM2 = NCTX / 256;
            EpiIn E{(bf16*)(ws + WS_GLU), (bf16*)(ws + WS_Q), (bf16*)(ws + WS_K), (bf16*)(ws + WS_V), (bf16*)(ws + WS_KC), (bf16*)(ws + WS_VC), IN(I_EBIN)};
            pg8::gemm_phase<EpiIn, DenseSched>(X.lds, S, E, X.tid); })
    PH_RUN(PH_CONV, { PH_ENTER(); phase_conv_qk(a, X); })
    PH_RUN(PH_ATT, { PH_ENTER(); phase_attention(a, X); })
    PH_RUN(PH_GOUT, { PH_ENTER(); DenseSched S; S.init((const bf16*)(ws + WS_MIX), (const bf16*)(ws + WS_WOUTT), NTOK, D, X.G, X.bid);
            EpiRes<true> E{IN(I_X), (bf16*)(ws + WS_H), IN(I_EBOUT), (const float*)(ws + WS_MOD) + 2 * 1024};
            pg8::gemm_phase<EpiRes<true>, DenseSched>(X.lds, S, E, X.tid); })
    PH_RUN(PH_RT0, { PH_ENTER(); phase_router(a, X, 0); })
    PH_RUN(PH_M1_0, { PH_ENTER(); const int l = (ph == PH_M1_1); moe_build_table(X, (const int*)(ws + WS_CTL) + CW_CNT + l * NE * CNT_STRIDE);
            MoeSchedT<true, 8> S; S.tab = (const LAS int*)(X.lds + TAB_OFF); S.G = X.G; S.c = X.vcu; S.A = (const unsigned char*)(ws + WS_XA8); S.Bt = (const unsigned char*)(ws + WS_W1T) + (size_t)l * NE * 2048 * 1024; S.list = (const int*)(ws + WS_LIST); S.meta = (const LAS int*)(X.lds + META_OFF);
            moe_stage_meta<false>(X, S, S.list, (const float*)nullptr, (LAS int*)(X.lds + META_OFF), IN(I_B1) + (size_t)l * NE * 2048, (LAS float*)(X.lds + BIAS_OFF));
            EpiSwiglu E{(unsigned char*)(ws + WS_ACT), (const LAS float*)(X.lds + BIAS_OFF)};
            pg8::gemm_phase<EpiSwiglu, MoeSchedT<true, 8>>(X.lds, S, E, X.tid); })
    PH_RUN(PH_M2_0, { PH_ENTER(); const int l = (ph == PH_M2_1); moe_build_table(X, (const int*)(ws + WS_CTL) + CW_CNT + l * NE * CNT_STRIDE);
            MoeSchedT<false, 4> S; S.tab = (const LAS int*)(X.lds + TAB_OFF); S.G = X.G; S.c = X.vcu; S.A = (const unsigned char*)(ws + WS_ACT); S.Bt = (const unsigned char*)(ws + WS_W2T) + (size_t)l * NE * 1024 * 1024; S.list = (const int*)(ws + WS_LIST); S.meta = (const LAS int*)(X.lds + META_OFF);
            moe_stage_meta<true>(X, S, S.list, (const float*)(ws + WS_GATE), (LAS int*)(X.lds + META_OFF), IN(I_B2) + (size_t)l * NE * D, (LAS float*)(X.lds + BIAS_OFF));
            EpiDown E{(bf16*)(ws + WS_Y), (const LAS float*)(X.lds + BIAS_OFF), (const LAS int*)(X.lds + META_OFF)};
            pg8::gemm_phase<EpiDown, MoeSchedT<false, 4>>(X.lds, S, E, X.tid); })
    PH_RUN(PH_CMB0, { PH_ENTER(); phase_combine(a, X, 0); })
    PH_RUN(PH_GMI, { PH_ENTER(); DenseSched S; S.init((const bf16*)(ws + WS_XA), (const bf16*)(ws + WS_GWINT), NTOK, 2048, X.G, X.bid);
            EpiGelu E{(bf16*)(ws + WS_U), (bf16*)(ws + WS_VB), IN(I_OBIN), (float*)(ws + WS_CTL) + CW_VSTAT};
            pg8::gemm_phase<EpiGelu, DenseSched>(X.lds, S, E, X.tid); })
    PH_RUN(PH_SPA, { PH_ENTER(); phase_spatial(a, X); })
    PH_RUN(PH_GMO, { PH_ENTER(); DenseSched S; S.init((const bf16*)(ws + WS_MIX), (const bf16*)(ws + WS_GWOUTT), NTOK, D, X.G, X.bid);
            EpiRes<false> E{(const bf16*)(ws + WS_H), (bf16*)(ws + WS_H), IN(I_OBOUT), (const float*)(ws + WS_MOD) + (size_t)9 * MODW + 2 * 1024};
            pg8::gemm_phase<EpiRes<false>, DenseSched>(X.lds, S, E, X.tid); })
    PH_RUN(PH_RT1, { PH_ENTER(); phase_router(a, X, 1); })
    PH_RUN(PH_M1_1, { PH_ENTER(); PMARK(50); const int l = (ph == PH_M1_1); moe_build_table(X, (const int*)(ws + WS_CTL) + CW_CNT + l * NE * CNT_STRIDE);
            MoeSchedT<true, 8> S; S.tab = (const LAS int*)(X.lds + TAB_OFF); S.G = X.G; S.c = X.vcu; S.A = (const unsigned char*)(ws + WS_XA8); S.Bt = (const unsigned char*)(ws + WS_W1T) + (size_t)l * NE * 2048 * 1024; S.list = (const int*)(ws + WS_LIST); S.meta = (const LAS int*)(X.lds + META_OFF);
            moe_stage_meta<false>(X, S, S.list, (const float*)nullptr, (LAS int*)(X.lds + META_OFF), IN(I_B1) + (size_t)l * NE * 2048, (LAS float*)(X.lds + BIAS_OFF));
            PMARK(51); EpiSwiglu E{(unsigned char*)(ws + WS_ACT), (const LAS float*)(X.lds + BIAS_OFF)};
            pg8::gemm_phase<EpiSwiglu, MoeSchedT<true, 8>>(X.lds, S, E, X.tid); PMARK(53); })
    PH_RUN(PH_M2_1, { PH_ENTER(); PMARK(54); const int l = (ph == PH_M2_1); moe_build_table(X, (const int*)(ws + WS_CTL) + CW_CNT + l * NE * CNT_STRIDE);
            MoeSchedT<false, 4> S; S.tab = (const LAS int*)(X.lds + TAB_OFF); S.G = X.G; S.c = X.vcu; S.A = (const unsigned char*)(ws + WS_ACT); S.Bt = (const unsigned char*)(ws + WS_W2T) + (size_t)l * NE * 1024 * 1024; S.list = (const int*)(ws + WS_LIST); S.meta = (const LAS int*)(X.lds + META_OFF);
            moe_stage_meta<true>(X, S, S.list, (const float*)(ws + WS_GATE), (LAS int*)(X.lds + META_OFF), IN(I_B2) + (size_t)l * NE * D, (LAS float*)(X.lds + BIAS_OFF));
            EpiDown E{(bf16*)(ws + WS_Y), (const LAS float*)(X.lds + BIAS_OFF), (const LAS int*)(X.lds + META_OFF)};
            pg8::gemm_phase<EpiDown, MoeSchedT<false, 4>>(X.lds, S, E, X.tid); })
    PH_RUN(PH_CMB1, { PH_ENTER(); phase_combine(a, X, 1); })
#if PROBE_PH == -2
    if (blockIdx.x == 0 && threadIdx.x == 0) { volatile LAS unsigned long long* pm_ = (volatile LAS unsigned long long*)(X.lds + MISC_OFF + 128); const unsigned long long te = __builtin_amdgcn_s_memrealtime(); const unsigned long long span = (pm_[1] - pm_[0]) * PROBE_MULT;
        while (__builtin_amdgcn_s_memrealtime() - te < span) __builtin_amdgcn_s_sleep(8); }
#endif
#if PROBE_PH >= 0
    if (pr_t1 == 0) pr_t1 = __builtin_amdgcn_s_memrealtime();
    if (blockIdx.x == 0 && wave0 == 0) { const unsigned long long te = __builtin_amdgcn_s_memrealtime(); const unsigned long long span = (pr_t1 - pr_t0) * PROBE_MULT;
        while (__builtin_amdgcn_s_memrealtime() - te < span) __builtin_amdgcn_s_sleep(8); }
#endif
}

__device__ __forceinline__ bool find_expert(const int* cnt, int s, int& e, int& slot) {
    int pb = 0;
    for (int i = 0; i < NE; ++i) { const int c = cnt[i * CNT_STRIDE]; const int pr = ((c + 255) >> 8) << 8; if (s < pb + pr) { e = i; slot = s - pb; return true; } pb += pr; }
    return false;
}
__global__ void __launch_bounds__(256) slow_gemm(const bf16* A, const int* arow, const bf16* Bt, float* C, int N, const int* cnt, size_t bstride) {
    __shared__ float As[16][65], Bs[16][65];
    const int tx = threadIdx.x & 15, ty = threadIdx.x >> 4; const int m0 = blockIdx.y * 64, n0 = blockIdx.x * 64;
    if (cnt) { int e, slot; if (!find_expert(cnt, m0, e, slot)) return; Bt += (size_t)e * bstride; }
    float acc[4][4];
    for (int i = 0; i < 4; ++i) for (int j = 0; j < 4; ++j) acc[i][j] = 0.f;
    for (int k0 = 0; k0 < 1024; k0 += 16) {
        for (int i = 0; i < 4; ++i) { const int idx = threadIdx.x + 256 * i; const int r = idx >> 4, kk = idx & 15; const int gm = m0 + r; const int ar = arow ? arow[gm] : gm;
            As[kk][r] = bf2f(A[(size_t)ar * 1024 + k0 + kk]); Bs[kk][r] = bf2f(Bt[(size_t)(n0 + r) * 1024 + k0 + kk]); }
        __syncthreads();
        for (int kk = 0; kk < 16; ++kk) { float av[4], bv[4];
            for (int i = 0; i < 4; ++i) { av[i] = As[kk][ty * 4 + i]; bv[i] = Bs[kk][tx * 4 + i]; }
            for (int i = 0; i < 4; ++i) for (int j = 0; j < 4; ++j) acc[i][j] += av[i] * bv[j]; }
        __syncthreads();
    }
    for (int i = 0; i < 4; ++i) for (int j = 0; j < 4; ++j) C[(size_t)(m0 + ty * 4 + i) * N + n0 + tx * 4 + j] = acc[i][j];
}
__device__ __forceinline__ unsigned short f2bf_s(float f) { return (unsigned short)(pk2(f, 0.f) & 0xffffu); }
__global__ void slow_epi_in(const float* C, const float* C2, const float* bias, bf16* GLU, bf16* Q, bf16* Kb, bf16* Vb, bf16* KC, bf16* VC) {
    const size_t i = (size_t)blockIdx.x * blockDim.x + threadIdx.x;
    if (i < (size_t)NTOK * 512) { const int row = (int)(i >> 9), j = (int)(i & 511); const int t = j >> 7, ii = j & 127; const float* cr = C + (size_t)row * EVEN_IN;
        const float u = cr[t * 256 + ii] + bias[j], g = cr[t * 256 + 128 + ii] + bias[512 + j];
        GLU[i] = f2bf_s(u / (1.0f + expf(-g)));
        Q[i] = f2bf_s(cr[1024 + j] + bias[1024 + j]);
        if (j < 128) { Kb[(size_t)row * 128 + j] = f2bf_s(cr[1536 + j] + bias[1536 + j]); Vb[(size_t)row * 128 + j] = f2bf_s(cr[1664 + j] + bias[1664 + j]); }
        if (row < NCTX && j < 128) { KC[(size_t)row * 128 + j] = f2bf_s(C2[(size_t)row * 256 + j] + bias[1536 + j]); VC[(size_t)row * 128 + j] = f2bf_s(C2[(size_t)row * 256 + 128 + j] + bias[1664 + j]); } }
}
__global__ void slow_epi_res(const float* C, const float* basef, const bf16* baseb, bf16* out, const float* bias, const float* gate) {
    const size_t i = (size_t)blockIdx.x * blockDim.x + threadIdx.x;
    if (i < (size_t)NTOK * D) { const int row = (int)(i >> 10), col = (int)(i & 1023); const float b = basef ? basef[i] : bf2f(baseb[i]); out[i] = f2bf_s(b + gate[(size_t)(row / SEQ) * MODW + col] * (C[i] + bias[col])); }
}
__global__ void slow_epi_gelu(const float* C, const float* bias, bf16* U, bf16* V) {
    const size_t i = (size_t)blockIdx.x * blockDim.x + threadIdx.x;
    if (i < (size_t)NTOK * 2048) { const int row = (int)(i >> 11), col = (int)(i & 2047); const float x = C[i] + bias[col]; const float y = 0.5f * x * (1.0f + erff(x * 0.70710678118654752f));
        if (col < 1024) U[(size_t)row * D + col] = f2bf_s(y); else V[(size_t)row * D + col - 1024] = f2bf_s(y); }
}
__global__ void slow_arow(const int* cnt, const int* list, int* arow) {
    const int s = blockIdx.x * blockDim.x + threadIdx.x; if (s >= ACT_ROWS) return;
    int e, slot; int r = 0; if (find_expert(cnt, s, e, slot) && slot < cnt[e * CNT_STRIDE]) r = list[(size_t)e * NTOK + slot] >> 2;
    arow[s] = r;
}
__global__ void slow_epi_swiglu(const float* C, const int* cnt, const float* b1, bf16* ACT) {
    const size_t i = (size_t)blockIdx.x * blockDim.x + threadIdx.x;
    if (i < (size_t)ACT_ROWS * 1024) { const int s = (int)(i >> 10), j = (int)(i & 1023); int e, slot; if (!find_expert(cnt, s, e, slot)) return;
        const int t = j >> 7, ii = j & 127; const float* cr = C + (size_t)s * 2048;
        float g = cr[t * 256 + ii] + b1[(size_t)e * 2048 + j], up = cr[t * 256 + 128 + ii] + b1[(size_t)e * 2048 + 1024 + j];
        g = fminf(g, 7.0f); up = fminf(fmaxf(up, -7.0f), 7.0f);
        ACT[i] = f2bf_s((up + 1.0f) * g / (1.0f + expf(-1.702f * g))); }
}
__global__ void slow_epi_down(const float* C, const int* cnt, const int* list, const float* gatew, const float* b2, bf16* Y) {
    const size_t i = (size_t)blockIdx.x * blockDim.x + threadIdx.x;
    if (i < (size_t)ACT_ROWS * 1024) { const int s = (int)(i >> 10), col = (int)(i & 1023); int e, slot; if (!find_expert(cnt, s, e, slot) || slot >= cnt[e * CNT_STRIDE]) return;
        const int aid = list[(size_t)e * NTOK + slot]; Y[(size_t)aid * D + col] = f2bf_s((C[i] + b2[(size_t)e * D + col]) * gatew[aid]); }
}
__global__ void __launch_bounds__(64) slow_attention(const bf16* QN, const bf16* KN, const bf16* VV, const bf16* KC, const bf16* VC, const float* sink, bf16* MIX) {
    const int i = blockIdx.x * blockDim.x + threadIdx.x; if (i >= NTOK * 8) return;
    const int row = i >> 3, h = i & 7, kh = h >> 2, b = row / SEQ, t = row % SEQ;
    float q[64], o[64];
    for (int d = 0; d < 64; ++d) { q[d] = bf2f(QN[(size_t)row * 512 + h * 64 + d]); o[d] = 0.f; }
    float m = sink[h] * LOG2E, l = 1.0f;
    const int j0 = t - 128 < 0 ? 0 : t - 128, j1 = t + 128 > SEQ - 1 ? SEQ - 1 : t + 128;
    for (int jj = j0; jj <= j1 + CTXL; ++jj) {
        const bf16* kp; const bf16* vp;
        if (jj <= j1) { kp = KN + (size_t)(b * SEQ + jj) * 128 + kh * 64; vp = VV + (size_t)(b * SEQ + jj) * 128 + kh * 64; }
        else { const int c = jj - j1 - 1; kp = KC + (size_t)(b * CTXL + c) * 128 + kh * 64; vp = VC + (size_t)(b * CTXL + c) * 128 + kh * 64; }
        float s = 0.f; for (int d = 0; d < 64; ++d) s += q[d] * bf2f(kp[d]);
        const float mn = fmaxf(m, s), al = exp2f(m - mn), p = exp2f(s - mn); m = mn; l = l * al + p;
        for (int d = 0; d < 64; ++d) o[d] = o[d] * al + p * bf2f(vp[d]);
    }
    for (int d = 0; d < 64; ++d) MIX[(size_t)row * D + 512 + h * 64 + d] = f2bf_s(o[d] / l);
}
__global__ void slow_vstats(const bf16* VB, float* stat) {
    const int row = blockIdx.x * blockDim.x + threadIdx.x; if (row >= NTOK) return;
    float s = 0.f; for (int c = 0; c < D; ++c) s += bf2f(VB[(size_t)row * D + c]); const float mean = s / D;
    float s2 = 0.f; for (int c = 0; c < D; ++c) { const float d = bf2f(VB[(size_t)row * D + c]) - mean; s2 += d * d; }
    stat[2 * row] = mean; stat[2 * row + 1] = rsqrtf(s2 / D + EPS);
}
__global__ void slow_spatial(const bf16* U, const bf16* VB, const float* stat, const float* ws, const float* bs, const float* lng, const float* lnb, bf16* SG) {
    const size_t i = (size_t)blockIdx.x * blockDim.x + threadIdx.x;
    if (i < (size_t)NTOK * D) { const int row = (int)(i >> 10), ch = (int)(i & 1023); const int g = ch >> 7, p = row & 127, r0 = row - p;
        float s = 0.f;
        for (int q = 0; q < 128; ++q) { const float vn = (bf2f(VB[(size_t)(r0 + q) * D + ch]) - stat[2 * (r0 + q)]) * stat[2 * (r0 + q) + 1] * lng[ch] + lnb[ch]; s += ws[((size_t)g * 128 + p) * 128 + q] * vn; }
        SG[i] = f2bf_s(bf2f(U[i]) * (s + bs[g * 128 + p])); }
}

static void launch_mega(Args& a, int lo, int hi, int& li, int grid, hipStream_t stream) {
    a.ph_lo = lo; a.ph_hi = hi; a.li = li++;
    hipLaunchKernelGGL(mega, dim3(grid), dim3(NTHREADS), LDS_BYTES, stream, a);
}
extern "C" void kernel_launch(void* const* d_in, const int* in_sizes, int n_in, void* d_out, int out_size, void* d_ws, size_t ws_size, hipStream_t stream) {
    static int grid = 0;
    if (grid == 0) {
        if (n_in != 33 || out_size != NTOK * D || ws_size < WS_END) { fprintf(stderr, "kernel_launch: unexpected problem (n_in %d, out %d, ws %zu)\n", n_in, out_size, ws_size); grid = -1; return; }
        int dev = 0, cus = 0, per_cu = 0;
        if (hipGetDevice(&dev) != hipSuccess || hipDeviceGetAttribute(&cus, hipDeviceAttributeMultiprocessorCount, dev) != hipSuccess) { grid = -1; return; }
        if (hipFuncSetAttribute((const void*)mega, hipFuncAttributeMaxDynamicSharedMemorySize, LDS_BYTES) != hipSuccess) { fprintf(stderr, "kernel_launch: hipFuncSetAttribute failed\n"); grid = -1; return; }
        if (hipOccupancyMaxActiveBlocksPerMultiprocessor(&per_cu, (const void*)mega, NTHREADS, LDS_BYTES) != hipSuccess || per_cu < 1) { fprintf(stderr, "kernel_launch: occupancy query says %d blocks per CU\n", per_cu); per_cu = 1; }
        (void)hipGetLastError();
        grid = cus;
    }
    if (grid < 0) return;
    unsigned char* ws = (unsigned char*)d_ws;
    (void)hipMemsetAsync(ws + WS_CTL, 0, CTL_ZERO_BYTES, stream);
    Args a{};
    for (int i = 0; i < 33; ++i) a.in[i] = (const float*)d_in[i];
    a.out = (float*)d_out; a.ws = ws;
    int li = 0;
    const float* in_[33]; for (int i = 0; i < 33; ++i) in_[i] = (const float*)d_in[i];
    float* CF = (float*)(ws + WS_CF); float* MOD = (float*)(ws + WS_MOD); int* CNT = (int*)(ws + WS_CTL) + CW_CNT;
    int lo = 0;
    auto flush = [&](int upto) { if (upto > lo) launch_mega(a, lo, upto, li, grid, stream); };
    for (int ph = 0; ph < NPHASE; ++ph) {
        bool slow = false;
        switch (ph) {
        case PH_GIN: slow = SLOW_MASK & 1; break;
        case PH_ATT: slow = SLOW_MASK & 2; break;
        case PH_GOUT: case PH_GMO: slow = SLOW_MASK & 4; break;
        case PH_M1_0: case PH_M1_1: slow = SLOW_MASK & 8; break;
        case PH_M2_0: case PH_M2_1: slow = SLOW_MASK & 16; break;
        case PH_GMI: slow = SLOW_MASK & 32; break;
        case PH_SPA: slow = SLOW_MASK & 64; break;
        default: break;
        }
        if (!slow) continue;
        flush(ph); lo = ph + 1;
        const int l = (ph == PH_M1_1 || ph == PH_M2_1) ? 1 : 0;
        switch (ph) {
        case PH_GIN:
            hipLaunchKernelGGL(slow_gemm, dim3(EVEN_IN / 64, NTOK / 64), dim3(256), 0, stream, (const bf16*)(ws + WS_XA), (const int*)nullptr, (const bf16*)(ws + WS_WINT), CF, EVEN_IN, (const int*)nullptr, (size_t)0);
            hipLaunchKernelGGL(slow_gemm, dim3(256 / 64, NCTX / 64), dim3(256), 0, stream, (const bf16*)(ws + WS_GM), (const int*)nullptr, (const bf16*)(ws + WS_WINT) + (size_t)KV_COL * D, CF + (size_t)NTOK * EVEN_IN, 256, (const int*)nullptr, (size_t)0);
            hipLaunchKernelGGL(slow_epi_in, dim3(NTOK * 512 / 256), dim3(256), 0, stream, (const float*)CF, (const float*)(CF + (size_t)NTOK * EVEN_IN), in_[I_EBIN], (bf16*)(ws + WS_GLU), (bf16*)(ws + WS_Q), (bf16*)(ws + WS_K), (bf16*)(ws + WS_V), (bf16*)(ws + WS_KC), (bf16*)(ws + WS_VC));
            break;
        case PH_ATT:
            hipLaunchKernelGGL(slow_attention, dim3(NTOK * 8 / 64), dim3(64), 0, stream, (const bf16*)(ws + WS_Q), (const bf16*)(ws + WS_K), (const bf16*)(ws + WS_V), (const bf16*)(ws + WS_KC), (const bf16*)(ws + WS_VC), in_[I_SINK], (bf16*)(ws + WS_MIX));
            break;
        case PH_GOUT:
            hipLaunchKernelGGL(slow_gemm, dim3(D / 64, NTOK / 64), dim3(256), 0, stream, (const bf16*)(ws + WS_MIX), (const int*)nullptr, (const bf16*)(ws + WS_WOUTT), CF, D, (const int*)nullptr, (size_t)0);
            hipLaunchKernelGGL(slow_epi_res, dim3(NTOK * D / 256), dim3(256), 0, stream, (const float*)CF, in_[I_X], (const bf16*)nullptr, (bf16*)(ws + WS_H), in_[I_EBOUT], (const float*)(MOD + 2 * 1024));
            break;
        case PH_GMO:
            hipLaunchKernelGGL(slow_gemm, dim3(D / 64, NTOK / 64), dim3(256), 0, stream, (const bf16*)(ws + WS_MIX), (const int*)nullptr, (const bf16*)(ws + WS_GWOUTT), CF, D, (const int*)nullptr, (size_t)0);
            hipLaunchKernelGGL(slow_epi_res, dim3(NTOK * D / 256), dim3(256), 0, stream, (const float*)CF, (const float*)nullptr, (const bf16*)(ws + WS_H), (bf16*)(ws + WS_H), in_[I_OBOUT], (const float*)(MOD + (size_t)9 * MODW + 2 * 1024));
            break;
        case PH_M1_0: case PH_M1_1:
            hipLaunchKernelGGL(slow_arow, dim3(ACT_ROWS / 256), dim3(256), 0, stream, (const int*)(CNT + l * NE * CNT_STRIDE), (const int*)(ws + WS_LIST), (int*)(ws + WS_AROW));
            hipLaunchKernelGGL(slow_gemm, dim3(2048 / 64, ACT_ROWS / 64), dim3(256), 0, stream, (const bf16*)(ws + WS_XA), (const int*)(ws + WS_AROW), (const bf16*)(ws + WS_W1T) + (size_t)l * NE * 2048 * 1024, CF, 2048, (const int*)(CNT + l * NE * CNT_STRIDE), (size_t)2048 * 1024);
            hipLaunchKernelGGL(slow_epi_swiglu, dim3(ACT_ROWS * 1024 / 256), dim3(256), 0, stream, (const float*)CF, (const int*)(CNT + l * NE * CNT_STRIDE), in_[I_B1] + (size_t)l * NE * 2048, (bf16*)(ws + WS_ACT));
            break;
        case PH_M2_0: case PH_M2_1:
            hipLaunchKernelGGL(slow_gemm, dim3(1024 / 64, ACT_ROWS / 64), dim3(256), 0, stream, (const bf16*)(ws + WS_ACT), (const int*)nullptr, (const bf16*)(ws + WS_W2T) + (size_t)l * NE * 1024 * 1024, CF, 1024, (const int*)(CNT + l * NE * CNT_STRIDE), (size_t)1024 * 1024);
            hipLaunchKernelGGL(slow_epi_down, dim3(ACT_ROWS * 1024 / 256), dim3(256), 0, stream, (const float*)CF, (const int*)(CNT + l * NE * CNT_STRIDE), (const int*)(ws + WS_LIST), (const float*)(ws + WS_GATE), in_[I_B2] + (size_t)l * NE * D, (bf16*)(ws + WS_Y));
            break;
        case PH_GMI:
            hipLaunchKernelGGL(slow_gemm, dim3(2048 / 64, NTOK / 64), dim3(256), 0, stream, (const bf16*)(ws + WS_XA), (const int*)nullptr, (const bf16*)(ws + WS_GWINT), CF, 2048, (const int*)nullptr, (size_t)0);
            hipLaunchKernelGGL(slow_epi_gelu, dim3(NTOK * 2048 / 256), dim3(256), 0, stream, (const float*)CF, in_[I_OBIN], (bf16*)(ws + WS_U), (bf16*)(ws + WS_VB));
            break;
        case PH_SPA:
            hipLaunchKernelGGL(slow_vstats, dim3(NTOK / 64), dim3(64), 0, stream, (const bf16*)(ws + WS_VB), CF);
            hipLaunchKernelGGL(slow_spatial, dim3(NTOK * D / 256), dim3(256), 0, stream, (const bf16*)(ws + WS_U), (const bf16*)(ws + WS_VB), (const float*)CF, in_[I_OWS], in_[I_OBS], in_[I_OLNG], in_[I_OLNB], (bf16*)(ws + WS_MIX));
            break;
        default: break;
        }
    }
    flush(NPHASE);
}
```

```cpp
#include <hip/hip_runtime.h>
#include <cstdio>
#include <cstdint>

#ifndef SLOW_MASK
#define SLOW_MASK 0x00
#endif

#ifndef GROUP_B
#define GROUP_B 80
#endif
#ifndef EXP_BAR2
#define EXP_BAR2 0
#endif
#ifndef EXP_STREAM
#define EXP_STREAM 0
#endif
#ifndef PROBE_PH
#define PROBE_PH (-1)
#endif
#ifndef PROBE_END
#define PROBE_END (PROBE_PH + 1)
#endif
#ifndef PROBE_A
#define PROBE_A (-1)
#define PROBE_B (-1)
#endif
#ifndef PROBE_MULT
#define PROBE_MULT 4
#endif

#define LAS __attribute__((address_space(3)))
typedef unsigned short bf16;
typedef short bf16x8 __attribute__((ext_vector_type(8)));
typedef float f32x4 __attribute__((ext_vector_type(4)));
typedef float f32x2 __attribute__((ext_vector_type(2)));
typedef unsigned u32x4 __attribute__((ext_vector_type(4)));
typedef unsigned u32x2 __attribute__((ext_vector_type(2)));
typedef __bf16 bf16x2_t __attribute__((ext_vector_type(2)));

constexpr int NB = 8, SEQ = 2048, D = 1024, NTOK = NB * SEQ, CTXL = 256, NCTX = NB * CTXL;
constexpr int NE = 32, TOPK = 4, NASSIGN = NTOK * TOPK, ACT_ROWS = NASSIGN + NE * 256;
constexpr int EVEN_IN = 1792, KV_COL = 1536;
constexpr float EPS = 1e-6f, LOG2E = 1.4426950408889634f;
constexpr float QSCALE = 0.125f * LOG2E;
constexpr int MODW = 6 * D;
constexpr int NWAVES = 8, NTHREADS = 512;

constexpr size_t MiB = 1u << 20;
constexpr size_t WS_CTL = 0, CTL_ZERO_BYTES = 1 * MiB;
constexpr size_t WS_MOD = 1 * MiB;
constexpr size_t WS_LIST = 2 * MiB;
constexpr size_t WS_GATE = 4 * MiB;
constexpr size_t WS_WSB = 5 * MiB;
constexpr size_t WS_WINT = 6 * MiB;
constexpr size_t WS_WOUTT = 10 * MiB;
constexpr size_t WS_GWINT = 12 * MiB;
constexpr size_t WS_GWOUTT = 16 * MiB;
constexpr size_t WS_KC = 18 * MiB;
constexpr size_t WS_VC = 18 * MiB + 512 * 1024;
constexpr size_t WS_K = 19 * MiB;
constexpr size_t WS_V = 23 * MiB;
constexpr size_t WS_GM = 27 * MiB;
constexpr size_t WS_AROW = 31 * MiB;
constexpr size_t WS_Q = 32 * MiB;
constexpr size_t WS_GLU = 48 * MiB;
constexpr size_t WS_XA = 64 * MiB;
constexpr size_t WS_MIX = 96 * MiB;
constexpr size_t WS_H = 128 * MiB;
constexpr size_t WS_U = 192 * MiB;
constexpr size_t WS_VB = 224 * MiB;
constexpr size_t WS_W1T = 256 * MiB;
constexpr size_t WS_W2T = 512 * MiB;
constexpr size_t WS_ACT = 640 * MiB;
constexpr size_t WS_Y = 784 * MiB;
constexpr size_t WS_XA8 = 912 * MiB;
constexpr size_t WS_CF = 928 * MiB;
constexpr size_t WS_END = 1504 * MiB;
constexpr int CW_BAR = 4096, CW_CNT = 131072, CNT_STRIDE = 64  , CW_VSTAT = 147456;
constexpr int MAX_LAUNCH = 20;

constexpr int RING_BYTES = 131072;
constexpr int MISC_OFF = RING_BYTES;
constexpr int TAB_OFF = RING_BYTES + 256;
constexpr int META_OFF = RING_BYTES + 3072;
constexpr int BIAS_OFF = META_OFF + 10240;
constexpr int LDS_BYTES = 163840;

#define LDS_WAIT() asm volatile("s_waitcnt lgkmcnt(0)" ::: "memory")
#define VM_WAIT() asm volatile("s_waitcnt vmcnt(0)" ::: "memory")

__device__ __forceinline__ float bf2f(unsigned b) { return __uint_as_float(b << 16); }
__device__ __forceinline__ unsigned pk2(float lo, float hi) { f32x2 v = {lo, hi}; bf16x2_t b = __builtin_convertvector(v, bf16x2_t); return __builtin_bit_cast(unsigned, b); }
template <int CTRL, int ROW_MASK> __device__ __forceinline__ float dpp_f(float old, float src) { return __builtin_bit_cast(float, __builtin_amdgcn_update_dpp(__builtin_bit_cast(int, old), __builtin_bit_cast(int, src), CTRL, ROW_MASK, 0xf, false)); }
__device__ __forceinline__ unsigned pk4_fp8(float a, float b, float c, float d) { int w = 0; w = __builtin_amdgcn_cvt_pk_fp8_f32(a, b, w, false); w = __builtin_amdgcn_cvt_pk_fp8_f32(c, d, w, true); return (unsigned)w; }
__device__ __forceinline__ float wave_sum(float v) {
    v += dpp_f<0xB1, 0xf>(0.f, v);
    v += dpp_f<0x4E, 0xf>(0.f, v);
    v += dpp_f<0x141, 0xf>(0.f, v);
    v += dpp_f<0x140, 0xf>(0.f, v);
    v += dpp_f<0x142, 0xa>(0.f, v);
    v += dpp_f<0x143, 0xc>(0.f, v);
    return __builtin_bit_cast(float, __builtin_amdgcn_readlane(__builtin_bit_cast(int, v), 63));
}
__device__ __forceinline__ float dpp_swap32(float v) { return __shfl_xor(v, 32); }
__device__ __forceinline__ float sigmoidf_(float x) { return __builtin_amdgcn_rcpf(1.0f + __builtin_amdgcn_exp2f(-x * LOG2E)); }

#define XB_TMO      128
#define XB_XCNT(j)  (256  + 64 * (j))
#define XB_XSUB(j)  (1280 + 64 * (j))
#define XB_XGEN(j)  (2304 + 64 * (j))
#define XB_TOP      3328
#define XB_TOPGEN   3392
#define XCD_BAR_WORDS 3456
#define XB_SPIN_CAP (1u << 20)
__device__ __forceinline__ unsigned xb_ld(unsigned* p)              { return __hip_atomic_load(p, __ATOMIC_RELAXED, __HIP_MEMORY_SCOPE_AGENT); }
__device__ __forceinline__ unsigned xb_add(unsigned* p, unsigned v) { return __hip_atomic_fetch_add(p, v, __ATOMIC_RELAXED, __HIP_MEMORY_SCOPE_AGENT); }
__device__ __forceinline__ unsigned xb_xcc_id() { return (unsigned)__builtin_amdgcn_s_getreg((3 << 11) | 20) & 0xFu; }
#define XB_SPIN(cond, bar) do { unsigned _sp = 0; while (cond) { __builtin_amdgcn_s_sleep(1); \
    if ((++_sp & 255u) == 0u) { if (xb_ld(&(bar)[XB_TMO])) break; if (_sp > XB_SPIN_CAP) { atomicAdd(&(bar)[XB_TMO], 1u); break; } } } } while (0)
struct XcdBarrier { unsigned* bar; unsigned x; volatile LAS unsigned* st; unsigned expected; };
__device__ __forceinline__ XcdBarrier xcd_barrier_post(unsigned* bar, volatile LAS unsigned* st, unsigned expected, bool member) {
    XcdBarrier b; b.bar = bar; b.x = xb_xcc_id(); b.st = st; b.expected = expected;
    if (member && threadIdx.x == 0) (void)xb_add(&bar[XB_XCNT(b.x)], 1u);
    return b;
}
__device__ __forceinline__ void xcd_barrier_complete(unsigned* bar, unsigned x, unsigned& nloc, unsigned& nx, const unsigned G) {
    unsigned sum, cnt, mine, sp = 0u;
    for (;;) {
        sum = 0u; cnt = 0u; mine = 0u;
#pragma unroll
        for (unsigned j = 0; j < 16; ++j) { const unsigned c = xb_ld(&bar[XB_XCNT(j)]); sum += c; cnt += (c > 0u) ? 1u : 0u; mine = (j == x) ? c : mine; }
        if (sum == G) break;
        __builtin_amdgcn_s_sleep(1);
        if ((++sp & 255u) == 0u) { if (xb_ld(&bar[XB_TMO])) break; if (sp > XB_SPIN_CAP) { atomicAdd(&bar[XB_TMO], 1u); break; } }
    }
    nloc = mine > 0u ? mine : 1u; nx = cnt > 0u ? cnt : 1u;
}
__device__ __forceinline__ void xcd_barrier(const XcdBarrier& b, const int tid) {
    asm volatile("s_waitcnt vmcnt(0)" ::: "memory");
    __syncthreads();
    if (tid == 0) {
        unsigned* bar = b.bar;
        __builtin_amdgcn_s_waitcnt(0);
        unsigned nloc = b.st[0], nx = b.st[1];
        if (nloc == 0u) { xcd_barrier_complete(bar, b.x, nloc, nx, b.expected); b.st[0] = nloc; b.st[1] = nx; }
        const unsigned old = xb_add(&bar[XB_XSUB(b.x)], 1u);
        const unsigned gen = old / nloc;
        if (old + 1u == (gen + 1u) * nloc) {
            __builtin_amdgcn_fence(__ATOMIC_RELEASE, "agent");
            asm volatile("s_waitcnt vmcnt(0)" ::: "memory");
            const unsigned og = xb_add(&bar[XB_TOP], 1u);
            const unsigned tg = og / nx;
            if (og + 1u == (tg + 1u) * nx) xb_add(&bar[XB_TOPGEN], 1u);
            else XB_SPIN(xb_ld(&bar[XB_TOPGEN]) == tg, bar);
            __builtin_amdgcn_fence(__ATOMIC_ACQUIRE, "agent");
            xb_add(&bar[XB_XGEN(b.x)], 1u);
            asm volatile("s_waitcnt vmcnt(0)" ::: "memory");
        } else {
            XB_SPIN(xb_ld(&bar[XB_XGEN(b.x)]) == gen, bar);
            __builtin_amdgcn_fence(__ATOMIC_ACQUIRE, "agent");
            asm volatile("s_waitcnt vmcnt(0)" ::: "memory");
        }
    }
    __syncthreads();
}

constexpr float FP8_WMUL = 32.0f, FP8_AMUL = 4.0f, FP8_DESCALE = 1.0f / (32.0f * 4.0f);
#if PROBE_PH == -2
#define GMARK(k) do { if (Sched::GATHER && ui == 0 && blockIdx.x == 0 && tid == 0) { volatile LAS unsigned long long* pm_ = (volatile LAS unsigned long long*)(lds + MISC_OFF + 128); \
    if ((k) == PROBE_A) pm_[0] = __builtin_amdgcn_s_memrealtime(); if ((k) == PROBE_B) pm_[1] = __builtin_amdgcn_s_memrealtime(); } } while (0)
#define GMARK1(k) do { if (Sched::GATHER && ui == 1 && blockIdx.x == 0 && tid == 0) { volatile LAS unsigned long long* pm_ = (volatile LAS unsigned long long*)(lds + MISC_OFF + 128); \
    if ((k) == PROBE_A) pm_[0] = __builtin_amdgcn_s_memrealtime(); if ((k) == PROBE_B) pm_[1] = __builtin_amdgcn_s_memrealtime(); } } while (0)
#else
#define GMARK(k) do { } while (0)
#define GMARK1(k) do { } while (0)
#endif
namespace pg8 {
constexpr int BM = 256, BK = 64, HALF = 128, HTB = HALF * BK * 2, STAGE_BYTES = 8 * HTB, KD = 1024  ;
__host__ __device__ __forceinline__ int lds_byte(int r, int c) { const int st = (r >> 4) * 2 + (c >> 5), rr = r & 15, cc = c & 31, ob = rr * 64 + cc * 2; return st * 1024 + (ob ^ (((ob >> 9) & 1) << 5)); }
__host__ __device__ __forceinline__ void stage_rc(int b, int& R, int& C) { const int st = b / 1024, sb = b % 1024, swz = sb ^ (((sb >> 9) & 1) << 5); R = (st >> 1) * 16 + swz / 64; C = (st & 1) * 32 + (swz % 64) / 2; }
__host__ __device__ __forceinline__ int perm32(int rho) { const int n = rho >> 4, i = rho & 15; return 8 * (i >> 2) + 4 * n + (i & 3); }

typedef int v8i_t __attribute__((ext_vector_type(8)));
__device__ __forceinline__ v8i_t cat8(bf16x8 a, bf16x8 b) { typedef int v4i_t __attribute__((ext_vector_type(4))); const v4i_t x = __builtin_bit_cast(v4i_t, a), y = __builtin_bit_cast(v4i_t, b); return __builtin_shufflevector(x, y, 0, 1, 2, 3, 4, 5, 6, 7); }
struct Unit { int pm, pn, e, cnt, idx; };

template <class Epi, class Sched>
__device__ __forceinline__ void gemm_phase(LAS unsigned char* lds, const Sched& S, const Epi& E, const int tid) {
    const int wid = __builtin_amdgcn_readfirstlane(tid >> 6), lane = tid & 63, wr = wid >> 2, wc = wid & 3, fr = lane & 15, fq = lane >> 4;
    constexpr int RP = Sched::FP8 ? 1024 : 2048  , nt = RP / 128;
    int Rr[2], Cc[2];
    unsigned voffA[2][2], voffB[2];
#pragma unroll
    for (int i = 0; i < 2; ++i) { stage_rc(tid * 16 + i * 8192, Rr[i], Cc[i]); const int Rb = Epi::PERM ? ((Rr[i] & ~31) + perm32(Rr[i] & 31)) : Rr[i];
        voffB[i] = (unsigned)(Rb * RP + Cc[i] * 2); }
    constexpr size_t kstep = (size_t)(BK * 2);
    constexpr size_t hstep = (size_t)HALF * RP;
    const unsigned ldsw = (unsigned)wid * 1024u;
    const int aoff = lds_byte(wr * 64 + fr, fq * 8), boff = lds_byte(wc * 32 + fr, fq * 8);
#define PG8_SA(b, h) (((b) * 2 + (h)) * HTB)
#define PG8_SB(b, h) ((4 + (b) * 2 + (h)) * HTB)
#define PG8_STAGE(bufoff, gbase, voff) do { _Pragma("unroll") for (int _i = 0; _i < 2; ++_i) \
        __builtin_amdgcn_global_load_lds((const unsigned*)((const char*)(gbase) + (voff)[_i]), (LAS unsigned*)(lds + (bufoff) + ldsw + _i * 8192), 16, 0, 0); } while (0)
#define PG8_STAGEA1(bufoff, gbase) do { if constexpr (Sched::GATHER) { PG8_STAGE(bufoff, gbase, voffA[1]); } else { PG8_STAGE(bufoff, (gbase) + hstep, voffA[0]); } } while (0)
#define PG8_LDA(dst, b, h) do { _Pragma("unroll") for (int m = 0; m < 4; ++m) _Pragma("unroll") for (int k = 0; k < 2; ++k) dst[m][k] = *(const LAS bf16x8*)(lds + PG8_SA(b, h) + aoff + m * 2048 + k * 1024); } while (0)
#define PG8_LDB(dst, b, h) do { _Pragma("unroll") for (int n = 0; n < 2; ++n) _Pragma("unroll") for (int k = 0; k < 2; ++k) dst[n][k] = *(const LAS bf16x8*)(lds + PG8_SB(b, h) + boff + n * 2048 + k * 1024); } while (0)
#define PG8_MMA(ai, bj, At, Bt) do { __builtin_amdgcn_s_setprio(1); _Pragma("unroll") for (int m = 0; m < 4; ++m) _Pragma("unroll") for (int n = 0; n < 2; ++n) { \
        if constexpr (Sched::FP8) { acc[ai][bj][m][n] = __builtin_amdgcn_mfma_scale_f32_16x16x128_f8f6f4(cat8(Bt[n][0], Bt[n][1]), cat8(At[m][0], At[m][1]), acc[ai][bj][m][n], 0, 0, 0, 0, 0, 0); } \
        else { _Pragma("unroll") for (int k = 0; k < 2; ++k) acc[ai][bj][m][n] = __builtin_amdgcn_mfma_f32_16x16x32_bf16(Bt[n][k], At[m][k], acc[ai][bj][m][n], 0, 0, 0); } } \
        __builtin_amdgcn_s_setprio(0); } while (0)
#define PG8_WAIT_V(n) asm volatile("s_waitcnt vmcnt(" #n ")" ::: "memory")
#define PG8_WAIT_L(n) asm volatile("s_waitcnt lgkmcnt(" #n ")" ::: "memory")
#define PG8_BAR __builtin_amdgcn_s_barrier()
#define PG8_SCHED __builtin_amdgcn_sched_barrier(0)
    Unit cur, nxt; int ui = 0;
    if (!S.next(0, cur)) return;
    S.a_voff(cur, voffA, Rr, Cc);
    f32x4 acc[2][2][4][2];
#pragma unroll
    for (int a = 0; a < 2; ++a)
#pragma unroll
        for (int b = 0; b < 2; ++b)
#pragma unroll
            for (int m = 0; m < 4; ++m)
#pragma unroll
                for (int n = 0; n < 2; ++n) acc[a][b][m][n] = (f32x4){0.f, 0.f, 0.f, 0.f};
    bf16x8 At[4][2], B0[2][2], B1[2][2];
    const char* cA = S.a_ptr(cur); const char* cB = S.b_ptr(cur);
    PG8_STAGE(PG8_SB(0, 0), cB, voffB); PG8_STAGE(PG8_SB(0, 1), cB + hstep, voffB); PG8_STAGE(PG8_SA(0, 0), cA, voffA[0]); PG8_STAGEA1(PG8_SA(0, 1), cA);
    if (wr == 1) PG8_BAR;
    PG8_WAIT_V(2); PG8_BAR;
    PG8_STAGE(PG8_SB(1, 0), cB + kstep, voffB); PG8_STAGE(PG8_SA(1, 0), cA + kstep, voffA[0]); PG8_STAGE(PG8_SB(1, 1), cB + hstep + kstep, voffB);
    PG8_WAIT_V(6); PG8_BAR;
    for (;;) {
        const bool has_next = S.next(ui + 1, nxt);
        const char* nA = has_next ? S.a_ptr(nxt) : cA; const char* nB = has_next ? S.b_ptr(nxt) : cB;
#pragma unroll 1
        for (int t = 0; t < nt; t += 2) {
            const bool last = (t == nt - 2);
            if (last) GMARK(40); if (t == 2) GMARK1(45);
            const char* a1 = cA + (size_t)(t + 1) * kstep;
            const char* a2 = last ? nA : cA + (size_t)(t + 2) * kstep; const char* b2 = last ? nB : cB + (size_t)(t + 2) * kstep;
            const char* a3 = a2 + kstep; const char* b3 = b2 + kstep;
            asm volatile("" : "+s"(a1), "+s"(a2), "+s"(a3), "+s"(b2), "+s"(b3));
            PG8_LDB(B0, 0, 0); PG8_LDB(B1, 0, 1); PG8_SCHED; PG8_LDA(At, 0, 0); PG8_STAGEA1(PG8_SA(1, 1), a1);
            if (Sched::GATHER) { if (last && has_next) S.a_voff(nxt, voffA, Rr, Cc); }
            PG8_WAIT_V(8); PG8_WAIT_L(0); PG8_BAR; PG8_MMA(0, 0, At, B0); PG8_MMA(0, 1, At, B1); PG8_BAR; PG8_SCHED;
            PG8_LDA(At, 0, 1); PG8_STAGE(PG8_SB(0, 0), b2, voffB); PG8_STAGE(PG8_SB(0, 1), b2 + hstep, voffB); PG8_STAGE(PG8_SA(0, 0), a2, voffA[0]);
            PG8_WAIT_V(8); PG8_WAIT_L(0); PG8_BAR; PG8_MMA(1, 0, At, B0); PG8_MMA(1, 1, At, B1); PG8_BAR; PG8_SCHED;
            PG8_LDB(B0, 1, 0); PG8_LDB(B1, 1, 1); PG8_SCHED; PG8_LDA(At, 1, 0); PG8_STAGEA1(PG8_SA(0, 1), a2);
            PG8_WAIT_V(8); PG8_WAIT_L(0); PG8_BAR; PG8_MMA(0, 0, At, B0); PG8_MMA(0, 1, At, B1); PG8_BAR; PG8_SCHED;
            PG8_LDA(At, 1, 1); PG8_STAGE(PG8_SB(1, 0), b3, voffB); PG8_STAGE(PG8_SB(1, 1), b3 + hstep, voffB); PG8_STAGE(PG8_SA(1, 0), a3, voffA[0]);
            PG8_WAIT_V(8); PG8_WAIT_L(0); PG8_BAR; PG8_MMA(1, 0, At, B0); PG8_MMA(1, 1, At, B1); PG8_BAR; PG8_SCHED;
        }
        GMARK(41);
        if (wr == 0) PG8_BAR;
        GMARK(42);
        E(acc, cur, wr, wc, fr, fq);
        GMARK(43);
        if (!has_next) break;
#pragma unroll
        for (int a = 0; a < 2; ++a)
#pragma unroll
            for (int b = 0; b < 2; ++b)
#pragma unroll
                for (int m = 0; m < 4; ++m)
#pragma unroll
                    for (int n = 0; n < 2; ++n) acc[a][b][m][n] = (f32x4){0.f, 0.f, 0.f, 0.f};
        cur = nxt; cA = nA; cB = nB; ++ui;
        if (wr == 1) PG8_BAR;
    }
    PG8_WAIT_V(0);
    PG8_BAR;
#undef PG8_SA
#undef PG8_SB
#undef PG8_STAGE
#undef PG8_STAGEA1
#undef PG8_LDA
#undef PG8_LDB
#undef PG8_MMA
#undef PG8_WAIT_V
#undef PG8_WAIT_L
#undef PG8_BAR
#undef PG8_SCHED
}
}

struct Args { const float* in[33]; float* out; unsigned char* ws; int ph_lo, ph_hi, li, pad; };
enum { I_X = 0, I_C, I_CTX, I_CCTX, I_ADAW, I_ADAB, I_NMG, I_NFG, I_EWIN, I_EBIN, I_ECW, I_ECB, I_ELNG, I_ELNB, I_QNG, I_KNG, I_SINK, I_EWOUT, I_EBOUT,
       I_OWIN, I_OBIN, I_OLNG, I_OLNB, I_OWS, I_OBS, I_OWOUT, I_OBOUT, I_RW, I_RB, I_W1, I_B1, I_W2, I_B2 };

typedef const __attribute__((address_space(4))) unsigned long long* kargp_t;
struct Ctx {
    LAS unsigned char* lds; int tid, lane, wave, G, vcu, gw, NGW, bid; unsigned char* ws; kargp_t kp;
};
__device__ __forceinline__ const float* in_ptr(const Ctx& X, int i) { return (const float*)(const __attribute__((address_space(1))) float*)X.kp[i]; }
#define IN(i) in_ptr(X, (i))
#if PROBE_PH == -2
#define PMARK(k) do { if (X.bid == 0 && X.tid == 0) { volatile LAS unsigned long long* pm_ = (volatile LAS unsigned long long*)(X.lds + MISC_OFF + 128); \
    if ((k) == PROBE_A) pm_[0] = __builtin_amdgcn_s_memrealtime(); if ((k) == PROBE_B) pm_[1] = __builtin_amdgcn_s_memrealtime(); } } while (0)
#else
#define PMARK(k) do { } while (0)
#endif

struct DenseSched {
    static constexpr bool GATHER = false, FP8 = false;
    const bf16* A; const bf16* Bt; int nM, nN, nwg, G, c;
    const bf16* A2; const bf16* Bt2; int nM2;
    __device__ __forceinline__ void init(const bf16* A_, const bf16* Bt_, int M, int N, int G_, int c_) { A = A_; Bt = Bt_; nM = M / 256; nN = N / 256; nwg = nM * nN; G = G_; c = c_; A2 = nullptr; Bt2 = nullptr; nM2 = 0; }
    __device__ __forceinline__ bool next(int i, pg8::Unit& u) const {
        const int L = i * G + c; if (L >= nwg + nM2) return false; u.idx = i;
        if (L >= nwg) { u.pm = L - nwg; u.pn = 0; u.e = 1; u.cnt = 256; return true; }
        int wgid = L; { const int q = nwg / 8, r = nwg % 8, xcd = wgid % 8, off = wgid / 8; wgid = (xcd < r ? xcd * (q + 1) : r * (q + 1) + (xcd - r) * q) + off; }
        const int nig = 8 * nN, gid = wgid / nig, fm = gid * 8, gsz = (nM - fm) < 8 ? (nM - fm) : 8;
        u.pm = fm + ((wgid % nig) % gsz); u.pn = (wgid % nig) / gsz; u.e = 0; u.cnt = 256; return true;
    }
    __device__ __forceinline__ const char* a_ptr(const pg8::Unit& u) const { return (const char*)(u.e ? A2 : A) + (size_t)u.pm * 256 * pg8::KD * 2; }
    __device__ __forceinline__ const char* b_ptr(const pg8::Unit& u) const { return (const char*)(u.e ? Bt2 : Bt) + (size_t)u.pn * 256 * pg8::KD * 2; }
    __device__ __forceinline__ void a_voff(const pg8::Unit&, unsigned (&v)[2][2], const int (&R)[2], const int (&C)[2]) const {
#pragma unroll
        for (int i = 0; i < 2; ++i) { v[0][i] = (unsigned)(R[i] * pg8::KD + C[i]) * 2u; v[1][i] = v[0][i] + (unsigned)(pg8::HALF * pg8::KD * 2); }
    }
};
template <bool GATHER_, int NTILE_N>
struct MoeSchedT {
    static constexpr bool GATHER = GATHER_, FP8 = true; static constexpr int RP = 1024;
    const LAS int* tab; int G, c;
    const unsigned char* A;
    const unsigned char* Bt;
    const int* list;
    const LAS int* meta;
    __device__ __forceinline__ bool next(int i, pg8::Unit& u) const {
        const int L = i * G + c; const int T = tab[0];
        if (L >= T * NTILE_N) return false;
        u.idx = i;
        const int mt = L / NTILE_N; u.pn = L % NTILE_N;
        const int w = __builtin_amdgcn_readfirstlane(tab[1 + mt]); u.e = w >> 16; const int tl = w & 0xffff;
        const int cnt = __builtin_amdgcn_readfirstlane(tab[512 + u.e]), pb = __builtin_amdgcn_readfirstlane(tab[544 + u.e]);
        u.pm = pb + tl * 256; u.cnt = cnt - tl * 256;
        return true;
    }
    __device__ __forceinline__ const char* a_ptr(const pg8::Unit& u) const { return GATHER ? (const char*)A : (const char*)A + (size_t)u.pm * RP; }
    __device__ __forceinline__ const char* b_ptr(const pg8::Unit& u) const { return (const char*)Bt + ((size_t)u.e * NTILE_N + u.pn) * 256 * RP; }
    __device__ __forceinline__ void a_voff(const pg8::Unit& u, unsigned (&v)[2][2], const int (&R)[2], const int (&C)[2]) const {
        if (GATHER) {
#pragma unroll
            for (int h = 0; h < 2; ++h)
#pragma unroll
                for (int i = 0; i < 2; ++i) { const int tok = meta[u.idx * 256 + h * 128 + R[i]]; v[h][i] = (unsigned)(tok * RP + C[i] * 2); }
        } else {
#pragma unroll
            for (int i = 0; i < 2; ++i) { v[0][i] = (unsigned)(R[i] * RP + C[i] * 2); v[1][i] = v[0][i] + (unsigned)(pg8::HALF * RP); }
        }
    }
};
__device__ __forceinline__ void moe_build_table(const Ctx& X, const int* cnt  ) {
    LAS int* tab = (LAS int*)(X.lds + TAB_OFF);
    __syncthreads();
    if (X.tid < 64) {
        const int e = X.lane; int c = 0; if (e < NE) c = __hip_atomic_load(cnt + e * CNT_STRIDE, __ATOMIC_RELAXED, __HIP_MEMORY_SCOPE_AGENT);
        const int mt = (c + 255) >> 8; int incl = mt;
#pragma unroll
        for (int off = 1; off < 32; off <<= 1) { const int v = __shfl_up(incl, off); if (X.lane >= off) incl += v; }
        const int start = incl - mt;
        if (e < NE) { tab[512 + e] = c; tab[544 + e] = start * 256; for (int t = 0; t < mt; ++t) tab[1 + start + t] = (e << 16) | t; if (e == NE - 1) tab[0] = incl; }
    }
    __syncthreads();
}
template <bool WITH_GATE, class Sched>
__device__ __forceinline__ void moe_stage_meta(const Ctx& X, const Sched& S, const int* list, const float* gatew, LAS int* meta, const float* bias, LAS float* lbias) {
    if (X.tid < 256) { pg8::Unit u;
        for (int i = 0; S.next(i, u); ++i) { const int slot0 = u.pm - S.tab[544 + u.e]; const int r = X.tid < u.cnt ? X.tid : u.cnt - 1;
            const int aid = list[(size_t)u.e * NTOK + slot0 + r];
            if (WITH_GATE) { const float g = gatew[aid]; *(LAS u32x2*)(meta + (i * 256 + X.tid) * 2) = (u32x2){(unsigned)aid, __float_as_uint(g)}; }
            else meta[i * 256 + X.tid] = aid >> 2; } }
    else { const int c = X.tid - 256; pg8::Unit u;
        for (int i = 0; S.next(i, u); ++i) lbias[i * 256 + c] = WITH_GATE ? bias[(size_t)u.e * D + u.pn * 256 + c] : bias[(size_t)u.e * 2048 + (c >> 7) * 1024 + u.pn * 128 + (c & 127)]; }
    __syncthreads();
}

__device__ __forceinline__ f32x2 gelu_pk(f32x2 v) {
    const f32x2 av = __builtin_elementwise_abs(v), d = av * 0.2316418882f + 1.0f;
    f32x2 t; t.x = __builtin_amdgcn_rcpf(d.x); t.y = __builtin_amdgcn_rcpf(d.y);
    f32x2 q = t * 0.5307027145f + (-0.7265760135f); q = q * t + 0.7107068705f; q = q * t + (-0.142248368f); q = q * t + 0.127414796f; q = q * t;
    const f32x2 s = (v * v) * (-0.72134752044f);
    f32x2 e; e.x = __builtin_amdgcn_exp2f(s.x); e.y = __builtin_amdgcn_exp2f(s.y);
    const f32x2 m = v * (q * e), r = v - m;
    f32x2 o; o.x = v.x < 0.f ? m.x : r.x; o.y = v.y < 0.f ? m.y : r.y; return o;
}
__device__ __forceinline__ u32x4 pack8(f32x4 a, f32x4 b) { u32x4 w; w.x = pk2(a[0], a[1]); w.y = pk2(a[2], a[3]); w.z = pk2(b[0], b[1]); w.w = pk2(b[2], b[3]); return w; }

struct EpiIn {
    static constexpr bool PERM = true;
    bf16 *GLU, *Q, *Kb, *Vb, *KC, *VC; const float* bias;
    __device__ __forceinline__ void operator()(const f32x4 (&acc)[2][2][4][2], const pg8::Unit& u, int wr, int wc, int fr, int fq) const {
        asm volatile("" : "+v"(fr), "+v"(fq));
        const int row0 = u.pm * 256 + wr * 64 + fr; const int c8 = wc * 32 + 8 * fq;
        if (u.e == 0 && u.pn < 4) {
            const int j0 = u.pn * 128 + c8;
            f32x4 bu[2], bg[2];
#pragma unroll
            for (int n = 0; n < 2; ++n) { bu[n] = *(const f32x4*)(bias + j0 + 4 * n); bg[n] = *(const f32x4*)(bias + 512 + j0 + 4 * n); }
#pragma unroll
            for (int ai = 0; ai < 2; ++ai)
#pragma unroll
                for (int m = 0; m < 4; ++m) { f32x4 o[2];
#pragma unroll
                    for (int n = 0; n < 2; ++n) { const f32x4 uu = acc[ai][0][m][n] + bu[n], gg = acc[ai][1][m][n] + bg[n];
#pragma unroll
                        for (int k = 0; k < 4; ++k) o[n][k] = uu[k] * sigmoidf_(gg[k]); }
                    *(u32x4*)(GLU + (size_t)(row0 + ai * 128 + m * 16) * 512 + j0) = pack8(o[0], o[1]); }
        } else {
#pragma unroll
            for (int bj = 0; bj < 2; ++bj) {
                bf16* dst; int ld, col, bcol;
                if (u.pn >= 6 || u.e) { dst = u.e ? (bj ? VC : KC) : (bj ? Vb : Kb); ld = 128; col = c8; bcol = KV_COL + bj * 128 + c8; }
                else { dst = Q; ld = 512; col = (u.pn - 4) * 256 + bj * 128 + c8; bcol = 1024 + col; }
                f32x4 bv[2];
#pragma unroll
                for (int n = 0; n < 2; ++n) bv[n] = *(const f32x4*)(bias + bcol + 4 * n);
#pragma unroll
                for (int ai = 0; ai < 2; ++ai)
#pragma unroll
                    for (int m = 0; m < 4; ++m) *(u32x4*)(dst + (size_t)(row0 + ai * 128 + m * 16) * ld + col) = pack8(acc[ai][bj][m][0] + bv[0], acc[ai][bj][m][1] + bv[1]);
            }
        }
    }
};
template <bool BASE_F32> struct EpiRes {
    static constexpr bool PERM = true;
    const void* base; bf16* out; const float* bias; const float* gate;
    __device__ __forceinline__ void operator()(const f32x4 (&acc)[2][2][4][2], const pg8::Unit& u, int wr, int wc, int fr, int fq) const {
        asm volatile("" : "+v"(fr), "+v"(fq));
        const int col0 = u.pn * 256 + wc * 32 + 8 * fq; const int b = (u.pm * 256) / SEQ;
#pragma unroll
        for (int bj = 0; bj < 2; ++bj) {
            f32x4 bv[2], gv[2];
#pragma unroll
            for (int n = 0; n < 2; ++n) { bv[n] = *(const f32x4*)(bias + col0 + bj * 128 + 4 * n); gv[n] = *(const f32x4*)(gate + (size_t)b * MODW + col0 + bj * 128 + 4 * n); }
#pragma unroll
            for (int ai = 0; ai < 2; ++ai)
#pragma unroll
                for (int m = 0; m < 4; ++m) { const size_t off = (size_t)(u.pm * 256 + ai * 128 + wr * 64 + m * 16 + fr) * D + col0 + bj * 128;
                    f32x4 b0, b1;
                    if (BASE_F32) { b0 = *(const f32x4*)((const float*)base + off); b1 = *(const f32x4*)((const float*)base + off + 4); }
                    else { const u32x4 w = *(const u32x4*)((const bf16*)base + off); b0 = (f32x4){bf2f(w.x & 0xffffu), bf2f(w.x >> 16), bf2f(w.y & 0xffffu), bf2f(w.y >> 16)}; b1 = (f32x4){bf2f(w.z & 0xffffu), bf2f(w.z >> 16), bf2f(w.w & 0xffffu), bf2f(w.w >> 16)}; }
                    *(u32x4*)(out + off) = pack8(b0 + gv[0] * (acc[ai][bj][m][0] + bv[0]), b1 + gv[1] * (acc[ai][bj][m][1] + bv[1])); }
        }
    }
};
struct EpiGelu {
    static constexpr bool PERM = true;
    bf16 *U, *V; const float* bias; float* vstat;
    __device__ __forceinline__ void operator()(const f32x4 (&acc)[2][2][4][2], const pg8::Unit& u, int wr, int wc, int fr, int fq) const {
        asm volatile("" : "+v"(fr), "+v"(fq));
        const int row0 = u.pm * 256 + wr * 64 + fr; const int colt = u.pn * 256; const bool isv = colt >= 1024; bf16* base = isv ? V : U; const int cb = (colt & 1023) + wc * 32 + 8 * fq, bcol = colt + wc * 32 + 8 * fq;
        f32x4 bv[2][2];
#pragma unroll
        for (int bj = 0; bj < 2; ++bj)
#pragma unroll
            for (int n = 0; n < 2; ++n) bv[bj][n] = *(const f32x4*)(bias + bcol + bj * 128 + 4 * n);
#pragma unroll
        for (int ai = 0; ai < 2; ++ai)
#pragma unroll
            for (int m = 0; m < 4; ++m) { const int row = row0 + ai * 128 + m * 16; bf16* rowp = base + (size_t)row * D + cb; float s = 0.f, s2 = 0.f;
#pragma unroll
                for (int bj = 0; bj < 2; ++bj) { f32x4 v0 = acc[ai][bj][m][0] + bv[bj][0], v1 = acc[ai][bj][m][1] + bv[bj][1];
                    f32x2 a = gelu_pk((f32x2){v0[0], v0[1]}), b = gelu_pk((f32x2){v0[2], v0[3]}), c = gelu_pk((f32x2){v1[0], v1[1]}), d = gelu_pk((f32x2){v1[2], v1[3]});
                    s += (a.x + a.y) + (b.x + b.y) + (c.x + c.y) + (d.x + d.y); s2 += (a.x * a.x + a.y * a.y) + (b.x * b.x + b.y * b.y) + (c.x * c.x + c.y * c.y) + (d.x * d.x + d.y * d.y);
                    *(u32x4*)(rowp + bj * 128) = pack8((f32x4){a.x, a.y, b.x, b.y}, (f32x4){c.x, c.y, d.x, d.y}); }
                if (isv) { s += __shfl_xor(s, 16); s += __shfl_xor(s, 32); s2 += __shfl_xor(s2, 16); s2 += __shfl_xor(s2, 32);
                    if (fq == 0) { unsafeAtomicAdd(vstat + 2 * row, s); unsafeAtomicAdd(vstat + 2 * row + 1, s2); } } }
    }
};
struct EpiSwiglu {
    static constexpr bool PERM = true;
    unsigned char* ACT; const LAS float* lbias;
    __device__ __forceinline__ void operator()(const f32x4 (&acc)[2][2][4][2], const pg8::Unit& u, int wr, int wc, int fr, int fq) const {
        asm volatile("" : "+v"(fr), "+v"(fq));
        const int j0 = u.pn * 128 + wc * 32 + 8 * fq; const LAS float* bb = lbias + u.idx * 256 + wc * 32 + 8 * fq;
        f32x4 bg[2], bu[2];
#pragma unroll
        for (int n = 0; n < 2; ++n) { bg[n] = *(const LAS f32x4*)(bb + 4 * n); bu[n] = *(const LAS f32x4*)(bb + 128 + 4 * n); }
#pragma unroll
        for (int ai = 0; ai < 2; ++ai)
#pragma unroll
            for (int m = 0; m < 4; ++m) { f32x4 o[2];
#pragma unroll
                for (int n = 0; n < 2; ++n) { const f32x4 g4 = acc[ai][0][m][n] * FP8_DESCALE + bg[n], u4 = acc[ai][1][m][n] * FP8_DESCALE + bu[n];
#pragma unroll
                    for (int k = 0; k < 4; ++k) { const float g = fminf(g4[k], 7.0f), up = fminf(fmaxf(u4[k], -7.0f), 7.0f); o[n][k] = (up + 1.0f) * g * sigmoidf_(g * 1.702f); } }
                u32x2 w8; w8.x = pk4_fp8(o[0][0] * FP8_AMUL, o[0][1] * FP8_AMUL, o[0][2] * FP8_AMUL, o[0][3] * FP8_AMUL); w8.y = pk4_fp8(o[1][0] * FP8_AMUL, o[1][1] * FP8_AMUL, o[1][2] * FP8_AMUL, o[1][3] * FP8_AMUL);
                *(u32x2*)(ACT + (size_t)(u.pm + ai * 128 + wr * 64 + m * 16 + fr) * D + j0) = w8; }
    }
};
struct EpiDown {
    static constexpr bool PERM = true;
    bf16* Y; const LAS float* lbias; const LAS int* meta;
    __device__ __forceinline__ void operator()(const f32x4 (&acc)[2][2][4][2], const pg8::Unit& u, int wr, int wc, int fr, int fq) const {
        asm volatile("" : "+v"(fr), "+v"(fq));
        const int c8 = u.pn * 256 + wc * 32 + 8 * fq; const LAS float* bb = lbias + u.idx * 256 + wc * 32 + 8 * fq;
#pragma unroll
        for (int bj = 0; bj < 2; ++bj) {
            f32x4 bv[2];
#pragma unroll
            for (int n = 0; n < 2; ++n) bv[n] = *(const LAS f32x4*)(bb + bj * 128 + 4 * n);
#pragma unroll
            for (int ai = 0; ai < 2; ++ai)
#pragma unroll
                for (int m = 0; m < 4; ++m) { const int r = ai * 128 + wr * 64 + m * 16 + fr; const u32x2 mg = *(const LAS u32x2*)(meta + (u.idx * 256 + r) * 2); const int aid = (int)mg.x; const float g = __uint_as_float(mg.y);
                    const u32x4 w = pack8((acc[ai][bj][m][0] * FP8_DESCALE + bv[0]) * g, (acc[ai][bj][m][1] * FP8_DESCALE + bv[1]) * g);
                    if (r < u.cnt) *(u32x4*)(Y + (size_t)aid * D + c8 + bj * 128) = w; }
        }
    }
};

struct TrItem { const float* src; bf16* dst; int N; int fp8; };
__device__ __forceinline__ void tr_load(const TrItem& t, float (&v)[32], int lane) {
#pragma unroll
    for (int i = 0; i < 32; ++i) v[i] = __builtin_nontemporal_load(t.src + (size_t)(2 * i + (lane >> 5)) * t.N + (lane & 31));
}
__device__ __forceinline__ void tr_store(const TrItem& t, const float (&v)[32], LAS float* scr, int lane) {
#pragma unroll
    for (int i = 0; i < 32; ++i) scr[(2 * i + (lane >> 5)) * 33 + (lane & 31)] = v[i];
    LDS_WAIT();
    if (t.fp8) {
        const int q = lane & 3;
#pragma unroll
        for (int j = 0; j < 2; ++j) { const int n = (lane >> 2) + 16 * j; const LAS float* s = scr + (16 * q) * 33 + n; u32x4 o;
#pragma unroll
            for (int c = 0; c < 4; ++c) o[c] = pk4_fp8(s[(4 * c) * 33] * FP8_WMUL, s[(4 * c + 1) * 33] * FP8_WMUL, s[(4 * c + 2) * 33] * FP8_WMUL, s[(4 * c + 3) * 33] * FP8_WMUL);
            *(u32x4*)((unsigned char*)t.dst + (size_t)n * 1024 + 16 * q) = o; }
    } else {
        const int c = lane & 7;
#pragma unroll
        for (int j = 0; j < 4; ++j) { const int n = (lane >> 3) + 8 * j; const LAS float* s = scr + (8 * c) * 33 + n;
            u32x4 o; o.x = pk2(s[0 * 33], s[1 * 33]); o.y = pk2(s[2 * 33], s[3 * 33]); o.z = pk2(s[4 * 33], s[5 * 33]); o.w = pk2(s[6 * 33], s[7 * 33]);
            *(u32x4*)(t.dst + (size_t)n * 1024 + 8 * c) = o; }
    }
    LDS_WAIT();
}
template <int N, bool PAIR> struct MoeCvt {
    static constexpr int STRIPS = N / 512, ITEMS_PER_MAT = 8 * STRIPS;
    static __device__ __forceinline__ void load_half(const float* W, int item, int h, f32x4 (&v)[2][2][4], int wave, int lane) {
        const int mat = item / ITEMS_PER_MAT, q = item % ITEMS_PER_MAT, kb = q / STRIPS, sb = q % STRIPS;
        const float* s = W + (size_t)mat * 1024 * N + (size_t)(128 * kb + 16 * wave + 8 * h) * N + 512 * sb + 4 * lane;
#pragma unroll
        for (int g = 0; g < 2; ++g)
#pragma unroll
            for (int hh = 0; hh < 2; ++hh)
#pragma unroll
                for (int r = 0; r < 4; ++r) v[g][hh][r] = __builtin_nontemporal_load((const f32x4*)(s + (size_t)(4 * g + r) * N + 256 * hh));
    }
    static __device__ __forceinline__ void to_lds_half(const f32x4 (&v)[2][2][4], int h, LAS unsigned* img, int wave, int lane) {
#pragma unroll
        for (int g = 0; g < 2; ++g) { const int kq = 4 * wave + 2 * h + g;
#pragma unroll
            for (int hh = 0; hh < 2; ++hh)
#pragma unroll
                for (int j = 0; j < 4; ++j) { const int rho = 64 * hh + lane + 128 * j;
                    img[rho * 32 + ((kq ^ rho) & 31)] = pk4_fp8(v[g][hh][0][j] * FP8_WMUL, v[g][hh][1][j] * FP8_WMUL, v[g][hh][2][j] * FP8_WMUL, v[g][hh][3][j] * FP8_WMUL); } }
    }
    static __device__ __forceinline__ void store(unsigned char* WT, int item, const LAS unsigned* img, int wave, int lane) {
        const int mat = item / ITEMS_PER_MAT, q = item % ITEMS_PER_MAT, kb = q / STRIPS, sb = q % STRIPS;
        unsigned char* d = WT + (size_t)mat * N * 1024 + 128 * kb;
        const int mi = lane >> 3, c = lane & 7;
#pragma unroll
        for (int st = 0; st < 2; ++st)
#pragma unroll
            for (int j = 0; j < 4; ++j) { const int m = 16 * wave + 8 * st + mi, rho = m + 128 * j, n = 4 * m + j;
                u32x4 o;
#pragma unroll
                for (int i = 0; i < 4; ++i) o[i] = img[rho * 32 + (((4 * c + i) ^ rho) & 31)];
                int drow;
                if (PAIR) { const int h = sb >> 1, rem = 512 * (sb & 1) + n; drow = (rem >> 7) * 256 + h * 128 + (rem & 127); } else drow = 512 * sb + n;
                __builtin_nontemporal_store(o, (u32x4*)(d + (size_t)drow * 1024 + 16 * c)); }
    }
    static __device__ __forceinline__ void run(const float* W, unsigned char* WT, int nitems, int first, int stride, LAS unsigned char* lds, int wave, int lane) {
        f32x4 va[2][2][4], vb[2][2][4]; int it = first, buf = 0;
        if (it < nitems) { load_half(W, it, 0, va, wave, lane); load_half(W, it, 1, vb, wave, lane); }
        while (it < nitems) {
            LAS unsigned* img = (LAS unsigned*)(lds + buf * 65536);
            const int nx = it + stride;
            to_lds_half(va, 0, img, wave, lane); if (nx < nitems) load_half(W, nx, 0, va, wave, lane);
            to_lds_half(vb, 1, img, wave, lane); if (nx < nitems) load_half(W, nx, 1, vb, wave, lane);
            __syncthreads();
            store(WT, it, img, wave, lane);
            it = nx; buf ^= 1;
        }
        __syncthreads();
    }
};

__device__ __forceinline__ int pair_src(int nd, int halfw) { return ((nd & 255) >> 7) * halfw + (nd >> 8) * 128 + (nd & 127); }

__device__ __forceinline__ void phase_moe_convert(const Ctx& X, int first, int stride) {
    MoeCvt<2048, true>::run(IN(I_W1), (unsigned char*)(X.ws + WS_W1T), 64 * MoeCvt<2048, true>::ITEMS_PER_MAT, first, stride, X.lds, X.wave, X.lane);
    MoeCvt<1024, false>::run(IN(I_W2), (unsigned char*)(X.ws + WS_W2T), 64 * MoeCvt<1024, false>::ITEMS_PER_MAT, first, stride, X.lds, X.wave, X.lane);
}
__device__ __forceinline__ void phase_prologue(const Args& a, const Ctx& X, const bool with_moe) {
    PMARK(20);
    {
        LAS float* sc = (LAS float*)X.lds;
        LAS float* red = (LAS float*)(X.lds + 36864);
        float* MOD = (float*)(X.ws + WS_MOD);
        for (int item = X.bid; item < 2 * 96; item += X.G) {
            const int l = item / 96, j0 = (item % 96) * 64;
            for (int idx = X.tid; idx < 9 * 1024; idx += NTHREADS) { const int r = idx >> 10, k = idx & 1023; const float v = r < 8 ? IN(I_C)[r * 1024 + k] : IN(I_CCTX)[k]; sc[idx] = v * sigmoidf_(v); }
            __syncthreads();
            float acc[9];
#pragma unroll
            for (int r = 0; r < 9; ++r) acc[r] = 0.f;
            const float* w = IN(I_ADAW) + (size_t)l * 1024 * MODW + j0 + X.lane;
#pragma unroll 8
            for (int k = X.wave * 128; k < X.wave * 128 + 128; ++k) { const float wv = __builtin_nontemporal_load(w + (size_t)k * MODW);
#pragma unroll
                for (int r = 0; r < 9; ++r) acc[r] += sc[r * 1024 + k] * wv; }
#pragma unroll
            for (int r = 0; r < 9; ++r) red[(X.wave * 9 + r) * 64 + X.lane] = acc[r];
            __syncthreads();
            for (int t = X.tid; t < 9 * 64; t += NTHREADS) { const int r = t >> 6, cidx = t & 63; float s = 0.f;
#pragma unroll
                for (int w8 = 0; w8 < 8; ++w8) s += red[(w8 * 9 + r) * 64 + cidx];
                MOD[((size_t)l * 9 + r) * MODW + j0 + cidx] = s + IN(I_ADAB)[l * MODW + j0 + cidx]; }
            __syncthreads();
        }
    }
    PMARK(21);
    LAS float* scr = (LAS float*)(X.lds + X.wave * 16384);
    bf16* WinT = (bf16*)(X.ws + WS_WINT); bf16* WoutT = (bf16*)(X.ws + WS_WOUTT); bf16* GWinT = (bf16*)(X.ws + WS_GWINT); bf16* GWoutT = (bf16*)(X.ws + WS_GWOUTT);
    bf16* W1T = (bf16*)(X.ws + WS_W1T); bf16* W2T = (bf16*)(X.ws + WS_W2T);
    constexpr int I_IN = 16 * (EVEN_IN / 32), I_OUT = 16 * 32, I_GIN = 16 * 64, I_GOUT = 16 * 32;
    constexpr int NITEMS = I_IN + I_OUT + I_GIN + I_GOUT;
    auto item_of = [&](int it) -> TrItem {
        int r = it; TrItem t; t.fp8 = 0;
        if (r < I_IN) { const int kb = r / 56, nd = (r % 56) * 32; const int ns = nd < 1024 ? pair_src(nd, 512) : nd; t.N = EVEN_IN; t.src = IN(I_EWIN) + (size_t)kb * 64 * EVEN_IN + ns; t.dst = WinT + (size_t)nd * 1024 + kb * 64; return t; } r -= I_IN;
        if (r < I_OUT) { const int kb = r >> 5, nd = (r & 31) * 32; t.N = 1024; t.src = IN(I_EWOUT) + (size_t)kb * 64 * 1024 + nd; t.dst = WoutT + (size_t)nd * 1024 + kb * 64; return t; } r -= I_OUT;
        if (r < I_GIN) { const int kb = r >> 6, nd = (r & 63) * 32; t.N = 2048; t.src = IN(I_OWIN) + (size_t)kb * 64 * 2048 + nd; t.dst = GWinT + (size_t)nd * 1024 + kb * 64; return t; } r -= I_GIN;
        { const int kb = r >> 5, nd = (r & 31) * 32; t.N = 1024; t.src = IN(I_OWOUT) + (size_t)kb * 64 * 1024 + nd; t.dst = GWoutT + (size_t)nd * 1024 + kb * 64; return t; }
    };
    {
        float va[32], vb[32]; int it = X.gw;
        TrItem ta, tb; if (it < NITEMS) { ta = item_of(it); tr_load(ta, va, X.lane); }
        while (it < NITEMS) {
            const int it1 = it + X.NGW; if (it1 < NITEMS) { tb = item_of(it1); tr_load(tb, vb, X.lane); }
            tr_store(ta, va, scr, X.lane);
            if (it1 >= NITEMS) break;
            const int it2 = it1 + X.NGW; if (it2 < NITEMS) { ta = item_of(it2); tr_load(ta, va, X.lane); }
            tr_store(tb, vb, scr, X.lane);
            it = it2;
        }
    }
    __syncthreads();
    if (with_moe) phase_moe_convert(X, X.vcu, X.G);
    PMARK(22);
    { bf16* WsB = (bf16*)(X.ws + WS_WSB); const float* ws = IN(I_OWS);
      for (int i = (X.gw * 64 + X.lane) * 4; i < 8 * 128 * 128; i += X.NGW * 64 * 4) { const f32x4 v = *(const f32x4*)(ws + i); u32x2 o; o.x = pk2(v[0], v[1]); o.y = pk2(v[2], v[3]); *(u32x2*)(WsB + i) = o; } }
}

__device__ __forceinline__ void modulate_row(const float* xrow, const float* g, const float* sh, const float* sc, bf16* orow, int lane, f32x4 (&y)[4]) {
    const f32x4* xr = (const f32x4*)xrow + lane; f32x4 v[4]; float ss = 0.f;
#pragma unroll
    for (int j = 0; j < 4; ++j) { v[j] = xr[64 * j]; ss += (v[j][0] * v[j][0] + v[j][1] * v[j][1]) + (v[j][2] * v[j][2] + v[j][3] * v[j][3]); }
    const float rstd = rsqrtf(wave_sum(ss) * (1.0f / D) + EPS);
#pragma unroll
    for (int j = 0; j < 4; ++j) { const f32x4 gk = ((const f32x4*)g)[lane + 64 * j], sk = ((const f32x4*)sc)[lane + 64 * j], hk = ((const f32x4*)sh)[lane + 64 * j];
        y[j] = v[j] * rstd * gk * (1.0f + sk) + hk;
        u32x2 o; o.x = pk2(y[j][0], y[j][1]); o.y = pk2(y[j][2], y[j][3]); *((u32x2*)orow + lane + 64 * j) = o; }
}
__device__ __forceinline__ void mod0_load(const Ctx& X, int row, f32x4 (&v)[4]) {
    const float* xrow = row < NTOK ? IN(I_X) + (size_t)row * D : IN(I_CTX) + (size_t)(row - NTOK) * D;
#pragma unroll
    for (int j = 0; j < 4; ++j) v[j] = ((const f32x4*)xrow)[X.lane + 64 * j];
}
__device__ __forceinline__ void mod0_finish(const Ctx& X, int row, const f32x4 (&v)[4]) {
    const float* m = (const float*)(X.ws + WS_MOD) + (size_t)(row < NTOK ? row / SEQ : 8) * MODW; const float* g = IN(I_NMG);
    bf16* orow = row < NTOK ? (bf16*)(X.ws + WS_XA) + (size_t)row * D : (bf16*)(X.ws + WS_GM) + (size_t)(row - NTOK) * D;
    f32x4 gk[4], hk[4], sk[4]; float ss = 0.f;
#pragma unroll
    for (int j = 0; j < 4; ++j) { gk[j] = ((const f32x4*)g)[X.lane + 64 * j]; hk[j] = ((const f32x4*)m)[X.lane + 64 * j]; sk[j] = ((const f32x4*)(m + 1024))[X.lane + 64 * j];
        ss += (v[j][0] * v[j][0] + v[j][1] * v[j][1]) + (v[j][2] * v[j][2] + v[j][3] * v[j][3]); }
    const float rstd = rsqrtf(wave_sum(ss) * (1.0f / D) + EPS);
#pragma unroll
    for (int j = 0; j < 4; ++j) { const f32x4 y = v[j] * rstd * gk[j] * (1.0f + sk[j]) + hk[j]; u32x2 o; o.x = pk2(y[0], y[1]); o.y = pk2(y[2], y[3]); *((u32x2*)orow + X.lane + 64 * j) = o; }
}
__device__ __forceinline__ void phase_modulate0(const Args& a, const Ctx& X) {
    constexpr int NR = NTOK + NCTX; f32x4 va[4], vb[4];
    int row = X.gw; if (row < NR) mod0_load(X, row, va);
    while (row < NR) {
        const int r1 = row + X.NGW; if (r1 < NR) mod0_load(X, r1, vb);
        mod0_finish(X, row, va);
        if (r1 >= NR) break;
        const int r2 = r1 + X.NGW; if (r2 < NR) mod0_load(X, r2, va);
        mod0_finish(X, r1, vb);
        row = r2;
    }
}

__device__ __forceinline__ void qk_chunks(bf16* buf, int nchunks, int rowlen, const float* gn, bool rope, float oscale, const Ctx& X, const LAS f32x2* cs) {
    for (int ch = X.gw; ch < nchunks; ch += X.NGW) {
        const int e0 = ch * 512 + 8 * X.lane; const int token = e0 / rowlen; const int d0 = e0 & 63;
        u32x4 raw = *(const u32x4*)(buf + e0); float v[8];
#pragma unroll
        for (int i = 0; i < 4; ++i) { v[2 * i] = bf2f(raw[i] & 0xffffu); v[2 * i + 1] = bf2f(raw[i] >> 16); }
        float ss = 0.f;
#pragma unroll
        for (int i = 0; i < 8; ++i) ss += v[i] * v[i];
        ss += __shfl_xor(ss, 1); ss += __shfl_xor(ss, 2); ss += __shfl_xor(ss, 4);
        const float rstd = rsqrtf(ss * (1.0f / 64.0f) + EPS);
        const f32x4 g0 = *(const f32x4*)(gn + d0), g1 = *(const f32x4*)(gn + d0 + 4);
#pragma unroll
        for (int i = 0; i < 4; ++i) { v[i] = v[i] * rstd * g0[i]; v[4 + i] = v[4 + i] * rstd * g1[i]; }
        if (rope) {
            const int t = token % SEQ; const int dd0 = d0 & 31; const int pos = dd0 < 16 ? (t >> 6) : (t & 63);
            const LAS f32x2* cp = cs + pos * 16 + (dd0 & 15);
#pragma unroll
            for (int i = 0; i < 8; ++i) { const float pv = __shfl_xor(v[i], 4); const f32x2 c = cp[i];
                v[i] = (d0 < 32) ? (v[i] * c.x - pv * c.y) : (v[i] * c.x + pv * c.y); }
        }
        u32x4 o; o.x = pk2(v[0] * oscale, v[1] * oscale); o.y = pk2(v[2] * oscale, v[3] * oscale); o.z = pk2(v[4] * oscale, v[5] * oscale); o.w = pk2(v[6] * oscale, v[7] * oscale);
        *(u32x4*)(buf + e0) = o;
    }
}
__device__ __forceinline__ void phase_conv_qk(const Args& a, const Ctx& X) {
    LAS f32x2* cs = (LAS f32x2*)(X.lds + 65536);
    for (int i = X.tid; i < 1024; i += NTHREADS) { const float inv = exp2f(-(float)(i & 15) * (13.287712379549449f / 16.0f)); float sn, csn; sincosf((float)(i >> 4) * inv, &sn, &csn); cs[i] = (f32x2){csn, sn}; }
    __syncthreads();
    qk_chunks((bf16*)(X.ws + WS_Q), NTOK, 512, IN(I_QNG), true, QSCALE, X, cs);
    qk_chunks((bf16*)(X.ws + WS_K), NTOK / 4, 128, IN(I_KNG), true, 1.0f, X, cs);
    qk_chunks((bf16*)(X.ws + WS_KC), NCTX / 4, 128, IN(I_KNG), false, 1.0f, X, cs);
    const bf16* GLU = (const bf16*)(X.ws + WS_GLU); bf16* MIX = (bf16*)(X.ws + WS_MIX);
    LAS unsigned* tin = (LAS unsigned*)X.lds;
    LAS float* tout = (LAS float*)(X.lds + 65536);
    const int cp = X.tid & 255, th = X.tid >> 8;
    float w0[31], w1[31];
#pragma unroll
    for (int j = 0; j < 31; ++j) { const f32x2 w = *(const f32x2*)(IN(I_ECW) + j * 512 + 2 * cp); w0[j] = w.x; w1[j] = w.y; }
    const f32x2 cb = *(const f32x2*)(IN(I_ECB) + 2 * cp);
    for (int tile = X.bid; tile < NTOK / 32; tile += X.G) {
        const int row0 = tile * 32; const int t0 = row0 % SEQ;
        __syncthreads();
        for (int c = X.tid; c < 62 * 64; c += NTHREADS) { const int lr = c >> 6, cc = c & 63; const int t = t0 - 15 + lr;
            u32x4 v = (u32x4){0u, 0u, 0u, 0u}; if (t >= 0 && t < SEQ) v = *(const u32x4*)(GLU + (size_t)(row0 - 15 + lr) * 512 + cc * 8);
            *(LAS u32x4*)(tin + lr * 256 + cc * 4) = v; }
        __syncthreads();
        float a0[16], a1[16];
#pragma unroll
        for (int o = 0; o < 16; ++o) { a0[o] = cb.x; a1[o] = cb.y; }
#pragma unroll
        for (int rr = 0; rr < 46; ++rr) { const unsigned pv = tin[(16 * th + rr) * 256 + cp]; const float x0 = bf2f(pv & 0xffffu), x1 = bf2f(pv >> 16);
#pragma unroll
            for (int o = 0; o < 16; ++o) { const int j = rr - o; if (j >= 0 && j <= 30) { a0[o] += x0 * w0[j]; a1[o] += x1 * w1[j]; } } }
#pragma unroll
        for (int o = 0; o < 16; ++o) *(LAS f32x2*)(tout + (16 * th + o) * 512 + 2 * cp) = (f32x2){a0[o], a1[o]};
        __syncthreads();
#pragma unroll
        for (int q = 0; q < 4; ++q) { const int tl = X.wave * 4 + q; f32x4 v[2]; float s = 0.f;
#pragma unroll
            for (int j = 0; j < 2; ++j) { v[j] = *(const LAS f32x4*)(tout + tl * 512 + 4 * X.lane + 256 * j); s += (v[j][0] + v[j][1]) + (v[j][2] + v[j][3]); }
            const float mean = wave_sum(s) * (1.0f / 512.0f); float s2 = 0.f;
#pragma unroll
            for (int j = 0; j < 2; ++j) { v[j] = v[j] - mean; s2 += (v[j][0] * v[j][0] + v[j][1] * v[j][1]) + (v[j][2] * v[j][2] + v[j][3] * v[j][3]); }
            const float rstd = rsqrtf(wave_sum(s2) * (1.0f / 512.0f) + EPS);
#pragma unroll
            for (int j = 0; j < 2; ++j) { const f32x4 g = *(const f32x4*)(IN(I_ELNG) + 4 * X.lane + 256 * j), b = *(const f32x4*)(IN(I_ELNB) + 4 * X.lane + 256 * j);
                f32x4 y = v[j] * rstd * g + b;
#pragma unroll
                for (int k = 0; k < 4; ++k) y[k] = y[k] * sigmoidf_(y[k]);
                u32x2 o; o.x = pk2(y[0], y[1]); o.y = pk2(y[2], y[3]); *(u32x2*)(MIX + (size_t)(row0 + tl) * D + 4 * X.lane + 256 * j) = o; } }
    }
}

__device__ __forceinline__ void phase_attention(const Args& a, const Ctx& X) {
    unsigned char* const wsb = X.ws;
    LAS unsigned char* Ks = X.lds;
    LAS unsigned char* Vt = X.lds + 16384;
    const int lane = X.lane, l15 = lane & 15, g4 = lane >> 4;
    for (int unit = X.bid; unit < NB * 2 * 32; unit += X.G) {
        const int b = unit >> 6, kh = (unit >> 5) & 1, qb = unit & 31; const int q0 = qb * 64;
        const int hq = kh * 4 + (X.wave >> 1), tq = (X.wave & 1) * 32;
        bf16x8 Qf[2][2];
#pragma unroll
        for (int qi = 0; qi < 2; ++qi)
#pragma unroll
            for (int s = 0; s < 2; ++s) Qf[qi][s] = *(const bf16x8*)(wsb + (unsigned)(WS_Q + 2u * (unsigned)((b * SEQ + q0 + tq + 16 * qi + l15) * 512 + hq * 64 + 32 * s + 8 * g4)));
        const float sink2 = IN(I_SINK)[hq] * LOG2E;
        float mrun[2], lrun[2]; f32x4 O[2][4];
#pragma unroll
        for (int qi = 0; qi < 2; ++qi) { mrun[qi] = sink2; lrun[qi] = (g4 == 0) ? 1.0f : 0.0f;
#pragma unroll
            for (int db = 0; db < 4; ++db) O[qi][db] = (f32x4){0.f, 0.f, 0.f, 0.f}; }
        const int t_first = (q0 >= 128) ? 0 : (q0 >= 64 ? 1 : 2), t_skip_lo = (q0 + 128 < SEQ) ? 5 : (q0 + 64 < SEQ ? 4 : 3);
        const int key = X.tid >> 3, ch = X.tid & 7;
        auto tile_offs = [&](int t, unsigned& ko, unsigned& vo) {
            if (t < 5) { const unsigned e = (unsigned)((b * SEQ + q0 - 128 + 64 * t) * 128 + kh * 64) * 2u; ko = (unsigned)WS_K + e; vo = (unsigned)WS_V + e; }
            else { const unsigned e = (unsigned)((b * CTXL + (t - 5) * 64) * 128 + kh * 64) * 2u; ko = (unsigned)WS_KC + e; vo = (unsigned)WS_VC + e; } };
        const unsigned lane_off = (unsigned)(key * 128 + ch * 8) * 2u;
        auto lds_put = [&](int buf, const u32x4& kv, const u32x4& vv) {
            LAS unsigned char* Kd = Ks + buf * 32768; LAS unsigned char* Vd = Vt + buf * 32768;
            *(LAS u32x4*)(Kd + key * 144 + ch * 16) = kv;
#pragma unroll
            for (int i = 0; i < 4; ++i) { *(LAS unsigned short*)(Vd + (8 * ch + 2 * i) * 136 + key * 2) = (unsigned short)(vv[i] & 0xffffu); *(LAS unsigned short*)(Vd + (8 * ch + 2 * i + 1) * 136 + key * 2) = (unsigned short)(vv[i] >> 16); } };
        u32x4 kreg, vreg;
        { unsigned ko, vo; tile_offs(t_first, ko, vo); kreg = *(const u32x4*)(wsb + (ko + lane_off)); vreg = *(const u32x4*)(wsb + (vo + lane_off)); }
        __syncthreads();
        lds_put(0, kreg, vreg);
        int bufi = 0;
        for (int t = t_first; t < 9; ++t) {
            if (t >= t_skip_lo && t < 5) continue;
            int tn = t + 1; if (tn >= t_skip_lo && tn < 5) tn = 5;
            if (tn < 9) { unsigned ko, vo; tile_offs(tn, ko, vo); kreg = *(const u32x4*)(wsb + (ko + lane_off)); vreg = *(const u32x4*)(wsb + (vo + lane_off)); }
            const int mode = (t == 0) ? 1 : (t == 4 ? 2 : 0);
            __syncthreads();
            const LAS unsigned char* Kc = Ks + bufi * 32768; const LAS unsigned char* Vc = Vt + bufi * 32768;
            bf16x8 kf[4][2];
#pragma unroll
            for (int kb = 0; kb < 4; ++kb)
#pragma unroll
                for (int s = 0; s < 2; ++s) kf[kb][s] = *(const LAS bf16x8*)(Kc + (16 * kb + l15) * 144 + (32 * s + 8 * g4) * 2);
            bf16x8 vf[4][2];
#pragma unroll
            for (int db = 0; db < 4; ++db)
#pragma unroll
                for (int ks2 = 0; ks2 < 2; ++ks2) { const LAS unsigned char* p = Vc + (16 * db + l15) * 136 + (32 * ks2 + 4 * g4) * 2;
                    const u32x2 lo = *(const LAS u32x2*)p, hi = *(const LAS u32x2*)(p + 32);
                    u32x4 w; w.x = lo.x; w.y = lo.y; w.z = hi.x; w.w = hi.y; vf[db][ks2] = __builtin_bit_cast(bf16x8, w); }
#pragma unroll
            for (int qi = 0; qi < 2; ++qi) {
                f32x4 st[4];
#pragma unroll
                for (int kb = 0; kb < 4; ++kb) { st[kb] = (f32x4){0.f, 0.f, 0.f, 0.f};
#pragma unroll
                    for (int s = 0; s < 2; ++s) st[kb] = __builtin_amdgcn_mfma_f32_16x16x32_bf16(kf[kb][s], Qf[qi][s], st[kb], 0, 0, 0); }
                if (mode) { int qloc = tq + 16 * qi + l15; asm volatile("" : "+v"(qloc));
#pragma unroll
                    for (int kb = 0; kb < 4; ++kb)
#pragma unroll
                        for (int r = 0; r < 4; ++r) { const int kk = 16 * kb + 4 * g4 + r; const bool keep = (mode == 1) ? (kk >= qloc) : (kk <= qloc); if (!keep) st[kb][r] = -1e30f; } }
                float mx = st[0][0];
#pragma unroll
                for (int kb = 0; kb < 4; ++kb)
#pragma unroll
                    for (int r = 0; r < 4; ++r) mx = fmaxf(mx, st[kb][r]);
                mx = fmaxf(mx, __shfl_xor(mx, 16)); mx = fmaxf(mx, __shfl_xor(mx, 32));
                const float mnew = fmaxf(mrun[qi], mx); const float alpha = __builtin_amdgcn_exp2f(mrun[qi] - mnew); mrun[qi] = mnew;
                float ps = 0.f;
#pragma unroll
                for (int kb = 0; kb < 4; ++kb)
#pragma unroll
                    for (int r = 0; r < 4; ++r) { st[kb][r] = __builtin_amdgcn_exp2f(st[kb][r] - mnew); ps += st[kb][r]; }
                lrun[qi] = lrun[qi] * alpha + ps;
#pragma unroll
                for (int db = 0; db < 4; ++db) O[qi][db] = O[qi][db] * alpha;
#pragma unroll
                for (int ks2 = 0; ks2 < 2; ++ks2) { u32x4 w; w.x = pk2(st[2 * ks2][0], st[2 * ks2][1]); w.y = pk2(st[2 * ks2][2], st[2 * ks2][3]); w.z = pk2(st[2 * ks2 + 1][0], st[2 * ks2 + 1][1]); w.w = pk2(st[2 * ks2 + 1][2], st[2 * ks2 + 1][3]);
                    const bf16x8 pf = __builtin_bit_cast(bf16x8, w);
#pragma unroll
                    for (int db = 0; db < 4; ++db) O[qi][db] = __builtin_amdgcn_mfma_f32_16x16x32_bf16(vf[db][ks2], pf, O[qi][db], 0, 0, 0); }
            }
            if (tn < 9) lds_put(bufi ^ 1, kreg, vreg);
            bufi ^= 1;
        }
#pragma unroll
        for (int qi = 0; qi < 2; ++qi) { float l = lrun[qi]; l += __shfl_xor(l, 16); l += __shfl_xor(l, 32); const float inv = 1.0f / l;
            bf16* orow = (bf16*)(wsb + (unsigned)(WS_MIX + 2u * (unsigned)((b * SEQ + q0 + tq + 16 * qi + l15) * D + 512 + hq * 64 + 4 * g4)));
#pragma unroll
            for (int db = 0; db < 4; ++db) { u32x2 o; o.x = pk2(O[qi][db][0] * inv, O[qi][db][1] * inv); o.y = pk2(O[qi][db][2] * inv, O[qi][db][3] * inv); *(u32x2*)(orow + 16 * db) = o; } }
    }
}

__device__ __forceinline__ void phase_router(const Args& a, const Ctx& X, int layer) {
    const bf16* __restrict__ H = (const bf16*)(X.ws + WS_H); unsigned char* XA8 = (unsigned char*)(X.ws + WS_XA8);
    const float* MODl = (const float*)(X.ws + WS_MOD) + (size_t)layer * 9 * MODW; const float* gn = IN(I_NFG) + layer * D;
    const float* rw = IN(I_RW) + (size_t)layer * D * NE; const float* rb = IN(I_RB) + layer * NE;
    int* cntg = (int*)(X.ws + WS_CTL) + CW_CNT + layer * NE * CNT_STRIDE; int* list = (int*)(X.ws + WS_LIST); float* gatew = (float*)(X.ws + WS_GATE);
    constexpr int YS = 1028;
    LAS float* ybuf = (LAS float*)X.lds;
    LAS float* part = (LAS float*)(X.lds + 66048);
    LAS int* sel = (LAS int*)(X.lds + 66048 + 16384);
    LAS int* lcnt = (LAS int*)(X.lds + 66048 + 16384 + 1024);
    LAS float* lgs = (LAS float*)(X.lds + 66048 + 16384 + 2048);
    LAS float* tvs = lgs + 512;
    LAS float* exs = lgs + 528;
    PMARK(0);
    const int e = X.lane & 31, hf = X.lane >> 5;
    const int e16 = X.lane & 15, kq = X.lane >> 4;
    float wreg[32][2];
#pragma unroll
    for (int s = 0; s < 32; ++s)
#pragma unroll
        for (int nb = 0; nb < 2; ++nb) wreg[s][nb] = rw[(size_t)(128 * X.wave + 4 * s + kq) * NE + 16 * nb + e16];
    const float rbe = rb[e];
    for (int blk = X.bid; blk < NTOK / 64; blk += X.G) {
        const int rowbase = blk * 64; const float* m = MODl + (size_t)(rowbase / SEQ) * MODW;
        f32x4 gk[4], hk[4], xv[2][4];
#pragma unroll
        for (int j = 0; j < 4; ++j) { gk[j] = ((const f32x4*)gn)[X.lane + 64 * j]; hk[j] = ((const f32x4*)(m + 3 * 1024))[X.lane + 64 * j]; const f32x4 s_ = ((const f32x4*)(m + 4 * 1024))[X.lane + 64 * j]; gk[j] = gk[j] * (1.0f + s_); }
#pragma unroll
        for (int i = 0; i < 2; ++i)
#pragma unroll
            for (int j = 0; j < 4; ++j) { const u32x2 w = ((const u32x2*)(H + (size_t)(rowbase + 2 * X.wave + i) * D))[X.lane + 64 * j]; xv[i][j] = (f32x4){bf2f(w.x & 0xffffu), bf2f(w.x >> 16), bf2f(w.y & 0xffffu), bf2f(w.y >> 16)}; }
        __syncthreads();
        if (X.tid < 64) lcnt[X.tid] = 0;
        PMARK(1);
#pragma unroll 1
        for (int bt = 0; bt < 4; ++bt) {
#pragma unroll
            for (int i = 0; i < 2; ++i) { const int rl = 2 * X.wave + i, row = rowbase + 16 * bt + rl; float ss = 0.f;
#pragma unroll
                for (int j = 0; j < 4; ++j) ss += (xv[i][j][0] * xv[i][j][0] + xv[i][j][1] * xv[i][j][1]) + (xv[i][j][2] * xv[i][j][2] + xv[i][j][3] * xv[i][j][3]);
                const float rstd = rsqrtf(wave_sum(ss) * (1.0f / D) + EPS);
#pragma unroll
                for (int j = 0; j < 4; ++j) { const f32x4 y = xv[i][j] * rstd * gk[j] + hk[j];
                    *((unsigned*)(XA8 + (size_t)row * D) + X.lane + 64 * j) = pk4_fp8(y[0] * FP8_AMUL, y[1] * FP8_AMUL, y[2] * FP8_AMUL, y[3] * FP8_AMUL);
                    *(LAS f32x4*)(ybuf + rl * YS + 4 * X.lane + 256 * j) = y; } }
            if (bt < 3) {
#pragma unroll
                for (int i = 0; i < 2; ++i)
#pragma unroll
                    for (int j = 0; j < 4; ++j) { const u32x2 w = ((const u32x2*)(H + (size_t)(rowbase + 16 * (bt + 1) + 2 * X.wave + i) * D))[X.lane + 64 * j]; xv[i][j] = (f32x4){bf2f(w.x & 0xffffu), bf2f(w.x >> 16), bf2f(w.y & 0xffffu), bf2f(w.y >> 16)}; }
            }
            __syncthreads();
            { f32x4 acc0 = (f32x4){0.f, 0.f, 0.f, 0.f}, acc1 = acc0; const LAS float* yp = ybuf + e16 * YS + 128 * X.wave + kq;
#pragma unroll
              for (int s = 0; s < 32; ++s) { const float av = yp[4 * s];
                  acc0 = __builtin_amdgcn_mfma_f32_16x16x4f32(av, wreg[s][0], acc0, 0, 0, 0); acc1 = __builtin_amdgcn_mfma_f32_16x16x4f32(av, wreg[s][1], acc1, 0, 0, 0); }
#pragma unroll
              for (int r = 0; r < 4; ++r) { part[((4 * kq + r) * 8 + X.wave) * 32 + e16] = acc0[r]; part[((4 * kq + r) * 8 + X.wave) * 32 + 16 + e16] = acc1[r]; } }
            __syncthreads();
            { const int r = 2 * X.wave + hf, rl = 16 * bt + r;
              float v = rbe;
#pragma unroll
              for (int w8 = 0; w8 < 8; ++w8) v += part[(r * 8 + w8) * 32 + e];
              lgs[r * 32 + e] = v; LDS_WAIT();
              int ez = e; asm volatile("" : "+v"(ez));
              int rank = 0;
#pragma unroll
              for (int j4 = 0; j4 < 8; ++j4) { const f32x4 o = *(const LAS f32x4*)(lgs + r * 32 + 4 * j4);
#pragma unroll
                  for (int c = 0; c < 4; ++c) rank += (o[c] > v || (o[c] == v && (4 * j4 + c) < ez)) ? 1 : 0; }
              if (rank == 0) tvs[r] = v;
              LDS_WAIT();
              const float ex = __expf(v - tvs[r]);
              if (rank < 4) exs[r * 4 + rank] = ex;
              LDS_WAIT();
              const f32x4 e4 = *(const LAS f32x4*)(exs + r * 4); const float inv = 1.0f / ((e4[0] + e4[1]) + (e4[2] + e4[3]));
              if (rank < 4) { const int slot = atomicAdd((int*)&lcnt[e], 1); sel[rl * 4 + rank] = (e << 16) | slot; gatew[(size_t)(rowbase + rl) * 4 + rank] = ex * inv; } }
        }
        __syncthreads();
        PMARK(2);
        if (X.tid < 32) lcnt[32 + X.tid] = atomicAdd(cntg + X.tid * CNT_STRIDE, lcnt[X.tid]);
        __syncthreads();
        if (X.tid < 256) { const int w = sel[X.tid]; const int ee = w >> 16, rank = w & 0xffff; list[(size_t)ee * NTOK + lcnt[32 + ee] + rank] = rowbase * 4 + X.tid; }
    }
    PMARK(3);
}

__device__ __forceinline__ void phase_combine(const Args& a, const Ctx& X, int layer) {
    bf16* H = (bf16*)(X.ws + WS_H); const bf16* __restrict__ Y = (const bf16*)(X.ws + WS_Y); bf16* XA = (bf16*)(X.ws + WS_XA);
    const float* __restrict__ MODl = (const float*)(X.ws + WS_MOD) + (size_t)layer * 9 * MODW;
    float* outp = (float*)(__attribute__((address_space(1))) float*)X.kp[33];
    for (int row = X.gw; row < NTOK; row += X.NGW) {
        const float* gt = MODl + (size_t)(row / SEQ) * MODW + 5 * 1024; f32x4 h[2][2], g[2][2]; u32x4 yw[2][4];
#pragma unroll
        for (int j = 0; j < 2; ++j) { const int c0 = 8 * X.lane + 512 * j;
#pragma unroll
            for (int q = 0; q < 2; ++q) g[j][q] = *(const f32x4*)(gt + c0 + 4 * q);
            { const u32x4 w = *(const u32x4*)(H + (size_t)row * D + c0); h[j][0] = (f32x4){bf2f(w.x & 0xffffu), bf2f(w.x >> 16), bf2f(w.y & 0xffffu), bf2f(w.y >> 16)}; h[j][1] = (f32x4){bf2f(w.z & 0xffffu), bf2f(w.z >> 16), bf2f(w.w & 0xffffu), bf2f(w.w >> 16)}; }
#pragma unroll
            for (int k = 0; k < 4; ++k) yw[j][k] = *(const u32x4*)(Y + ((size_t)row * 4 + k) * D + c0); }
        float ss = 0.f;
#pragma unroll
        for (int j = 0; j < 2; ++j) { f32x4 s0 = (f32x4){0.f, 0.f, 0.f, 0.f}, s1 = s0;
#pragma unroll
            for (int k = 0; k < 4; ++k) { const u32x4 w = yw[j][k]; s0 += (f32x4){bf2f(w.x & 0xffffu), bf2f(w.x >> 16), bf2f(w.y & 0xffffu), bf2f(w.y >> 16)}; s1 += (f32x4){bf2f(w.z & 0xffffu), bf2f(w.z >> 16), bf2f(w.w & 0xffffu), bf2f(w.w >> 16)}; }
            h[j][0] = h[j][0] + g[j][0] * s0; h[j][1] = h[j][1] + g[j][1] * s1;
#pragma unroll
            for (int q = 0; q < 2; ++q) ss += (h[j][q][0] * h[j][q][0] + h[j][q][1] * h[j][q][1]) + (h[j][q][2] * h[j][q][2] + h[j][q][3] * h[j][q][3]); }
        if (layer == 1) {
#pragma unroll
            for (int j = 0; j < 2; ++j)
#pragma unroll
                for (int q = 0; q < 2; ++q) *(f32x4*)(outp + (size_t)row * D + 8 * X.lane + 512 * j + 4 * q) = h[j][q];
        } else {
            const float* m1 = (const float*)(X.ws + WS_MOD) + (size_t)9 * MODW + (size_t)(row / SEQ) * MODW; const float* gn = IN(I_NMG) + D;
            f32x4 gk[2][2], hk[2][2], sk[2][2];
#pragma unroll
            for (int j = 0; j < 2; ++j)
#pragma unroll
                for (int q = 0; q < 2; ++q) { const int c0 = 8 * X.lane + 512 * j + 4 * q; gk[j][q] = *(const f32x4*)(gn + c0); hk[j][q] = *(const f32x4*)(m1 + c0); sk[j][q] = *(const f32x4*)(m1 + 1024 + c0); }
            const float rstd = rsqrtf(wave_sum(ss) * (1.0f / D) + EPS);
#pragma unroll
            for (int j = 0; j < 2; ++j) { const int c0 = 8 * X.lane + 512 * j;
                const f32x4 y0 = h[j][0] * rstd * gk[j][0] * (1.0f + sk[j][0]) + hk[j][0], y1 = h[j][1] * rstd * gk[j][1] * (1.0f + sk[j][1]) + hk[j][1];
                *(u32x4*)(H + (size_t)row * D + c0) = pack8(h[j][0], h[j][1]);
                *(u32x4*)(XA + (size_t)row * D + c0) = pack8(y0, y1); }
        }
    }
}

__device__ __forceinline__ void phase_spatial(const Args& a, const Ctx& X) {
    const bf16* U = (const bf16*)(X.ws + WS_U); const bf16* VB = (const bf16*)(X.ws + WS_VB); bf16* SG = (bf16*)(X.ws + WS_MIX); const bf16* WsB = (const bf16*)(X.ws + WS_WSB); const float* vstat = (const float*)(X.ws + WS_CTL) + CW_VSTAT;
    LAS unsigned char* Vt = X.lds + 4096;
    const int lane = X.lane, l15 = lane & 15, g4 = lane >> 4;
    const int q0 = X.tid >> 4, cc = X.tid & 15;
    int item = X.bid; const int nitems = 128 * 8;
    const bool same_g = (X.G & 7) == 0;
    bf16x8 bfr[4][8]; int gcur = -1;
    u32x4 vraw[4]; f32x2 st[4];
    auto fetch = [&](int it) { const int chunk = it >> 3, g = it & 7; const int row0 = chunk * 128;
#pragma unroll
        for (int i = 0; i < 4; ++i) { const int q = q0 + 32 * i; vraw[i] = *(const u32x4*)(VB + (size_t)(row0 + q) * D + g * 128 + cc * 8); st[i] = *(const f32x2*)(vstat + 2 * (row0 + q)); } };
    if (item < nitems) fetch(item);
    for (; item < nitems; item += X.G) {
        const int chunk = item >> 3, g = item & 7; const int row0 = chunk * 128;
        if (g != gcur) { gcur = g;
#pragma unroll
            for (int s = 0; s < 4; ++s)
#pragma unroll
                for (int pb = 0; pb < 8; ++pb) bfr[s][pb] = *(const bf16x8*)(WsB + ((size_t)g * 128 + 16 * pb + l15) * 128 + 32 * s + 8 * g4); }
        const float* lg_ = IN(I_OLNG) + g * 128 + cc * 8; const float* lb_ = IN(I_OLNB) + g * 128 + cc * 8;
        __syncthreads();
        float mean[4], rstd[4];
#pragma unroll
        for (int i = 0; i < 4; ++i) { mean[i] = st[i].x * (1.0f / D); const float var = fmaxf(st[i].y * (1.0f / D) - mean[i] * mean[i], 0.f); rstd[i] = rsqrtf(var + EPS); }
#pragma unroll
        for (int kh = 0; kh < 2; ++kh) { const f32x4 lgv = *(const f32x4*)(lg_ + 4 * kh), lbv = *(const f32x4*)(lb_ + 4 * kh);
#pragma unroll
            for (int i = 0; i < 4; ++i) { const int q = q0 + 32 * i;
#pragma unroll
                for (int k2 = 0; k2 < 2; ++k2) { const int k = 2 * kh + k2; const unsigned wv = vraw[i][k];
                    const float y0 = (bf2f(wv & 0xffffu) - mean[i]) * rstd[i] * lgv[2 * k2] + lbv[2 * k2], y1 = (bf2f(wv >> 16) - mean[i]) * rstd[i] * lgv[2 * k2 + 1] + lbv[2 * k2 + 1];
                    const unsigned pk = pk2(y0, y1);
                    *(LAS unsigned short*)(Vt + ((2 * k) * 17 + cc) * 272 + q * 2) = (unsigned short)(pk & 0xffffu); *(LAS unsigned short*)(Vt + ((2 * k + 1) * 17 + cc) * 272 + q * 2) = (unsigned short)(pk >> 16); } } }
        if (item + X.G < nitems) fetch(item + X.G);
        __syncthreads();
#pragma unroll
        for (int hp = 0; hp < 2; ++hp) {
            u32x2 uw[4];
#pragma unroll
            for (int pq = 0; pq < 4; ++pq) uw[pq] = *(const u32x2*)(U + (size_t)(row0 + 16 * (4 * hp + pq) + l15) * D + g * 128 + 16 * X.wave + 4 * g4);
            f32x4 acc[4];
#pragma unroll
            for (int pq = 0; pq < 4; ++pq) acc[pq] = (f32x4){0.f, 0.f, 0.f, 0.f};
#pragma unroll
            for (int s = 0; s < 4; ++s) { const bf16x8 af = *(const LAS bf16x8*)(Vt + ((l15 & 7) * 17 + 2 * X.wave + (l15 >> 3)) * 272 + (32 * s + 8 * g4) * 2);
#pragma unroll
                for (int pq = 0; pq < 4; ++pq) acc[pq] = __builtin_amdgcn_mfma_f32_16x16x32_bf16(af, bfr[s][4 * hp + pq], acc[pq], 0, 0, 0); }
#pragma unroll
            for (int pq = 0; pq < 4; ++pq) { const int p = 16 * (4 * hp + pq) + l15; const float bs = IN(I_OBS)[g * 128 + p]; const size_t off = (size_t)(row0 + p) * D + g * 128 + 16 * X.wave + 4 * g4;
                u32x2 o; o.x = pk2(bf2f(uw[pq].x & 0xffffu) * (acc[pq][0] + bs), bf2f(uw[pq].x >> 16) * (acc[pq][1] + bs)); o.y = pk2(bf2f(uw[pq].y & 0xffffu) * (acc[pq][2] + bs), bf2f(uw[pq].y >> 16) * (acc[pq][3] + bs));
                *(u32x2*)(SG + off) = o; }
        }
    }
    (void)same_g;
}

enum { PH_PRO = 0, PH_MOD0, PH_GIN, PH_CONV, PH_ATT, PH_GOUT, PH_RT0, PH_M1_0, PH_M2_0, PH_CMB0, PH_GMI, PH_SPA, PH_GMO, PH_RT1, PH_M1_1, PH_M2_1, PH_CMB1, NPHASE };

__global__ void __launch_bounds__(NTHREADS, 2) mega(Args a) {
    extern __shared__ __attribute__((aligned(16))) unsigned char lds_raw[];
    Ctx X; X.lds = (LAS unsigned char*)lds_raw;
    const int wave0 = __builtin_amdgcn_readfirstlane((int)threadIdx.x >> 6);
    const int G0 = gridDim.x, bid0 = blockIdx.x; const int vcu0 = (G0 % 8 == 0) ? (bid0 % 8) * (G0 / 8) + bid0 / 8 : bid0;
    X.wave = wave0;
    volatile LAS unsigned* MISC = (volatile LAS unsigned*)(X.lds + MISC_OFF);
    if (threadIdx.x < 64) MISC[threadIdx.x] = 0u;
    __syncthreads();
    const int ph_lo = a.ph_lo, ph_hi = a.ph_hi;
    XcdBarrier bar = xcd_barrier_post((unsigned*)(a.ws + WS_CTL) + CW_BAR + a.li * XCD_BAR_WORDS, MISC + 8, (unsigned)G0, true);
    const int GA = G0 - GROUP_B;
    const bool grouped = (GROUP_B > 0) && ph_lo == 0 && ph_hi == NPHASE && GA >= 8 && (GA % 8) == 0;
    const int vcuA = (bid0 % 8) * (GA / 8) + bid0 / 8;
    XcdBarrier barA = xcd_barrier_post((unsigned*)(a.ws + WS_CTL) + CW_BAR + 19 * XCD_BAR_WORDS, MISC + 12, (unsigned)GA, grouped && bid0 < GA);
#if PROBE_PH >= 0
#define PROBE_STAMP(p) do { if ((p) == PROBE_PH) pr_t0 = __builtin_amdgcn_s_memrealtime(); if ((p) == PROBE_END) pr_t1 = __builtin_amdgcn_s_memrealtime(); } while (0)
#else
#define PROBE_STAMP(p) do { } while (0)
#endif
#define PH_ENTER() int z; asm volatile("s_mov_b32 %0, 0" : "=s"(z)); \
        X.lane = (int)__builtin_amdgcn_mbcnt_hi(~0u, __builtin_amdgcn_mbcnt_lo(~0u, (unsigned)z)); X.tid = wave0 * 64 + X.lane; \
        X.G = G0 + z; X.vcu = vcu0 + z; X.bid = bid0 + z; X.NGW = X.G * NWAVES; X.gw = X.vcu * NWAVES + wave0; \
        { kargp_t kp = (kargp_t)__builtin_amdgcn_kernarg_segment_ptr(); asm volatile("" : "+s"(kp)); X.kp = kp; } \
        unsigned char* ws = (unsigned char*)(__attribute__((address_space(1))) unsigned char*)X.kp[34] + z; X.ws = ws;
#if PROBE_PH >= 0
    unsigned long long pr_t0 = 0, pr_t1 = 0;
#endif
#define PH_RUN(PHK, ...) if (ph_lo <= (PHK) && (PHK) < ph_hi) { const int ph = (PHK); \
        if (ph != ph_lo) { const int l0 = (int)__builtin_amdgcn_mbcnt_hi(~0u, __builtin_amdgcn_mbcnt_lo(~0u, 0u)); xcd_barrier(bar, wave0 * 64 + l0); if (EXP_BAR2 && (ph & 3) == 1) xcd_barrier(bar, wave0 * 64 + l0); } \
        PROBE_STAMP(ph); __VA_ARGS__ }
    PH_RUN(PH_PRO, { PH_ENTER(); phase_prologue(a, X, !grouped); })
#define PH_ENTER_A() int z; asm volatile("s_mov_b32 %0, 0" : "=s"(z)); \
        X.lane = (int)__builtin_amdgcn_mbcnt_hi(~0u, __builtin_amdgcn_mbcnt_lo(~0u, (unsigned)z)); X.tid = wave0 * 64 + X.lane; \
        X.G = GA + z; X.vcu = vcuA + z; X.bid = bid0 + z; X.NGW = X.G * NWAVES; X.gw = X.vcu * NWAVES + wave0; \
        { kargp_t kp = (kargp_t)__builtin_amdgcn_kernarg_segment_ptr(); asm volatile("" : "+s"(kp)); X.kp = kp; } \
        unsigned char* ws = (unsigned char*)(__attribute__((address_space(1))) unsigned char*)X.kp[34] + z; X.ws = ws;
#define PHA_RUN(PHK, ...) { const int ph = (PHK); \
        { const int l0 = (int)__builtin_amdgcn_mbcnt_hi(~0u, __builtin_amdgcn_mbcnt_lo(~0u, 0u)); if (ph == PH_MOD0) xcd_barrier(bar, wave0 * 64 + l0); else xcd_barrier(barA, wave0 * 64 + l0); } \
        PROBE_STAMP(ph); __VA_ARGS__ }
    if (grouped) {
        if (bid0 < GA) {
    PHA_RUN(PH_MOD0, { PH_ENTER_A(); phase_modulate0(a, X); })
    PHA_RUN(PH_GIN, { PH_ENTER_A(); DenseSched S; S.init((const bf16*)(ws + WS_XA), (const bf16*)(ws + WS_WINT), NTOK, EVEN_IN, X.G, X.bid);
            S.A2 = (const bf16*)(ws + WS_GM); S.Bt2 = (const bf16*)(ws + WS_WINT) + (size_t)KV_COL * D; S.nM2 = NCTX / 256;
            EpiIn E{(bf16*)(ws + WS_GLU), (bf16*)(ws + WS_Q), (bf16*)(ws + WS_K), (bf16*)(ws + WS_V), (bf16*)(ws + WS_KC), (bf16*)(ws + WS_VC), IN(I_EBIN)};
            pg8::gemm_phase<EpiIn, DenseSched>(X.lds, S, E, X.tid); })
    PHA_RUN(PH_CONV, { PH_ENTER_A(); phase_conv_qk(a, X); })
    PHA_RUN(PH_ATT, { PH_ENTER_A(); phase_attention(a, X); })
    PHA_RUN(PH_GOUT, { PH_ENTER_A(); DenseSched S; S.init((const bf16*)(ws + WS_MIX), (const bf16*)(ws + WS_WOUTT), NTOK, D, X.G, X.bid);
            EpiRes<true> E{IN(I_X), (bf16*)(ws + WS_H), IN(I_EBOUT), (const float*)(ws + WS_MOD) + 2 * 1024};
            pg8::gemm_phase<EpiRes<true>, DenseSched>(X.lds, S, E, X.tid); })
    PHA_RUN(PH_RT0, { PH_ENTER_A(); phase_router(a, X, 0); })
        } else {
            { const int l0 = (int)__builtin_amdgcn_mbcnt_hi(~0u, __builtin_amdgcn_mbcnt_lo(~0u, 0u)); xcd_barrier(bar, wave0 * 64 + l0); }
            { PH_ENTER(); phase_moe_convert(X, bid0 - GA + z, GROUP_B); }
        }
    } else {
    PH_RUN(PH_MOD0, { PH_ENTER(); phase_modulate0(a, X); })
    PH_RUN(PH_GIN, { PH_ENTER(); DenseSched S; S.init((const bf16*)(ws + WS_XA), (const bf16*)(ws + WS_WINT), NTOK, EVEN_IN, X.G, X.bid);
            S.A2 = (const bf16*)(ws + WS_GM); S.Bt2 = (const bf16*)(ws + WS_WINT) + (size_t)KV_COL * D; S.nM2 = NCTX / 256;
            EpiIn E{(bf16*)(ws + WS_GLU), (bf16*)(ws + WS_Q), (bf16*)(ws + WS_K), (bf16*)(ws + WS_V), (bf16*)(ws + WS_KC), (bf16*)(ws + WS_VC), IN(I_EBIN)};
            pg8::gemm_phase<EpiIn, DenseSched>(X.lds, S, E, X.tid); })
    PH_RUN(PH_CONV, { PH_ENTER(); phase_conv_qk(a, X); })
    PH_RUN(PH_ATT, { PH_ENTER(); phase_attention(a, X); })
    PH_RUN(PH_GOUT, { PH_ENTER(); DenseSched S; S.init((const bf16*)(ws + WS_MIX), (const bf16*)(ws + WS_WOUTT), NTOK, D, X.G, X.bid);
            EpiRes<true> E{IN(I_X), (bf16*)(ws + WS_H), IN(I_EBOUT), (const float*)(ws + WS_MOD) + 2 * 1024};
            pg8::gemm_phase<EpiRes<true>, DenseSched>(X.lds, S, E, X.tid); })
    PH_RUN(PH_RT0, { PH_ENTER(); phase_router(a, X, 0); })
    }
    PH_RUN(PH_M1_0, { PH_ENTER(); const int l = (ph == PH_M1_1); moe_build_table(X, (const int*)(ws + WS_CTL) + CW_CNT + l * NE * CNT_STRIDE);
            MoeSchedT<true, 8> S; S.tab = (const LAS int*)(X.lds + TAB_OFF); S.G = X.G; S.c = X.vcu; S.A = (const unsigned char*)(ws + WS_XA8); S.Bt = (const unsigned char*)(ws + WS_W1T) + (size_t)l * NE * 2048 * 1024; S.list = (const int*)(ws + WS_LIST); S.meta = (const LAS int*)(X.lds + META_OFF);
            moe_stage_meta<false>(X, S, S.list, (const float*)nullptr, (LAS int*)(X.lds + META_OFF), IN(I_B1) + (size_t)l * NE * 2048, (LAS float*)(X.lds + BIAS_OFF));
            EpiSwiglu E{(unsigned char*)(ws + WS_ACT), (const LAS float*)(X.lds + BIAS_OFF)};
            pg8::gemm_phase<EpiSwiglu, MoeSchedT<true, 8>>(X.lds, S, E, X.tid); })
    PH_RUN(PH_M2_0, { PH_ENTER(); const int l = (ph == PH_M2_1); moe_build_table(X, (const int*)(ws + WS_CTL) + CW_CNT + l * NE * CNT_STRIDE);
            MoeSchedT<false, 4> S; S.tab = (const LAS int*)(X.lds + TAB_OFF); S.G = X.G; S.c = X.vcu; S.A = (const unsigned char*)(ws + WS_ACT); S.Bt = (const unsigned char*)(ws + WS_W2T) + (size_t)l * NE * 1024 * 1024; S.list = (const int*)(ws + WS_LIST); S.meta = (const LAS int*)(X.lds + META_OFF);
            moe_stage_meta<true>(X, S, S.list, (const float*)(ws + WS_GATE), (LAS int*)(X.lds + META_OFF), IN(I_B2) + (size_t)l * NE * D, (LAS float*)(X.lds + BIAS_OFF));
            EpiDown E{(bf16*)(ws + WS_Y), (const LAS float*)(X.lds + BIAS_OFF), (const LAS int*)(X.lds + META_OFF)};
            pg8::gemm_phase<EpiDown, MoeSchedT<false, 4>>(X.lds, S, E, X.tid); })
    PH_RUN(PH_CMB0, { PH_ENTER(); phase_combine(a, X, 0); })
    PH_RUN(PH_GMI, { PH_ENTER(); DenseSched S; S.init((const bf16*)(ws + WS_XA), (const bf16*)(ws + WS_GWINT), NTOK, 2048, X.G, X.bid);
            EpiGelu E{(bf16*)(ws + WS_U), (bf16*)(ws + WS_VB), IN(I_OBIN), (float*)(ws + WS_CTL) + CW_VSTAT};
            pg8::gemm_phase<EpiGelu, DenseSched>(X.lds, S, E, X.tid); })
    PH_RUN(PH_SPA, { PH_ENTER(); phase_spatial(a, X); })
    PH_RUN(PH_GMO, { PH_ENTER(); DenseSched S; S.init((const bf16*)(ws + WS_MIX), (const bf16*)(ws + WS_GWOUTT), NTOK, D, X.G, X.bid);
            EpiRes<false> E{(const bf16*)(ws + WS_H), (bf16*)(ws + WS_H), IN(I_OBOUT), (const float*)(ws + WS_MOD) + (size_t)9 * MODW + 2 * 1024};
            pg8::gemm_phase<EpiRes<false>, DenseSched>(X.lds, S, E, X.tid); })
    PH_RUN(PH_RT1, { PH_ENTER(); phase_router(a, X, 1); })
    PH_RUN(PH_M1_1, { PH_ENTER(); PMARK(50); const int l = (ph == PH_M1_1); moe_build_table(X, (const int*)(ws + WS_CTL) + CW_CNT + l * NE * CNT_STRIDE);
            MoeSchedT<true, 8> S; S.tab = (const LAS int*)(X.lds + TAB_OFF); S.G = X.G; S.c = X.vcu; S.A = (const unsigned char*)(ws + WS_XA8); S.Bt = (const unsigned char*)(ws + WS_W1T) + (size_t)l * NE * 2048 * 1024; S.list = (const int*)(ws + WS_LIST); S.meta = (const LAS int*)(X.lds + META_OFF);
            moe_stage_meta<false>(X, S, S.list, (const float*)nullptr, (LAS int*)(X.lds + META_OFF), IN(I_B1) + (size_t)l * NE * 2048, (LAS float*)(X.lds + BIAS_OFF));
            PMARK(51); EpiSwiglu E{(unsigned char*)(ws + WS_ACT), (const LAS float*)(X.lds + BIAS_OFF)};
            pg8::gemm_phase<EpiSwiglu, MoeSchedT<true, 8>>(X.lds, S, E, X.tid); PMARK(53); })
    PH_RUN(PH_M2_1, { PH_ENTER(); PMARK(54); const int l = (ph == PH_M2_1); moe_build_table(X, (const int*)(ws + WS_CTL) + CW_CNT + l * NE * CNT_STRIDE);
            MoeSchedT<false, 4> S; S.tab = (const LAS int*)(X.lds + TAB_OFF); S.G = X.G; S.c = X.vcu; S.A = (const unsigned char*)(ws + WS_ACT); S.Bt = (const unsigned char*)(ws + WS_W2T) + (size_t)l * NE * 1024 * 1024; S.list = (const int*)(ws + WS_LIST); S.meta = (const LAS int*)(X.lds + META_OFF);
            moe_stage_meta<true>(X, S, S.list, (const float*)(ws + WS_GATE), (LAS int*)(X.lds + META_OFF), IN(I_B2) + (size_t)l * NE * D, (LAS float*)(X.lds + BIAS_OFF));
            EpiDown E{(bf16*)(ws + WS_Y), (const LAS float*)(X.lds + BIAS_OFF), (const LAS int*)(X.lds + META_OFF)};
            pg8::gemm_phase<EpiDown, MoeSchedT<false, 4>>(X.lds, S, E, X.tid); })
    PH_RUN(PH_CMB1, { PH_ENTER(); phase_combine(a, X, 1); })
#if PROBE_PH == -2
    if (blockIdx.x == 0 && threadIdx.x == 0) { volatile LAS unsigned long long* pm_ = (volatile LAS unsigned long long*)(X.lds + MISC_OFF + 128); const unsigned long long te = __builtin_amdgcn_s_memrealtime(); const unsigned long long span = (pm_[1] - pm_[0]) * PROBE_MULT;
        while (__builtin_amdgcn_s_memrealtime() - te < span) __builtin_amdgcn_s_sleep(8); }
#endif
#if PROBE_PH >= 0
    if (pr_t1 == 0) pr_t1 = __builtin_amdgcn_s_memrealtime();
    if (blockIdx.x == 0 && wave0 == 0) { const unsigned long long te = __builtin_amdgcn_s_memrealtime(); const unsigned long long span = (pr_t1 - pr_t0) * PROBE_MULT;
        while (__builtin_amdgcn_s_memrealtime() - te < span) __builtin_amdgcn_s_sleep(8); }
#endif
}

__device__ __forceinline__ bool find_expert(const int* cnt, int s, int& e, int& slot) {
    int pb = 0;
    for (int i = 0; i < NE; ++i) { const int c = cnt[i * CNT_STRIDE]; const int pr = ((c + 255) >> 8) << 8; if (s < pb + pr) { e = i; slot = s - pb; return true; } pb += pr; }
    return false;
}
__global__ void __launch_bounds__(256) slow_gemm(const bf16* A, const int* arow, const bf16* Bt, float* C, int N, const int* cnt, size_t bstride) {
    __shared__ float As[16][65], Bs[16][65];
    const int tx = threadIdx.x & 15, ty = threadIdx.x >> 4; const int m0 = blockIdx.y * 64, n0 = blockIdx.x * 64;
    if (cnt) { int e, slot; if (!find_expert(cnt, m0, e, slot)) return; Bt += (size_t)e * bstride; }
    float acc[4][4];
    for (int i = 0; i < 4; ++i) for (int j = 0; j < 4; ++j) acc[i][j] = 0.f;
    for (int k0 = 0; k0 < 1024; k0 += 16) {
        for (int i = 0; i < 4; ++i) { const int idx = threadIdx.x + 256 * i; const int r = idx >> 4, kk = idx & 15; const int gm = m0 + r; const int ar = arow ? arow[gm] : gm;
            As[kk][r] = bf2f(A[(size_t)ar * 1024 + k0 + kk]); Bs[kk][r] = bf2f(Bt[(size_t)(n0 + r) * 1024 + k0 + kk]); }
        __syncthreads();
        for (int kk = 0; kk < 16; ++kk) { float av[4], bv[4];
            for (int i = 0; i < 4; ++i) { av[i] = As[kk][ty * 4 + i]; bv[i] = Bs[kk][tx * 4 + i]; }
            for (int i = 0; i < 4; ++i) for (int j = 0; j < 4; ++j) acc[i][j] += av[i] * bv[j]; }
        __syncthreads();
    }
    for (int i = 0; i < 4; ++i) for (int j = 0; j < 4; ++j) C[(size_t)(m0 + ty * 4 + i) * N + n0 + tx * 4 + j] = acc[i][j];
}
__device__ __forceinline__ unsigned short f2bf_s(float f) { return (unsigned short)(pk2(f, 0.f) & 0xffffu); }
__global__ void slow_epi_in(const float* C, const float* C2, const float* bias, bf16* GLU, bf16* Q, bf16* Kb, bf16* Vb, bf16* KC, bf16* VC) {
    const size_t i = (size_t)blockIdx.x * blockDim.x + threadIdx.x;
    if (i < (size_t)NTOK * 512) { const int row = (int)(i >> 9), j = (int)(i & 511); const int t = j >> 7, ii = j & 127; const float* cr = C + (size_t)row * EVEN_IN;
        const float u = cr[t * 256 + ii] + bias[j], g = cr[t * 256 + 128 + ii] + bias[512 + j];
        GLU[i] = f2bf_s(u / (1.0f + expf(-g)));
        Q[i] = f2bf_s(cr[1024 + j] + bias[1024 + j]);
        if (j < 128) { Kb[(size_t)row * 128 + j] = f2bf_s(cr[1536 + j] + bias[1536 + j]); Vb[(size_t)row * 128 + j] = f2bf_s(cr[1664 + j] + bias[1664 + j]); }
        if (row < NCTX && j < 128) { KC[(size_t)row * 128 + j] = f2bf_s(C2[(size_t)row * 256 + j] + bias[1536 + j]); VC[(size_t)row * 128 + j] = f2bf_s(C2[(size_t)row * 256 + 128 + j] + bias[1664 + j]); } }
}
__global__ void slow_epi_res(const float* C, const float* basef, const bf16* baseb, bf16* out, const float* bias, const float* gate) {
    const size_t i = (size_t)blockIdx.x * blockDim.x + threadIdx.x;
    if (i < (size_t)NTOK * D) { const int row = (int)(i >> 10), col = (int)(i & 1023); const float b = basef ? basef[i] : bf2f(baseb[i]); out[i] = f2bf_s(b + gate[(size_t)(row / SEQ) * MODW + col] * (C[i] + bias[col])); }
}
__global__ void slow_epi_gelu(const float* C, const float* bias, bf16* U, bf16* V) {
    const size_t i = (size_t)blockIdx.x * blockDim.x + threadIdx.x;
    if (i < (size_t)NTOK * 2048) { const int row = (int)(i >> 11), col = (int)(i & 2047); const float x = C[i] + bias[col]; const float y = 0.5f * x * (1.0f + erff(x * 0.70710678118654752f));
        if (col < 1024) U[(size_t)row * D + col] = f2bf_s(y); else V[(size_t)row * D + col - 1024] = f2bf_s(y); }
}
__global__ void slow_arow(const int* cnt, const int* list, int* arow) {
    const int s = blockIdx.x * blockDim.x + threadIdx.x; if (s >= ACT_ROWS) return;
    int e, slot; int r = 0; if (find_expert(cnt, s, e, slot) && slot < cnt[e * CNT_STRIDE]) r = list[(size_t)e * NTOK + slot] >> 2;
    arow[s] = r;
}
__global__ void slow_epi_swiglu(const float* C, const int* cnt, const float* b1, bf16* ACT) {
    const size_t i = (size_t)blockIdx.x * blockDim.x + threadIdx.x;
    if (i < (size_t)ACT_ROWS * 1024) { const int s = (int)(i >> 10), j = (int)(i & 1023); int e, slot; if (!find_expert(cnt, s, e, slot)) return;
        const int t = j >> 7, ii = j & 127; const float* cr = C + (size_t)s * 2048;
        float g = cr[t * 256 + ii] + b1[(size_t)e * 2048 + j], up = cr[t * 256 + 128 + ii] + b1[(size_t)e * 2048 + 1024 + j];
        g = fminf(g, 7.0f); up = fminf(fmaxf(up, -7.0f), 7.0f);
        ACT[i] = f2bf_s((up + 1.0f) * g / (1.0f + expf(-1.702f * g))); }
}
__global__ void slow_epi_down(const float* C, const int* cnt, const int* list, const float* gatew, const float* b2, bf16* Y) {
    const size_t i = (size_t)blockIdx.x * blockDim.x + threadIdx.x;
    if (i < (size_t)ACT_ROWS * 1024) { const int s = (int)(i >> 10), col = (int)(i & 1023); int e, slot; if (!find_expert(cnt, s, e, slot) || slot >= cnt[e * CNT_STRIDE]) return;
        const int aid = list[(size_t)e * NTOK + slot]; Y[(size_t)aid * D + col] = f2bf_s((C[i] + b2[(size_t)e * D + col]) * gatew[aid]); }
}
__global__ void __launch_bounds__(64) slow_attention(const bf16* QN, const bf16* KN, const bf16* VV, const bf16* KC, const bf16* VC, const float* sink, bf16* MIX) {
    const int i = blockIdx.x * blockDim.x + threadIdx.x; if (i >= NTOK * 8) return;
    const int row = i >> 3, h = i & 7, kh = h >> 2, b = row / SEQ, t = row % SEQ;
    float q[64], o[64];
    for (int d = 0; d < 64; ++d) { q[d] = bf2f(QN[(size_t)row * 512 + h * 64 + d]); o[d] = 0.f; }
    float m = sink[h] * LOG2E, l = 1.0f;
    const int j0 = t - 128 < 0 ? 0 : t - 128, j1 = t + 128 > SEQ - 1 ? SEQ - 1 : t + 128;
    for (int jj = j0; jj <= j1 + CTXL; ++jj) {
        const bf16* kp; const bf16* vp;
        if (jj <= j1) { kp = KN + (size_t)(b * SEQ + jj) * 128 + kh * 64; vp = VV + (size_t)(b * SEQ + jj) * 128 + kh * 64; }
        else { const int c = jj - j1 - 1; kp = KC + (size_t)(b * CTXL + c) * 128 + kh * 64; vp = VC + (size_t)(b * CTXL + c) * 128 + kh * 64; }
        float s = 0.f; for (int d = 0; d < 64; ++d) s += q[d] * bf2f(kp[d]);
        const float mn = fmaxf(m, s), al = exp2f(m - mn), p = exp2f(s - mn); m = mn; l = l * al + p;
        for (int d = 0; d < 64; ++d) o[d] = o[d] * al + p * bf2f(vp[d]);
    }
    for (int d = 0; d < 64; ++d) MIX[(size_t)row * D + 512 + h * 64 + d] = f2bf_s(o[d] / l);
}
__global__ void slow_vstats(const bf16* VB, float* stat) {
    const int row = blockIdx.x * blockDim.x + threadIdx.x; if (row >= NTOK) return;
    float s = 0.f; for (int c = 0; c < D; ++c) s += bf2f(VB[(size_t)row * D + c]); const float mean = s / D;
    float s2 = 0.f; for (int c = 0; c < D; ++c) { const float d = bf2f(VB[(size_t)row * D + c]) - mean; s2 += d * d; }
    stat[2 * row] = mean; stat[2 * row + 1] = rsqrtf(s2 / D + EPS);
}
__global__ void slow_spatial(const bf16* U, const bf16* VB, const float* stat, const float* ws, const float* bs, const float* lng, const float* lnb, bf16* SG) {
    const size_t i = (size_t)blockIdx.x * blockDim.x + threadIdx.x;
    if (i < (size_t)NTOK * D) { const int row = (int)(i >> 10), ch = (int)(i & 1023); const int g = ch >> 7, p = row & 127, r0 = row - p;
        float s = 0.f;
        for (int q = 0; q < 128; ++q) { const float vn = (bf2f(VB[(size_t)(r0 + q) * D + ch]) - stat[2 * (r0 + q)]) * stat[2 * (r0 + q) + 1] * lng[ch] + lnb[ch]; s += ws[((size_t)g * 128 + p) * 128 + q] * vn; }
        SG[i] = f2bf_s(bf2f(U[i]) * (s + bs[g * 128 + p])); }
}

static void launch_mega(Args& a, int lo, int hi, int& li, int grid, hipStream_t stream) {
    a.ph_lo = lo; a.ph_hi = hi; a.li = li++;
    hipLaunchKernelGGL(mega, dim3(grid), dim3(NTHREADS), LDS_BYTES, stream, a);
}
extern "C" void kernel_launch(void* const* d_in, const int* in_sizes, int n_in, void* d_out, int out_size, void* d_ws, size_t ws_size, hipStream_t stream) {
    static int grid = 0;
    if (grid == 0) {
        if (n_in != 33 || out_size != NTOK * D || ws_size < WS_END) { fprintf(stderr, "kernel_launch: unexpected problem (n_in %d, out %d, ws %zu)\n", n_in, out_size, ws_size); grid = -1; return; }
        int dev = 0, cus = 0, per_cu = 0;
        if (hipGetDevice(&dev) != hipSuccess || hipDeviceGetAttribute(&cus, hipDeviceAttributeMultiprocessorCount, dev) != hipSuccess) { grid = -1; return; }
        if (hipFuncSetAttribute((const void*)mega, hipFuncAttributeMaxDynamicSharedMemorySize, LDS_BYTES) != hipSuccess) { fprintf(stderr, "kernel_launch: hipFuncSetAttribute failed\n"); grid = -1; return; }
        if (hipOccupancyMaxActiveBlocksPerMultiprocessor(&per_cu, (const void*)mega, NTHREADS, LDS_BYTES) != hipSuccess || per_cu < 1) { fprintf(stderr, "kernel_launch: occupancy query says %d blocks per CU\n", per_cu); per_cu = 1; }
        (void)hipGetLastError();
        grid = cus;
    }
    if (grid < 0) return;
    unsigned char* ws = (unsigned char*)d_ws;
    (void)hipMemsetAsync(ws + WS_CTL, 0, CTL_ZERO_BYTES, stream);
    Args a{};
    for (int i = 0; i < 33; ++i) a.in[i] = (const float*)d_in[i];
    a.out = (float*)d_out; a.ws = ws;
    int li = 0;
    const float* in_[33]; for (int i = 0; i < 33; ++i) in_[i] = (const float*)d_in[i];
    float* CF = (float*)(ws + WS_CF); float* MOD = (float*)(ws + WS_MOD); int* CNT = (int*)(ws + WS_CTL) + CW_CNT;
    int lo = 0;
    auto flush = [&](int upto) { if (upto > lo) launch_mega(a, lo, upto, li, grid, stream); };
    for (int ph = 0; ph < NPHASE; ++ph) {
        bool slow = false;
        switch (ph) {
        case PH_GIN: slow = SLOW_MASK & 1; break;
        case PH_ATT: slow = SLOW_MASK & 2; break;
        case PH_GOUT: case PH_GMO: slow = SLOW_MASK & 4; break;
        case PH_M1_0: case PH_M1_1: slow = SLOW_MASK & 8; break;
        case PH_M2_0: case PH_M2_1: slow = SLOW_MASK & 16; break;
        case PH_GMI: slow = SLOW_MASK & 32; break;
        case PH_SPA: slow = SLOW_MASK & 64; break;
        default: break;
        }
        if (!slow) continue;
        flush(ph); lo = ph + 1;
        const int l = (ph == PH_M1_1 || ph == PH_M2_1) ? 1 : 0;
        switch (ph) {
        case PH_GIN:
            hipLaunchKernelGGL(slow_gemm, dim3(EVEN_IN / 64, NTOK / 64), dim3(256), 0, stream, (const bf16*)(ws + WS_XA), (const int*)nullptr, (const bf16*)(ws + WS_WINT), CF, EVEN_IN, (const int*)nullptr, (size_t)0);
            hipLaunchKernelGGL(slow_gemm, dim3(256 / 64, NCTX / 64), dim3(256), 0, stream, (const bf16*)(ws + WS_GM), (const int*)nullptr, (const bf16*)(ws + WS_WINT) + (size_t)KV_COL * D, CF + (size_t)NTOK * EVEN_IN, 256, (const int*)nullptr, (size_t)0);
            hipLaunchKernelGGL(slow_epi_in, dim3(NTOK * 512 / 256), dim3(256), 0, stream, (const float*)CF, (const float*)(CF + (size_t)NTOK * EVEN_IN), in_[I_EBIN], (bf16*)(ws + WS_GLU), (bf16*)(ws + WS_Q), (bf16*)(ws + WS_K), (bf16*)(ws + WS_V), (bf16*)(ws + WS_KC), (bf16*)(ws + WS_VC));
            break;
        case PH_ATT:
            hipLaunchKernelGGL(slow_attention, dim3(NTOK * 8 / 64), dim3(64), 0, stream, (const bf16*)(ws + WS_Q), (const bf16*)(ws + WS_K), (const bf16*)(ws + WS_V), (const bf16*)(ws + WS_KC), (const bf16*)(ws + WS_VC), in_[I_SINK], (bf16*)(ws + WS_MIX));
            break;
        case PH_GOUT:
            hipLaunchKernelGGL(slow_gemm, dim3(D / 64, NTOK / 64), dim3(256), 0, stream, (const bf16*)(ws + WS_MIX), (const int*)nullptr, (const bf16*)(ws + WS_WOUTT), CF, D, (const int*)nullptr, (size_t)0);
            hipLaunchKernelGGL(slow_epi_res, dim3(NTOK * D / 256), dim3(256), 0, stream, (const float*)CF, in_[I_X], (const bf16*)nullptr, (bf16*)(ws + WS_H), in_[I_EBOUT], (const float*)(MOD + 2 * 1024));
            break;
        case PH_GMO:
            hipLaunchKernelGGL(slow_gemm, dim3(D / 64, NTOK / 64), dim3(256), 0, stream, (const bf16*)(ws + WS_MIX), (const int*)nullptr, (const bf16*)(ws + WS_GWOUTT), CF, D, (const int*)nullptr, (size_t)0);
            hipLaunchKernelGGL(slow_epi_res, dim3(NTOK * D / 256), dim3(256), 0, stream, (const float*)CF, (const float*)nullptr, (const bf16*)(ws + WS_H), (bf16*)(ws + WS_H), in_[I_OBOUT], (const float*)(MOD + (size_t)9 * MODW + 2 * 1024));
            break;
        case PH_M1_0: case PH_M1_1:
            hipLaunchKernelGGL(slow_arow, dim3(ACT_ROWS / 256), dim3(256), 0, stream, (const int*)(CNT + l * NE * CNT_STRIDE), (const int*)(ws + WS_LIST), (int*)(ws + WS_AROW));
            hipLaunchKernelGGL(slow_gemm, dim3(2048 / 64, ACT_ROWS / 64), dim3(256), 0, stream, (const bf16*)(ws + WS_XA), (const int*)(ws + WS_AROW), (const bf16*)(ws + WS_W1T) + (size_t)l * NE * 2048 * 1024, CF, 2048, (const int*)(CNT + l * NE * CNT_STRIDE), (size_t)2048 * 1024);
            hipLaunchKernelGGL(slow_epi_swiglu, dim3(ACT_ROWS * 1024 / 256), dim3(256), 0, stream, (const float*)CF, (const int*)(CNT + l * NE * CNT_STRIDE), in_[I_B1] + (size_t)l * NE * 2048, (bf16*)(ws + WS_ACT));
            break;
        case PH_M2_0: case PH_M2_1:
            hipLaunchKernelGGL(slow_gemm, dim3(1024 / 64, ACT_ROWS / 64), dim3(256), 0, stream, (const bf16*)(ws + WS_ACT), (const int*)nullptr, (const bf16*)(ws + WS_W2T) + (size_t)l * NE * 1024 * 1024, CF, 1024, (const int*)(CNT + l * NE * CNT_STRIDE), (size_t)1024 * 1024);
            hipLaunchKernelGGL(slow_epi_down, dim3(ACT_ROWS * 1024 / 256), dim3(256), 0, stream, (const float*)CF, (const int*)(CNT + l * NE * CNT_STRIDE), (const int*)(ws + WS_LIST), (const float*)(ws + WS_GATE), in_[I_B2] + (size_t)l * NE * D, (bf16*)(ws + WS_Y));
            break;
        case PH_GMI:
            hipLaunchKernelGGL(slow_gemm, dim3(2048 / 64, NTOK / 64), dim3(256), 0, stream, (const bf16*)(ws + WS_XA), (const int*)nullptr, (const bf16*)(ws + WS_GWINT), CF, 2048, (const int*)nullptr, (size_t)0);
            hipLaunchKernelGGL(slow_epi_gelu, dim3(NTOK * 2048 / 256), dim3(256), 0, stream, (const float*)CF, in_[I_OBIN], (bf16*)(ws + WS_U), (bf16*)(ws + WS_VB));
            break;
        case PH_SPA:
            hipLaunchKernelGGL(slow_vstats, dim3(NTOK / 64), dim3(64), 0, stream, (const bf16*)(ws + WS_VB), CF);
            hipLaunchKernelGGL(slow_spatial, dim3(NTOK * D / 256), dim3(256), 0, stream, (const bf16*)(ws + WS_U), (const bf16*)(ws + WS_VB), (const float*)CF, in_[I_OWS], in_[I_OBS], in_[I_OLNG], in_[I_OLNB], (bf16*)(ws + WS_MIX));
            break;
        default: break;
        }
    }
    flush(NPHASE);
}
```

```cpp
#include <hip/hip_runtime.h>
#include <cstdio>
#include <cstdint>

#ifndef SLOW_MASK
#define SLOW_MASK 0x00
#endif

#ifndef GROUP_B
#define GROUP_B 80
#endif
#ifndef EXP_BAR2
#define EXP_BAR2 0
#endif
#ifndef EXP_STREAM
#define EXP_STREAM 0
#endif
#ifndef PROBE_PH
#define PROBE_PH (-1)
#endif
#ifndef PROBE_END
#define PROBE_END (PROBE_PH + 1)
#endif
#ifndef PROBE_A
#define PROBE_A (-1)
#define PROBE_B (-1)
#endif
#ifndef PROBE_MULT
#define PROBE_MULT 4
#endif

#define LAS __attribute__((address_space(3)))
typedef unsigned short bf16;
typedef short bf16x8 __attribute__((ext_vector_type(8)));
typedef float f32x4 __attribute__((ext_vector_type(4)));
typedef float f32x2 __attribute__((ext_vector_type(2)));
typedef unsigned u32x4 __attribute__((ext_vector_type(4)));
typedef unsigned u32x2 __attribute__((ext_vector_type(2)));
typedef __bf16 bf16x2_t __attribute__((ext_vector_type(2)));

constexpr int NB = 8, SEQ = 2048, D = 1024, NTOK = NB * SEQ, CTXL = 256, NCTX = NB * CTXL;
constexpr int NE = 32, TOPK = 4, NASSIGN = NTOK * TOPK, ACT_ROWS = NASSIGN + NE * 256;
constexpr int EVEN_IN = 1792, KV_COL = 1536;
constexpr float EPS = 1e-6f, LOG2E = 1.4426950408889634f;
constexpr float QSCALE = 0.125f * LOG2E;
constexpr int MODW = 6 * D;
constexpr int NWAVES = 8, NTHREADS = 512;

constexpr size_t MiB = 1u << 20;
constexpr size_t WS_CTL = 0, CTL_ZERO_BYTES = 1 * MiB;
constexpr size_t WS_MOD = 1 * MiB;
constexpr size_t WS_LIST = 2 * MiB;
constexpr size_t WS_GATE = 4 * MiB;
constexpr size_t WS_WSB = 5 * MiB;
constexpr size_t WS_WINT = 6 * MiB;
constexpr size_t WS_WOUTT = 10 * MiB;
constexpr size_t WS_GWINT = 12 * MiB;
constexpr size_t WS_GWOUTT = 16 * MiB;
constexpr size_t WS_KC = 18 * MiB;
constexpr size_t WS_VC = 18 * MiB + 512 * 1024;
constexpr size_t WS_K = 19 * MiB;
constexpr size_t WS_V = 23 * MiB;
constexpr size_t WS_GM = 27 * MiB;
constexpr size_t WS_AROW = 31 * MiB;
constexpr size_t WS_Q = 32 * MiB;
constexpr size_t WS_GLU = 48 * MiB;
constexpr size_t WS_XA = 64 * MiB;
constexpr size_t WS_MIX = 96 * MiB;
constexpr size_t WS_H = 128 * MiB;
constexpr size_t WS_U = 192 * MiB;
constexpr size_t WS_VB = 224 * MiB;
constexpr size_t WS_W1T = 256 * MiB;
constexpr size_t WS_W2T = 512 * MiB;
constexpr size_t WS_ACT = 640 * MiB;
constexpr size_t WS_Y = 784 * MiB;
constexpr size_t WS_XA8 = 912 * MiB;
constexpr size_t WS_CF = 928 * MiB;
constexpr size_t WS_END = 1504 * MiB;
constexpr int CW_BAR = 4096, CW_CNT = 131072, CNT_STRIDE = 64  , CW_VSTAT = 147456;
constexpr int MAX_LAUNCH = 20;

constexpr int RING_BYTES = 131072;
constexpr int MISC_OFF = RING_BYTES;
constexpr int TAB_OFF = RING_BYTES + 256;
constexpr int META_OFF = RING_BYTES + 3072;
constexpr int BIAS_OFF = META_OFF + 10240;
constexpr int LDS_BYTES = 163840;

#define LDS_WAIT() asm volatile("s_waitcnt lgkmcnt(0)" ::: "memory")
#define VM_WAIT() asm volatile("s_waitcnt vmcnt(0)" ::: "memory")

__device__ __forceinline__ float bf2f(unsigned b) { return __uint_as_float(b << 16); }
__device__ __forceinline__ unsigned pk2(float lo, float hi) { f32x2 v = {lo, hi}; bf16x2_t b = __builtin_convertvector(v, bf16x2_t); return __builtin_bit_cast(unsigned, b); }
template <int CTRL, int ROW_MASK> __device__ __forceinline__ float dpp_f(float old, float src) { return __builtin_bit_cast(float, __builtin_amdgcn_update_dpp(__builtin_bit_cast(int, old), __builtin_bit_cast(int, src), CTRL, ROW_MASK, 0xf, false)); }
__device__ __forceinline__ unsigned pk4_fp8(float a, float b, float c, float d) { int w = 0; w = __builtin_amdgcn_cvt_pk_fp8_f32(a, b, w, false); w = __builtin_amdgcn_cvt_pk_fp8_f32(c, d, w, true); return (unsigned)w; }
__device__ __forceinline__ float wave_sum(float v) {
    v += dpp_f<0xB1, 0xf>(0.f, v);
    v += dpp_f<0x4E, 0xf>(0.f, v);
    v += dpp_f<0x141, 0xf>(0.f, v);
    v += dpp_f<0x140, 0xf>(0.f, v);
    v += dpp_f<0x142, 0xa>(0.f, v);
    v += dpp_f<0x143, 0xc>(0.f, v);
    return __builtin_bit_cast(float, __builtin_amdgcn_readlane(__builtin_bit_cast(int, v), 63));
}
__device__ __forceinline__ float dpp_swap32(float v) { return __shfl_xor(v, 32); }
__device__ __forceinline__ float sigmoidf_(float x) { return __builtin_amdgcn_rcpf(1.0f + __builtin_amdgcn_exp2f(-x * LOG2E)); }

#define XB_TMO      128
#define XB_XCNT(j)  (256  + 64 * (j))
#define XB_XSUB(j)  (1280 + 64 * (j))
#define XB_XGEN(j)  (2304 + 64 * (j))
#define XB_TOP      3328
#define XB_TOPGEN   3392
#define XCD_BAR_WORDS 3456
#define XB_SPIN_CAP (1u << 20)
__device__ __forceinline__ unsigned xb_ld(unsigned* p)              { return __hip_atomic_load(p, __ATOMIC_RELAXED, __HIP_MEMORY_SCOPE_AGENT); }
__device__ __forceinline__ unsigned xb_add(unsigned* p, unsigned v) { return __hip_atomic_fetch_add(p, v, __ATOMIC_RELAXED, __HIP_MEMORY_SCOPE_AGENT); }
__device__ __forceinline__ unsigned xb_xcc_id() { return (unsigned)__builtin_amdgcn_s_getreg((3 << 11) | 20) & 0xFu; }
#define XB_SPIN(cond, bar) do { unsigned _sp = 0; while (cond) { __builtin_amdgcn_s_sleep(1); \
    if ((++_sp & 255u) == 0u) { if (xb_ld(&(bar)[XB_TMO])) break; if (_sp > XB_SPIN_CAP) { atomicAdd(&(bar)[XB_TMO], 1u); break; } } } } while (0)
struct XcdBarrier { unsigned* bar; unsigned x; volatile LAS unsigned* st; unsigned expected; };
__device__ __forceinline__ XcdBarrier xcd_barrier_post(unsigned* bar, volatile LAS unsigned* st, unsigned expected, bool member) {
    XcdBarrier b; b.bar = bar; b.x = xb_xcc_id(); b.st = st; b.expected = expected;
    if (member && threadIdx.x == 0) (void)xb_add(&bar[XB_XCNT(b.x)], 1u);
    return b;
}
__device__ __forceinline__ void xcd_barrier_complete(unsigned* bar, unsigned x, unsigned& nloc, unsigned& nx, const unsigned G) {
    unsigned sum, cnt, mine, sp = 0u;
    for (;;) {
        sum = 0u; cnt = 0u; mine = 0u;
#pragma unroll
        for (unsigned j = 0; j < 16; ++j) { const unsigned c = xb_ld(&bar[XB_XCNT(j)]); sum += c; cnt += (c > 0u) ? 1u : 0u; mine = (j == x) ? c : mine; }
        if (sum == G) break;
        __builtin_amdgcn_s_sleep(1);
        if ((++sp & 255u) == 0u) { if (xb_ld(&bar[XB_TMO])) break; if (sp > XB_SPIN_CAP) { atomicAdd(&bar[XB_TMO], 1u); break; } }
    }
    nloc = mine > 0u ? mine : 1u; nx = cnt > 0u ? cnt : 1u;
}
__device__ __forceinline__ void xcd_barrier(const XcdBarrier& b, const int tid) {
    asm volatile("s_waitcnt vmcnt(0)" ::: "memory");
    __syncthreads();
    if (tid == 0) {
        unsigned* bar = b.bar;
        __builtin_amdgcn_s_waitcnt(0);
        unsigned nloc = b.st[0], nx = b.st[1];
        if (nloc == 0u) { xcd_barrier_complete(bar, b.x, nloc, nx, b.expected); b.st[0] = nloc; b.st[1] = nx; }
        const unsigned old = xb_add(&bar[XB_XSUB(b.x)], 1u);
        const unsigned gen = old / nloc;
        if (old + 1u == (gen + 1u) * nloc) {
            __builtin_amdgcn_fence(__ATOMIC_RELEASE, "agent");
            asm volatile("s_waitcnt vmcnt(0)" ::: "memory");
            const unsigned og = xb_add(&bar[XB_TOP], 1u);
            const unsigned tg = og / nx;
            if (og + 1u == (tg + 1u) * nx) xb_add(&bar[XB_TOPGEN], 1u);
            else XB_SPIN(xb_ld(&bar[XB_TOPGEN]) == tg, bar);
            __builtin_amdgcn_fence(__ATOMIC_ACQUIRE, "agent");
            xb_add(&bar[XB_XGEN(b.x)], 1u);
            asm volatile("s_waitcnt vmcnt(0)" ::: "memory");
        } else {
            XB_SPIN(xb_ld(&bar[XB_XGEN(b.x)]) == gen, bar);
            __builtin_amdgcn_fence(__ATOMIC_ACQUIRE, "agent");
            asm volatile("s_waitcnt vmcnt(0)" ::: "memory");
        }
    }
    __syncthreads();
}

constexpr float FP8_WMUL = 32.0f, FP8_AMUL = 4.0f, FP8_DESCALE = 1.0f / (32.0f * 4.0f);
#if PROBE_PH == -2
#define GMARK(k) do { if (Sched::GATHER && ui == 0 && blockIdx.x == 0 && tid == 0) { volatile LAS unsigned long long* pm_ = (volatile LAS unsigned long long*)(lds + MISC_OFF + 128); \
    if ((k) == PROBE_A) pm_[0] = __builtin_amdgcn_s_memrealtime(); if ((k) == PROBE_B) pm_[1] = __builtin_amdgcn_s_memrealtime(); } } while (0)
#define GMARK1(k) do { if (Sched::GATHER && ui == 1 && blockIdx.x == 0 && tid == 0) { volatile LAS unsigned long long* pm_ = (volatile LAS unsigned long long*)(lds + MISC_OFF + 128); \
    if ((k) == PROBE_A) pm_[0] = __builtin_amdgcn_s_memrealtime(); if ((k) == PROBE_B) pm_[1] = __builtin_amdgcn_s_memrealtime(); } } while (0)
#else
#define GMARK(k) do { } while (0)
#define GMARK1(k) do { } while (0)
#endif
namespace pg8 {
constexpr int BM = 256, BK = 64, HALF = 128, HTB = HALF * BK * 2, STAGE_BYTES = 8 * HTB, KD = 1024  ;
__host__ __device__ __forceinline__ int lds_byte(int r, int c) { const int st = (r >> 4) * 2 + (c >> 5), rr = r & 15, cc = c & 31, ob = rr * 64 + cc * 2; return st * 1024 + (ob ^ (((ob >> 9) & 1) << 5)); }
__host__ __device__ __forceinline__ void stage_rc(int b, int& R, int& C) { const int st = b / 1024, sb = b % 1024, swz = sb ^ (((sb >> 9) & 1) << 5); R = (st >> 1) * 16 + swz / 64; C = (st & 1) * 32 + (swz % 64) / 2; }
__host__ __device__ __forceinline__ int perm32(int rho) { const int n = rho >> 4, i = rho & 15; return 8 * (i >> 2) + 4 * n + (i & 3); }

typedef int v8i_t __attribute__((ext_vector_type(8)));
__device__ __forceinline__ v8i_t cat8(bf16x8 a, bf16x8 b) { typedef int v4i_t __attribute__((ext_vector_type(4))); const v4i_t x = __builtin_bit_cast(v4i_t, a), y = __builtin_bit_cast(v4i_t, b); return __builtin_shufflevector(x, y, 0, 1, 2, 3, 4, 5, 6, 7); }
struct Unit { int pm, pn, e, cnt, idx; };

template <class Epi, class Sched>
__device__ __forceinline__ void gemm_phase(LAS unsigned char* lds, const Sched& S, const Epi& E, const int tid) {
    const int wid = __builtin_amdgcn_readfirstlane(tid >> 6), lane = tid & 63, wr = wid >> 2, wc = wid & 3, fr = lane & 15, fq = lane >> 4;
    constexpr int RP = Sched::FP8 ? 1024 : 2048  , nt = RP / 128;
    int Rr[2], Cc[2];
    unsigned voffA[2][2], voffB[2];
#pragma unroll
    for (int i = 0; i < 2; ++i) { stage_rc(tid * 16 + i * 8192, Rr[i], Cc[i]); const int Rb = Epi::PERM ? ((Rr[i] & ~31) + perm32(Rr[i] & 31)) : Rr[i];
        voffB[i] = (unsigned)(Rb * RP + Cc[i] * 2); }
    constexpr size_t kstep = (size_t)(BK * 2);
    constexpr size_t hstep = (size_t)HALF * RP;
    const unsigned ldsw = (unsigned)wid * 1024u;
    const int aoff = lds_byte(wr * 64 + fr, fq * 8), boff = lds_byte(wc * 32 + fr, fq * 8);
#define PG8_SA(b, h) (((b) * 2 + (h)) * HTB)
#define PG8_SB(b, h) ((4 + (b) * 2 + (h)) * HTB)
#define PG8_STAGE(bufoff, gbase, voff) do { _Pragma("unroll") for (int _i = 0; _i < 2; ++_i) \
        __builtin_amdgcn_global_load_lds((const unsigned*)((const char*)(gbase) + (voff)[_i]), (LAS unsigned*)(lds + (bufoff) + ldsw + _i * 8192), 16, 0, 0); } while (0)
#define PG8_STAGEA1(bufoff, gbase) do { if constexpr (Sched::GATHER) { PG8_STAGE(bufoff, gbase, voffA[1]); } else { PG8_STAGE(bufoff, (gbase) + hstep, voffA[0]); } } while (0)
#define PG8_LDA(dst, b, h) do { _Pragma("unroll") for (int m = 0; m < 4; ++m) _Pragma("unroll") for (int k = 0; k < 2; ++k) dst[m][k] = *(const LAS bf16x8*)(lds + PG8_SA(b, h) + aoff + m * 2048 + k * 1024); } while (0)
#define PG8_LDB(dst, b, h) do { _Pragma("unroll") for (int n = 0; n < 2; ++n) _Pragma("unroll") for (int k = 0; k < 2; ++k) dst[n][k] = *(const LAS bf16x8*)(lds + PG8_SB(b, h) + boff + n * 2048 + k * 1024); } while (0)
#define PG8_MMA(ai, bj, At, Bt) do { __builtin_amdgcn_s_setprio(1); _Pragma("unroll") for (int m = 0; m < 4; ++m) _Pragma("unroll") for (int n = 0; n < 2; ++n) { \
        if constexpr (Sched::FP8) { acc[ai][bj][m][n] = __builtin_amdgcn_mfma_scale_f32_16x16x128_f8f6f4(cat8(Bt[n][0], Bt[n][1]), cat8(At[m][0], At[m][1]), acc[ai][bj][m][n], 0, 0, 0, 0, 0, 0); } \
        else { _Pragma("unroll") for (int k = 0; k < 2; ++k) acc[ai][bj][m][n] = __builtin_amdgcn_mfma_f32_16x16x32_bf16(Bt[n][k], At[m][k], acc[ai][bj][m][n], 0, 0, 0); } } \
        __builtin_amdgcn_s_setprio(0); } while (0)
#define PG8_WAIT_V(n) asm volatile("s_waitcnt vmcnt(" #n ")" ::: "memory")
#define PG8_WAIT_L(n) asm volatile("s_waitcnt lgkmcnt(" #n ")" ::: "memory")
#define PG8_BAR __builtin_amdgcn_s_barrier()
#define PG8_SCHED __builtin_amdgcn_sched_barrier(0)
    Unit cur, nxt; int ui = 0;
    if (!S.next(0, cur)) return;
    S.a_voff(cur, voffA, Rr, Cc);
    f32x4 acc[2][2][4][2];
#pragma unroll
    for (int a = 0; a < 2; ++a)
#pragma unroll
        for (int b = 0; b < 2; ++b)
#pragma unroll
            for (int m = 0; m < 4; ++m)
#pragma unroll
                for (int n = 0; n < 2; ++n) acc[a][b][m][n] = (f32x4){0.f, 0.f, 0.f, 0.f};
    bf16x8 At[4][2], B0[2][2], B1[2][2];
    const char* cA = S.a_ptr(cur); const char* cB = S.b_ptr(cur);
    PG8_STAGE(PG8_SB(0, 0), cB, voffB); PG8_STAGE(PG8_SB(0, 1), cB + hstep, voffB); PG8_STAGE(PG8_SA(0, 0), cA, voffA[0]); PG8_STAGEA1(PG8_SA(0, 1), cA);
    if (wr == 1) PG8_BAR;
    PG8_WAIT_V(2); PG8_BAR;
    PG8_STAGE(PG8_SB(1, 0), cB + kstep, voffB); PG8_STAGE(PG8_SA(1, 0), cA + kstep, voffA[0]); PG8_STAGE(PG8_SB(1, 1), cB + hstep + kstep, voffB);
    PG8_WAIT_V(6); PG8_BAR;
    for (;;) {
        const bool has_next = S.next(ui + 1, nxt);
        const char* nA = has_next ? S.a_ptr(nxt) : cA; const char* nB = has_next ? S.b_ptr(nxt) : cB;
#pragma unroll 1
        for (int t = 0; t < nt; t += 2) {
            const bool last = (t == nt - 2);
            if (last) GMARK(40); if (t == 2) GMARK1(45);
            const char* a1 = cA + (size_t)(t + 1) * kstep;
            const char* a2 = last ? nA : cA + (size_t)(t + 2) * kstep; const char* b2 = last ? nB : cB + (size_t)(t + 2) * kstep;
            const char* a3 = a2 + kstep; const char* b3 = b2 + kstep;
            asm volatile("" : "+s"(a1), "+s"(a2), "+s"(a3), "+s"(b2), "+s"(b3));
            PG8_LDB(B0, 0, 0); PG8_LDB(B1, 0, 1); PG8_SCHED; PG8_LDA(At, 0, 0); PG8_STAGEA1(PG8_SA(1, 1), a1);
            if (Sched::GATHER) { if (last && has_next) S.a_voff(nxt, voffA, Rr, Cc); }
            PG8_WAIT_V(8); PG8_WAIT_L(0); PG8_BAR; PG8_MMA(0, 0, At, B0); PG8_MMA(0, 1, At, B1); PG8_BAR; PG8_SCHED;
            PG8_LDA(At, 0, 1); PG8_STAGE(PG8_SB(0, 0), b2, voffB); PG8_STAGE(PG8_SB(0, 1), b2 + hstep, voffB); PG8_STAGE(PG8_SA(0, 0), a2, voffA[0]);
            PG8_WAIT_V(8); PG8_WAIT_L(0); PG8_BAR; PG8_MMA(1, 0, At, B0); PG8_MMA(1, 1, At, B1); PG8_BAR; PG8_SCHED;
            PG8_LDB(B0, 1, 0); PG8_LDB(B1, 1, 1); PG8_SCHED; PG8_LDA(At, 1, 0); PG8_STAGEA1(PG8_SA(0, 1), a2);
            PG8_WAIT_V(8); PG8_WAIT_L(0); PG8_BAR; PG8_MMA(0, 0, At, B0); PG8_MMA(0, 1, At, B1); PG8_BAR; PG8_SCHED;
            PG8_LDA(At, 1, 1); PG8_STAGE(PG8_SB(1, 0), b3, voffB); PG8_STAGE(PG8_SB(1, 1), b3 + hstep, voffB); PG8_STAGE(PG8_SA(1, 0), a3, voffA[0]);
            PG8_WAIT_V(8); PG8_WAIT_L(0); PG8_BAR; PG8_MMA(1, 0, At, B0); PG8_MMA(1, 1, At, B1); PG8_BAR; PG8_SCHED;
        }
        GMARK(41);
        if (wr == 0) PG8_BAR;
        GMARK(42);
        E(acc, cur, wr, wc, fr, fq);
        GMARK(43);
        if (!has_next) break;
#pragma unroll
        for (int a = 0; a < 2; ++a)
#pragma unroll
            for (int b = 0; b < 2; ++b)
#pragma unroll
                for (int m = 0; m < 4; ++m)
#pragma unroll
                    for (int n = 0; n < 2; ++n) acc[a][b][m][n] = (f32x4){0.f, 0.f, 0.f, 0.f};
        cur = nxt; cA = nA; cB = nB; ++ui;
        if (wr == 1) PG8_BAR;
    }
    PG8_WAIT_V(0);
    PG8_BAR;
#undef PG8_SA
#undef PG8_SB
#undef PG8_STAGE
#undef PG8_STAGEA1
#undef PG8_LDA
#undef PG8_LDB
#undef PG8_MMA
#undef PG8_WAIT_V
#undef PG8_WAIT_L
#undef PG8_BAR
#undef PG8_SCHED
}
}

struct Args { const float* in[33]; float* out; unsigned char* ws; int ph_lo, ph_hi, li, pad; };
enum { I_X = 0, I_C, I_CTX, I_CCTX, I_ADAW, I_ADAB, I_NMG, I_NFG, I_EWIN, I_EBIN, I_ECW, I_ECB, I_ELNG, I_ELNB, I_QNG, I_KNG, I_SINK, I_EWOUT, I_EBOUT,
       I_OWIN, I_OBIN, I_OLNG, I_OLNB, I_OWS, I_OBS, I_OWOUT, I_OBOUT, I_RW, I_RB, I_W1, I_B1, I_W2, I_B2 };

typedef const __attribute__((address_space(4))) unsigned long long* kargp_t;
struct Ctx {
    LAS unsigned char* lds; int tid, lane, wave, G, vcu, gw, NGW, bid; unsigned char* ws; kargp_t kp;
};
__device__ __forceinline__ const float* in_ptr(const Ctx& X, int i) { return (const float*)(const __attribute__((address_space(1))) float*)X.kp[i]; }
#define IN(i) in_ptr(X, (i))
#if PROBE_PH == -2
#define PMARK(k) do { if (X.bid == 0 && X.tid == 0) { volatile LAS unsigned long long* pm_ = (volatile LAS unsigned long long*)(X.lds + MISC_OFF + 128); \
    if ((k) == PROBE_A) pm_[0] = __builtin_amdgcn_s_memrealtime(); if ((k) == PROBE_B) pm_[1] = __builtin_amdgcn_s_memrealtime(); } } while (0)
#else
#define PMARK(k) do { } while (0)
#endif

struct DenseSched {
    static constexpr bool GATHER = false, FP8 = false;
    const bf16* A; const bf16* Bt; int nM, nN, nwg, G, c;
    const bf16* A2; const bf16* Bt2; int nM2;
    __device__ __forceinline__ void init(const bf16* A_, const bf16* Bt_, int M, int N, int G_, int c_) { A = A_; Bt = Bt_; nM = M / 256; nN = N / 256; nwg = nM * nN; G = G_; c = c_; A2 = nullptr; Bt2 = nullptr; nM2 = 0; }
    __device__ __forceinline__ bool next(int i, pg8::Unit& u) const {
        const int L = i * G + c; if (L >= nwg + nM2) return false; u.idx = i;
        if (L >= nwg) { u.pm = L - nwg; u.pn = 0; u.e = 1; u.cnt = 256; return true; }
        int wgid = L; { const int q = nwg / 8, r = nwg % 8, xcd = wgid % 8, off = wgid / 8; wgid = (xcd < r ? xcd * (q + 1) : r * (q + 1) + (xcd - r) * q) + off; }
        const int nig = 8 * nN, gid = wgid / nig, fm = gid * 8, gsz = (nM - fm) < 8 ? (nM - fm) : 8;
        u.pm = fm + ((wgid % nig) % gsz); u.pn = (wgid % nig) / gsz; u.e = 0; u.cnt = 256; return true;
    }
    __device__ __forceinline__ const char* a_ptr(const pg8::Unit& u) const { return (const char*)(u.e ? A2 : A) + (size_t)u.pm * 256 * pg8::KD * 2; }
    __device__ __forceinline__ const char* b_ptr(const pg8::Unit& u) const { return (const char*)(u.e ? Bt2 : Bt) + (size_t)u.pn * 256 * pg8::KD * 2; }
    __device__ __forceinline__ void a_voff(const pg8::Unit&, unsigned (&v)[2][2], const int (&R)[2], const int (&C)[2]) const {
#pragma unroll
        for (int i = 0; i < 2; ++i) { v[0][i] = (unsigned)(R[i] * pg8::KD + C[i]) * 2u; v[1][i] = v[0][i] + (unsigned)(pg8::HALF * pg8::KD * 2); }
    }
};
template <bool GATHER_, int NTILE_N>
struct MoeSchedT {
    static constexpr bool GATHER = GATHER_, FP8 = true; static constexpr int RP = 1024;
    const LAS int* tab; int G, c;
    const unsigned char* A;
    const unsigned char* Bt;
    const int* list;
    const LAS int* meta;
    __device__ __forceinline__ bool next(int i, pg8::Unit& u) const {
        const int L = i * G + c; const int T = tab[0];
        if (L >= T * NTILE_N) return false;
        u.idx = i;
        const int mt = L / NTILE_N; u.pn = L % NTILE_N;
        const int w = __builtin_amdgcn_readfirstlane(tab[1 + mt]); u.e = w >> 16; const int tl = w & 0xffff;
        const int cnt = __builtin_amdgcn_readfirstlane(tab[512 + u.e]), pb = __builtin_amdgcn_readfirstlane(tab[544 + u.e]);
        u.pm = pb + tl * 256; u.cnt = cnt - tl * 256;
        return true;
    }
    __device__ __forceinline__ const char* a_ptr(const pg8::Unit& u) const { return GATHER ? (const char*)A : (const char*)A + (size_t)u.pm * RP; }
    __device__ __forceinline__ const char* b_ptr(const pg8::Unit& u) const { return (const char*)Bt + ((size_t)u.e * NTILE_N + u.pn) * 256 * RP; }
    __device__ __forceinline__ void a_voff(const pg8::Unit& u, unsigned (&v)[2][2], const int (&R)[2], const int (&C)[2]) const {
        if (GATHER) {
#pragma unroll
            for (int h = 0; h < 2; ++h)
#pragma unroll
                for (int i = 0; i < 2; ++i) { const int tok = meta[u.idx * 256 + h * 128 + R[i]]; v[h][i] = (unsigned)(tok * RP + C[i] * 2); }
        } else {
#pragma unroll
            for (int i = 0; i < 2; ++i) { v[0][i] = (unsigned)(R[i] * RP + C[i] * 2); v[1][i] = v[0][i] + (unsigned)(pg8::HALF * RP); }
        }
    }
};
__device__ __forceinline__ void moe_build_table(const Ctx& X, const int* cnt  ) {
    LAS int* tab = (LAS int*)(X.lds + TAB_OFF);
    __syncthreads();
    if (X.tid < 64) {
        const int e = X.lane; int c = 0; if (e < NE) c = __hip_atomic_load(cnt + e * CNT_STRIDE, __ATOMIC_RELAXED, __HIP_MEMORY_SCOPE_AGENT);
        const int mt = (c + 255) >> 8; int incl = mt;
#pragma unroll
        for (int off = 1; off < 32; off <<= 1) { const int v = __shfl_up(incl, off); if (X.lane >= off) incl += v; }
        const int start = incl - mt;
        if (e < NE) { tab[512 + e] = c; tab[544 + e] = start * 256; for (int t = 0; t < mt; ++t) tab[1 + start + t] = (e << 16) | t; if (e == NE - 1) tab[0] = incl; }
    }
    __syncthreads();
}
template <bool WITH_GATE, class Sched>
__device__ __forceinline__ void moe_stage_meta(const Ctx& X, const Sched& S, const int* list, const float* gatew, LAS int* meta, const float* bias, LAS float* lbias) {
    if (X.tid < 256) { pg8::Unit u;
        for (int i = 0; S.next(i, u); ++i) { const int slot0 = u.pm - S.tab[544 + u.e]; const int r = X.tid < u.cnt ? X.tid : u.cnt - 1;
            const int aid = list[(size_t)u.e * NTOK + slot0 + r];
            if (WITH_GATE) { const float g = gatew[aid]; *(LAS u32x2*)(meta + (i * 256 + X.tid) * 2) = (u32x2){(unsigned)aid, __float_as_uint(g)}; }
            else meta[i * 256 + X.tid] = aid >> 2; } }
    else { const int c = X.tid - 256; pg8::Unit u;
        for (int i = 0; S.next(i, u); ++i) lbias[i * 256 + c] = WITH_GATE ? bias[(size_t)u.e * D + u.pn * 256 + c] : bias[(size_t)u.e * 2048 + (c >> 7) * 1024 + u.pn * 128 + (c & 127)]; }
    __syncthreads();
}

__device__ __forceinline__ f32x2 gelu_pk(f32x2 v) {
    const f32x2 av = __builtin_elementwise_abs(v), d = av * 0.2316418882f + 1.0f;
    f32x2 t; t.x = __builtin_amdgcn_rcpf(d.x); t.y = __builtin_amdgcn_rcpf(d.y);
    f32x2 q = t * 0.5307027145f + (-0.7265760135f); q = q * t + 0.7107068705f; q = q * t + (-0.142248368f); q = q * t + 0.127414796f; q = q * t;
    const f32x2 s = (v * v) * (-0.72134752044f);
    f32x2 e; e.x = __builtin_amdgcn_exp2f(s.x); e.y = __builtin_amdgcn_exp2f(s.y);
    const f32x2 m = v * (q * e), r = v - m;
    f32x2 o; o.x = v.x < 0.f ? m.x : r.x; o.y = v.y < 0.f ? m.y : r.y; return o;
}
__device__ __forceinline__ u32x4 pack8(f32x4 a, f32x4 b) { u32x4 w; w.x = pk2(a[0], a[1]); w.y = pk2(a[2], a[3]); w.z = pk2(b[0], b[1]); w.w = pk2(b[2], b[3]); return w; }

struct EpiIn {
    static constexpr bool PERM = true;
    bf16 *GLU, *Q, *Kb, *Vb, *KC, *VC; const float* bias;
    __device__ __forceinline__ void operator()(const f32x4 (&acc)[2][2][4][2], const pg8::Unit& u, int wr, int wc, int fr, int fq) const {
        asm volatile("" : "+v"(fr), "+v"(fq));
        const int row0 = u.pm * 256 + wr * 64 + fr; const int c8 = wc * 32 + 8 * fq;
        if (u.e == 0 && u.pn < 4) {
            const int j0 = u.pn * 128 + c8;
            f32x4 bu[2], bg[2];
#pragma unroll
            for (int n = 0; n < 2; ++n) { bu[n] = *(const f32x4*)(bias + j0 + 4 * n); bg[n] = *(const f32x4*)(bias + 512 + j0 + 4 * n); }
#pragma unroll
            for (int ai = 0; ai < 2; ++ai)
#pragma unroll
                for (int m = 0; m < 4; ++m) { f32x4 o[2];
#pragma unroll
                    for (int n = 0; n < 2; ++n) { const f32x4 uu = acc[ai][0][m][n] + bu[n], gg = acc[ai][1][m][n] + bg[n];
#pragma unroll
                        for (int k = 0; k < 4; ++k) o[n][k] = uu[k] * sigmoidf_(gg[k]); }
                    *(u32x4*)(GLU + (size_t)(row0 + ai * 128 + m * 16) * 512 + j0) = pack8(o[0], o[1]); }
        } else {
#pragma unroll
            for (int bj = 0; bj < 2; ++bj) {
                bf16* dst; int ld, col, bcol;
                if (u.pn >= 6 || u.e) { dst = u.e ? (bj ? VC : KC) : (bj ? Vb : Kb); ld = 128; col = c8; bcol = KV_COL + bj * 128 + c8; }
                else { dst = Q; ld = 512; col = (u.pn - 4) * 256 + bj * 128 + c8; bcol = 1024 + col; }
                f32x4 bv[2];
#pragma unroll
                for (int n = 0; n < 2; ++n) bv[n] = *(const f32x4*)(bias + bcol + 4 * n);
#pragma unroll
                for (int ai = 0; ai < 2; ++ai)
#pragma unroll
                    for (int m = 0; m < 4; ++m) *(u32x4*)(dst + (size_t)(row0 + ai * 128 + m * 16) * ld + col) = pack8(acc[ai][bj][m][0] + bv[0], acc[ai][bj][m][1] + bv[1]);
            }
        }
    }
};
template <bool BASE_F32> struct EpiRes {
    static constexpr bool PERM = true;
    const void* base; bf16* out; const float* bias; const float* gate;
    __device__ __forceinline__ void operator()(const f32x4 (&acc)[2][2][4][2], const pg8::Unit& u, int wr, int wc, int fr, int fq) const {
        asm volatile("" : "+v"(fr), "+v"(fq));
        const int col0 = u.pn * 256 + wc * 32 + 8 * fq; const int b = (u.pm * 256) / SEQ;
#pragma unroll
        for (int bj = 0; bj < 2; ++bj) {
            f32x4 bv[2], gv[2];
#pragma unroll
            for (int n = 0; n < 2; ++n) { bv[n] = *(const f32x4*)(bias + col0 + bj * 128 + 4 * n); gv[n] = *(const f32x4*)(gate + (size_t)b * MODW + col0 + bj * 128 + 4 * n); }
#pragma unroll
            for (int ai = 0; ai < 2; ++ai)
#pragma unroll
                for (int m = 0; m < 4; ++m) { const size_t off = (size_t)(u.pm * 256 + ai * 128 + wr * 64 + m * 16 + fr) * D + col0 + bj * 128;
                    f32x4 b0, b1;
                    if (BASE_F32) { b0 = *(const f32x4*)((const float*)base + off); b1 = *(const f32x4*)((const float*)base + off + 4); }
                    else { const u32x4 w = *(const u32x4*)((const bf16*)base + off); b0 = (f32x4){bf2f(w.x & 0xffffu), bf2f(w.x >> 16), bf2f(w.y & 0xffffu), bf2f(w.y >> 16)}; b1 = (f32x4){bf2f(w.z & 0xffffu), bf2f(w.z >> 16), bf2f(w.w & 0xffffu), bf2f(w.w >> 16)}; }
                    *(u32x4*)(out + off) = pack8(b0 + gv[0] * (acc[ai][bj][m][0] + bv[0]), b1 + gv[1] * (acc[ai][bj][m][1] + bv[1])); }
        }
    }
};
struct EpiGelu {
    static constexpr bool PERM = true;
    bf16 *U, *V; const float* bias; float* vstat;
    __device__ __forceinline__ void operator()(const f32x4 (&acc)[2][2][4][2], const pg8::Unit& u, int wr, int wc, int fr, int fq) const {
        asm volatile("" : "+v"(fr), "+v"(fq));
        const int row0 = u.pm * 256 + wr * 64 + fr; const int colt = u.pn * 256; const bool isv = colt >= 1024; bf16* base = isv ? V : U; const int cb = (colt & 1023) + wc * 32 + 8 * fq, bcol = colt + wc * 32 + 8 * fq;
        f32x4 bv[2][2];
#pragma unroll
        for (int bj = 0; bj < 2; ++bj)
#pragma unroll
            for (int n = 0; n < 2; ++n) bv[bj][n] = *(const f32x4*)(bias + bcol + bj * 128 + 4 * n);
#pragma unroll
        for (int ai = 0; ai < 2; ++ai)
#pragma unroll
            for (int m = 0; m < 4; ++m) { const int row = row0 + ai * 128 + m * 16; bf16* rowp = base + (size_t)row * D + cb; float s = 0.f, s2 = 0.f;
#pragma unroll
                for (int bj = 0; bj < 2; ++bj) { f32x4 v0 = acc[ai][bj][m][0] + bv[bj][0], v1 = acc[ai][bj][m][1] + bv[bj][1];
                    f32x2 a = gelu_pk((f32x2){v0[0], v0[1]}), b = gelu_pk((f32x2){v0[2], v0[3]}), c = gelu_pk((f32x2){v1[0], v1[1]}), d = gelu_pk((f32x2){v1[2], v1[3]});
                    s += (a.x + a.y) + (b.x + b.y) + (c.x + c.y) + (d.x + d.y); s2 += (a.x * a.x + a.y * a.y) + (b.x * b.x + b.y * b.y) + (c.x * c.x + c.y * c.y) + (d.x * d.x + d.y * d.y);
                    *(u32x4*)(rowp + bj * 128) = pack8((f32x4){a.x, a.y, b.x, b.y}, (f32x4){c.x, c.y, d.x, d.y}); }
                if (isv) { s += __shfl_xor(s, 16); s += __shfl_xor(s, 32); s2 += __shfl_xor(s2, 16); s2 += __shfl_xor(s2, 32);
                    if (fq == 0) { unsafeAtomicAdd(vstat + 2 * row, s); unsafeAtomicAdd(vstat + 2 * row + 1, s2); } } }
    }
};
struct EpiSwiglu {
    static constexpr bool PERM = true;
    unsigned char* ACT; const LAS float* lbias;
    __device__ __forceinline__ void operator()(const f32x4 (&acc)[2][2][4][2], const pg8::Unit& u, int wr, int wc, int fr, int fq) const {
        asm volatile("" : "+v"(fr), "+v"(fq));
        const int j0 = u.pn * 128 + wc * 32 + 8 * fq; const LAS float* bb = lbias + u.idx * 256 + wc * 32 + 8 * fq;
        f32x4 bg[2], bu[2];
#pragma unroll
        for (int n = 0; n < 2; ++n) { bg[n] = *(const LAS f32x4*)(bb + 4 * n); bu[n] = *(const LAS f32x4*)(bb + 128 + 4 * n); }
#pragma unroll
        for (int ai = 0; ai < 2; ++ai)
#pragma unroll
            for (int m = 0; m < 4; ++m) { f32x4 o[2];
#pragma unroll
                for (int n = 0; n < 2; ++n) { const f32x4 g4 = acc[ai][0][m][n] * FP8_DESCALE + bg[n], u4 = acc[ai][1][m][n] * FP8_DESCALE + bu[n];
#pragma unroll
                    for (int k = 0; k < 4; ++k) { const float g = fminf(g4[k], 7.0f), up = fminf(fmaxf(u4[k], -7.0f), 7.0f); o[n][k] = (up + 1.0f) * g * sigmoidf_(g * 1.702f); } }
                u32x2 w8; w8.x = pk4_fp8(o[0][0] * FP8_AMUL, o[0][1] * FP8_AMUL, o[0][2] * FP8_AMUL, o[0][3] * FP8_AMUL); w8.y = pk4_fp8(o[1][0] * FP8_AMUL, o[1][1] * FP8_AMUL, o[1][2] * FP8_AMUL, o[1][3] * FP8_AMUL);
                *(u32x2*)(ACT + (size_t)(u.pm + ai * 128 + wr * 64 + m * 16 + fr) * D + j0) = w8; }
    }
};
struct EpiDown {
    static constexpr bool PERM = true;
    bf16* Y; const LAS float* lbias; const LAS int* meta;
    __device__ __forceinline__ void operator()(const f32x4 (&acc)[2][2][4][2], const pg8::Unit& u, int wr, int wc, int fr, int fq) const {
        asm volatile("" : "+v"(fr), "+v"(fq));
        const int c8 = u.pn * 256 + wc * 32 + 8 * fq; const LAS float* bb = lbias + u.idx * 256 + wc * 32 + 8 * fq;
#pragma unroll
        for (int bj = 0; bj < 2; ++bj) {
            f32x4 bv[2];
#pragma unroll
            for (int n = 0; n < 2; ++n) bv[n] = *(const LAS f32x4*)(bb + bj * 128 + 4 * n);
#pragma unroll
            for (int ai = 0; ai < 2; ++ai)
#pragma unroll
                for (int m = 0; m < 4; ++m) { const int r = ai * 128 + wr * 64 + m * 16 + fr; const u32x2 mg = *(const LAS u32x2*)(meta + (u.idx * 256 + r) * 2); const int aid = (int)mg.x; const float g = __uint_as_float(mg.y);
                    const u32x4 w = pack8((acc[ai][bj][m][0] * FP8_DESCALE + bv[0]) * g, (acc[ai][bj][m][1] * FP8_DESCALE + bv[1]) * g);
                    if (r < u.cnt) *(u32x4*)(Y + (size_t)aid * D + c8 + bj * 128) = w; }
        }
    }
};

struct TrItem { const float* src; bf16* dst; int N; int fp8; };
__device__ __forceinline__ void tr_load(const TrItem& t, float (&v)[32], int lane) {
#pragma unroll
    for (int i = 0; i < 32; ++i) v[i] = __builtin_nontemporal_load(t.src + (size_t)(2 * i + (lane >> 5)) * t.N + (lane & 31));
}
__device__ __forceinline__ void tr_store(const TrItem& t, const float (&v)[32], LAS float* scr, int lane) {
#pragma unroll
    for (int i = 0; i < 32; ++i) scr[(2 * i + (lane >> 5)) * 33 + (lane & 31)] = v[i];
    LDS_WAIT();
    if (t.fp8) {
        const int q = lane & 3;
#pragma unroll
        for (int j = 0; j < 2; ++j) { const int n = (lane >> 2) + 16 * j; const LAS float* s = scr + (16 * q) * 33 + n; u32x4 o;
#pragma unroll
            for (int c = 0; c < 4; ++c) o[c] = pk4_fp8(s[(4 * c) * 33] * FP8_WMUL, s[(4 * c + 1) * 33] * FP8_WMUL, s[(4 * c + 2) * 33] * FP8_WMUL, s[(4 * c + 3) * 33] * FP8_WMUL);
            *(u32x4*)((unsigned char*)t.dst + (size_t)n * 1024 + 16 * q) = o; }
    } else {
        const int c = lane & 7;
#pragma unroll
        for (int j = 0; j < 4; ++j) { const int n = (lane >> 3) + 8 * j; const LAS float* s = scr + (8 * c) * 33 + n;
            u32x4 o; o.x = pk2(s[0 * 33], s[1 * 33]); o.y = pk2(s[2 * 33], s[3 * 33]); o.z = pk2(s[4 * 33], s[5 * 33]); o.w = pk2(s[6 * 33], s[7 * 33]);
            *(u32x4*)(t.dst + (size_t)n * 1024 + 8 * c) = o; }
    }
    LDS_WAIT();
}
template <int N, bool PAIR> struct MoeCvt {
    static constexpr int STRIPS = N / 512, ITEMS_PER_MAT = 8 * STRIPS;
    static __device__ __forceinline__ void load_half(const float* W, int item, int h, f32x4 (&v)[2][2][4], int wave, int lane) {
        const int mat = item / ITEMS_PER_MAT, q = item % ITEMS_PER_MAT, kb = q / STRIPS, sb = q % STRIPS;
        const float* s = W + (size_t)mat * 1024 * N + (size_t)(128 * kb + 16 * wave + 8 * h) * N + 512 * sb + 4 * lane;
#pragma unroll
        for (int g = 0; g < 2; ++g)
#pragma unroll
            for (int hh = 0; hh < 2; ++hh)
#pragma unroll
                for (int r = 0; r < 4; ++r) v[g][hh][r] = __builtin_nontemporal_load((const f32x4*)(s + (size_t)(4 * g + r) * N + 256 * hh));
    }
    static __device__ __forceinline__ void to_lds_half(const f32x4 (&v)[2][2][4], int h, LAS unsigned* img, int wave, int lane) {
#pragma unroll
        for (int g = 0; g < 2; ++g) { const int kq = 4 * wave + 2 * h + g;
#pragma unroll
            for (int hh = 0; hh < 2; ++hh)
#pragma unroll
                for (int j = 0; j < 4; ++j) { const int rho = 64 * hh + lane + 128 * j;
                    img[rho * 32 + ((kq ^ rho) & 31)] = pk4_fp8(v[g][hh][0][j] * FP8_WMUL, v[g][hh][1][j] * FP8_WMUL, v[g][hh][2][j] * FP8_WMUL, v[g][hh][3][j] * FP8_WMUL); } }
    }
    static __device__ __forceinline__ void store(unsigned char* WT, int item, const LAS unsigned* img, int wave, int lane) {
        const int mat = item / ITEMS_PER_MAT, q = item % ITEMS_PER_MAT, kb = q / STRIPS, sb = q % STRIPS;
        unsigned char* d = WT + (size_t)mat * N * 1024 + 128 * kb;
        const int mi = lane >> 3, c = lane & 7;
#pragma unroll
        for (int st = 0; st < 2; ++st)
#pragma unroll
            for (int j = 0; j < 4; ++j) { const int m = 16 * wave + 8 * st + mi, rho = m + 128 * j, n = 4 * m + j;
                u32x4 o;
#pragma unroll
                for (int i = 0; i < 4; ++i) o[i] = img[rho * 32 + (((4 * c + i) ^ rho) & 31)];
                int drow;
                if (PAIR) { const int h = sb >> 1, rem = 512 * (sb & 1) + n; drow = (rem >> 7) * 256 + h * 128 + (rem & 127); } else drow = 512 * sb + n;
                __builtin_nontemporal_store(o, (u32x4*)(d + (size_t)drow * 1024 + 16 * c)); }
    }
    static __device__ __forceinline__ void run(const float* W, unsigned char* WT, int nitems, int first, int stride, LAS unsigned char* lds, int wave, int lane) {
        f32x4 va[2][2][4], vb[2][2][4]; int it = first, buf = 0;
        if (it < nitems) { load_half(W, it, 0, va, wave, lane); load_half(W, it, 1, vb, wave, lane); }
        while (it < nitems) {
            LAS unsigned* img = (LAS unsigned*)(lds + buf * 65536);
            const int nx = it + stride;
            to_lds_half(va, 0, img, wave, lane); if (nx < nitems) load_half(W, nx, 0, va, wave, lane);
            to_lds_half(vb, 1, img, wave, lane); if (nx < nitems) load_half(W, nx, 1, vb, wave, lane);
            __syncthreads();
            store(WT, it, img, wave, lane);
            it = nx; buf ^= 1;
        }
        __syncthreads();
    }
};

__device__ __forceinline__ int pair_src(int nd, int halfw) { return ((nd & 255) >> 7) * halfw + (nd >> 8) * 128 + (nd & 127); }

__device__ __forceinline__ void phase_moe_convert(const Ctx& X, int first, int stride) {
    MoeCvt<2048, true>::run(IN(I_W1), (unsigned char*)(X.ws + WS_W1T), 64 * MoeCvt<2048, true>::ITEMS_PER_MAT, first, stride, X.lds, X.wave, X.lane);
    MoeCvt<1024, false>::run(IN(I_W2), (unsigned char*)(X.ws + WS_W2T), 64 * MoeCvt<1024, false>::ITEMS_PER_MAT, first, stride, X.lds, X.wave, X.lane);
}
__device__ __forceinline__ void phase_prologue(const Args& a, const Ctx& X, const bool with_moe) {
    PMARK(20);
    {
        LAS float* sc = (LAS float*)X.lds;
        LAS float* red = (LAS float*)(X.lds + 36864);
        float* MOD = (float*)(X.ws + WS_MOD);
        for (int item = X.bid; item < 2 * 96; item += X.G) {
            const int l = item / 96, j0 = (item % 96) * 64;
            for (int idx = X.tid; idx < 9 * 1024; idx += NTHREADS) { const int r = idx >> 10, k = idx & 1023; const float v = r < 8 ? IN(I_C)[r * 1024 + k] : IN(I_CCTX)[k]; sc[idx] = v * sigmoidf_(v); }
            __syncthreads();
            float acc[9];
#pragma unroll
            for (int r = 0; r < 9; ++r) acc[r] = 0.f;
            const float* w = IN(I_ADAW) + (size_t)l * 1024 * MODW + j0 + X.lane;
#pragma unroll 8
            for (int k = X.wave * 128; k < X.wave * 128 + 128; ++k) { const float wv = __builtin_nontemporal_load(w + (size_t)k * MODW);
#pragma unroll
                for (int r = 0; r < 9; ++r) acc[r] += sc[r * 1024 + k] * wv; }
#pragma unroll
            for (int r = 0; r < 9; ++r) red[(X.wave * 9 + r) * 64 + X.lane] = acc[r];
            __syncthreads();
            for (int t = X.tid; t < 9 * 64; t += NTHREADS) { const int r = t >> 6, cidx = t & 63; float s = 0.f;
#pragma unroll
                for (int w8 = 0; w8 < 8; ++w8) s += red[(w8 * 9 + r) * 64 + cidx];
                MOD[((size_t)l * 9 + r) * MODW + j0 + cidx] = s + IN(I_ADAB)[l * MODW + j0 + cidx]; }
            __syncthreads();
        }
    }
    PMARK(21);
    LAS float* scr = (LAS float*)(X.lds + X.wave * 16384);
    bf16* WinT = (bf16*)(X.ws + WS_WINT); bf16* WoutT = (bf16*)(X.ws + WS_WOUTT); bf16* GWinT = (bf16*)(X.ws + WS_GWINT); bf16* GWoutT = (bf16*)(X.ws + WS_GWOUTT);
    bf16* W1T = (bf16*)(X.ws + WS_W1T); bf16* W2T = (bf16*)(X.ws + WS_W2T);
    constexpr int I_IN = 16 * (EVEN_IN / 32), I_OUT = 16 * 32, I_GIN = 16 * 64, I_GOUT = 16 * 32;
    constexpr int NITEMS = I_IN + I_OUT + I_GIN + I_GOUT;
    auto item_of = [&](int it) -> TrItem {
        int r = it; TrItem t; t.fp8 = 0;
        if (r < I_IN) { const int kb = r / 56, nd = (r % 56) * 32; const int ns = nd < 1024 ? pair_src(nd, 512) : nd; t.N = EVEN_IN; t.src = IN(I_EWIN) + (size_t)kb * 64 * EVEN_IN + ns; t.dst = WinT + (size_t)nd * 1024 + kb * 64; return t; } r -= I_IN;
        if (r < I_OUT) { const int kb = r >> 5, nd = (r & 31) * 32; t.N = 1024; t.src = IN(I_EWOUT) + (size_t)kb * 64 * 1024 + nd; t.dst = WoutT + (size_t)nd * 1024 + kb * 64; return t; } r -= I_OUT;
        if (r < I_GIN) { const int kb = r >> 6, nd = (r & 63) * 32; t.N = 2048; t.src = IN(I_OWIN) + (size_t)kb * 64 * 2048 + nd; t.dst = GWinT + (size_t)nd * 1024 + kb * 64; return t; } r -= I_GIN;
        { const int kb = r >> 5, nd = (r & 31) * 32; t.N = 1024; t.src = IN(I_OWOUT) + (size_t)kb * 64 * 1024 + nd; t.dst = GWoutT + (size_t)nd * 1024 + kb * 64; return t; }
    };
    {
        float va[32], vb[32]; int it = X.gw;
        TrItem ta, tb; if (it < NITEMS) { ta = item_of(it); tr_load(ta, va, X.lane); }
        while (it < NITEMS) {
            const int it1 = it + X.NGW; if (it1 < NITEMS) { tb = item_of(it1); tr_load(tb, vb, X.lane); }
            tr_store(ta, va, scr, X.lane);
            if (it1 >= NITEMS) break;
            const int it2 = it1 + X.NGW; if (it2 < NITEMS) { ta = item_of(it2); tr_load(ta, va, X.lane); }
            tr_store(tb, vb, scr, X.lane);
            it = it2;
        }
    }
    __syncthreads();
    if (with_moe) phase_moe_convert(X, X.vcu, X.G);
    PMARK(22);
    { bf16* WsB = (bf16*)(X.ws + WS_WSB); const float* ws = IN(I_OWS);
      for (int i = (X.gw * 64 + X.lane) * 4; i < 8 * 128 * 128; i += X.NGW * 64 * 4) { const f32x4 v = *(const f32x4*)(ws + i); u32x2 o; o.x = pk2(v[0], v[1]); o.y = pk2(v[2], v[3]); *(u32x2*)(WsB + i) = o; } }
}

__device__ __forceinline__ void modulate_row(const float* xrow, const float* g, const float* sh, const float* sc, bf16* orow, int lane, f32x4 (&y)[4]) {
    const f32x4* xr = (const f32x4*)xrow + lane; f32x4 v[4]; float ss = 0.f;
#pragma unroll
    for (int j = 0; j < 4; ++j) { v[j] = xr[64 * j]; ss += (v[j][0] * v[j][0] + v[j][1] * v[j][1]) + (v[j][2] * v[j][2] + v[j][3] * v[j][3]); }
    const float rstd = rsqrtf(wave_sum(ss) * (1.0f / D) + EPS);
#pragma unroll
    for (int j = 0; j < 4; ++j) { const f32x4 gk = ((const f32x4*)g)[lane + 64 * j], sk = ((const f32x4*)sc)[lane + 64 * j], hk = ((const f32x4*)sh)[lane + 64 * j];
        y[j] = v[j] * rstd * gk * (1.0f + sk) + hk;
        u32x2 o; o.x = pk2(y[j][0], y[j][1]); o.y = pk2(y[j][2], y[j][3]); *((u32x2*)orow + lane + 64 * j) = o; }
}
__device__ __forceinline__ void mod0_load(const Ctx& X, int row, f32x4 (&v)[4]) {
    const float* xrow = row < NTOK ? IN(I_X) + (size_t)row * D : IN(I_CTX) + (size_t)(row - NTOK) * D;
#pragma unroll
    for (int j = 0; j < 4; ++j) v[j] = ((const f32x4*)xrow)[X.lane + 64 * j];
}
__device__ __forceinline__ void mod0_finish(const Ctx& X, int row, const f32x4 (&v)[4]) {
    const float* m = (const float*)(X.ws + WS_MOD) + (size_t)(row < NTOK ? row / SEQ : 8) * MODW; const float* g = IN(I_NMG);
    bf16* orow = row < NTOK ? (bf16*)(X.ws + WS_XA) + (size_t)row * D : (bf16*)(X.ws + WS_GM) + (size_t)(row - NTOK) * D;
    f32x4 gk[4], hk[4], sk[4]; float ss = 0.f;
#pragma unroll
    for (int j = 0; j < 4; ++j) { gk[j] = ((const f32x4*)g)[X.lane + 64 * j]; hk[j] = ((const f32x4*)m)[X.lane + 64 * j]; sk[j] = ((const f32x4*)(m + 1024))[X.lane + 64 * j];
        ss += (v[j][0] * v[j][0] + v[j][1] * v[j][1]) + (v[j][2] * v[j][2] + v[j][3] * v[j][3]); }
    const float rstd = rsqrtf(wave_sum(ss) * (1.0f / D) + EPS);
#pragma unroll
    for (int j = 0; j < 4; ++j) { const f32x4 y = v[j] * rstd * gk[j] * (1.0f + sk[j]) + hk[j]; u32x2 o; o.x = pk2(y[0], y[1]); o.y = pk2(y[2], y[3]); *((u32x2*)orow + X.lane + 64 * j) = o; }
}
__device__ __forceinline__ void phase_modulate0(const Args& a, const Ctx& X) {
    constexpr int NR = NTOK + NCTX; f32x4 va[4], vb[4];
    int row = X.gw; if (row < NR) mod0_load(X, row, va);
    while (row < NR) {
        const int r1 = row + X.NGW; if (r1 < NR) mod0_load(X, r1, vb);
        mod0_finish(X, row, va);
        if (r1 >= NR) break;
        const int r2 = r1 + X.NGW; if (r2 < NR) mod0_load(X, r2, va);
        mod0_finish(X, r1, vb);
        row = r2;
    }
}

__device__ __forceinline__ void qk_chunks(bf16* buf, int nchunks, int rowlen, const float* gn, bool rope, float oscale, const Ctx& X, const LAS f32x2* cs) {
    for (int ch = X.gw; ch < nchunks; ch += X.NGW) {
        const int e0 = ch * 512 + 8 * X.lane; const int token = e0 / rowlen; const int d0 = e0 & 63;
        u32x4 raw = *(const u32x4*)(buf + e0); float v[8];
#pragma unroll
        for (int i = 0; i < 4; ++i) { v[2 * i] = bf2f(raw[i] & 0xffffu); v[2 * i + 1] = bf2f(raw[i] >> 16); }
        float ss = 0.f;
#pragma unroll
        for (int i = 0; i < 8; ++i) ss += v[i] * v[i];
        ss += __shfl_xor(ss, 1); ss += __shfl_xor(ss, 2); ss += __shfl_xor(ss, 4);
        const float rstd = rsqrtf(ss * (1.0f / 64.0f) + EPS);
        const f32x4 g0 = *(const f32x4*)(gn + d0), g1 = *(const f32x4*)(gn + d0 + 4);
#pragma unroll
        for (int i = 0; i < 4; ++i) { v[i] = v[i] * rstd * g0[i]; v[4 + i] = v[4 + i] * rstd * g1[i]; }
        if (rope) {
            const int t = token % SEQ; const int dd0 = d0 & 31; const int pos = dd0 < 16 ? (t >> 6) : (t & 63);
            const LAS f32x2* cp = cs + pos * 16 + (dd0 & 15);
#pragma unroll
            for (int i = 0; i < 8; ++i) { const float pv = __shfl_xor(v[i], 4); const f32x2 c = cp[i];
                v[i] = (d0 < 32) ? (v[i] * c.x - pv * c.y) : (v[i] * c.x + pv * c.y); }
        }
        u32x4 o; o.x = pk2(v[0] * oscale, v[1] * oscale); o.y = pk2(v[2] * oscale, v[3] * oscale); o.z = pk2(v[4] * oscale, v[5] * oscale); o.w = pk2(v[6] * oscale, v[7] * oscale);
        *(u32x4*)(buf + e0) = o;
    }
}
__device__ __forceinline__ void phase_conv_qk(const Args& a, const Ctx& X) {
    LAS f32x2* cs = (LAS f32x2*)(X.lds + 65536);
    for (int i = X.tid; i < 1024; i += NTHREADS) { const float inv = exp2f(-(float)(i & 15) * (13.287712379549449f / 16.0f)); float sn, csn; sincosf((float)(i >> 4) * inv, &sn, &csn); cs[i] = (f32x2){csn, sn}; }
    __syncthreads();
    qk_chunks((bf16*)(X.ws + WS_Q), NTOK, 512, IN(I_QNG), true, QSCALE, X, cs);
    qk_chunks((bf16*)(X.ws + WS_K), NTOK / 4, 128, IN(I_KNG), true, 1.0f, X, cs);
    qk_chunks((bf16*)(X.ws + WS_KC), NCTX / 4, 128, IN(I_KNG), false, 1.0f, X, cs);
    const bf16* GLU = (const bf16*)(X.ws + WS_GLU); bf16* MIX = (bf16*)(X.ws + WS_MIX);
    LAS unsigned* tin = (LAS unsigned*)X.lds;
    LAS float* tout = (LAS float*)(X.lds + 65536);
    const int cp = X.tid & 255, th = X.tid >> 8;
    float w0[31], w1[31];
#pragma unroll
    for (int j = 0; j < 31; ++j) { const f32x2 w = *(const f32x2*)(IN(I_ECW) + j * 512 + 2 * cp); w0[j] = w.x; w1[j] = w.y; }
    const f32x2 cb = *(const f32x2*)(IN(I_ECB) + 2 * cp);
    for (int tile = X.bid; tile < NTOK / 32; tile += X.G) {
        const int row0 = tile * 32; const int t0 = row0 % SEQ;
        __syncthreads();
        for (int c = X.tid; c < 62 * 64; c += NTHREADS) { const int lr = c >> 6, cc = c & 63; const int t = t0 - 15 + lr;
            u32x4 v = (u32x4){0u, 0u, 0u, 0u}; if (t >= 0 && t < SEQ) v = *(const u32x4*)(GLU + (size_t)(row0 - 15 + lr) * 512 + cc * 8);
            *(LAS u32x4*)(tin + lr * 256 + cc * 4) = v; }
        __syncthreads();
        float a0[16], a1[16];
#pragma unroll
        for (int o = 0; o < 16; ++o) { a0[o] = cb.x; a1[o] = cb.y; }
#pragma unroll
        for (int rr = 0; rr < 46; ++rr) { const unsigned pv = tin[(16 * th + rr) * 256 + cp]; const float x0 = bf2f(pv & 0xffffu), x1 = bf2f(pv >> 16);
#pragma unroll
            for (int o = 0; o < 16; ++o) { const int j = rr - o; if (j >= 0 && j <= 30) { a0[o] += x0 * w0[j]; a1[o] += x1 * w1[j]; } } }
#pragma unroll
        for (int o = 0; o < 16; ++o) *(LAS f32x2*)(tout + (16 * th + o) * 512 + 2 * cp) = (f32x2){a0[o], a1[o]};
        __syncthreads();
#pragma unroll
        for (int q = 0; q < 4; ++q) { const int tl = X.wave * 4 + q; f32x4 v[2]; float s = 0.f;
#pragma unroll
            for (int j = 0; j < 2; ++j) { v[j] = *(const LAS f32x4*)(tout + tl * 512 + 4 * X.lane + 256 * j); s += (v[j][0] + v[j][1]) + (v[j][2] + v[j][3]); }
            const float mean = wave_sum(s) * (1.0f / 512.0f); float s2 = 0.f;
#pragma unroll
            for (int j = 0; j < 2; ++j) { v[j] = v[j] - mean; s2 += (v[j][0] * v[j][0] + v[j][1] * v[j][1]) + (v[j][2] * v[j][2] + v[j][3] * v[j][3]); }
            const float rstd = rsqrtf(wave_sum(s2) * (1.0f / 512.0f) + EPS);
#pragma unroll
            for (int j = 0; j < 2; ++j) { const f32x4 g = *(const f32x4*)(IN(I_ELNG) + 4 * X.lane + 256 * j), b = *(const f32x4*)(IN(I_ELNB) + 4 * X.lane + 256 * j);
                f32x4 y = v[j] * rstd * g + b;
#pragma unroll
                for (int k = 0; k < 4; ++k) y[k] = y[k] * sigmoidf_(y[k]);
                u32x2 o; o.x = pk2(y[0], y[1]); o.y = pk2(y[2], y[3]); *(u32x2*)(MIX + (size_t)(row0 + tl) * D + 4 * X.lane + 256 * j) = o; } }
    }
}

__device__ __forceinline__ void phase_attention(const Args& a, const Ctx& X) {
    unsigned char* const wsb = X.ws;
    LAS unsigned char* Ks = X.lds;
    LAS unsigned char* Vt = X.lds + 16384;
    const int lane = X.lane, l15 = lane & 15, g4 = lane >> 4;
    for (int unit = X.bid; unit < NB * 2 * 32; unit += X.G) {
        const int b = unit >> 6, kh = (unit >> 5) & 1, qb = unit & 31; const int q0 = qb * 64;
        const int hq = kh * 4 + (X.wave >> 1), tq = (X.wave & 1) * 32;
        bf16x8 Qf[2][2];
#pragma unroll
        for (int qi = 0; qi < 2; ++qi)
#pragma unroll
            for (int s = 0; s < 2; ++s) Qf[qi][s] = *(const bf16x8*)(wsb + (unsigned)(WS_Q + 2u * (unsigned)((b * SEQ + q0 + tq + 16 * qi + l15) * 512 + hq * 64 + 32 * s + 8 * g4)));
        const float sink2 = IN(I_SINK)[hq] * LOG2E;
        float mrun[2], lrun[2]; f32x4 O[2][4];
#pragma unroll
        for (int qi = 0; qi < 2; ++qi) { mrun[qi] = sink2; lrun[qi] = (g4 == 0) ? 1.0f : 0.0f;
#pragma unroll
            for (int db = 0; db < 4; ++db) O[qi][db] = (f32x4){0.f, 0.f, 0.f, 0.f}; }
        const int t_first = (q0 >= 128) ? 0 : (q0 >= 64 ? 1 : 2), t_skip_lo = (q0 + 128 < SEQ) ? 5 : (q0 + 64 < SEQ ? 4 : 3);
        const int key = X.tid >> 3, ch = X.tid & 7;
        auto tile_offs = [&](int t, unsigned& ko, unsigned& vo) {
            if (t < 5) { const unsigned e = (unsigned)((b * SEQ + q0 - 128 + 64 * t) * 128 + kh * 64) * 2u; ko = (unsigned)WS_K + e; vo = (unsigned)WS_V + e; }
            else { const unsigned e = (unsigned)((b * CTXL + (t - 5) * 64) * 128 + kh * 64) * 2u; ko = (unsigned)WS_KC + e; vo = (unsigned)WS_VC + e; } };
        const unsigned lane_off = (unsigned)(key * 128 + ch * 8) * 2u;
        auto lds_put = [&](int buf, const u32x4& kv, const u32x4& vv) {
            LAS unsigned char* Kd = Ks + buf * 32768; LAS unsigned char* Vd = Vt + buf * 32768;
            *(LAS u32x4*)(Kd + key * 144 + ch * 16) = kv;
#pragma unroll
            for (int i = 0; i < 4; ++i) { *(LAS unsigned short*)(Vd + (8 * ch + 2 * i) * 136 + key * 2) = (unsigned short)(vv[i] & 0xffffu); *(LAS unsigned short*)(Vd + (8 * ch + 2 * i + 1) * 136 + key * 2) = (unsigned short)(vv[i] >> 16); } };
        u32x4 kreg, vreg;
        { unsigned ko, vo; tile_offs(t_first, ko, vo); kreg = *(const u32x4*)(wsb + (ko + lane_off)); vreg = *(const u32x4*)(wsb + (vo + lane_off)); }
        __syncthreads();
        lds_put(0, kreg, vreg);
        int bufi = 0;
        for (int t = t_first; t < 9; ++t) {
            if (t >= t_skip_lo && t < 5) continue;
            int tn = t + 1; if (tn >= t_skip_lo && tn < 5) tn = 5;
            if (tn < 9) { unsigned ko, vo; tile_offs(tn, ko, vo); kreg = *(const u32x4*)(wsb + (ko + lane_off)); vreg = *(const u32x4*)(wsb + (vo + lane_off)); }
            const int mode = (t == 0) ? 1 : (t == 4 ? 2 : 0);
            __syncthreads();
            const LAS unsigned char* Kc = Ks + bufi * 32768; const LAS unsigned char* Vc = Vt + bufi * 32768;
            bf16x8 kf[4][2];
#pragma unroll
            for (int kb = 0; kb < 4; ++kb)
#pragma unroll
                for (int s = 0; s < 2; ++s) kf[kb][s] = *(const LAS bf16x8*)(Kc + (16 * kb + l15) * 144 + (32 * s + 8 * g4) * 2);
            bf16x8 vf[4][2];
#pragma unroll
            for (int db = 0; db < 4; ++db)
#pragma unroll
                for (int ks2 = 0; ks2 < 2; ++ks2) { const LAS unsigned char* p = Vc + (16 * db + l15) * 136 + (32 * ks2 + 4 * g4) * 2;
                    const u32x2 lo = *(const LAS u32x2*)p, hi = *(const LAS u32x2*)(p + 32);
                    u32x4 w; w.x = lo.x; w.y = lo.y; w.z = hi.x; w.w = hi.y; vf[db][ks2] = __builtin_bit_cast(bf16x8, w); }
#pragma unroll
            for (int qi = 0; qi < 2; ++qi) {
                f32x4 st[4];
#pragma unroll
                for (int kb = 0; kb < 4; ++kb) { st[kb] = (f32x4){0.f, 0.f, 0.f, 0.f};
#pragma unroll
                    for (int s = 0; s < 2; ++s) st[kb] = __builtin_amdgcn_mfma_f32_16x16x32_bf16(kf[kb][s], Qf[qi][s], st[kb], 0, 0, 0); }
                if (mode) { int qloc = tq + 16 * qi + l15; asm volatile("" : "+v"(qloc));
#pragma unroll
                    for (int kb = 0; kb < 4; ++kb)
#pragma unroll
                        for (int r = 0; r < 4; ++r) { const int kk = 16 * kb + 4 * g4 + r; const bool keep = (mode == 1) ? (kk >= qloc) : (kk <= qloc); if (!keep) st[kb][r] = -1e30f; } }
                float mx = st[0][0];
#pragma unroll
                for (int kb = 0; kb < 4; ++kb)
#pragma unroll
                    for (int r = 0; r < 4; ++r) mx = fmaxf(mx, st[kb][r]);
                mx = fmaxf(mx, __shfl_xor(mx, 16)); mx = fmaxf(mx, __shfl_xor(mx, 32));
                const float mnew = fmaxf(mrun[qi], mx); const float alpha = __builtin_amdgcn_exp2f(mrun[qi] - mnew); mrun[qi] = mnew;
                float ps = 0.f;
#pragma unroll
                for (int kb = 0; kb < 4; ++kb)
#pragma unroll
                    for (int r = 0; r < 4; ++r) { st[kb][r] = __builtin_amdgcn_exp2f(st[kb][r] - mnew); ps += st[kb][r]; }
                lrun[qi] = lrun[qi] * alpha + ps;
#pragma unroll
                for (int db = 0; db < 4; ++db) O[qi][db] = O[qi][db] * alpha;
#pragma unroll
                for (int ks2 = 0; ks2 < 2; ++ks2) { u32x4 w; w.x = pk2(st[2 * ks2][0], st[2 * ks2][1]); w.y = pk2(st[2 * ks2][2], st[2 * ks2][3]); w.z = pk2(st[2 * ks2 + 1][0], st[2 * ks2 + 1][1]); w.w = pk2(st[2 * ks2 + 1][2], st[2 * ks2 + 1][3]);
                    const bf16x8 pf = __builtin_bit_cast(bf16x8, w);
#pragma unroll
                    for (int db = 0; db < 4; ++db) O[qi][db] = __builtin_amdgcn_mfma_f32_16x16x32_bf16(vf[db][ks2], pf, O[qi][db], 0, 0, 0); }
            }
            if (tn < 9) lds_put(bufi ^ 1, kreg, vreg);
            bufi ^= 1;
        }
#pragma unroll
        for (int qi = 0; qi < 2; ++qi) { float l = lrun[qi]; l += __shfl_xor(l, 16); l += __shfl_xor(l, 32); const float inv = 1.0f / l;
            bf16* orow = (bf16*)(wsb + (unsigned)(WS_MIX + 2u * (unsigned)((b * SEQ + q0 + tq + 16 * qi + l15) * D + 512 + hq * 64 + 4 * g4)));
#pragma unroll
            for (int db = 0; db < 4; ++db) { u32x2 o; o.x = pk2(O[qi][db][0] * inv, O[qi][db][1] * inv); o.y = pk2(O[qi][db][2] * inv, O[qi][db][3] * inv); *(u32x2*)(orow + 16 * db) = o; } }
    }
}

__device__ __forceinline__ void phase_router(const Args& a, const Ctx& X, int layer) {
    const bf16* __restrict__ H = (const bf16*)(X.ws + WS_H); unsigned char* XA8 = (unsigned char*)(X.ws + WS_XA8);
    const float* MODl = (const float*)(X.ws + WS_MOD) + (size_t)layer * 9 * MODW; const float* gn = IN(I_NFG) + layer * D;
    const float* rw = IN(I_RW) + (size_t)layer * D * NE; const float* rb = IN(I_RB) + layer * NE;
    int* cntg = (int*)(X.ws + WS_CTL) + CW_CNT + layer * NE * CNT_STRIDE; int* list = (int*)(X.ws + WS_LIST); float* gatew = (float*)(X.ws + WS_GATE);
    constexpr int YS = 1028;
    LAS float* ybuf = (LAS float*)X.lds;
    LAS float* part = (LAS float*)(X.lds + 66048);
    LAS int* sel = (LAS int*)(X.lds + 66048 + 16384);
    LAS int* lcnt = (LAS int*)(X.lds + 66048 + 16384 + 1024);
    LAS float* lgs = (LAS float*)(X.lds + 66048 + 16384 + 2048);
    LAS float* tvs = lgs + 512;
    LAS float* exs = lgs + 528;
    PMARK(0);
    const int e = X.lane & 31, hf = X.lane >> 5;
    const int e16 = X.lane & 15, kq = X.lane >> 4;
    float wreg[32][2];
#pragma unroll
    for (int s = 0; s < 32; ++s)
#pragma unroll
        for (int nb = 0; nb < 2; ++nb) wreg[s][nb] = rw[(size_t)(128 * X.wave + 4 * s + kq) * NE + 16 * nb + e16];
    const float rbe = rb[e];
    for (int blk = X.bid; blk < NTOK / 64; blk += X.G) {
        const int rowbase = blk * 64; const float* m = MODl + (size_t)(rowbase / SEQ) * MODW;
        f32x4 gk[4], hk[4], xv[2][4];
#pragma unroll
        for (int j = 0; j < 4; ++j) { gk[j] = ((const f32x4*)gn)[X.lane + 64 * j]; hk[j] = ((const f32x4*)(m + 3 * 1024))[X.lane + 64 * j]; const f32x4 s_ = ((const f32x4*)(m + 4 * 1024))[X.lane + 64 * j]; gk[j] = gk[j] * (1.0f + s_); }
#pragma unroll
        for (int i = 0; i < 2; ++i)
#pragma unroll
            for (int j = 0; j < 4; ++j) { const u32x2 w = ((const u32x2*)(H + (size_t)(rowbase + 2 * X.wave + i) * D))[X.lane + 64 * j]; xv[i][j] = (f32x4){bf2f(w.x & 0xffffu), bf2f(w.x >> 16), bf2f(w.y & 0xffffu), bf2f(w.y >> 16)}; }
        __syncthreads();
        if (X.tid < 64) lcnt[X.tid] = 0;
        PMARK(1);
#pragma unroll 1
        for (int bt = 0; bt < 4; ++bt) {
#pragma unroll
            for (int i = 0; i < 2; ++i) { const int rl = 2 * X.wave + i, row = rowbase + 16 * bt + rl; float ss = 0.f;
#pragma unroll
                for (int j = 0; j < 4; ++j) ss += (xv[i][j][0] * xv[i][j][0] + xv[i][j][1] * xv[i][j][1]) + (xv[i][j][2] * xv[i][j][2] + xv[i][j][3] * xv[i][j][3]);
                const float rstd = rsqrtf(wave_sum(ss) * (1.0f / D) + EPS);
#pragma unroll
                for (int j = 0; j < 4; ++j) { const f32x4 y = xv[i][j] * rstd * gk[j] + hk[j];
                    *((unsigned*)(XA8 + (size_t)row * D) + X.lane + 64 * j) = pk4_fp8(y[0] * FP8_AMUL, y[1] * FP8_AMUL, y[2] * FP8_AMUL, y[3] * FP8_AMUL);
                    *(LAS f32x4*)(ybuf + rl * YS + 4 * X.lane + 256 * j) = y; } }
            if (bt < 3) {
#pragma unroll
                for (int i = 0; i < 2; ++i)
#pragma unroll
                    for (int j = 0; j < 4; ++j) { const u32x2 w = ((const u32x2*)(H + (size_t)(rowbase + 16 * (bt + 1) + 2 * X.wave + i) * D))[X.lane + 64 * j]; xv[i][j] = (f32x4){bf2f(w.x & 0xffffu), bf2f(w.x >> 16), bf2f(w.y & 0xffffu), bf2f(w.y >> 16)}; }
            }
            __syncthreads();
            { f32x4 acc0 = (f32x4){0.f, 0.f, 0.f, 0.f}, acc1 = acc0; const LAS float* yp = ybuf + e16 * YS + 128 * X.wave + kq;
#pragma unroll
              for (int s = 0; s < 32; ++s) { const float av = yp[4 * s];
                  acc0 = __builtin_amdgcn_mfma_f32_16x16x4f32(av, wreg[s][0], acc0, 0, 0, 0); acc1 = __builtin_amdgcn_mfma_f32_16x16x4f32(av, wreg[s][1], acc1, 0, 0, 0); }
#pragma unroll
              for (int r = 0; r < 4; ++r) { part[((4 * kq + r) * 8 + X.wave) * 32 + e16] = acc0[r]; part[((4 * kq + r) * 8 + X.wave) * 32 + 16 + e16] = acc1[r]; } }
            __syncthreads();
            { const int r = 2 * X.wave + hf, rl = 16 * bt + r;
              float v = rbe;
#pragma unroll
              for (int w8 = 0; w8 < 8; ++w8) v += part[(r * 8 + w8) * 32 + e];
              lgs[r * 32 + e] = v; LDS_WAIT();
              int ez = e; asm volatile("" : "+v"(ez));
              int rank = 0;
#pragma unroll
              for (int j4 = 0; j4 < 8; ++j4) { const f32x4 o = *(const LAS f32x4*)(lgs + r * 32 + 4 * j4);
#pragma unroll
                  for (int c = 0; c < 4; ++c) rank += (o[c] > v || (o[c] == v && (4 * j4 + c) < ez)) ? 1 : 0; }
              if (rank == 0) tvs[r] = v;
              LDS_WAIT();
              const float ex = __expf(v - tvs[r]);
              if (rank < 4) exs[r * 4 + rank] = ex;
              LDS_WAIT();
              const f32x4 e4 = *(const LAS f32x4*)(exs + r * 4); const float inv = 1.0f / ((e4[0] + e4[1]) + (e4[2] + e4[3]));
              if (rank < 4) { const int slot = atomicAdd((int*)&lcnt[e], 1); sel[rl * 4 + rank] = (e << 16) | slot; gatew[(size_t)(rowbase + rl) * 4 + rank] = ex * inv; } }
        }
        __syncthreads();
        PMARK(2);
        if (X.tid < 32) lcnt[32 + X.tid] = atomicAdd(cntg + X.tid * CNT_STRIDE, lcnt[X.tid]);
        __syncthreads();
        if (X.tid < 256) { const int w = sel[X.tid]; const int ee = w >> 16, rank = w & 0xffff; list[(size_t)ee * NTOK + lcnt[32 + ee] + rank] = rowbase * 4 + X.tid; }
    }
    PMARK(3);
}

__device__ __forceinline__ void phase_combine(const Args& a, const Ctx& X, int layer) {
    bf16* H = (bf16*)(X.ws + WS_H); const bf16* __restrict__ Y = (const bf16*)(X.ws + WS_Y); bf16* XA = (bf16*)(X.ws + WS_XA);
    const float* __restrict__ MODl = (const float*)(X.ws + WS_MOD) + (size_t)layer * 9 * MODW;
    float* outp = (float*)(__attribute__((address_space(1))) float*)X.kp[33];
    for (int row = X.gw; row < NTOK; row += X.NGW) {
        const float* gt = MODl + (size_t)(row / SEQ) * MODW + 5 * 1024; f32x4 h[2][2], g[2][2]; u32x4 yw[2][4];
#pragma unroll
        for (int j = 0; j < 2; ++j) { const int c0 = 8 * X.lane + 512 * j;
#pragma unroll
            for (int q = 0; q < 2; ++q) g[j][q] = *(const f32x4*)(gt + c0 + 4 * q);
            { const u32x4 w = *(const u32x4*)(H + (size_t)row * D + c0); h[j][0] = (f32x4){bf2f(w.x & 0xffffu), bf2f(w.x >> 16), bf2f(w.y & 0xffffu), bf2f(w.y >> 16)}; h[j][1] = (f32x4){bf2f(w.z & 0xffffu), bf2f(w.z >> 16), bf2f(w.w & 0xffffu), bf2f(w.w >> 16)}; }
#pragma unroll
            for (int k = 0; k < 4; ++k) yw[j][k] = __builtin_nontemporal_load((const u32x4*)(Y + ((size_t)row * 4 + k) * D + c0)); }
        float ss = 0.f;
#pragma unroll
        for (int j = 0; j < 2; ++j) { f32x4 s0 = (f32x4){0.f, 0.f, 0.f, 0.f}, s1 = s0;
#pragma unroll
            for (int k = 0; k < 4; ++k) { const u32x4 w = yw[j][k]; s0 += (f32x4){bf2f(w.x & 0xffffu), bf2f(w.x >> 16), bf2f(w.y & 0xffffu), bf2f(w.y >> 16)}; s1 += (f32x4){bf2f(w.z & 0xffffu), bf2f(w.z >> 16), bf2f(w.w & 0xffffu), bf2f(w.w >> 16)}; }
            h[j][0] = h[j][0] + g[j][0] * s0; h[j][1] = h[j][1] + g[j][1] * s1;
#pragma unroll
            for (int q = 0; q < 2; ++q) ss += (h[j][q][0] * h[j][q][0] + h[j][q][1] * h[j][q][1]) + (h[j][q][2] * h[j][q][2] + h[j][q][3] * h[j][q][3]); }
        if (layer == 1) {
#pragma unroll
            for (int j = 0; j < 2; ++j)
#pragma unroll
                for (int q = 0; q < 2; ++q) __builtin_nontemporal_store(h[j][q], (f32x4*)(outp + (size_t)row * D + 8 * X.lane + 512 * j + 4 * q));
        } else {
            const float* m1 = (const float*)(X.ws + WS_MOD) + (size_t)9 * MODW + (size_t)(row / SEQ) * MODW; const float* gn = IN(I_NMG) + D;
            f32x4 gk[2][2], hk[2][2], sk[2][2];
#pragma unroll
            for (int j = 0; j < 2; ++j)
#pragma unroll
                for (int q = 0; q < 2; ++q) { const int c0 = 8 * X.lane + 512 * j + 4 * q; gk[j][q] = *(const f32x4*)(gn + c0); hk[j][q] = *(const f32x4*)(m1 + c0); sk[j][q] = *(const f32x4*)(m1 + 1024 + c0); }
            const float rstd = rsqrtf(wave_sum(ss) * (1.0f / D) + EPS);
#pragma unroll
            for (int j = 0; j < 2; ++j) { const int c0 = 8 * X.lane + 512 * j;
                const f32x4 y0 = h[j][0] * rstd * gk[j][0] * (1.0f + sk[j][0]) + hk[j][0], y1 = h[j][1] * rstd * gk[j][1] * (1.0f + sk[j][1]) + hk[j][1];
                *(u32x4*)(H + (size_t)row * D + c0) = pack8(h[j][0], h[j][1]);
                *(u32x4*)(XA + (size_t)row * D + c0) = pack8(y0, y1); }
        }
    }
}

__device__ __forceinline__ void phase_spatial(const Args& a, const Ctx& X) {
    const bf16* U = (const bf16*)(X.ws + WS_U); const bf16* VB = (const bf16*)(X.ws + WS_VB); bf16* SG = (bf16*)(X.ws + WS_MIX); const bf16* WsB = (const bf16*)(X.ws + WS_WSB); const float* vstat = (const float*)(X.ws + WS_CTL) + CW_VSTAT;
    LAS unsigned char* Vt = X.lds + 4096;
    const int lane = X.lane, l15 = lane & 15, g4 = lane >> 4;
    const int q0 = X.tid >> 4, cc = X.tid & 15;
    int item = X.bid; const int nitems = 128 * 8;
    const bool same_g = (X.G & 7) == 0;
    bf16x8 bfr[4][8]; int gcur = -1;
    u32x4 vraw[4]; f32x2 st[4];
    auto fetch = [&](int it) { const int chunk = it >> 3, g = it & 7; const int row0 = chunk * 128;
#pragma unroll
        for (int i = 0; i < 4; ++i) { const int q = q0 + 32 * i; vraw[i] = *(const u32x4*)(VB + (size_t)(row0 + q) * D + g * 128 + cc * 8); st[i] = *(const f32x2*)(vstat + 2 * (row0 + q)); } };
    if (item < nitems) fetch(item);
    for (; item < nitems; item += X.G) {
        const int chunk = item >> 3, g = item & 7; const int row0 = chunk * 128;
        if (g != gcur) { gcur = g;
#pragma unroll
            for (int s = 0; s < 4; ++s)
#pragma unroll
                for (int pb = 0; pb < 8; ++pb) bfr[s][pb] = *(const bf16x8*)(WsB + ((size_t)g * 128 + 16 * pb + l15) * 128 + 32 * s + 8 * g4); }
        const float* lg_ = IN(I_OLNG) + g * 128 + cc * 8; const float* lb_ = IN(I_OLNB) + g * 128 + cc * 8;
        __syncthreads();
        float mean[4], rstd[4];
#pragma unroll
        for (int i = 0; i < 4; ++i) { mean[i] = st[i].x * (1.0f / D); const float var = fmaxf(st[i].y * (1.0f / D) - mean[i] * mean[i], 0.f); rstd[i] = rsqrtf(var + EPS); }
#pragma unroll
        for (int kh = 0; kh < 2; ++kh) { const f32x4 lgv = *(const f32x4*)(lg_ + 4 * kh), lbv = *(const f32x4*)(lb_ + 4 * kh);
#pragma unroll
            for (int i = 0; i < 4; ++i) { const int q = q0 + 32 * i;
#pragma unroll
                for (int k2 = 0; k2 < 2; ++k2) { const int k = 2 * kh + k2; const unsigned wv = vraw[i][k];
                    const float y0 = (bf2f(wv & 0xffffu) - mean[i]) * rstd[i] * lgv[2 * k2] + lbv[2 * k2], y1 = (bf2f(wv >> 16) - mean[i]) * rstd[i] * lgv[2 * k2 + 1] + lbv[2 * k2 + 1];
                    const unsigned pk = pk2(y0, y1);
                    *(LAS unsigned short*)(Vt + ((2 * k) * 17 + cc) * 272 + q * 2) = (unsigned short)(pk & 0xffffu); *(LAS unsigned short*)(Vt + ((2 * k + 1) * 17 + cc) * 272 + q * 2) = (unsigned short)(pk >> 16); } } }
        if (item + X.G < nitems) fetch(item + X.G);
        __syncthreads();
#pragma unroll
        for (int hp = 0; hp < 2; ++hp) {
            u32x2 uw[4];
#pragma unroll
            for (int pq = 0; pq < 4; ++pq) uw[pq] = *(const u32x2*)(U + (size_t)(row0 + 16 * (4 * hp + pq) + l15) * D + g * 128 + 16 * X.wave + 4 * g4);
            f32x4 acc[4];
#pragma unroll
            for (int pq = 0; pq < 4; ++pq) acc[pq] = (f32x4){0.f, 0.f, 0.f, 0.f};
#pragma unroll
            for (int s = 0; s < 4; ++s) { const bf16x8 af = *(const LAS bf16x8*)(Vt + ((l15 & 7) * 17 + 2 * X.wave + (l15 >> 3)) * 272 + (32 * s + 8 * g4) * 2);
#pragma unroll
                for (int pq = 0; pq < 4; ++pq) acc[pq] = __builtin_amdgcn_mfma_f32_16x16x32_bf16(af, bfr[s][4 * hp + pq], acc[pq], 0, 0, 0); }
#pragma unroll
            for (int pq = 0; pq < 4; ++pq) { const int p = 16 * (4 * hp + pq) + l15; const float bs = IN(I_OBS)[g * 128 + p]; const size_t off = (size_t)(row0 + p) * D + g * 128 + 16 * X.wave + 4 * g4;
                u32x2 o; o.x = pk2(bf2f(uw[pq].x & 0xffffu) * (acc[pq][0] + bs), bf2f(uw[pq].x >> 16) * (acc[pq][1] + bs)); o.y = pk2(bf2f(uw[pq].y & 0xffffu) * (acc[pq][2] + bs), bf2f(uw[pq].y >> 16) * (acc[pq][3] + bs));
                *(u32x2*)(SG + off) = o; }
        }
    }
    (void)same_g;
}

enum { PH_PRO = 0, PH_MOD0, PH_GIN, PH_CONV, PH_ATT, PH_GOUT, PH_RT0, PH_M1_0, PH_M2_0, PH_CMB0, PH_GMI, PH_SPA, PH_GMO, PH_RT1, PH_M1_1, PH_M2_1, PH_CMB1, NPHASE };

__global__ void __launch_bounds__(NTHREADS, 2) mega(Args a) {
    extern __shared__ __attribute__((aligned(16))) unsigned char lds_raw[];
    Ctx X; X.lds = (LAS unsigned char*)lds_raw;
    const int wave0 = __builtin_amdgcn_readfirstlane((int)threadIdx.x >> 6);
    const int G0 = gridDim.x, bid0 = blockIdx.x; const int vcu0 = (G0 % 8 == 0) ? (bid0 % 8) * (G0 / 8) + bid0 / 8 : bid0;
    X.wave = wave0;
    volatile LAS unsigned* MISC = (volatile LAS unsigned*)(X.lds + MISC_OFF);
    if (threadIdx.x < 64) MISC[threadIdx.x] = 0u;
    __syncthreads();
    const int ph_lo = a.ph_lo, ph_hi = a.ph_hi;
    XcdBarrier bar = xcd_barrier_post((unsigned*)(a.ws + WS_CTL) + CW_BAR + a.li * XCD_BAR_WORDS, MISC + 8, (unsigned)G0, true);
    const int GA = G0 - GROUP_B;
    const bool grouped = (GROUP_B > 0) && ph_lo == 0 && ph_hi == NPHASE && GA >= 8 && (GA % 8) == 0;
    const int vcuA = (bid0 % 8) * (GA / 8) + bid0 / 8;
    XcdBarrier barA = xcd_barrier_post((unsigned*)(a.ws + WS_CTL) + CW_BAR + 19 * XCD_BAR_WORDS, MISC + 12, (unsigned)GA, grouped && bid0 < GA);
#if PROBE_PH >= 0
#define PROBE_STAMP(p) do { if ((p) == PROBE_PH) pr_t0 = __builtin_amdgcn_s_memrealtime(); if ((p) == PROBE_END) pr_t1 = __builtin_amdgcn_s_memrealtime(); } while (0)
#else
#define PROBE_STAMP(p) do { } while (0)
#endif
#define PH_ENTER() int z; asm volatile("s_mov_b32 %0, 0" : "=s"(z)); \
        X.lane = (int)__builtin_amdgcn_mbcnt_hi(~0u, __builtin_amdgcn_mbcnt_lo(~0u, (unsigned)z)); X.tid = wave0 * 64 + X.lane; \
        X.G = G0 + z; X.vcu = vcu0 + z; X.bid = bid0 + z; X.NGW = X.G * NWAVES; X.gw = X.vcu * NWAVES + wave0; \
        { kargp_t kp = (kargp_t)__builtin_amdgcn_kernarg_segment_ptr(); asm volatile("" : "+s"(kp)); X.kp = kp; } \
        unsigned char* ws = (unsigned char*)(__attribute__((address_space(1))) unsigned char*)X.kp[34] + z; X.ws = ws;
#if PROBE_PH >= 0
    unsigned long long pr_t0 = 0, pr_t1 = 0;
#endif
#define PH_RUN(PHK, ...) if (ph_lo <= (PHK) && (PHK) < ph_hi) { const int ph = (PHK); \
        if (ph != ph_lo) { const int l0 = (int)__builtin_amdgcn_mbcnt_hi(~0u, __builtin_amdgcn_mbcnt_lo(~0u, 0u)); xcd_barrier(bar, wave0 * 64 + l0); if (EXP_BAR2 && (ph & 3) == 1) xcd_barrier(bar, wave0 * 64 + l0); } \
        PROBE_STAMP(ph); __VA_ARGS__ }
    PH_RUN(PH_PRO, { PH_ENTER(); phase_prologue(a, X, !grouped); })
#define PH_ENTER_A() int z; asm volatile("s_mov_b32 %0, 0" : "=s"(z)); \
        X.lane = (int)__builtin_amdgcn_mbcnt_hi(~0u, __builtin_amdgcn_mbcnt_lo(~0u, (unsigned)z)); X.tid = wave0 * 64 + X.lane; \
        X.G = GA + z; X.vcu = vcuA + z; X.bid = bid0 + z; X.NGW = X.G * NWAVES; X.gw = X.vcu * NWAVES + wave0; \
        { kargp_t kp = (kargp_t)__builtin_amdgcn_kernarg_segment_ptr(); asm volatile("" : "+s"(kp)); X.kp = kp; } \
        unsigned char* ws = (unsigned char*)(__attribute__((address_space(1))) unsigned char*)X.kp[34] + z; X.ws = ws;
#define PHA_RUN(PHK, ...) { const int ph = (PHK); \
        { const int l0 = (int)__builtin_amdgcn_mbcnt_hi(~0u, __builtin_amdgcn_mbcnt_lo(~0u, 0u)); if (ph == PH_MOD0) xcd_barrier(bar, wave0 * 64 + l0); else xcd_barrier(barA, wave0 * 64 + l0); } \
        PROBE_STAMP(ph); __VA_ARGS__ }
    if (grouped) {
        if (bid0 < GA) {
    PHA_RUN(PH_MOD0, { PH_ENTER_A(); phase_modulate0(a, X); })
    PHA_RUN(PH_GIN, { PH_ENTER_A(); DenseSched S; S.init((const bf16*)(ws + WS_XA), (const bf16*)(ws + WS_WINT), NTOK, EVEN_IN, X.G, X.bid);
            S.A2 = (const bf16*)(ws + WS_GM); S.Bt2 = (const bf16*)(ws + WS_WINT) + (size_t)KV_COL * D; S.nM2 = NCTX / 256;
            EpiIn E{(bf16*)(ws + WS_GLU), (bf16*)(ws + WS_Q), (bf16*)(ws + WS_K), (bf16*)(ws + WS_V), (bf16*)(ws + WS_KC), (bf16*)(ws + WS_VC), IN(I_EBIN)};
            pg8::gemm_phase<EpiIn, DenseSched>(X.lds, S, E, X.tid); })
    PHA_RUN(PH_CONV, { PH_ENTER_A(); phase_conv_qk(a, X); })
    PHA_RUN(PH_ATT, { PH_ENTER_A(); phase_attention(a, X); })
    PHA_RUN(PH_GOUT, { PH_ENTER_A(); DenseSched S; S.init((const bf16*)(ws + WS_MIX), (const bf16*)(ws + WS_WOUTT), NTOK, D, X.G, X.bid);
            EpiRes<true> E{IN(I_X), (bf16*)(ws + WS_H), IN(I_EBOUT), (const float*)(ws + WS_MOD) + 2 * 1024};
            pg8::gemm_phase<EpiRes<true>, DenseSched>(X.lds, S, E, X.tid); })
    PHA_RUN(PH_RT0, { PH_ENTER_A(); phase_router(a, X, 0); })
        } else {
            { const int l0 = (int)__builtin_amdgcn_mbcnt_hi(~0u, __builtin_amdgcn_mbcnt_lo(~0u, 0u)); xcd_barrier(bar, wave0 * 64 + l0); }
            { PH_ENTER(); phase_moe_convert(X, bid0 - GA + z, GROUP_B); }
        }
    } else {
    PH_RUN(PH_MOD0, { PH_ENTER(); phase_modulate0(a, X); })
    PH_RUN(PH_GIN, { PH_ENTER(); DenseSched S; S.init((const bf16*)(ws + WS_XA), (const bf16*)(ws + WS_WINT), NTOK, EVEN_IN, X.G, X.bid);
            S.A2 = (const bf16*)(ws + WS_GM); S.Bt2 = (const bf16*)(ws + WS_WINT) + (size_t)KV_COL * D; S.nM2 = NCTX / 256;
            EpiIn E{(bf16*)(ws + WS_GLU), (bf16*)(ws + WS_Q), (bf16*)(ws + WS_K), (bf16*)(ws + WS_V), (bf16*)(ws + WS_KC), (bf16*)(ws + WS_VC), IN(I_EBIN)};
            pg8::gemm_phase<EpiIn, DenseSched>(X.lds, S, E, X.tid); })
    PH_RUN(PH_CONV, { PH_ENTER(); phase_conv_qk(a, X); })
    PH_RUN(PH_ATT, { PH_ENTER(); phase_attention(a, X); })
    PH_RUN(PH_GOUT, { PH_ENTER(); DenseSched S; S.init((const bf16*)(ws + WS_MIX), (const bf16*)(ws + WS_WOUTT), NTOK, D, X.G, X.bid);
            EpiRes<true> E{IN(I_X), (bf16*)(ws + WS_H), IN(I_EBOUT), (const float*)(ws + WS_MOD) + 2 * 1024};
            pg8::gemm_phase<EpiRes<true>, DenseSched>(X.lds, S, E, X.tid); })
    PH_RUN(PH_RT0, { PH_ENTER(); phase_router(a, X, 0); })
    }
    PH_RUN(PH_M1_0, { PH_ENTER(); const int l = (ph == PH_M1_1); moe_build_table(X, (const int*)(ws + WS_CTL) + CW_CNT + l * NE * CNT_STRIDE);
            MoeSchedT<true, 8> S; S.tab = (const LAS int*)(X.lds + TAB_OFF); S.G = X.G; S.c = X.vcu; S.A = (const unsigned char*)(ws + WS_XA8); S.Bt = (const unsigned char*)(ws + WS_W1T) + (size_t)l * NE * 2048 * 1024; S.list = (const int*)(ws + WS_LIST); S.meta = (const LAS int*)(X.lds + META_OFF);
            moe_stage_meta<false>(X, S, S.list, (const float*)nullptr, (LAS int*)(X.lds + META_OFF), IN(I_B1) + (size_t)l * NE * 2048, (LAS float*)(X.lds + BIAS_OFF));
            EpiSwiglu E{(unsigned char*)(ws + WS_ACT), (const LAS float*)(X.lds + BIAS_OFF)};
            pg8::gemm_phase<EpiSwiglu, MoeSchedT<true, 8>>(X.lds, S, E, X.tid); })
    PH_RUN(PH_M2_0, { PH_ENTER(); const int l = (ph == PH_M2_1); moe_build_table(X, (const int*)(ws + WS_CTL) + CW_CNT + l * NE * CNT_STRIDE);
            MoeSchedT<false, 4> S; S.tab = (const LAS int*)(X.lds + TAB_OFF); S.G = X.G; S.c = X.vcu; S.A = (const unsigned char*)(ws + WS_ACT); S.Bt = (const unsigned char*)(ws + WS_W2T) + (size_t)l * NE * 1024 * 1024; S.list = (const int*)(ws + WS_LIST); S.meta = (const LAS int*)(X.lds + META_OFF);
            moe_stage_meta<true>(X, S, S.list, (const float*)(ws + WS_GATE), (LAS int*)(X.lds + META_OFF), IN(I_B2) + (size_t)l * NE * D, (LAS float*)(X.lds + BIAS_OFF));
            EpiDown E{(bf16*)(ws + WS_Y), (const LAS float*)(X.lds + BIAS_OFF), (const LAS int*)(X.lds + META_OFF)};
            pg8::gemm_phase<EpiDown, MoeSchedT<false, 4>>(X.lds, S, E, X.tid); })
    PH_RUN(PH_CMB0, { PH_ENTER(); phase_combine(a, X, 0); })
    PH_RUN(PH_GMI, { PH_ENTER(); DenseSched S; S.init((const bf16*)(ws + WS_XA), (const bf16*)(ws + WS_GWINT), NTOK, 2048, X.G, X.bid);
            EpiGelu E{(bf16*)(ws + WS_U), (bf16*)(ws + WS_VB), IN(I_OBIN), (float*)(ws + WS_CTL) + CW_VSTAT};
            pg8::gemm_phase<EpiGelu, DenseSched>(X.lds, S, E, X.tid); })
    PH_RUN(PH_SPA, { PH_ENTER(); phase_spatial(a, X); })
    PH_RUN(PH_GMO, { PH_ENTER(); DenseSched S; S.init((const bf16*)(ws + WS_MIX), (const bf16*)(ws + WS_GWOUTT), NTOK, D, X.G, X.bid);
            EpiRes<false> E{(const bf16*)(ws + WS_H), (bf16*)(ws + WS_H), IN(I_OBOUT), (const float*)(ws + WS_MOD) + (size_t)9 * MODW + 2 * 1024};
            pg8::gemm_phase<EpiRes<false>, DenseSched>(X.lds, S, E, X.tid); })
    PH_RUN(PH_RT1, { PH_ENTER(); phase_router(a, X, 1); })
    PH_RUN(PH_M1_1, { PH_ENTER(); PMARK(50); const int l = (ph == PH_M1_1); moe_build_table(X, (const int*)(ws + WS_CTL) + CW_CNT + l * NE * CNT_STRIDE);
            MoeSchedT<true, 8> S; S.tab = (const LAS int*)(X.lds + TAB_OFF); S.G = X.G; S.c = X.vcu; S.A = (const unsigned char*)(ws + WS_XA8); S.Bt = (const unsigned char*)(ws + WS_W1T) + (size_t)l * NE * 2048 * 1024; S.list = (const int*)(ws + WS_LIST); S.meta = (const LAS int*)(X.lds + META_OFF);
            moe_stage_meta<false>(X, S, S.list, (const float*)nullptr, (LAS int*)(X.lds + META_OFF), IN(I_B1) + (size_t)l * NE * 2048, (LAS float*)(X.lds + BIAS_OFF));
            PMARK(51); EpiSwiglu E{(unsigned char*)(ws + WS_ACT), (const LAS float*)(X.lds + BIAS_OFF)};
            pg8::gemm_phase<EpiSwiglu, MoeSchedT<true, 8>>(X.lds, S, E, X.tid); PMARK(53); })
    PH_RUN(PH_M2_1, { PH_ENTER(); PMARK(54); const int l = (ph == PH_M2_1); moe_build_table(X, (const int*)(ws + WS_CTL) + CW_CNT + l * NE * CNT_STRIDE);
            MoeSchedT<false, 4> S; S.tab = (const LAS int*)(X.lds + TAB_OFF); S.G = X.G; S.c = X.vcu; S.A = (const unsigned char*)(ws + WS_ACT); S.Bt = (const unsigned char*)(ws + WS_W2T) + (size_t)l * NE * 1024 * 1024; S.list = (const int*)(ws + WS_LIST); S.meta = (const LAS int*)(X.lds + META_OFF);
            moe_stage_meta<true>(X, S, S.list, (const float*)(ws + WS_GATE), (LAS int*)(X.lds + META_OFF), IN(I_B2) + (size_t)l * NE * D, (LAS float*)(X.lds + BIAS_OFF));
            EpiDown E{(bf16*)(ws + WS_Y), (const LAS float*)(X.lds + BIAS_OFF), (const LAS int*)(X.lds + META_OFF)};
            pg8::gemm_phase<EpiDown, MoeSchedT<false, 4>>(X.lds, S, E, X.tid); })
    PH_RUN(PH_CMB1, { PH_ENTER(); phase_combine(a, X, 1); })
#if PROBE_PH == -2
    if (blockIdx.x == 0 && threadIdx.x == 0) { volatile LAS unsigned long long* pm_ = (volatile LAS unsigned long long*)(X.lds + MISC_OFF + 128); const unsigned long long te = __builtin_amdgcn_s_memrealtime(); const unsigned long long span = (pm_[1] - pm_[0]) * PROBE_MULT;
        while (__builtin_amdgcn_s_memrealtime() - te < span) __builtin_amdgcn_s_sleep(8); }
#endif
#if PROBE_PH >= 0
    if (pr_t1 == 0) pr_t1 = __builtin_amdgcn_s_memrealtime();
    if (blockIdx.x == 0 && wave0 == 0) { const unsigned long long te = __builtin_amdgcn_s_memrealtime(); const unsigned long long span = (pr_t1 - pr_t0) * PROBE_MULT;
        while (__builtin_amdgcn_s_memrealtime() - te < span) __builtin_amdgcn_s_sleep(8); }
#endif
}

__device__ __forceinline__ bool find_expert(const int* cnt, int s, int& e, int& slot) {
    int pb = 0;
    for (int i = 0; i < NE; ++i) { const int c = cnt[i * CNT_STRIDE]; const int pr = ((c + 255) >> 8) << 8; if (s < pb + pr) { e = i; slot = s - pb; return true; } pb += pr; }
    return false;
}
__global__ void __launch_bounds__(256) slow_gemm(const bf16* A, const int* arow, const bf16* Bt, float* C, int N, const int* cnt, size_t bstride) {
    __shared__ float As[16][65], Bs[16][65];
    const int tx = threadIdx.x & 15, ty = threadIdx.x >> 4; const int m0 = blockIdx.y * 64, n0 = blockIdx.x * 64;
    if (cnt) { int e, slot; if (!find_expert(cnt, m0, e, slot)) return; Bt += (size_t)e * bstride; }
    float acc[4][4];
    for (int i = 0; i < 4; ++i) for (int j = 0; j < 4; ++j) acc[i][j] = 0.f;
    for (int k0 = 0; k0 < 1024; k0 += 16) {
        for (int i = 0; i < 4; ++i) { const int idx = threadIdx.x + 256 * i; const int r = idx >> 4, kk = idx & 15; const int gm = m0 + r; const int ar = arow ? arow[gm] : gm;
            As[kk][r] = bf2f(A[(size_t)ar * 1024 + k0 + kk]); Bs[kk][r] = bf2f(Bt[(size_t)(n0 + r) * 1024 + k0 + kk]); }
        __syncthreads();
        for (int kk = 0; kk < 16; ++kk) { float av[4], bv[4];
            for (int i = 0; i < 4; ++i) { av[i] = As[kk][ty * 4 + i]; bv[i] = Bs[kk][tx * 4 + i]; }
            for (int i = 0; i < 4; ++i) for (int j = 0; j < 4; ++j) acc[i][j] += av[i] * bv[j]; }
        __syncthreads();
    }
    for (int i = 0; i < 4; ++i) for (int j = 0; j < 4; ++j) C[(size_t)(m0 + ty * 4 + i) * N + n0 + tx * 4 + j] = acc[i][j];
}
__device__ __forceinline__ unsigned short f2bf_s(float f) { return (unsigned short)(pk2(f, 0.f) & 0xffffu); }
__global__ void slow_epi_in(const float* C, const float* C2, const float* bias, bf16* GLU, bf16* Q, bf16* Kb, bf16* Vb, bf16* KC, bf16* VC) {
    const size_t i = (size_t)blockIdx.x * blockDim.x + threadIdx.x;
    if (i < (size_t)NTOK * 512) { const int row = (int)(i >> 9), j = (int)(i & 511); const int t = j >> 7, ii = j & 127; const float* cr = C + (size_t)row * EVEN_IN;
        const float u = cr[t * 256 + ii] + bias[j], g = cr[t * 256 + 128 + ii] + bias[512 + j];
        GLU[i] = f2bf_s(u / (1.0f + expf(-g)));
        Q[i] = f2bf_s(cr[1024 + j] + bias[1024 + j]);
        if (j < 128) { Kb[(size_t)row * 128 + j] = f2bf_s(cr[1536 + j] + bias[1536 + j]); Vb[(size_t)row * 128 + j] = f2bf_s(cr[1664 + j] + bias[1664 + j]); }
        if (row < NCTX && j < 128) { KC[(size_t)row * 128 + j] = f2bf_s(C2[(size_t)row * 256 + j] + bias[1536 + j]); VC[(size_t)row * 128 + j] = f2bf_s(C2[(size_t)row * 256 + 128 + j] + bias[1664 + j]); } }
}
__global__ void slow_epi_res(const float* C, const float* basef, const bf16* baseb, bf16* out, const float* bias, const float* gate) {
    const size_t i = (size_t)blockIdx.x * blockDim.x + threadIdx.x;
    if (i < (size_t)NTOK * D) { const int row = (int)(i >> 10), col = (int)(i & 1023); const float b = basef ? basef[i] : bf2f(baseb[i]); out[i] = f2bf_s(b + gate[(size_t)(row / SEQ) * MODW + col] * (C[i] + bias[col])); }
}
__global__ void slow_epi_gelu(const float* C, const float* bias, bf16* U, bf16* V) {
    const size_t i = (size_t)blockIdx.x * blockDim.x + threadIdx.x;
    if (i < (size_t)NTOK * 2048) { const int row = (int)(i >> 11), col = (int)(i & 2047); const float x = C[i] + bias[col]; const float y = 0.5f * x * (1.0f + erff(x * 0.70710678118654752f));
        if (col < 1024) U[(size_t)row * D + col] = f2bf_s(y); else V[(size_t)row * D + col - 1024] = f2bf_s(y); }
}
__global__ void slow_arow(const int* cnt, const int* list, int* arow) {
    const int s = blockIdx.x * blockDim.x + threadIdx.x; if (s >= ACT_ROWS) return;
    int e, slot; int r = 0; if (find_expert(cnt, s, e, slot) && slot < cnt[e * CNT_STRIDE]) r = list[(size_t)e * NTOK + slot] >> 2;
    arow[s] = r;
}
__global__ void slow_epi_swiglu(const float* C, const int* cnt, const float* b1, bf16* ACT) {
    const size_t i = (size_t)blockIdx.x * blockDim.x + threadIdx.x;
    if (i < (size_t)ACT_ROWS * 1024) { const int s = (int)(i >> 10), j = (int)(i & 1023); int e, slot; if (!find_expert(cnt, s, e, slot)) return;
        const int t = j >> 7, ii = j & 127; const float* cr = C + (size_t)s * 2048;
        float g = cr[t * 256 + ii] + b1[(size_t)e * 2048 + j], up = cr[t * 256 + 128 + ii] + b1[(size_t)e * 2048 + 1024 + j];
        g = fminf(g, 7.0f); up = fminf(fmaxf(up, -7.0f), 7.0f);
        ACT[i] = f2bf_s((up + 1.0f) * g / (1.0f + expf(-1.702f * g))); }
}
__global__ void slow_epi_down(const float* C, const int* cnt, const int* list, const float* gatew, const float* b2, bf16* Y) {
    const size_t i = (size_t)blockIdx.x * blockDim.x + threadIdx.x;
    if (i < (size_t)ACT_ROWS * 1024) { const int s = (int)(i >> 10), col = (int)(i & 1023); int e, slot; if (!find_expert(cnt, s, e, slot) || slot >= cnt[e * CNT_STRIDE]) return;
        const int aid = list[(size_t)e * NTOK + slot]; Y[(size_t)aid * D + col] = f2bf_s((C[i] + b2[(size_t)e * D + col]) * gatew[aid]); }
}
__global__ void __launch_bounds__(64) slow_attention(const bf16* QN, const bf16* KN, const bf16* VV, const bf16* KC, const bf16* VC, const float* sink, bf16* MIX) {
    const int i = blockIdx.x * blockDim.x + threadIdx.x; if (i >= NTOK * 8) return;
    const int row = i >> 3, h = i & 7, kh = h >> 2, b = row / SEQ, t = row % SEQ;
    float q[64], o[64];
    for (int d = 0; d < 64; ++d) { q[d] = bf2f(QN[(size_t)row * 512 + h * 64 + d]); o[d] = 0.f; }
    float m = sink[h] * LOG2E, l = 1.0f;
    const int j0 = t - 128 < 0 ? 0 : t - 128, j1 = t + 128 > SEQ - 1 ? SEQ - 1 : t + 128;
    for (int jj = j0; jj <= j1 + CTXL; ++jj) {
        const bf16* kp; const bf16* vp;
        if (jj <= j1) { kp = KN + (size_t)(b * SEQ + jj) * 128 + kh * 64; vp = VV + (size_t)(b * SEQ + jj) * 128 + kh * 64; }
        else { const int c = jj - j1 - 1; kp = KC + (size_t)(b * CTXL + c) * 128 + kh * 64; vp = VC + (size_t)(b * CTXL + c) * 128 + kh * 64; }
        float s = 0.f; for (int d = 0; d < 64; ++d) s += q[d] * bf2f(kp[d]);
        const float mn = fmaxf(m, s), al = exp2f(m - mn), p = exp2f(s - mn); m = mn; l = l * al + p;
        for (int d = 0; d < 64; ++d) o[d] = o[d] * al + p * bf2f(vp[d]);
    }
    for (int d = 0; d < 64; ++d) MIX[(size_t)row * D + 512 + h * 64 + d] = f2bf_s(o[d] / l);
}
__global__ void slow_vstats(const bf16* VB, float* stat) {
    const int row = blockIdx.x * blockDim.x + threadIdx.x; if (row >= NTOK) return;
    float s = 0.f; for (int c = 0; c < D; ++c) s += bf2f(VB[(size_t)row * D + c]); const float mean = s / D;
    float s2 = 0.f; for (int c = 0; c < D; ++c) { const float d = bf2f(VB[(size_t)row * D + c]) - mean; s2 += d * d; }
    stat[2 * row] = mean; stat[2 * row + 1] = rsqrtf(s2 / D + EPS);
}
__global__ void slow_spatial(const bf16* U, const bf16* VB, const float* stat, const float* ws, const float* bs, const float* lng, const float* lnb, bf16* SG) {
    const size_t i = (size_t)blockIdx.x * blockDim.x + threadIdx.x;
    if (i < (size_t)NTOK * D) { const int row = (int)(i >> 10), ch = (int)(i & 1023); const int g = ch >> 7, p = row & 127, r0 = row - p;
        float s = 0.f;
        for (int q = 0; q < 128; ++q) { const float vn = (bf2f(VB[(size_t)(r0 + q) * D + ch]) - stat[2 * (r0 + q)]) * stat[2 * (r0 + q) + 1] * lng[ch] + lnb[ch]; s += ws[((size_t)g * 128 + p) * 128 + q] * vn; }
        SG[i] = f2bf_s(bf2f(U[i]) * (s + bs[g * 128 + p])); }
}

static void launch_mega(Args& a, int lo, int hi, int& li, int grid, hipStream_t stream) {
    a.ph_lo = lo; a.ph_hi = hi; a.li = li++;
    hipLaunchKernelGGL(mega, dim3(grid), dim3(NTHREADS), LDS_BYTES, stream, a);
}
extern "C" void kernel_launch(void* const* d_in, const int* in_sizes, int n_in, void* d_out, int out_size, void* d_ws, size_t ws_size, hipStream_t stream) {
    static int grid = 0;
    if (grid == 0) {
        if (n_in != 33 || out_size != NTOK * D || ws_size < WS_END) { fprintf(stderr, "kernel_launch: unexpected problem (n_in %d, out %d, ws %zu)\n", n_in, out_size, ws_size); grid = -1; return; }
        int dev = 0, cus = 0, per_cu = 0;
        if (hipGetDevice(&dev) != hipSuccess || hipDeviceGetAttribute(&cus, hipDeviceAttributeMultiprocessorCount, dev) != hipSuccess) { grid = -1; return; }
        if (hipFuncSetAttribute((const void*)mega, hipFuncAttributeMaxDynamicSharedMemorySize, LDS_BYTES) != hipSuccess) { fprintf(stderr, "kernel_launch: hipFuncSetAttribute failed\n"); grid = -1; return; }
        if (hipOccupancyMaxActiveBlocksPerMultiprocessor(&per_cu, (const void*)mega, NTHREADS, LDS_BYTES) != hipSuccess || per_cu < 1) { fprintf(stderr, "kernel_launch: occupancy query says %d blocks per CU\n", per_cu); per_cu = 1; }
        (void)hipGetLastError();
        grid = cus;
    }
    if (grid < 0) return;
    unsigned char* ws = (unsigned char*)d_ws;
    (void)hipMemsetAsync(ws + WS_CTL, 0, CTL_ZERO_BYTES, stream);
    Args a{};
    for (int i = 0; i < 33; ++i) a.in[i] = (const float*)d_in[i];
    a.out = (float*)d_out; a.ws = ws;
    int li = 0;
    const float* in_[33]; for (int i = 0; i < 33; ++i) in_[i] = (const float*)d_in[i];
    float* CF = (float*)(ws + WS_CF); float* MOD = (float*)(ws + WS_MOD); int* CNT = (int*)(ws + WS_CTL) + CW_CNT;
    int lo = 0;
    auto flush = [&](int upto) { if (upto > lo) launch_mega(a, lo, upto, li, grid, stream); };
    for (int ph = 0; ph < NPHASE; ++ph) {
        bool slow = false;
        switch (ph) {
        case PH_GIN: slow = SLOW_MASK & 1; break;
        case PH_ATT: slow = SLOW_MASK & 2; break;
        case PH_GOUT: case PH_GMO: slow = SLOW_MASK & 4; break;
        case PH_M1_0: case PH_M1_1: slow = SLOW_MASK & 8; break;
        case PH_M2_0: case PH_M2_1: slow = SLOW_MASK & 16; break;
        case PH_GMI: slow = SLOW_MASK & 32; break;
        case PH_SPA: slow = SLOW_MASK & 64; break;
        default: break;
        }
        if (!slow) continue;
        flush(ph); lo = ph + 1;
        const int l = (ph == PH_M1_1 || ph == PH_M2_1) ? 1 : 0;
        switch (ph) {
        case PH_GIN:
            hipLaunchKernelGGL(slow_gemm, dim3(EVEN_IN / 64, NTOK / 64), dim3(256), 0, stream, (const bf16*)(ws + WS_XA), (const int*)nullptr, (const bf16*)(ws + WS_WINT), CF, EVEN_IN, (const int*)nullptr, (size_t)0);
            hipLaunchKernelGGL(slow_gemm, dim3(256 / 64, NCTX / 64), dim3(256), 0, stream, (const bf16*)(ws + WS_GM), (const int*)nullptr, (const bf16*)(ws + WS_WINT) + (size_t)KV_COL * D, CF + (size_t)NTOK * EVEN_IN, 256, (const int*)nullptr, (size_t)0);
            hipLaunchKernelGGL(slow_epi_in, dim3(NTOK * 512 / 256), dim3(256), 0, stream, (const float*)CF, (const float*)(CF + (size_t)NTOK * EVEN_IN), in_[I_EBIN], (bf16*)(ws + WS_GLU), (bf16*)(ws + WS_Q), (bf16*)(ws + WS_K), (bf16*)(ws + WS_V), (bf16*)(ws + WS_KC), (bf16*)(ws + WS_VC));
            break;
        case PH_ATT:
            hipLaunchKernelGGL(slow_attention, dim3(NTOK * 8 / 64), dim3(64), 0, stream, (const bf16*)(ws + WS_Q), (const bf16*)(ws + WS_K), (const bf16*)(ws + WS_V), (const bf16*)(ws + WS_KC), (const bf16*)(ws + WS_VC), in_[I_SINK], (bf16*)(ws + WS_MIX));
            break;
        case PH_GOUT:
            hipLaunchKernelGGL(slow_gemm, dim3(D / 64, NTOK / 64), dim3(256), 0, stream, (const bf16*)(ws + WS_MIX), (const int*)nullptr, (const bf16*)(ws + WS_WOUTT), CF, D, (const int*)nullptr, (size_t)0);
            hipLaunchKernelGGL(slow_epi_res, dim3(NTOK * D / 256), dim3(256), 0, stream, (const float*)CF, in_[I_X], (const bf16*)nullptr, (bf16*)(ws + WS_H), in_[I_EBOUT], (const float*)(MOD + 2 * 1024));
            break;
        case PH_GMO:
            hipLaunchKernelGGL(slow_gemm, dim3(D / 64, NTOK / 64), dim3(256), 0, stream, (const bf16*)(ws + WS_MIX), (const int*)nullptr, (const bf16*)(ws + WS_GWOUTT), CF, D, (const int*)nullptr, (size_t)0);
            hipLaunchKernelGGL(slow_epi_res, dim3(NTOK * D / 256), dim3(256), 0, stream, (const float*)CF, (const float*)nullptr, (const bf16*)(ws + WS_H), (bf16*)(ws + WS_H), in_[I_OBOUT], (const float*)(MOD + (size_t)9 * MODW + 2 * 1024));
            break;
        case PH_M1_0: case PH_M1_1:
            hipLaunchKernelGGL(slow_arow, dim3(ACT_ROWS / 256), dim3(256), 0, stream, (const int*)(CNT + l * NE * CNT_STRIDE), (const int*)(ws + WS_LIST), (int*)(ws + WS_AROW));
            hipLaunchKernelGGL(slow_gemm, dim3(2048 / 64, ACT_ROWS / 64), dim3(256), 0, stream, (const bf16*)(ws + WS_XA), (const int*)(ws + WS_AROW), (const bf16*)(ws + WS_W1T) + (size_t)l * NE * 2048 * 1024, CF, 2048, (const int*)(CNT + l * NE * CNT_STRIDE), (size_t)2048 * 1024);
            hipLaunchKernelGGL(slow_epi_swiglu, dim3(ACT_ROWS * 1024 / 256), dim3(256), 0, stream, (const float*)CF, (const int*)(CNT + l * NE * CNT_STRIDE), in_[I_B1] + (size_t)l * NE * 2048, (bf16*)(ws + WS_ACT));
            break;
        case PH_M2_0: case PH_M2_1:
            hipLaunchKernelGGL(slow_gemm, dim3(1024 / 64, ACT_ROWS / 64), dim3(256), 0, stream, (const bf16*)(ws + WS_ACT), (const int*)nullptr, (const bf16*)(ws + WS_W2T) + (size_t)l * NE * 1024 * 1024, CF, 1024, (const int*)(CNT + l * NE * CNT_STRIDE), (size_t)1024 * 1024);
            hipLaunchKernelGGL(slow_epi_down, dim3(ACT_ROWS * 1024 / 256), dim3(256), 0, stream, (const float*)CF, (const int*)(CNT + l * NE * CNT_STRIDE), (const int*)(ws + WS_LIST), (const float*)(ws + WS_GATE), in_[I_B2] + (size_t)l * NE * D, (bf16*)(ws + WS_Y));
            break;
        case PH_GMI:
            hipLaunchKernelGGL(slow_gemm, dim3(2048 / 64, NTOK / 64), dim3(256), 0, stream, (const bf16*)(ws + WS_XA), (const int*)nullptr, (const bf16*)(ws + WS_GWINT), CF, 2048, (const int*)nullptr, (size_t)0);
            hipLaunchKernelGGL(slow_epi_gelu, dim3(NTOK * 2048 / 256), dim3(256), 0, stream, (const float*)CF, in_[I_OBIN], (bf16*)(ws + WS_U), (bf16*)(ws + WS_VB));
            break;
        case PH_SPA:
            hipLaunchKernelGGL(slow_vstats, dim3(NTOK / 64), dim3(64), 0, stream, (const bf16*)(ws + WS_VB), CF);
            hipLaunchKernelGGL(slow_spatial, dim3(NTOK * D / 256), dim3(256), 0, stream, (const bf16*)(ws + WS_U), (const bf16*)(ws + WS_VB), (const float*)CF, in_[I_OWS], in_[I_OBS], in_[I_OLNG], in_[I_OLNB], (bf16*)(ws + WS_MIX));
            break;
        default: break;
        }
    }
    flush(NPHASE);
}
```
